# Optimizing an MI355X kernel written in HIP

```python
import math
import jax, jax.numpy as jnp
from jax import lax
import numpy as np

D_MODEL = 1024
BATCH = 8
SEQ = 4096
DEPTH = 2

N_A_LAYERS = DEPTH // 2
N_B_LAYERS = DEPTH - N_A_LAYERS
SSM_WIDTH = D_MODEL
SSM_GROUP = 16
SSM_GROUPS = SSM_WIDTH // SSM_GROUP
SSM_STATE = 64
DT_MIN = 1e-3
DT_MAX = 1e-1
N_HEADS = 8
HEAD_DIM = D_MODEL // (2 * N_HEADS)
V_DIM = 2 * HEAD_DIM
QK_WIDTH = N_HEADS * 2 * HEAD_DIM
ATTN_WIDTH = N_HEADS * V_DIM
Q_BLOCK = 128
EPS = 1e-6

kernel_name = "yoco_s5_diffattn_sandwich_adaln"


def rmsnorm(x, g):
    xf = x.astype(jnp.float32)
    y = xf * lax.rsqrt(jnp.mean(xf * xf, axis=-1, keepdims=True) + EPS)
    return (y * g.astype(jnp.float32)).astype(x.dtype)


def adaln(c, w, b):
    mod = jax.nn.silu(c) @ w + b
    shift, scale, gate = jnp.split(mod, 3, axis=-1)
    return shift[:, None, :], scale[:, None, :], gate[:, None, :]


def _linear_recurrence_op(left, right):
    a_l, b_l = left
    a_r, b_r = right
    return a_l * a_r, a_r * b_l + b_r


def s5_mixer(h, w_in, lam_re, lam_im, log_dt, b_re, b_im, c_re, c_im, d_skip, w_glu, b_glu, w_out):
    bsz, seq, _ = h.shape
    u, z = jnp.split(h @ w_in, 2, axis=-1)
    uf = u.astype(jnp.float32).reshape(bsz, seq, SSM_GROUPS, SSM_GROUP)
    lam = lax.complex(lam_re.astype(jnp.float32), lam_im.astype(jnp.float32))
    dt = jnp.exp(log_dt.astype(jnp.float32))[:, None]
    lam_bar = jnp.exp(lam * dt)
    b_mat = lax.complex(b_re.astype(jnp.float32), b_im.astype(jnp.float32))
    b_bar = ((lam_bar - 1.0) / lam)[..., None] * b_mat
    bu = jnp.einsum('blgc,gpc->blgp', uf.astype(jnp.complex64), b_bar)
    a_seq = jnp.broadcast_to(lam_bar, bu.shape)
    _, states = lax.associative_scan(_linear_recurrence_op, (a_seq, bu), axis=1)
    c_mat = lax.complex(c_re.astype(jnp.float32), c_im.astype(jnp.float32))
    y = jnp.einsum('blgp,gcp->blgc', states, c_mat).real
    y = y + d_skip.astype(jnp.float32).reshape(SSM_GROUPS, SSM_GROUP) * uf
    y = jax.nn.gelu(y.reshape(bsz, seq, SSM_WIDTH))
    y = y * jax.nn.sigmoid(y @ w_glu.astype(jnp.float32) + b_glu.astype(jnp.float32))
    y = y * jax.nn.silu(z.astype(jnp.float32))
    return y.astype(h.dtype) @ w_out


def diff_attention(h, k, v, w_in, lq1, lk1, lq2, lk2, g_sub, w_out, lambda_init):
    bsz, seq, _ = h.shape
    q, z = jnp.split(h @ w_in, [QK_WIDTH], axis=-1)
    q = q.astype(jnp.float32).reshape(bsz, seq, N_HEADS, 2, HEAD_DIM)
    lam = (jnp.exp(jnp.sum(lq1.astype(jnp.float32) * lk1.astype(jnp.float32)))
           - jnp.exp(jnp.sum(lq2.astype(jnp.float32) * lk2.astype(jnp.float32))) + lambda_init)
    n_blocks = seq // Q_BLOCK
    qb = q.reshape(bsz, n_blocks, Q_BLOCK, N_HEADS, 2, HEAD_DIM).transpose(1, 0, 2, 3, 4, 5)
    kf = k.astype(jnp.float32)
    vf = v.astype(jnp.float32)
    key_pos = jnp.arange(seq)
    scale = HEAD_DIM ** -0.5

    def block(args):
        q_blk, blk = args
        s = jnp.einsum('bqhcd,bkhcd->bhcqk', q_blk, kf) * scale
        q_pos = blk * Q_BLOCK + jnp.arange(Q_BLOCK)
        mask = key_pos[None, :] <= q_pos[:, None]
        s = jnp.where(mask, s, -jnp.inf)
        p = jax.nn.softmax(s, axis=-1)
        att = p[:, :, 0] - lam * p[:, :, 1]
        return jnp.einsum('bhqk,bkhe->bqhe', att, vf)

    o = lax.map(block, (qb, jnp.arange(n_blocks)))
    o = o.transpose(1, 0, 2, 3, 4).reshape(bsz, seq, N_HEADS, V_DIM)
    o = rmsnorm(o, g_sub) * (1.0 - lambda_init)
    o = o.reshape(bsz, seq, ATTN_WIDTH) * jax.nn.silu(z.astype(jnp.float32))
    return o.astype(h.dtype) @ w_out


def setup_inputs(seed: int = 0) -> dict:
    key = jax.random.key(seed)
    ks = jax.random.split(key, 32)
    D = D_MODEL
    nrm = lambda k, shape, s: jax.random.normal(k, shape, jnp.float32) * s
    lam_im_base = jnp.pi * jnp.arange(SSM_STATE, dtype=jnp.float32)
    return {
        "x": nrm(ks[0], (BATCH, SEQ, D), 1.0),
        "c": nrm(ks[1], (BATCH, D), 1.0),
        "ada_w": nrm(ks[2], (DEPTH, D, 3 * D), D ** -0.5),
        "ada_b": nrm(ks[3], (DEPTH, 3 * D), 0.02),
        "g_pre": 1.0 + nrm(ks[4], (DEPTH, D), 0.02),
        "g_post": 1.0 + nrm(ks[5], (DEPTH, D), 0.02),
        "a_w_in": nrm(ks[6], (N_A_LAYERS, D, 2 * SSM_WIDTH), D ** -0.5),
        "a_lam_re": -0.5 + nrm(ks[7], (N_A_LAYERS, SSM_GROUPS, SSM_STATE), 0.01),
        "a_lam_im": lam_im_base + nrm(ks[8], (N_A_LAYERS, SSM_GROUPS, SSM_STATE), 0.01),
        "a_log_dt": jax.random.uniform(ks[9], (N_A_LAYERS, SSM_GROUPS), jnp.float32,
                                       math.log(DT_MIN), math.log(DT_MAX)),
        "a_b_re": nrm(ks[10], (N_A_LAYERS, SSM_GROUPS, SSM_STATE, SSM_GROUP), (2 * SSM_GROUP) ** -0.5),
        "a_b_im": nrm(ks[11], (N_A_LAYERS, SSM_GROUPS, SSM_STATE, SSM_GROUP), (2 * SSM_GROUP) ** -0.5),
        "a_c_re": nrm(ks[12], (N_A_LAYERS, SSM_GROUPS, SSM_GROUP, SSM_STATE), (2 * SSM_STATE) ** -0.5),
        "a_c_im": nrm(ks[13], (N_A_LAYERS, SSM_GROUPS, SSM_GROUP, SSM_STATE), (2 * SSM_STATE) ** -0.5),
        "a_d": nrm(ks[14], (N_A_LAYERS, SSM_WIDTH), 1.0),
        "a_w_glu": nrm(ks[15], (N_A_LAYERS, SSM_WIDTH, SSM_WIDTH), SSM_WIDTH ** -0.5),
        "a_b_glu": nrm(ks[16], (N_A_LAYERS, SSM_WIDTH), 0.02),
        "a_w_out": nrm(ks[17], (N_A_LAYERS, SSM_WIDTH, D), SSM_WIDTH ** -0.5),
        "g_kv": 1.0 + nrm(ks[18], (D,), 0.02),
        "w_k": nrm(ks[19], (D, QK_WIDTH), D ** -0.5),
        "w_v": nrm(ks[20], (D, ATTN_WIDTH), D ** -0.5),
        "b_w_in": nrm(ks[21], (N_B_LAYERS, D, QK_WIDTH + ATTN_WIDTH), D ** -0.5),
        "b_lq1": nrm(ks[22], (N_B_LAYERS, HEAD_DIM), 0.1),
        "b_lk1": nrm(ks[23], (N_B_LAYERS, HEAD_DIM), 0.1),
        "b_lq2": nrm(ks[24], (N_B_LAYERS, HEAD_DIM), 0.1),
        "b_lk2": nrm(ks[25], (N_B_LAYERS, HEAD_DIM), 0.1),
        "b_g_sub": 1.0 + nrm(ks[26], (N_B_LAYERS, V_DIM), 0.02),
        "b_w_out": nrm(ks[27], (N_B_LAYERS, ATTN_WIDTH, D), ATTN_WIDTH ** -0.5),
    }


def reference(x, c, ada_w, ada_b, g_pre, g_post, a_w_in, a_lam_re, a_lam_im, a_log_dt,
              a_b_re, a_b_im, a_c_re, a_c_im, a_d, a_w_glu, a_b_glu, a_w_out,
              g_kv, w_k, w_v, b_w_in, b_lq1, b_lk1, b_lq2, b_lk2, b_g_sub, b_w_out):
    bsz, seq, _ = x.shape
    h = x
    k = None
    v = None
    for layer in range(DEPTH):
        shift, scale, gate = adaln(c, ada_w[layer], ada_b[layer])
        h_in = rmsnorm(h, g_pre[layer]) * (1.0 + scale) + shift
        if layer < N_A_LAYERS:
            i = layer
            y = s5_mixer(h_in, a_w_in[i], a_lam_re[i], a_lam_im[i], a_log_dt[i], a_b_re[i], a_b_im[i],
                         a_c_re[i], a_c_im[i], a_d[i], a_w_glu[i], a_b_glu[i], a_w_out[i])
        else:
            if layer == N_A_LAYERS:
                kv_in = rmsnorm(h, g_kv)
                k = (kv_in @ w_k).reshape(bsz, seq, N_HEADS, 2, HEAD_DIM)
                v = (kv_in @ w_v).reshape(bsz, seq, N_HEADS, V_DIM)
            j = layer - N_A_LAYERS
            lambda_init = 0.8 - 0.6 * math.exp(-0.3 * layer)
            y = diff_attention(h_in, k, v, b_w_in[j], b_lq1[j], b_lk1[j], b_lq2[j], b_lk2[j],
                               b_g_sub[j], b_w_out[j], lambda_init)
        h = h + gate * rmsnorm(y, g_post[layer])
    return h
```

```cpp
#include <hip/hip_runtime.h>
#include <cstdio>
#include <cstdint>
typedef unsigned short bf16_t;
constexpr int NB = 8, SEQL = 4096, DM = 1024, MTOK = NB * SEQL;
constexpr int NGRP = 64, NTILE = MTOK / 16;
constexpr int US_P = 384, YG_P = 256;
constexpr float LAMBDA_INIT = 0.35550907f;
constexpr float ONE_M_LI = 1.0f - LAMBDA_INIT;
constexpr float RMS_EPS = 1e-6f;
constexpr float QC2 = 0.125f * 1.4426950408889634f;

__device__ __forceinline__ float bf2f(bf16_t v) { return __uint_as_float((unsigned)v << 16); }
__device__ __forceinline__ unsigned f2bf_u(float f) { unsigned u = __float_as_uint(f); return (u + 0x7fffu + ((u >> 16) & 1u)) >> 16; }
__device__ __forceinline__ bf16_t f2bf(float f) { return (bf16_t)f2bf_u(f); }
__device__ __forceinline__ unsigned pk2bf(float lo, float hi) { return f2bf_u(lo) | (f2bf_u(hi) << 16); }
__device__ __forceinline__ float silu_f(float v) { return v / (1.0f + __expf(-v)); }
__device__ __forceinline__ float sigmoid_f(float v) { return 1.0f / (1.0f + __expf(-v)); }
__device__ __forceinline__ float gelu_tanh_f(float v) {
    const float u = 0.7978845608028654f * (v + 0.044715f * v * v * v);
    const float e = __expf(2.0f * u);
    const float t = 1.0f - 2.0f / (e + 1.0f);
    return 0.5f * v * (1.0f + t);
}
__device__ __forceinline__ float wave_sum_f(float v) {
#pragma unroll
    for (int o = 1; o < 64; o <<= 1) v += __shfl_xor(v, o);
    return v;
}
__device__ __forceinline__ float wave_max_f(float v) {
#pragma unroll
    for (int o = 1; o < 64; o <<= 1) v = fmaxf(v, __shfl_xor(v, o));
    return v;
}
__device__ __forceinline__ size_t us_off(int g, int tile, int col) { return ((size_t)g * NTILE + tile) * US_P + col; }
__device__ __forceinline__ size_t yg_off(int g, int tile, int col) { return ((size_t)g * NTILE + tile) * YG_P + col; }

typedef float f32x4_t __attribute__((ext_vector_type(4)));
typedef unsigned u32x4_t __attribute__((ext_vector_type(4)));
typedef unsigned u32x2_t __attribute__((ext_vector_type(2)));

__device__ __forceinline__ void e_norm0(const float* __restrict__ x, const float* __restrict__ mod, const float* __restrict__ g_pre, bf16_t* a0, int gw, int ngw, int lane) {
    for (int m = gw; m < MTOK; m += ngw) {
        const int b = m / SEQL;
        const f32x4_t* xr = (const f32x4_t*)(x + (size_t)m * DM) + lane;
        f32x4_t v[4]; float s = 0.f;
#pragma unroll
        for (int j = 0; j < 4; ++j) { v[j] = xr[64 * j]; s += (v[j].x * v[j].x + v[j].y * v[j].y) + (v[j].z * v[j].z + v[j].w * v[j].w); }
        const float r = rsqrtf(wave_sum_f(s) * (1.0f / DM) + RMS_EPS);
        const float* sh = mod + (size_t)b * 3072; const float* sc = sh + 1024;
        u32x2_t* o = (u32x2_t*)(a0 + (size_t)m * DM) + lane;
#pragma unroll
        for (int j = 0; j < 4; ++j) {
            const int c = 256 * j + 4 * lane;
            const f32x4_t g = *(const f32x4_t*)(g_pre + c), scv = *(const f32x4_t*)(sc + c), shv = *(const f32x4_t*)(sh + c);
            f32x4_t y = v[j] * r * g * (scv + 1.0f) + shv;
            u32x2_t w; w.x = pk2bf(y.x, y.y); w.y = pk2bf(y.z, y.w); o[64 * j] = w;
        }
    }
}
__device__ __forceinline__ void e_mid(const float* __restrict__ x, const bf16_t* __restrict__ yo, const float* __restrict__ mod, const float* __restrict__ g_post, const float* __restrict__ g_pre,
                                      float* h1, bf16_t* akv, bf16_t* ain1, int gw, int ngw, int lane) {
    for (int m = gw; m < MTOK; m += ngw) {
        const int b = m / SEQL;
        const f32x4_t* xr = (const f32x4_t*)(x + (size_t)m * DM) + lane;
        const u32x2_t* yr = (const u32x2_t*)(yo + (size_t)m * DM) + lane;
        f32x4_t v[4], y[4]; float s = 0.f;
#pragma unroll
        for (int j = 0; j < 4; ++j) { v[j] = xr[64 * j]; const u32x2_t w = yr[64 * j];
            y[j].x = __uint_as_float(w.x << 16); y[j].y = __uint_as_float(w.x & 0xffff0000u); y[j].z = __uint_as_float(w.y << 16); y[j].w = __uint_as_float(w.y & 0xffff0000u);
            s += (y[j].x * y[j].x + y[j].y * y[j].y) + (y[j].z * y[j].z + y[j].w * y[j].w); }
        const float ry = rsqrtf(wave_sum_f(s) * (1.0f / DM) + RMS_EPS);
        const float* gate0 = mod + (size_t)b * 3072 + 2048;
        const float* sh1 = mod + (size_t)(8 + b) * 3072; const float* sc1 = sh1 + 1024;
        float s2 = 0.f;
        f32x4_t* ho = (f32x4_t*)(h1 + (size_t)m * DM) + lane;
#pragma unroll
        for (int j = 0; j < 4; ++j) { const int c = 256 * j + 4 * lane;
            const f32x4_t gp = *(const f32x4_t*)(g_post + c), gt = *(const f32x4_t*)(gate0 + c);
            v[j] = v[j] + gt * (y[j] * ry * gp);
            ho[64 * j] = v[j];
            s2 += (v[j].x * v[j].x + v[j].y * v[j].y) + (v[j].z * v[j].z + v[j].w * v[j].w); }
        const float rh = rsqrtf(wave_sum_f(s2) * (1.0f / DM) + RMS_EPS);
        u32x2_t* o1 = (u32x2_t*)(akv + (size_t)m * DM) + lane; u32x2_t* o2 = (u32x2_t*)(ain1 + (size_t)m * DM) + lane;
#pragma unroll
        for (int j = 0; j < 4; ++j) { const int c = 256 * j + 4 * lane;
            const f32x4_t n = v[j] * rh;
            u32x2_t w; w.x = pk2bf(n.x, n.y); w.y = pk2bf(n.z, n.w); o1[64 * j] = w;
            const f32x4_t g = *(const f32x4_t*)(g_pre + 1024 + c), scv = *(const f32x4_t*)(sc1 + c), shv = *(const f32x4_t*)(sh1 + c);
            const f32x4_t z = n * g * (scv + 1.0f) + shv;
            w.x = pk2bf(z.x, z.y); w.y = pk2bf(z.z, z.w); o2[64 * j] = w; }
    }
}
__device__ __forceinline__ void e_attn_post(const bf16_t* __restrict__ o0, const bf16_t* __restrict__ o1, const bf16_t* __restrict__ sz1, const float* __restrict__ g_sub, float lam,
                                            bf16_t* og, int gw, int ngw, int lane) {
    for (int m = gw; m < MTOK; m += ngw) {
#pragma unroll
        for (int j = 0; j < 2; ++j) {
            const int c = 512 * j + 8 * lane;
            const u32x4_t a = *(const u32x4_t*)(o0 + (size_t)m * DM + c), bq = *(const u32x4_t*)(o1 + (size_t)m * DM + c), zq = *(const u32x4_t*)(sz1 + (size_t)m * DM + c);
            float d[8]; float s = 0.f;
#pragma unroll
            for (int i = 0; i < 4; ++i) { const unsigned wa = a[i], wb = bq[i];
                d[2 * i] = __uint_as_float(wa << 16) - lam * __uint_as_float(wb << 16); d[2 * i + 1] = __uint_as_float(wa & 0xffff0000u) - lam * __uint_as_float(wb & 0xffff0000u);
                s += d[2 * i] * d[2 * i] + d[2 * i + 1] * d[2 * i + 1]; }
            s += __shfl_xor(s, 1); s += __shfl_xor(s, 2); s += __shfl_xor(s, 4); s += __shfl_xor(s, 8);
            const float r = rsqrtf(s * (1.0f / 128.0f) + RMS_EPS) * ONE_M_LI;
            const float* gs = g_sub + (c & 127);
            u32x4_t w;
#pragma unroll
            for (int i = 0; i < 4; ++i) { const unsigned wz = zq[i];
                const float z0 = __uint_as_float(wz << 16), z1 = __uint_as_float(wz & 0xffff0000u);
                w[i] = pk2bf(d[2 * i] * r * gs[2 * i] * z0, d[2 * i + 1] * r * gs[2 * i + 1] * z1); }
            *(u32x4_t*)(og + (size_t)m * DM + c) = w;
        }
    }
}
__device__ __forceinline__ void e_final(float* out, const bf16_t* __restrict__ yo1, const float* __restrict__ mod, const float* __restrict__ g_post, int gw, int ngw, int lane) {
    for (int m = gw; m < MTOK; m += ngw) {
        const int b = m / SEQL;
        f32x4_t* hr = (f32x4_t*)(out + (size_t)m * DM) + lane;
        const u32x2_t* yr = (const u32x2_t*)(yo1 + (size_t)m * DM) + lane;
        f32x4_t v[4], y[4]; float s = 0.f;
#pragma unroll
        for (int j = 0; j < 4; ++j) { v[j] = hr[64 * j]; const u32x2_t w = yr[64 * j];
            y[j].x = __uint_as_float(w.x << 16); y[j].y = __uint_as_float(w.x & 0xffff0000u); y[j].z = __uint_as_float(w.y << 16); y[j].w = __uint_as_float(w.y & 0xffff0000u);
            s += (y[j].x * y[j].x + y[j].y * y[j].y) + (y[j].z * y[j].z + y[j].w * y[j].w); }
        const float ry = rsqrtf(wave_sum_f(s) * (1.0f / DM) + RMS_EPS);
        const float* gate1 = mod + (size_t)(8 + b) * 3072 + 2048;
#pragma unroll
        for (int j = 0; j < 4; ++j) { const int c = 256 * j + 4 * lane;
            const f32x4_t gp = *(const f32x4_t*)(g_post + 1024 + c), gt = *(const f32x4_t*)(gate1 + c);
            hr[64 * j] = v[j] + gt * (y[j] * ry * gp); }
    }
}
__device__ __forceinline__ float diff_lambda(const float* lq1, const float* lk1, const float* lq2, const float* lk2) {
    float s1 = 0.f, s2 = 0.f;
    for (int i = 0; i < 64; ++i) { s1 += lq1[i] * lk1[i]; s2 += lq2[i] * lk2[i]; }
    return expf(s1) - expf(s2) + LAMBDA_INIT;
}

__global__ void n_adaln(const float* __restrict__ c, const float* __restrict__ ada_w, const float* __restrict__ ada_b, float* mod) {
    const int idx = blockIdx.x * 256 + threadIdx.x;
    if (idx >= 2 * 8 * 3072) return;
    const int j = idx % 3072, b = (idx / 3072) % 8, l = idx / (3072 * 8);
    float acc = ada_b[l * 3072 + j];
    const float* w = ada_w + (size_t)l * 1024 * 3072 + j; const float* cb = c + b * 1024;
    for (int k = 0; k < 1024; ++k) acc += silu_f(cb[k]) * w[(size_t)k * 3072];
    mod[idx] = acc;
}
__global__ void n_lambda(const float* lq1, const float* lk1, const float* lq2, const float* lk2, float* out) {
    if (threadIdx.x == 0 && blockIdx.x == 0) out[0] = diff_lambda(lq1, lk1, lq2, lk2);
}
__global__ void n_norm0(const float* x, const float* mod, const float* g_pre, bf16_t* a0) {
    e_norm0(x, mod, g_pre, a0, blockIdx.x * 4 + (threadIdx.x >> 6), gridDim.x * 4, threadIdx.x & 63);
}
__global__ void n_mid(const float* x, const bf16_t* yo, const float* mod, const float* g_post, const float* g_pre, float* h1, bf16_t* akv, bf16_t* ain1) {
    e_mid(x, yo, mod, g_post, g_pre, h1, akv, ain1, blockIdx.x * 4 + (threadIdx.x >> 6), gridDim.x * 4, threadIdx.x & 63);
}
__global__ void n_attn_post(const bf16_t* o0, const bf16_t* o1, const bf16_t* sz1, const float* g_sub, const float* lamp, bf16_t* og) {
    e_attn_post(o0, o1, sz1, g_sub, lamp[0], og, blockIdx.x * 4 + (threadIdx.x >> 6), gridDim.x * 4, threadIdx.x & 63);
}
__global__ void n_final(float* out, const bf16_t* yo1, const float* mod, const float* g_post) {
    e_final(out, yo1, mod, g_post, blockIdx.x * 4 + (threadIdx.x >> 6), gridDim.x * 4, threadIdx.x & 63);
}

struct AL_Row { const bf16_t* A; __device__ float ld(int m, int k) const { return bf2f(A[(size_t)m * DM + k]); } };
struct AL_YG  { const bf16_t* A; __device__ float ld(int m, int k) const { return bf2f(A[yg_off(k >> 4, m >> 4, (m & 15) * 16 + (k & 15))]); } };
struct WL_Plain { const float* W; long N; __device__ float ld(int k, int n) const { return W[(size_t)k * N + n]; } };
struct WL_KV { const float* wk; const float* wv; const float* g; __device__ float ld(int k, int n) const { return g[k] * (n < 1024 ? wk[(size_t)k * 1024 + n] : wv[(size_t)k * 1024 + n - 1024]); } };
struct EP_In0 { bf16_t* US; bf16_t* SZ; __device__ void st(int m, int n, float a) const {
    if (n < 1024) US[us_off(n >> 4, m >> 4, (m & 15) * 16 + (n & 15))] = f2bf(a); else SZ[(size_t)m * DM + n - 1024] = f2bf(silu_f(a)); } };
struct EP_Glu { const bf16_t* YG; const bf16_t* SZ; const float* bias; bf16_t* Y2; __device__ void st(int m, int n, float a) const {
    const float yv = bf2f(YG[yg_off(n >> 4, m >> 4, (m & 15) * 16 + (n & 15))]); const float t = a + bias[n];
    Y2[(size_t)m * DM + n] = f2bf(yv * sigmoid_f(t) * bf2f(SZ[(size_t)m * DM + n])); } };
struct EP_Plain { bf16_t* O; __device__ void st(int m, int n, float a) const { O[(size_t)m * DM + n] = f2bf(a); } };
struct EP_KV { bf16_t* K; bf16_t* V; __device__ void st(int m, int n, float a) const { if (n < 1024) K[(size_t)m * DM + n] = f2bf(a); else V[(size_t)m * DM + n - 1024] = f2bf(a); } };
struct EP_In1 { bf16_t* Q; bf16_t* SZ1; __device__ void st(int m, int n, float a) const { if (n < 1024) Q[(size_t)m * DM + n] = f2bf(a * QC2); else SZ1[(size_t)m * DM + n - 1024] = f2bf(silu_f(a)); } };

template <class AL, class WL, class EP>
__global__ void __launch_bounds__(256) n_gemm(AL al, WL wl, EP ep, int N) {
    __shared__ float As[16][68]; __shared__ float Ws[16][68];
    const int tid = threadIdx.x, tx = tid & 15, ty = tid >> 4;
    const int m0 = blockIdx.y * 64, n0 = blockIdx.x * 64;
    float acc[4][4];
#pragma unroll
    for (int i = 0; i < 4; ++i)
#pragma unroll
        for (int j = 0; j < 4; ++j) acc[i][j] = 0.f;
    for (int k0 = 0; k0 < 1024; k0 += 16) {
#pragma unroll
        for (int i = 0; i < 4; ++i) { const int e = tid + 256 * i; const int mm = e >> 4, kk = e & 15; As[kk][mm] = al.ld(m0 + mm, k0 + kk); }
#pragma unroll
        for (int i = 0; i < 4; ++i) { const int e = tid + 256 * i; const int kk = e >> 6, nn = e & 63; Ws[kk][nn] = wl.ld(k0 + kk, n0 + nn); }
        __syncthreads();
#pragma unroll
        for (int kk = 0; kk < 16; ++kk) {
            float a[4], b[4];
#pragma unroll
            for (int i = 0; i < 4; ++i) { a[i] = As[kk][ty * 4 + i]; b[i] = Ws[kk][tx * 4 + i]; }
#pragma unroll
            for (int i = 0; i < 4; ++i)
#pragma unroll
                for (int j = 0; j < 4; ++j) acc[i][j] += a[i] * b[j];
        }
        __syncthreads();
    }
#pragma unroll
    for (int i = 0; i < 4; ++i)
#pragma unroll
        for (int j = 0; j < 4; ++j) ep.st(m0 + ty * 4 + i, n0 + tx * 4 + j, acc[i][j]);
}

__global__ void __launch_bounds__(256) n_ssm(const bf16_t* __restrict__ US, const float* lam_re, const float* lam_im, const float* log_dt, const float* b_re, const float* b_im,
                                             const float* c_re, const float* c_im, const float* d_skip, bf16_t* YG) {
    const int wv = blockIdx.x * 4 + (threadIdx.x >> 6), lane = threadIdx.x & 63;
    if (wv >= NB * NGRP) return;
    const int b = wv / NGRP, g = wv % NGRP, p = lane;
    const float dt = expf(log_dt[g]);
    const float lr = lam_re[g * 64 + p], li = lam_im[g * 64 + p];
    const float mag = expf(lr * dt); float sn, cs; sn = sinf(li * dt); cs = cosf(li * dt);
    const float lbr = mag * cs, lbi = mag * sn;
    const float nr = lbr - 1.0f, ni = lbi, den = lr * lr + li * li;
    const float cr = (nr * lr + ni * li) / den, ci = (ni * lr - nr * li) / den;
    float bbr[16], bbi[16], ccr[16], cci[16];
#pragma unroll
    for (int c = 0; c < 16; ++c) { const float br = b_re[(g * 64 + p) * 16 + c], bi = b_im[(g * 64 + p) * 16 + c];
        bbr[c] = cr * br - ci * bi; bbi[c] = cr * bi + ci * br;
        ccr[c] = c_re[(g * 16 + c) * 64 + p]; cci[c] = c_im[(g * 16 + c) * 64 + p]; }
    const float dsk = d_skip[g * 16 + (lane & 15)];
    float sr = 0.f, si = 0.f;
    for (int t = 0; t < SEQL; ++t) {
        const int m = b * SEQL + t;
        const bf16_t* up = US + us_off(g, m >> 4, (m & 15) * 16);
        float u[16];
        { const u32x4_t w0 = *(const u32x4_t*)up, w1 = *(const u32x4_t*)(up + 8);
#pragma unroll
          for (int i = 0; i < 4; ++i) { u[2 * i] = __uint_as_float(w0[i] << 16); u[2 * i + 1] = __uint_as_float(w0[i] & 0xffff0000u); u[8 + 2 * i] = __uint_as_float(w1[i] << 16); u[8 + 2 * i + 1] = __uint_as_float(w1[i] & 0xffff0000u); } }
        float bur = 0.f, bui = 0.f;
#pragma unroll
        for (int c = 0; c < 16; ++c) { bur += bbr[c] * u[c]; bui += bbi[c] * u[c]; }
        const float nsr = lbr * sr - lbi * si + bur, nsi = lbr * si + lbi * sr + bui; sr = nsr; si = nsi;
        float yv = 0.f;
#pragma unroll
        for (int c = 0; c < 16; ++c) { const float part = wave_sum_f(ccr[c] * sr - cci[c] * si); if ((lane & 15) == c) yv = part; }
        if (lane < 16) { const float yy = yv + dsk * bf2f(up[lane]); YG[yg_off(g, m >> 4, (m & 15) * 16 + lane)] = f2bf(gelu_tanh_f(yy)); }
    }
}

__global__ void __launch_bounds__(256) n_attn(const bf16_t* __restrict__ Q, const bf16_t* __restrict__ K, const bf16_t* __restrict__ V, bf16_t* O0, bf16_t* O1) {
    __shared__ float qs[4][128];
    const int w = threadIdx.x >> 6, lane = threadIdx.x & 63;
    const int gwv = blockIdx.x * 4 + w;
    const int h = gwv & 7, m = gwv >> 3, b = m / SEQL, qi = m % SEQL;
    qs[w][lane] = bf2f(Q[(size_t)m * DM + h * 128 + lane]); qs[w][64 + lane] = bf2f(Q[(size_t)m * DM + h * 128 + 64 + lane]);
    __syncthreads();
    float m0 = -1e30f, m1 = -1e30f, l0 = 0.f, l1 = 0.f, a00 = 0.f, a01 = 0.f, a10 = 0.f, a11 = 0.f;
    const size_t rb = (size_t)b * SEQL;
    for (int kc = 0; kc * 64 <= qi; ++kc) {
        const int key = kc * 64 + lane; const bool valid = key <= qi;
        float s0 = 0.f, s1 = 0.f;
        { const bf16_t* kr = K + (rb + (valid ? key : qi)) * DM + h * 128;
#pragma unroll
          for (int ch = 0; ch < 8; ++ch) { const u32x4_t w0 = *(const u32x4_t*)(kr + ch * 8), w1 = *(const u32x4_t*)(kr + 64 + ch * 8);
#pragma unroll
            for (int i = 0; i < 4; ++i) { s0 += qs[w][ch * 8 + 2 * i] * __uint_as_float(w0[i] << 16) + qs[w][ch * 8 + 2 * i + 1] * __uint_as_float(w0[i] & 0xffff0000u);
                                          s1 += qs[w][64 + ch * 8 + 2 * i] * __uint_as_float(w1[i] << 16) + qs[w][64 + ch * 8 + 2 * i + 1] * __uint_as_float(w1[i] & 0xffff0000u); } } }
        if (!valid) { s0 = -1e30f; s1 = -1e30f; }
        const float nm0 = fmaxf(m0, wave_max_f(s0)), nm1 = fmaxf(m1, wave_max_f(s1));
        const float f0 = exp2f(m0 - nm0), f1 = exp2f(m1 - nm1);
        const float p0 = valid ? exp2f(s0 - nm0) : 0.f, p1 = valid ? exp2f(s1 - nm1) : 0.f;
        l0 = l0 * f0 + wave_sum_f(p0); l1 = l1 * f1 + wave_sum_f(p1); m0 = nm0; m1 = nm1;
        a00 *= f0; a01 *= f0; a10 *= f1; a11 *= f1;
        const int nk = min(64, qi - kc * 64 + 1);
        for (int j = 0; j < nk; ++j) {
            const float pj0 = __shfl(p0, j), pj1 = __shfl(p1, j);
            const bf16_t* vr = V + (rb + kc * 64 + j) * DM + h * 128;
            const float v0 = bf2f(vr[lane]), v1 = bf2f(vr[64 + lane]);
            a00 += pj0 * v0; a01 += pj0 * v1; a10 += pj1 * v0; a11 += pj1 * v1;
        }
    }
    const float i0 = 1.0f / l0, i1 = 1.0f / l1;
    O0[(size_t)m * DM + h * 128 + lane] = f2bf(a00 * i0); O0[(size_t)m * DM + h * 128 + 64 + lane] = f2bf(a01 * i0);
    O1[(size_t)m * DM + h * 128 + lane] = f2bf(a10 * i1); O1[(size_t)m * DM + h * 128 + 64 + lane] = f2bf(a11 * i1);
}
constexpr size_t MiB = 1u << 20;
constexpr size_t WS_CTL = 0;
constexpr size_t WS_MOD = 256 * 1024, WS_LAM = 512 * 1024;
constexpr size_t WS_S0 = 48 * MiB, WS_S1 = 112 * MiB, WS_S2 = 176 * MiB, WS_S3 = 240 * MiB, WS_S4 = 304 * MiB, WS_S5 = 368 * MiB, WS_S6 = 432 * MiB, WS_END = 496 * MiB;

extern "C" void kernel_launch(void* const* d_in, const int* in_sizes, int n_in, void* d_out, int out_size, void* d_ws, size_t ws_size, hipStream_t stream) {
    const float* x = (const float*)d_in[0]; const float* c = (const float*)d_in[1]; const float* ada_w = (const float*)d_in[2]; const float* ada_b = (const float*)d_in[3];
    const float* g_pre = (const float*)d_in[4]; const float* g_post = (const float*)d_in[5]; const float* a_w_in = (const float*)d_in[6];
    const float* a_lam_re = (const float*)d_in[7]; const float* a_lam_im = (const float*)d_in[8]; const float* a_log_dt = (const float*)d_in[9];
    const float* a_b_re = (const float*)d_in[10]; const float* a_b_im = (const float*)d_in[11]; const float* a_c_re = (const float*)d_in[12]; const float* a_c_im = (const float*)d_in[13];
    const float* a_d = (const float*)d_in[14]; const float* a_w_glu = (const float*)d_in[15]; const float* a_b_glu = (const float*)d_in[16]; const float* a_w_out = (const float*)d_in[17];
    const float* g_kv = (const float*)d_in[18]; const float* w_k = (const float*)d_in[19]; const float* w_v = (const float*)d_in[20]; const float* b_w_in = (const float*)d_in[21];
    const float* b_lq1 = (const float*)d_in[22]; const float* b_lk1 = (const float*)d_in[23]; const float* b_lq2 = (const float*)d_in[24]; const float* b_lk2 = (const float*)d_in[25];
    const float* b_g_sub = (const float*)d_in[26]; const float* b_w_out = (const float*)d_in[27];
    float* out = (float*)d_out; unsigned char* ws = (unsigned char*)d_ws;
    if (ws_size < WS_END) { fprintf(stderr, "ws too small: %zu\n", ws_size); return; }
    float* mod = (float*)(ws + WS_MOD); float* lam = (float*)(ws + WS_LAM);
    bf16_t* A0 = (bf16_t*)(ws + WS_S0); bf16_t* US = (bf16_t*)(ws + WS_S1); bf16_t* SZ = (bf16_t*)(ws + WS_S3); bf16_t* YG = (bf16_t*)(ws + WS_S4);
    bf16_t* Y2 = (bf16_t*)(ws + WS_S0); bf16_t* YO = (bf16_t*)(ws + WS_S1); bf16_t* AKV = (bf16_t*)(ws + WS_S0); bf16_t* AIN1 = (bf16_t*)(ws + WS_S2);
    bf16_t* KB = (bf16_t*)(ws + WS_S3); bf16_t* VB = (bf16_t*)(ws + WS_S4); bf16_t* QB = (bf16_t*)(ws + WS_S5); bf16_t* SZ1 = (bf16_t*)(ws + WS_S6);
    bf16_t* O0 = (bf16_t*)(ws + WS_S0); bf16_t* O1 = (bf16_t*)(ws + WS_S1); bf16_t* OG = (bf16_t*)(ws + WS_S2); bf16_t* YO1 = (bf16_t*)(ws + WS_S0);
    const int EG = 2048;
    n_adaln<<<(2 * 8 * 3072 + 255) / 256, 256, 0, stream>>>(c, ada_w, ada_b, mod);
    n_lambda<<<1, 64, 0, stream>>>(b_lq1, b_lk1, b_lq2, b_lk2, lam);
    n_norm0<<<EG, 256, 0, stream>>>(x, mod, g_pre, A0);
    n_gemm<<<dim3(2048 / 64, MTOK / 64), 256, 0, stream>>>(AL_Row{A0}, WL_Plain{a_w_in, 2048}, EP_In0{US, SZ}, 2048);
    n_ssm<<<NB * NGRP / 4, 256, 0, stream>>>(US, a_lam_re, a_lam_im, a_log_dt, a_b_re, a_b_im, a_c_re, a_c_im, a_d, YG);
    n_gemm<<<dim3(1024 / 64, MTOK / 64), 256, 0, stream>>>(AL_YG{YG}, WL_Plain{a_w_glu, 1024}, EP_Glu{YG, SZ, a_b_glu, Y2}, 1024);
    n_gemm<<<dim3(1024 / 64, MTOK / 64), 256, 0, stream>>>(AL_Row{Y2}, WL_Plain{a_w_out, 1024}, EP_Plain{YO}, 1024);
    n_mid<<<EG, 256, 0, stream>>>(x, YO, mod, g_post, g_pre, out, AKV, AIN1);
    n_gemm<<<dim3(2048 / 64, MTOK / 64), 256, 0, stream>>>(AL_Row{AKV}, WL_KV{w_k, w_v, g_kv}, EP_KV{KB, VB}, 2048);
    n_gemm<<<dim3(2048 / 64, MTOK / 64), 256, 0, stream>>>(AL_Row{AIN1}, WL_Plain{b_w_in, 2048}, EP_In1{QB, SZ1}, 2048);
    n_attn<<<MTOK * 8 / 4, 256, 0, stream>>>(QB, KB, VB, O0, O1);
    n_attn_post<<<EG, 256, 0, stream>>>(O0, O1, SZ1, b_g_sub, lam, OG);
    n_gemm<<<dim3(1024 / 64, MTOK / 64), 256, 0, stream>>>(AL_Row{OG}, WL_Plain{b_w_out, 1024}, EP_Plain{YO1}, 1024);
    n_final<<<EG, 256, 0, stream>>>(out, YO1, mod, g_post);
}
```

```cpp
#include <hip/hip_runtime.h>
#include <cstdio>
#include <cstdint>
#include <cmath>
#define FASTMASK 0x3fff
#define ONE_LAUNCH 0
typedef unsigned short bf16_t;
constexpr int NB = 8, SEQL = 4096, DM = 1024, MTOK = NB * SEQL;
constexpr int NGRP = 64, NTILE = MTOK / 16;
constexpr int US_P = 384, YG_P = 256;
constexpr float LAMBDA_INIT = 0.35550907f;
constexpr float ONE_M_LI = 1.0f - LAMBDA_INIT;
constexpr float RMS_EPS = 1e-6f;
constexpr float QC2 = 0.125f * 1.4426950408889634f;

__device__ __forceinline__ float bf2f(bf16_t v) { return __uint_as_float((unsigned)v << 16); }
__device__ __forceinline__ unsigned f2bf_u(float f) { unsigned u = __float_as_uint(f); return (u + 0x7fffu + ((u >> 16) & 1u)) >> 16; }
__device__ __forceinline__ bf16_t f2bf(float f) { return (bf16_t)f2bf_u(f); }
__device__ __forceinline__ unsigned pk2bf(float lo, float hi) { return f2bf_u(lo) | (f2bf_u(hi) << 16); }
__device__ __forceinline__ float silu_f(float v) { return v / (1.0f + __expf(-v)); }
__device__ __forceinline__ float sigmoid_f(float v) { return 1.0f / (1.0f + __expf(-v)); }
__device__ __forceinline__ float gelu_tanh_f(float v) {
    const float u = 0.7978845608028654f * (v + 0.044715f * v * v * v);
    const float e = __expf(2.0f * u);
    const float t = 1.0f - 2.0f / (e + 1.0f);
    return 0.5f * v * (1.0f + t);
}
__device__ __forceinline__ float wave_sum_f(float v) {
#pragma unroll
    for (int o = 1; o < 64; o <<= 1) v += __shfl_xor(v, o);
    return v;
}
__device__ __forceinline__ float wave_max_f(float v) {
#pragma unroll
    for (int o = 1; o < 64; o <<= 1) v = fmaxf(v, __shfl_xor(v, o));
    return v;
}
__device__ __forceinline__ size_t us_off(int g, int tile, int col) { return ((size_t)g * NTILE + tile) * US_P + col; }
__device__ __forceinline__ size_t yg_off(int g, int tile, int col) { return ((size_t)g * NTILE + tile) * YG_P + col; }

typedef float f32x4_t __attribute__((ext_vector_type(4)));
typedef unsigned u32x4_t __attribute__((ext_vector_type(4)));
typedef unsigned u32x2_t __attribute__((ext_vector_type(2)));

__device__ __forceinline__ void e_norm0(const float* __restrict__ x, const float* __restrict__ mod, const float* __restrict__ g_pre, bf16_t* a0, int gw, int ngw, int lane) {
    for (int m = gw; m < MTOK; m += ngw) {
        const int b = m / SEQL;
        const f32x4_t* xr = (const f32x4_t*)(x + (size_t)m * DM) + lane;
        f32x4_t v[4]; float s = 0.f;
#pragma unroll
        for (int j = 0; j < 4; ++j) { v[j] = xr[64 * j]; s += (v[j].x * v[j].x + v[j].y * v[j].y) + (v[j].z * v[j].z + v[j].w * v[j].w); }
        const float r = rsqrtf(wave_sum_f(s) * (1.0f / DM) + RMS_EPS);
        const float* sh = mod + (size_t)b * 3072; const float* sc = sh + 1024;
        u32x2_t* o = (u32x2_t*)(a0 + (size_t)m * DM) + lane;
#pragma unroll
        for (int j = 0; j < 4; ++j) {
            const int c = 256 * j + 4 * lane;
            const f32x4_t g = *(const f32x4_t*)(g_pre + c), scv = *(const f32x4_t*)(sc + c), shv = *(const f32x4_t*)(sh + c);
            f32x4_t y = v[j] * r * g * (scv + 1.0f) + shv;
            u32x2_t w; w.x = pk2bf(y.x, y.y); w.y = pk2bf(y.z, y.w); o[64 * j] = w;
        }
    }
}
__device__ __forceinline__ void e_mid(const float* __restrict__ x, const bf16_t* __restrict__ yo, const float* __restrict__ mod, const float* __restrict__ g_post, const float* __restrict__ g_pre,
                                      float* h1, bf16_t* akv, bf16_t* ain1, int gw, int ngw, int lane) {
    for (int m = gw; m < MTOK; m += ngw) {
        const int b = m / SEQL;
        const f32x4_t* xr = (const f32x4_t*)(x + (size_t)m * DM) + lane;
        const u32x2_t* yr = (const u32x2_t*)(yo + (size_t)m * DM) + lane;
        f32x4_t v[4], y[4]; float s = 0.f;
#pragma unroll
        for (int j = 0; j < 4; ++j) { v[j] = xr[64 * j]; const u32x2_t w = yr[64 * j];
            y[j].x = __uint_as_float(w.x << 16); y[j].y = __uint_as_float(w.x & 0xffff0000u); y[j].z = __uint_as_float(w.y << 16); y[j].w = __uint_as_float(w.y & 0xffff0000u);
            s += (y[j].x * y[j].x + y[j].y * y[j].y) + (y[j].z * y[j].z + y[j].w * y[j].w); }
        const float ry = rsqrtf(wave_sum_f(s) * (1.0f / DM) + RMS_EPS);
        const float* gate0 = mod + (size_t)b * 3072 + 2048;
        const float* sh1 = mod + (size_t)(8 + b) * 3072; const float* sc1 = sh1 + 1024;
        float s2 = 0.f;
        f32x4_t* ho = (f32x4_t*)(h1 + (size_t)m * DM) + lane;
#pragma unroll
        for (int j = 0; j < 4; ++j) { const int c = 256 * j + 4 * lane;
            const f32x4_t gp = *(const f32x4_t*)(g_post + c), gt = *(const f32x4_t*)(gate0 + c);
            v[j] = v[j] + gt * (y[j] * ry * gp);
            ho[64 * j] = v[j];
            s2 += (v[j].x * v[j].x + v[j].y * v[j].y) + (v[j].z * v[j].z + v[j].w * v[j].w); }
        const float rh = rsqrtf(wave_sum_f(s2) * (1.0f / DM) + RMS_EPS);
        u32x2_t* o1 = (u32x2_t*)(akv + (size_t)m * DM) + lane; u32x2_t* o2 = (u32x2_t*)(ain1 + (size_t)m * DM) + lane;
#pragma unroll
        for (int j = 0; j < 4; ++j) { const int c = 256 * j + 4 * lane;
            const f32x4_t n = v[j] * rh;
            u32x2_t w; w.x = pk2bf(n.x, n.y); w.y = pk2bf(n.z, n.w); o1[64 * j] = w;
            const f32x4_t g = *(const f32x4_t*)(g_pre + 1024 + c), scv = *(const f32x4_t*)(sc1 + c), shv = *(const f32x4_t*)(sh1 + c);
            const f32x4_t z = n * g * (scv + 1.0f) + shv;
            w.x = pk2bf(z.x, z.y); w.y = pk2bf(z.z, z.w); o2[64 * j] = w; }
    }
}
__device__ __forceinline__ void e_attn_post(const bf16_t* __restrict__ o0, const bf16_t* __restrict__ o1, const bf16_t* __restrict__ sz1, const float* __restrict__ g_sub, float lam,
                                            bf16_t* og, int gw, int ngw, int lane) {
    for (int m = gw; m < MTOK; m += ngw) {
#pragma unroll
        for (int j = 0; j < 2; ++j) {
            const int c = 512 * j + 8 * lane;
            const u32x4_t a = *(const u32x4_t*)(o0 + (size_t)m * DM + c), bq = *(const u32x4_t*)(o1 + (size_t)m * DM + c), zq = *(const u32x4_t*)(sz1 + (size_t)m * DM + c);
            float d[8]; float s = 0.f;
#pragma unroll
            for (int i = 0; i < 4; ++i) { const unsigned wa = a[i], wb = bq[i];
                d[2 * i] = __uint_as_float(wa << 16) - lam * __uint_as_float(wb << 16); d[2 * i + 1] = __uint_as_float(wa & 0xffff0000u) - lam * __uint_as_float(wb & 0xffff0000u);
                s += d[2 * i] * d[2 * i] + d[2 * i + 1] * d[2 * i + 1]; }
            s += __shfl_xor(s, 1); s += __shfl_xor(s, 2); s += __shfl_xor(s, 4); s += __shfl_xor(s, 8);
            const float r = rsqrtf(s * (1.0f / 128.0f) + RMS_EPS) * ONE_M_LI;
            const float* gs = g_sub + (c & 127);
            u32x4_t w;
#pragma unroll
            for (int i = 0; i < 4; ++i) { const unsigned wz = zq[i];
                const float z0 = __uint_as_float(wz << 16), z1 = __uint_as_float(wz & 0xffff0000u);
                w[i] = pk2bf(d[2 * i] * r * gs[2 * i] * z0, d[2 * i + 1] * r * gs[2 * i + 1] * z1); }
            *(u32x4_t*)(og + (size_t)m * DM + c) = w;
        }
    }
}
__device__ __forceinline__ void e_final(float* out, const bf16_t* __restrict__ yo1, const float* __restrict__ mod, const float* __restrict__ g_post, int gw, int ngw, int lane) {
    for (int m = gw; m < MTOK; m += ngw) {
        const int b = m / SEQL;
        f32x4_t* hr = (f32x4_t*)(out + (size_t)m * DM) + lane;
        const u32x2_t* yr = (const u32x2_t*)(yo1 + (size_t)m * DM) + lane;
        f32x4_t v[4], y[4]; float s = 0.f;
#pragma unroll
        for (int j = 0; j < 4; ++j) { v[j] = hr[64 * j]; const u32x2_t w = yr[64 * j];
            y[j].x = __uint_as_float(w.x << 16); y[j].y = __uint_as_float(w.x & 0xffff0000u); y[j].z = __uint_as_float(w.y << 16); y[j].w = __uint_as_float(w.y & 0xffff0000u);
            s += (y[j].x * y[j].x + y[j].y * y[j].y) + (y[j].z * y[j].z + y[j].w * y[j].w); }
        const float ry = rsqrtf(wave_sum_f(s) * (1.0f / DM) + RMS_EPS);
        const float* gate1 = mod + (size_t)(8 + b) * 3072 + 2048;
#pragma unroll
        for (int j = 0; j < 4; ++j) { const int c = 256 * j + 4 * lane;
            const f32x4_t gp = *(const f32x4_t*)(g_post + 1024 + c), gt = *(const f32x4_t*)(gate1 + c);
            hr[64 * j] = v[j] + gt * (y[j] * ry * gp); }
    }
}
__device__ __forceinline__ float diff_lambda(const float* lq1, const float* lk1, const float* lq2, const float* lk2) {
    float s1 = 0.f, s2 = 0.f;
    for (int i = 0; i < 64; ++i) { s1 += lq1[i] * lk1[i]; s2 += lq2[i] * lk2[i]; }
    return expf(s1) - expf(s2) + LAMBDA_INIT;
}

__global__ void n_adaln(const float* __restrict__ c, const float* __restrict__ ada_w, const float* __restrict__ ada_b, float* mod) {
    const int idx = blockIdx.x * 256 + threadIdx.x;
    if (idx >= 2 * 8 * 3072) return;
    const int j = idx % 3072, b = (idx / 3072) % 8, l = idx / (3072 * 8);
    float acc = ada_b[l * 3072 + j];
    const float* w = ada_w + (size_t)l * 1024 * 3072 + j; const float* cb = c + b * 1024;
    for (int k = 0; k < 1024; ++k) acc += silu_f(cb[k]) * w[(size_t)k * 3072];
    mod[idx] = acc;
}
__global__ void n_lambda(const float* lq1, const float* lk1, const float* lq2, const float* lk2, float* out) {
    if (threadIdx.x == 0 && blockIdx.x == 0) out[0] = diff_lambda(lq1, lk1, lq2, lk2);
}
__global__ void n_norm0(const float* x, const float* mod, const float* g_pre, bf16_t* a0) {
    e_norm0(x, mod, g_pre, a0, blockIdx.x * 4 + (threadIdx.x >> 6), gridDim.x * 4, threadIdx.x & 63);
}
__global__ void n_mid(const float* x, const bf16_t* yo, const float* mod, const float* g_post, const float* g_pre, float* h1, bf16_t* akv, bf16_t* ain1) {
    e_mid(x, yo, mod, g_post, g_pre, h1, akv, ain1, blockIdx.x * 4 + (threadIdx.x >> 6), gridDim.x * 4, threadIdx.x & 63);
}
__global__ void n_attn_post(const bf16_t* o0, const bf16_t* o1, const bf16_t* sz1, const float* g_sub, const float* lamp, bf16_t* og) {
    e_attn_post(o0, o1, sz1, g_sub, lamp[0], og, blockIdx.x * 4 + (threadIdx.x >> 6), gridDim.x * 4, threadIdx.x & 63);
}
__global__ void n_final(float* out, const bf16_t* yo1, const float* mod, const float* g_post) {
    e_final(out, yo1, mod, g_post, blockIdx.x * 4 + (threadIdx.x >> 6), gridDim.x * 4, threadIdx.x & 63);
}

struct AL_Row { const bf16_t* A; __device__ float ld(int m, int k) const { return bf2f(A[(size_t)m * DM + k]); } };
struct AL_YG  { const bf16_t* A; __device__ float ld(int m, int k) const { return bf2f(A[yg_off(k >> 4, m >> 4, (m & 15) * 16 + (k & 15))]); } };
struct WL_Plain { const float* W; long N; __device__ float ld(int k, int n) const { return W[(size_t)k * N + n]; } };
struct WL_KV { const float* wk; const float* wv; const float* g; __device__ float ld(int k, int n) const { return g[k] * (n < 1024 ? wk[(size_t)k * 1024 + n] : wv[(size_t)k * 1024 + n - 1024]); } };
struct EP_In0 { bf16_t* US; bf16_t* SZ; __device__ void st(int m, int n, float a) const {
    if (n < 1024) US[us_off(n >> 4, m >> 4, (m & 15) * 16 + (n & 15))] = f2bf(a); else SZ[(size_t)m * DM + n - 1024] = f2bf(silu_f(a)); } };
struct EP_Glu { const bf16_t* YG; const bf16_t* SZ; const float* bias; bf16_t* Y2; __device__ void st(int m, int n, float a) const {
    const float yv = bf2f(YG[yg_off(n >> 4, m >> 4, (m & 15) * 16 + (n & 15))]); const float t = a + bias[n];
    Y2[(size_t)m * DM + n] = f2bf(yv * sigmoid_f(t) * bf2f(SZ[(size_t)m * DM + n])); } };
struct EP_Plain { bf16_t* O; __device__ void st(int m, int n, float a) const { O[(size_t)m * DM + n] = f2bf(a); } };
struct EP_KV { bf16_t* K; bf16_t* V; __device__ void st(int m, int n, float a) const { if (n < 1024) K[(size_t)m * DM + n] = f2bf(a); else V[(size_t)m * DM + n - 1024] = f2bf(a); } };
struct EP_In1 { bf16_t* Q; bf16_t* SZ1; __device__ void st(int m, int n, float a) const { if (n < 1024) Q[(size_t)m * DM + n] = f2bf(a * QC2); else SZ1[(size_t)m * DM + n - 1024] = f2bf(silu_f(a)); } };

template <class AL, class WL, class EP>
__global__ void __launch_bounds__(256) n_gemm(AL al, WL wl, EP ep, int N) {
    __shared__ float As[16][68]; __shared__ float Ws[16][68];
    const int tid = threadIdx.x, tx = tid & 15, ty = tid >> 4;
    const int m0 = blockIdx.y * 64, n0 = blockIdx.x * 64;
    float acc[4][4];
#pragma unroll
    for (int i = 0; i < 4; ++i)
#pragma unroll
        for (int j = 0; j < 4; ++j) acc[i][j] = 0.f;
    for (int k0 = 0; k0 < 1024; k0 += 16) {
#pragma unroll
        for (int i = 0; i < 4; ++i) { const int e = tid + 256 * i; const int mm = e >> 4, kk = e & 15; As[kk][mm] = al.ld(m0 + mm, k0 + kk); }
#pragma unroll
        for (int i = 0; i < 4; ++i) { const int e = tid + 256 * i; const int kk = e >> 6, nn = e & 63; Ws[kk][nn] = wl.ld(k0 + kk, n0 + nn); }
        __syncthreads();
#pragma unroll
        for (int kk = 0; kk < 16; ++kk) {
            float a[4], b[4];
#pragma unroll
            for (int i = 0; i < 4; ++i) { a[i] = As[kk][ty * 4 + i]; b[i] = Ws[kk][tx * 4 + i]; }
#pragma unroll
            for (int i = 0; i < 4; ++i)
#pragma unroll
                for (int j = 0; j < 4; ++j) acc[i][j] += a[i] * b[j];
        }
        __syncthreads();
    }
#pragma unroll
    for (int i = 0; i < 4; ++i)
#pragma unroll
        for (int j = 0; j < 4; ++j) ep.st(m0 + ty * 4 + i, n0 + tx * 4 + j, acc[i][j]);
}

__global__ void __launch_bounds__(256) n_ssm(const bf16_t* __restrict__ US, const float* lam_re, const float* lam_im, const float* log_dt, const float* b_re, const float* b_im,
                                             const float* c_re, const float* c_im, const float* d_skip, bf16_t* YG) {
    const int wv = blockIdx.x * 4 + (threadIdx.x >> 6), lane = threadIdx.x & 63;
    if (wv >= NB * NGRP) return;
    const int b = wv / NGRP, g = wv % NGRP, p = lane;
    const float dt = expf(log_dt[g]);
    const float lr = lam_re[g * 64 + p], li = lam_im[g * 64 + p];
    const float mag = expf(lr * dt); float sn, cs; sn = sinf(li * dt); cs = cosf(li * dt);
    const float lbr = mag * cs, lbi = mag * sn;
    const float nr = lbr - 1.0f, ni = lbi, den = lr * lr + li * li;
    const float cr = (nr * lr + ni * li) / den, ci = (ni * lr - nr * li) / den;
    float bbr[16], bbi[16], ccr[16], cci[16];
#pragma unroll
    for (int c = 0; c < 16; ++c) { const float br = b_re[(g * 64 + p) * 16 + c], bi = b_im[(g * 64 + p) * 16 + c];
        bbr[c] = cr * br - ci * bi; bbi[c] = cr * bi + ci * br;
        ccr[c] = c_re[(g * 16 + c) * 64 + p]; cci[c] = c_im[(g * 16 + c) * 64 + p]; }
    const float dsk = d_skip[g * 16 + (lane & 15)];
    float sr = 0.f, si = 0.f;
    for (int t = 0; t < SEQL; ++t) {
        const int m = b * SEQL + t;
        const bf16_t* up = US + us_off(g, m >> 4, (m & 15) * 16);
        float u[16];
        { const u32x4_t w0 = *(const u32x4_t*)up, w1 = *(const u32x4_t*)(up + 8);
#pragma unroll
          for (int i = 0; i < 4; ++i) { u[2 * i] = __uint_as_float(w0[i] << 16); u[2 * i + 1] = __uint_as_float(w0[i] & 0xffff0000u); u[8 + 2 * i] = __uint_as_float(w1[i] << 16); u[8 + 2 * i + 1] = __uint_as_float(w1[i] & 0xffff0000u); } }
        float bur = 0.f, bui = 0.f;
#pragma unroll
        for (int c = 0; c < 16; ++c) { bur += bbr[c] * u[c]; bui += bbi[c] * u[c]; }
        const float nsr = lbr * sr - lbi * si + bur, nsi = lbr * si + lbi * sr + bui; sr = nsr; si = nsi;
        float yv = 0.f;
#pragma unroll
        for (int c = 0; c < 16; ++c) { const float part = wave_sum_f(ccr[c] * sr - cci[c] * si); if ((lane & 15) == c) yv = part; }
        if (lane < 16) { const float yy = yv + dsk * bf2f(up[lane]); YG[yg_off(g, m >> 4, (m & 15) * 16 + lane)] = f2bf(gelu_tanh_f(yy)); }
    }
}

__global__ void __launch_bounds__(256) n_attn(const bf16_t* __restrict__ Q, const bf16_t* __restrict__ K, const bf16_t* __restrict__ V, bf16_t* O0, bf16_t* O1) {
    __shared__ float qs[4][128];
    const int w = threadIdx.x >> 6, lane = threadIdx.x & 63;
    const int gwv = blockIdx.x * 4 + w;
    const int h = gwv & 7, m = gwv >> 3, b = m / SEQL, qi = m % SEQL;
    qs[w][lane] = bf2f(Q[(size_t)m * DM + h * 128 + lane]); qs[w][64 + lane] = bf2f(Q[(size_t)m * DM + h * 128 + 64 + lane]);
    __syncthreads();
    float m0 = -1e30f, m1 = -1e30f, l0 = 0.f, l1 = 0.f, a00 = 0.f, a01 = 0.f, a10 = 0.f, a11 = 0.f;
    const size_t rb = (size_t)b * SEQL;
    for (int kc = 0; kc * 64 <= qi; ++kc) {
        const int key = kc * 64 + lane; const bool valid = key <= qi;
        float s0 = 0.f, s1 = 0.f;
        { const bf16_t* kr = K + (rb + (valid ? key : qi)) * DM + h * 128;
#pragma unroll
          for (int ch = 0; ch < 8; ++ch) { const u32x4_t w0 = *(const u32x4_t*)(kr + ch * 8), w1 = *(const u32x4_t*)(kr + 64 + ch * 8);
#pragma unroll
            for (int i = 0; i < 4; ++i) { s0 += qs[w][ch * 8 + 2 * i] * __uint_as_float(w0[i] << 16) + qs[w][ch * 8 + 2 * i + 1] * __uint_as_float(w0[i] & 0xffff0000u);
                                          s1 += qs[w][64 + ch * 8 + 2 * i] * __uint_as_float(w1[i] << 16) + qs[w][64 + ch * 8 + 2 * i + 1] * __uint_as_float(w1[i] & 0xffff0000u); } } }
        if (!valid) { s0 = -1e30f; s1 = -1e30f; }
        const float nm0 = fmaxf(m0, wave_max_f(s0)), nm1 = fmaxf(m1, wave_max_f(s1));
        const float f0 = exp2f(m0 - nm0), f1 = exp2f(m1 - nm1);
        const float p0 = valid ? exp2f(s0 - nm0) : 0.f, p1 = valid ? exp2f(s1 - nm1) : 0.f;
        l0 = l0 * f0 + wave_sum_f(p0); l1 = l1 * f1 + wave_sum_f(p1); m0 = nm0; m1 = nm1;
        a00 *= f0; a01 *= f0; a10 *= f1; a11 *= f1;
        const int nk = min(64, qi - kc * 64 + 1);
        for (int j = 0; j < nk; ++j) {
            const float pj0 = __shfl(p0, j), pj1 = __shfl(p1, j);
            const bf16_t* vr = V + (rb + kc * 64 + j) * DM + h * 128;
            const float v0 = bf2f(vr[lane]), v1 = bf2f(vr[64 + lane]);
            a00 += pj0 * v0; a01 += pj0 * v1; a10 += pj1 * v0; a11 += pj1 * v1;
        }
    }
    const float i0 = 1.0f / l0, i1 = 1.0f / l1;
    O0[(size_t)m * DM + h * 128 + lane] = f2bf(a00 * i0); O0[(size_t)m * DM + h * 128 + 64 + lane] = f2bf(a01 * i0);
    O1[(size_t)m * DM + h * 128 + lane] = f2bf(a10 * i1); O1[(size_t)m * DM + h * 128 + 64 + lane] = f2bf(a11 * i1);
}
namespace pg8 {
#define PG8_LAS __attribute__((address_space(3)))
typedef short bf16x8 __attribute__((ext_vector_type(8)));
typedef float f32x4 __attribute__((ext_vector_type(4)));
typedef unsigned u32x4 __attribute__((ext_vector_type(4)));
constexpr int BM = 256, BK = 64, HALF = 128, HTB = HALF * BK * 2  , STAGE_BYTES = 8 * HTB, NXCD = 8, WGM = 8;

__host__ __device__ __forceinline__ int lds_byte(int r, int c) { const int st = (r >> 4) * 2 + (c >> 5), rr = r & 15, cc = c & 31, ob = rr * 64 + cc * 2; return st * 1024 + (ob ^ (((ob >> 9) & 1) << 5)); }
__host__ __device__ __forceinline__ void stage_rc(int b, int& R, int& C) { const int st = b / 1024, sb = b % 1024, swz = sb ^ (((sb >> 9) & 1) << 5); R = (st >> 1) * 16 + swz / 64; C = (st & 1) * 32 + (swz % 64) / 2; }
__host__ __device__ __forceinline__ int perm32(int rho) { const int n = rho >> 4, i = rho & 15; return 8 * (i >> 2) + 4 * n + (i & 3); }

struct Unit { int pm, pn, grp; };
struct Gemm {
    const char* A; const char* Bt; int nt, pad0;
    unsigned a_rs, a_c16; size_t a_kstep, a_tstep, a_gstep;
    unsigned b_rs, pad1; size_t b_tstep, b_gstep;
    __device__ __forceinline__ const char* abase(const Unit& u) const { return A + (size_t)u.grp * a_gstep + (size_t)u.pm * a_tstep; }
    __device__ __forceinline__ const char* bbase(const Unit& u) const { return Bt + (size_t)u.grp * b_gstep + (size_t)u.pn * b_tstep; }
};
__device__ __forceinline__ Gemm gemm_std(const void* A, int lda, const void* Bt, int ldb, int K) {
    Gemm g; g.A = (const char*)A; g.Bt = (const char*)Bt; g.nt = K / BK; g.pad0 = 0; g.a_rs = (unsigned)lda * 2u; g.a_c16 = 32u; g.a_kstep = BK * 2; g.a_tstep = (size_t)BM * lda * 2; g.a_gstep = 0;
    g.b_rs = (unsigned)ldb * 2u; g.pad1 = 0; g.b_tstep = (size_t)BM * ldb * 2; g.b_gstep = 0; return g;
}

struct Order {
    int nM, nN, nG, nwg, G, c, only;
    __device__ __forceinline__ void init(int nM_, int nN_, int nG_, int G_, int c_) { nM = nM_; nN = nN_; nG = nG_; nwg = nM * nN * nG; G = G_; c = c_; only = -1; }
    __device__ __forceinline__ bool next(int i, Unit& u) const {
        if (only >= 0) { if (i > 0) return false; i = only; }
        const long L = (long)i * G + c; if (L >= nwg) return false;
        int wgid = (int)L; { const int q = nwg / NXCD, r = nwg % NXCD, xcd = wgid % NXCD, off = wgid / NXCD; wgid = (xcd < r ? xcd * (q + 1) : r * (q + 1) + (xcd - r) * q) + off; }
        if (nG == 1) {
            const int nig = WGM * nN, gid = wgid / nig, fm = gid * WGM, gsz = (nM - fm) < WGM ? (nM - fm) : WGM;
            u.pm = fm + ((wgid % nig) % gsz); u.pn = (wgid % nig) / gsz; u.grp = 0;
        } else { const int per = nM * nN; u.grp = wgid / per; const int r2 = wgid % per; u.pm = r2 % nM; u.pn = r2 / nM; }
        return true;
    }
};

__device__ __forceinline__ unsigned cvt_pk_bf16(float lo, float hi) { unsigned r; asm volatile("v_cvt_pk_bf16_f32 %0, %1, %2" : "=v"(r) : "v"(lo), "v"(hi)); return r; }
__device__ __forceinline__ u32x4 pack8(const f32x4 a, const f32x4 b) { u32x4 w; w.x = cvt_pk_bf16(a[0], a[1]); w.y = cvt_pk_bf16(a[2], a[3]); w.z = cvt_pk_bf16(b[0], b[1]); w.w = cvt_pk_bf16(b[2], b[3]); return w; }
__device__ __forceinline__ void unpack8(const u32x4 w, f32x4& a, f32x4& b) {
    a[0] = __uint_as_float(w.x << 16); a[1] = __uint_as_float(w.x & 0xffff0000u); a[2] = __uint_as_float(w.y << 16); a[3] = __uint_as_float(w.y & 0xffff0000u);
    b[0] = __uint_as_float(w.z << 16); b[1] = __uint_as_float(w.z & 0xffff0000u); b[2] = __uint_as_float(w.w << 16); b[3] = __uint_as_float(w.w & 0xffff0000u); }
__device__ __forceinline__ float fsilu(float v) { return v * __builtin_amdgcn_rcpf(1.0f + __expf(-v)); }
__device__ __forceinline__ float fsigm(float v) { return __builtin_amdgcn_rcpf(1.0f + __expf(-v)); }
__device__ __forceinline__ f32x4 silu4(f32x4 v) { f32x4 o; o[0] = fsilu(v[0]); o[1] = fsilu(v[1]); o[2] = fsilu(v[2]); o[3] = fsilu(v[3]); return o; }
__device__ __forceinline__ f32x4 sigm4(f32x4 v) { f32x4 o; o[0] = fsigm(v[0]); o[1] = fsigm(v[1]); o[2] = fsigm(v[2]); o[3] = fsigm(v[3]); return o; }
__device__ __forceinline__ float fgelu(float v) { const float u = 0.7978845608028654f * (v + 0.044715f * v * v * v); const float e = __expf(2.0f * u); return 0.5f * v * (2.0f - 2.0f * __builtin_amdgcn_rcpf(e + 1.0f)); }
__device__ __forceinline__ f32x4 gelu4(f32x4 v) { f32x4 o; o[0] = fgelu(v[0]); o[1] = fgelu(v[1]); o[2] = fgelu(v[2]); o[3] = fgelu(v[3]); return o; }

template <class F> struct EpiRow8 {
    static constexpr bool PERM = true, AFTER_DRAIN = false;
    F f;
    __device__ __forceinline__ void operator()(const f32x4 (&acc)[2][2][4][2], const Unit& u, int wr, int wc, int fr, int fq) const {
#pragma unroll
        for (int ai = 0; ai < 2; ++ai)
#pragma unroll
            for (int m = 0; m < 4; ++m) { const int row = u.pm * BM + ai * HALF + wr * 64 + m * 16 + fr;
#pragma unroll
                for (int bj = 0; bj < 2; ++bj) { const int col0 = u.pn * BM + bj * HALF + wc * 32 + 8 * fq; f.apply(u, row, col0, acc[ai][bj][m][0], acc[ai][bj][m][1]); } }
    }
};
struct F_In0 { bf16_t* US; bf16_t* SZ;
    __device__ __forceinline__ void apply(const Unit&, int row, int col0, f32x4 v0, f32x4 v1) const {
        if (col0 < 1024) *(u32x4*)(US + us_off(col0 >> 4, row >> 4, (row & 15) * 16 + (col0 & 15))) = pack8(v0, v1);
        else *(u32x4*)(SZ + (size_t)row * DM + (col0 - 1024)) = pack8(silu4(v0), silu4(v1)); } };
struct F_SsmA { float* E;
    __device__ __forceinline__ void apply(const Unit& u, int row, int col0, f32x4 v0, f32x4 v1) const {
        if (col0 < 128) { float* p = E + ((size_t)u.grp * NTILE + row) * 128 + col0; *(f32x4*)p = v0; *(f32x4*)(p + 4) = v1; } } };
struct F_SsmB { const bf16_t* US; const float* dsk; bf16_t* YG;
    __device__ __forceinline__ void apply(const Unit& u, int row, int col0, f32x4 v0, f32x4 v1) const {
        const u32x4 uw = *(const u32x4*)(US + us_off(u.grp, row, col0)); f32x4 u0, u1; unpack8(uw, u0, u1);
        const float* d = dsk + u.grp * 16 + (col0 & 15); const f32x4 d0 = *(const f32x4*)d, d1 = *(const f32x4*)(d + 4);
        *(u32x4*)(YG + yg_off(u.grp, row, col0)) = pack8(gelu4(v0 + d0 * u0), gelu4(v1 + d1 * u1)); } };
struct F_Glu { const bf16_t* YG; const bf16_t* SZ; const float* bias; bf16_t* Y2;
    __device__ __forceinline__ void apply(const Unit&, int row, int col0, f32x4 v0, f32x4 v1) const {
        const u32x4 yw = *(const u32x4*)(YG + yg_off(col0 >> 4, row >> 4, (row & 15) * 16 + (col0 & 15))); f32x4 y0, y1; unpack8(yw, y0, y1);
        const u32x4 zw = *(const u32x4*)(SZ + (size_t)row * DM + col0); f32x4 z0, z1; unpack8(zw, z0, z1);
        const f32x4 b0 = *(const f32x4*)(bias + col0), b1 = *(const f32x4*)(bias + col0 + 4);
        *(u32x4*)(Y2 + (size_t)row * DM + col0) = pack8(y0 * sigm4(v0 + b0) * z0, y1 * sigm4(v1 + b1) * z1); } };
struct F_Plain { bf16_t* O;
    __device__ __forceinline__ void apply(const Unit&, int row, int col0, f32x4 v0, f32x4 v1) const { *(u32x4*)(O + (size_t)row * DM + col0) = pack8(v0, v1); } };
struct F_Split { bf16_t* Olo; bf16_t* Ohi; float sc_lo; int silu_hi;
    __device__ __forceinline__ void apply(const Unit&, int row, int col0, f32x4 v0, f32x4 v1) const {
        if (col0 < 1024) *(u32x4*)(Olo + (size_t)row * DM + col0) = pack8(v0 * sc_lo, v1 * sc_lo);
        else { if (silu_hi) { v0 = silu4(v0); v1 = silu4(v1); } *(u32x4*)(Ohi + (size_t)row * DM + (col0 - 1024)) = pack8(v0, v1); } } };

template <class Epi, bool ALIGN_EPI>
__device__ __forceinline__ void gemm_phase(PG8_LAS unsigned char* lds, const Gemm g, const Order& S, const Epi& E) {
    const int tid = threadIdx.x, wid = __builtin_amdgcn_readfirstlane(tid >> 6), lane = tid & 63, wr = wid >> 2, wc = wid & 3, fr = lane & 15, fq = lane >> 4;
    const int nt = g.nt;
    unsigned voffA[2], voffB[2];
#pragma unroll
    for (int i = 0; i < 2; ++i) { int R, C; stage_rc(tid * 16 + i * 8192, R, C); const int Rb = Epi::PERM ? ((R & ~31) + perm32(R & 31)) : R;
        voffA[i] = (unsigned)R * g.a_rs + (unsigned)(C >> 4) * g.a_c16 + (unsigned)(C & 15) * 2u; voffB[i] = (unsigned)Rb * g.b_rs + (unsigned)C * 2u; }
    const size_t kstepA = g.a_kstep, kstepB = (size_t)(BK * 2);
    const size_t hstepA = (size_t)HALF * g.a_rs, hstepB = (size_t)HALF * g.b_rs;
    const unsigned ldsw = (unsigned)wid * 1024u;
    const int aoff = lds_byte(wr * 64 + fr, fq * 8), boff = lds_byte(wc * 32 + fr, fq * 8);
#define PG8_SA(b, h) (((b) * 2 + (h)) * HTB)
#define PG8_SB(b, h) ((4 + (b) * 2 + (h)) * HTB)
#define PG8_STAGE(bufoff, gbase, voff) do { _Pragma("unroll") for (int _i = 0; _i < 2; ++_i) \
        __builtin_amdgcn_global_load_lds((const unsigned*)((const char*)(gbase) + (voff)[_i]), (PG8_LAS unsigned*)(lds + (bufoff) + ldsw + _i * 8192), 16, 0, 0); } while (0)
#define PG8_LDA(dst, b, h) do { _Pragma("unroll") for (int m = 0; m < 4; ++m) _Pragma("unroll") for (int k = 0; k < 2; ++k) dst[m][k] = *(const PG8_LAS bf16x8*)(lds + PG8_SA(b, h) + aoff + m * 2048 + k * 1024); } while (0)
#define PG8_LDB(dst, b, h) do { _Pragma("unroll") for (int n = 0; n < 2; ++n) _Pragma("unroll") for (int k = 0; k < 2; ++k) dst[n][k] = *(const PG8_LAS bf16x8*)(lds + PG8_SB(b, h) + boff + n * 2048 + k * 1024); } while (0)
#define PG8_MMA(ai, bj, At, Bt) do { __builtin_amdgcn_s_setprio(1); _Pragma("unroll") for (int m = 0; m < 4; ++m) _Pragma("unroll") for (int n = 0; n < 2; ++n) _Pragma("unroll") for (int k = 0; k < 2; ++k) \
        acc[ai][bj][m][n] = __builtin_amdgcn_mfma_f32_16x16x32_bf16(Bt[n][k], At[m][k], acc[ai][bj][m][n], 0, 0, 0); __builtin_amdgcn_s_setprio(0); } while (0)
#define PG8_WAIT_V(n) asm volatile("s_waitcnt vmcnt(" #n ")" ::: "memory")
#define PG8_WAIT_L(n) asm volatile("s_waitcnt lgkmcnt(" #n ")" ::: "memory")
#define PG8_BAR __builtin_amdgcn_s_barrier()
#define PG8_SCHED __builtin_amdgcn_sched_barrier(0)
    Unit cur, nxt; int ui = 0;
    if (!S.next(0, cur)) return;
    f32x4 acc[2][2][4][2];
#pragma unroll
    for (int a = 0; a < 2; ++a)
#pragma unroll
        for (int b = 0; b < 2; ++b)
#pragma unroll
            for (int m = 0; m < 4; ++m)
#pragma unroll
                for (int n = 0; n < 2; ++n) acc[a][b][m][n] = (f32x4){0.f, 0.f, 0.f, 0.f};
    bf16x8 At[4][2], B0[2][2], B1[2][2];
    const char* cA = g.abase(cur); const char* cB = g.bbase(cur);
    PG8_STAGE(PG8_SB(0, 0), cB, voffB); PG8_STAGE(PG8_SB(0, 1), cB + hstepB, voffB); PG8_STAGE(PG8_SA(0, 0), cA, voffA); PG8_STAGE(PG8_SA(0, 1), cA + hstepA, voffA);
    if (wr == 1) PG8_BAR;
    PG8_WAIT_V(2); PG8_BAR;
    PG8_STAGE(PG8_SB(1, 0), cB + kstepB, voffB); PG8_STAGE(PG8_SA(1, 0), cA + kstepA, voffA); PG8_STAGE(PG8_SB(1, 1), cB + hstepB + kstepB, voffB);
    PG8_WAIT_V(6); PG8_BAR;
    for (;;) {
        const bool has_next = S.next(ui + 1, nxt);
        const char* nA = has_next ? g.abase(nxt) : cA; const char* nB = has_next ? g.bbase(nxt) : cB;
        for (int t = 0; t < nt; t += 2) {
            const bool last = (t == nt - 2);
            const char* a1 = cA + (size_t)(t + 1) * kstepA;
            const char* a2 = last ? nA : cA + (size_t)(t + 2) * kstepA; const char* b2 = last ? nB : cB + (size_t)(t + 2) * kstepB;
            const char* a3 = a2 + kstepA; const char* b3 = b2 + kstepB;
            PG8_LDB(B0, 0, 0); PG8_LDB(B1, 0, 1); PG8_SCHED; PG8_LDA(At, 0, 0); PG8_STAGE(PG8_SA(1, 1), a1 + hstepA, voffA);
            PG8_WAIT_V(8); PG8_WAIT_L(0); PG8_BAR; PG8_MMA(0, 0, At, B0); PG8_MMA(0, 1, At, B1); PG8_BAR; PG8_SCHED;
            PG8_LDA(At, 0, 1); PG8_STAGE(PG8_SB(0, 0), b2, voffB); PG8_STAGE(PG8_SB(0, 1), b2 + hstepB, voffB); PG8_STAGE(PG8_SA(0, 0), a2, voffA);
            PG8_WAIT_V(8); PG8_WAIT_L(0); PG8_BAR; PG8_MMA(1, 0, At, B0); PG8_MMA(1, 1, At, B1); PG8_BAR; PG8_SCHED;
            PG8_LDB(B0, 1, 0); PG8_LDB(B1, 1, 1); PG8_SCHED; PG8_LDA(At, 1, 0); PG8_STAGE(PG8_SA(0, 1), a2 + hstepA, voffA);
            PG8_WAIT_V(8); PG8_WAIT_L(0); PG8_BAR; PG8_MMA(0, 0, At, B0); PG8_MMA(0, 1, At, B1); PG8_BAR; PG8_SCHED;
            PG8_LDA(At, 1, 1); PG8_STAGE(PG8_SB(1, 0), b3, voffB); PG8_STAGE(PG8_SB(1, 1), b3 + hstepB, voffB); PG8_STAGE(PG8_SA(1, 0), a3, voffA);
            PG8_WAIT_V(8); PG8_WAIT_L(0); PG8_BAR; PG8_MMA(1, 0, At, B0); PG8_MMA(1, 1, At, B1); PG8_BAR; PG8_SCHED;
        }
        if constexpr (ALIGN_EPI) { if (wr == 0) PG8_BAR; }
        E(acc, cur, wr, wc, fr, fq);
        if (!has_next) break;
#pragma unroll
        for (int a = 0; a < 2; ++a)
#pragma unroll
            for (int b = 0; b < 2; ++b)
#pragma unroll
                for (int m = 0; m < 4; ++m)
#pragma unroll
                    for (int n = 0; n < 2; ++n) acc[a][b][m][n] = (f32x4){0.f, 0.f, 0.f, 0.f};
        cur = nxt; cA = nA; cB = nB; ++ui;
        if constexpr (ALIGN_EPI) { if (wr == 1) PG8_BAR; }
    }
    PG8_WAIT_V(0);
    if constexpr (!ALIGN_EPI) { if (wr == 0) PG8_BAR; }
    PG8_BAR;
#undef PG8_SA
#undef PG8_SB
#undef PG8_STAGE
#undef PG8_LDA
#undef PG8_LDB
#undef PG8_MMA
#undef PG8_WAIT_V
#undef PG8_WAIT_L
#undef PG8_BAR
#undef PG8_SCHED
}
}

namespace attn_body {
using bf16 = bf16_t;
using bf16x8 = __attribute__((ext_vector_type(8))) short;
using s16x4 = __attribute__((ext_vector_type(4))) short;
using f32x16 = __attribute__((ext_vector_type(16))) float;
using u32x4 = __attribute__((ext_vector_type(4))) unsigned;
constexpr int SEQ = SEQL, D = 64, DMA = 1024;
constexpr int NW = 8, QBLK = 32, QB = QBLK * NW, KVBLK = 64, NQB = SEQ / QB;
__device__ __forceinline__ int crow(int r, int hi) { return (r & 3) + 8 * (r >> 2) + 4 * hi; }
#define SBAR() __builtin_amdgcn_sched_barrier(0)
__device__ __forceinline__ void cmask(f32x16& p0, f32x16& p1, int jb, int qrel, int hi) {
  const float NEG = -INFINITY; int kb = 64 * jb + 4 * hi;
  #pragma unroll
  for (int r = 0; r < 16; ++r) { int kv = kb + (r & 3) + 8 * (r >> 2); if (kv > qrel) p0[r] = NEG; if (kv + 32 > qrel) p1[r] = NEG; }
}
constexpr int NSLOT = 3, SLOTB = 8192;
constexpr int LDS_K = 0, LDS_V = NSLOT * SLOTB, LDS_WS = 2 * NSLOT * SLOTB, LDS_OST = LDS_WS + NW * 64 * 4, LDS_BYTES = LDS_OST + NW * 4096;
__device__ __forceinline__ void glds16(const void* gsrc, unsigned lds_dst) { unsigned keep;
  asm volatile("s_mov_b32 %0, m0\n\ts_mov_b32 m0, %2\n\ts_nop 0\n\tglobal_load_lds_dwordx4 %1, off\n\ts_mov_b32 m0, %0" : "=&s"(keep) : "v"(gsrc), "s"(lds_dst) : "memory"); }
__device__ __forceinline__ float max3f(float a, float b, float c) { float r; asm("v_max3_f32 %0, %1, %2, %3" : "=v"(r) : "v"(a), "v"(b), "v"(c)); return r; }
__device__ __forceinline__ float max2f(float a, float b) { float r; asm("v_max_f32_e32 %0, %1, %2" : "=v"(r) : "v"(a), "v"(b)); return r; }
__device__ __forceinline__ float fadd_s(float a, float b) { float r; asm("v_add_f32_e32 %0, %1, %2" : "=v"(r) : "v"(a), "v"(b)); return r; }
__device__ __forceinline__ float fsub_s(float a, float b) { float r; asm("v_sub_f32_e32 %0, %1, %2" : "=v"(r) : "v"(a), "v"(b)); return r; }
typedef float f32x2_t __attribute__((ext_vector_type(2))); typedef __bf16 bf16x2_t __attribute__((ext_vector_type(2)));
__device__ __forceinline__ unsigned cvtpk_s(float lo, float hi) { f32x2_t v = {lo, hi}; bf16x2_t b = __builtin_convertvector(v, bf16x2_t); return __builtin_bit_cast(unsigned, b); }
#define WAIT_BAR(N) asm volatile("s_waitcnt vmcnt(" #N ") lgkmcnt(0)\n\ts_barrier" ::: "memory")

__device__ __forceinline__ void qkt(f32x16& p0, f32x16& p1, const char* Kslot, const bf16x8* qr, const f32x16& negm, int r32, int hi) {
  const char* kb = Kslot + hi * 1024 + r32 * 16;
  #pragma unroll
  for (int d0 = 0; d0 < 4; ++d0) {
    const bf16x8 b0 = *reinterpret_cast<const bf16x8*>(kb + d0 * 2048);
    const bf16x8 b1 = *reinterpret_cast<const bf16x8*>(kb + d0 * 2048 + 512);
    if (d0 == 0) { p0 = __builtin_amdgcn_mfma_f32_32x32x16_bf16(b0, qr[0], negm, 0, 0, 0); p1 = __builtin_amdgcn_mfma_f32_32x32x16_bf16(b1, qr[0], negm, 0, 0, 0); }
    else { p0 = __builtin_amdgcn_mfma_f32_32x32x16_bf16(b0, qr[d0], p0, 0, 0, 0); p1 = __builtin_amdgcn_mfma_f32_32x32x16_bf16(b1, qr[d0], p1, 0, 0, 0); } }
}
typedef __attribute__((address_space(3))) const char* lds_cptr;
typedef short v4i16_t __attribute__((ext_vector_type(4)));
__device__ __forceinline__ void kload8(bf16x8* kf, lds_cptr kp) {
  kf[0] = *(const __attribute__((address_space(3))) bf16x8*)(kp);        kf[1] = *(const __attribute__((address_space(3))) bf16x8*)(kp + 512);
  kf[2] = *(const __attribute__((address_space(3))) bf16x8*)(kp + 2048); kf[3] = *(const __attribute__((address_space(3))) bf16x8*)(kp + 2560);
  kf[4] = *(const __attribute__((address_space(3))) bf16x8*)(kp + 4096); kf[5] = *(const __attribute__((address_space(3))) bf16x8*)(kp + 4608);
  kf[6] = *(const __attribute__((address_space(3))) bf16x8*)(kp + 6144); kf[7] = *(const __attribute__((address_space(3))) bf16x8*)(kp + 6656);
}
__device__ __forceinline__ void kload2(bf16x8* kf, lds_cptr kp, int j) { kf[2 * j] = *(const __attribute__((address_space(3))) bf16x8*)(kp + j * 2048); kf[2 * j + 1] = *(const __attribute__((address_space(3))) bf16x8*)(kp + j * 2048 + 512); }
__device__ __forceinline__ s16x4 vtr(lds_cptr p) { return __builtin_bit_cast(s16x4, __builtin_amdgcn_ds_read_tr16_b64_v4i16((__attribute__((address_space(3))) v4i16_t*)p)); }
__device__ __forceinline__ float rowmax(const f32x16& p0, const f32x16& p1) {
  float a = max3f(p0[0], p0[1], p1[0]), b = max3f(p0[2], p0[3], p1[1]); a = max3f(a, p1[2], p1[3]);
  #pragma unroll
  for (int r = 4; r < 16; r += 4) { a = max3f(a, p0[r], p0[r + 1]); b = max3f(b, p0[r + 2], p0[r + 3]); a = max3f(a, p1[r], p1[r + 1]); b = max3f(b, p1[r + 2], p1[r + 3]); }
  const float m = max2f(a, b);
  auto rr = __builtin_amdgcn_permlane32_swap(__float_as_uint(m), __float_as_uint(m), false, false);
  return max2f(__uint_as_float(rr[0]), __uint_as_float(rr[1]));
}
__device__ __forceinline__ void pv(f32x16* o, int vb, bf16x8 pa0, bf16x8 pa1, bf16x8 pa2, bf16x8 pa3) {
  #pragma unroll
  for (int d0 = 0; d0 < 2; ++d0) { s16x4 lo[4], hi[4];
    #pragma unroll
    for (int ks = 0; ks < 4; ++ks) {
      asm volatile("ds_read_b64_tr_b16 %0,%1 offset:%c2" : "=&v"(lo[ks]) : "v"(vb), "i"(d0 * 4096 + ks * 1024) : "memory");
      asm volatile("ds_read_b64_tr_b16 %0,%1 offset:%c2" : "=&v"(hi[ks]) : "v"(vb), "i"(d0 * 4096 + ks * 1024 + 512) : "memory"); }
    asm volatile("s_waitcnt lgkmcnt(0)" ::: "memory"); SBAR();
    #define PK(k) (bf16x8){lo[k][0], lo[k][1], lo[k][2], lo[k][3], hi[k][0], hi[k][1], hi[k][2], hi[k][3]}
    o[d0] = __builtin_amdgcn_mfma_f32_32x32x16_bf16(pa0, PK(0), o[d0], 0, 0, 0);
    o[d0] = __builtin_amdgcn_mfma_f32_32x32x16_bf16(pa1, PK(1), o[d0], 0, 0, 0);
    o[d0] = __builtin_amdgcn_mfma_f32_32x32x16_bf16(pa2, PK(2), o[d0], 0, 0, 0);
    o[d0] = __builtin_amdgcn_mfma_f32_32x32x16_bf16(pa3, PK(3), o[d0], 0, 0, 0);
    #undef PK
  }
}
#define ATTN_STORE16(p, v) (*(u32x4*)(p) = (v))
template <int THRL> __device__ __forceinline__ void attn_unit(int b, int hq, int hv, int qb, const bf16* Q, const bf16* __restrict__ K, const bf16* __restrict__ V, bf16* O, char* shm) {
  const int tid = threadIdx.x, lane = tid & 63, r32 = lane & 31, hi = lane >> 5; const int wid = __builtin_amdgcn_readfirstlane(tid >> 6);
  const long rowbase = (long)b * SEQ; const int q0 = qb * QB;
  const bf16* Qw = Q + (rowbase + q0 + wid * QBLK) * DMA + hq * D;
  const bf16* Kh = K + rowbase * DMA + hq * D, *Vh = V + rowbase * DMA + hv * D;
  const unsigned lds0 = (unsigned)(uintptr_t)shm;
  float* wsf = (float*)(shm + LDS_WS) + wid * 64;
  const bf16* ksrc = Kh + (long)lane * DMA + wid * 8;
  const bf16* vsrc = Vh + (long)(16 * (wid & 3) + (lane >> 2)) * DMA + (wid >> 2) * 32 + (lane & 3) * 8;
  const unsigned kdst = lds0 + LDS_K + wid * 1024, vdst = lds0 + LDS_V + wid * 1024;
  #define DMA_K(t, slot) glds16(ksrc + (long)(t) * KVBLK * DMA, (unsigned)__builtin_amdgcn_readfirstlane(kdst + (slot)))
  #define DMA_V(t, slot) glds16(vsrc + (long)(t) * KVBLK * DMA, (unsigned)__builtin_amdgcn_readfirstlane(vdst + (slot)))
  const int vb0 = (int)(lds0 + LDS_V) + ((lane >> 4) & 1) * 32 + (lane & 3) * 8 + (4 * hi + ((lane & 15) >> 2)) * 64;
  const char* Kbase = shm + LDS_K; bf16x8 kf[8];
  const lds_cptr shm3 = (lds_cptr)shm; const lds_cptr kp0 = shm3 + LDS_K + hi * 1024 + r32 * 16; const lds_cptr vp0 = shm3 + LDS_V + ((lane >> 4) & 1) * 32 + (lane & 3) * 8 + (4 * hi + ((lane & 15) >> 2)) * 64;
  const int NT = (q0 + QB) / KVBLK;
  DMA_K(0, 0); DMA_V(0, 0); DMA_K(1, SLOTB);
  bf16x8 qr[4];
  #pragma unroll
  for (int d0 = 0; d0 < 4; ++d0) qr[d0] = *reinterpret_cast<const bf16x8*>(&Qw[(long)r32 * DMA + d0 * 16 + hi * 8]);
  float mhat = 0.f, l_reg = 0.f; f32x16 o[2]; o[0] = f32x16{}; o[1] = f32x16{}; f32x16 negm = f32x16{}; asm volatile("" : "+v"(negm));
  const int qrel = wid * QBLK + r32;
  #define CMASK(P0, P1, t) do { int jb_ = (t) - (NT - 4); if (jb_ >= 0) cmask(P0, P1, jb_, qrel, hi); } while (0)
  bool resc = false;
  #define START(P0, P1) do { const float rm = rowmax(P0, P1); resc = false; \
    { const float dl = rm; mhat = fadd_s(mhat, dl); \
      _Pragma("unroll") for (int r = 0; r < 16; ++r) { P0[r] = fsub_s(P0[r], dl); P1[r] = fsub_s(P1[r], dl); } \
      _Pragma("unroll") for (int r = 0; r < 16; ++r) negm[r] = -mhat; asm volatile("" : "+v"(negm)); } \
    _Pragma("unroll") for (int r = 0; r < 16; ++r) P0[r] = __builtin_amdgcn_exp2f(P0[r]); } while (0)
  #define RESC() do { if (resc) { asm volatile("s_waitcnt lgkmcnt(0)" ::: "memory"); \
      _Pragma("unroll") for (int d_ = 0; d_ < 2; ++d_) _Pragma("unroll") for (int r = 0; r < 16; ++r) o[d_][r] *= wsf[crow(r, hi)]; } } while (0)
  f32x16 pA0, pA1, pB0, pB1;
  int sl_prev = 0, sl_cur = 0, sl_next = SLOTB;
  #define ROT() do { sl_prev = sl_cur; sl_cur = sl_next; sl_next = (sl_next == (NSLOT - 1) * SLOTB) ? 0 : sl_next + SLOTB; } while (0)
  DMA_K(2, 2 * SLOTB);
  WAIT_BAR(3);
  qkt(pA0, pA1, Kbase, qr, negm, r32, hi); asm volatile("s_nop 15\n\ts_nop 7" : "+v"(pA0), "+v"(pA1)); CMASK(pA0, pA1, 0);
  START(pA0, pA1);
  _Pragma("unroll") for (int r = 0; r < 16; ++r) pA1[r] = __builtin_amdgcn_exp2f(pA1[r]);
  WAIT_BAR(0);
  DMA_K(3, 0); DMA_V(1, SLOTB);
  ROT();
  kload8(kf, kp0 + sl_cur);
  WAIT_BAR(2);
  s16x4 vlo[8], vhi[8]; u32x4 pw0, pw1, pw2, pw3;
  #define PKW(P, B) cvtpk_s(P[B], P[B + 1])
  #define PAF(k) __builtin_bit_cast(bf16x8, pw##k)
  #define VFR(i) (bf16x8){vlo[i][0], vlo[i][1], vlo[i][2], vlo[i][3], vhi[i][0], vhi[i][1], vhi[i][2], vhi[i][3]}
  #define PIN(x) asm volatile("" : "+v"(x))
  #define MX3(a, b, c) __builtin_fmaxf(__builtin_fmaxf((a), (b)), (c))
  #define GAPA(MF, A0, A1, A2, A3, W0, W1, PW) do { MF; sacc += A0; sacc += A1; sacc += A2; sacc += A3; PIN(sacc); W0; W1; PIN(PW); SBAR(); } while (0)
  #define EX(v) __builtin_amdgcn_exp2f(v)
  #define GAPB(MF, X, B) do { MF; X[B] = EX(X[B]); X[B + 1] = EX(X[B + 1]); X[B + 2] = EX(X[B + 2]); X[B + 3] = EX(X[B + 3]); PIN(X); SBAR(); } while (0)
  #define VRD(i) do { vlo[i] = vtr(vp_ + (((i) >> 2) * 4096 + ((i) & 3) * 1024)); vhi[i] = vtr(vp_ + (((i) >> 2) * 4096 + ((i) & 3) * 1024 + 512)); } while (0)
  #define KRD(G, j) do { if (G) { kload2(kf, kp0 + sl_next, j); SBAR(); } } while (0)
  #define STEP(C0, C1, P0, P1, t, GK, GV, GL) do { SBAR(); \
    const lds_cptr vp_ = vp0 + sl_prev; \
    VRD(0); SBAR(); float sacc = (P0[0] + P0[1]); \
    GAPA(C0 = __builtin_amdgcn_mfma_f32_32x32x16_bf16(kf[0], qr[0], negm, 0, 0, 0), P0[2], P0[3], P0[4], P0[5],     pw0[0] = PKW(P0, 0), pw0[1] = PKW(P0, 2), pw0); \
    VRD(4); SBAR(); GAPA(C1 = __builtin_amdgcn_mfma_f32_32x32x16_bf16(kf[1], qr[0], negm, 0, 0, 0), P0[6], P0[7], P0[8], P0[9],     pw0[2] = PKW(P0, 4), pw0[3] = PKW(P0, 6), pw0); \
    VRD(1); SBAR(); GAPA(C0 = __builtin_amdgcn_mfma_f32_32x32x16_bf16(kf[2], qr[1], C0, 0, 0, 0),   P0[10], P0[11], P0[12], P0[13], pw1[0] = PKW(P0, 8), pw1[1] = PKW(P0, 10), pw1); \
    VRD(5); SBAR(); GAPA(C1 = __builtin_amdgcn_mfma_f32_32x32x16_bf16(kf[3], qr[1], C1, 0, 0, 0),   P0[14], P0[15], P1[0], P1[1],   pw1[2] = PKW(P0, 12), pw1[3] = PKW(P0, 14), pw1); \
    VRD(2); SBAR(); GAPA(C0 = __builtin_amdgcn_mfma_f32_32x32x16_bf16(kf[4], qr[2], C0, 0, 0, 0),   P1[2], P1[3], P1[4], P1[5],     pw2[0] = PKW(P1, 0), pw2[1] = PKW(P1, 2), pw2); \
    VRD(6); SBAR(); GAPA(C1 = __builtin_amdgcn_mfma_f32_32x32x16_bf16(kf[5], qr[2], C1, 0, 0, 0),   P1[6], P1[7], P1[8], P1[9],     pw2[2] = PKW(P1, 4), pw2[3] = PKW(P1, 6), pw2); \
    VRD(3); SBAR(); GAPA(C0 = __builtin_amdgcn_mfma_f32_32x32x16_bf16(kf[6], qr[3], C0, 0, 0, 0),   P1[10], P1[11], P1[12], P1[13], pw3[0] = PKW(P1, 8), pw3[1] = PKW(P1, 10), pw3); \
    VRD(7); SBAR(); GAPA(C1 = __builtin_amdgcn_mfma_f32_32x32x16_bf16(kf[7], qr[3], C1, 0, 0, 0),   P1[14], P1[15], 0.f, 0.f,       pw3[2] = PKW(P1, 12), pw3[3] = PKW(P1, 14), pw3); \
    l_reg += sacc; \
    if (GK) { DMA_K((t) + 3, sl_cur); } if (GV) { DMA_V((t) + 1, sl_next); } \
    CMASK(C0, C1, t); \
    { float a = MX3(C0[0], C0[1], C1[0]), b = MX3(C0[2], C0[3], C1[1]); a = MX3(a, C1[2], C1[3]); \
      _Pragma("unroll") for (int r = 4; r < 16; r += 4) { a = MX3(a, C0[r], C0[r + 1]); b = MX3(b, C0[r + 2], C0[r + 3]); a = MX3(a, C1[r], C1[r + 1]); b = MX3(b, C1[r + 2], C1[r + 3]); } \
      float rm = __builtin_fmaxf(a, b); { auto rr = __builtin_amdgcn_permlane32_swap(__float_as_uint(rm), __float_as_uint(rm), false, false); rm = __builtin_fmaxf(__uint_as_float(rr[0]), __uint_as_float(rr[1])); } \
      resc = false; \
      if (__builtin_expect(__any(rm > (float)THRL), 0)) { const float dl = __builtin_fmaxf(rm, 0.f); mhat += dl; \
        _Pragma("unroll") for (int r = 0; r < 16; ++r) { C0[r] -= dl; C1[r] -= dl; } \
        _Pragma("unroll") for (int r = 0; r < 16; ++r) negm[r] = -mhat; asm volatile("" : "+v"(negm)); \
        const float f = __builtin_amdgcn_exp2f(-dl); l_reg *= f; if (hi == 0) wsf[r32] = f; resc = true; } } \
    SBAR(); \
    GAPB(o[0] = __builtin_amdgcn_mfma_f32_32x32x16_bf16(PAF(0), VFR(0), o[0], 0, 0, 0), C0, 0); \
    GAPB(o[1] = __builtin_amdgcn_mfma_f32_32x32x16_bf16(PAF(0), VFR(4), o[1], 0, 0, 0), C0, 4); \
    KRD(GL, 0); GAPB(o[0] = __builtin_amdgcn_mfma_f32_32x32x16_bf16(PAF(1), VFR(1), o[0], 0, 0, 0), C0, 8); \
    KRD(GL, 1); GAPB(o[1] = __builtin_amdgcn_mfma_f32_32x32x16_bf16(PAF(1), VFR(5), o[1], 0, 0, 0), C0, 12); \
    KRD(GL, 2); GAPB(o[0] = __builtin_amdgcn_mfma_f32_32x32x16_bf16(PAF(2), VFR(2), o[0], 0, 0, 0), C1, 0); \
    KRD(GL, 3); GAPB(o[1] = __builtin_amdgcn_mfma_f32_32x32x16_bf16(PAF(2), VFR(6), o[1], 0, 0, 0), C1, 4); \
    GAPB(o[0] = __builtin_amdgcn_mfma_f32_32x32x16_bf16(PAF(3), VFR(3), o[0], 0, 0, 0), C1, 8); \
    GAPB(o[1] = __builtin_amdgcn_mfma_f32_32x32x16_bf16(PAF(3), VFR(7), o[1], 0, 0, 0), C1, 12); \
    } while (0)
  int t = 1;
  #undef CMASK
  #define CMASK(P0, P1, t) do {} while (0)
  for (; t + 5 < NT; t += 2) {
    STEP(pB0, pB1, pA0, pA1, t, true, true, true);     WAIT_BAR(2); RESC(); ROT();
    STEP(pA0, pA1, pB0, pB1, t + 1, true, true, true); WAIT_BAR(2); RESC(); ROT();
  }
  #undef CMASK
  #define CMASK(P0, P1, t) do { int jb_ = (t) - (NT - 4); if (jb_ >= 0) cmask(P0, P1, jb_, qrel, hi); } while (0)
  #define ENDW(tt) do { if ((tt) + 3 < NT) { WAIT_BAR(2); } else if ((tt) + 2 < NT) { WAIT_BAR(1); } else { WAIT_BAR(0); } } while (0)
  for (; t + 1 < NT; t += 2) {
    STEP(pB0, pB1, pA0, pA1, t, (t + 3 < NT), (t + 1 < NT), (t + 1 < NT));         ENDW(t);     RESC(); ROT();
    STEP(pA0, pA1, pB0, pB1, t + 1, (t + 4 < NT), (t + 2 < NT), (t + 2 < NT));     ENDW(t + 1); RESC(); ROT();
  }
  STEP(pB0, pB1, pA0, pA1, NT - 1, false, false, false); RESC();
  { float sacc = pB0[0] + pB0[1]; _Pragma("unroll") for (int r = 2; r < 16; ++r) sacc += pB0[r]; _Pragma("unroll") for (int r = 0; r < 16; ++r) sacc += pB1[r]; l_reg += sacc;
    pw0 = (u32x4){PKW(pB0, 0), PKW(pB0, 2), PKW(pB0, 4), PKW(pB0, 6)}; pw1 = (u32x4){PKW(pB0, 8), PKW(pB0, 10), PKW(pB0, 12), PKW(pB0, 14)}; pw2 = (u32x4){PKW(pB1, 0), PKW(pB1, 2), PKW(pB1, 4), PKW(pB1, 6)}; pw3 = (u32x4){PKW(pB1, 8), PKW(pB1, 10), PKW(pB1, 12), PKW(pB1, 14)};
    SBAR(); pv(o, vb0 + sl_cur, PAF(0), PAF(1), PAF(2), PAF(3)); }
  #undef PKW
  #undef PAF
  #undef VFR
  #undef PIN
  #undef MX3
  #undef GAPA
  #undef GAPB
  #undef EX
  #undef VRD
  #undef KRD
  #undef STEP
  #undef ENDW
  { auto rr = __builtin_amdgcn_permlane32_swap(__float_as_uint(l_reg), __float_as_uint(l_reg), false, false); l_reg = __uint_as_float(rr[0]) + __uint_as_float(rr[1]); }
  if (hi == 0) wsf[32 + r32] = l_reg; asm volatile("s_waitcnt lgkmcnt(0)" ::: "memory");
  float rli[16];
  #pragma unroll
  for (int r = 0; r < 16; ++r) rli[r] = __builtin_amdgcn_rcpf(wsf[32 + crow(r, hi)]);
  bf16* Ow = O + (rowbase + q0 + wid * QBLK) * DMA + hv * D;
  { bf16* stg = (bf16*)(shm + LDS_OST) + wid * 2048;
    #pragma unroll
    for (int r = 0; r < 16; ++r) { const int orow = crow(r, hi);
      #pragma unroll
      for (int d0 = 0; d0 < 2; ++d0) stg[orow * 64 + d0 * 32 + r32] = f2bf(o[d0][r] * rli[r]); }
    asm volatile("s_waitcnt lgkmcnt(0)" ::: "memory");
    #pragma unroll
    for (int i = 0; i < 4; ++i) { const int row = i * 8 + (lane >> 3), ch = lane & 7; const u32x4 v = *(const u32x4*)(stg + row * 64 + ch * 8); ATTN_STORE16(Ow + (long)row * DMA + ch * 8, v); } }
  asm volatile("s_waitcnt lgkmcnt(0)\n\ts_barrier" ::: "memory");
  #undef DMA_K
  #undef DMA_V
  #undef CMASK
  #undef START
  #undef RESC
  #undef ROT
}
constexpr int ATTN_LDS_BYTES = LDS_BYTES;
#undef SBAR
#undef WAIT_BAR
}

constexpr int NWAVES = 8;
constexpr size_t MiB = 1u << 20;
constexpr size_t WS_CTL = 0, CTL_ZERO_BYTES = 1 * MiB;
constexpr size_t WS_MOD = 256 * 1024;
constexpr size_t WS_LAM = 1 * MiB;
constexpr size_t WS_LB16 = 1 * MiB + 4096;
constexpr size_t WS_WIN0 = 2 * MiB, WS_WGLU = 6 * MiB, WS_WOUT0 = 8 * MiB, WS_WKV = 10 * MiB, WS_WIN1 = 14 * MiB, WS_WOUT1 = 18 * MiB;
constexpr size_t WS_BTA = 20 * MiB;
constexpr size_t WS_BTB = 28 * MiB;
constexpr size_t WS_S0 = 48 * MiB, WS_S1 = 112 * MiB, WS_S2 = 176 * MiB, WS_S3 = 240 * MiB, WS_S4 = 304 * MiB, WS_S5 = 368 * MiB, WS_S6 = 432 * MiB, WS_END = 496 * MiB;
constexpr int CW_BAR = 4096;
constexpr int RING_OFF = 0, RING_BYTES = 131072;
constexpr int LDSCTL_OFF = RING_BYTES, MISC_OFF = LDSCTL_OFF + 320;
constexpr int LDS_BYTES = 147456;

#define GAS __attribute__((address_space(1)))
#define LAS __attribute__((address_space(3)))
typedef unsigned v4u __attribute__((ext_vector_type(4)));
typedef GAS unsigned gu32;
#define RLX_AGENT __ATOMIC_RELAXED, __HIP_MEMORY_SCOPE_AGENT
#define LDS_WAIT() asm volatile("s_waitcnt lgkmcnt(0)" ::: "memory")
#define VM_WAIT() asm volatile("s_waitcnt vmcnt(0)" ::: "memory")

#define XB_TMO      128
#define XB_XCNT(j)  (256  + 64 * (j))
#define XB_XSUB(j)  (1280 + 64 * (j))
#define XB_XGEN(j)  (2304 + 64 * (j))
#define XB_TOP      3328
#define XB_TOPGEN   3392
#define XCD_BAR_WORDS 3456
#define XB_SPIN_CAP (1u << 18)
__device__ __forceinline__ unsigned xb_ld(unsigned* p)              { return __hip_atomic_load(p, __ATOMIC_RELAXED, __HIP_MEMORY_SCOPE_AGENT); }
__device__ __forceinline__ unsigned xb_add(unsigned* p, unsigned v) { return __hip_atomic_fetch_add(p, v, __ATOMIC_RELAXED, __HIP_MEMORY_SCOPE_AGENT); }
__device__ __forceinline__ unsigned xb_xcc_id() { return (unsigned)__builtin_amdgcn_s_getreg((3 << 11) | 20) & 0xFu; }
#define XB_SPIN(cond, bar) do { unsigned _sp = 0; while (cond) { __builtin_amdgcn_s_sleep(1); \
    if ((++_sp & 255u) == 0u) { if (xb_ld(&(bar)[XB_TMO])) break; if (_sp > XB_SPIN_CAP) { atomicAdd(&(bar)[XB_TMO], 1u); break; } } } } while (0)
struct XcdBarrier { unsigned* bar; unsigned x; volatile LAS unsigned* st; };
__device__ __forceinline__ XcdBarrier xcd_barrier_post(unsigned* bar, volatile LAS unsigned* st) {
    XcdBarrier b; b.bar = bar; b.x = xb_xcc_id(); b.st = st;
    if (threadIdx.x == 0) (void)xb_add(&bar[XB_XCNT(b.x)], 1u);
    return b;
}
__device__ __forceinline__ void xcd_barrier_complete(unsigned* bar, unsigned x, unsigned& nloc, unsigned& nx) {
    const unsigned G = gridDim.x * gridDim.y * gridDim.z;
    unsigned sum, cnt, mine, sp = 0u;
    for (;;) {
        sum = 0u; cnt = 0u; mine = 0u;
#pragma unroll
        for (unsigned j = 0; j < 16; ++j) { const unsigned c = xb_ld(&bar[XB_XCNT(j)]); sum += c; cnt += (c > 0u) ? 1u : 0u; mine = (j == x) ? c : mine; }
        if (sum == G) break;
        __builtin_amdgcn_s_sleep(1);
        if ((++sp & 255u) == 0u) { if (xb_ld(&bar[XB_TMO])) break; if (sp > XB_SPIN_CAP) { atomicAdd(&bar[XB_TMO], 1u); break; } }
    }
    nloc = mine > 0u ? mine : 1u; nx = cnt > 0u ? cnt : 1u;
}
__device__ __forceinline__ void xcd_barrier(const XcdBarrier& b) {
    asm volatile("s_waitcnt vmcnt(0)" ::: "memory");
    __syncthreads();
    if (threadIdx.x == 0) {
        unsigned* bar = b.bar;
        __builtin_amdgcn_s_waitcnt(0);
        unsigned nloc = b.st[0], nx = b.st[1];
        if (nloc == 0u) { xcd_barrier_complete(bar, b.x, nloc, nx); b.st[0] = nloc; b.st[1] = nx; }
        const unsigned old = xb_add(&bar[XB_XSUB(b.x)], 1u);
        const unsigned gen = old / nloc;
        if (old + 1u == (gen + 1u) * nloc) {
            __builtin_amdgcn_fence(__ATOMIC_RELEASE, "agent");
            asm volatile("s_waitcnt vmcnt(0)" ::: "memory");
            const unsigned og = xb_add(&bar[XB_TOP], 1u);
            const unsigned tg = og / nx;
            if (og + 1u == (tg + 1u) * nx) xb_add(&bar[XB_TOPGEN], 1u);
            else XB_SPIN(xb_ld(&bar[XB_TOPGEN]) == tg, bar);
            __builtin_amdgcn_fence(__ATOMIC_ACQUIRE, "agent");
            xb_add(&bar[XB_XGEN(b.x)], 1u);
            asm volatile("s_waitcnt vmcnt(0)" ::: "memory");
        } else {
            XB_SPIN(xb_ld(&bar[XB_XGEN(b.x)]) == gen, bar);
            __builtin_amdgcn_fence(__ATOMIC_ACQUIRE, "agent");
            asm volatile("s_waitcnt vmcnt(0)" ::: "memory");
        }
    }
    __syncthreads();
}

__device__ __forceinline__ void p0_transpose_item(const float* W, int K, int N, bf16_t* WT, int row_off, const float* kscale, LAS float* scr, int item, int lane) {
    const int nblk = N / 32, kb = item / nblk, nb = item % nblk, k0 = 64 * kb, n0 = 32 * nb;
#pragma unroll 8
    for (int i = 0; i < 32; ++i) { const int kk = 2 * i + (lane >> 5); float v = W[(size_t)(k0 + kk) * N + n0 + (lane & 31)]; if (kscale) v *= kscale[k0 + kk]; scr[kk * 33 + (lane & 31)] = v; }
    LDS_WAIT(); asm volatile("" ::: "memory");
    const int c = lane & 7;
#pragma unroll
    for (int j = 0; j < 4; ++j) { const int n = (lane >> 3) + 8 * j; const LAS float* s = scr + (8 * c) * 33 + n;
        v4u o; o.x = pk2bf(s[0 * 33], s[1 * 33]); o.y = pk2bf(s[2 * 33], s[3 * 33]); o.z = pk2bf(s[4 * 33], s[5 * 33]); o.w = pk2bf(s[6 * 33], s[7 * 33]);
        *(GAS v4u*)(WT + (size_t)(row_off + n0 + n) * K + k0 + 8 * c) = o; }
    LDS_WAIT(); asm volatile("" ::: "memory");
}

struct Args {
    const float* in[28]; float* out; unsigned char* ws;
    int ph_lo, ph_hi, use_bar, flags;
};

__global__ void __launch_bounds__(NWAVES * 64, 2) mega_fwd(Args args) {
    extern __shared__ __attribute__((aligned(16))) unsigned char lds_raw[];
    LAS unsigned char* lds = (LAS unsigned char*)lds_raw;
    volatile LAS unsigned* MISC = (volatile LAS unsigned*)(lds + MISC_OFF);
    const int tid = threadIdx.x, lane = tid & 63, wave = __builtin_amdgcn_readfirstlane(tid >> 6);
    const int G = gridDim.x; const int bx = blockIdx.x; const int vcu = (G % 8 == 0) ? (bx % 8) * (G / 8) + bx / 8 : bx;
    unsigned char* ws = args.ws;
    gu32* ctl = (gu32*)(ws + WS_CTL);
    const float* x = args.in[0]; const float* cvec = args.in[1]; const float* ada_w = args.in[2]; const float* ada_b = args.in[3];
    const float* g_pre = args.in[4]; const float* g_post = args.in[5];
    float* out = args.out;
    float* mod = (float*)(ws + WS_MOD); float* lamp = (float*)(ws + WS_LAM); float* lb16 = (float*)(ws + WS_LB16);
    bf16_t* Win0 = (bf16_t*)(ws + WS_WIN0); bf16_t* Wglu = (bf16_t*)(ws + WS_WGLU); bf16_t* Wout0 = (bf16_t*)(ws + WS_WOUT0); bf16_t* Wkv = (bf16_t*)(ws + WS_WKV);
    bf16_t* Win1 = (bf16_t*)(ws + WS_WIN1); bf16_t* Wout1 = (bf16_t*)(ws + WS_WOUT1); bf16_t* BtA = (bf16_t*)(ws + WS_BTA); bf16_t* BtB = (bf16_t*)(ws + WS_BTB);
    bf16_t* A0 = (bf16_t*)(ws + WS_S0); bf16_t* US = (bf16_t*)(ws + WS_S1); bf16_t* SZ = (bf16_t*)(ws + WS_S3); bf16_t* YG = (bf16_t*)(ws + WS_S4); float* EB = (float*)(ws + WS_S0);
    bf16_t* Y2 = (bf16_t*)(ws + WS_S0); bf16_t* YO = (bf16_t*)(ws + WS_S1); bf16_t* AKV = (bf16_t*)(ws + WS_S0); bf16_t* AIN1 = (bf16_t*)(ws + WS_S2);
    bf16_t* KB = (bf16_t*)(ws + WS_S3); bf16_t* VB = (bf16_t*)(ws + WS_S4); bf16_t* QB = (bf16_t*)(ws + WS_S5); bf16_t* SZ1 = (bf16_t*)(ws + WS_S6);
    bf16_t* O0 = (bf16_t*)(ws + WS_S0); bf16_t* O1 = (bf16_t*)(ws + WS_S1); bf16_t* OG = (bf16_t*)(ws + WS_S2); bf16_t* YO1 = (bf16_t*)(ws + WS_S0);

    for (int u = tid; u < (LDS_BYTES - LDSCTL_OFF) / 4; u += NWAVES * 64) ((LAS unsigned*)(lds + LDSCTL_OFF))[u] = 0u;
    __syncthreads();
    XcdBarrier bar; bar.bar = (unsigned*)(ctl + CW_BAR); bar.x = 0; bar.st = nullptr;
    if (args.use_bar) bar = xcd_barrier_post((unsigned*)(ctl + CW_BAR), MISC + 8);
    const int lo = args.ph_lo, hi = args.ph_hi;
#define IN(k) (lo <= (k) && (k) < hi)
#define SEAM(k) do { if (IN(k) && IN((k) + 1) && args.use_bar) xcd_barrier(bar); } while (0)
    const int gw = vcu * NWAVES + wave, NGW = G * NWAVES;

    if (IN(0)) {
        for (int it = vcu; it < NGRP * 4; it += G) {
            const int g = it >> 2, qt = it & 3;
            LAS float* LBP = (LAS float*)(lds + RING_OFF);
            LAS float* BBR = LBP + 17 * 128;
            LAS float* CC = BBR + 64 * 32;
            LAS float* KM = CC + 16 * 128;
            __syncthreads();
            if (tid < 64) {
                const int p = tid;
                const float dt = expf(args.in[9][g]);
                const float lr = args.in[7][g * 64 + p], li = args.in[8][g * 64 + p];
                const float mag = expf(lr * dt); const float sn = sinf(li * dt), cs = cosf(li * dt);
                const float lbr = mag * cs, lbi = mag * sn;
                float pr = 1.f, pi = 0.f;
                for (int d = 0; d <= 16; ++d) { LBP[(d * 64 + p) * 2] = pr; LBP[(d * 64 + p) * 2 + 1] = pi; const float nr = pr * lbr - pi * lbi, ni = pr * lbi + pi * lbr; pr = nr; pi = ni; }
                if (qt == 0) { lb16[(g * 64 + p) * 2] = LBP[(16 * 64 + p) * 2]; lb16[(g * 64 + p) * 2 + 1] = LBP[(16 * 64 + p) * 2 + 1]; }
                const float nr = lbr - 1.0f, ni = lbi, den = lr * lr + li * li;
                const float cr = (nr * lr + ni * li) / den, ci = (ni * lr - nr * li) / den;
                for (int c = 0; c < 16; ++c) { const float br = args.in[10][(g * 64 + p) * 16 + c], bi = args.in[11][(g * 64 + p) * 16 + c];
                    BBR[(p * 16 + c) * 2] = cr * br - ci * bi; BBR[(p * 16 + c) * 2 + 1] = cr * bi + ci * br; }
            }
            for (int e = tid; e < 1024; e += 512) { const int co = e >> 6, p = e & 63; CC[e * 2] = args.in[12][(g * 16 + co) * 64 + p]; CC[e * 2 + 1] = args.in[13][(g * 16 + co) * 64 + p]; }
            __syncthreads();
            for (int e = tid; e < 4096; e += 512) {
                const int d = e >> 8, co = (e >> 4) & 15, ci = e & 15; float acc = 0.f;
                for (int p = 0; p < 64; ++p) { const float cr = CC[(co * 64 + p) * 2], cim = CC[(co * 64 + p) * 2 + 1], lr = LBP[(d * 64 + p) * 2], lim = LBP[(d * 64 + p) * 2 + 1];
                    const float wr_ = cr * lr - cim * lim, wi_ = cr * lim + cim * lr; acc += wr_ * BBR[(p * 16 + ci) * 2] - wi_ * BBR[(p * 16 + ci) * 2 + 1]; }
                KM[e] = acc; }
            __syncthreads();
            for (int e = tid; e < 64 * 48; e += 512) {
                const int n = 64 * qt + e / 48, pc = e % 48, s = n >> 4, co = n & 15; float v[8];
                if (pc < 32) { const int s2 = pc >> 1, ci0 = (pc & 1) * 8;
#pragma unroll
                    for (int j = 0; j < 8; ++j) v[j] = (s2 <= s) ? KM[((s - s2) * 16 + co) * 16 + ci0 + j] : 0.f;
                } else { const int j0 = (pc - 32) * 8;
#pragma unroll
                    for (int jj = 0; jj < 4; ++jj) { const int p = (j0 >> 1) + jj; const float cr = CC[(co * 64 + p) * 2], cim = CC[(co * 64 + p) * 2 + 1], lr = LBP[((s + 1) * 64 + p) * 2], lim = LBP[((s + 1) * 64 + p) * 2 + 1];
                        v[2 * jj] = cr * lr - cim * lim; v[2 * jj + 1] = -(cr * lim + cim * lr); } }
                v4u o; o.x = pk2bf(v[0], v[1]); o.y = pk2bf(v[2], v[3]); o.z = pk2bf(v[4], v[5]); o.w = pk2bf(v[6], v[7]);
                *(GAS v4u*)(BtB + ((size_t)g * 256 + n) * 384 + pc * 8) = o; }
            for (int e = tid; e < 64 * 32; e += 512) {
                const int n = 64 * qt + (e >> 5), pc = e & 31; float v[8];
                if (n < 128) { const int p = n >> 1, ri = n & 1, s2 = pc >> 1, ci0 = (pc & 1) * 8; const float lr = LBP[((15 - s2) * 64 + p) * 2], lim = LBP[((15 - s2) * 64 + p) * 2 + 1];
#pragma unroll
                    for (int j = 0; j < 8; ++j) { const float br = BBR[(p * 16 + ci0 + j) * 2], bi = BBR[(p * 16 + ci0 + j) * 2 + 1]; v[j] = ri ? (lr * bi + lim * br) : (lr * br - lim * bi); }
                } else {
#pragma unroll
                    for (int j = 0; j < 8; ++j) v[j] = 0.f; }
                v4u o; o.x = pk2bf(v[0], v[1]); o.y = pk2bf(v[2], v[3]); o.z = pk2bf(v[4], v[5]); o.w = pk2bf(v[6], v[7]);
                *(GAS v4u*)(BtA + ((size_t)g * 256 + n) * 256 + pc * 8) = o; }
        }
        __syncthreads();
        {
            LAS float* scr = (LAS float*)(lds + RING_OFF + wave * 16384);
            constexpr int I_2K = (DM / 64) * (2048 / 32), I_1K = (DM / 64) * (1024 / 32);
            constexpr int NITEMS = 2 * I_2K + 5 * I_1K;
            for (int it = gw; it < NITEMS; it += NGW) {
                int r = it;
                if (r < I_2K) { p0_transpose_item(args.in[6], DM, 2048, Win0, 0, nullptr, scr, r, lane); continue; } r -= I_2K;
                if (r < I_2K) { p0_transpose_item(args.in[21], DM, 2048, Win1, 0, nullptr, scr, r, lane); continue; } r -= I_2K;
                if (r < I_1K) { p0_transpose_item(args.in[15], DM, 1024, Wglu, 0, nullptr, scr, r, lane); continue; } r -= I_1K;
                if (r < I_1K) { p0_transpose_item(args.in[17], DM, 1024, Wout0, 0, nullptr, scr, r, lane); continue; } r -= I_1K;
                if (r < I_1K) { p0_transpose_item(args.in[19], DM, 1024, Wkv, 0, args.in[18], scr, r, lane); continue; } r -= I_1K;
                if (r < I_1K) { p0_transpose_item(args.in[20], DM, 1024, Wkv, 1024, args.in[18], scr, r, lane); continue; } r -= I_1K;
                p0_transpose_item(args.in[27], DM, 1024, Wout1, 0, nullptr, scr, r, lane);
            }
        }
        if (!(args.flags & 1)) {
            __syncthreads();
            LAS float* sc = (LAS float*)(lds + RING_OFF);
            LAS float* red = sc + 8192;
            bool have = false;
            for (int it = vcu; it < 2 * 48; it += G) {
                if (!have) { for (int e = tid; e < 8192; e += 512) sc[e] = silu_f(cvec[e]); have = true; __syncthreads(); }
                const int l = it / 48, cc = it % 48, j = cc * 64 + lane;
                float acc[8];
#pragma unroll
                for (int b = 0; b < 8; ++b) acc[b] = 0.f;
                const float* wp = ada_w + ((size_t)l * 1024 + wave * 128) * 3072 + j;
                for (int k0 = 0; k0 < 128; k0 += 8) {
                    float w[8];
#pragma unroll
                    for (int kk = 0; kk < 8; ++kk) w[kk] = wp[(size_t)(k0 + kk) * 3072];
#pragma unroll
                    for (int kk = 0; kk < 8; ++kk)
#pragma unroll
                        for (int b = 0; b < 8; ++b) acc[b] += w[kk] * sc[b * 1024 + wave * 128 + k0 + kk];
                }
#pragma unroll
                for (int b = 0; b < 8; ++b) red[(wave * 8 + b) * 64 + lane] = acc[b];
                __syncthreads();
                { const int b = tid >> 6; float sum = ada_b[l * 3072 + j];
#pragma unroll
                  for (int w = 0; w < 8; ++w) sum += red[(w * 8 + b) * 64 + lane];
                  mod[((size_t)(l * 8 + b)) * 3072 + j] = sum; }
                __syncthreads();
            }
            if (bx == 0 && tid == 0) lamp[0] = diff_lambda(args.in[22], args.in[23], args.in[24], args.in[25]);
        }
    }
    SEAM(0);
    if (IN(1)) e_norm0(x, mod, g_pre, A0, gw, NGW, lane);
    SEAM(1);
    if (IN(2)) {
        pg8::Gemm g = pg8::gemm_std(A0, DM, Win0, DM, DM); pg8::Order S; S.init(MTOK / 256, 2048 / 256, 1, G, bx);
        pg8::EpiRow8<pg8::F_In0> E{{US, SZ}};
        pg8::gemm_phase<pg8::EpiRow8<pg8::F_In0>, true>(lds + RING_OFF, g, S, E);
    }
    SEAM(2);
    if (IN(3)) {
        pg8::Gemm g = pg8::gemm_std(US, US_P, BtA, 256, 256); g.a_gstep = (size_t)NTILE * US_P * 2; g.b_gstep = (size_t)256 * 256 * 2;
        pg8::Order S; S.init(NTILE / 256, 1, NGRP, G, bx);
        pg8::EpiRow8<pg8::F_SsmA> E{{EB}};
        pg8::gemm_phase<pg8::EpiRow8<pg8::F_SsmA>, true>(lds + RING_OFF, g, S, E);
    }
    SEAM(3);
    if (IN(4)) {
        for (int it = vcu + G * wave; it < NB * NGRP; it += G * NWAVES) {
            const int b = it / NGRP, g = it % NGRP, p = lane;
            const float lr = lb16[(g * 64 + p) * 2], li = lb16[(g * 64 + p) * 2 + 1];
            float sr = 0.f, si = 0.f;
            const float* ep = EB + ((size_t)g * NTILE + b * 256) * 128 + 2 * p;
            bf16_t* sp = US + us_off(g, b * 256, 256 + 2 * p);
            for (int t0 = 0; t0 < 256; t0 += 16) {
                float er[16], ei[16];
#pragma unroll
                for (int j = 0; j < 16; ++j) { const float2 e = *(const float2*)(ep + (size_t)(t0 + j) * 128); er[j] = e.x; ei[j] = e.y; }
#pragma unroll
                for (int j = 0; j < 16; ++j) { *(unsigned*)(sp + (size_t)(t0 + j) * US_P) = pk2bf(sr, si);
                    const float nr = lr * sr - li * si + er[j], ni = lr * si + li * sr + ei[j]; sr = nr; si = ni; }
            }
        }
    }
    SEAM(4);
    if (IN(5)) {
        pg8::Gemm g = pg8::gemm_std(US, US_P, BtB, 384, 384); g.a_gstep = (size_t)NTILE * US_P * 2; g.b_gstep = (size_t)256 * 384 * 2;
        pg8::Order S; S.init(NTILE / 256, 1, NGRP, G, bx);
        pg8::EpiRow8<pg8::F_SsmB> E{{US, args.in[14], YG}};
        pg8::gemm_phase<pg8::EpiRow8<pg8::F_SsmB>, true>(lds + RING_OFF, g, S, E);
    }
    SEAM(5);
    if (IN(6)) {
        pg8::Gemm g = pg8::gemm_std(YG, DM, Wglu, DM, DM);
        g.a_rs = 32u; g.a_c16 = (unsigned)((size_t)NTILE * YG_P * 2); g.a_kstep = (size_t)4 * NTILE * YG_P * 2; g.a_tstep = (size_t)256 * 32;
        pg8::Order S; S.init(MTOK / 256, 1024 / 256, 1, G, bx);
        pg8::EpiRow8<pg8::F_Glu> E{{YG, SZ, args.in[16], Y2}};
        pg8::gemm_phase<pg8::EpiRow8<pg8::F_Glu>, true>(lds + RING_OFF, g, S, E);
    }
    SEAM(6);
    if (IN(7)) {
        pg8::Gemm g = pg8::gemm_std(Y2, DM, Wout0, DM, DM); pg8::Order S; S.init(MTOK / 256, 1024 / 256, 1, G, bx);
        pg8::EpiRow8<pg8::F_Plain> E{{YO}};
        pg8::gemm_phase<pg8::EpiRow8<pg8::F_Plain>, true>(lds + RING_OFF, g, S, E);
    }
    SEAM(7);
    if (IN(8)) e_mid(x, YO, mod, g_post, g_pre, out, AKV, AIN1, gw, NGW, lane);
    SEAM(8);
    if (IN(9)) {
        { pg8::Gemm g = pg8::gemm_std(AKV, DM, Wkv, DM, DM); pg8::Order S; S.init(MTOK / 256, 2048 / 256, 1, G, bx);
          pg8::EpiRow8<pg8::F_Split> E{{KB, VB, 1.0f, 0}};
          pg8::gemm_phase<pg8::EpiRow8<pg8::F_Split>, true>(lds + RING_OFF, g, S, E); }
        { pg8::Gemm g = pg8::gemm_std(AIN1, DM, Win1, DM, DM); pg8::Order S; S.init(MTOK / 256, 2048 / 256, 1, G, bx);
          pg8::EpiRow8<pg8::F_Split> E{{QB, SZ1, QC2, 1}};
          pg8::gemm_phase<pg8::EpiRow8<pg8::F_Split>, true>(lds + RING_OFF, g, S, E); }
    }
    SEAM(9);
    if (IN(10)) {
        for (int i = 0;; ++i) {
            const long L = (long)i * G + vcu; if (L >= 256 * 16) break;
            const int combo = (int)(L % 256), qi = (int)(L / 256);
            const int qb = (qi & 1) ? (qi >> 1) : (15 - (qi >> 1));
            const int vh = combo & 1, c = (combo >> 1) & 1, h = (combo >> 2) & 7, b = combo >> 5;
            attn_body::attn_unit<8>(b, 2 * h + c, 2 * h + vh, qb, QB, KB, VB, c ? O1 : O0, (char*)lds_raw + RING_OFF);
        }
    }
    SEAM(10);
    if (IN(11)) e_attn_post(O0, O1, SZ1, args.in[26], lamp[0], OG, gw, NGW, lane);
    SEAM(11);
    if (IN(12)) {
        pg8::Gemm g = pg8::gemm_std(OG, DM, Wout1, DM, DM); pg8::Order S; S.init(MTOK / 256, 1024 / 256, 1, G, bx);
        pg8::EpiRow8<pg8::F_Plain> E{{YO1}};
        pg8::gemm_phase<pg8::EpiRow8<pg8::F_Plain>, true>(lds + RING_OFF, g, S, E);
    }
    SEAM(12);
    if (IN(13)) e_final(out, YO1, mod, g_post, gw, NGW, lane);
#undef IN
#undef SEAM
}

#ifndef FASTMASK
#define FASTMASK 0x3fff
#endif
#ifndef ONE_LAUNCH
#define ONE_LAUNCH 1
#endif
constexpr int NPHASE = 14;

extern "C" void kernel_launch(void* const* d_in, const int* in_sizes, int n_in, void* d_out, int out_size, void* d_ws, size_t ws_size, hipStream_t stream) {
    static int grid = 0;
    if (grid == 0) {
        if (n_in != 28 || out_size != MTOK * DM || ws_size < WS_END) { fprintf(stderr, "kernel_launch: unexpected shapes (n_in %d out %d ws %zu)\n", n_in, out_size, ws_size); grid = -1; return; }
        int dev = 0, cus = 0, per_cu = 0;
        if (hipGetDevice(&dev) != hipSuccess || hipDeviceGetAttribute(&cus, hipDeviceAttributeMultiprocessorCount, dev) != hipSuccess) { grid = -1; return; }
        if (hipFuncSetAttribute((const void*)mega_fwd, hipFuncAttributeMaxDynamicSharedMemorySize, LDS_BYTES) != hipSuccess) { fprintf(stderr, "kernel_launch: hipFuncSetAttribute failed\n"); grid = -1; return; }
        if (hipOccupancyMaxActiveBlocksPerMultiprocessor(&per_cu, (const void*)mega_fwd, NWAVES * 64, LDS_BYTES) != hipSuccess || per_cu < 1) { fprintf(stderr, "kernel_launch: occupancy query says %d\n", per_cu); }
        (void)hipGetLastError();
        grid = cus;
    }
    if (grid < 0) return;
    if (hipMemsetAsync((char*)d_ws + WS_CTL, 0, CTL_ZERO_BYTES, stream) != hipSuccess) { fprintf(stderr, "kernel_launch: memset failed\n"); return; }
    Args a{};
    for (int i = 0; i < 28; ++i) a.in[i] = (const float*)d_in[i];
    a.out = (float*)d_out; a.ws = (unsigned char*)d_ws;
#if ONE_LAUNCH
    a.ph_lo = 0; a.ph_hi = NPHASE; a.use_bar = 1; a.flags = 0;
    hipLaunchKernelGGL(mega_fwd, dim3(grid), dim3(NWAVES * 64), LDS_BYTES, stream, a);
#else
    const float* x = a.in[0]; unsigned char* ws = a.ws; float* out = a.out;
    float* mod = (float*)(ws + WS_MOD); float* lam = (float*)(ws + WS_LAM);
    bf16_t* A0 = (bf16_t*)(ws + WS_S0); bf16_t* US = (bf16_t*)(ws + WS_S1); bf16_t* SZ = (bf16_t*)(ws + WS_S3); bf16_t* YG = (bf16_t*)(ws + WS_S4);
    bf16_t* Y2 = (bf16_t*)(ws + WS_S0); bf16_t* YO = (bf16_t*)(ws + WS_S1); bf16_t* AKV = (bf16_t*)(ws + WS_S0); bf16_t* AIN1 = (bf16_t*)(ws + WS_S2);
    bf16_t* KB = (bf16_t*)(ws + WS_S3); bf16_t* VB = (bf16_t*)(ws + WS_S4); bf16_t* QB = (bf16_t*)(ws + WS_S5); bf16_t* SZ1 = (bf16_t*)(ws + WS_S6);
    bf16_t* O0 = (bf16_t*)(ws + WS_S0); bf16_t* O1 = (bf16_t*)(ws + WS_S1); bf16_t* OG = (bf16_t*)(ws + WS_S2); bf16_t* YO1 = (bf16_t*)(ws + WS_S0);
    const int EG = 2048;
    auto fast = [&](int lo, int hi, int flags) { a.ph_lo = lo; a.ph_hi = hi; a.use_bar = 0; a.flags = flags; hipLaunchKernelGGL(mega_fwd, dim3(grid), dim3(NWAVES * 64), LDS_BYTES, stream, a); };
    const unsigned FM = FASTMASK;
    if (FM & 1u) fast(0, 1, 0);
    else { fast(0, 1, 1); n_adaln<<<(2 * 8 * 3072 + 255) / 256, 256, 0, stream>>>(a.in[1], a.in[2], a.in[3], mod); n_lambda<<<1, 64, 0, stream>>>(a.in[22], a.in[23], a.in[24], a.in[25], lam); }
    if (FM & 2u) fast(1, 2, 0); else n_norm0<<<EG, 256, 0, stream>>>(x, mod, a.in[4], A0);
    if (FM & 4u) fast(2, 3, 0); else n_gemm<<<dim3(2048 / 64, MTOK / 64), 256, 0, stream>>>(AL_Row{A0}, WL_Plain{a.in[6], 2048}, EP_In0{US, SZ}, 2048);
    if (FM & 8u) { fast(3, 4, 0); fast(4, 5, 0); fast(5, 6, 0); }
    else n_ssm<<<NB * NGRP / 4, 256, 0, stream>>>(US, a.in[7], a.in[8], a.in[9], a.in[10], a.in[11], a.in[12], a.in[13], a.in[14], YG);
    if (FM & 64u) fast(6, 7, 0); else n_gemm<<<dim3(1024 / 64, MTOK / 64), 256, 0, stream>>>(AL_YG{YG}, WL_Plain{a.in[15], 1024}, EP_Glu{YG, SZ, a.in[16], Y2}, 1024);
    if (FM & 128u) fast(7, 8, 0); else n_gemm<<<dim3(1024 / 64, MTOK / 64), 256, 0, stream>>>(AL_Row{Y2}, WL_Plain{a.in[17], 1024}, EP_Plain{YO}, 1024);
    if (FM & 256u) fast(8, 9, 0); else n_mid<<<EG, 256, 0, stream>>>(x, YO, mod, a.in[5], a.in[4], out, AKV, AIN1);
    if (FM & 512u) fast(9, 10, 0);
    else { n_gemm<<<dim3(2048 / 64, MTOK / 64), 256, 0, stream>>>(AL_Row{AKV}, WL_KV{a.in[19], a.in[20], a.in[18]}, EP_KV{KB, VB}, 2048);
           n_gemm<<<dim3(2048 / 64, MTOK / 64), 256, 0, stream>>>(AL_Row{AIN1}, WL_Plain{a.in[21], 2048}, EP_In1{QB, SZ1}, 2048); }
    if (FM & 1024u) fast(10, 11, 0); else n_attn<<<MTOK * 8 / 4, 256, 0, stream>>>(QB, KB, VB, O0, O1);
    if (FM & 2048u) fast(11, 12, 0); else n_attn_post<<<EG, 256, 0, stream>>>(O0, O1, SZ1, a.in[26], lam, OG);
    if (FM & 4096u) fast(12, 13, 0); else n_gemm<<<dim3(1024 / 64, MTOK / 64), 256, 0, stream>>>(AL_Row{OG}, WL_Plain{a.in[27], 1024}, EP_Plain{YO1}, 1024);
    if (FM & 8192u) fast(13, 14, 0); else n_final<<<EG, 256, 0, stream>>>(out, YO1, mod, a.in[5]);
#endif
    const hipError_t le = hipPeekAtLastError();
    if (le != hipSuccess) fprintf(stderr, "kernel_launch: launch failed: %s\n", hipGetErrorName(le));
}
```

```cpp
#include <hip/hip_runtime.h>
#include <cstdio>
#include <cstdint>
#include <cmath>
#define FASTMASK 0x3fff
#define ONE_LAUNCH 1
typedef unsigned short bf16_t;
constexpr int NB = 8, SEQL = 4096, DM = 1024, MTOK = NB * SEQL;
constexpr int NGRP = 64, NTILE = MTOK / 16;
constexpr int US_P = 384, YG_P = 256;
constexpr float LAMBDA_INIT = 0.35550907f;
constexpr float ONE_M_LI = 1.0f - LAMBDA_INIT;
constexpr float RMS_EPS = 1e-6f;
constexpr float QC2 = 0.125f * 1.4426950408889634f;

__device__ __forceinline__ float bf2f(bf16_t v) { return __uint_as_float((unsigned)v << 16); }
__device__ __forceinline__ unsigned f2bf_u(float f) { unsigned u = __float_as_uint(f); return (u + 0x7fffu + ((u >> 16) & 1u)) >> 16; }
__device__ __forceinline__ bf16_t f2bf(float f) { return (bf16_t)f2bf_u(f); }
__device__ __forceinline__ unsigned pk2bf(float lo, float hi) { return f2bf_u(lo) | (f2bf_u(hi) << 16); }
__device__ __forceinline__ float silu_f(float v) { return v / (1.0f + __expf(-v)); }
__device__ __forceinline__ float sigmoid_f(float v) { return 1.0f / (1.0f + __expf(-v)); }
__device__ __forceinline__ float gelu_tanh_f(float v) {
    const float u = 0.7978845608028654f * (v + 0.044715f * v * v * v);
    const float e = __expf(2.0f * u);
    const float t = 1.0f - 2.0f / (e + 1.0f);
    return 0.5f * v * (1.0f + t);
}
__device__ __forceinline__ float wave_sum_f(float v) {
#pragma unroll
    for (int o = 1; o < 64; o <<= 1) v += __shfl_xor(v, o);
    return v;
}
__device__ __forceinline__ float wave_max_f(float v) {
#pragma unroll
    for (int o = 1; o < 64; o <<= 1) v = fmaxf(v, __shfl_xor(v, o));
    return v;
}
__device__ __forceinline__ size_t us_off(int g, int tile, int col) { return ((size_t)g * NTILE + tile) * US_P + col; }
__device__ __forceinline__ size_t yg_off(int g, int tile, int col) { return ((size_t)g * NTILE + tile) * YG_P + col; }

typedef float f32x4_t __attribute__((ext_vector_type(4)));
typedef unsigned u32x4_t __attribute__((ext_vector_type(4)));
typedef unsigned u32x2_t __attribute__((ext_vector_type(2)));

__device__ __forceinline__ void e_norm0(const float* __restrict__ x, const float* __restrict__ mod, const float* __restrict__ g_pre, bf16_t* a0, int gw, int ngw, int lane) {
    for (int m = gw; m < MTOK; m += ngw) {
        const int b = m / SEQL;
        const f32x4_t* xr = (const f32x4_t*)(x + (size_t)m * DM) + lane;
        f32x4_t v[4]; float s = 0.f;
#pragma unroll
        for (int j = 0; j < 4; ++j) { v[j] = xr[64 * j]; s += (v[j].x * v[j].x + v[j].y * v[j].y) + (v[j].z * v[j].z + v[j].w * v[j].w); }
        const float r = rsqrtf(wave_sum_f(s) * (1.0f / DM) + RMS_EPS);
        const float* sh = mod + (size_t)b * 3072; const float* sc = sh + 1024;
        u32x2_t* o = (u32x2_t*)(a0 + (size_t)m * DM) + lane;
#pragma unroll
        for (int j = 0; j < 4; ++j) {
            const int c = 256 * j + 4 * lane;
            const f32x4_t g = *(const f32x4_t*)(g_pre + c), scv = *(const f32x4_t*)(sc + c), shv = *(const f32x4_t*)(sh + c);
            f32x4_t y = v[j] * r * g * (scv + 1.0f) + shv;
            u32x2_t w; w.x = pk2bf(y.x, y.y); w.y = pk2bf(y.z, y.w); o[64 * j] = w;
        }
    }
}
__device__ __forceinline__ void e_mid(const float* __restrict__ x, const bf16_t* __restrict__ yo, const float* __restrict__ mod, const float* __restrict__ g_post, const float* __restrict__ g_pre,
                                      float* h1, bf16_t* akv, bf16_t* ain1, int gw, int ngw, int lane) {
    for (int m = gw; m < MTOK; m += ngw) {
        const int b = m / SEQL;
        const f32x4_t* xr = (const f32x4_t*)(x + (size_t)m * DM) + lane;
        const u32x2_t* yr = (const u32x2_t*)(yo + (size_t)m * DM) + lane;
        f32x4_t v[4], y[4]; float s = 0.f;
#pragma unroll
        for (int j = 0; j < 4; ++j) { v[j] = xr[64 * j]; const u32x2_t w = yr[64 * j];
            y[j].x = __uint_as_float(w.x << 16); y[j].y = __uint_as_float(w.x & 0xffff0000u); y[j].z = __uint_as_float(w.y << 16); y[j].w = __uint_as_float(w.y & 0xffff0000u);
            s += (y[j].x * y[j].x + y[j].y * y[j].y) + (y[j].z * y[j].z + y[j].w * y[j].w); }
        const float ry = rsqrtf(wave_sum_f(s) * (1.0f / DM) + RMS_EPS);
        const float* gate0 = mod + (size_t)b * 3072 + 2048;
        const float* sh1 = mod + (size_t)(8 + b) * 3072; const float* sc1 = sh1 + 1024;
        float s2 = 0.f;
        f32x4_t* ho = (f32x4_t*)(h1 + (size_t)m * DM) + lane;
#pragma unroll
        for (int j = 0; j < 4; ++j) { const int c = 256 * j + 4 * lane;
            const f32x4_t gp = *(const f32x4_t*)(g_post + c), gt = *(const f32x4_t*)(gate0 + c);
            v[j] = v[j] + gt * (y[j] * ry * gp);
            ho[64 * j] = v[j];
            s2 += (v[j].x * v[j].x + v[j].y * v[j].y) + (v[j].z * v[j].z + v[j].w * v[j].w); }
        const float rh = rsqrtf(wave_sum_f(s2) * (1.0f / DM) + RMS_EPS);
        u32x2_t* o1 = (u32x2_t*)(akv + (size_t)m * DM) + lane; u32x2_t* o2 = (u32x2_t*)(ain1 + (size_t)m * DM) + lane;
#pragma unroll
        for (int j = 0; j < 4; ++j) { const int c = 256 * j + 4 * lane;
            const f32x4_t n = v[j] * rh;
            u32x2_t w; w.x = pk2bf(n.x, n.y); w.y = pk2bf(n.z, n.w); o1[64 * j] = w;
            const f32x4_t g = *(const f32x4_t*)(g_pre + 1024 + c), scv = *(const f32x4_t*)(sc1 + c), shv = *(const f32x4_t*)(sh1 + c);
            const f32x4_t z = n * g * (scv + 1.0f) + shv;
            w.x = pk2bf(z.x, z.y); w.y = pk2bf(z.z, z.w); o2[64 * j] = w; }
    }
}
__device__ __forceinline__ void e_attn_post(const bf16_t* __restrict__ o0, const bf16_t* __restrict__ o1, const bf16_t* __restrict__ sz1, const float* __restrict__ g_sub, float lam,
                                            bf16_t* og, int gw, int ngw, int lane) {
    for (int m = gw; m < MTOK; m += ngw) {
#pragma unroll
        for (int j = 0; j < 2; ++j) {
            const int c = 512 * j + 8 * lane;
            const u32x4_t a = *(const u32x4_t*)(o0 + (size_t)m * DM + c), bq = *(const u32x4_t*)(o1 + (size_t)m * DM + c), zq = *(const u32x4_t*)(sz1 + (size_t)m * DM + c);
            float d[8]; float s = 0.f;
#pragma unroll
            for (int i = 0; i < 4; ++i) { const unsigned wa = a[i], wb = bq[i];
                d[2 * i] = __uint_as_float(wa << 16) - lam * __uint_as_float(wb << 16); d[2 * i + 1] = __uint_as_float(wa & 0xffff0000u) - lam * __uint_as_float(wb & 0xffff0000u);
                s += d[2 * i] * d[2 * i] + d[2 * i + 1] * d[2 * i + 1]; }
            s += __shfl_xor(s, 1); s += __shfl_xor(s, 2); s += __shfl_xor(s, 4); s += __shfl_xor(s, 8);
            const float r = rsqrtf(s * (1.0f / 128.0f) + RMS_EPS) * ONE_M_LI;
            const float* gs = g_sub + (c & 127);
            u32x4_t w;
#pragma unroll
            for (int i = 0; i < 4; ++i) { const unsigned wz = zq[i];
                const float z0 = __uint_as_float(wz << 16), z1 = __uint_as_float(wz & 0xffff0000u);
                w[i] = pk2bf(d[2 * i] * r * gs[2 * i] * z0, d[2 * i + 1] * r * gs[2 * i + 1] * z1); }
            *(u32x4_t*)(og + (size_t)m * DM + c) = w;
        }
    }
}
__device__ __forceinline__ void e_final(float* out, const bf16_t* __restrict__ yo1, const float* __restrict__ mod, const float* __restrict__ g_post, int gw, int ngw, int lane) {
    for (int m = gw; m < MTOK; m += ngw) {
        const int b = m / SEQL;
        f32x4_t* hr = (f32x4_t*)(out + (size_t)m * DM) + lane;
        const u32x2_t* yr = (const u32x2_t*)(yo1 + (size_t)m * DM) + lane;
        f32x4_t v[4], y[4]; float s = 0.f;
#pragma unroll
        for (int j = 0; j < 4; ++j) { v[j] = hr[64 * j]; const u32x2_t w = yr[64 * j];
            y[j].x = __uint_as_float(w.x << 16); y[j].y = __uint_as_float(w.x & 0xffff0000u); y[j].z = __uint_as_float(w.y << 16); y[j].w = __uint_as_float(w.y & 0xffff0000u);
            s += (y[j].x * y[j].x + y[j].y * y[j].y) + (y[j].z * y[j].z + y[j].w * y[j].w); }
        const float ry = rsqrtf(wave_sum_f(s) * (1.0f / DM) + RMS_EPS);
        const float* gate1 = mod + (size_t)(8 + b) * 3072 + 2048;
#pragma unroll
        for (int j = 0; j < 4; ++j) { const int c = 256 * j + 4 * lane;
            const f32x4_t gp = *(const f32x4_t*)(g_post + 1024 + c), gt = *(const f32x4_t*)(gate1 + c);
            hr[64 * j] = v[j] + gt * (y[j] * ry * gp); }
    }
}
__device__ __forceinline__ float diff_lambda(const float* lq1, const float* lk1, const float* lq2, const float* lk2) {
    float s1 = 0.f, s2 = 0.f;
    for (int i = 0; i < 64; ++i) { s1 += lq1[i] * lk1[i]; s2 += lq2[i] * lk2[i]; }
    return expf(s1) - expf(s2) + LAMBDA_INIT;
}

__global__ void n_adaln(const float* __restrict__ c, const float* __restrict__ ada_w, const float* __restrict__ ada_b, float* mod) {
    const int idx = blockIdx.x * 256 + threadIdx.x;
    if (idx >= 2 * 8 * 3072) return;
    const int j = idx % 3072, b = (idx / 3072) % 8, l = idx / (3072 * 8);
    float acc = ada_b[l * 3072 + j];
    const float* w = ada_w + (size_t)l * 1024 * 3072 + j; const float* cb = c + b * 1024;
    for (int k = 0; k < 1024; ++k) acc += silu_f(cb[k]) * w[(size_t)k * 3072];
    mod[idx] = acc;
}
__global__ void n_lambda(const float* lq1, const float* lk1, const float* lq2, const float* lk2, float* out) {
    if (threadIdx.x == 0 && blockIdx.x == 0) out[0] = diff_lambda(lq1, lk1, lq2, lk2);
}
__global__ void n_norm0(const float* x, const float* mod, const float* g_pre, bf16_t* a0) {
    e_norm0(x, mod, g_pre, a0, blockIdx.x * 4 + (threadIdx.x >> 6), gridDim.x * 4, threadIdx.x & 63);
}
__global__ void n_mid(const float* x, const bf16_t* yo, const float* mod, const float* g_post, const float* g_pre, float* h1, bf16_t* akv, bf16_t* ain1) {
    e_mid(x, yo, mod, g_post, g_pre, h1, akv, ain1, blockIdx.x * 4 + (threadIdx.x >> 6), gridDim.x * 4, threadIdx.x & 63);
}
__global__ void n_attn_post(const bf16_t* o0, const bf16_t* o1, const bf16_t* sz1, const float* g_sub, const float* lamp, bf16_t* og) {
    e_attn_post(o0, o1, sz1, g_sub, lamp[0], og, blockIdx.x * 4 + (threadIdx.x >> 6), gridDim.x * 4, threadIdx.x & 63);
}
__global__ void n_final(float* out, const bf16_t* yo1, const float* mod, const float* g_post) {
    e_final(out, yo1, mod, g_post, blockIdx.x * 4 + (threadIdx.x >> 6), gridDim.x * 4, threadIdx.x & 63);
}

struct AL_Row { const bf16_t* A; __device__ float ld(int m, int k) const { return bf2f(A[(size_t)m * DM + k]); } };
struct AL_YG  { const bf16_t* A; __device__ float ld(int m, int k) const { return bf2f(A[yg_off(k >> 4, m >> 4, (m & 15) * 16 + (k & 15))]); } };
struct WL_Plain { const float* W; long N; __device__ float ld(int k, int n) const { return W[(size_t)k * N + n]; } };
struct WL_KV { const float* wk; const float* wv; const float* g; __device__ float ld(int k, int n) const { return g[k] * (n < 1024 ? wk[(size_t)k * 1024 + n] : wv[(size_t)k * 1024 + n - 1024]); } };
struct EP_In0 { bf16_t* US; bf16_t* SZ; __device__ void st(int m, int n, float a) const {
    if (n < 1024) US[us_off(n >> 4, m >> 4, (m & 15) * 16 + (n & 15))] = f2bf(a); else SZ[(size_t)m * DM + n - 1024] = f2bf(silu_f(a)); } };
struct EP_Glu { const bf16_t* YG; const bf16_t* SZ; const float* bias; bf16_t* Y2; __device__ void st(int m, int n, float a) const {
    const float yv = bf2f(YG[yg_off(n >> 4, m >> 4, (m & 15) * 16 + (n & 15))]); const float t = a + bias[n];
    Y2[(size_t)m * DM + n] = f2bf(yv * sigmoid_f(t) * bf2f(SZ[(size_t)m * DM + n])); } };
struct EP_Plain { bf16_t* O; __device__ void st(int m, int n, float a) const { O[(size_t)m * DM + n] = f2bf(a); } };
struct EP_KV { bf16_t* K; bf16_t* V; __device__ void st(int m, int n, float a) const { if (n < 1024) K[(size_t)m * DM + n] = f2bf(a); else V[(size_t)m * DM + n - 1024] = f2bf(a); } };
struct EP_In1 { bf16_t* Q; bf16_t* SZ1; __device__ void st(int m, int n, float a) const { if (n < 1024) Q[(size_t)m * DM + n] = f2bf(a * QC2); else SZ1[(size_t)m * DM + n - 1024] = f2bf(silu_f(a)); } };

template <class AL, class WL, class EP>
__global__ void __launch_bounds__(256) n_gemm(AL al, WL wl, EP ep, int N) {
    __shared__ float As[16][68]; __shared__ float Ws[16][68];
    const int tid = threadIdx.x, tx = tid & 15, ty = tid >> 4;
    const int m0 = blockIdx.y * 64, n0 = blockIdx.x * 64;
    float acc[4][4];
#pragma unroll
    for (int i = 0; i < 4; ++i)
#pragma unroll
        for (int j = 0; j < 4; ++j) acc[i][j] = 0.f;
    for (int k0 = 0; k0 < 1024; k0 += 16) {
#pragma unroll
        for (int i = 0; i < 4; ++i) { const int e = tid + 256 * i; const int mm = e >> 4, kk = e & 15; As[kk][mm] = al.ld(m0 + mm, k0 + kk); }
#pragma unroll
        for (int i = 0; i < 4; ++i) { const int e = tid + 256 * i; const int kk = e >> 6, nn = e & 63; Ws[kk][nn] = wl.ld(k0 + kk, n0 + nn); }
        __syncthreads();
#pragma unroll
        for (int kk = 0; kk < 16; ++kk) {
            float a[4], b[4];
#pragma unroll
            for (int i = 0; i < 4; ++i) { a[i] = As[kk][ty * 4 + i]; b[i] = Ws[kk][tx * 4 + i]; }
#pragma unroll
            for (int i = 0; i < 4; ++i)
#pragma unroll
                for (int j = 0; j < 4; ++j) acc[i][j] += a[i] * b[j];
        }
        __syncthreads();
    }
#pragma unroll
    for (int i = 0; i < 4; ++i)
#pragma unroll
        for (int j = 0; j < 4; ++j) ep.st(m0 + ty * 4 + i, n0 + tx * 4 + j, acc[i][j]);
}

__global__ void __launch_bounds__(256) n_ssm(const bf16_t* __restrict__ US, const float* lam_re, const float* lam_im, const float* log_dt, const float* b_re, const float* b_im,
                                             const float* c_re, const float* c_im, const float* d_skip, bf16_t* YG) {
    const int wv = blockIdx.x * 4 + (threadIdx.x >> 6), lane = threadIdx.x & 63;
    if (wv >= NB * NGRP) return;
    const int b = wv / NGRP, g = wv % NGRP, p = lane;
    const float dt = expf(log_dt[g]);
    const float lr = lam_re[g * 64 + p], li = lam_im[g * 64 + p];
    const float mag = expf(lr * dt); float sn, cs; sn = sinf(li * dt); cs = cosf(li * dt);
    const float lbr = mag * cs, lbi = mag * sn;
    const float nr = lbr - 1.0f, ni = lbi, den = lr * lr + li * li;
    const float cr = (nr * lr + ni * li) / den, ci = (ni * lr - nr * li) / den;
    float bbr[16], bbi[16], ccr[16], cci[16];
#pragma unroll
    for (int c = 0; c < 16; ++c) { const float br = b_re[(g * 64 + p) * 16 + c], bi = b_im[(g * 64 + p) * 16 + c];
        bbr[c] = cr * br - ci * bi; bbi[c] = cr * bi + ci * br;
        ccr[c] = c_re[(g * 16 + c) * 64 + p]; cci[c] = c_im[(g * 16 + c) * 64 + p]; }
    const float dsk = d_skip[g * 16 + (lane & 15)];
    float sr = 0.f, si = 0.f;
    for (int t = 0; t < SEQL; ++t) {
        const int m = b * SEQL + t;
        const bf16_t* up = US + us_off(g, m >> 4, (m & 15) * 16);
        float u[16];
        { const u32x4_t w0 = *(const u32x4_t*)up, w1 = *(const u32x4_t*)(up + 8);
#pragma unroll
          for (int i = 0; i < 4; ++i) { u[2 * i] = __uint_as_float(w0[i] << 16); u[2 * i + 1] = __uint_as_float(w0[i] & 0xffff0000u); u[8 + 2 * i] = __uint_as_float(w1[i] << 16); u[8 + 2 * i + 1] = __uint_as_float(w1[i] & 0xffff0000u); } }
        float bur = 0.f, bui = 0.f;
#pragma unroll
        for (int c = 0; c < 16; ++c) { bur += bbr[c] * u[c]; bui += bbi[c] * u[c]; }
        const float nsr = lbr * sr - lbi * si + bur, nsi = lbr * si + lbi * sr + bui; sr = nsr; si = nsi;
        float yv = 0.f;
#pragma unroll
        for (int c = 0; c < 16; ++c) { const float part = wave_sum_f(ccr[c] * sr - cci[c] * si); if ((lane & 15) == c) yv = part; }
        if (lane < 16) { const float yy = yv + dsk * bf2f(up[lane]); YG[yg_off(g, m >> 4, (m & 15) * 16 + lane)] = f2bf(gelu_tanh_f(yy)); }
    }
}

__global__ void __launch_bounds__(256) n_attn(const bf16_t* __restrict__ Q, const bf16_t* __restrict__ K, const bf16_t* __restrict__ V, bf16_t* O0, bf16_t* O1) {
    __shared__ float qs[4][128];
    const int w = threadIdx.x >> 6, lane = threadIdx.x & 63;
    const int gwv = blockIdx.x * 4 + w;
    const int h = gwv & 7, m = gwv >> 3, b = m / SEQL, qi = m % SEQL;
    qs[w][lane] = bf2f(Q[(size_t)m * DM + h * 128 + lane]); qs[w][64 + lane] = bf2f(Q[(size_t)m * DM + h * 128 + 64 + lane]);
    __syncthreads();
    float m0 = -1e30f, m1 = -1e30f, l0 = 0.f, l1 = 0.f, a00 = 0.f, a01 = 0.f, a10 = 0.f, a11 = 0.f;
    const size_t rb = (size_t)b * SEQL;
    for (int kc = 0; kc * 64 <= qi; ++kc) {
        const int key = kc * 64 + lane; const bool valid = key <= qi;
        float s0 = 0.f, s1 = 0.f;
        { const bf16_t* kr = K + (rb + (valid ? key : qi)) * DM + h * 128;
#pragma unroll
          for (int ch = 0; ch < 8; ++ch) { const u32x4_t w0 = *(const u32x4_t*)(kr + ch * 8), w1 = *(const u32x4_t*)(kr + 64 + ch * 8);
#pragma unroll
            for (int i = 0; i < 4; ++i) { s0 += qs[w][ch * 8 + 2 * i] * __uint_as_float(w0[i] << 16) + qs[w][ch * 8 + 2 * i + 1] * __uint_as_float(w0[i] & 0xffff0000u);
                                          s1 += qs[w][64 + ch * 8 + 2 * i] * __uint_as_float(w1[i] << 16) + qs[w][64 + ch * 8 + 2 * i + 1] * __uint_as_float(w1[i] & 0xffff0000u); } } }
        if (!valid) { s0 = -1e30f; s1 = -1e30f; }
        const float nm0 = fmaxf(m0, wave_max_f(s0)), nm1 = fmaxf(m1, wave_max_f(s1));
        const float f0 = exp2f(m0 - nm0), f1 = exp2f(m1 - nm1);
        const float p0 = valid ? exp2f(s0 - nm0) : 0.f, p1 = valid ? exp2f(s1 - nm1) : 0.f;
        l0 = l0 * f0 + wave_sum_f(p0); l1 = l1 * f1 + wave_sum_f(p1); m0 = nm0; m1 = nm1;
        a00 *= f0; a01 *= f0; a10 *= f1; a11 *= f1;
        const int nk = min(64, qi - kc * 64 + 1);
        for (int j = 0; j < nk; ++j) {
            const float pj0 = __shfl(p0, j), pj1 = __shfl(p1, j);
            const bf16_t* vr = V + (rb + kc * 64 + j) * DM + h * 128;
            const float v0 = bf2f(vr[lane]), v1 = bf2f(vr[64 + lane]);
            a00 += pj0 * v0; a01 += pj0 * v1; a10 += pj1 * v0; a11 += pj1 * v1;
        }
    }
    const float i0 = 1.0f / l0, i1 = 1.0f / l1;
    O0[(size_t)m * DM + h * 128 + lane] = f2bf(a00 * i0); O0[(size_t)m * DM + h * 128 + 64 + lane] = f2bf(a01 * i0);
    O1[(size_t)m * DM + h * 128 + lane] = f2bf(a10 * i1); O1[(size_t)m * DM + h * 128 + 64 + lane] = f2bf(a11 * i1);
}
namespace pg8 {
#define PG8_LAS __attribute__((address_space(3)))
typedef short bf16x8 __attribute__((ext_vector_type(8)));
typedef float f32x4 __attribute__((ext_vector_type(4)));
typedef unsigned u32x4 __attribute__((ext_vector_type(4)));
constexpr int BM = 256, BK = 64, HALF = 128, HTB = HALF * BK * 2  , STAGE_BYTES = 8 * HTB, NXCD = 8, WGM = 8;

__host__ __device__ __forceinline__ int lds_byte(int r, int c) { const int st = (r >> 4) * 2 + (c >> 5), rr = r & 15, cc = c & 31, ob = rr * 64 + cc * 2; return st * 1024 + (ob ^ (((ob >> 9) & 1) << 5)); }
__host__ __device__ __forceinline__ void stage_rc(int b, int& R, int& C) { const int st = b / 1024, sb = b % 1024, swz = sb ^ (((sb >> 9) & 1) << 5); R = (st >> 1) * 16 + swz / 64; C = (st & 1) * 32 + (swz % 64) / 2; }
__host__ __device__ __forceinline__ int perm32(int rho) { const int n = rho >> 4, i = rho & 15; return 8 * (i >> 2) + 4 * n + (i & 3); }

struct Unit { int pm, pn, grp; };
struct Gemm {
    const char* A; const char* Bt; int nt, pad0;
    unsigned a_rs, a_c16; size_t a_kstep, a_tstep, a_gstep;
    unsigned b_rs, pad1; size_t b_tstep, b_gstep;
    __device__ __forceinline__ const char* abase(const Unit& u) const { return A + (size_t)u.grp * a_gstep + (size_t)u.pm * a_tstep; }
    __device__ __forceinline__ const char* bbase(const Unit& u) const { return Bt + (size_t)u.grp * b_gstep + (size_t)u.pn * b_tstep; }
};
__device__ __forceinline__ Gemm gemm_std(const void* A, int lda, const void* Bt, int ldb, int K) {
    Gemm g; g.A = (const char*)A; g.Bt = (const char*)Bt; g.nt = K / BK; g.pad0 = 0; g.a_rs = (unsigned)lda * 2u; g.a_c16 = 32u; g.a_kstep = BK * 2; g.a_tstep = (size_t)BM * lda * 2; g.a_gstep = 0;
    g.b_rs = (unsigned)ldb * 2u; g.pad1 = 0; g.b_tstep = (size_t)BM * ldb * 2; g.b_gstep = 0; return g;
}

struct Order {
    int nM, nN, nG, nwg, G, c, only;
    __device__ __forceinline__ void init(int nM_, int nN_, int nG_, int G_, int c_) { nM = nM_; nN = nN_; nG = nG_; nwg = nM * nN * nG; G = G_; c = c_; only = -1; }
    __device__ __forceinline__ bool next(int i, Unit& u) const {
        if (only >= 0) { if (i > 0) return false; i = only; }
        const long L = (long)i * G + c; if (L >= nwg) return false;
        int wgid = (int)L; { const int q = nwg / NXCD, r = nwg % NXCD, xcd = wgid % NXCD, off = wgid / NXCD; wgid = (xcd < r ? xcd * (q + 1) : r * (q + 1) + (xcd - r) * q) + off; }
        if (nG == 1) {
            const int nig = WGM * nN, gid = wgid / nig, fm = gid * WGM, gsz = (nM - fm) < WGM ? (nM - fm) : WGM;
            u.pm = fm + ((wgid % nig) % gsz); u.pn = (wgid % nig) / gsz; u.grp = 0;
        } else { const int per = nM * nN; u.grp = wgid / per; const int r2 = wgid % per; u.pm = r2 % nM; u.pn = r2 / nM; }
        return true;
    }
};

__device__ __forceinline__ unsigned cvt_pk_bf16(float lo, float hi) { unsigned r; asm volatile("v_cvt_pk_bf16_f32 %0, %1, %2" : "=v"(r) : "v"(lo), "v"(hi)); return r; }
__device__ __forceinline__ u32x4 pack8(const f32x4 a, const f32x4 b) { u32x4 w; w.x = cvt_pk_bf16(a[0], a[1]); w.y = cvt_pk_bf16(a[2], a[3]); w.z = cvt_pk_bf16(b[0], b[1]); w.w = cvt_pk_bf16(b[2], b[3]); return w; }
__device__ __forceinline__ void unpack8(const u32x4 w, f32x4& a, f32x4& b) {
    a[0] = __uint_as_float(w.x << 16); a[1] = __uint_as_float(w.x & 0xffff0000u); a[2] = __uint_as_float(w.y << 16); a[3] = __uint_as_float(w.y & 0xffff0000u);
    b[0] = __uint_as_float(w.z << 16); b[1] = __uint_as_float(w.z & 0xffff0000u); b[2] = __uint_as_float(w.w << 16); b[3] = __uint_as_float(w.w & 0xffff0000u); }
__device__ __forceinline__ float fsilu(float v) { return v * __builtin_amdgcn_rcpf(1.0f + __expf(-v)); }
__device__ __forceinline__ float fsigm(float v) { return __builtin_amdgcn_rcpf(1.0f + __expf(-v)); }
__device__ __forceinline__ f32x4 silu4(f32x4 v) { f32x4 o; o[0] = fsilu(v[0]); o[1] = fsilu(v[1]); o[2] = fsilu(v[2]); o[3] = fsilu(v[3]); return o; }
__device__ __forceinline__ f32x4 sigm4(f32x4 v) { f32x4 o; o[0] = fsigm(v[0]); o[1] = fsigm(v[1]); o[2] = fsigm(v[2]); o[3] = fsigm(v[3]); return o; }
__device__ __forceinline__ float fgelu(float v) { const float u = 0.7978845608028654f * (v + 0.044715f * v * v * v); const float e = __expf(2.0f * u); return 0.5f * v * (2.0f - 2.0f * __builtin_amdgcn_rcpf(e + 1.0f)); }
__device__ __forceinline__ f32x4 gelu4(f32x4 v) { f32x4 o; o[0] = fgelu(v[0]); o[1] = fgelu(v[1]); o[2] = fgelu(v[2]); o[3] = fgelu(v[3]); return o; }

template <class F> struct EpiRow8 {
    static constexpr bool PERM = true, AFTER_DRAIN = false;
    F f;
    __device__ __forceinline__ void operator()(const f32x4 (&acc)[2][2][4][2], const Unit& u, int wr, int wc, int fr, int fq) const {
#pragma unroll
        for (int ai = 0; ai < 2; ++ai)
#pragma unroll
            for (int m = 0; m < 4; ++m) { const int row = u.pm * BM + ai * HALF + wr * 64 + m * 16 + fr;
#pragma unroll
                for (int bj = 0; bj < 2; ++bj) { const int col0 = u.pn * BM + bj * HALF + wc * 32 + 8 * fq; f.apply(u, row, col0, acc[ai][bj][m][0], acc[ai][bj][m][1]); } }
    }
};
struct F_In0 { bf16_t* US; bf16_t* SZ;
    __device__ __forceinline__ void apply(const Unit&, int row, int col0, f32x4 v0, f32x4 v1) const {
        if (col0 < 1024) *(u32x4*)(US + us_off(col0 >> 4, row >> 4, (row & 15) * 16 + (col0 & 15))) = pack8(v0, v1);
        else *(u32x4*)(SZ + (size_t)row * DM + (col0 - 1024)) = pack8(silu4(v0), silu4(v1)); } };
struct F_SsmA { float* E;
    __device__ __forceinline__ void apply(const Unit& u, int row, int col0, f32x4 v0, f32x4 v1) const {
        if (col0 < 128) { float* p = E + ((size_t)u.grp * NTILE + row) * 128 + col0; *(f32x4*)p = v0; *(f32x4*)(p + 4) = v1; } } };
struct F_SsmB { const bf16_t* US; const float* dsk; bf16_t* YG;
    __device__ __forceinline__ void apply(const Unit& u, int row, int col0, f32x4 v0, f32x4 v1) const {
        const u32x4 uw = *(const u32x4*)(US + us_off(u.grp, row, col0)); f32x4 u0, u1; unpack8(uw, u0, u1);
        const float* d = dsk + u.grp * 16 + (col0 & 15); const f32x4 d0 = *(const f32x4*)d, d1 = *(const f32x4*)(d + 4);
        *(u32x4*)(YG + yg_off(u.grp, row, col0)) = pack8(gelu4(v0 + d0 * u0), gelu4(v1 + d1 * u1)); } };
struct F_Glu { const bf16_t* YG; const bf16_t* SZ; const float* bias; bf16_t* Y2;
    __device__ __forceinline__ void apply(const Unit&, int row, int col0, f32x4 v0, f32x4 v1) const {
        const u32x4 yw = *(const u32x4*)(YG + yg_off(col0 >> 4, row >> 4, (row & 15) * 16 + (col0 & 15))); f32x4 y0, y1; unpack8(yw, y0, y1);
        const u32x4 zw = *(const u32x4*)(SZ + (size_t)row * DM + col0); f32x4 z0, z1; unpack8(zw, z0, z1);
        const f32x4 b0 = *(const f32x4*)(bias + col0), b1 = *(const f32x4*)(bias + col0 + 4);
        *(u32x4*)(Y2 + (size_t)row * DM + col0) = pack8(y0 * sigm4(v0 + b0) * z0, y1 * sigm4(v1 + b1) * z1); } };
struct F_Plain { bf16_t* O;
    __device__ __forceinline__ void apply(const Unit&, int row, int col0, f32x4 v0, f32x4 v1) const { *(u32x4*)(O + (size_t)row * DM + col0) = pack8(v0, v1); } };
struct F_Split { bf16_t* Olo; bf16_t* Ohi; float sc_lo; int silu_hi;
    __device__ __forceinline__ void apply(const Unit&, int row, int col0, f32x4 v0, f32x4 v1) const {
        if (col0 < 1024) *(u32x4*)(Olo + (size_t)row * DM + col0) = pack8(v0 * sc_lo, v1 * sc_lo);
        else { if (silu_hi) { v0 = silu4(v0); v1 = silu4(v1); } *(u32x4*)(Ohi + (size_t)row * DM + (col0 - 1024)) = pack8(v0, v1); } } };

template <class Epi, bool ALIGN_EPI>
__device__ __forceinline__ void gemm_phase(PG8_LAS unsigned char* lds, const Gemm g, const Order& S, const Epi& E) {
    const int tid = threadIdx.x, wid = __builtin_amdgcn_readfirstlane(tid >> 6), lane = tid & 63, wr = wid >> 2, wc = wid & 3, fr = lane & 15, fq = lane >> 4;
    const int nt = g.nt;
    unsigned voffA[2], voffB[2];
#pragma unroll
    for (int i = 0; i < 2; ++i) { int R, C; stage_rc(tid * 16 + i * 8192, R, C); const int Rb = Epi::PERM ? ((R & ~31) + perm32(R & 31)) : R;
        voffA[i] = (unsigned)R * g.a_rs + (unsigned)(C >> 4) * g.a_c16 + (unsigned)(C & 15) * 2u; voffB[i] = (unsigned)Rb * g.b_rs + (unsigned)C * 2u; }
    const size_t kstepA = g.a_kstep, kstepB = (size_t)(BK * 2);
    const size_t hstepA = (size_t)HALF * g.a_rs, hstepB = (size_t)HALF * g.b_rs;
    const unsigned ldsw = (unsigned)wid * 1024u;
    const int aoff = lds_byte(wr * 64 + fr, fq * 8), boff = lds_byte(wc * 32 + fr, fq * 8);
#define PG8_SA(b, h) (((b) * 2 + (h)) * HTB)
#define PG8_SB(b, h) ((4 + (b) * 2 + (h)) * HTB)
#define PG8_STAGE(bufoff, gbase, voff) do { _Pragma("unroll") for (int _i = 0; _i < 2; ++_i) \
        __builtin_amdgcn_global_load_lds((const unsigned*)((const char*)(gbase) + (voff)[_i]), (PG8_LAS unsigned*)(lds + (bufoff) + ldsw + _i * 8192), 16, 0, 0); } while (0)
#define PG8_LDA(dst, b, h) do { _Pragma("unroll") for (int m = 0; m < 4; ++m) _Pragma("unroll") for (int k = 0; k < 2; ++k) dst[m][k] = *(const PG8_LAS bf16x8*)(lds + PG8_SA(b, h) + aoff + m * 2048 + k * 1024); } while (0)
#define PG8_LDB(dst, b, h) do { _Pragma("unroll") for (int n = 0; n < 2; ++n) _Pragma("unroll") for (int k = 0; k < 2; ++k) dst[n][k] = *(const PG8_LAS bf16x8*)(lds + PG8_SB(b, h) + boff + n * 2048 + k * 1024); } while (0)
#define PG8_MMA(ai, bj, At, Bt) do { __builtin_amdgcn_s_setprio(1); _Pragma("unroll") for (int m = 0; m < 4; ++m) _Pragma("unroll") for (int n = 0; n < 2; ++n) _Pragma("unroll") for (int k = 0; k < 2; ++k) \
        acc[ai][bj][m][n] = __builtin_amdgcn_mfma_f32_16x16x32_bf16(Bt[n][k], At[m][k], acc[ai][bj][m][n], 0, 0, 0); __builtin_amdgcn_s_setprio(0); } while (0)
#define PG8_WAIT_V(n) asm volatile("s_waitcnt vmcnt(" #n ")" ::: "memory")
#define PG8_WAIT_L(n) asm volatile("s_waitcnt lgkmcnt(" #n ")" ::: "memory")
#define PG8_BAR __builtin_amdgcn_s_barrier()
#define PG8_SCHED __builtin_amdgcn_sched_barrier(0)
    Unit cur, nxt; int ui = 0;
    if (!S.next(0, cur)) return;
    f32x4 acc[2][2][4][2];
#pragma unroll
    for (int a = 0; a < 2; ++a)
#pragma unroll
        for (int b = 0; b < 2; ++b)
#pragma unroll
            for (int m = 0; m < 4; ++m)
#pragma unroll
                for (int n = 0; n < 2; ++n) acc[a][b][m][n] = (f32x4){0.f, 0.f, 0.f, 0.f};
    bf16x8 At[4][2], B0[2][2], B1[2][2];
    const char* cA = g.abase(cur); const char* cB = g.bbase(cur);
    PG8_STAGE(PG8_SB(0, 0), cB, voffB); PG8_STAGE(PG8_SB(0, 1), cB + hstepB, voffB); PG8_STAGE(PG8_SA(0, 0), cA, voffA); PG8_STAGE(PG8_SA(0, 1), cA + hstepA, voffA);
    if (wr == 1) PG8_BAR;
    PG8_WAIT_V(2); PG8_BAR;
    PG8_STAGE(PG8_SB(1, 0), cB + kstepB, voffB); PG8_STAGE(PG8_SA(1, 0), cA + kstepA, voffA); PG8_STAGE(PG8_SB(1, 1), cB + hstepB + kstepB, voffB);
    PG8_WAIT_V(6); PG8_BAR;
    for (;;) {
        const bool has_next = S.next(ui + 1, nxt);
        const char* nA = has_next ? g.abase(nxt) : cA; const char* nB = has_next ? g.bbase(nxt) : cB;
        for (int t = 0; t < nt; t += 2) {
            const bool last = (t == nt - 2);
            const char* a1 = cA + (size_t)(t + 1) * kstepA;
            const char* a2 = last ? nA : cA + (size_t)(t + 2) * kstepA; const char* b2 = last ? nB : cB + (size_t)(t + 2) * kstepB;
            const char* a3 = a2 + kstepA; const char* b3 = b2 + kstepB;
            PG8_LDB(B0, 0, 0); PG8_LDB(B1, 0, 1); PG8_SCHED; PG8_LDA(At, 0, 0); PG8_STAGE(PG8_SA(1, 1), a1 + hstepA, voffA);
            PG8_WAIT_V(8); PG8_WAIT_L(0); PG8_BAR; PG8_MMA(0, 0, At, B0); PG8_MMA(0, 1, At, B1); PG8_BAR; PG8_SCHED;
            PG8_LDA(At, 0, 1); PG8_STAGE(PG8_SB(0, 0), b2, voffB); PG8_STAGE(PG8_SB(0, 1), b2 + hstepB, voffB); PG8_STAGE(PG8_SA(0, 0), a2, voffA);
            PG8_WAIT_V(8); PG8_WAIT_L(0); PG8_BAR; PG8_MMA(1, 0, At, B0); PG8_MMA(1, 1, At, B1); PG8_BAR; PG8_SCHED;
            PG8_LDB(B0, 1, 0); PG8_LDB(B1, 1, 1); PG8_SCHED; PG8_LDA(At, 1, 0); PG8_STAGE(PG8_SA(0, 1), a2 + hstepA, voffA);
            PG8_WAIT_V(8); PG8_WAIT_L(0); PG8_BAR; PG8_MMA(0, 0, At, B0); PG8_MMA(0, 1, At, B1); PG8_BAR; PG8_SCHED;
            PG8_LDA(At, 1, 1); PG8_STAGE(PG8_SB(1, 0), b3, voffB); PG8_STAGE(PG8_SB(1, 1), b3 + hstepB, voffB); PG8_STAGE(PG8_SA(1, 0), a3, voffA);
            PG8_WAIT_V(8); PG8_WAIT_L(0); PG8_BAR; PG8_MMA(1, 0, At, B0); PG8_MMA(1, 1, At, B1); PG8_BAR; PG8_SCHED;
        }
        if constexpr (ALIGN_EPI) { if (wr == 0) PG8_BAR; }
        E(acc, cur, wr, wc, fr, fq);
        if (!has_next) break;
#pragma unroll
        for (int a = 0; a < 2; ++a)
#pragma unroll
            for (int b = 0; b < 2; ++b)
#pragma unroll
                for (int m = 0; m < 4; ++m)
#pragma unroll
                    for (int n = 0; n < 2; ++n) acc[a][b][m][n] = (f32x4){0.f, 0.f, 0.f, 0.f};
        cur = nxt; cA = nA; cB = nB; ++ui;
        if constexpr (ALIGN_EPI) { if (wr == 1) PG8_BAR; }
    }
    PG8_WAIT_V(0);
    if constexpr (!ALIGN_EPI) { if (wr == 0) PG8_BAR; }
    PG8_BAR;
#undef PG8_SA
#undef PG8_SB
#undef PG8_STAGE
#undef PG8_LDA
#undef PG8_LDB
#undef PG8_MMA
#undef PG8_WAIT_V
#undef PG8_WAIT_L
#undef PG8_BAR
#undef PG8_SCHED
}
}

namespace attn_body {
using bf16 = bf16_t;
using bf16x8 = __attribute__((ext_vector_type(8))) short;
using s16x4 = __attribute__((ext_vector_type(4))) short;
using f32x16 = __attribute__((ext_vector_type(16))) float;
using u32x4 = __attribute__((ext_vector_type(4))) unsigned;
constexpr int SEQ = SEQL, D = 64, DMA = 1024;
constexpr int NW = 8, QBLK = 32, QB = QBLK * NW, KVBLK = 64, NQB = SEQ / QB;
__device__ __forceinline__ int crow(int r, int hi) { return (r & 3) + 8 * (r >> 2) + 4 * hi; }
#define SBAR() __builtin_amdgcn_sched_barrier(0)
__device__ __forceinline__ void cmask(f32x16& p0, f32x16& p1, int jb, int qrel, int hi) {
  const float NEG = -INFINITY; int kb = 64 * jb + 4 * hi;
  #pragma unroll
  for (int r = 0; r < 16; ++r) { int kv = kb + (r & 3) + 8 * (r >> 2); if (kv > qrel) p0[r] = NEG; if (kv + 32 > qrel) p1[r] = NEG; }
}
constexpr int NSLOT = 3, SLOTB = 8192;
constexpr int LDS_K = 0, LDS_V = NSLOT * SLOTB, LDS_WS = 2 * NSLOT * SLOTB, LDS_OST = LDS_WS + NW * 64 * 4, LDS_BYTES = LDS_OST + NW * 4096;
__device__ __forceinline__ void glds16(const void* gsrc, unsigned lds_dst) { unsigned keep;
  asm volatile("s_mov_b32 %0, m0\n\ts_mov_b32 m0, %2\n\ts_nop 0\n\tglobal_load_lds_dwordx4 %1, off\n\ts_mov_b32 m0, %0" : "=&s"(keep) : "v"(gsrc), "s"(lds_dst) : "memory"); }
__device__ __forceinline__ float max3f(float a, float b, float c) { float r; asm("v_max3_f32 %0, %1, %2, %3" : "=v"(r) : "v"(a), "v"(b), "v"(c)); return r; }
__device__ __forceinline__ float max2f(float a, float b) { float r; asm("v_max_f32_e32 %0, %1, %2" : "=v"(r) : "v"(a), "v"(b)); return r; }
__device__ __forceinline__ float fadd_s(float a, float b) { float r; asm("v_add_f32_e32 %0, %1, %2" : "=v"(r) : "v"(a), "v"(b)); return r; }
__device__ __forceinline__ float fsub_s(float a, float b) { float r; asm("v_sub_f32_e32 %0, %1, %2" : "=v"(r) : "v"(a), "v"(b)); return r; }
typedef float f32x2_t __attribute__((ext_vector_type(2))); typedef __bf16 bf16x2_t __attribute__((ext_vector_type(2)));
__device__ __forceinline__ unsigned cvtpk_s(float lo, float hi) { f32x2_t v = {lo, hi}; bf16x2_t b = __builtin_convertvector(v, bf16x2_t); return __builtin_bit_cast(unsigned, b); }
#define WAIT_BAR(N) asm volatile("s_waitcnt vmcnt(" #N ") lgkmcnt(0)\n\ts_barrier" ::: "memory")

__device__ __forceinline__ void qkt(f32x16& p0, f32x16& p1, const char* Kslot, const bf16x8* qr, const f32x16& negm, int r32, int hi) {
  const char* kb = Kslot + hi * 1024 + r32 * 16;
  #pragma unroll
  for (int d0 = 0; d0 < 4; ++d0) {
    const bf16x8 b0 = *reinterpret_cast<const bf16x8*>(kb + d0 * 2048);
    const bf16x8 b1 = *reinterpret_cast<const bf16x8*>(kb + d0 * 2048 + 512);
    if (d0 == 0) { p0 = __builtin_amdgcn_mfma_f32_32x32x16_bf16(b0, qr[0], negm, 0, 0, 0); p1 = __builtin_amdgcn_mfma_f32_32x32x16_bf16(b1, qr[0], negm, 0, 0, 0); }
    else { p0 = __builtin_amdgcn_mfma_f32_32x32x16_bf16(b0, qr[d0], p0, 0, 0, 0); p1 = __builtin_amdgcn_mfma_f32_32x32x16_bf16(b1, qr[d0], p1, 0, 0, 0); } }
}
typedef __attribute__((address_space(3))) const char* lds_cptr;
typedef short v4i16_t __attribute__((ext_vector_type(4)));
__device__ __forceinline__ void kload8(bf16x8* kf, lds_cptr kp) {
  kf[0] = *(const __attribute__((address_space(3))) bf16x8*)(kp);        kf[1] = *(const __attribute__((address_space(3))) bf16x8*)(kp + 512);
  kf[2] = *(const __attribute__((address_space(3))) bf16x8*)(kp + 2048); kf[3] = *(const __attribute__((address_space(3))) bf16x8*)(kp + 2560);
  kf[4] = *(const __attribute__((address_space(3))) bf16x8*)(kp + 4096); kf[5] = *(const __attribute__((address_space(3))) bf16x8*)(kp + 4608);
  kf[6] = *(const __attribute__((address_space(3))) bf16x8*)(kp + 6144); kf[7] = *(const __attribute__((address_space(3))) bf16x8*)(kp + 6656);
}
__device__ __forceinline__ void kload2(bf16x8* kf, lds_cptr kp, int j) { kf[2 * j] = *(const __attribute__((address_space(3))) bf16x8*)(kp + j * 2048); kf[2 * j + 1] = *(const __attribute__((address_space(3))) bf16x8*)(kp + j * 2048 + 512); }
__device__ __forceinline__ s16x4 vtr(lds_cptr p) { return __builtin_bit_cast(s16x4, __builtin_amdgcn_ds_read_tr16_b64_v4i16((__attribute__((address_space(3))) v4i16_t*)p)); }
__device__ __forceinline__ float rowmax(const f32x16& p0, const f32x16& p1) {
  float a = max3f(p0[0], p0[1], p1[0]), b = max3f(p0[2], p0[3], p1[1]); a = max3f(a, p1[2], p1[3]);
  #pragma unroll
  for (int r = 4; r < 16; r += 4) { a = max3f(a, p0[r], p0[r + 1]); b = max3f(b, p0[r + 2], p0[r + 3]); a = max3f(a, p1[r], p1[r + 1]); b = max3f(b, p1[r + 2], p1[r + 3]); }
  const float m = max2f(a, b);
  auto rr = __builtin_amdgcn_permlane32_swap(__float_as_uint(m), __float_as_uint(m), false, false);
  return max2f(__uint_as_float(rr[0]), __uint_as_float(rr[1]));
}
__device__ __forceinline__ void pv(f32x16* o, int vb, bf16x8 pa0, bf16x8 pa1, bf16x8 pa2, bf16x8 pa3) {
  #pragma unroll
  for (int d0 = 0; d0 < 2; ++d0) { s16x4 lo[4], hi[4];
    #pragma unroll
    for (int ks = 0; ks < 4; ++ks) {
      asm volatile("ds_read_b64_tr_b16 %0,%1 offset:%c2" : "=&v"(lo[ks]) : "v"(vb), "i"(d0 * 4096 + ks * 1024) : "memory");
      asm volatile("ds_read_b64_tr_b16 %0,%1 offset:%c2" : "=&v"(hi[ks]) : "v"(vb), "i"(d0 * 4096 + ks * 1024 + 512) : "memory"); }
    asm volatile("s_waitcnt lgkmcnt(0)" ::: "memory"); SBAR();
    #define PK(k) (bf16x8){lo[k][0], lo[k][1], lo[k][2], lo[k][3], hi[k][0], hi[k][1], hi[k][2], hi[k][3]}
    o[d0] = __builtin_amdgcn_mfma_f32_32x32x16_bf16(pa0, PK(0), o[d0], 0, 0, 0);
    o[d0] = __builtin_amdgcn_mfma_f32_32x32x16_bf16(pa1, PK(1), o[d0], 0, 0, 0);
    o[d0] = __builtin_amdgcn_mfma_f32_32x32x16_bf16(pa2, PK(2), o[d0], 0, 0, 0);
    o[d0] = __builtin_amdgcn_mfma_f32_32x32x16_bf16(pa3, PK(3), o[d0], 0, 0, 0);
    #undef PK
  }
}
#define ATTN_STORE16(p, v) (*(u32x4*)(p) = (v))
template <int THRL> __device__ __forceinline__ void attn_unit(int b, int hq, int hv, int qb, const bf16* Q, const bf16* __restrict__ K, const bf16* __restrict__ V, bf16* O, char* shm) {
  const int tid = threadIdx.x, lane = tid & 63, r32 = lane & 31, hi = lane >> 5; const int wid = __builtin_amdgcn_readfirstlane(tid >> 6);
  const long rowbase = (long)b * SEQ; const int q0 = qb * QB;
  const bf16* Qw = Q + (rowbase + q0 + wid * QBLK) * DMA + hq * D;
  const bf16* Kh = K + rowbase * DMA + hq * D, *Vh = V + rowbase * DMA + hv * D;
  const unsigned lds0 = (unsigned)(uintptr_t)shm;
  float* wsf = (float*)(shm + LDS_WS) + wid * 64;
  const bf16* ksrc = Kh + (long)lane * DMA + wid * 8;
  const bf16* vsrc = Vh + (long)(16 * (wid & 3) + (lane >> 2)) * DMA + (wid >> 2) * 32 + (lane & 3) * 8;
  const unsigned kdst = lds0 + LDS_K + wid * 1024, vdst = lds0 + LDS_V + wid * 1024;
  #define DMA_K(t, slot) glds16(ksrc + (long)(t) * KVBLK * DMA, (unsigned)__builtin_amdgcn_readfirstlane(kdst + (slot)))
  #define DMA_V(t, slot) glds16(vsrc + (long)(t) * KVBLK * DMA, (unsigned)__builtin_amdgcn_readfirstlane(vdst + (slot)))
  const int vb0 = (int)(lds0 + LDS_V) + ((lane >> 4) & 1) * 32 + (lane & 3) * 8 + (4 * hi + ((lane & 15) >> 2)) * 64;
  const char* Kbase = shm + LDS_K; bf16x8 kf[8];
  const lds_cptr shm3 = (lds_cptr)shm; const lds_cptr kp0 = shm3 + LDS_K + hi * 1024 + r32 * 16; const lds_cptr vp0 = shm3 + LDS_V + ((lane >> 4) & 1) * 32 + (lane & 3) * 8 + (4 * hi + ((lane & 15) >> 2)) * 64;
  const int NT = (q0 + QB) / KVBLK;
  DMA_K(0, 0); DMA_V(0, 0); DMA_K(1, SLOTB);
  bf16x8 qr[4];
  #pragma unroll
  for (int d0 = 0; d0 < 4; ++d0) qr[d0] = *reinterpret_cast<const bf16x8*>(&Qw[(long)r32 * DMA + d0 * 16 + hi * 8]);
  float mhat = 0.f, l_reg = 0.f; f32x16 o[2]; o[0] = f32x16{}; o[1] = f32x16{}; f32x16 negm = f32x16{}; asm volatile("" : "+v"(negm));
  const int qrel = wid * QBLK + r32;
  #define CMASK(P0, P1, t) do { int jb_ = (t) - (NT - 4); if (jb_ >= 0) cmask(P0, P1, jb_, qrel, hi); } while (0)
  bool resc = false;
  #define START(P0, P1) do { const float rm = rowmax(P0, P1); resc = false; \
    { const float dl = rm; mhat = fadd_s(mhat, dl); \
      _Pragma("unroll") for (int r = 0; r < 16; ++r) { P0[r] = fsub_s(P0[r], dl); P1[r] = fsub_s(P1[r], dl); } \
      _Pragma("unroll") for (int r = 0; r < 16; ++r) negm[r] = -mhat; asm volatile("" : "+v"(negm)); } \
    _Pragma("unroll") for (int r = 0; r < 16; ++r) P0[r] = __builtin_amdgcn_exp2f(P0[r]); } while (0)
  #define RESC() do { if (resc) { asm volatile("s_waitcnt lgkmcnt(0)" ::: "memory"); \
      _Pragma("unroll") for (int d_ = 0; d_ < 2; ++d_) _Pragma("unroll") for (int r = 0; r < 16; ++r) o[d_][r] *= wsf[crow(r, hi)]; } } while (0)
  f32x16 pA0, pA1, pB0, pB1;
  int sl_prev = 0, sl_cur = 0, sl_next = SLOTB;
  #define ROT() do { sl_prev = sl_cur; sl_cur = sl_next; sl_next = (sl_next == (NSLOT - 1) * SLOTB) ? 0 : sl_next + SLOTB; } while (0)
  DMA_K(2, 2 * SLOTB);
  WAIT_BAR(3);
  qkt(pA0, pA1, Kbase, qr, negm, r32, hi); asm volatile("s_nop 15\n\ts_nop 7" : "+v"(pA0), "+v"(pA1)); CMASK(pA0, pA1, 0);
  START(pA0, pA1);
  _Pragma("unroll") for (int r = 0; r < 16; ++r) pA1[r] = __builtin_amdgcn_exp2f(pA1[r]);
  WAIT_BAR(0);
  DMA_K(3, 0); DMA_V(1, SLOTB);
  ROT();
  kload8(kf, kp0 + sl_cur);
  WAIT_BAR(2);
  s16x4 vlo[8], vhi[8]; u32x4 pw0, pw1, pw2, pw3;
  #define PKW(P, B) cvtpk_s(P[B], P[B + 1])
  #define PAF(k) __builtin_bit_cast(bf16x8, pw##k)
  #define VFR(i) (bf16x8){vlo[i][0], vlo[i][1], vlo[i][2], vlo[i][3], vhi[i][0], vhi[i][1], vhi[i][2], vhi[i][3]}
  #define PIN(x) asm volatile("" : "+v"(x))
  #define MX3(a, b, c) __builtin_fmaxf(__builtin_fmaxf((a), (b)), (c))
  #define GAPA(MF, A0, A1, A2, A3, W0, W1, PW) do { MF; sacc += A0; sacc += A1; sacc += A2; sacc += A3; PIN(sacc); W0; W1; PIN(PW); SBAR(); } while (0)
  #define EX(v) __builtin_amdgcn_exp2f(v)
  #define GAPB(MF, X, B) do { MF; X[B] = EX(X[B]); X[B + 1] = EX(X[B + 1]); X[B + 2] = EX(X[B + 2]); X[B + 3] = EX(X[B + 3]); PIN(X); SBAR(); } while (0)
  #define VRD(i) do { vlo[i] = vtr(vp_ + (((i) >> 2) * 4096 + ((i) & 3) * 1024)); vhi[i] = vtr(vp_ + (((i) >> 2) * 4096 + ((i) & 3) * 1024 + 512)); } while (0)
  #define KRD(G, j) do { if (G) { kload2(kf, kp0 + sl_next, j); SBAR(); } } while (0)
  #define STEP(C0, C1, P0, P1, t, GK, GV, GL) do { SBAR(); \
    const lds_cptr vp_ = vp0 + sl_prev; \
    VRD(0); SBAR(); float sacc = (P0[0] + P0[1]); \
    GAPA(C0 = __builtin_amdgcn_mfma_f32_32x32x16_bf16(kf[0], qr[0], negm, 0, 0, 0), P0[2], P0[3], P0[4], P0[5],     pw0[0] = PKW(P0, 0), pw0[1] = PKW(P0, 2), pw0); \
    VRD(4); SBAR(); GAPA(C1 = __builtin_amdgcn_mfma_f32_32x32x16_bf16(kf[1], qr[0], negm, 0, 0, 0), P0[6], P0[7], P0[8], P0[9],     pw0[2] = PKW(P0, 4), pw0[3] = PKW(P0, 6), pw0); \
    VRD(1); SBAR(); GAPA(C0 = __builtin_amdgcn_mfma_f32_32x32x16_bf16(kf[2], qr[1], C0, 0, 0, 0),   P0[10], P0[11], P0[12], P0[13], pw1[0] = PKW(P0, 8), pw1[1] = PKW(P0, 10), pw1); \
    VRD(5); SBAR(); GAPA(C1 = __builtin_amdgcn_mfma_f32_32x32x16_bf16(kf[3], qr[1], C1, 0, 0, 0),   P0[14], P0[15], P1[0], P1[1],   pw1[2] = PKW(P0, 12), pw1[3] = PKW(P0, 14), pw1); \
    VRD(2); SBAR(); GAPA(C0 = __builtin_amdgcn_mfma_f32_32x32x16_bf16(kf[4], qr[2], C0, 0, 0, 0),   P1[2], P1[3], P1[4], P1[5],     pw2[0] = PKW(P1, 0), pw2[1] = PKW(P1, 2), pw2); \
    VRD(6); SBAR(); GAPA(C1 = __builtin_amdgcn_mfma_f32_32x32x16_bf16(kf[5], qr[2], C1, 0, 0, 0),   P1[6], P1[7], P1[8], P1[9],     pw2[2] = PKW(P1, 4), pw2[3] = PKW(P1, 6), pw2); \
    VRD(3); SBAR(); GAPA(C0 = __builtin_amdgcn_mfma_f32_32x32x16_bf16(kf[6], qr[3], C0, 0, 0, 0),   P1[10], P1[11], P1[12], P1[13], pw3[0] = PKW(P1, 8), pw3[1] = PKW(P1, 10), pw3); \
    VRD(7); SBAR(); GAPA(C1 = __builtin_amdgcn_mfma_f32_32x32x16_bf16(kf[7], qr[3], C1, 0, 0, 0),   P1[14], P1[15], 0.f, 0.f,       pw3[2] = PKW(P1, 12), pw3[3] = PKW(P1, 14), pw3); \
    l_reg += sacc; \
    if (GK) { DMA_K((t) + 3, sl_cur); } if (GV) { DMA_V((t) + 1, sl_next); } \
    CMASK(C0, C1, t); \
    { float a = MX3(C0[0], C0[1], C1[0]), b = MX3(C0[2], C0[3], C1[1]); a = MX3(a, C1[2], C1[3]); \
      _Pragma("unroll") for (int r = 4; r < 16; r += 4) { a = MX3(a, C0[r], C0[r + 1]); b = MX3(b, C0[r + 2], C0[r + 3]); a = MX3(a, C1[r], C1[r + 1]); b = MX3(b, C1[r + 2], C1[r + 3]); } \
      float rm = __builtin_fmaxf(a, b); { auto rr = __builtin_amdgcn_permlane32_swap(__float_as_uint(rm), __float_as_uint(rm), false, false); rm = __builtin_fmaxf(__uint_as_float(rr[0]), __uint_as_float(rr[1])); } \
      resc = false; \
      if (__builtin_expect(__any(rm > (float)THRL), 0)) { const float dl = __builtin_fmaxf(rm, 0.f); mhat += dl; \
        _Pragma("unroll") for (int r = 0; r < 16; ++r) { C0[r] -= dl; C1[r] -= dl; } \
        _Pragma("unroll") for (int r = 0; r < 16; ++r) negm[r] = -mhat; asm volatile("" : "+v"(negm)); \
        const float f = __builtin_amdgcn_exp2f(-dl); l_reg *= f; if (hi == 0) wsf[r32] = f; resc = true; } } \
    SBAR(); \
    GAPB(o[0] = __builtin_amdgcn_mfma_f32_32x32x16_bf16(PAF(0), VFR(0), o[0], 0, 0, 0), C0, 0); \
    GAPB(o[1] = __builtin_amdgcn_mfma_f32_32x32x16_bf16(PAF(0), VFR(4), o[1], 0, 0, 0), C0, 4); \
    KRD(GL, 0); GAPB(o[0] = __builtin_amdgcn_mfma_f32_32x32x16_bf16(PAF(1), VFR(1), o[0], 0, 0, 0), C0, 8); \
    KRD(GL, 1); GAPB(o[1] = __builtin_amdgcn_mfma_f32_32x32x16_bf16(PAF(1), VFR(5), o[1], 0, 0, 0), C0, 12); \
    KRD(GL, 2); GAPB(o[0] = __builtin_amdgcn_mfma_f32_32x32x16_bf16(PAF(2), VFR(2), o[0], 0, 0, 0), C1, 0); \
    KRD(GL, 3); GAPB(o[1] = __builtin_amdgcn_mfma_f32_32x32x16_bf16(PAF(2), VFR(6), o[1], 0, 0, 0), C1, 4); \
    GAPB(o[0] = __builtin_amdgcn_mfma_f32_32x32x16_bf16(PAF(3), VFR(3), o[0], 0, 0, 0), C1, 8); \
    GAPB(o[1] = __builtin_amdgcn_mfma_f32_32x32x16_bf16(PAF(3), VFR(7), o[1], 0, 0, 0), C1, 12); \
    } while (0)
  int t = 1;
  #undef CMASK
  #define CMASK(P0, P1, t) do {} while (0)
  for (; t + 5 < NT; t += 2) {
    STEP(pB0, pB1, pA0, pA1, t, true, true, true);     WAIT_BAR(2); RESC(); ROT();
    STEP(pA0, pA1, pB0, pB1, t + 1, true, true, true); WAIT_BAR(2); RESC(); ROT();
  }
  #undef CMASK
  #define CMASK(P0, P1, t) do { int jb_ = (t) - (NT - 4); if (jb_ >= 0) cmask(P0, P1, jb_, qrel, hi); } while (0)
  #define ENDW(tt) do { if ((tt) + 3 < NT) { WAIT_BAR(2); } else if ((tt) + 2 < NT) { WAIT_BAR(1); } else { WAIT_BAR(0); } } while (0)
  for (; t + 1 < NT; t += 2) {
    STEP(pB0, pB1, pA0, pA1, t, (t + 3 < NT), (t + 1 < NT), (t + 1 < NT));         ENDW(t);     RESC(); ROT();
    STEP(pA0, pA1, pB0, pB1, t + 1, (t + 4 < NT), (t + 2 < NT), (t + 2 < NT));     ENDW(t + 1); RESC(); ROT();
  }
  STEP(pB0, pB1, pA0, pA1, NT - 1, false, false, false); RESC();
  { float sacc = pB0[0] + pB0[1]; _Pragma("unroll") for (int r = 2; r < 16; ++r) sacc += pB0[r]; _Pragma("unroll") for (int r = 0; r < 16; ++r) sacc += pB1[r]; l_reg += sacc;
    pw0 = (u32x4){PKW(pB0, 0), PKW(pB0, 2), PKW(pB0, 4), PKW(pB0, 6)}; pw1 = (u32x4){PKW(pB0, 8), PKW(pB0, 10), PKW(pB0, 12), PKW(pB0, 14)}; pw2 = (u32x4){PKW(pB1, 0), PKW(pB1, 2), PKW(pB1, 4), PKW(pB1, 6)}; pw3 = (u32x4){PKW(pB1, 8), PKW(pB1, 10), PKW(pB1, 12), PKW(pB1, 14)};
    SBAR(); pv(o, vb0 + sl_cur, PAF(0), PAF(1), PAF(2), PAF(3)); }
  #undef PKW
  #undef PAF
  #undef VFR
  #undef PIN
  #undef MX3
  #undef GAPA
  #undef GAPB
  #undef EX
  #undef VRD
  #undef KRD
  #undef STEP
  #undef ENDW
  { auto rr = __builtin_amdgcn_permlane32_swap(__float_as_uint(l_reg), __float_as_uint(l_reg), false, false); l_reg = __uint_as_float(rr[0]) + __uint_as_float(rr[1]); }
  if (hi == 0) wsf[32 + r32] = l_reg; asm volatile("s_waitcnt lgkmcnt(0)" ::: "memory");
  float rli[16];
  #pragma unroll
  for (int r = 0; r < 16; ++r) rli[r] = __builtin_amdgcn_rcpf(wsf[32 + crow(r, hi)]);
  bf16* Ow = O + (rowbase + q0 + wid * QBLK) * DMA + hv * D;
  { bf16* stg = (bf16*)(shm + LDS_OST) + wid * 2048;
    #pragma unroll
    for (int r = 0; r < 16; ++r) { const int orow = crow(r, hi);
      #pragma unroll
      for (int d0 = 0; d0 < 2; ++d0) stg[orow * 64 + d0 * 32 + r32] = f2bf(o[d0][r] * rli[r]); }
    asm volatile("s_waitcnt lgkmcnt(0)" ::: "memory");
    #pragma unroll
    for (int i = 0; i < 4; ++i) { const int row = i * 8 + (lane >> 3), ch = lane & 7; const u32x4 v = *(const u32x4*)(stg + row * 64 + ch * 8); ATTN_STORE16(Ow + (long)row * DMA + ch * 8, v); } }
  asm volatile("s_waitcnt lgkmcnt(0)\n\ts_barrier" ::: "memory");
  #undef DMA_K
  #undef DMA_V
  #undef CMASK
  #undef START
  #undef RESC
  #undef ROT
}
constexpr int ATTN_LDS_BYTES = LDS_BYTES;
#undef SBAR
#undef WAIT_BAR
}

constexpr int NWAVES = 8;
constexpr size_t MiB = 1u << 20;
constexpr size_t WS_CTL = 0, CTL_ZERO_BYTES = 1 * MiB;
constexpr size_t WS_MOD = 256 * 1024;
constexpr size_t WS_LAM = 1 * MiB;
constexpr size_t WS_LB16 = 1 * MiB + 4096;
constexpr size_t WS_WIN0 = 2 * MiB, WS_WGLU = 6 * MiB, WS_WOUT0 = 8 * MiB, WS_WKV = 10 * MiB, WS_WIN1 = 14 * MiB, WS_WOUT1 = 18 * MiB;
constexpr size_t WS_BTA = 20 * MiB;
constexpr size_t WS_BTB = 28 * MiB;
constexpr size_t WS_S0 = 48 * MiB, WS_S1 = 112 * MiB, WS_S2 = 176 * MiB, WS_S3 = 240 * MiB, WS_S4 = 304 * MiB, WS_S5 = 368 * MiB, WS_S6 = 432 * MiB, WS_END = 496 * MiB;
constexpr int CW_BAR = 4096;
constexpr int RING_OFF = 0, RING_BYTES = 131072;
constexpr int LDSCTL_OFF = RING_BYTES, MISC_OFF = LDSCTL_OFF + 320;
constexpr int LDS_BYTES = 147456;

#define GAS __attribute__((address_space(1)))
#define LAS __attribute__((address_space(3)))
typedef unsigned v4u __attribute__((ext_vector_type(4)));
typedef GAS unsigned gu32;
#define RLX_AGENT __ATOMIC_RELAXED, __HIP_MEMORY_SCOPE_AGENT
#define LDS_WAIT() asm volatile("s_waitcnt lgkmcnt(0)" ::: "memory")
#define VM_WAIT() asm volatile("s_waitcnt vmcnt(0)" ::: "memory")

#define XB_TMO      128
#define XB_XCNT(j)  (256  + 64 * (j))
#define XB_XSUB(j)  (1280 + 64 * (j))
#define XB_XGEN(j)  (2304 + 64 * (j))
#define XB_TOP      3328
#define XB_TOPGEN   3392
#define XCD_BAR_WORDS 3456
#define XB_SPIN_CAP (1u << 18)
__device__ __forceinline__ unsigned xb_ld(unsigned* p)              { return __hip_atomic_load(p, __ATOMIC_RELAXED, __HIP_MEMORY_SCOPE_AGENT); }
__device__ __forceinline__ unsigned xb_add(unsigned* p, unsigned v) { return __hip_atomic_fetch_add(p, v, __ATOMIC_RELAXED, __HIP_MEMORY_SCOPE_AGENT); }
__device__ __forceinline__ unsigned xb_xcc_id() { return (unsigned)__builtin_amdgcn_s_getreg((3 << 11) | 20) & 0xFu; }
#define XB_SPIN(cond, bar) do { unsigned _sp = 0; while (cond) { __builtin_amdgcn_s_sleep(1); \
    if ((++_sp & 255u) == 0u) { if (xb_ld(&(bar)[XB_TMO])) break; if (_sp > XB_SPIN_CAP) { atomicAdd(&(bar)[XB_TMO], 1u); break; } } } } while (0)
struct XcdBarrier { unsigned* bar; unsigned x; volatile LAS unsigned* st; };
__device__ __forceinline__ XcdBarrier xcd_barrier_post(unsigned* bar, volatile LAS unsigned* st) {
    XcdBarrier b; b.bar = bar; b.x = xb_xcc_id(); b.st = st;
    if (threadIdx.x == 0) (void)xb_add(&bar[XB_XCNT(b.x)], 1u);
    return b;
}
__device__ __forceinline__ void xcd_barrier_complete(unsigned* bar, unsigned x, unsigned& nloc, unsigned& nx) {
    const unsigned G = gridDim.x * gridDim.y * gridDim.z;
    unsigned sum, cnt, mine, sp = 0u;
    for (;;) {
        sum = 0u; cnt = 0u; mine = 0u;
#pragma unroll
        for (unsigned j = 0; j < 16; ++j) { const unsigned c = xb_ld(&bar[XB_XCNT(j)]); sum += c; cnt += (c > 0u) ? 1u : 0u; mine = (j == x) ? c : mine; }
        if (sum == G) break;
        __builtin_amdgcn_s_sleep(1);
        if ((++sp & 255u) == 0u) { if (xb_ld(&bar[XB_TMO])) break; if (sp > XB_SPIN_CAP) { atomicAdd(&bar[XB_TMO], 1u); break; } }
    }
    nloc = mine > 0u ? mine : 1u; nx = cnt > 0u ? cnt : 1u;
}
__device__ __forceinline__ void xcd_barrier(const XcdBarrier& b) {
    asm volatile("s_waitcnt vmcnt(0)" ::: "memory");
    __syncthreads();
    if (threadIdx.x == 0) {
        unsigned* bar = b.bar;
        __builtin_amdgcn_s_waitcnt(0);
        unsigned nloc = b.st[0], nx = b.st[1];
        if (nloc == 0u) { xcd_barrier_complete(bar, b.x, nloc, nx); b.st[0] = nloc; b.st[1] = nx; }
        const unsigned old = xb_add(&bar[XB_XSUB(b.x)], 1u);
        const unsigned gen = old / nloc;
        if (old + 1u == (gen + 1u) * nloc) {
            __builtin_amdgcn_fence(__ATOMIC_RELEASE, "agent");
            asm volatile("s_waitcnt vmcnt(0)" ::: "memory");
            const unsigned og = xb_add(&bar[XB_TOP], 1u);
            const unsigned tg = og / nx;
            if (og + 1u == (tg + 1u) * nx) xb_add(&bar[XB_TOPGEN], 1u);
            else XB_SPIN(xb_ld(&bar[XB_TOPGEN]) == tg, bar);
            __builtin_amdgcn_fence(__ATOMIC_ACQUIRE, "agent");
            xb_add(&bar[XB_XGEN(b.x)], 1u);
            asm volatile("s_waitcnt vmcnt(0)" ::: "memory");
        } else {
            XB_SPIN(xb_ld(&bar[XB_XGEN(b.x)]) == gen, bar);
            __builtin_amdgcn_fence(__ATOMIC_ACQUIRE, "agent");
            asm volatile("s_waitcnt vmcnt(0)" ::: "memory");
        }
    }
    __syncthreads();
}

__device__ __forceinline__ void p0_transpose_item(const float* W, int K, int N, bf16_t* WT, int row_off, const float* kscale, LAS float* scr, int item, int lane) {
    const int nblk = N / 32, kb = item / nblk, nb = item % nblk, k0 = 64 * kb, n0 = 32 * nb;
#pragma unroll 8
    for (int i = 0; i < 32; ++i) { const int kk = 2 * i + (lane >> 5); float v = W[(size_t)(k0 + kk) * N + n0 + (lane & 31)]; if (kscale) v *= kscale[k0 + kk]; scr[kk * 33 + (lane & 31)] = v; }
    LDS_WAIT(); asm volatile("" ::: "memory");
    const int c = lane & 7;
#pragma unroll
    for (int j = 0; j < 4; ++j) { const int n = (lane >> 3) + 8 * j; const LAS float* s = scr + (8 * c) * 33 + n;
        v4u o; o.x = pk2bf(s[0 * 33], s[1 * 33]); o.y = pk2bf(s[2 * 33], s[3 * 33]); o.z = pk2bf(s[4 * 33], s[5 * 33]); o.w = pk2bf(s[6 * 33], s[7 * 33]);
        *(GAS v4u*)(WT + (size_t)(row_off + n0 + n) * K + k0 + 8 * c) = o; }
    LDS_WAIT(); asm volatile("" ::: "memory");
}

struct Args {
    const float* in[28]; float* out; unsigned char* ws;
    int ph_lo, ph_hi, use_bar, flags;
};

__global__ void __launch_bounds__(NWAVES * 64, 2) mega_fwd(Args args) {
    extern __shared__ __attribute__((aligned(16))) unsigned char lds_raw[];
    LAS unsigned char* lds = (LAS unsigned char*)lds_raw;
    volatile LAS unsigned* MISC = (volatile LAS unsigned*)(lds + MISC_OFF);
    const int tid = threadIdx.x, lane = tid & 63, wave = __builtin_amdgcn_readfirstlane(tid >> 6);
    const int G = gridDim.x; const int bx = blockIdx.x; const int vcu = (G % 8 == 0) ? (bx % 8) * (G / 8) + bx / 8 : bx;
    unsigned char* ws = args.ws;
    gu32* ctl = (gu32*)(ws + WS_CTL);
    const float* x = args.in[0]; const float* cvec = args.in[1]; const float* ada_w = args.in[2]; const float* ada_b = args.in[3];
    const float* g_pre = args.in[4]; const float* g_post = args.in[5];
    float* out = args.out;
    float* mod = (float*)(ws + WS_MOD); float* lamp = (float*)(ws + WS_LAM); float* lb16 = (float*)(ws + WS_LB16);
    bf16_t* Win0 = (bf16_t*)(ws + WS_WIN0); bf16_t* Wglu = (bf16_t*)(ws + WS_WGLU); bf16_t* Wout0 = (bf16_t*)(ws + WS_WOUT0); bf16_t* Wkv = (bf16_t*)(ws + WS_WKV);
    bf16_t* Win1 = (bf16_t*)(ws + WS_WIN1); bf16_t* Wout1 = (bf16_t*)(ws + WS_WOUT1); bf16_t* BtA = (bf16_t*)(ws + WS_BTA); bf16_t* BtB = (bf16_t*)(ws + WS_BTB);
    bf16_t* A0 = (bf16_t*)(ws + WS_S0); bf16_t* US = (bf16_t*)(ws + WS_S1); bf16_t* SZ = (bf16_t*)(ws + WS_S3); bf16_t* YG = (bf16_t*)(ws + WS_S4); float* EB = (float*)(ws + WS_S0);
    bf16_t* Y2 = (bf16_t*)(ws + WS_S0); bf16_t* YO = (bf16_t*)(ws + WS_S1); bf16_t* AKV = (bf16_t*)(ws + WS_S0); bf16_t* AIN1 = (bf16_t*)(ws + WS_S2);
    bf16_t* KB = (bf16_t*)(ws + WS_S3); bf16_t* VB = (bf16_t*)(ws + WS_S4); bf16_t* QB = (bf16_t*)(ws + WS_S5); bf16_t* SZ1 = (bf16_t*)(ws + WS_S6);
    bf16_t* O0 = (bf16_t*)(ws + WS_S0); bf16_t* O1 = (bf16_t*)(ws + WS_S1); bf16_t* OG = (bf16_t*)(ws + WS_S2); bf16_t* YO1 = (bf16_t*)(ws + WS_S0);

    for (int u = tid; u < (LDS_BYTES - LDSCTL_OFF) / 4; u += NWAVES * 64) ((LAS unsigned*)(lds + LDSCTL_OFF))[u] = 0u;
    __syncthreads();
    XcdBarrier bar; bar.bar = (unsigned*)(ctl + CW_BAR); bar.x = 0; bar.st = nullptr;
    if (args.use_bar) bar = xcd_barrier_post((unsigned*)(ctl + CW_BAR), MISC + 8);
    const int lo = args.ph_lo, hi = args.ph_hi;
#define IN(k) (lo <= (k) && (k) < hi)
#define SEAM(k) do { if (IN(k) && IN((k) + 1) && args.use_bar) xcd_barrier(bar); } while (0)
    const int gw = vcu * NWAVES + wave, NGW = G * NWAVES;

    if (IN(0)) {
        for (int it = vcu; it < NGRP * 4; it += G) {
            const int g = it >> 2, qt = it & 3;
            LAS float* LBP = (LAS float*)(lds + RING_OFF);
            LAS float* BBR = LBP + 17 * 128;
            LAS float* CC = BBR + 64 * 32;
            LAS float* KM = CC + 16 * 128;
            __syncthreads();
            if (tid < 64) {
                const int p = tid;
                const float dt = expf(args.in[9][g]);
                const float lr = args.in[7][g * 64 + p], li = args.in[8][g * 64 + p];
                const float mag = expf(lr * dt); const float sn = sinf(li * dt), cs = cosf(li * dt);
                const float lbr = mag * cs, lbi = mag * sn;
                float pr = 1.f, pi = 0.f;
                for (int d = 0; d <= 16; ++d) { LBP[(d * 64 + p) * 2] = pr; LBP[(d * 64 + p) * 2 + 1] = pi; const float nr = pr * lbr - pi * lbi, ni = pr * lbi + pi * lbr; pr = nr; pi = ni; }
                if (qt == 0) { lb16[(g * 64 + p) * 2] = LBP[(16 * 64 + p) * 2]; lb16[(g * 64 + p) * 2 + 1] = LBP[(16 * 64 + p) * 2 + 1]; }
                const float nr = lbr - 1.0f, ni = lbi, den = lr * lr + li * li;
                const float cr = (nr * lr + ni * li) / den, ci = (ni * lr - nr * li) / den;
                for (int c = 0; c < 16; ++c) { const float br = args.in[10][(g * 64 + p) * 16 + c], bi = args.in[11][(g * 64 + p) * 16 + c];
                    BBR[(p * 16 + c) * 2] = cr * br - ci * bi; BBR[(p * 16 + c) * 2 + 1] = cr * bi + ci * br; }
            }
            for (int e = tid; e < 1024; e += 512) { const int co = e >> 6, p = e & 63; CC[e * 2] = args.in[12][(g * 16 + co) * 64 + p]; CC[e * 2 + 1] = args.in[13][(g * 16 + co) * 64 + p]; }
            __syncthreads();
            for (int e = tid; e < 4096; e += 512) {
                const int d = e >> 8, co = (e >> 4) & 15, ci = e & 15; float acc = 0.f;
                for (int p = 0; p < 64; ++p) { const float cr = CC[(co * 64 + p) * 2], cim = CC[(co * 64 + p) * 2 + 1], lr = LBP[(d * 64 + p) * 2], lim = LBP[(d * 64 + p) * 2 + 1];
                    const float wr_ = cr * lr - cim * lim, wi_ = cr * lim + cim * lr; acc += wr_ * BBR[(p * 16 + ci) * 2] - wi_ * BBR[(p * 16 + ci) * 2 + 1]; }
                KM[e] = acc; }
            __syncthreads();
            for (int e = tid; e < 64 * 48; e += 512) {
                const int n = 64 * qt + e / 48, pc = e % 48, s = n >> 4, co = n & 15; float v[8];
                if (pc < 32) { const int s2 = pc >> 1, ci0 = (pc & 1) * 8;
#pragma unroll
                    for (int j = 0; j < 8; ++j) v[j] = (s2 <= s) ? KM[((s - s2) * 16 + co) * 16 + ci0 + j] : 0.f;
                } else { const int j0 = (pc - 32) * 8;
#pragma unroll
                    for (int jj = 0; jj < 4; ++jj) { const int p = (j0 >> 1) + jj; const float cr = CC[(co * 64 + p) * 2], cim = CC[(co * 64 + p) * 2 + 1], lr = LBP[((s + 1) * 64 + p) * 2], lim = LBP[((s + 1) * 64 + p) * 2 + 1];
                        v[2 * jj] = cr * lr - cim * lim; v[2 * jj + 1] = -(cr * lim + cim * lr); } }
                v4u o; o.x = pk2bf(v[0], v[1]); o.y = pk2bf(v[2], v[3]); o.z = pk2bf(v[4], v[5]); o.w = pk2bf(v[6], v[7]);
                *(GAS v4u*)(BtB + ((size_t)g * 256 + n) * 384 + pc * 8) = o; }
            for (int e = tid; e < 64 * 32; e += 512) {
                const int n = 64 * qt + (e >> 5), pc = e & 31; float v[8];
                if (n < 128) { const int p = n >> 1, ri = n & 1, s2 = pc >> 1, ci0 = (pc & 1) * 8; const float lr = LBP[((15 - s2) * 64 + p) * 2], lim = LBP[((15 - s2) * 64 + p) * 2 + 1];
#pragma unroll
                    for (int j = 0; j < 8; ++j) { const float br = BBR[(p * 16 + ci0 + j) * 2], bi = BBR[(p * 16 + ci0 + j) * 2 + 1]; v[j] = ri ? (lr * bi + lim * br) : (lr * br - lim * bi); }
                } else {
#pragma unroll
                    for (int j = 0; j < 8; ++j) v[j] = 0.f; }
                v4u o; o.x = pk2bf(v[0], v[1]); o.y = pk2bf(v[2], v[3]); o.z = pk2bf(v[4], v[5]); o.w = pk2bf(v[6], v[7]);
                *(GAS v4u*)(BtA + ((size_t)g * 256 + n) * 256 + pc * 8) = o; }
        }
        __syncthreads();
        {
            LAS float* scr = (LAS float*)(lds + RING_OFF + wave * 16384);
            constexpr int I_2K = (DM / 64) * (2048 / 32), I_1K = (DM / 64) * (1024 / 32);
            constexpr int NITEMS = 2 * I_2K + 5 * I_1K;
            for (int it = gw; it < NITEMS; it += NGW) {
                int r = it;
                if (r < I_2K) { p0_transpose_item(args.in[6], DM, 2048, Win0, 0, nullptr, scr, r, lane); continue; } r -= I_2K;
                if (r < I_2K) { p0_transpose_item(args.in[21], DM, 2048, Win1, 0, nullptr, scr, r, lane); continue; } r -= I_2K;
                if (r < I_1K) { p0_transpose_item(args.in[15], DM, 1024, Wglu, 0, nullptr, scr, r, lane); continue; } r -= I_1K;
                if (r < I_1K) { p0_transpose_item(args.in[17], DM, 1024, Wout0, 0, nullptr, scr, r, lane); continue; } r -= I_1K;
                if (r < I_1K) { p0_transpose_item(args.in[19], DM, 1024, Wkv, 0, args.in[18], scr, r, lane); continue; } r -= I_1K;
                if (r < I_1K) { p0_transpose_item(args.in[20], DM, 1024, Wkv, 1024, args.in[18], scr, r, lane); continue; } r -= I_1K;
                p0_transpose_item(args.in[27], DM, 1024, Wout1, 0, nullptr, scr, r, lane);
            }
        }
        if (!(args.flags & 1)) {
            __syncthreads();
            LAS float* sc = (LAS float*)(lds + RING_OFF);
            LAS float* red = sc + 8192;
            bool have = false;
            for (int it = vcu; it < 2 * 48; it += G) {
                if (!have) { for (int e = tid; e < 8192; e += 512) sc[e] = silu_f(cvec[e]); have = true; __syncthreads(); }
                const int l = it / 48, cc = it % 48, j = cc * 64 + lane;
                float acc[8];
#pragma unroll
                for (int b = 0; b < 8; ++b) acc[b] = 0.f;
                const float* wp = ada_w + ((size_t)l * 1024 + wave * 128) * 3072 + j;
                for (int k0 = 0; k0 < 128; k0 += 8) {
                    float w[8];
#pragma unroll
                    for (int kk = 0; kk < 8; ++kk) w[kk] = wp[(size_t)(k0 + kk) * 3072];
#pragma unroll
                    for (int kk = 0; kk < 8; ++kk)
#pragma unroll
                        for (int b = 0; b < 8; ++b) acc[b] += w[kk] * sc[b * 1024 + wave * 128 + k0 + kk];
                }
#pragma unroll
                for (int b = 0; b < 8; ++b) red[(wave * 8 + b) * 64 + lane] = acc[b];
                __syncthreads();
                { const int b = tid >> 6; float sum = ada_b[l * 3072 + j];
#pragma unroll
                  for (int w = 0; w < 8; ++w) sum += red[(w * 8 + b) * 64 + lane];
                  mod[((size_t)(l * 8 + b)) * 3072 + j] = sum; }
                __syncthreads();
            }
            if (bx == 0 && tid == 0) lamp[0] = diff_lambda(args.in[22], args.in[23], args.in[24], args.in[25]);
        }
    }
    SEAM(0);
    if (IN(1)) e_norm0(x, mod, g_pre, A0, gw, NGW, lane);
    SEAM(1);
    if (IN(2)) {
        pg8::Gemm g = pg8::gemm_std(A0, DM, Win0, DM, DM); pg8::Order S; S.init(MTOK / 256, 2048 / 256, 1, G, bx);
        pg8::EpiRow8<pg8::F_In0> E{{US, SZ}};
        pg8::gemm_phase<pg8::EpiRow8<pg8::F_In0>, true>(lds + RING_OFF, g, S, E);
    }
    SEAM(2);
    if (IN(3)) {
        pg8::Gemm g = pg8::gemm_std(US, US_P, BtA, 256, 256); g.a_gstep = (size_t)NTILE * US_P * 2; g.b_gstep = (size_t)256 * 256 * 2;
        pg8::Order S; S.init(NTILE / 256, 1, NGRP, G, bx);
        pg8::EpiRow8<pg8::F_SsmA> E{{EB}};
        pg8::gemm_phase<pg8::EpiRow8<pg8::F_SsmA>, true>(lds + RING_OFF, g, S, E);
    }
    SEAM(3);
    if (IN(4)) {
        for (int it = vcu + G * wave; it < NB * NGRP; it += G * NWAVES) {
            const int b = it / NGRP, g = it % NGRP, p = lane;
            const float lr = lb16[(g * 64 + p) * 2], li = lb16[(g * 64 + p) * 2 + 1];
            float sr = 0.f, si = 0.f;
            const float* ep = EB + ((size_t)g * NTILE + b * 256) * 128 + 2 * p;
            bf16_t* sp = US + us_off(g, b * 256, 256 + 2 * p);
            for (int t0 = 0; t0 < 256; t0 += 16) {
                float er[16], ei[16];
#pragma unroll
                for (int j = 0; j < 16; ++j) { const float2 e = *(const float2*)(ep + (size_t)(t0 + j) * 128); er[j] = e.x; ei[j] = e.y; }
#pragma unroll
                for (int j = 0; j < 16; ++j) { *(unsigned*)(sp + (size_t)(t0 + j) * US_P) = pk2bf(sr, si);
                    const float nr = lr * sr - li * si + er[j], ni = lr * si + li * sr + ei[j]; sr = nr; si = ni; }
            }
        }
    }
    SEAM(4);
    if (IN(5)) {
        pg8::Gemm g = pg8::gemm_std(US, US_P, BtB, 384, 384); g.a_gstep = (size_t)NTILE * US_P * 2; g.b_gstep = (size_t)256 * 384 * 2;
        pg8::Order S; S.init(NTILE / 256, 1, NGRP, G, bx);
        pg8::EpiRow8<pg8::F_SsmB> E{{US, args.in[14], YG}};
        pg8::gemm_phase<pg8::EpiRow8<pg8::F_SsmB>, true>(lds + RING_OFF, g, S, E);
    }
    SEAM(5);
    if (IN(6)) {
        pg8::Gemm g = pg8::gemm_std(YG, DM, Wglu, DM, DM);
        g.a_rs = 32u; g.a_c16 = (unsigned)((size_t)NTILE * YG_P * 2); g.a_kstep = (size_t)4 * NTILE * YG_P * 2; g.a_tstep = (size_t)256 * 32;
        pg8::Order S; S.init(MTOK / 256, 1024 / 256, 1, G, bx);
        pg8::EpiRow8<pg8::F_Glu> E{{YG, SZ, args.in[16], Y2}};
        pg8::gemm_phase<pg8::EpiRow8<pg8::F_Glu>, true>(lds + RING_OFF, g, S, E);
    }
    SEAM(6);
    if (IN(7)) {
        pg8::Gemm g = pg8::gemm_std(Y2, DM, Wout0, DM, DM); pg8::Order S; S.init(MTOK / 256, 1024 / 256, 1, G, bx);
        pg8::EpiRow8<pg8::F_Plain> E{{YO}};
        pg8::gemm_phase<pg8::EpiRow8<pg8::F_Plain>, true>(lds + RING_OFF, g, S, E);
    }
    SEAM(7);
    if (IN(8)) e_mid(x, YO, mod, g_post, g_pre, out, AKV, AIN1, gw, NGW, lane);
    SEAM(8);
    if (IN(9)) {
        { pg8::Gemm g = pg8::gemm_std(AKV, DM, Wkv, DM, DM); pg8::Order S; S.init(MTOK / 256, 2048 / 256, 1, G, bx);
          pg8::EpiRow8<pg8::F_Split> E{{KB, VB, 1.0f, 0}};
          pg8::gemm_phase<pg8::EpiRow8<pg8::F_Split>, true>(lds + RING_OFF, g, S, E); }
        { pg8::Gemm g = pg8::gemm_std(AIN1, DM, Win1, DM, DM); pg8::Order S; S.init(MTOK / 256, 2048 / 256, 1, G, bx);
          pg8::EpiRow8<pg8::F_Split> E{{QB, SZ1, QC2, 1}};
          pg8::gemm_phase<pg8::EpiRow8<pg8::F_Split>, true>(lds + RING_OFF, g, S, E); }
    }
    SEAM(9);
    if (IN(10)) {
        for (int i = 0;; ++i) {
            const long L = (long)i * G + vcu; if (L >= 256 * 16) break;
            const int combo = (int)(L % 256), qi = (int)(L / 256);
            const int qb = (qi & 1) ? (qi >> 1) : (15 - (qi >> 1));
            const int vh = combo & 1, c = (combo >> 1) & 1, h = (combo >> 2) & 7, b = combo >> 5;
            attn_body::attn_unit<8>(b, 2 * h + c, 2 * h + vh, qb, QB, KB, VB, c ? O1 : O0, (char*)lds_raw + RING_OFF);
        }
    }
    SEAM(10);
    if (IN(11)) e_attn_post(O0, O1, SZ1, args.in[26], lamp[0], OG, gw, NGW, lane);
    SEAM(11);
    if (IN(12)) {
        pg8::Gemm g = pg8::gemm_std(OG, DM, Wout1, DM, DM); pg8::Order S; S.init(MTOK / 256, 1024 / 256, 1, G, bx);
        pg8::EpiRow8<pg8::F_Plain> E{{YO1}};
        pg8::gemm_phase<pg8::EpiRow8<pg8::F_Plain>, true>(lds + RING_OFF, g, S, E);
    }
    SEAM(12);
    if (IN(13)) e_final(out, YO1, mod, g_post, gw, NGW, lane);
#undef IN
#undef SEAM
}

#ifndef FASTMASK
#define FASTMASK 0x3fff
#endif
#ifndef ONE_LAUNCH
#define ONE_LAUNCH 1
#endif
constexpr int NPHASE = 14;

extern "C" void kernel_launch(void* const* d_in, const int* in_sizes, int n_in, void* d_out, int out_size, void* d_ws, size_t ws_size, hipStream_t stream) {
    static int grid = 0;
    if (grid == 0) {
        if (n_in != 28 || out_size != MTOK * DM || ws_size < WS_END) { fprintf(stderr, "kernel_launch: unexpected shapes (n_in %d out %d ws %zu)\n", n_in, out_size, ws_size); grid = -1; return; }
        int dev = 0, cus = 0, per_cu = 0;
        if (hipGetDevice(&dev) != hipSuccess || hipDeviceGetAttribute(&cus, hipDeviceAttributeMultiprocessorCount, dev) != hipSuccess) { grid = -1; return; }
        if (hipFuncSetAttribute((const void*)mega_fwd, hipFuncAttributeMaxDynamicSharedMemorySize, LDS_BYTES) != hipSuccess) { fprintf(stderr, "kernel_launch: hipFuncSetAttribute failed\n"); grid = -1; return; }
        if (hipOccupancyMaxActiveBlocksPerMultiprocessor(&per_cu, (const void*)mega_fwd, NWAVES * 64, LDS_BYTES) != hipSuccess || per_cu < 1) { fprintf(stderr, "kernel_launch: occupancy query says %d\n", per_cu); }
        (void)hipGetLastError();
        grid = cus;
    }
    if (grid < 0) return;
    if (hipMemsetAsync((char*)d_ws + WS_CTL, 0, CTL_ZERO_BYTES, stream) != hipSuccess) { fprintf(stderr, "kernel_launch: memset failed\n"); return; }
    Args a{};
    for (int i = 0; i < 28; ++i) a.in[i] = (const float*)d_in[i];
    a.out = (float*)d_out; a.ws = (unsigned char*)d_ws;
#if ONE_LAUNCH
    a.ph_lo = 0; a.ph_hi = NPHASE; a.use_bar = 1; a.flags = 0;
    hipLaunchKernelGGL(mega_fwd, dim3(grid), dim3(NWAVES * 64), LDS_BYTES, stream, a);
#else
    const float* x = a.in[0]; unsigned char* ws = a.ws; float* out = a.out;
    float* mod = (float*)(ws + WS_MOD); float* lam = (float*)(ws + WS_LAM);
    bf16_t* A0 = (bf16_t*)(ws + WS_S0); bf16_t* US = (bf16_t*)(ws + WS_S1); bf16_t* SZ = (bf16_t*)(ws + WS_S3); bf16_t* YG = (bf16_t*)(ws + WS_S4);
    bf16_t* Y2 = (bf16_t*)(ws + WS_S0); bf16_t* YO = (bf16_t*)(ws + WS_S1); bf16_t* AKV = (bf16_t*)(ws + WS_S0); bf16_t* AIN1 = (bf16_t*)(ws + WS_S2);
    bf16_t* KB = (bf16_t*)(ws + WS_S3); bf16_t* VB = (bf16_t*)(ws + WS_S4); bf16_t* QB = (bf16_t*)(ws + WS_S5); bf16_t* SZ1 = (bf16_t*)(ws + WS_S6);
    bf16_t* O0 = (bf16_t*)(ws + WS_S0); bf16_t* O1 = (bf16_t*)(ws + WS_S1); bf16_t* OG = (bf16_t*)(ws + WS_S2); bf16_t* YO1 = (bf16_t*)(ws + WS_S0);
    const int EG = 2048;
    auto fast = [&](int lo, int hi, int flags) { a.ph_lo = lo; a.ph_hi = hi; a.use_bar = 0; a.flags = flags; hipLaunchKernelGGL(mega_fwd, dim3(grid), dim3(NWAVES * 64), LDS_BYTES, stream, a); };
    const unsigned FM = FASTMASK;
    if (FM & 1u) fast(0, 1, 0);
    else { fast(0, 1, 1); n_adaln<<<(2 * 8 * 3072 + 255) / 256, 256, 0, stream>>>(a.in[1], a.in[2], a.in[3], mod); n_lambda<<<1, 64, 0, stream>>>(a.in[22], a.in[23], a.in[24], a.in[25], lam); }
    if (FM & 2u) fast(1, 2, 0); else n_norm0<<<EG, 256, 0, stream>>>(x, mod, a.in[4], A0);
    if (FM & 4u) fast(2, 3, 0); else n_gemm<<<dim3(2048 / 64, MTOK / 64), 256, 0, stream>>>(AL_Row{A0}, WL_Plain{a.in[6], 2048}, EP_In0{US, SZ}, 2048);
    if (FM & 8u) { fast(3, 4, 0); fast(4, 5, 0); fast(5, 6, 0); }
    else n_ssm<<<NB * NGRP / 4, 256, 0, stream>>>(US, a.in[7], a.in[8], a.in[9], a.in[10], a.in[11], a.in[12], a.in[13], a.in[14], YG);
    if (FM & 64u) fast(6, 7, 0); else n_gemm<<<dim3(1024 / 64, MTOK / 64), 256, 0, stream>>>(AL_YG{YG}, WL_Plain{a.in[15], 1024}, EP_Glu{YG, SZ, a.in[16], Y2}, 1024);
    if (FM & 128u) fast(7, 8, 0); else n_gemm<<<dim3(1024 / 64, MTOK / 64), 256, 0, stream>>>(AL_Row{Y2}, WL_Plain{a.in[17], 1024}, EP_Plain{YO}, 1024);
    if (FM & 256u) fast(8, 9, 0); else n_mid<<<EG, 256, 0, stream>>>(x, YO, mod, a.in[5], a.in[4], out, AKV, AIN1);
    if (FM & 512u) fast(9, 10, 0);
    else { n_gemm<<<dim3(2048 / 64, MTOK / 64), 256, 0, stream>>>(AL_Row{AKV}, WL_KV{a.in[19], a.in[20], a.in[18]}, EP_KV{KB, VB}, 2048);
           n_gemm<<<dim3(2048 / 64, MTOK / 64), 256, 0, stream>>>(AL_Row{AIN1}, WL_Plain{a.in[21], 2048}, EP_In1{QB, SZ1}, 2048); }
    if (FM & 1024u) fast(10, 11, 0); else n_attn<<<MTOK * 8 / 4, 256, 0, stream>>>(QB, KB, VB, O0, O1);
    if (FM & 2048u) fast(11, 12, 0); else n_attn_post<<<EG, 256, 0, stream>>>(O0, O1, SZ1, a.in[26], lam, OG);
    if (FM & 4096u) fast(12, 13, 0); else n_gemm<<<dim3(1024 / 64, MTOK / 64), 256, 0, stream>>>(AL_Row{OG}, WL_Plain{a.in[27], 1024}, EP_Plain{YO1}, 1024);
    if (FM & 8192u) fast(13, 14, 0); else n_final<<<EG, 256, 0, stream>>>(out, YO1, mod, a.in[5]);
#endif
    const hipError_t le = hipPeekAtLastError();
    if (le != hipSuccess) fprintf(stderr, "kernel_launch: launch failed: %s\n", hipGetErrorName(le));
}
```

```cpp
#include <hip/hip_runtime.h>
#include <cstdio>
#include <cstdint>
#include <cmath>
#define FASTMASK 0x3fff
#define ONE_LAUNCH 1
#define REPEAT_MASK 0
typedef unsigned short bf16_t;
constexpr int NB = 8, SEQL = 4096, DM = 1024, MTOK = NB * SEQL;
constexpr int NGRP = 64, NTILE = MTOK / 16;
constexpr int US_P = 384, YG_P = 256;
constexpr float LAMBDA_INIT = 0.35550907f;
constexpr float ONE_M_LI = 1.0f - LAMBDA_INIT;
constexpr float RMS_EPS = 1e-6f;
constexpr float QC2 = 0.125f * 1.4426950408889634f;

__device__ __forceinline__ float bf2f(bf16_t v) { return __uint_as_float((unsigned)v << 16); }
__device__ __forceinline__ unsigned f2bf_u(float f) { unsigned u = __float_as_uint(f); return (u + 0x7fffu + ((u >> 16) & 1u)) >> 16; }
__device__ __forceinline__ bf16_t f2bf(float f) { return (bf16_t)f2bf_u(f); }
__device__ __forceinline__ unsigned pk2bf(float lo, float hi) { return f2bf_u(lo) | (f2bf_u(hi) << 16); }
__device__ __forceinline__ float silu_f(float v) { return v / (1.0f + __expf(-v)); }
__device__ __forceinline__ float sigmoid_f(float v) { return 1.0f / (1.0f + __expf(-v)); }
__device__ __forceinline__ float gelu_tanh_f(float v) {
    const float u = 0.7978845608028654f * (v + 0.044715f * v * v * v);
    const float e = __expf(2.0f * u);
    const float t = 1.0f - 2.0f / (e + 1.0f);
    return 0.5f * v * (1.0f + t);
}
__device__ __forceinline__ float wave_sum_f(float v) {
#pragma unroll
    for (int o = 1; o < 64; o <<= 1) v += __shfl_xor(v, o);
    return v;
}
__device__ __forceinline__ float wave_max_f(float v) {
#pragma unroll
    for (int o = 1; o < 64; o <<= 1) v = fmaxf(v, __shfl_xor(v, o));
    return v;
}
__device__ __forceinline__ size_t us_off(int g, int tile, int col) { return ((size_t)g * NTILE + tile) * US_P + col; }
__device__ __forceinline__ size_t yg_off(int g, int tile, int col) { return ((size_t)g * NTILE + tile) * YG_P + col; }

typedef float f32x4_t __attribute__((ext_vector_type(4)));
typedef unsigned u32x4_t __attribute__((ext_vector_type(4)));
typedef unsigned u32x2_t __attribute__((ext_vector_type(2)));

__device__ __forceinline__ void e_norm0(const float* __restrict__ x, const float* __restrict__ mod, const float* __restrict__ g_pre, bf16_t* a0, int gw, int ngw, int lane) {
    for (int m = gw; m < MTOK; m += ngw) {
        const int b = m / SEQL;
        const f32x4_t* xr = (const f32x4_t*)(x + (size_t)m * DM) + lane;
        f32x4_t v[4]; float s = 0.f;
#pragma unroll
        for (int j = 0; j < 4; ++j) { v[j] = xr[64 * j]; s += (v[j].x * v[j].x + v[j].y * v[j].y) + (v[j].z * v[j].z + v[j].w * v[j].w); }
        const float r = rsqrtf(wave_sum_f(s) * (1.0f / DM) + RMS_EPS);
        const float* sh = mod + (size_t)b * 3072; const float* sc = sh + 1024;
        u32x2_t* o = (u32x2_t*)(a0 + (size_t)m * DM) + lane;
#pragma unroll
        for (int j = 0; j < 4; ++j) {
            const int c = 256 * j + 4 * lane;
            const f32x4_t g = *(const f32x4_t*)(g_pre + c), scv = *(const f32x4_t*)(sc + c), shv = *(const f32x4_t*)(sh + c);
            f32x4_t y = v[j] * r * g * (scv + 1.0f) + shv;
            u32x2_t w; w.x = pk2bf(y.x, y.y); w.y = pk2bf(y.z, y.w); o[64 * j] = w;
        }
    }
}
__device__ __forceinline__ void e_mid(const float* __restrict__ x, const bf16_t* __restrict__ yo, const float* __restrict__ mod, const float* __restrict__ g_post, const float* __restrict__ g_pre,
                                      float* h1, bf16_t* akv, bf16_t* ain1, int gw, int ngw, int lane) {
    for (int m = gw; m < MTOK; m += ngw) {
        const int b = m / SEQL;
        const f32x4_t* xr = (const f32x4_t*)(x + (size_t)m * DM) + lane;
        const u32x2_t* yr = (const u32x2_t*)(yo + (size_t)m * DM) + lane;
        f32x4_t v[4], y[4]; float s = 0.f;
#pragma unroll
        for (int j = 0; j < 4; ++j) { v[j] = xr[64 * j]; const u32x2_t w = yr[64 * j];
            y[j].x = __uint_as_float(w.x << 16); y[j].y = __uint_as_float(w.x & 0xffff0000u); y[j].z = __uint_as_float(w.y << 16); y[j].w = __uint_as_float(w.y & 0xffff0000u);
            s += (y[j].x * y[j].x + y[j].y * y[j].y) + (y[j].z * y[j].z + y[j].w * y[j].w); }
        const float ry = rsqrtf(wave_sum_f(s) * (1.0f / DM) + RMS_EPS);
        const float* gate0 = mod + (size_t)b * 3072 + 2048;
        const float* sh1 = mod + (size_t)(8 + b) * 3072; const float* sc1 = sh1 + 1024;
        float s2 = 0.f;
        f32x4_t* ho = (f32x4_t*)(h1 + (size_t)m * DM) + lane;
#pragma unroll
        for (int j = 0; j < 4; ++j) { const int c = 256 * j + 4 * lane;
            const f32x4_t gp = *(const f32x4_t*)(g_post + c), gt = *(const f32x4_t*)(gate0 + c);
            v[j] = v[j] + gt * (y[j] * ry * gp);
            ho[64 * j] = v[j];
            s2 += (v[j].x * v[j].x + v[j].y * v[j].y) + (v[j].z * v[j].z + v[j].w * v[j].w); }
        const float rh = rsqrtf(wave_sum_f(s2) * (1.0f / DM) + RMS_EPS);
        u32x2_t* o1 = (u32x2_t*)(akv + (size_t)m * DM) + lane; u32x2_t* o2 = (u32x2_t*)(ain1 + (size_t)m * DM) + lane;
#pragma unroll
        for (int j = 0; j < 4; ++j) { const int c = 256 * j + 4 * lane;
            const f32x4_t n = v[j] * rh;
            u32x2_t w; w.x = pk2bf(n.x, n.y); w.y = pk2bf(n.z, n.w); o1[64 * j] = w;
            const f32x4_t g = *(const f32x4_t*)(g_pre + 1024 + c), scv = *(const f32x4_t*)(sc1 + c), shv = *(const f32x4_t*)(sh1 + c);
            const f32x4_t z = n * g * (scv + 1.0f) + shv;
            w.x = pk2bf(z.x, z.y); w.y = pk2bf(z.z, z.w); o2[64 * j] = w; }
    }
}
__device__ __forceinline__ void e_attn_post(const bf16_t* __restrict__ o0, const bf16_t* __restrict__ o1, const bf16_t* __restrict__ sz1, const float* __restrict__ g_sub, float lam,
                                            bf16_t* og, int gw, int ngw, int lane) {
    for (int m = gw; m < MTOK; m += ngw) {
#pragma unroll
        for (int j = 0; j < 2; ++j) {
            const int c = 512 * j + 8 * lane;
            const u32x4_t a = *(const u32x4_t*)(o0 + (size_t)m * DM + c), bq = *(const u32x4_t*)(o1 + (size_t)m * DM + c), zq = *(const u32x4_t*)(sz1 + (size_t)m * DM + c);
            float d[8]; float s = 0.f;
#pragma unroll
            for (int i = 0; i < 4; ++i) { const unsigned wa = a[i], wb = bq[i];
                d[2 * i] = __uint_as_float(wa << 16) - lam * __uint_as_float(wb << 16); d[2 * i + 1] = __uint_as_float(wa & 0xffff0000u) - lam * __uint_as_float(wb & 0xffff0000u);
                s += d[2 * i] * d[2 * i] + d[2 * i + 1] * d[2 * i + 1]; }
            s += __shfl_xor(s, 1); s += __shfl_xor(s, 2); s += __shfl_xor(s, 4); s += __shfl_xor(s, 8);
            const float r = rsqrtf(s * (1.0f / 128.0f) + RMS_EPS) * ONE_M_LI;
            const float* gs = g_sub + (c & 127);
            u32x4_t w;
#pragma unroll
            for (int i = 0; i < 4; ++i) { const unsigned wz = zq[i];
                const float z0 = __uint_as_float(wz << 16), z1 = __uint_as_float(wz & 0xffff0000u);
                w[i] = pk2bf(d[2 * i] * r * gs[2 * i] * z0, d[2 * i + 1] * r * gs[2 * i + 1] * z1); }
            *(u32x4_t*)(og + (size_t)m * DM + c) = w;
        }
    }
}
__device__ __forceinline__ void e_final(float* out, const bf16_t* __restrict__ yo1, const float* __restrict__ mod, const float* __restrict__ g_post, int gw, int ngw, int lane) {
    for (int m = gw; m < MTOK; m += ngw) {
        const int b = m / SEQL;
        f32x4_t* hr = (f32x4_t*)(out + (size_t)m * DM) + lane;
        const u32x2_t* yr = (const u32x2_t*)(yo1 + (size_t)m * DM) + lane;
        f32x4_t v[4], y[4]; float s = 0.f;
#pragma unroll
        for (int j = 0; j < 4; ++j) { v[j] = hr[64 * j]; const u32x2_t w = yr[64 * j];
            y[j].x = __uint_as_float(w.x << 16); y[j].y = __uint_as_float(w.x & 0xffff0000u); y[j].z = __uint_as_float(w.y << 16); y[j].w = __uint_as_float(w.y & 0xffff0000u);
            s += (y[j].x * y[j].x + y[j].y * y[j].y) + (y[j].z * y[j].z + y[j].w * y[j].w); }
        const float ry = rsqrtf(wave_sum_f(s) * (1.0f / DM) + RMS_EPS);
        const float* gate1 = mod + (size_t)(8 + b) * 3072 + 2048;
#pragma unroll
        for (int j = 0; j < 4; ++j) { const int c = 256 * j + 4 * lane;
            const f32x4_t gp = *(const f32x4_t*)(g_post + 1024 + c), gt = *(const f32x4_t*)(gate1 + c);
            hr[64 * j] = v[j] + gt * (y[j] * ry * gp); }
    }
}
__device__ __forceinline__ float diff_lambda(const float* lq1, const float* lk1, const float* lq2, const float* lk2) {
    float s1 = 0.f, s2 = 0.f;
    for (int i = 0; i < 64; ++i) { s1 += lq1[i] * lk1[i]; s2 += lq2[i] * lk2[i]; }
    return expf(s1) - expf(s2) + LAMBDA_INIT;
}

__global__ void n_adaln(const float* __restrict__ c, const float* __restrict__ ada_w, const float* __restrict__ ada_b, float* mod) {
    const int idx = blockIdx.x * 256 + threadIdx.x;
    if (idx >= 2 * 8 * 3072) return;
    const int j = idx % 3072, b = (idx / 3072) % 8, l = idx / (3072 * 8);
    float acc = ada_b[l * 3072 + j];
    const float* w = ada_w + (size_t)l * 1024 * 3072 + j; const float* cb = c + b * 1024;
    for (int k = 0; k < 1024; ++k) acc += silu_f(cb[k]) * w[(size_t)k * 3072];
    mod[idx] = acc;
}
__global__ void n_lambda(const float* lq1, const float* lk1, const float* lq2, const float* lk2, float* out) {
    if (threadIdx.x == 0 && blockIdx.x == 0) out[0] = diff_lambda(lq1, lk1, lq2, lk2);
}
__global__ void n_norm0(const float* x, const float* mod, const float* g_pre, bf16_t* a0) {
    e_norm0(x, mod, g_pre, a0, blockIdx.x * 4 + (threadIdx.x >> 6), gridDim.x * 4, threadIdx.x & 63);
}
__global__ void n_mid(const float* x, const bf16_t* yo, const float* mod, const float* g_post, const float* g_pre, float* h1, bf16_t* akv, bf16_t* ain1) {
    e_mid(x, yo, mod, g_post, g_pre, h1, akv, ain1, blockIdx.x * 4 + (threadIdx.x >> 6), gridDim.x * 4, threadIdx.x & 63);
}
__global__ void n_attn_post(const bf16_t* o0, const bf16_t* o1, const bf16_t* sz1, const float* g_sub, const float* lamp, bf16_t* og) {
    e_attn_post(o0, o1, sz1, g_sub, lamp[0], og, blockIdx.x * 4 + (threadIdx.x >> 6), gridDim.x * 4, threadIdx.x & 63);
}
__global__ void n_final(float* out, const bf16_t* yo1, const float* mod, const float* g_post) {
    e_final(out, yo1, mod, g_post, blockIdx.x * 4 + (threadIdx.x >> 6), gridDim.x * 4, threadIdx.x & 63);
}

struct AL_Row { const bf16_t* A; __device__ float ld(int m, int k) const { return bf2f(A[(size_t)m * DM + k]); } };
struct AL_YG  { const bf16_t* A; __device__ float ld(int m, int k) const { return bf2f(A[yg_off(k >> 4, m >> 4, (m & 15) * 16 + (k & 15))]); } };
struct WL_Plain { const float* W; long N; __device__ float ld(int k, int n) const { return W[(size_t)k * N + n]; } };
struct WL_KV { const float* wk; const float* wv; const float* g; __device__ float ld(int k, int n) const { return g[k] * (n < 1024 ? wk[(size_t)k * 1024 + n] : wv[(size_t)k * 1024 + n - 1024]); } };
struct EP_In0 { bf16_t* US; bf16_t* SZ; __device__ void st(int m, int n, float a) const {
    if (n < 1024) US[us_off(n >> 4, m >> 4, (m & 15) * 16 + (n & 15))] = f2bf(a); else SZ[(size_t)m * DM + n - 1024] = f2bf(silu_f(a)); } };
struct EP_Glu { const bf16_t* YG; const bf16_t* SZ; const float* bias; bf16_t* Y2; __device__ void st(int m, int n, float a) const {
    const float yv = bf2f(YG[yg_off(n >> 4, m >> 4, (m & 15) * 16 + (n & 15))]); const float t = a + bias[n];
    Y2[(size_t)m * DM + n] = f2bf(yv * sigmoid_f(t) * bf2f(SZ[(size_t)m * DM + n])); } };
struct EP_Plain { bf16_t* O; __device__ void st(int m, int n, float a) const { O[(size_t)m * DM + n] = f2bf(a); } };
struct EP_KV { bf16_t* K; bf16_t* V; __device__ void st(int m, int n, float a) const { if (n < 1024) K[(size_t)m * DM + n] = f2bf(a); else V[(size_t)m * DM + n - 1024] = f2bf(a); } };
struct EP_In1 { bf16_t* Q; bf16_t* SZ1; __device__ void st(int m, int n, float a) const { if (n < 1024) Q[(size_t)m * DM + n] = f2bf(a * QC2); else SZ1[(size_t)m * DM + n - 1024] = f2bf(silu_f(a)); } };

template <class AL, class WL, class EP>
__global__ void __launch_bounds__(256) n_gemm(AL al, WL wl, EP ep, int N) {
    __shared__ float As[16][68]; __shared__ float Ws[16][68];
    const int tid = threadIdx.x, tx = tid & 15, ty = tid >> 4;
    const int m0 = blockIdx.y * 64, n0 = blockIdx.x * 64;
    float acc[4][4];
#pragma unroll
    for (int i = 0; i < 4; ++i)
#pragma unroll
        for (int j = 0; j < 4; ++j) acc[i][j] = 0.f;
    for (int k0 = 0; k0 < 1024; k0 += 16) {
#pragma unroll
        for (int i = 0; i < 4; ++i) { const int e = tid + 256 * i; const int mm = e >> 4, kk = e & 15; As[kk][mm] = al.ld(m0 + mm, k0 + kk); }
#pragma unroll
        for (int i = 0; i < 4; ++i) { const int e = tid + 256 * i; const int kk = e >> 6, nn = e & 63; Ws[kk][nn] = wl.ld(k0 + kk, n0 + nn); }
        __syncthreads();
#pragma unroll
        for (int kk = 0; kk < 16; ++kk) {
            float a[4], b[4];
#pragma unroll
            for (int i = 0; i < 4; ++i) { a[i] = As[kk][ty * 4 + i]; b[i] = Ws[kk][tx * 4 + i]; }
#pragma unroll
            for (int i = 0; i < 4; ++i)
#pragma unroll
                for (int j = 0; j < 4; ++j) acc[i][j] += a[i] * b[j];
        }
        __syncthreads();
    }
#pragma unroll
    for (int i = 0; i < 4; ++i)
#pragma unroll
        for (int j = 0; j < 4; ++j) ep.st(m0 + ty * 4 + i, n0 + tx * 4 + j, acc[i][j]);
}

__global__ void __launch_bounds__(256) n_ssm(const bf16_t* __restrict__ US, const float* lam_re, const float* lam_im, const float* log_dt, const float* b_re, const float* b_im,
                                             const float* c_re, const float* c_im, const float* d_skip, bf16_t* YG) {
    const int wv = blockIdx.x * 4 + (threadIdx.x >> 6), lane = threadIdx.x & 63;
    if (wv >= NB * NGRP) return;
    const int b = wv / NGRP, g = wv % NGRP, p = lane;
    const float dt = expf(log_dt[g]);
    const float lr = lam_re[g * 64 + p], li = lam_im[g * 64 + p];
    const float mag = expf(lr * dt); float sn, cs; sn = sinf(li * dt); cs = cosf(li * dt);
    const float lbr = mag * cs, lbi = mag * sn;
    const float nr = lbr - 1.0f, ni = lbi, den = lr * lr + li * li;
    const float cr = (nr * lr + ni * li) / den, ci = (ni * lr - nr * li) / den;
    float bbr[16], bbi[16], ccr[16], cci[16];
#pragma unroll
    for (int c = 0; c < 16; ++c) { const float br = b_re[(g * 64 + p) * 16 + c], bi = b_im[(g * 64 + p) * 16 + c];
        bbr[c] = cr * br - ci * bi; bbi[c] = cr * bi + ci * br;
        ccr[c] = c_re[(g * 16 + c) * 64 + p]; cci[c] = c_im[(g * 16 + c) * 64 + p]; }
    const float dsk = d_skip[g * 16 + (lane & 15)];
    float sr = 0.f, si = 0.f;
    for (int t = 0; t < SEQL; ++t) {
        const int m = b * SEQL + t;
        const bf16_t* up = US + us_off(g, m >> 4, (m & 15) * 16);
        float u[16];
        { const u32x4_t w0 = *(const u32x4_t*)up, w1 = *(const u32x4_t*)(up + 8);
#pragma unroll
          for (int i = 0; i < 4; ++i) { u[2 * i] = __uint_as_float(w0[i] << 16); u[2 * i + 1] = __uint_as_float(w0[i] & 0xffff0000u); u[8 + 2 * i] = __uint_as_float(w1[i] << 16); u[8 + 2 * i + 1] = __uint_as_float(w1[i] & 0xffff0000u); } }
        float bur = 0.f, bui = 0.f;
#pragma unroll
        for (int c = 0; c < 16; ++c) { bur += bbr[c] * u[c]; bui += bbi[c] * u[c]; }
        const float nsr = lbr * sr - lbi * si + bur, nsi = lbr * si + lbi * sr + bui; sr = nsr; si = nsi;
        float yv = 0.f;
#pragma unroll
        for (int c = 0; c < 16; ++c) { const float part = wave_sum_f(ccr[c] * sr - cci[c] * si); if ((lane & 15) == c) yv = part; }
        if (lane < 16) { const float yy = yv + dsk * bf2f(up[lane]); YG[yg_off(g, m >> 4, (m & 15) * 16 + lane)] = f2bf(gelu_tanh_f(yy)); }
    }
}

__global__ void __launch_bounds__(256) n_attn(const bf16_t* __restrict__ Q, const bf16_t* __restrict__ K, const bf16_t* __restrict__ V, bf16_t* O0, bf16_t* O1) {
    __shared__ float qs[4][128];
    const int w = threadIdx.x >> 6, lane = threadIdx.x & 63;
    const int gwv = blockIdx.x * 4 + w;
    const int h = gwv & 7, m = gwv >> 3, b = m / SEQL, qi = m % SEQL;
    qs[w][lane] = bf2f(Q[(size_t)m * DM + h * 128 + lane]); qs[w][64 + lane] = bf2f(Q[(size_t)m * DM + h * 128 + 64 + lane]);
    __syncthreads();
    float m0 = -1e30f, m1 = -1e30f, l0 = 0.f, l1 = 0.f, a00 = 0.f, a01 = 0.f, a10 = 0.f, a11 = 0.f;
    const size_t rb = (size_t)b * SEQL;
    for (int kc = 0; kc * 64 <= qi; ++kc) {
        const int key = kc * 64 + lane; const bool valid = key <= qi;
        float s0 = 0.f, s1 = 0.f;
        { const bf16_t* kr = K + (rb + (valid ? key : qi)) * DM + h * 128;
#pragma unroll
          for (int ch = 0; ch < 8; ++ch) { const u32x4_t w0 = *(const u32x4_t*)(kr + ch * 8), w1 = *(const u32x4_t*)(kr + 64 + ch * 8);
#pragma unroll
            for (int i = 0; i < 4; ++i) { s0 += qs[w][ch * 8 + 2 * i] * __uint_as_float(w0[i] << 16) + qs[w][ch * 8 + 2 * i + 1] * __uint_as_float(w0[i] & 0xffff0000u);
                                          s1 += qs[w][64 + ch * 8 + 2 * i] * __uint_as_float(w1[i] << 16) + qs[w][64 + ch * 8 + 2 * i + 1] * __uint_as_float(w1[i] & 0xffff0000u); } } }
        if (!valid) { s0 = -1e30f; s1 = -1e30f; }
        const float nm0 = fmaxf(m0, wave_max_f(s0)), nm1 = fmaxf(m1, wave_max_f(s1));
        const float f0 = exp2f(m0 - nm0), f1 = exp2f(m1 - nm1);
        const float p0 = valid ? exp2f(s0 - nm0) : 0.f, p1 = valid ? exp2f(s1 - nm1) : 0.f;
        l0 = l0 * f0 + wave_sum_f(p0); l1 = l1 * f1 + wave_sum_f(p1); m0 = nm0; m1 = nm1;
        a00 *= f0; a01 *= f0; a10 *= f1; a11 *= f1;
        const int nk = min(64, qi - kc * 64 + 1);
        for (int j = 0; j < nk; ++j) {
            const float pj0 = __shfl(p0, j), pj1 = __shfl(p1, j);
            const bf16_t* vr = V + (rb + kc * 64 + j) * DM + h * 128;
            const float v0 = bf2f(vr[lane]), v1 = bf2f(vr[64 + lane]);
            a00 += pj0 * v0; a01 += pj0 * v1; a10 += pj1 * v0; a11 += pj1 * v1;
        }
    }
    const float i0 = 1.0f / l0, i1 = 1.0f / l1;
    O0[(size_t)m * DM + h * 128 + lane] = f2bf(a00 * i0); O0[(size_t)m * DM + h * 128 + 64 + lane] = f2bf(a01 * i0);
    O1[(size_t)m * DM + h * 128 + lane] = f2bf(a10 * i1); O1[(size_t)m * DM + h * 128 + 64 + lane] = f2bf(a11 * i1);
}
#ifndef REPEAT_MASK
#define REPEAT_MASK 0
#endif
#ifndef ATTN_V128
#define ATTN_V128 1
#endif
namespace pg8 {
#define PG8_LAS __attribute__((address_space(3)))
typedef short bf16x8 __attribute__((ext_vector_type(8)));
typedef float f32x4 __attribute__((ext_vector_type(4)));
typedef unsigned u32x4 __attribute__((ext_vector_type(4)));
constexpr int BM = 256, BK = 64, HALF = 128, HTB = HALF * BK * 2  , STAGE_BYTES = 8 * HTB, NXCD = 8, WGM = 8;

__host__ __device__ __forceinline__ int lds_byte(int r, int c) { const int st = (r >> 4) * 2 + (c >> 5), rr = r & 15, cc = c & 31, ob = rr * 64 + cc * 2; return st * 1024 + (ob ^ (((ob >> 9) & 1) << 5)); }
__host__ __device__ __forceinline__ void stage_rc(int b, int& R, int& C) { const int st = b / 1024, sb = b % 1024, swz = sb ^ (((sb >> 9) & 1) << 5); R = (st >> 1) * 16 + swz / 64; C = (st & 1) * 32 + (swz % 64) / 2; }
__host__ __device__ __forceinline__ int perm32(int rho) { const int n = rho >> 4, i = rho & 15; return 8 * (i >> 2) + 4 * n + (i & 3); }

struct Unit { int pm, pn, grp; };
struct Gemm {
    const char* A; const char* Bt; int nt, pad0;
    unsigned a_rs, a_c16; size_t a_kstep, a_tstep, a_gstep;
    unsigned b_rs, pad1; size_t b_tstep, b_gstep;
    __device__ __forceinline__ const char* abase(const Unit& u) const { return A + (size_t)u.grp * a_gstep + (size_t)u.pm * a_tstep; }
    __device__ __forceinline__ const char* bbase(const Unit& u) const { return Bt + (size_t)u.grp * b_gstep + (size_t)u.pn * b_tstep; }
};
__device__ __forceinline__ Gemm gemm_std(const void* A, int lda, const void* Bt, int ldb, int K) {
    Gemm g; g.A = (const char*)A; g.Bt = (const char*)Bt; g.nt = K / BK; g.pad0 = 0; g.a_rs = (unsigned)lda * 2u; g.a_c16 = 32u; g.a_kstep = BK * 2; g.a_tstep = (size_t)BM * lda * 2; g.a_gstep = 0;
    g.b_rs = (unsigned)ldb * 2u; g.pad1 = 0; g.b_tstep = (size_t)BM * ldb * 2; g.b_gstep = 0; return g;
}

struct Order {
    int nM, nN, nG, nwg, G, c, only;
    __device__ __forceinline__ void init(int nM_, int nN_, int nG_, int G_, int c_) { nM = nM_; nN = nN_; nG = nG_; nwg = nM * nN * nG; G = G_; c = c_; only = -1; }
    __device__ __forceinline__ bool next(int i, Unit& u) const {
        if (only >= 0) { if (i > 0) return false; i = only; }
        const long L = (long)i * G + c; if (L >= nwg) return false;
        int wgid = (int)L; { const int q = nwg / NXCD, r = nwg % NXCD, xcd = wgid % NXCD, off = wgid / NXCD; wgid = (xcd < r ? xcd * (q + 1) : r * (q + 1) + (xcd - r) * q) + off; }
        if (nG == 1) {
            const int nig = WGM * nN, gid = wgid / nig, fm = gid * WGM, gsz = (nM - fm) < WGM ? (nM - fm) : WGM;
            u.pm = fm + ((wgid % nig) % gsz); u.pn = (wgid % nig) / gsz; u.grp = 0;
        } else { const int per = nM * nN; u.grp = wgid / per; const int r2 = wgid % per; u.pm = r2 % nM; u.pn = r2 / nM; }
        return true;
    }
};

__device__ __forceinline__ unsigned cvt_pk_bf16(float lo, float hi) { unsigned r; asm volatile("v_cvt_pk_bf16_f32 %0, %1, %2" : "=v"(r) : "v"(lo), "v"(hi)); return r; }
__device__ __forceinline__ u32x4 pack8(const f32x4 a, const f32x4 b) { u32x4 w; w.x = cvt_pk_bf16(a[0], a[1]); w.y = cvt_pk_bf16(a[2], a[3]); w.z = cvt_pk_bf16(b[0], b[1]); w.w = cvt_pk_bf16(b[2], b[3]); return w; }
__device__ __forceinline__ void unpack8(const u32x4 w, f32x4& a, f32x4& b) {
    a[0] = __uint_as_float(w.x << 16); a[1] = __uint_as_float(w.x & 0xffff0000u); a[2] = __uint_as_float(w.y << 16); a[3] = __uint_as_float(w.y & 0xffff0000u);
    b[0] = __uint_as_float(w.z << 16); b[1] = __uint_as_float(w.z & 0xffff0000u); b[2] = __uint_as_float(w.w << 16); b[3] = __uint_as_float(w.w & 0xffff0000u); }
__device__ __forceinline__ float fsilu(float v) { return v * __builtin_amdgcn_rcpf(1.0f + __expf(-v)); }
__device__ __forceinline__ float fsigm(float v) { return __builtin_amdgcn_rcpf(1.0f + __expf(-v)); }
__device__ __forceinline__ f32x4 silu4(f32x4 v) { f32x4 o; o[0] = fsilu(v[0]); o[1] = fsilu(v[1]); o[2] = fsilu(v[2]); o[3] = fsilu(v[3]); return o; }
__device__ __forceinline__ f32x4 sigm4(f32x4 v) { f32x4 o; o[0] = fsigm(v[0]); o[1] = fsigm(v[1]); o[2] = fsigm(v[2]); o[3] = fsigm(v[3]); return o; }
__device__ __forceinline__ float fgelu(float v) { const float u = 0.7978845608028654f * (v + 0.044715f * v * v * v); const float e = __expf(2.0f * u); return 0.5f * v * (2.0f - 2.0f * __builtin_amdgcn_rcpf(e + 1.0f)); }
__device__ __forceinline__ f32x4 gelu4(f32x4 v) { f32x4 o; o[0] = fgelu(v[0]); o[1] = fgelu(v[1]); o[2] = fgelu(v[2]); o[3] = fgelu(v[3]); return o; }

template <class F> struct EpiRow8 {
    static constexpr bool PERM = true, AFTER_DRAIN = false;
    F f;
    __device__ __forceinline__ void operator()(const f32x4 (&acc)[2][2][4][2], const Unit& u, int wr, int wc, int fr, int fq) const {
#pragma unroll
        for (int ai = 0; ai < 2; ++ai)
#pragma unroll
            for (int m = 0; m < 4; ++m) { const int row = u.pm * BM + ai * HALF + wr * 64 + m * 16 + fr;
#pragma unroll
                for (int bj = 0; bj < 2; ++bj) { const int col0 = u.pn * BM + bj * HALF + wc * 32 + 8 * fq; f.apply(u, row, col0, acc[ai][bj][m][0], acc[ai][bj][m][1]); } }
    }
};
struct F_In0 { bf16_t* US; bf16_t* SZ;
    __device__ __forceinline__ void apply(const Unit&, int row, int col0, f32x4 v0, f32x4 v1) const {
        if (col0 < 1024) *(u32x4*)(US + us_off(col0 >> 4, row >> 4, (row & 15) * 16 + (col0 & 15))) = pack8(v0, v1);
        else *(u32x4*)(SZ + (size_t)row * DM + (col0 - 1024)) = pack8(silu4(v0), silu4(v1)); } };
struct F_SsmA { float* E;
    __device__ __forceinline__ void apply(const Unit& u, int row, int col0, f32x4 v0, f32x4 v1) const {
        if (col0 < 128) { float* p = E + ((size_t)u.grp * NTILE + row) * 128 + col0; *(f32x4*)p = v0; *(f32x4*)(p + 4) = v1; } } };
struct F_SsmB { const bf16_t* US; const float* dsk; bf16_t* YG;
    __device__ __forceinline__ void apply(const Unit& u, int row, int col0, f32x4 v0, f32x4 v1) const {
        const u32x4 uw = *(const u32x4*)(US + us_off(u.grp, row, col0)); f32x4 u0, u1; unpack8(uw, u0, u1);
        const float* d = dsk + u.grp * 16 + (col0 & 15); const f32x4 d0 = *(const f32x4*)d, d1 = *(const f32x4*)(d + 4);
        *(u32x4*)(YG + yg_off(u.grp, row, col0)) = pack8(gelu4(v0 + d0 * u0), gelu4(v1 + d1 * u1)); } };
struct F_Glu { const bf16_t* YG; const bf16_t* SZ; const float* bias; bf16_t* Y2;
    __device__ __forceinline__ void apply(const Unit&, int row, int col0, f32x4 v0, f32x4 v1) const {
        const u32x4 yw = *(const u32x4*)(YG + yg_off(col0 >> 4, row >> 4, (row & 15) * 16 + (col0 & 15))); f32x4 y0, y1; unpack8(yw, y0, y1);
        const u32x4 zw = *(const u32x4*)(SZ + (size_t)row * DM + col0); f32x4 z0, z1; unpack8(zw, z0, z1);
        const f32x4 b0 = *(const f32x4*)(bias + col0), b1 = *(const f32x4*)(bias + col0 + 4);
        *(u32x4*)(Y2 + (size_t)row * DM + col0) = pack8(y0 * sigm4(v0 + b0) * z0, y1 * sigm4(v1 + b1) * z1); } };
struct F_Plain { bf16_t* O;
    __device__ __forceinline__ void apply(const Unit&, int row, int col0, f32x4 v0, f32x4 v1) const { *(u32x4*)(O + (size_t)row * DM + col0) = pack8(v0, v1); } };
struct F_Split { bf16_t* Olo; bf16_t* Ohi; float sc_lo; int silu_hi;
    __device__ __forceinline__ void apply(const Unit&, int row, int col0, f32x4 v0, f32x4 v1) const {
        if (col0 < 1024) *(u32x4*)(Olo + (size_t)row * DM + col0) = pack8(v0 * sc_lo, v1 * sc_lo);
        else { if (silu_hi) { v0 = silu4(v0); v1 = silu4(v1); } *(u32x4*)(Ohi + (size_t)row * DM + (col0 - 1024)) = pack8(v0, v1); } } };

template <class Epi, bool ALIGN_EPI>
__device__ __forceinline__ void gemm_phase(PG8_LAS unsigned char* lds, const Gemm g, const Order& S, const Epi& E) {
    const int tid = threadIdx.x, wid = __builtin_amdgcn_readfirstlane(tid >> 6), lane = tid & 63, wr = wid >> 2, wc = wid & 3, fr = lane & 15, fq = lane >> 4;
    const int nt = g.nt;
    unsigned voffA[2], voffB[2];
#pragma unroll
    for (int i = 0; i < 2; ++i) { int R, C; stage_rc(tid * 16 + i * 8192, R, C); const int Rb = Epi::PERM ? ((R & ~31) + perm32(R & 31)) : R;
        voffA[i] = (unsigned)R * g.a_rs + (unsigned)(C >> 4) * g.a_c16 + (unsigned)(C & 15) * 2u; voffB[i] = (unsigned)Rb * g.b_rs + (unsigned)C * 2u; }
    const size_t kstepA = g.a_kstep, kstepB = (size_t)(BK * 2);
    const size_t hstepA = (size_t)HALF * g.a_rs, hstepB = (size_t)HALF * g.b_rs;
    const unsigned ldsw = (unsigned)wid * 1024u;
    const int aoff = lds_byte(wr * 64 + fr, fq * 8), boff = lds_byte(wc * 32 + fr, fq * 8);
#define PG8_SA(b, h) (((b) * 2 + (h)) * HTB)
#define PG8_SB(b, h) ((4 + (b) * 2 + (h)) * HTB)
#define PG8_STAGE(bufoff, gbase, voff) do { _Pragma("unroll") for (int _i = 0; _i < 2; ++_i) \
        __builtin_amdgcn_global_load_lds((const unsigned*)((const char*)(gbase) + (voff)[_i]), (PG8_LAS unsigned*)(lds + (bufoff) + ldsw + _i * 8192), 16, 0, 0); } while (0)
#define PG8_LDA(dst, b, h) do { _Pragma("unroll") for (int m = 0; m < 4; ++m) _Pragma("unroll") for (int k = 0; k < 2; ++k) dst[m][k] = *(const PG8_LAS bf16x8*)(lds + PG8_SA(b, h) + aoff + m * 2048 + k * 1024); } while (0)
#define PG8_LDB(dst, b, h) do { _Pragma("unroll") for (int n = 0; n < 2; ++n) _Pragma("unroll") for (int k = 0; k < 2; ++k) dst[n][k] = *(const PG8_LAS bf16x8*)(lds + PG8_SB(b, h) + boff + n * 2048 + k * 1024); } while (0)
#define PG8_MMA(ai, bj, At, Bt) do { __builtin_amdgcn_s_setprio(1); _Pragma("unroll") for (int m = 0; m < 4; ++m) _Pragma("unroll") for (int n = 0; n < 2; ++n) _Pragma("unroll") for (int k = 0; k < 2; ++k) \
        acc[ai][bj][m][n] = __builtin_amdgcn_mfma_f32_16x16x32_bf16(Bt[n][k], At[m][k], acc[ai][bj][m][n], 0, 0, 0); __builtin_amdgcn_s_setprio(0); } while (0)
#define PG8_WAIT_V(n) asm volatile("s_waitcnt vmcnt(" #n ")" ::: "memory")
#define PG8_WAIT_L(n) asm volatile("s_waitcnt lgkmcnt(" #n ")" ::: "memory")
#define PG8_BAR __builtin_amdgcn_s_barrier()
#define PG8_SCHED __builtin_amdgcn_sched_barrier(0)
    Unit cur, nxt; int ui = 0;
    if (!S.next(0, cur)) return;
    f32x4 acc[2][2][4][2];
#pragma unroll
    for (int a = 0; a < 2; ++a)
#pragma unroll
        for (int b = 0; b < 2; ++b)
#pragma unroll
            for (int m = 0; m < 4; ++m)
#pragma unroll
                for (int n = 0; n < 2; ++n) acc[a][b][m][n] = (f32x4){0.f, 0.f, 0.f, 0.f};
    bf16x8 At[4][2], B0[2][2], B1[2][2];
    const char* cA = g.abase(cur); const char* cB = g.bbase(cur);
    PG8_STAGE(PG8_SB(0, 0), cB, voffB); PG8_STAGE(PG8_SB(0, 1), cB + hstepB, voffB); PG8_STAGE(PG8_SA(0, 0), cA, voffA); PG8_STAGE(PG8_SA(0, 1), cA + hstepA, voffA);
    if (wr == 1) PG8_BAR;
    PG8_WAIT_V(2); PG8_BAR;
    PG8_STAGE(PG8_SB(1, 0), cB + kstepB, voffB); PG8_STAGE(PG8_SA(1, 0), cA + kstepA, voffA); PG8_STAGE(PG8_SB(1, 1), cB + hstepB + kstepB, voffB);
    PG8_WAIT_V(6); PG8_BAR;
    for (;;) {
        const bool has_next = S.next(ui + 1, nxt);
        const char* nA = has_next ? g.abase(nxt) : cA; const char* nB = has_next ? g.bbase(nxt) : cB;
        for (int t = 0; t < nt; t += 2) {
            const bool last = (t == nt - 2);
            const char* a1 = cA + (size_t)(t + 1) * kstepA;
            const char* a2 = last ? nA : cA + (size_t)(t + 2) * kstepA; const char* b2 = last ? nB : cB + (size_t)(t + 2) * kstepB;
            const char* a3 = a2 + kstepA; const char* b3 = b2 + kstepB;
            PG8_LDB(B0, 0, 0); PG8_LDB(B1, 0, 1); PG8_SCHED; PG8_LDA(At, 0, 0); PG8_STAGE(PG8_SA(1, 1), a1 + hstepA, voffA);
            PG8_WAIT_V(8); PG8_WAIT_L(0); PG8_BAR; PG8_MMA(0, 0, At, B0); PG8_MMA(0, 1, At, B1); PG8_BAR; PG8_SCHED;
            PG8_LDA(At, 0, 1); PG8_STAGE(PG8_SB(0, 0), b2, voffB); PG8_STAGE(PG8_SB(0, 1), b2 + hstepB, voffB); PG8_STAGE(PG8_SA(0, 0), a2, voffA);
            PG8_WAIT_V(8); PG8_WAIT_L(0); PG8_BAR; PG8_MMA(1, 0, At, B0); PG8_MMA(1, 1, At, B1); PG8_BAR; PG8_SCHED;
            PG8_LDB(B0, 1, 0); PG8_LDB(B1, 1, 1); PG8_SCHED; PG8_LDA(At, 1, 0); PG8_STAGE(PG8_SA(0, 1), a2 + hstepA, voffA);
            PG8_WAIT_V(8); PG8_WAIT_L(0); PG8_BAR; PG8_MMA(0, 0, At, B0); PG8_MMA(0, 1, At, B1); PG8_BAR; PG8_SCHED;
            PG8_LDA(At, 1, 1); PG8_STAGE(PG8_SB(1, 0), b3, voffB); PG8_STAGE(PG8_SB(1, 1), b3 + hstepB, voffB); PG8_STAGE(PG8_SA(1, 0), a3, voffA);
            PG8_WAIT_V(8); PG8_WAIT_L(0); PG8_BAR; PG8_MMA(1, 0, At, B0); PG8_MMA(1, 1, At, B1); PG8_BAR; PG8_SCHED;
        }
        if constexpr (ALIGN_EPI) { if (wr == 0) PG8_BAR; }
        E(acc, cur, wr, wc, fr, fq);
        if (!has_next) break;
#pragma unroll
        for (int a = 0; a < 2; ++a)
#pragma unroll
            for (int b = 0; b < 2; ++b)
#pragma unroll
                for (int m = 0; m < 4; ++m)
#pragma unroll
                    for (int n = 0; n < 2; ++n) acc[a][b][m][n] = (f32x4){0.f, 0.f, 0.f, 0.f};
        cur = nxt; cA = nA; cB = nB; ++ui;
        if constexpr (ALIGN_EPI) { if (wr == 1) PG8_BAR; }
    }
    PG8_WAIT_V(0);
    if constexpr (!ALIGN_EPI) { if (wr == 0) PG8_BAR; }
    PG8_BAR;
#undef PG8_SA
#undef PG8_SB
#undef PG8_STAGE
#undef PG8_LDA
#undef PG8_LDB
#undef PG8_MMA
#undef PG8_WAIT_V
#undef PG8_WAIT_L
#undef PG8_BAR
#undef PG8_SCHED
}
}

namespace attn_body {
using bf16 = bf16_t;
using bf16x8 = __attribute__((ext_vector_type(8))) short;
using s16x4 = __attribute__((ext_vector_type(4))) short;
using f32x16 = __attribute__((ext_vector_type(16))) float;
using u32x4 = __attribute__((ext_vector_type(4))) unsigned;
constexpr int SEQ = SEQL, D = 64, DMA = 1024;
constexpr int NW = 8, QBLK = 32, QB = QBLK * NW, KVBLK = 64, NQB = SEQ / QB;
__device__ __forceinline__ int crow(int r, int hi) { return (r & 3) + 8 * (r >> 2) + 4 * hi; }
#define SBAR() __builtin_amdgcn_sched_barrier(0)
__device__ __forceinline__ void cmask(f32x16& p0, f32x16& p1, int jb, int qrel, int hi) {
  const float NEG = -INFINITY; int kb = 64 * jb + 4 * hi;
  #pragma unroll
  for (int r = 0; r < 16; ++r) { int kv = kb + (r & 3) + 8 * (r >> 2); if (kv > qrel) p0[r] = NEG; if (kv + 32 > qrel) p1[r] = NEG; }
}
constexpr int NSLOT = 3, SLOTB = 8192;
constexpr int LDS_K = 0, LDS_V = NSLOT * SLOTB, LDS_WS = 2 * NSLOT * SLOTB, LDS_OST = LDS_WS + NW * 64 * 4, LDS_BYTES = LDS_OST + NW * 4096;
__device__ __forceinline__ void glds16(const void* gsrc, unsigned lds_dst) { unsigned keep;
  asm volatile("s_mov_b32 %0, m0\n\ts_mov_b32 m0, %2\n\ts_nop 0\n\tglobal_load_lds_dwordx4 %1, off\n\ts_mov_b32 m0, %0" : "=&s"(keep) : "v"(gsrc), "s"(lds_dst) : "memory"); }
__device__ __forceinline__ float max3f(float a, float b, float c) { float r; asm("v_max3_f32 %0, %1, %2, %3" : "=v"(r) : "v"(a), "v"(b), "v"(c)); return r; }
__device__ __forceinline__ float max2f(float a, float b) { float r; asm("v_max_f32_e32 %0, %1, %2" : "=v"(r) : "v"(a), "v"(b)); return r; }
__device__ __forceinline__ float fadd_s(float a, float b) { float r; asm("v_add_f32_e32 %0, %1, %2" : "=v"(r) : "v"(a), "v"(b)); return r; }
__device__ __forceinline__ float fsub_s(float a, float b) { float r; asm("v_sub_f32_e32 %0, %1, %2" : "=v"(r) : "v"(a), "v"(b)); return r; }
typedef float f32x2_t __attribute__((ext_vector_type(2))); typedef __bf16 bf16x2_t __attribute__((ext_vector_type(2)));
__device__ __forceinline__ unsigned cvtpk_s(float lo, float hi) { f32x2_t v = {lo, hi}; bf16x2_t b = __builtin_convertvector(v, bf16x2_t); return __builtin_bit_cast(unsigned, b); }
#define WAIT_BAR(N) asm volatile("s_waitcnt vmcnt(" #N ") lgkmcnt(0)\n\ts_barrier" ::: "memory")

__device__ __forceinline__ void qkt(f32x16& p0, f32x16& p1, const char* Kslot, const bf16x8* qr, const f32x16& negm, int r32, int hi) {
  const char* kb = Kslot + hi * 1024 + r32 * 16;
  #pragma unroll
  for (int d0 = 0; d0 < 4; ++d0) {
    const bf16x8 b0 = *reinterpret_cast<const bf16x8*>(kb + d0 * 2048);
    const bf16x8 b1 = *reinterpret_cast<const bf16x8*>(kb + d0 * 2048 + 512);
    if (d0 == 0) { p0 = __builtin_amdgcn_mfma_f32_32x32x16_bf16(b0, qr[0], negm, 0, 0, 0); p1 = __builtin_amdgcn_mfma_f32_32x32x16_bf16(b1, qr[0], negm, 0, 0, 0); }
    else { p0 = __builtin_amdgcn_mfma_f32_32x32x16_bf16(b0, qr[d0], p0, 0, 0, 0); p1 = __builtin_amdgcn_mfma_f32_32x32x16_bf16(b1, qr[d0], p1, 0, 0, 0); } }
}
typedef __attribute__((address_space(3))) const char* lds_cptr;
typedef short v4i16_t __attribute__((ext_vector_type(4)));
__device__ __forceinline__ void kload8(bf16x8* kf, lds_cptr kp) {
  kf[0] = *(const __attribute__((address_space(3))) bf16x8*)(kp);        kf[1] = *(const __attribute__((address_space(3))) bf16x8*)(kp + 512);
  kf[2] = *(const __attribute__((address_space(3))) bf16x8*)(kp + 2048); kf[3] = *(const __attribute__((address_space(3))) bf16x8*)(kp + 2560);
  kf[4] = *(const __attribute__((address_space(3))) bf16x8*)(kp + 4096); kf[5] = *(const __attribute__((address_space(3))) bf16x8*)(kp + 4608);
  kf[6] = *(const __attribute__((address_space(3))) bf16x8*)(kp + 6144); kf[7] = *(const __attribute__((address_space(3))) bf16x8*)(kp + 6656);
}
__device__ __forceinline__ void kload2(bf16x8* kf, lds_cptr kp, int j) { kf[2 * j] = *(const __attribute__((address_space(3))) bf16x8*)(kp + j * 2048); kf[2 * j + 1] = *(const __attribute__((address_space(3))) bf16x8*)(kp + j * 2048 + 512); }
__device__ __forceinline__ s16x4 vtr(lds_cptr p) { return __builtin_bit_cast(s16x4, __builtin_amdgcn_ds_read_tr16_b64_v4i16((__attribute__((address_space(3))) v4i16_t*)p)); }
__device__ __forceinline__ float rowmax(const f32x16& p0, const f32x16& p1) {
  float a = max3f(p0[0], p0[1], p1[0]), b = max3f(p0[2], p0[3], p1[1]); a = max3f(a, p1[2], p1[3]);
  #pragma unroll
  for (int r = 4; r < 16; r += 4) { a = max3f(a, p0[r], p0[r + 1]); b = max3f(b, p0[r + 2], p0[r + 3]); a = max3f(a, p1[r], p1[r + 1]); b = max3f(b, p1[r + 2], p1[r + 3]); }
  const float m = max2f(a, b);
  auto rr = __builtin_amdgcn_permlane32_swap(__float_as_uint(m), __float_as_uint(m), false, false);
  return max2f(__uint_as_float(rr[0]), __uint_as_float(rr[1]));
}
__device__ __forceinline__ void pv(f32x16* o, int vb, bf16x8 pa0, bf16x8 pa1, bf16x8 pa2, bf16x8 pa3) {
  #pragma unroll
  for (int d0 = 0; d0 < 2; ++d0) { s16x4 lo[4], hi[4];
    #pragma unroll
    for (int ks = 0; ks < 4; ++ks) {
      asm volatile("ds_read_b64_tr_b16 %0,%1 offset:%c2" : "=&v"(lo[ks]) : "v"(vb), "i"(d0 * 4096 + ks * 1024) : "memory");
      asm volatile("ds_read_b64_tr_b16 %0,%1 offset:%c2" : "=&v"(hi[ks]) : "v"(vb), "i"(d0 * 4096 + ks * 1024 + 512) : "memory"); }
    asm volatile("s_waitcnt lgkmcnt(0)" ::: "memory"); SBAR();
    #define PK(k) (bf16x8){lo[k][0], lo[k][1], lo[k][2], lo[k][3], hi[k][0], hi[k][1], hi[k][2], hi[k][3]}
    o[d0] = __builtin_amdgcn_mfma_f32_32x32x16_bf16(pa0, PK(0), o[d0], 0, 0, 0);
    o[d0] = __builtin_amdgcn_mfma_f32_32x32x16_bf16(pa1, PK(1), o[d0], 0, 0, 0);
    o[d0] = __builtin_amdgcn_mfma_f32_32x32x16_bf16(pa2, PK(2), o[d0], 0, 0, 0);
    o[d0] = __builtin_amdgcn_mfma_f32_32x32x16_bf16(pa3, PK(3), o[d0], 0, 0, 0);
    #undef PK
  }
}
#define ATTN_STORE16(p, v) (*(u32x4*)(p) = (v))
template <int THRL> __device__ __forceinline__ void attn_unit(int b, int hq, int hv, int qb, const bf16* Q, const bf16* __restrict__ K, const bf16* __restrict__ V, bf16* O, char* shm) {
  const int tid = threadIdx.x, lane = tid & 63, r32 = lane & 31, hi = lane >> 5; const int wid = __builtin_amdgcn_readfirstlane(tid >> 6);
  const long rowbase = (long)b * SEQ; const int q0 = qb * QB;
  const bf16* Qw = Q + (rowbase + q0 + wid * QBLK) * DMA + hq * D;
  const bf16* Kh = K + rowbase * DMA + hq * D, *Vh = V + rowbase * DMA + hv * D;
  const unsigned lds0 = (unsigned)(uintptr_t)shm;
  float* wsf = (float*)(shm + LDS_WS) + wid * 64;
  const bf16* ksrc = Kh + (long)lane * DMA + wid * 8;
  const bf16* vsrc = Vh + (long)(16 * (wid & 3) + (lane >> 2)) * DMA + (wid >> 2) * 32 + (lane & 3) * 8;
  const unsigned kdst = lds0 + LDS_K + wid * 1024, vdst = lds0 + LDS_V + wid * 1024;
  #define DMA_K(t, slot) glds16(ksrc + (long)(t) * KVBLK * DMA, (unsigned)__builtin_amdgcn_readfirstlane(kdst + (slot)))
  #define DMA_V(t, slot) glds16(vsrc + (long)(t) * KVBLK * DMA, (unsigned)__builtin_amdgcn_readfirstlane(vdst + (slot)))
  const int vb0 = (int)(lds0 + LDS_V) + ((lane >> 4) & 1) * 32 + (lane & 3) * 8 + (4 * hi + ((lane & 15) >> 2)) * 64;
  const char* Kbase = shm + LDS_K; bf16x8 kf[8];
  const lds_cptr shm3 = (lds_cptr)shm; const lds_cptr kp0 = shm3 + LDS_K + hi * 1024 + r32 * 16; const lds_cptr vp0 = shm3 + LDS_V + ((lane >> 4) & 1) * 32 + (lane & 3) * 8 + (4 * hi + ((lane & 15) >> 2)) * 64;
  const int NT = (q0 + QB) / KVBLK;
  DMA_K(0, 0); DMA_V(0, 0); DMA_K(1, SLOTB);
  bf16x8 qr[4];
  #pragma unroll
  for (int d0 = 0; d0 < 4; ++d0) qr[d0] = *reinterpret_cast<const bf16x8*>(&Qw[(long)r32 * DMA + d0 * 16 + hi * 8]);
  float mhat = 0.f, l_reg = 0.f; f32x16 o[2]; o[0] = f32x16{}; o[1] = f32x16{}; f32x16 negm = f32x16{}; asm volatile("" : "+v"(negm));
  const int qrel = wid * QBLK + r32;
  #define CMASK(P0, P1, t) do { int jb_ = (t) - (NT - 4); if (jb_ >= 0) cmask(P0, P1, jb_, qrel, hi); } while (0)
  bool resc = false;
  #define START(P0, P1) do { const float rm = rowmax(P0, P1); resc = false; \
    { const float dl = rm; mhat = fadd_s(mhat, dl); \
      _Pragma("unroll") for (int r = 0; r < 16; ++r) { P0[r] = fsub_s(P0[r], dl); P1[r] = fsub_s(P1[r], dl); } \
      _Pragma("unroll") for (int r = 0; r < 16; ++r) negm[r] = -mhat; asm volatile("" : "+v"(negm)); } \
    _Pragma("unroll") for (int r = 0; r < 16; ++r) P0[r] = __builtin_amdgcn_exp2f(P0[r]); } while (0)
  #define RESC() do { if (resc) { asm volatile("s_waitcnt lgkmcnt(0)" ::: "memory"); \
      _Pragma("unroll") for (int d_ = 0; d_ < 2; ++d_) _Pragma("unroll") for (int r = 0; r < 16; ++r) o[d_][r] *= wsf[crow(r, hi)]; } } while (0)
  f32x16 pA0, pA1, pB0, pB1;
  int sl_prev = 0, sl_cur = 0, sl_next = SLOTB;
  #define ROT() do { sl_prev = sl_cur; sl_cur = sl_next; sl_next = (sl_next == (NSLOT - 1) * SLOTB) ? 0 : sl_next + SLOTB; } while (0)
  DMA_K(2, 2 * SLOTB);
  WAIT_BAR(3);
  qkt(pA0, pA1, Kbase, qr, negm, r32, hi); asm volatile("s_nop 15\n\ts_nop 7" : "+v"(pA0), "+v"(pA1)); CMASK(pA0, pA1, 0);
  START(pA0, pA1);
  _Pragma("unroll") for (int r = 0; r < 16; ++r) pA1[r] = __builtin_amdgcn_exp2f(pA1[r]);
  WAIT_BAR(0);
  DMA_K(3, 0); DMA_V(1, SLOTB);
  ROT();
  kload8(kf, kp0 + sl_cur);
  WAIT_BAR(2);
  s16x4 vlo[8], vhi[8]; u32x4 pw0, pw1, pw2, pw3;
  #define PKW(P, B) cvtpk_s(P[B], P[B + 1])
  #define PAF(k) __builtin_bit_cast(bf16x8, pw##k)
  #define VFR(i) (bf16x8){vlo[i][0], vlo[i][1], vlo[i][2], vlo[i][3], vhi[i][0], vhi[i][1], vhi[i][2], vhi[i][3]}
  #define PIN(x) asm volatile("" : "+v"(x))
  #define MX3(a, b, c) __builtin_fmaxf(__builtin_fmaxf((a), (b)), (c))
  #define GAPA(MF, A0, A1, A2, A3, W0, W1, PW) do { MF; sacc += A0; sacc += A1; sacc += A2; sacc += A3; PIN(sacc); W0; W1; PIN(PW); SBAR(); } while (0)
  #define EX(v) __builtin_amdgcn_exp2f(v)
  #define GAPB(MF, X, B) do { MF; X[B] = EX(X[B]); X[B + 1] = EX(X[B + 1]); X[B + 2] = EX(X[B + 2]); X[B + 3] = EX(X[B + 3]); PIN(X); SBAR(); } while (0)
  #define VRD(i) do { vlo[i] = vtr(vp_ + (((i) >> 2) * 4096 + ((i) & 3) * 1024)); vhi[i] = vtr(vp_ + (((i) >> 2) * 4096 + ((i) & 3) * 1024 + 512)); } while (0)
  #define KRD(G, j) do { if (G) { kload2(kf, kp0 + sl_next, j); SBAR(); } } while (0)
  #define STEP(C0, C1, P0, P1, t, GK, GV, GL) do { SBAR(); \
    const lds_cptr vp_ = vp0 + sl_prev; \
    VRD(0); SBAR(); float sacc = (P0[0] + P0[1]); \
    GAPA(C0 = __builtin_amdgcn_mfma_f32_32x32x16_bf16(kf[0], qr[0], negm, 0, 0, 0), P0[2], P0[3], P0[4], P0[5],     pw0[0] = PKW(P0, 0), pw0[1] = PKW(P0, 2), pw0); \
    VRD(4); SBAR(); GAPA(C1 = __builtin_amdgcn_mfma_f32_32x32x16_bf16(kf[1], qr[0], negm, 0, 0, 0), P0[6], P0[7], P0[8], P0[9],     pw0[2] = PKW(P0, 4), pw0[3] = PKW(P0, 6), pw0); \
    VRD(1); SBAR(); GAPA(C0 = __builtin_amdgcn_mfma_f32_32x32x16_bf16(kf[2], qr[1], C0, 0, 0, 0),   P0[10], P0[11], P0[12], P0[13], pw1[0] = PKW(P0, 8), pw1[1] = PKW(P0, 10), pw1); \
    VRD(5); SBAR(); GAPA(C1 = __builtin_amdgcn_mfma_f32_32x32x16_bf16(kf[3], qr[1], C1, 0, 0, 0),   P0[14], P0[15], P1[0], P1[1],   pw1[2] = PKW(P0, 12), pw1[3] = PKW(P0, 14), pw1); \
    VRD(2); SBAR(); GAPA(C0 = __builtin_amdgcn_mfma_f32_32x32x16_bf16(kf[4], qr[2], C0, 0, 0, 0),   P1[2], P1[3], P1[4], P1[5],     pw2[0] = PKW(P1, 0), pw2[1] = PKW(P1, 2), pw2); \
    VRD(6); SBAR(); GAPA(C1 = __builtin_amdgcn_mfma_f32_32x32x16_bf16(kf[5], qr[2], C1, 0, 0, 0),   P1[6], P1[7], P1[8], P1[9],     pw2[2] = PKW(P1, 4), pw2[3] = PKW(P1, 6), pw2); \
    VRD(3); SBAR(); GAPA(C0 = __builtin_amdgcn_mfma_f32_32x32x16_bf16(kf[6], qr[3], C0, 0, 0, 0),   P1[10], P1[11], P1[12], P1[13], pw3[0] = PKW(P1, 8), pw3[1] = PKW(P1, 10), pw3); \
    VRD(7); SBAR(); GAPA(C1 = __builtin_amdgcn_mfma_f32_32x32x16_bf16(kf[7], qr[3], C1, 0, 0, 0),   P1[14], P1[15], 0.f, 0.f,       pw3[2] = PKW(P1, 12), pw3[3] = PKW(P1, 14), pw3); \
    l_reg += sacc; \
    if (GK) { DMA_K((t) + 3, sl_cur); } if (GV) { DMA_V((t) + 1, sl_next); } \
    CMASK(C0, C1, t); \
    { float a = MX3(C0[0], C0[1], C1[0]), b = MX3(C0[2], C0[3], C1[1]); a = MX3(a, C1[2], C1[3]); \
      _Pragma("unroll") for (int r = 4; r < 16; r += 4) { a = MX3(a, C0[r], C0[r + 1]); b = MX3(b, C0[r + 2], C0[r + 3]); a = MX3(a, C1[r], C1[r + 1]); b = MX3(b, C1[r + 2], C1[r + 3]); } \
      float rm = __builtin_fmaxf(a, b); { auto rr = __builtin_amdgcn_permlane32_swap(__float_as_uint(rm), __float_as_uint(rm), false, false); rm = __builtin_fmaxf(__uint_as_float(rr[0]), __uint_as_float(rr[1])); } \
      resc = false; \
      if (__builtin_expect(__any(rm > (float)THRL), 0)) { const float dl = __builtin_fmaxf(rm, 0.f); mhat += dl; \
        _Pragma("unroll") for (int r = 0; r < 16; ++r) { C0[r] -= dl; C1[r] -= dl; } \
        _Pragma("unroll") for (int r = 0; r < 16; ++r) negm[r] = -mhat; asm volatile("" : "+v"(negm)); \
        const float f = __builtin_amdgcn_exp2f(-dl); l_reg *= f; if (hi == 0) wsf[r32] = f; resc = true; } } \
    SBAR(); \
    GAPB(o[0] = __builtin_amdgcn_mfma_f32_32x32x16_bf16(PAF(0), VFR(0), o[0], 0, 0, 0), C0, 0); \
    GAPB(o[1] = __builtin_amdgcn_mfma_f32_32x32x16_bf16(PAF(0), VFR(4), o[1], 0, 0, 0), C0, 4); \
    KRD(GL, 0); GAPB(o[0] = __builtin_amdgcn_mfma_f32_32x32x16_bf16(PAF(1), VFR(1), o[0], 0, 0, 0), C0, 8); \
    KRD(GL, 1); GAPB(o[1] = __builtin_amdgcn_mfma_f32_32x32x16_bf16(PAF(1), VFR(5), o[1], 0, 0, 0), C0, 12); \
    KRD(GL, 2); GAPB(o[0] = __builtin_amdgcn_mfma_f32_32x32x16_bf16(PAF(2), VFR(2), o[0], 0, 0, 0), C1, 0); \
    KRD(GL, 3); GAPB(o[1] = __builtin_amdgcn_mfma_f32_32x32x16_bf16(PAF(2), VFR(6), o[1], 0, 0, 0), C1, 4); \
    GAPB(o[0] = __builtin_amdgcn_mfma_f32_32x32x16_bf16(PAF(3), VFR(3), o[0], 0, 0, 0), C1, 8); \
    GAPB(o[1] = __builtin_amdgcn_mfma_f32_32x32x16_bf16(PAF(3), VFR(7), o[1], 0, 0, 0), C1, 12); \
    } while (0)
  int t = 1;
  #undef CMASK
  #define CMASK(P0, P1, t) do {} while (0)
  for (; t + 5 < NT; t += 2) {
    STEP(pB0, pB1, pA0, pA1, t, true, true, true);     WAIT_BAR(2); RESC(); ROT();
    STEP(pA0, pA1, pB0, pB1, t + 1, true, true, true); WAIT_BAR(2); RESC(); ROT();
  }
  #undef CMASK
  #define CMASK(P0, P1, t) do { int jb_ = (t) - (NT - 4); if (jb_ >= 0) cmask(P0, P1, jb_, qrel, hi); } while (0)
  #define ENDW(tt) do { if ((tt) + 3 < NT) { WAIT_BAR(2); } else if ((tt) + 2 < NT) { WAIT_BAR(1); } else { WAIT_BAR(0); } } while (0)
  for (; t + 1 < NT; t += 2) {
    STEP(pB0, pB1, pA0, pA1, t, (t + 3 < NT), (t + 1 < NT), (t + 1 < NT));         ENDW(t);     RESC(); ROT();
    STEP(pA0, pA1, pB0, pB1, t + 1, (t + 4 < NT), (t + 2 < NT), (t + 2 < NT));     ENDW(t + 1); RESC(); ROT();
  }
  STEP(pB0, pB1, pA0, pA1, NT - 1, false, false, false); RESC();
  { float sacc = pB0[0] + pB0[1]; _Pragma("unroll") for (int r = 2; r < 16; ++r) sacc += pB0[r]; _Pragma("unroll") for (int r = 0; r < 16; ++r) sacc += pB1[r]; l_reg += sacc;
    pw0 = (u32x4){PKW(pB0, 0), PKW(pB0, 2), PKW(pB0, 4), PKW(pB0, 6)}; pw1 = (u32x4){PKW(pB0, 8), PKW(pB0, 10), PKW(pB0, 12), PKW(pB0, 14)}; pw2 = (u32x4){PKW(pB1, 0), PKW(pB1, 2), PKW(pB1, 4), PKW(pB1, 6)}; pw3 = (u32x4){PKW(pB1, 8), PKW(pB1, 10), PKW(pB1, 12), PKW(pB1, 14)};
    SBAR(); pv(o, vb0 + sl_cur, PAF(0), PAF(1), PAF(2), PAF(3)); }
  #undef PKW
  #undef PAF
  #undef VFR
  #undef PIN
  #undef MX3
  #undef GAPA
  #undef GAPB
  #undef EX
  #undef VRD
  #undef KRD
  #undef STEP
  #undef ENDW
  { auto rr = __builtin_amdgcn_permlane32_swap(__float_as_uint(l_reg), __float_as_uint(l_reg), false, false); l_reg = __uint_as_float(rr[0]) + __uint_as_float(rr[1]); }
  if (hi == 0) wsf[32 + r32] = l_reg; asm volatile("s_waitcnt lgkmcnt(0)" ::: "memory");
  float rli[16];
  #pragma unroll
  for (int r = 0; r < 16; ++r) rli[r] = __builtin_amdgcn_rcpf(wsf[32 + crow(r, hi)]);
  bf16* Ow = O + (rowbase + q0 + wid * QBLK) * DMA + hv * D;
  { bf16* stg = (bf16*)(shm + LDS_OST) + wid * 2048;
    #pragma unroll
    for (int r = 0; r < 16; ++r) { const int orow = crow(r, hi);
      #pragma unroll
      for (int d0 = 0; d0 < 2; ++d0) stg[orow * 64 + d0 * 32 + r32] = f2bf(o[d0][r] * rli[r]); }
    asm volatile("s_waitcnt lgkmcnt(0)" ::: "memory");
    #pragma unroll
    for (int i = 0; i < 4; ++i) { const int row = i * 8 + (lane >> 3), ch = lane & 7; const u32x4 v = *(const u32x4*)(stg + row * 64 + ch * 8); ATTN_STORE16(Ow + (long)row * DMA + ch * 8, v); } }
  asm volatile("s_waitcnt lgkmcnt(0)\n\ts_barrier" ::: "memory");
  #undef DMA_K
  #undef DMA_V
  #undef CMASK
  #undef START
  #undef RESC
  #undef ROT
}
constexpr int ATTN_LDS_BYTES = LDS_BYTES;
#undef SBAR
#undef WAIT_BAR
}

namespace attn3 {
using namespace attn_body;
constexpr int KSLOT = 8192, VSLOT = 16384;
constexpr int L_K = 0, L_V = NSLOT * KSLOT, L_WS = L_V + NSLOT * VSLOT, L_OST = L_WS + NW * 64 * 4, L_BYTES = L_OST + NW * 4096;
#define SBAR() __builtin_amdgcn_sched_barrier(0)
#define WAIT_BAR(N) asm volatile("s_waitcnt vmcnt(" #N ") lgkmcnt(0)\n\ts_barrier" ::: "memory")
template <int THRL> __device__ __forceinline__ void attn_unit(int b, int hq, int h, int qb, const bf16* Q, const bf16* __restrict__ K, const bf16* __restrict__ V, bf16* O, char* shm) {
  const int tid = threadIdx.x, lane = tid & 63, r32 = lane & 31, hi = lane >> 5; const int wid = __builtin_amdgcn_readfirstlane(tid >> 6);
  const long rowbase = (long)b * SEQ; const int q0 = qb * QB;
  const bf16* Qw = Q + (rowbase + q0 + wid * QBLK) * DMA + hq * D;
  const bf16* Kh = K + rowbase * DMA + hq * D, *Vh = V + rowbase * DMA + h * 128;
  const unsigned lds0 = (unsigned)(uintptr_t)shm;
  float* wsf = (float*)(shm + L_WS) + wid * 64;
  const bf16* ksrc = Kh + (long)lane * DMA + wid * 8;
  const bf16* vsrc = Vh + (long)(16 * (wid & 3) + (lane >> 2)) * DMA + (wid >> 2) * 32 + (lane & 3) * 8;
  const unsigned kdst = lds0 + L_K + wid * 1024, vdst = lds0 + L_V + wid * 1024;
  #define DMA_K(t, si) glds16(ksrc + (long)(t) * KVBLK * DMA, (unsigned)__builtin_amdgcn_readfirstlane(kdst + (si) * KSLOT))
  #define DMA_V(t, si) do { glds16(vsrc + (long)(t) * KVBLK * DMA, (unsigned)__builtin_amdgcn_readfirstlane(vdst + (si) * VSLOT)); \
                            glds16(vsrc + (long)(t) * KVBLK * DMA + 64, (unsigned)__builtin_amdgcn_readfirstlane(vdst + (si) * VSLOT + 8192)); } while (0)
  const int vb0 = (int)(lds0 + L_V) + ((lane >> 4) & 1) * 32 + (lane & 3) * 8 + (4 * hi + ((lane & 15) >> 2)) * 64;
  const char* Kbase = shm + L_K; bf16x8 kf[8];
  const lds_cptr shm3 = (lds_cptr)shm; const lds_cptr kp0 = shm3 + L_K + hi * 1024 + r32 * 16; const lds_cptr vp0 = shm3 + L_V + ((lane >> 4) & 1) * 32 + (lane & 3) * 8 + (4 * hi + ((lane & 15) >> 2)) * 64;
  const int NT = (q0 + QB) / KVBLK;
  DMA_K(0, 0); DMA_V(0, 0); DMA_K(1, 1);
  bf16x8 qr[4];
  #pragma unroll
  for (int d0 = 0; d0 < 4; ++d0) qr[d0] = *reinterpret_cast<const bf16x8*>(&Qw[(long)r32 * DMA + d0 * 16 + hi * 8]);
  float mhat = 0.f, l_reg = 0.f; f32x16 o[4]; o[0] = f32x16{}; o[1] = f32x16{}; o[2] = f32x16{}; o[3] = f32x16{}; f32x16 negm = f32x16{}; asm volatile("" : "+v"(negm));
  const int qrel = wid * QBLK + r32;
  #define CMASK(P0, P1, t) do { int jb_ = (t) - (NT - 4); if (jb_ >= 0) cmask(P0, P1, jb_, qrel, hi); } while (0)
  bool resc = false;
  #define RESC() do { if (resc) { asm volatile("s_waitcnt lgkmcnt(0)" ::: "memory"); \
      _Pragma("unroll") for (int d_ = 0; d_ < 4; ++d_) _Pragma("unroll") for (int r = 0; r < 16; ++r) o[d_][r] *= wsf[crow(r, hi)]; } } while (0)
  f32x16 C0, C1;
  int s_prev = 0, s_cur = 0, s_next = 1;
  #define ROT() do { s_prev = s_cur; s_cur = s_next; s_next = (s_next == NSLOT - 1) ? 0 : s_next + 1; } while (0)
  DMA_K(2, 2);
  WAIT_BAR(4);
  u32x4 pwA0, pwA1, pwA2, pwA3, pwB0, pwB1, pwB2, pwB3;
  #define PKW(P, B) cvtpk_s(P[B], P[B + 1])
  qkt(C0, C1, Kbase, qr, negm, r32, hi); asm volatile("s_nop 15\n\ts_nop 7" : "+v"(C0), "+v"(C1)); CMASK(C0, C1, 0);
  { const float rm = rowmax(C0, C1); mhat = fadd_s(mhat, rm);
    _Pragma("unroll") for (int r = 0; r < 16; ++r) { C0[r] = fsub_s(C0[r], rm); C1[r] = fsub_s(C1[r], rm); }
    _Pragma("unroll") for (int r = 0; r < 16; ++r) negm[r] = -mhat; asm volatile("" : "+v"(negm));
    float sacc = 0.f;
    _Pragma("unroll") for (int r = 0; r < 16; ++r) { C0[r] = __builtin_amdgcn_exp2f(C0[r]); C1[r] = __builtin_amdgcn_exp2f(C1[r]); }
    _Pragma("unroll") for (int r = 0; r < 16; ++r) sacc += C0[r] + C1[r];
    l_reg = sacc;
    pwA0 = (u32x4){PKW(C0, 0), PKW(C0, 2), PKW(C0, 4), PKW(C0, 6)}; pwA1 = (u32x4){PKW(C0, 8), PKW(C0, 10), PKW(C0, 12), PKW(C0, 14)};
    pwA2 = (u32x4){PKW(C1, 0), PKW(C1, 2), PKW(C1, 4), PKW(C1, 6)}; pwA3 = (u32x4){PKW(C1, 8), PKW(C1, 10), PKW(C1, 12), PKW(C1, 14)}; }
  WAIT_BAR(0);
  DMA_K(3, 0); DMA_V(1, 1);
  ROT();
  kload8(kf, kp0 + s_cur * KSLOT);
  WAIT_BAR(3);
  s16x4 vlo[8], vhi[8];
  #define PAF(w) __builtin_bit_cast(bf16x8, w)
  #define VFR(i) (bf16x8){vlo[i][0], vlo[i][1], vlo[i][2], vlo[i][3], vhi[i][0], vhi[i][1], vhi[i][2], vhi[i][3]}
  #define PIN(x) asm volatile("" : "+v"(x))
  #define MX3(a, b, c) __builtin_fmaxf(__builtin_fmaxf((a), (b)), (c))
  #define EX(v) __builtin_amdgcn_exp2f(v)
  #define VRD(s, f) do { vlo[s] = vtr(vp_ + (((f) >> 2) * 4096 + ((f) & 3) * 1024)); vhi[s] = vtr(vp_ + (((f) >> 2) * 4096 + ((f) & 3) * 1024 + 512)); } while (0)
  #define KRD(G, j) do { if (G) { kload2(kf, kp0 + s_next * KSLOT, j); SBAR(); } } while (0)
  #define GAPB(MF, X, B, PWW) do { MF; X[B] = EX(X[B]); X[B + 1] = EX(X[B + 1]); sacc += X[B]; sacc += X[B + 1]; PIN(sacc); PWW = PKW(X, B); PIN(PWW); SBAR(); } while (0)
  #define MFQ(a, b, c) __builtin_amdgcn_mfma_f32_32x32x16_bf16(a, b, c, 0, 0, 0)
  #define STEP(PP0, PP1, PP2, PP3, PN0, PN1, PN2, PN3, t, GK, GV, GL) do { SBAR(); \
    const lds_cptr vp_ = vp0 + s_prev * VSLOT; \
    VRD(0, 0); SBAR(); C0 = MFQ(kf[0], qr[0], negm); SBAR(); \
    VRD(4, 4); SBAR(); C1 = MFQ(kf[1], qr[0], negm); SBAR(); \
    VRD(1, 1); SBAR(); C0 = MFQ(kf[2], qr[1], C0); SBAR(); \
    VRD(5, 5); SBAR(); C1 = MFQ(kf[3], qr[1], C1); SBAR(); \
    VRD(2, 2); SBAR(); C0 = MFQ(kf[4], qr[2], C0); SBAR(); \
    VRD(6, 6); SBAR(); C1 = MFQ(kf[5], qr[2], C1); SBAR(); \
    VRD(3, 3); SBAR(); C0 = MFQ(kf[6], qr[3], C0); SBAR(); \
    VRD(7, 7); SBAR(); C1 = MFQ(kf[7], qr[3], C1); SBAR(); \
    if (GK) { DMA_K((t) + 3, s_cur); } if (GV) { DMA_V((t) + 1, s_next); } \
    CMASK(C0, C1, t); \
    { float a = MX3(C0[0], C0[1], C1[0]), b = MX3(C0[2], C0[3], C1[1]); a = MX3(a, C1[2], C1[3]); \
      _Pragma("unroll") for (int r = 4; r < 16; r += 4) { a = MX3(a, C0[r], C0[r + 1]); b = MX3(b, C0[r + 2], C0[r + 3]); a = MX3(a, C1[r], C1[r + 1]); b = MX3(b, C1[r + 2], C1[r + 3]); } \
      float rm = __builtin_fmaxf(a, b); { auto rr = __builtin_amdgcn_permlane32_swap(__float_as_uint(rm), __float_as_uint(rm), false, false); rm = __builtin_fmaxf(__uint_as_float(rr[0]), __uint_as_float(rr[1])); } \
      resc = false; \
      if (__builtin_expect(__any(rm > (float)THRL), 0)) { const float dl = __builtin_fmaxf(rm, 0.f); mhat += dl; \
        _Pragma("unroll") for (int r = 0; r < 16; ++r) { C0[r] -= dl; C1[r] -= dl; } \
        _Pragma("unroll") for (int r = 0; r < 16; ++r) negm[r] = -mhat; asm volatile("" : "+v"(negm)); \
        const float f = __builtin_amdgcn_exp2f(-dl); l_reg *= f; if (hi == 0) wsf[r32] = f; resc = true; } } \
    SBAR(); float sacc = 0.f; \
    GAPB(o[0] = MFQ(PAF(PP0), VFR(0), o[0]), C0, 0,  PN0[0]); VRD(0, 8);  SBAR(); \
    GAPB(o[1] = MFQ(PAF(PP0), VFR(4), o[1]), C0, 2,  PN0[1]); VRD(4, 12); SBAR(); \
    GAPB(o[0] = MFQ(PAF(PP1), VFR(1), o[0]), C0, 4,  PN0[2]); VRD(1, 9);  SBAR(); \
    GAPB(o[1] = MFQ(PAF(PP1), VFR(5), o[1]), C0, 6,  PN0[3]); VRD(5, 13); SBAR(); \
    GAPB(o[0] = MFQ(PAF(PP2), VFR(2), o[0]), C0, 8,  PN1[0]); VRD(2, 10); SBAR(); \
    GAPB(o[1] = MFQ(PAF(PP2), VFR(6), o[1]), C0, 10, PN1[1]); VRD(6, 14); SBAR(); \
    GAPB(o[0] = MFQ(PAF(PP3), VFR(3), o[0]), C0, 12, PN1[2]); VRD(3, 11); SBAR(); \
    GAPB(o[1] = MFQ(PAF(PP3), VFR(7), o[1]), C0, 14, PN1[3]); VRD(7, 15); SBAR(); \
    GAPB(o[2] = MFQ(PAF(PP0), VFR(0), o[2]), C1, 0,  PN2[0]); \
    GAPB(o[3] = MFQ(PAF(PP0), VFR(4), o[3]), C1, 2,  PN2[1]); \
    KRD(GL, 0); GAPB(o[2] = MFQ(PAF(PP1), VFR(1), o[2]), C1, 4,  PN2[2]); \
    KRD(GL, 1); GAPB(o[3] = MFQ(PAF(PP1), VFR(5), o[3]), C1, 6,  PN2[3]); \
    KRD(GL, 2); GAPB(o[2] = MFQ(PAF(PP2), VFR(2), o[2]), C1, 8,  PN3[0]); \
    KRD(GL, 3); GAPB(o[3] = MFQ(PAF(PP2), VFR(6), o[3]), C1, 10, PN3[1]); \
    GAPB(o[2] = MFQ(PAF(PP3), VFR(3), o[2]), C1, 12, PN3[2]); \
    GAPB(o[3] = MFQ(PAF(PP3), VFR(7), o[3]), C1, 14, PN3[3]); \
    l_reg += sacc; \
    } while (0)
  #define STEP_AB(t, GK, GV, GL) STEP(pwA0, pwA1, pwA2, pwA3, pwB0, pwB1, pwB2, pwB3, t, GK, GV, GL)
  #define STEP_BA(t, GK, GV, GL) STEP(pwB0, pwB1, pwB2, pwB3, pwA0, pwA1, pwA2, pwA3, t, GK, GV, GL)
  int t = 1;
  #undef CMASK
  #define CMASK(P0, P1, t) do {} while (0)
  for (; t + 5 < NT; t += 2) {
    STEP_AB(t, true, true, true);     WAIT_BAR(3); RESC(); ROT();
    STEP_BA(t + 1, true, true, true); WAIT_BAR(3); RESC(); ROT();
  }
  #undef CMASK
  #define CMASK(P0, P1, t) do { int jb_ = (t) - (NT - 4); if (jb_ >= 0) cmask(P0, P1, jb_, qrel, hi); } while (0)
  #define ENDW(tt) do { if ((tt) + 3 < NT) { WAIT_BAR(3); } else if ((tt) + 2 < NT) { WAIT_BAR(2); } else { WAIT_BAR(0); } } while (0)
  for (; t + 1 < NT; t += 2) {
    STEP_AB(t, (t + 3 < NT), (t + 1 < NT), (t + 1 < NT));         ENDW(t);     RESC(); ROT();
    STEP_BA(t + 1, (t + 4 < NT), (t + 2 < NT), (t + 2 < NT));     ENDW(t + 1); RESC(); ROT();
  }
  STEP_AB(NT - 1, false, false, false); RESC();
  { SBAR();
    const int vb = vb0 + s_cur * VSLOT;
    #pragma unroll
    for (int d0 = 0; d0 < 4; ++d0) { s16x4 lo[4], hh[4];
      #pragma unroll
      for (int ks = 0; ks < 4; ++ks) {
        asm volatile("ds_read_b64_tr_b16 %0,%1 offset:%c2" : "=&v"(lo[ks]) : "v"(vb), "i"(d0 * 4096 + ks * 1024) : "memory");
        asm volatile("ds_read_b64_tr_b16 %0,%1 offset:%c2" : "=&v"(hh[ks]) : "v"(vb), "i"(d0 * 4096 + ks * 1024 + 512) : "memory"); }
      asm volatile("s_waitcnt lgkmcnt(0)" ::: "memory"); SBAR();
      #define PK(k) (bf16x8){lo[k][0], lo[k][1], lo[k][2], lo[k][3], hh[k][0], hh[k][1], hh[k][2], hh[k][3]}
      o[d0] = MFQ(PAF(pwB0), PK(0), o[d0]); o[d0] = MFQ(PAF(pwB1), PK(1), o[d0]); o[d0] = MFQ(PAF(pwB2), PK(2), o[d0]); o[d0] = MFQ(PAF(pwB3), PK(3), o[d0]);
      #undef PK
    } }
  { auto rr = __builtin_amdgcn_permlane32_swap(__float_as_uint(l_reg), __float_as_uint(l_reg), false, false); l_reg = __uint_as_float(rr[0]) + __uint_as_float(rr[1]); }
  if (hi == 0) wsf[32 + r32] = l_reg; asm volatile("s_waitcnt lgkmcnt(0)" ::: "memory");
  float rli[16];
  #pragma unroll
  for (int r = 0; r < 16; ++r) rli[r] = __builtin_amdgcn_rcpf(wsf[32 + crow(r, hi)]);
  bf16* Ow = O + (rowbase + q0 + wid * QBLK) * DMA + h * 128;
  { bf16* stg = (bf16*)(shm + L_OST) + wid * 2048;
    #pragma unroll
    for (int ps = 0; ps < 2; ++ps) {
      #pragma unroll
      for (int r = 0; r < 16; ++r) { const int orow = crow(r, hi);
        #pragma unroll
        for (int d0 = 0; d0 < 2; ++d0) stg[orow * 64 + d0 * 32 + r32] = f2bf(o[2 * ps + d0][r] * rli[r]); }
      asm volatile("s_waitcnt lgkmcnt(0)" ::: "memory");
      #pragma unroll
      for (int i = 0; i < 4; ++i) { const int row = i * 8 + (lane >> 3), ch = lane & 7; const u32x4 v = *(const u32x4*)(stg + row * 64 + ch * 8); *(u32x4*)(Ow + (long)row * DMA + ps * 64 + ch * 8) = v; }
      asm volatile("s_waitcnt lgkmcnt(0)" ::: "memory");
    } }
  asm volatile("s_waitcnt lgkmcnt(0)\n\ts_barrier" ::: "memory");
  #undef DMA_K
  #undef DMA_V
  #undef CMASK
  #undef RESC
  #undef ROT
  #undef PKW
  #undef PAF
  #undef VFR
  #undef PIN
  #undef MX3
  #undef EX
  #undef VRD
  #undef KRD
  #undef GAPB
  #undef MFQ
  #undef STEP
  #undef STEP_AB
  #undef STEP_BA
  #undef ENDW
}
#undef SBAR
#undef WAIT_BAR
}

constexpr int NWAVES = 8;
constexpr size_t MiB = 1u << 20;
constexpr size_t WS_CTL = 0, CTL_ZERO_BYTES = 1 * MiB;
constexpr size_t WS_MOD = 256 * 1024;
constexpr size_t WS_LAM = 1 * MiB;
constexpr size_t WS_LB16 = 1 * MiB + 4096;
constexpr size_t WS_WIN0 = 2 * MiB, WS_WGLU = 6 * MiB, WS_WOUT0 = 8 * MiB, WS_WKV = 10 * MiB, WS_WIN1 = 14 * MiB, WS_WOUT1 = 18 * MiB;
constexpr size_t WS_BTA = 20 * MiB;
constexpr size_t WS_BTB = 28 * MiB;
constexpr size_t WS_S0 = 48 * MiB, WS_S1 = 112 * MiB, WS_S2 = 176 * MiB, WS_S3 = 240 * MiB, WS_S4 = 304 * MiB, WS_S5 = 368 * MiB, WS_S6 = 432 * MiB, WS_END = 496 * MiB;
constexpr int CW_BAR = 4096;
constexpr int RING_OFF = 0, RING_BYTES = 131072;
constexpr int LDSCTL_OFF = RING_BYTES, MISC_OFF = LDSCTL_OFF + 320;
constexpr int LDS_BYTES = 147456;

#define GAS __attribute__((address_space(1)))
#define LAS __attribute__((address_space(3)))
typedef unsigned v4u __attribute__((ext_vector_type(4)));
typedef GAS unsigned gu32;
#define RLX_AGENT __ATOMIC_RELAXED, __HIP_MEMORY_SCOPE_AGENT
#define LDS_WAIT() asm volatile("s_waitcnt lgkmcnt(0)" ::: "memory")
#define VM_WAIT() asm volatile("s_waitcnt vmcnt(0)" ::: "memory")

#define XB_TMO      128
#define XB_XCNT(j)  (256  + 64 * (j))
#define XB_XSUB(j)  (1280 + 64 * (j))
#define XB_XGEN(j)  (2304 + 64 * (j))
#define XB_TOP      3328
#define XB_TOPGEN   3392
#define XCD_BAR_WORDS 3456
#define XB_SPIN_CAP (1u << 18)
__device__ __forceinline__ unsigned xb_ld(unsigned* p)              { return __hip_atomic_load(p, __ATOMIC_RELAXED, __HIP_MEMORY_SCOPE_AGENT); }
__device__ __forceinline__ unsigned xb_add(unsigned* p, unsigned v) { return __hip_atomic_fetch_add(p, v, __ATOMIC_RELAXED, __HIP_MEMORY_SCOPE_AGENT); }
__device__ __forceinline__ unsigned xb_xcc_id() { return (unsigned)__builtin_amdgcn_s_getreg((3 << 11) | 20) & 0xFu; }
#define XB_SPIN(cond, bar) do { unsigned _sp = 0; while (cond) { __builtin_amdgcn_s_sleep(1); \
    if ((++_sp & 255u) == 0u) { if (xb_ld(&(bar)[XB_TMO])) break; if (_sp > XB_SPIN_CAP) { atomicAdd(&(bar)[XB_TMO], 1u); break; } } } } while (0)
struct XcdBarrier { unsigned* bar; unsigned x; volatile LAS unsigned* st; };
__device__ __forceinline__ XcdBarrier xcd_barrier_post(unsigned* bar, volatile LAS unsigned* st) {
    XcdBarrier b; b.bar = bar; b.x = xb_xcc_id(); b.st = st;
    if (threadIdx.x == 0) (void)xb_add(&bar[XB_XCNT(b.x)], 1u);
    return b;
}
__device__ __forceinline__ void xcd_barrier_complete(unsigned* bar, unsigned x, unsigned& nloc, unsigned& nx) {
    const unsigned G = gridDim.x * gridDim.y * gridDim.z;
    unsigned sum, cnt, mine, sp = 0u;
    for (;;) {
        sum = 0u; cnt = 0u; mine = 0u;
#pragma unroll
        for (unsigned j = 0; j < 16; ++j) { const unsigned c = xb_ld(&bar[XB_XCNT(j)]); sum += c; cnt += (c > 0u) ? 1u : 0u; mine = (j == x) ? c : mine; }
        if (sum == G) break;
        __builtin_amdgcn_s_sleep(1);
        if ((++sp & 255u) == 0u) { if (xb_ld(&bar[XB_TMO])) break; if (sp > XB_SPIN_CAP) { atomicAdd(&bar[XB_TMO], 1u); break; } }
    }
    nloc = mine > 0u ? mine : 1u; nx = cnt > 0u ? cnt : 1u;
}
__device__ __forceinline__ void xcd_barrier(const XcdBarrier& b) {
    asm volatile("s_waitcnt vmcnt(0)" ::: "memory");
    __syncthreads();
    if (threadIdx.x == 0) {
        unsigned* bar = b.bar;
        __builtin_amdgcn_s_waitcnt(0);
        unsigned nloc = b.st[0], nx = b.st[1];
        if (nloc == 0u) { xcd_barrier_complete(bar, b.x, nloc, nx); b.st[0] = nloc; b.st[1] = nx; }
        const unsigned old = xb_add(&bar[XB_XSUB(b.x)], 1u);
        const unsigned gen = old / nloc;
        if (old + 1u == (gen + 1u) * nloc) {
            __builtin_amdgcn_fence(__ATOMIC_RELEASE, "agent");
            asm volatile("s_waitcnt vmcnt(0)" ::: "memory");
            const unsigned og = xb_add(&bar[XB_TOP], 1u);
            const unsigned tg = og / nx;
            if (og + 1u == (tg + 1u) * nx) xb_add(&bar[XB_TOPGEN], 1u);
            else XB_SPIN(xb_ld(&bar[XB_TOPGEN]) == tg, bar);
            __builtin_amdgcn_fence(__ATOMIC_ACQUIRE, "agent");
            xb_add(&bar[XB_XGEN(b.x)], 1u);
            asm volatile("s_waitcnt vmcnt(0)" ::: "memory");
        } else {
            XB_SPIN(xb_ld(&bar[XB_XGEN(b.x)]) == gen, bar);
            __builtin_amdgcn_fence(__ATOMIC_ACQUIRE, "agent");
            asm volatile("s_waitcnt vmcnt(0)" ::: "memory");
        }
    }
    __syncthreads();
}

__device__ __forceinline__ void p0_transpose_item(const float* W, int K, int N, bf16_t* WT, int row_off, const float* kscale, LAS float* scr, int item, int lane) {
    const int nblk = N / 32, kb = item / nblk, nb = item % nblk, k0 = 64 * kb, n0 = 32 * nb;
#pragma unroll 8
    for (int i = 0; i < 32; ++i) { const int kk = 2 * i + (lane >> 5); float v = W[(size_t)(k0 + kk) * N + n0 + (lane & 31)]; if (kscale) v *= kscale[k0 + kk]; scr[kk * 33 + (lane & 31)] = v; }
    LDS_WAIT(); asm volatile("" ::: "memory");
    const int c = lane & 7;
#pragma unroll
    for (int j = 0; j < 4; ++j) { const int n = (lane >> 3) + 8 * j; const LAS float* s = scr + (8 * c) * 33 + n;
        v4u o; o.x = pk2bf(s[0 * 33], s[1 * 33]); o.y = pk2bf(s[2 * 33], s[3 * 33]); o.z = pk2bf(s[4 * 33], s[5 * 33]); o.w = pk2bf(s[6 * 33], s[7 * 33]);
        *(GAS v4u*)(WT + (size_t)(row_off + n0 + n) * K + k0 + 8 * c) = o; }
    LDS_WAIT(); asm volatile("" ::: "memory");
}

struct Args {
    const float* in[28]; float* out; unsigned char* ws;
    int ph_lo, ph_hi, use_bar, flags;
};

__global__ void __launch_bounds__(NWAVES * 64, 2) mega_fwd(Args args) {
    extern __shared__ __attribute__((aligned(16))) unsigned char lds_raw[];
    LAS unsigned char* lds = (LAS unsigned char*)lds_raw;
    volatile LAS unsigned* MISC = (volatile LAS unsigned*)(lds + MISC_OFF);
    const int tid = threadIdx.x, lane = tid & 63, wave = __builtin_amdgcn_readfirstlane(tid >> 6);
    const int G = gridDim.x; const int bx = blockIdx.x; const int vcu = (G % 8 == 0) ? (bx % 8) * (G / 8) + bx / 8 : bx;
    unsigned char* ws = args.ws;
    gu32* ctl = (gu32*)(ws + WS_CTL);
    const float* x = args.in[0]; const float* cvec = args.in[1]; const float* ada_w = args.in[2]; const float* ada_b = args.in[3];
    const float* g_pre = args.in[4]; const float* g_post = args.in[5];
    float* out = args.out;
    float* mod = (float*)(ws + WS_MOD); float* lamp = (float*)(ws + WS_LAM); float* lb16 = (float*)(ws + WS_LB16);
    bf16_t* Win0 = (bf16_t*)(ws + WS_WIN0); bf16_t* Wglu = (bf16_t*)(ws + WS_WGLU); bf16_t* Wout0 = (bf16_t*)(ws + WS_WOUT0); bf16_t* Wkv = (bf16_t*)(ws + WS_WKV);
    bf16_t* Win1 = (bf16_t*)(ws + WS_WIN1); bf16_t* Wout1 = (bf16_t*)(ws + WS_WOUT1); bf16_t* BtA = (bf16_t*)(ws + WS_BTA); bf16_t* BtB = (bf16_t*)(ws + WS_BTB);
    bf16_t* A0 = (bf16_t*)(ws + WS_S0); bf16_t* US = (bf16_t*)(ws + WS_S1); bf16_t* SZ = (bf16_t*)(ws + WS_S3); bf16_t* YG = (bf16_t*)(ws + WS_S4); float* EB = (float*)(ws + WS_S0);
    bf16_t* Y2 = (bf16_t*)(ws + WS_S0); bf16_t* YO = (bf16_t*)(ws + WS_S1); bf16_t* AKV = (bf16_t*)(ws + WS_S0); bf16_t* AIN1 = (bf16_t*)(ws + WS_S2);
    bf16_t* KB = (bf16_t*)(ws + WS_S3); bf16_t* VB = (bf16_t*)(ws + WS_S4); bf16_t* QB = (bf16_t*)(ws + WS_S5); bf16_t* SZ1 = (bf16_t*)(ws + WS_S6);
    bf16_t* O0 = (bf16_t*)(ws + WS_S0); bf16_t* O1 = (bf16_t*)(ws + WS_S1); bf16_t* OG = (bf16_t*)(ws + WS_S2); bf16_t* YO1 = (bf16_t*)(ws + WS_S0);

    for (int u = tid; u < (LDS_BYTES - LDSCTL_OFF) / 4; u += NWAVES * 64) ((LAS unsigned*)(lds + LDSCTL_OFF))[u] = 0u;
    __syncthreads();
    XcdBarrier bar; bar.bar = (unsigned*)(ctl + CW_BAR); bar.x = 0; bar.st = nullptr;
    if (args.use_bar) bar = xcd_barrier_post((unsigned*)(ctl + CW_BAR), MISC + 8);
    const int lo = args.ph_lo, hi = args.ph_hi;
#define IN(k) (lo <= (k) && (k) < hi)
#define REPS(k) (1 + ((REPEAT_MASK >> (k)) & 1))
#define SEAM(k) do { if (IN(k) && IN((k) + 1) && args.use_bar) xcd_barrier(bar); } while (0)
    const int gw = vcu * NWAVES + wave, NGW = G * NWAVES;

    if (IN(0)) for (int rep_ = 0; rep_ < REPS(0); ++rep_) {
        for (int it = vcu; it < NGRP * 4; it += G) {
            const int g = it >> 2, qt = it & 3;
            LAS float* LBP = (LAS float*)(lds + RING_OFF);
            LAS float* BBR = LBP + 17 * 128;
            LAS float* CC = BBR + 64 * 32;
            LAS float* KM = CC + 16 * 128;
            __syncthreads();
            if (tid < 64) {
                const int p = tid;
                const float dt = expf(args.in[9][g]);
                const float lr = args.in[7][g * 64 + p], li = args.in[8][g * 64 + p];
                const float mag = expf(lr * dt); const float sn = sinf(li * dt), cs = cosf(li * dt);
                const float lbr = mag * cs, lbi = mag * sn;
                float pr = 1.f, pi = 0.f;
                for (int d = 0; d <= 16; ++d) { LBP[(d * 64 + p) * 2] = pr; LBP[(d * 64 + p) * 2 + 1] = pi; const float nr = pr * lbr - pi * lbi, ni = pr * lbi + pi * lbr; pr = nr; pi = ni; }
                if (qt == 0) { lb16[(g * 64 + p) * 2] = LBP[(16 * 64 + p) * 2]; lb16[(g * 64 + p) * 2 + 1] = LBP[(16 * 64 + p) * 2 + 1]; }
                const float nr = lbr - 1.0f, ni = lbi, den = lr * lr + li * li;
                const float cr = (nr * lr + ni * li) / den, ci = (ni * lr - nr * li) / den;
                for (int c = 0; c < 16; ++c) { const float br = args.in[10][(g * 64 + p) * 16 + c], bi = args.in[11][(g * 64 + p) * 16 + c];
                    BBR[(p * 16 + c) * 2] = cr * br - ci * bi; BBR[(p * 16 + c) * 2 + 1] = cr * bi + ci * br; }
            }
            for (int e = tid; e < 1024; e += 512) { const int co = e >> 6, p = e & 63; CC[e * 2] = args.in[12][(g * 16 + co) * 64 + p]; CC[e * 2 + 1] = args.in[13][(g * 16 + co) * 64 + p]; }
            __syncthreads();
            for (int e = tid; e < 4096; e += 512) {
                const int d = e >> 8, co = (e >> 4) & 15, ci = e & 15; float acc = 0.f;
                for (int p = 0; p < 64; ++p) { const float cr = CC[(co * 64 + p) * 2], cim = CC[(co * 64 + p) * 2 + 1], lr = LBP[(d * 64 + p) * 2], lim = LBP[(d * 64 + p) * 2 + 1];
                    const float wr_ = cr * lr - cim * lim, wi_ = cr * lim + cim * lr; acc += wr_ * BBR[(p * 16 + ci) * 2] - wi_ * BBR[(p * 16 + ci) * 2 + 1]; }
                KM[e] = acc; }
            __syncthreads();
            for (int e = tid; e < 64 * 48; e += 512) {
                const int n = 64 * qt + e / 48, pc = e % 48, s = n >> 4, co = n & 15; float v[8];
                if (pc < 32) { const int s2 = pc >> 1, ci0 = (pc & 1) * 8;
#pragma unroll
                    for (int j = 0; j < 8; ++j) v[j] = (s2 <= s) ? KM[((s - s2) * 16 + co) * 16 + ci0 + j] : 0.f;
                } else { const int j0 = (pc - 32) * 8;
#pragma unroll
                    for (int jj = 0; jj < 4; ++jj) { const int p = (j0 >> 1) + jj; const float cr = CC[(co * 64 + p) * 2], cim = CC[(co * 64 + p) * 2 + 1], lr = LBP[((s + 1) * 64 + p) * 2], lim = LBP[((s + 1) * 64 + p) * 2 + 1];
                        v[2 * jj] = cr * lr - cim * lim; v[2 * jj + 1] = -(cr * lim + cim * lr); } }
                v4u o; o.x = pk2bf(v[0], v[1]); o.y = pk2bf(v[2], v[3]); o.z = pk2bf(v[4], v[5]); o.w = pk2bf(v[6], v[7]);
                *(GAS v4u*)(BtB + ((size_t)g * 256 + n) * 384 + pc * 8) = o; }
            for (int e = tid; e < 64 * 32; e += 512) {
                const int n = 64 * qt + (e >> 5), pc = e & 31; float v[8];
                if (n < 128) { const int p = n >> 1, ri = n & 1, s2 = pc >> 1, ci0 = (pc & 1) * 8; const float lr = LBP[((15 - s2) * 64 + p) * 2], lim = LBP[((15 - s2) * 64 + p) * 2 + 1];
#pragma unroll
                    for (int j = 0; j < 8; ++j) { const float br = BBR[(p * 16 + ci0 + j) * 2], bi = BBR[(p * 16 + ci0 + j) * 2 + 1]; v[j] = ri ? (lr * bi + lim * br) : (lr * br - lim * bi); }
                } else {
#pragma unroll
                    for (int j = 0; j < 8; ++j) v[j] = 0.f; }
                v4u o; o.x = pk2bf(v[0], v[1]); o.y = pk2bf(v[2], v[3]); o.z = pk2bf(v[4], v[5]); o.w = pk2bf(v[6], v[7]);
                *(GAS v4u*)(BtA + ((size_t)g * 256 + n) * 256 + pc * 8) = o; }
        }
        __syncthreads();
        {
            LAS float* scr = (LAS float*)(lds + RING_OFF + wave * 16384);
            constexpr int I_2K = (DM / 64) * (2048 / 32), I_1K = (DM / 64) * (1024 / 32);
            constexpr int NITEMS = 2 * I_2K + 5 * I_1K;
            for (int it = gw; it < NITEMS; it += NGW) {
                int r = it;
                if (r < I_2K) { p0_transpose_item(args.in[6], DM, 2048, Win0, 0, nullptr, scr, r, lane); continue; } r -= I_2K;
                if (r < I_2K) { p0_transpose_item(args.in[21], DM, 2048, Win1, 0, nullptr, scr, r, lane); continue; } r -= I_2K;
                if (r < I_1K) { p0_transpose_item(args.in[15], DM, 1024, Wglu, 0, nullptr, scr, r, lane); continue; } r -= I_1K;
                if (r < I_1K) { p0_transpose_item(args.in[17], DM, 1024, Wout0, 0, nullptr, scr, r, lane); continue; } r -= I_1K;
                if (r < I_1K) { p0_transpose_item(args.in[19], DM, 1024, Wkv, 0, args.in[18], scr, r, lane); continue; } r -= I_1K;
                if (r < I_1K) { p0_transpose_item(args.in[20], DM, 1024, Wkv, 1024, args.in[18], scr, r, lane); continue; } r -= I_1K;
                p0_transpose_item(args.in[27], DM, 1024, Wout1, 0, nullptr, scr, r, lane);
            }
        }
        if (!(args.flags & 1)) {
            __syncthreads();
            LAS float* sc = (LAS float*)(lds + RING_OFF);
            LAS float* red = sc + 8192;
            bool have = false;
            for (int it = vcu; it < 2 * 48; it += G) {
                if (!have) { for (int e = tid; e < 8192; e += 512) sc[e] = silu_f(cvec[e]); have = true; __syncthreads(); }
                const int l = it / 48, cc = it % 48, j = cc * 64 + lane;
                float acc[8];
#pragma unroll
                for (int b = 0; b < 8; ++b) acc[b] = 0.f;
                const float* wp = ada_w + ((size_t)l * 1024 + wave * 128) * 3072 + j;
                for (int k0 = 0; k0 < 128; k0 += 8) {
                    float w[8];
#pragma unroll
                    for (int kk = 0; kk < 8; ++kk) w[kk] = wp[(size_t)(k0 + kk) * 3072];
#pragma unroll
                    for (int kk = 0; kk < 8; ++kk)
#pragma unroll
                        for (int b = 0; b < 8; ++b) acc[b] += w[kk] * sc[b * 1024 + wave * 128 + k0 + kk];
                }
#pragma unroll
                for (int b = 0; b < 8; ++b) red[(wave * 8 + b) * 64 + lane] = acc[b];
                __syncthreads();
                { const int b = tid >> 6; float sum = ada_b[l * 3072 + j];
#pragma unroll
                  for (int w = 0; w < 8; ++w) sum += red[(w * 8 + b) * 64 + lane];
                  mod[((size_t)(l * 8 + b)) * 3072 + j] = sum; }
                __syncthreads();
            }
            if (bx == 0 && tid == 0) lamp[0] = diff_lambda(args.in[22], args.in[23], args.in[24], args.in[25]);
        }
    }
    SEAM(0);
    if (IN(1)) for (int rep_ = 0; rep_ < REPS(1); ++rep_) e_norm0(x, mod, g_pre, A0, gw, NGW, lane);
    SEAM(1);
    if (IN(2)) for (int rep_ = 0; rep_ < REPS(2); ++rep_) {
        pg8::Gemm g = pg8::gemm_std(A0, DM, Win0, DM, DM); pg8::Order S; S.init(MTOK / 256, 2048 / 256, 1, G, bx);
        pg8::EpiRow8<pg8::F_In0> E{{US, SZ}};
        pg8::gemm_phase<pg8::EpiRow8<pg8::F_In0>, true>(lds + RING_OFF, g, S, E);
    }
    SEAM(2);
    if (IN(3)) for (int rep_ = 0; rep_ < REPS(3); ++rep_) {
        pg8::Gemm g = pg8::gemm_std(US, US_P, BtA, 256, 256); g.a_gstep = (size_t)NTILE * US_P * 2; g.b_gstep = (size_t)256 * 256 * 2;
        pg8::Order S; S.init(NTILE / 256, 1, NGRP, G, bx);
        pg8::EpiRow8<pg8::F_SsmA> E{{EB}};
        pg8::gemm_phase<pg8::EpiRow8<pg8::F_SsmA>, true>(lds + RING_OFF, g, S, E);
    }
    SEAM(3);
    if (IN(4)) for (int rep_ = 0; rep_ < REPS(4); ++rep_) {
        for (int it = vcu + G * wave; it < NB * NGRP; it += G * NWAVES) {
            const int b = it / NGRP, g = it % NGRP, p = lane;
            const float lr = lb16[(g * 64 + p) * 2], li = lb16[(g * 64 + p) * 2 + 1];
            float sr = 0.f, si = 0.f;
            const float* ep = EB + ((size_t)g * NTILE + b * 256) * 128 + 2 * p;
            bf16_t* sp = US + us_off(g, b * 256, 256 + 2 * p);
            for (int t0 = 0; t0 < 256; t0 += 16) {
                float er[16], ei[16];
#pragma unroll
                for (int j = 0; j < 16; ++j) { const float2 e = *(const float2*)(ep + (size_t)(t0 + j) * 128); er[j] = e.x; ei[j] = e.y; }
#pragma unroll
                for (int j = 0; j < 16; ++j) { *(unsigned*)(sp + (size_t)(t0 + j) * US_P) = pk2bf(sr, si);
                    const float nr = lr * sr - li * si + er[j], ni = lr * si + li * sr + ei[j]; sr = nr; si = ni; }
            }
        }
    }
    SEAM(4);
    if (IN(5)) for (int rep_ = 0; rep_ < REPS(5); ++rep_) {
        pg8::Gemm g = pg8::gemm_std(US, US_P, BtB, 384, 384); g.a_gstep = (size_t)NTILE * US_P * 2; g.b_gstep = (size_t)256 * 384 * 2;
        pg8::Order S; S.init(NTILE / 256, 1, NGRP, G, bx);
        pg8::EpiRow8<pg8::F_SsmB> E{{US, args.in[14], YG}};
        pg8::gemm_phase<pg8::EpiRow8<pg8::F_SsmB>, true>(lds + RING_OFF, g, S, E);
    }
    SEAM(5);
    if (IN(6)) for (int rep_ = 0; rep_ < REPS(6); ++rep_) {
        pg8::Gemm g = pg8::gemm_std(YG, DM, Wglu, DM, DM);
        g.a_rs = 32u; g.a_c16 = (unsigned)((size_t)NTILE * YG_P * 2); g.a_kstep = (size_t)4 * NTILE * YG_P * 2; g.a_tstep = (size_t)256 * 32;
        pg8::Order S; S.init(MTOK / 256, 1024 / 256, 1, G, bx);
        pg8::EpiRow8<pg8::F_Glu> E{{YG, SZ, args.in[16], Y2}};
        pg8::gemm_phase<pg8::EpiRow8<pg8::F_Glu>, true>(lds + RING_OFF, g, S, E);
    }
    SEAM(6);
    if (IN(7)) for (int rep_ = 0; rep_ < REPS(7); ++rep_) {
        pg8::Gemm g = pg8::gemm_std(Y2, DM, Wout0, DM, DM); pg8::Order S; S.init(MTOK / 256, 1024 / 256, 1, G, bx);
        pg8::EpiRow8<pg8::F_Plain> E{{YO}};
        pg8::gemm_phase<pg8::EpiRow8<pg8::F_Plain>, true>(lds + RING_OFF, g, S, E);
    }
    SEAM(7);
    if (IN(8)) for (int rep_ = 0; rep_ < REPS(8); ++rep_) e_mid(x, YO, mod, g_post, g_pre, out, AKV, AIN1, gw, NGW, lane);
    SEAM(8);
    if (IN(9)) for (int rep_ = 0; rep_ < REPS(9); ++rep_) {
        { pg8::Gemm g = pg8::gemm_std(AKV, DM, Wkv, DM, DM); pg8::Order S; S.init(MTOK / 256, 2048 / 256, 1, G, bx);
          pg8::EpiRow8<pg8::F_Split> E{{KB, VB, 1.0f, 0}};
          pg8::gemm_phase<pg8::EpiRow8<pg8::F_Split>, true>(lds + RING_OFF, g, S, E); }
        { pg8::Gemm g = pg8::gemm_std(AIN1, DM, Win1, DM, DM); pg8::Order S; S.init(MTOK / 256, 2048 / 256, 1, G, bx);
          pg8::EpiRow8<pg8::F_Split> E{{QB, SZ1, QC2, 1}};
          pg8::gemm_phase<pg8::EpiRow8<pg8::F_Split>, true>(lds + RING_OFF, g, S, E); }
    }
    SEAM(9);
    if (IN(10)) {
#if ATTN_V128
        for (int i = 0;; ++i) {
            const long L = (long)i * G + vcu; if (L >= 128 * 16) break;
            const int pr = (int)(L % 256), qi = (int)(L / 256);
            const int combo = pr >> 1, j = pr & 1;
            const int k4 = qi >> 1; const int qb = (qi & 1) ? (4 * k4 + 3 - j) : (4 * k4 + j);
            const int c = combo & 1, h = (combo >> 1) & 7, b = combo >> 4;
            attn3::attn_unit<8>(b, 2 * h + c, h, qb, QB, KB, VB, c ? O1 : O0, (char*)lds_raw + RING_OFF);
        }
#else
        for (int i = 0;; ++i) {
            const long L = (long)i * G + vcu; if (L >= 256 * 16) break;
            const int combo = (int)(L % 256), qi = (int)(L / 256);
            const int qb = (qi & 1) ? (qi >> 1) : (15 - (qi >> 1));
            const int vh = combo & 1, c = (combo >> 1) & 1, h = (combo >> 2) & 7, b = combo >> 5;
            attn_body::attn_unit<8>(b, 2 * h + c, 2 * h + vh, qb, QB, KB, VB, c ? O1 : O0, (char*)lds_raw + RING_OFF);
        }
#endif
    }
    SEAM(10);
    if (IN(11)) for (int rep_ = 0; rep_ < REPS(11); ++rep_) e_attn_post(O0, O1, SZ1, args.in[26], lamp[0], OG, gw, NGW, lane);
    SEAM(11);
    if (IN(12)) for (int rep_ = 0; rep_ < REPS(12); ++rep_) {
        pg8::Gemm g = pg8::gemm_std(OG, DM, Wout1, DM, DM); pg8::Order S; S.init(MTOK / 256, 1024 / 256, 1, G, bx);
        pg8::EpiRow8<pg8::F_Plain> E{{YO1}};
        pg8::gemm_phase<pg8::EpiRow8<pg8::F_Plain>, true>(lds + RING_OFF, g, S, E);
    }
    SEAM(12);
    if (IN(13)) e_final(out, YO1, mod, g_post, gw, NGW, lane);
#undef IN
#undef SEAM
}

#ifndef FASTMASK
#define FASTMASK 0x3fff
#endif
#ifndef ONE_LAUNCH
#define ONE_LAUNCH 1
#endif
constexpr int NPHASE = 14;

extern "C" void kernel_launch(void* const* d_in, const int* in_sizes, int n_in, void* d_out, int out_size, void* d_ws, size_t ws_size, hipStream_t stream) {
    static int grid = 0;
    if (grid == 0) {
        if (n_in != 28 || out_size != MTOK * DM || ws_size < WS_END) { fprintf(stderr, "kernel_launch: unexpected shapes (n_in %d out %d ws %zu)\n", n_in, out_size, ws_size); grid = -1; return; }
        int dev = 0, cus = 0, per_cu = 0;
        if (hipGetDevice(&dev) != hipSuccess || hipDeviceGetAttribute(&cus, hipDeviceAttributeMultiprocessorCount, dev) != hipSuccess) { grid = -1; return; }
        if (hipFuncSetAttribute((const void*)mega_fwd, hipFuncAttributeMaxDynamicSharedMemorySize, LDS_BYTES) != hipSuccess) { fprintf(stderr, "kernel_launch: hipFuncSetAttribute failed\n"); grid = -1; return; }
        if (hipOccupancyMaxActiveBlocksPerMultiprocessor(&per_cu, (const void*)mega_fwd, NWAVES * 64, LDS_BYTES) != hipSuccess || per_cu < 1) { fprintf(stderr, "kernel_launch: occupancy query says %d\n", per_cu); }
        (void)hipGetLastError();
        grid = cus;
    }
    if (grid < 0) return;
    if (hipMemsetAsync((char*)d_ws + WS_CTL, 0, CTL_ZERO_BYTES, stream) != hipSuccess) { fprintf(stderr, "kernel_launch: memset failed\n"); return; }
    Args a{};
    for (int i = 0; i < 28; ++i) a.in[i] = (const float*)d_in[i];
    a.out = (float*)d_out; a.ws = (unsigned char*)d_ws;
#if ONE_LAUNCH
    a.ph_lo = 0; a.ph_hi = NPHASE; a.use_bar = 1; a.flags = 0;
    hipLaunchKernelGGL(mega_fwd, dim3(grid), dim3(NWAVES * 64), LDS_BYTES, stream, a);
#else
    const float* x = a.in[0]; unsigned char* ws = a.ws; float* out = a.out;
    float* mod = (float*)(ws + WS_MOD); float* lam = (float*)(ws + WS_LAM);
    bf16_t* A0 = (bf16_t*)(ws + WS_S0); bf16_t* US = (bf16_t*)(ws + WS_S1); bf16_t* SZ = (bf16_t*)(ws + WS_S3); bf16_t* YG = (bf16_t*)(ws + WS_S4);
    bf16_t* Y2 = (bf16_t*)(ws + WS_S0); bf16_t* YO = (bf16_t*)(ws + WS_S1); bf16_t* AKV = (bf16_t*)(ws + WS_S0); bf16_t* AIN1 = (bf16_t*)(ws + WS_S2);
    bf16_t* KB = (bf16_t*)(ws + WS_S3); bf16_t* VB = (bf16_t*)(ws + WS_S4); bf16_t* QB = (bf16_t*)(ws + WS_S5); bf16_t* SZ1 = (bf16_t*)(ws + WS_S6);
    bf16_t* O0 = (bf16_t*)(ws + WS_S0); bf16_t* O1 = (bf16_t*)(ws + WS_S1); bf16_t* OG = (bf16_t*)(ws + WS_S2); bf16_t* YO1 = (bf16_t*)(ws + WS_S0);
    const int EG = 2048;
    auto fast = [&](int lo, int hi, int flags) { a.ph_lo = lo; a.ph_hi = hi; a.use_bar = 0; a.flags = flags; hipLaunchKernelGGL(mega_fwd, dim3(grid), dim3(NWAVES * 64), LDS_BYTES, stream, a); };
    const unsigned FM = FASTMASK;
    if (FM & 1u) fast(0, 1, 0);
    else { fast(0, 1, 1); n_adaln<<<(2 * 8 * 3072 + 255) / 256, 256, 0, stream>>>(a.in[1], a.in[2], a.in[3], mod); n_lambda<<<1, 64, 0, stream>>>(a.in[22], a.in[23], a.in[24], a.in[25], lam); }
    if (FM & 2u) fast(1, 2, 0); else n_norm0<<<EG, 256, 0, stream>>>(x, mod, a.in[4], A0);
    if (FM & 4u) fast(2, 3, 0); else n_gemm<<<dim3(2048 / 64, MTOK / 64), 256, 0, stream>>>(AL_Row{A0}, WL_Plain{a.in[6], 2048}, EP_In0{US, SZ}, 2048);
    if (FM & 8u) { fast(3, 4, 0); fast(4, 5, 0); fast(5, 6, 0); }
    else n_ssm<<<NB * NGRP / 4, 256, 0, stream>>>(US, a.in[7], a.in[8], a.in[9], a.in[10], a.in[11], a.in[12], a.in[13], a.in[14], YG);
    if (FM & 64u) fast(6, 7, 0); else n_gemm<<<dim3(1024 / 64, MTOK / 64), 256, 0, stream>>>(AL_YG{YG}, WL_Plain{a.in[15], 1024}, EP_Glu{YG, SZ, a.in[16], Y2}, 1024);
    if (FM & 128u) fast(7, 8, 0); else n_gemm<<<dim3(1024 / 64, MTOK / 64), 256, 0, stream>>>(AL_Row{Y2}, WL_Plain{a.in[17], 1024}, EP_Plain{YO}, 1024);
    if (FM & 256u) fast(8, 9, 0); else n_mid<<<EG, 256, 0, stream>>>(x, YO, mod, a.in[5], a.in[4], out, AKV, AIN1);
    if (FM & 512u) fast(9, 10, 0);
    else { n_gemm<<<dim3(2048 / 64, MTOK / 64), 256, 0, stream>>>(AL_Row{AKV}, WL_KV{a.in[19], a.in[20], a.in[18]}, EP_KV{KB, VB}, 2048);
           n_gemm<<<dim3(2048 / 64, MTOK / 64), 256, 0, stream>>>(AL_Row{AIN1}, WL_Plain{a.in[21], 2048}, EP_In1{QB, SZ1}, 2048); }
    if (FM & 1024u) fast(10, 11, 0); else n_attn<<<MTOK * 8 / 4, 256, 0, stream>>>(QB, KB, VB, O0, O1);
    if (FM & 2048u) fast(11, 12, 0); else n_attn_post<<<EG, 256, 0, stream>>>(O0, O1, SZ1, a.in[26], lam, OG);
    if (FM & 4096u) fast(12, 13, 0); else n_gemm<<<dim3(1024 / 64, MTOK / 64), 256, 0, stream>>>(AL_Row{OG}, WL_Plain{a.in[27], 1024}, EP_Plain{YO1}, 1024);
    if (FM & 8192u) fast(13, 14, 0); else n_final<<<EG, 256, 0, stream>>>(out, YO1, mod, a.in[5]);
#endif
    const hipError_t le = hipPeekAtLastError();
    if (le != hipSuccess) fprintf(stderr, "kernel_launch: launch failed: %s\n", hipGetErrorName(le));
}
```

```cpp
#include <hip/hip_runtime.h>
#include <cstdio>
#include <cstdint>
#include <cmath>
#define FASTMASK 0x3fff
#define ONE_LAUNCH 1
#define REPEAT_MASK 0

typedef unsigned short bf16_t;
constexpr int NB = 8, SEQL = 4096, DM = 1024, MTOK = NB * SEQL;
constexpr int NGRP = 64, NTILE = MTOK / 16;
constexpr int US_P = 384, YG_P = 256;
constexpr float LAMBDA_INIT = 0.35550907f;
constexpr float ONE_M_LI = 1.0f - LAMBDA_INIT;
constexpr float RMS_EPS = 1e-6f;
constexpr float QC2 = 0.125f * 1.4426950408889634f;

__device__ __forceinline__ float bf2f(bf16_t v) { return __uint_as_float((unsigned)v << 16); }
__device__ __forceinline__ unsigned f2bf_u(float f) { unsigned u = __float_as_uint(f); return (u + 0x7fffu + ((u >> 16) & 1u)) >> 16; }
__device__ __forceinline__ bf16_t f2bf(float f) { return (bf16_t)f2bf_u(f); }
__device__ __forceinline__ unsigned pk2bf(float lo, float hi) { return f2bf_u(lo) | (f2bf_u(hi) << 16); }
__device__ __forceinline__ float silu_f(float v) { return v / (1.0f + __expf(-v)); }
__device__ __forceinline__ float sigmoid_f(float v) { return 1.0f / (1.0f + __expf(-v)); }
__device__ __forceinline__ float gelu_tanh_f(float v) {
    const float u = 0.7978845608028654f * (v + 0.044715f * v * v * v);
    const float e = __expf(2.0f * u);
    const float t = 1.0f - 2.0f / (e + 1.0f);
    return 0.5f * v * (1.0f + t);
}
__device__ __forceinline__ float wave_sum_f(float v) {
#pragma unroll
    for (int o = 1; o < 64; o <<= 1) v += __shfl_xor(v, o);
    return v;
}
__device__ __forceinline__ float wave_max_f(float v) {
#pragma unroll
    for (int o = 1; o < 64; o <<= 1) v = fmaxf(v, __shfl_xor(v, o));
    return v;
}
__device__ __forceinline__ size_t us_off(int g, int tile, int col) { return ((size_t)g * NTILE + tile) * US_P + col; }
__device__ __forceinline__ size_t yg_off(int g, int tile, int col) { return ((size_t)g * NTILE + tile) * YG_P + col; }

typedef float f32x4_t __attribute__((ext_vector_type(4)));
typedef unsigned u32x4_t __attribute__((ext_vector_type(4)));
typedef unsigned u32x2_t __attribute__((ext_vector_type(2)));

__device__ __forceinline__ void e_norm0(const float* __restrict__ x, const float* __restrict__ mod, const float* __restrict__ g_pre, bf16_t* a0, int gw, int ngw, int lane) {
    for (int m = gw; m < MTOK; m += ngw) {
        const int b = m / SEQL;
        const f32x4_t* xr = (const f32x4_t*)(x + (size_t)m * DM) + lane;
        f32x4_t v[4]; float s = 0.f;
#pragma unroll
        for (int j = 0; j < 4; ++j) { v[j] = xr[64 * j]; s += (v[j].x * v[j].x + v[j].y * v[j].y) + (v[j].z * v[j].z + v[j].w * v[j].w); }
        const float r = rsqrtf(wave_sum_f(s) * (1.0f / DM) + RMS_EPS);
        const float* sh = mod + (size_t)b * 3072; const float* sc = sh + 1024;
        u32x2_t* o = (u32x2_t*)(a0 + (size_t)m * DM) + lane;
#pragma unroll
        for (int j = 0; j < 4; ++j) {
            const int c = 256 * j + 4 * lane;
            const f32x4_t g = *(const f32x4_t*)(g_pre + c), scv = *(const f32x4_t*)(sc + c), shv = *(const f32x4_t*)(sh + c);
            f32x4_t y = v[j] * r * g * (scv + 1.0f) + shv;
            u32x2_t w; w.x = pk2bf(y.x, y.y); w.y = pk2bf(y.z, y.w); o[64 * j] = w;
        }
    }
}
__device__ __forceinline__ void e_mid(const float* __restrict__ x, const bf16_t* __restrict__ yo, const float* __restrict__ mod, const float* __restrict__ g_post, const float* __restrict__ g_pre,
                                      float* h1, bf16_t* akv, bf16_t* ain1, int gw, int ngw, int lane) {
    for (int m = gw; m < MTOK; m += ngw) {
        const int b = m / SEQL;
        const f32x4_t* xr = (const f32x4_t*)(x + (size_t)m * DM) + lane;
        const u32x2_t* yr = (const u32x2_t*)(yo + (size_t)m * DM) + lane;
        f32x4_t v[4], y[4]; float s = 0.f;
#pragma unroll
        for (int j = 0; j < 4; ++j) { v[j] = xr[64 * j]; const u32x2_t w = yr[64 * j];
            y[j].x = __uint_as_float(w.x << 16); y[j].y = __uint_as_float(w.x & 0xffff0000u); y[j].z = __uint_as_float(w.y << 16); y[j].w = __uint_as_float(w.y & 0xffff0000u);
            s += (y[j].x * y[j].x + y[j].y * y[j].y) + (y[j].z * y[j].z + y[j].w * y[j].w); }
        const float ry = rsqrtf(wave_sum_f(s) * (1.0f / DM) + RMS_EPS);
        const float* gate0 = mod + (size_t)b * 3072 + 2048;
        const float* sh1 = mod + (size_t)(8 + b) * 3072; const float* sc1 = sh1 + 1024;
        float s2 = 0.f;
        f32x4_t* ho = (f32x4_t*)(h1 + (size_t)m * DM) + lane;
#pragma unroll
        for (int j = 0; j < 4; ++j) { const int c = 256 * j + 4 * lane;
            const f32x4_t gp = *(const f32x4_t*)(g_post + c), gt = *(const f32x4_t*)(gate0 + c);
            v[j] = v[j] + gt * (y[j] * ry * gp);
            ho[64 * j] = v[j];
            s2 += (v[j].x * v[j].x + v[j].y * v[j].y) + (v[j].z * v[j].z + v[j].w * v[j].w); }
        const float rh = rsqrtf(wave_sum_f(s2) * (1.0f / DM) + RMS_EPS);
        u32x2_t* o1 = (u32x2_t*)(akv + (size_t)m * DM) + lane; u32x2_t* o2 = (u32x2_t*)(ain1 + (size_t)m * DM) + lane;
#pragma unroll
        for (int j = 0; j < 4; ++j) { const int c = 256 * j + 4 * lane;
            const f32x4_t n = v[j] * rh;
            u32x2_t w; w.x = pk2bf(n.x, n.y); w.y = pk2bf(n.z, n.w); o1[64 * j] = w;
            const f32x4_t g = *(const f32x4_t*)(g_pre + 1024 + c), scv = *(const f32x4_t*)(sc1 + c), shv = *(const f32x4_t*)(sh1 + c);
            const f32x4_t z = n * g * (scv + 1.0f) + shv;
            w.x = pk2bf(z.x, z.y); w.y = pk2bf(z.z, z.w); o2[64 * j] = w; }
    }
}
__device__ __forceinline__ void e_attn_post(const bf16_t* __restrict__ o0, const bf16_t* __restrict__ o1, const bf16_t* __restrict__ sz1, const float* __restrict__ g_sub, float lam,
                                            bf16_t* og, int gw, int ngw, int lane) {
    for (int m = gw; m < MTOK; m += ngw) {
#pragma unroll
        for (int j = 0; j < 2; ++j) {
            const int c = 512 * j + 8 * lane;
            const u32x4_t a = *(const u32x4_t*)(o0 + (size_t)m * DM + c), bq = *(const u32x4_t*)(o1 + (size_t)m * DM + c), zq = *(const u32x4_t*)(sz1 + (size_t)m * DM + c);
            float d[8]; float s = 0.f;
#pragma unroll
            for (int i = 0; i < 4; ++i) { const unsigned wa = a[i], wb = bq[i];
                d[2 * i] = __uint_as_float(wa << 16) - lam * __uint_as_float(wb << 16); d[2 * i + 1] = __uint_as_float(wa & 0xffff0000u) - lam * __uint_as_float(wb & 0xffff0000u);
                s += d[2 * i] * d[2 * i] + d[2 * i + 1] * d[2 * i + 1]; }
            s += __shfl_xor(s, 1); s += __shfl_xor(s, 2); s += __shfl_xor(s, 4); s += __shfl_xor(s, 8);
            const float r = rsqrtf(s * (1.0f / 128.0f) + RMS_EPS) * ONE_M_LI;
            const float* gs = g_sub + (c & 127);
            u32x4_t w;
#pragma unroll
            for (int i = 0; i < 4; ++i) { const unsigned wz = zq[i];
                const float z0 = __uint_as_float(wz << 16), z1 = __uint_as_float(wz & 0xffff0000u);
                w[i] = pk2bf(d[2 * i] * r * gs[2 * i] * z0, d[2 * i + 1] * r * gs[2 * i + 1] * z1); }
            *(u32x4_t*)(og + (size_t)m * DM + c) = w;
        }
    }
}
__device__ __forceinline__ void e_final(float* out, const bf16_t* __restrict__ yo1, const float* __restrict__ mod, const float* __restrict__ g_post, int gw, int ngw, int lane) {
    for (int m = gw; m < MTOK; m += ngw) {
        const int b = m / SEQL;
        f32x4_t* hr = (f32x4_t*)(out + (size_t)m * DM) + lane;
        const u32x2_t* yr = (const u32x2_t*)(yo1 + (size_t)m * DM) + lane;
        f32x4_t v[4], y[4]; float s = 0.f;
#pragma unroll
        for (int j = 0; j < 4; ++j) { v[j] = hr[64 * j]; const u32x2_t w = yr[64 * j];
            y[j].x = __uint_as_float(w.x << 16); y[j].y = __uint_as_float(w.x & 0xffff0000u); y[j].z = __uint_as_float(w.y << 16); y[j].w = __uint_as_float(w.y & 0xffff0000u);
            s += (y[j].x * y[j].x + y[j].y * y[j].y) + (y[j].z * y[j].z + y[j].w * y[j].w); }
        const float ry = rsqrtf(wave_sum_f(s) * (1.0f / DM) + RMS_EPS);
        const float* gate1 = mod + (size_t)(8 + b) * 3072 + 2048;
#pragma unroll
        for (int j = 0; j < 4; ++j) { const int c = 256 * j + 4 * lane;
            const f32x4_t gp = *(const f32x4_t*)(g_post + 1024 + c), gt = *(const f32x4_t*)(gate1 + c);
            hr[64 * j] = v[j] + gt * (y[j] * ry * gp); }
    }
}
__device__ __forceinline__ float diff_lambda(const float* lq1, const float* lk1, const float* lq2, const float* lk2) {
    float s1 = 0.f, s2 = 0.f;
    for (int i = 0; i < 64; ++i) { s1 += lq1[i] * lk1[i]; s2 += lq2[i] * lk2[i]; }
    return expf(s1) - expf(s2) + LAMBDA_INIT;
}

__global__ void n_adaln(const float* __restrict__ c, const float* __restrict__ ada_w, const float* __restrict__ ada_b, float* mod) {
    const int idx = blockIdx.x * 256 + threadIdx.x;
    if (idx >= 2 * 8 * 3072) return;
    const int j = idx % 3072, b = (idx / 3072) % 8, l = idx / (3072 * 8);
    float acc = ada_b[l * 3072 + j];
    const float* w = ada_w + (size_t)l * 1024 * 3072 + j; const float* cb = c + b * 1024;
    for (int k = 0; k < 1024; ++k) acc += silu_f(cb[k]) * w[(size_t)k * 3072];
    mod[idx] = acc;
}
__global__ void n_lambda(const float* lq1, const float* lk1, const float* lq2, const float* lk2, float* out) {
    if (threadIdx.x == 0 && blockIdx.x == 0) out[0] = diff_lambda(lq1, lk1, lq2, lk2);
}
__global__ void n_norm0(const float* x, const float* mod, const float* g_pre, bf16_t* a0) {
    e_norm0(x, mod, g_pre, a0, blockIdx.x * 4 + (threadIdx.x >> 6), gridDim.x * 4, threadIdx.x & 63);
}
__global__ void n_mid(const float* x, const bf16_t* yo, const float* mod, const float* g_post, const float* g_pre, float* h1, bf16_t* akv, bf16_t* ain1) {
    e_mid(x, yo, mod, g_post, g_pre, h1, akv, ain1, blockIdx.x * 4 + (threadIdx.x >> 6), gridDim.x * 4, threadIdx.x & 63);
}
__global__ void n_attn_post(const bf16_t* o0, const bf16_t* o1, const bf16_t* sz1, const float* g_sub, const float* lamp, bf16_t* og) {
    e_attn_post(o0, o1, sz1, g_sub, lamp[0], og, blockIdx.x * 4 + (threadIdx.x >> 6), gridDim.x * 4, threadIdx.x & 63);
}
__global__ void n_final(float* out, const bf16_t* yo1, const float* mod, const float* g_post) {
    e_final(out, yo1, mod, g_post, blockIdx.x * 4 + (threadIdx.x >> 6), gridDim.x * 4, threadIdx.x & 63);
}

struct AL_Row { const bf16_t* A; __device__ float ld(int m, int k) const { return bf2f(A[(size_t)m * DM + k]); } };
struct AL_YG  { const bf16_t* A; __device__ float ld(int m, int k) const { return bf2f(A[yg_off(k >> 4, m >> 4, (m & 15) * 16 + (k & 15))]); } };
struct WL_Plain { const float* W; long N; __device__ float ld(int k, int n) const { return W[(size_t)k * N + n]; } };
struct WL_KV { const float* wk; const float* wv; const float* g; __device__ float ld(int k, int n) const { return g[k] * (n < 1024 ? wk[(size_t)k * 1024 + n] : wv[(size_t)k * 1024 + n - 1024]); } };
struct EP_In0 { bf16_t* US; bf16_t* SZ; __device__ void st(int m, int n, float a) const {
    if (n < 1024) US[us_off(n >> 4, m >> 4, (m & 15) * 16 + (n & 15))] = f2bf(a); else SZ[(size_t)m * DM + n - 1024] = f2bf(silu_f(a)); } };
struct EP_Glu { const bf16_t* YG; const bf16_t* SZ; const float* bias; bf16_t* Y2; __device__ void st(int m, int n, float a) const {
    const float yv = bf2f(YG[yg_off(n >> 4, m >> 4, (m & 15) * 16 + (n & 15))]); const float t = a + bias[n];
    Y2[(size_t)m * DM + n] = f2bf(yv * sigmoid_f(t) * bf2f(SZ[(size_t)m * DM + n])); } };
struct EP_Plain { bf16_t* O; __device__ void st(int m, int n, float a) const { O[(size_t)m * DM + n] = f2bf(a); } };
struct EP_KV { bf16_t* K; bf16_t* V; __device__ void st(int m, int n, float a) const { if (n < 1024) K[(size_t)m * DM + n] = f2bf(a); else V[(size_t)m * DM + n - 1024] = f2bf(a); } };
struct EP_In1 { bf16_t* Q; bf16_t* SZ1; __device__ void st(int m, int n, float a) const { if (n < 1024) Q[(size_t)m * DM + n] = f2bf(a * QC2); else SZ1[(size_t)m * DM + n - 1024] = f2bf(silu_f(a)); } };

template <class AL, class WL, class EP>
__global__ void __launch_bounds__(256) n_gemm(AL al, WL wl, EP ep, int N) {
    __shared__ float As[16][68]; __shared__ float Ws[16][68];
    const int tid = threadIdx.x, tx = tid & 15, ty = tid >> 4;
    const int m0 = blockIdx.y * 64, n0 = blockIdx.x * 64;
    float acc[4][4];
#pragma unroll
    for (int i = 0; i < 4; ++i)
#pragma unroll
        for (int j = 0; j < 4; ++j) acc[i][j] = 0.f;
    for (int k0 = 0; k0 < 1024; k0 += 16) {
#pragma unroll
        for (int i = 0; i < 4; ++i) { const int e = tid + 256 * i; const int mm = e >> 4, kk = e & 15; As[kk][mm] = al.ld(m0 + mm, k0 + kk); }
#pragma unroll
        for (int i = 0; i < 4; ++i) { const int e = tid + 256 * i; const int kk = e >> 6, nn = e & 63; Ws[kk][nn] = wl.ld(k0 + kk, n0 + nn); }
        __syncthreads();
#pragma unroll
        for (int kk = 0; kk < 16; ++kk) {
            float a[4], b[4];
#pragma unroll
            for (int i = 0; i < 4; ++i) { a[i] = As[kk][ty * 4 + i]; b[i] = Ws[kk][tx * 4 + i]; }
#pragma unroll
            for (int i = 0; i < 4; ++i)
#pragma unroll
                for (int j = 0; j < 4; ++j) acc[i][j] += a[i] * b[j];
        }
        __syncthreads();
    }
#pragma unroll
    for (int i = 0; i < 4; ++i)
#pragma unroll
        for (int j = 0; j < 4; ++j) ep.st(m0 + ty * 4 + i, n0 + tx * 4 + j, acc[i][j]);
}

__global__ void __launch_bounds__(256) n_ssm(const bf16_t* __restrict__ US, const float* lam_re, const float* lam_im, const float* log_dt, const float* b_re, const float* b_im,
                                             const float* c_re, const float* c_im, const float* d_skip, bf16_t* YG) {
    const int wv = blockIdx.x * 4 + (threadIdx.x >> 6), lane = threadIdx.x & 63;
    if (wv >= NB * NGRP) return;
    const int b = wv / NGRP, g = wv % NGRP, p = lane;
    const float dt = expf(log_dt[g]);
    const float lr = lam_re[g * 64 + p], li = lam_im[g * 64 + p];
    const float mag = expf(lr * dt); float sn, cs; sn = sinf(li * dt); cs = cosf(li * dt);
    const float lbr = mag * cs, lbi = mag * sn;
    const float nr = lbr - 1.0f, ni = lbi, den = lr * lr + li * li;
    const float cr = (nr * lr + ni * li) / den, ci = (ni * lr - nr * li) / den;
    float bbr[16], bbi[16], ccr[16], cci[16];
#pragma unroll
    for (int c = 0; c < 16; ++c) { const float br = b_re[(g * 64 + p) * 16 + c], bi = b_im[(g * 64 + p) * 16 + c];
        bbr[c] = cr * br - ci * bi; bbi[c] = cr * bi + ci * br;
        ccr[c] = c_re[(g * 16 + c) * 64 + p]; cci[c] = c_im[(g * 16 + c) * 64 + p]; }
    const float dsk = d_skip[g * 16 + (lane & 15)];
    float sr = 0.f, si = 0.f;
    for (int t = 0; t < SEQL; ++t) {
        const int m = b * SEQL + t;
        const bf16_t* up = US + us_off(g, m >> 4, (m & 15) * 16);
        float u[16];
        { const u32x4_t w0 = *(const u32x4_t*)up, w1 = *(const u32x4_t*)(up + 8);
#pragma unroll
          for (int i = 0; i < 4; ++i) { u[2 * i] = __uint_as_float(w0[i] << 16); u[2 * i + 1] = __uint_as_float(w0[i] & 0xffff0000u); u[8 + 2 * i] = __uint_as_float(w1[i] << 16); u[8 + 2 * i + 1] = __uint_as_float(w1[i] & 0xffff0000u); } }
        float bur = 0.f, bui = 0.f;
#pragma unroll
        for (int c = 0; c < 16; ++c) { bur += bbr[c] * u[c]; bui += bbi[c] * u[c]; }
        const float nsr = lbr * sr - lbi * si + bur, nsi = lbr * si + lbi * sr + bui; sr = nsr; si = nsi;
        float yv = 0.f;
#pragma unroll
        for (int c = 0; c < 16; ++c) { const float part = wave_sum_f(ccr[c] * sr - cci[c] * si); if ((lane & 15) == c) yv = part; }
        if (lane < 16) { const float yy = yv + dsk * bf2f(up[lane]); YG[yg_off(g, m >> 4, (m & 15) * 16 + lane)] = f2bf(gelu_tanh_f(yy)); }
    }
}

__global__ void __launch_bounds__(256) n_attn(const bf16_t* __restrict__ Q, const bf16_t* __restrict__ K, const bf16_t* __restrict__ V, bf16_t* O0, bf16_t* O1) {
    __shared__ float qs[4][128];
    const int w = threadIdx.x >> 6, lane = threadIdx.x & 63;
    const int gwv = blockIdx.x * 4 + w;
    const int h = gwv & 7, m = gwv >> 3, b = m / SEQL, qi = m % SEQL;
    qs[w][lane] = bf2f(Q[(size_t)m * DM + h * 128 + lane]); qs[w][64 + lane] = bf2f(Q[(size_t)m * DM + h * 128 + 64 + lane]);
    __syncthreads();
    float m0 = -1e30f, m1 = -1e30f, l0 = 0.f, l1 = 0.f, a00 = 0.f, a01 = 0.f, a10 = 0.f, a11 = 0.f;
    const size_t rb = (size_t)b * SEQL;
    for (int kc = 0; kc * 64 <= qi; ++kc) {
        const int key = kc * 64 + lane; const bool valid = key <= qi;
        float s0 = 0.f, s1 = 0.f;
        { const bf16_t* kr = K + (rb + (valid ? key : qi)) * DM + h * 128;
#pragma unroll
          for (int ch = 0; ch < 8; ++ch) { const u32x4_t w0 = *(const u32x4_t*)(kr + ch * 8), w1 = *(const u32x4_t*)(kr + 64 + ch * 8);
#pragma unroll
            for (int i = 0; i < 4; ++i) { s0 += qs[w][ch * 8 + 2 * i] * __uint_as_float(w0[i] << 16) + qs[w][ch * 8 + 2 * i + 1] * __uint_as_float(w0[i] & 0xffff0000u);
                                          s1 += qs[w][64 + ch * 8 + 2 * i] * __uint_as_float(w1[i] << 16) + qs[w][64 + ch * 8 + 2 * i + 1] * __uint_as_float(w1[i] & 0xffff0000u); } } }
        if (!valid) { s0 = -1e30f; s1 = -1e30f; }
        const float nm0 = fmaxf(m0, wave_max_f(s0)), nm1 = fmaxf(m1, wave_max_f(s1));
        const float f0 = exp2f(m0 - nm0), f1 = exp2f(m1 - nm1);
        const float p0 = valid ? exp2f(s0 - nm0) : 0.f, p1 = valid ? exp2f(s1 - nm1) : 0.f;
        l0 = l0 * f0 + wave_sum_f(p0); l1 = l1 * f1 + wave_sum_f(p1); m0 = nm0; m1 = nm1;
        a00 *= f0; a01 *= f0; a10 *= f1; a11 *= f1;
        const int nk = min(64, qi - kc * 64 + 1);
        for (int j = 0; j < nk; ++j) {
            const float pj0 = __shfl(p0, j), pj1 = __shfl(p1, j);
            const bf16_t* vr = V + (rb + kc * 64 + j) * DM + h * 128;
            const float v0 = bf2f(vr[lane]), v1 = bf2f(vr[64 + lane]);
            a00 += pj0 * v0; a01 += pj0 * v1; a10 += pj1 * v0; a11 += pj1 * v1;
        }
    }
    const float i0 = 1.0f / l0, i1 = 1.0f / l1;
    O0[(size_t)m * DM + h * 128 + lane] = f2bf(a00 * i0); O0[(size_t)m * DM + h * 128 + 64 + lane] = f2bf(a01 * i0);
    O1[(size_t)m * DM + h * 128 + lane] = f2bf(a10 * i1); O1[(size_t)m * DM + h * 128 + 64 + lane] = f2bf(a11 * i1);
}
#ifndef REPEAT_MASK
#define REPEAT_MASK 0
#endif
#ifndef ATTN_V128
#define ATTN_V128 1
#endif
#ifndef EXTRA_PHASE
#define EXTRA_PHASE -1
#endif
#ifndef ATTN_FUSE_POST
#define ATTN_FUSE_POST 1
#endif
#ifndef FUSE_EPI
#define FUSE_EPI 0
#endif
#ifndef ALIGN_E
#define ALIGN_E true
#endif
namespace pg8 {
#define PG8_LAS __attribute__((address_space(3)))
typedef short bf16x8 __attribute__((ext_vector_type(8)));
typedef float f32x4 __attribute__((ext_vector_type(4)));
typedef unsigned u32x4 __attribute__((ext_vector_type(4)));
constexpr int BM = 256, BK = 64, HALF = 128, HTB = HALF * BK * 2  , STAGE_BYTES = 8 * HTB, NXCD = 8, WGM = 8;

__host__ __device__ __forceinline__ int lds_byte(int r, int c) { const int st = (r >> 4) * 2 + (c >> 5), rr = r & 15, cc = c & 31, ob = rr * 64 + cc * 2; return st * 1024 + (ob ^ (((ob >> 9) & 1) << 5)); }
__host__ __device__ __forceinline__ void stage_rc(int b, int& R, int& C) { const int st = b / 1024, sb = b % 1024, swz = sb ^ (((sb >> 9) & 1) << 5); R = (st >> 1) * 16 + swz / 64; C = (st & 1) * 32 + (swz % 64) / 2; }
__host__ __device__ __forceinline__ int perm32(int rho) { const int n = rho >> 4, i = rho & 15; return 8 * (i >> 2) + 4 * n + (i & 3); }

struct Unit { int pm, pn, grp; };
struct Gemm {
    const char* A; const char* Bt; int nt, pad0;
    unsigned a_rs, a_c16; size_t a_kstep, a_tstep, a_gstep;
    unsigned b_rs, pad1; size_t b_tstep, b_gstep;
    __device__ __forceinline__ const char* abase(const Unit& u) const { return A + (size_t)u.grp * a_gstep + (size_t)u.pm * a_tstep; }
    __device__ __forceinline__ const char* bbase(const Unit& u) const { return Bt + (size_t)u.grp * b_gstep + (size_t)u.pn * b_tstep; }
};
__device__ __forceinline__ Gemm gemm_std(const void* A, int lda, const void* Bt, int ldb, int K) {
    Gemm g; g.A = (const char*)A; g.Bt = (const char*)Bt; g.nt = K / BK; g.pad0 = 0; g.a_rs = (unsigned)lda * 2u; g.a_c16 = 32u; g.a_kstep = BK * 2; g.a_tstep = (size_t)BM * lda * 2; g.a_gstep = 0;
    g.b_rs = (unsigned)ldb * 2u; g.pad1 = 0; g.b_tstep = (size_t)BM * ldb * 2; g.b_gstep = 0; return g;
}

struct Order {
    int nM, nN, nG, nwg, G, c, only, pm_off;
    __device__ __forceinline__ void init(int nM_, int nN_, int nG_, int G_, int c_) { nM = nM_; nN = nN_; nG = nG_; nwg = nM * nN * nG; G = G_; c = c_; only = -1; pm_off = 0; }
    __device__ __forceinline__ bool next(int i, Unit& u) const {
        if (only >= 0) { if (i > 0) return false; i = only; }
        const long L = (long)i * G + c; if (L >= nwg) return false;
        int wgid = (int)L; { const int q = nwg / NXCD, r = nwg % NXCD, xcd = wgid % NXCD, off = wgid / NXCD; wgid = (xcd < r ? xcd * (q + 1) : r * (q + 1) + (xcd - r) * q) + off; }
        if (nG == 1) {
            const int nig = WGM * nN, gid = wgid / nig, fm = gid * WGM, gsz = (nM - fm) < WGM ? (nM - fm) : WGM;
            u.pm = pm_off + fm + ((wgid % nig) % gsz); u.pn = (wgid % nig) / gsz; u.grp = 0;
        } else { const int per = nM * nN; u.grp = wgid / per; const int r2 = wgid % per; u.pm = r2 % nM; u.pn = r2 / nM; }
        return true;
    }
};

__device__ __forceinline__ unsigned cvt_pk_bf16(float lo, float hi) { unsigned r; asm volatile("v_cvt_pk_bf16_f32 %0, %1, %2" : "=v"(r) : "v"(lo), "v"(hi)); return r; }
__device__ __forceinline__ u32x4 pack8(const f32x4 a, const f32x4 b) { u32x4 w; w.x = cvt_pk_bf16(a[0], a[1]); w.y = cvt_pk_bf16(a[2], a[3]); w.z = cvt_pk_bf16(b[0], b[1]); w.w = cvt_pk_bf16(b[2], b[3]); return w; }
__device__ __forceinline__ void unpack8(const u32x4 w, f32x4& a, f32x4& b) {
    a[0] = __uint_as_float(w.x << 16); a[1] = __uint_as_float(w.x & 0xffff0000u); a[2] = __uint_as_float(w.y << 16); a[3] = __uint_as_float(w.y & 0xffff0000u);
    b[0] = __uint_as_float(w.z << 16); b[1] = __uint_as_float(w.z & 0xffff0000u); b[2] = __uint_as_float(w.w << 16); b[3] = __uint_as_float(w.w & 0xffff0000u); }
__device__ __forceinline__ float fsilu(float v) { return v * __builtin_amdgcn_rcpf(1.0f + __expf(-v)); }
__device__ __forceinline__ float fsigm(float v) { return __builtin_amdgcn_rcpf(1.0f + __expf(-v)); }
__device__ __forceinline__ f32x4 silu4(f32x4 v) { f32x4 o; o[0] = fsilu(v[0]); o[1] = fsilu(v[1]); o[2] = fsilu(v[2]); o[3] = fsilu(v[3]); return o; }
__device__ __forceinline__ f32x4 sigm4(f32x4 v) { f32x4 o; o[0] = fsigm(v[0]); o[1] = fsigm(v[1]); o[2] = fsigm(v[2]); o[3] = fsigm(v[3]); return o; }
__device__ __forceinline__ float fgelu(float v) { const float u = 0.7978845608028654f * (v + 0.044715f * v * v * v); const float e = __expf(2.0f * u); return 0.5f * v * (2.0f - 2.0f * __builtin_amdgcn_rcpf(e + 1.0f)); }
__device__ __forceinline__ f32x4 gelu4(f32x4 v) { f32x4 o; o[0] = fgelu(v[0]); o[1] = fgelu(v[1]); o[2] = fgelu(v[2]); o[3] = fgelu(v[3]); return o; }

template <class F> struct EpiRow8 {
    static constexpr bool PERM = true, AFTER_DRAIN = false;
    F f;
    __device__ __forceinline__ void operator()(const f32x4 (&acc)[2][2][4][2], const Unit& u, int wr, int wc, int fr, int fq) const {
#pragma unroll
        for (int ai = 0; ai < 2; ++ai)
#pragma unroll
            for (int m = 0; m < 4; ++m) { const int row = u.pm * BM + ai * HALF + wr * 64 + m * 16 + fr;
#pragma unroll
                for (int bj = 0; bj < 2; ++bj) { const int col0 = u.pn * BM + bj * HALF + wc * 32 + 8 * fq; f.apply(u, row, col0, acc[ai][bj][m][0], acc[ai][bj][m][1]); } }
    }
};
struct F_In0 { bf16_t* US; bf16_t* SZ;
    __device__ __forceinline__ void apply(const Unit&, int row, int col0, f32x4 v0, f32x4 v1) const {
        if (col0 < 1024) *(u32x4*)(US + us_off(col0 >> 4, row >> 4, (row & 15) * 16 + (col0 & 15))) = pack8(v0, v1);
        else *(u32x4*)(SZ + (size_t)row * DM + (col0 - 1024)) = pack8(silu4(v0), silu4(v1)); } };
struct F_SsmA { float* E;
    __device__ __forceinline__ void apply(const Unit& u, int row, int col0, f32x4 v0, f32x4 v1) const {
        if (col0 < 128) { float* p = E + ((size_t)u.grp * NTILE + row) * 128 + col0; *(f32x4*)p = v0; *(f32x4*)(p + 4) = v1; } } };
struct F_SsmB { const bf16_t* US; const float* dsk; bf16_t* YG;
    __device__ __forceinline__ void apply(const Unit& u, int row, int col0, f32x4 v0, f32x4 v1) const {
        const u32x4 uw = *(const u32x4*)(US + us_off(u.grp, row, col0)); f32x4 u0, u1; unpack8(uw, u0, u1);
        const float* d = dsk + u.grp * 16 + (col0 & 15); const f32x4 d0 = *(const f32x4*)d, d1 = *(const f32x4*)(d + 4);
        *(u32x4*)(YG + yg_off(u.grp, row, col0)) = pack8(gelu4(v0 + d0 * u0), gelu4(v1 + d1 * u1)); } };
struct F_Glu { const bf16_t* YG; const bf16_t* SZ; const float* bias; bf16_t* Y2;
    __device__ __forceinline__ void apply(const Unit&, int row, int col0, f32x4 v0, f32x4 v1) const {
        const u32x4 yw = *(const u32x4*)(YG + yg_off(col0 >> 4, row >> 4, (row & 15) * 16 + (col0 & 15))); f32x4 y0, y1; unpack8(yw, y0, y1);
        const u32x4 zw = *(const u32x4*)(SZ + (size_t)row * DM + col0); f32x4 z0, z1; unpack8(zw, z0, z1);
        const f32x4 b0 = *(const f32x4*)(bias + col0), b1 = *(const f32x4*)(bias + col0 + 4);
        *(u32x4*)(Y2 + (size_t)row * DM + col0) = pack8(y0 * sigm4(v0 + b0) * z0, y1 * sigm4(v1 + b1) * z1); } };
struct F_Plain { bf16_t* O;
    __device__ __forceinline__ void apply(const Unit&, int row, int col0, f32x4 v0, f32x4 v1) const { *(u32x4*)(O + (size_t)row * DM + col0) = pack8(v0, v1); } };
struct F_Split { bf16_t* Olo; bf16_t* Ohi; float sc_lo; int silu_hi;
    __device__ __forceinline__ void apply(const Unit&, int row, int col0, f32x4 v0, f32x4 v1) const {
        if (col0 < 1024) *(u32x4*)(Olo + (size_t)row * DM + col0) = pack8(v0 * sc_lo, v1 * sc_lo);
        else { if (silu_hi) { v0 = silu4(v0); v1 = silu4(v1); } *(u32x4*)(Ohi + (size_t)row * DM + (col0 - 1024)) = pack8(v0, v1); } } };


struct PanelRms {
    unsigned* xbuf;
    unsigned* cnt;
    unsigned* tmo;
    float eps;
    __device__ __forceinline__ bool run(const f32x4 (&v)[2][2][4][2], const Unit& u, int wr, int wc, int fr, int fq, PG8_LAS unsigned char* lds, int wid, int lane) const {
        PG8_LAS float* P = (PG8_LAS float*)lds;
        PG8_LAS float* S = (PG8_LAS float*)(lds + 8192);
        PG8_LAS unsigned* flag = (PG8_LAS unsigned*)(lds + 8192 + 2048);
#pragma unroll
        for (int ai = 0; ai < 2; ++ai)
#pragma unroll
            for (int m = 0; m < 4; ++m) {
                float q = 0.f;
#pragma unroll
                for (int bj = 0; bj < 2; ++bj)
#pragma unroll
                    for (int n = 0; n < 2; ++n) { const f32x4 d = v[ai][bj][m][n]; q += (d[0] * d[0] + d[1] * d[1]) + (d[2] * d[2] + d[3] * d[3]); }
                q += __shfl_xor(q, 16); q += __shfl_xor(q, 32);
                if (fq == 0) P[(ai * HALF + wr * 64 + m * 16 + fr) * 4 + wc] = q;
            }
        asm volatile("s_waitcnt lgkmcnt(0)" ::: "memory"); __builtin_amdgcn_s_barrier(); asm volatile("" ::: "memory");
        const int row = wid * 32 + (lane & 31);
        if (lane < 32) {
            const float tot = (P[row * 4 + 0] + P[row * 4 + 1]) + (P[row * 4 + 2] + P[row * 4 + 3]);
            unsigned long long* slot = (unsigned long long*)xbuf + ((size_t)(u.pm * BM + row) * 4 + u.pn);
            __hip_atomic_store(slot, (unsigned long long)__float_as_uint(tot), __ATOMIC_RELAXED, __HIP_MEMORY_SCOPE_AGENT);
        }
        asm volatile("s_waitcnt vmcnt(0)" ::: "memory");
        if (lane == 0) __hip_atomic_fetch_add(cnt + 64 * u.pm, 1u, __ATOMIC_RELAXED, __HIP_MEMORY_SCOPE_AGENT);
        if (wid == 0) {
            bool dead = false; const unsigned long long t0 = __builtin_amdgcn_s_memrealtime(); const unsigned want = 32u;
            for (;;) {
                if ((unsigned)__builtin_amdgcn_readfirstlane(__hip_atomic_load(cnt + 64 * u.pm, __ATOMIC_RELAXED, __HIP_MEMORY_SCOPE_AGENT)) >= want) break;
                if (__builtin_amdgcn_s_memrealtime() - t0 > 2000000ull) { if (lane == 0) __hip_atomic_store(tmo, 1u, __ATOMIC_RELAXED, __HIP_MEMORY_SCOPE_AGENT); dead = true; break; }
                __builtin_amdgcn_s_sleep(2);
            }
            __builtin_amdgcn_fence(__ATOMIC_ACQUIRE, "agent");
            if (lane == 0) flag[0] = dead ? 1u : 0u;
        }
        asm volatile("s_waitcnt vmcnt(0) lgkmcnt(0)" ::: "memory"); __builtin_amdgcn_s_barrier(); asm volatile("" ::: "memory");
        const bool bad = flag[0] != 0u;
        if (lane < 32) {
            const unsigned long long* slot = (const unsigned long long*)xbuf + (size_t)(u.pm * BM + row) * 4; float t4[4];
#pragma unroll
            for (int t = 0; t < 4; ++t) t4[t] = __uint_as_float((unsigned)__hip_atomic_load(slot + t, __ATOMIC_RELAXED, __HIP_MEMORY_SCOPE_AGENT));
            S[row] = rsqrtf(((t4[0] + t4[1]) + (t4[2] + t4[3])) * (1.0f / 1024.0f) + eps);
        }
        asm volatile("s_waitcnt lgkmcnt(0)" ::: "memory"); __builtin_amdgcn_s_barrier(); asm volatile("" ::: "memory");
        return bad;
    }
};
struct EpiFinal {
    static constexpr bool PERM = false, AFTER_DRAIN = true;
    const float* base; float* out; const float* mod1; const float* gpost1; PanelRms st;
    __device__ __forceinline__ void fused(f32x4 (&acc)[2][2][4][2], const Unit& u, int wr, int wc, int fr, int fq, PG8_LAS unsigned char* lds, int wid, int lane) const {
        const PG8_LAS float* S = (const PG8_LAS float*)(lds + 8192);
        const int col0 = u.pn * BM + wc * 32 + 4 * fq; const int b = u.pm >> 4;
        const float* gate = mod1 + (size_t)b * 3072 + 2048;
        const bool bad = st.run(acc, u, wr, wc, fr, fq, lds, wid, lane);
        const float qnan = __builtin_nanf("");
        f32x4 gg[2][2];
#pragma unroll
        for (int bj = 0; bj < 2; ++bj)
#pragma unroll
            for (int n = 0; n < 2; ++n) gg[bj][n] = *(const f32x4*)(gate + col0 + bj * HALF + n * 16) * *(const f32x4*)(gpost1 + col0 + bj * HALF + n * 16);
#pragma unroll
        for (int ai = 0; ai < 2; ++ai)
#pragma unroll
            for (int m = 0; m < 4; ++m) { const int r = ai * HALF + wr * 64 + m * 16 + fr; const float sr = S[r]; const size_t off = (size_t)(u.pm * BM + r) * DM + col0;
#pragma unroll
                for (int bj = 0; bj < 2; ++bj)
#pragma unroll
                    for (int n = 0; n < 2; ++n) { const f32x4 bs = *(const f32x4*)(base + off + bj * HALF + n * 16); f32x4 o = bs + gg[bj][n] * (acc[ai][bj][m][n] * sr);
                        if (bad) o = (f32x4){qnan, qnan, qnan, qnan}; *(f32x4*)(out + off + bj * HALF + n * 16) = o; }
                if (m & 1) asm volatile("" ::: "memory"); }
    }
};
struct EpiMid {
    static constexpr bool PERM = false, AFTER_DRAIN = true;
    const float* x; float* out; bf16_t* akv; bf16_t* ain1; const float* mod; const float* gpost0; const float* gpre1; PanelRms st1, st2;
    __device__ __forceinline__ void fused(f32x4 (&acc)[2][2][4][2], const Unit& u, int wr, int wc, int fr, int fq, PG8_LAS unsigned char* lds, int wid, int lane) const {
        typedef unsigned u32x2v __attribute__((ext_vector_type(2)));
        const PG8_LAS float* S = (const PG8_LAS float*)(lds + 8192);
        const int col0 = u.pn * BM + wc * 32 + 4 * fq; const int b = u.pm >> 4;
        const float* gate0 = mod + (size_t)b * 3072 + 2048; const float* sh1 = mod + (size_t)(8 + b) * 3072; const float* sc1 = sh1 + 1024;
        bool bad = st1.run(acc, u, wr, wc, fr, fq, lds, wid, lane);
        {
            f32x4 gg[2][2];
#pragma unroll
            for (int bj = 0; bj < 2; ++bj)
#pragma unroll
                for (int n = 0; n < 2; ++n) gg[bj][n] = *(const f32x4*)(gate0 + col0 + bj * HALF + n * 16) * *(const f32x4*)(gpost0 + col0 + bj * HALF + n * 16);
#pragma unroll
            for (int ai = 0; ai < 2; ++ai)
#pragma unroll
                for (int m = 0; m < 4; ++m) { const int r = ai * HALF + wr * 64 + m * 16 + fr; const float sr = S[r]; const size_t off = (size_t)(u.pm * BM + r) * DM + col0;
#pragma unroll
                    for (int bj = 0; bj < 2; ++bj)
#pragma unroll
                        for (int n = 0; n < 2; ++n) { const f32x4 bs = *(const f32x4*)(x + off + bj * HALF + n * 16); acc[ai][bj][m][n] = bs + gg[bj][n] * (acc[ai][bj][m][n] * sr); }
                    asm volatile("" : "+v"(acc[ai][0][m][0]), "+v"(acc[ai][0][m][1]), "+v"(acc[ai][1][m][0]), "+v"(acc[ai][1][m][1]));
                    if (m & 1) asm volatile("" ::: "memory"); }
        }
        bad = st2.run(acc, u, wr, wc, fr, fq, lds, wid, lane) || bad;
        const float qnan = __builtin_nanf("");
#pragma unroll
        for (int bj = 0; bj < 2; ++bj)
#pragma unroll
            for (int n = 0; n < 2; ++n) { const int c = col0 + bj * HALF + n * 16;
                const f32x4 gf = *(const f32x4*)(gpre1 + c) * (*(const f32x4*)(sc1 + c) + 1.0f), sh = *(const f32x4*)(sh1 + c);
#pragma unroll
                for (int ai = 0; ai < 2; ++ai)
#pragma unroll
                    for (int m = 0; m < 4; ++m) { const int r = ai * HALF + wr * 64 + m * 16 + fr; const float sr = S[r]; const size_t off = (size_t)(u.pm * BM + r) * DM + c;
                        f32x4 h = acc[ai][bj][m][n]; if (bad) h = (f32x4){qnan, qnan, qnan, qnan};
                        *(f32x4*)(out + off) = h;
                        const f32x4 nr = h * sr; u32x2v w; w.x = cvt_pk_bf16(nr[0], nr[1]); w.y = cvt_pk_bf16(nr[2], nr[3]); *(u32x2v*)(akv + off) = w;
                        const f32x4 z = nr * gf + sh; w.x = cvt_pk_bf16(z[0], z[1]); w.y = cvt_pk_bf16(z[2], z[3]); *(u32x2v*)(ain1 + off) = w; }
                asm volatile("" ::: "memory"); }
    }
};
template <class Epi, bool ALIGN_EPI>
__device__ __forceinline__ void gemm_phase(PG8_LAS unsigned char* lds, const Gemm g, const Order& S, const Epi& E, int tid_in) {
    int tid_ = tid_in; asm volatile("" : "+v"(tid_));
    const int tid = tid_, wid = __builtin_amdgcn_readfirstlane(tid >> 6), lane = tid & 63, wr = wid >> 2, wc = wid & 3, fr = lane & 15, fq = lane >> 4;
    const int nt = g.nt;
    unsigned voffA[2], voffB[2];
#pragma unroll
    for (int i = 0; i < 2; ++i) { int R, C; stage_rc(tid * 16 + i * 8192, R, C); const int Rb = Epi::PERM ? ((R & ~31) + perm32(R & 31)) : R;
        voffA[i] = (unsigned)R * g.a_rs + (unsigned)(C >> 4) * g.a_c16 + (unsigned)(C & 15) * 2u; voffB[i] = (unsigned)Rb * g.b_rs + (unsigned)C * 2u; }
    const size_t kstepA = g.a_kstep, kstepB = (size_t)(BK * 2);
    const size_t hstepA = (size_t)HALF * g.a_rs, hstepB = (size_t)HALF * g.b_rs;
    const unsigned ldsw = (unsigned)wid * 1024u;
    const int aoff = lds_byte(wr * 64 + fr, fq * 8), boff = lds_byte(wc * 32 + fr, fq * 8);
#define PG8_SA(b, h) (((b) * 2 + (h)) * HTB)
#define PG8_SB(b, h) ((4 + (b) * 2 + (h)) * HTB)
#define PG8_STAGE(bufoff, gbase, voff) do { _Pragma("unroll") for (int _i = 0; _i < 2; ++_i) \
        __builtin_amdgcn_global_load_lds((const unsigned*)((const char*)(gbase) + (voff)[_i]), (PG8_LAS unsigned*)(lds + (bufoff) + ldsw + _i * 8192), 16, 0, 0); } while (0)
#define PG8_LDA(dst, b, h) do { _Pragma("unroll") for (int m = 0; m < 4; ++m) _Pragma("unroll") for (int k = 0; k < 2; ++k) dst[m][k] = *(const PG8_LAS bf16x8*)(lds + PG8_SA(b, h) + aoff + m * 2048 + k * 1024); } while (0)
#define PG8_LDB(dst, b, h) do { _Pragma("unroll") for (int n = 0; n < 2; ++n) _Pragma("unroll") for (int k = 0; k < 2; ++k) dst[n][k] = *(const PG8_LAS bf16x8*)(lds + PG8_SB(b, h) + boff + n * 2048 + k * 1024); } while (0)
#define PG8_MMA(ai, bj, At, Bt) do { __builtin_amdgcn_s_setprio(1); _Pragma("unroll") for (int m = 0; m < 4; ++m) _Pragma("unroll") for (int n = 0; n < 2; ++n) _Pragma("unroll") for (int k = 0; k < 2; ++k) \
        acc[ai][bj][m][n] = __builtin_amdgcn_mfma_f32_16x16x32_bf16(Bt[n][k], At[m][k], acc[ai][bj][m][n], 0, 0, 0); __builtin_amdgcn_s_setprio(0); } while (0)
#define PG8_WAIT_V(n) asm volatile("s_waitcnt vmcnt(" #n ")" ::: "memory")
#define PG8_WAIT_L(n) asm volatile("s_waitcnt lgkmcnt(" #n ")" ::: "memory")
#define PG8_BAR __builtin_amdgcn_s_barrier()
#define PG8_SCHED __builtin_amdgcn_sched_barrier(0)
    Unit cur, nxt; int ui = 0;
    if (!S.next(0, cur)) return;
    f32x4 acc[2][2][4][2];
#pragma unroll
    for (int a = 0; a < 2; ++a)
#pragma unroll
        for (int b = 0; b < 2; ++b)
#pragma unroll
            for (int m = 0; m < 4; ++m)
#pragma unroll
                for (int n = 0; n < 2; ++n) acc[a][b][m][n] = (f32x4){0.f, 0.f, 0.f, 0.f};
    bf16x8 At[4][2], B0[2][2], B1[2][2];
    const char* cA = g.abase(cur); const char* cB = g.bbase(cur);
    PG8_STAGE(PG8_SB(0, 0), cB, voffB); PG8_STAGE(PG8_SB(0, 1), cB + hstepB, voffB); PG8_STAGE(PG8_SA(0, 0), cA, voffA); PG8_STAGE(PG8_SA(0, 1), cA + hstepA, voffA);
    if (wr == 1) PG8_BAR;
    PG8_WAIT_V(2); PG8_BAR;
    PG8_STAGE(PG8_SB(1, 0), cB + kstepB, voffB); PG8_STAGE(PG8_SA(1, 0), cA + kstepA, voffA); PG8_STAGE(PG8_SB(1, 1), cB + hstepB + kstepB, voffB);
    PG8_WAIT_V(6); PG8_BAR;
    for (;;) {
        const bool has_next = S.next(ui + 1, nxt);
        const char* nA = has_next ? g.abase(nxt) : cA; const char* nB = has_next ? g.bbase(nxt) : cB;
        for (int t = 0; t < nt; t += 2) {
            const bool last = (t == nt - 2);
            const char* a1 = cA + (size_t)(t + 1) * kstepA;
            const char* a2 = last ? nA : cA + (size_t)(t + 2) * kstepA; const char* b2 = last ? nB : cB + (size_t)(t + 2) * kstepB;
            const char* a3 = a2 + kstepA; const char* b3 = b2 + kstepB;
            PG8_LDB(B0, 0, 0); PG8_LDB(B1, 0, 1); PG8_SCHED; PG8_LDA(At, 0, 0); PG8_STAGE(PG8_SA(1, 1), a1 + hstepA, voffA);
            PG8_WAIT_V(8); PG8_WAIT_L(0); PG8_BAR; PG8_MMA(0, 0, At, B0); PG8_MMA(0, 1, At, B1); PG8_BAR; PG8_SCHED;
            PG8_LDA(At, 0, 1); PG8_STAGE(PG8_SB(0, 0), b2, voffB); PG8_STAGE(PG8_SB(0, 1), b2 + hstepB, voffB); PG8_STAGE(PG8_SA(0, 0), a2, voffA);
            PG8_WAIT_V(8); PG8_WAIT_L(0); PG8_BAR; PG8_MMA(1, 0, At, B0); PG8_MMA(1, 1, At, B1); PG8_BAR; PG8_SCHED;
            PG8_LDB(B0, 1, 0); PG8_LDB(B1, 1, 1); PG8_SCHED; PG8_LDA(At, 1, 0); PG8_STAGE(PG8_SA(0, 1), a2 + hstepA, voffA);
            PG8_WAIT_V(8); PG8_WAIT_L(0); PG8_BAR; PG8_MMA(0, 0, At, B0); PG8_MMA(0, 1, At, B1); PG8_BAR; PG8_SCHED;
            PG8_LDA(At, 1, 1); PG8_STAGE(PG8_SB(1, 0), b3, voffB); PG8_STAGE(PG8_SB(1, 1), b3 + hstepB, voffB); PG8_STAGE(PG8_SA(1, 0), a3, voffA);
            PG8_WAIT_V(8); PG8_WAIT_L(0); PG8_BAR; PG8_MMA(1, 0, At, B0); PG8_MMA(1, 1, At, B1); PG8_BAR; PG8_SCHED;
        }
        if constexpr (ALIGN_EPI) { if (wr == 0) PG8_BAR; }
        if constexpr (!Epi::AFTER_DRAIN) { E(acc, cur, wr, wc, fr, fq); }
        if (!has_next) break;
#pragma unroll
        for (int a = 0; a < 2; ++a)
#pragma unroll
            for (int b = 0; b < 2; ++b)
#pragma unroll
                for (int m = 0; m < 4; ++m)
#pragma unroll
                    for (int n = 0; n < 2; ++n) acc[a][b][m][n] = (f32x4){0.f, 0.f, 0.f, 0.f};
        cur = nxt; cA = nA; cB = nB; ++ui;
        if constexpr (ALIGN_EPI) { if (wr == 1) PG8_BAR; }
    }
    PG8_WAIT_V(0);
    if constexpr (!ALIGN_EPI) { if (wr == 0) PG8_BAR; }
    PG8_BAR;
    if constexpr (Epi::AFTER_DRAIN) { E.fused(acc, cur, wr, wc, fr, fq, lds, wid, lane); PG8_WAIT_L(0); PG8_BAR; }
#undef PG8_SA
#undef PG8_SB
#undef PG8_STAGE
#undef PG8_LDA
#undef PG8_LDB
#undef PG8_MMA
#undef PG8_WAIT_V
#undef PG8_WAIT_L
#undef PG8_BAR
#undef PG8_SCHED
}
}

namespace attn_body {
using bf16 = bf16_t;
using bf16x8 = __attribute__((ext_vector_type(8))) short;
using s16x4 = __attribute__((ext_vector_type(4))) short;
using f32x16 = __attribute__((ext_vector_type(16))) float;
using u32x4 = __attribute__((ext_vector_type(4))) unsigned;
constexpr int SEQ = SEQL, D = 64, DMA = 1024;
constexpr int NW = 8, QBLK = 32, QB = QBLK * NW, KVBLK = 64, NQB = SEQ / QB;
__device__ __forceinline__ int crow(int r, int hi) { return (r & 3) + 8 * (r >> 2) + 4 * hi; }
#define SBAR() __builtin_amdgcn_sched_barrier(0)
__device__ __forceinline__ void cmask(f32x16& p0, f32x16& p1, int jb, int qrel, int hi) {
  const float NEG = -INFINITY; int kb = 64 * jb + 4 * hi;
  #pragma unroll
  for (int r = 0; r < 16; ++r) { int kv = kb + (r & 3) + 8 * (r >> 2); if (kv > qrel) p0[r] = NEG; if (kv + 32 > qrel) p1[r] = NEG; }
}
constexpr int NSLOT = 3, SLOTB = 8192;
constexpr int LDS_K = 0, LDS_V = NSLOT * SLOTB, LDS_WS = 2 * NSLOT * SLOTB, LDS_OST = LDS_WS + NW * 64 * 4, LDS_BYTES = LDS_OST + NW * 4096;
__device__ __forceinline__ void glds16(const void* gsrc, unsigned lds_dst) { unsigned keep;
  asm volatile("s_mov_b32 %0, m0\n\ts_mov_b32 m0, %2\n\ts_nop 0\n\tglobal_load_lds_dwordx4 %1, off\n\ts_mov_b32 m0, %0" : "=&s"(keep) : "v"(gsrc), "s"(lds_dst) : "memory"); }
__device__ __forceinline__ float max3f(float a, float b, float c) { float r; asm("v_max3_f32 %0, %1, %2, %3" : "=v"(r) : "v"(a), "v"(b), "v"(c)); return r; }
__device__ __forceinline__ float max2f(float a, float b) { float r; asm("v_max_f32_e32 %0, %1, %2" : "=v"(r) : "v"(a), "v"(b)); return r; }
__device__ __forceinline__ float fadd_s(float a, float b) { float r; asm("v_add_f32_e32 %0, %1, %2" : "=v"(r) : "v"(a), "v"(b)); return r; }
__device__ __forceinline__ float fsub_s(float a, float b) { float r; asm("v_sub_f32_e32 %0, %1, %2" : "=v"(r) : "v"(a), "v"(b)); return r; }
typedef float f32x2_t __attribute__((ext_vector_type(2))); typedef __bf16 bf16x2_t __attribute__((ext_vector_type(2)));
__device__ __forceinline__ unsigned cvtpk_s(float lo, float hi) { f32x2_t v = {lo, hi}; bf16x2_t b = __builtin_convertvector(v, bf16x2_t); return __builtin_bit_cast(unsigned, b); }
#define WAIT_BAR(N) asm volatile("s_waitcnt vmcnt(" #N ") lgkmcnt(0)\n\ts_barrier" ::: "memory")

__device__ __forceinline__ void qkt(f32x16& p0, f32x16& p1, const char* Kslot, const bf16x8* qr, const f32x16& negm, int r32, int hi) {
  const char* kb = Kslot + hi * 1024 + r32 * 16;
  #pragma unroll
  for (int d0 = 0; d0 < 4; ++d0) {
    const bf16x8 b0 = *reinterpret_cast<const bf16x8*>(kb + d0 * 2048);
    const bf16x8 b1 = *reinterpret_cast<const bf16x8*>(kb + d0 * 2048 + 512);
    if (d0 == 0) { p0 = __builtin_amdgcn_mfma_f32_32x32x16_bf16(b0, qr[0], negm, 0, 0, 0); p1 = __builtin_amdgcn_mfma_f32_32x32x16_bf16(b1, qr[0], negm, 0, 0, 0); }
    else { p0 = __builtin_amdgcn_mfma_f32_32x32x16_bf16(b0, qr[d0], p0, 0, 0, 0); p1 = __builtin_amdgcn_mfma_f32_32x32x16_bf16(b1, qr[d0], p1, 0, 0, 0); } }
}
typedef __attribute__((address_space(3))) const char* lds_cptr;
typedef short v4i16_t __attribute__((ext_vector_type(4)));
__device__ __forceinline__ void kload8(bf16x8* kf, lds_cptr kp) {
  kf[0] = *(const __attribute__((address_space(3))) bf16x8*)(kp);        kf[1] = *(const __attribute__((address_space(3))) bf16x8*)(kp + 512);
  kf[2] = *(const __attribute__((address_space(3))) bf16x8*)(kp + 2048); kf[3] = *(const __attribute__((address_space(3))) bf16x8*)(kp + 2560);
  kf[4] = *(const __attribute__((address_space(3))) bf16x8*)(kp + 4096); kf[5] = *(const __attribute__((address_space(3))) bf16x8*)(kp + 4608);
  kf[6] = *(const __attribute__((address_space(3))) bf16x8*)(kp + 6144); kf[7] = *(const __attribute__((address_space(3))) bf16x8*)(kp + 6656);
}
__device__ __forceinline__ void kload2(bf16x8* kf, lds_cptr kp, int j) { kf[2 * j] = *(const __attribute__((address_space(3))) bf16x8*)(kp + j * 2048); kf[2 * j + 1] = *(const __attribute__((address_space(3))) bf16x8*)(kp + j * 2048 + 512); }
__device__ __forceinline__ s16x4 vtr(lds_cptr p) { return __builtin_bit_cast(s16x4, __builtin_amdgcn_ds_read_tr16_b64_v4i16((__attribute__((address_space(3))) v4i16_t*)p)); }
__device__ __forceinline__ float rowmax(const f32x16& p0, const f32x16& p1) {
  float a = max3f(p0[0], p0[1], p1[0]), b = max3f(p0[2], p0[3], p1[1]); a = max3f(a, p1[2], p1[3]);
  #pragma unroll
  for (int r = 4; r < 16; r += 4) { a = max3f(a, p0[r], p0[r + 1]); b = max3f(b, p0[r + 2], p0[r + 3]); a = max3f(a, p1[r], p1[r + 1]); b = max3f(b, p1[r + 2], p1[r + 3]); }
  const float m = max2f(a, b);
  auto rr = __builtin_amdgcn_permlane32_swap(__float_as_uint(m), __float_as_uint(m), false, false);
  return max2f(__uint_as_float(rr[0]), __uint_as_float(rr[1]));
}
__device__ __forceinline__ void pv(f32x16* o, int vb, bf16x8 pa0, bf16x8 pa1, bf16x8 pa2, bf16x8 pa3) {
  #pragma unroll
  for (int d0 = 0; d0 < 2; ++d0) { s16x4 lo[4], hi[4];
    #pragma unroll
    for (int ks = 0; ks < 4; ++ks) {
      asm volatile("ds_read_b64_tr_b16 %0,%1 offset:%c2" : "=&v"(lo[ks]) : "v"(vb), "i"(d0 * 4096 + ks * 1024) : "memory");
      asm volatile("ds_read_b64_tr_b16 %0,%1 offset:%c2" : "=&v"(hi[ks]) : "v"(vb), "i"(d0 * 4096 + ks * 1024 + 512) : "memory"); }
    asm volatile("s_waitcnt lgkmcnt(0)" ::: "memory"); SBAR();
    #define PK(k) (bf16x8){lo[k][0], lo[k][1], lo[k][2], lo[k][3], hi[k][0], hi[k][1], hi[k][2], hi[k][3]}
    o[d0] = __builtin_amdgcn_mfma_f32_32x32x16_bf16(pa0, PK(0), o[d0], 0, 0, 0);
    o[d0] = __builtin_amdgcn_mfma_f32_32x32x16_bf16(pa1, PK(1), o[d0], 0, 0, 0);
    o[d0] = __builtin_amdgcn_mfma_f32_32x32x16_bf16(pa2, PK(2), o[d0], 0, 0, 0);
    o[d0] = __builtin_amdgcn_mfma_f32_32x32x16_bf16(pa3, PK(3), o[d0], 0, 0, 0);
    #undef PK
  }
}
#define ATTN_STORE16(p, v) (*(u32x4*)(p) = (v))
template <int THRL> __device__ __forceinline__ void attn_unit(int tid_in, int b, int hq, int hv, int qb, const bf16* Q, const bf16* __restrict__ K, const bf16* __restrict__ V, bf16* O, char* shm) {
  const int tid = tid_in, lane = tid & 63, r32 = lane & 31, hi = lane >> 5; const int wid = __builtin_amdgcn_readfirstlane(tid >> 6);
  const long rowbase = (long)b * SEQ; const int q0 = qb * QB;
  const bf16* Qw = Q + (rowbase + q0 + wid * QBLK) * DMA + hq * D;
  const bf16* Kh = K + rowbase * DMA + hq * D, *Vh = V + rowbase * DMA + hv * D;
  const unsigned lds0 = (unsigned)(uintptr_t)shm;
  float* wsf = (float*)(shm + LDS_WS) + wid * 64;
  const bf16* ksrc = Kh + (long)lane * DMA + wid * 8;
  const bf16* vsrc = Vh + (long)(16 * (wid & 3) + (lane >> 2)) * DMA + (wid >> 2) * 32 + (lane & 3) * 8;
  const unsigned kdst = lds0 + LDS_K + wid * 1024, vdst = lds0 + LDS_V + wid * 1024;
  #define DMA_K(t, slot) glds16(ksrc + (long)(t) * KVBLK * DMA, (unsigned)__builtin_amdgcn_readfirstlane(kdst + (slot)))
  #define DMA_V(t, slot) glds16(vsrc + (long)(t) * KVBLK * DMA, (unsigned)__builtin_amdgcn_readfirstlane(vdst + (slot)))
  const int vb0 = (int)(lds0 + LDS_V) + ((lane >> 4) & 1) * 32 + (lane & 3) * 8 + (4 * hi + ((lane & 15) >> 2)) * 64;
  const char* Kbase = shm + LDS_K; bf16x8 kf[8];
  const lds_cptr shm3 = (lds_cptr)shm; const lds_cptr kp0 = shm3 + LDS_K + hi * 1024 + r32 * 16; const lds_cptr vp0 = shm3 + LDS_V + ((lane >> 4) & 1) * 32 + (lane & 3) * 8 + (4 * hi + ((lane & 15) >> 2)) * 64;
  const int NT = (q0 + QB) / KVBLK;
  DMA_K(0, 0); DMA_V(0, 0); DMA_K(1, SLOTB);
  bf16x8 qr[4];
  #pragma unroll
  for (int d0 = 0; d0 < 4; ++d0) qr[d0] = *reinterpret_cast<const bf16x8*>(&Qw[(long)r32 * DMA + d0 * 16 + hi * 8]);
  float mhat = 0.f, l_reg = 0.f; f32x16 o[2]; o[0] = f32x16{}; o[1] = f32x16{}; f32x16 negm = f32x16{}; asm volatile("" : "+v"(negm));
  const int qrel = wid * QBLK + r32;
  #define CMASK(P0, P1, t) do { int jb_ = (t) - (NT - 4); if (jb_ >= 0) cmask(P0, P1, jb_, qrel, hi); } while (0)
  bool resc = false;
  #define START(P0, P1) do { const float rm = rowmax(P0, P1); resc = false; \
    { const float dl = rm; mhat = fadd_s(mhat, dl); \
      _Pragma("unroll") for (int r = 0; r < 16; ++r) { P0[r] = fsub_s(P0[r], dl); P1[r] = fsub_s(P1[r], dl); } \
      _Pragma("unroll") for (int r = 0; r < 16; ++r) negm[r] = -mhat; asm volatile("" : "+v"(negm)); } \
    _Pragma("unroll") for (int r = 0; r < 16; ++r) P0[r] = __builtin_amdgcn_exp2f(P0[r]); } while (0)
  #define RESC() do { if (resc) { asm volatile("s_waitcnt lgkmcnt(0)" ::: "memory"); \
      _Pragma("unroll") for (int d_ = 0; d_ < 2; ++d_) _Pragma("unroll") for (int r = 0; r < 16; ++r) o[d_][r] *= wsf[crow(r, hi)]; } } while (0)
  f32x16 pA0, pA1, pB0, pB1;
  int sl_prev = 0, sl_cur = 0, sl_next = SLOTB;
  #define ROT() do { sl_prev = sl_cur; sl_cur = sl_next; sl_next = (sl_next == (NSLOT - 1) * SLOTB) ? 0 : sl_next + SLOTB; } while (0)
  DMA_K(2, 2 * SLOTB);
  WAIT_BAR(3);
  qkt(pA0, pA1, Kbase, qr, negm, r32, hi); asm volatile("s_nop 15\n\ts_nop 7" : "+v"(pA0), "+v"(pA1)); CMASK(pA0, pA1, 0);
  START(pA0, pA1);
  _Pragma("unroll") for (int r = 0; r < 16; ++r) pA1[r] = __builtin_amdgcn_exp2f(pA1[r]);
  WAIT_BAR(0);
  DMA_K(3, 0); DMA_V(1, SLOTB);
  ROT();
  kload8(kf, kp0 + sl_cur);
  WAIT_BAR(2);
  s16x4 vlo[8], vhi[8]; u32x4 pw0, pw1, pw2, pw3;
  #define PKW(P, B) cvtpk_s(P[B], P[B + 1])
  #define PAF(k) __builtin_bit_cast(bf16x8, pw##k)
  #define VFR(i) (bf16x8){vlo[i][0], vlo[i][1], vlo[i][2], vlo[i][3], vhi[i][0], vhi[i][1], vhi[i][2], vhi[i][3]}
  #define PIN(x) asm volatile("" : "+v"(x))
  #define MX3(a, b, c) __builtin_fmaxf(__builtin_fmaxf((a), (b)), (c))
  #define GAPA(MF, A0, A1, A2, A3, W0, W1, PW) do { MF; sacc += A0; sacc += A1; sacc += A2; sacc += A3; PIN(sacc); W0; W1; PIN(PW); SBAR(); } while (0)
  #define EX(v) __builtin_amdgcn_exp2f(v)
  #define GAPB(MF, X, B) do { MF; X[B] = EX(X[B]); X[B + 1] = EX(X[B + 1]); X[B + 2] = EX(X[B + 2]); X[B + 3] = EX(X[B + 3]); PIN(X); SBAR(); } while (0)
  #define VRD(i) do { vlo[i] = vtr(vp_ + (((i) >> 2) * 4096 + ((i) & 3) * 1024)); vhi[i] = vtr(vp_ + (((i) >> 2) * 4096 + ((i) & 3) * 1024 + 512)); } while (0)
  #define KRD(G, j) do { if (G) { kload2(kf, kp0 + sl_next, j); SBAR(); } } while (0)
  #define STEP(C0, C1, P0, P1, t, GK, GV, GL) do { SBAR(); \
    const lds_cptr vp_ = vp0 + sl_prev; \
    VRD(0); SBAR(); float sacc = (P0[0] + P0[1]); \
    GAPA(C0 = __builtin_amdgcn_mfma_f32_32x32x16_bf16(kf[0], qr[0], negm, 0, 0, 0), P0[2], P0[3], P0[4], P0[5],     pw0[0] = PKW(P0, 0), pw0[1] = PKW(P0, 2), pw0); \
    VRD(4); SBAR(); GAPA(C1 = __builtin_amdgcn_mfma_f32_32x32x16_bf16(kf[1], qr[0], negm, 0, 0, 0), P0[6], P0[7], P0[8], P0[9],     pw0[2] = PKW(P0, 4), pw0[3] = PKW(P0, 6), pw0); \
    VRD(1); SBAR(); GAPA(C0 = __builtin_amdgcn_mfma_f32_32x32x16_bf16(kf[2], qr[1], C0, 0, 0, 0),   P0[10], P0[11], P0[12], P0[13], pw1[0] = PKW(P0, 8), pw1[1] = PKW(P0, 10), pw1); \
    VRD(5); SBAR(); GAPA(C1 = __builtin_amdgcn_mfma_f32_32x32x16_bf16(kf[3], qr[1], C1, 0, 0, 0),   P0[14], P0[15], P1[0], P1[1],   pw1[2] = PKW(P0, 12), pw1[3] = PKW(P0, 14), pw1); \
    VRD(2); SBAR(); GAPA(C0 = __builtin_amdgcn_mfma_f32_32x32x16_bf16(kf[4], qr[2], C0, 0, 0, 0),   P1[2], P1[3], P1[4], P1[5],     pw2[0] = PKW(P1, 0), pw2[1] = PKW(P1, 2), pw2); \
    VRD(6); SBAR(); GAPA(C1 = __builtin_amdgcn_mfma_f32_32x32x16_bf16(kf[5], qr[2], C1, 0, 0, 0),   P1[6], P1[7], P1[8], P1[9],     pw2[2] = PKW(P1, 4), pw2[3] = PKW(P1, 6), pw2); \
    VRD(3); SBAR(); GAPA(C0 = __builtin_amdgcn_mfma_f32_32x32x16_bf16(kf[6], qr[3], C0, 0, 0, 0),   P1[10], P1[11], P1[12], P1[13], pw3[0] = PKW(P1, 8), pw3[1] = PKW(P1, 10), pw3); \
    VRD(7); SBAR(); GAPA(C1 = __builtin_amdgcn_mfma_f32_32x32x16_bf16(kf[7], qr[3], C1, 0, 0, 0),   P1[14], P1[15], 0.f, 0.f,       pw3[2] = PKW(P1, 12), pw3[3] = PKW(P1, 14), pw3); \
    l_reg += sacc; \
    if (GK) { DMA_K((t) + 3, sl_cur); } if (GV) { DMA_V((t) + 1, sl_next); } \
    CMASK(C0, C1, t); \
    { float a = MX3(C0[0], C0[1], C1[0]), b = MX3(C0[2], C0[3], C1[1]); a = MX3(a, C1[2], C1[3]); \
      _Pragma("unroll") for (int r = 4; r < 16; r += 4) { a = MX3(a, C0[r], C0[r + 1]); b = MX3(b, C0[r + 2], C0[r + 3]); a = MX3(a, C1[r], C1[r + 1]); b = MX3(b, C1[r + 2], C1[r + 3]); } \
      float rm = __builtin_fmaxf(a, b); { auto rr = __builtin_amdgcn_permlane32_swap(__float_as_uint(rm), __float_as_uint(rm), false, false); rm = __builtin_fmaxf(__uint_as_float(rr[0]), __uint_as_float(rr[1])); } \
      resc = false; \
      if (__builtin_expect(__any(rm > (float)THRL), 0)) { const float dl = __builtin_fmaxf(rm, 0.f); mhat += dl; \
        _Pragma("unroll") for (int r = 0; r < 16; ++r) { C0[r] -= dl; C1[r] -= dl; } \
        _Pragma("unroll") for (int r = 0; r < 16; ++r) negm[r] = -mhat; asm volatile("" : "+v"(negm)); \
        const float f = __builtin_amdgcn_exp2f(-dl); l_reg *= f; if (hi == 0) wsf[r32] = f; resc = true; } } \
    SBAR(); \
    GAPB(o[0] = __builtin_amdgcn_mfma_f32_32x32x16_bf16(PAF(0), VFR(0), o[0], 0, 0, 0), C0, 0); \
    GAPB(o[1] = __builtin_amdgcn_mfma_f32_32x32x16_bf16(PAF(0), VFR(4), o[1], 0, 0, 0), C0, 4); \
    KRD(GL, 0); GAPB(o[0] = __builtin_amdgcn_mfma_f32_32x32x16_bf16(PAF(1), VFR(1), o[0], 0, 0, 0), C0, 8); \
    KRD(GL, 1); GAPB(o[1] = __builtin_amdgcn_mfma_f32_32x32x16_bf16(PAF(1), VFR(5), o[1], 0, 0, 0), C0, 12); \
    KRD(GL, 2); GAPB(o[0] = __builtin_amdgcn_mfma_f32_32x32x16_bf16(PAF(2), VFR(2), o[0], 0, 0, 0), C1, 0); \
    KRD(GL, 3); GAPB(o[1] = __builtin_amdgcn_mfma_f32_32x32x16_bf16(PAF(2), VFR(6), o[1], 0, 0, 0), C1, 4); \
    GAPB(o[0] = __builtin_amdgcn_mfma_f32_32x32x16_bf16(PAF(3), VFR(3), o[0], 0, 0, 0), C1, 8); \
    GAPB(o[1] = __builtin_amdgcn_mfma_f32_32x32x16_bf16(PAF(3), VFR(7), o[1], 0, 0, 0), C1, 12); \
    } while (0)
  int t = 1;
  #undef CMASK
  #define CMASK(P0, P1, t) do {} while (0)
  for (; t + 5 < NT; t += 2) {
    STEP(pB0, pB1, pA0, pA1, t, true, true, true);     WAIT_BAR(2); RESC(); ROT();
    STEP(pA0, pA1, pB0, pB1, t + 1, true, true, true); WAIT_BAR(2); RESC(); ROT();
  }
  #undef CMASK
  #define CMASK(P0, P1, t) do { int jb_ = (t) - (NT - 4); if (jb_ >= 0) cmask(P0, P1, jb_, qrel, hi); } while (0)
  #define ENDW(tt) do { if ((tt) + 3 < NT) { WAIT_BAR(2); } else if ((tt) + 2 < NT) { WAIT_BAR(1); } else { WAIT_BAR(0); } } while (0)
  for (; t + 1 < NT; t += 2) {
    STEP(pB0, pB1, pA0, pA1, t, (t + 3 < NT), (t + 1 < NT), (t + 1 < NT));         ENDW(t);     RESC(); ROT();
    STEP(pA0, pA1, pB0, pB1, t + 1, (t + 4 < NT), (t + 2 < NT), (t + 2 < NT));     ENDW(t + 1); RESC(); ROT();
  }
  STEP(pB0, pB1, pA0, pA1, NT - 1, false, false, false); RESC();
  { float sacc = pB0[0] + pB0[1]; _Pragma("unroll") for (int r = 2; r < 16; ++r) sacc += pB0[r]; _Pragma("unroll") for (int r = 0; r < 16; ++r) sacc += pB1[r]; l_reg += sacc;
    pw0 = (u32x4){PKW(pB0, 0), PKW(pB0, 2), PKW(pB0, 4), PKW(pB0, 6)}; pw1 = (u32x4){PKW(pB0, 8), PKW(pB0, 10), PKW(pB0, 12), PKW(pB0, 14)}; pw2 = (u32x4){PKW(pB1, 0), PKW(pB1, 2), PKW(pB1, 4), PKW(pB1, 6)}; pw3 = (u32x4){PKW(pB1, 8), PKW(pB1, 10), PKW(pB1, 12), PKW(pB1, 14)};
    SBAR(); pv(o, vb0 + sl_cur, PAF(0), PAF(1), PAF(2), PAF(3)); }
  #undef PKW
  #undef PAF
  #undef VFR
  #undef PIN
  #undef MX3
  #undef GAPA
  #undef GAPB
  #undef EX
  #undef VRD
  #undef KRD
  #undef STEP
  #undef ENDW
  { auto rr = __builtin_amdgcn_permlane32_swap(__float_as_uint(l_reg), __float_as_uint(l_reg), false, false); l_reg = __uint_as_float(rr[0]) + __uint_as_float(rr[1]); }
  if (hi == 0) wsf[32 + r32] = l_reg; asm volatile("s_waitcnt lgkmcnt(0)" ::: "memory");
  float rli[16];
  #pragma unroll
  for (int r = 0; r < 16; ++r) rli[r] = __builtin_amdgcn_rcpf(wsf[32 + crow(r, hi)]);
  bf16* Ow = O + (rowbase + q0 + wid * QBLK) * DMA + hv * D;
  { bf16* stg = (bf16*)(shm + LDS_OST) + wid * 2048;
    #pragma unroll
    for (int r = 0; r < 16; ++r) { const int orow = crow(r, hi);
      #pragma unroll
      for (int d0 = 0; d0 < 2; ++d0) stg[orow * 64 + d0 * 32 + r32] = f2bf(o[d0][r] * rli[r]); }
    asm volatile("s_waitcnt lgkmcnt(0)" ::: "memory");
    #pragma unroll
    for (int i = 0; i < 4; ++i) { const int row = i * 8 + (lane >> 3), ch = lane & 7; const u32x4 v = *(const u32x4*)(stg + row * 64 + ch * 8); ATTN_STORE16(Ow + (long)row * DMA + ch * 8, v); } }
  asm volatile("s_waitcnt lgkmcnt(0)\n\ts_barrier" ::: "memory");
  #undef DMA_K
  #undef DMA_V
  #undef CMASK
  #undef START
  #undef RESC
  #undef ROT
}
constexpr int ATTN_LDS_BYTES = LDS_BYTES;
#undef SBAR
#undef WAIT_BAR
}

namespace attn3 {
using namespace attn_body;
constexpr int KSLOT = 8192, VSLOT = 16384;
constexpr int L_K = 0, L_V = NSLOT * KSLOT, L_WS = L_V + NSLOT * VSLOT, L_OST = L_WS + NW * 64 * 4, L_BYTES = L_OST + NW * 4096;
#define SBAR() __builtin_amdgcn_sched_barrier(0)
#define WAIT_BAR(N) asm volatile("s_waitcnt vmcnt(" #N ") lgkmcnt(0)\n\ts_barrier" ::: "memory")
template <int THRL> __device__ __forceinline__ void attn_unit(int tid_in, int b, int hq, int h, int qb, const bf16* Q, const bf16* __restrict__ K, const bf16* __restrict__ V, bf16* O, char* shm,
                                                             int mode, const bf16* SZ1, const float* g_sub, float lam, bf16* OG) {
  int tid_ = tid_in; asm volatile("" : "+v"(tid_));
  const int tid = tid_, lane = tid & 63, r32 = lane & 31, hi = lane >> 5; const int wid = __builtin_amdgcn_readfirstlane(tid >> 6);
  const long rowbase = (long)b * SEQ; const int q0 = qb * QB;
  const bf16* Qw = Q + (rowbase + q0 + wid * QBLK) * DMA + hq * D;
  const bf16* Kh = K + rowbase * DMA + hq * D, *Vh = V + rowbase * DMA + h * 128;
  const unsigned lds0 = (unsigned)(uintptr_t)shm;
  float* wsf = (float*)(shm + L_WS) + wid * 64;
  const bf16* ksrc = Kh + (long)lane * DMA + wid * 8;
  const bf16* vsrc = Vh + (long)(16 * (wid & 3) + (lane >> 2)) * DMA + (wid >> 2) * 32 + (lane & 3) * 8;
  const unsigned kdst = lds0 + L_K + wid * 1024, vdst = lds0 + L_V + wid * 1024;
  #define DMA_K(t, si) glds16(ksrc + (long)(t) * KVBLK * DMA, (unsigned)__builtin_amdgcn_readfirstlane(kdst + (si) * KSLOT))
  #define DMA_V(t, si) do { glds16(vsrc + (long)(t) * KVBLK * DMA, (unsigned)__builtin_amdgcn_readfirstlane(vdst + (si) * VSLOT)); \
                            glds16(vsrc + (long)(t) * KVBLK * DMA + 64, (unsigned)__builtin_amdgcn_readfirstlane(vdst + (si) * VSLOT + 8192)); } while (0)
  const int vb0 = (int)(lds0 + L_V) + ((lane >> 4) & 1) * 32 + (lane & 3) * 8 + (4 * hi + ((lane & 15) >> 2)) * 64;
  const char* Kbase = shm + L_K; bf16x8 kf[8];
  const lds_cptr shm3 = (lds_cptr)shm; const lds_cptr kp0 = shm3 + L_K + hi * 1024 + r32 * 16; const lds_cptr vp0 = shm3 + L_V + ((lane >> 4) & 1) * 32 + (lane & 3) * 8 + (4 * hi + ((lane & 15) >> 2)) * 64;
  const int NT = (q0 + QB) / KVBLK;
  DMA_K(0, 0); DMA_V(0, 0); DMA_K(1, 1);
  bf16x8 qr[4];
  #pragma unroll
  for (int d0 = 0; d0 < 4; ++d0) qr[d0] = *reinterpret_cast<const bf16x8*>(&Qw[(long)r32 * DMA + d0 * 16 + hi * 8]);
  float mhat = 0.f, l_reg = 0.f; f32x16 o[4]; f32x16 negm;
  { float zf = 0.f; asm volatile("" : "+v"(zf));
    _Pragma("unroll") for (int r = 0; r < 16; ++r) { o[0][r] = zf; o[1][r] = zf; o[2][r] = zf; o[3][r] = zf; negm[r] = zf; } }
  asm volatile("" : "+v"(negm));
  const int qrel = wid * QBLK + r32;
  #define CMASK(P0, P1, t) do { int jb_ = (t) - (NT - 4); if (jb_ >= 0) cmask(P0, P1, jb_, qrel, hi); } while (0)
  bool resc = false;
  #define RESC() do { if (resc) { asm volatile("s_waitcnt lgkmcnt(0)" ::: "memory"); \
      _Pragma("unroll") for (int d_ = 0; d_ < 4; ++d_) _Pragma("unroll") for (int r = 0; r < 16; ++r) o[d_][r] *= wsf[crow(r, hi)]; } } while (0)
  f32x16 C0, C1;
  int s_prev = 0, s_cur = 0, s_next = 1;
  #define ROT() do { s_prev = s_cur; s_cur = s_next; s_next = (s_next == NSLOT - 1) ? 0 : s_next + 1; } while (0)
  DMA_K(2, 2);
  WAIT_BAR(4);
  u32x4 pwA0, pwA1, pwA2, pwA3, pwB0, pwB1, pwB2, pwB3;
  #define PKW(P, B) cvtpk_s(P[B], P[B + 1])
  qkt(C0, C1, Kbase, qr, negm, r32, hi); asm volatile("s_nop 15\n\ts_nop 7" : "+v"(C0), "+v"(C1)); CMASK(C0, C1, 0);
  { const float rm = rowmax(C0, C1); mhat = fadd_s(mhat, rm);
    _Pragma("unroll") for (int r = 0; r < 16; ++r) { C0[r] = fsub_s(C0[r], rm); C1[r] = fsub_s(C1[r], rm); }
    _Pragma("unroll") for (int r = 0; r < 16; ++r) negm[r] = -mhat; asm volatile("" : "+v"(negm));
    float sacc = 0.f;
    _Pragma("unroll") for (int r = 0; r < 16; ++r) { C0[r] = __builtin_amdgcn_exp2f(C0[r]); C1[r] = __builtin_amdgcn_exp2f(C1[r]); }
    _Pragma("unroll") for (int r = 0; r < 16; ++r) sacc += C0[r] + C1[r];
    l_reg = sacc;
    pwA0 = (u32x4){PKW(C0, 0), PKW(C0, 2), PKW(C0, 4), PKW(C0, 6)}; pwA1 = (u32x4){PKW(C0, 8), PKW(C0, 10), PKW(C0, 12), PKW(C0, 14)};
    pwA2 = (u32x4){PKW(C1, 0), PKW(C1, 2), PKW(C1, 4), PKW(C1, 6)}; pwA3 = (u32x4){PKW(C1, 8), PKW(C1, 10), PKW(C1, 12), PKW(C1, 14)}; }
  WAIT_BAR(0);
  DMA_K(3, 0); DMA_V(1, 1);
  ROT();
  kload8(kf, kp0 + s_cur * KSLOT);
  WAIT_BAR(3);
  s16x4 vlo[8], vhi[8];
  #define PAF(w) __builtin_bit_cast(bf16x8, w)
  #define VFR(i) (bf16x8){vlo[i][0], vlo[i][1], vlo[i][2], vlo[i][3], vhi[i][0], vhi[i][1], vhi[i][2], vhi[i][3]}
  #define PIN(x) asm volatile("" : "+v"(x))
  #define MX3(a, b, c) __builtin_fmaxf(__builtin_fmaxf((a), (b)), (c))
  #define EX(v) __builtin_amdgcn_exp2f(v)
  #define VRD(s, f) do { vlo[s] = vtr(vp_ + (((f) >> 2) * 4096 + ((f) & 3) * 1024)); vhi[s] = vtr(vp_ + (((f) >> 2) * 4096 + ((f) & 3) * 1024 + 512)); } while (0)
  #define KRD(G, j) do { if (G) { kload2(kf, kp0 + s_next * KSLOT, j); SBAR(); } } while (0)
  #define GAPB(MF, X, B, PWW) do { MF; X[B] = EX(X[B]); X[B + 1] = EX(X[B + 1]); sacc += X[B]; sacc += X[B + 1]; PIN(sacc); PWW = PKW(X, B); PIN(PWW); SBAR(); } while (0)
  #define MFQ(a, b, c) __builtin_amdgcn_mfma_f32_32x32x16_bf16(a, b, c, 0, 0, 0)
  #define STEP(PP0, PP1, PP2, PP3, PN0, PN1, PN2, PN3, t, GK, GV, GL) do { SBAR(); \
    const lds_cptr vp_ = vp0 + s_prev * VSLOT; \
    VRD(0, 0); SBAR(); C0 = MFQ(kf[0], qr[0], negm); SBAR(); \
    VRD(4, 4); SBAR(); C1 = MFQ(kf[1], qr[0], negm); SBAR(); \
    VRD(1, 1); SBAR(); C0 = MFQ(kf[2], qr[1], C0); SBAR(); \
    VRD(5, 5); SBAR(); C1 = MFQ(kf[3], qr[1], C1); SBAR(); \
    VRD(2, 2); SBAR(); C0 = MFQ(kf[4], qr[2], C0); SBAR(); \
    VRD(6, 6); SBAR(); C1 = MFQ(kf[5], qr[2], C1); SBAR(); \
    VRD(3, 3); SBAR(); C0 = MFQ(kf[6], qr[3], C0); SBAR(); \
    VRD(7, 7); SBAR(); C1 = MFQ(kf[7], qr[3], C1); SBAR(); \
    if (GK) { DMA_K((t) + 3, s_cur); } if (GV) { DMA_V((t) + 1, s_next); } \
    CMASK(C0, C1, t); \
    { float a = MX3(C0[0], C0[1], C1[0]), b = MX3(C0[2], C0[3], C1[1]); a = MX3(a, C1[2], C1[3]); \
      _Pragma("unroll") for (int r = 4; r < 16; r += 4) { a = MX3(a, C0[r], C0[r + 1]); b = MX3(b, C0[r + 2], C0[r + 3]); a = MX3(a, C1[r], C1[r + 1]); b = MX3(b, C1[r + 2], C1[r + 3]); } \
      float rm = __builtin_fmaxf(a, b); { auto rr = __builtin_amdgcn_permlane32_swap(__float_as_uint(rm), __float_as_uint(rm), false, false); rm = __builtin_fmaxf(__uint_as_float(rr[0]), __uint_as_float(rr[1])); } \
      resc = false; \
      if (__builtin_expect(__any(rm > (float)THRL), 0)) { const float dl = __builtin_fmaxf(rm, 0.f); mhat += dl; \
        _Pragma("unroll") for (int r = 0; r < 16; ++r) { C0[r] -= dl; C1[r] -= dl; } \
        _Pragma("unroll") for (int r = 0; r < 16; ++r) negm[r] = -mhat; asm volatile("" : "+v"(negm)); \
        const float f = __builtin_amdgcn_exp2f(-dl); l_reg *= f; if (hi == 0) wsf[r32] = f; resc = true; } } \
    SBAR(); float sacc = 0.f; \
    GAPB(o[0] = MFQ(PAF(PP0), VFR(0), o[0]), C0, 0,  PN0[0]); VRD(0, 8);  SBAR(); \
    GAPB(o[1] = MFQ(PAF(PP0), VFR(4), o[1]), C0, 2,  PN0[1]); VRD(4, 12); SBAR(); \
    GAPB(o[0] = MFQ(PAF(PP1), VFR(1), o[0]), C0, 4,  PN0[2]); VRD(1, 9);  SBAR(); \
    GAPB(o[1] = MFQ(PAF(PP1), VFR(5), o[1]), C0, 6,  PN0[3]); VRD(5, 13); SBAR(); \
    GAPB(o[0] = MFQ(PAF(PP2), VFR(2), o[0]), C0, 8,  PN1[0]); VRD(2, 10); SBAR(); \
    GAPB(o[1] = MFQ(PAF(PP2), VFR(6), o[1]), C0, 10, PN1[1]); VRD(6, 14); SBAR(); \
    GAPB(o[0] = MFQ(PAF(PP3), VFR(3), o[0]), C0, 12, PN1[2]); VRD(3, 11); SBAR(); \
    GAPB(o[1] = MFQ(PAF(PP3), VFR(7), o[1]), C0, 14, PN1[3]); VRD(7, 15); SBAR(); \
    GAPB(o[2] = MFQ(PAF(PP0), VFR(0), o[2]), C1, 0,  PN2[0]); \
    GAPB(o[3] = MFQ(PAF(PP0), VFR(4), o[3]), C1, 2,  PN2[1]); \
    KRD(GL, 0); GAPB(o[2] = MFQ(PAF(PP1), VFR(1), o[2]), C1, 4,  PN2[2]); \
    KRD(GL, 1); GAPB(o[3] = MFQ(PAF(PP1), VFR(5), o[3]), C1, 6,  PN2[3]); \
    KRD(GL, 2); GAPB(o[2] = MFQ(PAF(PP2), VFR(2), o[2]), C1, 8,  PN3[0]); \
    KRD(GL, 3); GAPB(o[3] = MFQ(PAF(PP2), VFR(6), o[3]), C1, 10, PN3[1]); \
    GAPB(o[2] = MFQ(PAF(PP3), VFR(3), o[2]), C1, 12, PN3[2]); \
    GAPB(o[3] = MFQ(PAF(PP3), VFR(7), o[3]), C1, 14, PN3[3]); \
    l_reg += sacc; \
    } while (0)
  #define STEP_AB(t, GK, GV, GL) STEP(pwA0, pwA1, pwA2, pwA3, pwB0, pwB1, pwB2, pwB3, t, GK, GV, GL)
  #define STEP_BA(t, GK, GV, GL) STEP(pwB0, pwB1, pwB2, pwB3, pwA0, pwA1, pwA2, pwA3, t, GK, GV, GL)
  int t = 1;
  #undef CMASK
  #define CMASK(P0, P1, t) do {} while (0)
  for (; t + 5 < NT; t += 2) {
    STEP_AB(t, true, true, true);     WAIT_BAR(3); RESC(); ROT();
    STEP_BA(t + 1, true, true, true); WAIT_BAR(3); RESC(); ROT();
  }
  #undef CMASK
  #define CMASK(P0, P1, t) do { int jb_ = (t) - (NT - 4); if (jb_ >= 0) cmask(P0, P1, jb_, qrel, hi); } while (0)
  #define ENDW(tt) do { if ((tt) + 3 < NT) { WAIT_BAR(3); } else if ((tt) + 2 < NT) { WAIT_BAR(2); } else { WAIT_BAR(0); } } while (0)
  for (; t + 1 < NT; t += 2) {
    STEP_AB(t, (t + 3 < NT), (t + 1 < NT), (t + 1 < NT));         ENDW(t);     RESC(); ROT();
    STEP_BA(t + 1, (t + 4 < NT), (t + 2 < NT), (t + 2 < NT));     ENDW(t + 1); RESC(); ROT();
  }
  STEP_AB(NT - 1, false, false, false); RESC();
  { SBAR();
    const int vb = vb0 + s_cur * VSLOT;
    #pragma unroll
    for (int d0 = 0; d0 < 4; ++d0) { s16x4 lo[4], hh[4];
      #pragma unroll
      for (int ks = 0; ks < 4; ++ks) {
        asm volatile("ds_read_b64_tr_b16 %0,%1 offset:%c2" : "=&v"(lo[ks]) : "v"(vb), "i"(d0 * 4096 + ks * 1024) : "memory");
        asm volatile("ds_read_b64_tr_b16 %0,%1 offset:%c2" : "=&v"(hh[ks]) : "v"(vb), "i"(d0 * 4096 + ks * 1024 + 512) : "memory"); }
      asm volatile("s_waitcnt lgkmcnt(0)" ::: "memory"); SBAR();
      #define PK(k) (bf16x8){lo[k][0], lo[k][1], lo[k][2], lo[k][3], hh[k][0], hh[k][1], hh[k][2], hh[k][3]}
      o[d0] = MFQ(PAF(pwB0), PK(0), o[d0]); o[d0] = MFQ(PAF(pwB1), PK(1), o[d0]); o[d0] = MFQ(PAF(pwB2), PK(2), o[d0]); o[d0] = MFQ(PAF(pwB3), PK(3), o[d0]);
      #undef PK
    } }
  { auto rr = __builtin_amdgcn_permlane32_swap(__float_as_uint(l_reg), __float_as_uint(l_reg), false, false); l_reg = __uint_as_float(rr[0]) + __uint_as_float(rr[1]); }
  if (hi == 0) wsf[32 + r32] = l_reg; asm volatile("s_waitcnt lgkmcnt(0)" ::: "memory");
  float rli[16];
  #pragma unroll
  for (int r = 0; r < 16; ++r) rli[r] = __builtin_amdgcn_rcpf(wsf[32 + crow(r, hi)]);
  int lane_e = lane; asm volatile("" : "+v"(lane_e));
  const int erow = lane_e >> 3, ech = lane_e & 7;
  bf16* Ow = O + (rowbase + q0 + wid * QBLK) * DMA + h * 128;
  bf16* stg = (bf16*)(shm + L_OST) + wid * 2048;
  if (mode == 0) {
    #pragma unroll
    for (int ps = 0; ps < 2; ++ps) {
      #pragma unroll
      for (int r = 0; r < 16; ++r) { const int orow = crow(r, hi);
        #pragma unroll
        for (int d0 = 0; d0 < 2; ++d0) stg[orow * 64 + d0 * 32 + r32] = f2bf(o[2 * ps + d0][r] * rli[r]); }
      asm volatile("s_waitcnt lgkmcnt(0)" ::: "memory");
      #pragma unroll
      for (int i = 0; i < 4; ++i) { const int row = i * 8 + erow, ch = ech; const u32x4 v = *(const u32x4*)(stg + row * 64 + ch * 8); *(u32x4*)(Ow + (long)row * DMA + ps * 64 + ch * 8) = v; }
      asm volatile("s_waitcnt lgkmcnt(0)" ::: "memory");
    }
    asm volatile("s_waitcnt vmcnt(0)" ::: "memory");
  } else {
    const bf16* Zw = SZ1 + (rowbase + q0 + wid * QBLK) * DMA + h * 128; bf16* Gw = OG + (rowbase + q0 + wid * QBLK) * DMA + h * 128;
    float dk[2][4][8]; float ss[4] = {0.f, 0.f, 0.f, 0.f};
    #pragma unroll
    for (int ps = 0; ps < 2; ++ps) {
      #pragma unroll
      for (int r = 0; r < 16; ++r) { const int orow = crow(r, hi);
        #pragma unroll
        for (int d0 = 0; d0 < 2; ++d0) stg[orow * 64 + d0 * 32 + r32] = f2bf(o[2 * ps + d0][r] * rli[r]); }
      asm volatile("s_waitcnt lgkmcnt(0)" ::: "memory");
      #pragma unroll
      for (int i = 0; i < 4; ++i) { const int row = i * 8 + erow, ch = ech;
        const u32x4 v1 = *(const u32x4*)(stg + row * 64 + ch * 8); const u32x4 v0 = *(const u32x4*)(Ow + (long)row * DMA + ps * 64 + ch * 8);
        #pragma unroll
        for (int j = 0; j < 4; ++j) { const float a0 = __uint_as_float(v0[j] << 16), a1 = __uint_as_float(v0[j] & 0xffff0000u), b0 = __uint_as_float(v1[j] << 16), b1 = __uint_as_float(v1[j] & 0xffff0000u);
          const float d0_ = a0 - lam * b0, d1_ = a1 - lam * b1; dk[ps][i][2 * j] = d0_; dk[ps][i][2 * j + 1] = d1_; ss[i] += d0_ * d0_ + d1_ * d1_; } }
      asm volatile("s_waitcnt lgkmcnt(0)" ::: "memory");
    }
    #pragma unroll
    for (int i = 0; i < 4; ++i) { float t_ = ss[i]; t_ += __shfl_xor(t_, 1); t_ += __shfl_xor(t_, 2); t_ += __shfl_xor(t_, 4); ss[i] = rsqrtf(t_ * (1.0f / 128.0f) + RMS_EPS) * ONE_M_LI; }
    #pragma unroll
    for (int ps = 0; ps < 2; ++ps) {
      const int ch = ech; const float* gp = g_sub + ps * 64 + ch * 8; const f32x4_t g0 = *(const f32x4_t*)gp, g1 = *(const f32x4_t*)(gp + 4);
      #pragma unroll
      for (int i = 0; i < 4; ++i) { const int row = i * 8 + erow;
        const u32x4 z = *(const u32x4*)(Zw + (long)row * DMA + ps * 64 + ch * 8); u32x4 w;
        #pragma unroll
        for (int j = 0; j < 4; ++j) { const float z0 = __uint_as_float(z[j] << 16), z1 = __uint_as_float(z[j] & 0xffff0000u);
          const float ga = (j < 2) ? g0[2 * j] : g1[2 * j - 4], gb = (j < 2) ? g0[2 * j + 1] : g1[2 * j - 3];
          w[j] = cvtpk_s(dk[ps][i][2 * j] * ss[i] * ga * z0, dk[ps][i][2 * j + 1] * ss[i] * gb * z1); }
        *(u32x4*)(Gw + (long)row * DMA + ps * 64 + ch * 8) = w; }
    }
  }
  asm volatile("s_waitcnt lgkmcnt(0)\n\ts_barrier" ::: "memory");
  #undef DMA_K
  #undef DMA_V
  #undef CMASK
  #undef RESC
  #undef ROT
  #undef PKW
  #undef PAF
  #undef VFR
  #undef PIN
  #undef MX3
  #undef EX
  #undef VRD
  #undef KRD
  #undef GAPB
  #undef MFQ
  #undef STEP
  #undef STEP_AB
  #undef STEP_BA
  #undef ENDW
}
#undef SBAR
#undef WAIT_BAR
}

constexpr int NWAVES = 8;
constexpr size_t MiB = 1u << 20;
constexpr size_t WS_CTL = 0, CTL_ZERO_BYTES = 1 * MiB;
constexpr size_t WS_MOD = 256 * 1024;
constexpr size_t WS_LAM = 1 * MiB;
constexpr size_t WS_LB16 = 1 * MiB + 4096;
constexpr size_t WS_WIN0 = 2 * MiB, WS_WGLU = 6 * MiB, WS_WOUT0 = 8 * MiB, WS_WKV = 10 * MiB, WS_WIN1 = 14 * MiB, WS_WOUT1 = 18 * MiB;
constexpr size_t WS_BTA = 20 * MiB;
constexpr size_t WS_BTB = 28 * MiB;
constexpr size_t WS_S0 = 48 * MiB, WS_S1 = 112 * MiB, WS_S2 = 176 * MiB, WS_S3 = 240 * MiB, WS_S4 = 304 * MiB, WS_S5 = 368 * MiB, WS_S6 = 432 * MiB, WS_END = 496 * MiB;
constexpr int CW_BAR = 4096;
constexpr int CW_TMO = 8, CW_SEAM = 16384, SEAM_BANK = 128 * 64;
constexpr size_t WS_XCH = 40 * MiB;
constexpr int RING_OFF = 0, RING_BYTES = 131072;
constexpr int LDSCTL_OFF = RING_BYTES, MISC_OFF = LDSCTL_OFF + 320;
constexpr int LDS_BYTES = 147456;

#define GAS __attribute__((address_space(1)))
#define LAS __attribute__((address_space(3)))
typedef unsigned v4u __attribute__((ext_vector_type(4)));
typedef GAS unsigned gu32;
#define RLX_AGENT __ATOMIC_RELAXED, __HIP_MEMORY_SCOPE_AGENT
#define LDS_WAIT() asm volatile("s_waitcnt lgkmcnt(0)" ::: "memory")
#define VM_WAIT() asm volatile("s_waitcnt vmcnt(0)" ::: "memory")

#define XB_TMO      128
#define XB_XCNT(j)  (256  + 64 * (j))
#define XB_XSUB(j)  (1280 + 64 * (j))
#define XB_XGEN(j)  (2304 + 64 * (j))
#define XB_TOP      3328
#define XB_TOPGEN   3392
#define XCD_BAR_WORDS 3456
#define XB_SPIN_CAP (1u << 18)
__device__ __forceinline__ unsigned xb_ld(unsigned* p)              { return __hip_atomic_load(p, __ATOMIC_RELAXED, __HIP_MEMORY_SCOPE_AGENT); }
__device__ __forceinline__ unsigned xb_add(unsigned* p, unsigned v) { return __hip_atomic_fetch_add(p, v, __ATOMIC_RELAXED, __HIP_MEMORY_SCOPE_AGENT); }
__device__ __forceinline__ unsigned xb_xcc_id() { return (unsigned)__builtin_amdgcn_s_getreg((3 << 11) | 20) & 0xFu; }
#define XB_SPIN(cond, bar) do { unsigned _sp = 0; while (cond) { __builtin_amdgcn_s_sleep(1); \
    if ((++_sp & 255u) == 0u) { if (xb_ld(&(bar)[XB_TMO])) break; if (_sp > XB_SPIN_CAP) { atomicAdd(&(bar)[XB_TMO], 1u); break; } } } } while (0)
struct XcdBarrier { unsigned* bar; unsigned x; volatile LAS unsigned* st; };
__device__ __forceinline__ XcdBarrier xcd_barrier_post(unsigned* bar, volatile LAS unsigned* st, int tid) {
    XcdBarrier b; b.bar = bar; b.x = xb_xcc_id(); b.st = st;
    if (tid == 0) (void)xb_add(&bar[XB_XCNT(b.x)], 1u);
    return b;
}
__device__ __forceinline__ void xcd_barrier_complete(unsigned* bar, unsigned x, unsigned& nloc, unsigned& nx) {
    const unsigned G = gridDim.x * gridDim.y * gridDim.z;
    unsigned sum, cnt, mine, sp = 0u;
    for (;;) {
        sum = 0u; cnt = 0u; mine = 0u;
#pragma unroll
        for (unsigned j = 0; j < 16; ++j) { const unsigned c = xb_ld(&bar[XB_XCNT(j)]); sum += c; cnt += (c > 0u) ? 1u : 0u; mine = (j == x) ? c : mine; }
        if (sum == G) break;
        __builtin_amdgcn_s_sleep(1);
        if ((++sp & 255u) == 0u) { if (xb_ld(&bar[XB_TMO])) break; if (sp > XB_SPIN_CAP) { atomicAdd(&bar[XB_TMO], 1u); break; } }
    }
    nloc = mine > 0u ? mine : 1u; nx = cnt > 0u ? cnt : 1u;
}
__device__ __forceinline__ void xcd_barrier(const XcdBarrier& b, int tid) {
    asm volatile("s_waitcnt vmcnt(0)" ::: "memory");
    __syncthreads();
    if (tid == 0) {
        unsigned* bar = b.bar;
        __builtin_amdgcn_s_waitcnt(0);
        unsigned nloc = b.st[0], nx = b.st[1];
        if (nloc == 0u) { xcd_barrier_complete(bar, b.x, nloc, nx); b.st[0] = nloc; b.st[1] = nx; }
        const unsigned old = xb_add(&bar[XB_XSUB(b.x)], 1u);
        const unsigned gen = old / nloc;
        if (old + 1u == (gen + 1u) * nloc) {
            __builtin_amdgcn_fence(__ATOMIC_RELEASE, "agent");
            asm volatile("s_waitcnt vmcnt(0)" ::: "memory");
            const unsigned og = xb_add(&bar[XB_TOP], 1u);
            const unsigned tg = og / nx;
            if (og + 1u == (tg + 1u) * nx) xb_add(&bar[XB_TOPGEN], 1u);
            else XB_SPIN(xb_ld(&bar[XB_TOPGEN]) == tg, bar);
            __builtin_amdgcn_fence(__ATOMIC_ACQUIRE, "agent");
            xb_add(&bar[XB_XGEN(b.x)], 1u);
            asm volatile("s_waitcnt vmcnt(0)" ::: "memory");
        } else {
            XB_SPIN(xb_ld(&bar[XB_XGEN(b.x)]) == gen, bar);
            __builtin_amdgcn_fence(__ATOMIC_ACQUIRE, "agent");
            asm volatile("s_waitcnt vmcnt(0)" ::: "memory");
        }
    }
    __syncthreads();
}

__device__ __forceinline__ void p0_transpose_item(const float* W, int K, int N, bf16_t* WT, int row_off, const float* kscale, LAS float* scr, int item, int lane) {
    const int nblk = N / 32, kb = item / nblk, nb = item % nblk, k0 = 64 * kb, n0 = 32 * nb;
#pragma unroll 8
    for (int i = 0; i < 32; ++i) { const int kk = 2 * i + (lane >> 5); float v = W[(size_t)(k0 + kk) * N + n0 + (lane & 31)]; if (kscale) v *= kscale[k0 + kk]; scr[kk * 33 + (lane & 31)] = v; }
    LDS_WAIT(); asm volatile("" ::: "memory");
    const int c = lane & 7;
#pragma unroll
    for (int j = 0; j < 4; ++j) { const int n = (lane >> 3) + 8 * j; const LAS float* s = scr + (8 * c) * 33 + n;
        v4u o; o.x = pk2bf(s[0 * 33], s[1 * 33]); o.y = pk2bf(s[2 * 33], s[3 * 33]); o.z = pk2bf(s[4 * 33], s[5 * 33]); o.w = pk2bf(s[6 * 33], s[7 * 33]);
        *(GAS v4u*)(WT + (size_t)(row_off + n0 + n) * K + k0 + 8 * c) = o; }
    LDS_WAIT(); asm volatile("" ::: "memory");
}

__device__ __forceinline__ int lane_now_asm() { int r; asm volatile("v_mbcnt_lo_u32_b32 %0, -1, 0\n\tv_mbcnt_hi_u32_b32 %0, -1, %0" : "=v"(r)); return r; }
struct Args {
    const float* in[28]; float* out; unsigned char* ws;
    int ph_lo, ph_hi, use_bar, flags;
};

__global__ void __launch_bounds__(NWAVES * 64, 2) mega_fwd(Args args) {
    extern __shared__ __attribute__((aligned(16))) unsigned char lds_raw[];
    LAS unsigned char* lds = (LAS unsigned char*)lds_raw;
    volatile LAS unsigned* MISC = (volatile LAS unsigned*)(lds + MISC_OFF);
    const int wave = __builtin_amdgcn_readfirstlane((int)threadIdx.x >> 6);
#define LANE_NOW() lane_now_asm()
#define TID_NOW() (wave * 64 + LANE_NOW())
    const int G = gridDim.x; const int bx = blockIdx.x; const int vcu = (G % 8 == 0) ? (bx % 8) * (G / 8) + bx / 8 : bx;
    unsigned char* ws = args.ws;
    gu32* ctl = (gu32*)(ws + WS_CTL);
    const float* x = args.in[0]; const float* cvec = args.in[1]; const float* ada_w = args.in[2]; const float* ada_b = args.in[3];
    const float* g_pre = args.in[4]; const float* g_post = args.in[5];
    float* out = args.out;
    float* mod = (float*)(ws + WS_MOD); float* lamp = (float*)(ws + WS_LAM); float* lb16 = (float*)(ws + WS_LB16);
    bf16_t* Win0 = (bf16_t*)(ws + WS_WIN0); bf16_t* Wglu = (bf16_t*)(ws + WS_WGLU); bf16_t* Wout0 = (bf16_t*)(ws + WS_WOUT0); bf16_t* Wkv = (bf16_t*)(ws + WS_WKV);
    bf16_t* Win1 = (bf16_t*)(ws + WS_WIN1); bf16_t* Wout1 = (bf16_t*)(ws + WS_WOUT1); bf16_t* BtA = (bf16_t*)(ws + WS_BTA); bf16_t* BtB = (bf16_t*)(ws + WS_BTB);
    bf16_t* A0 = (bf16_t*)(ws + WS_S0); bf16_t* US = (bf16_t*)(ws + WS_S1); bf16_t* SZ = (bf16_t*)(ws + WS_S3); bf16_t* YG = (bf16_t*)(ws + WS_S4); float* EB = (float*)(ws + WS_S0);
    bf16_t* Y2 = (bf16_t*)(ws + WS_S0); bf16_t* YO = (bf16_t*)(ws + WS_S1); bf16_t* AKV = (bf16_t*)(ws + WS_S0); bf16_t* AIN1 = (bf16_t*)(ws + WS_S2);
    bf16_t* KB = (bf16_t*)(ws + WS_S3); bf16_t* VB = (bf16_t*)(ws + WS_S4); bf16_t* QB = (bf16_t*)(ws + WS_S5); bf16_t* SZ1 = (bf16_t*)(ws + WS_S6);
    bf16_t* O0 = (bf16_t*)(ws + WS_S0); bf16_t* O1 = (bf16_t*)(ws + WS_S1); bf16_t* OG = (bf16_t*)(ws + WS_S2); bf16_t* YO1 = (bf16_t*)(ws + WS_S0);

    for (int u = TID_NOW(); u < (LDS_BYTES - LDSCTL_OFF) / 4; u += NWAVES * 64) ((LAS unsigned*)(lds + LDSCTL_OFF))[u] = 0u;
    __syncthreads();
    XcdBarrier bar; bar.bar = (unsigned*)(ctl + CW_BAR); bar.x = 0; bar.st = nullptr;
    if (args.use_bar) bar = xcd_barrier_post((unsigned*)(ctl + CW_BAR), MISC + 8, TID_NOW());
    const int lo = args.ph_lo, hi = args.ph_hi;
#define IN(k) (lo <= (k) && (k) < hi)
#define REPS(k) (1 + ((REPEAT_MASK >> (k)) & 1))
#define SEAM(k) do { if (IN(k) && IN((k) + 1) && args.use_bar) xcd_barrier(bar, TID_NOW()); } while (0)
    const int gw = vcu * NWAVES + wave, NGW = G * NWAVES;
#define LANE_L() ({ int l_ = LANE_NOW(); asm volatile("" : "+v"(l_)); l_; })

    if (IN(0)) for (int rep_ = 0; rep_ < REPS(0); ++rep_) {
        const int tid = TID_NOW(), lane = tid & 63;
        for (int it = vcu; it < NGRP * 4; it += G) {
            const int g = it >> 2, qt = it & 3;
            LAS float* LBP = (LAS float*)(lds + RING_OFF);
            LAS float* BBR = LBP + 17 * 128;
            LAS float* CC = BBR + 64 * 32;
            LAS float* KM = CC + 16 * 128;
            __syncthreads();
            if (tid < 64) {
                const int p = tid;
                const float dt = expf(args.in[9][g]);
                const float lr = args.in[7][g * 64 + p], li = args.in[8][g * 64 + p];
                const float mag = expf(lr * dt); const float sn = sinf(li * dt), cs = cosf(li * dt);
                const float lbr = mag * cs, lbi = mag * sn;
                float pr = 1.f, pi = 0.f;
                for (int d = 0; d <= 16; ++d) { LBP[(d * 64 + p) * 2] = pr; LBP[(d * 64 + p) * 2 + 1] = pi; const float nr = pr * lbr - pi * lbi, ni = pr * lbi + pi * lbr; pr = nr; pi = ni; }
                if (qt == 0) { lb16[(g * 64 + p) * 2] = LBP[(16 * 64 + p) * 2]; lb16[(g * 64 + p) * 2 + 1] = LBP[(16 * 64 + p) * 2 + 1]; }
                const float nr = lbr - 1.0f, ni = lbi, den = lr * lr + li * li;
                const float cr = (nr * lr + ni * li) / den, ci = (ni * lr - nr * li) / den;
                for (int c = 0; c < 16; ++c) { const float br = args.in[10][(g * 64 + p) * 16 + c], bi = args.in[11][(g * 64 + p) * 16 + c];
                    BBR[(p * 16 + c) * 2] = cr * br - ci * bi; BBR[(p * 16 + c) * 2 + 1] = cr * bi + ci * br; }
            }
            for (int e = tid; e < 1024; e += 512) { const int co = e >> 6, p = e & 63; CC[e * 2] = args.in[12][(g * 16 + co) * 64 + p]; CC[e * 2 + 1] = args.in[13][(g * 16 + co) * 64 + p]; }
            __syncthreads();
            for (int e = tid; e < 4096; e += 512) {
                const int d = e >> 8, co = (e >> 4) & 15, ci = e & 15; float acc = 0.f;
                for (int p = 0; p < 64; ++p) { const float cr = CC[(co * 64 + p) * 2], cim = CC[(co * 64 + p) * 2 + 1], lr = LBP[(d * 64 + p) * 2], lim = LBP[(d * 64 + p) * 2 + 1];
                    const float wr_ = cr * lr - cim * lim, wi_ = cr * lim + cim * lr; acc += wr_ * BBR[(p * 16 + ci) * 2] - wi_ * BBR[(p * 16 + ci) * 2 + 1]; }
                KM[e] = acc; }
            __syncthreads();
            for (int e = tid; e < 64 * 48; e += 512) {
                const int n = 64 * qt + e / 48, pc = e % 48, s = n >> 4, co = n & 15; float v[8];
                if (pc < 32) { const int s2 = pc >> 1, ci0 = (pc & 1) * 8;
#pragma unroll
                    for (int j = 0; j < 8; ++j) v[j] = (s2 <= s) ? KM[((s - s2) * 16 + co) * 16 + ci0 + j] : 0.f;
                } else { const int j0 = (pc - 32) * 8;
#pragma unroll
                    for (int jj = 0; jj < 4; ++jj) { const int p = (j0 >> 1) + jj; const float cr = CC[(co * 64 + p) * 2], cim = CC[(co * 64 + p) * 2 + 1], lr = LBP[((s + 1) * 64 + p) * 2], lim = LBP[((s + 1) * 64 + p) * 2 + 1];
                        v[2 * jj] = cr * lr - cim * lim; v[2 * jj + 1] = -(cr * lim + cim * lr); } }
                v4u o; o.x = pk2bf(v[0], v[1]); o.y = pk2bf(v[2], v[3]); o.z = pk2bf(v[4], v[5]); o.w = pk2bf(v[6], v[7]);
                *(GAS v4u*)(BtB + ((size_t)g * 256 + n) * 384 + pc * 8) = o; }
            for (int e = tid; e < 64 * 32; e += 512) {
                const int n = 64 * qt + (e >> 5), pc = e & 31; float v[8];
                if (n < 128) { const int p = n >> 1, ri = n & 1, s2 = pc >> 1, ci0 = (pc & 1) * 8; const float lr = LBP[((15 - s2) * 64 + p) * 2], lim = LBP[((15 - s2) * 64 + p) * 2 + 1];
#pragma unroll
                    for (int j = 0; j < 8; ++j) { const float br = BBR[(p * 16 + ci0 + j) * 2], bi = BBR[(p * 16 + ci0 + j) * 2 + 1]; v[j] = ri ? (lr * bi + lim * br) : (lr * br - lim * bi); }
                } else {
#pragma unroll
                    for (int j = 0; j < 8; ++j) v[j] = 0.f; }
                v4u o; o.x = pk2bf(v[0], v[1]); o.y = pk2bf(v[2], v[3]); o.z = pk2bf(v[4], v[5]); o.w = pk2bf(v[6], v[7]);
                *(GAS v4u*)(BtA + ((size_t)g * 256 + n) * 256 + pc * 8) = o; }
        }
        __syncthreads();
        {
            LAS float* scr = (LAS float*)(lds + RING_OFF + wave * 16384);
            constexpr int I_2K = (DM / 64) * (2048 / 32), I_1K = (DM / 64) * (1024 / 32);
            constexpr int NITEMS = 2 * I_2K + 5 * I_1K;
            for (int it = gw; it < NITEMS; it += NGW) {
                int r = it;
                if (r < I_2K) { p0_transpose_item(args.in[6], DM, 2048, Win0, 0, nullptr, scr, r, lane); continue; } r -= I_2K;
                if (r < I_2K) { p0_transpose_item(args.in[21], DM, 2048, Win1, 0, nullptr, scr, r, lane); continue; } r -= I_2K;
                if (r < I_1K) { p0_transpose_item(args.in[15], DM, 1024, Wglu, 0, nullptr, scr, r, lane); continue; } r -= I_1K;
                if (r < I_1K) { p0_transpose_item(args.in[17], DM, 1024, Wout0, 0, nullptr, scr, r, lane); continue; } r -= I_1K;
                if (r < I_1K) { p0_transpose_item(args.in[19], DM, 1024, Wkv, 0, args.in[18], scr, r, lane); continue; } r -= I_1K;
                if (r < I_1K) { p0_transpose_item(args.in[20], DM, 1024, Wkv, 1024, args.in[18], scr, r, lane); continue; } r -= I_1K;
                p0_transpose_item(args.in[27], DM, 1024, Wout1, 0, nullptr, scr, r, lane);
            }
        }
        if (!(args.flags & 1)) {
            __syncthreads();
            LAS float* sc = (LAS float*)(lds + RING_OFF);
            LAS float* red = sc + 8192;
            bool have = false;
            for (int it = vcu; it < 2 * 48; it += G) {
                if (!have) { for (int e = tid; e < 8192; e += 512) sc[e] = silu_f(cvec[e]); have = true; __syncthreads(); }
                const int l = it / 48, cc = it % 48, j = cc * 64 + lane;
                float acc[8];
#pragma unroll
                for (int b = 0; b < 8; ++b) acc[b] = 0.f;
                const float* wp = ada_w + ((size_t)l * 1024 + wave * 128) * 3072 + j;
                for (int k0 = 0; k0 < 128; k0 += 8) {
                    float w[8];
#pragma unroll
                    for (int kk = 0; kk < 8; ++kk) w[kk] = wp[(size_t)(k0 + kk) * 3072];
#pragma unroll
                    for (int kk = 0; kk < 8; ++kk)
#pragma unroll
                        for (int b = 0; b < 8; ++b) acc[b] += w[kk] * sc[b * 1024 + wave * 128 + k0 + kk];
                }
#pragma unroll
                for (int b = 0; b < 8; ++b) red[(wave * 8 + b) * 64 + lane] = acc[b];
                __syncthreads();
                { const int b = tid >> 6; float sum = ada_b[l * 3072 + j];
#pragma unroll
                  for (int w = 0; w < 8; ++w) sum += red[(w * 8 + b) * 64 + lane];
                  mod[((size_t)(l * 8 + b)) * 3072 + j] = sum; }
                __syncthreads();
            }
            if (bx == 0 && tid == 0) lamp[0] = diff_lambda(args.in[22], args.in[23], args.in[24], args.in[25]);
        }
    }
    SEAM(0);
    if (IN(1)) for (int rep_ = 0; rep_ < REPS(1); ++rep_) e_norm0(x, mod, g_pre, A0, gw, NGW, LANE_L());
    SEAM(1);
    if (IN(2)) for (int rep_ = 0; rep_ < REPS(2); ++rep_) {
        pg8::Gemm g = pg8::gemm_std(A0, DM, Win0, DM, DM); pg8::Order S; S.init(MTOK / 256, 2048 / 256, 1, G, bx);
        pg8::EpiRow8<pg8::F_In0> E{{US, SZ}};
        pg8::gemm_phase<pg8::EpiRow8<pg8::F_In0>, ALIGN_E>(lds + RING_OFF, g, S, E, TID_NOW());
    }
    SEAM(2);
    if (IN(3)) for (int rep_ = 0; rep_ < REPS(3); ++rep_) {
        pg8::Gemm g = pg8::gemm_std(US, US_P, BtA, 256, 256); g.a_gstep = (size_t)NTILE * US_P * 2; g.b_gstep = (size_t)256 * 256 * 2;
        pg8::Order S; S.init(NTILE / 256, 1, NGRP, G, bx);
        pg8::EpiRow8<pg8::F_SsmA> E{{EB}};
        pg8::gemm_phase<pg8::EpiRow8<pg8::F_SsmA>, ALIGN_E>(lds + RING_OFF, g, S, E, TID_NOW());
    }
    SEAM(3);
    if (IN(4)) for (int rep_ = 0; rep_ < REPS(4); ++rep_) {
        for (int it = vcu + G * wave; it < NB * NGRP; it += G * NWAVES) {
            const int b = it / NGRP, g = it % NGRP, p = LANE_L();
            const float lr = lb16[(g * 64 + p) * 2], li = lb16[(g * 64 + p) * 2 + 1];
            float sr = 0.f, si = 0.f;
            const float* ep = EB + ((size_t)g * NTILE + b * 256) * 128 + 2 * p;
            bf16_t* sp = US + us_off(g, b * 256, 256 + 2 * p);
            for (int t0 = 0; t0 < 256; t0 += 16) {
                float er[16], ei[16];
#pragma unroll
                for (int j = 0; j < 16; ++j) { const float2 e = *(const float2*)(ep + (size_t)(t0 + j) * 128); er[j] = e.x; ei[j] = e.y; }
#pragma unroll
                for (int j = 0; j < 16; ++j) { *(unsigned*)(sp + (size_t)(t0 + j) * US_P) = pk2bf(sr, si);
                    const float nr = lr * sr - li * si + er[j], ni = lr * si + li * sr + ei[j]; sr = nr; si = ni; }
            }
        }
    }
    SEAM(4);
    if (IN(5)) for (int rep_ = 0; rep_ < REPS(5); ++rep_) {
        pg8::Gemm g = pg8::gemm_std(US, US_P, BtB, 384, 384); g.a_gstep = (size_t)NTILE * US_P * 2; g.b_gstep = (size_t)256 * 384 * 2;
        pg8::Order S; S.init(NTILE / 256, 1, NGRP, G, bx);
        pg8::EpiRow8<pg8::F_SsmB> E{{US, args.in[14], YG}};
        pg8::gemm_phase<pg8::EpiRow8<pg8::F_SsmB>, ALIGN_E>(lds + RING_OFF, g, S, E, TID_NOW());
    }
    SEAM(5);
    if (IN(6)) for (int rep_ = 0; rep_ < REPS(6); ++rep_) {
        pg8::Gemm g = pg8::gemm_std(YG, DM, Wglu, DM, DM);
        g.a_rs = 32u; g.a_c16 = (unsigned)((size_t)NTILE * YG_P * 2); g.a_kstep = (size_t)4 * NTILE * YG_P * 2; g.a_tstep = (size_t)256 * 32;
        pg8::Order S; S.init(MTOK / 256, 1024 / 256, 1, G, bx);
        pg8::EpiRow8<pg8::F_Glu> E{{YG, SZ, args.in[16], Y2}};
        pg8::gemm_phase<pg8::EpiRow8<pg8::F_Glu>, ALIGN_E>(lds + RING_OFF, g, S, E, TID_NOW());
    }
    SEAM(6);
#if FUSE_EPI
    if (IN(7)) {
        pg8::Gemm g = pg8::gemm_std(Y2, DM, Wout0, DM, DM);
        for (int half = 0; half < 2; ++half) {
            pg8::Order S; S.init(MTOK / 512, 1024 / 256, 1, G, bx); S.pm_off = half * (MTOK / 512);
            pg8::PanelRms st1{(unsigned*)(ws + WS_XCH), (unsigned*)(ctl + CW_SEAM), (unsigned*)(ctl + CW_TMO), RMS_EPS};
            pg8::PanelRms st2{(unsigned*)(ws + WS_XCH + 1 * MiB), (unsigned*)(ctl + CW_SEAM + SEAM_BANK), (unsigned*)(ctl + CW_TMO), RMS_EPS};
            pg8::EpiMid E{x, out, AKV, AIN1, mod, g_post, g_pre + 1024, st1, st2};
            pg8::gemm_phase<pg8::EpiMid, false>(lds + RING_OFF, g, S, E, TID_NOW());
        }
    }
#else
    if (IN(7)) {
        pg8::Gemm g = pg8::gemm_std(Y2, DM, Wout0, DM, DM); pg8::Order S; S.init(MTOK / 256, 1024 / 256, 1, G, bx);
        pg8::EpiRow8<pg8::F_Plain> E{{YO}};
        pg8::gemm_phase<pg8::EpiRow8<pg8::F_Plain>, ALIGN_E>(lds + RING_OFF, g, S, E, TID_NOW());
    }
    SEAM(7);
    if (IN(8)) e_mid(x, YO, mod, g_post, g_pre, out, AKV, AIN1, gw, NGW, LANE_L());
#endif
    SEAM(8);
    if (IN(9)) for (int rep_ = 0; rep_ < REPS(9); ++rep_) {
        { pg8::Gemm g = pg8::gemm_std(AKV, DM, Wkv, DM, DM); pg8::Order S; S.init(MTOK / 256, 2048 / 256, 1, G, bx);
          pg8::EpiRow8<pg8::F_Split> E{{KB, VB, 1.0f, 0}};
          pg8::gemm_phase<pg8::EpiRow8<pg8::F_Split>, ALIGN_E>(lds + RING_OFF, g, S, E, TID_NOW()); }
        { pg8::Gemm g = pg8::gemm_std(AIN1, DM, Win1, DM, DM); pg8::Order S; S.init(MTOK / 256, 2048 / 256, 1, G, bx);
          pg8::EpiRow8<pg8::F_Split> E{{QB, SZ1, QC2, 1}};
          pg8::gemm_phase<pg8::EpiRow8<pg8::F_Split>, ALIGN_E>(lds + RING_OFF, g, S, E, TID_NOW()); }
    }
    SEAM(9);
    if (IN(10)) {
#if ATTN_V128
#if ATTN_FUSE_POST
        { const float lam = __int_as_float(__builtin_amdgcn_readfirstlane(__float_as_int(lamp[0])));
          for (int i = 0;; ++i) {
            const long L = (long)i * G + vcu; if (L >= 64 * 16) break;
            const int pr = (int)(L % 256), qi = (int)(L / 256);
            const int bh = pr >> 2, j = pr & 3;
            const int qb = (qi & 1) ? (8 * (qi >> 1) + 7 - j) : (8 * (qi >> 1) + j);
            const int h = bh & 7, b = bh >> 3;
#pragma unroll 1
            for (int cc = 0; cc < 2; ++cc) attn3::attn_unit<8>(TID_NOW(), b, 2 * h + cc, h, qb, QB, KB, VB, O0, (char*)lds_raw + RING_OFF, cc, SZ1, args.in[26], lam, OG);
          } }
#else
        for (int i = 0;; ++i) {
            const long L = (long)i * G + vcu; if (L >= 128 * 16) break;
            const int pr = (int)(L % 256), qi = (int)(L / 256);
            const int combo = pr >> 1, j = pr & 1;
            const int k4 = qi >> 1; const int qb = (qi & 1) ? (4 * k4 + 3 - j) : (4 * k4 + j);
            const int c = combo & 1, h = (combo >> 1) & 7, b = combo >> 4;
            attn3::attn_unit<8>(TID_NOW(), b, 2 * h + c, h, qb, QB, KB, VB, c ? O1 : O0, (char*)lds_raw + RING_OFF, 0, SZ1, args.in[26], 0.f, OG);
        }
#endif
#else
        for (int i = 0;; ++i) {
            const long L = (long)i * G + vcu; if (L >= 256 * 16) break;
            const int combo = (int)(L % 256), qi = (int)(L / 256);
            const int qb = (qi & 1) ? (qi >> 1) : (15 - (qi >> 1));
            const int vh = combo & 1, c = (combo >> 1) & 1, h = (combo >> 2) & 7, b = combo >> 5;
            attn_body::attn_unit<8>(TID_NOW(), b, 2 * h + c, 2 * h + vh, qb, QB, KB, VB, c ? O1 : O0, (char*)lds_raw + RING_OFF);
        }
#endif
    }
    SEAM(10);
#if !(ATTN_V128 && ATTN_FUSE_POST)
    if (IN(11)) for (int rep_ = 0; rep_ < REPS(11); ++rep_) e_attn_post(O0, O1, SZ1, args.in[26], lamp[0], OG, gw, NGW, LANE_L());
    SEAM(11);
#endif
#if FUSE_EPI
    if (IN(12)) {
        pg8::Gemm g = pg8::gemm_std(OG, DM, Wout1, DM, DM);
        for (int half = 0; half < 2; ++half) {
            pg8::Order S; S.init(MTOK / 512, 1024 / 256, 1, G, bx); S.pm_off = half * (MTOK / 512);
            pg8::PanelRms st{(unsigned*)(ws + WS_XCH + 2 * MiB), (unsigned*)(ctl + CW_SEAM + 2 * SEAM_BANK), (unsigned*)(ctl + CW_TMO), RMS_EPS};
            pg8::EpiFinal E{out, out, mod + 8 * 3072, g_post + 1024, st};
            pg8::gemm_phase<pg8::EpiFinal, false>(lds + RING_OFF, g, S, E, TID_NOW());
        }
    }
#else
    if (IN(12)) {
        pg8::Gemm g = pg8::gemm_std(OG, DM, Wout1, DM, DM); pg8::Order S; S.init(MTOK / 256, 1024 / 256, 1, G, bx);
        pg8::EpiRow8<pg8::F_Plain> E{{YO1}};
        pg8::gemm_phase<pg8::EpiRow8<pg8::F_Plain>, ALIGN_E>(lds + RING_OFF, g, S, E, TID_NOW());
    }
    SEAM(12);
    if (IN(13)) e_final(out, YO1, mod, g_post, gw, NGW, LANE_L());
#endif
#undef IN
#undef SEAM
}

#ifndef FASTMASK
#define FASTMASK 0x3fff
#endif
#ifndef ONE_LAUNCH
#define ONE_LAUNCH 1
#endif
constexpr int NPHASE = 14;

extern "C" void kernel_launch(void* const* d_in, const int* in_sizes, int n_in, void* d_out, int out_size, void* d_ws, size_t ws_size, hipStream_t stream) {
    static int grid = 0;
    if (grid == 0) {
        if (n_in != 28 || out_size != MTOK * DM || ws_size < WS_END) { fprintf(stderr, "kernel_launch: unexpected shapes (n_in %d out %d ws %zu)\n", n_in, out_size, ws_size); grid = -1; return; }
        int dev = 0, cus = 0, per_cu = 0;
        if (hipGetDevice(&dev) != hipSuccess || hipDeviceGetAttribute(&cus, hipDeviceAttributeMultiprocessorCount, dev) != hipSuccess) { grid = -1; return; }
        if (hipFuncSetAttribute((const void*)mega_fwd, hipFuncAttributeMaxDynamicSharedMemorySize, LDS_BYTES) != hipSuccess) { fprintf(stderr, "kernel_launch: hipFuncSetAttribute failed\n"); grid = -1; return; }
        if (hipOccupancyMaxActiveBlocksPerMultiprocessor(&per_cu, (const void*)mega_fwd, NWAVES * 64, LDS_BYTES) != hipSuccess || per_cu < 1) { fprintf(stderr, "kernel_launch: occupancy query says %d\n", per_cu); }
        (void)hipGetLastError();
        grid = cus;
    }
    if (grid < 0) return;
    if (hipMemsetAsync((char*)d_ws + WS_CTL, 0, CTL_ZERO_BYTES, stream) != hipSuccess) { fprintf(stderr, "kernel_launch: memset failed\n"); return; }
    Args a{};
    for (int i = 0; i < 28; ++i) a.in[i] = (const float*)d_in[i];
    a.out = (float*)d_out; a.ws = (unsigned char*)d_ws;
#if ONE_LAUNCH
    a.ph_lo = 0; a.ph_hi = NPHASE; a.use_bar = 1; a.flags = 0;
    hipLaunchKernelGGL(mega_fwd, dim3(grid), dim3(NWAVES * 64), LDS_BYTES, stream, a);
#else
    const float* x = a.in[0]; unsigned char* ws = a.ws; float* out = a.out;
    float* mod = (float*)(ws + WS_MOD); float* lam = (float*)(ws + WS_LAM);
    bf16_t* A0 = (bf16_t*)(ws + WS_S0); bf16_t* US = (bf16_t*)(ws + WS_S1); bf16_t* SZ = (bf16_t*)(ws + WS_S3); bf16_t* YG = (bf16_t*)(ws + WS_S4);
    bf16_t* Y2 = (bf16_t*)(ws + WS_S0); bf16_t* YO = (bf16_t*)(ws + WS_S1); bf16_t* AKV = (bf16_t*)(ws + WS_S0); bf16_t* AIN1 = (bf16_t*)(ws + WS_S2);
    bf16_t* KB = (bf16_t*)(ws + WS_S3); bf16_t* VB = (bf16_t*)(ws + WS_S4); bf16_t* QB = (bf16_t*)(ws + WS_S5); bf16_t* SZ1 = (bf16_t*)(ws + WS_S6);
    bf16_t* O0 = (bf16_t*)(ws + WS_S0); bf16_t* O1 = (bf16_t*)(ws + WS_S1); bf16_t* OG = (bf16_t*)(ws + WS_S2); bf16_t* YO1 = (bf16_t*)(ws + WS_S0);
    const int EG = 2048;
    auto fast1 = [&](int lo, int hi, int flags) { a.ph_lo = lo; a.ph_hi = hi; a.use_bar = 0; a.flags = flags; hipLaunchKernelGGL(mega_fwd, dim3(grid), dim3(NWAVES * 64), LDS_BYTES, stream, a); };
    auto fast = [&](int lo, int hi, int flags) { fast1(lo, hi, flags); if (lo == EXTRA_PHASE) fast1(lo, hi, flags); };
    const unsigned FM = FASTMASK;
    if (FM & 1u) fast(0, 1, 0);
    else { fast(0, 1, 1); n_adaln<<<(2 * 8 * 3072 + 255) / 256, 256, 0, stream>>>(a.in[1], a.in[2], a.in[3], mod); n_lambda<<<1, 64, 0, stream>>>(a.in[22], a.in[23], a.in[24], a.in[25], lam); }
    if (FM & 2u) fast(1, 2, 0); else n_norm0<<<EG, 256, 0, stream>>>(x, mod, a.in[4], A0);
    if (FM & 4u) fast(2, 3, 0); else n_gemm<<<dim3(2048 / 64, MTOK / 64), 256, 0, stream>>>(AL_Row{A0}, WL_Plain{a.in[6], 2048}, EP_In0{US, SZ}, 2048);
    if (FM & 8u) { fast(3, 4, 0); fast(4, 5, 0); fast(5, 6, 0); }
    else n_ssm<<<NB * NGRP / 4, 256, 0, stream>>>(US, a.in[7], a.in[8], a.in[9], a.in[10], a.in[11], a.in[12], a.in[13], a.in[14], YG);
    if (FM & 64u) fast(6, 7, 0); else n_gemm<<<dim3(1024 / 64, MTOK / 64), 256, 0, stream>>>(AL_YG{YG}, WL_Plain{a.in[15], 1024}, EP_Glu{YG, SZ, a.in[16], Y2}, 1024);
    if (FM & 128u) fast(7, 8, 0); else n_gemm<<<dim3(1024 / 64, MTOK / 64), 256, 0, stream>>>(AL_Row{Y2}, WL_Plain{a.in[17], 1024}, EP_Plain{YO}, 1024);
    if (FM & 256u) fast(8, 9, 0); else n_mid<<<EG, 256, 0, stream>>>(x, YO, mod, a.in[5], a.in[4], out, AKV, AIN1);
    if (FM & 512u) fast(9, 10, 0);
    else { n_gemm<<<dim3(2048 / 64, MTOK / 64), 256, 0, stream>>>(AL_Row{AKV}, WL_KV{a.in[19], a.in[20], a.in[18]}, EP_KV{KB, VB}, 2048);
           n_gemm<<<dim3(2048 / 64, MTOK / 64), 256, 0, stream>>>(AL_Row{AIN1}, WL_Plain{a.in[21], 2048}, EP_In1{QB, SZ1}, 2048); }
    if (FM & 1024u) fast(10, 11, 0); else n_attn<<<MTOK * 8 / 4, 256, 0, stream>>>(QB, KB, VB, O0, O1);
    if (FM & 2048u) fast(11, 12, 0); else n_attn_post<<<EG, 256, 0, stream>>>(O0, O1, SZ1, a.in[26], lam, OG);
    if (FM & 4096u) fast(12, 13, 0); else n_gemm<<<dim3(1024 / 64, MTOK / 64), 256, 0, stream>>>(AL_Row{OG}, WL_Plain{a.in[27], 1024}, EP_Plain{YO1}, 1024);
    if (FM & 8192u) fast(13, 14, 0); else n_final<<<EG, 256, 0, stream>>>(out, YO1, mod, a.in[5]);
#endif
    const hipError_t le = hipPeekAtLastError();
    if (le != hipSuccess) fprintf(stderr, "kernel_launch: launch failed: %s\n", hipGetErrorName(le));
}
```

```cpp
#include <hip/hip_runtime.h>
#include <cstdio>
#include <cstdint>
#include <cmath>
#define FASTMASK 0x3fff
#define ONE_LAUNCH 1
#define REPEAT_MASK 0

typedef unsigned short bf16_t;
constexpr int NB = 8, SEQL = 4096, DM = 1024, MTOK = NB * SEQL;
constexpr int NGRP = 64, NTILE = MTOK / 16;
constexpr int US_P = 384, YG_P = 256;
constexpr float LAMBDA_INIT = 0.35550907f;
constexpr float ONE_M_LI = 1.0f - LAMBDA_INIT;
constexpr float RMS_EPS = 1e-6f;
constexpr float QC2 = 0.125f * 1.4426950408889634f;

__device__ __forceinline__ float bf2f(bf16_t v) { return __uint_as_float((unsigned)v << 16); }
__device__ __forceinline__ unsigned f2bf_u(float f) { unsigned u = __float_as_uint(f); return (u + 0x7fffu + ((u >> 16) & 1u)) >> 16; }
__device__ __forceinline__ bf16_t f2bf(float f) { return (bf16_t)f2bf_u(f); }
__device__ __forceinline__ unsigned pk2bf(float lo, float hi) { return f2bf_u(lo) | (f2bf_u(hi) << 16); }
__device__ __forceinline__ float silu_f(float v) { return v / (1.0f + __expf(-v)); }
__device__ __forceinline__ float sigmoid_f(float v) { return 1.0f / (1.0f + __expf(-v)); }
__device__ __forceinline__ float gelu_tanh_f(float v) {
    const float u = 0.7978845608028654f * (v + 0.044715f * v * v * v);
    const float e = __expf(2.0f * u);
    const float t = 1.0f - 2.0f / (e + 1.0f);
    return 0.5f * v * (1.0f + t);
}
__device__ __forceinline__ float wave_sum_f(float v) {
#pragma unroll
    for (int o = 1; o < 64; o <<= 1) v += __shfl_xor(v, o);
    return v;
}
__device__ __forceinline__ float wave_max_f(float v) {
#pragma unroll
    for (int o = 1; o < 64; o <<= 1) v = fmaxf(v, __shfl_xor(v, o));
    return v;
}
__device__ __forceinline__ size_t us_off(int g, int tile, int col) { return ((size_t)g * NTILE + tile) * US_P + col; }
__device__ __forceinline__ size_t yg_off(int g, int tile, int col) { return ((size_t)g * NTILE + tile) * YG_P + col; }

typedef float f32x4_t __attribute__((ext_vector_type(4)));
typedef unsigned u32x4_t __attribute__((ext_vector_type(4)));
typedef unsigned u32x2_t __attribute__((ext_vector_type(2)));

__device__ __forceinline__ void e_norm0(const float* __restrict__ x, const float* __restrict__ mod, const float* __restrict__ g_pre, bf16_t* a0, int gw, int ngw, int lane) {
    for (int m = gw; m < MTOK; m += ngw) {
        const int b = m / SEQL;
        const f32x4_t* xr = (const f32x4_t*)(x + (size_t)m * DM) + lane;
        f32x4_t v[4]; float s = 0.f;
#pragma unroll
        for (int j = 0; j < 4; ++j) { v[j] = xr[64 * j]; s += (v[j].x * v[j].x + v[j].y * v[j].y) + (v[j].z * v[j].z + v[j].w * v[j].w); }
        const float r = rsqrtf(wave_sum_f(s) * (1.0f / DM) + RMS_EPS);
        const float* sh = mod + (size_t)b * 3072; const float* sc = sh + 1024;
        u32x2_t* o = (u32x2_t*)(a0 + (size_t)m * DM) + lane;
#pragma unroll
        for (int j = 0; j < 4; ++j) {
            const int c = 256 * j + 4 * lane;
            const f32x4_t g = *(const f32x4_t*)(g_pre + c), scv = *(const f32x4_t*)(sc + c), shv = *(const f32x4_t*)(sh + c);
            f32x4_t y = v[j] * r * g * (scv + 1.0f) + shv;
            u32x2_t w; w.x = pk2bf(y.x, y.y); w.y = pk2bf(y.z, y.w); o[64 * j] = w;
        }
    }
}
__device__ __forceinline__ void e_mid(const float* __restrict__ x, const bf16_t* __restrict__ yo, const float* __restrict__ mod, const float* __restrict__ g_post, const float* __restrict__ g_pre,
                                      float* h1, bf16_t* akv, bf16_t* ain1, int gw, int ngw, int lane) {
    for (int m = gw; m < MTOK; m += ngw) {
        const int b = m / SEQL;
        const f32x4_t* xr = (const f32x4_t*)(x + (size_t)m * DM) + lane;
        const u32x2_t* yr = (const u32x2_t*)(yo + (size_t)m * DM) + lane;
        f32x4_t v[4], y[4]; float s = 0.f;
#pragma unroll
        for (int j = 0; j < 4; ++j) { v[j] = xr[64 * j]; const u32x2_t w = yr[64 * j];
            y[j].x = __uint_as_float(w.x << 16); y[j].y = __uint_as_float(w.x & 0xffff0000u); y[j].z = __uint_as_float(w.y << 16); y[j].w = __uint_as_float(w.y & 0xffff0000u);
            s += (y[j].x * y[j].x + y[j].y * y[j].y) + (y[j].z * y[j].z + y[j].w * y[j].w); }
        const float ry = rsqrtf(wave_sum_f(s) * (1.0f / DM) + RMS_EPS);
        const float* gate0 = mod + (size_t)b * 3072 + 2048;
        const float* sh1 = mod + (size_t)(8 + b) * 3072; const float* sc1 = sh1 + 1024;
        float s2 = 0.f;
        f32x4_t* ho = (f32x4_t*)(h1 + (size_t)m * DM) + lane;
#pragma unroll
        for (int j = 0; j < 4; ++j) { const int c = 256 * j + 4 * lane;
            const f32x4_t gp = *(const f32x4_t*)(g_post + c), gt = *(const f32x4_t*)(gate0 + c);
            v[j] = v[j] + gt * (y[j] * ry * gp);
            if (h1) ho[64 * j] = v[j];
            s2 += (v[j].x * v[j].x + v[j].y * v[j].y) + (v[j].z * v[j].z + v[j].w * v[j].w); }
        const float rh = rsqrtf(wave_sum_f(s2) * (1.0f / DM) + RMS_EPS);
        u32x2_t* o1 = (u32x2_t*)(akv + (size_t)m * DM) + lane; u32x2_t* o2 = (u32x2_t*)(ain1 + (size_t)m * DM) + lane;
#pragma unroll
        for (int j = 0; j < 4; ++j) { const int c = 256 * j + 4 * lane;
            const f32x4_t n = v[j] * rh;
            u32x2_t w; w.x = pk2bf(n.x, n.y); w.y = pk2bf(n.z, n.w); o1[64 * j] = w;
            const f32x4_t g = *(const f32x4_t*)(g_pre + 1024 + c), scv = *(const f32x4_t*)(sc1 + c), shv = *(const f32x4_t*)(sh1 + c);
            const f32x4_t z = n * g * (scv + 1.0f) + shv;
            w.x = pk2bf(z.x, z.y); w.y = pk2bf(z.z, z.w); o2[64 * j] = w; }
    }
}
__device__ __forceinline__ void e_attn_post(const bf16_t* __restrict__ o0, const bf16_t* __restrict__ o1, const bf16_t* __restrict__ sz1, const float* __restrict__ g_sub, float lam,
                                            bf16_t* og, int gw, int ngw, int lane) {
    for (int m = gw; m < MTOK; m += ngw) {
#pragma unroll
        for (int j = 0; j < 2; ++j) {
            const int c = 512 * j + 8 * lane;
            const u32x4_t a = *(const u32x4_t*)(o0 + (size_t)m * DM + c), bq = *(const u32x4_t*)(o1 + (size_t)m * DM + c), zq = *(const u32x4_t*)(sz1 + (size_t)m * DM + c);
            float d[8]; float s = 0.f;
#pragma unroll
            for (int i = 0; i < 4; ++i) { const unsigned wa = a[i], wb = bq[i];
                d[2 * i] = __uint_as_float(wa << 16) - lam * __uint_as_float(wb << 16); d[2 * i + 1] = __uint_as_float(wa & 0xffff0000u) - lam * __uint_as_float(wb & 0xffff0000u);
                s += d[2 * i] * d[2 * i] + d[2 * i + 1] * d[2 * i + 1]; }
            s += __shfl_xor(s, 1); s += __shfl_xor(s, 2); s += __shfl_xor(s, 4); s += __shfl_xor(s, 8);
            const float r = rsqrtf(s * (1.0f / 128.0f) + RMS_EPS) * ONE_M_LI;
            const float* gs = g_sub + (c & 127);
            u32x4_t w;
#pragma unroll
            for (int i = 0; i < 4; ++i) { const unsigned wz = zq[i];
                const float z0 = __uint_as_float(wz << 16), z1 = __uint_as_float(wz & 0xffff0000u);
                w[i] = pk2bf(d[2 * i] * r * gs[2 * i] * z0, d[2 * i + 1] * r * gs[2 * i + 1] * z1); }
            *(u32x4_t*)(og + (size_t)m * DM + c) = w;
        }
    }
}
__device__ __forceinline__ void e_final(float* out, const bf16_t* __restrict__ yo1, const float* __restrict__ mod, const float* __restrict__ g_post, int gw, int ngw, int lane) {
    for (int m = gw; m < MTOK; m += ngw) {
        const int b = m / SEQL;
        f32x4_t* hr = (f32x4_t*)(out + (size_t)m * DM) + lane;
        const u32x2_t* yr = (const u32x2_t*)(yo1 + (size_t)m * DM) + lane;
        f32x4_t v[4], y[4]; float s = 0.f;
#pragma unroll
        for (int j = 0; j < 4; ++j) { v[j] = hr[64 * j]; const u32x2_t w = yr[64 * j];
            y[j].x = __uint_as_float(w.x << 16); y[j].y = __uint_as_float(w.x & 0xffff0000u); y[j].z = __uint_as_float(w.y << 16); y[j].w = __uint_as_float(w.y & 0xffff0000u);
            s += (y[j].x * y[j].x + y[j].y * y[j].y) + (y[j].z * y[j].z + y[j].w * y[j].w); }
        const float ry = rsqrtf(wave_sum_f(s) * (1.0f / DM) + RMS_EPS);
        const float* gate1 = mod + (size_t)(8 + b) * 3072 + 2048;
#pragma unroll
        for (int j = 0; j < 4; ++j) { const int c = 256 * j + 4 * lane;
            const f32x4_t gp = *(const f32x4_t*)(g_post + 1024 + c), gt = *(const f32x4_t*)(gate1 + c);
            hr[64 * j] = v[j] + gt * (y[j] * ry * gp); }
    }
}
__device__ __forceinline__ void e_final2(const float* __restrict__ x, const bf16_t* __restrict__ yo, const bf16_t* __restrict__ yo1, float* out, const float* __restrict__ mod, const float* __restrict__ g_post, int gw, int ngw, int lane) {
    for (int m = gw; m < MTOK; m += ngw) {
        const int b = m / SEQL;
        const f32x4_t* xr = (const f32x4_t*)(x + (size_t)m * DM) + lane;
        const u32x2_t* y0r = (const u32x2_t*)(yo + (size_t)m * DM) + lane; const u32x2_t* y1r = (const u32x2_t*)(yo1 + (size_t)m * DM) + lane;
        f32x4_t v[4], y0[4], y1[4]; float s0 = 0.f, s1 = 0.f;
#pragma unroll
        for (int j = 0; j < 4; ++j) { v[j] = xr[64 * j]; const u32x2_t w0 = y0r[64 * j], w1 = y1r[64 * j];
            y0[j].x = __uint_as_float(w0.x << 16); y0[j].y = __uint_as_float(w0.x & 0xffff0000u); y0[j].z = __uint_as_float(w0.y << 16); y0[j].w = __uint_as_float(w0.y & 0xffff0000u);
            y1[j].x = __uint_as_float(w1.x << 16); y1[j].y = __uint_as_float(w1.x & 0xffff0000u); y1[j].z = __uint_as_float(w1.y << 16); y1[j].w = __uint_as_float(w1.y & 0xffff0000u);
            s0 += (y0[j].x * y0[j].x + y0[j].y * y0[j].y) + (y0[j].z * y0[j].z + y0[j].w * y0[j].w);
            s1 += (y1[j].x * y1[j].x + y1[j].y * y1[j].y) + (y1[j].z * y1[j].z + y1[j].w * y1[j].w); }
        const float r0 = rsqrtf(wave_sum_f(s0) * (1.0f / DM) + RMS_EPS), r1 = rsqrtf(wave_sum_f(s1) * (1.0f / DM) + RMS_EPS);
        const float* gate0 = mod + (size_t)b * 3072 + 2048; const float* gate1 = mod + (size_t)(8 + b) * 3072 + 2048;
        f32x4_t* orow = (f32x4_t*)(out + (size_t)m * DM) + lane;
#pragma unroll
        for (int j = 0; j < 4; ++j) { const int c = 256 * j + 4 * lane;
            const f32x4_t gp0 = *(const f32x4_t*)(g_post + c), gt0 = *(const f32x4_t*)(gate0 + c), gp1 = *(const f32x4_t*)(g_post + 1024 + c), gt1 = *(const f32x4_t*)(gate1 + c);
            const f32x4_t h = v[j] + gt0 * (y0[j] * r0 * gp0);
            orow[64 * j] = h + gt1 * (y1[j] * r1 * gp1); }
    }
}
__device__ __forceinline__ float diff_lambda(const float* lq1, const float* lk1, const float* lq2, const float* lk2) {
    float s1 = 0.f, s2 = 0.f;
    for (int i = 0; i < 64; ++i) { s1 += lq1[i] * lk1[i]; s2 += lq2[i] * lk2[i]; }
    return expf(s1) - expf(s2) + LAMBDA_INIT;
}

__global__ void n_adaln(const float* __restrict__ c, const float* __restrict__ ada_w, const float* __restrict__ ada_b, float* mod) {
    const int idx = blockIdx.x * 256 + threadIdx.x;
    if (idx >= 2 * 8 * 3072) return;
    const int j = idx % 3072, b = (idx / 3072) % 8, l = idx / (3072 * 8);
    float acc = ada_b[l * 3072 + j];
    const float* w = ada_w + (size_t)l * 1024 * 3072 + j; const float* cb = c + b * 1024;
    for (int k = 0; k < 1024; ++k) acc += silu_f(cb[k]) * w[(size_t)k * 3072];
    mod[idx] = acc;
}
__global__ void n_lambda(const float* lq1, const float* lk1, const float* lq2, const float* lk2, float* out) {
    if (threadIdx.x == 0 && blockIdx.x == 0) out[0] = diff_lambda(lq1, lk1, lq2, lk2);
}
__global__ void n_norm0(const float* x, const float* mod, const float* g_pre, bf16_t* a0) {
    e_norm0(x, mod, g_pre, a0, blockIdx.x * 4 + (threadIdx.x >> 6), gridDim.x * 4, threadIdx.x & 63);
}
__global__ void n_mid(const float* x, const bf16_t* yo, const float* mod, const float* g_post, const float* g_pre, float* h1, bf16_t* akv, bf16_t* ain1) {
    e_mid(x, yo, mod, g_post, g_pre, h1, akv, ain1, blockIdx.x * 4 + (threadIdx.x >> 6), gridDim.x * 4, threadIdx.x & 63);
}
__global__ void n_attn_post(const bf16_t* o0, const bf16_t* o1, const bf16_t* sz1, const float* g_sub, const float* lamp, bf16_t* og) {
    e_attn_post(o0, o1, sz1, g_sub, lamp[0], og, blockIdx.x * 4 + (threadIdx.x >> 6), gridDim.x * 4, threadIdx.x & 63);
}
__global__ void n_final(float* out, const bf16_t* yo1, const float* mod, const float* g_post) {
    e_final(out, yo1, mod, g_post, blockIdx.x * 4 + (threadIdx.x >> 6), gridDim.x * 4, threadIdx.x & 63);
}

struct AL_Row { const bf16_t* A; __device__ float ld(int m, int k) const { return bf2f(A[(size_t)m * DM + k]); } };
struct AL_YG  { const bf16_t* A; __device__ float ld(int m, int k) const { return bf2f(A[yg_off(k >> 4, m >> 4, (m & 15) * 16 + (k & 15))]); } };
struct WL_Plain { const float* W; long N; __device__ float ld(int k, int n) const { return W[(size_t)k * N + n]; } };
struct WL_KV { const float* wk; const float* wv; const float* g; __device__ float ld(int k, int n) const { return g[k] * (n < 1024 ? wk[(size_t)k * 1024 + n] : wv[(size_t)k * 1024 + n - 1024]); } };
struct EP_In0 { bf16_t* US; bf16_t* SZ; __device__ void st(int m, int n, float a) const {
    if (n < 1024) US[us_off(n >> 4, m >> 4, (m & 15) * 16 + (n & 15))] = f2bf(a); else SZ[(size_t)m * DM + n - 1024] = f2bf(silu_f(a)); } };
struct EP_Glu { const bf16_t* YG; const bf16_t* SZ; const float* bias; bf16_t* Y2; __device__ void st(int m, int n, float a) const {
    const float yv = bf2f(YG[yg_off(n >> 4, m >> 4, (m & 15) * 16 + (n & 15))]); const float t = a + bias[n];
    Y2[(size_t)m * DM + n] = f2bf(yv * sigmoid_f(t) * bf2f(SZ[(size_t)m * DM + n])); } };
struct EP_Plain { bf16_t* O; __device__ void st(int m, int n, float a) const { O[(size_t)m * DM + n] = f2bf(a); } };
struct EP_KV { bf16_t* K; bf16_t* V; __device__ void st(int m, int n, float a) const { if (n < 1024) K[(size_t)m * DM + n] = f2bf(a); else V[(size_t)m * DM + n - 1024] = f2bf(a); } };
struct EP_In1 { bf16_t* Q; bf16_t* SZ1; __device__ void st(int m, int n, float a) const { if (n < 1024) Q[(size_t)m * DM + n] = f2bf(a * QC2); else SZ1[(size_t)m * DM + n - 1024] = f2bf(silu_f(a)); } };

template <class AL, class WL, class EP>
__global__ void __launch_bounds__(256) n_gemm(AL al, WL wl, EP ep, int N) {
    __shared__ float As[16][68]; __shared__ float Ws[16][68];
    const int tid = threadIdx.x, tx = tid & 15, ty = tid >> 4;
    const int m0 = blockIdx.y * 64, n0 = blockIdx.x * 64;
    float acc[4][4];
#pragma unroll
    for (int i = 0; i < 4; ++i)
#pragma unroll
        for (int j = 0; j < 4; ++j) acc[i][j] = 0.f;
    for (int k0 = 0; k0 < 1024; k0 += 16) {
#pragma unroll
        for (int i = 0; i < 4; ++i) { const int e = tid + 256 * i; const int mm = e >> 4, kk = e & 15; As[kk][mm] = al.ld(m0 + mm, k0 + kk); }
#pragma unroll
        for (int i = 0; i < 4; ++i) { const int e = tid + 256 * i; const int kk = e >> 6, nn = e & 63; Ws[kk][nn] = wl.ld(k0 + kk, n0 + nn); }
        __syncthreads();
#pragma unroll
        for (int kk = 0; kk < 16; ++kk) {
            float a[4], b[4];
#pragma unroll
            for (int i = 0; i < 4; ++i) { a[i] = As[kk][ty * 4 + i]; b[i] = Ws[kk][tx * 4 + i]; }
#pragma unroll
            for (int i = 0; i < 4; ++i)
#pragma unroll
                for (int j = 0; j < 4; ++j) acc[i][j] += a[i] * b[j];
        }
        __syncthreads();
    }
#pragma unroll
    for (int i = 0; i < 4; ++i)
#pragma unroll
        for (int j = 0; j < 4; ++j) ep.st(m0 + ty * 4 + i, n0 + tx * 4 + j, acc[i][j]);
}

__global__ void __launch_bounds__(256) n_ssm(const bf16_t* __restrict__ US, const float* lam_re, const float* lam_im, const float* log_dt, const float* b_re, const float* b_im,
                                             const float* c_re, const float* c_im, const float* d_skip, bf16_t* YG) {
    const int wv = blockIdx.x * 4 + (threadIdx.x >> 6), lane = threadIdx.x & 63;
    if (wv >= NB * NGRP) return;
    const int b = wv / NGRP, g = wv % NGRP, p = lane;
    const float dt = expf(log_dt[g]);
    const float lr = lam_re[g * 64 + p], li = lam_im[g * 64 + p];
    const float mag = expf(lr * dt); float sn, cs; sn = sinf(li * dt); cs = cosf(li * dt);
    const float lbr = mag * cs, lbi = mag * sn;
    const float nr = lbr - 1.0f, ni = lbi, den = lr * lr + li * li;
    const float cr = (nr * lr + ni * li) / den, ci = (ni * lr - nr * li) / den;
    float bbr[16], bbi[16], ccr[16], cci[16];
#pragma unroll
    for (int c = 0; c < 16; ++c) { const float br = b_re[(g * 64 + p) * 16 + c], bi = b_im[(g * 64 + p) * 16 + c];
        bbr[c] = cr * br - ci * bi; bbi[c] = cr * bi + ci * br;
        ccr[c] = c_re[(g * 16 + c) * 64 + p]; cci[c] = c_im[(g * 16 + c) * 64 + p]; }
    const float dsk = d_skip[g * 16 + (lane & 15)];
    float sr = 0.f, si = 0.f;
    for (int t = 0; t < SEQL; ++t) {
        const int m = b * SEQL + t;
        const bf16_t* up = US + us_off(g, m >> 4, (m & 15) * 16);
        float u[16];
        { const u32x4_t w0 = *(const u32x4_t*)up, w1 = *(const u32x4_t*)(up + 8);
#pragma unroll
          for (int i = 0; i < 4; ++i) { u[2 * i] = __uint_as_float(w0[i] << 16); u[2 * i + 1] = __uint_as_float(w0[i] & 0xffff0000u); u[8 + 2 * i] = __uint_as_float(w1[i] << 16); u[8 + 2 * i + 1] = __uint_as_float(w1[i] & 0xffff0000u); } }
        float bur = 0.f, bui = 0.f;
#pragma unroll
        for (int c = 0; c < 16; ++c) { bur += bbr[c] * u[c]; bui += bbi[c] * u[c]; }
        const float nsr = lbr * sr - lbi * si + bur, nsi = lbr * si + lbi * sr + bui; sr = nsr; si = nsi;
        float yv = 0.f;
#pragma unroll
        for (int c = 0; c < 16; ++c) { const float part = wave_sum_f(ccr[c] * sr - cci[c] * si); if ((lane & 15) == c) yv = part; }
        if (lane < 16) { const float yy = yv + dsk * bf2f(up[lane]); YG[yg_off(g, m >> 4, (m & 15) * 16 + lane)] = f2bf(gelu_tanh_f(yy)); }
    }
}

__global__ void __launch_bounds__(256) n_attn(const bf16_t* __restrict__ Q, const bf16_t* __restrict__ K, const bf16_t* __restrict__ V, bf16_t* O0, bf16_t* O1) {
    __shared__ float qs[4][128];
    const int w = threadIdx.x >> 6, lane = threadIdx.x & 63;
    const int gwv = blockIdx.x * 4 + w;
    const int h = gwv & 7, m = gwv >> 3, b = m / SEQL, qi = m % SEQL;
    qs[w][lane] = bf2f(Q[(size_t)m * DM + h * 128 + lane]); qs[w][64 + lane] = bf2f(Q[(size_t)m * DM + h * 128 + 64 + lane]);
    __syncthreads();
    float m0 = -1e30f, m1 = -1e30f, l0 = 0.f, l1 = 0.f, a00 = 0.f, a01 = 0.f, a10 = 0.f, a11 = 0.f;
    const size_t rb = (size_t)b * SEQL;
    for (int kc = 0; kc * 64 <= qi; ++kc) {
        const int key = kc * 64 + lane; const bool valid = key <= qi;
        float s0 = 0.f, s1 = 0.f;
        { const bf16_t* kr = K + (rb + (valid ? key : qi)) * DM + h * 128;
#pragma unroll
          for (int ch = 0; ch < 8; ++ch) { const u32x4_t w0 = *(const u32x4_t*)(kr + ch * 8), w1 = *(const u32x4_t*)(kr + 64 + ch * 8);
#pragma unroll
            for (int i = 0; i < 4; ++i) { s0 += qs[w][ch * 8 + 2 * i] * __uint_as_float(w0[i] << 16) + qs[w][ch * 8 + 2 * i + 1] * __uint_as_float(w0[i] & 0xffff0000u);
                                          s1 += qs[w][64 + ch * 8 + 2 * i] * __uint_as_float(w1[i] << 16) + qs[w][64 + ch * 8 + 2 * i + 1] * __uint_as_float(w1[i] & 0xffff0000u); } } }
        if (!valid) { s0 = -1e30f; s1 = -1e30f; }
        const float nm0 = fmaxf(m0, wave_max_f(s0)), nm1 = fmaxf(m1, wave_max_f(s1));
        const float f0 = exp2f(m0 - nm0), f1 = exp2f(m1 - nm1);
        const float p0 = valid ? exp2f(s0 - nm0) : 0.f, p1 = valid ? exp2f(s1 - nm1) : 0.f;
        l0 = l0 * f0 + wave_sum_f(p0); l1 = l1 * f1 + wave_sum_f(p1); m0 = nm0; m1 = nm1;
        a00 *= f0; a01 *= f0; a10 *= f1; a11 *= f1;
        const int nk = min(64, qi - kc * 64 + 1);
        for (int j = 0; j < nk; ++j) {
            const float pj0 = __shfl(p0, j), pj1 = __shfl(p1, j);
            const bf16_t* vr = V + (rb + kc * 64 + j) * DM + h * 128;
            const float v0 = bf2f(vr[lane]), v1 = bf2f(vr[64 + lane]);
            a00 += pj0 * v0; a01 += pj0 * v1; a10 += pj1 * v0; a11 += pj1 * v1;
        }
    }
    const float i0 = 1.0f / l0, i1 = 1.0f / l1;
    O0[(size_t)m * DM + h * 128 + lane] = f2bf(a00 * i0); O0[(size_t)m * DM + h * 128 + 64 + lane] = f2bf(a01 * i0);
    O1[(size_t)m * DM + h * 128 + lane] = f2bf(a10 * i1); O1[(size_t)m * DM + h * 128 + 64 + lane] = f2bf(a11 * i1);
}
#ifndef REPEAT_MASK
#define REPEAT_MASK 0
#endif
#ifndef ATTN_V128
#define ATTN_V128 1
#endif
#ifndef EXTRA_PHASE
#define EXTRA_PHASE -1
#endif
#ifndef ATTN_FUSE_POST
#define ATTN_FUSE_POST 1
#endif
#ifndef H1_RECOMP
#define H1_RECOMP 0
#endif
#ifndef SSM_FUSED
#define SSM_FUSED 1
#endif
#ifndef FUSE_EPI
#define FUSE_EPI 0
#endif
#ifndef ALIGN_E
#define ALIGN_E true
#endif
namespace pg8 {
#define PG8_LAS __attribute__((address_space(3)))
typedef short bf16x8 __attribute__((ext_vector_type(8)));
typedef float f32x4 __attribute__((ext_vector_type(4)));
typedef unsigned u32x4 __attribute__((ext_vector_type(4)));
constexpr int BM = 256, BK = 64, HALF = 128, HTB = HALF * BK * 2  , STAGE_BYTES = 8 * HTB, NXCD = 8, WGM = 8;

__host__ __device__ __forceinline__ int lds_byte(int r, int c) { const int st = (r >> 4) * 2 + (c >> 5), rr = r & 15, cc = c & 31, ob = rr * 64 + cc * 2; return st * 1024 + (ob ^ (((ob >> 9) & 1) << 5)); }
__host__ __device__ __forceinline__ void stage_rc(int b, int& R, int& C) { const int st = b / 1024, sb = b % 1024, swz = sb ^ (((sb >> 9) & 1) << 5); R = (st >> 1) * 16 + swz / 64; C = (st & 1) * 32 + (swz % 64) / 2; }
__host__ __device__ __forceinline__ int perm32(int rho) { const int n = rho >> 4, i = rho & 15; return 8 * (i >> 2) + 4 * n + (i & 3); }

struct Unit { int pm, pn, grp; };
struct Gemm {
    const char* A; const char* Bt; int nt, pad0;
    unsigned a_rs, a_c16; size_t a_kstep, a_tstep, a_gstep;
    unsigned b_rs, pad1; size_t b_tstep, b_gstep;
    __device__ __forceinline__ const char* abase(const Unit& u) const { return A + (size_t)u.grp * a_gstep + (size_t)u.pm * a_tstep; }
    __device__ __forceinline__ const char* bbase(const Unit& u) const { return Bt + (size_t)u.grp * b_gstep + (size_t)u.pn * b_tstep; }
};
__device__ __forceinline__ Gemm gemm_std(const void* A, int lda, const void* Bt, int ldb, int K) {
    Gemm g; g.A = (const char*)A; g.Bt = (const char*)Bt; g.nt = K / BK; g.pad0 = 0; g.a_rs = (unsigned)lda * 2u; g.a_c16 = 32u; g.a_kstep = BK * 2; g.a_tstep = (size_t)BM * lda * 2; g.a_gstep = 0;
    g.b_rs = (unsigned)ldb * 2u; g.pad1 = 0; g.b_tstep = (size_t)BM * ldb * 2; g.b_gstep = 0; return g;
}

struct Order {
    int nM, nN, nG, nwg, G, c, only, pm_off;
    __device__ __forceinline__ void init(int nM_, int nN_, int nG_, int G_, int c_) { nM = nM_; nN = nN_; nG = nG_; nwg = nM * nN * nG; G = G_; c = c_; only = -1; pm_off = 0; }
    __device__ __forceinline__ bool next(int i, Unit& u) const {
        if (only >= 0) { if (i > 0) return false; i = only; }
        const long L = (long)i * G + c; if (L >= nwg) return false;
        int wgid = (int)L; { const int q = nwg / NXCD, r = nwg % NXCD, xcd = wgid % NXCD, off = wgid / NXCD; wgid = (xcd < r ? xcd * (q + 1) : r * (q + 1) + (xcd - r) * q) + off; }
        if (nG == 1) {
            const int nig = WGM * nN, gid = wgid / nig, fm = gid * WGM, gsz = (nM - fm) < WGM ? (nM - fm) : WGM;
            u.pm = pm_off + fm + ((wgid % nig) % gsz); u.pn = (wgid % nig) / gsz; u.grp = 0;
        } else { const int per = nM * nN; u.grp = wgid / per; const int r2 = wgid % per; u.pm = r2 % nM; u.pn = r2 / nM; }
        return true;
    }
};

__device__ __forceinline__ unsigned cvt_pk_bf16(float lo, float hi) { unsigned r; asm volatile("v_cvt_pk_bf16_f32 %0, %1, %2" : "=v"(r) : "v"(lo), "v"(hi)); return r; }
__device__ __forceinline__ u32x4 pack8(const f32x4 a, const f32x4 b) { u32x4 w; w.x = cvt_pk_bf16(a[0], a[1]); w.y = cvt_pk_bf16(a[2], a[3]); w.z = cvt_pk_bf16(b[0], b[1]); w.w = cvt_pk_bf16(b[2], b[3]); return w; }
__device__ __forceinline__ void unpack8(const u32x4 w, f32x4& a, f32x4& b) {
    a[0] = __uint_as_float(w.x << 16); a[1] = __uint_as_float(w.x & 0xffff0000u); a[2] = __uint_as_float(w.y << 16); a[3] = __uint_as_float(w.y & 0xffff0000u);
    b[0] = __uint_as_float(w.z << 16); b[1] = __uint_as_float(w.z & 0xffff0000u); b[2] = __uint_as_float(w.w << 16); b[3] = __uint_as_float(w.w & 0xffff0000u); }
__device__ __forceinline__ float fsilu(float v) { return v * __builtin_amdgcn_rcpf(1.0f + __expf(-v)); }
__device__ __forceinline__ float fsigm(float v) { return __builtin_amdgcn_rcpf(1.0f + __expf(-v)); }
__device__ __forceinline__ f32x4 silu4(f32x4 v) { f32x4 o; o[0] = fsilu(v[0]); o[1] = fsilu(v[1]); o[2] = fsilu(v[2]); o[3] = fsilu(v[3]); return o; }
__device__ __forceinline__ f32x4 sigm4(f32x4 v) { f32x4 o; o[0] = fsigm(v[0]); o[1] = fsigm(v[1]); o[2] = fsigm(v[2]); o[3] = fsigm(v[3]); return o; }
__device__ __forceinline__ float fgelu(float v) { const float u = 0.7978845608028654f * (v + 0.044715f * v * v * v); const float e = __expf(2.0f * u); return 0.5f * v * (2.0f - 2.0f * __builtin_amdgcn_rcpf(e + 1.0f)); }
__device__ __forceinline__ f32x4 gelu4(f32x4 v) { f32x4 o; o[0] = fgelu(v[0]); o[1] = fgelu(v[1]); o[2] = fgelu(v[2]); o[3] = fgelu(v[3]); return o; }

template <class F> struct EpiRow8 {
    static constexpr bool PERM = true, AFTER_DRAIN = false;
    F f;
    __device__ __forceinline__ void operator()(const f32x4 (&acc)[2][2][4][2], const Unit& u, int wr, int wc, int fr, int fq) const {
#pragma unroll
        for (int ai = 0; ai < 2; ++ai)
#pragma unroll
            for (int m = 0; m < 4; ++m) { const int row = u.pm * BM + ai * HALF + wr * 64 + m * 16 + fr;
#pragma unroll
                for (int bj = 0; bj < 2; ++bj) { const int col0 = u.pn * BM + bj * HALF + wc * 32 + 8 * fq; f.apply(u, row, col0, acc[ai][bj][m][0], acc[ai][bj][m][1]); } }
    }
};
struct F_In0 { bf16_t* US; bf16_t* SZ;
    __device__ __forceinline__ void apply(const Unit&, int row, int col0, f32x4 v0, f32x4 v1) const {
        if (col0 < 1024) *(u32x4*)(US + us_off(col0 >> 4, row >> 4, (row & 15) * 16 + (col0 & 15))) = pack8(v0, v1);
        else *(u32x4*)(SZ + (size_t)row * DM + (col0 - 1024)) = pack8(silu4(v0), silu4(v1)); } };
struct F_SsmA { float* E;
    __device__ __forceinline__ void apply(const Unit& u, int row, int col0, f32x4 v0, f32x4 v1) const {
        if (col0 < 128) { float* p = E + ((size_t)u.grp * NTILE + row) * 128 + col0; *(f32x4*)p = v0; *(f32x4*)(p + 4) = v1; } } };
struct F_SsmB { const bf16_t* US; const float* dsk; bf16_t* YG;
    __device__ __forceinline__ void apply(const Unit& u, int row, int col0, f32x4 v0, f32x4 v1) const {
        const u32x4 uw = *(const u32x4*)(US + us_off(u.grp, row, col0)); f32x4 u0, u1; unpack8(uw, u0, u1);
        const float* d = dsk + u.grp * 16 + (col0 & 15); const f32x4 d0 = *(const f32x4*)d, d1 = *(const f32x4*)(d + 4);
        *(u32x4*)(YG + yg_off(u.grp, row, col0)) = pack8(gelu4(v0 + d0 * u0), gelu4(v1 + d1 * u1)); } };
struct F_Glu { const bf16_t* YG; const bf16_t* SZ; const float* bias; bf16_t* Y2;
    __device__ __forceinline__ void apply(const Unit&, int row, int col0, f32x4 v0, f32x4 v1) const {
        const u32x4 yw = *(const u32x4*)(YG + yg_off(col0 >> 4, row >> 4, (row & 15) * 16 + (col0 & 15))); f32x4 y0, y1; unpack8(yw, y0, y1);
        const u32x4 zw = *(const u32x4*)(SZ + (size_t)row * DM + col0); f32x4 z0, z1; unpack8(zw, z0, z1);
        const f32x4 b0 = *(const f32x4*)(bias + col0), b1 = *(const f32x4*)(bias + col0 + 4);
        *(u32x4*)(Y2 + (size_t)row * DM + col0) = pack8(y0 * sigm4(v0 + b0) * z0, y1 * sigm4(v1 + b1) * z1); } };
struct F_Plain { bf16_t* O;
    __device__ __forceinline__ void apply(const Unit&, int row, int col0, f32x4 v0, f32x4 v1) const { *(u32x4*)(O + (size_t)row * DM + col0) = pack8(v0, v1); } };
struct F_Split { bf16_t* Olo; bf16_t* Ohi; float sc_lo; int silu_hi;
    __device__ __forceinline__ void apply(const Unit&, int row, int col0, f32x4 v0, f32x4 v1) const {
        if (col0 < 1024) *(u32x4*)(Olo + (size_t)row * DM + col0) = pack8(v0 * sc_lo, v1 * sc_lo);
        else { if (silu_hi) { v0 = silu4(v0); v1 = silu4(v1); } *(u32x4*)(Ohi + (size_t)row * DM + (col0 - 1024)) = pack8(v0, v1); } } };


struct PanelRms {
    unsigned* xbuf;
    unsigned* cnt;
    unsigned* tmo;
    float eps;
    __device__ __forceinline__ bool run(const f32x4 (&v)[2][2][4][2], const Unit& u, int wr, int wc, int fr, int fq, PG8_LAS unsigned char* lds, int wid, int lane) const {
        PG8_LAS float* P = (PG8_LAS float*)lds;
        PG8_LAS float* S = (PG8_LAS float*)(lds + 8192);
        PG8_LAS unsigned* flag = (PG8_LAS unsigned*)(lds + 8192 + 2048);
#pragma unroll
        for (int ai = 0; ai < 2; ++ai)
#pragma unroll
            for (int m = 0; m < 4; ++m) {
                float q = 0.f;
#pragma unroll
                for (int bj = 0; bj < 2; ++bj)
#pragma unroll
                    for (int n = 0; n < 2; ++n) { const f32x4 d = v[ai][bj][m][n]; q += (d[0] * d[0] + d[1] * d[1]) + (d[2] * d[2] + d[3] * d[3]); }
                q += __shfl_xor(q, 16); q += __shfl_xor(q, 32);
                if (fq == 0) P[(ai * HALF + wr * 64 + m * 16 + fr) * 4 + wc] = q;
            }
        asm volatile("s_waitcnt lgkmcnt(0)" ::: "memory"); __builtin_amdgcn_s_barrier(); asm volatile("" ::: "memory");
        const int row = wid * 32 + (lane & 31);
        if (lane < 32) {
            const float tot = (P[row * 4 + 0] + P[row * 4 + 1]) + (P[row * 4 + 2] + P[row * 4 + 3]);
            unsigned long long* slot = (unsigned long long*)xbuf + ((size_t)(u.pm * BM + row) * 4 + u.pn);
            __hip_atomic_store(slot, (unsigned long long)__float_as_uint(tot), __ATOMIC_RELAXED, __HIP_MEMORY_SCOPE_AGENT);
        }
        asm volatile("s_waitcnt vmcnt(0)" ::: "memory");
        if (lane == 0) __hip_atomic_fetch_add(cnt + 64 * u.pm, 1u, __ATOMIC_RELAXED, __HIP_MEMORY_SCOPE_AGENT);
        if (wid == 0) {
            bool dead = false; const unsigned long long t0 = __builtin_amdgcn_s_memrealtime(); const unsigned want = 32u;
            for (;;) {
                if ((unsigned)__builtin_amdgcn_readfirstlane(__hip_atomic_load(cnt + 64 * u.pm, __ATOMIC_RELAXED, __HIP_MEMORY_SCOPE_AGENT)) >= want) break;
                if (__builtin_amdgcn_s_memrealtime() - t0 > 2000000ull) { if (lane == 0) __hip_atomic_store(tmo, 1u, __ATOMIC_RELAXED, __HIP_MEMORY_SCOPE_AGENT); dead = true; break; }
                __builtin_amdgcn_s_sleep(2);
            }
            __builtin_amdgcn_fence(__ATOMIC_ACQUIRE, "agent");
            if (lane == 0) flag[0] = dead ? 1u : 0u;
        }
        asm volatile("s_waitcnt vmcnt(0) lgkmcnt(0)" ::: "memory"); __builtin_amdgcn_s_barrier(); asm volatile("" ::: "memory");
        const bool bad = flag[0] != 0u;
        if (lane < 32) {
            const unsigned long long* slot = (const unsigned long long*)xbuf + (size_t)(u.pm * BM + row) * 4; float t4[4];
#pragma unroll
            for (int t = 0; t < 4; ++t) t4[t] = __uint_as_float((unsigned)__hip_atomic_load(slot + t, __ATOMIC_RELAXED, __HIP_MEMORY_SCOPE_AGENT));
            S[row] = rsqrtf(((t4[0] + t4[1]) + (t4[2] + t4[3])) * (1.0f / 1024.0f) + eps);
        }
        asm volatile("s_waitcnt lgkmcnt(0)" ::: "memory"); __builtin_amdgcn_s_barrier(); asm volatile("" ::: "memory");
        return bad;
    }
};
struct EpiFinal {
    static constexpr bool PERM = false, AFTER_DRAIN = true;
    const float* base; float* out; const float* mod1; const float* gpost1; PanelRms st;
    __device__ __forceinline__ void fused(f32x4 (&acc)[2][2][4][2], const Unit& u, int wr, int wc, int fr, int fq, PG8_LAS unsigned char* lds, int wid, int lane) const {
        const PG8_LAS float* S = (const PG8_LAS float*)(lds + 8192);
        const int col0 = u.pn * BM + wc * 32 + 4 * fq; const int b = u.pm >> 4;
        const float* gate = mod1 + (size_t)b * 3072 + 2048;
        const bool bad = st.run(acc, u, wr, wc, fr, fq, lds, wid, lane);
        const float qnan = __builtin_nanf("");
        f32x4 gg[2][2];
#pragma unroll
        for (int bj = 0; bj < 2; ++bj)
#pragma unroll
            for (int n = 0; n < 2; ++n) gg[bj][n] = *(const f32x4*)(gate + col0 + bj * HALF + n * 16) * *(const f32x4*)(gpost1 + col0 + bj * HALF + n * 16);
#pragma unroll
        for (int ai = 0; ai < 2; ++ai)
#pragma unroll
            for (int m = 0; m < 4; ++m) { const int r = ai * HALF + wr * 64 + m * 16 + fr; const float sr = S[r]; const size_t off = (size_t)(u.pm * BM + r) * DM + col0;
#pragma unroll
                for (int bj = 0; bj < 2; ++bj)
#pragma unroll
                    for (int n = 0; n < 2; ++n) { const f32x4 bs = *(const f32x4*)(base + off + bj * HALF + n * 16); f32x4 o = bs + gg[bj][n] * (acc[ai][bj][m][n] * sr);
                        if (bad) o = (f32x4){qnan, qnan, qnan, qnan}; *(f32x4*)(out + off + bj * HALF + n * 16) = o; }
                if (m & 1) asm volatile("" ::: "memory"); }
    }
};
struct EpiMid {
    static constexpr bool PERM = false, AFTER_DRAIN = true;
    const float* x; float* out; bf16_t* akv; bf16_t* ain1; const float* mod; const float* gpost0; const float* gpre1; PanelRms st1, st2;
    __device__ __forceinline__ void fused(f32x4 (&acc)[2][2][4][2], const Unit& u, int wr, int wc, int fr, int fq, PG8_LAS unsigned char* lds, int wid, int lane) const {
        typedef unsigned u32x2v __attribute__((ext_vector_type(2)));
        const PG8_LAS float* S = (const PG8_LAS float*)(lds + 8192);
        const int col0 = u.pn * BM + wc * 32 + 4 * fq; const int b = u.pm >> 4;
        const float* gate0 = mod + (size_t)b * 3072 + 2048; const float* sh1 = mod + (size_t)(8 + b) * 3072; const float* sc1 = sh1 + 1024;
        bool bad = st1.run(acc, u, wr, wc, fr, fq, lds, wid, lane);
        {
            f32x4 gg[2][2];
#pragma unroll
            for (int bj = 0; bj < 2; ++bj)
#pragma unroll
                for (int n = 0; n < 2; ++n) gg[bj][n] = *(const f32x4*)(gate0 + col0 + bj * HALF + n * 16) * *(const f32x4*)(gpost0 + col0 + bj * HALF + n * 16);
#pragma unroll
            for (int ai = 0; ai < 2; ++ai)
#pragma unroll
                for (int m = 0; m < 4; ++m) { const int r = ai * HALF + wr * 64 + m * 16 + fr; const float sr = S[r]; const size_t off = (size_t)(u.pm * BM + r) * DM + col0;
#pragma unroll
                    for (int bj = 0; bj < 2; ++bj)
#pragma unroll
                        for (int n = 0; n < 2; ++n) { const f32x4 bs = *(const f32x4*)(x + off + bj * HALF + n * 16); acc[ai][bj][m][n] = bs + gg[bj][n] * (acc[ai][bj][m][n] * sr); }
                    asm volatile("" : "+v"(acc[ai][0][m][0]), "+v"(acc[ai][0][m][1]), "+v"(acc[ai][1][m][0]), "+v"(acc[ai][1][m][1]));
                    if (m & 1) asm volatile("" ::: "memory"); }
        }
        bad = st2.run(acc, u, wr, wc, fr, fq, lds, wid, lane) || bad;
        const float qnan = __builtin_nanf("");
#pragma unroll
        for (int bj = 0; bj < 2; ++bj)
#pragma unroll
            for (int n = 0; n < 2; ++n) { const int c = col0 + bj * HALF + n * 16;
                const f32x4 gf = *(const f32x4*)(gpre1 + c) * (*(const f32x4*)(sc1 + c) + 1.0f), sh = *(const f32x4*)(sh1 + c);
#pragma unroll
                for (int ai = 0; ai < 2; ++ai)
#pragma unroll
                    for (int m = 0; m < 4; ++m) { const int r = ai * HALF + wr * 64 + m * 16 + fr; const float sr = S[r]; const size_t off = (size_t)(u.pm * BM + r) * DM + c;
                        f32x4 h = acc[ai][bj][m][n]; if (bad) h = (f32x4){qnan, qnan, qnan, qnan};
                        *(f32x4*)(out + off) = h;
                        const f32x4 nr = h * sr; u32x2v w; w.x = cvt_pk_bf16(nr[0], nr[1]); w.y = cvt_pk_bf16(nr[2], nr[3]); *(u32x2v*)(akv + off) = w;
                        const f32x4 z = nr * gf + sh; w.x = cvt_pk_bf16(z[0], z[1]); w.y = cvt_pk_bf16(z[2], z[3]); *(u32x2v*)(ain1 + off) = w; }
                asm volatile("" ::: "memory"); }
    }
};

struct EpiScan {
    static constexpr bool PERM = true, AFTER_DRAIN = true;
    const float* lb16; bf16_t* US; int carry_off;
    __device__ __forceinline__ void fused(f32x4 (&acc)[2][2][4][2], const Unit& u, int wr, int wc, int fr, int fq, PG8_LAS unsigned char* lds, int wid, int lane) const {
#pragma unroll
        for (int ai = 0; ai < 2; ++ai)
#pragma unroll
            for (int m = 0; m < 4; ++m) { const int row = ai * HALF + wr * 64 + m * 16 + fr; const int ch = (wc * 32 + 8 * fq) >> 2;
                *(PG8_LAS f32x4*)(lds + row * 512 + ((ch ^ (row & 7)) << 4)) = acc[ai][0][m][0];
                *(PG8_LAS f32x4*)(lds + row * 512 + (((ch + 1) ^ (row & 7)) << 4)) = acc[ai][0][m][1]; }
        asm volatile("s_waitcnt lgkmcnt(0)" ::: "memory"); __builtin_amdgcn_s_barrier(); asm volatile("" ::: "memory");
        const int p = lane, g = u.grp, b = u.pm;
        const float lr = lb16[(g * 64 + p) * 2], li = lb16[(g * 64 + p) * 2 + 1];
        typedef float f32x2v __attribute__((ext_vector_type(2)));
        const int coff = ((p >> 1) << 4) + (p & 1) * 8;
        float sr = 0.f, si = 0.f;
#pragma unroll 8
        for (int j = 0; j < 32; ++j) { const int t = wid * 32 + j; const f32x2v e = *(const PG8_LAS f32x2v*)(lds + t * 512 + (coff ^ ((t & 7) << 4)));
            const float nr = lr * sr - li * si + e.x, ni = lr * si + li * sr + e.y; sr = nr; si = ni; }
        PG8_LAS f32x2v* C = (PG8_LAS f32x2v*)(lds + carry_off);
        C[wid * 64 + p] = (f32x2v){sr, si};
        float pr = lr, pi = li;
#pragma unroll
        for (int q = 0; q < 5; ++q) { const float nr = pr * pr - pi * pi, ni = 2.f * pr * pi; pr = nr; pi = ni; }
        asm volatile("s_waitcnt lgkmcnt(0)" ::: "memory"); __builtin_amdgcn_s_barrier(); asm volatile("" ::: "memory");
        sr = 0.f; si = 0.f;
        for (int v = 0; v < wid; ++v) { const f32x2v c = C[v * 64 + p]; const float nr = pr * sr - pi * si + c.x, ni = pr * si + pi * sr + c.y; sr = nr; si = ni; }
        bf16_t* sp = US + us_off(g, b * 256 + wid * 32, 256 + 2 * p);
#pragma unroll 8
        for (int j = 0; j < 32; ++j) { const int t = wid * 32 + j; const f32x2v e = *(const PG8_LAS f32x2v*)(lds + t * 512 + (coff ^ ((t & 7) << 4)));
            *(unsigned*)(sp + (size_t)j * US_P) = cvt_pk_bf16(sr, si);
            const float nr = lr * sr - li * si + e.x, ni = lr * si + li * sr + e.y; sr = nr; si = ni; }
        asm volatile("s_waitcnt vmcnt(0)" ::: "memory");
    }
};
template <class Epi, bool ALIGN_EPI>
__device__ __forceinline__ void gemm_phase(PG8_LAS unsigned char* lds, const Gemm g, const Order& S, const Epi& E, int tid_in) {
    int tid_ = tid_in; asm volatile("" : "+v"(tid_));
    const int tid = tid_, wid = __builtin_amdgcn_readfirstlane(tid >> 6), lane = tid & 63, wr = wid >> 2, wc = wid & 3, fr = lane & 15, fq = lane >> 4;
    const int nt = g.nt;
    unsigned voffA[2], voffB[2];
#pragma unroll
    for (int i = 0; i < 2; ++i) { int R, C; stage_rc(tid * 16 + i * 8192, R, C); const int Rb = Epi::PERM ? ((R & ~31) + perm32(R & 31)) : R;
        voffA[i] = (unsigned)R * g.a_rs + (unsigned)(C >> 4) * g.a_c16 + (unsigned)(C & 15) * 2u; voffB[i] = (unsigned)Rb * g.b_rs + (unsigned)C * 2u; }
    const size_t kstepA = g.a_kstep, kstepB = (size_t)(BK * 2);
    const size_t hstepA = (size_t)HALF * g.a_rs, hstepB = (size_t)HALF * g.b_rs;
    const unsigned ldsw = (unsigned)wid * 1024u;
    const int aoff = lds_byte(wr * 64 + fr, fq * 8), boff = lds_byte(wc * 32 + fr, fq * 8);
#define PG8_SA(b, h) (((b) * 2 + (h)) * HTB)
#define PG8_SB(b, h) ((4 + (b) * 2 + (h)) * HTB)
#define PG8_STAGE(bufoff, gbase, voff) do { _Pragma("unroll") for (int _i = 0; _i < 2; ++_i) \
        __builtin_amdgcn_global_load_lds((const unsigned*)((const char*)(gbase) + (voff)[_i]), (PG8_LAS unsigned*)(lds + (bufoff) + ldsw + _i * 8192), 16, 0, 0); } while (0)
#define PG8_LDA(dst, b, h) do { _Pragma("unroll") for (int m = 0; m < 4; ++m) _Pragma("unroll") for (int k = 0; k < 2; ++k) dst[m][k] = *(const PG8_LAS bf16x8*)(lds + PG8_SA(b, h) + aoff + m * 2048 + k * 1024); } while (0)
#define PG8_LDB(dst, b, h) do { _Pragma("unroll") for (int n = 0; n < 2; ++n) _Pragma("unroll") for (int k = 0; k < 2; ++k) dst[n][k] = *(const PG8_LAS bf16x8*)(lds + PG8_SB(b, h) + boff + n * 2048 + k * 1024); } while (0)
#define PG8_MMA(ai, bj, At, Bt) do { __builtin_amdgcn_s_setprio(1); _Pragma("unroll") for (int m = 0; m < 4; ++m) _Pragma("unroll") for (int n = 0; n < 2; ++n) _Pragma("unroll") for (int k = 0; k < 2; ++k) \
        acc[ai][bj][m][n] = __builtin_amdgcn_mfma_f32_16x16x32_bf16(Bt[n][k], At[m][k], acc[ai][bj][m][n], 0, 0, 0); __builtin_amdgcn_s_setprio(0); } while (0)
#define PG8_WAIT_V(n) asm volatile("s_waitcnt vmcnt(" #n ")" ::: "memory")
#define PG8_WAIT_L(n) asm volatile("s_waitcnt lgkmcnt(" #n ")" ::: "memory")
#define PG8_BAR __builtin_amdgcn_s_barrier()
#define PG8_SCHED __builtin_amdgcn_sched_barrier(0)
    Unit cur, nxt; int ui = 0;
    if (!S.next(0, cur)) return;
    f32x4 acc[2][2][4][2];
#pragma unroll
    for (int a = 0; a < 2; ++a)
#pragma unroll
        for (int b = 0; b < 2; ++b)
#pragma unroll
            for (int m = 0; m < 4; ++m)
#pragma unroll
                for (int n = 0; n < 2; ++n) acc[a][b][m][n] = (f32x4){0.f, 0.f, 0.f, 0.f};
    bf16x8 At[4][2], B0[2][2], B1[2][2];
    const char* cA = g.abase(cur); const char* cB = g.bbase(cur);
    PG8_STAGE(PG8_SB(0, 0), cB, voffB); PG8_STAGE(PG8_SB(0, 1), cB + hstepB, voffB); PG8_STAGE(PG8_SA(0, 0), cA, voffA); PG8_STAGE(PG8_SA(0, 1), cA + hstepA, voffA);
    if (wr == 1) PG8_BAR;
    PG8_WAIT_V(2); PG8_BAR;
    PG8_STAGE(PG8_SB(1, 0), cB + kstepB, voffB); PG8_STAGE(PG8_SA(1, 0), cA + kstepA, voffA); PG8_STAGE(PG8_SB(1, 1), cB + hstepB + kstepB, voffB);
    PG8_WAIT_V(6); PG8_BAR;
    for (;;) {
        const bool has_next = S.next(ui + 1, nxt);
        const char* nA = has_next ? g.abase(nxt) : cA; const char* nB = has_next ? g.bbase(nxt) : cB;
        for (int t = 0; t < nt; t += 2) {
            const bool last = (t == nt - 2);
            const char* a1 = cA + (size_t)(t + 1) * kstepA;
            const char* a2 = last ? nA : cA + (size_t)(t + 2) * kstepA; const char* b2 = last ? nB : cB + (size_t)(t + 2) * kstepB;
            const char* a3 = a2 + kstepA; const char* b3 = b2 + kstepB;
            PG8_LDB(B0, 0, 0); PG8_LDB(B1, 0, 1); PG8_SCHED; PG8_LDA(At, 0, 0); PG8_STAGE(PG8_SA(1, 1), a1 + hstepA, voffA);
            PG8_WAIT_V(8); PG8_WAIT_L(0); PG8_BAR; PG8_MMA(0, 0, At, B0); PG8_MMA(0, 1, At, B1); PG8_BAR; PG8_SCHED;
            PG8_LDA(At, 0, 1); PG8_STAGE(PG8_SB(0, 0), b2, voffB); PG8_STAGE(PG8_SB(0, 1), b2 + hstepB, voffB); PG8_STAGE(PG8_SA(0, 0), a2, voffA);
            PG8_WAIT_V(8); PG8_WAIT_L(0); PG8_BAR; PG8_MMA(1, 0, At, B0); PG8_MMA(1, 1, At, B1); PG8_BAR; PG8_SCHED;
            PG8_LDB(B0, 1, 0); PG8_LDB(B1, 1, 1); PG8_SCHED; PG8_LDA(At, 1, 0); PG8_STAGE(PG8_SA(0, 1), a2 + hstepA, voffA);
            PG8_WAIT_V(8); PG8_WAIT_L(0); PG8_BAR; PG8_MMA(0, 0, At, B0); PG8_MMA(0, 1, At, B1); PG8_BAR; PG8_SCHED;
            PG8_LDA(At, 1, 1); PG8_STAGE(PG8_SB(1, 0), b3, voffB); PG8_STAGE(PG8_SB(1, 1), b3 + hstepB, voffB); PG8_STAGE(PG8_SA(1, 0), a3, voffA);
            PG8_WAIT_V(8); PG8_WAIT_L(0); PG8_BAR; PG8_MMA(1, 0, At, B0); PG8_MMA(1, 1, At, B1); PG8_BAR; PG8_SCHED;
        }
        if constexpr (ALIGN_EPI) { if (wr == 0) PG8_BAR; }
        if constexpr (!Epi::AFTER_DRAIN) { E(acc, cur, wr, wc, fr, fq); }
        if (!has_next) break;
#pragma unroll
        for (int a = 0; a < 2; ++a)
#pragma unroll
            for (int b = 0; b < 2; ++b)
#pragma unroll
                for (int m = 0; m < 4; ++m)
#pragma unroll
                    for (int n = 0; n < 2; ++n) acc[a][b][m][n] = (f32x4){0.f, 0.f, 0.f, 0.f};
        cur = nxt; cA = nA; cB = nB; ++ui;
        if constexpr (ALIGN_EPI) { if (wr == 1) PG8_BAR; }
    }
    PG8_WAIT_V(0);
    if constexpr (!ALIGN_EPI) { if (wr == 0) PG8_BAR; }
    PG8_BAR;
    if constexpr (Epi::AFTER_DRAIN) { E.fused(acc, cur, wr, wc, fr, fq, lds, wid, lane); PG8_WAIT_L(0); PG8_BAR; }
#undef PG8_SA
#undef PG8_SB
#undef PG8_STAGE
#undef PG8_LDA
#undef PG8_LDB
#undef PG8_MMA
#undef PG8_WAIT_V
#undef PG8_WAIT_L
#undef PG8_BAR
#undef PG8_SCHED
}
}

namespace attn_body {
using bf16 = bf16_t;
using bf16x8 = __attribute__((ext_vector_type(8))) short;
using s16x4 = __attribute__((ext_vector_type(4))) short;
using f32x16 = __attribute__((ext_vector_type(16))) float;
using u32x4 = __attribute__((ext_vector_type(4))) unsigned;
constexpr int SEQ = SEQL, D = 64, DMA = 1024;
constexpr int NW = 8, QBLK = 32, QB = QBLK * NW, KVBLK = 64, NQB = SEQ / QB;
__device__ __forceinline__ int crow(int r, int hi) { return (r & 3) + 8 * (r >> 2) + 4 * hi; }
#define SBAR() __builtin_amdgcn_sched_barrier(0)
__device__ __forceinline__ void cmask(f32x16& p0, f32x16& p1, int jb, int qrel, int hi) {
  const float NEG = -INFINITY; int kb = 64 * jb + 4 * hi;
  #pragma unroll
  for (int r = 0; r < 16; ++r) { int kv = kb + (r & 3) + 8 * (r >> 2); if (kv > qrel) p0[r] = NEG; if (kv + 32 > qrel) p1[r] = NEG; }
}
constexpr int NSLOT = 3, SLOTB = 8192;
constexpr int LDS_K = 0, LDS_V = NSLOT * SLOTB, LDS_WS = 2 * NSLOT * SLOTB, LDS_OST = LDS_WS + NW * 64 * 4, LDS_BYTES = LDS_OST + NW * 4096;
__device__ __forceinline__ void glds16(const void* gsrc, unsigned lds_dst) { unsigned keep;
  asm volatile("s_mov_b32 %0, m0\n\ts_mov_b32 m0, %2\n\ts_nop 0\n\tglobal_load_lds_dwordx4 %1, off\n\ts_mov_b32 m0, %0" : "=&s"(keep) : "v"(gsrc), "s"(lds_dst) : "memory"); }
__device__ __forceinline__ float max3f(float a, float b, float c) { float r; asm("v_max3_f32 %0, %1, %2, %3" : "=v"(r) : "v"(a), "v"(b), "v"(c)); return r; }
__device__ __forceinline__ float max2f(float a, float b) { float r; asm("v_max_f32_e32 %0, %1, %2" : "=v"(r) : "v"(a), "v"(b)); return r; }
__device__ __forceinline__ float fadd_s(float a, float b) { float r; asm("v_add_f32_e32 %0, %1, %2" : "=v"(r) : "v"(a), "v"(b)); return r; }
__device__ __forceinline__ float fsub_s(float a, float b) { float r; asm("v_sub_f32_e32 %0, %1, %2" : "=v"(r) : "v"(a), "v"(b)); return r; }
typedef float f32x2_t __attribute__((ext_vector_type(2))); typedef __bf16 bf16x2_t __attribute__((ext_vector_type(2)));
__device__ __forceinline__ unsigned cvtpk_s(float lo, float hi) { f32x2_t v = {lo, hi}; bf16x2_t b = __builtin_convertvector(v, bf16x2_t); return __builtin_bit_cast(unsigned, b); }
#define WAIT_BAR(N) asm volatile("s_waitcnt vmcnt(" #N ") lgkmcnt(0)\n\ts_barrier" ::: "memory")

__device__ __forceinline__ void qkt(f32x16& p0, f32x16& p1, const char* Kslot, const bf16x8* qr, const f32x16& negm, int r32, int hi) {
  const char* kb = Kslot + hi * 1024 + r32 * 16;
  #pragma unroll
  for (int d0 = 0; d0 < 4; ++d0) {
    const bf16x8 b0 = *reinterpret_cast<const bf16x8*>(kb + d0 * 2048);
    const bf16x8 b1 = *reinterpret_cast<const bf16x8*>(kb + d0 * 2048 + 512);
    if (d0 == 0) { p0 = __builtin_amdgcn_mfma_f32_32x32x16_bf16(b0, qr[0], negm, 0, 0, 0); p1 = __builtin_amdgcn_mfma_f32_32x32x16_bf16(b1, qr[0], negm, 0, 0, 0); }
    else { p0 = __builtin_amdgcn_mfma_f32_32x32x16_bf16(b0, qr[d0], p0, 0, 0, 0); p1 = __builtin_amdgcn_mfma_f32_32x32x16_bf16(b1, qr[d0], p1, 0, 0, 0); } }
}
typedef __attribute__((address_space(3))) const char* lds_cptr;
typedef short v4i16_t __attribute__((ext_vector_type(4)));
__device__ __forceinline__ void kload8(bf16x8* kf, lds_cptr kp) {
  kf[0] = *(const __attribute__((address_space(3))) bf16x8*)(kp);        kf[1] = *(const __attribute__((address_space(3))) bf16x8*)(kp + 512);
  kf[2] = *(const __attribute__((address_space(3))) bf16x8*)(kp + 2048); kf[3] = *(const __attribute__((address_space(3))) bf16x8*)(kp + 2560);
  kf[4] = *(const __attribute__((address_space(3))) bf16x8*)(kp + 4096); kf[5] = *(const __attribute__((address_space(3))) bf16x8*)(kp + 4608);
  kf[6] = *(const __attribute__((address_space(3))) bf16x8*)(kp + 6144); kf[7] = *(const __attribute__((address_space(3))) bf16x8*)(kp + 6656);
}
__device__ __forceinline__ void kload2(bf16x8* kf, lds_cptr kp, int j) { kf[2 * j] = *(const __attribute__((address_space(3))) bf16x8*)(kp + j * 2048); kf[2 * j + 1] = *(const __attribute__((address_space(3))) bf16x8*)(kp + j * 2048 + 512); }
__device__ __forceinline__ s16x4 vtr(lds_cptr p) { return __builtin_bit_cast(s16x4, __builtin_amdgcn_ds_read_tr16_b64_v4i16((__attribute__((address_space(3))) v4i16_t*)p)); }
__device__ __forceinline__ float rowmax(const f32x16& p0, const f32x16& p1) {
  float a = max3f(p0[0], p0[1], p1[0]), b = max3f(p0[2], p0[3], p1[1]); a = max3f(a, p1[2], p1[3]);
  #pragma unroll
  for (int r = 4; r < 16; r += 4) { a = max3f(a, p0[r], p0[r + 1]); b = max3f(b, p0[r + 2], p0[r + 3]); a = max3f(a, p1[r], p1[r + 1]); b = max3f(b, p1[r + 2], p1[r + 3]); }
  const float m = max2f(a, b);
  auto rr = __builtin_amdgcn_permlane32_swap(__float_as_uint(m), __float_as_uint(m), false, false);
  return max2f(__uint_as_float(rr[0]), __uint_as_float(rr[1]));
}
__device__ __forceinline__ void pv(f32x16* o, int vb, bf16x8 pa0, bf16x8 pa1, bf16x8 pa2, bf16x8 pa3) {
  #pragma unroll
  for (int d0 = 0; d0 < 2; ++d0) { s16x4 lo[4], hi[4];
    #pragma unroll
    for (int ks = 0; ks < 4; ++ks) {
      asm volatile("ds_read_b64_tr_b16 %0,%1 offset:%c2" : "=&v"(lo[ks]) : "v"(vb), "i"(d0 * 4096 + ks * 1024) : "memory");
      asm volatile("ds_read_b64_tr_b16 %0,%1 offset:%c2" : "=&v"(hi[ks]) : "v"(vb), "i"(d0 * 4096 + ks * 1024 + 512) : "memory"); }
    asm volatile("s_waitcnt lgkmcnt(0)" ::: "memory"); SBAR();
    #define PK(k) (bf16x8){lo[k][0], lo[k][1], lo[k][2], lo[k][3], hi[k][0], hi[k][1], hi[k][2], hi[k][3]}
    o[d0] = __builtin_amdgcn_mfma_f32_32x32x16_bf16(pa0, PK(0), o[d0], 0, 0, 0);
    o[d0] = __builtin_amdgcn_mfma_f32_32x32x16_bf16(pa1, PK(1), o[d0], 0, 0, 0);
    o[d0] = __builtin_amdgcn_mfma_f32_32x32x16_bf16(pa2, PK(2), o[d0], 0, 0, 0);
    o[d0] = __builtin_amdgcn_mfma_f32_32x32x16_bf16(pa3, PK(3), o[d0], 0, 0, 0);
    #undef PK
  }
}
#define ATTN_STORE16(p, v) (*(u32x4*)(p) = (v))
template <int THRL> __device__ __forceinline__ void attn_unit(int tid_in, int b, int hq, int hv, int qb, const bf16* Q, const bf16* __restrict__ K, const bf16* __restrict__ V, bf16* O, char* shm) {
  const int tid = tid_in, lane = tid & 63, r32 = lane & 31, hi = lane >> 5; const int wid = __builtin_amdgcn_readfirstlane(tid >> 6);
  const long rowbase = (long)b * SEQ; const int q0 = qb * QB;
  const bf16* Qw = Q + (rowbase + q0 + wid * QBLK) * DMA + hq * D;
  const bf16* Kh = K + rowbase * DMA + hq * D, *Vh = V + rowbase * DMA + hv * D;
  const unsigned lds0 = (unsigned)(uintptr_t)shm;
  float* wsf = (float*)(shm + LDS_WS) + wid * 64;
  const bf16* ksrc = Kh + (long)lane * DMA + wid * 8;
  const bf16* vsrc = Vh + (long)(16 * (wid & 3) + (lane >> 2)) * DMA + (wid >> 2) * 32 + (lane & 3) * 8;
  const unsigned kdst = lds0 + LDS_K + wid * 1024, vdst = lds0 + LDS_V + wid * 1024;
  #define DMA_K(t, slot) glds16(ksrc + (long)(t) * KVBLK * DMA, (unsigned)__builtin_amdgcn_readfirstlane(kdst + (slot)))
  #define DMA_V(t, slot) glds16(vsrc + (long)(t) * KVBLK * DMA, (unsigned)__builtin_amdgcn_readfirstlane(vdst + (slot)))
  const int vb0 = (int)(lds0 + LDS_V) + ((lane >> 4) & 1) * 32 + (lane & 3) * 8 + (4 * hi + ((lane & 15) >> 2)) * 64;
  const char* Kbase = shm + LDS_K; bf16x8 kf[8];
  const lds_cptr shm3 = (lds_cptr)shm; const lds_cptr kp0 = shm3 + LDS_K + hi * 1024 + r32 * 16; const lds_cptr vp0 = shm3 + LDS_V + ((lane >> 4) & 1) * 32 + (lane & 3) * 8 + (4 * hi + ((lane & 15) >> 2)) * 64;
  const int NT = (q0 + QB) / KVBLK;
  DMA_K(0, 0); DMA_V(0, 0); DMA_K(1, SLOTB);
  bf16x8 qr[4];
  #pragma unroll
  for (int d0 = 0; d0 < 4; ++d0) qr[d0] = *reinterpret_cast<const bf16x8*>(&Qw[(long)r32 * DMA + d0 * 16 + hi * 8]);
  float mhat = 0.f, l_reg = 0.f; f32x16 o[2]; o[0] = f32x16{}; o[1] = f32x16{}; f32x16 negm = f32x16{}; asm volatile("" : "+v"(negm));
  const int qrel = wid * QBLK + r32;
  #define CMASK(P0, P1, t) do { int jb_ = (t) - (NT - 4); if (jb_ >= 0) cmask(P0, P1, jb_, qrel, hi); } while (0)
  bool resc = false;
  #define START(P0, P1) do { const float rm = rowmax(P0, P1); resc = false; \
    { const float dl = rm; mhat = fadd_s(mhat, dl); \
      _Pragma("unroll") for (int r = 0; r < 16; ++r) { P0[r] = fsub_s(P0[r], dl); P1[r] = fsub_s(P1[r], dl); } \
      _Pragma("unroll") for (int r = 0; r < 16; ++r) negm[r] = -mhat; asm volatile("" : "+v"(negm)); } \
    _Pragma("unroll") for (int r = 0; r < 16; ++r) P0[r] = __builtin_amdgcn_exp2f(P0[r]); } while (0)
  #define RESC() do { if (resc) { asm volatile("s_waitcnt lgkmcnt(0)" ::: "memory"); \
      _Pragma("unroll") for (int d_ = 0; d_ < 2; ++d_) _Pragma("unroll") for (int r = 0; r < 16; ++r) o[d_][r] *= wsf[crow(r, hi)]; } } while (0)
  f32x16 pA0, pA1, pB0, pB1;
  int sl_prev = 0, sl_cur = 0, sl_next = SLOTB;
  #define ROT() do { sl_prev = sl_cur; sl_cur = sl_next; sl_next = (sl_next == (NSLOT - 1) * SLOTB) ? 0 : sl_next + SLOTB; } while (0)
  DMA_K(2, 2 * SLOTB);
  WAIT_BAR(3);
  qkt(pA0, pA1, Kbase, qr, negm, r32, hi); asm volatile("s_nop 15\n\ts_nop 7" : "+v"(pA0), "+v"(pA1)); CMASK(pA0, pA1, 0);
  START(pA0, pA1);
  _Pragma("unroll") for (int r = 0; r < 16; ++r) pA1[r] = __builtin_amdgcn_exp2f(pA1[r]);
  WAIT_BAR(0);
  DMA_K(3, 0); DMA_V(1, SLOTB);
  ROT();
  kload8(kf, kp0 + sl_cur);
  WAIT_BAR(2);
  s16x4 vlo[8], vhi[8]; u32x4 pw0, pw1, pw2, pw3;
  #define PKW(P, B) cvtpk_s(P[B], P[B + 1])
  #define PAF(k) __builtin_bit_cast(bf16x8, pw##k)
  #define VFR(i) (bf16x8){vlo[i][0], vlo[i][1], vlo[i][2], vlo[i][3], vhi[i][0], vhi[i][1], vhi[i][2], vhi[i][3]}
  #define PIN(x) asm volatile("" : "+v"(x))
  #define MX3(a, b, c) __builtin_fmaxf(__builtin_fmaxf((a), (b)), (c))
  #define GAPA(MF, A0, A1, A2, A3, W0, W1, PW) do { MF; sacc += A0; sacc += A1; sacc += A2; sacc += A3; PIN(sacc); W0; W1; PIN(PW); SBAR(); } while (0)
  #define EX(v) __builtin_amdgcn_exp2f(v)
  #define GAPB(MF, X, B) do { MF; X[B] = EX(X[B]); X[B + 1] = EX(X[B + 1]); X[B + 2] = EX(X[B + 2]); X[B + 3] = EX(X[B + 3]); PIN(X); SBAR(); } while (0)
  #define VRD(i) do { vlo[i] = vtr(vp_ + (((i) >> 2) * 4096 + ((i) & 3) * 1024)); vhi[i] = vtr(vp_ + (((i) >> 2) * 4096 + ((i) & 3) * 1024 + 512)); } while (0)
  #define KRD(G, j) do { if (G) { kload2(kf, kp0 + sl_next, j); SBAR(); } } while (0)
  #define STEP(C0, C1, P0, P1, t, GK, GV, GL) do { SBAR(); \
    const lds_cptr vp_ = vp0 + sl_prev; \
    VRD(0); SBAR(); float sacc = (P0[0] + P0[1]); \
    GAPA(C0 = __builtin_amdgcn_mfma_f32_32x32x16_bf16(kf[0], qr[0], negm, 0, 0, 0), P0[2], P0[3], P0[4], P0[5],     pw0[0] = PKW(P0, 0), pw0[1] = PKW(P0, 2), pw0); \
    VRD(4); SBAR(); GAPA(C1 = __builtin_amdgcn_mfma_f32_32x32x16_bf16(kf[1], qr[0], negm, 0, 0, 0), P0[6], P0[7], P0[8], P0[9],     pw0[2] = PKW(P0, 4), pw0[3] = PKW(P0, 6), pw0); \
    VRD(1); SBAR(); GAPA(C0 = __builtin_amdgcn_mfma_f32_32x32x16_bf16(kf[2], qr[1], C0, 0, 0, 0),   P0[10], P0[11], P0[12], P0[13], pw1[0] = PKW(P0, 8), pw1[1] = PKW(P0, 10), pw1); \
    VRD(5); SBAR(); GAPA(C1 = __builtin_amdgcn_mfma_f32_32x32x16_bf16(kf[3], qr[1], C1, 0, 0, 0),   P0[14], P0[15], P1[0], P1[1],   pw1[2] = PKW(P0, 12), pw1[3] = PKW(P0, 14), pw1); \
    VRD(2); SBAR(); GAPA(C0 = __builtin_amdgcn_mfma_f32_32x32x16_bf16(kf[4], qr[2], C0, 0, 0, 0),   P1[2], P1[3], P1[4], P1[5],     pw2[0] = PKW(P1, 0), pw2[1] = PKW(P1, 2), pw2); \
    VRD(6); SBAR(); GAPA(C1 = __builtin_amdgcn_mfma_f32_32x32x16_bf16(kf[5], qr[2], C1, 0, 0, 0),   P1[6], P1[7], P1[8], P1[9],     pw2[2] = PKW(P1, 4), pw2[3] = PKW(P1, 6), pw2); \
    VRD(3); SBAR(); GAPA(C0 = __builtin_amdgcn_mfma_f32_32x32x16_bf16(kf[6], qr[3], C0, 0, 0, 0),   P1[10], P1[11], P1[12], P1[13], pw3[0] = PKW(P1, 8), pw3[1] = PKW(P1, 10), pw3); \
    VRD(7); SBAR(); GAPA(C1 = __builtin_amdgcn_mfma_f32_32x32x16_bf16(kf[7], qr[3], C1, 0, 0, 0),   P1[14], P1[15], 0.f, 0.f,       pw3[2] = PKW(P1, 12), pw3[3] = PKW(P1, 14), pw3); \
    l_reg += sacc; \
    if (GK) { DMA_K((t) + 3, sl_cur); } if (GV) { DMA_V((t) + 1, sl_next); } \
    CMASK(C0, C1, t); \
    { float a = MX3(C0[0], C0[1], C1[0]), b = MX3(C0[2], C0[3], C1[1]); a = MX3(a, C1[2], C1[3]); \
      _Pragma("unroll") for (int r = 4; r < 16; r += 4) { a = MX3(a, C0[r], C0[r + 1]); b = MX3(b, C0[r + 2], C0[r + 3]); a = MX3(a, C1[r], C1[r + 1]); b = MX3(b, C1[r + 2], C1[r + 3]); } \
      float rm = __builtin_fmaxf(a, b); { auto rr = __builtin_amdgcn_permlane32_swap(__float_as_uint(rm), __float_as_uint(rm), false, false); rm = __builtin_fmaxf(__uint_as_float(rr[0]), __uint_as_float(rr[1])); } \
      resc = false; \
      if (__builtin_expect(__any(rm > (float)THRL), 0)) { const float dl = __builtin_fmaxf(rm, 0.f); mhat += dl; \
        _Pragma("unroll") for (int r = 0; r < 16; ++r) { C0[r] -= dl; C1[r] -= dl; } \
        _Pragma("unroll") for (int r = 0; r < 16; ++r) negm[r] = -mhat; asm volatile("" : "+v"(negm)); \
        const float f = __builtin_amdgcn_exp2f(-dl); l_reg *= f; if (hi == 0) wsf[r32] = f; resc = true; } } \
    SBAR(); \
    GAPB(o[0] = __builtin_amdgcn_mfma_f32_32x32x16_bf16(PAF(0), VFR(0), o[0], 0, 0, 0), C0, 0); \
    GAPB(o[1] = __builtin_amdgcn_mfma_f32_32x32x16_bf16(PAF(0), VFR(4), o[1], 0, 0, 0), C0, 4); \
    KRD(GL, 0); GAPB(o[0] = __builtin_amdgcn_mfma_f32_32x32x16_bf16(PAF(1), VFR(1), o[0], 0, 0, 0), C0, 8); \
    KRD(GL, 1); GAPB(o[1] = __builtin_amdgcn_mfma_f32_32x32x16_bf16(PAF(1), VFR(5), o[1], 0, 0, 0), C0, 12); \
    KRD(GL, 2); GAPB(o[0] = __builtin_amdgcn_mfma_f32_32x32x16_bf16(PAF(2), VFR(2), o[0], 0, 0, 0), C1, 0); \
    KRD(GL, 3); GAPB(o[1] = __builtin_amdgcn_mfma_f32_32x32x16_bf16(PAF(2), VFR(6), o[1], 0, 0, 0), C1, 4); \
    GAPB(o[0] = __builtin_amdgcn_mfma_f32_32x32x16_bf16(PAF(3), VFR(3), o[0], 0, 0, 0), C1, 8); \
    GAPB(o[1] = __builtin_amdgcn_mfma_f32_32x32x16_bf16(PAF(3), VFR(7), o[1], 0, 0, 0), C1, 12); \
    } while (0)
  int t = 1;
  #undef CMASK
  #define CMASK(P0, P1, t) do {} while (0)
  for (; t + 5 < NT; t += 2) {
    STEP(pB0, pB1, pA0, pA1, t, true, true, true);     WAIT_BAR(2); RESC(); ROT();
    STEP(pA0, pA1, pB0, pB1, t + 1, true, true, true); WAIT_BAR(2); RESC(); ROT();
  }
  #undef CMASK
  #define CMASK(P0, P1, t) do { int jb_ = (t) - (NT - 4); if (jb_ >= 0) cmask(P0, P1, jb_, qrel, hi); } while (0)
  #define ENDW(tt) do { if ((tt) + 3 < NT) { WAIT_BAR(2); } else if ((tt) + 2 < NT) { WAIT_BAR(1); } else { WAIT_BAR(0); } } while (0)
  for (; t + 1 < NT; t += 2) {
    STEP(pB0, pB1, pA0, pA1, t, (t + 3 < NT), (t + 1 < NT), (t + 1 < NT));         ENDW(t);     RESC(); ROT();
    STEP(pA0, pA1, pB0, pB1, t + 1, (t + 4 < NT), (t + 2 < NT), (t + 2 < NT));     ENDW(t + 1); RESC(); ROT();
  }
  STEP(pB0, pB1, pA0, pA1, NT - 1, false, false, false); RESC();
  { float sacc = pB0[0] + pB0[1]; _Pragma("unroll") for (int r = 2; r < 16; ++r) sacc += pB0[r]; _Pragma("unroll") for (int r = 0; r < 16; ++r) sacc += pB1[r]; l_reg += sacc;
    pw0 = (u32x4){PKW(pB0, 0), PKW(pB0, 2), PKW(pB0, 4), PKW(pB0, 6)}; pw1 = (u32x4){PKW(pB0, 8), PKW(pB0, 10), PKW(pB0, 12), PKW(pB0, 14)}; pw2 = (u32x4){PKW(pB1, 0), PKW(pB1, 2), PKW(pB1, 4), PKW(pB1, 6)}; pw3 = (u32x4){PKW(pB1, 8), PKW(pB1, 10), PKW(pB1, 12), PKW(pB1, 14)};
    SBAR(); pv(o, vb0 + sl_cur, PAF(0), PAF(1), PAF(2), PAF(3)); }
  #undef PKW
  #undef PAF
  #undef VFR
  #undef PIN
  #undef MX3
  #undef GAPA
  #undef GAPB
  #undef EX
  #undef VRD
  #undef KRD
  #undef STEP
  #undef ENDW
  { auto rr = __builtin_amdgcn_permlane32_swap(__float_as_uint(l_reg), __float_as_uint(l_reg), false, false); l_reg = __uint_as_float(rr[0]) + __uint_as_float(rr[1]); }
  if (hi == 0) wsf[32 + r32] = l_reg; asm volatile("s_waitcnt lgkmcnt(0)" ::: "memory");
  float rli[16];
  #pragma unroll
  for (int r = 0; r < 16; ++r) rli[r] = __builtin_amdgcn_rcpf(wsf[32 + crow(r, hi)]);
  bf16* Ow = O + (rowbase + q0 + wid * QBLK) * DMA + hv * D;
  { bf16* stg = (bf16*)(shm + LDS_OST) + wid * 2048;
    #pragma unroll
    for (int r = 0; r < 16; ++r) { const int orow = crow(r, hi);
      #pragma unroll
      for (int d0 = 0; d0 < 2; ++d0) stg[orow * 64 + d0 * 32 + r32] = f2bf(o[d0][r] * rli[r]); }
    asm volatile("s_waitcnt lgkmcnt(0)" ::: "memory");
    #pragma unroll
    for (int i = 0; i < 4; ++i) { const int row = i * 8 + (lane >> 3), ch = lane & 7; const u32x4 v = *(const u32x4*)(stg + row * 64 + ch * 8); ATTN_STORE16(Ow + (long)row * DMA + ch * 8, v); } }
  asm volatile("s_waitcnt lgkmcnt(0)\n\ts_barrier" ::: "memory");
  #undef DMA_K
  #undef DMA_V
  #undef CMASK
  #undef START
  #undef RESC
  #undef ROT
}
constexpr int ATTN_LDS_BYTES = LDS_BYTES;
#undef SBAR
#undef WAIT_BAR
}

namespace attn3 {
using namespace attn_body;
constexpr int KSLOT = 8192, VSLOT = 16384;
constexpr int L_K = 0, L_V = NSLOT * KSLOT, L_WS = L_V + NSLOT * VSLOT, L_OST = L_WS + NW * 64 * 4, L_BYTES = L_OST + NW * 4096;
#define SBAR() __builtin_amdgcn_sched_barrier(0)
#define WAIT_BAR(N) asm volatile("s_waitcnt vmcnt(" #N ") lgkmcnt(0)\n\ts_barrier" ::: "memory")
template <int THRL> __device__ __forceinline__ void attn_unit(int tid_in, int b, int hq, int h, int qb, const bf16* Q, const bf16* __restrict__ K, const bf16* __restrict__ V, bf16* O, char* shm,
                                                             int mode, const bf16* SZ1, const float* g_sub, float lam, bf16* OG) {
  int tid_ = tid_in; asm volatile("" : "+v"(tid_));
  const int tid = tid_, lane = tid & 63, r32 = lane & 31, hi = lane >> 5; const int wid = __builtin_amdgcn_readfirstlane(tid >> 6);
  const long rowbase = (long)b * SEQ; const int q0 = qb * QB;
  const bf16* Qw = Q + (rowbase + q0 + wid * QBLK) * DMA + hq * D;
  const bf16* Kh = K + rowbase * DMA + hq * D, *Vh = V + rowbase * DMA + h * 128;
  const unsigned lds0 = (unsigned)(uintptr_t)shm;
  float* wsf = (float*)(shm + L_WS) + wid * 64;
  const bf16* ksrc = Kh + (long)lane * DMA + wid * 8;
  const bf16* vsrc = Vh + (long)(16 * (wid & 3) + (lane >> 2)) * DMA + (wid >> 2) * 32 + (lane & 3) * 8;
  const unsigned kdst = lds0 + L_K + wid * 1024, vdst = lds0 + L_V + wid * 1024;
  #define DMA_K(t, si) glds16(ksrc + (long)(t) * KVBLK * DMA, (unsigned)__builtin_amdgcn_readfirstlane(kdst + (si) * KSLOT))
  #define DMA_V(t, si) do { glds16(vsrc + (long)(t) * KVBLK * DMA, (unsigned)__builtin_amdgcn_readfirstlane(vdst + (si) * VSLOT)); \
                            glds16(vsrc + (long)(t) * KVBLK * DMA + 64, (unsigned)__builtin_amdgcn_readfirstlane(vdst + (si) * VSLOT + 8192)); } while (0)
  const int vb0 = (int)(lds0 + L_V) + ((lane >> 4) & 1) * 32 + (lane & 3) * 8 + (4 * hi + ((lane & 15) >> 2)) * 64;
  const char* Kbase = shm + L_K; bf16x8 kf[8];
  const lds_cptr shm3 = (lds_cptr)shm; const lds_cptr kp0 = shm3 + L_K + hi * 1024 + r32 * 16; const lds_cptr vp0 = shm3 + L_V + ((lane >> 4) & 1) * 32 + (lane & 3) * 8 + (4 * hi + ((lane & 15) >> 2)) * 64;
  const int NT = (q0 + QB) / KVBLK;
  DMA_K(0, 0); DMA_V(0, 0); DMA_K(1, 1);
  bf16x8 qr[4];
  #pragma unroll
  for (int d0 = 0; d0 < 4; ++d0) qr[d0] = *reinterpret_cast<const bf16x8*>(&Qw[(long)r32 * DMA + d0 * 16 + hi * 8]);
  float mhat = 0.f, l_reg = 0.f; f32x16 o[4]; f32x16 negm;
  { float zf = 0.f; asm volatile("" : "+v"(zf));
    _Pragma("unroll") for (int r = 0; r < 16; ++r) { o[0][r] = zf; o[1][r] = zf; o[2][r] = zf; o[3][r] = zf; negm[r] = zf; } }
  asm volatile("" : "+v"(negm));
  const int qrel = wid * QBLK + r32;
  #define CMASK(P0, P1, t) do { int jb_ = (t) - (NT - 4); if (jb_ >= 0) cmask(P0, P1, jb_, qrel, hi); } while (0)
  bool resc = false;
  #define RESC() do { if (resc) { asm volatile("s_waitcnt lgkmcnt(0)" ::: "memory"); \
      _Pragma("unroll") for (int d_ = 0; d_ < 4; ++d_) _Pragma("unroll") for (int r = 0; r < 16; ++r) o[d_][r] *= wsf[crow(r, hi)]; } } while (0)
  f32x16 C0, C1;
  int s_prev = 0, s_cur = 0, s_next = 1;
  #define ROT() do { s_prev = s_cur; s_cur = s_next; s_next = (s_next == NSLOT - 1) ? 0 : s_next + 1; } while (0)
  DMA_K(2, 2);
  WAIT_BAR(4);
  u32x4 pwA0, pwA1, pwA2, pwA3, pwB0, pwB1, pwB2, pwB3;
  #define PKW(P, B) cvtpk_s(P[B], P[B + 1])
  qkt(C0, C1, Kbase, qr, negm, r32, hi); asm volatile("s_nop 15\n\ts_nop 7" : "+v"(C0), "+v"(C1)); CMASK(C0, C1, 0);
  { const float rm = rowmax(C0, C1); mhat = fadd_s(mhat, rm);
    _Pragma("unroll") for (int r = 0; r < 16; ++r) { C0[r] = fsub_s(C0[r], rm); C1[r] = fsub_s(C1[r], rm); }
    _Pragma("unroll") for (int r = 0; r < 16; ++r) negm[r] = -mhat; asm volatile("" : "+v"(negm));
    float sacc = 0.f;
    _Pragma("unroll") for (int r = 0; r < 16; ++r) { C0[r] = __builtin_amdgcn_exp2f(C0[r]); C1[r] = __builtin_amdgcn_exp2f(C1[r]); }
    _Pragma("unroll") for (int r = 0; r < 16; ++r) sacc += C0[r] + C1[r];
    l_reg = sacc;
    pwA0 = (u32x4){PKW(C0, 0), PKW(C0, 2), PKW(C0, 4), PKW(C0, 6)}; pwA1 = (u32x4){PKW(C0, 8), PKW(C0, 10), PKW(C0, 12), PKW(C0, 14)};
    pwA2 = (u32x4){PKW(C1, 0), PKW(C1, 2), PKW(C1, 4), PKW(C1, 6)}; pwA3 = (u32x4){PKW(C1, 8), PKW(C1, 10), PKW(C1, 12), PKW(C1, 14)}; }
  WAIT_BAR(0);
  DMA_K(3, 0); DMA_V(1, 1);
  ROT();
  kload8(kf, kp0 + s_cur * KSLOT);
  WAIT_BAR(3);
  s16x4 vlo[8], vhi[8];
  #define PAF(w) __builtin_bit_cast(bf16x8, w)
  #define VFR(i) (bf16x8){vlo[i][0], vlo[i][1], vlo[i][2], vlo[i][3], vhi[i][0], vhi[i][1], vhi[i][2], vhi[i][3]}
  #define PIN(x) asm volatile("" : "+v"(x))
  #define MX3(a, b, c) __builtin_fmaxf(__builtin_fmaxf((a), (b)), (c))
  #define EX(v) __builtin_amdgcn_exp2f(v)
  #define VRD(s, f) do { vlo[s] = vtr(vp_ + (((f) >> 2) * 4096 + ((f) & 3) * 1024)); vhi[s] = vtr(vp_ + (((f) >> 2) * 4096 + ((f) & 3) * 1024 + 512)); } while (0)
  #define KRD(G, j) do { if (G) { kload2(kf, kp0 + s_next * KSLOT, j); SBAR(); } } while (0)
  #define GAPB(MF, X, B, PWW) do { MF; X[B] = EX(X[B]); X[B + 1] = EX(X[B + 1]); sacc += X[B]; sacc += X[B + 1]; PIN(sacc); PWW = PKW(X, B); PIN(PWW); SBAR(); } while (0)
  #define MFQ(a, b, c) __builtin_amdgcn_mfma_f32_32x32x16_bf16(a, b, c, 0, 0, 0)
  #define STEP(PP0, PP1, PP2, PP3, PN0, PN1, PN2, PN3, t, GK, GV, GL) do { SBAR(); \
    const lds_cptr vp_ = vp0 + s_prev * VSLOT; \
    VRD(0, 0); SBAR(); C0 = MFQ(kf[0], qr[0], negm); SBAR(); \
    VRD(4, 4); SBAR(); C1 = MFQ(kf[1], qr[0], negm); SBAR(); \
    VRD(1, 1); SBAR(); C0 = MFQ(kf[2], qr[1], C0); SBAR(); \
    VRD(5, 5); SBAR(); C1 = MFQ(kf[3], qr[1], C1); SBAR(); \
    VRD(2, 2); SBAR(); C0 = MFQ(kf[4], qr[2], C0); SBAR(); \
    VRD(6, 6); SBAR(); C1 = MFQ(kf[5], qr[2], C1); SBAR(); \
    VRD(3, 3); SBAR(); C0 = MFQ(kf[6], qr[3], C0); SBAR(); \
    VRD(7, 7); SBAR(); C1 = MFQ(kf[7], qr[3], C1); SBAR(); \
    if (GK) { DMA_K((t) + 3, s_cur); } if (GV) { DMA_V((t) + 1, s_next); } \
    CMASK(C0, C1, t); \
    { float a = MX3(C0[0], C0[1], C1[0]), b = MX3(C0[2], C0[3], C1[1]); a = MX3(a, C1[2], C1[3]); \
      _Pragma("unroll") for (int r = 4; r < 16; r += 4) { a = MX3(a, C0[r], C0[r + 1]); b = MX3(b, C0[r + 2], C0[r + 3]); a = MX3(a, C1[r], C1[r + 1]); b = MX3(b, C1[r + 2], C1[r + 3]); } \
      float rm = __builtin_fmaxf(a, b); { auto rr = __builtin_amdgcn_permlane32_swap(__float_as_uint(rm), __float_as_uint(rm), false, false); rm = __builtin_fmaxf(__uint_as_float(rr[0]), __uint_as_float(rr[1])); } \
      resc = false; \
      if (__builtin_expect(__any(rm > (float)THRL), 0)) { const float dl = __builtin_fmaxf(rm, 0.f); mhat += dl; \
        _Pragma("unroll") for (int r = 0; r < 16; ++r) { C0[r] -= dl; C1[r] -= dl; } \
        _Pragma("unroll") for (int r = 0; r < 16; ++r) negm[r] = -mhat; asm volatile("" : "+v"(negm)); \
        const float f = __builtin_amdgcn_exp2f(-dl); l_reg *= f; if (hi == 0) wsf[r32] = f; resc = true; } } \
    SBAR(); float sacc = 0.f; \
    GAPB(o[0] = MFQ(PAF(PP0), VFR(0), o[0]), C0, 0,  PN0[0]); VRD(0, 8);  SBAR(); \
    GAPB(o[1] = MFQ(PAF(PP0), VFR(4), o[1]), C0, 2,  PN0[1]); VRD(4, 12); SBAR(); \
    GAPB(o[0] = MFQ(PAF(PP1), VFR(1), o[0]), C0, 4,  PN0[2]); VRD(1, 9);  SBAR(); \
    GAPB(o[1] = MFQ(PAF(PP1), VFR(5), o[1]), C0, 6,  PN0[3]); VRD(5, 13); SBAR(); \
    GAPB(o[0] = MFQ(PAF(PP2), VFR(2), o[0]), C0, 8,  PN1[0]); VRD(2, 10); SBAR(); \
    GAPB(o[1] = MFQ(PAF(PP2), VFR(6), o[1]), C0, 10, PN1[1]); VRD(6, 14); SBAR(); \
    GAPB(o[0] = MFQ(PAF(PP3), VFR(3), o[0]), C0, 12, PN1[2]); VRD(3, 11); SBAR(); \
    GAPB(o[1] = MFQ(PAF(PP3), VFR(7), o[1]), C0, 14, PN1[3]); VRD(7, 15); SBAR(); \
    GAPB(o[2] = MFQ(PAF(PP0), VFR(0), o[2]), C1, 0,  PN2[0]); \
    GAPB(o[3] = MFQ(PAF(PP0), VFR(4), o[3]), C1, 2,  PN2[1]); \
    KRD(GL, 0); GAPB(o[2] = MFQ(PAF(PP1), VFR(1), o[2]), C1, 4,  PN2[2]); \
    KRD(GL, 1); GAPB(o[3] = MFQ(PAF(PP1), VFR(5), o[3]), C1, 6,  PN2[3]); \
    KRD(GL, 2); GAPB(o[2] = MFQ(PAF(PP2), VFR(2), o[2]), C1, 8,  PN3[0]); \
    KRD(GL, 3); GAPB(o[3] = MFQ(PAF(PP2), VFR(6), o[3]), C1, 10, PN3[1]); \
    GAPB(o[2] = MFQ(PAF(PP3), VFR(3), o[2]), C1, 12, PN3[2]); \
    GAPB(o[3] = MFQ(PAF(PP3), VFR(7), o[3]), C1, 14, PN3[3]); \
    l_reg += sacc; \
    } while (0)
  #define STEP_AB(t, GK, GV, GL) STEP(pwA0, pwA1, pwA2, pwA3, pwB0, pwB1, pwB2, pwB3, t, GK, GV, GL)
  #define STEP_BA(t, GK, GV, GL) STEP(pwB0, pwB1, pwB2, pwB3, pwA0, pwA1, pwA2, pwA3, t, GK, GV, GL)
  int t = 1;
  #undef CMASK
  #define CMASK(P0, P1, t) do {} while (0)
  for (; t + 5 < NT; t += 2) {
    STEP_AB(t, true, true, true);     WAIT_BAR(3); RESC(); ROT();
    STEP_BA(t + 1, true, true, true); WAIT_BAR(3); RESC(); ROT();
  }
  #undef CMASK
  #define CMASK(P0, P1, t) do { int jb_ = (t) - (NT - 4); if (jb_ >= 0) cmask(P0, P1, jb_, qrel, hi); } while (0)
  #define ENDW(tt) do { if ((tt) + 3 < NT) { WAIT_BAR(3); } else if ((tt) + 2 < NT) { WAIT_BAR(2); } else { WAIT_BAR(0); } } while (0)
  for (; t + 1 < NT; t += 2) {
    STEP_AB(t, (t + 3 < NT), (t + 1 < NT), (t + 1 < NT));         ENDW(t);     RESC(); ROT();
    STEP_BA(t + 1, (t + 4 < NT), (t + 2 < NT), (t + 2 < NT));     ENDW(t + 1); RESC(); ROT();
  }
  STEP_AB(NT - 1, false, false, false); RESC();
  { SBAR();
    const int vb = vb0 + s_cur * VSLOT;
    #pragma unroll
    for (int d0 = 0; d0 < 4; ++d0) { s16x4 lo[4], hh[4];
      #pragma unroll
      for (int ks = 0; ks < 4; ++ks) {
        asm volatile("ds_read_b64_tr_b16 %0,%1 offset:%c2" : "=&v"(lo[ks]) : "v"(vb), "i"(d0 * 4096 + ks * 1024) : "memory");
        asm volatile("ds_read_b64_tr_b16 %0,%1 offset:%c2" : "=&v"(hh[ks]) : "v"(vb), "i"(d0 * 4096 + ks * 1024 + 512) : "memory"); }
      asm volatile("s_waitcnt lgkmcnt(0)" ::: "memory"); SBAR();
      #define PK(k) (bf16x8){lo[k][0], lo[k][1], lo[k][2], lo[k][3], hh[k][0], hh[k][1], hh[k][2], hh[k][3]}
      o[d0] = MFQ(PAF(pwB0), PK(0), o[d0]); o[d0] = MFQ(PAF(pwB1), PK(1), o[d0]); o[d0] = MFQ(PAF(pwB2), PK(2), o[d0]); o[d0] = MFQ(PAF(pwB3), PK(3), o[d0]);
      #undef PK
    } }
  { auto rr = __builtin_amdgcn_permlane32_swap(__float_as_uint(l_reg), __float_as_uint(l_reg), false, false); l_reg = __uint_as_float(rr[0]) + __uint_as_float(rr[1]); }
  if (hi == 0) wsf[32 + r32] = l_reg; asm volatile("s_waitcnt lgkmcnt(0)" ::: "memory");
  float rli[16];
  #pragma unroll
  for (int r = 0; r < 16; ++r) rli[r] = __builtin_amdgcn_rcpf(wsf[32 + crow(r, hi)]);
  int lane_e = lane; asm volatile("" : "+v"(lane_e));
  const int erow = lane_e >> 3, ech = lane_e & 7;
  bf16* Ow = O + (rowbase + q0 + wid * QBLK) * DMA + h * 128;
  bf16* stg = (bf16*)(shm + L_OST) + wid * 2048;
  if (mode == 0) {
    #pragma unroll
    for (int ps = 0; ps < 2; ++ps) {
      #pragma unroll
      for (int r = 0; r < 16; ++r) { const int orow = crow(r, hi);
        #pragma unroll
        for (int d0 = 0; d0 < 2; ++d0) stg[orow * 64 + d0 * 32 + r32] = f2bf(o[2 * ps + d0][r] * rli[r]); }
      asm volatile("s_waitcnt lgkmcnt(0)" ::: "memory");
      #pragma unroll
      for (int i = 0; i < 4; ++i) { const int row = i * 8 + erow, ch = ech; const u32x4 v = *(const u32x4*)(stg + row * 64 + ch * 8); *(u32x4*)(Ow + (long)row * DMA + ps * 64 + ch * 8) = v; }
      asm volatile("s_waitcnt lgkmcnt(0)" ::: "memory");
    }
    asm volatile("s_waitcnt vmcnt(0)" ::: "memory");
  } else {
    const bf16* Zw = SZ1 + (rowbase + q0 + wid * QBLK) * DMA + h * 128; bf16* Gw = OG + (rowbase + q0 + wid * QBLK) * DMA + h * 128;
    float dk[2][4][8]; float ss[4] = {0.f, 0.f, 0.f, 0.f};
    #pragma unroll
    for (int ps = 0; ps < 2; ++ps) {
      #pragma unroll
      for (int r = 0; r < 16; ++r) { const int orow = crow(r, hi);
        #pragma unroll
        for (int d0 = 0; d0 < 2; ++d0) stg[orow * 64 + d0 * 32 + r32] = f2bf(o[2 * ps + d0][r] * rli[r]); }
      asm volatile("s_waitcnt lgkmcnt(0)" ::: "memory");
      #pragma unroll
      for (int i = 0; i < 4; ++i) { const int row = i * 8 + erow, ch = ech;
        const u32x4 v1 = *(const u32x4*)(stg + row * 64 + ch * 8); const u32x4 v0 = *(const u32x4*)(Ow + (long)row * DMA + ps * 64 + ch * 8);
        #pragma unroll
        for (int j = 0; j < 4; ++j) { const float a0 = __uint_as_float(v0[j] << 16), a1 = __uint_as_float(v0[j] & 0xffff0000u), b0 = __uint_as_float(v1[j] << 16), b1 = __uint_as_float(v1[j] & 0xffff0000u);
          const float d0_ = a0 - lam * b0, d1_ = a1 - lam * b1; dk[ps][i][2 * j] = d0_; dk[ps][i][2 * j + 1] = d1_; ss[i] += d0_ * d0_ + d1_ * d1_; } }
      asm volatile("s_waitcnt lgkmcnt(0)" ::: "memory");
    }
    #pragma unroll
    for (int i = 0; i < 4; ++i) { float t_ = ss[i]; t_ += __shfl_xor(t_, 1); t_ += __shfl_xor(t_, 2); t_ += __shfl_xor(t_, 4); ss[i] = rsqrtf(t_ * (1.0f / 128.0f) + RMS_EPS) * ONE_M_LI; }
    #pragma unroll
    for (int ps = 0; ps < 2; ++ps) {
      const int ch = ech; const float* gp = g_sub + ps * 64 + ch * 8; const f32x4_t g0 = *(const f32x4_t*)gp, g1 = *(const f32x4_t*)(gp + 4);
      #pragma unroll
      for (int i = 0; i < 4; ++i) { const int row = i * 8 + erow;
        const u32x4 z = *(const u32x4*)(Zw + (long)row * DMA + ps * 64 + ch * 8); u32x4 w;
        #pragma unroll
        for (int j = 0; j < 4; ++j) { const float z0 = __uint_as_float(z[j] << 16), z1 = __uint_as_float(z[j] & 0xffff0000u);
          const float ga = (j < 2) ? g0[2 * j] : g1[2 * j - 4], gb = (j < 2) ? g0[2 * j + 1] : g1[2 * j - 3];
          w[j] = cvtpk_s(dk[ps][i][2 * j] * ss[i] * ga * z0, dk[ps][i][2 * j + 1] * ss[i] * gb * z1); }
        *(u32x4*)(Gw + (long)row * DMA + ps * 64 + ch * 8) = w; }
    }
  }
  asm volatile("s_waitcnt lgkmcnt(0)\n\ts_barrier" ::: "memory");
  #undef DMA_K
  #undef DMA_V
  #undef CMASK
  #undef RESC
  #undef ROT
  #undef PKW
  #undef PAF
  #undef VFR
  #undef PIN
  #undef MX3
  #undef EX
  #undef VRD
  #undef KRD
  #undef GAPB
  #undef MFQ
  #undef STEP
  #undef STEP_AB
  #undef STEP_BA
  #undef ENDW
}
#undef SBAR
#undef WAIT_BAR
}

constexpr int NWAVES = 8;
constexpr size_t MiB = 1u << 20;
constexpr size_t WS_CTL = 0, CTL_ZERO_BYTES = 1 * MiB;
constexpr size_t WS_MOD = 256 * 1024;
constexpr size_t WS_LAM = 1 * MiB;
constexpr size_t WS_LB16 = 1 * MiB + 4096;
constexpr size_t WS_WIN0 = 2 * MiB, WS_WGLU = 6 * MiB, WS_WOUT0 = 8 * MiB, WS_WKV = 10 * MiB, WS_WIN1 = 14 * MiB, WS_WOUT1 = 18 * MiB;
constexpr size_t WS_BTA = 20 * MiB;
constexpr size_t WS_BTB = 28 * MiB;
constexpr size_t WS_S0 = 48 * MiB, WS_S1 = 112 * MiB, WS_S2 = 176 * MiB, WS_S3 = 240 * MiB, WS_S4 = 304 * MiB, WS_S5 = 368 * MiB, WS_S6 = 432 * MiB, WS_END = 496 * MiB;
constexpr int CW_BAR = 4096;
constexpr int CW_TMO = 8, CW_SEAM = 16384, SEAM_BANK = 128 * 64;
constexpr size_t WS_XCH = 40 * MiB;
constexpr int RING_OFF = 0, RING_BYTES = 131072;
constexpr int LDSCTL_OFF = RING_BYTES, MISC_OFF = LDSCTL_OFF + 320;
constexpr int LDS_BYTES = 147456;

#define GAS __attribute__((address_space(1)))
#define LAS __attribute__((address_space(3)))
typedef unsigned v4u __attribute__((ext_vector_type(4)));
typedef GAS unsigned gu32;
#define RLX_AGENT __ATOMIC_RELAXED, __HIP_MEMORY_SCOPE_AGENT
#define LDS_WAIT() asm volatile("s_waitcnt lgkmcnt(0)" ::: "memory")
#define VM_WAIT() asm volatile("s_waitcnt vmcnt(0)" ::: "memory")

#define XB_TMO      128
#define XB_XCNT(j)  (256  + 64 * (j))
#define XB_XSUB(j)  (1280 + 64 * (j))
#define XB_XGEN(j)  (2304 + 64 * (j))
#define XB_TOP      3328
#define XB_TOPGEN   3392
#define XCD_BAR_WORDS 3456
#define XB_SPIN_CAP (1u << 18)
__device__ __forceinline__ unsigned xb_ld(unsigned* p)              { return __hip_atomic_load(p, __ATOMIC_RELAXED, __HIP_MEMORY_SCOPE_AGENT); }
__device__ __forceinline__ unsigned xb_add(unsigned* p, unsigned v) { return __hip_atomic_fetch_add(p, v, __ATOMIC_RELAXED, __HIP_MEMORY_SCOPE_AGENT); }
__device__ __forceinline__ unsigned xb_xcc_id() { return (unsigned)__builtin_amdgcn_s_getreg((3 << 11) | 20) & 0xFu; }
#define XB_SPIN(cond, bar) do { unsigned _sp = 0; while (cond) { __builtin_amdgcn_s_sleep(1); \
    if ((++_sp & 255u) == 0u) { if (xb_ld(&(bar)[XB_TMO])) break; if (_sp > XB_SPIN_CAP) { atomicAdd(&(bar)[XB_TMO], 1u); break; } } } } while (0)
struct XcdBarrier { unsigned* bar; unsigned x; volatile LAS unsigned* st; };
__device__ __forceinline__ XcdBarrier xcd_barrier_post(unsigned* bar, volatile LAS unsigned* st, int tid) {
    XcdBarrier b; b.bar = bar; b.x = xb_xcc_id(); b.st = st;
    if (tid == 0) (void)xb_add(&bar[XB_XCNT(b.x)], 1u);
    return b;
}
__device__ __forceinline__ void xcd_barrier_complete(unsigned* bar, unsigned x, unsigned& nloc, unsigned& nx) {
    const unsigned G = gridDim.x * gridDim.y * gridDim.z;
    unsigned sum, cnt, mine, sp = 0u;
    for (;;) {
        sum = 0u; cnt = 0u; mine = 0u;
#pragma unroll
        for (unsigned j = 0; j < 16; ++j) { const unsigned c = xb_ld(&bar[XB_XCNT(j)]); sum += c; cnt += (c > 0u) ? 1u : 0u; mine = (j == x) ? c : mine; }
        if (sum == G) break;
        __builtin_amdgcn_s_sleep(1);
        if ((++sp & 255u) == 0u) { if (xb_ld(&bar[XB_TMO])) break; if (sp > XB_SPIN_CAP) { atomicAdd(&bar[XB_TMO], 1u); break; } }
    }
    nloc = mine > 0u ? mine : 1u; nx = cnt > 0u ? cnt : 1u;
}
__device__ __forceinline__ void xcd_barrier(const XcdBarrier& b, int tid) {
    asm volatile("s_waitcnt vmcnt(0)" ::: "memory");
    __syncthreads();
    if (tid == 0) {
        unsigned* bar = b.bar;
        __builtin_amdgcn_s_waitcnt(0);
        unsigned nloc = b.st[0], nx = b.st[1];
        if (nloc == 0u) { xcd_barrier_complete(bar, b.x, nloc, nx); b.st[0] = nloc; b.st[1] = nx; }
        const unsigned old = xb_add(&bar[XB_XSUB(b.x)], 1u);
        const unsigned gen = old / nloc;
        if (old + 1u == (gen + 1u) * nloc) {
            __builtin_amdgcn_fence(__ATOMIC_RELEASE, "agent");
            asm volatile("s_waitcnt vmcnt(0)" ::: "memory");
            const unsigned og = xb_add(&bar[XB_TOP], 1u);
            const unsigned tg = og / nx;
            if (og + 1u == (tg + 1u) * nx) xb_add(&bar[XB_TOPGEN], 1u);
            else XB_SPIN(xb_ld(&bar[XB_TOPGEN]) == tg, bar);
            __builtin_amdgcn_fence(__ATOMIC_ACQUIRE, "agent");
            xb_add(&bar[XB_XGEN(b.x)], 1u);
            asm volatile("s_waitcnt vmcnt(0)" ::: "memory");
        } else {
            XB_SPIN(xb_ld(&bar[XB_XGEN(b.x)]) == gen, bar);
            __builtin_amdgcn_fence(__ATOMIC_ACQUIRE, "agent");
            asm volatile("s_waitcnt vmcnt(0)" ::: "memory");
        }
    }
    __syncthreads();
}

__device__ __forceinline__ void p0_transpose_item(const float* W, int K, int N, bf16_t* WT, int row_off, const float* kscale, LAS float* scr, int item, int lane) {
    const int nblk = N / 32, kb = item / nblk, nb = item % nblk, k0 = 64 * kb, n0 = 32 * nb;
    float tv[32];
#pragma unroll
    for (int i = 0; i < 32; ++i) tv[i] = W[(size_t)(k0 + 2 * i + (lane >> 5)) * N + n0 + (lane & 31)];
#pragma unroll
    for (int i = 0; i < 32; ++i) { const int kk = 2 * i + (lane >> 5); float v = tv[i]; if (kscale) v *= kscale[k0 + kk]; scr[kk * 33 + (lane & 31)] = v; }
    LDS_WAIT(); asm volatile("" ::: "memory");
    const int c = lane & 7;
#pragma unroll
    for (int j = 0; j < 4; ++j) { const int n = (lane >> 3) + 8 * j; const LAS float* s = scr + (8 * c) * 33 + n;
        v4u o; o.x = pk2bf(s[0 * 33], s[1 * 33]); o.y = pk2bf(s[2 * 33], s[3 * 33]); o.z = pk2bf(s[4 * 33], s[5 * 33]); o.w = pk2bf(s[6 * 33], s[7 * 33]);
        *(GAS v4u*)(WT + (size_t)(row_off + n0 + n) * K + k0 + 8 * c) = o; }
    LDS_WAIT(); asm volatile("" ::: "memory");
}

__device__ __forceinline__ int lane_now_asm() { int r; asm volatile("v_mbcnt_lo_u32_b32 %0, -1, 0\n\tv_mbcnt_hi_u32_b32 %0, -1, %0" : "=v"(r)); return r; }
struct Args {
    const float* in[28]; float* out; unsigned char* ws;
    int ph_lo, ph_hi, use_bar, flags;
};

__global__ void __launch_bounds__(NWAVES * 64, 2) mega_fwd(Args args) {
    extern __shared__ __attribute__((aligned(16))) unsigned char lds_raw[];
    LAS unsigned char* lds = (LAS unsigned char*)lds_raw;
    volatile LAS unsigned* MISC = (volatile LAS unsigned*)(lds + MISC_OFF);
    const int wave = __builtin_amdgcn_readfirstlane((int)threadIdx.x >> 6);
#define LANE_NOW() lane_now_asm()
#define TID_NOW() (wave * 64 + LANE_NOW())
    const int G = gridDim.x; const int bx = blockIdx.x; const int vcu = (G % 8 == 0) ? (bx % 8) * (G / 8) + bx / 8 : bx;
    unsigned char* ws = args.ws;
    gu32* ctl = (gu32*)(ws + WS_CTL);
    const float* x = args.in[0]; const float* cvec = args.in[1]; const float* ada_w = args.in[2]; const float* ada_b = args.in[3];
    const float* g_pre = args.in[4]; const float* g_post = args.in[5];
    float* out = args.out;
    float* mod = (float*)(ws + WS_MOD); float* lamp = (float*)(ws + WS_LAM); float* lb16 = (float*)(ws + WS_LB16);
    bf16_t* Win0 = (bf16_t*)(ws + WS_WIN0); bf16_t* Wglu = (bf16_t*)(ws + WS_WGLU); bf16_t* Wout0 = (bf16_t*)(ws + WS_WOUT0); bf16_t* Wkv = (bf16_t*)(ws + WS_WKV);
    bf16_t* Win1 = (bf16_t*)(ws + WS_WIN1); bf16_t* Wout1 = (bf16_t*)(ws + WS_WOUT1); bf16_t* BtA = (bf16_t*)(ws + WS_BTA); bf16_t* BtB = (bf16_t*)(ws + WS_BTB);
    bf16_t* A0 = (bf16_t*)(ws + WS_S0); bf16_t* US = (bf16_t*)(ws + WS_S1); bf16_t* SZ = (bf16_t*)(ws + WS_S3); bf16_t* YG = (bf16_t*)(ws + WS_S4); float* EB = (float*)(ws + WS_S0);
    bf16_t* Y2 = (bf16_t*)(ws + WS_S0); bf16_t* YO = (bf16_t*)(ws + WS_S1); bf16_t* AKV = (bf16_t*)(ws + WS_S0); bf16_t* AIN1 = (bf16_t*)(ws + WS_S2);
    bf16_t* KB = (bf16_t*)(ws + WS_S3); bf16_t* VB = (bf16_t*)(ws + WS_S4); bf16_t* QB = (bf16_t*)(ws + WS_S5); bf16_t* SZ1 = (bf16_t*)(ws + WS_S6);
    bf16_t* O0 = (bf16_t*)(ws + WS_S0); bf16_t* O1 = (bf16_t*)(ws + WS_S1); bf16_t* OG = (bf16_t*)(ws + WS_S2); bf16_t* YO1 = (bf16_t*)(ws + WS_S0);

    for (int u = TID_NOW(); u < (LDS_BYTES - LDSCTL_OFF) / 4; u += NWAVES * 64) ((LAS unsigned*)(lds + LDSCTL_OFF))[u] = 0u;
    __syncthreads();
    XcdBarrier bar; bar.bar = (unsigned*)(ctl + CW_BAR); bar.x = 0; bar.st = nullptr;
    if (args.use_bar) bar = xcd_barrier_post((unsigned*)(ctl + CW_BAR), MISC + 8, TID_NOW());
    const int lo = args.ph_lo, hi = args.ph_hi;
#define IN(k) (lo <= (k) && (k) < hi)
#define REPS(k) (1 + ((REPEAT_MASK >> (k)) & 1))
#define SEAM(k) do { if (IN(k) && IN((k) + 1) && args.use_bar) xcd_barrier(bar, TID_NOW()); } while (0)
    const int gw = vcu * NWAVES + wave, NGW = G * NWAVES;
#define LANE_L() ({ int l_ = LANE_NOW(); asm volatile("" : "+v"(l_)); l_; })

    if (IN(0)) for (int rep_ = 0; rep_ < REPS(0); ++rep_) {
        const int tid = TID_NOW(), lane = tid & 63;
        for (int it = vcu; it < NGRP * 4; it += G) {
            const int g = it >> 2, qt = it & 3;
            LAS float* LBP = (LAS float*)(lds + RING_OFF);
            LAS float* BBR = LBP + 17 * 128;
            LAS float* CC = BBR + 64 * 32;
            LAS float* KM = CC + 16 * 130 + 12;
            __syncthreads();
            if (tid < 64) {
                const int p = tid;
                const float dt = expf(args.in[9][g]);
                const float lr = args.in[7][g * 64 + p], li = args.in[8][g * 64 + p];
                const float mag = expf(lr * dt); const float sn = sinf(li * dt), cs = cosf(li * dt);
                const float lbr = mag * cs, lbi = mag * sn;
                float pr = 1.f, pi = 0.f;
                for (int d = 0; d <= 16; ++d) { LBP[(d * 64 + p) * 2] = pr; LBP[(d * 64 + p) * 2 + 1] = pi; const float nr = pr * lbr - pi * lbi, ni = pr * lbi + pi * lbr; pr = nr; pi = ni; }
                if (qt == 0) { lb16[(g * 64 + p) * 2] = LBP[(16 * 64 + p) * 2]; lb16[(g * 64 + p) * 2 + 1] = LBP[(16 * 64 + p) * 2 + 1]; }
                const float nr = lbr - 1.0f, ni = lbi, den = lr * lr + li * li;
                const float cr = (nr * lr + ni * li) / den, ci = (ni * lr - nr * li) / den;
                for (int c = 0; c < 16; ++c) { const float br = args.in[10][(g * 64 + p) * 16 + c], bi = args.in[11][(g * 64 + p) * 16 + c];
                    BBR[(p * 16 + c) * 2] = cr * br - ci * bi; BBR[(p * 16 + c) * 2 + 1] = cr * bi + ci * br; }
            }
            for (int e = tid; e < 1024; e += 512) { const int co = e >> 6, p = e & 63; CC[(co * 65 + p) * 2] = args.in[12][(g * 16 + co) * 64 + p]; CC[(co * 65 + p) * 2 + 1] = args.in[13][(g * 16 + co) * 64 + p]; }
            __syncthreads();
            {
                const int pair = tid >> 1, hh = tid & 1, d = pair >> 4, co = pair & 15; float acc8[8];
#pragma unroll
                for (int j = 0; j < 8; ++j) acc8[j] = 0.f;
                for (int p = 0; p < 64; ++p) { const float cr = CC[(co * 65 + p) * 2], cim = CC[(co * 65 + p) * 2 + 1], lr = LBP[(d * 64 + p) * 2], lim = LBP[(d * 64 + p) * 2 + 1];
                    const float wr_ = cr * lr - cim * lim, wi_ = cr * lim + cim * lr; const LAS f32x4_t* bp = (const LAS f32x4_t*)(BBR + (p * 16 + 8 * hh) * 2);
#pragma unroll
                    for (int q4 = 0; q4 < 4; ++q4) { const f32x4_t bb = bp[q4]; acc8[2 * q4] += wr_ * bb.x - wi_ * bb.y; acc8[2 * q4 + 1] += wr_ * bb.z - wi_ * bb.w; } }
#pragma unroll
                for (int j = 0; j < 8; ++j) KM[(d * 16 + co) * 16 + 8 * hh + j] = acc8[j];
            }
            __syncthreads();
            for (int e = tid; e < 64 * 48; e += 512) {
                const int n = 64 * qt + e / 48, pc = e % 48, s = n >> 4, co = n & 15; float v[8];
                if (pc < 32) { const int s2 = pc >> 1, ci0 = (pc & 1) * 8;
#pragma unroll
                    for (int j = 0; j < 8; ++j) v[j] = (s2 <= s) ? KM[((s - s2) * 16 + co) * 16 + ci0 + j] : 0.f;
                } else { const int j0 = (pc - 32) * 8;
#pragma unroll
                    for (int jj = 0; jj < 4; ++jj) { const int p = (j0 >> 1) + jj; const float cr = CC[(co * 65 + p) * 2], cim = CC[(co * 65 + p) * 2 + 1], lr = LBP[((s + 1) * 64 + p) * 2], lim = LBP[((s + 1) * 64 + p) * 2 + 1];
                        v[2 * jj] = cr * lr - cim * lim; v[2 * jj + 1] = -(cr * lim + cim * lr); } }
                v4u o; o.x = pk2bf(v[0], v[1]); o.y = pk2bf(v[2], v[3]); o.z = pk2bf(v[4], v[5]); o.w = pk2bf(v[6], v[7]);
                *(GAS v4u*)(BtB + ((size_t)g * 256 + n) * 384 + pc * 8) = o; }
            for (int e = tid; e < 64 * 32; e += 512) {
                const int n = 64 * qt + (e >> 5), pc = e & 31; float v[8];
                if (n < 128) { const int p = n >> 1, ri = n & 1, s2 = pc >> 1, ci0 = (pc & 1) * 8; const float lr = LBP[((15 - s2) * 64 + p) * 2], lim = LBP[((15 - s2) * 64 + p) * 2 + 1];
#pragma unroll
                    for (int j = 0; j < 8; ++j) { const float br = BBR[(p * 16 + ci0 + j) * 2], bi = BBR[(p * 16 + ci0 + j) * 2 + 1]; v[j] = ri ? (lr * bi + lim * br) : (lr * br - lim * bi); }
                } else {
#pragma unroll
                    for (int j = 0; j < 8; ++j) v[j] = 0.f; }
                v4u o; o.x = pk2bf(v[0], v[1]); o.y = pk2bf(v[2], v[3]); o.z = pk2bf(v[4], v[5]); o.w = pk2bf(v[6], v[7]);
                *(GAS v4u*)(BtA + ((size_t)g * 256 + n) * 256 + pc * 8) = o; }
        }
        __syncthreads();
        {
            LAS float* scr = (LAS float*)(lds + RING_OFF + wave * 16384);
            constexpr int I_2K = (DM / 64) * (2048 / 32), I_1K = (DM / 64) * (1024 / 32);
            constexpr int NITEMS = 2 * I_2K + 5 * I_1K;
            for (int it = gw; it < NITEMS; it += NGW) {
                int r = it;
                if (r < I_2K) { p0_transpose_item(args.in[6], DM, 2048, Win0, 0, nullptr, scr, r, lane); continue; } r -= I_2K;
                if (r < I_2K) { p0_transpose_item(args.in[21], DM, 2048, Win1, 0, nullptr, scr, r, lane); continue; } r -= I_2K;
                if (r < I_1K) { p0_transpose_item(args.in[15], DM, 1024, Wglu, 0, nullptr, scr, r, lane); continue; } r -= I_1K;
                if (r < I_1K) { p0_transpose_item(args.in[17], DM, 1024, Wout0, 0, nullptr, scr, r, lane); continue; } r -= I_1K;
                if (r < I_1K) { p0_transpose_item(args.in[19], DM, 1024, Wkv, 0, args.in[18], scr, r, lane); continue; } r -= I_1K;
                if (r < I_1K) { p0_transpose_item(args.in[20], DM, 1024, Wkv, 1024, args.in[18], scr, r, lane); continue; } r -= I_1K;
                p0_transpose_item(args.in[27], DM, 1024, Wout1, 0, nullptr, scr, r, lane);
            }
        }
        if (!(args.flags & 1)) {
            __syncthreads();
            LAS float* sc = (LAS float*)(lds + RING_OFF);
            LAS float* red = sc + 8192;
            bool have = false;
            for (int it = vcu; it < 2 * 96; it += G) {
                if (!have) { for (int e = tid; e < 8192; e += 512) sc[e] = silu_f(cvec[e]); have = true; __syncthreads(); }
                const int l = it / 96, cc = it % 96, j = cc * 32 + (lane & 31), kh = lane >> 5;
                float acc[8];
#pragma unroll
                for (int b = 0; b < 8; ++b) acc[b] = 0.f;
                const float* wp = ada_w + ((size_t)l * 1024 + wave * 128 + kh) * 3072 + j;
                for (int k0 = 0; k0 < 64; k0 += 32) {
                    float w[32];
#pragma unroll
                    for (int kk = 0; kk < 32; ++kk) w[kk] = wp[(size_t)(2 * (k0 + kk)) * 3072];
#pragma unroll
                    for (int kk = 0; kk < 32; ++kk) {
#pragma unroll
                        for (int b = 0; b < 8; ++b) acc[b] += w[kk] * sc[b * 1024 + wave * 128 + 2 * (k0 + kk) + kh];
                        if ((kk & 3) == 3) asm volatile("" ::: "memory"); }
                }
#pragma unroll
                for (int b = 0; b < 8; ++b) { acc[b] += __shfl_xor(acc[b], 32); if (lane < 32) red[(wave * 8 + b) * 32 + lane] = acc[b]; }
                __syncthreads();
                if (tid < 256) { const int b = tid >> 5, jl = tid & 31; float sum = ada_b[l * 3072 + cc * 32 + jl];
#pragma unroll
                  for (int w = 0; w < 8; ++w) sum += red[(w * 8 + b) * 32 + jl];
                  mod[((size_t)(l * 8 + b)) * 3072 + cc * 32 + jl] = sum; }
                __syncthreads();
            }
            if (bx == 0 && tid == 0) lamp[0] = diff_lambda(args.in[22], args.in[23], args.in[24], args.in[25]);
        }
    }
    SEAM(0);
    if (IN(1)) for (int rep_ = 0; rep_ < REPS(1); ++rep_) e_norm0(x, mod, g_pre, A0, gw, NGW, LANE_L());
    SEAM(1);
#ifdef EXTRA_BARS
    if (args.use_bar) for (int eb = 0; eb < EXTRA_BARS; ++eb) xcd_barrier(bar, TID_NOW());
#endif
    if (IN(2)) for (int rep_ = 0; rep_ < REPS(2); ++rep_) {
        pg8::Gemm g = pg8::gemm_std(A0, DM, Win0, DM, DM); pg8::Order S; S.init(MTOK / 256, 2048 / 256, 1, G, bx);
        pg8::EpiRow8<pg8::F_In0> E{{US, SZ}};
        pg8::gemm_phase<pg8::EpiRow8<pg8::F_In0>, ALIGN_E>(lds + RING_OFF, g, S, E, TID_NOW());
    }
    SEAM(2);
#if SSM_FUSED
    if (IN(3)) {
        pg8::Gemm gA = pg8::gemm_std(US, US_P, BtA, 256, 256); gA.a_gstep = (size_t)NTILE * US_P * 2; gA.b_gstep = (size_t)256 * 256 * 2;
        pg8::Gemm gB = pg8::gemm_std(US, US_P, BtB, 384, 384); gB.a_gstep = (size_t)NTILE * US_P * 2; gB.b_gstep = (size_t)256 * 384 * 2;
        pg8::EpiScan ES{lb16, US, LDSCTL_OFF + 2048};
        pg8::EpiRow8<pg8::F_SsmB> EB2{{US, args.in[14], YG}};
        for (int uu = 0; (long)uu * G + bx < NGRP * NB; ++uu) {
            pg8::Order S; S.init(NTILE / 256, 1, NGRP, G, bx); S.only = uu;
            pg8::gemm_phase<pg8::EpiScan, false>(lds + RING_OFF, gA, S, ES, TID_NOW());
            pg8::gemm_phase<pg8::EpiRow8<pg8::F_SsmB>, false>(lds + RING_OFF, gB, S, EB2, TID_NOW());
        }
    }
    SEAM(5);
#else
    if (IN(3)) for (int rep_ = 0; rep_ < REPS(3); ++rep_) {
        pg8::Gemm g = pg8::gemm_std(US, US_P, BtA, 256, 256); g.a_gstep = (size_t)NTILE * US_P * 2; g.b_gstep = (size_t)256 * 256 * 2;
        pg8::Order S; S.init(NTILE / 256, 1, NGRP, G, bx);
        pg8::EpiRow8<pg8::F_SsmA> E{{EB}};
        pg8::gemm_phase<pg8::EpiRow8<pg8::F_SsmA>, ALIGN_E>(lds + RING_OFF, g, S, E, TID_NOW());
    }
    SEAM(3);
    if (IN(4)) for (int rep_ = 0; rep_ < REPS(4); ++rep_) {
        for (int it = vcu + G * wave; it < NB * NGRP; it += G * NWAVES) {
            const int b = it / NGRP, g = it % NGRP, p = LANE_L();
            const float lr = lb16[(g * 64 + p) * 2], li = lb16[(g * 64 + p) * 2 + 1];
            float sr = 0.f, si = 0.f;
            const float* ep = EB + ((size_t)g * NTILE + b * 256) * 128 + 2 * p;
            bf16_t* sp = US + us_off(g, b * 256, 256 + 2 * p);
            for (int t0 = 0; t0 < 256; t0 += 16) {
                float er[16], ei[16];
#pragma unroll
                for (int j = 0; j < 16; ++j) { const float2 e = *(const float2*)(ep + (size_t)(t0 + j) * 128); er[j] = e.x; ei[j] = e.y; }
#pragma unroll
                for (int j = 0; j < 16; ++j) { *(unsigned*)(sp + (size_t)(t0 + j) * US_P) = pk2bf(sr, si);
                    const float nr = lr * sr - li * si + er[j], ni = lr * si + li * sr + ei[j]; sr = nr; si = ni; }
            }
        }
    }
    SEAM(4);
    if (IN(5)) for (int rep_ = 0; rep_ < REPS(5); ++rep_) {
        pg8::Gemm g = pg8::gemm_std(US, US_P, BtB, 384, 384); g.a_gstep = (size_t)NTILE * US_P * 2; g.b_gstep = (size_t)256 * 384 * 2;
        pg8::Order S; S.init(NTILE / 256, 1, NGRP, G, bx);
        pg8::EpiRow8<pg8::F_SsmB> E{{US, args.in[14], YG}};
        pg8::gemm_phase<pg8::EpiRow8<pg8::F_SsmB>, ALIGN_E>(lds + RING_OFF, g, S, E, TID_NOW());
    }
    SEAM(5);
#endif
    if (IN(6)) for (int rep_ = 0; rep_ < REPS(6); ++rep_) {
        pg8::Gemm g = pg8::gemm_std(YG, DM, Wglu, DM, DM);
        g.a_rs = 32u; g.a_c16 = (unsigned)((size_t)NTILE * YG_P * 2); g.a_kstep = (size_t)4 * NTILE * YG_P * 2; g.a_tstep = (size_t)256 * 32;
        pg8::Order S; S.init(MTOK / 256, 1024 / 256, 1, G, bx);
        pg8::EpiRow8<pg8::F_Glu> E{{YG, SZ, args.in[16], Y2}};
        pg8::gemm_phase<pg8::EpiRow8<pg8::F_Glu>, ALIGN_E>(lds + RING_OFF, g, S, E, TID_NOW());
    }
    SEAM(6);
#if FUSE_EPI
    if (IN(7)) {
        pg8::Gemm g = pg8::gemm_std(Y2, DM, Wout0, DM, DM);
        for (int half = 0; half < 2; ++half) {
            pg8::Order S; S.init(MTOK / 512, 1024 / 256, 1, G, bx); S.pm_off = half * (MTOK / 512);
            pg8::PanelRms st1{(unsigned*)(ws + WS_XCH), (unsigned*)(ctl + CW_SEAM), (unsigned*)(ctl + CW_TMO), RMS_EPS};
            pg8::PanelRms st2{(unsigned*)(ws + WS_XCH + 1 * MiB), (unsigned*)(ctl + CW_SEAM + SEAM_BANK), (unsigned*)(ctl + CW_TMO), RMS_EPS};
            pg8::EpiMid E{x, out, AKV, AIN1, mod, g_post, g_pre + 1024, st1, st2};
            pg8::gemm_phase<pg8::EpiMid, false>(lds + RING_OFF, g, S, E, TID_NOW());
        }
    }
#else
    if (IN(7)) {
        pg8::Gemm g = pg8::gemm_std(Y2, DM, Wout0, DM, DM); pg8::Order S; S.init(MTOK / 256, 1024 / 256, 1, G, bx);
        pg8::EpiRow8<pg8::F_Plain> E{{YO}};
        pg8::gemm_phase<pg8::EpiRow8<pg8::F_Plain>, ALIGN_E>(lds + RING_OFF, g, S, E, TID_NOW());
    }
    SEAM(7);
    if (IN(8)) e_mid(x, YO, mod, g_post, g_pre, H1_RECOMP ? (float*)nullptr : out, AKV, AIN1, gw, NGW, LANE_L());
#endif
    SEAM(8);
    if (IN(9)) for (int rep_ = 0; rep_ < REPS(9); ++rep_) {
        { pg8::Gemm g = pg8::gemm_std(AKV, DM, Wkv, DM, DM); pg8::Order S; S.init(MTOK / 256, 2048 / 256, 1, G, bx);
          pg8::EpiRow8<pg8::F_Split> E{{KB, VB, 1.0f, 0}};
          pg8::gemm_phase<pg8::EpiRow8<pg8::F_Split>, ALIGN_E>(lds + RING_OFF, g, S, E, TID_NOW()); }
        { pg8::Gemm g = pg8::gemm_std(AIN1, DM, Win1, DM, DM); pg8::Order S; S.init(MTOK / 256, 2048 / 256, 1, G, bx);
          pg8::EpiRow8<pg8::F_Split> E{{QB, SZ1, QC2, 1}};
          pg8::gemm_phase<pg8::EpiRow8<pg8::F_Split>, ALIGN_E>(lds + RING_OFF, g, S, E, TID_NOW()); }
    }
    SEAM(9);
    if (IN(10)) {
#if ATTN_V128
#if ATTN_FUSE_POST
        { const float lam = __int_as_float(__builtin_amdgcn_readfirstlane(__float_as_int(lamp[0])));
          for (int i = 0;; ++i) {
            const long L = (long)i * G + vcu; if (L >= 64 * 16) break;
            const int pr = (int)(L % 256), qi = (int)(L / 256);
            const int bh = pr >> 2, j = pr & 3;
            const int qb = (qi & 1) ? (8 * (qi >> 1) + 7 - j) : (8 * (qi >> 1) + j);
            const int h = bh & 7, b = bh >> 3;
#pragma unroll 1
            for (int cc = 0; cc < 2; ++cc) attn3::attn_unit<8>(TID_NOW(), b, 2 * h + cc, h, qb, QB, KB, VB, O0, (char*)lds_raw + RING_OFF, cc, SZ1, args.in[26], lam, OG);
          } }
#else
        for (int i = 0;; ++i) {
            const long L = (long)i * G + vcu; if (L >= 128 * 16) break;
            const int pr = (int)(L % 256), qi = (int)(L / 256);
            const int combo = pr >> 1, j = pr & 1;
            const int k4 = qi >> 1; const int qb = (qi & 1) ? (4 * k4 + 3 - j) : (4 * k4 + j);
            const int c = combo & 1, h = (combo >> 1) & 7, b = combo >> 4;
            attn3::attn_unit<8>(TID_NOW(), b, 2 * h + c, h, qb, QB, KB, VB, c ? O1 : O0, (char*)lds_raw + RING_OFF, 0, SZ1, args.in[26], 0.f, OG);
        }
#endif
#else
        for (int i = 0;; ++i) {
            const long L = (long)i * G + vcu; if (L >= 256 * 16) break;
            const int combo = (int)(L % 256), qi = (int)(L / 256);
            const int qb = (qi & 1) ? (qi >> 1) : (15 - (qi >> 1));
            const int vh = combo & 1, c = (combo >> 1) & 1, h = (combo >> 2) & 7, b = combo >> 5;
            attn_body::attn_unit<8>(TID_NOW(), b, 2 * h + c, 2 * h + vh, qb, QB, KB, VB, c ? O1 : O0, (char*)lds_raw + RING_OFF);
        }
#endif
    }
    SEAM(10);
#if !(ATTN_V128 && ATTN_FUSE_POST)
    if (IN(11)) for (int rep_ = 0; rep_ < REPS(11); ++rep_) e_attn_post(O0, O1, SZ1, args.in[26], lamp[0], OG, gw, NGW, LANE_L());
    SEAM(11);
#endif
#if FUSE_EPI
    if (IN(12)) {
        pg8::Gemm g = pg8::gemm_std(OG, DM, Wout1, DM, DM);
        for (int half = 0; half < 2; ++half) {
            pg8::Order S; S.init(MTOK / 512, 1024 / 256, 1, G, bx); S.pm_off = half * (MTOK / 512);
            pg8::PanelRms st{(unsigned*)(ws + WS_XCH + 2 * MiB), (unsigned*)(ctl + CW_SEAM + 2 * SEAM_BANK), (unsigned*)(ctl + CW_TMO), RMS_EPS};
            pg8::EpiFinal E{out, out, mod + 8 * 3072, g_post + 1024, st};
            pg8::gemm_phase<pg8::EpiFinal, false>(lds + RING_OFF, g, S, E, TID_NOW());
        }
    }
#else
    if (IN(12)) {
        pg8::Gemm g = pg8::gemm_std(OG, DM, Wout1, DM, DM); pg8::Order S; S.init(MTOK / 256, 1024 / 256, 1, G, bx);
        pg8::EpiRow8<pg8::F_Plain> E{{YO1}};
        pg8::gemm_phase<pg8::EpiRow8<pg8::F_Plain>, ALIGN_E>(lds + RING_OFF, g, S, E, TID_NOW());
    }
    SEAM(12);
    if (IN(13)) { if (H1_RECOMP) e_final2(x, YO, YO1, out, mod, g_post, gw, NGW, LANE_L()); else e_final(out, YO1, mod, g_post, gw, NGW, LANE_L()); }
#endif
#undef IN
#undef SEAM
}

#ifndef FASTMASK
#define FASTMASK 0x3fff
#endif
#ifndef ONE_LAUNCH
#define ONE_LAUNCH 1
#endif
constexpr int NPHASE = 14;

extern "C" void kernel_launch(void* const* d_in, const int* in_sizes, int n_in, void* d_out, int out_size, void* d_ws, size_t ws_size, hipStream_t stream) {
    static int grid = 0;
    if (grid == 0) {
        if (n_in != 28 || out_size != MTOK * DM || ws_size < WS_END) { fprintf(stderr, "kernel_launch: unexpected shapes (n_in %d out %d ws %zu)\n", n_in, out_size, ws_size); grid = -1; return; }
        int dev = 0, cus = 0, per_cu = 0;
        if (hipGetDevice(&dev) != hipSuccess || hipDeviceGetAttribute(&cus, hipDeviceAttributeMultiprocessorCount, dev) != hipSuccess) { grid = -1; return; }
        if (hipFuncSetAttribute((const void*)mega_fwd, hipFuncAttributeMaxDynamicSharedMemorySize, LDS_BYTES) != hipSuccess) { fprintf(stderr, "kernel_launch: hipFuncSetAttribute failed\n"); grid = -1; return; }
        if (hipOccupancyMaxActiveBlocksPerMultiprocessor(&per_cu, (const void*)mega_fwd, NWAVES * 64, LDS_BYTES) != hipSuccess || per_cu < 1) { fprintf(stderr, "kernel_launch: occupancy query says %d\n", per_cu); }
        (void)hipGetLastError();
        grid = cus;
    }
    if (grid < 0) return;
    if (hipMemsetAsync((char*)d_ws + WS_CTL, 0, CTL_ZERO_BYTES, stream) != hipSuccess) { fprintf(stderr, "kernel_launch: memset failed\n"); return; }
    Args a{};
    for (int i = 0; i < 28; ++i) a.in[i] = (const float*)d_in[i];
    a.out = (float*)d_out; a.ws = (unsigned char*)d_ws;
#if ONE_LAUNCH
    a.ph_lo = 0; a.ph_hi = NPHASE; a.use_bar = 1; a.flags = 0;
    hipLaunchKernelGGL(mega_fwd, dim3(grid), dim3(NWAVES * 64), LDS_BYTES, stream, a);
#else
    const float* x = a.in[0]; unsigned char* ws = a.ws; float* out = a.out;
    float* mod = (float*)(ws + WS_MOD); float* lam = (float*)(ws + WS_LAM);
    bf16_t* A0 = (bf16_t*)(ws + WS_S0); bf16_t* US = (bf16_t*)(ws + WS_S1); bf16_t* SZ = (bf16_t*)(ws + WS_S3); bf16_t* YG = (bf16_t*)(ws + WS_S4);
    bf16_t* Y2 = (bf16_t*)(ws + WS_S0); bf16_t* YO = (bf16_t*)(ws + WS_S1); bf16_t* AKV = (bf16_t*)(ws + WS_S0); bf16_t* AIN1 = (bf16_t*)(ws + WS_S2);
    bf16_t* KB = (bf16_t*)(ws + WS_S3); bf16_t* VB = (bf16_t*)(ws + WS_S4); bf16_t* QB = (bf16_t*)(ws + WS_S5); bf16_t* SZ1 = (bf16_t*)(ws + WS_S6);
    bf16_t* O0 = (bf16_t*)(ws + WS_S0); bf16_t* O1 = (bf16_t*)(ws + WS_S1); bf16_t* OG = (bf16_t*)(ws + WS_S2); bf16_t* YO1 = (bf16_t*)(ws + WS_S0);
    const int EG = 2048;
    auto fast1 = [&](int lo, int hi, int flags) { a.ph_lo = lo; a.ph_hi = hi; a.use_bar = 0; a.flags = flags; hipLaunchKernelGGL(mega_fwd, dim3(grid), dim3(NWAVES * 64), LDS_BYTES, stream, a); };
    auto fast = [&](int lo, int hi, int flags) { fast1(lo, hi, flags); if (lo == EXTRA_PHASE) fast1(lo, hi, flags); };
    const unsigned FM = FASTMASK;
    if (FM & 1u) fast(0, 1, 0);
    else { fast(0, 1, 1); n_adaln<<<(2 * 8 * 3072 + 255) / 256, 256, 0, stream>>>(a.in[1], a.in[2], a.in[3], mod); n_lambda<<<1, 64, 0, stream>>>(a.in[22], a.in[23], a.in[24], a.in[25], lam); }
    if (FM & 2u) fast(1, 2, 0); else n_norm0<<<EG, 256, 0, stream>>>(x, mod, a.in[4], A0);
    if (FM & 4u) fast(2, 3, 0); else n_gemm<<<dim3(2048 / 64, MTOK / 64), 256, 0, stream>>>(AL_Row{A0}, WL_Plain{a.in[6], 2048}, EP_In0{US, SZ}, 2048);
    if (FM & 8u) { fast(3, 4, 0); fast(4, 5, 0); fast(5, 6, 0); }
    else n_ssm<<<NB * NGRP / 4, 256, 0, stream>>>(US, a.in[7], a.in[8], a.in[9], a.in[10], a.in[11], a.in[12], a.in[13], a.in[14], YG);
    if (FM & 64u) fast(6, 7, 0); else n_gemm<<<dim3(1024 / 64, MTOK / 64), 256, 0, stream>>>(AL_YG{YG}, WL_Plain{a.in[15], 1024}, EP_Glu{YG, SZ, a.in[16], Y2}, 1024);
    if (FM & 128u) fast(7, 8, 0); else n_gemm<<<dim3(1024 / 64, MTOK / 64), 256, 0, stream>>>(AL_Row{Y2}, WL_Plain{a.in[17], 1024}, EP_Plain{YO}, 1024);
    if (FM & 256u) fast(8, 9, 0); else n_mid<<<EG, 256, 0, stream>>>(x, YO, mod, a.in[5], a.in[4], out, AKV, AIN1);
    if (FM & 512u) fast(9, 10, 0);
    else { n_gemm<<<dim3(2048 / 64, MTOK / 64), 256, 0, stream>>>(AL_Row{AKV}, WL_KV{a.in[19], a.in[20], a.in[18]}, EP_KV{KB, VB}, 2048);
           n_gemm<<<dim3(2048 / 64, MTOK / 64), 256, 0, stream>>>(AL_Row{AIN1}, WL_Plain{a.in[21], 2048}, EP_In1{QB, SZ1}, 2048); }
    if (FM & 1024u) fast(10, 11, 0); else n_attn<<<MTOK * 8 / 4, 256, 0, stream>>>(QB, KB, VB, O0, O1);
    if (FM & 2048u) fast(11, 12, 0); else n_attn_post<<<EG, 256, 0, stream>>>(O0, O1, SZ1, a.in[26], lam, OG);
    if (FM & 4096u) fast(12, 13, 0); else n_gemm<<<dim3(1024 / 64, MTOK / 64), 256, 0, stream>>>(AL_Row{OG}, WL_Plain{a.in[27], 1024}, EP_Plain{YO1}, 1024);
    if (FM & 8192u) fast(13, 14, 0); else n_final<<<EG, 256, 0, stream>>>(out, YO1, mod, a.in[5]);
#endif
    const hipError_t le = hipPeekAtLastError();
    if (le != hipSuccess) fprintf(stderr, "kernel_launch: launch failed: %s\n", hipGetErrorName(le));
}
```

```cpp
#include <hip/hip_runtime.h>
#include <cstdio>
#include <cstdint>
#include <cmath>
#define FASTMASK 0x3fff
#define ONE_LAUNCH 1
#define REPEAT_MASK 0

typedef unsigned short bf16_t;
constexpr int NB = 8, SEQL = 4096, DM = 1024, MTOK = NB * SEQL;
constexpr int NGRP = 64, NTILE = MTOK / 16;
constexpr int US_P = 384, YG_P = 256;
constexpr float LAMBDA_INIT = 0.35550907f;
constexpr float ONE_M_LI = 1.0f - LAMBDA_INIT;
constexpr float RMS_EPS = 1e-6f;
constexpr float QC2 = 0.125f * 1.4426950408889634f;

__device__ __forceinline__ float bf2f(bf16_t v) { return __uint_as_float((unsigned)v << 16); }
__device__ __forceinline__ unsigned f2bf_u(float f) { unsigned u = __float_as_uint(f); return (u + 0x7fffu + ((u >> 16) & 1u)) >> 16; }
__device__ __forceinline__ bf16_t f2bf(float f) { return (bf16_t)f2bf_u(f); }
__device__ __forceinline__ unsigned pk2bf(float lo, float hi) { return f2bf_u(lo) | (f2bf_u(hi) << 16); }
__device__ __forceinline__ float silu_f(float v) { return v / (1.0f + __expf(-v)); }
__device__ __forceinline__ float sigmoid_f(float v) { return 1.0f / (1.0f + __expf(-v)); }
__device__ __forceinline__ float gelu_tanh_f(float v) {
    const float u = 0.7978845608028654f * (v + 0.044715f * v * v * v);
    const float e = __expf(2.0f * u);
    const float t = 1.0f - 2.0f / (e + 1.0f);
    return 0.5f * v * (1.0f + t);
}
__device__ __forceinline__ float wave_sum_f(float v) {
#pragma unroll
    for (int o = 1; o < 64; o <<= 1) v += __shfl_xor(v, o);
    return v;
}
__device__ __forceinline__ float wave_max_f(float v) {
#pragma unroll
    for (int o = 1; o < 64; o <<= 1) v = fmaxf(v, __shfl_xor(v, o));
    return v;
}
__device__ __forceinline__ size_t us_off(int g, int tile, int col) { return ((size_t)g * NTILE + tile) * US_P + col; }
__device__ __forceinline__ size_t yg_off(int g, int tile, int col) { return ((size_t)g * NTILE + tile) * YG_P + col; }

typedef float f32x4_t __attribute__((ext_vector_type(4)));
typedef unsigned u32x4_t __attribute__((ext_vector_type(4)));
typedef unsigned u32x2_t __attribute__((ext_vector_type(2)));
#ifndef USE_NT
#define USE_NT 1
#endif
#if USE_NT
#define NT_LD(p) __builtin_nontemporal_load(p)
#define NT_ST(p, v) __builtin_nontemporal_store((v), (p))
#else
#define NT_LD(p) (*(p))
#define NT_ST(p, v) (*(p) = (v))
#endif

__device__ __forceinline__ void e_norm0(const float* __restrict__ x, const float* __restrict__ mod, const float* __restrict__ g_pre, bf16_t* a0, int gw, int ngw, int lane) {
    for (int m = gw; m < MTOK; m += ngw) {
        const int b = m / SEQL;
        const f32x4_t* xr = (const f32x4_t*)(x + (size_t)m * DM) + lane;
        f32x4_t v[4]; float s = 0.f;
#pragma unroll
        for (int j = 0; j < 4; ++j) { v[j] = NT_LD(xr + 64 * j); s += (v[j].x * v[j].x + v[j].y * v[j].y) + (v[j].z * v[j].z + v[j].w * v[j].w); }
        const float r = rsqrtf(wave_sum_f(s) * (1.0f / DM) + RMS_EPS);
        const float* sh = mod + (size_t)b * 3072; const float* sc = sh + 1024;
        u32x2_t* o = (u32x2_t*)(a0 + (size_t)m * DM) + lane;
#pragma unroll
        for (int j = 0; j < 4; ++j) {
            const int c = 256 * j + 4 * lane;
            const f32x4_t g = *(const f32x4_t*)(g_pre + c), scv = *(const f32x4_t*)(sc + c), shv = *(const f32x4_t*)(sh + c);
            f32x4_t y = v[j] * r * g * (scv + 1.0f) + shv;
            u32x2_t w; w.x = pk2bf(y.x, y.y); w.y = pk2bf(y.z, y.w); o[64 * j] = w;
        }
    }
}
__device__ __forceinline__ void e_mid(const float* __restrict__ x, const bf16_t* __restrict__ yo, const float* __restrict__ mod, const float* __restrict__ g_post, const float* __restrict__ g_pre,
                                      float* h1, bf16_t* akv, bf16_t* ain1, int gw, int ngw, int lane) {
    for (int m = gw; m < MTOK; m += ngw) {
        const int b = m / SEQL;
        const f32x4_t* xr = (const f32x4_t*)(x + (size_t)m * DM) + lane;
        const u32x2_t* yr = (const u32x2_t*)(yo + (size_t)m * DM) + lane;
        f32x4_t v[4], y[4]; float s = 0.f;
#pragma unroll
        for (int j = 0; j < 4; ++j) { v[j] = NT_LD(xr + 64 * j); const u32x2_t w = NT_LD(yr + 64 * j);
            y[j].x = __uint_as_float(w.x << 16); y[j].y = __uint_as_float(w.x & 0xffff0000u); y[j].z = __uint_as_float(w.y << 16); y[j].w = __uint_as_float(w.y & 0xffff0000u);
            s += (y[j].x * y[j].x + y[j].y * y[j].y) + (y[j].z * y[j].z + y[j].w * y[j].w); }
        const float ry = rsqrtf(wave_sum_f(s) * (1.0f / DM) + RMS_EPS);
        const float* gate0 = mod + (size_t)b * 3072 + 2048;
        const float* sh1 = mod + (size_t)(8 + b) * 3072; const float* sc1 = sh1 + 1024;
        float s2 = 0.f;
        f32x4_t* ho = (f32x4_t*)(h1 + (size_t)m * DM) + lane;
#pragma unroll
        for (int j = 0; j < 4; ++j) { const int c = 256 * j + 4 * lane;
            const f32x4_t gp = *(const f32x4_t*)(g_post + c), gt = *(const f32x4_t*)(gate0 + c);
            v[j] = v[j] + gt * (y[j] * ry * gp);
            if (h1) NT_ST(ho + 64 * j, v[j]);
            s2 += (v[j].x * v[j].x + v[j].y * v[j].y) + (v[j].z * v[j].z + v[j].w * v[j].w); }
        const float rh = rsqrtf(wave_sum_f(s2) * (1.0f / DM) + RMS_EPS);
        u32x2_t* o1 = (u32x2_t*)(akv + (size_t)m * DM) + lane; u32x2_t* o2 = (u32x2_t*)(ain1 + (size_t)m * DM) + lane;
#pragma unroll
        for (int j = 0; j < 4; ++j) { const int c = 256 * j + 4 * lane;
            const f32x4_t n = v[j] * rh;
            u32x2_t w; w.x = pk2bf(n.x, n.y); w.y = pk2bf(n.z, n.w); o1[64 * j] = w;
            const f32x4_t g = *(const f32x4_t*)(g_pre + 1024 + c), scv = *(const f32x4_t*)(sc1 + c), shv = *(const f32x4_t*)(sh1 + c);
            const f32x4_t z = n * g * (scv + 1.0f) + shv;
            w.x = pk2bf(z.x, z.y); w.y = pk2bf(z.z, z.w); o2[64 * j] = w; }
    }
}
__device__ __forceinline__ void e_attn_post(const bf16_t* __restrict__ o0, const bf16_t* __restrict__ o1, const bf16_t* __restrict__ sz1, const float* __restrict__ g_sub, float lam,
                                            bf16_t* og, int gw, int ngw, int lane) {
    for (int m = gw; m < MTOK; m += ngw) {
#pragma unroll
        for (int j = 0; j < 2; ++j) {
            const int c = 512 * j + 8 * lane;
            const u32x4_t a = *(const u32x4_t*)(o0 + (size_t)m * DM + c), bq = *(const u32x4_t*)(o1 + (size_t)m * DM + c), zq = *(const u32x4_t*)(sz1 + (size_t)m * DM + c);
            float d[8]; float s = 0.f;
#pragma unroll
            for (int i = 0; i < 4; ++i) { const unsigned wa = a[i], wb = bq[i];
                d[2 * i] = __uint_as_float(wa << 16) - lam * __uint_as_float(wb << 16); d[2 * i + 1] = __uint_as_float(wa & 0xffff0000u) - lam * __uint_as_float(wb & 0xffff0000u);
                s += d[2 * i] * d[2 * i] + d[2 * i + 1] * d[2 * i + 1]; }
            s += __shfl_xor(s, 1); s += __shfl_xor(s, 2); s += __shfl_xor(s, 4); s += __shfl_xor(s, 8);
            const float r = rsqrtf(s * (1.0f / 128.0f) + RMS_EPS) * ONE_M_LI;
            const float* gs = g_sub + (c & 127);
            u32x4_t w;
#pragma unroll
            for (int i = 0; i < 4; ++i) { const unsigned wz = zq[i];
                const float z0 = __uint_as_float(wz << 16), z1 = __uint_as_float(wz & 0xffff0000u);
                w[i] = pk2bf(d[2 * i] * r * gs[2 * i] * z0, d[2 * i + 1] * r * gs[2 * i + 1] * z1); }
            *(u32x4_t*)(og + (size_t)m * DM + c) = w;
        }
    }
}
__device__ __forceinline__ void e_final(float* out, const bf16_t* __restrict__ yo1, const float* __restrict__ mod, const float* __restrict__ g_post, int gw, int ngw, int lane) {
    for (int m = gw; m < MTOK; m += ngw) {
        const int b = m / SEQL;
        f32x4_t* hr = (f32x4_t*)(out + (size_t)m * DM) + lane;
        const u32x2_t* yr = (const u32x2_t*)(yo1 + (size_t)m * DM) + lane;
        f32x4_t v[4], y[4]; float s = 0.f;
#pragma unroll
        for (int j = 0; j < 4; ++j) { v[j] = NT_LD(hr + 64 * j); const u32x2_t w = NT_LD(yr + 64 * j);
            y[j].x = __uint_as_float(w.x << 16); y[j].y = __uint_as_float(w.x & 0xffff0000u); y[j].z = __uint_as_float(w.y << 16); y[j].w = __uint_as_float(w.y & 0xffff0000u);
            s += (y[j].x * y[j].x + y[j].y * y[j].y) + (y[j].z * y[j].z + y[j].w * y[j].w); }
        const float ry = rsqrtf(wave_sum_f(s) * (1.0f / DM) + RMS_EPS);
        const float* gate1 = mod + (size_t)(8 + b) * 3072 + 2048;
#pragma unroll
        for (int j = 0; j < 4; ++j) { const int c = 256 * j + 4 * lane;
            const f32x4_t gp = *(const f32x4_t*)(g_post + 1024 + c), gt = *(const f32x4_t*)(gate1 + c);
            NT_ST(hr + 64 * j, v[j] + gt * (y[j] * ry * gp)); }
    }
}
__device__ __forceinline__ void e_final2(const float* __restrict__ x, const bf16_t* __restrict__ yo, const bf16_t* __restrict__ yo1, float* out, const float* __restrict__ mod, const float* __restrict__ g_post, int gw, int ngw, int lane) {
    for (int m = gw; m < MTOK; m += ngw) {
        const int b = m / SEQL;
        const f32x4_t* xr = (const f32x4_t*)(x + (size_t)m * DM) + lane;
        const u32x2_t* y0r = (const u32x2_t*)(yo + (size_t)m * DM) + lane; const u32x2_t* y1r = (const u32x2_t*)(yo1 + (size_t)m * DM) + lane;
        f32x4_t v[4], y0[4], y1[4]; float s0 = 0.f, s1 = 0.f;
#pragma unroll
        for (int j = 0; j < 4; ++j) { v[j] = xr[64 * j]; const u32x2_t w0 = y0r[64 * j], w1 = y1r[64 * j];
            y0[j].x = __uint_as_float(w0.x << 16); y0[j].y = __uint_as_float(w0.x & 0xffff0000u); y0[j].z = __uint_as_float(w0.y << 16); y0[j].w = __uint_as_float(w0.y & 0xffff0000u);
            y1[j].x = __uint_as_float(w1.x << 16); y1[j].y = __uint_as_float(w1.x & 0xffff0000u); y1[j].z = __uint_as_float(w1.y << 16); y1[j].w = __uint_as_float(w1.y & 0xffff0000u);
            s0 += (y0[j].x * y0[j].x + y0[j].y * y0[j].y) + (y0[j].z * y0[j].z + y0[j].w * y0[j].w);
            s1 += (y1[j].x * y1[j].x + y1[j].y * y1[j].y) + (y1[j].z * y1[j].z + y1[j].w * y1[j].w); }
        const float r0 = rsqrtf(wave_sum_f(s0) * (1.0f / DM) + RMS_EPS), r1 = rsqrtf(wave_sum_f(s1) * (1.0f / DM) + RMS_EPS);
        const float* gate0 = mod + (size_t)b * 3072 + 2048; const float* gate1 = mod + (size_t)(8 + b) * 3072 + 2048;
        f32x4_t* orow = (f32x4_t*)(out + (size_t)m * DM) + lane;
#pragma unroll
        for (int j = 0; j < 4; ++j) { const int c = 256 * j + 4 * lane;
            const f32x4_t gp0 = *(const f32x4_t*)(g_post + c), gt0 = *(const f32x4_t*)(gate0 + c), gp1 = *(const f32x4_t*)(g_post + 1024 + c), gt1 = *(const f32x4_t*)(gate1 + c);
            const f32x4_t h = v[j] + gt0 * (y0[j] * r0 * gp0);
            orow[64 * j] = h + gt1 * (y1[j] * r1 * gp1); }
    }
}
__device__ __forceinline__ float diff_lambda(const float* lq1, const float* lk1, const float* lq2, const float* lk2) {
    float s1 = 0.f, s2 = 0.f;
    for (int i = 0; i < 64; ++i) { s1 += lq1[i] * lk1[i]; s2 += lq2[i] * lk2[i]; }
    return expf(s1) - expf(s2) + LAMBDA_INIT;
}

__global__ void n_adaln(const float* __restrict__ c, const float* __restrict__ ada_w, const float* __restrict__ ada_b, float* mod) {
    const int idx = blockIdx.x * 256 + threadIdx.x;
    if (idx >= 2 * 8 * 3072) return;
    const int j = idx % 3072, b = (idx / 3072) % 8, l = idx / (3072 * 8);
    float acc = ada_b[l * 3072 + j];
    const float* w = ada_w + (size_t)l * 1024 * 3072 + j; const float* cb = c + b * 1024;
    for (int k = 0; k < 1024; ++k) acc += silu_f(cb[k]) * w[(size_t)k * 3072];
    mod[idx] = acc;
}
__global__ void n_lambda(const float* lq1, const float* lk1, const float* lq2, const float* lk2, float* out) {
    if (threadIdx.x == 0 && blockIdx.x == 0) out[0] = diff_lambda(lq1, lk1, lq2, lk2);
}
__global__ void n_norm0(const float* x, const float* mod, const float* g_pre, bf16_t* a0) {
    e_norm0(x, mod, g_pre, a0, blockIdx.x * 4 + (threadIdx.x >> 6), gridDim.x * 4, threadIdx.x & 63);
}
__global__ void n_mid(const float* x, const bf16_t* yo, const float* mod, const float* g_post, const float* g_pre, float* h1, bf16_t* akv, bf16_t* ain1) {
    e_mid(x, yo, mod, g_post, g_pre, h1, akv, ain1, blockIdx.x * 4 + (threadIdx.x >> 6), gridDim.x * 4, threadIdx.x & 63);
}
__global__ void n_attn_post(const bf16_t* o0, const bf16_t* o1, const bf16_t* sz1, const float* g_sub, const float* lamp, bf16_t* og) {
    e_attn_post(o0, o1, sz1, g_sub, lamp[0], og, blockIdx.x * 4 + (threadIdx.x >> 6), gridDim.x * 4, threadIdx.x & 63);
}
__global__ void n_final(float* out, const bf16_t* yo1, const float* mod, const float* g_post) {
    e_final(out, yo1, mod, g_post, blockIdx.x * 4 + (threadIdx.x >> 6), gridDim.x * 4, threadIdx.x & 63);
}

struct AL_Row { const bf16_t* A; __device__ float ld(int m, int k) const { return bf2f(A[(size_t)m * DM + k]); } };
struct AL_YG  { const bf16_t* A; __device__ float ld(int m, int k) const { return bf2f(A[yg_off(k >> 4, m >> 4, (m & 15) * 16 + (k & 15))]); } };
struct WL_Plain { const float* W; long N; __device__ float ld(int k, int n) const { return W[(size_t)k * N + n]; } };
struct WL_KV { const float* wk; const float* wv; const float* g; __device__ float ld(int k, int n) const { return g[k] * (n < 1024 ? wk[(size_t)k * 1024 + n] : wv[(size_t)k * 1024 + n - 1024]); } };
struct EP_In0 { bf16_t* US; bf16_t* SZ; __device__ void st(int m, int n, float a) const {
    if (n < 1024) US[us_off(n >> 4, m >> 4, (m & 15) * 16 + (n & 15))] = f2bf(a); else SZ[(size_t)m * DM + n - 1024] = f2bf(silu_f(a)); } };
struct EP_Glu { const bf16_t* YG; const bf16_t* SZ; const float* bias; bf16_t* Y2; __device__ void st(int m, int n, float a) const {
    const float yv = bf2f(YG[yg_off(n >> 4, m >> 4, (m & 15) * 16 + (n & 15))]); const float t = a + bias[n];
    Y2[(size_t)m * DM + n] = f2bf(yv * sigmoid_f(t) * bf2f(SZ[(size_t)m * DM + n])); } };
struct EP_Plain { bf16_t* O; __device__ void st(int m, int n, float a) const { O[(size_t)m * DM + n] = f2bf(a); } };
struct EP_KV { bf16_t* K; bf16_t* V; __device__ void st(int m, int n, float a) const { if (n < 1024) K[(size_t)m * DM + n] = f2bf(a); else V[(size_t)m * DM + n - 1024] = f2bf(a); } };
struct EP_In1 { bf16_t* Q; bf16_t* SZ1; __device__ void st(int m, int n, float a) const { if (n < 1024) Q[(size_t)m * DM + n] = f2bf(a * QC2); else SZ1[(size_t)m * DM + n - 1024] = f2bf(silu_f(a)); } };

template <class AL, class WL, class EP>
__global__ void __launch_bounds__(256) n_gemm(AL al, WL wl, EP ep, int N) {
    __shared__ float As[16][68]; __shared__ float Ws[16][68];
    const int tid = threadIdx.x, tx = tid & 15, ty = tid >> 4;
    const int m0 = blockIdx.y * 64, n0 = blockIdx.x * 64;
    float acc[4][4];
#pragma unroll
    for (int i = 0; i < 4; ++i)
#pragma unroll
        for (int j = 0; j < 4; ++j) acc[i][j] = 0.f;
    for (int k0 = 0; k0 < 1024; k0 += 16) {
#pragma unroll
        for (int i = 0; i < 4; ++i) { const int e = tid + 256 * i; const int mm = e >> 4, kk = e & 15; As[kk][mm] = al.ld(m0 + mm, k0 + kk); }
#pragma unroll
        for (int i = 0; i < 4; ++i) { const int e = tid + 256 * i; const int kk = e >> 6, nn = e & 63; Ws[kk][nn] = wl.ld(k0 + kk, n0 + nn); }
        __syncthreads();
#pragma unroll
        for (int kk = 0; kk < 16; ++kk) {
            float a[4], b[4];
#pragma unroll
            for (int i = 0; i < 4; ++i) { a[i] = As[kk][ty * 4 + i]; b[i] = Ws[kk][tx * 4 + i]; }
#pragma unroll
            for (int i = 0; i < 4; ++i)
#pragma unroll
                for (int j = 0; j < 4; ++j) acc[i][j] += a[i] * b[j];
        }
        __syncthreads();
    }
#pragma unroll
    for (int i = 0; i < 4; ++i)
#pragma unroll
        for (int j = 0; j < 4; ++j) ep.st(m0 + ty * 4 + i, n0 + tx * 4 + j, acc[i][j]);
}

__global__ void __launch_bounds__(256) n_ssm(const bf16_t* __restrict__ US, const float* lam_re, const float* lam_im, const float* log_dt, const float* b_re, const float* b_im,
                                             const float* c_re, const float* c_im, const float* d_skip, bf16_t* YG) {
    const int wv = blockIdx.x * 4 + (threadIdx.x >> 6), lane = threadIdx.x & 63;
    if (wv >= NB * NGRP) return;
    const int b = wv / NGRP, g = wv % NGRP, p = lane;
    const float dt = expf(log_dt[g]);
    const float lr = lam_re[g * 64 + p], li = lam_im[g * 64 + p];
    const float mag = expf(lr * dt); float sn, cs; sn = sinf(li * dt); cs = cosf(li * dt);
    const float lbr = mag * cs, lbi = mag * sn;
    const float nr = lbr - 1.0f, ni = lbi, den = lr * lr + li * li;
    const float cr = (nr * lr + ni * li) / den, ci = (ni * lr - nr * li) / den;
    float bbr[16], bbi[16], ccr[16], cci[16];
#pragma unroll
    for (int c = 0; c < 16; ++c) { const float br = b_re[(g * 64 + p) * 16 + c], bi = b_im[(g * 64 + p) * 16 + c];
        bbr[c] = cr * br - ci * bi; bbi[c] = cr * bi + ci * br;
        ccr[c] = c_re[(g * 16 + c) * 64 + p]; cci[c] = c_im[(g * 16 + c) * 64 + p]; }
    const float dsk = d_skip[g * 16 + (lane & 15)];
    float sr = 0.f, si = 0.f;
    for (int t = 0; t < SEQL; ++t) {
        const int m = b * SEQL + t;
        const bf16_t* up = US + us_off(g, m >> 4, (m & 15) * 16);
        float u[16];
        { const u32x4_t w0 = *(const u32x4_t*)up, w1 = *(const u32x4_t*)(up + 8);
#pragma unroll
          for (int i = 0; i < 4; ++i) { u[2 * i] = __uint_as_float(w0[i] << 16); u[2 * i + 1] = __uint_as_float(w0[i] & 0xffff0000u); u[8 + 2 * i] = __uint_as_float(w1[i] << 16); u[8 + 2 * i + 1] = __uint_as_float(w1[i] & 0xffff0000u); } }
        float bur = 0.f, bui = 0.f;
#pragma unroll
        for (int c = 0; c < 16; ++c) { bur += bbr[c] * u[c]; bui += bbi[c] * u[c]; }
        const float nsr = lbr * sr - lbi * si + bur, nsi = lbr * si + lbi * sr + bui; sr = nsr; si = nsi;
        float yv = 0.f;
#pragma unroll
        for (int c = 0; c < 16; ++c) { const float part = wave_sum_f(ccr[c] * sr - cci[c] * si); if ((lane & 15) == c) yv = part; }
        if (lane < 16) { const float yy = yv + dsk * bf2f(up[lane]); YG[yg_off(g, m >> 4, (m & 15) * 16 + lane)] = f2bf(gelu_tanh_f(yy)); }
    }
}

__global__ void __launch_bounds__(256) n_attn(const bf16_t* __restrict__ Q, const bf16_t* __restrict__ K, const bf16_t* __restrict__ V, bf16_t* O0, bf16_t* O1) {
    __shared__ float qs[4][128];
    const int w = threadIdx.x >> 6, lane = threadIdx.x & 63;
    const int gwv = blockIdx.x * 4 + w;
    const int h = gwv & 7, m = gwv >> 3, b = m / SEQL, qi = m % SEQL;
    qs[w][lane] = bf2f(Q[(size_t)m * DM + h * 128 + lane]); qs[w][64 + lane] = bf2f(Q[(size_t)m * DM + h * 128 + 64 + lane]);
    __syncthreads();
    float m0 = -1e30f, m1 = -1e30f, l0 = 0.f, l1 = 0.f, a00 = 0.f, a01 = 0.f, a10 = 0.f, a11 = 0.f;
    const size_t rb = (size_t)b * SEQL;
    for (int kc = 0; kc * 64 <= qi; ++kc) {
        const int key = kc * 64 + lane; const bool valid = key <= qi;
        float s0 = 0.f, s1 = 0.f;
        { const bf16_t* kr = K + (rb + (valid ? key : qi)) * DM + h * 128;
#pragma unroll
          for (int ch = 0; ch < 8; ++ch) { const u32x4_t w0 = *(const u32x4_t*)(kr + ch * 8), w1 = *(const u32x4_t*)(kr + 64 + ch * 8);
#pragma unroll
            for (int i = 0; i < 4; ++i) { s0 += qs[w][ch * 8 + 2 * i] * __uint_as_float(w0[i] << 16) + qs[w][ch * 8 + 2 * i + 1] * __uint_as_float(w0[i] & 0xffff0000u);
                                          s1 += qs[w][64 + ch * 8 + 2 * i] * __uint_as_float(w1[i] << 16) + qs[w][64 + ch * 8 + 2 * i + 1] * __uint_as_float(w1[i] & 0xffff0000u); } } }
        if (!valid) { s0 = -1e30f; s1 = -1e30f; }
        const float nm0 = fmaxf(m0, wave_max_f(s0)), nm1 = fmaxf(m1, wave_max_f(s1));
        const float f0 = exp2f(m0 - nm0), f1 = exp2f(m1 - nm1);
        const float p0 = valid ? exp2f(s0 - nm0) : 0.f, p1 = valid ? exp2f(s1 - nm1) : 0.f;
        l0 = l0 * f0 + wave_sum_f(p0); l1 = l1 * f1 + wave_sum_f(p1); m0 = nm0; m1 = nm1;
        a00 *= f0; a01 *= f0; a10 *= f1; a11 *= f1;
        const int nk = min(64, qi - kc * 64 + 1);
        for (int j = 0; j < nk; ++j) {
            const float pj0 = __shfl(p0, j), pj1 = __shfl(p1, j);
            const bf16_t* vr = V + (rb + kc * 64 + j) * DM + h * 128;
            const float v0 = bf2f(vr[lane]), v1 = bf2f(vr[64 + lane]);
            a00 += pj0 * v0; a01 += pj0 * v1; a10 += pj1 * v0; a11 += pj1 * v1;
        }
    }
    const float i0 = 1.0f / l0, i1 = 1.0f / l1;
    O0[(size_t)m * DM + h * 128 + lane] = f2bf(a00 * i0); O0[(size_t)m * DM + h * 128 + 64 + lane] = f2bf(a01 * i0);
    O1[(size_t)m * DM + h * 128 + lane] = f2bf(a10 * i1); O1[(size_t)m * DM + h * 128 + 64 + lane] = f2bf(a11 * i1);
}
#ifndef REPEAT_MASK
#define REPEAT_MASK 0
#endif
#ifndef ATTN_V128
#define ATTN_V128 1
#endif
#ifndef EXTRA_PHASE
#define EXTRA_PHASE -1
#endif
#ifndef ATTN_FUSE_POST
#define ATTN_FUSE_POST 1
#endif
#ifndef H1_RECOMP
#define H1_RECOMP 0
#endif
#ifndef SSM_FUSED
#define SSM_FUSED 1
#endif
#ifndef FUSE_EPI
#define FUSE_EPI 0
#endif
#ifndef ALIGN_E
#define ALIGN_E true
#endif
namespace pg8 {
#define PG8_LAS __attribute__((address_space(3)))
typedef short bf16x8 __attribute__((ext_vector_type(8)));
typedef float f32x4 __attribute__((ext_vector_type(4)));
typedef unsigned u32x4 __attribute__((ext_vector_type(4)));
constexpr int BM = 256, BK = 64, HALF = 128, HTB = HALF * BK * 2  , STAGE_BYTES = 8 * HTB, NXCD = 8, WGM = 8;

__host__ __device__ __forceinline__ int lds_byte(int r, int c) { const int st = (r >> 4) * 2 + (c >> 5), rr = r & 15, cc = c & 31, ob = rr * 64 + cc * 2; return st * 1024 + (ob ^ (((ob >> 9) & 1) << 5)); }
__host__ __device__ __forceinline__ void stage_rc(int b, int& R, int& C) { const int st = b / 1024, sb = b % 1024, swz = sb ^ (((sb >> 9) & 1) << 5); R = (st >> 1) * 16 + swz / 64; C = (st & 1) * 32 + (swz % 64) / 2; }
__host__ __device__ __forceinline__ int perm32(int rho) { const int n = rho >> 4, i = rho & 15; return 8 * (i >> 2) + 4 * n + (i & 3); }

struct Unit { int pm, pn, grp; };
struct Gemm {
    const char* A; const char* Bt; int nt, pad0;
    unsigned a_rs, a_c16; size_t a_kstep, a_tstep, a_gstep;
    unsigned b_rs, pad1; size_t b_tstep, b_gstep;
    __device__ __forceinline__ const char* abase(const Unit& u) const { return A + (size_t)u.grp * a_gstep + (size_t)u.pm * a_tstep; }
    __device__ __forceinline__ const char* bbase(const Unit& u) const { return Bt + (size_t)u.grp * b_gstep + (size_t)u.pn * b_tstep; }
};
__device__ __forceinline__ Gemm gemm_std(const void* A, int lda, const void* Bt, int ldb, int K) {
    Gemm g; g.A = (const char*)A; g.Bt = (const char*)Bt; g.nt = K / BK; g.pad0 = 0; g.a_rs = (unsigned)lda * 2u; g.a_c16 = 32u; g.a_kstep = BK * 2; g.a_tstep = (size_t)BM * lda * 2; g.a_gstep = 0;
    g.b_rs = (unsigned)ldb * 2u; g.pad1 = 0; g.b_tstep = (size_t)BM * ldb * 2; g.b_gstep = 0; return g;
}

struct Order {
    int nM, nN, nG, nwg, G, c, only, pm_off;
    __device__ __forceinline__ void init(int nM_, int nN_, int nG_, int G_, int c_) { nM = nM_; nN = nN_; nG = nG_; nwg = nM * nN * nG; G = G_; c = c_; only = -1; pm_off = 0; }
    __device__ __forceinline__ bool next(int i, Unit& u) const {
        if (only >= 0) { if (i > 0) return false; i = only; }
        const long L = (long)i * G + c; if (L >= nwg) return false;
        int wgid = (int)L; { const int q = nwg / NXCD, r = nwg % NXCD, xcd = wgid % NXCD, off = wgid / NXCD; wgid = (xcd < r ? xcd * (q + 1) : r * (q + 1) + (xcd - r) * q) + off; }
        if (nG == 1) {
            const int nig = WGM * nN, gid = wgid / nig, fm = gid * WGM, gsz = (nM - fm) < WGM ? (nM - fm) : WGM;
            u.pm = pm_off + fm + ((wgid % nig) % gsz); u.pn = (wgid % nig) / gsz; u.grp = 0;
        } else { const int per = nM * nN; u.grp = wgid / per; const int r2 = wgid % per; u.pm = r2 % nM; u.pn = r2 / nM; }
        return true;
    }
};

__device__ __forceinline__ unsigned cvt_pk_bf16(float lo, float hi) { unsigned r; asm volatile("v_cvt_pk_bf16_f32 %0, %1, %2" : "=v"(r) : "v"(lo), "v"(hi)); return r; }
__device__ __forceinline__ u32x4 pack8(const f32x4 a, const f32x4 b) { u32x4 w; w.x = cvt_pk_bf16(a[0], a[1]); w.y = cvt_pk_bf16(a[2], a[3]); w.z = cvt_pk_bf16(b[0], b[1]); w.w = cvt_pk_bf16(b[2], b[3]); return w; }
__device__ __forceinline__ void unpack8(const u32x4 w, f32x4& a, f32x4& b) {
    a[0] = __uint_as_float(w.x << 16); a[1] = __uint_as_float(w.x & 0xffff0000u); a[2] = __uint_as_float(w.y << 16); a[3] = __uint_as_float(w.y & 0xffff0000u);
    b[0] = __uint_as_float(w.z << 16); b[1] = __uint_as_float(w.z & 0xffff0000u); b[2] = __uint_as_float(w.w << 16); b[3] = __uint_as_float(w.w & 0xffff0000u); }
__device__ __forceinline__ float fsilu(float v) { return v * __builtin_amdgcn_rcpf(1.0f + __expf(-v)); }
__device__ __forceinline__ float fsigm(float v) { return __builtin_amdgcn_rcpf(1.0f + __expf(-v)); }
__device__ __forceinline__ f32x4 silu4(f32x4 v) { f32x4 o; o[0] = fsilu(v[0]); o[1] = fsilu(v[1]); o[2] = fsilu(v[2]); o[3] = fsilu(v[3]); return o; }
__device__ __forceinline__ f32x4 sigm4(f32x4 v) { f32x4 o; o[0] = fsigm(v[0]); o[1] = fsigm(v[1]); o[2] = fsigm(v[2]); o[3] = fsigm(v[3]); return o; }
__device__ __forceinline__ float fgelu(float v) { const float u = 0.7978845608028654f * (v + 0.044715f * v * v * v); const float e = __expf(2.0f * u); return 0.5f * v * (2.0f - 2.0f * __builtin_amdgcn_rcpf(e + 1.0f)); }
__device__ __forceinline__ f32x4 gelu4(f32x4 v) { f32x4 o; o[0] = fgelu(v[0]); o[1] = fgelu(v[1]); o[2] = fgelu(v[2]); o[3] = fgelu(v[3]); return o; }

template <class F> struct EpiRow8 {
    static constexpr bool PERM = true, AFTER_DRAIN = false;
    F f;
    __device__ __forceinline__ void operator()(const f32x4 (&acc)[2][2][4][2], const Unit& u, int wr, int wc, int fr, int fq) const {
#pragma unroll
        for (int ai = 0; ai < 2; ++ai)
#pragma unroll
            for (int m = 0; m < 4; ++m) { const int row = u.pm * BM + ai * HALF + wr * 64 + m * 16 + fr;
#pragma unroll
                for (int bj = 0; bj < 2; ++bj) { const int col0 = u.pn * BM + bj * HALF + wc * 32 + 8 * fq; f.apply(u, row, col0, acc[ai][bj][m][0], acc[ai][bj][m][1]); } }
    }
};
struct F_In0 { bf16_t* US; bf16_t* SZ;
    __device__ __forceinline__ void apply(const Unit&, int row, int col0, f32x4 v0, f32x4 v1) const {
        if (col0 < 1024) *(u32x4*)(US + us_off(col0 >> 4, row >> 4, (row & 15) * 16 + (col0 & 15))) = pack8(v0, v1);
        else NT_ST((u32x4*)(SZ + (size_t)row * DM + (col0 - 1024)), pack8(silu4(v0), silu4(v1))); } };
struct F_SsmA { float* E;
    __device__ __forceinline__ void apply(const Unit& u, int row, int col0, f32x4 v0, f32x4 v1) const {
        if (col0 < 128) { float* p = E + ((size_t)u.grp * NTILE + row) * 128 + col0; *(f32x4*)p = v0; *(f32x4*)(p + 4) = v1; } } };
struct F_SsmB { const bf16_t* US; const float* dsk; bf16_t* YG;
    __device__ __forceinline__ void apply(const Unit& u, int row, int col0, f32x4 v0, f32x4 v1) const {
        const u32x4 uw = *(const u32x4*)(US + us_off(u.grp, row, col0)); f32x4 u0, u1; unpack8(uw, u0, u1);
        const float* d = dsk + u.grp * 16 + (col0 & 15); const f32x4 d0 = *(const f32x4*)d, d1 = *(const f32x4*)(d + 4);
        *(u32x4*)(YG + yg_off(u.grp, row, col0)) = pack8(gelu4(v0 + d0 * u0), gelu4(v1 + d1 * u1)); } };
struct F_Glu { const bf16_t* YG; const bf16_t* SZ; const float* bias; bf16_t* Y2;
    __device__ __forceinline__ void apply(const Unit&, int row, int col0, f32x4 v0, f32x4 v1) const {
        const u32x4 yw = *(const u32x4*)(YG + yg_off(col0 >> 4, row >> 4, (row & 15) * 16 + (col0 & 15))); f32x4 y0, y1; unpack8(yw, y0, y1);
        const u32x4 zw = NT_LD((const u32x4*)(SZ + (size_t)row * DM + col0)); f32x4 z0, z1; unpack8(zw, z0, z1);
        const f32x4 b0 = *(const f32x4*)(bias + col0), b1 = *(const f32x4*)(bias + col0 + 4);
        *(u32x4*)(Y2 + (size_t)row * DM + col0) = pack8(y0 * sigm4(v0 + b0) * z0, y1 * sigm4(v1 + b1) * z1); } };
template <class F> struct EpiRow8L {
    static constexpr bool PERM = true, AFTER_DRAIN = false;
    F f;
    __device__ __forceinline__ void operator()(const f32x4 (&acc)[2][2][4][2], const Unit& u, int wr, int wc, int fr, int fq) const {
#pragma unroll
        for (int ai = 0; ai < 2; ++ai) {
            typename F::Pre pre[4][2];
#pragma unroll
            for (int m = 0; m < 4; ++m) { const int row = u.pm * BM + ai * HALF + wr * 64 + m * 16 + fr;
#pragma unroll
                for (int bj = 0; bj < 2; ++bj) { const int col0 = u.pn * BM + bj * HALF + wc * 32 + 8 * fq; f.load(u, row, col0, pre[m][bj]); } }
#pragma unroll
            for (int m = 0; m < 4; ++m) { const int row = u.pm * BM + ai * HALF + wr * 64 + m * 16 + fr;
#pragma unroll
                for (int bj = 0; bj < 2; ++bj) { const int col0 = u.pn * BM + bj * HALF + wc * 32 + 8 * fq; f.apply(u, row, col0, acc[ai][bj][m][0], acc[ai][bj][m][1], pre[m][bj]); } }
        }
    }
};
struct F_SsmB2 { const bf16_t* US; const float* dsk; bf16_t* YG;
    struct Pre { u32x4 uw; };
    __device__ __forceinline__ void load(const Unit& u, int row, int col0, Pre& p) const { p.uw = *(const u32x4*)(US + us_off(u.grp, row, col0)); }
    __device__ __forceinline__ void apply(const Unit& u, int row, int col0, f32x4 v0, f32x4 v1, const Pre& p) const {
        f32x4 u0, u1; unpack8(p.uw, u0, u1);
        const float* d = dsk + u.grp * 16 + (col0 & 15); const f32x4 d0 = *(const f32x4*)d, d1 = *(const f32x4*)(d + 4);
        *(u32x4*)(YG + yg_off(u.grp, row, col0)) = pack8(gelu4(v0 + d0 * u0), gelu4(v1 + d1 * u1)); } };
struct F_Glu2 { const bf16_t* YG; const bf16_t* SZ; const float* bias; bf16_t* Y2;
    struct Pre { u32x4 yw, zw; };
    __device__ __forceinline__ void load(const Unit&, int row, int col0, Pre& p) const {
        p.yw = *(const u32x4*)(YG + yg_off(col0 >> 4, row >> 4, (row & 15) * 16 + (col0 & 15))); p.zw = *(const u32x4*)(SZ + (size_t)row * DM + col0); }
    __device__ __forceinline__ void apply(const Unit&, int row, int col0, f32x4 v0, f32x4 v1, const Pre& p) const {
        f32x4 y0, y1, z0, z1; unpack8(p.yw, y0, y1); unpack8(p.zw, z0, z1);
        const f32x4 b0 = *(const f32x4*)(bias + col0), b1 = *(const f32x4*)(bias + col0 + 4);
        *(u32x4*)(Y2 + (size_t)row * DM + col0) = pack8(y0 * sigm4(v0 + b0) * z0, y1 * sigm4(v1 + b1) * z1); } };
struct F_Plain { bf16_t* O;
    __device__ __forceinline__ void apply(const Unit&, int row, int col0, f32x4 v0, f32x4 v1) const { *(u32x4*)(O + (size_t)row * DM + col0) = pack8(v0, v1); } };
struct F_Split { bf16_t* Olo; bf16_t* Ohi; float sc_lo; int silu_hi;
    __device__ __forceinline__ void apply(const Unit&, int row, int col0, f32x4 v0, f32x4 v1) const {
        if (col0 < 1024) *(u32x4*)(Olo + (size_t)row * DM + col0) = pack8(v0 * sc_lo, v1 * sc_lo);
        else { if (silu_hi) { NT_ST((u32x4*)(Ohi + (size_t)row * DM + (col0 - 1024)), pack8(silu4(v0), silu4(v1))); } else *(u32x4*)(Ohi + (size_t)row * DM + (col0 - 1024)) = pack8(v0, v1); } } };


struct PanelRms {
    unsigned* xbuf;
    unsigned* cnt;
    unsigned* tmo;
    float eps;
    __device__ __forceinline__ bool run(const f32x4 (&v)[2][2][4][2], const Unit& u, int wr, int wc, int fr, int fq, PG8_LAS unsigned char* lds, int wid, int lane) const {
        PG8_LAS float* P = (PG8_LAS float*)lds;
        PG8_LAS float* S = (PG8_LAS float*)(lds + 8192);
        PG8_LAS unsigned* flag = (PG8_LAS unsigned*)(lds + 8192 + 2048);
#pragma unroll
        for (int ai = 0; ai < 2; ++ai)
#pragma unroll
            for (int m = 0; m < 4; ++m) {
                float q = 0.f;
#pragma unroll
                for (int bj = 0; bj < 2; ++bj)
#pragma unroll
                    for (int n = 0; n < 2; ++n) { const f32x4 d = v[ai][bj][m][n]; q += (d[0] * d[0] + d[1] * d[1]) + (d[2] * d[2] + d[3] * d[3]); }
                q += __shfl_xor(q, 16); q += __shfl_xor(q, 32);
                if (fq == 0) P[(ai * HALF + wr * 64 + m * 16 + fr) * 4 + wc] = q;
            }
        asm volatile("s_waitcnt lgkmcnt(0)" ::: "memory"); __builtin_amdgcn_s_barrier(); asm volatile("" ::: "memory");
        const int row = wid * 32 + (lane & 31);
        if (lane < 32) {
            const float tot = (P[row * 4 + 0] + P[row * 4 + 1]) + (P[row * 4 + 2] + P[row * 4 + 3]);
            unsigned long long* slot = (unsigned long long*)xbuf + ((size_t)(u.pm * BM + row) * 4 + u.pn);
            __hip_atomic_store(slot, (unsigned long long)__float_as_uint(tot), __ATOMIC_RELAXED, __HIP_MEMORY_SCOPE_AGENT);
        }
        asm volatile("s_waitcnt vmcnt(0)" ::: "memory");
        if (lane == 0) __hip_atomic_fetch_add(cnt + 64 * u.pm, 1u, __ATOMIC_RELAXED, __HIP_MEMORY_SCOPE_AGENT);
        if (wid == 0) {
            bool dead = false; const unsigned long long t0 = __builtin_amdgcn_s_memrealtime(); const unsigned want = 32u;
            for (;;) {
                if ((unsigned)__builtin_amdgcn_readfirstlane(__hip_atomic_load(cnt + 64 * u.pm, __ATOMIC_RELAXED, __HIP_MEMORY_SCOPE_AGENT)) >= want) break;
                if (__builtin_amdgcn_s_memrealtime() - t0 > 2000000ull) { if (lane == 0) __hip_atomic_store(tmo, 1u, __ATOMIC_RELAXED, __HIP_MEMORY_SCOPE_AGENT); dead = true; break; }
                __builtin_amdgcn_s_sleep(2);
            }
            __builtin_amdgcn_fence(__ATOMIC_ACQUIRE, "agent");
            if (lane == 0) flag[0] = dead ? 1u : 0u;
        }
        asm volatile("s_waitcnt vmcnt(0) lgkmcnt(0)" ::: "memory"); __builtin_amdgcn_s_barrier(); asm volatile("" ::: "memory");
        const bool bad = flag[0] != 0u;
        if (lane < 32) {
            const unsigned long long* slot = (const unsigned long long*)xbuf + (size_t)(u.pm * BM + row) * 4; float t4[4];
#pragma unroll
            for (int t = 0; t < 4; ++t) t4[t] = __uint_as_float((unsigned)__hip_atomic_load(slot + t, __ATOMIC_RELAXED, __HIP_MEMORY_SCOPE_AGENT));
            S[row] = rsqrtf(((t4[0] + t4[1]) + (t4[2] + t4[3])) * (1.0f / 1024.0f) + eps);
        }
        asm volatile("s_waitcnt lgkmcnt(0)" ::: "memory"); __builtin_amdgcn_s_barrier(); asm volatile("" ::: "memory");
        return bad;
    }
};
struct EpiFinal {
    static constexpr bool PERM = false, AFTER_DRAIN = true;
    const float* base; float* out; const float* mod1; const float* gpost1; PanelRms st;
    __device__ __forceinline__ void fused(f32x4 (&acc)[2][2][4][2], const Unit& u, int wr, int wc, int fr, int fq, PG8_LAS unsigned char* lds, int wid, int lane) const {
        const PG8_LAS float* S = (const PG8_LAS float*)(lds + 8192);
        const int col0 = u.pn * BM + wc * 32 + 4 * fq; const int b = u.pm >> 4;
        const float* gate = mod1 + (size_t)b * 3072 + 2048;
        const bool bad = st.run(acc, u, wr, wc, fr, fq, lds, wid, lane);
        const float qnan = __builtin_nanf("");
        f32x4 gg[2][2];
#pragma unroll
        for (int bj = 0; bj < 2; ++bj)
#pragma unroll
            for (int n = 0; n < 2; ++n) gg[bj][n] = *(const f32x4*)(gate + col0 + bj * HALF + n * 16) * *(const f32x4*)(gpost1 + col0 + bj * HALF + n * 16);
#pragma unroll
        for (int ai = 0; ai < 2; ++ai)
#pragma unroll
            for (int m = 0; m < 4; ++m) { const int r = ai * HALF + wr * 64 + m * 16 + fr; const float sr = S[r]; const size_t off = (size_t)(u.pm * BM + r) * DM + col0;
#pragma unroll
                for (int bj = 0; bj < 2; ++bj)
#pragma unroll
                    for (int n = 0; n < 2; ++n) { const f32x4 bs = *(const f32x4*)(base + off + bj * HALF + n * 16); f32x4 o = bs + gg[bj][n] * (acc[ai][bj][m][n] * sr);
                        if (bad) o = (f32x4){qnan, qnan, qnan, qnan}; *(f32x4*)(out + off + bj * HALF + n * 16) = o; }
                if (m & 1) asm volatile("" ::: "memory"); }
    }
};
struct EpiMid {
    static constexpr bool PERM = false, AFTER_DRAIN = true;
    const float* x; float* out; bf16_t* akv; bf16_t* ain1; const float* mod; const float* gpost0; const float* gpre1; PanelRms st1, st2;
    __device__ __forceinline__ void fused(f32x4 (&acc)[2][2][4][2], const Unit& u, int wr, int wc, int fr, int fq, PG8_LAS unsigned char* lds, int wid, int lane) const {
        typedef unsigned u32x2v __attribute__((ext_vector_type(2)));
        const PG8_LAS float* S = (const PG8_LAS float*)(lds + 8192);
        const int col0 = u.pn * BM + wc * 32 + 4 * fq; const int b = u.pm >> 4;
        const float* gate0 = mod + (size_t)b * 3072 + 2048; const float* sh1 = mod + (size_t)(8 + b) * 3072; const float* sc1 = sh1 + 1024;
        bool bad = st1.run(acc, u, wr, wc, fr, fq, lds, wid, lane);
        {
            f32x4 gg[2][2];
#pragma unroll
            for (int bj = 0; bj < 2; ++bj)
#pragma unroll
                for (int n = 0; n < 2; ++n) gg[bj][n] = *(const f32x4*)(gate0 + col0 + bj * HALF + n * 16) * *(const f32x4*)(gpost0 + col0 + bj * HALF + n * 16);
#pragma unroll
            for (int ai = 0; ai < 2; ++ai)
#pragma unroll
                for (int m = 0; m < 4; ++m) { const int r = ai * HALF + wr * 64 + m * 16 + fr; const float sr = S[r]; const size_t off = (size_t)(u.pm * BM + r) * DM + col0;
#pragma unroll
                    for (int bj = 0; bj < 2; ++bj)
#pragma unroll
                        for (int n = 0; n < 2; ++n) { const f32x4 bs = *(const f32x4*)(x + off + bj * HALF + n * 16); acc[ai][bj][m][n] = bs + gg[bj][n] * (acc[ai][bj][m][n] * sr); }
                    asm volatile("" : "+v"(acc[ai][0][m][0]), "+v"(acc[ai][0][m][1]), "+v"(acc[ai][1][m][0]), "+v"(acc[ai][1][m][1]));
                    if (m & 1) asm volatile("" ::: "memory"); }
        }
        bad = st2.run(acc, u, wr, wc, fr, fq, lds, wid, lane) || bad;
        const float qnan = __builtin_nanf("");
#pragma unroll
        for (int bj = 0; bj < 2; ++bj)
#pragma unroll
            for (int n = 0; n < 2; ++n) { const int c = col0 + bj * HALF + n * 16;
                const f32x4 gf = *(const f32x4*)(gpre1 + c) * (*(const f32x4*)(sc1 + c) + 1.0f), sh = *(const f32x4*)(sh1 + c);
#pragma unroll
                for (int ai = 0; ai < 2; ++ai)
#pragma unroll
                    for (int m = 0; m < 4; ++m) { const int r = ai * HALF + wr * 64 + m * 16 + fr; const float sr = S[r]; const size_t off = (size_t)(u.pm * BM + r) * DM + c;
                        f32x4 h = acc[ai][bj][m][n]; if (bad) h = (f32x4){qnan, qnan, qnan, qnan};
                        *(f32x4*)(out + off) = h;
                        const f32x4 nr = h * sr; u32x2v w; w.x = cvt_pk_bf16(nr[0], nr[1]); w.y = cvt_pk_bf16(nr[2], nr[3]); *(u32x2v*)(akv + off) = w;
                        const f32x4 z = nr * gf + sh; w.x = cvt_pk_bf16(z[0], z[1]); w.y = cvt_pk_bf16(z[2], z[3]); *(u32x2v*)(ain1 + off) = w; }
                asm volatile("" ::: "memory"); }
    }
};

struct EpiScan {
    static constexpr bool PERM = true, AFTER_DRAIN = true;
    const float* lb16; bf16_t* US; int carry_off;
    __device__ __forceinline__ void fused(f32x4 (&acc)[2][2][4][2], const Unit& u, int wr, int wc, int fr, int fq, PG8_LAS unsigned char* lds, int wid, int lane) const {
#pragma unroll
        for (int ai = 0; ai < 2; ++ai)
#pragma unroll
            for (int m = 0; m < 4; ++m) { const int row = ai * HALF + wr * 64 + m * 16 + fr; const int ch = (wc * 32 + 8 * fq) >> 2;
                *(PG8_LAS f32x4*)(lds + row * 512 + ((ch ^ (row & 7)) << 4)) = acc[ai][0][m][0];
                *(PG8_LAS f32x4*)(lds + row * 512 + (((ch + 1) ^ (row & 7)) << 4)) = acc[ai][0][m][1]; }
        asm volatile("s_waitcnt lgkmcnt(0)" ::: "memory"); __builtin_amdgcn_s_barrier(); asm volatile("" ::: "memory");
        const int p = lane, g = u.grp, b = u.pm;
        const float lr = lb16[(g * 64 + p) * 2], li = lb16[(g * 64 + p) * 2 + 1];
        typedef float f32x2v __attribute__((ext_vector_type(2)));
        const int coff = ((p >> 1) << 4) + (p & 1) * 8;
        float sr = 0.f, si = 0.f;
#pragma unroll 8
        for (int j = 0; j < 32; ++j) { const int t = wid * 32 + j; const f32x2v e = *(const PG8_LAS f32x2v*)(lds + t * 512 + (coff ^ ((t & 7) << 4)));
            const float nr = lr * sr - li * si + e.x, ni = lr * si + li * sr + e.y; sr = nr; si = ni; }
        PG8_LAS f32x2v* C = (PG8_LAS f32x2v*)(lds + carry_off);
        C[wid * 64 + p] = (f32x2v){sr, si};
        float pr = lr, pi = li;
#pragma unroll
        for (int q = 0; q < 5; ++q) { const float nr = pr * pr - pi * pi, ni = 2.f * pr * pi; pr = nr; pi = ni; }
        asm volatile("s_waitcnt lgkmcnt(0)" ::: "memory"); __builtin_amdgcn_s_barrier(); asm volatile("" ::: "memory");
        sr = 0.f; si = 0.f;
        for (int v = 0; v < wid; ++v) { const f32x2v c = C[v * 64 + p]; const float nr = pr * sr - pi * si + c.x, ni = pr * si + pi * sr + c.y; sr = nr; si = ni; }
        bf16_t* sp = US + us_off(g, b * 256 + wid * 32, 256 + 2 * p);
#pragma unroll 8
        for (int j = 0; j < 32; ++j) { const int t = wid * 32 + j; const f32x2v e = *(const PG8_LAS f32x2v*)(lds + t * 512 + (coff ^ ((t & 7) << 4)));
            *(unsigned*)(sp + (size_t)j * US_P) = cvt_pk_bf16(sr, si);
            const float nr = lr * sr - li * si + e.x, ni = lr * si + li * sr + e.y; sr = nr; si = ni; }
        asm volatile("s_waitcnt vmcnt(0)" ::: "memory");
    }
};
template <class Epi, bool ALIGN_EPI>
__device__ __forceinline__ void gemm_phase(PG8_LAS unsigned char* lds, const Gemm g, const Order& S, const Epi& E, int tid_in) {
    int tid_ = tid_in; asm volatile("" : "+v"(tid_));
    const int tid = tid_, wid = __builtin_amdgcn_readfirstlane(tid >> 6), lane = tid & 63, wr = wid >> 2, wc = wid & 3, fr = lane & 15, fq = lane >> 4;
    const int nt = g.nt;
    unsigned voffA[2], voffB[2];
#pragma unroll
    for (int i = 0; i < 2; ++i) { int R, C; stage_rc(tid * 16 + i * 8192, R, C); const int Rb = Epi::PERM ? ((R & ~31) + perm32(R & 31)) : R;
        voffA[i] = (unsigned)R * g.a_rs + (unsigned)(C >> 4) * g.a_c16 + (unsigned)(C & 15) * 2u; voffB[i] = (unsigned)Rb * g.b_rs + (unsigned)C * 2u; }
    const size_t kstepA = g.a_kstep, kstepB = (size_t)(BK * 2);
    const size_t hstepA = (size_t)HALF * g.a_rs, hstepB = (size_t)HALF * g.b_rs;
    const unsigned ldsw = (unsigned)wid * 1024u;
    const int aoff = lds_byte(wr * 64 + fr, fq * 8), boff = lds_byte(wc * 32 + fr, fq * 8);
#define PG8_SA(b, h) (((b) * 2 + (h)) * HTB)
#define PG8_SB(b, h) ((4 + (b) * 2 + (h)) * HTB)
#define PG8_STAGE(bufoff, gbase, voff) do { _Pragma("unroll") for (int _i = 0; _i < 2; ++_i) \
        __builtin_amdgcn_global_load_lds((const unsigned*)((const char*)(gbase) + (voff)[_i]), (PG8_LAS unsigned*)(lds + (bufoff) + ldsw + _i * 8192), 16, 0, 0); } while (0)
#define PG8_LDA(dst, b, h) do { _Pragma("unroll") for (int m = 0; m < 4; ++m) _Pragma("unroll") for (int k = 0; k < 2; ++k) dst[m][k] = *(const PG8_LAS bf16x8*)(lds + PG8_SA(b, h) + aoff + m * 2048 + k * 1024); } while (0)
#define PG8_LDB(dst, b, h) do { _Pragma("unroll") for (int n = 0; n < 2; ++n) _Pragma("unroll") for (int k = 0; k < 2; ++k) dst[n][k] = *(const PG8_LAS bf16x8*)(lds + PG8_SB(b, h) + boff + n * 2048 + k * 1024); } while (0)
#define PG8_MMA(ai, bj, At, Bt) do { __builtin_amdgcn_s_setprio(1); _Pragma("unroll") for (int m = 0; m < 4; ++m) _Pragma("unroll") for (int n = 0; n < 2; ++n) _Pragma("unroll") for (int k = 0; k < 2; ++k) \
        acc[ai][bj][m][n] = __builtin_amdgcn_mfma_f32_16x16x32_bf16(Bt[n][k], At[m][k], acc[ai][bj][m][n], 0, 0, 0); __builtin_amdgcn_s_setprio(0); } while (0)
#define PG8_WAIT_V(n) asm volatile("s_waitcnt vmcnt(" #n ")" ::: "memory")
#define PG8_WAIT_L(n) asm volatile("s_waitcnt lgkmcnt(" #n ")" ::: "memory")
#define PG8_BAR __builtin_amdgcn_s_barrier()
#define PG8_SCHED __builtin_amdgcn_sched_barrier(0)
    Unit cur, nxt; int ui = 0;
    if (!S.next(0, cur)) return;
    f32x4 acc[2][2][4][2];
#pragma unroll
    for (int a = 0; a < 2; ++a)
#pragma unroll
        for (int b = 0; b < 2; ++b)
#pragma unroll
            for (int m = 0; m < 4; ++m)
#pragma unroll
                for (int n = 0; n < 2; ++n) acc[a][b][m][n] = (f32x4){0.f, 0.f, 0.f, 0.f};
    bf16x8 At[4][2], B0[2][2], B1[2][2];
    const char* cA = g.abase(cur); const char* cB = g.bbase(cur);
    PG8_STAGE(PG8_SB(0, 0), cB, voffB); PG8_STAGE(PG8_SB(0, 1), cB + hstepB, voffB); PG8_STAGE(PG8_SA(0, 0), cA, voffA); PG8_STAGE(PG8_SA(0, 1), cA + hstepA, voffA);
    if (wr == 1) PG8_BAR;
    PG8_WAIT_V(2); PG8_BAR;
    PG8_STAGE(PG8_SB(1, 0), cB + kstepB, voffB); PG8_STAGE(PG8_SA(1, 0), cA + kstepA, voffA); PG8_STAGE(PG8_SB(1, 1), cB + hstepB + kstepB, voffB);
    PG8_WAIT_V(6); PG8_BAR;
    for (;;) {
        const bool has_next = S.next(ui + 1, nxt);
        const char* nA = has_next ? g.abase(nxt) : cA; const char* nB = has_next ? g.bbase(nxt) : cB;
        for (int t = 0; t < nt; t += 2) {
            const bool last = (t == nt - 2);
            const char* a1 = cA + (size_t)(t + 1) * kstepA;
            const char* a2 = last ? nA : cA + (size_t)(t + 2) * kstepA; const char* b2 = last ? nB : cB + (size_t)(t + 2) * kstepB;
            const char* a3 = a2 + kstepA; const char* b3 = b2 + kstepB;
            PG8_LDB(B0, 0, 0); PG8_LDB(B1, 0, 1); PG8_SCHED; PG8_LDA(At, 0, 0); PG8_STAGE(PG8_SA(1, 1), a1 + hstepA, voffA);
            PG8_WAIT_V(8); PG8_WAIT_L(0); PG8_BAR; PG8_MMA(0, 0, At, B0); PG8_MMA(0, 1, At, B1); PG8_BAR; PG8_SCHED;
            PG8_LDA(At, 0, 1); PG8_STAGE(PG8_SB(0, 0), b2, voffB); PG8_STAGE(PG8_SB(0, 1), b2 + hstepB, voffB); PG8_STAGE(PG8_SA(0, 0), a2, voffA);
            PG8_WAIT_V(8); PG8_WAIT_L(0); PG8_BAR; PG8_MMA(1, 0, At, B0); PG8_MMA(1, 1, At, B1); PG8_BAR; PG8_SCHED;
            PG8_LDB(B0, 1, 0); PG8_LDB(B1, 1, 1); PG8_SCHED; PG8_LDA(At, 1, 0); PG8_STAGE(PG8_SA(0, 1), a2 + hstepA, voffA);
            PG8_WAIT_V(8); PG8_WAIT_L(0); PG8_BAR; PG8_MMA(0, 0, At, B0); PG8_MMA(0, 1, At, B1); PG8_BAR; PG8_SCHED;
            PG8_LDA(At, 1, 1); PG8_STAGE(PG8_SB(1, 0), b3, voffB); PG8_STAGE(PG8_SB(1, 1), b3 + hstepB, voffB); PG8_STAGE(PG8_SA(1, 0), a3, voffA);
            PG8_WAIT_V(8); PG8_WAIT_L(0); PG8_BAR; PG8_MMA(1, 0, At, B0); PG8_MMA(1, 1, At, B1); PG8_BAR; PG8_SCHED;
        }
        if constexpr (ALIGN_EPI) { if (wr == 0) PG8_BAR; }
        if constexpr (!Epi::AFTER_DRAIN) { E(acc, cur, wr, wc, fr, fq); }
        if (!has_next) break;
#pragma unroll
        for (int a = 0; a < 2; ++a)
#pragma unroll
            for (int b = 0; b < 2; ++b)
#pragma unroll
                for (int m = 0; m < 4; ++m)
#pragma unroll
                    for (int n = 0; n < 2; ++n) acc[a][b][m][n] = (f32x4){0.f, 0.f, 0.f, 0.f};
        cur = nxt; cA = nA; cB = nB; ++ui;
        if constexpr (ALIGN_EPI) { if (wr == 1) PG8_BAR; }
    }
    PG8_WAIT_V(0);
    if constexpr (!ALIGN_EPI) { if (wr == 0) PG8_BAR; }
    PG8_BAR;
    if constexpr (Epi::AFTER_DRAIN) { E.fused(acc, cur, wr, wc, fr, fq, lds, wid, lane); PG8_WAIT_L(0); PG8_BAR; }
#undef PG8_SA
#undef PG8_SB
#undef PG8_STAGE
#undef PG8_LDA
#undef PG8_LDB
#undef PG8_MMA
#undef PG8_WAIT_V
#undef PG8_WAIT_L
#undef PG8_BAR
#undef PG8_SCHED
}
}

namespace attn_body {
using bf16 = bf16_t;
using bf16x8 = __attribute__((ext_vector_type(8))) short;
using s16x4 = __attribute__((ext_vector_type(4))) short;
using f32x16 = __attribute__((ext_vector_type(16))) float;
using u32x4 = __attribute__((ext_vector_type(4))) unsigned;
constexpr int SEQ = SEQL, D = 64, DMA = 1024;
constexpr int NW = 8, QBLK = 32, QB = QBLK * NW, KVBLK = 64, NQB = SEQ / QB;
__device__ __forceinline__ int crow(int r, int hi) { return (r & 3) + 8 * (r >> 2) + 4 * hi; }
#define SBAR() __builtin_amdgcn_sched_barrier(0)
__device__ __forceinline__ void cmask(f32x16& p0, f32x16& p1, int jb, int qrel, int hi) {
  const float NEG = -INFINITY; int kb = 64 * jb + 4 * hi;
  #pragma unroll
  for (int r = 0; r < 16; ++r) { int kv = kb + (r & 3) + 8 * (r >> 2); if (kv > qrel) p0[r] = NEG; if (kv + 32 > qrel) p1[r] = NEG; }
}
constexpr int NSLOT = 3, SLOTB = 8192;
constexpr int LDS_K = 0, LDS_V = NSLOT * SLOTB, LDS_WS = 2 * NSLOT * SLOTB, LDS_OST = LDS_WS + NW * 64 * 4, LDS_BYTES = LDS_OST + NW * 4096;
__device__ __forceinline__ void glds16(const void* gsrc, unsigned lds_dst) { unsigned keep;
  asm volatile("s_mov_b32 %0, m0\n\ts_mov_b32 m0, %2\n\ts_nop 0\n\tglobal_load_lds_dwordx4 %1, off\n\ts_mov_b32 m0, %0" : "=&s"(keep) : "v"(gsrc), "s"(lds_dst) : "memory"); }
__device__ __forceinline__ float max3f(float a, float b, float c) { float r; asm("v_max3_f32 %0, %1, %2, %3" : "=v"(r) : "v"(a), "v"(b), "v"(c)); return r; }
__device__ __forceinline__ float max2f(float a, float b) { float r; asm("v_max_f32_e32 %0, %1, %2" : "=v"(r) : "v"(a), "v"(b)); return r; }
__device__ __forceinline__ float fadd_s(float a, float b) { float r; asm("v_add_f32_e32 %0, %1, %2" : "=v"(r) : "v"(a), "v"(b)); return r; }
__device__ __forceinline__ float fsub_s(float a, float b) { float r; asm("v_sub_f32_e32 %0, %1, %2" : "=v"(r) : "v"(a), "v"(b)); return r; }
typedef float f32x2_t __attribute__((ext_vector_type(2))); typedef __bf16 bf16x2_t __attribute__((ext_vector_type(2)));
__device__ __forceinline__ unsigned cvtpk_s(float lo, float hi) { f32x2_t v = {lo, hi}; bf16x2_t b = __builtin_convertvector(v, bf16x2_t); return __builtin_bit_cast(unsigned, b); }
#define WAIT_BAR(N) asm volatile("s_waitcnt vmcnt(" #N ") lgkmcnt(0)\n\ts_barrier" ::: "memory")

__device__ __forceinline__ void qkt(f32x16& p0, f32x16& p1, const char* Kslot, const bf16x8* qr, const f32x16& negm, int r32, int hi) {
  const char* kb = Kslot + hi * 1024 + r32 * 16;
  #pragma unroll
  for (int d0 = 0; d0 < 4; ++d0) {
    const bf16x8 b0 = *reinterpret_cast<const bf16x8*>(kb + d0 * 2048);
    const bf16x8 b1 = *reinterpret_cast<const bf16x8*>(kb + d0 * 2048 + 512);
    if (d0 == 0) { p0 = __builtin_amdgcn_mfma_f32_32x32x16_bf16(b0, qr[0], negm, 0, 0, 0); p1 = __builtin_amdgcn_mfma_f32_32x32x16_bf16(b1, qr[0], negm, 0, 0, 0); }
    else { p0 = __builtin_amdgcn_mfma_f32_32x32x16_bf16(b0, qr[d0], p0, 0, 0, 0); p1 = __builtin_amdgcn_mfma_f32_32x32x16_bf16(b1, qr[d0], p1, 0, 0, 0); } }
}
typedef __attribute__((address_space(3))) const char* lds_cptr;
typedef short v4i16_t __attribute__((ext_vector_type(4)));
__device__ __forceinline__ void kload8(bf16x8* kf, lds_cptr kp) {
  kf[0] = *(const __attribute__((address_space(3))) bf16x8*)(kp);        kf[1] = *(const __attribute__((address_space(3))) bf16x8*)(kp + 512);
  kf[2] = *(const __attribute__((address_space(3))) bf16x8*)(kp + 2048); kf[3] = *(const __attribute__((address_space(3))) bf16x8*)(kp + 2560);
  kf[4] = *(const __attribute__((address_space(3))) bf16x8*)(kp + 4096); kf[5] = *(const __attribute__((address_space(3))) bf16x8*)(kp + 4608);
  kf[6] = *(const __attribute__((address_space(3))) bf16x8*)(kp + 6144); kf[7] = *(const __attribute__((address_space(3))) bf16x8*)(kp + 6656);
}
__device__ __forceinline__ void kload2(bf16x8* kf, lds_cptr kp, int j) { kf[2 * j] = *(const __attribute__((address_space(3))) bf16x8*)(kp + j * 2048); kf[2 * j + 1] = *(const __attribute__((address_space(3))) bf16x8*)(kp + j * 2048 + 512); }
__device__ __forceinline__ s16x4 vtr(lds_cptr p) { return __builtin_bit_cast(s16x4, __builtin_amdgcn_ds_read_tr16_b64_v4i16((__attribute__((address_space(3))) v4i16_t*)p)); }
__device__ __forceinline__ float rowmax(const f32x16& p0, const f32x16& p1) {
  float a = max3f(p0[0], p0[1], p1[0]), b = max3f(p0[2], p0[3], p1[1]); a = max3f(a, p1[2], p1[3]);
  #pragma unroll
  for (int r = 4; r < 16; r += 4) { a = max3f(a, p0[r], p0[r + 1]); b = max3f(b, p0[r + 2], p0[r + 3]); a = max3f(a, p1[r], p1[r + 1]); b = max3f(b, p1[r + 2], p1[r + 3]); }
  const float m = max2f(a, b);
  auto rr = __builtin_amdgcn_permlane32_swap(__float_as_uint(m), __float_as_uint(m), false, false);
  return max2f(__uint_as_float(rr[0]), __uint_as_float(rr[1]));
}
__device__ __forceinline__ void pv(f32x16* o, int vb, bf16x8 pa0, bf16x8 pa1, bf16x8 pa2, bf16x8 pa3) {
  #pragma unroll
  for (int d0 = 0; d0 < 2; ++d0) { s16x4 lo[4], hi[4];
    #pragma unroll
    for (int ks = 0; ks < 4; ++ks) {
      asm volatile("ds_read_b64_tr_b16 %0,%1 offset:%c2" : "=&v"(lo[ks]) : "v"(vb), "i"(d0 * 4096 + ks * 1024) : "memory");
      asm volatile("ds_read_b64_tr_b16 %0,%1 offset:%c2" : "=&v"(hi[ks]) : "v"(vb), "i"(d0 * 4096 + ks * 1024 + 512) : "memory"); }
    asm volatile("s_waitcnt lgkmcnt(0)" ::: "memory"); SBAR();
    #define PK(k) (bf16x8){lo[k][0], lo[k][1], lo[k][2], lo[k][3], hi[k][0], hi[k][1], hi[k][2], hi[k][3]}
    o[d0] = __builtin_amdgcn_mfma_f32_32x32x16_bf16(pa0, PK(0), o[d0], 0, 0, 0);
    o[d0] = __builtin_amdgcn_mfma_f32_32x32x16_bf16(pa1, PK(1), o[d0], 0, 0, 0);
    o[d0] = __builtin_amdgcn_mfma_f32_32x32x16_bf16(pa2, PK(2), o[d0], 0, 0, 0);
    o[d0] = __builtin_amdgcn_mfma_f32_32x32x16_bf16(pa3, PK(3), o[d0], 0, 0, 0);
    #undef PK
  }
}
#define ATTN_STORE16(p, v) (*(u32x4*)(p) = (v))
template <int THRL> __device__ __forceinline__ void attn_unit(int tid_in, int b, int hq, int hv, int qb, const bf16* Q, const bf16* __restrict__ K, const bf16* __restrict__ V, bf16* O, char* shm) {
  const int tid = tid_in, lane = tid & 63, r32 = lane & 31, hi = lane >> 5; const int wid = __builtin_amdgcn_readfirstlane(tid >> 6);
  const long rowbase = (long)b * SEQ; const int q0 = qb * QB;
  const bf16* Qw = Q + (rowbase + q0 + wid * QBLK) * DMA + hq * D;
  const bf16* Kh = K + rowbase * DMA + hq * D, *Vh = V + rowbase * DMA + hv * D;
  const unsigned lds0 = (unsigned)(uintptr_t)shm;
  float* wsf = (float*)(shm + LDS_WS) + wid * 64;
  const bf16* ksrc = Kh + (long)lane * DMA + wid * 8;
  const bf16* vsrc = Vh + (long)(16 * (wid & 3) + (lane >> 2)) * DMA + (wid >> 2) * 32 + (lane & 3) * 8;
  const unsigned kdst = lds0 + LDS_K + wid * 1024, vdst = lds0 + LDS_V + wid * 1024;
  #define DMA_K(t, slot) glds16(ksrc + (long)(t) * KVBLK * DMA, (unsigned)__builtin_amdgcn_readfirstlane(kdst + (slot)))
  #define DMA_V(t, slot) glds16(vsrc + (long)(t) * KVBLK * DMA, (unsigned)__builtin_amdgcn_readfirstlane(vdst + (slot)))
  const int vb0 = (int)(lds0 + LDS_V) + ((lane >> 4) & 1) * 32 + (lane & 3) * 8 + (4 * hi + ((lane & 15) >> 2)) * 64;
  const char* Kbase = shm + LDS_K; bf16x8 kf[8];
  const lds_cptr shm3 = (lds_cptr)shm; const lds_cptr kp0 = shm3 + LDS_K + hi * 1024 + r32 * 16; const lds_cptr vp0 = shm3 + LDS_V + ((lane >> 4) & 1) * 32 + (lane & 3) * 8 + (4 * hi + ((lane & 15) >> 2)) * 64;
  const int NT = (q0 + QB) / KVBLK;
  DMA_K(0, 0); DMA_V(0, 0); DMA_K(1, SLOTB);
  bf16x8 qr[4];
  #pragma unroll
  for (int d0 = 0; d0 < 4; ++d0) qr[d0] = *reinterpret_cast<const bf16x8*>(&Qw[(long)r32 * DMA + d0 * 16 + hi * 8]);
  float mhat = 0.f, l_reg = 0.f; f32x16 o[2]; o[0] = f32x16{}; o[1] = f32x16{}; f32x16 negm = f32x16{}; asm volatile("" : "+v"(negm));
  const int qrel = wid * QBLK + r32;
  #define CMASK(P0, P1, t) do { int jb_ = (t) - (NT - 4); if (jb_ >= 0) cmask(P0, P1, jb_, qrel, hi); } while (0)
  bool resc = false;
  #define START(P0, P1) do { const float rm = rowmax(P0, P1); resc = false; \
    { const float dl = rm; mhat = fadd_s(mhat, dl); \
      _Pragma("unroll") for (int r = 0; r < 16; ++r) { P0[r] = fsub_s(P0[r], dl); P1[r] = fsub_s(P1[r], dl); } \
      _Pragma("unroll") for (int r = 0; r < 16; ++r) negm[r] = -mhat; asm volatile("" : "+v"(negm)); } \
    _Pragma("unroll") for (int r = 0; r < 16; ++r) P0[r] = __builtin_amdgcn_exp2f(P0[r]); } while (0)
  #define RESC() do { if (resc) { asm volatile("s_waitcnt lgkmcnt(0)" ::: "memory"); \
      _Pragma("unroll") for (int d_ = 0; d_ < 2; ++d_) _Pragma("unroll") for (int r = 0; r < 16; ++r) o[d_][r] *= wsf[crow(r, hi)]; } } while (0)
  f32x16 pA0, pA1, pB0, pB1;
  int sl_prev = 0, sl_cur = 0, sl_next = SLOTB;
  #define ROT() do { sl_prev = sl_cur; sl_cur = sl_next; sl_next = (sl_next == (NSLOT - 1) * SLOTB) ? 0 : sl_next + SLOTB; } while (0)
  DMA_K(2, 2 * SLOTB);
  WAIT_BAR(3);
  qkt(pA0, pA1, Kbase, qr, negm, r32, hi); asm volatile("s_nop 15\n\ts_nop 7" : "+v"(pA0), "+v"(pA1)); CMASK(pA0, pA1, 0);
  START(pA0, pA1);
  _Pragma("unroll") for (int r = 0; r < 16; ++r) pA1[r] = __builtin_amdgcn_exp2f(pA1[r]);
  WAIT_BAR(0);
  DMA_K(3, 0); DMA_V(1, SLOTB);
  ROT();
  kload8(kf, kp0 + sl_cur);
  WAIT_BAR(2);
  s16x4 vlo[8], vhi[8]; u32x4 pw0, pw1, pw2, pw3;
  #define PKW(P, B) cvtpk_s(P[B], P[B + 1])
  #define PAF(k) __builtin_bit_cast(bf16x8, pw##k)
  #define VFR(i) (bf16x8){vlo[i][0], vlo[i][1], vlo[i][2], vlo[i][3], vhi[i][0], vhi[i][1], vhi[i][2], vhi[i][3]}
  #define PIN(x) asm volatile("" : "+v"(x))
  #define MX3(a, b, c) __builtin_fmaxf(__builtin_fmaxf((a), (b)), (c))
  #define GAPA(MF, A0, A1, A2, A3, W0, W1, PW) do { MF; sacc += A0; sacc += A1; sacc += A2; sacc += A3; PIN(sacc); W0; W1; PIN(PW); SBAR(); } while (0)
  #define EX(v) __builtin_amdgcn_exp2f(v)
  #define GAPB(MF, X, B) do { MF; X[B] = EX(X[B]); X[B + 1] = EX(X[B + 1]); X[B + 2] = EX(X[B + 2]); X[B + 3] = EX(X[B + 3]); PIN(X); SBAR(); } while (0)
  #define VRD(i) do { vlo[i] = vtr(vp_ + (((i) >> 2) * 4096 + ((i) & 3) * 1024)); vhi[i] = vtr(vp_ + (((i) >> 2) * 4096 + ((i) & 3) * 1024 + 512)); } while (0)
  #define KRD(G, j) do { if (G) { kload2(kf, kp0 + sl_next, j); SBAR(); } } while (0)
  #define STEP(C0, C1, P0, P1, t, GK, GV, GL) do { SBAR(); \
    const lds_cptr vp_ = vp0 + sl_prev; \
    VRD(0); SBAR(); float sacc = (P0[0] + P0[1]); \
    GAPA(C0 = __builtin_amdgcn_mfma_f32_32x32x16_bf16(kf[0], qr[0], negm, 0, 0, 0), P0[2], P0[3], P0[4], P0[5],     pw0[0] = PKW(P0, 0), pw0[1] = PKW(P0, 2), pw0); \
    VRD(4); SBAR(); GAPA(C1 = __builtin_amdgcn_mfma_f32_32x32x16_bf16(kf[1], qr[0], negm, 0, 0, 0), P0[6], P0[7], P0[8], P0[9],     pw0[2] = PKW(P0, 4), pw0[3] = PKW(P0, 6), pw0); \
    VRD(1); SBAR(); GAPA(C0 = __builtin_amdgcn_mfma_f32_32x32x16_bf16(kf[2], qr[1], C0, 0, 0, 0),   P0[10], P0[11], P0[12], P0[13], pw1[0] = PKW(P0, 8), pw1[1] = PKW(P0, 10), pw1); \
    VRD(5); SBAR(); GAPA(C1 = __builtin_amdgcn_mfma_f32_32x32x16_bf16(kf[3], qr[1], C1, 0, 0, 0),   P0[14], P0[15], P1[0], P1[1],   pw1[2] = PKW(P0, 12), pw1[3] = PKW(P0, 14), pw1); \
    VRD(2); SBAR(); GAPA(C0 = __builtin_amdgcn_mfma_f32_32x32x16_bf16(kf[4], qr[2], C0, 0, 0, 0),   P1[2], P1[3], P1[4], P1[5],     pw2[0] = PKW(P1, 0), pw2[1] = PKW(P1, 2), pw2); \
    VRD(6); SBAR(); GAPA(C1 = __builtin_amdgcn_mfma_f32_32x32x16_bf16(kf[5], qr[2], C1, 0, 0, 0),   P1[6], P1[7], P1[8], P1[9],     pw2[2] = PKW(P1, 4), pw2[3] = PKW(P1, 6), pw2); \
    VRD(3); SBAR(); GAPA(C0 = __builtin_amdgcn_mfma_f32_32x32x16_bf16(kf[6], qr[3], C0, 0, 0, 0),   P1[10], P1[11], P1[12], P1[13], pw3[0] = PKW(P1, 8), pw3[1] = PKW(P1, 10), pw3); \
    VRD(7); SBAR(); GAPA(C1 = __builtin_amdgcn_mfma_f32_32x32x16_bf16(kf[7], qr[3], C1, 0, 0, 0),   P1[14], P1[15], 0.f, 0.f,       pw3[2] = PKW(P1, 12), pw3[3] = PKW(P1, 14), pw3); \
    l_reg += sacc; \
    if (GK) { DMA_K((t) + 3, sl_cur); } if (GV) { DMA_V((t) + 1, sl_next); } \
    CMASK(C0, C1, t); \
    { float a = MX3(C0[0], C0[1], C1[0]), b = MX3(C0[2], C0[3], C1[1]); a = MX3(a, C1[2], C1[3]); \
      _Pragma("unroll") for (int r = 4; r < 16; r += 4) { a = MX3(a, C0[r], C0[r + 1]); b = MX3(b, C0[r + 2], C0[r + 3]); a = MX3(a, C1[r], C1[r + 1]); b = MX3(b, C1[r + 2], C1[r + 3]); } \
      float rm = __builtin_fmaxf(a, b); { auto rr = __builtin_amdgcn_permlane32_swap(__float_as_uint(rm), __float_as_uint(rm), false, false); rm = __builtin_fmaxf(__uint_as_float(rr[0]), __uint_as_float(rr[1])); } \
      resc = false; \
      if (__builtin_expect(__any(rm > (float)THRL), 0)) { const float dl = __builtin_fmaxf(rm, 0.f); mhat += dl; \
        _Pragma("unroll") for (int r = 0; r < 16; ++r) { C0[r] -= dl; C1[r] -= dl; } \
        _Pragma("unroll") for (int r = 0; r < 16; ++r) negm[r] = -mhat; asm volatile("" : "+v"(negm)); \
        const float f = __builtin_amdgcn_exp2f(-dl); l_reg *= f; if (hi == 0) wsf[r32] = f; resc = true; } } \
    SBAR(); \
    GAPB(o[0] = __builtin_amdgcn_mfma_f32_32x32x16_bf16(PAF(0), VFR(0), o[0], 0, 0, 0), C0, 0); \
    GAPB(o[1] = __builtin_amdgcn_mfma_f32_32x32x16_bf16(PAF(0), VFR(4), o[1], 0, 0, 0), C0, 4); \
    KRD(GL, 0); GAPB(o[0] = __builtin_amdgcn_mfma_f32_32x32x16_bf16(PAF(1), VFR(1), o[0], 0, 0, 0), C0, 8); \
    KRD(GL, 1); GAPB(o[1] = __builtin_amdgcn_mfma_f32_32x32x16_bf16(PAF(1), VFR(5), o[1], 0, 0, 0), C0, 12); \
    KRD(GL, 2); GAPB(o[0] = __builtin_amdgcn_mfma_f32_32x32x16_bf16(PAF(2), VFR(2), o[0], 0, 0, 0), C1, 0); \
    KRD(GL, 3); GAPB(o[1] = __builtin_amdgcn_mfma_f32_32x32x16_bf16(PAF(2), VFR(6), o[1], 0, 0, 0), C1, 4); \
    GAPB(o[0] = __builtin_amdgcn_mfma_f32_32x32x16_bf16(PAF(3), VFR(3), o[0], 0, 0, 0), C1, 8); \
    GAPB(o[1] = __builtin_amdgcn_mfma_f32_32x32x16_bf16(PAF(3), VFR(7), o[1], 0, 0, 0), C1, 12); \
    } while (0)
  int t = 1;
  #undef CMASK
  #define CMASK(P0, P1, t) do {} while (0)
  for (; t + 5 < NT; t += 2) {
    STEP(pB0, pB1, pA0, pA1, t, true, true, true);     WAIT_BAR(2); RESC(); ROT();
    STEP(pA0, pA1, pB0, pB1, t + 1, true, true, true); WAIT_BAR(2); RESC(); ROT();
  }
  #undef CMASK
  #define CMASK(P0, P1, t) do { int jb_ = (t) - (NT - 4); if (jb_ >= 0) cmask(P0, P1, jb_, qrel, hi); } while (0)
  #define ENDW(tt) do { if ((tt) + 3 < NT) { WAIT_BAR(2); } else if ((tt) + 2 < NT) { WAIT_BAR(1); } else { WAIT_BAR(0); } } while (0)
  for (; t + 1 < NT; t += 2) {
    STEP(pB0, pB1, pA0, pA1, t, (t + 3 < NT), (t + 1 < NT), (t + 1 < NT));         ENDW(t);     RESC(); ROT();
    STEP(pA0, pA1, pB0, pB1, t + 1, (t + 4 < NT), (t + 2 < NT), (t + 2 < NT));     ENDW(t + 1); RESC(); ROT();
  }
  STEP(pB0, pB1, pA0, pA1, NT - 1, false, false, false); RESC();
  { float sacc = pB0[0] + pB0[1]; _Pragma("unroll") for (int r = 2; r < 16; ++r) sacc += pB0[r]; _Pragma("unroll") for (int r = 0; r < 16; ++r) sacc += pB1[r]; l_reg += sacc;
    pw0 = (u32x4){PKW(pB0, 0), PKW(pB0, 2), PKW(pB0, 4), PKW(pB0, 6)}; pw1 = (u32x4){PKW(pB0, 8), PKW(pB0, 10), PKW(pB0, 12), PKW(pB0, 14)}; pw2 = (u32x4){PKW(pB1, 0), PKW(pB1, 2), PKW(pB1, 4), PKW(pB1, 6)}; pw3 = (u32x4){PKW(pB1, 8), PKW(pB1, 10), PKW(pB1, 12), PKW(pB1, 14)};
    SBAR(); pv(o, vb0 + sl_cur, PAF(0), PAF(1), PAF(2), PAF(3)); }
  #undef PKW
  #undef PAF
  #undef VFR
  #undef PIN
  #undef MX3
  #undef GAPA
  #undef GAPB
  #undef EX
  #undef VRD
  #undef KRD
  #undef STEP
  #undef ENDW
  { auto rr = __builtin_amdgcn_permlane32_swap(__float_as_uint(l_reg), __float_as_uint(l_reg), false, false); l_reg = __uint_as_float(rr[0]) + __uint_as_float(rr[1]); }
  if (hi == 0) wsf[32 + r32] = l_reg; asm volatile("s_waitcnt lgkmcnt(0)" ::: "memory");
  float rli[16];
  #pragma unroll
  for (int r = 0; r < 16; ++r) rli[r] = __builtin_amdgcn_rcpf(wsf[32 + crow(r, hi)]);
  bf16* Ow = O + (rowbase + q0 + wid * QBLK) * DMA + hv * D;
  { bf16* stg = (bf16*)(shm + LDS_OST) + wid * 2048;
    #pragma unroll
    for (int r = 0; r < 16; ++r) { const int orow = crow(r, hi);
      #pragma unroll
      for (int d0 = 0; d0 < 2; ++d0) stg[orow * 64 + d0 * 32 + r32] = f2bf(o[d0][r] * rli[r]); }
    asm volatile("s_waitcnt lgkmcnt(0)" ::: "memory");
    #pragma unroll
    for (int i = 0; i < 4; ++i) { const int row = i * 8 + (lane >> 3), ch = lane & 7; const u32x4 v = *(const u32x4*)(stg + row * 64 + ch * 8); ATTN_STORE16(Ow + (long)row * DMA + ch * 8, v); } }
  asm volatile("s_waitcnt lgkmcnt(0)\n\ts_barrier" ::: "memory");
  #undef DMA_K
  #undef DMA_V
  #undef CMASK
  #undef START
  #undef RESC
  #undef ROT
}
constexpr int ATTN_LDS_BYTES = LDS_BYTES;
#undef SBAR
#undef WAIT_BAR
}

namespace attn3 {
using namespace attn_body;
constexpr int KSLOT = 8192, VSLOT = 16384;
constexpr int L_K = 0, L_V = NSLOT * KSLOT, L_WS = L_V + NSLOT * VSLOT, L_OST = L_WS + NW * 64 * 4, L_BYTES = L_OST + NW * 4096;
#define SBAR() __builtin_amdgcn_sched_barrier(0)
#define WAIT_BAR(N) asm volatile("s_waitcnt vmcnt(" #N ") lgkmcnt(0)\n\ts_barrier" ::: "memory")
template <int THRL> __device__ __forceinline__ void attn_unit(int tid_in, int b, int hq, int h, int qb, const bf16* Q, const bf16* __restrict__ K, const bf16* __restrict__ V, bf16* O, char* shm,
                                                             int mode, const bf16* SZ1, const float* g_sub, float lam, bf16* OG) {
  int tid_ = tid_in; asm volatile("" : "+v"(tid_));
  const int tid = tid_, lane = tid & 63, r32 = lane & 31, hi = lane >> 5; const int wid = __builtin_amdgcn_readfirstlane(tid >> 6);
  const long rowbase = (long)b * SEQ; const int q0 = qb * QB;
  const bf16* Qw = Q + (rowbase + q0 + wid * QBLK) * DMA + hq * D;
  const bf16* Kh = K + rowbase * DMA + hq * D, *Vh = V + rowbase * DMA + h * 128;
  const unsigned lds0 = (unsigned)(uintptr_t)shm;
  float* wsf = (float*)(shm + L_WS) + wid * 64;
  const bf16* ksrc = Kh + (long)lane * DMA + wid * 8;
  const bf16* vsrc = Vh + (long)(16 * (wid & 3) + (lane >> 2)) * DMA + (wid >> 2) * 32 + (lane & 3) * 8;
  const unsigned kdst = lds0 + L_K + wid * 1024, vdst = lds0 + L_V + wid * 1024;
  #define DMA_K(t, si) glds16(ksrc + (long)(t) * KVBLK * DMA, (unsigned)__builtin_amdgcn_readfirstlane(kdst + (si) * KSLOT))
  #define DMA_V(t, si) do { glds16(vsrc + (long)(t) * KVBLK * DMA, (unsigned)__builtin_amdgcn_readfirstlane(vdst + (si) * VSLOT)); \
                            glds16(vsrc + (long)(t) * KVBLK * DMA + 64, (unsigned)__builtin_amdgcn_readfirstlane(vdst + (si) * VSLOT + 8192)); } while (0)
  const int vb0 = (int)(lds0 + L_V) + ((lane >> 4) & 1) * 32 + (lane & 3) * 8 + (4 * hi + ((lane & 15) >> 2)) * 64;
  const char* Kbase = shm + L_K; bf16x8 kf[8];
  const lds_cptr shm3 = (lds_cptr)shm; const lds_cptr kp0 = shm3 + L_K + hi * 1024 + r32 * 16; const lds_cptr vp0 = shm3 + L_V + ((lane >> 4) & 1) * 32 + (lane & 3) * 8 + (4 * hi + ((lane & 15) >> 2)) * 64;
  const int NT = (q0 + QB) / KVBLK;
  DMA_K(0, 0); DMA_V(0, 0); DMA_K(1, 1);
  bf16x8 qr[4];
  #pragma unroll
  for (int d0 = 0; d0 < 4; ++d0) qr[d0] = *reinterpret_cast<const bf16x8*>(&Qw[(long)r32 * DMA + d0 * 16 + hi * 8]);
  float mhat = 0.f, l_reg = 0.f; f32x16 o[4]; f32x16 negm;
  { float zf = 0.f; asm volatile("" : "+v"(zf));
    _Pragma("unroll") for (int r = 0; r < 16; ++r) { o[0][r] = zf; o[1][r] = zf; o[2][r] = zf; o[3][r] = zf; negm[r] = zf; } }
  asm volatile("" : "+v"(negm));
  const int qrel = wid * QBLK + r32;
  #define CMASK(P0, P1, t) do { int jb_ = (t) - (NT - 4); if (jb_ >= 0) cmask(P0, P1, jb_, qrel, hi); } while (0)
  bool resc = false;
  #define RESC() do { if (resc) { asm volatile("s_waitcnt lgkmcnt(0)" ::: "memory"); \
      _Pragma("unroll") for (int d_ = 0; d_ < 4; ++d_) _Pragma("unroll") for (int r = 0; r < 16; ++r) o[d_][r] *= wsf[crow(r, hi)]; } } while (0)
  f32x16 C0, C1;
  int s_prev = 0, s_cur = 0, s_next = 1;
  #define ROT() do { s_prev = s_cur; s_cur = s_next; s_next = (s_next == NSLOT - 1) ? 0 : s_next + 1; } while (0)
  DMA_K(2, 2);
  WAIT_BAR(4);
  u32x4 pwA0, pwA1, pwA2, pwA3, pwB0, pwB1, pwB2, pwB3;
  #define PKW(P, B) cvtpk_s(P[B], P[B + 1])
  qkt(C0, C1, Kbase, qr, negm, r32, hi); asm volatile("s_nop 15\n\ts_nop 7" : "+v"(C0), "+v"(C1)); CMASK(C0, C1, 0);
  { const float rm = rowmax(C0, C1); mhat = fadd_s(mhat, rm);
    _Pragma("unroll") for (int r = 0; r < 16; ++r) { C0[r] = fsub_s(C0[r], rm); C1[r] = fsub_s(C1[r], rm); }
    _Pragma("unroll") for (int r = 0; r < 16; ++r) negm[r] = -mhat; asm volatile("" : "+v"(negm));
    float sacc = 0.f;
    _Pragma("unroll") for (int r = 0; r < 16; ++r) { C0[r] = __builtin_amdgcn_exp2f(C0[r]); C1[r] = __builtin_amdgcn_exp2f(C1[r]); }
    _Pragma("unroll") for (int r = 0; r < 16; ++r) sacc += C0[r] + C1[r];
    l_reg = sacc;
    pwA0 = (u32x4){PKW(C0, 0), PKW(C0, 2), PKW(C0, 4), PKW(C0, 6)}; pwA1 = (u32x4){PKW(C0, 8), PKW(C0, 10), PKW(C0, 12), PKW(C0, 14)};
    pwA2 = (u32x4){PKW(C1, 0), PKW(C1, 2), PKW(C1, 4), PKW(C1, 6)}; pwA3 = (u32x4){PKW(C1, 8), PKW(C1, 10), PKW(C1, 12), PKW(C1, 14)}; }
  WAIT_BAR(0);
  DMA_K(3, 0); DMA_V(1, 1);
  ROT();
  kload8(kf, kp0 + s_cur * KSLOT);
  WAIT_BAR(3);
  s16x4 vlo[8], vhi[8];
  #define PAF(w) __builtin_bit_cast(bf16x8, w)
  #define VFR(i) (bf16x8){vlo[i][0], vlo[i][1], vlo[i][2], vlo[i][3], vhi[i][0], vhi[i][1], vhi[i][2], vhi[i][3]}
  #define PIN(x) asm volatile("" : "+v"(x))
  #define MX3(a, b, c) __builtin_fmaxf(__builtin_fmaxf((a), (b)), (c))
  #define EX(v) __builtin_amdgcn_exp2f(v)
  #define VRD(s, f) do { vlo[s] = vtr(vp_ + (((f) >> 2) * 4096 + ((f) & 3) * 1024)); vhi[s] = vtr(vp_ + (((f) >> 2) * 4096 + ((f) & 3) * 1024 + 512)); } while (0)
  #define KRD(G, j) do { if (G) { kload2(kf, kp0 + s_next * KSLOT, j); SBAR(); } } while (0)
  #define GAPB(MF, X, B, PWW) do { MF; X[B] = EX(X[B]); X[B + 1] = EX(X[B + 1]); sacc += X[B]; sacc += X[B + 1]; PIN(sacc); PWW = PKW(X, B); PIN(PWW); SBAR(); } while (0)
  #define MFQ(a, b, c) __builtin_amdgcn_mfma_f32_32x32x16_bf16(a, b, c, 0, 0, 0)
  #define STEP(PP0, PP1, PP2, PP3, PN0, PN1, PN2, PN3, t, GK, GV, GL) do { SBAR(); \
    const lds_cptr vp_ = vp0 + s_prev * VSLOT; \
    VRD(0, 0); SBAR(); C0 = MFQ(kf[0], qr[0], negm); SBAR(); \
    VRD(4, 4); SBAR(); C1 = MFQ(kf[1], qr[0], negm); SBAR(); \
    VRD(1, 1); SBAR(); C0 = MFQ(kf[2], qr[1], C0); SBAR(); \
    VRD(5, 5); SBAR(); C1 = MFQ(kf[3], qr[1], C1); SBAR(); \
    VRD(2, 2); SBAR(); C0 = MFQ(kf[4], qr[2], C0); SBAR(); \
    VRD(6, 6); SBAR(); C1 = MFQ(kf[5], qr[2], C1); SBAR(); \
    VRD(3, 3); SBAR(); C0 = MFQ(kf[6], qr[3], C0); SBAR(); \
    VRD(7, 7); SBAR(); C1 = MFQ(kf[7], qr[3], C1); SBAR(); \
    if (GK) { DMA_K((t) + 3, s_cur); } if (GV) { DMA_V((t) + 1, s_next); } \
    CMASK(C0, C1, t); \
    { float a = MX3(C0[0], C0[1], C1[0]), b = MX3(C0[2], C0[3], C1[1]); a = MX3(a, C1[2], C1[3]); \
      _Pragma("unroll") for (int r = 4; r < 16; r += 4) { a = MX3(a, C0[r], C0[r + 1]); b = MX3(b, C0[r + 2], C0[r + 3]); a = MX3(a, C1[r], C1[r + 1]); b = MX3(b, C1[r + 2], C1[r + 3]); } \
      float rm = __builtin_fmaxf(a, b); { auto rr = __builtin_amdgcn_permlane32_swap(__float_as_uint(rm), __float_as_uint(rm), false, false); rm = __builtin_fmaxf(__uint_as_float(rr[0]), __uint_as_float(rr[1])); } \
      resc = false; \
      if (__builtin_expect(__any(rm > (float)THRL), 0)) { const float dl = __builtin_fmaxf(rm, 0.f); mhat += dl; \
        _Pragma("unroll") for (int r = 0; r < 16; ++r) { C0[r] -= dl; C1[r] -= dl; } \
        _Pragma("unroll") for (int r = 0; r < 16; ++r) negm[r] = -mhat; asm volatile("" : "+v"(negm)); \
        const float f = __builtin_amdgcn_exp2f(-dl); l_reg *= f; if (hi == 0) wsf[r32] = f; resc = true; } } \
    SBAR(); float sacc = 0.f; \
    GAPB(o[0] = MFQ(PAF(PP0), VFR(0), o[0]), C0, 0,  PN0[0]); VRD(0, 8);  SBAR(); \
    GAPB(o[1] = MFQ(PAF(PP0), VFR(4), o[1]), C0, 2,  PN0[1]); VRD(4, 12); SBAR(); \
    GAPB(o[0] = MFQ(PAF(PP1), VFR(1), o[0]), C0, 4,  PN0[2]); VRD(1, 9);  SBAR(); \
    GAPB(o[1] = MFQ(PAF(PP1), VFR(5), o[1]), C0, 6,  PN0[3]); VRD(5, 13); SBAR(); \
    GAPB(o[0] = MFQ(PAF(PP2), VFR(2), o[0]), C0, 8,  PN1[0]); VRD(2, 10); SBAR(); \
    GAPB(o[1] = MFQ(PAF(PP2), VFR(6), o[1]), C0, 10, PN1[1]); VRD(6, 14); SBAR(); \
    GAPB(o[0] = MFQ(PAF(PP3), VFR(3), o[0]), C0, 12, PN1[2]); VRD(3, 11); SBAR(); \
    GAPB(o[1] = MFQ(PAF(PP3), VFR(7), o[1]), C0, 14, PN1[3]); VRD(7, 15); SBAR(); \
    GAPB(o[2] = MFQ(PAF(PP0), VFR(0), o[2]), C1, 0,  PN2[0]); \
    GAPB(o[3] = MFQ(PAF(PP0), VFR(4), o[3]), C1, 2,  PN2[1]); \
    KRD(GL, 0); GAPB(o[2] = MFQ(PAF(PP1), VFR(1), o[2]), C1, 4,  PN2[2]); \
    KRD(GL, 1); GAPB(o[3] = MFQ(PAF(PP1), VFR(5), o[3]), C1, 6,  PN2[3]); \
    KRD(GL, 2); GAPB(o[2] = MFQ(PAF(PP2), VFR(2), o[2]), C1, 8,  PN3[0]); \
    KRD(GL, 3); GAPB(o[3] = MFQ(PAF(PP2), VFR(6), o[3]), C1, 10, PN3[1]); \
    GAPB(o[2] = MFQ(PAF(PP3), VFR(3), o[2]), C1, 12, PN3[2]); \
    GAPB(o[3] = MFQ(PAF(PP3), VFR(7), o[3]), C1, 14, PN3[3]); \
    l_reg += sacc; \
    } while (0)
  #define STEP_AB(t, GK, GV, GL) STEP(pwA0, pwA1, pwA2, pwA3, pwB0, pwB1, pwB2, pwB3, t, GK, GV, GL)
  #define STEP_BA(t, GK, GV, GL) STEP(pwB0, pwB1, pwB2, pwB3, pwA0, pwA1, pwA2, pwA3, t, GK, GV, GL)
  int t = 1;
  #undef CMASK
  #define CMASK(P0, P1, t) do {} while (0)
  for (; t + 5 < NT; t += 2) {
    STEP_AB(t, true, true, true);     WAIT_BAR(3); RESC(); ROT();
    STEP_BA(t + 1, true, true, true); WAIT_BAR(3); RESC(); ROT();
  }
  #undef CMASK
  #define CMASK(P0, P1, t) do { int jb_ = (t) - (NT - 4); if (jb_ >= 0) cmask(P0, P1, jb_, qrel, hi); } while (0)
  #define ENDW(tt) do { if ((tt) + 3 < NT) { WAIT_BAR(3); } else if ((tt) + 2 < NT) { WAIT_BAR(2); } else { WAIT_BAR(0); } } while (0)
  for (; t + 1 < NT; t += 2) {
    STEP_AB(t, (t + 3 < NT), (t + 1 < NT), (t + 1 < NT));         ENDW(t);     RESC(); ROT();
    STEP_BA(t + 1, (t + 4 < NT), (t + 2 < NT), (t + 2 < NT));     ENDW(t + 1); RESC(); ROT();
  }
  STEP_AB(NT - 1, false, false, false); RESC();
  { SBAR();
    const int vb = vb0 + s_cur * VSLOT;
    #pragma unroll
    for (int d0 = 0; d0 < 4; ++d0) { s16x4 lo[4], hh[4];
      #pragma unroll
      for (int ks = 0; ks < 4; ++ks) {
        asm volatile("ds_read_b64_tr_b16 %0,%1 offset:%c2" : "=&v"(lo[ks]) : "v"(vb), "i"(d0 * 4096 + ks * 1024) : "memory");
        asm volatile("ds_read_b64_tr_b16 %0,%1 offset:%c2" : "=&v"(hh[ks]) : "v"(vb), "i"(d0 * 4096 + ks * 1024 + 512) : "memory"); }
      asm volatile("s_waitcnt lgkmcnt(0)" ::: "memory"); SBAR();
      #define PK(k) (bf16x8){lo[k][0], lo[k][1], lo[k][2], lo[k][3], hh[k][0], hh[k][1], hh[k][2], hh[k][3]}
      o[d0] = MFQ(PAF(pwB0), PK(0), o[d0]); o[d0] = MFQ(PAF(pwB1), PK(1), o[d0]); o[d0] = MFQ(PAF(pwB2), PK(2), o[d0]); o[d0] = MFQ(PAF(pwB3), PK(3), o[d0]);
      #undef PK
    } }
  { auto rr = __builtin_amdgcn_permlane32_swap(__float_as_uint(l_reg), __float_as_uint(l_reg), false, false); l_reg = __uint_as_float(rr[0]) + __uint_as_float(rr[1]); }
  if (hi == 0) wsf[32 + r32] = l_reg; asm volatile("s_waitcnt lgkmcnt(0)" ::: "memory");
  float rli[16];
  #pragma unroll
  for (int r = 0; r < 16; ++r) rli[r] = __builtin_amdgcn_rcpf(wsf[32 + crow(r, hi)]);
  int lane_e = lane; asm volatile("" : "+v"(lane_e));
  const int erow = lane_e >> 3, ech = lane_e & 7;
  bf16* Ow = O + (rowbase + q0 + wid * QBLK) * DMA + h * 128;
  bf16* stg = (bf16*)(shm + L_OST) + wid * 2048;
  if (mode == 0) {
    #pragma unroll
    for (int ps = 0; ps < 2; ++ps) {
      #pragma unroll
      for (int r = 0; r < 16; ++r) { const int orow = crow(r, hi);
        #pragma unroll
        for (int d0 = 0; d0 < 2; ++d0) stg[orow * 64 + d0 * 32 + r32] = f2bf(o[2 * ps + d0][r] * rli[r]); }
      asm volatile("s_waitcnt lgkmcnt(0)" ::: "memory");
      #pragma unroll
      for (int i = 0; i < 4; ++i) { const int row = i * 8 + erow, ch = ech; const u32x4 v = *(const u32x4*)(stg + row * 64 + ch * 8); *(u32x4*)(Ow + (long)row * DMA + ps * 64 + ch * 8) = v; }
      asm volatile("s_waitcnt lgkmcnt(0)" ::: "memory");
    }
    asm volatile("s_waitcnt vmcnt(0)" ::: "memory");
  } else {
    const bf16* Zw = SZ1 + (rowbase + q0 + wid * QBLK) * DMA + h * 128; bf16* Gw = OG + (rowbase + q0 + wid * QBLK) * DMA + h * 128;
    float dk[2][4][8]; float ss[4] = {0.f, 0.f, 0.f, 0.f};
    #pragma unroll
    for (int ps = 0; ps < 2; ++ps) {
      #pragma unroll
      for (int r = 0; r < 16; ++r) { const int orow = crow(r, hi);
        #pragma unroll
        for (int d0 = 0; d0 < 2; ++d0) stg[orow * 64 + d0 * 32 + r32] = f2bf(o[2 * ps + d0][r] * rli[r]); }
      asm volatile("s_waitcnt lgkmcnt(0)" ::: "memory");
      #pragma unroll
      for (int i = 0; i < 4; ++i) { const int row = i * 8 + erow, ch = ech;
        const u32x4 v1 = *(const u32x4*)(stg + row * 64 + ch * 8); const u32x4 v0 = *(const u32x4*)(Ow + (long)row * DMA + ps * 64 + ch * 8);
        #pragma unroll
        for (int j = 0; j < 4; ++j) { const float a0 = __uint_as_float(v0[j] << 16), a1 = __uint_as_float(v0[j] & 0xffff0000u), b0 = __uint_as_float(v1[j] << 16), b1 = __uint_as_float(v1[j] & 0xffff0000u);
          const float d0_ = a0 - lam * b0, d1_ = a1 - lam * b1; dk[ps][i][2 * j] = d0_; dk[ps][i][2 * j + 1] = d1_; ss[i] += d0_ * d0_ + d1_ * d1_; } }
      asm volatile("s_waitcnt lgkmcnt(0)" ::: "memory");
    }
    #pragma unroll
    for (int i = 0; i < 4; ++i) { float t_ = ss[i]; t_ += __shfl_xor(t_, 1); t_ += __shfl_xor(t_, 2); t_ += __shfl_xor(t_, 4); ss[i] = rsqrtf(t_ * (1.0f / 128.0f) + RMS_EPS) * ONE_M_LI; }
    #pragma unroll
    for (int ps = 0; ps < 2; ++ps) {
      const int ch = ech; const float* gp = g_sub + ps * 64 + ch * 8; const f32x4_t g0 = *(const f32x4_t*)gp, g1 = *(const f32x4_t*)(gp + 4);
      #pragma unroll
      for (int i = 0; i < 4; ++i) { const int row = i * 8 + erow;
        const u32x4 z = NT_LD((const u32x4*)(Zw + (long)row * DMA + ps * 64 + ch * 8)); u32x4 w;
        #pragma unroll
        for (int j = 0; j < 4; ++j) { const float z0 = __uint_as_float(z[j] << 16), z1 = __uint_as_float(z[j] & 0xffff0000u);
          const float ga = (j < 2) ? g0[2 * j] : g1[2 * j - 4], gb = (j < 2) ? g0[2 * j + 1] : g1[2 * j - 3];
          w[j] = cvtpk_s(dk[ps][i][2 * j] * ss[i] * ga * z0, dk[ps][i][2 * j + 1] * ss[i] * gb * z1); }
        *(u32x4*)(Gw + (long)row * DMA + ps * 64 + ch * 8) = w; }
    }
  }
  asm volatile("s_waitcnt lgkmcnt(0)\n\ts_barrier" ::: "memory");
  #undef DMA_K
  #undef DMA_V
  #undef CMASK
  #undef RESC
  #undef ROT
  #undef PKW
  #undef PAF
  #undef VFR
  #undef PIN
  #undef MX3
  #undef EX
  #undef VRD
  #undef KRD
  #undef GAPB
  #undef MFQ
  #undef STEP
  #undef STEP_AB
  #undef STEP_BA
  #undef ENDW
}
#undef SBAR
#undef WAIT_BAR
}

constexpr int NWAVES = 8;
constexpr size_t MiB = 1u << 20;
constexpr size_t WS_CTL = 0, CTL_ZERO_BYTES = 1 * MiB;
constexpr size_t WS_MOD = 256 * 1024;
constexpr size_t WS_LAM = 1 * MiB;
constexpr size_t WS_LB16 = 1 * MiB + 4096;
constexpr size_t WS_WIN0 = 2 * MiB, WS_WGLU = 6 * MiB, WS_WOUT0 = 8 * MiB, WS_WKV = 10 * MiB, WS_WIN1 = 14 * MiB, WS_WOUT1 = 18 * MiB;
constexpr size_t WS_BTA = 20 * MiB;
constexpr size_t WS_BTB = 28 * MiB;
constexpr size_t WS_S0 = 48 * MiB, WS_S1 = 112 * MiB, WS_S2 = 176 * MiB, WS_S3 = 240 * MiB, WS_S4 = 304 * MiB, WS_S5 = 368 * MiB, WS_S6 = 432 * MiB, WS_END = 496 * MiB;
constexpr int CW_BAR = 4096;
constexpr int CW_TMO = 8, CW_SEAM = 16384, SEAM_BANK = 128 * 64;
constexpr size_t WS_XCH = 40 * MiB;
constexpr int RING_OFF = 0, RING_BYTES = 131072;
constexpr int LDSCTL_OFF = RING_BYTES, MISC_OFF = LDSCTL_OFF + 320;
constexpr int LDS_BYTES = 147456;

#define GAS __attribute__((address_space(1)))
#define LAS __attribute__((address_space(3)))
typedef unsigned v4u __attribute__((ext_vector_type(4)));
typedef GAS unsigned gu32;
#define RLX_AGENT __ATOMIC_RELAXED, __HIP_MEMORY_SCOPE_AGENT
#define LDS_WAIT() asm volatile("s_waitcnt lgkmcnt(0)" ::: "memory")
#define VM_WAIT() asm volatile("s_waitcnt vmcnt(0)" ::: "memory")

#define XB_TMO      128
#define XB_XCNT(j)  (256  + 64 * (j))
#define XB_XSUB(j)  (1280 + 64 * (j))
#define XB_XGEN(j)  (2304 + 64 * (j))
#define XB_TOP      3328
#define XB_TOPGEN   3392
#define XCD_BAR_WORDS 3456
#define XB_SPIN_CAP (1u << 18)
__device__ __forceinline__ unsigned xb_ld(unsigned* p)              { return __hip_atomic_load(p, __ATOMIC_RELAXED, __HIP_MEMORY_SCOPE_AGENT); }
__device__ __forceinline__ unsigned xb_add(unsigned* p, unsigned v) { return __hip_atomic_fetch_add(p, v, __ATOMIC_RELAXED, __HIP_MEMORY_SCOPE_AGENT); }
__device__ __forceinline__ unsigned xb_xcc_id() { return (unsigned)__builtin_amdgcn_s_getreg((3 << 11) | 20) & 0xFu; }
#define XB_SPIN(cond, bar) do { unsigned _sp = 0; while (cond) { __builtin_amdgcn_s_sleep(1); \
    if ((++_sp & 255u) == 0u) { if (xb_ld(&(bar)[XB_TMO])) break; if (_sp > XB_SPIN_CAP) { atomicAdd(&(bar)[XB_TMO], 1u); break; } } } } while (0)
struct XcdBarrier { unsigned* bar; unsigned x; volatile LAS unsigned* st; };
__device__ __forceinline__ XcdBarrier xcd_barrier_post(unsigned* bar, volatile LAS unsigned* st, int tid) {
    XcdBarrier b; b.bar = bar; b.x = xb_xcc_id(); b.st = st;
    if (tid == 0) (void)xb_add(&bar[XB_XCNT(b.x)], 1u);
    return b;
}
__device__ __forceinline__ void xcd_barrier_complete(unsigned* bar, unsigned x, unsigned& nloc, unsigned& nx) {
    const unsigned G = gridDim.x * gridDim.y * gridDim.z;
    unsigned sum, cnt, mine, sp = 0u;
    for (;;) {
        sum = 0u; cnt = 0u; mine = 0u;
#pragma unroll
        for (unsigned j = 0; j < 16; ++j) { const unsigned c = xb_ld(&bar[XB_XCNT(j)]); sum += c; cnt += (c > 0u) ? 1u : 0u; mine = (j == x) ? c : mine; }
        if (sum == G) break;
        __builtin_amdgcn_s_sleep(1);
        if ((++sp & 255u) == 0u) { if (xb_ld(&bar[XB_TMO])) break; if (sp > XB_SPIN_CAP) { atomicAdd(&bar[XB_TMO], 1u); break; } }
    }
    nloc = mine > 0u ? mine : 1u; nx = cnt > 0u ? cnt : 1u;
}
__device__ __forceinline__ void xcd_barrier(const XcdBarrier& b, int tid) {
    asm volatile("s_waitcnt vmcnt(0)" ::: "memory");
    __syncthreads();
    if (tid == 0) {
        unsigned* bar = b.bar;
        __builtin_amdgcn_s_waitcnt(0);
        unsigned nloc = b.st[0], nx = b.st[1];
        if (nloc == 0u) { xcd_barrier_complete(bar, b.x, nloc, nx); b.st[0] = nloc; b.st[1] = nx; }
        const unsigned old = xb_add(&bar[XB_XSUB(b.x)], 1u);
        const unsigned gen = old / nloc;
        if (old + 1u == (gen + 1u) * nloc) {
            __builtin_amdgcn_fence(__ATOMIC_RELEASE, "agent");
            asm volatile("s_waitcnt vmcnt(0)" ::: "memory");
            const unsigned og = xb_add(&bar[XB_TOP], 1u);
            const unsigned tg = og / nx;
            if (og + 1u == (tg + 1u) * nx) xb_add(&bar[XB_TOPGEN], 1u);
            else XB_SPIN(xb_ld(&bar[XB_TOPGEN]) == tg, bar);
            __builtin_amdgcn_fence(__ATOMIC_ACQUIRE, "agent");
            xb_add(&bar[XB_XGEN(b.x)], 1u);
            asm volatile("s_waitcnt vmcnt(0)" ::: "memory");
        } else {
            XB_SPIN(xb_ld(&bar[XB_XGEN(b.x)]) == gen, bar);
            __builtin_amdgcn_fence(__ATOMIC_ACQUIRE, "agent");
            asm volatile("s_waitcnt vmcnt(0)" ::: "memory");
        }
    }
    __syncthreads();
}

__device__ __forceinline__ void p0_transpose_item(const float* W, int K, int N, bf16_t* WT, int row_off, const float* kscale, LAS float* scr, int item, int lane) {
    const int nblk = N / 32, kb = item / nblk, nb = item % nblk, k0 = 64 * kb, n0 = 32 * nb;
    float tv[32];
#pragma unroll
    for (int i = 0; i < 32; ++i) tv[i] = NT_LD(W + (size_t)(k0 + 2 * i + (lane >> 5)) * N + n0 + (lane & 31));
#pragma unroll
    for (int i = 0; i < 32; ++i) { const int kk = 2 * i + (lane >> 5); float v = tv[i]; if (kscale) v *= kscale[k0 + kk]; scr[kk * 33 + (lane & 31)] = v; }
    LDS_WAIT(); asm volatile("" ::: "memory");
    const int c = lane & 7;
#pragma unroll
    for (int j = 0; j < 4; ++j) { const int n = (lane >> 3) + 8 * j; const LAS float* s = scr + (8 * c) * 33 + n;
        v4u o; o.x = pk2bf(s[0 * 33], s[1 * 33]); o.y = pk2bf(s[2 * 33], s[3 * 33]); o.z = pk2bf(s[4 * 33], s[5 * 33]); o.w = pk2bf(s[6 * 33], s[7 * 33]);
        *(GAS v4u*)(WT + (size_t)(row_off + n0 + n) * K + k0 + 8 * c) = o; }
    LDS_WAIT(); asm volatile("" ::: "memory");
}

__device__ __forceinline__ int lane_now_asm() { int r; asm volatile("v_mbcnt_lo_u32_b32 %0, -1, 0\n\tv_mbcnt_hi_u32_b32 %0, -1, %0" : "=v"(r)); return r; }
struct Args {
    const float* in[28]; float* out; unsigned char* ws;
    int ph_lo, ph_hi, use_bar, flags;
};

__global__ void __launch_bounds__(NWAVES * 64, 2) mega_fwd(Args args) {
    extern __shared__ __attribute__((aligned(16))) unsigned char lds_raw[];
    LAS unsigned char* lds = (LAS unsigned char*)lds_raw;
    volatile LAS unsigned* MISC = (volatile LAS unsigned*)(lds + MISC_OFF);
    const int wave = __builtin_amdgcn_readfirstlane((int)threadIdx.x >> 6);
#define LANE_NOW() lane_now_asm()
#define TID_NOW() (wave * 64 + LANE_NOW())
    const int G = gridDim.x; const int bx = blockIdx.x; const int vcu = (G % 8 == 0) ? (bx % 8) * (G / 8) + bx / 8 : bx;
    unsigned char* ws = args.ws;
    gu32* ctl = (gu32*)(ws + WS_CTL);
    const float* x = args.in[0]; const float* cvec = args.in[1]; const float* ada_w = args.in[2]; const float* ada_b = args.in[3];
    const float* g_pre = args.in[4]; const float* g_post = args.in[5];
    float* out = args.out;
    float* mod = (float*)(ws + WS_MOD); float* lamp = (float*)(ws + WS_LAM); float* lb16 = (float*)(ws + WS_LB16);
    bf16_t* Win0 = (bf16_t*)(ws + WS_WIN0); bf16_t* Wglu = (bf16_t*)(ws + WS_WGLU); bf16_t* Wout0 = (bf16_t*)(ws + WS_WOUT0); bf16_t* Wkv = (bf16_t*)(ws + WS_WKV);
    bf16_t* Win1 = (bf16_t*)(ws + WS_WIN1); bf16_t* Wout1 = (bf16_t*)(ws + WS_WOUT1); bf16_t* BtA = (bf16_t*)(ws + WS_BTA); bf16_t* BtB = (bf16_t*)(ws + WS_BTB);
    bf16_t* A0 = (bf16_t*)(ws + WS_S0); bf16_t* US = (bf16_t*)(ws + WS_S1); bf16_t* SZ = (bf16_t*)(ws + WS_S3); bf16_t* YG = (bf16_t*)(ws + WS_S4); float* EB = (float*)(ws + WS_S0);
    bf16_t* Y2 = (bf16_t*)(ws + WS_S0); bf16_t* YO = (bf16_t*)(ws + WS_S1); bf16_t* AKV = (bf16_t*)(ws + WS_S0); bf16_t* AIN1 = (bf16_t*)(ws + WS_S2);
    bf16_t* KB = (bf16_t*)(ws + WS_S3); bf16_t* VB = (bf16_t*)(ws + WS_S4); bf16_t* QB = (bf16_t*)(ws + WS_S5); bf16_t* SZ1 = (bf16_t*)(ws + WS_S6);
    bf16_t* O0 = (bf16_t*)(ws + WS_S0); bf16_t* O1 = (bf16_t*)(ws + WS_S1); bf16_t* OG = (bf16_t*)(ws + WS_S2); bf16_t* YO1 = (bf16_t*)(ws + WS_S0);

    for (int u = TID_NOW(); u < (LDS_BYTES - LDSCTL_OFF) / 4; u += NWAVES * 64) ((LAS unsigned*)(lds + LDSCTL_OFF))[u] = 0u;
    __syncthreads();
    XcdBarrier bar; bar.bar = (unsigned*)(ctl + CW_BAR); bar.x = 0; bar.st = nullptr;
    if (args.use_bar) bar = xcd_barrier_post((unsigned*)(ctl + CW_BAR), MISC + 8, TID_NOW());
    const int lo = args.ph_lo, hi = args.ph_hi;
#define IN(k) (lo <= (k) && (k) < hi)
#define REPS(k) (1 + ((REPEAT_MASK >> (k)) & 1))
#define SEAM(k) do { if (IN(k) && IN((k) + 1) && args.use_bar) xcd_barrier(bar, TID_NOW()); } while (0)
    const int gw = vcu * NWAVES + wave, NGW = G * NWAVES;
#define LANE_L() ({ int l_ = LANE_NOW(); asm volatile("" : "+v"(l_)); l_; })

    if (IN(0)) for (int rep_ = 0; rep_ < REPS(0); ++rep_) {
        const int tid = TID_NOW(), lane = tid & 63;
        for (int it = vcu; it < NGRP * 4; it += G) {
            const int g = it >> 2, qt = it & 3;
            LAS float* LBP = (LAS float*)(lds + RING_OFF);
            LAS float* BBR = LBP + 17 * 128;
            LAS float* CC = BBR + 64 * 32;
            LAS float* KM = CC + 16 * 130 + 12;
            __syncthreads();
            if (tid < 64) {
                const int p = tid;
                const float dt = expf(args.in[9][g]);
                const float lr = args.in[7][g * 64 + p], li = args.in[8][g * 64 + p];
                const float mag = expf(lr * dt); const float sn = sinf(li * dt), cs = cosf(li * dt);
                const float lbr = mag * cs, lbi = mag * sn;
                float pr = 1.f, pi = 0.f;
                for (int d = 0; d <= 16; ++d) { LBP[(d * 64 + p) * 2] = pr; LBP[(d * 64 + p) * 2 + 1] = pi; const float nr = pr * lbr - pi * lbi, ni = pr * lbi + pi * lbr; pr = nr; pi = ni; }
                if (qt == 0) { lb16[(g * 64 + p) * 2] = LBP[(16 * 64 + p) * 2]; lb16[(g * 64 + p) * 2 + 1] = LBP[(16 * 64 + p) * 2 + 1]; }
                const float nr = lbr - 1.0f, ni = lbi, den = lr * lr + li * li;
                const float cr = (nr * lr + ni * li) / den, ci = (ni * lr - nr * li) / den;
                for (int c = 0; c < 16; ++c) { const float br = args.in[10][(g * 64 + p) * 16 + c], bi = args.in[11][(g * 64 + p) * 16 + c];
                    BBR[(p * 16 + c) * 2] = cr * br - ci * bi; BBR[(p * 16 + c) * 2 + 1] = cr * bi + ci * br; }
            }
            for (int e = tid; e < 1024; e += 512) { const int co = e >> 6, p = e & 63; CC[(co * 65 + p) * 2] = args.in[12][(g * 16 + co) * 64 + p]; CC[(co * 65 + p) * 2 + 1] = args.in[13][(g * 16 + co) * 64 + p]; }
            __syncthreads();
            {
                const int pair = tid >> 1, hh = tid & 1, d = pair >> 4, co = pair & 15; float acc8[8];
#pragma unroll
                for (int j = 0; j < 8; ++j) acc8[j] = 0.f;
                for (int p = 0; p < 64; ++p) { const float cr = CC[(co * 65 + p) * 2], cim = CC[(co * 65 + p) * 2 + 1], lr = LBP[(d * 64 + p) * 2], lim = LBP[(d * 64 + p) * 2 + 1];
                    const float wr_ = cr * lr - cim * lim, wi_ = cr * lim + cim * lr; const LAS f32x4_t* bp = (const LAS f32x4_t*)(BBR + (p * 16 + 8 * hh) * 2);
#pragma unroll
                    for (int q4 = 0; q4 < 4; ++q4) { const f32x4_t bb = bp[q4]; acc8[2 * q4] += wr_ * bb.x - wi_ * bb.y; acc8[2 * q4 + 1] += wr_ * bb.z - wi_ * bb.w; } }
#pragma unroll
                for (int j = 0; j < 8; ++j) KM[(d * 16 + co) * 16 + 8 * hh + j] = acc8[j];
            }
            __syncthreads();
            for (int e = tid; e < 64 * 48; e += 512) {
                const int n = 64 * qt + e / 48, pc = e % 48, s = n >> 4, co = n & 15; float v[8];
                if (pc < 32) { const int s2 = pc >> 1, ci0 = (pc & 1) * 8;
#pragma unroll
                    for (int j = 0; j < 8; ++j) v[j] = (s2 <= s) ? KM[((s - s2) * 16 + co) * 16 + ci0 + j] : 0.f;
                } else { const int j0 = (pc - 32) * 8;
#pragma unroll
                    for (int jj = 0; jj < 4; ++jj) { const int p = (j0 >> 1) + jj; const float cr = CC[(co * 65 + p) * 2], cim = CC[(co * 65 + p) * 2 + 1], lr = LBP[((s + 1) * 64 + p) * 2], lim = LBP[((s + 1) * 64 + p) * 2 + 1];
                        v[2 * jj] = cr * lr - cim * lim; v[2 * jj + 1] = -(cr * lim + cim * lr); } }
                v4u o; o.x = pk2bf(v[0], v[1]); o.y = pk2bf(v[2], v[3]); o.z = pk2bf(v[4], v[5]); o.w = pk2bf(v[6], v[7]);
                *(GAS v4u*)(BtB + ((size_t)g * 256 + n) * 384 + pc * 8) = o; }
            for (int e = tid; e < 64 * 32; e += 512) {
                const int n = 64 * qt + (e >> 5), pc = e & 31; float v[8];
                if (n < 128) { const int p = n >> 1, ri = n & 1, s2 = pc >> 1, ci0 = (pc & 1) * 8; const float lr = LBP[((15 - s2) * 64 + p) * 2], lim = LBP[((15 - s2) * 64 + p) * 2 + 1];
#pragma unroll
                    for (int j = 0; j < 8; ++j) { const float br = BBR[(p * 16 + ci0 + j) * 2], bi = BBR[(p * 16 + ci0 + j) * 2 + 1]; v[j] = ri ? (lr * bi + lim * br) : (lr * br - lim * bi); }
                } else {
#pragma unroll
                    for (int j = 0; j < 8; ++j) v[j] = 0.f; }
                v4u o; o.x = pk2bf(v[0], v[1]); o.y = pk2bf(v[2], v[3]); o.z = pk2bf(v[4], v[5]); o.w = pk2bf(v[6], v[7]);
                *(GAS v4u*)(BtA + ((size_t)g * 256 + n) * 256 + pc * 8) = o; }
        }
        __syncthreads();
        {
            LAS float* scr = (LAS float*)(lds + RING_OFF + wave * 16384);
            constexpr int I_2K = (DM / 64) * (2048 / 32), I_1K = (DM / 64) * (1024 / 32);
            constexpr int NITEMS = 2 * I_2K + 5 * I_1K;
            for (int it = gw; it < NITEMS; it += NGW) {
                int r = it;
                if (r < I_2K) { p0_transpose_item(args.in[6], DM, 2048, Win0, 0, nullptr, scr, r, lane); continue; } r -= I_2K;
                if (r < I_2K) { p0_transpose_item(args.in[21], DM, 2048, Win1, 0, nullptr, scr, r, lane); continue; } r -= I_2K;
                if (r < I_1K) { p0_transpose_item(args.in[15], DM, 1024, Wglu, 0, nullptr, scr, r, lane); continue; } r -= I_1K;
                if (r < I_1K) { p0_transpose_item(args.in[17], DM, 1024, Wout0, 0, nullptr, scr, r, lane); continue; } r -= I_1K;
                if (r < I_1K) { p0_transpose_item(args.in[19], DM, 1024, Wkv, 0, args.in[18], scr, r, lane); continue; } r -= I_1K;
                if (r < I_1K) { p0_transpose_item(args.in[20], DM, 1024, Wkv, 1024, args.in[18], scr, r, lane); continue; } r -= I_1K;
                p0_transpose_item(args.in[27], DM, 1024, Wout1, 0, nullptr, scr, r, lane);
            }
        }
        if (!(args.flags & 1)) {
            __syncthreads();
            LAS float* sc = (LAS float*)(lds + RING_OFF);
            LAS float* red = sc + 8192;
            bool have = false;
            for (int it = vcu; it < 2 * 96; it += G) {
                if (!have) { for (int e = tid; e < 8192; e += 512) sc[e] = silu_f(cvec[e]); have = true; __syncthreads(); }
                const int l = it / 96, cc = it % 96, j = cc * 32 + (lane & 31), kh = lane >> 5;
                float acc[8];
#pragma unroll
                for (int b = 0; b < 8; ++b) acc[b] = 0.f;
                const float* wp = ada_w + ((size_t)l * 1024 + wave * 128 + kh) * 3072 + j;
                for (int k0 = 0; k0 < 64; k0 += 32) {
                    float w[32];
#pragma unroll
                    for (int kk = 0; kk < 32; ++kk) w[kk] = NT_LD(wp + (size_t)(2 * (k0 + kk)) * 3072);
#pragma unroll
                    for (int kk = 0; kk < 32; ++kk) {
#pragma unroll
                        for (int b = 0; b < 8; ++b) acc[b] += w[kk] * sc[b * 1024 + wave * 128 + 2 * (k0 + kk) + kh];
                        if ((kk & 3) == 3) asm volatile("" ::: "memory"); }
                }
#pragma unroll
                for (int b = 0; b < 8; ++b) { acc[b] += __shfl_xor(acc[b], 32); if (lane < 32) red[(wave * 8 + b) * 32 + lane] = acc[b]; }
                __syncthreads();
                if (tid < 256) { const int b = tid >> 5, jl = tid & 31; float sum = ada_b[l * 3072 + cc * 32 + jl];
#pragma unroll
                  for (int w = 0; w < 8; ++w) sum += red[(w * 8 + b) * 32 + jl];
                  mod[((size_t)(l * 8 + b)) * 3072 + cc * 32 + jl] = sum; }
                __syncthreads();
            }
            if (bx == 0 && tid == 0) lamp[0] = diff_lambda(args.in[22], args.in[23], args.in[24], args.in[25]);
        }
    }
    SEAM(0);
    if (IN(1)) for (int rep_ = 0; rep_ < REPS(1); ++rep_) e_norm0(x, mod, g_pre, A0, gw, NGW, LANE_L());
    SEAM(1);
#ifdef EXTRA_BARS
    if (args.use_bar) for (int eb = 0; eb < EXTRA_BARS; ++eb) xcd_barrier(bar, TID_NOW());
#endif
    if (IN(2)) for (int rep_ = 0; rep_ < REPS(2); ++rep_) {
        pg8::Gemm g = pg8::gemm_std(A0, DM, Win0, DM, DM); pg8::Order S; S.init(MTOK / 256, 2048 / 256, 1, G, bx);
        pg8::EpiRow8<pg8::F_In0> E{{US, SZ}};
        pg8::gemm_phase<pg8::EpiRow8<pg8::F_In0>, ALIGN_E>(lds + RING_OFF, g, S, E, TID_NOW());
    }
    SEAM(2);
#if SSM_FUSED
    if (IN(3)) {
        pg8::Gemm gA = pg8::gemm_std(US, US_P, BtA, 256, 256); gA.a_gstep = (size_t)NTILE * US_P * 2; gA.b_gstep = (size_t)256 * 256 * 2;
        pg8::Gemm gB = pg8::gemm_std(US, US_P, BtB, 384, 384); gB.a_gstep = (size_t)NTILE * US_P * 2; gB.b_gstep = (size_t)256 * 384 * 2;
        pg8::EpiScan ES{lb16, US, LDSCTL_OFF + 2048};
        pg8::EpiRow8<pg8::F_SsmB> EB2{{US, args.in[14], YG}};
        for (int uu = 0; (long)uu * G + bx < NGRP * NB; ++uu) {
            pg8::Order S; S.init(NTILE / 256, 1, NGRP, G, bx); S.only = uu;
            pg8::gemm_phase<pg8::EpiScan, false>(lds + RING_OFF, gA, S, ES, TID_NOW());
            pg8::gemm_phase<pg8::EpiRow8<pg8::F_SsmB>, false>(lds + RING_OFF, gB, S, EB2, TID_NOW());
        }
    }
    SEAM(5);
#else
    if (IN(3)) for (int rep_ = 0; rep_ < REPS(3); ++rep_) {
        pg8::Gemm g = pg8::gemm_std(US, US_P, BtA, 256, 256); g.a_gstep = (size_t)NTILE * US_P * 2; g.b_gstep = (size_t)256 * 256 * 2;
        pg8::Order S; S.init(NTILE / 256, 1, NGRP, G, bx);
        pg8::EpiRow8<pg8::F_SsmA> E{{EB}};
        pg8::gemm_phase<pg8::EpiRow8<pg8::F_SsmA>, ALIGN_E>(lds + RING_OFF, g, S, E, TID_NOW());
    }
    SEAM(3);
    if (IN(4)) for (int rep_ = 0; rep_ < REPS(4); ++rep_) {
        for (int it = vcu + G * wave; it < NB * NGRP; it += G * NWAVES) {
            const int b = it / NGRP, g = it % NGRP, p = LANE_L();
            const float lr = lb16[(g * 64 + p) * 2], li = lb16[(g * 64 + p) * 2 + 1];
            float sr = 0.f, si = 0.f;
            const float* ep = EB + ((size_t)g * NTILE + b * 256) * 128 + 2 * p;
            bf16_t* sp = US + us_off(g, b * 256, 256 + 2 * p);
            for (int t0 = 0; t0 < 256; t0 += 16) {
                float er[16], ei[16];
#pragma unroll
                for (int j = 0; j < 16; ++j) { const float2 e = *(const float2*)(ep + (size_t)(t0 + j) * 128); er[j] = e.x; ei[j] = e.y; }
#pragma unroll
                for (int j = 0; j < 16; ++j) { *(unsigned*)(sp + (size_t)(t0 + j) * US_P) = pk2bf(sr, si);
                    const float nr = lr * sr - li * si + er[j], ni = lr * si + li * sr + ei[j]; sr = nr; si = ni; }
            }
        }
    }
    SEAM(4);
    if (IN(5)) for (int rep_ = 0; rep_ < REPS(5); ++rep_) {
        pg8::Gemm g = pg8::gemm_std(US, US_P, BtB, 384, 384); g.a_gstep = (size_t)NTILE * US_P * 2; g.b_gstep = (size_t)256 * 384 * 2;
        pg8::Order S; S.init(NTILE / 256, 1, NGRP, G, bx);
        pg8::EpiRow8<pg8::F_SsmB> E{{US, args.in[14], YG}};
        pg8::gemm_phase<pg8::EpiRow8<pg8::F_SsmB>, ALIGN_E>(lds + RING_OFF, g, S, E, TID_NOW());
    }
    SEAM(5);
#endif
    if (IN(6)) for (int rep_ = 0; rep_ < REPS(6); ++rep_) {
        pg8::Gemm g = pg8::gemm_std(YG, DM, Wglu, DM, DM);
        g.a_rs = 32u; g.a_c16 = (unsigned)((size_t)NTILE * YG_P * 2); g.a_kstep = (size_t)4 * NTILE * YG_P * 2; g.a_tstep = (size_t)256 * 32;
        pg8::Order S; S.init(MTOK / 256, 1024 / 256, 1, G, bx);
        pg8::EpiRow8<pg8::F_Glu> E{{YG, SZ, args.in[16], Y2}};
        pg8::gemm_phase<pg8::EpiRow8<pg8::F_Glu>, ALIGN_E>(lds + RING_OFF, g, S, E, TID_NOW());
    }
    SEAM(6);
#if FUSE_EPI
    if (IN(7)) {
        pg8::Gemm g = pg8::gemm_std(Y2, DM, Wout0, DM, DM);
        for (int half = 0; half < 2; ++half) {
            pg8::Order S; S.init(MTOK / 512, 1024 / 256, 1, G, bx); S.pm_off = half * (MTOK / 512);
            pg8::PanelRms st1{(unsigned*)(ws + WS_XCH), (unsigned*)(ctl + CW_SEAM), (unsigned*)(ctl + CW_TMO), RMS_EPS};
            pg8::PanelRms st2{(unsigned*)(ws + WS_XCH + 1 * MiB), (unsigned*)(ctl + CW_SEAM + SEAM_BANK), (unsigned*)(ctl + CW_TMO), RMS_EPS};
            pg8::EpiMid E{x, out, AKV, AIN1, mod, g_post, g_pre + 1024, st1, st2};
            pg8::gemm_phase<pg8::EpiMid, false>(lds + RING_OFF, g, S, E, TID_NOW());
        }
    }
#else
    if (IN(7)) {
        pg8::Gemm g = pg8::gemm_std(Y2, DM, Wout0, DM, DM); pg8::Order S; S.init(MTOK / 256, 1024 / 256, 1, G, bx);
        pg8::EpiRow8<pg8::F_Plain> E{{YO}};
        pg8::gemm_phase<pg8::EpiRow8<pg8::F_Plain>, ALIGN_E>(lds + RING_OFF, g, S, E, TID_NOW());
    }
    SEAM(7);
    if (IN(8)) e_mid(x, YO, mod, g_post, g_pre, H1_RECOMP ? (float*)nullptr : out, AKV, AIN1, gw, NGW, LANE_L());
#endif
    SEAM(8);
    if (IN(9)) for (int rep_ = 0; rep_ < REPS(9); ++rep_) {
        { pg8::Gemm g = pg8::gemm_std(AKV, DM, Wkv, DM, DM); pg8::Order S; S.init(MTOK / 256, 2048 / 256, 1, G, bx);
          pg8::EpiRow8<pg8::F_Split> E{{KB, VB, 1.0f, 0}};
          pg8::gemm_phase<pg8::EpiRow8<pg8::F_Split>, ALIGN_E>(lds + RING_OFF, g, S, E, TID_NOW()); }
        { pg8::Gemm g = pg8::gemm_std(AIN1, DM, Win1, DM, DM); pg8::Order S; S.init(MTOK / 256, 2048 / 256, 1, G, bx);
          pg8::EpiRow8<pg8::F_Split> E{{QB, SZ1, QC2, 1}};
          pg8::gemm_phase<pg8::EpiRow8<pg8::F_Split>, ALIGN_E>(lds + RING_OFF, g, S, E, TID_NOW()); }
    }
    SEAM(9);
    if (IN(10)) {
#if ATTN_V128
#if ATTN_FUSE_POST
        { const float lam = __int_as_float(__builtin_amdgcn_readfirstlane(__float_as_int(lamp[0])));
          for (int i = 0;; ++i) {
            const long L = (long)i * G + vcu; if (L >= 64 * 16) break;
            const int pr = (int)(L % 256), qi = (int)(L / 256);
            const int bh = pr >> 2, j = pr & 3;
            const int qb = (qi & 1) ? (8 * (qi >> 1) + 7 - j) : (8 * (qi >> 1) + j);
            const int h = bh & 7, b = bh >> 3;
#pragma unroll 1
            for (int cc = 0; cc < 2; ++cc) attn3::attn_unit<8>(TID_NOW(), b, 2 * h + cc, h, qb, QB, KB, VB, O0, (char*)lds_raw + RING_OFF, cc, SZ1, args.in[26], lam, OG);
          } }
#else
        for (int i = 0;; ++i) {
            const long L = (long)i * G + vcu; if (L >= 128 * 16) break;
            const int pr = (int)(L % 256), qi = (int)(L / 256);
            const int combo = pr >> 1, j = pr & 1;
            const int k4 = qi >> 1; const int qb = (qi & 1) ? (4 * k4 + 3 - j) : (4 * k4 + j);
            const int c = combo & 1, h = (combo >> 1) & 7, b = combo >> 4;
            attn3::attn_unit<8>(TID_NOW(), b, 2 * h + c, h, qb, QB, KB, VB, c ? O1 : O0, (char*)lds_raw + RING_OFF, 0, SZ1, args.in[26], 0.f, OG);
        }
#endif
#else
        for (int i = 0;; ++i) {
            const long L = (long)i * G + vcu; if (L >= 256 * 16) break;
            const int combo = (int)(L % 256), qi = (int)(L / 256);
            const int qb = (qi & 1) ? (qi >> 1) : (15 - (qi >> 1));
            const int vh = combo & 1, c = (combo >> 1) & 1, h = (combo >> 2) & 7, b = combo >> 5;
            attn_body::attn_unit<8>(TID_NOW(), b, 2 * h + c, 2 * h + vh, qb, QB, KB, VB, c ? O1 : O0, (char*)lds_raw + RING_OFF);
        }
#endif
    }
    SEAM(10);
#if !(ATTN_V128 && ATTN_FUSE_POST)
    if (IN(11)) for (int rep_ = 0; rep_ < REPS(11); ++rep_) e_attn_post(O0, O1, SZ1, args.in[26], lamp[0], OG, gw, NGW, LANE_L());
    SEAM(11);
#endif
#if FUSE_EPI
    if (IN(12)) {
        pg8::Gemm g = pg8::gemm_std(OG, DM, Wout1, DM, DM);
        for (int half = 0; half < 2; ++half) {
            pg8::Order S; S.init(MTOK / 512, 1024 / 256, 1, G, bx); S.pm_off = half * (MTOK / 512);
            pg8::PanelRms st{(unsigned*)(ws + WS_XCH + 2 * MiB), (unsigned*)(ctl + CW_SEAM + 2 * SEAM_BANK), (unsigned*)(ctl + CW_TMO), RMS_EPS};
            pg8::EpiFinal E{out, out, mod + 8 * 3072, g_post + 1024, st};
            pg8::gemm_phase<pg8::EpiFinal, false>(lds + RING_OFF, g, S, E, TID_NOW());
        }
    }
#else
    if (IN(12)) {
        pg8::Gemm g = pg8::gemm_std(OG, DM, Wout1, DM, DM); pg8::Order S; S.init(MTOK / 256, 1024 / 256, 1, G, bx);
        pg8::EpiRow8<pg8::F_Plain> E{{YO1}};
        pg8::gemm_phase<pg8::EpiRow8<pg8::F_Plain>, ALIGN_E>(lds + RING_OFF, g, S, E, TID_NOW());
    }
    SEAM(12);
    if (IN(13)) { if (H1_RECOMP) e_final2(x, YO, YO1, out, mod, g_post, gw, NGW, LANE_L()); else e_final(out, YO1, mod, g_post, gw, NGW, LANE_L()); }
#endif
#undef IN
#undef SEAM
}

#ifndef FASTMASK
#define FASTMASK 0x3fff
#endif
#ifndef ONE_LAUNCH
#define ONE_LAUNCH 1
#endif
constexpr int NPHASE = 14;

extern "C" void kernel_launch(void* const* d_in, const int* in_sizes, int n_in, void* d_out, int out_size, void* d_ws, size_t ws_size, hipStream_t stream) {
    static int grid = 0;
    if (grid == 0) {
        if (n_in != 28 || out_size != MTOK * DM || ws_size < WS_END) { fprintf(stderr, "kernel_launch: unexpected shapes (n_in %d out %d ws %zu)\n", n_in, out_size, ws_size); grid = -1; return; }
        int dev = 0, cus = 0, per_cu = 0;
        if (hipGetDevice(&dev) != hipSuccess || hipDeviceGetAttribute(&cus, hipDeviceAttributeMultiprocessorCount, dev) != hipSuccess) { grid = -1; return; }
        if (hipFuncSetAttribute((const void*)mega_fwd, hipFuncAttributeMaxDynamicSharedMemorySize, LDS_BYTES) != hipSuccess) { fprintf(stderr, "kernel_launch: hipFuncSetAttribute failed\n"); grid = -1; return; }
        if (hipOccupancyMaxActiveBlocksPerMultiprocessor(&per_cu, (const void*)mega_fwd, NWAVES * 64, LDS_BYTES) != hipSuccess || per_cu < 1) { fprintf(stderr, "kernel_launch: occupancy query says %d\n", per_cu); }
        (void)hipGetLastError();
        grid = cus;
    }
    if (grid < 0) return;
    if (hipMemsetAsync((char*)d_ws + WS_CTL, 0, CTL_ZERO_BYTES, stream) != hipSuccess) { fprintf(stderr, "kernel_launch: memset failed\n"); return; }
    Args a{};
    for (int i = 0; i < 28; ++i) a.in[i] = (const float*)d_in[i];
    a.out = (float*)d_out; a.ws = (unsigned char*)d_ws;
#if ONE_LAUNCH
    a.ph_lo = 0; a.ph_hi = NPHASE; a.use_bar = 1; a.flags = 0;
    hipLaunchKernelGGL(mega_fwd, dim3(grid), dim3(NWAVES * 64), LDS_BYTES, stream, a);
#else
    const float* x = a.in[0]; unsigned char* ws = a.ws; float* out = a.out;
    float* mod = (float*)(ws + WS_MOD); float* lam = (float*)(ws + WS_LAM);
    bf16_t* A0 = (bf16_t*)(ws + WS_S0); bf16_t* US = (bf16_t*)(ws + WS_S1); bf16_t* SZ = (bf16_t*)(ws + WS_S3); bf16_t* YG = (bf16_t*)(ws + WS_S4);
    bf16_t* Y2 = (bf16_t*)(ws + WS_S0); bf16_t* YO = (bf16_t*)(ws + WS_S1); bf16_t* AKV = (bf16_t*)(ws + WS_S0); bf16_t* AIN1 = (bf16_t*)(ws + WS_S2);
    bf16_t* KB = (bf16_t*)(ws + WS_S3); bf16_t* VB = (bf16_t*)(ws + WS_S4); bf16_t* QB = (bf16_t*)(ws + WS_S5); bf16_t* SZ1 = (bf16_t*)(ws + WS_S6);
    bf16_t* O0 = (bf16_t*)(ws + WS_S0); bf16_t* O1 = (bf16_t*)(ws + WS_S1); bf16_t* OG = (bf16_t*)(ws + WS_S2); bf16_t* YO1 = (bf16_t*)(ws + WS_S0);
    const int EG = 2048;
    auto fast1 = [&](int lo, int hi, int flags) { a.ph_lo = lo; a.ph_hi = hi; a.use_bar = 0; a.flags = flags; hipLaunchKernelGGL(mega_fwd, dim3(grid), dim3(NWAVES * 64), LDS_BYTES, stream, a); };
    auto fast = [&](int lo, int hi, int flags) { fast1(lo, hi, flags); if (lo == EXTRA_PHASE) fast1(lo, hi, flags); };
    const unsigned FM = FASTMASK;
    if (FM & 1u) fast(0, 1, 0);
    else { fast(0, 1, 1); n_adaln<<<(2 * 8 * 3072 + 255) / 256, 256, 0, stream>>>(a.in[1], a.in[2], a.in[3], mod); n_lambda<<<1, 64, 0, stream>>>(a.in[22], a.in[23], a.in[24], a.in[25], lam); }
    if (FM & 2u) fast(1, 2, 0); else n_norm0<<<EG, 256, 0, stream>>>(x, mod, a.in[4], A0);
    if (FM & 4u) fast(2, 3, 0); else n_gemm<<<dim3(2048 / 64, MTOK / 64), 256, 0, stream>>>(AL_Row{A0}, WL_Plain{a.in[6], 2048}, EP_In0{US, SZ}, 2048);
    if (FM & 8u) { fast(3, 4, 0); fast(4, 5, 0); fast(5, 6, 0); }
    else n_ssm<<<NB * NGRP / 4, 256, 0, stream>>>(US, a.in[7], a.in[8], a.in[9], a.in[10], a.in[11], a.in[12], a.in[13], a.in[14], YG);
    if (FM & 64u) fast(6, 7, 0); else n_gemm<<<dim3(1024 / 64, MTOK / 64), 256, 0, stream>>>(AL_YG{YG}, WL_Plain{a.in[15], 1024}, EP_Glu{YG, SZ, a.in[16], Y2}, 1024);
    if (FM & 128u) fast(7, 8, 0); else n_gemm<<<dim3(1024 / 64, MTOK / 64), 256, 0, stream>>>(AL_Row{Y2}, WL_Plain{a.in[17], 1024}, EP_Plain{YO}, 1024);
    if (FM & 256u) fast(8, 9, 0); else n_mid<<<EG, 256, 0, stream>>>(x, YO, mod, a.in[5], a.in[4], out, AKV, AIN1);
    if (FM & 512u) fast(9, 10, 0);
    else { n_gemm<<<dim3(2048 / 64, MTOK / 64), 256, 0, stream>>>(AL_Row{AKV}, WL_KV{a.in[19], a.in[20], a.in[18]}, EP_KV{KB, VB}, 2048);
           n_gemm<<<dim3(2048 / 64, MTOK / 64), 256, 0, stream>>>(AL_Row{AIN1}, WL_Plain{a.in[21], 2048}, EP_In1{QB, SZ1}, 2048); }
    if (FM & 1024u) fast(10, 11, 0); else n_attn<<<MTOK * 8 / 4, 256, 0, stream>>>(QB, KB, VB, O0, O1);
    if (FM & 2048u) fast(11, 12, 0); else n_attn_post<<<EG, 256, 0, stream>>>(O0, O1, SZ1, a.in[26], lam, OG);
    if (FM & 4096u) fast(12, 13, 0); else n_gemm<<<dim3(1024 / 64, MTOK / 64), 256, 0, stream>>>(AL_Row{OG}, WL_Plain{a.in[27], 1024}, EP_Plain{YO1}, 1024);
    if (FM & 8192u) fast(13, 14, 0); else n_final<<<EG, 256, 0, stream>>>(out, YO1, mod, a.in[5]);
#endif
    const hipError_t le = hipPeekAtLastError();
    if (le != hipSuccess) fprintf(stderr, "kernel_launch: launch failed: %s\n", hipGetErrorName(le));
}
```

```cpp
#include <hip/hip_runtime.h>
#include <cstdio>
#include <cstdint>
#include <cmath>
#define FASTMASK 0x3fff
#define ONE_LAUNCH 1
#define REPEAT_MASK 0

typedef unsigned short bf16_t;
constexpr int NB = 8, SEQL = 4096, DM = 1024, MTOK = NB * SEQL;
constexpr int NGRP = 64, NTILE = MTOK / 16;
constexpr int US_P = 384, YG_P = 256;
constexpr float LAMBDA_INIT = 0.35550907f;
constexpr float ONE_M_LI = 1.0f - LAMBDA_INIT;
constexpr float RMS_EPS = 1e-6f;
constexpr float QC2 = 0.125f * 1.4426950408889634f;

__device__ __forceinline__ float bf2f(bf16_t v) { return __uint_as_float((unsigned)v << 16); }
__device__ __forceinline__ unsigned f2bf_u(float f) { unsigned u = __float_as_uint(f); return (u + 0x7fffu + ((u >> 16) & 1u)) >> 16; }
__device__ __forceinline__ bf16_t f2bf(float f) { return (bf16_t)f2bf_u(f); }
__device__ __forceinline__ unsigned pk2bf(float lo, float hi) { return f2bf_u(lo) | (f2bf_u(hi) << 16); }
__device__ __forceinline__ float silu_f(float v) { return v / (1.0f + __expf(-v)); }
__device__ __forceinline__ float sigmoid_f(float v) { return 1.0f / (1.0f + __expf(-v)); }
__device__ __forceinline__ float gelu_tanh_f(float v) {
    const float u = 0.7978845608028654f * (v + 0.044715f * v * v * v);
    const float e = __expf(2.0f * u);
    const float t = 1.0f - 2.0f / (e + 1.0f);
    return 0.5f * v * (1.0f + t);
}
__device__ __forceinline__ float wave_sum_f(float v) {
#pragma unroll
    for (int o = 1; o < 64; o <<= 1) v += __shfl_xor(v, o);
    return v;
}
__device__ __forceinline__ float wave_max_f(float v) {
#pragma unroll
    for (int o = 1; o < 64; o <<= 1) v = fmaxf(v, __shfl_xor(v, o));
    return v;
}
__device__ __forceinline__ size_t us_off(int g, int tile, int col) { return ((size_t)g * NTILE + tile) * US_P + col; }
__device__ __forceinline__ size_t yg_off(int g, int tile, int col) { return ((size_t)g * NTILE + tile) * YG_P + col; }

typedef float f32x4_t __attribute__((ext_vector_type(4)));
typedef unsigned u32x4_t __attribute__((ext_vector_type(4)));
typedef unsigned u32x2_t __attribute__((ext_vector_type(2)));
#ifndef USE_NT
#define USE_NT 1
#endif
#if USE_NT
#define NT_LD(p) __builtin_nontemporal_load(p)
#define NT_ST(p, v) __builtin_nontemporal_store((v), (p))
#else
#define NT_LD(p) (*(p))
#define NT_ST(p, v) (*(p) = (v))
#endif

__device__ __forceinline__ void e_norm0(const float* __restrict__ x, const float* __restrict__ mod, const float* __restrict__ g_pre, bf16_t* a0, int gw, int ngw, int lane) {
    for (int m = gw; m < MTOK; m += ngw) {
        const int b = m / SEQL;
        const f32x4_t* xr = (const f32x4_t*)(x + (size_t)m * DM) + lane;
        f32x4_t v[4]; float s = 0.f;
#pragma unroll
        for (int j = 0; j < 4; ++j) { v[j] = NT_LD(xr + 64 * j); s += (v[j].x * v[j].x + v[j].y * v[j].y) + (v[j].z * v[j].z + v[j].w * v[j].w); }
        const float r = rsqrtf(wave_sum_f(s) * (1.0f / DM) + RMS_EPS);
        const float* sh = mod + (size_t)b * 3072; const float* sc = sh + 1024;
        u32x2_t* o = (u32x2_t*)(a0 + (size_t)m * DM) + lane;
#pragma unroll
        for (int j = 0; j < 4; ++j) {
            const int c = 256 * j + 4 * lane;
            const f32x4_t g = *(const f32x4_t*)(g_pre + c), scv = *(const f32x4_t*)(sc + c), shv = *(const f32x4_t*)(sh + c);
            f32x4_t y = v[j] * r * g * (scv + 1.0f) + shv;
            u32x2_t w; w.x = pk2bf(y.x, y.y); w.y = pk2bf(y.z, y.w); o[64 * j] = w;
        }
    }
}
__device__ __forceinline__ void e_mid(const float* __restrict__ x, const bf16_t* __restrict__ yo, const float* __restrict__ mod, const float* __restrict__ g_post, const float* __restrict__ g_pre,
                                      float* h1, bf16_t* h1b, bf16_t* akv, bf16_t* ain1, int gw, int ngw, int lane) {
    for (int m = gw; m < MTOK; m += ngw) {
        const int b = m / SEQL;
        const f32x4_t* xr = (const f32x4_t*)(x + (size_t)m * DM) + lane;
        const u32x2_t* yr = (const u32x2_t*)(yo + (size_t)m * DM) + lane;
        f32x4_t v[4], y[4]; float s = 0.f;
#pragma unroll
        for (int j = 0; j < 4; ++j) { v[j] = NT_LD(xr + 64 * j); const u32x2_t w = NT_LD(yr + 64 * j);
            y[j].x = __uint_as_float(w.x << 16); y[j].y = __uint_as_float(w.x & 0xffff0000u); y[j].z = __uint_as_float(w.y << 16); y[j].w = __uint_as_float(w.y & 0xffff0000u);
            s += (y[j].x * y[j].x + y[j].y * y[j].y) + (y[j].z * y[j].z + y[j].w * y[j].w); }
        const float ry = rsqrtf(wave_sum_f(s) * (1.0f / DM) + RMS_EPS);
        const float* gate0 = mod + (size_t)b * 3072 + 2048;
        const float* sh1 = mod + (size_t)(8 + b) * 3072; const float* sc1 = sh1 + 1024;
        float s2 = 0.f;
        f32x4_t* ho = (f32x4_t*)(h1 + (size_t)m * DM) + lane;
#pragma unroll
        for (int j = 0; j < 4; ++j) { const int c = 256 * j + 4 * lane;
            const f32x4_t gp = *(const f32x4_t*)(g_post + c), gt = *(const f32x4_t*)(gate0 + c);
            v[j] = v[j] + gt * (y[j] * ry * gp);
            if (h1) NT_ST(ho + 64 * j, v[j]);
            if (h1b) { u32x2_t wq; wq.x = pk2bf(v[j].x, v[j].y); wq.y = pk2bf(v[j].z, v[j].w); ((u32x2_t*)(h1b + (size_t)m * DM) + lane)[64 * j] = wq; }
            s2 += (v[j].x * v[j].x + v[j].y * v[j].y) + (v[j].z * v[j].z + v[j].w * v[j].w); }
        const float rh = rsqrtf(wave_sum_f(s2) * (1.0f / DM) + RMS_EPS);
        u32x2_t* o1 = (u32x2_t*)(akv + (size_t)m * DM) + lane; u32x2_t* o2 = (u32x2_t*)(ain1 + (size_t)m * DM) + lane;
#pragma unroll
        for (int j = 0; j < 4; ++j) { const int c = 256 * j + 4 * lane;
            const f32x4_t n = v[j] * rh;
            u32x2_t w; w.x = pk2bf(n.x, n.y); w.y = pk2bf(n.z, n.w); o1[64 * j] = w;
            const f32x4_t g = *(const f32x4_t*)(g_pre + 1024 + c), scv = *(const f32x4_t*)(sc1 + c), shv = *(const f32x4_t*)(sh1 + c);
            const f32x4_t z = n * g * (scv + 1.0f) + shv;
            w.x = pk2bf(z.x, z.y); w.y = pk2bf(z.z, z.w); o2[64 * j] = w; }
    }
}
__device__ __forceinline__ void e_attn_post(const bf16_t* __restrict__ o0, const bf16_t* __restrict__ o1, const bf16_t* __restrict__ sz1, const float* __restrict__ g_sub, float lam,
                                            bf16_t* og, int gw, int ngw, int lane) {
    for (int m = gw; m < MTOK; m += ngw) {
#pragma unroll
        for (int j = 0; j < 2; ++j) {
            const int c = 512 * j + 8 * lane;
            const u32x4_t a = *(const u32x4_t*)(o0 + (size_t)m * DM + c), bq = *(const u32x4_t*)(o1 + (size_t)m * DM + c), zq = *(const u32x4_t*)(sz1 + (size_t)m * DM + c);
            float d[8]; float s = 0.f;
#pragma unroll
            for (int i = 0; i < 4; ++i) { const unsigned wa = a[i], wb = bq[i];
                d[2 * i] = __uint_as_float(wa << 16) - lam * __uint_as_float(wb << 16); d[2 * i + 1] = __uint_as_float(wa & 0xffff0000u) - lam * __uint_as_float(wb & 0xffff0000u);
                s += d[2 * i] * d[2 * i] + d[2 * i + 1] * d[2 * i + 1]; }
            s += __shfl_xor(s, 1); s += __shfl_xor(s, 2); s += __shfl_xor(s, 4); s += __shfl_xor(s, 8);
            const float r = rsqrtf(s * (1.0f / 128.0f) + RMS_EPS) * ONE_M_LI;
            const float* gs = g_sub + (c & 127);
            u32x4_t w;
#pragma unroll
            for (int i = 0; i < 4; ++i) { const unsigned wz = zq[i];
                const float z0 = __uint_as_float(wz << 16), z1 = __uint_as_float(wz & 0xffff0000u);
                w[i] = pk2bf(d[2 * i] * r * gs[2 * i] * z0, d[2 * i + 1] * r * gs[2 * i + 1] * z1); }
            *(u32x4_t*)(og + (size_t)m * DM + c) = w;
        }
    }
}
__device__ __forceinline__ void e_final(float* out, const bf16_t* __restrict__ yo1, const float* __restrict__ mod, const float* __restrict__ g_post, int gw, int ngw, int lane) {
    for (int m = gw; m < MTOK; m += ngw) {
        const int b = m / SEQL;
        f32x4_t* hr = (f32x4_t*)(out + (size_t)m * DM) + lane;
        const u32x2_t* yr = (const u32x2_t*)(yo1 + (size_t)m * DM) + lane;
        f32x4_t v[4], y[4]; float s = 0.f;
#pragma unroll
        for (int j = 0; j < 4; ++j) { v[j] = NT_LD(hr + 64 * j); const u32x2_t w = NT_LD(yr + 64 * j);
            y[j].x = __uint_as_float(w.x << 16); y[j].y = __uint_as_float(w.x & 0xffff0000u); y[j].z = __uint_as_float(w.y << 16); y[j].w = __uint_as_float(w.y & 0xffff0000u);
            s += (y[j].x * y[j].x + y[j].y * y[j].y) + (y[j].z * y[j].z + y[j].w * y[j].w); }
        const float ry = rsqrtf(wave_sum_f(s) * (1.0f / DM) + RMS_EPS);
        const float* gate1 = mod + (size_t)(8 + b) * 3072 + 2048;
#pragma unroll
        for (int j = 0; j < 4; ++j) { const int c = 256 * j + 4 * lane;
            const f32x4_t gp = *(const f32x4_t*)(g_post + 1024 + c), gt = *(const f32x4_t*)(gate1 + c);
            NT_ST(hr + 64 * j, v[j] + gt * (y[j] * ry * gp)); }
    }
}
__device__ __forceinline__ void e_final2(const float* __restrict__ x, const bf16_t* __restrict__ yo, const bf16_t* __restrict__ yo1, float* out, const float* __restrict__ mod, const float* __restrict__ g_post, int gw, int ngw, int lane) {
    for (int m = gw; m < MTOK; m += ngw) {
        const int b = m / SEQL;
        const f32x4_t* xr = (const f32x4_t*)(x + (size_t)m * DM) + lane;
        const u32x2_t* y0r = (const u32x2_t*)(yo + (size_t)m * DM) + lane; const u32x2_t* y1r = (const u32x2_t*)(yo1 + (size_t)m * DM) + lane;
        f32x4_t v[4], y0[4], y1[4]; float s0 = 0.f, s1 = 0.f;
#pragma unroll
        for (int j = 0; j < 4; ++j) { v[j] = xr[64 * j]; const u32x2_t w0 = y0r[64 * j], w1 = y1r[64 * j];
            y0[j].x = __uint_as_float(w0.x << 16); y0[j].y = __uint_as_float(w0.x & 0xffff0000u); y0[j].z = __uint_as_float(w0.y << 16); y0[j].w = __uint_as_float(w0.y & 0xffff0000u);
            y1[j].x = __uint_as_float(w1.x << 16); y1[j].y = __uint_as_float(w1.x & 0xffff0000u); y1[j].z = __uint_as_float(w1.y << 16); y1[j].w = __uint_as_float(w1.y & 0xffff0000u);
            s0 += (y0[j].x * y0[j].x + y0[j].y * y0[j].y) + (y0[j].z * y0[j].z + y0[j].w * y0[j].w);
            s1 += (y1[j].x * y1[j].x + y1[j].y * y1[j].y) + (y1[j].z * y1[j].z + y1[j].w * y1[j].w); }
        const float r0 = rsqrtf(wave_sum_f(s0) * (1.0f / DM) + RMS_EPS), r1 = rsqrtf(wave_sum_f(s1) * (1.0f / DM) + RMS_EPS);
        const float* gate0 = mod + (size_t)b * 3072 + 2048; const float* gate1 = mod + (size_t)(8 + b) * 3072 + 2048;
        f32x4_t* orow = (f32x4_t*)(out + (size_t)m * DM) + lane;
#pragma unroll
        for (int j = 0; j < 4; ++j) { const int c = 256 * j + 4 * lane;
            const f32x4_t gp0 = *(const f32x4_t*)(g_post + c), gt0 = *(const f32x4_t*)(gate0 + c), gp1 = *(const f32x4_t*)(g_post + 1024 + c), gt1 = *(const f32x4_t*)(gate1 + c);
            const f32x4_t h = v[j] + gt0 * (y0[j] * r0 * gp0);
            orow[64 * j] = h + gt1 * (y1[j] * r1 * gp1); }
    }
}
__device__ __forceinline__ void e_final_b(const bf16_t* __restrict__ h1b, float* out, const bf16_t* __restrict__ yo1, const float* __restrict__ mod, const float* __restrict__ g_post, int gw, int ngw, int lane) {
    for (int m = gw; m < MTOK; m += ngw) {
        const int b = m / SEQL;
        const u32x2_t* hr = (const u32x2_t*)(h1b + (size_t)m * DM) + lane;
        const u32x2_t* yr = (const u32x2_t*)(yo1 + (size_t)m * DM) + lane;
        f32x4_t v[4], y[4]; float s = 0.f;
#pragma unroll
        for (int j = 0; j < 4; ++j) { const u32x2_t hw = NT_LD(hr + 64 * j); const u32x2_t w = NT_LD(yr + 64 * j);
            v[j].x = __uint_as_float(hw.x << 16); v[j].y = __uint_as_float(hw.x & 0xffff0000u); v[j].z = __uint_as_float(hw.y << 16); v[j].w = __uint_as_float(hw.y & 0xffff0000u);
            y[j].x = __uint_as_float(w.x << 16); y[j].y = __uint_as_float(w.x & 0xffff0000u); y[j].z = __uint_as_float(w.y << 16); y[j].w = __uint_as_float(w.y & 0xffff0000u);
            s += (y[j].x * y[j].x + y[j].y * y[j].y) + (y[j].z * y[j].z + y[j].w * y[j].w); }
        const float ry = rsqrtf(wave_sum_f(s) * (1.0f / DM) + RMS_EPS);
        const float* gate1 = mod + (size_t)(8 + b) * 3072 + 2048;
        f32x4_t* orow = (f32x4_t*)(out + (size_t)m * DM) + lane;
#pragma unroll
        for (int j = 0; j < 4; ++j) { const int c = 256 * j + 4 * lane;
            const f32x4_t gp = *(const f32x4_t*)(g_post + 1024 + c), gt = *(const f32x4_t*)(gate1 + c);
            NT_ST(orow + 64 * j, v[j] + gt * (y[j] * ry * gp)); }
    }
}

#define ER 2
__device__ __forceinline__ void unpk4(const u32x2_t w, f32x4_t& y) { y.x = __uint_as_float(w.x << 16); y.y = __uint_as_float(w.x & 0xffff0000u); y.z = __uint_as_float(w.y << 16); y.w = __uint_as_float(w.y & 0xffff0000u); }
__device__ __forceinline__ float ssq4(const f32x4_t v) { return (v.x * v.x + v.y * v.y) + (v.z * v.z + v.w * v.w); }
__device__ __forceinline__ void e_norm0_r(const float* __restrict__ x, const float* __restrict__ mod, const float* __restrict__ g_pre, bf16_t* a0, int gw, int ngw, int lane) {
    for (int m0 = gw; m0 < MTOK; m0 += ER * ngw) {
        f32x4_t v[ER][4]; float s[ER];
#pragma unroll
        for (int r = 0; r < ER; ++r) { const int m = min(m0 + r * ngw, MTOK - 1); const f32x4_t* xr = (const f32x4_t*)(x + (size_t)m * DM) + lane;
#pragma unroll
            for (int j = 0; j < 4; ++j) v[r][j] = NT_LD(xr + 64 * j); }
#pragma unroll
        for (int r = 0; r < ER; ++r) { s[r] = 0.f;
#pragma unroll
            for (int j = 0; j < 4; ++j) s[r] += ssq4(v[r][j]); }
#pragma unroll
        for (int r = 0; r < ER; ++r) { const int m = m0 + r * ngw; if (m >= MTOK) break;
            const int b = m / SEQL; const float rr = rsqrtf(wave_sum_f(s[r]) * (1.0f / DM) + RMS_EPS);
            const float* sh = mod + (size_t)b * 3072; const float* sc = sh + 1024;
            u32x2_t* o = (u32x2_t*)(a0 + (size_t)m * DM) + lane;
#pragma unroll
            for (int j = 0; j < 4; ++j) { const int c = 256 * j + 4 * lane;
                const f32x4_t g = *(const f32x4_t*)(g_pre + c), scv = *(const f32x4_t*)(sc + c), shv = *(const f32x4_t*)(sh + c);
                const f32x4_t y = v[r][j] * rr * g * (scv + 1.0f) + shv;
                u32x2_t w; w.x = pk2bf(y.x, y.y); w.y = pk2bf(y.z, y.w); o[64 * j] = w; } }
    }
}
__device__ __forceinline__ void e_mid_r(const float* __restrict__ x, const bf16_t* __restrict__ yo, const float* __restrict__ mod, const float* __restrict__ g_post, const float* __restrict__ g_pre,
                                        float* h1, bf16_t* akv, bf16_t* ain1, int gw, int ngw, int lane) {
    for (int m0 = gw; m0 < MTOK; m0 += ER * ngw) {
        f32x4_t v[ER][4], y[ER][4]; float s[ER];
#pragma unroll
        for (int r = 0; r < ER; ++r) { const int m = min(m0 + r * ngw, MTOK - 1); const f32x4_t* xr = (const f32x4_t*)(x + (size_t)m * DM) + lane; const u32x2_t* yr = (const u32x2_t*)(yo + (size_t)m * DM) + lane;
#pragma unroll
            for (int j = 0; j < 4; ++j) { v[r][j] = NT_LD(xr + 64 * j); unpk4(NT_LD(yr + 64 * j), y[r][j]); } }
#pragma unroll
        for (int r = 0; r < ER; ++r) { s[r] = 0.f;
#pragma unroll
            for (int j = 0; j < 4; ++j) s[r] += ssq4(y[r][j]); }
#pragma unroll
        for (int r = 0; r < ER; ++r) { const int m = m0 + r * ngw; if (m >= MTOK) break;
            const int b = m / SEQL; const float ry = rsqrtf(wave_sum_f(s[r]) * (1.0f / DM) + RMS_EPS);
            const float* gate0 = mod + (size_t)b * 3072 + 2048; const float* sh1 = mod + (size_t)(8 + b) * 3072; const float* sc1 = sh1 + 1024;
            float s2 = 0.f; f32x4_t* ho = (f32x4_t*)(h1 + (size_t)m * DM) + lane;
#pragma unroll
            for (int j = 0; j < 4; ++j) { const int c = 256 * j + 4 * lane;
                const f32x4_t gp = *(const f32x4_t*)(g_post + c), gt = *(const f32x4_t*)(gate0 + c);
                v[r][j] = v[r][j] + gt * (y[r][j] * ry * gp); NT_ST(ho + 64 * j, v[r][j]); s2 += ssq4(v[r][j]); }
            const float rh = rsqrtf(wave_sum_f(s2) * (1.0f / DM) + RMS_EPS);
            u32x2_t* o1 = (u32x2_t*)(akv + (size_t)m * DM) + lane; u32x2_t* o2 = (u32x2_t*)(ain1 + (size_t)m * DM) + lane;
#pragma unroll
            for (int j = 0; j < 4; ++j) { const int c = 256 * j + 4 * lane;
                const f32x4_t nn = v[r][j] * rh; u32x2_t w; w.x = pk2bf(nn.x, nn.y); w.y = pk2bf(nn.z, nn.w); o1[64 * j] = w;
                const f32x4_t g = *(const f32x4_t*)(g_pre + 1024 + c), scv = *(const f32x4_t*)(sc1 + c), shv = *(const f32x4_t*)(sh1 + c);
                const f32x4_t z = nn * g * (scv + 1.0f) + shv; w.x = pk2bf(z.x, z.y); w.y = pk2bf(z.z, z.w); o2[64 * j] = w; } }
    }
}
__device__ __forceinline__ void e_final_r(float* out, const bf16_t* __restrict__ yo1, const float* __restrict__ mod, const float* __restrict__ g_post, int gw, int ngw, int lane) {
    for (int m0 = gw; m0 < MTOK; m0 += ER * ngw) {
        f32x4_t v[ER][4], y[ER][4]; float s[ER];
#pragma unroll
        for (int r = 0; r < ER; ++r) { const int m = min(m0 + r * ngw, MTOK - 1); const f32x4_t* hr = (const f32x4_t*)(out + (size_t)m * DM) + lane; const u32x2_t* yr = (const u32x2_t*)(yo1 + (size_t)m * DM) + lane;
#pragma unroll
            for (int j = 0; j < 4; ++j) { v[r][j] = NT_LD(hr + 64 * j); unpk4(NT_LD(yr + 64 * j), y[r][j]); } }
#pragma unroll
        for (int r = 0; r < ER; ++r) { s[r] = 0.f;
#pragma unroll
            for (int j = 0; j < 4; ++j) s[r] += ssq4(y[r][j]); }
#pragma unroll
        for (int r = 0; r < ER; ++r) { const int m = m0 + r * ngw; if (m >= MTOK) break;
            const int b = m / SEQL; const float ry = rsqrtf(wave_sum_f(s[r]) * (1.0f / DM) + RMS_EPS);
            const float* gate1 = mod + (size_t)(8 + b) * 3072 + 2048; f32x4_t* hr = (f32x4_t*)(out + (size_t)m * DM) + lane;
#pragma unroll
            for (int j = 0; j < 4; ++j) { const int c = 256 * j + 4 * lane;
                const f32x4_t gp = *(const f32x4_t*)(g_post + 1024 + c), gt = *(const f32x4_t*)(gate1 + c);
                NT_ST(hr + 64 * j, v[r][j] + gt * (y[r][j] * ry * gp)); } }
    }
}
__device__ __forceinline__ float diff_lambda(const float* lq1, const float* lk1, const float* lq2, const float* lk2) {
    float s1 = 0.f, s2 = 0.f;
    for (int i = 0; i < 64; ++i) { s1 += lq1[i] * lk1[i]; s2 += lq2[i] * lk2[i]; }
    return expf(s1) - expf(s2) + LAMBDA_INIT;
}

__global__ void n_adaln(const float* __restrict__ c, const float* __restrict__ ada_w, const float* __restrict__ ada_b, float* mod) {
    const int idx = blockIdx.x * 256 + threadIdx.x;
    if (idx >= 2 * 8 * 3072) return;
    const int j = idx % 3072, b = (idx / 3072) % 8, l = idx / (3072 * 8);
    float acc = ada_b[l * 3072 + j];
    const float* w = ada_w + (size_t)l * 1024 * 3072 + j; const float* cb = c + b * 1024;
    for (int k = 0; k < 1024; ++k) acc += silu_f(cb[k]) * w[(size_t)k * 3072];
    mod[idx] = acc;
}
__global__ void n_lambda(const float* lq1, const float* lk1, const float* lq2, const float* lk2, float* out) {
    if (threadIdx.x == 0 && blockIdx.x == 0) out[0] = diff_lambda(lq1, lk1, lq2, lk2);
}
__global__ void n_norm0(const float* x, const float* mod, const float* g_pre, bf16_t* a0) {
    e_norm0(x, mod, g_pre, a0, blockIdx.x * 4 + (threadIdx.x >> 6), gridDim.x * 4, threadIdx.x & 63);
}
__global__ void n_mid(const float* x, const bf16_t* yo, const float* mod, const float* g_post, const float* g_pre, float* h1, bf16_t* akv, bf16_t* ain1) {
    e_mid(x, yo, mod, g_post, g_pre, h1, (bf16_t*)nullptr, akv, ain1, blockIdx.x * 4 + (threadIdx.x >> 6), gridDim.x * 4, threadIdx.x & 63);
}
__global__ void n_attn_post(const bf16_t* o0, const bf16_t* o1, const bf16_t* sz1, const float* g_sub, const float* lamp, bf16_t* og) {
    e_attn_post(o0, o1, sz1, g_sub, lamp[0], og, blockIdx.x * 4 + (threadIdx.x >> 6), gridDim.x * 4, threadIdx.x & 63);
}
__global__ void n_final(float* out, const bf16_t* yo1, const float* mod, const float* g_post) {
    e_final(out, yo1, mod, g_post, blockIdx.x * 4 + (threadIdx.x >> 6), gridDim.x * 4, threadIdx.x & 63);
}

struct AL_Row { const bf16_t* A; __device__ float ld(int m, int k) const { return bf2f(A[(size_t)m * DM + k]); } };
struct AL_YG  { const bf16_t* A; __device__ float ld(int m, int k) const { return bf2f(A[yg_off(k >> 4, m >> 4, (m & 15) * 16 + (k & 15))]); } };
struct WL_Plain { const float* W; long N; __device__ float ld(int k, int n) const { return W[(size_t)k * N + n]; } };
struct WL_KV { const float* wk; const float* wv; const float* g; __device__ float ld(int k, int n) const { return g[k] * (n < 1024 ? wk[(size_t)k * 1024 + n] : wv[(size_t)k * 1024 + n - 1024]); } };
struct EP_In0 { bf16_t* US; bf16_t* SZ; __device__ void st(int m, int n, float a) const {
    if (n < 1024) US[us_off(n >> 4, m >> 4, (m & 15) * 16 + (n & 15))] = f2bf(a); else SZ[(size_t)m * DM + n - 1024] = f2bf(silu_f(a)); } };
struct EP_Glu { const bf16_t* YG; const bf16_t* SZ; const float* bias; bf16_t* Y2; __device__ void st(int m, int n, float a) const {
    const float yv = bf2f(YG[yg_off(n >> 4, m >> 4, (m & 15) * 16 + (n & 15))]); const float t = a + bias[n];
    Y2[(size_t)m * DM + n] = f2bf(yv * sigmoid_f(t) * bf2f(SZ[(size_t)m * DM + n])); } };
struct EP_Plain { bf16_t* O; __device__ void st(int m, int n, float a) const { O[(size_t)m * DM + n] = f2bf(a); } };
struct EP_KV { bf16_t* K; bf16_t* V; __device__ void st(int m, int n, float a) const { if (n < 1024) K[(size_t)m * DM + n] = f2bf(a); else V[(size_t)m * DM + n - 1024] = f2bf(a); } };
struct EP_In1 { bf16_t* Q; bf16_t* SZ1; __device__ void st(int m, int n, float a) const { if (n < 1024) Q[(size_t)m * DM + n] = f2bf(a * QC2); else SZ1[(size_t)m * DM + n - 1024] = f2bf(silu_f(a)); } };

template <class AL, class WL, class EP>
__global__ void __launch_bounds__(256) n_gemm(AL al, WL wl, EP ep, int N) {
    __shared__ float As[16][68]; __shared__ float Ws[16][68];
    const int tid = threadIdx.x, tx = tid & 15, ty = tid >> 4;
    const int m0 = blockIdx.y * 64, n0 = blockIdx.x * 64;
    float acc[4][4];
#pragma unroll
    for (int i = 0; i < 4; ++i)
#pragma unroll
        for (int j = 0; j < 4; ++j) acc[i][j] = 0.f;
    for (int k0 = 0; k0 < 1024; k0 += 16) {
#pragma unroll
        for (int i = 0; i < 4; ++i) { const int e = tid + 256 * i; const int mm = e >> 4, kk = e & 15; As[kk][mm] = al.ld(m0 + mm, k0 + kk); }
#pragma unroll
        for (int i = 0; i < 4; ++i) { const int e = tid + 256 * i; const int kk = e >> 6, nn = e & 63; Ws[kk][nn] = wl.ld(k0 + kk, n0 + nn); }
        __syncthreads();
#pragma unroll
        for (int kk = 0; kk < 16; ++kk) {
            float a[4], b[4];
#pragma unroll
            for (int i = 0; i < 4; ++i) { a[i] = As[kk][ty * 4 + i]; b[i] = Ws[kk][tx * 4 + i]; }
#pragma unroll
            for (int i = 0; i < 4; ++i)
#pragma unroll
                for (int j = 0; j < 4; ++j) acc[i][j] += a[i] * b[j];
        }
        __syncthreads();
    }
#pragma unroll
    for (int i = 0; i < 4; ++i)
#pragma unroll
        for (int j = 0; j < 4; ++j) ep.st(m0 + ty * 4 + i, n0 + tx * 4 + j, acc[i][j]);
}

__global__ void __launch_bounds__(256) n_ssm(const bf16_t* __restrict__ US, const float* lam_re, const float* lam_im, const float* log_dt, const float* b_re, const float* b_im,
                                             const float* c_re, const float* c_im, const float* d_skip, bf16_t* YG) {
    const int wv = blockIdx.x * 4 + (threadIdx.x >> 6), lane = threadIdx.x & 63;
    if (wv >= NB * NGRP) return;
    const int b = wv / NGRP, g = wv % NGRP, p = lane;
    const float dt = expf(log_dt[g]);
    const float lr = lam_re[g * 64 + p], li = lam_im[g * 64 + p];
    const float mag = expf(lr * dt); float sn, cs; sn = sinf(li * dt); cs = cosf(li * dt);
    const float lbr = mag * cs, lbi = mag * sn;
    const float nr = lbr - 1.0f, ni = lbi, den = lr * lr + li * li;
    const float cr = (nr * lr + ni * li) / den, ci = (ni * lr - nr * li) / den;
    float bbr[16], bbi[16], ccr[16], cci[16];
#pragma unroll
    for (int c = 0; c < 16; ++c) { const float br = b_re[(g * 64 + p) * 16 + c], bi = b_im[(g * 64 + p) * 16 + c];
        bbr[c] = cr * br - ci * bi; bbi[c] = cr * bi + ci * br;
        ccr[c] = c_re[(g * 16 + c) * 64 + p]; cci[c] = c_im[(g * 16 + c) * 64 + p]; }
    const float dsk = d_skip[g * 16 + (lane & 15)];
    float sr = 0.f, si = 0.f;
    for (int t = 0; t < SEQL; ++t) {
        const int m = b * SEQL + t;
        const bf16_t* up = US + us_off(g, m >> 4, (m & 15) * 16);
        float u[16];
        { const u32x4_t w0 = *(const u32x4_t*)up, w1 = *(const u32x4_t*)(up + 8);
#pragma unroll
          for (int i = 0; i < 4; ++i) { u[2 * i] = __uint_as_float(w0[i] << 16); u[2 * i + 1] = __uint_as_float(w0[i] & 0xffff0000u); u[8 + 2 * i] = __uint_as_float(w1[i] << 16); u[8 + 2 * i + 1] = __uint_as_float(w1[i] & 0xffff0000u); } }
        float bur = 0.f, bui = 0.f;
#pragma unroll
        for (int c = 0; c < 16; ++c) { bur += bbr[c] * u[c]; bui += bbi[c] * u[c]; }
        const float nsr = lbr * sr - lbi * si + bur, nsi = lbr * si + lbi * sr + bui; sr = nsr; si = nsi;
        float yv = 0.f;
#pragma unroll
        for (int c = 0; c < 16; ++c) { const float part = wave_sum_f(ccr[c] * sr - cci[c] * si); if ((lane & 15) == c) yv = part; }
        if (lane < 16) { const float yy = yv + dsk * bf2f(up[lane]); YG[yg_off(g, m >> 4, (m & 15) * 16 + lane)] = f2bf(gelu_tanh_f(yy)); }
    }
}

__global__ void __launch_bounds__(256) n_attn(const bf16_t* __restrict__ Q, const bf16_t* __restrict__ K, const bf16_t* __restrict__ V, bf16_t* O0, bf16_t* O1) {
    __shared__ float qs[4][128];
    const int w = threadIdx.x >> 6, lane = threadIdx.x & 63;
    const int gwv = blockIdx.x * 4 + w;
    const int h = gwv & 7, m = gwv >> 3, b = m / SEQL, qi = m % SEQL;
    qs[w][lane] = bf2f(Q[(size_t)m * DM + h * 128 + lane]); qs[w][64 + lane] = bf2f(Q[(size_t)m * DM + h * 128 + 64 + lane]);
    __syncthreads();
    float m0 = -1e30f, m1 = -1e30f, l0 = 0.f, l1 = 0.f, a00 = 0.f, a01 = 0.f, a10 = 0.f, a11 = 0.f;
    const size_t rb = (size_t)b * SEQL;
    for (int kc = 0; kc * 64 <= qi; ++kc) {
        const int key = kc * 64 + lane; const bool valid = key <= qi;
        float s0 = 0.f, s1 = 0.f;
        { const bf16_t* kr = K + (rb + (valid ? key : qi)) * DM + h * 128;
#pragma unroll
          for (int ch = 0; ch < 8; ++ch) { const u32x4_t w0 = *(const u32x4_t*)(kr + ch * 8), w1 = *(const u32x4_t*)(kr + 64 + ch * 8);
#pragma unroll
            for (int i = 0; i < 4; ++i) { s0 += qs[w][ch * 8 + 2 * i] * __uint_as_float(w0[i] << 16) + qs[w][ch * 8 + 2 * i + 1] * __uint_as_float(w0[i] & 0xffff0000u);
                                          s1 += qs[w][64 + ch * 8 + 2 * i] * __uint_as_float(w1[i] << 16) + qs[w][64 + ch * 8 + 2 * i + 1] * __uint_as_float(w1[i] & 0xffff0000u); } } }
        if (!valid) { s0 = -1e30f; s1 = -1e30f; }
        const float nm0 = fmaxf(m0, wave_max_f(s0)), nm1 = fmaxf(m1, wave_max_f(s1));
        const float f0 = exp2f(m0 - nm0), f1 = exp2f(m1 - nm1);
        const float p0 = valid ? exp2f(s0 - nm0) : 0.f, p1 = valid ? exp2f(s1 - nm1) : 0.f;
        l0 = l0 * f0 + wave_sum_f(p0); l1 = l1 * f1 + wave_sum_f(p1); m0 = nm0; m1 = nm1;
        a00 *= f0; a01 *= f0; a10 *= f1; a11 *= f1;
        const int nk = min(64, qi - kc * 64 + 1);
        for (int j = 0; j < nk; ++j) {
            const float pj0 = __shfl(p0, j), pj1 = __shfl(p1, j);
            const bf16_t* vr = V + (rb + kc * 64 + j) * DM + h * 128;
            const float v0 = bf2f(vr[lane]), v1 = bf2f(vr[64 + lane]);
            a00 += pj0 * v0; a01 += pj0 * v1; a10 += pj1 * v0; a11 += pj1 * v1;
        }
    }
    const float i0 = 1.0f / l0, i1 = 1.0f / l1;
    O0[(size_t)m * DM + h * 128 + lane] = f2bf(a00 * i0); O0[(size_t)m * DM + h * 128 + 64 + lane] = f2bf(a01 * i0);
    O1[(size_t)m * DM + h * 128 + lane] = f2bf(a10 * i1); O1[(size_t)m * DM + h * 128 + 64 + lane] = f2bf(a11 * i1);
}
#ifndef REPEAT_MASK
#define REPEAT_MASK 0
#endif
#ifndef ATTN_V128
#define ATTN_V128 1
#endif
#ifndef EXTRA_PHASE
#define EXTRA_PHASE -1
#endif
#ifndef ATTN_FUSE_POST
#define ATTN_FUSE_POST 1
#endif
#ifndef H1_RECOMP
#define H1_RECOMP 0
#endif
#ifndef SSM_FUSED
#define SSM_FUSED 1
#endif
#ifndef ATTN_PRIO
#define ATTN_PRIO 0
#endif
#ifndef H1_BF16
#define H1_BF16 0
#endif
#ifndef NT_OUT
#define NT_OUT 0
#endif
#if NT_OUT
#define ST_OUT(p, v) __builtin_nontemporal_store((v), (p))
#else
#define ST_OUT(p, v) (*(p) = (v))
#endif
#ifndef FUSE_EPI
#define FUSE_EPI 0
#endif
#ifndef ALIGN_E
#define ALIGN_E true
#endif
namespace pg8 {
#define PG8_LAS __attribute__((address_space(3)))
typedef short bf16x8 __attribute__((ext_vector_type(8)));
typedef float f32x4 __attribute__((ext_vector_type(4)));
typedef unsigned u32x4 __attribute__((ext_vector_type(4)));
constexpr int BM = 256, BK = 64, HALF = 128, HTB = HALF * BK * 2  , STAGE_BYTES = 8 * HTB, NXCD = 8, WGM = 8;

__host__ __device__ __forceinline__ int lds_byte(int r, int c) { const int st = (r >> 4) * 2 + (c >> 5), rr = r & 15, cc = c & 31, ob = rr * 64 + cc * 2; return st * 1024 + (ob ^ (((ob >> 9) & 1) << 5)); }
__host__ __device__ __forceinline__ void stage_rc(int b, int& R, int& C) { const int st = b / 1024, sb = b % 1024, swz = sb ^ (((sb >> 9) & 1) << 5); R = (st >> 1) * 16 + swz / 64; C = (st & 1) * 32 + (swz % 64) / 2; }
__host__ __device__ __forceinline__ int perm32(int rho) { const int n = rho >> 4, i = rho & 15; return 8 * (i >> 2) + 4 * n + (i & 3); }

struct Unit { int pm, pn, grp; };
struct Gemm {
    const char* A; const char* Bt; int nt, pad0;
    unsigned a_rs, a_c16; size_t a_kstep, a_tstep, a_gstep;
    unsigned b_rs, pad1; size_t b_tstep, b_gstep;
    __device__ __forceinline__ const char* abase(const Unit& u) const { return A + (size_t)u.grp * a_gstep + (size_t)u.pm * a_tstep; }
    __device__ __forceinline__ const char* bbase(const Unit& u) const { return Bt + (size_t)u.grp * b_gstep + (size_t)u.pn * b_tstep; }
};
__device__ __forceinline__ Gemm gemm_std(const void* A, int lda, const void* Bt, int ldb, int K) {
    Gemm g; g.A = (const char*)A; g.Bt = (const char*)Bt; g.nt = K / BK; g.pad0 = 0; g.a_rs = (unsigned)lda * 2u; g.a_c16 = 32u; g.a_kstep = BK * 2; g.a_tstep = (size_t)BM * lda * 2; g.a_gstep = 0;
    g.b_rs = (unsigned)ldb * 2u; g.pad1 = 0; g.b_tstep = (size_t)BM * ldb * 2; g.b_gstep = 0; return g;
}

struct Order {
    int nM, nN, nG, nwg, G, c, only, pm_off, mode2;
    __device__ __forceinline__ void init(int nM_, int nN_, int nG_, int G_, int c_) { nM = nM_; nN = nN_; nG = nG_; nwg = nM * nN * nG; G = G_; c = c_; only = -1; pm_off = 0; mode2 = 0; }
    __device__ __forceinline__ bool next(int i, Unit& u) const {
        if (only >= 0) { if (i > 0) return false; i = only; }
        const long L = (long)i * G + c; if (L >= nwg) return false;
        int wgid = (int)L; { const int q = nwg / NXCD, r = nwg % NXCD, xcd = wgid % NXCD, off = wgid / NXCD; wgid = (xcd < r ? xcd * (q + 1) : r * (q + 1) + (xcd - r) * q) + off; }
        if (mode2) {
            const int x = wgid >> 8, y = wgid & 255, bk = y >> 6, w2 = y & 63; u.grp = bk & 1; u.pm = (x * 2 + (bk >> 1)) * 8 + (w2 & 7); u.pn = w2 >> 3;
        } else
        { const int per = nM * nN; u.grp = wgid / per; const int w2 = wgid % per;
          const int nig = WGM * nN, gid = w2 / nig, fm = gid * WGM, gsz = (nM - fm) < WGM ? (nM - fm) : WGM;
          u.pm = pm_off + fm + ((w2 % nig) % gsz); u.pn = (w2 % nig) / gsz; }
        return true;
    }
};

__device__ __forceinline__ unsigned cvt_pk_bf16(float lo, float hi) { unsigned r; asm volatile("v_cvt_pk_bf16_f32 %0, %1, %2" : "=v"(r) : "v"(lo), "v"(hi)); return r; }
__device__ __forceinline__ u32x4 pack8(const f32x4 a, const f32x4 b) { u32x4 w; w.x = cvt_pk_bf16(a[0], a[1]); w.y = cvt_pk_bf16(a[2], a[3]); w.z = cvt_pk_bf16(b[0], b[1]); w.w = cvt_pk_bf16(b[2], b[3]); return w; }
__device__ __forceinline__ void unpack8(const u32x4 w, f32x4& a, f32x4& b) {
    a[0] = __uint_as_float(w.x << 16); a[1] = __uint_as_float(w.x & 0xffff0000u); a[2] = __uint_as_float(w.y << 16); a[3] = __uint_as_float(w.y & 0xffff0000u);
    b[0] = __uint_as_float(w.z << 16); b[1] = __uint_as_float(w.z & 0xffff0000u); b[2] = __uint_as_float(w.w << 16); b[3] = __uint_as_float(w.w & 0xffff0000u); }
__device__ __forceinline__ float fsilu(float v) { return v * __builtin_amdgcn_rcpf(1.0f + __expf(-v)); }
__device__ __forceinline__ float fsigm(float v) { return __builtin_amdgcn_rcpf(1.0f + __expf(-v)); }
__device__ __forceinline__ f32x4 silu4(f32x4 v) { f32x4 o; o[0] = fsilu(v[0]); o[1] = fsilu(v[1]); o[2] = fsilu(v[2]); o[3] = fsilu(v[3]); return o; }
__device__ __forceinline__ f32x4 sigm4(f32x4 v) { f32x4 o; o[0] = fsigm(v[0]); o[1] = fsigm(v[1]); o[2] = fsigm(v[2]); o[3] = fsigm(v[3]); return o; }
__device__ __forceinline__ float fgelu(float v) { const float u = 0.7978845608028654f * (v + 0.044715f * v * v * v); const float e = __expf(2.0f * u); return 0.5f * v * (2.0f - 2.0f * __builtin_amdgcn_rcpf(e + 1.0f)); }
__device__ __forceinline__ f32x4 gelu4(f32x4 v) { f32x4 o; o[0] = fgelu(v[0]); o[1] = fgelu(v[1]); o[2] = fgelu(v[2]); o[3] = fgelu(v[3]); return o; }

template <class F> struct EpiRow8 {
    static constexpr bool PERM = true, AFTER_DRAIN = false;
    F f;
    __device__ __forceinline__ void operator()(const f32x4 (&acc)[2][2][4][2], const Unit& u, int wr, int wc, int fr, int fq) const {
#pragma unroll
        for (int ai = 0; ai < 2; ++ai)
#pragma unroll
            for (int m = 0; m < 4; ++m) { const int row = u.pm * BM + ai * HALF + wr * 64 + m * 16 + fr;
#pragma unroll
                for (int bj = 0; bj < 2; ++bj) { const int col0 = u.pn * BM + bj * HALF + wc * 32 + 8 * fq; f.apply(u, row, col0, acc[ai][bj][m][0], acc[ai][bj][m][1]); } }
    }
};
struct F_In0 { bf16_t* US; bf16_t* SZ;
    __device__ __forceinline__ void apply(const Unit&, int row, int col0, f32x4 v0, f32x4 v1) const {
        if (col0 < 1024) ST_OUT((u32x4*)(US + us_off(col0 >> 4, row >> 4, (row & 15) * 16 + (col0 & 15))), pack8(v0, v1));
        else NT_ST((u32x4*)(SZ + (size_t)row * DM + (col0 - 1024)), pack8(silu4(v0), silu4(v1))); } };
struct F_SsmA { float* E;
    __device__ __forceinline__ void apply(const Unit& u, int row, int col0, f32x4 v0, f32x4 v1) const {
        if (col0 < 128) { float* p = E + ((size_t)u.grp * NTILE + row) * 128 + col0; *(f32x4*)p = v0; *(f32x4*)(p + 4) = v1; } } };
struct F_SsmB { const bf16_t* US; const float* dsk; bf16_t* YG;
    __device__ __forceinline__ void apply(const Unit& u, int row, int col0, f32x4 v0, f32x4 v1) const {
        const u32x4 uw = *(const u32x4*)(US + us_off(u.grp, row, col0)); f32x4 u0, u1; unpack8(uw, u0, u1);
        const float* d = dsk + u.grp * 16 + (col0 & 15); const f32x4 d0 = *(const f32x4*)d, d1 = *(const f32x4*)(d + 4);
        ST_OUT((u32x4*)(YG + yg_off(u.grp, row, col0)), pack8(gelu4(v0 + d0 * u0), gelu4(v1 + d1 * u1))); } };
struct F_Glu { const bf16_t* YG; const bf16_t* SZ; const float* bias; bf16_t* Y2;
    __device__ __forceinline__ void apply(const Unit&, int row, int col0, f32x4 v0, f32x4 v1) const {
        const u32x4 yw = *(const u32x4*)(YG + yg_off(col0 >> 4, row >> 4, (row & 15) * 16 + (col0 & 15))); f32x4 y0, y1; unpack8(yw, y0, y1);
        const u32x4 zw = NT_LD((const u32x4*)(SZ + (size_t)row * DM + col0)); f32x4 z0, z1; unpack8(zw, z0, z1);
        const f32x4 b0 = *(const f32x4*)(bias + col0), b1 = *(const f32x4*)(bias + col0 + 4);
        ST_OUT((u32x4*)(Y2 + (size_t)row * DM + col0), pack8(y0 * sigm4(v0 + b0) * z0, y1 * sigm4(v1 + b1) * z1)); } };
template <class F> struct EpiRow8L {
    static constexpr bool PERM = true, AFTER_DRAIN = false;
    F f;
    __device__ __forceinline__ void operator()(const f32x4 (&acc)[2][2][4][2], const Unit& u, int wr, int wc, int fr, int fq) const {
#pragma unroll
        for (int ai = 0; ai < 2; ++ai) {
            typename F::Pre pre[4][2];
#pragma unroll
            for (int m = 0; m < 4; ++m) { const int row = u.pm * BM + ai * HALF + wr * 64 + m * 16 + fr;
#pragma unroll
                for (int bj = 0; bj < 2; ++bj) { const int col0 = u.pn * BM + bj * HALF + wc * 32 + 8 * fq; f.load(u, row, col0, pre[m][bj]); } }
#pragma unroll
            for (int m = 0; m < 4; ++m) { const int row = u.pm * BM + ai * HALF + wr * 64 + m * 16 + fr;
#pragma unroll
                for (int bj = 0; bj < 2; ++bj) { const int col0 = u.pn * BM + bj * HALF + wc * 32 + 8 * fq; f.apply(u, row, col0, acc[ai][bj][m][0], acc[ai][bj][m][1], pre[m][bj]); } }
        }
    }
};
struct F_SsmB2 { const bf16_t* US; const float* dsk; bf16_t* YG;
    struct Pre { u32x4 uw; };
    __device__ __forceinline__ void load(const Unit& u, int row, int col0, Pre& p) const { p.uw = *(const u32x4*)(US + us_off(u.grp, row, col0)); }
    __device__ __forceinline__ void apply(const Unit& u, int row, int col0, f32x4 v0, f32x4 v1, const Pre& p) const {
        f32x4 u0, u1; unpack8(p.uw, u0, u1);
        const float* d = dsk + u.grp * 16 + (col0 & 15); const f32x4 d0 = *(const f32x4*)d, d1 = *(const f32x4*)(d + 4);
        *(u32x4*)(YG + yg_off(u.grp, row, col0)) = pack8(gelu4(v0 + d0 * u0), gelu4(v1 + d1 * u1)); } };
struct F_Glu2 { const bf16_t* YG; const bf16_t* SZ; const float* bias; bf16_t* Y2;
    struct Pre { u32x4 yw, zw; };
    __device__ __forceinline__ void load(const Unit&, int row, int col0, Pre& p) const {
        p.yw = *(const u32x4*)(YG + yg_off(col0 >> 4, row >> 4, (row & 15) * 16 + (col0 & 15))); p.zw = *(const u32x4*)(SZ + (size_t)row * DM + col0); }
    __device__ __forceinline__ void apply(const Unit&, int row, int col0, f32x4 v0, f32x4 v1, const Pre& p) const {
        f32x4 y0, y1, z0, z1; unpack8(p.yw, y0, y1); unpack8(p.zw, z0, z1);
        const f32x4 b0 = *(const f32x4*)(bias + col0), b1 = *(const f32x4*)(bias + col0 + 4);
        *(u32x4*)(Y2 + (size_t)row * DM + col0) = pack8(y0 * sigm4(v0 + b0) * z0, y1 * sigm4(v1 + b1) * z1); } };
struct F_Split2 { bf16_t* Olo[2]; bf16_t* Ohi[2];
    __device__ __forceinline__ void apply(const Unit& u, int row, int col0, f32x4 v0, f32x4 v1) const {
        if (u.grp == 0) { bf16_t* o = (col0 < 1024) ? Olo[0] + (size_t)row * DM + col0 : Ohi[0] + (size_t)row * DM + (col0 - 1024); ST_OUT((u32x4*)o, pack8(v0, v1)); }
        else if (col0 < 1024) NT_ST((u32x4*)(Olo[1] + (size_t)row * DM + col0), pack8(v0 * QC2, v1 * QC2));
        else NT_ST((u32x4*)(Ohi[1] + (size_t)row * DM + (col0 - 1024)), pack8(silu4(v0), silu4(v1))); } };
struct F_Plain { bf16_t* O;
    __device__ __forceinline__ void apply(const Unit&, int row, int col0, f32x4 v0, f32x4 v1) const { ST_OUT((u32x4*)(O + (size_t)row * DM + col0), pack8(v0, v1)); } };
struct F_Split { bf16_t* Olo; bf16_t* Ohi; float sc_lo; int silu_hi;
    __device__ __forceinline__ void apply(const Unit&, int row, int col0, f32x4 v0, f32x4 v1) const {
        if (col0 < 1024) *(u32x4*)(Olo + (size_t)row * DM + col0) = pack8(v0 * sc_lo, v1 * sc_lo);
        else { if (silu_hi) { NT_ST((u32x4*)(Ohi + (size_t)row * DM + (col0 - 1024)), pack8(silu4(v0), silu4(v1))); } else *(u32x4*)(Ohi + (size_t)row * DM + (col0 - 1024)) = pack8(v0, v1); } } };


struct PanelRms {
    unsigned* xbuf;
    unsigned* cnt;
    unsigned* tmo;
    float eps;
    __device__ __forceinline__ bool run(const f32x4 (&v)[2][2][4][2], const Unit& u, int wr, int wc, int fr, int fq, PG8_LAS unsigned char* lds, int wid, int lane) const {
        PG8_LAS float* P = (PG8_LAS float*)lds;
        PG8_LAS float* S = (PG8_LAS float*)(lds + 8192);
        PG8_LAS unsigned* flag = (PG8_LAS unsigned*)(lds + 8192 + 2048);
#pragma unroll
        for (int ai = 0; ai < 2; ++ai)
#pragma unroll
            for (int m = 0; m < 4; ++m) {
                float q = 0.f;
#pragma unroll
                for (int bj = 0; bj < 2; ++bj)
#pragma unroll
                    for (int n = 0; n < 2; ++n) { const f32x4 d = v[ai][bj][m][n]; q += (d[0] * d[0] + d[1] * d[1]) + (d[2] * d[2] + d[3] * d[3]); }
                q += __shfl_xor(q, 16); q += __shfl_xor(q, 32);
                if (fq == 0) P[(ai * HALF + wr * 64 + m * 16 + fr) * 4 + wc] = q;
            }
        asm volatile("s_waitcnt lgkmcnt(0)" ::: "memory"); __builtin_amdgcn_s_barrier(); asm volatile("" ::: "memory");
        const int row = wid * 32 + (lane & 31);
        if (lane < 32) {
            const float tot = (P[row * 4 + 0] + P[row * 4 + 1]) + (P[row * 4 + 2] + P[row * 4 + 3]);
            unsigned long long* slot = (unsigned long long*)xbuf + ((size_t)(u.pm * BM + row) * 4 + u.pn);
            __hip_atomic_store(slot, (unsigned long long)__float_as_uint(tot), __ATOMIC_RELAXED, __HIP_MEMORY_SCOPE_AGENT);
        }
        asm volatile("s_waitcnt vmcnt(0)" ::: "memory");
        if (lane == 0) __hip_atomic_fetch_add(cnt + 64 * u.pm, 1u, __ATOMIC_RELAXED, __HIP_MEMORY_SCOPE_AGENT);
        if (wid == 0) {
            bool dead = false; const unsigned long long t0 = __builtin_amdgcn_s_memrealtime(); const unsigned want = 32u;
            for (;;) {
                if ((unsigned)__builtin_amdgcn_readfirstlane(__hip_atomic_load(cnt + 64 * u.pm, __ATOMIC_RELAXED, __HIP_MEMORY_SCOPE_AGENT)) >= want) break;
                if (__builtin_amdgcn_s_memrealtime() - t0 > 2000000ull) { if (lane == 0) __hip_atomic_store(tmo, 1u, __ATOMIC_RELAXED, __HIP_MEMORY_SCOPE_AGENT); dead = true; break; }
                __builtin_amdgcn_s_sleep(2);
            }
            __builtin_amdgcn_fence(__ATOMIC_ACQUIRE, "agent");
            if (lane == 0) flag[0] = dead ? 1u : 0u;
        }
        asm volatile("s_waitcnt vmcnt(0) lgkmcnt(0)" ::: "memory"); __builtin_amdgcn_s_barrier(); asm volatile("" ::: "memory");
        const bool bad = flag[0] != 0u;
        if (lane < 32) {
            const unsigned long long* slot = (const unsigned long long*)xbuf + (size_t)(u.pm * BM + row) * 4; float t4[4];
#pragma unroll
            for (int t = 0; t < 4; ++t) t4[t] = __uint_as_float((unsigned)__hip_atomic_load(slot + t, __ATOMIC_RELAXED, __HIP_MEMORY_SCOPE_AGENT));
            S[row] = rsqrtf(((t4[0] + t4[1]) + (t4[2] + t4[3])) * (1.0f / 1024.0f) + eps);
        }
        asm volatile("s_waitcnt lgkmcnt(0)" ::: "memory"); __builtin_amdgcn_s_barrier(); asm volatile("" ::: "memory");
        return bad;
    }
};
struct EpiFinal {
    static constexpr bool PERM = false, AFTER_DRAIN = true;
    const float* base; float* out; const float* mod1; const float* gpost1; PanelRms st;
    __device__ __forceinline__ void fused(f32x4 (&acc)[2][2][4][2], const Unit& u, int wr, int wc, int fr, int fq, PG8_LAS unsigned char* lds, int wid, int lane) const {
        const PG8_LAS float* S = (const PG8_LAS float*)(lds + 8192);
        const int col0 = u.pn * BM + wc * 32 + 4 * fq; const int b = u.pm >> 4;
        const float* gate = mod1 + (size_t)b * 3072 + 2048;
        const bool bad = st.run(acc, u, wr, wc, fr, fq, lds, wid, lane);
        const float qnan = __builtin_nanf("");
        f32x4 gg[2][2];
#pragma unroll
        for (int bj = 0; bj < 2; ++bj)
#pragma unroll
            for (int n = 0; n < 2; ++n) gg[bj][n] = *(const f32x4*)(gate + col0 + bj * HALF + n * 16) * *(const f32x4*)(gpost1 + col0 + bj * HALF + n * 16);
#pragma unroll
        for (int ai = 0; ai < 2; ++ai)
#pragma unroll
            for (int m = 0; m < 4; ++m) { const int r = ai * HALF + wr * 64 + m * 16 + fr; const float sr = S[r]; const size_t off = (size_t)(u.pm * BM + r) * DM + col0;
#pragma unroll
                for (int bj = 0; bj < 2; ++bj)
#pragma unroll
                    for (int n = 0; n < 2; ++n) { const f32x4 bs = *(const f32x4*)(base + off + bj * HALF + n * 16); f32x4 o = bs + gg[bj][n] * (acc[ai][bj][m][n] * sr);
                        if (bad) o = (f32x4){qnan, qnan, qnan, qnan}; *(f32x4*)(out + off + bj * HALF + n * 16) = o; }
                if (m & 1) asm volatile("" ::: "memory"); }
    }
};
struct EpiMid {
    static constexpr bool PERM = false, AFTER_DRAIN = true;
    const float* x; float* out; bf16_t* akv; bf16_t* ain1; const float* mod; const float* gpost0; const float* gpre1; PanelRms st1, st2;
    __device__ __forceinline__ void fused(f32x4 (&acc)[2][2][4][2], const Unit& u, int wr, int wc, int fr, int fq, PG8_LAS unsigned char* lds, int wid, int lane) const {
        typedef unsigned u32x2v __attribute__((ext_vector_type(2)));
        const PG8_LAS float* S = (const PG8_LAS float*)(lds + 8192);
        const int col0 = u.pn * BM + wc * 32 + 4 * fq; const int b = u.pm >> 4;
        const float* gate0 = mod + (size_t)b * 3072 + 2048; const float* sh1 = mod + (size_t)(8 + b) * 3072; const float* sc1 = sh1 + 1024;
        bool bad = st1.run(acc, u, wr, wc, fr, fq, lds, wid, lane);
        {
            f32x4 gg[2][2];
#pragma unroll
            for (int bj = 0; bj < 2; ++bj)
#pragma unroll
                for (int n = 0; n < 2; ++n) gg[bj][n] = *(const f32x4*)(gate0 + col0 + bj * HALF + n * 16) * *(const f32x4*)(gpost0 + col0 + bj * HALF + n * 16);
#pragma unroll
            for (int ai = 0; ai < 2; ++ai)
#pragma unroll
                for (int m = 0; m < 4; ++m) { const int r = ai * HALF + wr * 64 + m * 16 + fr; const float sr = S[r]; const size_t off = (size_t)(u.pm * BM + r) * DM + col0;
#pragma unroll
                    for (int bj = 0; bj < 2; ++bj)
#pragma unroll
                        for (int n = 0; n < 2; ++n) { const f32x4 bs = *(const f32x4*)(x + off + bj * HALF + n * 16); acc[ai][bj][m][n] = bs + gg[bj][n] * (acc[ai][bj][m][n] * sr); }
                    asm volatile("" : "+v"(acc[ai][0][m][0]), "+v"(acc[ai][0][m][1]), "+v"(acc[ai][1][m][0]), "+v"(acc[ai][1][m][1]));
                    if (m & 1) asm volatile("" ::: "memory"); }
        }
        bad = st2.run(acc, u, wr, wc, fr, fq, lds, wid, lane) || bad;
        const float qnan = __builtin_nanf("");
#pragma unroll
        for (int bj = 0; bj < 2; ++bj)
#pragma unroll
            for (int n = 0; n < 2; ++n) { const int c = col0 + bj * HALF + n * 16;
                const f32x4 gf = *(const f32x4*)(gpre1 + c) * (*(const f32x4*)(sc1 + c) + 1.0f), sh = *(const f32x4*)(sh1 + c);
#pragma unroll
                for (int ai = 0; ai < 2; ++ai)
#pragma unroll
                    for (int m = 0; m < 4; ++m) { const int r = ai * HALF + wr * 64 + m * 16 + fr; const float sr = S[r]; const size_t off = (size_t)(u.pm * BM + r) * DM + c;
                        f32x4 h = acc[ai][bj][m][n]; if (bad) h = (f32x4){qnan, qnan, qnan, qnan};
                        *(f32x4*)(out + off) = h;
                        const f32x4 nr = h * sr; u32x2v w; w.x = cvt_pk_bf16(nr[0], nr[1]); w.y = cvt_pk_bf16(nr[2], nr[3]); *(u32x2v*)(akv + off) = w;
                        const f32x4 z = nr * gf + sh; w.x = cvt_pk_bf16(z[0], z[1]); w.y = cvt_pk_bf16(z[2], z[3]); *(u32x2v*)(ain1 + off) = w; }
                asm volatile("" ::: "memory"); }
    }
};

struct EpiScan {
    static constexpr bool PERM = true, AFTER_DRAIN = true;
    const float* lb16; bf16_t* US; int carry_off;
    __device__ __forceinline__ void fused(f32x4 (&acc)[2][2][4][2], const Unit& u, int wr, int wc, int fr, int fq, PG8_LAS unsigned char* lds, int wid, int lane) const {
#pragma unroll
        for (int ai = 0; ai < 2; ++ai)
#pragma unroll
            for (int m = 0; m < 4; ++m) { const int row = ai * HALF + wr * 64 + m * 16 + fr; const int ch = (wc * 32 + 8 * fq) >> 2;
                *(PG8_LAS f32x4*)(lds + row * 512 + ((ch ^ (row & 7)) << 4)) = acc[ai][0][m][0];
                *(PG8_LAS f32x4*)(lds + row * 512 + (((ch + 1) ^ (row & 7)) << 4)) = acc[ai][0][m][1]; }
        asm volatile("s_waitcnt lgkmcnt(0)" ::: "memory"); __builtin_amdgcn_s_barrier(); asm volatile("" ::: "memory");
        const int p = lane, g = u.grp, b = u.pm;
        const float lr = lb16[(g * 64 + p) * 2], li = lb16[(g * 64 + p) * 2 + 1];
        typedef float f32x2v __attribute__((ext_vector_type(2)));
        const int coff = ((p >> 1) << 4) + (p & 1) * 8;
        float sr = 0.f, si = 0.f;
#pragma unroll 8
        for (int j = 0; j < 32; ++j) { const int t = wid * 32 + j; const f32x2v e = *(const PG8_LAS f32x2v*)(lds + t * 512 + (coff ^ ((t & 7) << 4)));
            const float nr = lr * sr - li * si + e.x, ni = lr * si + li * sr + e.y; sr = nr; si = ni; }
        PG8_LAS f32x2v* C = (PG8_LAS f32x2v*)(lds + carry_off);
        C[wid * 64 + p] = (f32x2v){sr, si};
        float pr = lr, pi = li;
#pragma unroll
        for (int q = 0; q < 5; ++q) { const float nr = pr * pr - pi * pi, ni = 2.f * pr * pi; pr = nr; pi = ni; }
        asm volatile("s_waitcnt lgkmcnt(0)" ::: "memory"); __builtin_amdgcn_s_barrier(); asm volatile("" ::: "memory");
        sr = 0.f; si = 0.f;
        for (int v = 0; v < wid; ++v) { const f32x2v c = C[v * 64 + p]; const float nr = pr * sr - pi * si + c.x, ni = pr * si + pi * sr + c.y; sr = nr; si = ni; }
        bf16_t* sp = US + us_off(g, b * 256 + wid * 32, 256 + 2 * p);
#pragma unroll 8
        for (int j = 0; j < 32; ++j) { const int t = wid * 32 + j; const f32x2v e = *(const PG8_LAS f32x2v*)(lds + t * 512 + (coff ^ ((t & 7) << 4)));
            *(unsigned*)(sp + (size_t)j * US_P) = cvt_pk_bf16(sr, si);
            const float nr = lr * sr - li * si + e.x, ni = lr * si + li * sr + e.y; sr = nr; si = ni; }
        asm volatile("s_waitcnt vmcnt(0)" ::: "memory");
    }
};
template <class Epi, bool ALIGN_EPI>
__device__ __forceinline__ void gemm_phase(PG8_LAS unsigned char* lds, const Gemm g, const Order& S, const Epi& E, int tid_in) {
    int tid_ = tid_in; asm volatile("" : "+v"(tid_));
    const int tid = tid_, wid = __builtin_amdgcn_readfirstlane(tid >> 6), lane = tid & 63, wr = wid >> 2, wc = wid & 3, fr = lane & 15, fq = lane >> 4;
    const int nt = g.nt;
    unsigned voffA[2], voffB[2];
#pragma unroll
    for (int i = 0; i < 2; ++i) { int R, C; stage_rc(tid * 16 + i * 8192, R, C); const int Rb = Epi::PERM ? ((R & ~31) + perm32(R & 31)) : R;
        voffA[i] = (unsigned)R * g.a_rs + (unsigned)(C >> 4) * g.a_c16 + (unsigned)(C & 15) * 2u; voffB[i] = (unsigned)Rb * g.b_rs + (unsigned)C * 2u; }
    const size_t kstepA = g.a_kstep, kstepB = (size_t)(BK * 2);
    const size_t hstepA = (size_t)HALF * g.a_rs, hstepB = (size_t)HALF * g.b_rs;
    const unsigned ldsw = (unsigned)wid * 1024u;
    const int aoff = lds_byte(wr * 64 + fr, fq * 8), boff = lds_byte(wc * 32 + fr, fq * 8);
#define PG8_SA(b, h) (((b) * 2 + (h)) * HTB)
#define PG8_SB(b, h) ((4 + (b) * 2 + (h)) * HTB)
#define PG8_STAGE(bufoff, gbase, voff) do { _Pragma("unroll") for (int _i = 0; _i < 2; ++_i) \
        __builtin_amdgcn_global_load_lds((const unsigned*)((const char*)(gbase) + (voff)[_i]), (PG8_LAS unsigned*)(lds + (bufoff) + ldsw + _i * 8192), 16, 0, 0); } while (0)
#define PG8_LDA(dst, b, h) do { _Pragma("unroll") for (int m = 0; m < 4; ++m) _Pragma("unroll") for (int k = 0; k < 2; ++k) dst[m][k] = *(const PG8_LAS bf16x8*)(lds + PG8_SA(b, h) + aoff + m * 2048 + k * 1024); } while (0)
#define PG8_LDB(dst, b, h) do { _Pragma("unroll") for (int n = 0; n < 2; ++n) _Pragma("unroll") for (int k = 0; k < 2; ++k) dst[n][k] = *(const PG8_LAS bf16x8*)(lds + PG8_SB(b, h) + boff + n * 2048 + k * 1024); } while (0)
#define PG8_MMA(ai, bj, At, Bt) do { __builtin_amdgcn_s_setprio(1); _Pragma("unroll") for (int m = 0; m < 4; ++m) _Pragma("unroll") for (int n = 0; n < 2; ++n) _Pragma("unroll") for (int k = 0; k < 2; ++k) \
        acc[ai][bj][m][n] = __builtin_amdgcn_mfma_f32_16x16x32_bf16(Bt[n][k], At[m][k], acc[ai][bj][m][n], 0, 0, 0); __builtin_amdgcn_s_setprio(0); } while (0)
#define PG8_WAIT_V(n) asm volatile("s_waitcnt vmcnt(" #n ")" ::: "memory")
#define PG8_WAIT_L(n) asm volatile("s_waitcnt lgkmcnt(" #n ")" ::: "memory")
#define PG8_BAR __builtin_amdgcn_s_barrier()
#define PG8_SCHED __builtin_amdgcn_sched_barrier(0)
    Unit cur, nxt; int ui = 0;
    if (!S.next(0, cur)) return;
    f32x4 acc[2][2][4][2];
#pragma unroll
    for (int a = 0; a < 2; ++a)
#pragma unroll
        for (int b = 0; b < 2; ++b)
#pragma unroll
            for (int m = 0; m < 4; ++m)
#pragma unroll
                for (int n = 0; n < 2; ++n) acc[a][b][m][n] = (f32x4){0.f, 0.f, 0.f, 0.f};
    bf16x8 At[4][2], B0[2][2], B1[2][2];
    const char* cA = g.abase(cur); const char* cB = g.bbase(cur);
    PG8_STAGE(PG8_SB(0, 0), cB, voffB); PG8_STAGE(PG8_SB(0, 1), cB + hstepB, voffB); PG8_STAGE(PG8_SA(0, 0), cA, voffA); PG8_STAGE(PG8_SA(0, 1), cA + hstepA, voffA);
    if (wr == 1) PG8_BAR;
    PG8_WAIT_V(2); PG8_BAR;
    PG8_STAGE(PG8_SB(1, 0), cB + kstepB, voffB); PG8_STAGE(PG8_SA(1, 0), cA + kstepA, voffA); PG8_STAGE(PG8_SB(1, 1), cB + hstepB + kstepB, voffB);
    PG8_WAIT_V(6); PG8_BAR;
    for (;;) {
        const bool has_next = S.next(ui + 1, nxt);
        const char* nA = has_next ? g.abase(nxt) : cA; const char* nB = has_next ? g.bbase(nxt) : cB;
        for (int t = 0; t < nt; t += 2) {
            const bool last = (t == nt - 2);
            const char* a1 = cA + (size_t)(t + 1) * kstepA;
            const char* a2 = last ? nA : cA + (size_t)(t + 2) * kstepA; const char* b2 = last ? nB : cB + (size_t)(t + 2) * kstepB;
            const char* a3 = a2 + kstepA; const char* b3 = b2 + kstepB;
            PG8_LDB(B0, 0, 0); PG8_LDB(B1, 0, 1); PG8_SCHED; PG8_LDA(At, 0, 0); PG8_STAGE(PG8_SA(1, 1), a1 + hstepA, voffA);
            PG8_WAIT_V(8); PG8_WAIT_L(0); PG8_BAR; PG8_MMA(0, 0, At, B0); PG8_MMA(0, 1, At, B1); PG8_BAR; PG8_SCHED;
            PG8_LDA(At, 0, 1); PG8_STAGE(PG8_SB(0, 0), b2, voffB); PG8_STAGE(PG8_SB(0, 1), b2 + hstepB, voffB); PG8_STAGE(PG8_SA(0, 0), a2, voffA);
            PG8_WAIT_V(8); PG8_WAIT_L(0); PG8_BAR; PG8_MMA(1, 0, At, B0); PG8_MMA(1, 1, At, B1); PG8_BAR; PG8_SCHED;
            PG8_LDB(B0, 1, 0); PG8_LDB(B1, 1, 1); PG8_SCHED; PG8_LDA(At, 1, 0); PG8_STAGE(PG8_SA(0, 1), a2 + hstepA, voffA);
            PG8_WAIT_V(8); PG8_WAIT_L(0); PG8_BAR; PG8_MMA(0, 0, At, B0); PG8_MMA(0, 1, At, B1); PG8_BAR; PG8_SCHED;
            PG8_LDA(At, 1, 1); PG8_STAGE(PG8_SB(1, 0), b3, voffB); PG8_STAGE(PG8_SB(1, 1), b3 + hstepB, voffB); PG8_STAGE(PG8_SA(1, 0), a3, voffA);
            PG8_WAIT_V(8); PG8_WAIT_L(0); PG8_BAR; PG8_MMA(1, 0, At, B0); PG8_MMA(1, 1, At, B1); PG8_BAR; PG8_SCHED;
        }
        if constexpr (ALIGN_EPI) { if (wr == 0) PG8_BAR; }
        if constexpr (!Epi::AFTER_DRAIN) { E(acc, cur, wr, wc, fr, fq); }
        if (!has_next) break;
#pragma unroll
        for (int a = 0; a < 2; ++a)
#pragma unroll
            for (int b = 0; b < 2; ++b)
#pragma unroll
                for (int m = 0; m < 4; ++m)
#pragma unroll
                    for (int n = 0; n < 2; ++n) acc[a][b][m][n] = (f32x4){0.f, 0.f, 0.f, 0.f};
        cur = nxt; cA = nA; cB = nB; ++ui;
        if constexpr (ALIGN_EPI) { if (wr == 1) PG8_BAR; }
    }
    PG8_WAIT_V(0);
    if constexpr (!ALIGN_EPI) { if (wr == 0) PG8_BAR; }
    PG8_BAR;
    if constexpr (Epi::AFTER_DRAIN) { E.fused(acc, cur, wr, wc, fr, fq, lds, wid, lane); PG8_WAIT_L(0); PG8_BAR; }
#undef PG8_SA
#undef PG8_SB
#undef PG8_STAGE
#undef PG8_LDA
#undef PG8_LDB
#undef PG8_MMA
#undef PG8_WAIT_V
#undef PG8_WAIT_L
#undef PG8_BAR
#undef PG8_SCHED
}
}

namespace attn_body {
using bf16 = bf16_t;
using bf16x8 = __attribute__((ext_vector_type(8))) short;
using s16x4 = __attribute__((ext_vector_type(4))) short;
using f32x16 = __attribute__((ext_vector_type(16))) float;
using u32x4 = __attribute__((ext_vector_type(4))) unsigned;
constexpr int SEQ = SEQL, D = 64, DMA = 1024;
constexpr int NW = 8, QBLK = 32, QB = QBLK * NW, KVBLK = 64, NQB = SEQ / QB;
__device__ __forceinline__ int crow(int r, int hi) { return (r & 3) + 8 * (r >> 2) + 4 * hi; }
#define SBAR() __builtin_amdgcn_sched_barrier(0)
__device__ __forceinline__ void cmask(f32x16& p0, f32x16& p1, int jb, int qrel, int hi) {
  const float NEG = -INFINITY; int kb = 64 * jb + 4 * hi;
  #pragma unroll
  for (int r = 0; r < 16; ++r) { int kv = kb + (r & 3) + 8 * (r >> 2); if (kv > qrel) p0[r] = NEG; if (kv + 32 > qrel) p1[r] = NEG; }
}
constexpr int NSLOT = 3, SLOTB = 8192;
constexpr int LDS_K = 0, LDS_V = NSLOT * SLOTB, LDS_WS = 2 * NSLOT * SLOTB, LDS_OST = LDS_WS + NW * 64 * 4, LDS_BYTES = LDS_OST + NW * 4096;
__device__ __forceinline__ void glds16(const void* gsrc, unsigned lds_dst) { unsigned keep;
  asm volatile("s_mov_b32 %0, m0\n\ts_mov_b32 m0, %2\n\ts_nop 0\n\tglobal_load_lds_dwordx4 %1, off\n\ts_mov_b32 m0, %0" : "=&s"(keep) : "v"(gsrc), "s"(lds_dst) : "memory"); }
__device__ __forceinline__ float max3f(float a, float b, float c) { float r; asm("v_max3_f32 %0, %1, %2, %3" : "=v"(r) : "v"(a), "v"(b), "v"(c)); return r; }
__device__ __forceinline__ float max2f(float a, float b) { float r; asm("v_max_f32_e32 %0, %1, %2" : "=v"(r) : "v"(a), "v"(b)); return r; }
__device__ __forceinline__ float fadd_s(float a, float b) { float r; asm("v_add_f32_e32 %0, %1, %2" : "=v"(r) : "v"(a), "v"(b)); return r; }
__device__ __forceinline__ float fsub_s(float a, float b) { float r; asm("v_sub_f32_e32 %0, %1, %2" : "=v"(r) : "v"(a), "v"(b)); return r; }
typedef float f32x2_t __attribute__((ext_vector_type(2))); typedef __bf16 bf16x2_t __attribute__((ext_vector_type(2)));
__device__ __forceinline__ unsigned cvtpk_s(float lo, float hi) { f32x2_t v = {lo, hi}; bf16x2_t b = __builtin_convertvector(v, bf16x2_t); return __builtin_bit_cast(unsigned, b); }
#define WAIT_BAR(N) asm volatile("s_waitcnt vmcnt(" #N ") lgkmcnt(0)\n\ts_barrier" ::: "memory")

__device__ __forceinline__ void qkt(f32x16& p0, f32x16& p1, const char* Kslot, const bf16x8* qr, const f32x16& negm, int r32, int hi) {
  const char* kb = Kslot + hi * 1024 + r32 * 16;
  #pragma unroll
  for (int d0 = 0; d0 < 4; ++d0) {
    const bf16x8 b0 = *reinterpret_cast<const bf16x8*>(kb + d0 * 2048);
    const bf16x8 b1 = *reinterpret_cast<const bf16x8*>(kb + d0 * 2048 + 512);
    if (d0 == 0) { p0 = __builtin_amdgcn_mfma_f32_32x32x16_bf16(b0, qr[0], negm, 0, 0, 0); p1 = __builtin_amdgcn_mfma_f32_32x32x16_bf16(b1, qr[0], negm, 0, 0, 0); }
    else { p0 = __builtin_amdgcn_mfma_f32_32x32x16_bf16(b0, qr[d0], p0, 0, 0, 0); p1 = __builtin_amdgcn_mfma_f32_32x32x16_bf16(b1, qr[d0], p1, 0, 0, 0); } }
}
typedef __attribute__((address_space(3))) const char* lds_cptr;
typedef short v4i16_t __attribute__((ext_vector_type(4)));
__device__ __forceinline__ void kload8(bf16x8* kf, lds_cptr kp) {
  kf[0] = *(const __attribute__((address_space(3))) bf16x8*)(kp);        kf[1] = *(const __attribute__((address_space(3))) bf16x8*)(kp + 512);
  kf[2] = *(const __attribute__((address_space(3))) bf16x8*)(kp + 2048); kf[3] = *(const __attribute__((address_space(3))) bf16x8*)(kp + 2560);
  kf[4] = *(const __attribute__((address_space(3))) bf16x8*)(kp + 4096); kf[5] = *(const __attribute__((address_space(3))) bf16x8*)(kp + 4608);
  kf[6] = *(const __attribute__((address_space(3))) bf16x8*)(kp + 6144); kf[7] = *(const __attribute__((address_space(3))) bf16x8*)(kp + 6656);
}
__device__ __forceinline__ void kload2(bf16x8* kf, lds_cptr kp, int j) { kf[2 * j] = *(const __attribute__((address_space(3))) bf16x8*)(kp + j * 2048); kf[2 * j + 1] = *(const __attribute__((address_space(3))) bf16x8*)(kp + j * 2048 + 512); }
__device__ __forceinline__ s16x4 vtr(lds_cptr p) { return __builtin_bit_cast(s16x4, __builtin_amdgcn_ds_read_tr16_b64_v4i16((__attribute__((address_space(3))) v4i16_t*)p)); }
__device__ __forceinline__ float rowmax(const f32x16& p0, const f32x16& p1) {
  float a = max3f(p0[0], p0[1], p1[0]), b = max3f(p0[2], p0[3], p1[1]); a = max3f(a, p1[2], p1[3]);
  #pragma unroll
  for (int r = 4; r < 16; r += 4) { a = max3f(a, p0[r], p0[r + 1]); b = max3f(b, p0[r + 2], p0[r + 3]); a = max3f(a, p1[r], p1[r + 1]); b = max3f(b, p1[r + 2], p1[r + 3]); }
  const float m = max2f(a, b);
  auto rr = __builtin_amdgcn_permlane32_swap(__float_as_uint(m), __float_as_uint(m), false, false);
  return max2f(__uint_as_float(rr[0]), __uint_as_float(rr[1]));
}
__device__ __forceinline__ void pv(f32x16* o, int vb, bf16x8 pa0, bf16x8 pa1, bf16x8 pa2, bf16x8 pa3) {
  #pragma unroll
  for (int d0 = 0; d0 < 2; ++d0) { s16x4 lo[4], hi[4];
    #pragma unroll
    for (int ks = 0; ks < 4; ++ks) {
      asm volatile("ds_read_b64_tr_b16 %0,%1 offset:%c2" : "=&v"(lo[ks]) : "v"(vb), "i"(d0 * 4096 + ks * 1024) : "memory");
      asm volatile("ds_read_b64_tr_b16 %0,%1 offset:%c2" : "=&v"(hi[ks]) : "v"(vb), "i"(d0 * 4096 + ks * 1024 + 512) : "memory"); }
    asm volatile("s_waitcnt lgkmcnt(0)" ::: "memory"); SBAR();
    #define PK(k) (bf16x8){lo[k][0], lo[k][1], lo[k][2], lo[k][3], hi[k][0], hi[k][1], hi[k][2], hi[k][3]}
    o[d0] = __builtin_amdgcn_mfma_f32_32x32x16_bf16(pa0, PK(0), o[d0], 0, 0, 0);
    o[d0] = __builtin_amdgcn_mfma_f32_32x32x16_bf16(pa1, PK(1), o[d0], 0, 0, 0);
    o[d0] = __builtin_amdgcn_mfma_f32_32x32x16_bf16(pa2, PK(2), o[d0], 0, 0, 0);
    o[d0] = __builtin_amdgcn_mfma_f32_32x32x16_bf16(pa3, PK(3), o[d0], 0, 0, 0);
    #undef PK
  }
}
#define ATTN_STORE16(p, v) (*(u32x4*)(p) = (v))
template <int THRL> __device__ __forceinline__ void attn_unit(int tid_in, int b, int hq, int hv, int qb, const bf16* Q, const bf16* __restrict__ K, const bf16* __restrict__ V, bf16* O, char* shm) {
  const int tid = tid_in, lane = tid & 63, r32 = lane & 31, hi = lane >> 5; const int wid = __builtin_amdgcn_readfirstlane(tid >> 6);
  const long rowbase = (long)b * SEQ; const int q0 = qb * QB;
  const bf16* Qw = Q + (rowbase + q0 + wid * QBLK) * DMA + hq * D;
  const bf16* Kh = K + rowbase * DMA + hq * D, *Vh = V + rowbase * DMA + hv * D;
  const unsigned lds0 = (unsigned)(uintptr_t)shm;
  float* wsf = (float*)(shm + LDS_WS) + wid * 64;
  const bf16* ksrc = Kh + (long)lane * DMA + wid * 8;
  const bf16* vsrc = Vh + (long)(16 * (wid & 3) + (lane >> 2)) * DMA + (wid >> 2) * 32 + (lane & 3) * 8;
  const unsigned kdst = lds0 + LDS_K + wid * 1024, vdst = lds0 + LDS_V + wid * 1024;
  #define DMA_K(t, slot) glds16(ksrc + (long)(t) * KVBLK * DMA, (unsigned)__builtin_amdgcn_readfirstlane(kdst + (slot)))
  #define DMA_V(t, slot) glds16(vsrc + (long)(t) * KVBLK * DMA, (unsigned)__builtin_amdgcn_readfirstlane(vdst + (slot)))
  const int vb0 = (int)(lds0 + LDS_V) + ((lane >> 4) & 1) * 32 + (lane & 3) * 8 + (4 * hi + ((lane & 15) >> 2)) * 64;
  const char* Kbase = shm + LDS_K; bf16x8 kf[8];
  const lds_cptr shm3 = (lds_cptr)shm; const lds_cptr kp0 = shm3 + LDS_K + hi * 1024 + r32 * 16; const lds_cptr vp0 = shm3 + LDS_V + ((lane >> 4) & 1) * 32 + (lane & 3) * 8 + (4 * hi + ((lane & 15) >> 2)) * 64;
  const int NT = (q0 + QB) / KVBLK;
  DMA_K(0, 0); DMA_V(0, 0); DMA_K(1, SLOTB);
  bf16x8 qr[4];
  #pragma unroll
  for (int d0 = 0; d0 < 4; ++d0) qr[d0] = *reinterpret_cast<const bf16x8*>(&Qw[(long)r32 * DMA + d0 * 16 + hi * 8]);
  float mhat = 0.f, l_reg = 0.f; f32x16 o[2]; o[0] = f32x16{}; o[1] = f32x16{}; f32x16 negm = f32x16{}; asm volatile("" : "+v"(negm));
  const int qrel = wid * QBLK + r32;
  #define CMASK(P0, P1, t) do { int jb_ = (t) - (NT - 4); if (jb_ >= 0) cmask(P0, P1, jb_, qrel, hi); } while (0)
  bool resc = false;
  #define START(P0, P1) do { const float rm = rowmax(P0, P1); resc = false; \
    { const float dl = rm; mhat = fadd_s(mhat, dl); \
      _Pragma("unroll") for (int r = 0; r < 16; ++r) { P0[r] = fsub_s(P0[r], dl); P1[r] = fsub_s(P1[r], dl); } \
      _Pragma("unroll") for (int r = 0; r < 16; ++r) negm[r] = -mhat; asm volatile("" : "+v"(negm)); } \
    _Pragma("unroll") for (int r = 0; r < 16; ++r) P0[r] = __builtin_amdgcn_exp2f(P0[r]); } while (0)
  #define RESC() do { if (resc) { asm volatile("s_waitcnt lgkmcnt(0)" ::: "memory"); \
      _Pragma("unroll") for (int d_ = 0; d_ < 2; ++d_) _Pragma("unroll") for (int r = 0; r < 16; ++r) o[d_][r] *= wsf[crow(r, hi)]; } } while (0)
  f32x16 pA0, pA1, pB0, pB1;
  int sl_prev = 0, sl_cur = 0, sl_next = SLOTB;
  #define ROT() do { sl_prev = sl_cur; sl_cur = sl_next; sl_next = (sl_next == (NSLOT - 1) * SLOTB) ? 0 : sl_next + SLOTB; } while (0)
  DMA_K(2, 2 * SLOTB);
  WAIT_BAR(3);
  qkt(pA0, pA1, Kbase, qr, negm, r32, hi); asm volatile("s_nop 15\n\ts_nop 7" : "+v"(pA0), "+v"(pA1)); CMASK(pA0, pA1, 0);
  START(pA0, pA1);
  _Pragma("unroll") for (int r = 0; r < 16; ++r) pA1[r] = __builtin_amdgcn_exp2f(pA1[r]);
  WAIT_BAR(0);
  DMA_K(3, 0); DMA_V(1, SLOTB);
  ROT();
  kload8(kf, kp0 + sl_cur);
  WAIT_BAR(2);
  s16x4 vlo[8], vhi[8]; u32x4 pw0, pw1, pw2, pw3;
  #define PKW(P, B) cvtpk_s(P[B], P[B + 1])
  #define PAF(k) __builtin_bit_cast(bf16x8, pw##k)
  #define VFR(i) (bf16x8){vlo[i][0], vlo[i][1], vlo[i][2], vlo[i][3], vhi[i][0], vhi[i][1], vhi[i][2], vhi[i][3]}
  #define PIN(x) asm volatile("" : "+v"(x))
  #define MX3(a, b, c) __builtin_fmaxf(__builtin_fmaxf((a), (b)), (c))
  #define GAPA(MF, A0, A1, A2, A3, W0, W1, PW) do { MF; sacc += A0; sacc += A1; sacc += A2; sacc += A3; PIN(sacc); W0; W1; PIN(PW); SBAR(); } while (0)
  #define EX(v) __builtin_amdgcn_exp2f(v)
  #define GAPB(MF, X, B) do { MF; X[B] = EX(X[B]); X[B + 1] = EX(X[B + 1]); X[B + 2] = EX(X[B + 2]); X[B + 3] = EX(X[B + 3]); PIN(X); SBAR(); } while (0)
  #define VRD(i) do { vlo[i] = vtr(vp_ + (((i) >> 2) * 4096 + ((i) & 3) * 1024)); vhi[i] = vtr(vp_ + (((i) >> 2) * 4096 + ((i) & 3) * 1024 + 512)); } while (0)
  #define KRD(G, j) do { if (G) { kload2(kf, kp0 + sl_next, j); SBAR(); } } while (0)
  #define STEP(C0, C1, P0, P1, t, GK, GV, GL) do { SBAR(); \
    const lds_cptr vp_ = vp0 + sl_prev; \
    VRD(0); SBAR(); float sacc = (P0[0] + P0[1]); \
    GAPA(C0 = __builtin_amdgcn_mfma_f32_32x32x16_bf16(kf[0], qr[0], negm, 0, 0, 0), P0[2], P0[3], P0[4], P0[5],     pw0[0] = PKW(P0, 0), pw0[1] = PKW(P0, 2), pw0); \
    VRD(4); SBAR(); GAPA(C1 = __builtin_amdgcn_mfma_f32_32x32x16_bf16(kf[1], qr[0], negm, 0, 0, 0), P0[6], P0[7], P0[8], P0[9],     pw0[2] = PKW(P0, 4), pw0[3] = PKW(P0, 6), pw0); \
    VRD(1); SBAR(); GAPA(C0 = __builtin_amdgcn_mfma_f32_32x32x16_bf16(kf[2], qr[1], C0, 0, 0, 0),   P0[10], P0[11], P0[12], P0[13], pw1[0] = PKW(P0, 8), pw1[1] = PKW(P0, 10), pw1); \
    VRD(5); SBAR(); GAPA(C1 = __builtin_amdgcn_mfma_f32_32x32x16_bf16(kf[3], qr[1], C1, 0, 0, 0),   P0[14], P0[15], P1[0], P1[1],   pw1[2] = PKW(P0, 12), pw1[3] = PKW(P0, 14), pw1); \
    VRD(2); SBAR(); GAPA(C0 = __builtin_amdgcn_mfma_f32_32x32x16_bf16(kf[4], qr[2], C0, 0, 0, 0),   P1[2], P1[3], P1[4], P1[5],     pw2[0] = PKW(P1, 0), pw2[1] = PKW(P1, 2), pw2); \
    VRD(6); SBAR(); GAPA(C1 = __builtin_amdgcn_mfma_f32_32x32x16_bf16(kf[5], qr[2], C1, 0, 0, 0),   P1[6], P1[7], P1[8], P1[9],     pw2[2] = PKW(P1, 4), pw2[3] = PKW(P1, 6), pw2); \
    VRD(3); SBAR(); GAPA(C0 = __builtin_amdgcn_mfma_f32_32x32x16_bf16(kf[6], qr[3], C0, 0, 0, 0),   P1[10], P1[11], P1[12], P1[13], pw3[0] = PKW(P1, 8), pw3[1] = PKW(P1, 10), pw3); \
    VRD(7); SBAR(); GAPA(C1 = __builtin_amdgcn_mfma_f32_32x32x16_bf16(kf[7], qr[3], C1, 0, 0, 0),   P1[14], P1[15], 0.f, 0.f,       pw3[2] = PKW(P1, 12), pw3[3] = PKW(P1, 14), pw3); \
    l_reg += sacc; \
    if (GK) { DMA_K((t) + 3, sl_cur); } if (GV) { DMA_V((t) + 1, sl_next); } \
    CMASK(C0, C1, t); \
    { float a = MX3(C0[0], C0[1], C1[0]), b = MX3(C0[2], C0[3], C1[1]); a = MX3(a, C1[2], C1[3]); \
      _Pragma("unroll") for (int r = 4; r < 16; r += 4) { a = MX3(a, C0[r], C0[r + 1]); b = MX3(b, C0[r + 2], C0[r + 3]); a = MX3(a, C1[r], C1[r + 1]); b = MX3(b, C1[r + 2], C1[r + 3]); } \
      float rm = __builtin_fmaxf(a, b); { auto rr = __builtin_amdgcn_permlane32_swap(__float_as_uint(rm), __float_as_uint(rm), false, false); rm = __builtin_fmaxf(__uint_as_float(rr[0]), __uint_as_float(rr[1])); } \
      resc = false; \
      if (__builtin_expect(__any(rm > (float)THRL), 0)) { const float dl = __builtin_fmaxf(rm, 0.f); mhat += dl; \
        _Pragma("unroll") for (int r = 0; r < 16; ++r) { C0[r] -= dl; C1[r] -= dl; } \
        _Pragma("unroll") for (int r = 0; r < 16; ++r) negm[r] = -mhat; asm volatile("" : "+v"(negm)); \
        const float f = __builtin_amdgcn_exp2f(-dl); l_reg *= f; if (hi == 0) wsf[r32] = f; resc = true; } } \
    SBAR(); \
    GAPB(o[0] = __builtin_amdgcn_mfma_f32_32x32x16_bf16(PAF(0), VFR(0), o[0], 0, 0, 0), C0, 0); \
    GAPB(o[1] = __builtin_amdgcn_mfma_f32_32x32x16_bf16(PAF(0), VFR(4), o[1], 0, 0, 0), C0, 4); \
    KRD(GL, 0); GAPB(o[0] = __builtin_amdgcn_mfma_f32_32x32x16_bf16(PAF(1), VFR(1), o[0], 0, 0, 0), C0, 8); \
    KRD(GL, 1); GAPB(o[1] = __builtin_amdgcn_mfma_f32_32x32x16_bf16(PAF(1), VFR(5), o[1], 0, 0, 0), C0, 12); \
    KRD(GL, 2); GAPB(o[0] = __builtin_amdgcn_mfma_f32_32x32x16_bf16(PAF(2), VFR(2), o[0], 0, 0, 0), C1, 0); \
    KRD(GL, 3); GAPB(o[1] = __builtin_amdgcn_mfma_f32_32x32x16_bf16(PAF(2), VFR(6), o[1], 0, 0, 0), C1, 4); \
    GAPB(o[0] = __builtin_amdgcn_mfma_f32_32x32x16_bf16(PAF(3), VFR(3), o[0], 0, 0, 0), C1, 8); \
    GAPB(o[1] = __builtin_amdgcn_mfma_f32_32x32x16_bf16(PAF(3), VFR(7), o[1], 0, 0, 0), C1, 12); \
    } while (0)
  int t = 1;
  #undef CMASK
  #define CMASK(P0, P1, t) do {} while (0)
  for (; t + 5 < NT; t += 2) {
    STEP(pB0, pB1, pA0, pA1, t, true, true, true);     WAIT_BAR(2); RESC(); ROT();
    STEP(pA0, pA1, pB0, pB1, t + 1, true, true, true); WAIT_BAR(2); RESC(); ROT();
  }
  #undef CMASK
  #define CMASK(P0, P1, t) do { int jb_ = (t) - (NT - 4); if (jb_ >= 0) cmask(P0, P1, jb_, qrel, hi); } while (0)
  #define ENDW(tt) do { if ((tt) + 3 < NT) { WAIT_BAR(2); } else if ((tt) + 2 < NT) { WAIT_BAR(1); } else { WAIT_BAR(0); } } while (0)
  for (; t + 1 < NT; t += 2) {
    STEP(pB0, pB1, pA0, pA1, t, (t + 3 < NT), (t + 1 < NT), (t + 1 < NT));         ENDW(t);     RESC(); ROT();
    STEP(pA0, pA1, pB0, pB1, t + 1, (t + 4 < NT), (t + 2 < NT), (t + 2 < NT));     ENDW(t + 1); RESC(); ROT();
  }
  STEP(pB0, pB1, pA0, pA1, NT - 1, false, false, false); RESC();
  { float sacc = pB0[0] + pB0[1]; _Pragma("unroll") for (int r = 2; r < 16; ++r) sacc += pB0[r]; _Pragma("unroll") for (int r = 0; r < 16; ++r) sacc += pB1[r]; l_reg += sacc;
    pw0 = (u32x4){PKW(pB0, 0), PKW(pB0, 2), PKW(pB0, 4), PKW(pB0, 6)}; pw1 = (u32x4){PKW(pB0, 8), PKW(pB0, 10), PKW(pB0, 12), PKW(pB0, 14)}; pw2 = (u32x4){PKW(pB1, 0), PKW(pB1, 2), PKW(pB1, 4), PKW(pB1, 6)}; pw3 = (u32x4){PKW(pB1, 8), PKW(pB1, 10), PKW(pB1, 12), PKW(pB1, 14)};
    SBAR(); pv(o, vb0 + sl_cur, PAF(0), PAF(1), PAF(2), PAF(3)); }
  #undef PKW
  #undef PAF
  #undef VFR
  #undef PIN
  #undef MX3
  #undef GAPA
  #undef GAPB
  #undef EX
  #undef VRD
  #undef KRD
  #undef STEP
  #undef ENDW
  { auto rr = __builtin_amdgcn_permlane32_swap(__float_as_uint(l_reg), __float_as_uint(l_reg), false, false); l_reg = __uint_as_float(rr[0]) + __uint_as_float(rr[1]); }
  if (hi == 0) wsf[32 + r32] = l_reg; asm volatile("s_waitcnt lgkmcnt(0)" ::: "memory");
  float rli[16];
  #pragma unroll
  for (int r = 0; r < 16; ++r) rli[r] = __builtin_amdgcn_rcpf(wsf[32 + crow(r, hi)]);
  bf16* Ow = O + (rowbase + q0 + wid * QBLK) * DMA + hv * D;
  { bf16* stg = (bf16*)(shm + LDS_OST) + wid * 2048;
    #pragma unroll
    for (int r = 0; r < 16; ++r) { const int orow = crow(r, hi);
      #pragma unroll
      for (int d0 = 0; d0 < 2; ++d0) stg[orow * 64 + d0 * 32 + r32] = f2bf(o[d0][r] * rli[r]); }
    asm volatile("s_waitcnt lgkmcnt(0)" ::: "memory");
    #pragma unroll
    for (int i = 0; i < 4; ++i) { const int row = i * 8 + (lane >> 3), ch = lane & 7; const u32x4 v = *(const u32x4*)(stg + row * 64 + ch * 8); ATTN_STORE16(Ow + (long)row * DMA + ch * 8, v); } }
  asm volatile("s_waitcnt lgkmcnt(0)\n\ts_barrier" ::: "memory");
  #undef DMA_K
  #undef DMA_V
  #undef CMASK
  #undef START
  #undef RESC
  #undef ROT
}
constexpr int ATTN_LDS_BYTES = LDS_BYTES;
#undef SBAR
#undef WAIT_BAR
}

namespace attn3 {
using namespace attn_body;
constexpr int KSLOT = 8192, VSLOT = 16384;
constexpr int L_K = 0, L_V = NSLOT * KSLOT, L_WS = L_V + NSLOT * VSLOT, L_OST = L_WS + NW * 64 * 4, L_BYTES = L_OST + NW * 4096;
#define SBAR() __builtin_amdgcn_sched_barrier(0)
#define WAIT_BAR(N) asm volatile("s_waitcnt vmcnt(" #N ") lgkmcnt(0)\n\ts_barrier" ::: "memory")
template <int THRL> __device__ __forceinline__ void attn_unit(int tid_in, int b, int hq, int h, int qb, const bf16* Q, const bf16* __restrict__ K, const bf16* __restrict__ V, bf16* O, char* shm,
                                                             int mode, const bf16* SZ1, const float* g_sub, float lam, bf16* OG,
                                                             bool primed, bool has_next, int nb, int nhq, int nh, int nqb, bf16x8 (&qr)[4]) {
  int tid_ = tid_in; asm volatile("" : "+v"(tid_));
  const int tid = tid_, lane = tid & 63, r32 = lane & 31, hi = lane >> 5; const int wid = __builtin_amdgcn_readfirstlane(tid >> 6);
  const long rowbase = (long)b * SEQ; const int q0 = qb * QB;
  const bf16* Qw = Q + (rowbase + q0 + wid * QBLK) * DMA + hq * D;
  const bf16* Kh = K + rowbase * DMA + hq * D, *Vh = V + rowbase * DMA + h * 128;
  const unsigned lds0 = (unsigned)(uintptr_t)shm;
  float* wsf = (float*)(shm + L_WS) + wid * 64;
  const bf16* ksrc = Kh + (long)lane * DMA + wid * 8;
  const bf16* vsrc = Vh + (long)(16 * (wid & 3) + (lane >> 2)) * DMA + (wid >> 2) * 32 + (lane & 3) * 8;
  const unsigned kdst = lds0 + L_K + wid * 1024, vdst = lds0 + L_V + wid * 1024;
  #define DMA_K(t, si) glds16(ksrc + (long)(t) * KVBLK * DMA, (unsigned)__builtin_amdgcn_readfirstlane(kdst + (si) * KSLOT))
  #define DMA_V(t, si) do { glds16(vsrc + (long)(t) * KVBLK * DMA, (unsigned)__builtin_amdgcn_readfirstlane(vdst + (si) * VSLOT)); \
                            glds16(vsrc + (long)(t) * KVBLK * DMA + 64, (unsigned)__builtin_amdgcn_readfirstlane(vdst + (si) * VSLOT + 8192)); } while (0)
  const int vb0 = (int)(lds0 + L_V) + ((lane >> 4) & 1) * 32 + (lane & 3) * 8 + (4 * hi + ((lane & 15) >> 2)) * 64;
  const char* Kbase = shm + L_K; bf16x8 kf[8];
  const lds_cptr shm3 = (lds_cptr)shm; const lds_cptr kp0 = shm3 + L_K + hi * 1024 + r32 * 16; const lds_cptr vp0 = shm3 + L_V + ((lane >> 4) & 1) * 32 + (lane & 3) * 8 + (4 * hi + ((lane & 15) >> 2)) * 64;
  const int NT = (q0 + QB) / KVBLK;
  if (!primed) { DMA_K(0, 0); DMA_V(0, 0); DMA_K(1, 1);
    #pragma unroll
    for (int d0 = 0; d0 < 4; ++d0) qr[d0] = *reinterpret_cast<const bf16x8*>(&Qw[(long)r32 * DMA + d0 * 16 + hi * 8]); }
  float mhat = 0.f, l_reg = 0.f; f32x16 o[4]; f32x16 negm;
  { float zf = 0.f; asm volatile("" : "+v"(zf));
    _Pragma("unroll") for (int r = 0; r < 16; ++r) { o[0][r] = zf; o[1][r] = zf; o[2][r] = zf; o[3][r] = zf; negm[r] = zf; } }
  asm volatile("" : "+v"(negm));
  const int qrel = wid * QBLK + r32;
  #define CMASK(P0, P1, t) do { int jb_ = (t) - (NT - 4); if (jb_ >= 0) cmask(P0, P1, jb_, qrel, hi); } while (0)
  bool resc = false;
  #define RESC() do { if (resc) { asm volatile("s_waitcnt lgkmcnt(0)" ::: "memory"); \
      _Pragma("unroll") for (int d_ = 0; d_ < 4; ++d_) _Pragma("unroll") for (int r = 0; r < 16; ++r) o[d_][r] *= wsf[crow(r, hi)]; } } while (0)
  f32x16 C0, C1;
  int s_prev = 0, s_cur = 0, s_next = 1;
  #define ROT() do { s_prev = s_cur; s_cur = s_next; s_next = (s_next == NSLOT - 1) ? 0 : s_next + 1; } while (0)
  if (!primed) { DMA_K(2, 2); WAIT_BAR(4); }
  else { WAIT_BAR(0); }
  u32x4 pwA0, pwA1, pwA2, pwA3, pwB0, pwB1, pwB2, pwB3;
  #define PKW(P, B) cvtpk_s(P[B], P[B + 1])
  qkt(C0, C1, Kbase, qr, negm, r32, hi); asm volatile("s_nop 15\n\ts_nop 7" : "+v"(C0), "+v"(C1)); CMASK(C0, C1, 0);
  { const float rm = rowmax(C0, C1); mhat = fadd_s(mhat, rm);
    _Pragma("unroll") for (int r = 0; r < 16; ++r) { C0[r] = fsub_s(C0[r], rm); C1[r] = fsub_s(C1[r], rm); }
    _Pragma("unroll") for (int r = 0; r < 16; ++r) negm[r] = -mhat; asm volatile("" : "+v"(negm));
    float sacc = 0.f;
    _Pragma("unroll") for (int r = 0; r < 16; ++r) { C0[r] = __builtin_amdgcn_exp2f(C0[r]); C1[r] = __builtin_amdgcn_exp2f(C1[r]); }
    _Pragma("unroll") for (int r = 0; r < 16; ++r) sacc += C0[r] + C1[r];
    l_reg = sacc;
    pwA0 = (u32x4){PKW(C0, 0), PKW(C0, 2), PKW(C0, 4), PKW(C0, 6)}; pwA1 = (u32x4){PKW(C0, 8), PKW(C0, 10), PKW(C0, 12), PKW(C0, 14)};
    pwA2 = (u32x4){PKW(C1, 0), PKW(C1, 2), PKW(C1, 4), PKW(C1, 6)}; pwA3 = (u32x4){PKW(C1, 8), PKW(C1, 10), PKW(C1, 12), PKW(C1, 14)}; }
  WAIT_BAR(0);
  DMA_K(3, 0); DMA_V(1, 1);
  ROT();
  kload8(kf, kp0 + s_cur * KSLOT);
  WAIT_BAR(3);
  s16x4 vlo[8], vhi[8];
  #define PAF(w) __builtin_bit_cast(bf16x8, w)
  #define VFR(i) (bf16x8){vlo[i][0], vlo[i][1], vlo[i][2], vlo[i][3], vhi[i][0], vhi[i][1], vhi[i][2], vhi[i][3]}
  #define PIN(x) asm volatile("" : "+v"(x))
  #define MX3(a, b, c) __builtin_fmaxf(__builtin_fmaxf((a), (b)), (c))
  #define EX(v) __builtin_amdgcn_exp2f(v)
  #define VRD(s, f) do { vlo[s] = vtr(vp_ + (((f) >> 2) * 4096 + ((f) & 3) * 1024)); vhi[s] = vtr(vp_ + (((f) >> 2) * 4096 + ((f) & 3) * 1024 + 512)); } while (0)
  #define KRD(G, j) do { if (G) { kload2(kf, kp0 + s_next * KSLOT, j); SBAR(); } } while (0)
  #define GAPB(MF, X, B, PWW) do { MF; X[B] = EX(X[B]); X[B + 1] = EX(X[B + 1]); sacc += X[B]; sacc += X[B + 1]; PIN(sacc); PWW = PKW(X, B); PIN(PWW); SBAR(); } while (0)
  #define MFQ(a, b, c) __builtin_amdgcn_mfma_f32_32x32x16_bf16(a, b, c, 0, 0, 0)
  #define STEP(PP0, PP1, PP2, PP3, PN0, PN1, PN2, PN3, t, GK, GV, GL) do { SBAR(); \
    const lds_cptr vp_ = vp0 + s_prev * VSLOT; \
    VRD(0, 0); SBAR(); C0 = MFQ(kf[0], qr[0], negm); SBAR(); \
    VRD(4, 4); SBAR(); C1 = MFQ(kf[1], qr[0], negm); SBAR(); \
    VRD(1, 1); SBAR(); C0 = MFQ(kf[2], qr[1], C0); SBAR(); \
    VRD(5, 5); SBAR(); C1 = MFQ(kf[3], qr[1], C1); SBAR(); \
    VRD(2, 2); SBAR(); C0 = MFQ(kf[4], qr[2], C0); SBAR(); \
    VRD(6, 6); SBAR(); C1 = MFQ(kf[5], qr[2], C1); SBAR(); \
    VRD(3, 3); SBAR(); C0 = MFQ(kf[6], qr[3], C0); SBAR(); \
    VRD(7, 7); SBAR(); C1 = MFQ(kf[7], qr[3], C1); SBAR(); \
    if (GK) { DMA_K((t) + 3, s_cur); } if (GV) { DMA_V((t) + 1, s_next); } \
    CMASK(C0, C1, t); \
    { float a = MX3(C0[0], C0[1], C1[0]), b = MX3(C0[2], C0[3], C1[1]); a = MX3(a, C1[2], C1[3]); \
      _Pragma("unroll") for (int r = 4; r < 16; r += 4) { a = MX3(a, C0[r], C0[r + 1]); b = MX3(b, C0[r + 2], C0[r + 3]); a = MX3(a, C1[r], C1[r + 1]); b = MX3(b, C1[r + 2], C1[r + 3]); } \
      float rm = __builtin_fmaxf(a, b); { auto rr = __builtin_amdgcn_permlane32_swap(__float_as_uint(rm), __float_as_uint(rm), false, false); rm = __builtin_fmaxf(__uint_as_float(rr[0]), __uint_as_float(rr[1])); } \
      resc = false; \
      if (__builtin_expect(__any(rm > (float)THRL), 0)) { const float dl = __builtin_fmaxf(rm, 0.f); mhat += dl; \
        _Pragma("unroll") for (int r = 0; r < 16; ++r) { C0[r] -= dl; C1[r] -= dl; } \
        _Pragma("unroll") for (int r = 0; r < 16; ++r) negm[r] = -mhat; asm volatile("" : "+v"(negm)); \
        const float f = __builtin_amdgcn_exp2f(-dl); l_reg *= f; if (hi == 0) wsf[r32] = f; resc = true; } } \
    SBAR(); float sacc = 0.f; \
    GAPB(o[0] = MFQ(PAF(PP0), VFR(0), o[0]), C0, 0,  PN0[0]); VRD(0, 8);  SBAR(); \
    GAPB(o[1] = MFQ(PAF(PP0), VFR(4), o[1]), C0, 2,  PN0[1]); VRD(4, 12); SBAR(); \
    GAPB(o[0] = MFQ(PAF(PP1), VFR(1), o[0]), C0, 4,  PN0[2]); VRD(1, 9);  SBAR(); \
    GAPB(o[1] = MFQ(PAF(PP1), VFR(5), o[1]), C0, 6,  PN0[3]); VRD(5, 13); SBAR(); \
    GAPB(o[0] = MFQ(PAF(PP2), VFR(2), o[0]), C0, 8,  PN1[0]); VRD(2, 10); SBAR(); \
    GAPB(o[1] = MFQ(PAF(PP2), VFR(6), o[1]), C0, 10, PN1[1]); VRD(6, 14); SBAR(); \
    GAPB(o[0] = MFQ(PAF(PP3), VFR(3), o[0]), C0, 12, PN1[2]); VRD(3, 11); SBAR(); \
    GAPB(o[1] = MFQ(PAF(PP3), VFR(7), o[1]), C0, 14, PN1[3]); VRD(7, 15); SBAR(); \
    GAPB(o[2] = MFQ(PAF(PP0), VFR(0), o[2]), C1, 0,  PN2[0]); \
    GAPB(o[3] = MFQ(PAF(PP0), VFR(4), o[3]), C1, 2,  PN2[1]); \
    KRD(GL, 0); GAPB(o[2] = MFQ(PAF(PP1), VFR(1), o[2]), C1, 4,  PN2[2]); \
    KRD(GL, 1); GAPB(o[3] = MFQ(PAF(PP1), VFR(5), o[3]), C1, 6,  PN2[3]); \
    KRD(GL, 2); GAPB(o[2] = MFQ(PAF(PP2), VFR(2), o[2]), C1, 8,  PN3[0]); \
    KRD(GL, 3); GAPB(o[3] = MFQ(PAF(PP2), VFR(6), o[3]), C1, 10, PN3[1]); \
    GAPB(o[2] = MFQ(PAF(PP3), VFR(3), o[2]), C1, 12, PN3[2]); \
    GAPB(o[3] = MFQ(PAF(PP3), VFR(7), o[3]), C1, 14, PN3[3]); \
    l_reg += sacc; \
    } while (0)
  #define STEP_AB(t, GK, GV, GL) STEP(pwA0, pwA1, pwA2, pwA3, pwB0, pwB1, pwB2, pwB3, t, GK, GV, GL)
  #define STEP_BA(t, GK, GV, GL) STEP(pwB0, pwB1, pwB2, pwB3, pwA0, pwA1, pwA2, pwA3, t, GK, GV, GL)
  int t = 1;
  #undef CMASK
  #define CMASK(P0, P1, t) do {} while (0)
  for (; t + 5 < NT; t += 2) {
    STEP_AB(t, true, true, true);     WAIT_BAR(3); RESC(); ROT();
    STEP_BA(t + 1, true, true, true); WAIT_BAR(3); RESC(); ROT();
  }
  #undef CMASK
  #define CMASK(P0, P1, t) do { int jb_ = (t) - (NT - 4); if (jb_ >= 0) cmask(P0, P1, jb_, qrel, hi); } while (0)
  #define ENDW(tt) do { if ((tt) + 3 < NT) { WAIT_BAR(3); } else if ((tt) + 2 < NT) { WAIT_BAR(2); } else { WAIT_BAR(0); } } while (0)
  for (; t + 1 < NT; t += 2) {
    STEP_AB(t, (t + 3 < NT), (t + 1 < NT), (t + 1 < NT));         ENDW(t);     RESC(); ROT();
    STEP_BA(t + 1, (t + 4 < NT), (t + 2 < NT), (t + 2 < NT));     ENDW(t + 1); RESC(); ROT();
  }
  STEP_AB(NT - 1, false, false, false); RESC();
  { SBAR();
    const int vb = vb0 + s_cur * VSLOT;
    #pragma unroll
    for (int d0 = 0; d0 < 4; ++d0) { s16x4 lo[4], hh[4];
      #pragma unroll
      for (int ks = 0; ks < 4; ++ks) {
        asm volatile("ds_read_b64_tr_b16 %0,%1 offset:%c2" : "=&v"(lo[ks]) : "v"(vb), "i"(d0 * 4096 + ks * 1024) : "memory");
        asm volatile("ds_read_b64_tr_b16 %0,%1 offset:%c2" : "=&v"(hh[ks]) : "v"(vb), "i"(d0 * 4096 + ks * 1024 + 512) : "memory"); }
      asm volatile("s_waitcnt lgkmcnt(0)" ::: "memory"); SBAR();
      #define PK(k) (bf16x8){lo[k][0], lo[k][1], lo[k][2], lo[k][3], hh[k][0], hh[k][1], hh[k][2], hh[k][3]}
      o[d0] = MFQ(PAF(pwB0), PK(0), o[d0]); o[d0] = MFQ(PAF(pwB1), PK(1), o[d0]); o[d0] = MFQ(PAF(pwB2), PK(2), o[d0]); o[d0] = MFQ(PAF(pwB3), PK(3), o[d0]);
      #undef PK
    } }
  asm volatile("s_waitcnt lgkmcnt(0)\n\ts_barrier" ::: "memory");
  if (has_next) {
    const long nrow = (long)nb * SEQ; const int nq0 = nqb * QB;
    const bf16* nQw = Q + (nrow + nq0 + wid * QBLK) * DMA + nhq * D;
    const bf16* nks = K + nrow * DMA + nhq * D + (long)lane * DMA + wid * 8;
    const bf16* nvs = V + nrow * DMA + nh * 128 + (long)(16 * (wid & 3) + (lane >> 2)) * DMA + (wid >> 2) * 32 + (lane & 3) * 8;
    glds16(nks, (unsigned)__builtin_amdgcn_readfirstlane(kdst));
    glds16(nvs, (unsigned)__builtin_amdgcn_readfirstlane(vdst)); glds16(nvs + 64, (unsigned)__builtin_amdgcn_readfirstlane(vdst + 8192));
    glds16(nks + (long)KVBLK * DMA, (unsigned)__builtin_amdgcn_readfirstlane(kdst + KSLOT));
    glds16(nks + (long)2 * KVBLK * DMA, (unsigned)__builtin_amdgcn_readfirstlane(kdst + 2 * KSLOT));
    #pragma unroll
    for (int d0 = 0; d0 < 4; ++d0) qr[d0] = *reinterpret_cast<const bf16x8*>(&nQw[(long)r32 * DMA + d0 * 16 + hi * 8]);
  }
  { auto rr = __builtin_amdgcn_permlane32_swap(__float_as_uint(l_reg), __float_as_uint(l_reg), false, false); l_reg = __uint_as_float(rr[0]) + __uint_as_float(rr[1]); }
  if (hi == 0) wsf[32 + r32] = l_reg; asm volatile("s_waitcnt lgkmcnt(0)" ::: "memory");
  float rli[16];
  #pragma unroll
  for (int r = 0; r < 16; ++r) rli[r] = __builtin_amdgcn_rcpf(wsf[32 + crow(r, hi)]);
  int lane_e = lane; asm volatile("" : "+v"(lane_e));
  const int erow = lane_e >> 3, ech = lane_e & 7;
  bf16* Ow = O + (rowbase + q0 + wid * QBLK) * DMA + h * 128;
  bf16* stg = (bf16*)(shm + L_OST) + wid * 2048;
  if (mode == 0) {
    #pragma unroll
    for (int ps = 0; ps < 2; ++ps) {
      #pragma unroll
      for (int r = 0; r < 16; ++r) { const int orow = crow(r, hi);
        #pragma unroll
        for (int d0 = 0; d0 < 2; ++d0) stg[orow * 64 + d0 * 32 + r32] = f2bf(o[2 * ps + d0][r] * rli[r]); }
      asm volatile("s_waitcnt lgkmcnt(0)" ::: "memory");
      #pragma unroll
      for (int i = 0; i < 4; ++i) { const int row = i * 8 + erow, ch = ech; const u32x4 v = *(const u32x4*)(stg + row * 64 + ch * 8); *(u32x4*)(Ow + (long)row * DMA + ps * 64 + ch * 8) = v; }
      asm volatile("s_waitcnt lgkmcnt(0)" ::: "memory");
    }
    asm volatile("s_waitcnt vmcnt(0)" ::: "memory");
  } else {
    const bf16* Zw = SZ1 + (rowbase + q0 + wid * QBLK) * DMA + h * 128; bf16* Gw = OG + (rowbase + q0 + wid * QBLK) * DMA + h * 128;
    float dk[2][4][8]; float ss[4] = {0.f, 0.f, 0.f, 0.f};
    #pragma unroll
    for (int ps = 0; ps < 2; ++ps) {
      #pragma unroll
      for (int r = 0; r < 16; ++r) { const int orow = crow(r, hi);
        #pragma unroll
        for (int d0 = 0; d0 < 2; ++d0) stg[orow * 64 + d0 * 32 + r32] = f2bf(o[2 * ps + d0][r] * rli[r]); }
      asm volatile("s_waitcnt lgkmcnt(0)" ::: "memory");
      #pragma unroll
      for (int i = 0; i < 4; ++i) { const int row = i * 8 + erow, ch = ech;
        const u32x4 v1 = *(const u32x4*)(stg + row * 64 + ch * 8); const u32x4 v0 = *(const u32x4*)(Ow + (long)row * DMA + ps * 64 + ch * 8);
        #pragma unroll
        for (int j = 0; j < 4; ++j) { const float a0 = __uint_as_float(v0[j] << 16), a1 = __uint_as_float(v0[j] & 0xffff0000u), b0 = __uint_as_float(v1[j] << 16), b1 = __uint_as_float(v1[j] & 0xffff0000u);
          const float d0_ = a0 - lam * b0, d1_ = a1 - lam * b1; dk[ps][i][2 * j] = d0_; dk[ps][i][2 * j + 1] = d1_; ss[i] += d0_ * d0_ + d1_ * d1_; } }
      asm volatile("s_waitcnt lgkmcnt(0)" ::: "memory");
    }
    #pragma unroll
    for (int i = 0; i < 4; ++i) { float t_ = ss[i];
      t_ += __int_as_float(__builtin_amdgcn_ds_swizzle(__float_as_int(t_), 0x1f | (1 << 10))); t_ += __int_as_float(__builtin_amdgcn_ds_swizzle(__float_as_int(t_), 0x1f | (2 << 10)));
      t_ += __int_as_float(__builtin_amdgcn_ds_swizzle(__float_as_int(t_), 0x1f | (4 << 10))); ss[i] = rsqrtf(t_ * (1.0f / 128.0f) + RMS_EPS) * ONE_M_LI; }
    #pragma unroll
    for (int ps = 0; ps < 2; ++ps) {
      const int ch = ech; const float* gp = g_sub + ps * 64 + ch * 8; const f32x4_t g0 = *(const f32x4_t*)gp, g1 = *(const f32x4_t*)(gp + 4);
      #pragma unroll
      for (int i = 0; i < 4; ++i) { const int row = i * 8 + erow;
        const u32x4 z = NT_LD((const u32x4*)(Zw + (long)row * DMA + ps * 64 + ch * 8)); u32x4 w;
        #pragma unroll
        for (int j = 0; j < 4; ++j) { const float z0 = __uint_as_float(z[j] << 16), z1 = __uint_as_float(z[j] & 0xffff0000u);
          const float ga = (j < 2) ? g0[2 * j] : g1[2 * j - 4], gb = (j < 2) ? g0[2 * j + 1] : g1[2 * j - 3];
          w[j] = cvtpk_s(dk[ps][i][2 * j] * ss[i] * ga * z0, dk[ps][i][2 * j + 1] * ss[i] * gb * z1); }
        *(u32x4*)(Gw + (long)row * DMA + ps * 64 + ch * 8) = w; }
    }
  }
  asm volatile("s_waitcnt lgkmcnt(0)" ::: "memory");
  #undef DMA_K
  #undef DMA_V
  #undef CMASK
  #undef RESC
  #undef ROT
  #undef PKW
  #undef PAF
  #undef VFR
  #undef PIN
  #undef MX3
  #undef EX
  #undef VRD
  #undef KRD
  #undef GAPB
  #undef MFQ
  #undef STEP
  #undef STEP_AB
  #undef STEP_BA
  #undef ENDW
}
#undef SBAR
#undef WAIT_BAR
}

constexpr int NWAVES = 8;
constexpr size_t MiB = 1u << 20;
constexpr size_t WS_CTL = 0, CTL_ZERO_BYTES = 1 * MiB;
constexpr size_t WS_MOD = 256 * 1024;
constexpr size_t WS_LAM = 1 * MiB;
constexpr size_t WS_LB16 = 1 * MiB + 4096;
constexpr size_t WS_WIN0 = 2 * MiB, WS_WGLU = 6 * MiB, WS_WOUT0 = 8 * MiB, WS_WKV = 10 * MiB, WS_WIN1 = 14 * MiB, WS_WOUT1 = 18 * MiB;
constexpr size_t WS_BTA = 20 * MiB;
constexpr size_t WS_BTB = 28 * MiB;
constexpr size_t WS_S0 = 48 * MiB, WS_S1 = 112 * MiB, WS_S2 = 176 * MiB, WS_S3 = 240 * MiB, WS_S4 = 304 * MiB, WS_S5 = 368 * MiB, WS_S6 = 432 * MiB, WS_END = 496 * MiB;
constexpr int CW_BAR = 4096;
constexpr int CW_TMO = 8, CW_SEAM = 16384, SEAM_BANK = 128 * 64;
constexpr size_t WS_XCH = 40 * MiB;
constexpr int RING_OFF = 0, RING_BYTES = 131072;
constexpr int LDSCTL_OFF = RING_BYTES, MISC_OFF = LDSCTL_OFF + 320;
constexpr int LDS_BYTES = 147456;

#define GAS __attribute__((address_space(1)))
#define LAS __attribute__((address_space(3)))
typedef unsigned v4u __attribute__((ext_vector_type(4)));
typedef GAS unsigned gu32;
#define RLX_AGENT __ATOMIC_RELAXED, __HIP_MEMORY_SCOPE_AGENT
#define LDS_WAIT() asm volatile("s_waitcnt lgkmcnt(0)" ::: "memory")
#define VM_WAIT() asm volatile("s_waitcnt vmcnt(0)" ::: "memory")

#define XB_TMO      128
#define XB_XCNT(j)  (256  + 64 * (j))
#define XB_XSUB(j)  (1280 + 64 * (j))
#define XB_XGEN(j)  (2304 + 64 * (j))
#define XB_TOP      3328
#define XB_TOPGEN   3392
#define XCD_BAR_WORDS 3456
#define XB_SPIN_CAP (1u << 18)
__device__ __forceinline__ unsigned xb_ld(unsigned* p)              { return __hip_atomic_load(p, __ATOMIC_RELAXED, __HIP_MEMORY_SCOPE_AGENT); }
__device__ __forceinline__ unsigned xb_add(unsigned* p, unsigned v) { return __hip_atomic_fetch_add(p, v, __ATOMIC_RELAXED, __HIP_MEMORY_SCOPE_AGENT); }
__device__ __forceinline__ unsigned xb_xcc_id() { return (unsigned)__builtin_amdgcn_s_getreg((3 << 11) | 20) & 0xFu; }
#define XB_SPIN(cond, bar) do { unsigned _sp = 0; while (cond) { __builtin_amdgcn_s_sleep(1); \
    if ((++_sp & 255u) == 0u) { if (xb_ld(&(bar)[XB_TMO])) break; if (_sp > XB_SPIN_CAP) { atomicAdd(&(bar)[XB_TMO], 1u); break; } } } } while (0)
struct XcdBarrier { unsigned* bar; unsigned x; volatile LAS unsigned* st; };
__device__ __forceinline__ XcdBarrier xcd_barrier_post(unsigned* bar, volatile LAS unsigned* st, int tid) {
    XcdBarrier b; b.bar = bar; b.x = xb_xcc_id(); b.st = st;
    if (tid == 0) (void)xb_add(&bar[XB_XCNT(b.x)], 1u);
    return b;
}
__device__ __forceinline__ void xcd_barrier_complete(unsigned* bar, unsigned x, unsigned& nloc, unsigned& nx) {
    const unsigned G = gridDim.x * gridDim.y * gridDim.z;
    unsigned sum, cnt, mine, sp = 0u;
    for (;;) {
        sum = 0u; cnt = 0u; mine = 0u;
#pragma unroll
        for (unsigned j = 0; j < 16; ++j) { const unsigned c = xb_ld(&bar[XB_XCNT(j)]); sum += c; cnt += (c > 0u) ? 1u : 0u; mine = (j == x) ? c : mine; }
        if (sum == G) break;
        __builtin_amdgcn_s_sleep(1);
        if ((++sp & 255u) == 0u) { if (xb_ld(&bar[XB_TMO])) break; if (sp > XB_SPIN_CAP) { atomicAdd(&bar[XB_TMO], 1u); break; } }
    }
    nloc = mine > 0u ? mine : 1u; nx = cnt > 0u ? cnt : 1u;
}
__device__ __forceinline__ void xcd_barrier(const XcdBarrier& b, int tid) {
    asm volatile("s_waitcnt vmcnt(0)" ::: "memory");
    __syncthreads();
    if (tid == 0) {
        unsigned* bar = b.bar;
        __builtin_amdgcn_s_waitcnt(0);
        unsigned nloc = b.st[0], nx = b.st[1];
        if (nloc == 0u) { xcd_barrier_complete(bar, b.x, nloc, nx); b.st[0] = nloc; b.st[1] = nx; }
        const unsigned old = xb_add(&bar[XB_XSUB(b.x)], 1u);
        const unsigned gen = old / nloc;
        if (old + 1u == (gen + 1u) * nloc) {
            __builtin_amdgcn_fence(__ATOMIC_RELEASE, "agent");
            asm volatile("s_waitcnt vmcnt(0)" ::: "memory");
            const unsigned og = xb_add(&bar[XB_TOP], 1u);
            const unsigned tg = og / nx;
            if (og + 1u == (tg + 1u) * nx) xb_add(&bar[XB_TOPGEN], 1u);
            else XB_SPIN(xb_ld(&bar[XB_TOPGEN]) == tg, bar);
            __builtin_amdgcn_fence(__ATOMIC_ACQUIRE, "agent");
            xb_add(&bar[XB_XGEN(b.x)], 1u);
            asm volatile("s_waitcnt vmcnt(0)" ::: "memory");
        } else {
            XB_SPIN(xb_ld(&bar[XB_XGEN(b.x)]) == gen, bar);
            __builtin_amdgcn_fence(__ATOMIC_ACQUIRE, "agent");
            asm volatile("s_waitcnt vmcnt(0)" ::: "memory");
        }
    }
    __syncthreads();
}

__device__ __forceinline__ void p0_transpose_item(const float* W, int K, int N, bf16_t* WT, int row_off, const float* kscale, LAS float* scr, int item, int lane) {
    const int nblk = N / 32, kb = item / nblk, nb = item % nblk, k0 = 64 * kb, n0 = 32 * nb;
    float tv[32];
#pragma unroll
    for (int i = 0; i < 32; ++i) tv[i] = NT_LD(W + (size_t)(k0 + 2 * i + (lane >> 5)) * N + n0 + (lane & 31));
#pragma unroll
    for (int i = 0; i < 32; ++i) { const int kk = 2 * i + (lane >> 5); float v = tv[i]; if (kscale) v *= kscale[k0 + kk]; scr[kk * 33 + (lane & 31)] = v; }
    LDS_WAIT(); asm volatile("" ::: "memory");
    const int c = lane & 7;
#pragma unroll
    for (int j = 0; j < 4; ++j) { const int n = (lane >> 3) + 8 * j; const LAS float* s = scr + (8 * c) * 33 + n;
        v4u o; o.x = pk2bf(s[0 * 33], s[1 * 33]); o.y = pk2bf(s[2 * 33], s[3 * 33]); o.z = pk2bf(s[4 * 33], s[5 * 33]); o.w = pk2bf(s[6 * 33], s[7 * 33]);
        *(GAS v4u*)(WT + (size_t)(row_off + n0 + n) * K + k0 + 8 * c) = o; }
    LDS_WAIT(); asm volatile("" ::: "memory");
}

__device__ __forceinline__ int lane_now_asm() { int r; asm volatile("v_mbcnt_lo_u32_b32 %0, -1, 0\n\tv_mbcnt_hi_u32_b32 %0, -1, %0" : "=v"(r)); return r; }
struct Args {
    const float* in[28]; float* out; unsigned char* ws;
    int ph_lo, ph_hi, use_bar, flags;
};

__global__ void __launch_bounds__(NWAVES * 64, 2) mega_fwd(Args args) {
    extern __shared__ __attribute__((aligned(16))) unsigned char lds_raw[];
    LAS unsigned char* lds = (LAS unsigned char*)lds_raw;
    volatile LAS unsigned* MISC = (volatile LAS unsigned*)(lds + MISC_OFF);
    const int wave = __builtin_amdgcn_readfirstlane((int)threadIdx.x >> 6);
#define LANE_NOW() lane_now_asm()
#define TID_NOW() (wave * 64 + LANE_NOW())
    const int G = gridDim.x; const int bx = blockIdx.x; const int vcu = (G % 8 == 0) ? (bx % 8) * (G / 8) + bx / 8 : bx;
    unsigned char* ws = args.ws;
    gu32* ctl = (gu32*)(ws + WS_CTL);
    const float* x = args.in[0]; const float* cvec = args.in[1]; const float* ada_w = args.in[2]; const float* ada_b = args.in[3];
    const float* g_pre = args.in[4]; const float* g_post = args.in[5];
    float* out = args.out;
    float* mod = (float*)(ws + WS_MOD); float* lamp = (float*)(ws + WS_LAM); float* lb16 = (float*)(ws + WS_LB16);
    bf16_t* Win0 = (bf16_t*)(ws + WS_WIN0); bf16_t* Wglu = (bf16_t*)(ws + WS_WGLU); bf16_t* Wout0 = (bf16_t*)(ws + WS_WOUT0); bf16_t* Wkv = (bf16_t*)(ws + WS_WKV);
    bf16_t* Win1 = (bf16_t*)(ws + WS_WIN1); bf16_t* Wout1 = (bf16_t*)(ws + WS_WOUT1); bf16_t* BtA = (bf16_t*)(ws + WS_BTA); bf16_t* BtB = (bf16_t*)(ws + WS_BTB);
    bf16_t* A0 = (bf16_t*)(ws + WS_S0); bf16_t* US = (bf16_t*)(ws + WS_S1); bf16_t* SZ = (bf16_t*)(ws + WS_S3); bf16_t* YG = (bf16_t*)(ws + WS_S4); float* EB = (float*)(ws + WS_S0);
    bf16_t* Y2 = (bf16_t*)(ws + WS_S0); bf16_t* YO = (bf16_t*)(ws + WS_S1); bf16_t* AKV = (bf16_t*)(ws + WS_S0); bf16_t* AIN1 = (bf16_t*)(ws + WS_S2);
    bf16_t* KB = (bf16_t*)(ws + WS_S3); bf16_t* VB = (bf16_t*)(ws + WS_S4); bf16_t* QB = (bf16_t*)(ws + WS_S5); bf16_t* SZ1 = (bf16_t*)(ws + WS_S6);
    bf16_t* O0 = (bf16_t*)(ws + WS_S0); bf16_t* O1 = (bf16_t*)(ws + WS_S1); bf16_t* OG = (bf16_t*)(ws + WS_S2); bf16_t* YO1 = (bf16_t*)(ws + WS_S0);

    for (int u = TID_NOW(); u < (LDS_BYTES - LDSCTL_OFF) / 4; u += NWAVES * 64) ((LAS unsigned*)(lds + LDSCTL_OFF))[u] = 0u;
    __syncthreads();
    XcdBarrier bar; bar.bar = (unsigned*)(ctl + CW_BAR); bar.x = 0; bar.st = nullptr;
    if (args.use_bar) bar = xcd_barrier_post((unsigned*)(ctl + CW_BAR), MISC + 8, TID_NOW());
    const int lo = args.ph_lo, hi = args.ph_hi;
#define IN(k) (lo <= (k) && (k) < hi)
#define REPS(k) (1 + ((REPEAT_MASK >> (k)) & 1))
#define SEAM(k) do { if (IN(k) && IN((k) + 1) && args.use_bar) xcd_barrier(bar, TID_NOW()); } while (0)
    const int gw = vcu * NWAVES + wave, NGW = G * NWAVES;
#define LANE_L() ({ int l_ = LANE_NOW(); asm volatile("" : "+v"(l_)); l_; })

    if (IN(0)) for (int rep_ = 0; rep_ < REPS(0); ++rep_) {
        const int tid = TID_NOW(), lane = tid & 63;
        for (int it = vcu; it < NGRP * 4; it += G) {
            const int g = it >> 2, qt = it & 3;
            LAS float* LBP = (LAS float*)(lds + RING_OFF);
            LAS float* BBR = LBP + 17 * 128;
            LAS float* CC = BBR + 64 * 32;
            LAS float* KM = CC + 16 * 130 + 12;
            __syncthreads();
            if (tid < 64) {
                const int p = tid;
                const float dt = expf(args.in[9][g]);
                const float lr = args.in[7][g * 64 + p], li = args.in[8][g * 64 + p];
                const float mag = expf(lr * dt); const float sn = sinf(li * dt), cs = cosf(li * dt);
                const float lbr = mag * cs, lbi = mag * sn;
                float pr = 1.f, pi = 0.f;
                for (int d = 0; d <= 16; ++d) { LBP[(d * 64 + p) * 2] = pr; LBP[(d * 64 + p) * 2 + 1] = pi; const float nr = pr * lbr - pi * lbi, ni = pr * lbi + pi * lbr; pr = nr; pi = ni; }
                if (qt == 0) { lb16[(g * 64 + p) * 2] = LBP[(16 * 64 + p) * 2]; lb16[(g * 64 + p) * 2 + 1] = LBP[(16 * 64 + p) * 2 + 1]; }
                const float nr = lbr - 1.0f, ni = lbi, den = lr * lr + li * li;
                const float cr = (nr * lr + ni * li) / den, ci = (ni * lr - nr * li) / den;
                for (int c = 0; c < 16; ++c) { const float br = args.in[10][(g * 64 + p) * 16 + c], bi = args.in[11][(g * 64 + p) * 16 + c];
                    BBR[(p * 16 + c) * 2] = cr * br - ci * bi; BBR[(p * 16 + c) * 2 + 1] = cr * bi + ci * br; }
            }
            for (int e = tid; e < 1024; e += 512) { const int co = e >> 6, p = e & 63; CC[(co * 65 + p) * 2] = args.in[12][(g * 16 + co) * 64 + p]; CC[(co * 65 + p) * 2 + 1] = args.in[13][(g * 16 + co) * 64 + p]; }
            __syncthreads();
            {
                const int pair = tid >> 1, hh = tid & 1, d = pair >> 4, co = pair & 15; float acc8[8];
#pragma unroll
                for (int j = 0; j < 8; ++j) acc8[j] = 0.f;
                for (int p = 0; p < 64; ++p) { const float cr = CC[(co * 65 + p) * 2], cim = CC[(co * 65 + p) * 2 + 1], lr = LBP[(d * 64 + p) * 2], lim = LBP[(d * 64 + p) * 2 + 1];
                    const float wr_ = cr * lr - cim * lim, wi_ = cr * lim + cim * lr; const LAS f32x4_t* bp = (const LAS f32x4_t*)(BBR + (p * 16 + 8 * hh) * 2);
#pragma unroll
                    for (int q4 = 0; q4 < 4; ++q4) { const f32x4_t bb = bp[q4]; acc8[2 * q4] += wr_ * bb.x - wi_ * bb.y; acc8[2 * q4 + 1] += wr_ * bb.z - wi_ * bb.w; } }
#pragma unroll
                for (int j = 0; j < 8; ++j) KM[(d * 16 + co) * 16 + 8 * hh + j] = acc8[j];
            }
            __syncthreads();
            for (int e = tid; e < 64 * 48; e += 512) {
                const int n = 64 * qt + e / 48, pc = e % 48, s = n >> 4, co = n & 15; float v[8];
                if (pc < 32) { const int s2 = pc >> 1, ci0 = (pc & 1) * 8;
#pragma unroll
                    for (int j = 0; j < 8; ++j) v[j] = (s2 <= s) ? KM[((s - s2) * 16 + co) * 16 + ci0 + j] : 0.f;
                } else { const int j0 = (pc - 32) * 8;
#pragma unroll
                    for (int jj = 0; jj < 4; ++jj) { const int p = (j0 >> 1) + jj; const float cr = CC[(co * 65 + p) * 2], cim = CC[(co * 65 + p) * 2 + 1], lr = LBP[((s + 1) * 64 + p) * 2], lim = LBP[((s + 1) * 64 + p) * 2 + 1];
                        v[2 * jj] = cr * lr - cim * lim; v[2 * jj + 1] = -(cr * lim + cim * lr); } }
                v4u o; o.x = pk2bf(v[0], v[1]); o.y = pk2bf(v[2], v[3]); o.z = pk2bf(v[4], v[5]); o.w = pk2bf(v[6], v[7]);
                *(GAS v4u*)(BtB + ((size_t)g * 256 + n) * 384 + pc * 8) = o; }
            for (int e = tid; e < 64 * 32; e += 512) {
                const int n = 64 * qt + (e >> 5), pc = e & 31; float v[8];
                if (n < 128) { const int p = n >> 1, ri = n & 1, s2 = pc >> 1, ci0 = (pc & 1) * 8; const float lr = LBP[((15 - s2) * 64 + p) * 2], lim = LBP[((15 - s2) * 64 + p) * 2 + 1];
#pragma unroll
                    for (int j = 0; j < 8; ++j) { const float br = BBR[(p * 16 + ci0 + j) * 2], bi = BBR[(p * 16 + ci0 + j) * 2 + 1]; v[j] = ri ? (lr * bi + lim * br) : (lr * br - lim * bi); }
                } else {
#pragma unroll
                    for (int j = 0; j < 8; ++j) v[j] = 0.f; }
                v4u o; o.x = pk2bf(v[0], v[1]); o.y = pk2bf(v[2], v[3]); o.z = pk2bf(v[4], v[5]); o.w = pk2bf(v[6], v[7]);
                *(GAS v4u*)(BtA + ((size_t)g * 256 + n) * 256 + pc * 8) = o; }
        }
        __syncthreads();
        {
            LAS float* scr = (LAS float*)(lds + RING_OFF + wave * 16384);
            constexpr int I_2K = (DM / 64) * (2048 / 32), I_1K = (DM / 64) * (1024 / 32);
            constexpr int NITEMS = 2 * I_2K + 5 * I_1K;
            for (int it = gw; it < NITEMS; it += NGW) {
                int r = it;
                if (r < I_2K) { p0_transpose_item(args.in[6], DM, 2048, Win0, 0, nullptr, scr, r, lane); continue; } r -= I_2K;
                if (r < I_2K) { p0_transpose_item(args.in[21], DM, 2048, Win1, 0, nullptr, scr, r, lane); continue; } r -= I_2K;
                if (r < I_1K) { p0_transpose_item(args.in[15], DM, 1024, Wglu, 0, nullptr, scr, r, lane); continue; } r -= I_1K;
                if (r < I_1K) { p0_transpose_item(args.in[17], DM, 1024, Wout0, 0, nullptr, scr, r, lane); continue; } r -= I_1K;
                if (r < I_1K) { p0_transpose_item(args.in[19], DM, 1024, Wkv, 0, args.in[18], scr, r, lane); continue; } r -= I_1K;
                if (r < I_1K) { p0_transpose_item(args.in[20], DM, 1024, Wkv, 1024, args.in[18], scr, r, lane); continue; } r -= I_1K;
                p0_transpose_item(args.in[27], DM, 1024, Wout1, 0, nullptr, scr, r, lane);
            }
        }
        if (!(args.flags & 1)) {
            __syncthreads();
            LAS float* sc = (LAS float*)(lds + RING_OFF);
            LAS float* red = sc + 8192;
            bool have = false;
            for (int it = vcu; it < 2 * 96; it += G) {
                if (!have) { for (int e = tid; e < 8192; e += 512) sc[e] = silu_f(cvec[e]); have = true; __syncthreads(); }
                const int l = it / 96, cc = it % 96, j = cc * 32 + (lane & 31), kh = lane >> 5;
                float acc[8];
#pragma unroll
                for (int b = 0; b < 8; ++b) acc[b] = 0.f;
                const float* wp = ada_w + ((size_t)l * 1024 + wave * 128 + kh) * 3072 + j;
                for (int k0 = 0; k0 < 64; k0 += 32) {
                    float w[32];
#pragma unroll
                    for (int kk = 0; kk < 32; ++kk) w[kk] = NT_LD(wp + (size_t)(2 * (k0 + kk)) * 3072);
#pragma unroll
                    for (int kk = 0; kk < 32; ++kk) {
#pragma unroll
                        for (int b = 0; b < 8; ++b) acc[b] += w[kk] * sc[b * 1024 + wave * 128 + 2 * (k0 + kk) + kh];
                        if ((kk & 3) == 3) asm volatile("" ::: "memory"); }
                }
#pragma unroll
                for (int b = 0; b < 8; ++b) { acc[b] += __shfl_xor(acc[b], 32); if (lane < 32) red[(wave * 8 + b) * 32 + lane] = acc[b]; }
                __syncthreads();
                if (tid < 256) { const int b = tid >> 5, jl = tid & 31; float sum = ada_b[l * 3072 + cc * 32 + jl];
#pragma unroll
                  for (int w = 0; w < 8; ++w) sum += red[(w * 8 + b) * 32 + jl];
                  mod[((size_t)(l * 8 + b)) * 3072 + cc * 32 + jl] = sum; }
                __syncthreads();
            }
            if (bx == 0 && tid == 0) lamp[0] = diff_lambda(args.in[22], args.in[23], args.in[24], args.in[25]);
        }
    }
    SEAM(0);
    if (IN(1)) for (int rep_ = 0; rep_ < REPS(1); ++rep_) e_norm0(x, mod, g_pre, A0, gw, NGW, LANE_L());
    SEAM(1);
#ifdef EXTRA_BARS
    if (args.use_bar) for (int eb = 0; eb < EXTRA_BARS; ++eb) xcd_barrier(bar, TID_NOW());
#endif
    if (IN(2)) for (int rep_ = 0; rep_ < REPS(2); ++rep_) {
        pg8::Gemm g = pg8::gemm_std(A0, DM, Win0, DM, DM); pg8::Order S; S.init(MTOK / 256, 2048 / 256, 1, G, bx);
        pg8::EpiRow8<pg8::F_In0> E{{US, SZ}};
        pg8::gemm_phase<pg8::EpiRow8<pg8::F_In0>, ALIGN_E>(lds + RING_OFF, g, S, E, TID_NOW());
    }
    SEAM(2);
#if SSM_FUSED
    if (IN(3)) {
        pg8::Gemm gA = pg8::gemm_std(US, US_P, BtA, 256, 256); gA.a_gstep = (size_t)NTILE * US_P * 2; gA.b_gstep = (size_t)256 * 256 * 2;
        pg8::Gemm gB = pg8::gemm_std(US, US_P, BtB, 384, 384); gB.a_gstep = (size_t)NTILE * US_P * 2; gB.b_gstep = (size_t)256 * 384 * 2;
        pg8::EpiScan ES{lb16, US, LDSCTL_OFF + 2048};
        pg8::EpiRow8<pg8::F_SsmB> EB2{{US, args.in[14], YG}};
        for (int uu = 0; (long)uu * G + bx < NGRP * NB; ++uu) {
            pg8::Order S; S.init(NTILE / 256, 1, NGRP, G, bx); S.only = uu;
            pg8::gemm_phase<pg8::EpiScan, false>(lds + RING_OFF, gA, S, ES, TID_NOW());
            pg8::gemm_phase<pg8::EpiRow8<pg8::F_SsmB>, false>(lds + RING_OFF, gB, S, EB2, TID_NOW());
        }
    }
    SEAM(5);
#else
    if (IN(3)) for (int rep_ = 0; rep_ < REPS(3); ++rep_) {
        pg8::Gemm g = pg8::gemm_std(US, US_P, BtA, 256, 256); g.a_gstep = (size_t)NTILE * US_P * 2; g.b_gstep = (size_t)256 * 256 * 2;
        pg8::Order S; S.init(NTILE / 256, 1, NGRP, G, bx);
        pg8::EpiRow8<pg8::F_SsmA> E{{EB}};
        pg8::gemm_phase<pg8::EpiRow8<pg8::F_SsmA>, ALIGN_E>(lds + RING_OFF, g, S, E, TID_NOW());
    }
    SEAM(3);
    if (IN(4)) for (int rep_ = 0; rep_ < REPS(4); ++rep_) {
        for (int it = vcu + G * wave; it < NB * NGRP; it += G * NWAVES) {
            const int b = it / NGRP, g = it % NGRP, p = LANE_L();
            const float lr = lb16[(g * 64 + p) * 2], li = lb16[(g * 64 + p) * 2 + 1];
            float sr = 0.f, si = 0.f;
            const float* ep = EB + ((size_t)g * NTILE + b * 256) * 128 + 2 * p;
            bf16_t* sp = US + us_off(g, b * 256, 256 + 2 * p);
            for (int t0 = 0; t0 < 256; t0 += 16) {
                float er[16], ei[16];
#pragma unroll
                for (int j = 0; j < 16; ++j) { const float2 e = *(const float2*)(ep + (size_t)(t0 + j) * 128); er[j] = e.x; ei[j] = e.y; }
#pragma unroll
                for (int j = 0; j < 16; ++j) { *(unsigned*)(sp + (size_t)(t0 + j) * US_P) = pk2bf(sr, si);
                    const float nr = lr * sr - li * si + er[j], ni = lr * si + li * sr + ei[j]; sr = nr; si = ni; }
            }
        }
    }
    SEAM(4);
    if (IN(5)) for (int rep_ = 0; rep_ < REPS(5); ++rep_) {
        pg8::Gemm g = pg8::gemm_std(US, US_P, BtB, 384, 384); g.a_gstep = (size_t)NTILE * US_P * 2; g.b_gstep = (size_t)256 * 384 * 2;
        pg8::Order S; S.init(NTILE / 256, 1, NGRP, G, bx);
        pg8::EpiRow8<pg8::F_SsmB> E{{US, args.in[14], YG}};
        pg8::gemm_phase<pg8::EpiRow8<pg8::F_SsmB>, ALIGN_E>(lds + RING_OFF, g, S, E, TID_NOW());
    }
    SEAM(5);
#endif
    if (IN(6)) for (int rep_ = 0; rep_ < REPS(6); ++rep_) {
        pg8::Gemm g = pg8::gemm_std(YG, DM, Wglu, DM, DM);
        g.a_rs = 32u; g.a_c16 = (unsigned)((size_t)NTILE * YG_P * 2); g.a_kstep = (size_t)4 * NTILE * YG_P * 2; g.a_tstep = (size_t)256 * 32;
        pg8::Order S; S.init(MTOK / 256, 1024 / 256, 1, G, bx);
        pg8::EpiRow8<pg8::F_Glu> E{{YG, SZ, args.in[16], Y2}};
        pg8::gemm_phase<pg8::EpiRow8<pg8::F_Glu>, ALIGN_E>(lds + RING_OFF, g, S, E, TID_NOW());
    }
    SEAM(6);
#if FUSE_EPI
    if (IN(7)) {
        pg8::Gemm g = pg8::gemm_std(Y2, DM, Wout0, DM, DM);
        for (int half = 0; half < 2; ++half) {
            pg8::Order S; S.init(MTOK / 512, 1024 / 256, 1, G, bx); S.pm_off = half * (MTOK / 512);
            pg8::PanelRms st1{(unsigned*)(ws + WS_XCH), (unsigned*)(ctl + CW_SEAM), (unsigned*)(ctl + CW_TMO), RMS_EPS};
            pg8::PanelRms st2{(unsigned*)(ws + WS_XCH + 1 * MiB), (unsigned*)(ctl + CW_SEAM + SEAM_BANK), (unsigned*)(ctl + CW_TMO), RMS_EPS};
            pg8::EpiMid E{x, out, AKV, AIN1, mod, g_post, g_pre + 1024, st1, st2};
            pg8::gemm_phase<pg8::EpiMid, false>(lds + RING_OFF, g, S, E, TID_NOW());
        }
    }
#else
    if (IN(7)) {
        pg8::Gemm g = pg8::gemm_std(Y2, DM, Wout0, DM, DM); pg8::Order S; S.init(MTOK / 256, 1024 / 256, 1, G, bx);
        pg8::EpiRow8<pg8::F_Plain> E{{YO}};
        pg8::gemm_phase<pg8::EpiRow8<pg8::F_Plain>, ALIGN_E>(lds + RING_OFF, g, S, E, TID_NOW());
    }
    SEAM(7);
    if (IN(8)) { if (H1_BF16) e_mid(x, YO, mod, g_post, g_pre, (float*)nullptr, YO, AKV, AIN1, gw, NGW, LANE_L()); else e_mid(x, YO, mod, g_post, g_pre, out, (bf16_t*)nullptr, AKV, AIN1, gw, NGW, LANE_L()); }
#endif
    SEAM(8);
    if (IN(9)) for (int rep_ = 0; rep_ < REPS(9); ++rep_) {
        pg8::Gemm g = pg8::gemm_std(AKV, DM, Wkv, DM, DM); g.a_gstep = (size_t)(WS_S2 - WS_S0); g.b_gstep = (size_t)(WS_WIN1 - WS_WKV);
        pg8::Order S; S.init(MTOK / 256, 2048 / 256, 2, G, bx); S.mode2 = (G == 256);
        pg8::EpiRow8<pg8::F_Split2> E{{{KB, QB}, {VB, SZ1}}};
        pg8::gemm_phase<pg8::EpiRow8<pg8::F_Split2>, ALIGN_E>(lds + RING_OFF, g, S, E, TID_NOW());
    }
    SEAM(9);
    if (IN(10)) {
#if ATTN_V128
#if ATTN_FUSE_POST
        { const float lam = __int_as_float(__builtin_amdgcn_readfirstlane(__float_as_int(lamp[0])));
          attn_body::bf16x8 qr[4]; bool primed = false;
#if ATTN_PRIO
          if (wave >= 4) __builtin_amdgcn_s_setprio(1);
#endif
          const int nun = (64 * 16 - vcu + G - 1) / G;
#pragma unroll 1
          for (int su = 0; su < 2 * nun; ++su) {
            const int i = su >> 1, cc = su & 1;
            const long L = (long)i * G + vcu; const int pr = (int)(L % 256), qi = (int)(L / 256);
            const int bh = pr >> 2, j = pr & 3; const int qb = (qi & 1) ? (8 * (qi >> 1) + 7 - j) : (8 * (qi >> 1) + j); const int h = bh & 7, b = bh >> 3;
            const bool has_next = su + 1 < 2 * nun;
            const int i2 = (su + 1) >> 1, cc2 = (su + 1) & 1;
            const long L2 = (long)i2 * G + vcu; const int pr2 = (int)(L2 % 256), qi2 = (int)(L2 / 256);
            const int bh2 = pr2 >> 2, j2 = pr2 & 3; const int qb2 = (qi2 & 1) ? (8 * (qi2 >> 1) + 7 - j2) : (8 * (qi2 >> 1) + j2); const int h2 = bh2 & 7, b2 = bh2 >> 3;
            attn3::attn_unit<8>(TID_NOW(), b, 2 * h + cc, h, qb, QB, KB, VB, O0, (char*)lds_raw + RING_OFF, cc, SZ1, args.in[26], lam, OG, primed, has_next, b2, 2 * h2 + cc2, h2, qb2, qr);
            primed = true;
          }
#if ATTN_PRIO
          __builtin_amdgcn_s_setprio(0);
#endif
          }
#else
        for (int i = 0;; ++i) {
            const long L = (long)i * G + vcu; if (L >= 128 * 16) break;
            const int pr = (int)(L % 256), qi = (int)(L / 256);
            const int combo = pr >> 1, j = pr & 1;
            const int k4 = qi >> 1; const int qb = (qi & 1) ? (4 * k4 + 3 - j) : (4 * k4 + j);
            const int c = combo & 1, h = (combo >> 1) & 7, b = combo >> 4;
            { attn_body::bf16x8 qr_[4]; attn3::attn_unit<8>(TID_NOW(), b, 2 * h + c, h, qb, QB, KB, VB, c ? O1 : O0, (char*)lds_raw + RING_OFF, 0, SZ1, args.in[26], 0.f, OG, false, false, 0, 0, 0, 0, qr_); asm volatile("s_barrier" ::: "memory"); }
        }
#endif
#else
        for (int i = 0;; ++i) {
            const long L = (long)i * G + vcu; if (L >= 256 * 16) break;
            const int combo = (int)(L % 256), qi = (int)(L / 256);
            const int qb = (qi & 1) ? (qi >> 1) : (15 - (qi >> 1));
            const int vh = combo & 1, c = (combo >> 1) & 1, h = (combo >> 2) & 7, b = combo >> 5;
            attn_body::attn_unit<8>(TID_NOW(), b, 2 * h + c, 2 * h + vh, qb, QB, KB, VB, c ? O1 : O0, (char*)lds_raw + RING_OFF);
        }
#endif
    }
    SEAM(10);
#if !(ATTN_V128 && ATTN_FUSE_POST)
    if (IN(11)) for (int rep_ = 0; rep_ < REPS(11); ++rep_) e_attn_post(O0, O1, SZ1, args.in[26], lamp[0], OG, gw, NGW, LANE_L());
    SEAM(11);
#endif
#if FUSE_EPI
    if (IN(12)) {
        pg8::Gemm g = pg8::gemm_std(OG, DM, Wout1, DM, DM);
        for (int half = 0; half < 2; ++half) {
            pg8::Order S; S.init(MTOK / 512, 1024 / 256, 1, G, bx); S.pm_off = half * (MTOK / 512);
            pg8::PanelRms st{(unsigned*)(ws + WS_XCH + 2 * MiB), (unsigned*)(ctl + CW_SEAM + 2 * SEAM_BANK), (unsigned*)(ctl + CW_TMO), RMS_EPS};
            pg8::EpiFinal E{out, out, mod + 8 * 3072, g_post + 1024, st};
            pg8::gemm_phase<pg8::EpiFinal, false>(lds + RING_OFF, g, S, E, TID_NOW());
        }
    }
#else
    if (IN(12)) {
        pg8::Gemm g = pg8::gemm_std(OG, DM, Wout1, DM, DM); pg8::Order S; S.init(MTOK / 256, 1024 / 256, 1, G, bx);
        pg8::EpiRow8<pg8::F_Plain> E{{YO1}};
        pg8::gemm_phase<pg8::EpiRow8<pg8::F_Plain>, ALIGN_E>(lds + RING_OFF, g, S, E, TID_NOW());
    }
    SEAM(12);
    if (IN(13)) { if (H1_BF16) e_final_b(YO, out, YO1, mod, g_post, gw, NGW, LANE_L()); else e_final(out, YO1, mod, g_post, gw, NGW, LANE_L()); }
#endif
#undef IN
#undef SEAM
}

#ifndef FASTMASK
#define FASTMASK 0x3fff
#endif
#ifndef ONE_LAUNCH
#define ONE_LAUNCH 1
#endif
constexpr int NPHASE = 14;

extern "C" void kernel_launch(void* const* d_in, const int* in_sizes, int n_in, void* d_out, int out_size, void* d_ws, size_t ws_size, hipStream_t stream) {
    static int grid = 0;
    if (grid == 0) {
        if (n_in != 28 || out_size != MTOK * DM || ws_size < WS_END) { fprintf(stderr, "kernel_launch: unexpected shapes (n_in %d out %d ws %zu)\n", n_in, out_size, ws_size); grid = -1; return; }
        int dev = 0, cus = 0, per_cu = 0;
        if (hipGetDevice(&dev) != hipSuccess || hipDeviceGetAttribute(&cus, hipDeviceAttributeMultiprocessorCount, dev) != hipSuccess) { grid = -1; return; }
        if (hipFuncSetAttribute((const void*)mega_fwd, hipFuncAttributeMaxDynamicSharedMemorySize, LDS_BYTES) != hipSuccess) { fprintf(stderr, "kernel_launch: hipFuncSetAttribute failed\n"); grid = -1; return; }
        if (hipOccupancyMaxActiveBlocksPerMultiprocessor(&per_cu, (const void*)mega_fwd, NWAVES * 64, LDS_BYTES) != hipSuccess || per_cu < 1) { fprintf(stderr, "kernel_launch: occupancy query says %d\n", per_cu); }
        (void)hipGetLastError();
        grid = cus;
    }
    if (grid < 0) return;
    if (hipMemsetAsync((char*)d_ws + WS_CTL + (size_t)CW_BAR * 4, 0, (size_t)XCD_BAR_WORDS * 4, stream) != hipSuccess) { fprintf(stderr, "kernel_launch: memset failed\n"); return; }
    Args a{};
    for (int i = 0; i < 28; ++i) a.in[i] = (const float*)d_in[i];
    a.out = (float*)d_out; a.ws = (unsigned char*)d_ws;
#if ONE_LAUNCH
    a.ph_lo = 0; a.ph_hi = NPHASE; a.use_bar = 1; a.flags = 0;
    hipLaunchKernelGGL(mega_fwd, dim3(grid), dim3(NWAVES * 64), LDS_BYTES, stream, a);
#else
    const float* x = a.in[0]; unsigned char* ws = a.ws; float* out = a.out;
    float* mod = (float*)(ws + WS_MOD); float* lam = (float*)(ws + WS_LAM);
    bf16_t* A0 = (bf16_t*)(ws + WS_S0); bf16_t* US = (bf16_t*)(ws + WS_S1); bf16_t* SZ = (bf16_t*)(ws + WS_S3); bf16_t* YG = (bf16_t*)(ws + WS_S4);
    bf16_t* Y2 = (bf16_t*)(ws + WS_S0); bf16_t* YO = (bf16_t*)(ws + WS_S1); bf16_t* AKV = (bf16_t*)(ws + WS_S0); bf16_t* AIN1 = (bf16_t*)(ws + WS_S2);
    bf16_t* KB = (bf16_t*)(ws + WS_S3); bf16_t* VB = (bf16_t*)(ws + WS_S4); bf16_t* QB = (bf16_t*)(ws + WS_S5); bf16_t* SZ1 = (bf16_t*)(ws + WS_S6);
    bf16_t* O0 = (bf16_t*)(ws + WS_S0); bf16_t* O1 = (bf16_t*)(ws + WS_S1); bf16_t* OG = (bf16_t*)(ws + WS_S2); bf16_t* YO1 = (bf16_t*)(ws + WS_S0);
    const int EG = 2048;
    auto fast1 = [&](int lo, int hi, int flags) { a.ph_lo = lo; a.ph_hi = hi; a.use_bar = 0; a.flags = flags; hipLaunchKernelGGL(mega_fwd, dim3(grid), dim3(NWAVES * 64), LDS_BYTES, stream, a); };
    auto fast = [&](int lo, int hi, int flags) { fast1(lo, hi, flags); if (lo == EXTRA_PHASE) fast1(lo, hi, flags); };
    const unsigned FM = FASTMASK;
    if (FM & 1u) fast(0, 1, 0);
    else { fast(0, 1, 1); n_adaln<<<(2 * 8 * 3072 + 255) / 256, 256, 0, stream>>>(a.in[1], a.in[2], a.in[3], mod); n_lambda<<<1, 64, 0, stream>>>(a.in[22], a.in[23], a.in[24], a.in[25], lam); }
    if (FM & 2u) fast(1, 2, 0); else n_norm0<<<EG, 256, 0, stream>>>(x, mod, a.in[4], A0);
    if (FM & 4u) fast(2, 3, 0); else n_gemm<<<dim3(2048 / 64, MTOK / 64), 256, 0, stream>>>(AL_Row{A0}, WL_Plain{a.in[6], 2048}, EP_In0{US, SZ}, 2048);
    if (FM & 8u) { fast(3, 4, 0); fast(4, 5, 0); fast(5, 6, 0); }
    else n_ssm<<<NB * NGRP / 4, 256, 0, stream>>>(US, a.in[7], a.in[8], a.in[9], a.in[10], a.in[11], a.in[12], a.in[13], a.in[14], YG);
    if (FM & 64u) fast(6, 7, 0); else n_gemm<<<dim3(1024 / 64, MTOK / 64), 256, 0, stream>>>(AL_YG{YG}, WL_Plain{a.in[15], 1024}, EP_Glu{YG, SZ, a.in[16], Y2}, 1024);
    if (FM & 128u) fast(7, 8, 0); else n_gemm<<<dim3(1024 / 64, MTOK / 64), 256, 0, stream>>>(AL_Row{Y2}, WL_Plain{a.in[17], 1024}, EP_Plain{YO}, 1024);
    if (FM & 256u) fast(8, 9, 0); else n_mid<<<EG, 256, 0, stream>>>(x, YO, mod, a.in[5], a.in[4], out, AKV, AIN1);
    if (FM & 512u) fast(9, 10, 0);
    else { n_gemm<<<dim3(2048 / 64, MTOK / 64), 256, 0, stream>>>(AL_Row{AKV}, WL_KV{a.in[19], a.in[20], a.in[18]}, EP_KV{KB, VB}, 2048);
           n_gemm<<<dim3(2048 / 64, MTOK / 64), 256, 0, stream>>>(AL_Row{AIN1}, WL_Plain{a.in[21], 2048}, EP_In1{QB, SZ1}, 2048); }
    if (FM & 1024u) fast(10, 11, 0); else n_attn<<<MTOK * 8 / 4, 256, 0, stream>>>(QB, KB, VB, O0, O1);
    if (FM & 2048u) fast(11, 12, 0); else n_attn_post<<<EG, 256, 0, stream>>>(O0, O1, SZ1, a.in[26], lam, OG);
    if (FM & 4096u) fast(12, 13, 0); else n_gemm<<<dim3(1024 / 64, MTOK / 64), 256, 0, stream>>>(AL_Row{OG}, WL_Plain{a.in[27], 1024}, EP_Plain{YO1}, 1024);
    if (FM & 8192u) fast(13, 14, 0); else n_final<<<EG, 256, 0, stream>>>(out, YO1, mod, a.in[5]);
#endif
    const hipError_t le = hipPeekAtLastError();
    if (le != hipSuccess) fprintf(stderr, "kernel_launch: launch failed: %s\n", hipGetErrorName(le));
}
```

```cpp
#include <hip/hip_runtime.h>
#include <cstdio>
#include <cstdint>
#include <cmath>
#define FASTMASK 0x3fff
#define ONE_LAUNCH 1
#define REPEAT_MASK 0

typedef unsigned short bf16_t;
constexpr int NB = 8, SEQL = 4096, DM = 1024, MTOK = NB * SEQL;
constexpr int NGRP = 64, NTILE = MTOK / 16;
constexpr int US_P = 384, YG_P = 256;
constexpr float LAMBDA_INIT = 0.35550907f;
constexpr float ONE_M_LI = 1.0f - LAMBDA_INIT;
constexpr float RMS_EPS = 1e-6f;
constexpr float QC2 = 0.125f * 1.4426950408889634f;

__device__ __forceinline__ float bf2f(bf16_t v) { return __uint_as_float((unsigned)v << 16); }
__device__ __forceinline__ unsigned f2bf_u(float f) { unsigned u = __float_as_uint(f); return (u + 0x7fffu + ((u >> 16) & 1u)) >> 16; }
__device__ __forceinline__ bf16_t f2bf(float f) { return (bf16_t)f2bf_u(f); }
__device__ __forceinline__ unsigned pk2bf(float lo, float hi) { return f2bf_u(lo) | (f2bf_u(hi) << 16); }
__device__ __forceinline__ float silu_f(float v) { return v / (1.0f + __expf(-v)); }
__device__ __forceinline__ float sigmoid_f(float v) { return 1.0f / (1.0f + __expf(-v)); }
__device__ __forceinline__ float gelu_tanh_f(float v) {
    const float u = 0.7978845608028654f * (v + 0.044715f * v * v * v);
    const float e = __expf(2.0f * u);
    const float t = 1.0f - 2.0f / (e + 1.0f);
    return 0.5f * v * (1.0f + t);
}
__device__ __forceinline__ float wave_sum_f(float v) {
#pragma unroll
    for (int o = 1; o < 64; o <<= 1) v += __shfl_xor(v, o);
    return v;
}
__device__ __forceinline__ float wave_max_f(float v) {
#pragma unroll
    for (int o = 1; o < 64; o <<= 1) v = fmaxf(v, __shfl_xor(v, o));
    return v;
}
__device__ __forceinline__ size_t us_off(int g, int tile, int col) { return ((size_t)g * NTILE + tile) * US_P + col; }
__device__ __forceinline__ size_t yg_off(int g, int tile, int col) { return ((size_t)g * NTILE + tile) * YG_P + col; }

typedef float f32x4_t __attribute__((ext_vector_type(4)));
typedef unsigned u32x4_t __attribute__((ext_vector_type(4)));
typedef unsigned u32x2_t __attribute__((ext_vector_type(2)));
#ifndef USE_NT
#define USE_NT 1
#endif
#if USE_NT
#define NT_LD(p) __builtin_nontemporal_load(p)
#define NT_ST(p, v) __builtin_nontemporal_store((v), (p))
#else
#define NT_LD(p) (*(p))
#define NT_ST(p, v) (*(p) = (v))
#endif

__device__ __forceinline__ void e_norm0(const float* __restrict__ x, const float* __restrict__ mod, const float* __restrict__ g_pre, bf16_t* a0, int gw, int ngw, int lane) {
    for (int m = gw; m < MTOK; m += ngw) {
        const int b = m / SEQL;
        const f32x4_t* xr = (const f32x4_t*)(x + (size_t)m * DM) + lane;
        f32x4_t v[4]; float s = 0.f;
#pragma unroll
        for (int j = 0; j < 4; ++j) { v[j] = NT_LD(xr + 64 * j); s += (v[j].x * v[j].x + v[j].y * v[j].y) + (v[j].z * v[j].z + v[j].w * v[j].w); }
        const float r = rsqrtf(wave_sum_f(s) * (1.0f / DM) + RMS_EPS);
        const float* sh = mod + (size_t)b * 3072; const float* sc = sh + 1024;
        u32x2_t* o = (u32x2_t*)(a0 + (size_t)m * DM) + lane;
#pragma unroll
        for (int j = 0; j < 4; ++j) {
            const int c = 256 * j + 4 * lane;
            const f32x4_t g = *(const f32x4_t*)(g_pre + c), scv = *(const f32x4_t*)(sc + c), shv = *(const f32x4_t*)(sh + c);
            f32x4_t y = v[j] * r * g * (scv + 1.0f) + shv;
            u32x2_t w; w.x = pk2bf(y.x, y.y); w.y = pk2bf(y.z, y.w); o[64 * j] = w;
        }
    }
}
__device__ __forceinline__ void e_mid(const float* __restrict__ x, const bf16_t* __restrict__ yo, const float* __restrict__ mod, const float* __restrict__ g_post, const float* __restrict__ g_pre,
                                      float* h1, bf16_t* h1b, bf16_t* akv, bf16_t* ain1, int gw, int ngw, int lane) {
    for (int m = gw; m < MTOK; m += ngw) {
        const int b = m / SEQL;
        const f32x4_t* xr = (const f32x4_t*)(x + (size_t)m * DM) + lane;
        const u32x2_t* yr = (const u32x2_t*)(yo + (size_t)m * DM) + lane;
        f32x4_t v[4], y[4]; float s = 0.f;
#pragma unroll
        for (int j = 0; j < 4; ++j) { v[j] = NT_LD(xr + 64 * j); const u32x2_t w = NT_LD(yr + 64 * j);
            y[j].x = __uint_as_float(w.x << 16); y[j].y = __uint_as_float(w.x & 0xffff0000u); y[j].z = __uint_as_float(w.y << 16); y[j].w = __uint_as_float(w.y & 0xffff0000u);
            s += (y[j].x * y[j].x + y[j].y * y[j].y) + (y[j].z * y[j].z + y[j].w * y[j].w); }
        const float ry = rsqrtf(wave_sum_f(s) * (1.0f / DM) + RMS_EPS);
        const float* gate0 = mod + (size_t)b * 3072 + 2048;
        const float* sh1 = mod + (size_t)(8 + b) * 3072; const float* sc1 = sh1 + 1024;
        float s2 = 0.f;
        f32x4_t* ho = (f32x4_t*)(h1 + (size_t)m * DM) + lane;
#pragma unroll
        for (int j = 0; j < 4; ++j) { const int c = 256 * j + 4 * lane;
            const f32x4_t gp = *(const f32x4_t*)(g_post + c), gt = *(const f32x4_t*)(gate0 + c);
            v[j] = v[j] + gt * (y[j] * ry * gp);
            if (h1) NT_ST(ho + 64 * j, v[j]);
            if (h1b) { u32x2_t wq; wq.x = pk2bf(v[j].x, v[j].y); wq.y = pk2bf(v[j].z, v[j].w); ((u32x2_t*)(h1b + (size_t)m * DM) + lane)[64 * j] = wq; }
            s2 += (v[j].x * v[j].x + v[j].y * v[j].y) + (v[j].z * v[j].z + v[j].w * v[j].w); }
        const float rh = rsqrtf(wave_sum_f(s2) * (1.0f / DM) + RMS_EPS);
        u32x2_t* o1 = (u32x2_t*)(akv + (size_t)m * DM) + lane; u32x2_t* o2 = (u32x2_t*)(ain1 + (size_t)m * DM) + lane;
#pragma unroll
        for (int j = 0; j < 4; ++j) { const int c = 256 * j + 4 * lane;
            const f32x4_t n = v[j] * rh;
            u32x2_t w; w.x = pk2bf(n.x, n.y); w.y = pk2bf(n.z, n.w); o1[64 * j] = w;
            const f32x4_t g = *(const f32x4_t*)(g_pre + 1024 + c), scv = *(const f32x4_t*)(sc1 + c), shv = *(const f32x4_t*)(sh1 + c);
            const f32x4_t z = n * g * (scv + 1.0f) + shv;
            w.x = pk2bf(z.x, z.y); w.y = pk2bf(z.z, z.w); o2[64 * j] = w; }
    }
}
__device__ __forceinline__ void e_attn_post(const bf16_t* __restrict__ o0, const bf16_t* __restrict__ o1, const bf16_t* __restrict__ sz1, const float* __restrict__ g_sub, float lam,
                                            bf16_t* og, int gw, int ngw, int lane) {
    for (int m = gw; m < MTOK; m += ngw) {
#pragma unroll
        for (int j = 0; j < 2; ++j) {
            const int c = 512 * j + 8 * lane;
            const u32x4_t a = *(const u32x4_t*)(o0 + (size_t)m * DM + c), bq = *(const u32x4_t*)(o1 + (size_t)m * DM + c), zq = *(const u32x4_t*)(sz1 + (size_t)m * DM + c);
            float d[8]; float s = 0.f;
#pragma unroll
            for (int i = 0; i < 4; ++i) { const unsigned wa = a[i], wb = bq[i];
                d[2 * i] = __uint_as_float(wa << 16) - lam * __uint_as_float(wb << 16); d[2 * i + 1] = __uint_as_float(wa & 0xffff0000u) - lam * __uint_as_float(wb & 0xffff0000u);
                s += d[2 * i] * d[2 * i] + d[2 * i + 1] * d[2 * i + 1]; }
            s += __shfl_xor(s, 1); s += __shfl_xor(s, 2); s += __shfl_xor(s, 4); s += __shfl_xor(s, 8);
            const float r = rsqrtf(s * (1.0f / 128.0f) + RMS_EPS) * ONE_M_LI;
            const float* gs = g_sub + (c & 127);
            u32x4_t w;
#pragma unroll
            for (int i = 0; i < 4; ++i) { const unsigned wz = zq[i];
                const float z0 = __uint_as_float(wz << 16), z1 = __uint_as_float(wz & 0xffff0000u);
                w[i] = pk2bf(d[2 * i] * r * gs[2 * i] * z0, d[2 * i + 1] * r * gs[2 * i + 1] * z1); }
            *(u32x4_t*)(og + (size_t)m * DM + c) = w;
        }
    }
}
__device__ __forceinline__ void e_final(float* out, const bf16_t* __restrict__ yo1, const float* __restrict__ mod, const float* __restrict__ g_post, int gw, int ngw, int lane) {
    for (int m = gw; m < MTOK; m += ngw) {
        const int b = m / SEQL;
        f32x4_t* hr = (f32x4_t*)(out + (size_t)m * DM) + lane;
        const u32x2_t* yr = (const u32x2_t*)(yo1 + (size_t)m * DM) + lane;
        f32x4_t v[4], y[4]; float s = 0.f;
#pragma unroll
        for (int j = 0; j < 4; ++j) { v[j] = NT_LD(hr + 64 * j); const u32x2_t w = NT_LD(yr + 64 * j);
            y[j].x = __uint_as_float(w.x << 16); y[j].y = __uint_as_float(w.x & 0xffff0000u); y[j].z = __uint_as_float(w.y << 16); y[j].w = __uint_as_float(w.y & 0xffff0000u);
            s += (y[j].x * y[j].x + y[j].y * y[j].y) + (y[j].z * y[j].z + y[j].w * y[j].w); }
        const float ry = rsqrtf(wave_sum_f(s) * (1.0f / DM) + RMS_EPS);
        const float* gate1 = mod + (size_t)(8 + b) * 3072 + 2048;
#pragma unroll
        for (int j = 0; j < 4; ++j) { const int c = 256 * j + 4 * lane;
            const f32x4_t gp = *(const f32x4_t*)(g_post + 1024 + c), gt = *(const f32x4_t*)(gate1 + c);
            NT_ST(hr + 64 * j, v[j] + gt * (y[j] * ry * gp)); }
    }
}
__device__ __forceinline__ void e_final2(const float* __restrict__ x, const bf16_t* __restrict__ yo, const bf16_t* __restrict__ yo1, float* out, const float* __restrict__ mod, const float* __restrict__ g_post, int gw, int ngw, int lane) {
    for (int m = gw; m < MTOK; m += ngw) {
        const int b = m / SEQL;
        const f32x4_t* xr = (const f32x4_t*)(x + (size_t)m * DM) + lane;
        const u32x2_t* y0r = (const u32x2_t*)(yo + (size_t)m * DM) + lane; const u32x2_t* y1r = (const u32x2_t*)(yo1 + (size_t)m * DM) + lane;
        f32x4_t v[4], y0[4], y1[4]; float s0 = 0.f, s1 = 0.f;
#pragma unroll
        for (int j = 0; j < 4; ++j) { v[j] = xr[64 * j]; const u32x2_t w0 = y0r[64 * j], w1 = y1r[64 * j];
            y0[j].x = __uint_as_float(w0.x << 16); y0[j].y = __uint_as_float(w0.x & 0xffff0000u); y0[j].z = __uint_as_float(w0.y << 16); y0[j].w = __uint_as_float(w0.y & 0xffff0000u);
            y1[j].x = __uint_as_float(w1.x << 16); y1[j].y = __uint_as_float(w1.x & 0xffff0000u); y1[j].z = __uint_as_float(w1.y << 16); y1[j].w = __uint_as_float(w1.y & 0xffff0000u);
            s0 += (y0[j].x * y0[j].x + y0[j].y * y0[j].y) + (y0[j].z * y0[j].z + y0[j].w * y0[j].w);
            s1 += (y1[j].x * y1[j].x + y1[j].y * y1[j].y) + (y1[j].z * y1[j].z + y1[j].w * y1[j].w); }
        const float r0 = rsqrtf(wave_sum_f(s0) * (1.0f / DM) + RMS_EPS), r1 = rsqrtf(wave_sum_f(s1) * (1.0f / DM) + RMS_EPS);
        const float* gate0 = mod + (size_t)b * 3072 + 2048; const float* gate1 = mod + (size_t)(8 + b) * 3072 + 2048;
        f32x4_t* orow = (f32x4_t*)(out + (size_t)m * DM) + lane;
#pragma unroll
        for (int j = 0; j < 4; ++j) { const int c = 256 * j + 4 * lane;
            const f32x4_t gp0 = *(const f32x4_t*)(g_post + c), gt0 = *(const f32x4_t*)(gate0 + c), gp1 = *(const f32x4_t*)(g_post + 1024 + c), gt1 = *(const f32x4_t*)(gate1 + c);
            const f32x4_t h = v[j] + gt0 * (y0[j] * r0 * gp0);
            orow[64 * j] = h + gt1 * (y1[j] * r1 * gp1); }
    }
}
__device__ __forceinline__ void e_final_b(const bf16_t* __restrict__ h1b, float* out, const bf16_t* __restrict__ yo1, const float* __restrict__ mod, const float* __restrict__ g_post, int gw, int ngw, int lane) {
    for (int m = gw; m < MTOK; m += ngw) {
        const int b = m / SEQL;
        const u32x2_t* hr = (const u32x2_t*)(h1b + (size_t)m * DM) + lane;
        const u32x2_t* yr = (const u32x2_t*)(yo1 + (size_t)m * DM) + lane;
        f32x4_t v[4], y[4]; float s = 0.f;
#pragma unroll
        for (int j = 0; j < 4; ++j) { const u32x2_t hw = NT_LD(hr + 64 * j); const u32x2_t w = NT_LD(yr + 64 * j);
            v[j].x = __uint_as_float(hw.x << 16); v[j].y = __uint_as_float(hw.x & 0xffff0000u); v[j].z = __uint_as_float(hw.y << 16); v[j].w = __uint_as_float(hw.y & 0xffff0000u);
            y[j].x = __uint_as_float(w.x << 16); y[j].y = __uint_as_float(w.x & 0xffff0000u); y[j].z = __uint_as_float(w.y << 16); y[j].w = __uint_as_float(w.y & 0xffff0000u);
            s += (y[j].x * y[j].x + y[j].y * y[j].y) + (y[j].z * y[j].z + y[j].w * y[j].w); }
        const float ry = rsqrtf(wave_sum_f(s) * (1.0f / DM) + RMS_EPS);
        const float* gate1 = mod + (size_t)(8 + b) * 3072 + 2048;
        f32x4_t* orow = (f32x4_t*)(out + (size_t)m * DM) + lane;
#pragma unroll
        for (int j = 0; j < 4; ++j) { const int c = 256 * j + 4 * lane;
            const f32x4_t gp = *(const f32x4_t*)(g_post + 1024 + c), gt = *(const f32x4_t*)(gate1 + c);
            NT_ST(orow + 64 * j, v[j] + gt * (y[j] * ry * gp)); }
    }
}

#define ER 2
__device__ __forceinline__ void unpk4(const u32x2_t w, f32x4_t& y) { y.x = __uint_as_float(w.x << 16); y.y = __uint_as_float(w.x & 0xffff0000u); y.z = __uint_as_float(w.y << 16); y.w = __uint_as_float(w.y & 0xffff0000u); }
__device__ __forceinline__ float ssq4(const f32x4_t v) { return (v.x * v.x + v.y * v.y) + (v.z * v.z + v.w * v.w); }
__device__ __forceinline__ void e_norm0_r(const float* __restrict__ x, const float* __restrict__ mod, const float* __restrict__ g_pre, bf16_t* a0, int gw, int ngw, int lane) {
    for (int m0 = gw; m0 < MTOK; m0 += ER * ngw) {
        f32x4_t v[ER][4]; float s[ER];
#pragma unroll
        for (int r = 0; r < ER; ++r) { const int m = min(m0 + r * ngw, MTOK - 1); const f32x4_t* xr = (const f32x4_t*)(x + (size_t)m * DM) + lane;
#pragma unroll
            for (int j = 0; j < 4; ++j) v[r][j] = NT_LD(xr + 64 * j); }
#pragma unroll
        for (int r = 0; r < ER; ++r) { s[r] = 0.f;
#pragma unroll
            for (int j = 0; j < 4; ++j) s[r] += ssq4(v[r][j]); }
#pragma unroll
        for (int r = 0; r < ER; ++r) { const int m = m0 + r * ngw; if (m >= MTOK) break;
            const int b = m / SEQL; const float rr = rsqrtf(wave_sum_f(s[r]) * (1.0f / DM) + RMS_EPS);
            const float* sh = mod + (size_t)b * 3072; const float* sc = sh + 1024;
            u32x2_t* o = (u32x2_t*)(a0 + (size_t)m * DM) + lane;
#pragma unroll
            for (int j = 0; j < 4; ++j) { const int c = 256 * j + 4 * lane;
                const f32x4_t g = *(const f32x4_t*)(g_pre + c), scv = *(const f32x4_t*)(sc + c), shv = *(const f32x4_t*)(sh + c);
                const f32x4_t y = v[r][j] * rr * g * (scv + 1.0f) + shv;
                u32x2_t w; w.x = pk2bf(y.x, y.y); w.y = pk2bf(y.z, y.w); o[64 * j] = w; } }
    }
}
__device__ __forceinline__ void e_mid_r(const float* __restrict__ x, const bf16_t* __restrict__ yo, const float* __restrict__ mod, const float* __restrict__ g_post, const float* __restrict__ g_pre,
                                        float* h1, bf16_t* akv, bf16_t* ain1, int gw, int ngw, int lane) {
    for (int m0 = gw; m0 < MTOK; m0 += ER * ngw) {
        f32x4_t v[ER][4], y[ER][4]; float s[ER];
#pragma unroll
        for (int r = 0; r < ER; ++r) { const int m = min(m0 + r * ngw, MTOK - 1); const f32x4_t* xr = (const f32x4_t*)(x + (size_t)m * DM) + lane; const u32x2_t* yr = (const u32x2_t*)(yo + (size_t)m * DM) + lane;
#pragma unroll
            for (int j = 0; j < 4; ++j) { v[r][j] = NT_LD(xr + 64 * j); unpk4(NT_LD(yr + 64 * j), y[r][j]); } }
#pragma unroll
        for (int r = 0; r < ER; ++r) { s[r] = 0.f;
#pragma unroll
            for (int j = 0; j < 4; ++j) s[r] += ssq4(y[r][j]); }
#pragma unroll
        for (int r = 0; r < ER; ++r) { const int m = m0 + r * ngw; if (m >= MTOK) break;
            const int b = m / SEQL; const float ry = rsqrtf(wave_sum_f(s[r]) * (1.0f / DM) + RMS_EPS);
            const float* gate0 = mod + (size_t)b * 3072 + 2048; const float* sh1 = mod + (size_t)(8 + b) * 3072; const float* sc1 = sh1 + 1024;
            float s2 = 0.f; f32x4_t* ho = (f32x4_t*)(h1 + (size_t)m * DM) + lane;
#pragma unroll
            for (int j = 0; j < 4; ++j) { const int c = 256 * j + 4 * lane;
                const f32x4_t gp = *(const f32x4_t*)(g_post + c), gt = *(const f32x4_t*)(gate0 + c);
                v[r][j] = v[r][j] + gt * (y[r][j] * ry * gp); NT_ST(ho + 64 * j, v[r][j]); s2 += ssq4(v[r][j]); }
            const float rh = rsqrtf(wave_sum_f(s2) * (1.0f / DM) + RMS_EPS);
            u32x2_t* o1 = (u32x2_t*)(akv + (size_t)m * DM) + lane; u32x2_t* o2 = (u32x2_t*)(ain1 + (size_t)m * DM) + lane;
#pragma unroll
            for (int j = 0; j < 4; ++j) { const int c = 256 * j + 4 * lane;
                const f32x4_t nn = v[r][j] * rh; u32x2_t w; w.x = pk2bf(nn.x, nn.y); w.y = pk2bf(nn.z, nn.w); o1[64 * j] = w;
                const f32x4_t g = *(const f32x4_t*)(g_pre + 1024 + c), scv = *(const f32x4_t*)(sc1 + c), shv = *(const f32x4_t*)(sh1 + c);
                const f32x4_t z = nn * g * (scv + 1.0f) + shv; w.x = pk2bf(z.x, z.y); w.y = pk2bf(z.z, z.w); o2[64 * j] = w; } }
    }
}
__device__ __forceinline__ void e_final_r(float* out, const bf16_t* __restrict__ yo1, const float* __restrict__ mod, const float* __restrict__ g_post, int gw, int ngw, int lane) {
    for (int m0 = gw; m0 < MTOK; m0 += ER * ngw) {
        f32x4_t v[ER][4], y[ER][4]; float s[ER];
#pragma unroll
        for (int r = 0; r < ER; ++r) { const int m = min(m0 + r * ngw, MTOK - 1); const f32x4_t* hr = (const f32x4_t*)(out + (size_t)m * DM) + lane; const u32x2_t* yr = (const u32x2_t*)(yo1 + (size_t)m * DM) + lane;
#pragma unroll
            for (int j = 0; j < 4; ++j) { v[r][j] = NT_LD(hr + 64 * j); unpk4(NT_LD(yr + 64 * j), y[r][j]); } }
#pragma unroll
        for (int r = 0; r < ER; ++r) { s[r] = 0.f;
#pragma unroll
            for (int j = 0; j < 4; ++j) s[r] += ssq4(y[r][j]); }
#pragma unroll
        for (int r = 0; r < ER; ++r) { const int m = m0 + r * ngw; if (m >= MTOK) break;
            const int b = m / SEQL; const float ry = rsqrtf(wave_sum_f(s[r]) * (1.0f / DM) + RMS_EPS);
            const float* gate1 = mod + (size_t)(8 + b) * 3072 + 2048; f32x4_t* hr = (f32x4_t*)(out + (size_t)m * DM) + lane;
#pragma unroll
            for (int j = 0; j < 4; ++j) { const int c = 256 * j + 4 * lane;
                const f32x4_t gp = *(const f32x4_t*)(g_post + 1024 + c), gt = *(const f32x4_t*)(gate1 + c);
                NT_ST(hr + 64 * j, v[r][j] + gt * (y[r][j] * ry * gp)); } }
    }
}

__device__ __forceinline__ void unpk4b(const u32x2_t w, f32x4_t& y) { y.x = __uint_as_float(w.x << 16); y.y = __uint_as_float(w.x & 0xffff0000u); y.z = __uint_as_float(w.y << 16); y.w = __uint_as_float(w.y & 0xffff0000u); }
__device__ __forceinline__ float ssq4b(const f32x4_t v) { return (v.x * v.x + v.y * v.y) + (v.z * v.z + v.w * v.w); }
__device__ __forceinline__ void e_norm0_b(const float* __restrict__ x, const float* __restrict__ mod, const float* __restrict__ g_pre, bf16_t* a0, int gw, int ngw, int lane) {
    for (int b = 0; b < NB; ++b) {
        const float* sh = mod + (size_t)b * 3072; const float* sc = sh + 1024;
        f32x4_t G[4], SH[4];
#pragma unroll
        for (int j = 0; j < 4; ++j) { const int c = 256 * j + 4 * lane; G[j] = *(const f32x4_t*)(g_pre + c) * (*(const f32x4_t*)(sc + c) + 1.0f); SH[j] = *(const f32x4_t*)(sh + c); }
        for (int r0 = gw; r0 < SEQL; r0 += 2 * ngw) {
            const int ra = r0, rb = r0 + ngw; const bool hb = rb < SEQL;
            const int ma = b * SEQL + ra, mb = b * SEQL + (hb ? rb : ra);
            f32x4_t va[4], vb[4];
            const f32x4_t* xa = (const f32x4_t*)(x + (size_t)ma * DM) + lane; const f32x4_t* xb = (const f32x4_t*)(x + (size_t)mb * DM) + lane;
#pragma unroll
            for (int j = 0; j < 4; ++j) { va[j] = NT_LD(xa + 64 * j); vb[j] = NT_LD(xb + 64 * j); }
            float sa = 0.f, sb = 0.f;
#pragma unroll
            for (int j = 0; j < 4; ++j) { sa += ssq4b(va[j]); sb += ssq4b(vb[j]); }
            const float rra = rsqrtf(wave_sum_f(sa) * (1.0f / DM) + RMS_EPS), rrb = rsqrtf(wave_sum_f(sb) * (1.0f / DM) + RMS_EPS);
            u32x2_t* oa = (u32x2_t*)(a0 + (size_t)ma * DM) + lane; u32x2_t* ob = (u32x2_t*)(a0 + (size_t)mb * DM) + lane;
#pragma unroll
            for (int j = 0; j < 4; ++j) { const f32x4_t y = va[j] * rra * G[j] + SH[j]; u32x2_t w; w.x = pk2bf(y.x, y.y); w.y = pk2bf(y.z, y.w); oa[64 * j] = w; }
            if (hb) {
#pragma unroll
                for (int j = 0; j < 4; ++j) { const f32x4_t y = vb[j] * rrb * G[j] + SH[j]; u32x2_t w; w.x = pk2bf(y.x, y.y); w.y = pk2bf(y.z, y.w); ob[64 * j] = w; } }
        }
    }
}
__device__ __forceinline__ void e_mid_b(const float* __restrict__ x, const bf16_t* __restrict__ yo, const float* __restrict__ mod, const float* __restrict__ g_post, const float* __restrict__ g_pre,
                                        float* h1, bf16_t* akv, bf16_t* ain1, int gw, int ngw, int lane) {
    for (int b = 0; b < NB; ++b) {
        const float* gate0 = mod + (size_t)b * 3072 + 2048; const float* sh1 = mod + (size_t)(8 + b) * 3072; const float* sc1 = sh1 + 1024;
        f32x4_t GG[4], GF[4], SH[4];
#pragma unroll
        for (int j = 0; j < 4; ++j) { const int c = 256 * j + 4 * lane; GG[j] = *(const f32x4_t*)(gate0 + c) * *(const f32x4_t*)(g_post + c);
            GF[j] = *(const f32x4_t*)(g_pre + 1024 + c) * (*(const f32x4_t*)(sc1 + c) + 1.0f); SH[j] = *(const f32x4_t*)(sh1 + c); }
        for (int r0 = gw; r0 < SEQL; r0 += 2 * ngw) {
            const int ra = r0, rb = r0 + ngw; const bool hb = rb < SEQL;
            const int mr[2] = {b * SEQL + ra, b * SEQL + (hb ? rb : ra)};
            f32x4_t v[2][4], y[2][4];
#pragma unroll
            for (int q = 0; q < 2; ++q) { const f32x4_t* xr = (const f32x4_t*)(x + (size_t)mr[q] * DM) + lane; const u32x2_t* yr = (const u32x2_t*)(yo + (size_t)mr[q] * DM) + lane;
#pragma unroll
                for (int j = 0; j < 4; ++j) { v[q][j] = NT_LD(xr + 64 * j); unpk4b(NT_LD(yr + 64 * j), y[q][j]); } }
            float s[2] = {0.f, 0.f};
#pragma unroll
            for (int q = 0; q < 2; ++q)
#pragma unroll
                for (int j = 0; j < 4; ++j) s[q] += ssq4b(y[q][j]);
            float ry[2]; ry[0] = rsqrtf(wave_sum_f(s[0]) * (1.0f / DM) + RMS_EPS); ry[1] = rsqrtf(wave_sum_f(s[1]) * (1.0f / DM) + RMS_EPS);
            float s2[2] = {0.f, 0.f};
#pragma unroll
            for (int q = 0; q < 2; ++q)
#pragma unroll
                for (int j = 0; j < 4; ++j) { v[q][j] = v[q][j] + GG[j] * (y[q][j] * ry[q]); s2[q] += ssq4b(v[q][j]); }
            float rh[2]; rh[0] = rsqrtf(wave_sum_f(s2[0]) * (1.0f / DM) + RMS_EPS); rh[1] = rsqrtf(wave_sum_f(s2[1]) * (1.0f / DM) + RMS_EPS);
#pragma unroll
            for (int q = 0; q < 2; ++q) { if (q == 1 && !hb) break;
                f32x4_t* ho = (f32x4_t*)(h1 + (size_t)mr[q] * DM) + lane; u32x2_t* o1 = (u32x2_t*)(akv + (size_t)mr[q] * DM) + lane; u32x2_t* o2 = (u32x2_t*)(ain1 + (size_t)mr[q] * DM) + lane;
#pragma unroll
                for (int j = 0; j < 4; ++j) { if (h1) NT_ST(ho + 64 * j, v[q][j]);
                    const f32x4_t nn = v[q][j] * rh[q]; u32x2_t w; w.x = pk2bf(nn.x, nn.y); w.y = pk2bf(nn.z, nn.w); o1[64 * j] = w;
                    const f32x4_t z = nn * GF[j] + SH[j]; w.x = pk2bf(z.x, z.y); w.y = pk2bf(z.z, z.w); o2[64 * j] = w; } }
        }
    }
}
__device__ __forceinline__ void e_final_bm(float* out, const bf16_t* __restrict__ yo1, const float* __restrict__ mod, const float* __restrict__ g_post, int gw, int ngw, int lane) {
    for (int b = 0; b < NB; ++b) {
        const float* gate1 = mod + (size_t)(8 + b) * 3072 + 2048;
        f32x4_t GG[4];
#pragma unroll
        for (int j = 0; j < 4; ++j) { const int c = 256 * j + 4 * lane; GG[j] = *(const f32x4_t*)(gate1 + c) * *(const f32x4_t*)(g_post + 1024 + c); }
        for (int r0 = gw; r0 < SEQL; r0 += 2 * ngw) {
            const int ra = r0, rb = r0 + ngw; const bool hb = rb < SEQL;
            const int mr[2] = {b * SEQL + ra, b * SEQL + (hb ? rb : ra)};
            f32x4_t v[2][4], y[2][4];
#pragma unroll
            for (int q = 0; q < 2; ++q) { const f32x4_t* hr = (const f32x4_t*)(out + (size_t)mr[q] * DM) + lane; const u32x2_t* yr = (const u32x2_t*)(yo1 + (size_t)mr[q] * DM) + lane;
#pragma unroll
                for (int j = 0; j < 4; ++j) { v[q][j] = NT_LD(hr + 64 * j); unpk4b(NT_LD(yr + 64 * j), y[q][j]); } }
            float s[2] = {0.f, 0.f};
#pragma unroll
            for (int q = 0; q < 2; ++q)
#pragma unroll
                for (int j = 0; j < 4; ++j) s[q] += ssq4b(y[q][j]);
            float ry[2]; ry[0] = rsqrtf(wave_sum_f(s[0]) * (1.0f / DM) + RMS_EPS); ry[1] = rsqrtf(wave_sum_f(s[1]) * (1.0f / DM) + RMS_EPS);
#pragma unroll
            for (int q = 0; q < 2; ++q) { if (q == 1 && !hb) break;
                f32x4_t* hr = (f32x4_t*)(out + (size_t)mr[q] * DM) + lane;
#pragma unroll
                for (int j = 0; j < 4; ++j) NT_ST(hr + 64 * j, v[q][j] + GG[j] * (y[q][j] * ry[q])); }
        }
    }
}
__device__ __forceinline__ void e_final_x(const float* __restrict__ x, const bf16_t* __restrict__ yo, const bf16_t* __restrict__ yo1, float* out, const float* __restrict__ mod, const float* __restrict__ g_post, int gw, int ngw, int lane) {
    for (int b = 0; b < NB; ++b) {
        const float* gate0 = mod + (size_t)b * 3072 + 2048; const float* gate1 = mod + (size_t)(8 + b) * 3072 + 2048;
        f32x4_t G0[4], G1[4];
#pragma unroll
        for (int j = 0; j < 4; ++j) { const int c = 256 * j + 4 * lane; G0[j] = *(const f32x4_t*)(gate0 + c) * *(const f32x4_t*)(g_post + c); G1[j] = *(const f32x4_t*)(gate1 + c) * *(const f32x4_t*)(g_post + 1024 + c); }
        for (int r0 = gw; r0 < SEQL; r0 += 2 * ngw) {
            const int ra = r0, rb = r0 + ngw; const bool hb = rb < SEQL;
            const int mr[2] = {b * SEQL + ra, b * SEQL + (hb ? rb : ra)};
            f32x4_t v[2][4], y0[2][4], y1[2][4];
#pragma unroll
            for (int q = 0; q < 2; ++q) { const f32x4_t* xr = (const f32x4_t*)(x + (size_t)mr[q] * DM) + lane; const u32x2_t* ar = (const u32x2_t*)(yo + (size_t)mr[q] * DM) + lane; const u32x2_t* br = (const u32x2_t*)(yo1 + (size_t)mr[q] * DM) + lane;
#pragma unroll
                for (int j = 0; j < 4; ++j) { v[q][j] = NT_LD(xr + 64 * j); unpk4b(NT_LD(ar + 64 * j), y0[q][j]); unpk4b(NT_LD(br + 64 * j), y1[q][j]); } }
            float s0[2] = {0.f, 0.f}, s1[2] = {0.f, 0.f};
#pragma unroll
            for (int q = 0; q < 2; ++q)
#pragma unroll
                for (int j = 0; j < 4; ++j) { s0[q] += ssq4b(y0[q][j]); s1[q] += ssq4b(y1[q][j]); }
            float r0_[2], r1_[2];
#pragma unroll
            for (int q = 0; q < 2; ++q) { r0_[q] = rsqrtf(wave_sum_f(s0[q]) * (1.0f / DM) + RMS_EPS); r1_[q] = rsqrtf(wave_sum_f(s1[q]) * (1.0f / DM) + RMS_EPS); }
#pragma unroll
            for (int q = 0; q < 2; ++q) { if (q == 1 && !hb) break;
                f32x4_t* orow = (f32x4_t*)(out + (size_t)mr[q] * DM) + lane;
#pragma unroll
                for (int j = 0; j < 4; ++j) { const f32x4_t h = v[q][j] + G0[j] * (y0[q][j] * r0_[q]); NT_ST(orow + 64 * j, h + G1[j] * (y1[q][j] * r1_[q])); } }
        }
    }
}
__device__ __forceinline__ float diff_lambda(const float* lq1, const float* lk1, const float* lq2, const float* lk2) {
    float s1 = 0.f, s2 = 0.f;
    for (int i = 0; i < 64; ++i) { s1 += lq1[i] * lk1[i]; s2 += lq2[i] * lk2[i]; }
    return expf(s1) - expf(s2) + LAMBDA_INIT;
}

__global__ void n_adaln(const float* __restrict__ c, const float* __restrict__ ada_w, const float* __restrict__ ada_b, float* mod) {
    const int idx = blockIdx.x * 256 + threadIdx.x;
    if (idx >= 2 * 8 * 3072) return;
    const int j = idx % 3072, b = (idx / 3072) % 8, l = idx / (3072 * 8);
    float acc = ada_b[l * 3072 + j];
    const float* w = ada_w + (size_t)l * 1024 * 3072 + j; const float* cb = c + b * 1024;
    for (int k = 0; k < 1024; ++k) acc += silu_f(cb[k]) * w[(size_t)k * 3072];
    mod[idx] = acc;
}
__global__ void n_lambda(const float* lq1, const float* lk1, const float* lq2, const float* lk2, float* out) {
    if (threadIdx.x == 0 && blockIdx.x == 0) out[0] = diff_lambda(lq1, lk1, lq2, lk2);
}
__global__ void n_norm0(const float* x, const float* mod, const float* g_pre, bf16_t* a0) {
    e_norm0(x, mod, g_pre, a0, blockIdx.x * 4 + (threadIdx.x >> 6), gridDim.x * 4, threadIdx.x & 63);
}
__global__ void n_mid(const float* x, const bf16_t* yo, const float* mod, const float* g_post, const float* g_pre, float* h1, bf16_t* akv, bf16_t* ain1) {
    e_mid(x, yo, mod, g_post, g_pre, h1, (bf16_t*)nullptr, akv, ain1, blockIdx.x * 4 + (threadIdx.x >> 6), gridDim.x * 4, threadIdx.x & 63);
}
__global__ void n_attn_post(const bf16_t* o0, const bf16_t* o1, const bf16_t* sz1, const float* g_sub, const float* lamp, bf16_t* og) {
    e_attn_post(o0, o1, sz1, g_sub, lamp[0], og, blockIdx.x * 4 + (threadIdx.x >> 6), gridDim.x * 4, threadIdx.x & 63);
}
__global__ void n_final(float* out, const bf16_t* yo1, const float* mod, const float* g_post) {
    e_final(out, yo1, mod, g_post, blockIdx.x * 4 + (threadIdx.x >> 6), gridDim.x * 4, threadIdx.x & 63);
}

struct AL_Row { const bf16_t* A; __device__ float ld(int m, int k) const { return bf2f(A[(size_t)m * DM + k]); } };
struct AL_YG  { const bf16_t* A; __device__ float ld(int m, int k) const { return bf2f(A[yg_off(k >> 4, m >> 4, (m & 15) * 16 + (k & 15))]); } };
struct WL_Plain { const float* W; long N; __device__ float ld(int k, int n) const { return W[(size_t)k * N + n]; } };
struct WL_KV { const float* wk; const float* wv; const float* g; __device__ float ld(int k, int n) const { return g[k] * (n < 1024 ? wk[(size_t)k * 1024 + n] : wv[(size_t)k * 1024 + n - 1024]); } };
struct EP_In0 { bf16_t* US; bf16_t* SZ; __device__ void st(int m, int n, float a) const {
    if (n < 1024) US[us_off(n >> 4, m >> 4, (m & 15) * 16 + (n & 15))] = f2bf(a); else SZ[(size_t)m * DM + n - 1024] = f2bf(silu_f(a)); } };
struct EP_Glu { const bf16_t* YG; const bf16_t* SZ; const float* bias; bf16_t* Y2; __device__ void st(int m, int n, float a) const {
    const float yv = bf2f(YG[yg_off(n >> 4, m >> 4, (m & 15) * 16 + (n & 15))]); const float t = a + bias[n];
    Y2[(size_t)m * DM + n] = f2bf(yv * sigmoid_f(t) * bf2f(SZ[(size_t)m * DM + n])); } };
struct EP_Plain { bf16_t* O; __device__ void st(int m, int n, float a) const { O[(size_t)m * DM + n] = f2bf(a); } };
struct EP_KV { bf16_t* K; bf16_t* V; __device__ void st(int m, int n, float a) const { if (n < 1024) K[(size_t)m * DM + n] = f2bf(a); else V[(size_t)m * DM + n - 1024] = f2bf(a); } };
struct EP_In1 { bf16_t* Q; bf16_t* SZ1; __device__ void st(int m, int n, float a) const { if (n < 1024) Q[(size_t)m * DM + n] = f2bf(a * QC2); else SZ1[(size_t)m * DM + n - 1024] = f2bf(silu_f(a)); } };

template <class AL, class WL, class EP>
__global__ void __launch_bounds__(256) n_gemm(AL al, WL wl, EP ep, int N) {
    __shared__ float As[16][68]; __shared__ float Ws[16][68];
    const int tid = threadIdx.x, tx = tid & 15, ty = tid >> 4;
    const int m0 = blockIdx.y * 64, n0 = blockIdx.x * 64;
    float acc[4][4];
#pragma unroll
    for (int i = 0; i < 4; ++i)
#pragma unroll
        for (int j = 0; j < 4; ++j) acc[i][j] = 0.f;
    for (int k0 = 0; k0 < 1024; k0 += 16) {
#pragma unroll
        for (int i = 0; i < 4; ++i) { const int e = tid + 256 * i; const int mm = e >> 4, kk = e & 15; As[kk][mm] = al.ld(m0 + mm, k0 + kk); }
#pragma unroll
        for (int i = 0; i < 4; ++i) { const int e = tid + 256 * i; const int kk = e >> 6, nn = e & 63; Ws[kk][nn] = wl.ld(k0 + kk, n0 + nn); }
        __syncthreads();
#pragma unroll
        for (int kk = 0; kk < 16; ++kk) {
            float a[4], b[4];
#pragma unroll
            for (int i = 0; i < 4; ++i) { a[i] = As[kk][ty * 4 + i]; b[i] = Ws[kk][tx * 4 + i]; }
#pragma unroll
            for (int i = 0; i < 4; ++i)
#pragma unroll
                for (int j = 0; j < 4; ++j) acc[i][j] += a[i] * b[j];
        }
        __syncthreads();
    }
#pragma unroll
    for (int i = 0; i < 4; ++i)
#pragma unroll
        for (int j = 0; j < 4; ++j) ep.st(m0 + ty * 4 + i, n0 + tx * 4 + j, acc[i][j]);
}

__global__ void __launch_bounds__(256) n_ssm(const bf16_t* __restrict__ US, const float* lam_re, const float* lam_im, const float* log_dt, const float* b_re, const float* b_im,
                                             const float* c_re, const float* c_im, const float* d_skip, bf16_t* YG) {
    const int wv = blockIdx.x * 4 + (threadIdx.x >> 6), lane = threadIdx.x & 63;
    if (wv >= NB * NGRP) return;
    const int b = wv / NGRP, g = wv % NGRP, p = lane;
    const float dt = expf(log_dt[g]);
    const float lr = lam_re[g * 64 + p], li = lam_im[g * 64 + p];
    const float mag = expf(lr * dt); float sn, cs; sn = sinf(li * dt); cs = cosf(li * dt);
    const float lbr = mag * cs, lbi = mag * sn;
    const float nr = lbr - 1.0f, ni = lbi, den = lr * lr + li * li;
    const float cr = (nr * lr + ni * li) / den, ci = (ni * lr - nr * li) / den;
    float bbr[16], bbi[16], ccr[16], cci[16];
#pragma unroll
    for (int c = 0; c < 16; ++c) { const float br = b_re[(g * 64 + p) * 16 + c], bi = b_im[(g * 64 + p) * 16 + c];
        bbr[c] = cr * br - ci * bi; bbi[c] = cr * bi + ci * br;
        ccr[c] = c_re[(g * 16 + c) * 64 + p]; cci[c] = c_im[(g * 16 + c) * 64 + p]; }
    const float dsk = d_skip[g * 16 + (lane & 15)];
    float sr = 0.f, si = 0.f;
    for (int t = 0; t < SEQL; ++t) {
        const int m = b * SEQL + t;
        const bf16_t* up = US + us_off(g, m >> 4, (m & 15) * 16);
        float u[16];
        { const u32x4_t w0 = *(const u32x4_t*)up, w1 = *(const u32x4_t*)(up + 8);
#pragma unroll
          for (int i = 0; i < 4; ++i) { u[2 * i] = __uint_as_float(w0[i] << 16); u[2 * i + 1] = __uint_as_float(w0[i] & 0xffff0000u); u[8 + 2 * i] = __uint_as_float(w1[i] << 16); u[8 + 2 * i + 1] = __uint_as_float(w1[i] & 0xffff0000u); } }
        float bur = 0.f, bui = 0.f;
#pragma unroll
        for (int c = 0; c < 16; ++c) { bur += bbr[c] * u[c]; bui += bbi[c] * u[c]; }
        const float nsr = lbr * sr - lbi * si + bur, nsi = lbr * si + lbi * sr + bui; sr = nsr; si = nsi;
        float yv = 0.f;
#pragma unroll
        for (int c = 0; c < 16; ++c) { const float part = wave_sum_f(ccr[c] * sr - cci[c] * si); if ((lane & 15) == c) yv = part; }
        if (lane < 16) { const float yy = yv + dsk * bf2f(up[lane]); YG[yg_off(g, m >> 4, (m & 15) * 16 + lane)] = f2bf(gelu_tanh_f(yy)); }
    }
}

__global__ void __launch_bounds__(256) n_attn(const bf16_t* __restrict__ Q, const bf16_t* __restrict__ K, const bf16_t* __restrict__ V, bf16_t* O0, bf16_t* O1) {
    __shared__ float qs[4][128];
    const int w = threadIdx.x >> 6, lane = threadIdx.x & 63;
    const int gwv = blockIdx.x * 4 + w;
    const int h = gwv & 7, m = gwv >> 3, b = m / SEQL, qi = m % SEQL;
    qs[w][lane] = bf2f(Q[(size_t)m * DM + h * 128 + lane]); qs[w][64 + lane] = bf2f(Q[(size_t)m * DM + h * 128 + 64 + lane]);
    __syncthreads();
    float m0 = -1e30f, m1 = -1e30f, l0 = 0.f, l1 = 0.f, a00 = 0.f, a01 = 0.f, a10 = 0.f, a11 = 0.f;
    const size_t rb = (size_t)b * SEQL;
    for (int kc = 0; kc * 64 <= qi; ++kc) {
        const int key = kc * 64 + lane; const bool valid = key <= qi;
        float s0 = 0.f, s1 = 0.f;
        { const bf16_t* kr = K + (rb + (valid ? key : qi)) * DM + h * 128;
#pragma unroll
          for (int ch = 0; ch < 8; ++ch) { const u32x4_t w0 = *(const u32x4_t*)(kr + ch * 8), w1 = *(const u32x4_t*)(kr + 64 + ch * 8);
#pragma unroll
            for (int i = 0; i < 4; ++i) { s0 += qs[w][ch * 8 + 2 * i] * __uint_as_float(w0[i] << 16) + qs[w][ch * 8 + 2 * i + 1] * __uint_as_float(w0[i] & 0xffff0000u);
                                          s1 += qs[w][64 + ch * 8 + 2 * i] * __uint_as_float(w1[i] << 16) + qs[w][64 + ch * 8 + 2 * i + 1] * __uint_as_float(w1[i] & 0xffff0000u); } } }
        if (!valid) { s0 = -1e30f; s1 = -1e30f; }
        const float nm0 = fmaxf(m0, wave_max_f(s0)), nm1 = fmaxf(m1, wave_max_f(s1));
        const float f0 = exp2f(m0 - nm0), f1 = exp2f(m1 - nm1);
        const float p0 = valid ? exp2f(s0 - nm0) : 0.f, p1 = valid ? exp2f(s1 - nm1) : 0.f;
        l0 = l0 * f0 + wave_sum_f(p0); l1 = l1 * f1 + wave_sum_f(p1); m0 = nm0; m1 = nm1;
        a00 *= f0; a01 *= f0; a10 *= f1; a11 *= f1;
        const int nk = min(64, qi - kc * 64 + 1);
        for (int j = 0; j < nk; ++j) {
            const float pj0 = __shfl(p0, j), pj1 = __shfl(p1, j);
            const bf16_t* vr = V + (rb + kc * 64 + j) * DM + h * 128;
            const float v0 = bf2f(vr[lane]), v1 = bf2f(vr[64 + lane]);
            a00 += pj0 * v0; a01 += pj0 * v1; a10 += pj1 * v0; a11 += pj1 * v1;
        }
    }
    const float i0 = 1.0f / l0, i1 = 1.0f / l1;
    O0[(size_t)m * DM + h * 128 + lane] = f2bf(a00 * i0); O0[(size_t)m * DM + h * 128 + 64 + lane] = f2bf(a01 * i0);
    O1[(size_t)m * DM + h * 128 + lane] = f2bf(a10 * i1); O1[(size_t)m * DM + h * 128 + 64 + lane] = f2bf(a11 * i1);
}
#ifndef REPEAT_MASK
#define REPEAT_MASK 0
#endif
#ifndef ATTN_V128
#define ATTN_V128 1
#endif
#ifndef EXTRA_PHASE
#define EXTRA_PHASE -1
#endif
#ifndef ATTN_FUSE_POST
#define ATTN_FUSE_POST 1
#endif
#ifndef H1_RECOMP
#define H1_RECOMP 1
#endif
#ifndef SSM_FUSED
#define SSM_FUSED 1
#endif
#ifndef ATTN_PRIO
#define ATTN_PRIO 0
#endif
#ifndef H1_BF16
#define H1_BF16 0
#endif
#ifndef NT_OUT
#define NT_OUT 0
#endif
#if NT_OUT
#define ST_OUT(p, v) __builtin_nontemporal_store((v), (p))
#else
#define ST_OUT(p, v) (*(p) = (v))
#endif
#ifndef FUSE_EPI
#define FUSE_EPI 0
#endif
#ifndef ALIGN_E
#define ALIGN_E true
#endif
namespace pg8 {
#define PG8_LAS __attribute__((address_space(3)))
typedef short bf16x8 __attribute__((ext_vector_type(8)));
typedef float f32x4 __attribute__((ext_vector_type(4)));
typedef unsigned u32x4 __attribute__((ext_vector_type(4)));
constexpr int BM = 256, BK = 64, HALF = 128, HTB = HALF * BK * 2  , STAGE_BYTES = 8 * HTB, NXCD = 8, WGM = 8;

__host__ __device__ __forceinline__ int lds_byte(int r, int c) { const int st = (r >> 4) * 2 + (c >> 5), rr = r & 15, cc = c & 31, ob = rr * 64 + cc * 2; return st * 1024 + (ob ^ (((ob >> 9) & 1) << 5)); }
__host__ __device__ __forceinline__ void stage_rc(int b, int& R, int& C) { const int st = b / 1024, sb = b % 1024, swz = sb ^ (((sb >> 9) & 1) << 5); R = (st >> 1) * 16 + swz / 64; C = (st & 1) * 32 + (swz % 64) / 2; }
__host__ __device__ __forceinline__ int perm32(int rho) { const int n = rho >> 4, i = rho & 15; return 8 * (i >> 2) + 4 * n + (i & 3); }

struct Unit { int pm, pn, grp; };
struct Gemm {
    const char* A; const char* Bt; int nt, pad0;
    unsigned a_rs, a_c16; size_t a_kstep, a_tstep, a_gstep;
    unsigned b_rs, pad1; size_t b_tstep, b_gstep;
    __device__ __forceinline__ const char* abase(const Unit& u) const { return A + (size_t)u.grp * a_gstep + (size_t)u.pm * a_tstep; }
    __device__ __forceinline__ const char* bbase(const Unit& u) const { return Bt + (size_t)u.grp * b_gstep + (size_t)u.pn * b_tstep; }
};
__device__ __forceinline__ Gemm gemm_std(const void* A, int lda, const void* Bt, int ldb, int K) {
    Gemm g; g.A = (const char*)A; g.Bt = (const char*)Bt; g.nt = K / BK; g.pad0 = 0; g.a_rs = (unsigned)lda * 2u; g.a_c16 = 32u; g.a_kstep = BK * 2; g.a_tstep = (size_t)BM * lda * 2; g.a_gstep = 0;
    g.b_rs = (unsigned)ldb * 2u; g.pad1 = 0; g.b_tstep = (size_t)BM * ldb * 2; g.b_gstep = 0; return g;
}

struct Order {
    int nM, nN, nG, nwg, G, c, only, pm_off, mode2;
    __device__ __forceinline__ void init(int nM_, int nN_, int nG_, int G_, int c_) { nM = nM_; nN = nN_; nG = nG_; nwg = nM * nN * nG; G = G_; c = c_; only = -1; pm_off = 0; mode2 = 0; }
    __device__ __forceinline__ bool next(int i, Unit& u) const {
        if (only >= 0) { if (i > 0) return false; i = only; }
        const long L = (long)i * G + c; if (L >= nwg) return false;
        int wgid = (int)L; { const int q = nwg / NXCD, r = nwg % NXCD, xcd = wgid % NXCD, off = wgid / NXCD; wgid = (xcd < r ? xcd * (q + 1) : r * (q + 1) + (xcd - r) * q) + off; }
        if (mode2) {
            const int x = wgid >> 8, y = wgid & 255, bk = y >> 6, w2 = y & 63; u.grp = bk & 1; u.pm = (x * 2 + (bk >> 1)) * 8 + (w2 & 7); u.pn = w2 >> 3;
        } else
        { const int per = nM * nN; u.grp = wgid / per; const int w2 = wgid % per;
          const int nig = WGM * nN, gid = w2 / nig, fm = gid * WGM, gsz = (nM - fm) < WGM ? (nM - fm) : WGM;
          u.pm = pm_off + fm + ((w2 % nig) % gsz); u.pn = (w2 % nig) / gsz; }
        return true;
    }
};

__device__ __forceinline__ unsigned cvt_pk_bf16(float lo, float hi) { unsigned r; asm volatile("v_cvt_pk_bf16_f32 %0, %1, %2" : "=v"(r) : "v"(lo), "v"(hi)); return r; }
__device__ __forceinline__ u32x4 pack8(const f32x4 a, const f32x4 b) { u32x4 w; w.x = cvt_pk_bf16(a[0], a[1]); w.y = cvt_pk_bf16(a[2], a[3]); w.z = cvt_pk_bf16(b[0], b[1]); w.w = cvt_pk_bf16(b[2], b[3]); return w; }
__device__ __forceinline__ void unpack8(const u32x4 w, f32x4& a, f32x4& b) {
    a[0] = __uint_as_float(w.x << 16); a[1] = __uint_as_float(w.x & 0xffff0000u); a[2] = __uint_as_float(w.y << 16); a[3] = __uint_as_float(w.y & 0xffff0000u);
    b[0] = __uint_as_float(w.z << 16); b[1] = __uint_as_float(w.z & 0xffff0000u); b[2] = __uint_as_float(w.w << 16); b[3] = __uint_as_float(w.w & 0xffff0000u); }
__device__ __forceinline__ float fsilu(float v) { return v * __builtin_amdgcn_rcpf(1.0f + __expf(-v)); }
__device__ __forceinline__ float fsigm(float v) { return __builtin_amdgcn_rcpf(1.0f + __expf(-v)); }
__device__ __forceinline__ f32x4 silu4(f32x4 v) { f32x4 o; o[0] = fsilu(v[0]); o[1] = fsilu(v[1]); o[2] = fsilu(v[2]); o[3] = fsilu(v[3]); return o; }
__device__ __forceinline__ f32x4 sigm4(f32x4 v) { f32x4 o; o[0] = fsigm(v[0]); o[1] = fsigm(v[1]); o[2] = fsigm(v[2]); o[3] = fsigm(v[3]); return o; }
__device__ __forceinline__ float fgelu(float v) { const float u = 0.7978845608028654f * (v + 0.044715f * v * v * v); const float e = __expf(2.0f * u); return 0.5f * v * (2.0f - 2.0f * __builtin_amdgcn_rcpf(e + 1.0f)); }
__device__ __forceinline__ f32x4 gelu4(f32x4 v) { f32x4 o; o[0] = fgelu(v[0]); o[1] = fgelu(v[1]); o[2] = fgelu(v[2]); o[3] = fgelu(v[3]); return o; }

template <class F> struct EpiRow8 {
    static constexpr bool PERM = true, AFTER_DRAIN = false;
    F f;
    __device__ __forceinline__ void operator()(const f32x4 (&acc)[2][2][4][2], const Unit& u, int wr, int wc, int fr, int fq) const {
#pragma unroll
        for (int ai = 0; ai < 2; ++ai)
#pragma unroll
            for (int m = 0; m < 4; ++m) { const int row = u.pm * BM + ai * HALF + wr * 64 + m * 16 + fr;
#pragma unroll
                for (int bj = 0; bj < 2; ++bj) { const int col0 = u.pn * BM + bj * HALF + wc * 32 + 8 * fq; f.apply(u, row, col0, acc[ai][bj][m][0], acc[ai][bj][m][1]); } }
    }
};
struct F_In0 { bf16_t* US; bf16_t* SZ;
    __device__ __forceinline__ void apply(const Unit&, int row, int col0, f32x4 v0, f32x4 v1) const {
        if (col0 < 1024) ST_OUT((u32x4*)(US + us_off(col0 >> 4, row >> 4, (row & 15) * 16 + (col0 & 15))), pack8(v0, v1));
        else NT_ST((u32x4*)(SZ + (size_t)row * DM + (col0 - 1024)), pack8(silu4(v0), silu4(v1))); } };
struct F_SsmA { float* E;
    __device__ __forceinline__ void apply(const Unit& u, int row, int col0, f32x4 v0, f32x4 v1) const {
        if (col0 < 128) { float* p = E + ((size_t)u.grp * NTILE + row) * 128 + col0; *(f32x4*)p = v0; *(f32x4*)(p + 4) = v1; } } };
struct F_SsmB { const bf16_t* US; const float* dsk; bf16_t* YG;
    __device__ __forceinline__ void apply(const Unit& u, int row, int col0, f32x4 v0, f32x4 v1) const {
        const u32x4 uw = *(const u32x4*)(US + us_off(u.grp, row, col0)); f32x4 u0, u1; unpack8(uw, u0, u1);
        const float* d = dsk + u.grp * 16 + (col0 & 15); const f32x4 d0 = *(const f32x4*)d, d1 = *(const f32x4*)(d + 4);
        ST_OUT((u32x4*)(YG + yg_off(u.grp, row, col0)), pack8(gelu4(v0 + d0 * u0), gelu4(v1 + d1 * u1))); } };
struct F_Glu { const bf16_t* YG; const bf16_t* SZ; const float* bias; bf16_t* Y2;
    __device__ __forceinline__ void apply(const Unit&, int row, int col0, f32x4 v0, f32x4 v1) const {
        const u32x4 yw = *(const u32x4*)(YG + yg_off(col0 >> 4, row >> 4, (row & 15) * 16 + (col0 & 15))); f32x4 y0, y1; unpack8(yw, y0, y1);
        const u32x4 zw = NT_LD((const u32x4*)(SZ + (size_t)row * DM + col0)); f32x4 z0, z1; unpack8(zw, z0, z1);
        const f32x4 b0 = *(const f32x4*)(bias + col0), b1 = *(const f32x4*)(bias + col0 + 4);
        ST_OUT((u32x4*)(Y2 + (size_t)row * DM + col0), pack8(y0 * sigm4(v0 + b0) * z0, y1 * sigm4(v1 + b1) * z1)); } };
template <class F> struct EpiRow8L {
    static constexpr bool PERM = true, AFTER_DRAIN = false;
    F f;
    __device__ __forceinline__ void operator()(const f32x4 (&acc)[2][2][4][2], const Unit& u, int wr, int wc, int fr, int fq) const {
#pragma unroll
        for (int ai = 0; ai < 2; ++ai) {
            typename F::Pre pre[4][2];
#pragma unroll
            for (int m = 0; m < 4; ++m) { const int row = u.pm * BM + ai * HALF + wr * 64 + m * 16 + fr;
#pragma unroll
                for (int bj = 0; bj < 2; ++bj) { const int col0 = u.pn * BM + bj * HALF + wc * 32 + 8 * fq; f.load(u, row, col0, pre[m][bj]); } }
#pragma unroll
            for (int m = 0; m < 4; ++m) { const int row = u.pm * BM + ai * HALF + wr * 64 + m * 16 + fr;
#pragma unroll
                for (int bj = 0; bj < 2; ++bj) { const int col0 = u.pn * BM + bj * HALF + wc * 32 + 8 * fq; f.apply(u, row, col0, acc[ai][bj][m][0], acc[ai][bj][m][1], pre[m][bj]); } }
        }
    }
};
struct F_SsmB2 { const bf16_t* US; const float* dsk; bf16_t* YG;
    struct Pre { u32x4 uw; };
    __device__ __forceinline__ void load(const Unit& u, int row, int col0, Pre& p) const { p.uw = *(const u32x4*)(US + us_off(u.grp, row, col0)); }
    __device__ __forceinline__ void apply(const Unit& u, int row, int col0, f32x4 v0, f32x4 v1, const Pre& p) const {
        f32x4 u0, u1; unpack8(p.uw, u0, u1);
        const float* d = dsk + u.grp * 16 + (col0 & 15); const f32x4 d0 = *(const f32x4*)d, d1 = *(const f32x4*)(d + 4);
        *(u32x4*)(YG + yg_off(u.grp, row, col0)) = pack8(gelu4(v0 + d0 * u0), gelu4(v1 + d1 * u1)); } };
struct F_Glu2 { const bf16_t* YG; const bf16_t* SZ; const float* bias; bf16_t* Y2;
    struct Pre { u32x4 yw, zw; };
    __device__ __forceinline__ void load(const Unit&, int row, int col0, Pre& p) const {
        p.yw = *(const u32x4*)(YG + yg_off(col0 >> 4, row >> 4, (row & 15) * 16 + (col0 & 15))); p.zw = *(const u32x4*)(SZ + (size_t)row * DM + col0); }
    __device__ __forceinline__ void apply(const Unit&, int row, int col0, f32x4 v0, f32x4 v1, const Pre& p) const {
        f32x4 y0, y1, z0, z1; unpack8(p.yw, y0, y1); unpack8(p.zw, z0, z1);
        const f32x4 b0 = *(const f32x4*)(bias + col0), b1 = *(const f32x4*)(bias + col0 + 4);
        *(u32x4*)(Y2 + (size_t)row * DM + col0) = pack8(y0 * sigm4(v0 + b0) * z0, y1 * sigm4(v1 + b1) * z1); } };
struct F_Split2 { bf16_t* Olo[2]; bf16_t* Ohi[2];
    __device__ __forceinline__ void apply(const Unit& u, int row, int col0, f32x4 v0, f32x4 v1) const {
        if (u.grp == 0) { bf16_t* o = (col0 < 1024) ? Olo[0] + (size_t)row * DM + col0 : Ohi[0] + (size_t)row * DM + (col0 - 1024); ST_OUT((u32x4*)o, pack8(v0, v1)); }
        else if (col0 < 1024) NT_ST((u32x4*)(Olo[1] + (size_t)row * DM + col0), pack8(v0 * QC2, v1 * QC2));
        else NT_ST((u32x4*)(Ohi[1] + (size_t)row * DM + (col0 - 1024)), pack8(silu4(v0), silu4(v1))); } };
struct F_Plain { bf16_t* O;
    __device__ __forceinline__ void apply(const Unit&, int row, int col0, f32x4 v0, f32x4 v1) const { ST_OUT((u32x4*)(O + (size_t)row * DM + col0), pack8(v0, v1)); } };
struct F_Split { bf16_t* Olo; bf16_t* Ohi; float sc_lo; int silu_hi;
    __device__ __forceinline__ void apply(const Unit&, int row, int col0, f32x4 v0, f32x4 v1) const {
        if (col0 < 1024) *(u32x4*)(Olo + (size_t)row * DM + col0) = pack8(v0 * sc_lo, v1 * sc_lo);
        else { if (silu_hi) { NT_ST((u32x4*)(Ohi + (size_t)row * DM + (col0 - 1024)), pack8(silu4(v0), silu4(v1))); } else *(u32x4*)(Ohi + (size_t)row * DM + (col0 - 1024)) = pack8(v0, v1); } } };


struct PanelRms {
    unsigned* xbuf;
    unsigned* cnt;
    unsigned* tmo;
    float eps;
    __device__ __forceinline__ bool run(const f32x4 (&v)[2][2][4][2], const Unit& u, int wr, int wc, int fr, int fq, PG8_LAS unsigned char* lds, int wid, int lane) const {
        PG8_LAS float* P = (PG8_LAS float*)lds;
        PG8_LAS float* S = (PG8_LAS float*)(lds + 8192);
        PG8_LAS unsigned* flag = (PG8_LAS unsigned*)(lds + 8192 + 2048);
#pragma unroll
        for (int ai = 0; ai < 2; ++ai)
#pragma unroll
            for (int m = 0; m < 4; ++m) {
                float q = 0.f;
#pragma unroll
                for (int bj = 0; bj < 2; ++bj)
#pragma unroll
                    for (int n = 0; n < 2; ++n) { const f32x4 d = v[ai][bj][m][n]; q += (d[0] * d[0] + d[1] * d[1]) + (d[2] * d[2] + d[3] * d[3]); }
                q += __shfl_xor(q, 16); q += __shfl_xor(q, 32);
                if (fq == 0) P[(ai * HALF + wr * 64 + m * 16 + fr) * 4 + wc] = q;
            }
        asm volatile("s_waitcnt lgkmcnt(0)" ::: "memory"); __builtin_amdgcn_s_barrier(); asm volatile("" ::: "memory");
        const int row = wid * 32 + (lane & 31);
        if (lane < 32) {
            const float tot = (P[row * 4 + 0] + P[row * 4 + 1]) + (P[row * 4 + 2] + P[row * 4 + 3]);
            unsigned long long* slot = (unsigned long long*)xbuf + ((size_t)(u.pm * BM + row) * 4 + u.pn);
            __hip_atomic_store(slot, (unsigned long long)__float_as_uint(tot), __ATOMIC_RELAXED, __HIP_MEMORY_SCOPE_AGENT);
        }
        asm volatile("s_waitcnt vmcnt(0)" ::: "memory");
        if (lane == 0) __hip_atomic_fetch_add(cnt + 64 * u.pm, 1u, __ATOMIC_RELAXED, __HIP_MEMORY_SCOPE_AGENT);
        if (wid == 0) {
            bool dead = false; const unsigned long long t0 = __builtin_amdgcn_s_memrealtime(); const unsigned want = 32u;
            for (;;) {
                if ((unsigned)__builtin_amdgcn_readfirstlane(__hip_atomic_load(cnt + 64 * u.pm, __ATOMIC_RELAXED, __HIP_MEMORY_SCOPE_AGENT)) >= want) break;
                if (__builtin_amdgcn_s_memrealtime() - t0 > 2000000ull) { if (lane == 0) __hip_atomic_store(tmo, 1u, __ATOMIC_RELAXED, __HIP_MEMORY_SCOPE_AGENT); dead = true; break; }
                __builtin_amdgcn_s_sleep(2);
            }
            __builtin_amdgcn_fence(__ATOMIC_ACQUIRE, "agent");
            if (lane == 0) flag[0] = dead ? 1u : 0u;
        }
        asm volatile("s_waitcnt vmcnt(0) lgkmcnt(0)" ::: "memory"); __builtin_amdgcn_s_barrier(); asm volatile("" ::: "memory");
        const bool bad = flag[0] != 0u;
        if (lane < 32) {
            const unsigned long long* slot = (const unsigned long long*)xbuf + (size_t)(u.pm * BM + row) * 4; float t4[4];
#pragma unroll
            for (int t = 0; t < 4; ++t) t4[t] = __uint_as_float((unsigned)__hip_atomic_load(slot + t, __ATOMIC_RELAXED, __HIP_MEMORY_SCOPE_AGENT));
            S[row] = rsqrtf(((t4[0] + t4[1]) + (t4[2] + t4[3])) * (1.0f / 1024.0f) + eps);
        }
        asm volatile("s_waitcnt lgkmcnt(0)" ::: "memory"); __builtin_amdgcn_s_barrier(); asm volatile("" ::: "memory");
        return bad;
    }
};
struct EpiFinal {
    static constexpr bool PERM = false, AFTER_DRAIN = true;
    const float* base; float* out; const float* mod1; const float* gpost1; PanelRms st;
    __device__ __forceinline__ void fused(f32x4 (&acc)[2][2][4][2], const Unit& u, int wr, int wc, int fr, int fq, PG8_LAS unsigned char* lds, int wid, int lane) const {
        const PG8_LAS float* S = (const PG8_LAS float*)(lds + 8192);
        const int col0 = u.pn * BM + wc * 32 + 4 * fq; const int b = u.pm >> 4;
        const float* gate = mod1 + (size_t)b * 3072 + 2048;
        const bool bad = st.run(acc, u, wr, wc, fr, fq, lds, wid, lane);
        const float qnan = __builtin_nanf("");
        f32x4 gg[2][2];
#pragma unroll
        for (int bj = 0; bj < 2; ++bj)
#pragma unroll
            for (int n = 0; n < 2; ++n) gg[bj][n] = *(const f32x4*)(gate + col0 + bj * HALF + n * 16) * *(const f32x4*)(gpost1 + col0 + bj * HALF + n * 16);
#pragma unroll
        for (int ai = 0; ai < 2; ++ai)
#pragma unroll
            for (int m = 0; m < 4; ++m) { const int r = ai * HALF + wr * 64 + m * 16 + fr; const float sr = S[r]; const size_t off = (size_t)(u.pm * BM + r) * DM + col0;
#pragma unroll
                for (int bj = 0; bj < 2; ++bj)
#pragma unroll
                    for (int n = 0; n < 2; ++n) { const f32x4 bs = *(const f32x4*)(base + off + bj * HALF + n * 16); f32x4 o = bs + gg[bj][n] * (acc[ai][bj][m][n] * sr);
                        if (bad) o = (f32x4){qnan, qnan, qnan, qnan}; *(f32x4*)(out + off + bj * HALF + n * 16) = o; }
                if (m & 1) asm volatile("" ::: "memory"); }
    }
};
struct EpiMid {
    static constexpr bool PERM = false, AFTER_DRAIN = true;
    const float* x; float* out; bf16_t* akv; bf16_t* ain1; const float* mod; const float* gpost0; const float* gpre1; PanelRms st1, st2;
    __device__ __forceinline__ void fused(f32x4 (&acc)[2][2][4][2], const Unit& u, int wr, int wc, int fr, int fq, PG8_LAS unsigned char* lds, int wid, int lane) const {
        typedef unsigned u32x2v __attribute__((ext_vector_type(2)));
        const PG8_LAS float* S = (const PG8_LAS float*)(lds + 8192);
        const int col0 = u.pn * BM + wc * 32 + 4 * fq; const int b = u.pm >> 4;
        const float* gate0 = mod + (size_t)b * 3072 + 2048; const float* sh1 = mod + (size_t)(8 + b) * 3072; const float* sc1 = sh1 + 1024;
        bool bad = st1.run(acc, u, wr, wc, fr, fq, lds, wid, lane);
        {
            f32x4 gg[2][2];
#pragma unroll
            for (int bj = 0; bj < 2; ++bj)
#pragma unroll
                for (int n = 0; n < 2; ++n) gg[bj][n] = *(const f32x4*)(gate0 + col0 + bj * HALF + n * 16) * *(const f32x4*)(gpost0 + col0 + bj * HALF + n * 16);
#pragma unroll
            for (int ai = 0; ai < 2; ++ai)
#pragma unroll
                for (int m = 0; m < 4; ++m) { const int r = ai * HALF + wr * 64 + m * 16 + fr; const float sr = S[r]; const size_t off = (size_t)(u.pm * BM + r) * DM + col0;
#pragma unroll
                    for (int bj = 0; bj < 2; ++bj)
#pragma unroll
                        for (int n = 0; n < 2; ++n) { const f32x4 bs = *(const f32x4*)(x + off + bj * HALF + n * 16); acc[ai][bj][m][n] = bs + gg[bj][n] * (acc[ai][bj][m][n] * sr); }
                    asm volatile("" : "+v"(acc[ai][0][m][0]), "+v"(acc[ai][0][m][1]), "+v"(acc[ai][1][m][0]), "+v"(acc[ai][1][m][1]));
                    if (m & 1) asm volatile("" ::: "memory"); }
        }
        bad = st2.run(acc, u, wr, wc, fr, fq, lds, wid, lane) || bad;
        const float qnan = __builtin_nanf("");
#pragma unroll
        for (int bj = 0; bj < 2; ++bj)
#pragma unroll
            for (int n = 0; n < 2; ++n) { const int c = col0 + bj * HALF + n * 16;
                const f32x4 gf = *(const f32x4*)(gpre1 + c) * (*(const f32x4*)(sc1 + c) + 1.0f), sh = *(const f32x4*)(sh1 + c);
#pragma unroll
                for (int ai = 0; ai < 2; ++ai)
#pragma unroll
                    for (int m = 0; m < 4; ++m) { const int r = ai * HALF + wr * 64 + m * 16 + fr; const float sr = S[r]; const size_t off = (size_t)(u.pm * BM + r) * DM + c;
                        f32x4 h = acc[ai][bj][m][n]; if (bad) h = (f32x4){qnan, qnan, qnan, qnan};
                        *(f32x4*)(out + off) = h;
                        const f32x4 nr = h * sr; u32x2v w; w.x = cvt_pk_bf16(nr[0], nr[1]); w.y = cvt_pk_bf16(nr[2], nr[3]); *(u32x2v*)(akv + off) = w;
                        const f32x4 z = nr * gf + sh; w.x = cvt_pk_bf16(z[0], z[1]); w.y = cvt_pk_bf16(z[2], z[3]); *(u32x2v*)(ain1 + off) = w; }
                asm volatile("" ::: "memory"); }
    }
};

struct EpiScan {
    static constexpr bool PERM = true, AFTER_DRAIN = true;
    const float* lb16; bf16_t* US; int carry_off;
    __device__ __forceinline__ void fused(f32x4 (&acc)[2][2][4][2], const Unit& u, int wr, int wc, int fr, int fq, PG8_LAS unsigned char* lds, int wid, int lane) const {
#pragma unroll
        for (int ai = 0; ai < 2; ++ai)
#pragma unroll
            for (int m = 0; m < 4; ++m) { const int row = ai * HALF + wr * 64 + m * 16 + fr; const int ch = (wc * 32 + 8 * fq) >> 2;
                *(PG8_LAS f32x4*)(lds + row * 512 + ((ch ^ (row & 7)) << 4)) = acc[ai][0][m][0];
                *(PG8_LAS f32x4*)(lds + row * 512 + (((ch + 1) ^ (row & 7)) << 4)) = acc[ai][0][m][1]; }
        asm volatile("s_waitcnt lgkmcnt(0)" ::: "memory"); __builtin_amdgcn_s_barrier(); asm volatile("" ::: "memory");
        const int p = lane, g = u.grp, b = u.pm;
        const float lr = lb16[(g * 64 + p) * 2], li = lb16[(g * 64 + p) * 2 + 1];
        typedef float f32x2v __attribute__((ext_vector_type(2)));
        const int coff = ((p >> 1) << 4) + (p & 1) * 8;
        float sr = 0.f, si = 0.f;
#pragma unroll 8
        for (int j = 0; j < 32; ++j) { const int t = wid * 32 + j; const f32x2v e = *(const PG8_LAS f32x2v*)(lds + t * 512 + (coff ^ ((t & 7) << 4)));
            const float nr = lr * sr - li * si + e.x, ni = lr * si + li * sr + e.y; sr = nr; si = ni; }
        PG8_LAS f32x2v* C = (PG8_LAS f32x2v*)(lds + carry_off);
        C[wid * 64 + p] = (f32x2v){sr, si};
        float pr = lr, pi = li;
#pragma unroll
        for (int q = 0; q < 5; ++q) { const float nr = pr * pr - pi * pi, ni = 2.f * pr * pi; pr = nr; pi = ni; }
        asm volatile("s_waitcnt lgkmcnt(0)" ::: "memory"); __builtin_amdgcn_s_barrier(); asm volatile("" ::: "memory");
        sr = 0.f; si = 0.f;
        for (int v = 0; v < wid; ++v) { const f32x2v c = C[v * 64 + p]; const float nr = pr * sr - pi * si + c.x, ni = pr * si + pi * sr + c.y; sr = nr; si = ni; }
        bf16_t* sp = US + us_off(g, b * 256 + wid * 32, 256 + 2 * p);
#pragma unroll 8
        for (int j = 0; j < 32; ++j) { const int t = wid * 32 + j; const f32x2v e = *(const PG8_LAS f32x2v*)(lds + t * 512 + (coff ^ ((t & 7) << 4)));
            *(unsigned*)(sp + (size_t)j * US_P) = cvt_pk_bf16(sr, si);
            const float nr = lr * sr - li * si + e.x, ni = lr * si + li * sr + e.y; sr = nr; si = ni; }
        asm volatile("s_waitcnt vmcnt(0)" ::: "memory");
    }
};
template <class Epi, bool ALIGN_EPI>
__device__ __forceinline__ void gemm_phase(PG8_LAS unsigned char* lds, const Gemm g, const Order& S, const Epi& E, int tid_in) {
    int tid_ = tid_in; asm volatile("" : "+v"(tid_));
    const int tid = tid_, wid = __builtin_amdgcn_readfirstlane(tid >> 6), lane = tid & 63, wr = wid >> 2, wc = wid & 3, fr = lane & 15, fq = lane >> 4;
    const int nt = g.nt;
    unsigned voffA[2], voffB[2];
#pragma unroll
    for (int i = 0; i < 2; ++i) { int R, C; stage_rc(tid * 16 + i * 8192, R, C); const int Rb = Epi::PERM ? ((R & ~31) + perm32(R & 31)) : R;
        voffA[i] = (unsigned)R * g.a_rs + (unsigned)(C >> 4) * g.a_c16 + (unsigned)(C & 15) * 2u; voffB[i] = (unsigned)Rb * g.b_rs + (unsigned)C * 2u; }
    const size_t kstepA = g.a_kstep, kstepB = (size_t)(BK * 2);
    const size_t hstepA = (size_t)HALF * g.a_rs, hstepB = (size_t)HALF * g.b_rs;
    const unsigned ldsw = (unsigned)wid * 1024u;
    const int aoff = lds_byte(wr * 64 + fr, fq * 8), boff = lds_byte(wc * 32 + fr, fq * 8);
#define PG8_SA(b, h) (((b) * 2 + (h)) * HTB)
#define PG8_SB(b, h) ((4 + (b) * 2 + (h)) * HTB)
#define PG8_STAGE(bufoff, gbase, voff) do { _Pragma("unroll") for (int _i = 0; _i < 2; ++_i) \
        __builtin_amdgcn_global_load_lds((const unsigned*)((const char*)(gbase) + (voff)[_i]), (PG8_LAS unsigned*)(lds + (bufoff) + ldsw + _i * 8192), 16, 0, 0); } while (0)
#define PG8_LDA(dst, b, h) do { _Pragma("unroll") for (int m = 0; m < 4; ++m) _Pragma("unroll") for (int k = 0; k < 2; ++k) dst[m][k] = *(const PG8_LAS bf16x8*)(lds + PG8_SA(b, h) + aoff + m * 2048 + k * 1024); } while (0)
#define PG8_LDB(dst, b, h) do { _Pragma("unroll") for (int n = 0; n < 2; ++n) _Pragma("unroll") for (int k = 0; k < 2; ++k) dst[n][k] = *(const PG8_LAS bf16x8*)(lds + PG8_SB(b, h) + boff + n * 2048 + k * 1024); } while (0)
#define PG8_MMA(ai, bj, At, Bt) do { __builtin_amdgcn_s_setprio(1); _Pragma("unroll") for (int m = 0; m < 4; ++m) _Pragma("unroll") for (int n = 0; n < 2; ++n) _Pragma("unroll") for (int k = 0; k < 2; ++k) \
        acc[ai][bj][m][n] = __builtin_amdgcn_mfma_f32_16x16x32_bf16(Bt[n][k], At[m][k], acc[ai][bj][m][n], 0, 0, 0); __builtin_amdgcn_s_setprio(0); } while (0)
#define PG8_WAIT_V(n) asm volatile("s_waitcnt vmcnt(" #n ")" ::: "memory")
#define PG8_WAIT_L(n) asm volatile("s_waitcnt lgkmcnt(" #n ")" ::: "memory")
#define PG8_BAR __builtin_amdgcn_s_barrier()
#define PG8_SCHED __builtin_amdgcn_sched_barrier(0)
    Unit cur, nxt; int ui = 0;
    if (!S.next(0, cur)) return;
    f32x4 acc[2][2][4][2];
#pragma unroll
    for (int a = 0; a < 2; ++a)
#pragma unroll
        for (int b = 0; b < 2; ++b)
#pragma unroll
            for (int m = 0; m < 4; ++m)
#pragma unroll
                for (int n = 0; n < 2; ++n) acc[a][b][m][n] = (f32x4){0.f, 0.f, 0.f, 0.f};
    bf16x8 At[4][2], B0[2][2], B1[2][2];
    const char* cA = g.abase(cur); const char* cB = g.bbase(cur);
    PG8_STAGE(PG8_SB(0, 0), cB, voffB); PG8_STAGE(PG8_SB(0, 1), cB + hstepB, voffB); PG8_STAGE(PG8_SA(0, 0), cA, voffA); PG8_STAGE(PG8_SA(0, 1), cA + hstepA, voffA);
    if (wr == 1) PG8_BAR;
    PG8_WAIT_V(2); PG8_BAR;
    PG8_STAGE(PG8_SB(1, 0), cB + kstepB, voffB); PG8_STAGE(PG8_SA(1, 0), cA + kstepA, voffA); PG8_STAGE(PG8_SB(1, 1), cB + hstepB + kstepB, voffB);
    PG8_WAIT_V(6); PG8_BAR;
    for (;;) {
        const bool has_next = S.next(ui + 1, nxt);
        const char* nA = has_next ? g.abase(nxt) : cA; const char* nB = has_next ? g.bbase(nxt) : cB;
        for (int t = 0; t < nt; t += 2) {
            const bool last = (t == nt - 2);
            const char* a1 = cA + (size_t)(t + 1) * kstepA;
            const char* a2 = last ? nA : cA + (size_t)(t + 2) * kstepA; const char* b2 = last ? nB : cB + (size_t)(t + 2) * kstepB;
            const char* a3 = a2 + kstepA; const char* b3 = b2 + kstepB;
            PG8_LDB(B0, 0, 0); PG8_LDB(B1, 0, 1); PG8_SCHED; PG8_LDA(At, 0, 0); PG8_STAGE(PG8_SA(1, 1), a1 + hstepA, voffA);
            PG8_WAIT_V(8); PG8_WAIT_L(0); PG8_BAR; PG8_MMA(0, 0, At, B0); PG8_MMA(0, 1, At, B1); PG8_BAR; PG8_SCHED;
            PG8_LDA(At, 0, 1); PG8_STAGE(PG8_SB(0, 0), b2, voffB); PG8_STAGE(PG8_SB(0, 1), b2 + hstepB, voffB); PG8_STAGE(PG8_SA(0, 0), a2, voffA);
            PG8_WAIT_V(8); PG8_WAIT_L(0); PG8_BAR; PG8_MMA(1, 0, At, B0); PG8_MMA(1, 1, At, B1); PG8_BAR; PG8_SCHED;
            PG8_LDB(B0, 1, 0); PG8_LDB(B1, 1, 1); PG8_SCHED; PG8_LDA(At, 1, 0); PG8_STAGE(PG8_SA(0, 1), a2 + hstepA, voffA);
            PG8_WAIT_V(8); PG8_WAIT_L(0); PG8_BAR; PG8_MMA(0, 0, At, B0); PG8_MMA(0, 1, At, B1); PG8_BAR; PG8_SCHED;
            PG8_LDA(At, 1, 1); PG8_STAGE(PG8_SB(1, 0), b3, voffB); PG8_STAGE(PG8_SB(1, 1), b3 + hstepB, voffB); PG8_STAGE(PG8_SA(1, 0), a3, voffA);
            PG8_WAIT_V(8); PG8_WAIT_L(0); PG8_BAR; PG8_MMA(1, 0, At, B0); PG8_MMA(1, 1, At, B1); PG8_BAR; PG8_SCHED;
        }
        if constexpr (ALIGN_EPI) { if (wr == 0) PG8_BAR; }
        if constexpr (!Epi::AFTER_DRAIN) { E(acc, cur, wr, wc, fr, fq); }
        if (!has_next) break;
#pragma unroll
        for (int a = 0; a < 2; ++a)
#pragma unroll
            for (int b = 0; b < 2; ++b)
#pragma unroll
                for (int m = 0; m < 4; ++m)
#pragma unroll
                    for (int n = 0; n < 2; ++n) acc[a][b][m][n] = (f32x4){0.f, 0.f, 0.f, 0.f};
        cur = nxt; cA = nA; cB = nB; ++ui;
        if constexpr (ALIGN_EPI) { if (wr == 1) PG8_BAR; }
    }
    PG8_WAIT_V(0);
    if constexpr (!ALIGN_EPI) { if (wr == 0) PG8_BAR; }
    PG8_BAR;
    if constexpr (Epi::AFTER_DRAIN) { E.fused(acc, cur, wr, wc, fr, fq, lds, wid, lane); PG8_WAIT_L(0); PG8_BAR; }
#undef PG8_SA
#undef PG8_SB
#undef PG8_STAGE
#undef PG8_LDA
#undef PG8_LDB
#undef PG8_MMA
#undef PG8_WAIT_V
#undef PG8_WAIT_L
#undef PG8_BAR
#undef PG8_SCHED
}
}

namespace attn_body {
using bf16 = bf16_t;
using bf16x8 = __attribute__((ext_vector_type(8))) short;
using s16x4 = __attribute__((ext_vector_type(4))) short;
using f32x16 = __attribute__((ext_vector_type(16))) float;
using u32x4 = __attribute__((ext_vector_type(4))) unsigned;
constexpr int SEQ = SEQL, D = 64, DMA = 1024;
constexpr int NW = 8, QBLK = 32, QB = QBLK * NW, KVBLK = 64, NQB = SEQ / QB;
__device__ __forceinline__ int crow(int r, int hi) { return (r & 3) + 8 * (r >> 2) + 4 * hi; }
#define SBAR() __builtin_amdgcn_sched_barrier(0)
__device__ __forceinline__ void cmask(f32x16& p0, f32x16& p1, int jb, int qrel, int hi) {
  const float NEG = -INFINITY; int kb = 64 * jb + 4 * hi;
  #pragma unroll
  for (int r = 0; r < 16; ++r) { int kv = kb + (r & 3) + 8 * (r >> 2); if (kv > qrel) p0[r] = NEG; if (kv + 32 > qrel) p1[r] = NEG; }
}
constexpr int NSLOT = 3, SLOTB = 8192;
constexpr int LDS_K = 0, LDS_V = NSLOT * SLOTB, LDS_WS = 2 * NSLOT * SLOTB, LDS_OST = LDS_WS + NW * 64 * 4, LDS_BYTES = LDS_OST + NW * 4096;
__device__ __forceinline__ void glds16(const void* gsrc, unsigned lds_dst) { unsigned keep;
  asm volatile("s_mov_b32 %0, m0\n\ts_mov_b32 m0, %2\n\ts_nop 0\n\tglobal_load_lds_dwordx4 %1, off\n\ts_mov_b32 m0, %0" : "=&s"(keep) : "v"(gsrc), "s"(lds_dst) : "memory"); }
__device__ __forceinline__ float max3f(float a, float b, float c) { float r; asm("v_max3_f32 %0, %1, %2, %3" : "=v"(r) : "v"(a), "v"(b), "v"(c)); return r; }
__device__ __forceinline__ float max2f(float a, float b) { float r; asm("v_max_f32_e32 %0, %1, %2" : "=v"(r) : "v"(a), "v"(b)); return r; }
__device__ __forceinline__ float fadd_s(float a, float b) { float r; asm("v_add_f32_e32 %0, %1, %2" : "=v"(r) : "v"(a), "v"(b)); return r; }
__device__ __forceinline__ float fsub_s(float a, float b) { float r; asm("v_sub_f32_e32 %0, %1, %2" : "=v"(r) : "v"(a), "v"(b)); return r; }
typedef float f32x2_t __attribute__((ext_vector_type(2))); typedef __bf16 bf16x2_t __attribute__((ext_vector_type(2)));
__device__ __forceinline__ unsigned cvtpk_s(float lo, float hi) { f32x2_t v = {lo, hi}; bf16x2_t b = __builtin_convertvector(v, bf16x2_t); return __builtin_bit_cast(unsigned, b); }
#define WAIT_BAR(N) asm volatile("s_waitcnt vmcnt(" #N ") lgkmcnt(0)\n\ts_barrier" ::: "memory")

__device__ __forceinline__ void qkt(f32x16& p0, f32x16& p1, const char* Kslot, const bf16x8* qr, const f32x16& negm, int r32, int hi) {
  const char* kb = Kslot + hi * 1024 + r32 * 16;
  #pragma unroll
  for (int d0 = 0; d0 < 4; ++d0) {
    const bf16x8 b0 = *reinterpret_cast<const bf16x8*>(kb + d0 * 2048);
    const bf16x8 b1 = *reinterpret_cast<const bf16x8*>(kb + d0 * 2048 + 512);
    if (d0 == 0) { p0 = __builtin_amdgcn_mfma_f32_32x32x16_bf16(b0, qr[0], negm, 0, 0, 0); p1 = __builtin_amdgcn_mfma_f32_32x32x16_bf16(b1, qr[0], negm, 0, 0, 0); }
    else { p0 = __builtin_amdgcn_mfma_f32_32x32x16_bf16(b0, qr[d0], p0, 0, 0, 0); p1 = __builtin_amdgcn_mfma_f32_32x32x16_bf16(b1, qr[d0], p1, 0, 0, 0); } }
}
typedef __attribute__((address_space(3))) const char* lds_cptr;
typedef short v4i16_t __attribute__((ext_vector_type(4)));
__device__ __forceinline__ void kload8(bf16x8* kf, lds_cptr kp) {
  kf[0] = *(const __attribute__((address_space(3))) bf16x8*)(kp);        kf[1] = *(const __attribute__((address_space(3))) bf16x8*)(kp + 512);
  kf[2] = *(const __attribute__((address_space(3))) bf16x8*)(kp + 2048); kf[3] = *(const __attribute__((address_space(3))) bf16x8*)(kp + 2560);
  kf[4] = *(const __attribute__((address_space(3))) bf16x8*)(kp + 4096); kf[5] = *(const __attribute__((address_space(3))) bf16x8*)(kp + 4608);
  kf[6] = *(const __attribute__((address_space(3))) bf16x8*)(kp + 6144); kf[7] = *(const __attribute__((address_space(3))) bf16x8*)(kp + 6656);
}
__device__ __forceinline__ void kload2(bf16x8* kf, lds_cptr kp, int j) { kf[2 * j] = *(const __attribute__((address_space(3))) bf16x8*)(kp + j * 2048); kf[2 * j + 1] = *(const __attribute__((address_space(3))) bf16x8*)(kp + j * 2048 + 512); }
__device__ __forceinline__ s16x4 vtr(lds_cptr p) { return __builtin_bit_cast(s16x4, __builtin_amdgcn_ds_read_tr16_b64_v4i16((__attribute__((address_space(3))) v4i16_t*)p)); }
__device__ __forceinline__ float rowmax(const f32x16& p0, const f32x16& p1) {
  float a = max3f(p0[0], p0[1], p1[0]), b = max3f(p0[2], p0[3], p1[1]); a = max3f(a, p1[2], p1[3]);
  #pragma unroll
  for (int r = 4; r < 16; r += 4) { a = max3f(a, p0[r], p0[r + 1]); b = max3f(b, p0[r + 2], p0[r + 3]); a = max3f(a, p1[r], p1[r + 1]); b = max3f(b, p1[r + 2], p1[r + 3]); }
  const float m = max2f(a, b);
  auto rr = __builtin_amdgcn_permlane32_swap(__float_as_uint(m), __float_as_uint(m), false, false);
  return max2f(__uint_as_float(rr[0]), __uint_as_float(rr[1]));
}
__device__ __forceinline__ void pv(f32x16* o, int vb, bf16x8 pa0, bf16x8 pa1, bf16x8 pa2, bf16x8 pa3) {
  #pragma unroll
  for (int d0 = 0; d0 < 2; ++d0) { s16x4 lo[4], hi[4];
    #pragma unroll
    for (int ks = 0; ks < 4; ++ks) {
      asm volatile("ds_read_b64_tr_b16 %0,%1 offset:%c2" : "=&v"(lo[ks]) : "v"(vb), "i"(d0 * 4096 + ks * 1024) : "memory");
      asm volatile("ds_read_b64_tr_b16 %0,%1 offset:%c2" : "=&v"(hi[ks]) : "v"(vb), "i"(d0 * 4096 + ks * 1024 + 512) : "memory"); }
    asm volatile("s_waitcnt lgkmcnt(0)" ::: "memory"); SBAR();
    #define PK(k) (bf16x8){lo[k][0], lo[k][1], lo[k][2], lo[k][3], hi[k][0], hi[k][1], hi[k][2], hi[k][3]}
    o[d0] = __builtin_amdgcn_mfma_f32_32x32x16_bf16(pa0, PK(0), o[d0], 0, 0, 0);
    o[d0] = __builtin_amdgcn_mfma_f32_32x32x16_bf16(pa1, PK(1), o[d0], 0, 0, 0);
    o[d0] = __builtin_amdgcn_mfma_f32_32x32x16_bf16(pa2, PK(2), o[d0], 0, 0, 0);
    o[d0] = __builtin_amdgcn_mfma_f32_32x32x16_bf16(pa3, PK(3), o[d0], 0, 0, 0);
    #undef PK
  }
}
#define ATTN_STORE16(p, v) (*(u32x4*)(p) = (v))
template <int THRL> __device__ __forceinline__ void attn_unit(int tid_in, int b, int hq, int hv, int qb, const bf16* Q, const bf16* __restrict__ K, const bf16* __restrict__ V, bf16* O, char* shm) {
  const int tid = tid_in, lane = tid & 63, r32 = lane & 31, hi = lane >> 5; const int wid = __builtin_amdgcn_readfirstlane(tid >> 6);
  const long rowbase = (long)b * SEQ; const int q0 = qb * QB;
  const bf16* Qw = Q + (rowbase + q0 + wid * QBLK) * DMA + hq * D;
  const bf16* Kh = K + rowbase * DMA + hq * D, *Vh = V + rowbase * DMA + hv * D;
  const unsigned lds0 = (unsigned)(uintptr_t)shm;
  float* wsf = (float*)(shm + LDS_WS) + wid * 64;
  const bf16* ksrc = Kh + (long)lane * DMA + wid * 8;
  const bf16* vsrc = Vh + (long)(16 * (wid & 3) + (lane >> 2)) * DMA + (wid >> 2) * 32 + (lane & 3) * 8;
  const unsigned kdst = lds0 + LDS_K + wid * 1024, vdst = lds0 + LDS_V + wid * 1024;
  #define DMA_K(t, slot) glds16(ksrc + (long)(t) * KVBLK * DMA, (unsigned)__builtin_amdgcn_readfirstlane(kdst + (slot)))
  #define DMA_V(t, slot) glds16(vsrc + (long)(t) * KVBLK * DMA, (unsigned)__builtin_amdgcn_readfirstlane(vdst + (slot)))
  const int vb0 = (int)(lds0 + LDS_V) + ((lane >> 4) & 1) * 32 + (lane & 3) * 8 + (4 * hi + ((lane & 15) >> 2)) * 64;
  const char* Kbase = shm + LDS_K; bf16x8 kf[8];
  const lds_cptr shm3 = (lds_cptr)shm; const lds_cptr kp0 = shm3 + LDS_K + hi * 1024 + r32 * 16; const lds_cptr vp0 = shm3 + LDS_V + ((lane >> 4) & 1) * 32 + (lane & 3) * 8 + (4 * hi + ((lane & 15) >> 2)) * 64;
  const int NT = (q0 + QB) / KVBLK;
  DMA_K(0, 0); DMA_V(0, 0); DMA_K(1, SLOTB);
  bf16x8 qr[4];
  #pragma unroll
  for (int d0 = 0; d0 < 4; ++d0) qr[d0] = *reinterpret_cast<const bf16x8*>(&Qw[(long)r32 * DMA + d0 * 16 + hi * 8]);
  float mhat = 0.f, l_reg = 0.f; f32x16 o[2]; o[0] = f32x16{}; o[1] = f32x16{}; f32x16 negm = f32x16{}; asm volatile("" : "+v"(negm));
  const int qrel = wid * QBLK + r32;
  #define CMASK(P0, P1, t) do { int jb_ = (t) - (NT - 4); if (jb_ >= 0) cmask(P0, P1, jb_, qrel, hi); } while (0)
  bool resc = false;
  #define START(P0, P1) do { const float rm = rowmax(P0, P1); resc = false; \
    { const float dl = rm; mhat = fadd_s(mhat, dl); \
      _Pragma("unroll") for (int r = 0; r < 16; ++r) { P0[r] = fsub_s(P0[r], dl); P1[r] = fsub_s(P1[r], dl); } \
      _Pragma("unroll") for (int r = 0; r < 16; ++r) negm[r] = -mhat; asm volatile("" : "+v"(negm)); } \
    _Pragma("unroll") for (int r = 0; r < 16; ++r) P0[r] = __builtin_amdgcn_exp2f(P0[r]); } while (0)
  #define RESC() do { if (resc) { asm volatile("s_waitcnt lgkmcnt(0)" ::: "memory"); \
      _Pragma("unroll") for (int d_ = 0; d_ < 2; ++d_) _Pragma("unroll") for (int r = 0; r < 16; ++r) o[d_][r] *= wsf[crow(r, hi)]; } } while (0)
  f32x16 pA0, pA1, pB0, pB1;
  int sl_prev = 0, sl_cur = 0, sl_next = SLOTB;
  #define ROT() do { sl_prev = sl_cur; sl_cur = sl_next; sl_next = (sl_next == (NSLOT - 1) * SLOTB) ? 0 : sl_next + SLOTB; } while (0)
  DMA_K(2, 2 * SLOTB);
  WAIT_BAR(3);
  qkt(pA0, pA1, Kbase, qr, negm, r32, hi); asm volatile("s_nop 15\n\ts_nop 7" : "+v"(pA0), "+v"(pA1)); CMASK(pA0, pA1, 0);
  START(pA0, pA1);
  _Pragma("unroll") for (int r = 0; r < 16; ++r) pA1[r] = __builtin_amdgcn_exp2f(pA1[r]);
  WAIT_BAR(0);
  DMA_K(3, 0); DMA_V(1, SLOTB);
  ROT();
  kload8(kf, kp0 + sl_cur);
  WAIT_BAR(2);
  s16x4 vlo[8], vhi[8]; u32x4 pw0, pw1, pw2, pw3;
  #define PKW(P, B) cvtpk_s(P[B], P[B + 1])
  #define PAF(k) __builtin_bit_cast(bf16x8, pw##k)
  #define VFR(i) (bf16x8){vlo[i][0], vlo[i][1], vlo[i][2], vlo[i][3], vhi[i][0], vhi[i][1], vhi[i][2], vhi[i][3]}
  #define PIN(x) asm volatile("" : "+v"(x))
  #define MX3(a, b, c) __builtin_fmaxf(__builtin_fmaxf((a), (b)), (c))
  #define GAPA(MF, A0, A1, A2, A3, W0, W1, PW) do { MF; sacc += A0; sacc += A1; sacc += A2; sacc += A3; PIN(sacc); W0; W1; PIN(PW); SBAR(); } while (0)
  #define EX(v) __builtin_amdgcn_exp2f(v)
  #define GAPB(MF, X, B) do { MF; X[B] = EX(X[B]); X[B + 1] = EX(X[B + 1]); X[B + 2] = EX(X[B + 2]); X[B + 3] = EX(X[B + 3]); PIN(X); SBAR(); } while (0)
  #define VRD(i) do { vlo[i] = vtr(vp_ + (((i) >> 2) * 4096 + ((i) & 3) * 1024)); vhi[i] = vtr(vp_ + (((i) >> 2) * 4096 + ((i) & 3) * 1024 + 512)); } while (0)
  #define KRD(G, j) do { if (G) { kload2(kf, kp0 + sl_next, j); SBAR(); } } while (0)
  #define STEP(C0, C1, P0, P1, t, GK, GV, GL) do { SBAR(); \
    const lds_cptr vp_ = vp0 + sl_prev; \
    VRD(0); SBAR(); float sacc = (P0[0] + P0[1]); \
    GAPA(C0 = __builtin_amdgcn_mfma_f32_32x32x16_bf16(kf[0], qr[0], negm, 0, 0, 0), P0[2], P0[3], P0[4], P0[5],     pw0[0] = PKW(P0, 0), pw0[1] = PKW(P0, 2), pw0); \
    VRD(4); SBAR(); GAPA(C1 = __builtin_amdgcn_mfma_f32_32x32x16_bf16(kf[1], qr[0], negm, 0, 0, 0), P0[6], P0[7], P0[8], P0[9],     pw0[2] = PKW(P0, 4), pw0[3] = PKW(P0, 6), pw0); \
    VRD(1); SBAR(); GAPA(C0 = __builtin_amdgcn_mfma_f32_32x32x16_bf16(kf[2], qr[1], C0, 0, 0, 0),   P0[10], P0[11], P0[12], P0[13], pw1[0] = PKW(P0, 8), pw1[1] = PKW(P0, 10), pw1); \
    VRD(5); SBAR(); GAPA(C1 = __builtin_amdgcn_mfma_f32_32x32x16_bf16(kf[3], qr[1], C1, 0, 0, 0),   P0[14], P0[15], P1[0], P1[1],   pw1[2] = PKW(P0, 12), pw1[3] = PKW(P0, 14), pw1); \
    VRD(2); SBAR(); GAPA(C0 = __builtin_amdgcn_mfma_f32_32x32x16_bf16(kf[4], qr[2], C0, 0, 0, 0),   P1[2], P1[3], P1[4], P1[5],     pw2[0] = PKW(P1, 0), pw2[1] = PKW(P1, 2), pw2); \
    VRD(6); SBAR(); GAPA(C1 = __builtin_amdgcn_mfma_f32_32x32x16_bf16(kf[5], qr[2], C1, 0, 0, 0),   P1[6], P1[7], P1[8], P1[9],     pw2[2] = PKW(P1, 4), pw2[3] = PKW(P1, 6), pw2); \
    VRD(3); SBAR(); GAPA(C0 = __builtin_amdgcn_mfma_f32_32x32x16_bf16(kf[6], qr[3], C0, 0, 0, 0),   P1[10], P1[11], P1[12], P1[13], pw3[0] = PKW(P1, 8), pw3[1] = PKW(P1, 10), pw3); \
    VRD(7); SBAR(); GAPA(C1 = __builtin_amdgcn_mfma_f32_32x32x16_bf16(kf[7], qr[3], C1, 0, 0, 0),   P1[14], P1[15], 0.f, 0.f,       pw3[2] = PKW(P1, 12), pw3[3] = PKW(P1, 14), pw3); \
    l_reg += sacc; \
    if (GK) { DMA_K((t) + 3, sl_cur); } if (GV) { DMA_V((t) + 1, sl_next); } \
    CMASK(C0, C1, t); \
    { float a = MX3(C0[0], C0[1], C1[0]), b = MX3(C0[2], C0[3], C1[1]); a = MX3(a, C1[2], C1[3]); \
      _Pragma("unroll") for (int r = 4; r < 16; r += 4) { a = MX3(a, C0[r], C0[r + 1]); b = MX3(b, C0[r + 2], C0[r + 3]); a = MX3(a, C1[r], C1[r + 1]); b = MX3(b, C1[r + 2], C1[r + 3]); } \
      float rm = __builtin_fmaxf(a, b); { auto rr = __builtin_amdgcn_permlane32_swap(__float_as_uint(rm), __float_as_uint(rm), false, false); rm = __builtin_fmaxf(__uint_as_float(rr[0]), __uint_as_float(rr[1])); } \
      resc = false; \
      if (__builtin_expect(__any(rm > (float)THRL), 0)) { const float dl = __builtin_fmaxf(rm, 0.f); mhat += dl; \
        _Pragma("unroll") for (int r = 0; r < 16; ++r) { C0[r] -= dl; C1[r] -= dl; } \
        _Pragma("unroll") for (int r = 0; r < 16; ++r) negm[r] = -mhat; asm volatile("" : "+v"(negm)); \
        const float f = __builtin_amdgcn_exp2f(-dl); l_reg *= f; if (hi == 0) wsf[r32] = f; resc = true; } } \
    SBAR(); \
    GAPB(o[0] = __builtin_amdgcn_mfma_f32_32x32x16_bf16(PAF(0), VFR(0), o[0], 0, 0, 0), C0, 0); \
    GAPB(o[1] = __builtin_amdgcn_mfma_f32_32x32x16_bf16(PAF(0), VFR(4), o[1], 0, 0, 0), C0, 4); \
    KRD(GL, 0); GAPB(o[0] = __builtin_amdgcn_mfma_f32_32x32x16_bf16(PAF(1), VFR(1), o[0], 0, 0, 0), C0, 8); \
    KRD(GL, 1); GAPB(o[1] = __builtin_amdgcn_mfma_f32_32x32x16_bf16(PAF(1), VFR(5), o[1], 0, 0, 0), C0, 12); \
    KRD(GL, 2); GAPB(o[0] = __builtin_amdgcn_mfma_f32_32x32x16_bf16(PAF(2), VFR(2), o[0], 0, 0, 0), C1, 0); \
    KRD(GL, 3); GAPB(o[1] = __builtin_amdgcn_mfma_f32_32x32x16_bf16(PAF(2), VFR(6), o[1], 0, 0, 0), C1, 4); \
    GAPB(o[0] = __builtin_amdgcn_mfma_f32_32x32x16_bf16(PAF(3), VFR(3), o[0], 0, 0, 0), C1, 8); \
    GAPB(o[1] = __builtin_amdgcn_mfma_f32_32x32x16_bf16(PAF(3), VFR(7), o[1], 0, 0, 0), C1, 12); \
    } while (0)
  int t = 1;
  #undef CMASK
  #define CMASK(P0, P1, t) do {} while (0)
  for (; t + 5 < NT; t += 2) {
    STEP(pB0, pB1, pA0, pA1, t, true, true, true);     WAIT_BAR(2); RESC(); ROT();
    STEP(pA0, pA1, pB0, pB1, t + 1, true, true, true); WAIT_BAR(2); RESC(); ROT();
  }
  #undef CMASK
  #define CMASK(P0, P1, t) do { int jb_ = (t) - (NT - 4); if (jb_ >= 0) cmask(P0, P1, jb_, qrel, hi); } while (0)
  #define ENDW(tt) do { if ((tt) + 3 < NT) { WAIT_BAR(2); } else if ((tt) + 2 < NT) { WAIT_BAR(1); } else { WAIT_BAR(0); } } while (0)
  for (; t + 1 < NT; t += 2) {
    STEP(pB0, pB1, pA0, pA1, t, (t + 3 < NT), (t + 1 < NT), (t + 1 < NT));         ENDW(t);     RESC(); ROT();
    STEP(pA0, pA1, pB0, pB1, t + 1, (t + 4 < NT), (t + 2 < NT), (t + 2 < NT));     ENDW(t + 1); RESC(); ROT();
  }
  STEP(pB0, pB1, pA0, pA1, NT - 1, false, false, false); RESC();
  { float sacc = pB0[0] + pB0[1]; _Pragma("unroll") for (int r = 2; r < 16; ++r) sacc += pB0[r]; _Pragma("unroll") for (int r = 0; r < 16; ++r) sacc += pB1[r]; l_reg += sacc;
    pw0 = (u32x4){PKW(pB0, 0), PKW(pB0, 2), PKW(pB0, 4), PKW(pB0, 6)}; pw1 = (u32x4){PKW(pB0, 8), PKW(pB0, 10), PKW(pB0, 12), PKW(pB0, 14)}; pw2 = (u32x4){PKW(pB1, 0), PKW(pB1, 2), PKW(pB1, 4), PKW(pB1, 6)}; pw3 = (u32x4){PKW(pB1, 8), PKW(pB1, 10), PKW(pB1, 12), PKW(pB1, 14)};
    SBAR(); pv(o, vb0 + sl_cur, PAF(0), PAF(1), PAF(2), PAF(3)); }
  #undef PKW
  #undef PAF
  #undef VFR
  #undef PIN
  #undef MX3
  #undef GAPA
  #undef GAPB
  #undef EX
  #undef VRD
  #undef KRD
  #undef STEP
  #undef ENDW
  { auto rr = __builtin_amdgcn_permlane32_swap(__float_as_uint(l_reg), __float_as_uint(l_reg), false, false); l_reg = __uint_as_float(rr[0]) + __uint_as_float(rr[1]); }
  if (hi == 0) wsf[32 + r32] = l_reg; asm volatile("s_waitcnt lgkmcnt(0)" ::: "memory");
  float rli[16];
  #pragma unroll
  for (int r = 0; r < 16; ++r) rli[r] = __builtin_amdgcn_rcpf(wsf[32 + crow(r, hi)]);
  bf16* Ow = O + (rowbase + q0 + wid * QBLK) * DMA + hv * D;
  { bf16* stg = (bf16*)(shm + LDS_OST) + wid * 2048;
    #pragma unroll
    for (int r = 0; r < 16; ++r) { const int orow = crow(r, hi);
      #pragma unroll
      for (int d0 = 0; d0 < 2; ++d0) stg[orow * 64 + d0 * 32 + r32] = f2bf(o[d0][r] * rli[r]); }
    asm volatile("s_waitcnt lgkmcnt(0)" ::: "memory");
    #pragma unroll
    for (int i = 0; i < 4; ++i) { const int row = i * 8 + (lane >> 3), ch = lane & 7; const u32x4 v = *(const u32x4*)(stg + row * 64 + ch * 8); ATTN_STORE16(Ow + (long)row * DMA + ch * 8, v); } }
  asm volatile("s_waitcnt lgkmcnt(0)\n\ts_barrier" ::: "memory");
  #undef DMA_K
  #undef DMA_V
  #undef CMASK
  #undef START
  #undef RESC
  #undef ROT
}
constexpr int ATTN_LDS_BYTES = LDS_BYTES;
#undef SBAR
#undef WAIT_BAR
}

namespace attn3 {
using namespace attn_body;
constexpr int KSLOT = 8192, VSLOT = 16384;
constexpr int L_K = 0, L_V = NSLOT * KSLOT, L_WS = L_V + NSLOT * VSLOT, L_OST = L_WS + NW * 64 * 4, L_BYTES = L_OST + NW * 4096;
#define SBAR() __builtin_amdgcn_sched_barrier(0)
#define WAIT_BAR(N) asm volatile("s_waitcnt vmcnt(" #N ") lgkmcnt(0)\n\ts_barrier" ::: "memory")
template <int THRL> __device__ __forceinline__ void attn_unit(int tid_in, int b, int hq, int h, int qb, const bf16* Q, const bf16* __restrict__ K, const bf16* __restrict__ V, bf16* O, char* shm,
                                                             int mode, const bf16* SZ1, const float* g_sub, float lam, bf16* OG,
                                                             bool primed, bool has_next, int nb, int nhq, int nh, int nqb, bf16x8 (&qr)[4]) {
  int tid_ = tid_in; asm volatile("" : "+v"(tid_));
  const int tid = tid_, lane = tid & 63, r32 = lane & 31, hi = lane >> 5; const int wid = __builtin_amdgcn_readfirstlane(tid >> 6);
  const long rowbase = (long)b * SEQ; const int q0 = qb * QB;
  const bf16* Qw = Q + (rowbase + q0 + wid * QBLK) * DMA + hq * D;
  const bf16* Kh = K + rowbase * DMA + hq * D, *Vh = V + rowbase * DMA + h * 128;
  const unsigned lds0 = (unsigned)(uintptr_t)shm;
  float* wsf = (float*)(shm + L_WS) + wid * 64;
  const bf16* ksrc = Kh + (long)lane * DMA + wid * 8;
  const bf16* vsrc = Vh + (long)(16 * (wid & 3) + (lane >> 2)) * DMA + (wid >> 2) * 32 + (lane & 3) * 8;
  const unsigned kdst = lds0 + L_K + wid * 1024, vdst = lds0 + L_V + wid * 1024;
  #define DMA_K(t, si) glds16(ksrc + (long)(t) * KVBLK * DMA, (unsigned)__builtin_amdgcn_readfirstlane(kdst + (si) * KSLOT))
  #define DMA_V(t, si) do { glds16(vsrc + (long)(t) * KVBLK * DMA, (unsigned)__builtin_amdgcn_readfirstlane(vdst + (si) * VSLOT)); \
                            glds16(vsrc + (long)(t) * KVBLK * DMA + 64, (unsigned)__builtin_amdgcn_readfirstlane(vdst + (si) * VSLOT + 8192)); } while (0)
  const int vb0 = (int)(lds0 + L_V) + ((lane >> 4) & 1) * 32 + (lane & 3) * 8 + (4 * hi + ((lane & 15) >> 2)) * 64;
  const char* Kbase = shm + L_K; bf16x8 kf[8];
  const lds_cptr shm3 = (lds_cptr)shm; const lds_cptr kp0 = shm3 + L_K + hi * 1024 + r32 * 16; const lds_cptr vp0 = shm3 + L_V + ((lane >> 4) & 1) * 32 + (lane & 3) * 8 + (4 * hi + ((lane & 15) >> 2)) * 64;
  const int NT = (q0 + QB) / KVBLK;
  if (!primed) { DMA_K(0, 0); DMA_V(0, 0); DMA_K(1, 1);
    #pragma unroll
    for (int d0 = 0; d0 < 4; ++d0) qr[d0] = *reinterpret_cast<const bf16x8*>(&Qw[(long)r32 * DMA + d0 * 16 + hi * 8]); }
  float mhat = 0.f, l_reg = 0.f; f32x16 o[4]; f32x16 negm;
  { float zf = 0.f; asm volatile("" : "+v"(zf));
    _Pragma("unroll") for (int r = 0; r < 16; ++r) { o[0][r] = zf; o[1][r] = zf; o[2][r] = zf; o[3][r] = zf; negm[r] = zf; } }
  asm volatile("" : "+v"(negm));
  const int qrel = wid * QBLK + r32;
  #define CMASK(P0, P1, t) do { int jb_ = (t) - (NT - 4); if (jb_ >= 0) cmask(P0, P1, jb_, qrel, hi); } while (0)
  bool resc = false;
  #define RESC() do { if (resc) { asm volatile("s_waitcnt lgkmcnt(0)" ::: "memory"); \
      _Pragma("unroll") for (int d_ = 0; d_ < 4; ++d_) _Pragma("unroll") for (int r = 0; r < 16; ++r) o[d_][r] *= wsf[crow(r, hi)]; } } while (0)
  f32x16 C0, C1;
  int s_prev = 0, s_cur = 0, s_next = 1;
  #define ROT() do { s_prev = s_cur; s_cur = s_next; s_next = (s_next == NSLOT - 1) ? 0 : s_next + 1; } while (0)
  if (!primed) { DMA_K(2, 2); WAIT_BAR(4); }
  else { WAIT_BAR(0); }
  u32x4 pwA0, pwA1, pwA2, pwA3, pwB0, pwB1, pwB2, pwB3;
  #define PKW(P, B) cvtpk_s(P[B], P[B + 1])
  qkt(C0, C1, Kbase, qr, negm, r32, hi); asm volatile("s_nop 15\n\ts_nop 7" : "+v"(C0), "+v"(C1)); CMASK(C0, C1, 0);
  { const float rm = rowmax(C0, C1); mhat = fadd_s(mhat, rm);
    _Pragma("unroll") for (int r = 0; r < 16; ++r) { C0[r] = fsub_s(C0[r], rm); C1[r] = fsub_s(C1[r], rm); }
    _Pragma("unroll") for (int r = 0; r < 16; ++r) negm[r] = -mhat; asm volatile("" : "+v"(negm));
    float sacc = 0.f;
    _Pragma("unroll") for (int r = 0; r < 16; ++r) { C0[r] = __builtin_amdgcn_exp2f(C0[r]); C1[r] = __builtin_amdgcn_exp2f(C1[r]); }
    _Pragma("unroll") for (int r = 0; r < 16; ++r) sacc += C0[r] + C1[r];
    l_reg = sacc;
    pwA0 = (u32x4){PKW(C0, 0), PKW(C0, 2), PKW(C0, 4), PKW(C0, 6)}; pwA1 = (u32x4){PKW(C0, 8), PKW(C0, 10), PKW(C0, 12), PKW(C0, 14)};
    pwA2 = (u32x4){PKW(C1, 0), PKW(C1, 2), PKW(C1, 4), PKW(C1, 6)}; pwA3 = (u32x4){PKW(C1, 8), PKW(C1, 10), PKW(C1, 12), PKW(C1, 14)}; }
  WAIT_BAR(0);
  DMA_K(3, 0); DMA_V(1, 1);
  ROT();
  kload8(kf, kp0 + s_cur * KSLOT);
  WAIT_BAR(3);
  s16x4 vlo[8], vhi[8];
  #define PAF(w) __builtin_bit_cast(bf16x8, w)
  #define VFR(i) (bf16x8){vlo[i][0], vlo[i][1], vlo[i][2], vlo[i][3], vhi[i][0], vhi[i][1], vhi[i][2], vhi[i][3]}
  #define PIN(x) asm volatile("" : "+v"(x))
  #define MX3(a, b, c) __builtin_fmaxf(__builtin_fmaxf((a), (b)), (c))
  #define EX(v) __builtin_amdgcn_exp2f(v)
  #define VRD(s, f) do { vlo[s] = vtr(vp_ + (((f) >> 2) * 4096 + ((f) & 3) * 1024)); vhi[s] = vtr(vp_ + (((f) >> 2) * 4096 + ((f) & 3) * 1024 + 512)); } while (0)
  #define KRD(G, j) do { if (G) { kload2(kf, kp0 + s_next * KSLOT, j); SBAR(); } } while (0)
  #define GAPB(MF, X, B, PWW) do { MF; X[B] = EX(X[B]); X[B + 1] = EX(X[B + 1]); sacc += X[B]; sacc += X[B + 1]; PIN(sacc); PWW = PKW(X, B); PIN(PWW); SBAR(); } while (0)
  #define MFQ(a, b, c) __builtin_amdgcn_mfma_f32_32x32x16_bf16(a, b, c, 0, 0, 0)
  #define STEP(PP0, PP1, PP2, PP3, PN0, PN1, PN2, PN3, t, GK, GV, GL) do { SBAR(); \
    const lds_cptr vp_ = vp0 + s_prev * VSLOT; \
    VRD(0, 0); SBAR(); C0 = MFQ(kf[0], qr[0], negm); SBAR(); \
    VRD(4, 4); SBAR(); C1 = MFQ(kf[1], qr[0], negm); SBAR(); \
    VRD(1, 1); SBAR(); C0 = MFQ(kf[2], qr[1], C0); SBAR(); \
    VRD(5, 5); SBAR(); C1 = MFQ(kf[3], qr[1], C1); SBAR(); \
    VRD(2, 2); SBAR(); C0 = MFQ(kf[4], qr[2], C0); SBAR(); \
    VRD(6, 6); SBAR(); C1 = MFQ(kf[5], qr[2], C1); SBAR(); \
    VRD(3, 3); SBAR(); C0 = MFQ(kf[6], qr[3], C0); SBAR(); \
    VRD(7, 7); SBAR(); C1 = MFQ(kf[7], qr[3], C1); SBAR(); \
    if (GK) { DMA_K((t) + 3, s_cur); } if (GV) { DMA_V((t) + 1, s_next); } \
    CMASK(C0, C1, t); \
    { float a = MX3(C0[0], C0[1], C1[0]), b = MX3(C0[2], C0[3], C1[1]); a = MX3(a, C1[2], C1[3]); \
      _Pragma("unroll") for (int r = 4; r < 16; r += 4) { a = MX3(a, C0[r], C0[r + 1]); b = MX3(b, C0[r + 2], C0[r + 3]); a = MX3(a, C1[r], C1[r + 1]); b = MX3(b, C1[r + 2], C1[r + 3]); } \
      float rm = __builtin_fmaxf(a, b); { auto rr = __builtin_amdgcn_permlane32_swap(__float_as_uint(rm), __float_as_uint(rm), false, false); rm = __builtin_fmaxf(__uint_as_float(rr[0]), __uint_as_float(rr[1])); } \
      resc = false; \
      if (__builtin_expect(__any(rm > (float)THRL), 0)) { const float dl = __builtin_fmaxf(rm, 0.f); mhat += dl; \
        _Pragma("unroll") for (int r = 0; r < 16; ++r) { C0[r] -= dl; C1[r] -= dl; } \
        _Pragma("unroll") for (int r = 0; r < 16; ++r) negm[r] = -mhat; asm volatile("" : "+v"(negm)); \
        const float f = __builtin_amdgcn_exp2f(-dl); l_reg *= f; if (hi == 0) wsf[r32] = f; resc = true; } } \
    SBAR(); float sacc = 0.f; \
    GAPB(o[0] = MFQ(PAF(PP0), VFR(0), o[0]), C0, 0,  PN0[0]); VRD(0, 8);  SBAR(); \
    GAPB(o[1] = MFQ(PAF(PP0), VFR(4), o[1]), C0, 2,  PN0[1]); VRD(4, 12); SBAR(); \
    GAPB(o[0] = MFQ(PAF(PP1), VFR(1), o[0]), C0, 4,  PN0[2]); VRD(1, 9);  SBAR(); \
    GAPB(o[1] = MFQ(PAF(PP1), VFR(5), o[1]), C0, 6,  PN0[3]); VRD(5, 13); SBAR(); \
    GAPB(o[0] = MFQ(PAF(PP2), VFR(2), o[0]), C0, 8,  PN1[0]); VRD(2, 10); SBAR(); \
    GAPB(o[1] = MFQ(PAF(PP2), VFR(6), o[1]), C0, 10, PN1[1]); VRD(6, 14); SBAR(); \
    GAPB(o[0] = MFQ(PAF(PP3), VFR(3), o[0]), C0, 12, PN1[2]); VRD(3, 11); SBAR(); \
    GAPB(o[1] = MFQ(PAF(PP3), VFR(7), o[1]), C0, 14, PN1[3]); VRD(7, 15); SBAR(); \
    GAPB(o[2] = MFQ(PAF(PP0), VFR(0), o[2]), C1, 0,  PN2[0]); \
    GAPB(o[3] = MFQ(PAF(PP0), VFR(4), o[3]), C1, 2,  PN2[1]); \
    KRD(GL, 0); GAPB(o[2] = MFQ(PAF(PP1), VFR(1), o[2]), C1, 4,  PN2[2]); \
    KRD(GL, 1); GAPB(o[3] = MFQ(PAF(PP1), VFR(5), o[3]), C1, 6,  PN2[3]); \
    KRD(GL, 2); GAPB(o[2] = MFQ(PAF(PP2), VFR(2), o[2]), C1, 8,  PN3[0]); \
    KRD(GL, 3); GAPB(o[3] = MFQ(PAF(PP2), VFR(6), o[3]), C1, 10, PN3[1]); \
    GAPB(o[2] = MFQ(PAF(PP3), VFR(3), o[2]), C1, 12, PN3[2]); \
    GAPB(o[3] = MFQ(PAF(PP3), VFR(7), o[3]), C1, 14, PN3[3]); \
    l_reg += sacc; \
    } while (0)
  #define STEP_AB(t, GK, GV, GL) STEP(pwA0, pwA1, pwA2, pwA3, pwB0, pwB1, pwB2, pwB3, t, GK, GV, GL)
  #define STEP_BA(t, GK, GV, GL) STEP(pwB0, pwB1, pwB2, pwB3, pwA0, pwA1, pwA2, pwA3, t, GK, GV, GL)
  int t = 1;
  #undef CMASK
  #define CMASK(P0, P1, t) do {} while (0)
  for (; t + 5 < NT; t += 2) {
    STEP_AB(t, true, true, true);     WAIT_BAR(3); RESC(); ROT();
    STEP_BA(t + 1, true, true, true); WAIT_BAR(3); RESC(); ROT();
  }
  #undef CMASK
  #define CMASK(P0, P1, t) do { int jb_ = (t) - (NT - 4); if (jb_ >= 0) cmask(P0, P1, jb_, qrel, hi); } while (0)
  #define ENDW(tt) do { if ((tt) + 3 < NT) { WAIT_BAR(3); } else if ((tt) + 2 < NT) { WAIT_BAR(2); } else { WAIT_BAR(0); } } while (0)
  for (; t + 1 < NT; t += 2) {
    STEP_AB(t, (t + 3 < NT), (t + 1 < NT), (t + 1 < NT));         ENDW(t);     RESC(); ROT();
    STEP_BA(t + 1, (t + 4 < NT), (t + 2 < NT), (t + 2 < NT));     ENDW(t + 1); RESC(); ROT();
  }
  STEP_AB(NT - 1, false, false, false); RESC();
  { SBAR();
    const int vb = vb0 + s_cur * VSLOT;
    #pragma unroll
    for (int d0 = 0; d0 < 4; ++d0) { s16x4 lo[4], hh[4];
      #pragma unroll
      for (int ks = 0; ks < 4; ++ks) {
        asm volatile("ds_read_b64_tr_b16 %0,%1 offset:%c2" : "=&v"(lo[ks]) : "v"(vb), "i"(d0 * 4096 + ks * 1024) : "memory");
        asm volatile("ds_read_b64_tr_b16 %0,%1 offset:%c2" : "=&v"(hh[ks]) : "v"(vb), "i"(d0 * 4096 + ks * 1024 + 512) : "memory"); }
      asm volatile("s_waitcnt lgkmcnt(0)" ::: "memory"); SBAR();
      #define PK(k) (bf16x8){lo[k][0], lo[k][1], lo[k][2], lo[k][3], hh[k][0], hh[k][1], hh[k][2], hh[k][3]}
      o[d0] = MFQ(PAF(pwB0), PK(0), o[d0]); o[d0] = MFQ(PAF(pwB1), PK(1), o[d0]); o[d0] = MFQ(PAF(pwB2), PK(2), o[d0]); o[d0] = MFQ(PAF(pwB3), PK(3), o[d0]);
      #undef PK
    } }
  asm volatile("s_waitcnt lgkmcnt(0)\n\ts_barrier" ::: "memory");
  if (has_next) {
    const long nrow = (long)nb * SEQ; const int nq0 = nqb * QB;
    const bf16* nQw = Q + (nrow + nq0 + wid * QBLK) * DMA + nhq * D;
    const bf16* nks = K + nrow * DMA + nhq * D + (long)lane * DMA + wid * 8;
    const bf16* nvs = V + nrow * DMA + nh * 128 + (long)(16 * (wid & 3) + (lane >> 2)) * DMA + (wid >> 2) * 32 + (lane & 3) * 8;
    glds16(nks, (unsigned)__builtin_amdgcn_readfirstlane(kdst));
    glds16(nvs, (unsigned)__builtin_amdgcn_readfirstlane(vdst)); glds16(nvs + 64, (unsigned)__builtin_amdgcn_readfirstlane(vdst + 8192));
    glds16(nks + (long)KVBLK * DMA, (unsigned)__builtin_amdgcn_readfirstlane(kdst + KSLOT));
    glds16(nks + (long)2 * KVBLK * DMA, (unsigned)__builtin_amdgcn_readfirstlane(kdst + 2 * KSLOT));
    #pragma unroll
    for (int d0 = 0; d0 < 4; ++d0) qr[d0] = *reinterpret_cast<const bf16x8*>(&nQw[(long)r32 * DMA + d0 * 16 + hi * 8]);
  }
  { auto rr = __builtin_amdgcn_permlane32_swap(__float_as_uint(l_reg), __float_as_uint(l_reg), false, false); l_reg = __uint_as_float(rr[0]) + __uint_as_float(rr[1]); }
  if (hi == 0) wsf[32 + r32] = l_reg; asm volatile("s_waitcnt lgkmcnt(0)" ::: "memory");
  float rli[16];
  #pragma unroll
  for (int r = 0; r < 16; ++r) rli[r] = __builtin_amdgcn_rcpf(wsf[32 + crow(r, hi)]);
  int lane_e = lane; asm volatile("" : "+v"(lane_e));
  const int erow = lane_e >> 3, ech = lane_e & 7;
  bf16* Ow = O + (rowbase + q0 + wid * QBLK) * DMA + h * 128;
  bf16* stg = (bf16*)(shm + L_OST) + wid * 2048;
  if (mode == 0) {
    #pragma unroll
    for (int ps = 0; ps < 2; ++ps) {
      #pragma unroll
      for (int r = 0; r < 16; ++r) { const int orow = crow(r, hi);
        #pragma unroll
        for (int d0 = 0; d0 < 2; ++d0) stg[orow * 64 + d0 * 32 + r32] = f2bf(o[2 * ps + d0][r] * rli[r]); }
      asm volatile("s_waitcnt lgkmcnt(0)" ::: "memory");
      #pragma unroll
      for (int i = 0; i < 4; ++i) { const int row = i * 8 + erow, ch = ech; const u32x4 v = *(const u32x4*)(stg + row * 64 + ch * 8); *(u32x4*)(Ow + (long)row * DMA + ps * 64 + ch * 8) = v; }
      asm volatile("s_waitcnt lgkmcnt(0)" ::: "memory");
    }
    asm volatile("s_waitcnt vmcnt(0)" ::: "memory");
  } else {
    const bf16* Zw = SZ1 + (rowbase + q0 + wid * QBLK) * DMA + h * 128; bf16* Gw = OG + (rowbase + q0 + wid * QBLK) * DMA + h * 128;
    float dk[2][4][8]; float ss[4] = {0.f, 0.f, 0.f, 0.f};
    #pragma unroll
    for (int ps = 0; ps < 2; ++ps) {
      #pragma unroll
      for (int r = 0; r < 16; ++r) { const int orow = crow(r, hi);
        #pragma unroll
        for (int d0 = 0; d0 < 2; ++d0) stg[orow * 64 + d0 * 32 + r32] = f2bf(o[2 * ps + d0][r] * rli[r]); }
      asm volatile("s_waitcnt lgkmcnt(0)" ::: "memory");
      #pragma unroll
      for (int i = 0; i < 4; ++i) { const int row = i * 8 + erow, ch = ech;
        const u32x4 v1 = *(const u32x4*)(stg + row * 64 + ch * 8); const u32x4 v0 = *(const u32x4*)(Ow + (long)row * DMA + ps * 64 + ch * 8);
        #pragma unroll
        for (int j = 0; j < 4; ++j) { const float a0 = __uint_as_float(v0[j] << 16), a1 = __uint_as_float(v0[j] & 0xffff0000u), b0 = __uint_as_float(v1[j] << 16), b1 = __uint_as_float(v1[j] & 0xffff0000u);
          const float d0_ = a0 - lam * b0, d1_ = a1 - lam * b1; dk[ps][i][2 * j] = d0_; dk[ps][i][2 * j + 1] = d1_; ss[i] += d0_ * d0_ + d1_ * d1_; } }
      asm volatile("s_waitcnt lgkmcnt(0)" ::: "memory");
    }
    #pragma unroll
    for (int i = 0; i < 4; ++i) { float t_ = ss[i];
      t_ += __int_as_float(__builtin_amdgcn_ds_swizzle(__float_as_int(t_), 0x1f | (1 << 10))); t_ += __int_as_float(__builtin_amdgcn_ds_swizzle(__float_as_int(t_), 0x1f | (2 << 10)));
      t_ += __int_as_float(__builtin_amdgcn_ds_swizzle(__float_as_int(t_), 0x1f | (4 << 10))); ss[i] = rsqrtf(t_ * (1.0f / 128.0f) + RMS_EPS) * ONE_M_LI; }
    #pragma unroll
    for (int ps = 0; ps < 2; ++ps) {
      const int ch = ech; const float* gp = g_sub + ps * 64 + ch * 8; const f32x4_t g0 = *(const f32x4_t*)gp, g1 = *(const f32x4_t*)(gp + 4);
      #pragma unroll
      for (int i = 0; i < 4; ++i) { const int row = i * 8 + erow;
        const u32x4 z = NT_LD((const u32x4*)(Zw + (long)row * DMA + ps * 64 + ch * 8)); u32x4 w;
        #pragma unroll
        for (int j = 0; j < 4; ++j) { const float z0 = __uint_as_float(z[j] << 16), z1 = __uint_as_float(z[j] & 0xffff0000u);
          const float ga = (j < 2) ? g0[2 * j] : g1[2 * j - 4], gb = (j < 2) ? g0[2 * j + 1] : g1[2 * j - 3];
          w[j] = cvtpk_s(dk[ps][i][2 * j] * ss[i] * ga * z0, dk[ps][i][2 * j + 1] * ss[i] * gb * z1); }
        *(u32x4*)(Gw + (long)row * DMA + ps * 64 + ch * 8) = w; }
    }
  }
  asm volatile("s_waitcnt lgkmcnt(0)" ::: "memory");
  #undef DMA_K
  #undef DMA_V
  #undef CMASK
  #undef RESC
  #undef ROT
  #undef PKW
  #undef PAF
  #undef VFR
  #undef PIN
  #undef MX3
  #undef EX
  #undef VRD
  #undef KRD
  #undef GAPB
  #undef MFQ
  #undef STEP
  #undef STEP_AB
  #undef STEP_BA
  #undef ENDW
}
#undef SBAR
#undef WAIT_BAR
}

constexpr int NWAVES = 8;
constexpr size_t MiB = 1u << 20;
constexpr size_t WS_CTL = 0, CTL_ZERO_BYTES = 1 * MiB;
constexpr size_t WS_MOD = 256 * 1024;
constexpr size_t WS_LAM = 1 * MiB;
constexpr size_t WS_LB16 = 1 * MiB + 4096;
constexpr size_t WS_WIN0 = 2 * MiB, WS_WGLU = 6 * MiB, WS_WOUT0 = 8 * MiB, WS_WKV = 10 * MiB, WS_WIN1 = 14 * MiB, WS_WOUT1 = 18 * MiB;
constexpr size_t WS_BTA = 20 * MiB;
constexpr size_t WS_BTB = 28 * MiB;
constexpr size_t WS_S0 = 48 * MiB, WS_S1 = 112 * MiB, WS_S2 = 176 * MiB, WS_S3 = 240 * MiB, WS_S4 = 304 * MiB, WS_S5 = 368 * MiB, WS_S6 = 432 * MiB, WS_END = 496 * MiB;
constexpr int CW_BAR = 4096;
constexpr int CW_TMO = 8, CW_SEAM = 16384, SEAM_BANK = 128 * 64;
constexpr size_t WS_XCH = 40 * MiB;
constexpr int RING_OFF = 0, RING_BYTES = 131072;
constexpr int LDSCTL_OFF = RING_BYTES, MISC_OFF = LDSCTL_OFF + 320;
constexpr int LDS_BYTES = 147456;

#define GAS __attribute__((address_space(1)))
#define LAS __attribute__((address_space(3)))
typedef unsigned v4u __attribute__((ext_vector_type(4)));
typedef GAS unsigned gu32;
#define RLX_AGENT __ATOMIC_RELAXED, __HIP_MEMORY_SCOPE_AGENT
#define LDS_WAIT() asm volatile("s_waitcnt lgkmcnt(0)" ::: "memory")
#define VM_WAIT() asm volatile("s_waitcnt vmcnt(0)" ::: "memory")

#define XB_TMO      128
#define XB_XCNT(j)  (256  + 64 * (j))
#define XB_XSUB(j)  (1280 + 64 * (j))
#define XB_XGEN(j)  (2304 + 64 * (j))
#define XB_TOP      3328
#define XB_TOPGEN   3392
#define XCD_BAR_WORDS 3456
#define XB_SPIN_CAP (1u << 18)
__device__ __forceinline__ unsigned xb_ld(unsigned* p)              { return __hip_atomic_load(p, __ATOMIC_RELAXED, __HIP_MEMORY_SCOPE_AGENT); }
__device__ __forceinline__ unsigned xb_add(unsigned* p, unsigned v) { return __hip_atomic_fetch_add(p, v, __ATOMIC_RELAXED, __HIP_MEMORY_SCOPE_AGENT); }
__device__ __forceinline__ unsigned xb_xcc_id() { return (unsigned)__builtin_amdgcn_s_getreg((3 << 11) | 20) & 0xFu; }
#define XB_SPIN(cond, bar) do { unsigned _sp = 0; while (cond) { __builtin_amdgcn_s_sleep(1); \
    if ((++_sp & 255u) == 0u) { if (xb_ld(&(bar)[XB_TMO])) break; if (_sp > XB_SPIN_CAP) { atomicAdd(&(bar)[XB_TMO], 1u); break; } } } } while (0)
struct XcdBarrier { unsigned* bar; unsigned x; volatile LAS unsigned* st; };
__device__ __forceinline__ XcdBarrier xcd_barrier_post(unsigned* bar, volatile LAS unsigned* st, int tid) {
    XcdBarrier b; b.bar = bar; b.x = xb_xcc_id(); b.st = st;
    if (tid == 0) (void)xb_add(&bar[XB_XCNT(b.x)], 1u);
    return b;
}
__device__ __forceinline__ void xcd_barrier_complete(unsigned* bar, unsigned x, unsigned& nloc, unsigned& nx) {
    const unsigned G = gridDim.x * gridDim.y * gridDim.z;
    unsigned sum, cnt, mine, sp = 0u;
    for (;;) {
        sum = 0u; cnt = 0u; mine = 0u;
#pragma unroll
        for (unsigned j = 0; j < 16; ++j) { const unsigned c = xb_ld(&bar[XB_XCNT(j)]); sum += c; cnt += (c > 0u) ? 1u : 0u; mine = (j == x) ? c : mine; }
        if (sum == G) break;
        __builtin_amdgcn_s_sleep(1);
        if ((++sp & 255u) == 0u) { if (xb_ld(&bar[XB_TMO])) break; if (sp > XB_SPIN_CAP) { atomicAdd(&bar[XB_TMO], 1u); break; } }
    }
    nloc = mine > 0u ? mine : 1u; nx = cnt > 0u ? cnt : 1u;
}
__device__ __forceinline__ void xcd_barrier(const XcdBarrier& b, int tid) {
    asm volatile("s_waitcnt vmcnt(0)" ::: "memory");
    __syncthreads();
    if (tid == 0) {
        unsigned* bar = b.bar;
        __builtin_amdgcn_s_waitcnt(0);
        unsigned nloc = b.st[0], nx = b.st[1];
        if (nloc == 0u) { xcd_barrier_complete(bar, b.x, nloc, nx); b.st[0] = nloc; b.st[1] = nx; }
        const unsigned old = xb_add(&bar[XB_XSUB(b.x)], 1u);
        const unsigned gen = old / nloc;
        if (old + 1u == (gen + 1u) * nloc) {
            __builtin_amdgcn_fence(__ATOMIC_RELEASE, "agent");
            asm volatile("s_waitcnt vmcnt(0)" ::: "memory");
            const unsigned og = xb_add(&bar[XB_TOP], 1u);
            const unsigned tg = og / nx;
            if (og + 1u == (tg + 1u) * nx) xb_add(&bar[XB_TOPGEN], 1u);
            else XB_SPIN(xb_ld(&bar[XB_TOPGEN]) == tg, bar);
            __builtin_amdgcn_fence(__ATOMIC_ACQUIRE, "agent");
            xb_add(&bar[XB_XGEN(b.x)], 1u);
            asm volatile("s_waitcnt vmcnt(0)" ::: "memory");
        } else {
            XB_SPIN(xb_ld(&bar[XB_XGEN(b.x)]) == gen, bar);
            __builtin_amdgcn_fence(__ATOMIC_ACQUIRE, "agent");
            asm volatile("s_waitcnt vmcnt(0)" ::: "memory");
        }
    }
    __syncthreads();
}

__device__ __forceinline__ void p0_transpose_item(const float* W, int K, int N, bf16_t* WT, int row_off, const float* kscale, LAS float* scr, int item, int lane) {
    const int nblk = N / 32, kb = item / nblk, nb = item % nblk, k0 = 64 * kb, n0 = 32 * nb;
    float tv[32];
#pragma unroll
    for (int i = 0; i < 32; ++i) tv[i] = NT_LD(W + (size_t)(k0 + 2 * i + (lane >> 5)) * N + n0 + (lane & 31));
#pragma unroll
    for (int i = 0; i < 32; ++i) { const int kk = 2 * i + (lane >> 5); float v = tv[i]; if (kscale) v *= kscale[k0 + kk]; scr[kk * 33 + (lane & 31)] = v; }
    LDS_WAIT(); asm volatile("" ::: "memory");
    const int c = lane & 7;
#pragma unroll
    for (int j = 0; j < 4; ++j) { const int n = (lane >> 3) + 8 * j; const LAS float* s = scr + (8 * c) * 33 + n;
        v4u o; o.x = pk2bf(s[0 * 33], s[1 * 33]); o.y = pk2bf(s[2 * 33], s[3 * 33]); o.z = pk2bf(s[4 * 33], s[5 * 33]); o.w = pk2bf(s[6 * 33], s[7 * 33]);
        *(GAS v4u*)(WT + (size_t)(row_off + n0 + n) * K + k0 + 8 * c) = o; }
    LDS_WAIT(); asm volatile("" ::: "memory");
}

__device__ __forceinline__ int lane_now_asm() { int r; asm volatile("v_mbcnt_lo_u32_b32 %0, -1, 0\n\tv_mbcnt_hi_u32_b32 %0, -1, %0" : "=v"(r)); return r; }
struct Args {
    const float* in[28]; float* out; unsigned char* ws;
    int ph_lo, ph_hi, use_bar, flags;
};

__global__ void __launch_bounds__(NWAVES * 64, 2) mega_fwd(Args args) {
    extern __shared__ __attribute__((aligned(16))) unsigned char lds_raw[];
    LAS unsigned char* lds = (LAS unsigned char*)lds_raw;
    volatile LAS unsigned* MISC = (volatile LAS unsigned*)(lds + MISC_OFF);
    const int wave = __builtin_amdgcn_readfirstlane((int)threadIdx.x >> 6);
#define LANE_NOW() lane_now_asm()
#define TID_NOW() (wave * 64 + LANE_NOW())
    const int G = gridDim.x; const int bx = blockIdx.x; const int vcu = (G % 8 == 0) ? (bx % 8) * (G / 8) + bx / 8 : bx;
    unsigned char* ws = args.ws;
    gu32* ctl = (gu32*)(ws + WS_CTL);
    const float* x = args.in[0]; const float* cvec = args.in[1]; const float* ada_w = args.in[2]; const float* ada_b = args.in[3];
    const float* g_pre = args.in[4]; const float* g_post = args.in[5];
    float* out = args.out;
    float* mod = (float*)(ws + WS_MOD); float* lamp = (float*)(ws + WS_LAM); float* lb16 = (float*)(ws + WS_LB16);
    bf16_t* Win0 = (bf16_t*)(ws + WS_WIN0); bf16_t* Wglu = (bf16_t*)(ws + WS_WGLU); bf16_t* Wout0 = (bf16_t*)(ws + WS_WOUT0); bf16_t* Wkv = (bf16_t*)(ws + WS_WKV);
    bf16_t* Win1 = (bf16_t*)(ws + WS_WIN1); bf16_t* Wout1 = (bf16_t*)(ws + WS_WOUT1); bf16_t* BtA = (bf16_t*)(ws + WS_BTA); bf16_t* BtB = (bf16_t*)(ws + WS_BTB);
    bf16_t* A0 = (bf16_t*)(ws + WS_S0); bf16_t* US = (bf16_t*)(ws + WS_S1); bf16_t* SZ = (bf16_t*)(ws + WS_S3); bf16_t* YG = (bf16_t*)(ws + WS_S4); float* EB = (float*)(ws + WS_S0);
    bf16_t* Y2 = (bf16_t*)(ws + WS_S0); bf16_t* YO = (bf16_t*)(ws + WS_S1); bf16_t* AKV = (bf16_t*)(ws + WS_S0); bf16_t* AIN1 = (bf16_t*)(ws + WS_S2);
    bf16_t* KB = (bf16_t*)(ws + WS_S3); bf16_t* VB = (bf16_t*)(ws + WS_S4); bf16_t* QB = (bf16_t*)(ws + WS_S5); bf16_t* SZ1 = (bf16_t*)(ws + WS_S6);
    bf16_t* O0 = (bf16_t*)(ws + WS_S0); bf16_t* O1 = (bf16_t*)(ws + WS_S1); bf16_t* OG = (bf16_t*)(ws + WS_S2); bf16_t* YO1 = (bf16_t*)(ws + WS_S0);

    for (int u = TID_NOW(); u < (LDS_BYTES - LDSCTL_OFF) / 4; u += NWAVES * 64) ((LAS unsigned*)(lds + LDSCTL_OFF))[u] = 0u;
    __syncthreads();
    XcdBarrier bar; bar.bar = (unsigned*)(ctl + CW_BAR); bar.x = 0; bar.st = nullptr;
    if (args.use_bar) bar = xcd_barrier_post((unsigned*)(ctl + CW_BAR), MISC + 8, TID_NOW());
    const int lo = args.ph_lo, hi = args.ph_hi;
#define IN(k) (lo <= (k) && (k) < hi)
#define REPS(k) (1 + ((REPEAT_MASK >> (k)) & 1))
#define SEAM(k) do { if (IN(k) && IN((k) + 1) && args.use_bar) xcd_barrier(bar, TID_NOW()); } while (0)
    const int gw = vcu * NWAVES + wave, NGW = G * NWAVES;
#define LANE_L() ({ int l_ = LANE_NOW(); asm volatile("" : "+v"(l_)); l_; })

    if (IN(0)) for (int rep_ = 0; rep_ < REPS(0); ++rep_) {
        const int tid = TID_NOW(), lane = tid & 63;
        for (int it = vcu; it < NGRP * 4; it += G) {
            const int g = it >> 2, qt = it & 3;
            LAS float* LBP = (LAS float*)(lds + RING_OFF);
            LAS float* BBR = LBP + 17 * 128;
            LAS float* CC = BBR + 64 * 32;
            LAS float* KM = CC + 16 * 130 + 12;
            __syncthreads();
            if (tid < 64) {
                const int p = tid;
                const float dt = expf(args.in[9][g]);
                const float lr = args.in[7][g * 64 + p], li = args.in[8][g * 64 + p];
                const float mag = expf(lr * dt); const float sn = sinf(li * dt), cs = cosf(li * dt);
                const float lbr = mag * cs, lbi = mag * sn;
                float pr = 1.f, pi = 0.f;
                for (int d = 0; d <= 16; ++d) { LBP[(d * 64 + p) * 2] = pr; LBP[(d * 64 + p) * 2 + 1] = pi; const float nr = pr * lbr - pi * lbi, ni = pr * lbi + pi * lbr; pr = nr; pi = ni; }
                if (qt == 0) { lb16[(g * 64 + p) * 2] = LBP[(16 * 64 + p) * 2]; lb16[(g * 64 + p) * 2 + 1] = LBP[(16 * 64 + p) * 2 + 1]; }
                const float nr = lbr - 1.0f, ni = lbi, den = lr * lr + li * li;
                const float cr = (nr * lr + ni * li) / den, ci = (ni * lr - nr * li) / den;
                for (int c = 0; c < 16; ++c) { const float br = args.in[10][(g * 64 + p) * 16 + c], bi = args.in[11][(g * 64 + p) * 16 + c];
                    BBR[(p * 16 + c) * 2] = cr * br - ci * bi; BBR[(p * 16 + c) * 2 + 1] = cr * bi + ci * br; }
            }
            for (int e = tid; e < 1024; e += 512) { const int co = e >> 6, p = e & 63; CC[(co * 65 + p) * 2] = args.in[12][(g * 16 + co) * 64 + p]; CC[(co * 65 + p) * 2 + 1] = args.in[13][(g * 16 + co) * 64 + p]; }
            __syncthreads();
            {
                const int pair = tid >> 1, hh = tid & 1, d = pair >> 4, co = pair & 15; float acc8[8];
#pragma unroll
                for (int j = 0; j < 8; ++j) acc8[j] = 0.f;
                for (int p = 0; p < 64; ++p) { const float cr = CC[(co * 65 + p) * 2], cim = CC[(co * 65 + p) * 2 + 1], lr = LBP[(d * 64 + p) * 2], lim = LBP[(d * 64 + p) * 2 + 1];
                    const float wr_ = cr * lr - cim * lim, wi_ = cr * lim + cim * lr; const LAS f32x4_t* bp = (const LAS f32x4_t*)(BBR + (p * 16 + 8 * hh) * 2);
#pragma unroll
                    for (int q4 = 0; q4 < 4; ++q4) { const f32x4_t bb = bp[q4]; acc8[2 * q4] += wr_ * bb.x - wi_ * bb.y; acc8[2 * q4 + 1] += wr_ * bb.z - wi_ * bb.w; } }
#pragma unroll
                for (int j = 0; j < 8; ++j) KM[(d * 16 + co) * 16 + 8 * hh + j] = acc8[j];
            }
            __syncthreads();
            for (int e = tid; e < 64 * 48; e += 512) {
                const int n = 64 * qt + e / 48, pc = e % 48, s = n >> 4, co = n & 15; float v[8];
                if (pc < 32) { const int s2 = pc >> 1, ci0 = (pc & 1) * 8;
#pragma unroll
                    for (int j = 0; j < 8; ++j) v[j] = (s2 <= s) ? KM[((s - s2) * 16 + co) * 16 + ci0 + j] : 0.f;
                } else { const int j0 = (pc - 32) * 8;
#pragma unroll
                    for (int jj = 0; jj < 4; ++jj) { const int p = (j0 >> 1) + jj; const float cr = CC[(co * 65 + p) * 2], cim = CC[(co * 65 + p) * 2 + 1], lr = LBP[((s + 1) * 64 + p) * 2], lim = LBP[((s + 1) * 64 + p) * 2 + 1];
                        v[2 * jj] = cr * lr - cim * lim; v[2 * jj + 1] = -(cr * lim + cim * lr); } }
                v4u o; o.x = pk2bf(v[0], v[1]); o.y = pk2bf(v[2], v[3]); o.z = pk2bf(v[4], v[5]); o.w = pk2bf(v[6], v[7]);
                *(GAS v4u*)(BtB + ((size_t)g * 256 + n) * 384 + pc * 8) = o; }
            for (int e = tid; e < 64 * 32; e += 512) {
                const int n = 64 * qt + (e >> 5), pc = e & 31; float v[8];
                if (n < 128) { const int p = n >> 1, ri = n & 1, s2 = pc >> 1, ci0 = (pc & 1) * 8; const float lr = LBP[((15 - s2) * 64 + p) * 2], lim = LBP[((15 - s2) * 64 + p) * 2 + 1];
#pragma unroll
                    for (int j = 0; j < 8; ++j) { const float br = BBR[(p * 16 + ci0 + j) * 2], bi = BBR[(p * 16 + ci0 + j) * 2 + 1]; v[j] = ri ? (lr * bi + lim * br) : (lr * br - lim * bi); }
                } else {
#pragma unroll
                    for (int j = 0; j < 8; ++j) v[j] = 0.f; }
                v4u o; o.x = pk2bf(v[0], v[1]); o.y = pk2bf(v[2], v[3]); o.z = pk2bf(v[4], v[5]); o.w = pk2bf(v[6], v[7]);
                *(GAS v4u*)(BtA + ((size_t)g * 256 + n) * 256 + pc * 8) = o; }
        }
        __syncthreads();
        {
            LAS float* scr = (LAS float*)(lds + RING_OFF + wave * 16384);
            constexpr int I_2K = (DM / 64) * (2048 / 32), I_1K = (DM / 64) * (1024 / 32);
            constexpr int NITEMS = 2 * I_2K + 5 * I_1K;
            for (int it = gw; it < NITEMS; it += NGW) {
                int r = it;
                if (r < I_2K) { p0_transpose_item(args.in[6], DM, 2048, Win0, 0, nullptr, scr, r, lane); continue; } r -= I_2K;
                if (r < I_2K) { p0_transpose_item(args.in[21], DM, 2048, Win1, 0, nullptr, scr, r, lane); continue; } r -= I_2K;
                if (r < I_1K) { p0_transpose_item(args.in[15], DM, 1024, Wglu, 0, nullptr, scr, r, lane); continue; } r -= I_1K;
                if (r < I_1K) { p0_transpose_item(args.in[17], DM, 1024, Wout0, 0, nullptr, scr, r, lane); continue; } r -= I_1K;
                if (r < I_1K) { p0_transpose_item(args.in[19], DM, 1024, Wkv, 0, args.in[18], scr, r, lane); continue; } r -= I_1K;
                if (r < I_1K) { p0_transpose_item(args.in[20], DM, 1024, Wkv, 1024, args.in[18], scr, r, lane); continue; } r -= I_1K;
                p0_transpose_item(args.in[27], DM, 1024, Wout1, 0, nullptr, scr, r, lane);
            }
        }
        if (!(args.flags & 1)) {
            __syncthreads();
            LAS float* sc = (LAS float*)(lds + RING_OFF);
            LAS float* red = sc + 8192;
            bool have = false;
            for (int it = vcu; it < 2 * 96; it += G) {
                if (!have) { for (int e = tid; e < 8192; e += 512) sc[e] = silu_f(cvec[e]); have = true; __syncthreads(); }
                const int l = it / 96, cc = it % 96, j = cc * 32 + (lane & 31), kh = lane >> 5;
                float acc[8];
#pragma unroll
                for (int b = 0; b < 8; ++b) acc[b] = 0.f;
                const float* wp = ada_w + ((size_t)l * 1024 + wave * 128 + kh) * 3072 + j;
                for (int k0 = 0; k0 < 64; k0 += 32) {
                    float w[32];
#pragma unroll
                    for (int kk = 0; kk < 32; ++kk) w[kk] = NT_LD(wp + (size_t)(2 * (k0 + kk)) * 3072);
#pragma unroll
                    for (int kk = 0; kk < 32; ++kk) {
#pragma unroll
                        for (int b = 0; b < 8; ++b) acc[b] += w[kk] * sc[b * 1024 + wave * 128 + 2 * (k0 + kk) + kh];
                        if ((kk & 3) == 3) asm volatile("" ::: "memory"); }
                }
#pragma unroll
                for (int b = 0; b < 8; ++b) { acc[b] += __shfl_xor(acc[b], 32); if (lane < 32) red[(wave * 8 + b) * 32 + lane] = acc[b]; }
                __syncthreads();
                if (tid < 256) { const int b = tid >> 5, jl = tid & 31; float sum = ada_b[l * 3072 + cc * 32 + jl];
#pragma unroll
                  for (int w = 0; w < 8; ++w) sum += red[(w * 8 + b) * 32 + jl];
                  mod[((size_t)(l * 8 + b)) * 3072 + cc * 32 + jl] = sum; }
                __syncthreads();
            }
            if (bx == 0 && tid == 0) lamp[0] = diff_lambda(args.in[22], args.in[23], args.in[24], args.in[25]);
        }
    }
    SEAM(0);
    if (IN(1)) for (int rep_ = 0; rep_ < REPS(1); ++rep_) e_norm0_b(x, mod, g_pre, A0, gw, NGW, LANE_L());
    SEAM(1);
#ifdef EXTRA_BARS
    if (args.use_bar) for (int eb = 0; eb < EXTRA_BARS; ++eb) xcd_barrier(bar, TID_NOW());
#endif
    if (IN(2)) for (int rep_ = 0; rep_ < REPS(2); ++rep_) {
        pg8::Gemm g = pg8::gemm_std(A0, DM, Win0, DM, DM); pg8::Order S; S.init(MTOK / 256, 2048 / 256, 1, G, bx);
        pg8::EpiRow8<pg8::F_In0> E{{US, SZ}};
        pg8::gemm_phase<pg8::EpiRow8<pg8::F_In0>, ALIGN_E>(lds + RING_OFF, g, S, E, TID_NOW());
    }
    SEAM(2);
#if SSM_FUSED
    if (IN(3)) {
        pg8::Gemm gA = pg8::gemm_std(US, US_P, BtA, 256, 256); gA.a_gstep = (size_t)NTILE * US_P * 2; gA.b_gstep = (size_t)256 * 256 * 2;
        pg8::Gemm gB = pg8::gemm_std(US, US_P, BtB, 384, 384); gB.a_gstep = (size_t)NTILE * US_P * 2; gB.b_gstep = (size_t)256 * 384 * 2;
        pg8::EpiScan ES{lb16, US, LDSCTL_OFF + 2048};
        pg8::EpiRow8<pg8::F_SsmB> EB2{{US, args.in[14], YG}};
        for (int uu = 0; (long)uu * G + bx < NGRP * NB; ++uu) {
            pg8::Order S; S.init(NTILE / 256, 1, NGRP, G, bx); S.only = uu;
            pg8::gemm_phase<pg8::EpiScan, false>(lds + RING_OFF, gA, S, ES, TID_NOW());
            pg8::gemm_phase<pg8::EpiRow8<pg8::F_SsmB>, false>(lds + RING_OFF, gB, S, EB2, TID_NOW());
        }
    }
    SEAM(5);
#else
    if (IN(3)) for (int rep_ = 0; rep_ < REPS(3); ++rep_) {
        pg8::Gemm g = pg8::gemm_std(US, US_P, BtA, 256, 256); g.a_gstep = (size_t)NTILE * US_P * 2; g.b_gstep = (size_t)256 * 256 * 2;
        pg8::Order S; S.init(NTILE / 256, 1, NGRP, G, bx);
        pg8::EpiRow8<pg8::F_SsmA> E{{EB}};
        pg8::gemm_phase<pg8::EpiRow8<pg8::F_SsmA>, ALIGN_E>(lds + RING_OFF, g, S, E, TID_NOW());
    }
    SEAM(3);
    if (IN(4)) for (int rep_ = 0; rep_ < REPS(4); ++rep_) {
        for (int it = vcu + G * wave; it < NB * NGRP; it += G * NWAVES) {
            const int b = it / NGRP, g = it % NGRP, p = LANE_L();
            const float lr = lb16[(g * 64 + p) * 2], li = lb16[(g * 64 + p) * 2 + 1];
            float sr = 0.f, si = 0.f;
            const float* ep = EB + ((size_t)g * NTILE + b * 256) * 128 + 2 * p;
            bf16_t* sp = US + us_off(g, b * 256, 256 + 2 * p);
            for (int t0 = 0; t0 < 256; t0 += 16) {
                float er[16], ei[16];
#pragma unroll
                for (int j = 0; j < 16; ++j) { const float2 e = *(const float2*)(ep + (size_t)(t0 + j) * 128); er[j] = e.x; ei[j] = e.y; }
#pragma unroll
                for (int j = 0; j < 16; ++j) { *(unsigned*)(sp + (size_t)(t0 + j) * US_P) = pk2bf(sr, si);
                    const float nr = lr * sr - li * si + er[j], ni = lr * si + li * sr + ei[j]; sr = nr; si = ni; }
            }
        }
    }
    SEAM(4);
    if (IN(5)) for (int rep_ = 0; rep_ < REPS(5); ++rep_) {
        pg8::Gemm g = pg8::gemm_std(US, US_P, BtB, 384, 384); g.a_gstep = (size_t)NTILE * US_P * 2; g.b_gstep = (size_t)256 * 384 * 2;
        pg8::Order S; S.init(NTILE / 256, 1, NGRP, G, bx);
        pg8::EpiRow8<pg8::F_SsmB> E{{US, args.in[14], YG}};
        pg8::gemm_phase<pg8::EpiRow8<pg8::F_SsmB>, ALIGN_E>(lds + RING_OFF, g, S, E, TID_NOW());
    }
    SEAM(5);
#endif
    if (IN(6)) for (int rep_ = 0; rep_ < REPS(6); ++rep_) {
        pg8::Gemm g = pg8::gemm_std(YG, DM, Wglu, DM, DM);
        g.a_rs = 32u; g.a_c16 = (unsigned)((size_t)NTILE * YG_P * 2); g.a_kstep = (size_t)4 * NTILE * YG_P * 2; g.a_tstep = (size_t)256 * 32;
        pg8::Order S; S.init(MTOK / 256, 1024 / 256, 1, G, bx);
        pg8::EpiRow8<pg8::F_Glu> E{{YG, SZ, args.in[16], Y2}};
        pg8::gemm_phase<pg8::EpiRow8<pg8::F_Glu>, ALIGN_E>(lds + RING_OFF, g, S, E, TID_NOW());
    }
    SEAM(6);
#if FUSE_EPI
    if (IN(7)) {
        pg8::Gemm g = pg8::gemm_std(Y2, DM, Wout0, DM, DM);
        for (int half = 0; half < 2; ++half) {
            pg8::Order S; S.init(MTOK / 512, 1024 / 256, 1, G, bx); S.pm_off = half * (MTOK / 512);
            pg8::PanelRms st1{(unsigned*)(ws + WS_XCH), (unsigned*)(ctl + CW_SEAM), (unsigned*)(ctl + CW_TMO), RMS_EPS};
            pg8::PanelRms st2{(unsigned*)(ws + WS_XCH + 1 * MiB), (unsigned*)(ctl + CW_SEAM + SEAM_BANK), (unsigned*)(ctl + CW_TMO), RMS_EPS};
            pg8::EpiMid E{x, out, AKV, AIN1, mod, g_post, g_pre + 1024, st1, st2};
            pg8::gemm_phase<pg8::EpiMid, false>(lds + RING_OFF, g, S, E, TID_NOW());
        }
    }
#else
    if (IN(7)) {
        pg8::Gemm g = pg8::gemm_std(Y2, DM, Wout0, DM, DM); pg8::Order S; S.init(MTOK / 256, 1024 / 256, 1, G, bx);
        pg8::EpiRow8<pg8::F_Plain> E{{YO}};
        pg8::gemm_phase<pg8::EpiRow8<pg8::F_Plain>, ALIGN_E>(lds + RING_OFF, g, S, E, TID_NOW());
    }
    SEAM(7);
    if (IN(8)) { if (H1_BF16) e_mid(x, YO, mod, g_post, g_pre, (float*)nullptr, YO, AKV, AIN1, gw, NGW, LANE_L()); else e_mid_b(x, YO, mod, g_post, g_pre, H1_RECOMP ? (float*)nullptr : out, AKV, AIN1, gw, NGW, LANE_L()); }
#endif
    SEAM(8);
    if (IN(9)) for (int rep_ = 0; rep_ < REPS(9); ++rep_) {
        pg8::Gemm g = pg8::gemm_std(AKV, DM, Wkv, DM, DM); g.a_gstep = (size_t)(WS_S2 - WS_S0); g.b_gstep = (size_t)(WS_WIN1 - WS_WKV);
        pg8::Order S; S.init(MTOK / 256, 2048 / 256, 2, G, bx); S.mode2 = (G == 256);
        pg8::EpiRow8<pg8::F_Split2> E{{{KB, QB}, {VB, SZ1}}};
        pg8::gemm_phase<pg8::EpiRow8<pg8::F_Split2>, ALIGN_E>(lds + RING_OFF, g, S, E, TID_NOW());
    }
    SEAM(9);
    if (IN(10)) {
#if ATTN_V128
#if ATTN_FUSE_POST
        { const float lam = __int_as_float(__builtin_amdgcn_readfirstlane(__float_as_int(lamp[0])));
          attn_body::bf16x8 qr[4]; bool primed = false;
#if ATTN_PRIO
          if (wave >= 4) __builtin_amdgcn_s_setprio(1);
#endif
          const int nun = (64 * 16 - vcu + G - 1) / G;
#pragma unroll 1
          for (int su = 0; su < 2 * nun; ++su) {
            const int i = su >> 1, cc = su & 1;
            const long L = (long)i * G + vcu; const int pr = (int)(L % 256), qi = (int)(L / 256);
            const int bh = pr >> 2, j = pr & 3; const int qb = (qi & 1) ? (8 * (qi >> 1) + 7 - j) : (8 * (qi >> 1) + j); const int h = bh & 7, b = bh >> 3;
            const bool has_next = su + 1 < 2 * nun;
            const int i2 = (su + 1) >> 1, cc2 = (su + 1) & 1;
            const long L2 = (long)i2 * G + vcu; const int pr2 = (int)(L2 % 256), qi2 = (int)(L2 / 256);
            const int bh2 = pr2 >> 2, j2 = pr2 & 3; const int qb2 = (qi2 & 1) ? (8 * (qi2 >> 1) + 7 - j2) : (8 * (qi2 >> 1) + j2); const int h2 = bh2 & 7, b2 = bh2 >> 3;
            attn3::attn_unit<8>(TID_NOW(), b, 2 * h + cc, h, qb, QB, KB, VB, O0, (char*)lds_raw + RING_OFF, cc, SZ1, args.in[26], lam, OG, primed, has_next, b2, 2 * h2 + cc2, h2, qb2, qr);
            primed = true;
          }
#if ATTN_PRIO
          __builtin_amdgcn_s_setprio(0);
#endif
          }
#else
        for (int i = 0;; ++i) {
            const long L = (long)i * G + vcu; if (L >= 128 * 16) break;
            const int pr = (int)(L % 256), qi = (int)(L / 256);
            const int combo = pr >> 1, j = pr & 1;
            const int k4 = qi >> 1; const int qb = (qi & 1) ? (4 * k4 + 3 - j) : (4 * k4 + j);
            const int c = combo & 1, h = (combo >> 1) & 7, b = combo >> 4;
            { attn_body::bf16x8 qr_[4]; attn3::attn_unit<8>(TID_NOW(), b, 2 * h + c, h, qb, QB, KB, VB, c ? O1 : O0, (char*)lds_raw + RING_OFF, 0, SZ1, args.in[26], 0.f, OG, false, false, 0, 0, 0, 0, qr_); asm volatile("s_barrier" ::: "memory"); }
        }
#endif
#else
        for (int i = 0;; ++i) {
            const long L = (long)i * G + vcu; if (L >= 256 * 16) break;
            const int combo = (int)(L % 256), qi = (int)(L / 256);
            const int qb = (qi & 1) ? (qi >> 1) : (15 - (qi >> 1));
            const int vh = combo & 1, c = (combo >> 1) & 1, h = (combo >> 2) & 7, b = combo >> 5;
            attn_body::attn_unit<8>(TID_NOW(), b, 2 * h + c, 2 * h + vh, qb, QB, KB, VB, c ? O1 : O0, (char*)lds_raw + RING_OFF);
        }
#endif
    }
    SEAM(10);
#if !(ATTN_V128 && ATTN_FUSE_POST)
    if (IN(11)) for (int rep_ = 0; rep_ < REPS(11); ++rep_) e_attn_post(O0, O1, SZ1, args.in[26], lamp[0], OG, gw, NGW, LANE_L());
    SEAM(11);
#endif
#if FUSE_EPI
    if (IN(12)) {
        pg8::Gemm g = pg8::gemm_std(OG, DM, Wout1, DM, DM);
        for (int half = 0; half < 2; ++half) {
            pg8::Order S; S.init(MTOK / 512, 1024 / 256, 1, G, bx); S.pm_off = half * (MTOK / 512);
            pg8::PanelRms st{(unsigned*)(ws + WS_XCH + 2 * MiB), (unsigned*)(ctl + CW_SEAM + 2 * SEAM_BANK), (unsigned*)(ctl + CW_TMO), RMS_EPS};
            pg8::EpiFinal E{out, out, mod + 8 * 3072, g_post + 1024, st};
            pg8::gemm_phase<pg8::EpiFinal, false>(lds + RING_OFF, g, S, E, TID_NOW());
        }
    }
#else
    if (IN(12)) {
        pg8::Gemm g = pg8::gemm_std(OG, DM, Wout1, DM, DM); pg8::Order S; S.init(MTOK / 256, 1024 / 256, 1, G, bx);
        pg8::EpiRow8<pg8::F_Plain> E{{YO1}};
        pg8::gemm_phase<pg8::EpiRow8<pg8::F_Plain>, ALIGN_E>(lds + RING_OFF, g, S, E, TID_NOW());
    }
    SEAM(12);
    if (IN(13)) { if (H1_BF16) e_final_b(YO, out, YO1, mod, g_post, gw, NGW, LANE_L()); else if (H1_RECOMP) e_final_x(x, YO, YO1, out, mod, g_post, gw, NGW, LANE_L()); else e_final_bm(out, YO1, mod, g_post, gw, NGW, LANE_L()); }
#endif
#undef IN
#undef SEAM
}

#ifndef FASTMASK
#define FASTMASK 0x3fff
#endif
#ifndef ONE_LAUNCH
#define ONE_LAUNCH 1
#endif
constexpr int NPHASE = 14;

extern "C" void kernel_launch(void* const* d_in, const int* in_sizes, int n_in, void* d_out, int out_size, void* d_ws, size_t ws_size, hipStream_t stream) {
    static int grid = 0;
    if (grid == 0) {
        if (n_in != 28 || out_size != MTOK * DM || ws_size < WS_END) { fprintf(stderr, "kernel_launch: unexpected shapes (n_in %d out %d ws %zu)\n", n_in, out_size, ws_size); grid = -1; return; }
        int dev = 0, cus = 0, per_cu = 0;
        if (hipGetDevice(&dev) != hipSuccess || hipDeviceGetAttribute(&cus, hipDeviceAttributeMultiprocessorCount, dev) != hipSuccess) { grid = -1; return; }
        if (hipFuncSetAttribute((const void*)mega_fwd, hipFuncAttributeMaxDynamicSharedMemorySize, LDS_BYTES) != hipSuccess) { fprintf(stderr, "kernel_launch: hipFuncSetAttribute failed\n"); grid = -1; return; }
        if (hipOccupancyMaxActiveBlocksPerMultiprocessor(&per_cu, (const void*)mega_fwd, NWAVES * 64, LDS_BYTES) != hipSuccess || per_cu < 1) { fprintf(stderr, "kernel_launch: occupancy query says %d\n", per_cu); }
        (void)hipGetLastError();
        grid = cus;
    }
    if (grid < 0) return;
    if (hipMemsetAsync((char*)d_ws + WS_CTL + (size_t)CW_BAR * 4, 0, (size_t)XCD_BAR_WORDS * 4, stream) != hipSuccess) { fprintf(stderr, "kernel_launch: memset failed\n"); return; }
    Args a{};
    for (int i = 0; i < 28; ++i) a.in[i] = (const float*)d_in[i];
    a.out = (float*)d_out; a.ws = (unsigned char*)d_ws;
#if ONE_LAUNCH
    a.ph_lo = 0; a.ph_hi = NPHASE; a.use_bar = 1; a.flags = 0;
    hipLaunchKernelGGL(mega_fwd, dim3(grid), dim3(NWAVES * 64), LDS_BYTES, stream, a);
#else
    const float* x = a.in[0]; unsigned char* ws = a.ws; float* out = a.out;
    float* mod = (float*)(ws + WS_MOD); float* lam = (float*)(ws + WS_LAM);
    bf16_t* A0 = (bf16_t*)(ws + WS_S0); bf16_t* US = (bf16_t*)(ws + WS_S1); bf16_t* SZ = (bf16_t*)(ws + WS_S3); bf16_t* YG = (bf16_t*)(ws + WS_S4);
    bf16_t* Y2 = (bf16_t*)(ws + WS_S0); bf16_t* YO = (bf16_t*)(ws + WS_S1); bf16_t* AKV = (bf16_t*)(ws + WS_S0); bf16_t* AIN1 = (bf16_t*)(ws + WS_S2);
    bf16_t* KB = (bf16_t*)(ws + WS_S3); bf16_t* VB = (bf16_t*)(ws + WS_S4); bf16_t* QB = (bf16_t*)(ws + WS_S5); bf16_t* SZ1 = (bf16_t*)(ws + WS_S6);
    bf16_t* O0 = (bf16_t*)(ws + WS_S0); bf16_t* O1 = (bf16_t*)(ws + WS_S1); bf16_t* OG = (bf16_t*)(ws + WS_S2); bf16_t* YO1 = (bf16_t*)(ws + WS_S0);
    const int EG = 2048;
    auto fast1 = [&](int lo, int hi, int flags) { a.ph_lo = lo; a.ph_hi = hi; a.use_bar = 0; a.flags = flags; hipLaunchKernelGGL(mega_fwd, dim3(grid), dim3(NWAVES * 64), LDS_BYTES, stream, a); };
    auto fast = [&](int lo, int hi, int flags) { fast1(lo, hi, flags); if (lo == EXTRA_PHASE) fast1(lo, hi, flags); };
    const unsigned FM = FASTMASK;
    if (FM & 1u) fast(0, 1, 0);
    else { fast(0, 1, 1); n_adaln<<<(2 * 8 * 3072 + 255) / 256, 256, 0, stream>>>(a.in[1], a.in[2], a.in[3], mod); n_lambda<<<1, 64, 0, stream>>>(a.in[22], a.in[23], a.in[24], a.in[25], lam); }
    if (FM & 2u) fast(1, 2, 0); else n_norm0<<<EG, 256, 0, stream>>>(x, mod, a.in[4], A0);
    if (FM & 4u) fast(2, 3, 0); else n_gemm<<<dim3(2048 / 64, MTOK / 64), 256, 0, stream>>>(AL_Row{A0}, WL_Plain{a.in[6], 2048}, EP_In0{US, SZ}, 2048);
    if (FM & 8u) { fast(3, 4, 0); fast(4, 5, 0); fast(5, 6, 0); }
    else n_ssm<<<NB * NGRP / 4, 256, 0, stream>>>(US, a.in[7], a.in[8], a.in[9], a.in[10], a.in[11], a.in[12], a.in[13], a.in[14], YG);
    if (FM & 64u) fast(6, 7, 0); else n_gemm<<<dim3(1024 / 64, MTOK / 64), 256, 0, stream>>>(AL_YG{YG}, WL_Plain{a.in[15], 1024}, EP_Glu{YG, SZ, a.in[16], Y2}, 1024);
    if (FM & 128u) fast(7, 8, 0); else n_gemm<<<dim3(1024 / 64, MTOK / 64), 256, 0, stream>>>(AL_Row{Y2}, WL_Plain{a.in[17], 1024}, EP_Plain{YO}, 1024);
    if (FM & 256u) fast(8, 9, 0); else n_mid<<<EG, 256, 0, stream>>>(x, YO, mod, a.in[5], a.in[4], out, AKV, AIN1);
    if (FM & 512u) fast(9, 10, 0);
    else { n_gemm<<<dim3(2048 / 64, MTOK / 64), 256, 0, stream>>>(AL_Row{AKV}, WL_KV{a.in[19], a.in[20], a.in[18]}, EP_KV{KB, VB}, 2048);
           n_gemm<<<dim3(2048 / 64, MTOK / 64), 256, 0, stream>>>(AL_Row{AIN1}, WL_Plain{a.in[21], 2048}, EP_In1{QB, SZ1}, 2048); }
    if (FM & 1024u) fast(10, 11, 0); else n_attn<<<MTOK * 8 / 4, 256, 0, stream>>>(QB, KB, VB, O0, O1);
    if (FM & 2048u) fast(11, 12, 0); else n_attn_post<<<EG, 256, 0, stream>>>(O0, O1, SZ1, a.in[26], lam, OG);
    if (FM & 4096u) fast(12, 13, 0); else n_gemm<<<dim3(1024 / 64, MTOK / 64), 256, 0, stream>>>(AL_Row{OG}, WL_Plain{a.in[27], 1024}, EP_Plain{YO1}, 1024);
    if (FM & 8192u) fast(13, 14, 0); else n_final<<<EG, 256, 0, stream>>>(out, YO1, mod, a.in[5]);
#endif
    const hipError_t le = hipPeekAtLastError();
    if (le != hipSuccess) fprintf(stderr, "kernel_launch: launch failed: %s\n", hipGetErrorName(le));
}
```

```cpp
#include <hip/hip_runtime.h>
#include <cstdio>
#include <cstdint>
#include <cmath>
#define FASTMASK 0x3fff
#define ONE_LAUNCH 1
#define REPEAT_MASK 0

typedef unsigned short bf16_t;
constexpr int NB = 8, SEQL = 4096, DM = 1024, MTOK = NB * SEQL;
constexpr int NGRP = 64, NTILE = MTOK / 16;
constexpr int US_P = 384, YG_P = 256;
constexpr float LAMBDA_INIT = 0.35550907f;
constexpr float ONE_M_LI = 1.0f - LAMBDA_INIT;
constexpr float RMS_EPS = 1e-6f;
constexpr float QC2 = 0.125f * 1.4426950408889634f;

__device__ __forceinline__ float bf2f(bf16_t v) { return __uint_as_float((unsigned)v << 16); }
__device__ __forceinline__ unsigned f2bf_u(float f) { unsigned u = __float_as_uint(f); return (u + 0x7fffu + ((u >> 16) & 1u)) >> 16; }
__device__ __forceinline__ bf16_t f2bf(float f) { return (bf16_t)f2bf_u(f); }
__device__ __forceinline__ unsigned pk2bf(float lo, float hi) { return f2bf_u(lo) | (f2bf_u(hi) << 16); }
__device__ __forceinline__ float silu_f(float v) { return v / (1.0f + __expf(-v)); }
__device__ __forceinline__ float sigmoid_f(float v) { return 1.0f / (1.0f + __expf(-v)); }
__device__ __forceinline__ float gelu_tanh_f(float v) {
    const float u = 0.7978845608028654f * (v + 0.044715f * v * v * v);
    const float e = __expf(2.0f * u);
    const float t = 1.0f - 2.0f / (e + 1.0f);
    return 0.5f * v * (1.0f + t);
}
__device__ __forceinline__ float wave_sum_f(float v) {
#pragma unroll
    for (int o = 1; o < 64; o <<= 1) v += __shfl_xor(v, o);
    return v;
}
__device__ __forceinline__ float wave_max_f(float v) {
#pragma unroll
    for (int o = 1; o < 64; o <<= 1) v = fmaxf(v, __shfl_xor(v, o));
    return v;
}
__device__ __forceinline__ size_t us_off(int g, int tile, int col) { return ((size_t)g * NTILE + tile) * US_P + col; }
__device__ __forceinline__ size_t yg_off(int g, int tile, int col) { return ((size_t)g * NTILE + tile) * YG_P + col; }

typedef float f32x4_t __attribute__((ext_vector_type(4)));
typedef unsigned u32x4_t __attribute__((ext_vector_type(4)));
typedef unsigned u32x2_t __attribute__((ext_vector_type(2)));
#ifndef USE_NT
#define USE_NT 1
#endif
#if USE_NT
#define NT_LD(p) __builtin_nontemporal_load(p)
#define NT_ST(p, v) __builtin_nontemporal_store((v), (p))
#else
#define NT_LD(p) (*(p))
#define NT_ST(p, v) (*(p) = (v))
#endif

__device__ __forceinline__ void e_norm0(const float* __restrict__ x, const float* __restrict__ mod, const float* __restrict__ g_pre, bf16_t* a0, int gw, int ngw, int lane) {
    for (int m = gw; m < MTOK; m += ngw) {
        const int b = m / SEQL;
        const f32x4_t* xr = (const f32x4_t*)(x + (size_t)m * DM) + lane;
        f32x4_t v[4]; float s = 0.f;
#pragma unroll
        for (int j = 0; j < 4; ++j) { v[j] = NT_LD(xr + 64 * j); s += (v[j].x * v[j].x + v[j].y * v[j].y) + (v[j].z * v[j].z + v[j].w * v[j].w); }
        const float r = rsqrtf(wave_sum_f(s) * (1.0f / DM) + RMS_EPS);
        const float* sh = mod + (size_t)b * 3072; const float* sc = sh + 1024;
        u32x2_t* o = (u32x2_t*)(a0 + (size_t)m * DM) + lane;
#pragma unroll
        for (int j = 0; j < 4; ++j) {
            const int c = 256 * j + 4 * lane;
            const f32x4_t g = *(const f32x4_t*)(g_pre + c), scv = *(const f32x4_t*)(sc + c), shv = *(const f32x4_t*)(sh + c);
            f32x4_t y = v[j] * r * g * (scv + 1.0f) + shv;
            u32x2_t w; w.x = pk2bf(y.x, y.y); w.y = pk2bf(y.z, y.w); o[64 * j] = w;
        }
    }
}
__device__ __forceinline__ void e_mid(const float* __restrict__ x, const bf16_t* __restrict__ yo, const float* __restrict__ mod, const float* __restrict__ g_post, const float* __restrict__ g_pre,
                                      float* h1, bf16_t* h1b, bf16_t* akv, bf16_t* ain1, int gw, int ngw, int lane) {
    for (int m = gw; m < MTOK; m += ngw) {
        const int b = m / SEQL;
        const f32x4_t* xr = (const f32x4_t*)(x + (size_t)m * DM) + lane;
        const u32x2_t* yr = (const u32x2_t*)(yo + (size_t)m * DM) + lane;
        f32x4_t v[4], y[4]; float s = 0.f;
#pragma unroll
        for (int j = 0; j < 4; ++j) { v[j] = NT_LD(xr + 64 * j); const u32x2_t w = NT_LD(yr + 64 * j);
            y[j].x = __uint_as_float(w.x << 16); y[j].y = __uint_as_float(w.x & 0xffff0000u); y[j].z = __uint_as_float(w.y << 16); y[j].w = __uint_as_float(w.y & 0xffff0000u);
            s += (y[j].x * y[j].x + y[j].y * y[j].y) + (y[j].z * y[j].z + y[j].w * y[j].w); }
        const float ry = rsqrtf(wave_sum_f(s) * (1.0f / DM) + RMS_EPS);
        const float* gate0 = mod + (size_t)b * 3072 + 2048;
        const float* sh1 = mod + (size_t)(8 + b) * 3072; const float* sc1 = sh1 + 1024;
        float s2 = 0.f;
        f32x4_t* ho = (f32x4_t*)(h1 + (size_t)m * DM) + lane;
#pragma unroll
        for (int j = 0; j < 4; ++j) { const int c = 256 * j + 4 * lane;
            const f32x4_t gp = *(const f32x4_t*)(g_post + c), gt = *(const f32x4_t*)(gate0 + c);
            v[j] = v[j] + gt * (y[j] * ry * gp);
            if (h1) NT_ST(ho + 64 * j, v[j]);
            if (h1b) { u32x2_t wq; wq.x = pk2bf(v[j].x, v[j].y); wq.y = pk2bf(v[j].z, v[j].w); ((u32x2_t*)(h1b + (size_t)m * DM) + lane)[64 * j] = wq; }
            s2 += (v[j].x * v[j].x + v[j].y * v[j].y) + (v[j].z * v[j].z + v[j].w * v[j].w); }
        const float rh = rsqrtf(wave_sum_f(s2) * (1.0f / DM) + RMS_EPS);
        u32x2_t* o1 = (u32x2_t*)(akv + (size_t)m * DM) + lane; u32x2_t* o2 = (u32x2_t*)(ain1 + (size_t)m * DM) + lane;
#pragma unroll
        for (int j = 0; j < 4; ++j) { const int c = 256 * j + 4 * lane;
            const f32x4_t n = v[j] * rh;
            u32x2_t w; w.x = pk2bf(n.x, n.y); w.y = pk2bf(n.z, n.w); o1[64 * j] = w;
            const f32x4_t g = *(const f32x4_t*)(g_pre + 1024 + c), scv = *(const f32x4_t*)(sc1 + c), shv = *(const f32x4_t*)(sh1 + c);
            const f32x4_t z = n * g * (scv + 1.0f) + shv;
            w.x = pk2bf(z.x, z.y); w.y = pk2bf(z.z, z.w); o2[64 * j] = w; }
    }
}
__device__ __forceinline__ void e_attn_post(const bf16_t* __restrict__ o0, const bf16_t* __restrict__ o1, const bf16_t* __restrict__ sz1, const float* __restrict__ g_sub, float lam,
                                            bf16_t* og, int gw, int ngw, int lane) {
    for (int m = gw; m < MTOK; m += ngw) {
#pragma unroll
        for (int j = 0; j < 2; ++j) {
            const int c = 512 * j + 8 * lane;
            const u32x4_t a = *(const u32x4_t*)(o0 + (size_t)m * DM + c), bq = *(const u32x4_t*)(o1 + (size_t)m * DM + c), zq = *(const u32x4_t*)(sz1 + (size_t)m * DM + c);
            float d[8]; float s = 0.f;
#pragma unroll
            for (int i = 0; i < 4; ++i) { const unsigned wa = a[i], wb = bq[i];
                d[2 * i] = __uint_as_float(wa << 16) - lam * __uint_as_float(wb << 16); d[2 * i + 1] = __uint_as_float(wa & 0xffff0000u) - lam * __uint_as_float(wb & 0xffff0000u);
                s += d[2 * i] * d[2 * i] + d[2 * i + 1] * d[2 * i + 1]; }
            s += __shfl_xor(s, 1); s += __shfl_xor(s, 2); s += __shfl_xor(s, 4); s += __shfl_xor(s, 8);
            const float r = rsqrtf(s * (1.0f / 128.0f) + RMS_EPS) * ONE_M_LI;
            const float* gs = g_sub + (c & 127);
            u32x4_t w;
#pragma unroll
            for (int i = 0; i < 4; ++i) { const unsigned wz = zq[i];
                const float z0 = __uint_as_float(wz << 16), z1 = __uint_as_float(wz & 0xffff0000u);
                w[i] = pk2bf(d[2 * i] * r * gs[2 * i] * z0, d[2 * i + 1] * r * gs[2 * i + 1] * z1); }
            *(u32x4_t*)(og + (size_t)m * DM + c) = w;
        }
    }
}
__device__ __forceinline__ void e_final(float* out, const bf16_t* __restrict__ yo1, const float* __restrict__ mod, const float* __restrict__ g_post, int gw, int ngw, int lane) {
    for (int m = gw; m < MTOK; m += ngw) {
        const int b = m / SEQL;
        f32x4_t* hr = (f32x4_t*)(out + (size_t)m * DM) + lane;
        const u32x2_t* yr = (const u32x2_t*)(yo1 + (size_t)m * DM) + lane;
        f32x4_t v[4], y[4]; float s = 0.f;
#pragma unroll
        for (int j = 0; j < 4; ++j) { v[j] = NT_LD(hr + 64 * j); const u32x2_t w = NT_LD(yr + 64 * j);
            y[j].x = __uint_as_float(w.x << 16); y[j].y = __uint_as_float(w.x & 0xffff0000u); y[j].z = __uint_as_float(w.y << 16); y[j].w = __uint_as_float(w.y & 0xffff0000u);
            s += (y[j].x * y[j].x + y[j].y * y[j].y) + (y[j].z * y[j].z + y[j].w * y[j].w); }
        const float ry = rsqrtf(wave_sum_f(s) * (1.0f / DM) + RMS_EPS);
        const float* gate1 = mod + (size_t)(8 + b) * 3072 + 2048;
#pragma unroll
        for (int j = 0; j < 4; ++j) { const int c = 256 * j + 4 * lane;
            const f32x4_t gp = *(const f32x4_t*)(g_post + 1024 + c), gt = *(const f32x4_t*)(gate1 + c);
            NT_ST(hr + 64 * j, v[j] + gt * (y[j] * ry * gp)); }
    }
}
__device__ __forceinline__ void e_final2(const float* __restrict__ x, const bf16_t* __restrict__ yo, const bf16_t* __restrict__ yo1, float* out, const float* __restrict__ mod, const float* __restrict__ g_post, int gw, int ngw, int lane) {
    for (int m = gw; m < MTOK; m += ngw) {
        const int b = m / SEQL;
        const f32x4_t* xr = (const f32x4_t*)(x + (size_t)m * DM) + lane;
        const u32x2_t* y0r = (const u32x2_t*)(yo + (size_t)m * DM) + lane; const u32x2_t* y1r = (const u32x2_t*)(yo1 + (size_t)m * DM) + lane;
        f32x4_t v[4], y0[4], y1[4]; float s0 = 0.f, s1 = 0.f;
#pragma unroll
        for (int j = 0; j < 4; ++j) { v[j] = xr[64 * j]; const u32x2_t w0 = y0r[64 * j], w1 = y1r[64 * j];
            y0[j].x = __uint_as_float(w0.x << 16); y0[j].y = __uint_as_float(w0.x & 0xffff0000u); y0[j].z = __uint_as_float(w0.y << 16); y0[j].w = __uint_as_float(w0.y & 0xffff0000u);
            y1[j].x = __uint_as_float(w1.x << 16); y1[j].y = __uint_as_float(w1.x & 0xffff0000u); y1[j].z = __uint_as_float(w1.y << 16); y1[j].w = __uint_as_float(w1.y & 0xffff0000u);
            s0 += (y0[j].x * y0[j].x + y0[j].y * y0[j].y) + (y0[j].z * y0[j].z + y0[j].w * y0[j].w);
            s1 += (y1[j].x * y1[j].x + y1[j].y * y1[j].y) + (y1[j].z * y1[j].z + y1[j].w * y1[j].w); }
        const float r0 = rsqrtf(wave_sum_f(s0) * (1.0f / DM) + RMS_EPS), r1 = rsqrtf(wave_sum_f(s1) * (1.0f / DM) + RMS_EPS);
        const float* gate0 = mod + (size_t)b * 3072 + 2048; const float* gate1 = mod + (size_t)(8 + b) * 3072 + 2048;
        f32x4_t* orow = (f32x4_t*)(out + (size_t)m * DM) + lane;
#pragma unroll
        for (int j = 0; j < 4; ++j) { const int c = 256 * j + 4 * lane;
            const f32x4_t gp0 = *(const f32x4_t*)(g_post + c), gt0 = *(const f32x4_t*)(gate0 + c), gp1 = *(const f32x4_t*)(g_post + 1024 + c), gt1 = *(const f32x4_t*)(gate1 + c);
            const f32x4_t h = v[j] + gt0 * (y0[j] * r0 * gp0);
            orow[64 * j] = h + gt1 * (y1[j] * r1 * gp1); }
    }
}
__device__ __forceinline__ void e_final_b(const bf16_t* __restrict__ h1b, float* out, const bf16_t* __restrict__ yo1, const float* __restrict__ mod, const float* __restrict__ g_post, int gw, int ngw, int lane) {
    for (int m = gw; m < MTOK; m += ngw) {
        const int b = m / SEQL;
        const u32x2_t* hr = (const u32x2_t*)(h1b + (size_t)m * DM) + lane;
        const u32x2_t* yr = (const u32x2_t*)(yo1 + (size_t)m * DM) + lane;
        f32x4_t v[4], y[4]; float s = 0.f;
#pragma unroll
        for (int j = 0; j < 4; ++j) { const u32x2_t hw = NT_LD(hr + 64 * j); const u32x2_t w = NT_LD(yr + 64 * j);
            v[j].x = __uint_as_float(hw.x << 16); v[j].y = __uint_as_float(hw.x & 0xffff0000u); v[j].z = __uint_as_float(hw.y << 16); v[j].w = __uint_as_float(hw.y & 0xffff0000u);
            y[j].x = __uint_as_float(w.x << 16); y[j].y = __uint_as_float(w.x & 0xffff0000u); y[j].z = __uint_as_float(w.y << 16); y[j].w = __uint_as_float(w.y & 0xffff0000u);
            s += (y[j].x * y[j].x + y[j].y * y[j].y) + (y[j].z * y[j].z + y[j].w * y[j].w); }
        const float ry = rsqrtf(wave_sum_f(s) * (1.0f / DM) + RMS_EPS);
        const float* gate1 = mod + (size_t)(8 + b) * 3072 + 2048;
        f32x4_t* orow = (f32x4_t*)(out + (size_t)m * DM) + lane;
#pragma unroll
        for (int j = 0; j < 4; ++j) { const int c = 256 * j + 4 * lane;
            const f32x4_t gp = *(const f32x4_t*)(g_post + 1024 + c), gt = *(const f32x4_t*)(gate1 + c);
            NT_ST(orow + 64 * j, v[j] + gt * (y[j] * ry * gp)); }
    }
}

#define ER 2
__device__ __forceinline__ void unpk4(const u32x2_t w, f32x4_t& y) { y.x = __uint_as_float(w.x << 16); y.y = __uint_as_float(w.x & 0xffff0000u); y.z = __uint_as_float(w.y << 16); y.w = __uint_as_float(w.y & 0xffff0000u); }
__device__ __forceinline__ float ssq4(const f32x4_t v) { return (v.x * v.x + v.y * v.y) + (v.z * v.z + v.w * v.w); }
__device__ __forceinline__ void e_norm0_r(const float* __restrict__ x, const float* __restrict__ mod, const float* __restrict__ g_pre, bf16_t* a0, int gw, int ngw, int lane) {
    for (int m0 = gw; m0 < MTOK; m0 += ER * ngw) {
        f32x4_t v[ER][4]; float s[ER];
#pragma unroll
        for (int r = 0; r < ER; ++r) { const int m = min(m0 + r * ngw, MTOK - 1); const f32x4_t* xr = (const f32x4_t*)(x + (size_t)m * DM) + lane;
#pragma unroll
            for (int j = 0; j < 4; ++j) v[r][j] = NT_LD(xr + 64 * j); }
#pragma unroll
        for (int r = 0; r < ER; ++r) { s[r] = 0.f;
#pragma unroll
            for (int j = 0; j < 4; ++j) s[r] += ssq4(v[r][j]); }
#pragma unroll
        for (int r = 0; r < ER; ++r) { const int m = m0 + r * ngw; if (m >= MTOK) break;
            const int b = m / SEQL; const float rr = rsqrtf(wave_sum_f(s[r]) * (1.0f / DM) + RMS_EPS);
            const float* sh = mod + (size_t)b * 3072; const float* sc = sh + 1024;
            u32x2_t* o = (u32x2_t*)(a0 + (size_t)m * DM) + lane;
#pragma unroll
            for (int j = 0; j < 4; ++j) { const int c = 256 * j + 4 * lane;
                const f32x4_t g = *(const f32x4_t*)(g_pre + c), scv = *(const f32x4_t*)(sc + c), shv = *(const f32x4_t*)(sh + c);
                const f32x4_t y = v[r][j] * rr * g * (scv + 1.0f) + shv;
                u32x2_t w; w.x = pk2bf(y.x, y.y); w.y = pk2bf(y.z, y.w); o[64 * j] = w; } }
    }
}
__device__ __forceinline__ void e_mid_r(const float* __restrict__ x, const bf16_t* __restrict__ yo, const float* __restrict__ mod, const float* __restrict__ g_post, const float* __restrict__ g_pre,
                                        float* h1, bf16_t* akv, bf16_t* ain1, int gw, int ngw, int lane) {
    for (int m0 = gw; m0 < MTOK; m0 += ER * ngw) {
        f32x4_t v[ER][4], y[ER][4]; float s[ER];
#pragma unroll
        for (int r = 0; r < ER; ++r) { const int m = min(m0 + r * ngw, MTOK - 1); const f32x4_t* xr = (const f32x4_t*)(x + (size_t)m * DM) + lane; const u32x2_t* yr = (const u32x2_t*)(yo + (size_t)m * DM) + lane;
#pragma unroll
            for (int j = 0; j < 4; ++j) { v[r][j] = NT_LD(xr + 64 * j); unpk4(NT_LD(yr + 64 * j), y[r][j]); } }
#pragma unroll
        for (int r = 0; r < ER; ++r) { s[r] = 0.f;
#pragma unroll
            for (int j = 0; j < 4; ++j) s[r] += ssq4(y[r][j]); }
#pragma unroll
        for (int r = 0; r < ER; ++r) { const int m = m0 + r * ngw; if (m >= MTOK) break;
            const int b = m / SEQL; const float ry = rsqrtf(wave_sum_f(s[r]) * (1.0f / DM) + RMS_EPS);
            const float* gate0 = mod + (size_t)b * 3072 + 2048; const float* sh1 = mod + (size_t)(8 + b) * 3072; const float* sc1 = sh1 + 1024;
            float s2 = 0.f; f32x4_t* ho = (f32x4_t*)(h1 + (size_t)m * DM) + lane;
#pragma unroll
            for (int j = 0; j < 4; ++j) { const int c = 256 * j + 4 * lane;
                const f32x4_t gp = *(const f32x4_t*)(g_post + c), gt = *(const f32x4_t*)(gate0 + c);
                v[r][j] = v[r][j] + gt * (y[r][j] * ry * gp); NT_ST(ho + 64 * j, v[r][j]); s2 += ssq4(v[r][j]); }
            const float rh = rsqrtf(wave_sum_f(s2) * (1.0f / DM) + RMS_EPS);
            u32x2_t* o1 = (u32x2_t*)(akv + (size_t)m * DM) + lane; u32x2_t* o2 = (u32x2_t*)(ain1 + (size_t)m * DM) + lane;
#pragma unroll
            for (int j = 0; j < 4; ++j) { const int c = 256 * j + 4 * lane;
                const f32x4_t nn = v[r][j] * rh; u32x2_t w; w.x = pk2bf(nn.x, nn.y); w.y = pk2bf(nn.z, nn.w); o1[64 * j] = w;
                const f32x4_t g = *(const f32x4_t*)(g_pre + 1024 + c), scv = *(const f32x4_t*)(sc1 + c), shv = *(const f32x4_t*)(sh1 + c);
                const f32x4_t z = nn * g * (scv + 1.0f) + shv; w.x = pk2bf(z.x, z.y); w.y = pk2bf(z.z, z.w); o2[64 * j] = w; } }
    }
}
__device__ __forceinline__ void e_final_r(float* out, const bf16_t* __restrict__ yo1, const float* __restrict__ mod, const float* __restrict__ g_post, int gw, int ngw, int lane) {
    for (int m0 = gw; m0 < MTOK; m0 += ER * ngw) {
        f32x4_t v[ER][4], y[ER][4]; float s[ER];
#pragma unroll
        for (int r = 0; r < ER; ++r) { const int m = min(m0 + r * ngw, MTOK - 1); const f32x4_t* hr = (const f32x4_t*)(out + (size_t)m * DM) + lane; const u32x2_t* yr = (const u32x2_t*)(yo1 + (size_t)m * DM) + lane;
#pragma unroll
            for (int j = 0; j < 4; ++j) { v[r][j] = NT_LD(hr + 64 * j); unpk4(NT_LD(yr + 64 * j), y[r][j]); } }
#pragma unroll
        for (int r = 0; r < ER; ++r) { s[r] = 0.f;
#pragma unroll
            for (int j = 0; j < 4; ++j) s[r] += ssq4(y[r][j]); }
#pragma unroll
        for (int r = 0; r < ER; ++r) { const int m = m0 + r * ngw; if (m >= MTOK) break;
            const int b = m / SEQL; const float ry = rsqrtf(wave_sum_f(s[r]) * (1.0f / DM) + RMS_EPS);
            const float* gate1 = mod + (size_t)(8 + b) * 3072 + 2048; f32x4_t* hr = (f32x4_t*)(out + (size_t)m * DM) + lane;
#pragma unroll
            for (int j = 0; j < 4; ++j) { const int c = 256 * j + 4 * lane;
                const f32x4_t gp = *(const f32x4_t*)(g_post + 1024 + c), gt = *(const f32x4_t*)(gate1 + c);
                NT_ST(hr + 64 * j, v[r][j] + gt * (y[r][j] * ry * gp)); } }
    }
}

__device__ __forceinline__ void unpk4b(const u32x2_t w, f32x4_t& y) { y.x = __uint_as_float(w.x << 16); y.y = __uint_as_float(w.x & 0xffff0000u); y.z = __uint_as_float(w.y << 16); y.w = __uint_as_float(w.y & 0xffff0000u); }
__device__ __forceinline__ float ssq4b(const f32x4_t v) { return (v.x * v.x + v.y * v.y) + (v.z * v.z + v.w * v.w); }
__device__ __forceinline__ void e_norm0_b(const float* __restrict__ x, const float* __restrict__ mod, const float* __restrict__ g_pre, bf16_t* a0, int gw, int ngw, int lane) {
    for (int b = 0; b < NB; ++b) {
        const float* sh = mod + (size_t)b * 3072; const float* sc = sh + 1024;
        f32x4_t G[4], SH[4];
#pragma unroll
        for (int j = 0; j < 4; ++j) { const int c = 256 * j + 4 * lane; G[j] = *(const f32x4_t*)(g_pre + c) * (*(const f32x4_t*)(sc + c) + 1.0f); SH[j] = *(const f32x4_t*)(sh + c); }
        for (int r0 = gw; r0 < SEQL; r0 += 2 * ngw) {
            const int ra = r0, rb = r0 + ngw; const bool hb = rb < SEQL;
            const int ma = b * SEQL + ra, mb = b * SEQL + (hb ? rb : ra);
            f32x4_t va[4], vb[4];
            const f32x4_t* xa = (const f32x4_t*)(x + (size_t)ma * DM) + lane; const f32x4_t* xb = (const f32x4_t*)(x + (size_t)mb * DM) + lane;
#pragma unroll
            for (int j = 0; j < 4; ++j) { va[j] = NT_LD(xa + 64 * j); vb[j] = NT_LD(xb + 64 * j); }
            float sa = 0.f, sb = 0.f;
#pragma unroll
            for (int j = 0; j < 4; ++j) { sa += ssq4b(va[j]); sb += ssq4b(vb[j]); }
            const float rra = rsqrtf(wave_sum_f(sa) * (1.0f / DM) + RMS_EPS), rrb = rsqrtf(wave_sum_f(sb) * (1.0f / DM) + RMS_EPS);
            u32x2_t* oa = (u32x2_t*)(a0 + (size_t)ma * DM) + lane; u32x2_t* ob = (u32x2_t*)(a0 + (size_t)mb * DM) + lane;
#pragma unroll
            for (int j = 0; j < 4; ++j) { const f32x4_t y = va[j] * rra * G[j] + SH[j]; u32x2_t w; w.x = pk2bf(y.x, y.y); w.y = pk2bf(y.z, y.w); oa[64 * j] = w; }
            if (hb) {
#pragma unroll
                for (int j = 0; j < 4; ++j) { const f32x4_t y = vb[j] * rrb * G[j] + SH[j]; u32x2_t w; w.x = pk2bf(y.x, y.y); w.y = pk2bf(y.z, y.w); ob[64 * j] = w; } }
        }
    }
}
__device__ __forceinline__ void e_mid_b(const float* __restrict__ x, const bf16_t* __restrict__ yo, const float* __restrict__ mod, const float* __restrict__ g_post, const float* __restrict__ g_pre,
                                        float* h1, bf16_t* akv, bf16_t* ain1, int gw, int ngw, int lane, float* hnorm = nullptr) {
    for (int b = 0; b < NB; ++b) {
        const float* gate0 = mod + (size_t)b * 3072 + 2048; const float* sh1 = mod + (size_t)(8 + b) * 3072; const float* sc1 = sh1 + 1024;
        f32x4_t GG[4], GF[4], SH[4];
#pragma unroll
        for (int j = 0; j < 4; ++j) { const int c = 256 * j + 4 * lane; GG[j] = *(const f32x4_t*)(gate0 + c) * *(const f32x4_t*)(g_post + c);
            GF[j] = *(const f32x4_t*)(g_pre + 1024 + c) * (*(const f32x4_t*)(sc1 + c) + 1.0f); SH[j] = *(const f32x4_t*)(sh1 + c); }
        for (int r0 = gw; r0 < SEQL; r0 += 2 * ngw) {
            const int ra = r0, rb = r0 + ngw; const bool hb = rb < SEQL;
            const int mr[2] = {b * SEQL + ra, b * SEQL + (hb ? rb : ra)};
            f32x4_t v[2][4], y[2][4];
#pragma unroll
            for (int q = 0; q < 2; ++q) { const f32x4_t* xr = (const f32x4_t*)(x + (size_t)mr[q] * DM) + lane; const u32x2_t* yr = (const u32x2_t*)(yo + (size_t)mr[q] * DM) + lane;
#pragma unroll
                for (int j = 0; j < 4; ++j) { v[q][j] = NT_LD(xr + 64 * j); unpk4b(NT_LD(yr + 64 * j), y[q][j]); } }
            float s[2] = {0.f, 0.f};
#pragma unroll
            for (int q = 0; q < 2; ++q)
#pragma unroll
                for (int j = 0; j < 4; ++j) s[q] += ssq4b(y[q][j]);
            float ry[2]; ry[0] = rsqrtf(wave_sum_f(s[0]) * (1.0f / DM) + RMS_EPS); ry[1] = rsqrtf(wave_sum_f(s[1]) * (1.0f / DM) + RMS_EPS);
            float s2[2] = {0.f, 0.f};
#pragma unroll
            for (int q = 0; q < 2; ++q)
#pragma unroll
                for (int j = 0; j < 4; ++j) { v[q][j] = v[q][j] + GG[j] * (y[q][j] * ry[q]); s2[q] += ssq4b(v[q][j]); }
            float rh[2]; rh[0] = rsqrtf(wave_sum_f(s2[0]) * (1.0f / DM) + RMS_EPS); rh[1] = rsqrtf(wave_sum_f(s2[1]) * (1.0f / DM) + RMS_EPS);
            if (hnorm && lane == 0) { hnorm[mr[0]] = 1.0f / rh[0]; if (hb) hnorm[mr[1]] = 1.0f / rh[1]; }
#pragma unroll
            for (int q = 0; q < 2; ++q) { if (q == 1 && !hb) break;
                f32x4_t* ho = (f32x4_t*)(h1 + (size_t)mr[q] * DM) + lane; u32x2_t* o1 = (u32x2_t*)(akv + (size_t)mr[q] * DM) + lane; u32x2_t* o2 = (u32x2_t*)(ain1 + (size_t)mr[q] * DM) + lane;
#pragma unroll
                for (int j = 0; j < 4; ++j) { if (h1) NT_ST(ho + 64 * j, v[q][j]);
                    const f32x4_t nn = v[q][j] * rh[q]; u32x2_t w; w.x = pk2bf(nn.x, nn.y); w.y = pk2bf(nn.z, nn.w); o1[64 * j] = w;
                    const f32x4_t z = nn * GF[j] + SH[j]; w.x = pk2bf(z.x, z.y); w.y = pk2bf(z.z, z.w); o2[64 * j] = w; } }
        }
    }
}
__device__ __forceinline__ void e_final_bm(float* out, const bf16_t* __restrict__ yo1, const float* __restrict__ mod, const float* __restrict__ g_post, int gw, int ngw, int lane) {
    for (int b = 0; b < NB; ++b) {
        const float* gate1 = mod + (size_t)(8 + b) * 3072 + 2048;
        f32x4_t GG[4];
#pragma unroll
        for (int j = 0; j < 4; ++j) { const int c = 256 * j + 4 * lane; GG[j] = *(const f32x4_t*)(gate1 + c) * *(const f32x4_t*)(g_post + 1024 + c); }
        for (int r0 = gw; r0 < SEQL; r0 += 2 * ngw) {
            const int ra = r0, rb = r0 + ngw; const bool hb = rb < SEQL;
            const int mr[2] = {b * SEQL + ra, b * SEQL + (hb ? rb : ra)};
            f32x4_t v[2][4], y[2][4];
#pragma unroll
            for (int q = 0; q < 2; ++q) { const f32x4_t* hr = (const f32x4_t*)(out + (size_t)mr[q] * DM) + lane; const u32x2_t* yr = (const u32x2_t*)(yo1 + (size_t)mr[q] * DM) + lane;
#pragma unroll
                for (int j = 0; j < 4; ++j) { v[q][j] = NT_LD(hr + 64 * j); unpk4b(NT_LD(yr + 64 * j), y[q][j]); } }
            float s[2] = {0.f, 0.f};
#pragma unroll
            for (int q = 0; q < 2; ++q)
#pragma unroll
                for (int j = 0; j < 4; ++j) s[q] += ssq4b(y[q][j]);
            float ry[2]; ry[0] = rsqrtf(wave_sum_f(s[0]) * (1.0f / DM) + RMS_EPS); ry[1] = rsqrtf(wave_sum_f(s[1]) * (1.0f / DM) + RMS_EPS);
#pragma unroll
            for (int q = 0; q < 2; ++q) { if (q == 1 && !hb) break;
                f32x4_t* hr = (f32x4_t*)(out + (size_t)mr[q] * DM) + lane;
#pragma unroll
                for (int j = 0; j < 4; ++j) NT_ST(hr + 64 * j, v[q][j] + GG[j] * (y[q][j] * ry[q])); }
        }
    }
}
__device__ __forceinline__ void e_final_x(const float* __restrict__ x, const bf16_t* __restrict__ yo, const bf16_t* __restrict__ yo1, float* out, const float* __restrict__ mod, const float* __restrict__ g_post, int gw, int ngw, int lane) {
    for (int b = 0; b < NB; ++b) {
        const float* gate0 = mod + (size_t)b * 3072 + 2048; const float* gate1 = mod + (size_t)(8 + b) * 3072 + 2048;
        f32x4_t G0[4], G1[4];
#pragma unroll
        for (int j = 0; j < 4; ++j) { const int c = 256 * j + 4 * lane; G0[j] = *(const f32x4_t*)(gate0 + c) * *(const f32x4_t*)(g_post + c); G1[j] = *(const f32x4_t*)(gate1 + c) * *(const f32x4_t*)(g_post + 1024 + c); }
        for (int r0 = gw; r0 < SEQL; r0 += 2 * ngw) {
            const int ra = r0, rb = r0 + ngw; const bool hb = rb < SEQL;
            const int mr[2] = {b * SEQL + ra, b * SEQL + (hb ? rb : ra)};
            f32x4_t v[2][4], y0[2][4], y1[2][4];
#pragma unroll
            for (int q = 0; q < 2; ++q) { const f32x4_t* xr = (const f32x4_t*)(x + (size_t)mr[q] * DM) + lane; const u32x2_t* ar = (const u32x2_t*)(yo + (size_t)mr[q] * DM) + lane; const u32x2_t* br = (const u32x2_t*)(yo1 + (size_t)mr[q] * DM) + lane;
#pragma unroll
                for (int j = 0; j < 4; ++j) { v[q][j] = NT_LD(xr + 64 * j); unpk4b(NT_LD(ar + 64 * j), y0[q][j]); unpk4b(NT_LD(br + 64 * j), y1[q][j]); } }
            float s0[2] = {0.f, 0.f}, s1[2] = {0.f, 0.f};
#pragma unroll
            for (int q = 0; q < 2; ++q)
#pragma unroll
                for (int j = 0; j < 4; ++j) { s0[q] += ssq4b(y0[q][j]); s1[q] += ssq4b(y1[q][j]); }
            float r0_[2], r1_[2];
#pragma unroll
            for (int q = 0; q < 2; ++q) { r0_[q] = rsqrtf(wave_sum_f(s0[q]) * (1.0f / DM) + RMS_EPS); r1_[q] = rsqrtf(wave_sum_f(s1[q]) * (1.0f / DM) + RMS_EPS); }
#pragma unroll
            for (int q = 0; q < 2; ++q) { if (q == 1 && !hb) break;
                f32x4_t* orow = (f32x4_t*)(out + (size_t)mr[q] * DM) + lane;
#pragma unroll
                for (int j = 0; j < 4; ++j) { const f32x4_t h = v[q][j] + G0[j] * (y0[q][j] * r0_[q]); NT_ST(orow + 64 * j, h + G1[j] * (y1[q][j] * r1_[q])); } }
        }
    }
}
__device__ __forceinline__ void e_final_k(const bf16_t* __restrict__ akv, const float* __restrict__ hnorm, const bf16_t* __restrict__ yo1, float* out, const float* __restrict__ mod, const float* __restrict__ g_post, int gw, int ngw, int lane) {
    for (int b = 0; b < NB; ++b) {
        const float* gate1 = mod + (size_t)(8 + b) * 3072 + 2048;
        f32x4_t G1[4];
#pragma unroll
        for (int j = 0; j < 4; ++j) { const int c = 256 * j + 4 * lane; G1[j] = *(const f32x4_t*)(gate1 + c) * *(const f32x4_t*)(g_post + 1024 + c); }
        for (int r0 = gw; r0 < SEQL; r0 += 2 * ngw) {
            const int ra = r0, rb = r0 + ngw; const bool hb = rb < SEQL;
            const int mr[2] = {b * SEQL + ra, b * SEQL + (hb ? rb : ra)};
            f32x4_t v[2][4], y1[2][4]; float hn[2];
#pragma unroll
            for (int q = 0; q < 2; ++q) { const u32x2_t* ar = (const u32x2_t*)(akv + (size_t)mr[q] * DM) + lane; const u32x2_t* br = (const u32x2_t*)(yo1 + (size_t)mr[q] * DM) + lane; hn[q] = hnorm[mr[q]];
#pragma unroll
                for (int j = 0; j < 4; ++j) { unpk4b(NT_LD(ar + 64 * j), v[q][j]); unpk4b(NT_LD(br + 64 * j), y1[q][j]); } }
            float s1[2] = {0.f, 0.f};
#pragma unroll
            for (int q = 0; q < 2; ++q)
#pragma unroll
                for (int j = 0; j < 4; ++j) s1[q] += ssq4b(y1[q][j]);
            float r1_[2];
#pragma unroll
            for (int q = 0; q < 2; ++q) r1_[q] = rsqrtf(wave_sum_f(s1[q]) * (1.0f / DM) + RMS_EPS);
#pragma unroll
            for (int q = 0; q < 2; ++q) { if (q == 1 && !hb) break;
                f32x4_t* orow = (f32x4_t*)(out + (size_t)mr[q] * DM) + lane;
#pragma unroll
                for (int j = 0; j < 4; ++j) NT_ST(orow + 64 * j, v[q][j] * hn[q] + G1[j] * (y1[q][j] * r1_[q])); }
        }
    }
}
__device__ __forceinline__ float diff_lambda(const float* lq1, const float* lk1, const float* lq2, const float* lk2) {
    float s1 = 0.f, s2 = 0.f;
    for (int i = 0; i < 64; ++i) { s1 += lq1[i] * lk1[i]; s2 += lq2[i] * lk2[i]; }
    return expf(s1) - expf(s2) + LAMBDA_INIT;
}

__global__ void n_adaln(const float* __restrict__ c, const float* __restrict__ ada_w, const float* __restrict__ ada_b, float* mod) {
    const int idx = blockIdx.x * 256 + threadIdx.x;
    if (idx >= 2 * 8 * 3072) return;
    const int j = idx % 3072, b = (idx / 3072) % 8, l = idx / (3072 * 8);
    float acc = ada_b[l * 3072 + j];
    const float* w = ada_w + (size_t)l * 1024 * 3072 + j; const float* cb = c + b * 1024;
    for (int k = 0; k < 1024; ++k) acc += silu_f(cb[k]) * w[(size_t)k * 3072];
    mod[idx] = acc;
}
__global__ void n_lambda(const float* lq1, const float* lk1, const float* lq2, const float* lk2, float* out) {
    if (threadIdx.x == 0 && blockIdx.x == 0) out[0] = diff_lambda(lq1, lk1, lq2, lk2);
}
__global__ void n_norm0(const float* x, const float* mod, const float* g_pre, bf16_t* a0) {
    e_norm0(x, mod, g_pre, a0, blockIdx.x * 4 + (threadIdx.x >> 6), gridDim.x * 4, threadIdx.x & 63);
}
__global__ void n_mid(const float* x, const bf16_t* yo, const float* mod, const float* g_post, const float* g_pre, float* h1, bf16_t* akv, bf16_t* ain1) {
    e_mid(x, yo, mod, g_post, g_pre, h1, (bf16_t*)nullptr, akv, ain1, blockIdx.x * 4 + (threadIdx.x >> 6), gridDim.x * 4, threadIdx.x & 63);
}
__global__ void n_attn_post(const bf16_t* o0, const bf16_t* o1, const bf16_t* sz1, const float* g_sub, const float* lamp, bf16_t* og) {
    e_attn_post(o0, o1, sz1, g_sub, lamp[0], og, blockIdx.x * 4 + (threadIdx.x >> 6), gridDim.x * 4, threadIdx.x & 63);
}
__global__ void n_final(float* out, const bf16_t* yo1, const float* mod, const float* g_post) {
    e_final(out, yo1, mod, g_post, blockIdx.x * 4 + (threadIdx.x >> 6), gridDim.x * 4, threadIdx.x & 63);
}

struct AL_Row { const bf16_t* A; __device__ float ld(int m, int k) const { return bf2f(A[(size_t)m * DM + k]); } };
struct AL_YG  { const bf16_t* A; __device__ float ld(int m, int k) const { return bf2f(A[yg_off(k >> 4, m >> 4, (m & 15) * 16 + (k & 15))]); } };
struct WL_Plain { const float* W; long N; __device__ float ld(int k, int n) const { return W[(size_t)k * N + n]; } };
struct WL_KV { const float* wk; const float* wv; const float* g; __device__ float ld(int k, int n) const { return g[k] * (n < 1024 ? wk[(size_t)k * 1024 + n] : wv[(size_t)k * 1024 + n - 1024]); } };
struct EP_In0 { bf16_t* US; bf16_t* SZ; __device__ void st(int m, int n, float a) const {
    if (n < 1024) US[us_off(n >> 4, m >> 4, (m & 15) * 16 + (n & 15))] = f2bf(a); else SZ[(size_t)m * DM + n - 1024] = f2bf(silu_f(a)); } };
struct EP_Glu { const bf16_t* YG; const bf16_t* SZ; const float* bias; bf16_t* Y2; __device__ void st(int m, int n, float a) const {
    const float yv = bf2f(YG[yg_off(n >> 4, m >> 4, (m & 15) * 16 + (n & 15))]); const float t = a + bias[n];
    Y2[(size_t)m * DM + n] = f2bf(yv * sigmoid_f(t) * bf2f(SZ[(size_t)m * DM + n])); } };
struct EP_Plain { bf16_t* O; __device__ void st(int m, int n, float a) const { O[(size_t)m * DM + n] = f2bf(a); } };
struct EP_KV { bf16_t* K; bf16_t* V; __device__ void st(int m, int n, float a) const { if (n < 1024) K[(size_t)m * DM + n] = f2bf(a); else V[(size_t)m * DM + n - 1024] = f2bf(a); } };
struct EP_In1 { bf16_t* Q; bf16_t* SZ1; __device__ void st(int m, int n, float a) const { if (n < 1024) Q[(size_t)m * DM + n] = f2bf(a * QC2); else SZ1[(size_t)m * DM + n - 1024] = f2bf(silu_f(a)); } };

template <class AL, class WL, class EP>
__global__ void __launch_bounds__(256) n_gemm(AL al, WL wl, EP ep, int N) {
    __shared__ float As[16][68]; __shared__ float Ws[16][68];
    const int tid = threadIdx.x, tx = tid & 15, ty = tid >> 4;
    const int m0 = blockIdx.y * 64, n0 = blockIdx.x * 64;
    float acc[4][4];
#pragma unroll
    for (int i = 0; i < 4; ++i)
#pragma unroll
        for (int j = 0; j < 4; ++j) acc[i][j] = 0.f;
    for (int k0 = 0; k0 < 1024; k0 += 16) {
#pragma unroll
        for (int i = 0; i < 4; ++i) { const int e = tid + 256 * i; const int mm = e >> 4, kk = e & 15; As[kk][mm] = al.ld(m0 + mm, k0 + kk); }
#pragma unroll
        for (int i = 0; i < 4; ++i) { const int e = tid + 256 * i; const int kk = e >> 6, nn = e & 63; Ws[kk][nn] = wl.ld(k0 + kk, n0 + nn); }
        __syncthreads();
#pragma unroll
        for (int kk = 0; kk < 16; ++kk) {
            float a[4], b[4];
#pragma unroll
            for (int i = 0; i < 4; ++i) { a[i] = As[kk][ty * 4 + i]; b[i] = Ws[kk][tx * 4 + i]; }
#pragma unroll
            for (int i = 0; i < 4; ++i)
#pragma unroll
                for (int j = 0; j < 4; ++j) acc[i][j] += a[i] * b[j];
        }
        __syncthreads();
    }
#pragma unroll
    for (int i = 0; i < 4; ++i)
#pragma unroll
        for (int j = 0; j < 4; ++j) ep.st(m0 + ty * 4 + i, n0 + tx * 4 + j, acc[i][j]);
}

__global__ void __launch_bounds__(256) n_ssm(const bf16_t* __restrict__ US, const float* lam_re, const float* lam_im, const float* log_dt, const float* b_re, const float* b_im,
                                             const float* c_re, const float* c_im, const float* d_skip, bf16_t* YG) {
    const int wv = blockIdx.x * 4 + (threadIdx.x >> 6), lane = threadIdx.x & 63;
    if (wv >= NB * NGRP) return;
    const int b = wv / NGRP, g = wv % NGRP, p = lane;
    const float dt = expf(log_dt[g]);
    const float lr = lam_re[g * 64 + p], li = lam_im[g * 64 + p];
    const float mag = expf(lr * dt); float sn, cs; sn = sinf(li * dt); cs = cosf(li * dt);
    const float lbr = mag * cs, lbi = mag * sn;
    const float nr = lbr - 1.0f, ni = lbi, den = lr * lr + li * li;
    const float cr = (nr * lr + ni * li) / den, ci = (ni * lr - nr * li) / den;
    float bbr[16], bbi[16], ccr[16], cci[16];
#pragma unroll
    for (int c = 0; c < 16; ++c) { const float br = b_re[(g * 64 + p) * 16 + c], bi = b_im[(g * 64 + p) * 16 + c];
        bbr[c] = cr * br - ci * bi; bbi[c] = cr * bi + ci * br;
        ccr[c] = c_re[(g * 16 + c) * 64 + p]; cci[c] = c_im[(g * 16 + c) * 64 + p]; }
    const float dsk = d_skip[g * 16 + (lane & 15)];
    float sr = 0.f, si = 0.f;
    for (int t = 0; t < SEQL; ++t) {
        const int m = b * SEQL + t;
        const bf16_t* up = US + us_off(g, m >> 4, (m & 15) * 16);
        float u[16];
        { const u32x4_t w0 = *(const u32x4_t*)up, w1 = *(const u32x4_t*)(up + 8);
#pragma unroll
          for (int i = 0; i < 4; ++i) { u[2 * i] = __uint_as_float(w0[i] << 16); u[2 * i + 1] = __uint_as_float(w0[i] & 0xffff0000u); u[8 + 2 * i] = __uint_as_float(w1[i] << 16); u[8 + 2 * i + 1] = __uint_as_float(w1[i] & 0xffff0000u); } }
        float bur = 0.f, bui = 0.f;
#pragma unroll
        for (int c = 0; c < 16; ++c) { bur += bbr[c] * u[c]; bui += bbi[c] * u[c]; }
        const float nsr = lbr * sr - lbi * si + bur, nsi = lbr * si + lbi * sr + bui; sr = nsr; si = nsi;
        float yv = 0.f;
#pragma unroll
        for (int c = 0; c < 16; ++c) { const float part = wave_sum_f(ccr[c] * sr - cci[c] * si); if ((lane & 15) == c) yv = part; }
        if (lane < 16) { const float yy = yv + dsk * bf2f(up[lane]); YG[yg_off(g, m >> 4, (m & 15) * 16 + lane)] = f2bf(gelu_tanh_f(yy)); }
    }
}

__global__ void __launch_bounds__(256) n_attn(const bf16_t* __restrict__ Q, const bf16_t* __restrict__ K, const bf16_t* __restrict__ V, bf16_t* O0, bf16_t* O1) {
    __shared__ float qs[4][128];
    const int w = threadIdx.x >> 6, lane = threadIdx.x & 63;
    const int gwv = blockIdx.x * 4 + w;
    const int h = gwv & 7, m = gwv >> 3, b = m / SEQL, qi = m % SEQL;
    qs[w][lane] = bf2f(Q[(size_t)m * DM + h * 128 + lane]); qs[w][64 + lane] = bf2f(Q[(size_t)m * DM + h * 128 + 64 + lane]);
    __syncthreads();
    float m0 = -1e30f, m1 = -1e30f, l0 = 0.f, l1 = 0.f, a00 = 0.f, a01 = 0.f, a10 = 0.f, a11 = 0.f;
    const size_t rb = (size_t)b * SEQL;
    for (int kc = 0; kc * 64 <= qi; ++kc) {
        const int key = kc * 64 + lane; const bool valid = key <= qi;
        float s0 = 0.f, s1 = 0.f;
        { const bf16_t* kr = K + (rb + (valid ? key : qi)) * DM + h * 128;
#pragma unroll
          for (int ch = 0; ch < 8; ++ch) { const u32x4_t w0 = *(const u32x4_t*)(kr + ch * 8), w1 = *(const u32x4_t*)(kr + 64 + ch * 8);
#pragma unroll
            for (int i = 0; i < 4; ++i) { s0 += qs[w][ch * 8 + 2 * i] * __uint_as_float(w0[i] << 16) + qs[w][ch * 8 + 2 * i + 1] * __uint_as_float(w0[i] & 0xffff0000u);
                                          s1 += qs[w][64 + ch * 8 + 2 * i] * __uint_as_float(w1[i] << 16) + qs[w][64 + ch * 8 + 2 * i + 1] * __uint_as_float(w1[i] & 0xffff0000u); } } }
        if (!valid) { s0 = -1e30f; s1 = -1e30f; }
        const float nm0 = fmaxf(m0, wave_max_f(s0)), nm1 = fmaxf(m1, wave_max_f(s1));
        const float f0 = exp2f(m0 - nm0), f1 = exp2f(m1 - nm1);
        const float p0 = valid ? exp2f(s0 - nm0) : 0.f, p1 = valid ? exp2f(s1 - nm1) : 0.f;
        l0 = l0 * f0 + wave_sum_f(p0); l1 = l1 * f1 + wave_sum_f(p1); m0 = nm0; m1 = nm1;
        a00 *= f0; a01 *= f0; a10 *= f1; a11 *= f1;
        const int nk = min(64, qi - kc * 64 + 1);
        for (int j = 0; j < nk; ++j) {
            const float pj0 = __shfl(p0, j), pj1 = __shfl(p1, j);
            const bf16_t* vr = V + (rb + kc * 64 + j) * DM + h * 128;
            const float v0 = bf2f(vr[lane]), v1 = bf2f(vr[64 + lane]);
            a00 += pj0 * v0; a01 += pj0 * v1; a10 += pj1 * v0; a11 += pj1 * v1;
        }
    }
    const float i0 = 1.0f / l0, i1 = 1.0f / l1;
    O0[(size_t)m * DM + h * 128 + lane] = f2bf(a00 * i0); O0[(size_t)m * DM + h * 128 + 64 + lane] = f2bf(a01 * i0);
    O1[(size_t)m * DM + h * 128 + lane] = f2bf(a10 * i1); O1[(size_t)m * DM + h * 128 + 64 + lane] = f2bf(a11 * i1);
}
#ifndef REPEAT_MASK
#define REPEAT_MASK 0
#endif
#ifndef ATTN_V128
#define ATTN_V128 1
#endif
#ifndef EXTRA_PHASE
#define EXTRA_PHASE -1
#endif
#ifndef ATTN_FUSE_POST
#define ATTN_FUSE_POST 1
#endif
#ifndef H1_RECOMP
#define H1_RECOMP 1
#endif
#ifndef SSM_FUSED
#define SSM_FUSED 1
#endif
#ifndef ATTN_PRIO
#define ATTN_PRIO 0
#endif
#ifndef H1_BF16
#define H1_BF16 0
#endif
#ifndef H1_AKV
#define H1_AKV 1
#endif
#ifndef NT_OUT
#define NT_OUT 0
#endif
#if NT_OUT
#define ST_OUT(p, v) __builtin_nontemporal_store((v), (p))
#else
#define ST_OUT(p, v) (*(p) = (v))
#endif
#ifndef FUSE_EPI
#define FUSE_EPI 0
#endif
#ifndef ALIGN_E
#define ALIGN_E true
#endif
namespace pg8 {
#define PG8_LAS __attribute__((address_space(3)))
typedef short bf16x8 __attribute__((ext_vector_type(8)));
typedef float f32x4 __attribute__((ext_vector_type(4)));
typedef unsigned u32x4 __attribute__((ext_vector_type(4)));
constexpr int BM = 256, BK = 64, HALF = 128, HTB = HALF * BK * 2  , STAGE_BYTES = 8 * HTB, NXCD = 8, WGM = 8;

__host__ __device__ __forceinline__ int lds_byte(int r, int c) { const int st = (r >> 4) * 2 + (c >> 5), rr = r & 15, cc = c & 31, ob = rr * 64 + cc * 2; return st * 1024 + (ob ^ (((ob >> 9) & 1) << 5)); }
__host__ __device__ __forceinline__ void stage_rc(int b, int& R, int& C) { const int st = b / 1024, sb = b % 1024, swz = sb ^ (((sb >> 9) & 1) << 5); R = (st >> 1) * 16 + swz / 64; C = (st & 1) * 32 + (swz % 64) / 2; }
__host__ __device__ __forceinline__ int perm32(int rho) { const int n = rho >> 4, i = rho & 15; return 8 * (i >> 2) + 4 * n + (i & 3); }

struct Unit { int pm, pn, grp; };
struct Gemm {
    const char* A; const char* Bt; int nt, pad0;
    unsigned a_rs, a_c16; size_t a_kstep, a_tstep, a_gstep;
    unsigned b_rs, pad1; size_t b_tstep, b_gstep;
    __device__ __forceinline__ const char* abase(const Unit& u) const { return A + (size_t)u.grp * a_gstep + (size_t)u.pm * a_tstep; }
    __device__ __forceinline__ const char* bbase(const Unit& u) const { return Bt + (size_t)u.grp * b_gstep + (size_t)u.pn * b_tstep; }
};
__device__ __forceinline__ Gemm gemm_std(const void* A, int lda, const void* Bt, int ldb, int K) {
    Gemm g; g.A = (const char*)A; g.Bt = (const char*)Bt; g.nt = K / BK; g.pad0 = 0; g.a_rs = (unsigned)lda * 2u; g.a_c16 = 32u; g.a_kstep = BK * 2; g.a_tstep = (size_t)BM * lda * 2; g.a_gstep = 0;
    g.b_rs = (unsigned)ldb * 2u; g.pad1 = 0; g.b_tstep = (size_t)BM * ldb * 2; g.b_gstep = 0; return g;
}

struct Order {
    int nM, nN, nG, nwg, G, c, only, pm_off, mode2;
    __device__ __forceinline__ void init(int nM_, int nN_, int nG_, int G_, int c_) { nM = nM_; nN = nN_; nG = nG_; nwg = nM * nN * nG; G = G_; c = c_; only = -1; pm_off = 0; mode2 = 0; }
    __device__ __forceinline__ bool next(int i, Unit& u) const {
        if (only >= 0) { if (i > 0) return false; i = only; }
        const long L = (long)i * G + c; if (L >= nwg) return false;
        int wgid = (int)L; { const int q = nwg / NXCD, r = nwg % NXCD, xcd = wgid % NXCD, off = wgid / NXCD; wgid = (xcd < r ? xcd * (q + 1) : r * (q + 1) + (xcd - r) * q) + off; }
        if (mode2) {
            const int x = wgid >> 8, y = wgid & 255, bk = y >> 6, w2 = y & 63; u.grp = bk & 1; u.pm = (x * 2 + (bk >> 1)) * 8 + (w2 & 7); u.pn = w2 >> 3;
        } else
        { const int per = nM * nN; u.grp = wgid / per; const int w2 = wgid % per;
          const int nig = WGM * nN, gid = w2 / nig, fm = gid * WGM, gsz = (nM - fm) < WGM ? (nM - fm) : WGM;
          u.pm = pm_off + fm + ((w2 % nig) % gsz); u.pn = (w2 % nig) / gsz; }
        return true;
    }
};

__device__ __forceinline__ unsigned cvt_pk_bf16(float lo, float hi) { unsigned r; asm volatile("v_cvt_pk_bf16_f32 %0, %1, %2" : "=v"(r) : "v"(lo), "v"(hi)); return r; }
__device__ __forceinline__ u32x4 pack8(const f32x4 a, const f32x4 b) { u32x4 w; w.x = cvt_pk_bf16(a[0], a[1]); w.y = cvt_pk_bf16(a[2], a[3]); w.z = cvt_pk_bf16(b[0], b[1]); w.w = cvt_pk_bf16(b[2], b[3]); return w; }
__device__ __forceinline__ void unpack8(const u32x4 w, f32x4& a, f32x4& b) {
    a[0] = __uint_as_float(w.x << 16); a[1] = __uint_as_float(w.x & 0xffff0000u); a[2] = __uint_as_float(w.y << 16); a[3] = __uint_as_float(w.y & 0xffff0000u);
    b[0] = __uint_as_float(w.z << 16); b[1] = __uint_as_float(w.z & 0xffff0000u); b[2] = __uint_as_float(w.w << 16); b[3] = __uint_as_float(w.w & 0xffff0000u); }
__device__ __forceinline__ float fsilu(float v) { return v * __builtin_amdgcn_rcpf(1.0f + __expf(-v)); }
__device__ __forceinline__ float fsigm(float v) { return __builtin_amdgcn_rcpf(1.0f + __expf(-v)); }
__device__ __forceinline__ f32x4 silu4(f32x4 v) { f32x4 o; o[0] = fsilu(v[0]); o[1] = fsilu(v[1]); o[2] = fsilu(v[2]); o[3] = fsilu(v[3]); return o; }
__device__ __forceinline__ f32x4 sigm4(f32x4 v) { f32x4 o; o[0] = fsigm(v[0]); o[1] = fsigm(v[1]); o[2] = fsigm(v[2]); o[3] = fsigm(v[3]); return o; }
__device__ __forceinline__ float fgelu(float v) { const float u = 0.7978845608028654f * (v + 0.044715f * v * v * v); const float e = __expf(2.0f * u); return 0.5f * v * (2.0f - 2.0f * __builtin_amdgcn_rcpf(e + 1.0f)); }
__device__ __forceinline__ f32x4 gelu4(f32x4 v) { f32x4 o; o[0] = fgelu(v[0]); o[1] = fgelu(v[1]); o[2] = fgelu(v[2]); o[3] = fgelu(v[3]); return o; }

template <class F> struct EpiRow8 {
    static constexpr bool PERM = true, AFTER_DRAIN = false;
    F f;
    __device__ __forceinline__ void operator()(const f32x4 (&acc)[2][2][4][2], const Unit& u, int wr, int wc, int fr, int fq) const {
#pragma unroll
        for (int ai = 0; ai < 2; ++ai)
#pragma unroll
            for (int m = 0; m < 4; ++m) { const int row = u.pm * BM + ai * HALF + wr * 64 + m * 16 + fr;
#pragma unroll
                for (int bj = 0; bj < 2; ++bj) { const int col0 = u.pn * BM + bj * HALF + wc * 32 + 8 * fq; f.apply(u, row, col0, acc[ai][bj][m][0], acc[ai][bj][m][1]); } }
    }
};
struct F_In0 { bf16_t* US; bf16_t* SZ;
    __device__ __forceinline__ void apply(const Unit&, int row, int col0, f32x4 v0, f32x4 v1) const {
        if (col0 < 1024) ST_OUT((u32x4*)(US + us_off(col0 >> 4, row >> 4, (row & 15) * 16 + (col0 & 15))), pack8(v0, v1));
        else NT_ST((u32x4*)(SZ + (size_t)row * DM + (col0 - 1024)), pack8(silu4(v0), silu4(v1))); } };
struct F_SsmA { float* E;
    __device__ __forceinline__ void apply(const Unit& u, int row, int col0, f32x4 v0, f32x4 v1) const {
        if (col0 < 128) { float* p = E + ((size_t)u.grp * NTILE + row) * 128 + col0; *(f32x4*)p = v0; *(f32x4*)(p + 4) = v1; } } };
struct F_SsmB { const bf16_t* US; const float* dsk; bf16_t* YG;
    __device__ __forceinline__ void apply(const Unit& u, int row, int col0, f32x4 v0, f32x4 v1) const {
        const u32x4 uw = *(const u32x4*)(US + us_off(u.grp, row, col0)); f32x4 u0, u1; unpack8(uw, u0, u1);
        const float* d = dsk + u.grp * 16 + (col0 & 15); const f32x4 d0 = *(const f32x4*)d, d1 = *(const f32x4*)(d + 4);
        ST_OUT((u32x4*)(YG + yg_off(u.grp, row, col0)), pack8(gelu4(v0 + d0 * u0), gelu4(v1 + d1 * u1))); } };
struct F_Glu { const bf16_t* YG; const bf16_t* SZ; const float* bias; bf16_t* Y2;
    __device__ __forceinline__ void apply(const Unit&, int row, int col0, f32x4 v0, f32x4 v1) const {
        const u32x4 yw = *(const u32x4*)(YG + yg_off(col0 >> 4, row >> 4, (row & 15) * 16 + (col0 & 15))); f32x4 y0, y1; unpack8(yw, y0, y1);
        const u32x4 zw = NT_LD((const u32x4*)(SZ + (size_t)row * DM + col0)); f32x4 z0, z1; unpack8(zw, z0, z1);
        const f32x4 b0 = *(const f32x4*)(bias + col0), b1 = *(const f32x4*)(bias + col0 + 4);
        ST_OUT((u32x4*)(Y2 + (size_t)row * DM + col0), pack8(y0 * sigm4(v0 + b0) * z0, y1 * sigm4(v1 + b1) * z1)); } };
template <class F> struct EpiRow8L {
    static constexpr bool PERM = true, AFTER_DRAIN = false;
    F f;
    __device__ __forceinline__ void operator()(const f32x4 (&acc)[2][2][4][2], const Unit& u, int wr, int wc, int fr, int fq) const {
#pragma unroll
        for (int ai = 0; ai < 2; ++ai) {
            typename F::Pre pre[4][2];
#pragma unroll
            for (int m = 0; m < 4; ++m) { const int row = u.pm * BM + ai * HALF + wr * 64 + m * 16 + fr;
#pragma unroll
                for (int bj = 0; bj < 2; ++bj) { const int col0 = u.pn * BM + bj * HALF + wc * 32 + 8 * fq; f.load(u, row, col0, pre[m][bj]); } }
#pragma unroll
            for (int m = 0; m < 4; ++m) { const int row = u.pm * BM + ai * HALF + wr * 64 + m * 16 + fr;
#pragma unroll
                for (int bj = 0; bj < 2; ++bj) { const int col0 = u.pn * BM + bj * HALF + wc * 32 + 8 * fq; f.apply(u, row, col0, acc[ai][bj][m][0], acc[ai][bj][m][1], pre[m][bj]); } }
        }
    }
};
struct F_SsmB2 { const bf16_t* US; const float* dsk; bf16_t* YG;
    struct Pre { u32x4 uw; };
    __device__ __forceinline__ void load(const Unit& u, int row, int col0, Pre& p) const { p.uw = *(const u32x4*)(US + us_off(u.grp, row, col0)); }
    __device__ __forceinline__ void apply(const Unit& u, int row, int col0, f32x4 v0, f32x4 v1, const Pre& p) const {
        f32x4 u0, u1; unpack8(p.uw, u0, u1);
        const float* d = dsk + u.grp * 16 + (col0 & 15); const f32x4 d0 = *(const f32x4*)d, d1 = *(const f32x4*)(d + 4);
        *(u32x4*)(YG + yg_off(u.grp, row, col0)) = pack8(gelu4(v0 + d0 * u0), gelu4(v1 + d1 * u1)); } };
struct F_Glu2 { const bf16_t* YG; const bf16_t* SZ; const float* bias; bf16_t* Y2;
    struct Pre { u32x4 yw, zw; };
    __device__ __forceinline__ void load(const Unit&, int row, int col0, Pre& p) const {
        p.yw = *(const u32x4*)(YG + yg_off(col0 >> 4, row >> 4, (row & 15) * 16 + (col0 & 15))); p.zw = *(const u32x4*)(SZ + (size_t)row * DM + col0); }
    __device__ __forceinline__ void apply(const Unit&, int row, int col0, f32x4 v0, f32x4 v1, const Pre& p) const {
        f32x4 y0, y1, z0, z1; unpack8(p.yw, y0, y1); unpack8(p.zw, z0, z1);
        const f32x4 b0 = *(const f32x4*)(bias + col0), b1 = *(const f32x4*)(bias + col0 + 4);
        *(u32x4*)(Y2 + (size_t)row * DM + col0) = pack8(y0 * sigm4(v0 + b0) * z0, y1 * sigm4(v1 + b1) * z1); } };
struct F_Split2 { bf16_t* Olo[2]; bf16_t* Ohi[2];
    __device__ __forceinline__ void apply(const Unit& u, int row, int col0, f32x4 v0, f32x4 v1) const {
        if (u.grp == 0) { bf16_t* o = (col0 < 1024) ? Olo[0] + (size_t)row * DM + col0 : Ohi[0] + (size_t)row * DM + (col0 - 1024); ST_OUT((u32x4*)o, pack8(v0, v1)); }
        else if (col0 < 1024) NT_ST((u32x4*)(Olo[1] + (size_t)row * DM + col0), pack8(v0 * QC2, v1 * QC2));
        else NT_ST((u32x4*)(Ohi[1] + (size_t)row * DM + (col0 - 1024)), pack8(silu4(v0), silu4(v1))); } };
struct F_Plain { bf16_t* O;
    __device__ __forceinline__ void apply(const Unit&, int row, int col0, f32x4 v0, f32x4 v1) const { ST_OUT((u32x4*)(O + (size_t)row * DM + col0), pack8(v0, v1)); } };
struct F_Split { bf16_t* Olo; bf16_t* Ohi; float sc_lo; int silu_hi;
    __device__ __forceinline__ void apply(const Unit&, int row, int col0, f32x4 v0, f32x4 v1) const {
        if (col0 < 1024) *(u32x4*)(Olo + (size_t)row * DM + col0) = pack8(v0 * sc_lo, v1 * sc_lo);
        else { if (silu_hi) { NT_ST((u32x4*)(Ohi + (size_t)row * DM + (col0 - 1024)), pack8(silu4(v0), silu4(v1))); } else *(u32x4*)(Ohi + (size_t)row * DM + (col0 - 1024)) = pack8(v0, v1); } } };


struct PanelRms {
    unsigned* xbuf;
    unsigned* cnt;
    unsigned* tmo;
    float eps;
    __device__ __forceinline__ bool run(const f32x4 (&v)[2][2][4][2], const Unit& u, int wr, int wc, int fr, int fq, PG8_LAS unsigned char* lds, int wid, int lane) const {
        PG8_LAS float* P = (PG8_LAS float*)lds;
        PG8_LAS float* S = (PG8_LAS float*)(lds + 8192);
        PG8_LAS unsigned* flag = (PG8_LAS unsigned*)(lds + 8192 + 2048);
#pragma unroll
        for (int ai = 0; ai < 2; ++ai)
#pragma unroll
            for (int m = 0; m < 4; ++m) {
                float q = 0.f;
#pragma unroll
                for (int bj = 0; bj < 2; ++bj)
#pragma unroll
                    for (int n = 0; n < 2; ++n) { const f32x4 d = v[ai][bj][m][n]; q += (d[0] * d[0] + d[1] * d[1]) + (d[2] * d[2] + d[3] * d[3]); }
                q += __shfl_xor(q, 16); q += __shfl_xor(q, 32);
                if (fq == 0) P[(ai * HALF + wr * 64 + m * 16 + fr) * 4 + wc] = q;
            }
        asm volatile("s_waitcnt lgkmcnt(0)" ::: "memory"); __builtin_amdgcn_s_barrier(); asm volatile("" ::: "memory");
        const int row = wid * 32 + (lane & 31);
        if (lane < 32) {
            const float tot = (P[row * 4 + 0] + P[row * 4 + 1]) + (P[row * 4 + 2] + P[row * 4 + 3]);
            unsigned long long* slot = (unsigned long long*)xbuf + ((size_t)(u.pm * BM + row) * 4 + u.pn);
            __hip_atomic_store(slot, (unsigned long long)__float_as_uint(tot), __ATOMIC_RELAXED, __HIP_MEMORY_SCOPE_AGENT);
        }
        asm volatile("s_waitcnt vmcnt(0)" ::: "memory");
        if (lane == 0) __hip_atomic_fetch_add(cnt + 64 * u.pm, 1u, __ATOMIC_RELAXED, __HIP_MEMORY_SCOPE_AGENT);
        if (wid == 0) {
            bool dead = false; const unsigned long long t0 = __builtin_amdgcn_s_memrealtime(); const unsigned want = 32u;
            for (;;) {
                if ((unsigned)__builtin_amdgcn_readfirstlane(__hip_atomic_load(cnt + 64 * u.pm, __ATOMIC_RELAXED, __HIP_MEMORY_SCOPE_AGENT)) >= want) break;
                if (__builtin_amdgcn_s_memrealtime() - t0 > 2000000ull) { if (lane == 0) __hip_atomic_store(tmo, 1u, __ATOMIC_RELAXED, __HIP_MEMORY_SCOPE_AGENT); dead = true; break; }
                __builtin_amdgcn_s_sleep(2);
            }
            __builtin_amdgcn_fence(__ATOMIC_ACQUIRE, "agent");
            if (lane == 0) flag[0] = dead ? 1u : 0u;
        }
        asm volatile("s_waitcnt vmcnt(0) lgkmcnt(0)" ::: "memory"); __builtin_amdgcn_s_barrier(); asm volatile("" ::: "memory");
        const bool bad = flag[0] != 0u;
        if (lane < 32) {
            const unsigned long long* slot = (const unsigned long long*)xbuf + (size_t)(u.pm * BM + row) * 4; float t4[4];
#pragma unroll
            for (int t = 0; t < 4; ++t) t4[t] = __uint_as_float((unsigned)__hip_atomic_load(slot + t, __ATOMIC_RELAXED, __HIP_MEMORY_SCOPE_AGENT));
            S[row] = rsqrtf(((t4[0] + t4[1]) + (t4[2] + t4[3])) * (1.0f / 1024.0f) + eps);
        }
        asm volatile("s_waitcnt lgkmcnt(0)" ::: "memory"); __builtin_amdgcn_s_barrier(); asm volatile("" ::: "memory");
        return bad;
    }
};
struct EpiFinal {
    static constexpr bool PERM = false, AFTER_DRAIN = true;
    const float* base; float* out; const float* mod1; const float* gpost1; PanelRms st;
    __device__ __forceinline__ void fused(f32x4 (&acc)[2][2][4][2], const Unit& u, int wr, int wc, int fr, int fq, PG8_LAS unsigned char* lds, int wid, int lane) const {
        const PG8_LAS float* S = (const PG8_LAS float*)(lds + 8192);
        const int col0 = u.pn * BM + wc * 32 + 4 * fq; const int b = u.pm >> 4;
        const float* gate = mod1 + (size_t)b * 3072 + 2048;
        const bool bad = st.run(acc, u, wr, wc, fr, fq, lds, wid, lane);
        const float qnan = __builtin_nanf("");
        f32x4 gg[2][2];
#pragma unroll
        for (int bj = 0; bj < 2; ++bj)
#pragma unroll
            for (int n = 0; n < 2; ++n) gg[bj][n] = *(const f32x4*)(gate + col0 + bj * HALF + n * 16) * *(const f32x4*)(gpost1 + col0 + bj * HALF + n * 16);
#pragma unroll
        for (int ai = 0; ai < 2; ++ai)
#pragma unroll
            for (int m = 0; m < 4; ++m) { const int r = ai * HALF + wr * 64 + m * 16 + fr; const float sr = S[r]; const size_t off = (size_t)(u.pm * BM + r) * DM + col0;
#pragma unroll
                for (int bj = 0; bj < 2; ++bj)
#pragma unroll
                    for (int n = 0; n < 2; ++n) { const f32x4 bs = *(const f32x4*)(base + off + bj * HALF + n * 16); f32x4 o = bs + gg[bj][n] * (acc[ai][bj][m][n] * sr);
                        if (bad) o = (f32x4){qnan, qnan, qnan, qnan}; *(f32x4*)(out + off + bj * HALF + n * 16) = o; }
                if (m & 1) asm volatile("" ::: "memory"); }
    }
};
struct EpiMid {
    static constexpr bool PERM = false, AFTER_DRAIN = true;
    const float* x; float* out; bf16_t* akv; bf16_t* ain1; const float* mod; const float* gpost0; const float* gpre1; PanelRms st1, st2;
    __device__ __forceinline__ void fused(f32x4 (&acc)[2][2][4][2], const Unit& u, int wr, int wc, int fr, int fq, PG8_LAS unsigned char* lds, int wid, int lane) const {
        typedef unsigned u32x2v __attribute__((ext_vector_type(2)));
        const PG8_LAS float* S = (const PG8_LAS float*)(lds + 8192);
        const int col0 = u.pn * BM + wc * 32 + 4 * fq; const int b = u.pm >> 4;
        const float* gate0 = mod + (size_t)b * 3072 + 2048; const float* sh1 = mod + (size_t)(8 + b) * 3072; const float* sc1 = sh1 + 1024;
        bool bad = st1.run(acc, u, wr, wc, fr, fq, lds, wid, lane);
        {
            f32x4 gg[2][2];
#pragma unroll
            for (int bj = 0; bj < 2; ++bj)
#pragma unroll
                for (int n = 0; n < 2; ++n) gg[bj][n] = *(const f32x4*)(gate0 + col0 + bj * HALF + n * 16) * *(const f32x4*)(gpost0 + col0 + bj * HALF + n * 16);
#pragma unroll
            for (int ai = 0; ai < 2; ++ai)
#pragma unroll
                for (int m = 0; m < 4; ++m) { const int r = ai * HALF + wr * 64 + m * 16 + fr; const float sr = S[r]; const size_t off = (size_t)(u.pm * BM + r) * DM + col0;
#pragma unroll
                    for (int bj = 0; bj < 2; ++bj)
#pragma unroll
                        for (int n = 0; n < 2; ++n) { const f32x4 bs = *(const f32x4*)(x + off + bj * HALF + n * 16); acc[ai][bj][m][n] = bs + gg[bj][n] * (acc[ai][bj][m][n] * sr); }
                    asm volatile("" : "+v"(acc[ai][0][m][0]), "+v"(acc[ai][0][m][1]), "+v"(acc[ai][1][m][0]), "+v"(acc[ai][1][m][1]));
                    if (m & 1) asm volatile("" ::: "memory"); }
        }
        bad = st2.run(acc, u, wr, wc, fr, fq, lds, wid, lane) || bad;
        const float qnan = __builtin_nanf("");
#pragma unroll
        for (int bj = 0; bj < 2; ++bj)
#pragma unroll
            for (int n = 0; n < 2; ++n) { const int c = col0 + bj * HALF + n * 16;
                const f32x4 gf = *(const f32x4*)(gpre1 + c) * (*(const f32x4*)(sc1 + c) + 1.0f), sh = *(const f32x4*)(sh1 + c);
#pragma unroll
                for (int ai = 0; ai < 2; ++ai)
#pragma unroll
                    for (int m = 0; m < 4; ++m) { const int r = ai * HALF + wr * 64 + m * 16 + fr; const float sr = S[r]; const size_t off = (size_t)(u.pm * BM + r) * DM + c;
                        f32x4 h = acc[ai][bj][m][n]; if (bad) h = (f32x4){qnan, qnan, qnan, qnan};
                        *(f32x4*)(out + off) = h;
                        const f32x4 nr = h * sr; u32x2v w; w.x = cvt_pk_bf16(nr[0], nr[1]); w.y = cvt_pk_bf16(nr[2], nr[3]); *(u32x2v*)(akv + off) = w;
                        const f32x4 z = nr * gf + sh; w.x = cvt_pk_bf16(z[0], z[1]); w.y = cvt_pk_bf16(z[2], z[3]); *(u32x2v*)(ain1 + off) = w; }
                asm volatile("" ::: "memory"); }
    }
};

struct EpiScan {
    static constexpr bool PERM = true, AFTER_DRAIN = true;
    const float* lb16; bf16_t* US; int carry_off;
    __device__ __forceinline__ void fused(f32x4 (&acc)[2][2][4][2], const Unit& u, int wr, int wc, int fr, int fq, PG8_LAS unsigned char* lds, int wid, int lane) const {
#pragma unroll
        for (int ai = 0; ai < 2; ++ai)
#pragma unroll
            for (int m = 0; m < 4; ++m) { const int row = ai * HALF + wr * 64 + m * 16 + fr; const int ch = (wc * 32 + 8 * fq) >> 2;
                *(PG8_LAS f32x4*)(lds + row * 512 + ((ch ^ (row & 7)) << 4)) = acc[ai][0][m][0];
                *(PG8_LAS f32x4*)(lds + row * 512 + (((ch + 1) ^ (row & 7)) << 4)) = acc[ai][0][m][1]; }
        asm volatile("s_waitcnt lgkmcnt(0)" ::: "memory"); __builtin_amdgcn_s_barrier(); asm volatile("" ::: "memory");
        const int p = lane, g = u.grp, b = u.pm;
        const float lr = lb16[(g * 64 + p) * 2], li = lb16[(g * 64 + p) * 2 + 1];
        typedef float f32x2v __attribute__((ext_vector_type(2)));
        const int coff = ((p >> 1) << 4) + (p & 1) * 8;
        float sr = 0.f, si = 0.f;
#pragma unroll 8
        for (int j = 0; j < 32; ++j) { const int t = wid * 32 + j; const f32x2v e = *(const PG8_LAS f32x2v*)(lds + t * 512 + (coff ^ ((t & 7) << 4)));
            const float nr = lr * sr - li * si + e.x, ni = lr * si + li * sr + e.y; sr = nr; si = ni; }
        PG8_LAS f32x2v* C = (PG8_LAS f32x2v*)(lds + carry_off);
        C[wid * 64 + p] = (f32x2v){sr, si};
        float pr = lr, pi = li;
#pragma unroll
        for (int q = 0; q < 5; ++q) { const float nr = pr * pr - pi * pi, ni = 2.f * pr * pi; pr = nr; pi = ni; }
        asm volatile("s_waitcnt lgkmcnt(0)" ::: "memory"); __builtin_amdgcn_s_barrier(); asm volatile("" ::: "memory");
        sr = 0.f; si = 0.f;
        for (int v = 0; v < wid; ++v) { const f32x2v c = C[v * 64 + p]; const float nr = pr * sr - pi * si + c.x, ni = pr * si + pi * sr + c.y; sr = nr; si = ni; }
        bf16_t* sp = US + us_off(g, b * 256 + wid * 32, 256 + 2 * p);
#pragma unroll 8
        for (int j = 0; j < 32; ++j) { const int t = wid * 32 + j; const f32x2v e = *(const PG8_LAS f32x2v*)(lds + t * 512 + (coff ^ ((t & 7) << 4)));
            *(unsigned*)(sp + (size_t)j * US_P) = cvt_pk_bf16(sr, si);
            const float nr = lr * sr - li * si + e.x, ni = lr * si + li * sr + e.y; sr = nr; si = ni; }
        asm volatile("s_waitcnt vmcnt(0)" ::: "memory");
    }
};
template <class Epi, bool ALIGN_EPI>
__device__ __forceinline__ void gemm_phase(PG8_LAS unsigned char* lds, const Gemm g, const Order& S, const Epi& E, int tid_in) {
    int tid_ = tid_in; asm volatile("" : "+v"(tid_));
    const int tid = tid_, wid = __builtin_amdgcn_readfirstlane(tid >> 6), lane = tid & 63, wr = wid >> 2, wc = wid & 3, fr = lane & 15, fq = lane >> 4;
    const int nt = g.nt;
    unsigned voffA[2], voffB[2];
#pragma unroll
    for (int i = 0; i < 2; ++i) { int R, C; stage_rc(tid * 16 + i * 8192, R, C); const int Rb = Epi::PERM ? ((R & ~31) + perm32(R & 31)) : R;
        voffA[i] = (unsigned)R * g.a_rs + (unsigned)(C >> 4) * g.a_c16 + (unsigned)(C & 15) * 2u; voffB[i] = (unsigned)Rb * g.b_rs + (unsigned)C * 2u; }
    const size_t kstepA = g.a_kstep, kstepB = (size_t)(BK * 2);
    const size_t hstepA = (size_t)HALF * g.a_rs, hstepB = (size_t)HALF * g.b_rs;
    const unsigned ldsw = (unsigned)wid * 1024u;
    const int aoff = lds_byte(wr * 64 + fr, fq * 8), boff = lds_byte(wc * 32 + fr, fq * 8);
#define PG8_SA(b, h) (((b) * 2 + (h)) * HTB)
#define PG8_SB(b, h) ((4 + (b) * 2 + (h)) * HTB)
#define PG8_STAGE(bufoff, gbase, voff) do { _Pragma("unroll") for (int _i = 0; _i < 2; ++_i) \
        __builtin_amdgcn_global_load_lds((const unsigned*)((const char*)(gbase) + (voff)[_i]), (PG8_LAS unsigned*)(lds + (bufoff) + ldsw + _i * 8192), 16, 0, 0); } while (0)
#define PG8_LDA(dst, b, h) do { _Pragma("unroll") for (int m = 0; m < 4; ++m) _Pragma("unroll") for (int k = 0; k < 2; ++k) dst[m][k] = *(const PG8_LAS bf16x8*)(lds + PG8_SA(b, h) + aoff + m * 2048 + k * 1024); } while (0)
#define PG8_LDB(dst, b, h) do { _Pragma("unroll") for (int n = 0; n < 2; ++n) _Pragma("unroll") for (int k = 0; k < 2; ++k) dst[n][k] = *(const PG8_LAS bf16x8*)(lds + PG8_SB(b, h) + boff + n * 2048 + k * 1024); } while (0)
#define PG8_MMA(ai, bj, At, Bt) do { __builtin_amdgcn_s_setprio(1); _Pragma("unroll") for (int m = 0; m < 4; ++m) _Pragma("unroll") for (int n = 0; n < 2; ++n) _Pragma("unroll") for (int k = 0; k < 2; ++k) \
        acc[ai][bj][m][n] = __builtin_amdgcn_mfma_f32_16x16x32_bf16(Bt[n][k], At[m][k], acc[ai][bj][m][n], 0, 0, 0); __builtin_amdgcn_s_setprio(0); } while (0)
#define PG8_WAIT_V(n) asm volatile("s_waitcnt vmcnt(" #n ")" ::: "memory")
#define PG8_WAIT_L(n) asm volatile("s_waitcnt lgkmcnt(" #n ")" ::: "memory")
#define PG8_BAR __builtin_amdgcn_s_barrier()
#define PG8_SCHED __builtin_amdgcn_sched_barrier(0)
    Unit cur, nxt; int ui = 0;
    if (!S.next(0, cur)) return;
    f32x4 acc[2][2][4][2];
#pragma unroll
    for (int a = 0; a < 2; ++a)
#pragma unroll
        for (int b = 0; b < 2; ++b)
#pragma unroll
            for (int m = 0; m < 4; ++m)
#pragma unroll
                for (int n = 0; n < 2; ++n) acc[a][b][m][n] = (f32x4){0.f, 0.f, 0.f, 0.f};
    bf16x8 At[4][2], B0[2][2], B1[2][2];
    const char* cA = g.abase(cur); const char* cB = g.bbase(cur);
    PG8_STAGE(PG8_SB(0, 0), cB, voffB); PG8_STAGE(PG8_SB(0, 1), cB + hstepB, voffB); PG8_STAGE(PG8_SA(0, 0), cA, voffA); PG8_STAGE(PG8_SA(0, 1), cA + hstepA, voffA);
    if (wr == 1) PG8_BAR;
    PG8_WAIT_V(2); PG8_BAR;
    PG8_STAGE(PG8_SB(1, 0), cB + kstepB, voffB); PG8_STAGE(PG8_SA(1, 0), cA + kstepA, voffA); PG8_STAGE(PG8_SB(1, 1), cB + hstepB + kstepB, voffB);
    PG8_WAIT_V(6); PG8_BAR;
    for (;;) {
        const bool has_next = S.next(ui + 1, nxt);
        const char* nA = has_next ? g.abase(nxt) : cA; const char* nB = has_next ? g.bbase(nxt) : cB;
        for (int t = 0; t < nt; t += 2) {
            const bool last = (t == nt - 2);
            const char* a1 = cA + (size_t)(t + 1) * kstepA;
            const char* a2 = last ? nA : cA + (size_t)(t + 2) * kstepA; const char* b2 = last ? nB : cB + (size_t)(t + 2) * kstepB;
            const char* a3 = a2 + kstepA; const char* b3 = b2 + kstepB;
            PG8_LDB(B0, 0, 0); PG8_LDB(B1, 0, 1); PG8_SCHED; PG8_LDA(At, 0, 0); PG8_STAGE(PG8_SA(1, 1), a1 + hstepA, voffA);
            PG8_WAIT_V(8); PG8_WAIT_L(0); PG8_BAR; PG8_MMA(0, 0, At, B0); PG8_MMA(0, 1, At, B1); PG8_BAR; PG8_SCHED;
            PG8_LDA(At, 0, 1); PG8_STAGE(PG8_SB(0, 0), b2, voffB); PG8_STAGE(PG8_SB(0, 1), b2 + hstepB, voffB); PG8_STAGE(PG8_SA(0, 0), a2, voffA);
            PG8_WAIT_V(8); PG8_WAIT_L(0); PG8_BAR; PG8_MMA(1, 0, At, B0); PG8_MMA(1, 1, At, B1); PG8_BAR; PG8_SCHED;
            PG8_LDB(B0, 1, 0); PG8_LDB(B1, 1, 1); PG8_SCHED; PG8_LDA(At, 1, 0); PG8_STAGE(PG8_SA(0, 1), a2 + hstepA, voffA);
            PG8_WAIT_V(8); PG8_WAIT_L(0); PG8_BAR; PG8_MMA(0, 0, At, B0); PG8_MMA(0, 1, At, B1); PG8_BAR; PG8_SCHED;
            PG8_LDA(At, 1, 1); PG8_STAGE(PG8_SB(1, 0), b3, voffB); PG8_STAGE(PG8_SB(1, 1), b3 + hstepB, voffB); PG8_STAGE(PG8_SA(1, 0), a3, voffA);
            PG8_WAIT_V(8); PG8_WAIT_L(0); PG8_BAR; PG8_MMA(1, 0, At, B0); PG8_MMA(1, 1, At, B1); PG8_BAR; PG8_SCHED;
        }
        if constexpr (ALIGN_EPI) { if (wr == 0) PG8_BAR; }
        if constexpr (!Epi::AFTER_DRAIN) { E(acc, cur, wr, wc, fr, fq); }
        if (!has_next) break;
#pragma unroll
        for (int a = 0; a < 2; ++a)
#pragma unroll
            for (int b = 0; b < 2; ++b)
#pragma unroll
                for (int m = 0; m < 4; ++m)
#pragma unroll
                    for (int n = 0; n < 2; ++n) acc[a][b][m][n] = (f32x4){0.f, 0.f, 0.f, 0.f};
        cur = nxt; cA = nA; cB = nB; ++ui;
        if constexpr (ALIGN_EPI) { if (wr == 1) PG8_BAR; }
    }
    PG8_WAIT_V(0);
    if constexpr (!ALIGN_EPI) { if (wr == 0) PG8_BAR; }
    PG8_BAR;
    if constexpr (Epi::AFTER_DRAIN) { E.fused(acc, cur, wr, wc, fr, fq, lds, wid, lane); PG8_WAIT_L(0); PG8_BAR; }
#undef PG8_SA
#undef PG8_SB
#undef PG8_STAGE
#undef PG8_LDA
#undef PG8_LDB
#undef PG8_MMA
#undef PG8_WAIT_V
#undef PG8_WAIT_L
#undef PG8_BAR
#undef PG8_SCHED
}
}

namespace attn_body {
using bf16 = bf16_t;
using bf16x8 = __attribute__((ext_vector_type(8))) short;
using s16x4 = __attribute__((ext_vector_type(4))) short;
using f32x16 = __attribute__((ext_vector_type(16))) float;
using u32x4 = __attribute__((ext_vector_type(4))) unsigned;
constexpr int SEQ = SEQL, D = 64, DMA = 1024;
constexpr int NW = 8, QBLK = 32, QB = QBLK * NW, KVBLK = 64, NQB = SEQ / QB;
__device__ __forceinline__ int crow(int r, int hi) { return (r & 3) + 8 * (r >> 2) + 4 * hi; }
#define SBAR() __builtin_amdgcn_sched_barrier(0)
__device__ __forceinline__ void cmask(f32x16& p0, f32x16& p1, int jb, int qrel, int hi) {
  const float NEG = -INFINITY; int kb = 64 * jb + 4 * hi;
  #pragma unroll
  for (int r = 0; r < 16; ++r) { int kv = kb + (r & 3) + 8 * (r >> 2); if (kv > qrel) p0[r] = NEG; if (kv + 32 > qrel) p1[r] = NEG; }
}
constexpr int NSLOT = 3, SLOTB = 8192;
constexpr int LDS_K = 0, LDS_V = NSLOT * SLOTB, LDS_WS = 2 * NSLOT * SLOTB, LDS_OST = LDS_WS + NW * 64 * 4, LDS_BYTES = LDS_OST + NW * 4096;
__device__ __forceinline__ void glds16(const void* gsrc, unsigned lds_dst) { unsigned keep;
  asm volatile("s_mov_b32 %0, m0\n\ts_mov_b32 m0, %2\n\ts_nop 0\n\tglobal_load_lds_dwordx4 %1, off\n\ts_mov_b32 m0, %0" : "=&s"(keep) : "v"(gsrc), "s"(lds_dst) : "memory"); }
__device__ __forceinline__ float max3f(float a, float b, float c) { float r; asm("v_max3_f32 %0, %1, %2, %3" : "=v"(r) : "v"(a), "v"(b), "v"(c)); return r; }
__device__ __forceinline__ float max2f(float a, float b) { float r; asm("v_max_f32_e32 %0, %1, %2" : "=v"(r) : "v"(a), "v"(b)); return r; }
__device__ __forceinline__ float fadd_s(float a, float b) { float r; asm("v_add_f32_e32 %0, %1, %2" : "=v"(r) : "v"(a), "v"(b)); return r; }
__device__ __forceinline__ float fsub_s(float a, float b) { float r; asm("v_sub_f32_e32 %0, %1, %2" : "=v"(r) : "v"(a), "v"(b)); return r; }
typedef float f32x2_t __attribute__((ext_vector_type(2))); typedef __bf16 bf16x2_t __attribute__((ext_vector_type(2)));
__device__ __forceinline__ unsigned cvtpk_s(float lo, float hi) { f32x2_t v = {lo, hi}; bf16x2_t b = __builtin_convertvector(v, bf16x2_t); return __builtin_bit_cast(unsigned, b); }
#define WAIT_BAR(N) asm volatile("s_waitcnt vmcnt(" #N ") lgkmcnt(0)\n\ts_barrier" ::: "memory")

__device__ __forceinline__ void qkt(f32x16& p0, f32x16& p1, const char* Kslot, const bf16x8* qr, const f32x16& negm, int r32, int hi) {
  const char* kb = Kslot + hi * 1024 + r32 * 16;
  #pragma unroll
  for (int d0 = 0; d0 < 4; ++d0) {
    const bf16x8 b0 = *reinterpret_cast<const bf16x8*>(kb + d0 * 2048);
    const bf16x8 b1 = *reinterpret_cast<const bf16x8*>(kb + d0 * 2048 + 512);
    if (d0 == 0) { p0 = __builtin_amdgcn_mfma_f32_32x32x16_bf16(b0, qr[0], negm, 0, 0, 0); p1 = __builtin_amdgcn_mfma_f32_32x32x16_bf16(b1, qr[0], negm, 0, 0, 0); }
    else { p0 = __builtin_amdgcn_mfma_f32_32x32x16_bf16(b0, qr[d0], p0, 0, 0, 0); p1 = __builtin_amdgcn_mfma_f32_32x32x16_bf16(b1, qr[d0], p1, 0, 0, 0); } }
}
typedef __attribute__((address_space(3))) const char* lds_cptr;
typedef short v4i16_t __attribute__((ext_vector_type(4)));
__device__ __forceinline__ void kload8(bf16x8* kf, lds_cptr kp) {
  kf[0] = *(const __attribute__((address_space(3))) bf16x8*)(kp);        kf[1] = *(const __attribute__((address_space(3))) bf16x8*)(kp + 512);
  kf[2] = *(const __attribute__((address_space(3))) bf16x8*)(kp + 2048); kf[3] = *(const __attribute__((address_space(3))) bf16x8*)(kp + 2560);
  kf[4] = *(const __attribute__((address_space(3))) bf16x8*)(kp + 4096); kf[5] = *(const __attribute__((address_space(3))) bf16x8*)(kp + 4608);
  kf[6] = *(const __attribute__((address_space(3))) bf16x8*)(kp + 6144); kf[7] = *(const __attribute__((address_space(3))) bf16x8*)(kp + 6656);
}
__device__ __forceinline__ void kload2(bf16x8* kf, lds_cptr kp, int j) { kf[2 * j] = *(const __attribute__((address_space(3))) bf16x8*)(kp + j * 2048); kf[2 * j + 1] = *(const __attribute__((address_space(3))) bf16x8*)(kp + j * 2048 + 512); }
__device__ __forceinline__ s16x4 vtr(lds_cptr p) { return __builtin_bit_cast(s16x4, __builtin_amdgcn_ds_read_tr16_b64_v4i16((__attribute__((address_space(3))) v4i16_t*)p)); }
__device__ __forceinline__ float rowmax(const f32x16& p0, const f32x16& p1) {
  float a = max3f(p0[0], p0[1], p1[0]), b = max3f(p0[2], p0[3], p1[1]); a = max3f(a, p1[2], p1[3]);
  #pragma unroll
  for (int r = 4; r < 16; r += 4) { a = max3f(a, p0[r], p0[r + 1]); b = max3f(b, p0[r + 2], p0[r + 3]); a = max3f(a, p1[r], p1[r + 1]); b = max3f(b, p1[r + 2], p1[r + 3]); }
  const float m = max2f(a, b);
  auto rr = __builtin_amdgcn_permlane32_swap(__float_as_uint(m), __float_as_uint(m), false, false);
  return max2f(__uint_as_float(rr[0]), __uint_as_float(rr[1]));
}
__device__ __forceinline__ void pv(f32x16* o, int vb, bf16x8 pa0, bf16x8 pa1, bf16x8 pa2, bf16x8 pa3) {
  #pragma unroll
  for (int d0 = 0; d0 < 2; ++d0) { s16x4 lo[4], hi[4];
    #pragma unroll
    for (int ks = 0; ks < 4; ++ks) {
      asm volatile("ds_read_b64_tr_b16 %0,%1 offset:%c2" : "=&v"(lo[ks]) : "v"(vb), "i"(d0 * 4096 + ks * 1024) : "memory");
      asm volatile("ds_read_b64_tr_b16 %0,%1 offset:%c2" : "=&v"(hi[ks]) : "v"(vb), "i"(d0 * 4096 + ks * 1024 + 512) : "memory"); }
    asm volatile("s_waitcnt lgkmcnt(0)" ::: "memory"); SBAR();
    #define PK(k) (bf16x8){lo[k][0], lo[k][1], lo[k][2], lo[k][3], hi[k][0], hi[k][1], hi[k][2], hi[k][3]}
    o[d0] = __builtin_amdgcn_mfma_f32_32x32x16_bf16(pa0, PK(0), o[d0], 0, 0, 0);
    o[d0] = __builtin_amdgcn_mfma_f32_32x32x16_bf16(pa1, PK(1), o[d0], 0, 0, 0);
    o[d0] = __builtin_amdgcn_mfma_f32_32x32x16_bf16(pa2, PK(2), o[d0], 0, 0, 0);
    o[d0] = __builtin_amdgcn_mfma_f32_32x32x16_bf16(pa3, PK(3), o[d0], 0, 0, 0);
    #undef PK
  }
}
#define ATTN_STORE16(p, v) (*(u32x4*)(p) = (v))
template <int THRL> __device__ __forceinline__ void attn_unit(int tid_in, int b, int hq, int hv, int qb, const bf16* Q, const bf16* __restrict__ K, const bf16* __restrict__ V, bf16* O, char* shm) {
  const int tid = tid_in, lane = tid & 63, r32 = lane & 31, hi = lane >> 5; const int wid = __builtin_amdgcn_readfirstlane(tid >> 6);
  const long rowbase = (long)b * SEQ; const int q0 = qb * QB;
  const bf16* Qw = Q + (rowbase + q0 + wid * QBLK) * DMA + hq * D;
  const bf16* Kh = K + rowbase * DMA + hq * D, *Vh = V + rowbase * DMA + hv * D;
  const unsigned lds0 = (unsigned)(uintptr_t)shm;
  float* wsf = (float*)(shm + LDS_WS) + wid * 64;
  const bf16* ksrc = Kh + (long)lane * DMA + wid * 8;
  const bf16* vsrc = Vh + (long)(16 * (wid & 3) + (lane >> 2)) * DMA + (wid >> 2) * 32 + (lane & 3) * 8;
  const unsigned kdst = lds0 + LDS_K + wid * 1024, vdst = lds0 + LDS_V + wid * 1024;
  #define DMA_K(t, slot) glds16(ksrc + (long)(t) * KVBLK * DMA, (unsigned)__builtin_amdgcn_readfirstlane(kdst + (slot)))
  #define DMA_V(t, slot) glds16(vsrc + (long)(t) * KVBLK * DMA, (unsigned)__builtin_amdgcn_readfirstlane(vdst + (slot)))
  const int vb0 = (int)(lds0 + LDS_V) + ((lane >> 4) & 1) * 32 + (lane & 3) * 8 + (4 * hi + ((lane & 15) >> 2)) * 64;
  const char* Kbase = shm + LDS_K; bf16x8 kf[8];
  const lds_cptr shm3 = (lds_cptr)shm; const lds_cptr kp0 = shm3 + LDS_K + hi * 1024 + r32 * 16; const lds_cptr vp0 = shm3 + LDS_V + ((lane >> 4) & 1) * 32 + (lane & 3) * 8 + (4 * hi + ((lane & 15) >> 2)) * 64;
  const int NT = (q0 + QB) / KVBLK;
  DMA_K(0, 0); DMA_V(0, 0); DMA_K(1, SLOTB);
  bf16x8 qr[4];
  #pragma unroll
  for (int d0 = 0; d0 < 4; ++d0) qr[d0] = *reinterpret_cast<const bf16x8*>(&Qw[(long)r32 * DMA + d0 * 16 + hi * 8]);
  float mhat = 0.f, l_reg = 0.f; f32x16 o[2]; o[0] = f32x16{}; o[1] = f32x16{}; f32x16 negm = f32x16{}; asm volatile("" : "+v"(negm));
  const int qrel = wid * QBLK + r32;
  #define CMASK(P0, P1, t) do { int jb_ = (t) - (NT - 4); if (jb_ >= 0) cmask(P0, P1, jb_, qrel, hi); } while (0)
  bool resc = false;
  #define START(P0, P1) do { const float rm = rowmax(P0, P1); resc = false; \
    { const float dl = rm; mhat = fadd_s(mhat, dl); \
      _Pragma("unroll") for (int r = 0; r < 16; ++r) { P0[r] = fsub_s(P0[r], dl); P1[r] = fsub_s(P1[r], dl); } \
      _Pragma("unroll") for (int r = 0; r < 16; ++r) negm[r] = -mhat; asm volatile("" : "+v"(negm)); } \
    _Pragma("unroll") for (int r = 0; r < 16; ++r) P0[r] = __builtin_amdgcn_exp2f(P0[r]); } while (0)
  #define RESC() do { if (resc) { asm volatile("s_waitcnt lgkmcnt(0)" ::: "memory"); \
      _Pragma("unroll") for (int d_ = 0; d_ < 2; ++d_) _Pragma("unroll") for (int r = 0; r < 16; ++r) o[d_][r] *= wsf[crow(r, hi)]; } } while (0)
  f32x16 pA0, pA1, pB0, pB1;
  int sl_prev = 0, sl_cur = 0, sl_next = SLOTB;
  #define ROT() do { sl_prev = sl_cur; sl_cur = sl_next; sl_next = (sl_next == (NSLOT - 1) * SLOTB) ? 0 : sl_next + SLOTB; } while (0)
  DMA_K(2, 2 * SLOTB);
  WAIT_BAR(3);
  qkt(pA0, pA1, Kbase, qr, negm, r32, hi); asm volatile("s_nop 15\n\ts_nop 7" : "+v"(pA0), "+v"(pA1)); CMASK(pA0, pA1, 0);
  START(pA0, pA1);
  _Pragma("unroll") for (int r = 0; r < 16; ++r) pA1[r] = __builtin_amdgcn_exp2f(pA1[r]);
  WAIT_BAR(0);
  DMA_K(3, 0); DMA_V(1, SLOTB);
  ROT();
  kload8(kf, kp0 + sl_cur);
  WAIT_BAR(2);
  s16x4 vlo[8], vhi[8]; u32x4 pw0, pw1, pw2, pw3;
  #define PKW(P, B) cvtpk_s(P[B], P[B + 1])
  #define PAF(k) __builtin_bit_cast(bf16x8, pw##k)
  #define VFR(i) (bf16x8){vlo[i][0], vlo[i][1], vlo[i][2], vlo[i][3], vhi[i][0], vhi[i][1], vhi[i][2], vhi[i][3]}
  #define PIN(x) asm volatile("" : "+v"(x))
  #define MX3(a, b, c) __builtin_fmaxf(__builtin_fmaxf((a), (b)), (c))
  #define GAPA(MF, A0, A1, A2, A3, W0, W1, PW) do { MF; sacc += A0; sacc += A1; sacc += A2; sacc += A3; PIN(sacc); W0; W1; PIN(PW); SBAR(); } while (0)
  #define EX(v) __builtin_amdgcn_exp2f(v)
  #define GAPB(MF, X, B) do { MF; X[B] = EX(X[B]); X[B + 1] = EX(X[B + 1]); X[B + 2] = EX(X[B + 2]); X[B + 3] = EX(X[B + 3]); PIN(X); SBAR(); } while (0)
  #define VRD(i) do { vlo[i] = vtr(vp_ + (((i) >> 2) * 4096 + ((i) & 3) * 1024)); vhi[i] = vtr(vp_ + (((i) >> 2) * 4096 + ((i) & 3) * 1024 + 512)); } while (0)
  #define KRD(G, j) do { if (G) { kload2(kf, kp0 + sl_next, j); SBAR(); } } while (0)
  #define STEP(C0, C1, P0, P1, t, GK, GV, GL) do { SBAR(); \
    const lds_cptr vp_ = vp0 + sl_prev; \
    VRD(0); SBAR(); float sacc = (P0[0] + P0[1]); \
    GAPA(C0 = __builtin_amdgcn_mfma_f32_32x32x16_bf16(kf[0], qr[0], negm, 0, 0, 0), P0[2], P0[3], P0[4], P0[5],     pw0[0] = PKW(P0, 0), pw0[1] = PKW(P0, 2), pw0); \
    VRD(4); SBAR(); GAPA(C1 = __builtin_amdgcn_mfma_f32_32x32x16_bf16(kf[1], qr[0], negm, 0, 0, 0), P0[6], P0[7], P0[8], P0[9],     pw0[2] = PKW(P0, 4), pw0[3] = PKW(P0, 6), pw0); \
    VRD(1); SBAR(); GAPA(C0 = __builtin_amdgcn_mfma_f32_32x32x16_bf16(kf[2], qr[1], C0, 0, 0, 0),   P0[10], P0[11], P0[12], P0[13], pw1[0] = PKW(P0, 8), pw1[1] = PKW(P0, 10), pw1); \
    VRD(5); SBAR(); GAPA(C1 = __builtin_amdgcn_mfma_f32_32x32x16_bf16(kf[3], qr[1], C1, 0, 0, 0),   P0[14], P0[15], P1[0], P1[1],   pw1[2] = PKW(P0, 12), pw1[3] = PKW(P0, 14), pw1); \
    VRD(2); SBAR(); GAPA(C0 = __builtin_amdgcn_mfma_f32_32x32x16_bf16(kf[4], qr[2], C0, 0, 0, 0),   P1[2], P1[3], P1[4], P1[5],     pw2[0] = PKW(P1, 0), pw2[1] = PKW(P1, 2), pw2); \
    VRD(6); SBAR(); GAPA(C1 = __builtin_amdgcn_mfma_f32_32x32x16_bf16(kf[5], qr[2], C1, 0, 0, 0),   P1[6], P1[7], P1[8], P1[9],     pw2[2] = PKW(P1, 4), pw2[3] = PKW(P1, 6), pw2); \
    VRD(3); SBAR(); GAPA(C0 = __builtin_amdgcn_mfma_f32_32x32x16_bf16(kf[6], qr[3], C0, 0, 0, 0),   P1[10], P1[11], P1[12], P1[13], pw3[0] = PKW(P1, 8), pw3[1] = PKW(P1, 10), pw3); \
    VRD(7); SBAR(); GAPA(C1 = __builtin_amdgcn_mfma_f32_32x32x16_bf16(kf[7], qr[3], C1, 0, 0, 0),   P1[14], P1[15], 0.f, 0.f,       pw3[2] = PKW(P1, 12), pw3[3] = PKW(P1, 14), pw3); \
    l_reg += sacc; \
    if (GK) { DMA_K((t) + 3, sl_cur); } if (GV) { DMA_V((t) + 1, sl_next); } \
    CMASK(C0, C1, t); \
    { float a = MX3(C0[0], C0[1], C1[0]), b = MX3(C0[2], C0[3], C1[1]); a = MX3(a, C1[2], C1[3]); \
      _Pragma("unroll") for (int r = 4; r < 16; r += 4) { a = MX3(a, C0[r], C0[r + 1]); b = MX3(b, C0[r + 2], C0[r + 3]); a = MX3(a, C1[r], C1[r + 1]); b = MX3(b, C1[r + 2], C1[r + 3]); } \
      float rm = __builtin_fmaxf(a, b); { auto rr = __builtin_amdgcn_permlane32_swap(__float_as_uint(rm), __float_as_uint(rm), false, false); rm = __builtin_fmaxf(__uint_as_float(rr[0]), __uint_as_float(rr[1])); } \
      resc = false; \
      if (__builtin_expect(__any(rm > (float)THRL), 0)) { const float dl = __builtin_fmaxf(rm, 0.f); mhat += dl; \
        _Pragma("unroll") for (int r = 0; r < 16; ++r) { C0[r] -= dl; C1[r] -= dl; } \
        _Pragma("unroll") for (int r = 0; r < 16; ++r) negm[r] = -mhat; asm volatile("" : "+v"(negm)); \
        const float f = __builtin_amdgcn_exp2f(-dl); l_reg *= f; if (hi == 0) wsf[r32] = f; resc = true; } } \
    SBAR(); \
    GAPB(o[0] = __builtin_amdgcn_mfma_f32_32x32x16_bf16(PAF(0), VFR(0), o[0], 0, 0, 0), C0, 0); \
    GAPB(o[1] = __builtin_amdgcn_mfma_f32_32x32x16_bf16(PAF(0), VFR(4), o[1], 0, 0, 0), C0, 4); \
    KRD(GL, 0); GAPB(o[0] = __builtin_amdgcn_mfma_f32_32x32x16_bf16(PAF(1), VFR(1), o[0], 0, 0, 0), C0, 8); \
    KRD(GL, 1); GAPB(o[1] = __builtin_amdgcn_mfma_f32_32x32x16_bf16(PAF(1), VFR(5), o[1], 0, 0, 0), C0, 12); \
    KRD(GL, 2); GAPB(o[0] = __builtin_amdgcn_mfma_f32_32x32x16_bf16(PAF(2), VFR(2), o[0], 0, 0, 0), C1, 0); \
    KRD(GL, 3); GAPB(o[1] = __builtin_amdgcn_mfma_f32_32x32x16_bf16(PAF(2), VFR(6), o[1], 0, 0, 0), C1, 4); \
    GAPB(o[0] = __builtin_amdgcn_mfma_f32_32x32x16_bf16(PAF(3), VFR(3), o[0], 0, 0, 0), C1, 8); \
    GAPB(o[1] = __builtin_amdgcn_mfma_f32_32x32x16_bf16(PAF(3), VFR(7), o[1], 0, 0, 0), C1, 12); \
    } while (0)
  int t = 1;
  #undef CMASK
  #define CMASK(P0, P1, t) do {} while (0)
  for (; t + 5 < NT; t += 2) {
    STEP(pB0, pB1, pA0, pA1, t, true, true, true);     WAIT_BAR(2); RESC(); ROT();
    STEP(pA0, pA1, pB0, pB1, t + 1, true, true, true); WAIT_BAR(2); RESC(); ROT();
  }
  #undef CMASK
  #define CMASK(P0, P1, t) do { int jb_ = (t) - (NT - 4); if (jb_ >= 0) cmask(P0, P1, jb_, qrel, hi); } while (0)
  #define ENDW(tt) do { if ((tt) + 3 < NT) { WAIT_BAR(2); } else if ((tt) + 2 < NT) { WAIT_BAR(1); } else { WAIT_BAR(0); } } while (0)
  for (; t + 1 < NT; t += 2) {
    STEP(pB0, pB1, pA0, pA1, t, (t + 3 < NT), (t + 1 < NT), (t + 1 < NT));         ENDW(t);     RESC(); ROT();
    STEP(pA0, pA1, pB0, pB1, t + 1, (t + 4 < NT), (t + 2 < NT), (t + 2 < NT));     ENDW(t + 1); RESC(); ROT();
  }
  STEP(pB0, pB1, pA0, pA1, NT - 1, false, false, false); RESC();
  { float sacc = pB0[0] + pB0[1]; _Pragma("unroll") for (int r = 2; r < 16; ++r) sacc += pB0[r]; _Pragma("unroll") for (int r = 0; r < 16; ++r) sacc += pB1[r]; l_reg += sacc;
    pw0 = (u32x4){PKW(pB0, 0), PKW(pB0, 2), PKW(pB0, 4), PKW(pB0, 6)}; pw1 = (u32x4){PKW(pB0, 8), PKW(pB0, 10), PKW(pB0, 12), PKW(pB0, 14)}; pw2 = (u32x4){PKW(pB1, 0), PKW(pB1, 2), PKW(pB1, 4), PKW(pB1, 6)}; pw3 = (u32x4){PKW(pB1, 8), PKW(pB1, 10), PKW(pB1, 12), PKW(pB1, 14)};
    SBAR(); pv(o, vb0 + sl_cur, PAF(0), PAF(1), PAF(2), PAF(3)); }
  #undef PKW
  #undef PAF
  #undef VFR
  #undef PIN
  #undef MX3
  #undef GAPA
  #undef GAPB
  #undef EX
  #undef VRD
  #undef KRD
  #undef STEP
  #undef ENDW
  { auto rr = __builtin_amdgcn_permlane32_swap(__float_as_uint(l_reg), __float_as_uint(l_reg), false, false); l_reg = __uint_as_float(rr[0]) + __uint_as_float(rr[1]); }
  if (hi == 0) wsf[32 + r32] = l_reg; asm volatile("s_waitcnt lgkmcnt(0)" ::: "memory");
  float rli[16];
  #pragma unroll
  for (int r = 0; r < 16; ++r) rli[r] = __builtin_amdgcn_rcpf(wsf[32 + crow(r, hi)]);
  bf16* Ow = O + (rowbase + q0 + wid * QBLK) * DMA + hv * D;
  { bf16* stg = (bf16*)(shm + LDS_OST) + wid * 2048;
    #pragma unroll
    for (int r = 0; r < 16; ++r) { const int orow = crow(r, hi);
      #pragma unroll
      for (int d0 = 0; d0 < 2; ++d0) stg[orow * 64 + d0 * 32 + r32] = f2bf(o[d0][r] * rli[r]); }
    asm volatile("s_waitcnt lgkmcnt(0)" ::: "memory");
    #pragma unroll
    for (int i = 0; i < 4; ++i) { const int row = i * 8 + (lane >> 3), ch = lane & 7; const u32x4 v = *(const u32x4*)(stg + row * 64 + ch * 8); ATTN_STORE16(Ow + (long)row * DMA + ch * 8, v); } }
  asm volatile("s_waitcnt lgkmcnt(0)\n\ts_barrier" ::: "memory");
  #undef DMA_K
  #undef DMA_V
  #undef CMASK
  #undef START
  #undef RESC
  #undef ROT
}
constexpr int ATTN_LDS_BYTES = LDS_BYTES;
#undef SBAR
#undef WAIT_BAR
}

namespace attn3 {
using namespace attn_body;
constexpr int KSLOT = 8192, VSLOT = 16384;
constexpr int L_K = 0, L_V = NSLOT * KSLOT, L_WS = L_V + NSLOT * VSLOT, L_OST = L_WS + NW * 64 * 4, L_BYTES = L_OST + NW * 4096;
#define SBAR() __builtin_amdgcn_sched_barrier(0)
#define WAIT_BAR(N) asm volatile("s_waitcnt vmcnt(" #N ") lgkmcnt(0)\n\ts_barrier" ::: "memory")
template <int THRL> __device__ __forceinline__ void attn_unit(int tid_in, int b, int hq, int h, int qb, const bf16* Q, const bf16* __restrict__ K, const bf16* __restrict__ V, bf16* O, char* shm,
                                                             int mode, const bf16* SZ1, const float* g_sub, float lam, bf16* OG,
                                                             bool primed, bool has_next, int nb, int nhq, int nh, int nqb, bf16x8 (&qr)[4]) {
  int tid_ = tid_in; asm volatile("" : "+v"(tid_));
  const int tid = tid_, lane = tid & 63, r32 = lane & 31, hi = lane >> 5; const int wid = __builtin_amdgcn_readfirstlane(tid >> 6);
  const long rowbase = (long)b * SEQ; const int q0 = qb * QB;
  const bf16* Qw = Q + (rowbase + q0 + wid * QBLK) * DMA + hq * D;
  const bf16* Kh = K + rowbase * DMA + hq * D, *Vh = V + rowbase * DMA + h * 128;
  const unsigned lds0 = (unsigned)(uintptr_t)shm;
  float* wsf = (float*)(shm + L_WS) + wid * 64;
  const bf16* ksrc = Kh + (long)lane * DMA + wid * 8;
  const bf16* vsrc = Vh + (long)(16 * (wid & 3) + (lane >> 2)) * DMA + (wid >> 2) * 32 + (lane & 3) * 8;
  const unsigned kdst = lds0 + L_K + wid * 1024, vdst = lds0 + L_V + wid * 1024;
  #define DMA_K(t, si) glds16(ksrc + (long)(t) * KVBLK * DMA, (unsigned)__builtin_amdgcn_readfirstlane(kdst + (si) * KSLOT))
  #define DMA_V(t, si) do { glds16(vsrc + (long)(t) * KVBLK * DMA, (unsigned)__builtin_amdgcn_readfirstlane(vdst + (si) * VSLOT)); \
                            glds16(vsrc + (long)(t) * KVBLK * DMA + 64, (unsigned)__builtin_amdgcn_readfirstlane(vdst + (si) * VSLOT + 8192)); } while (0)
  const int vb0 = (int)(lds0 + L_V) + ((lane >> 4) & 1) * 32 + (lane & 3) * 8 + (4 * hi + ((lane & 15) >> 2)) * 64;
  const char* Kbase = shm + L_K; bf16x8 kf[8];
  const lds_cptr shm3 = (lds_cptr)shm; const lds_cptr kp0 = shm3 + L_K + hi * 1024 + r32 * 16; const lds_cptr vp0 = shm3 + L_V + ((lane >> 4) & 1) * 32 + (lane & 3) * 8 + (4 * hi + ((lane & 15) >> 2)) * 64;
  const int NT = (q0 + QB) / KVBLK;
  if (!primed) { DMA_K(0, 0); DMA_V(0, 0); DMA_K(1, 1);
    #pragma unroll
    for (int d0 = 0; d0 < 4; ++d0) qr[d0] = *reinterpret_cast<const bf16x8*>(&Qw[(long)r32 * DMA + d0 * 16 + hi * 8]); }
  float mhat = 0.f, l_reg = 0.f; f32x16 o[4]; f32x16 negm;
  { float zf = 0.f; asm volatile("" : "+v"(zf));
    _Pragma("unroll") for (int r = 0; r < 16; ++r) { o[0][r] = zf; o[1][r] = zf; o[2][r] = zf; o[3][r] = zf; negm[r] = zf; } }
  asm volatile("" : "+v"(negm));
  const int qrel = wid * QBLK + r32;
  #define CMASK(P0, P1, t) do { int jb_ = (t) - (NT - 4); if (jb_ >= 0) cmask(P0, P1, jb_, qrel, hi); } while (0)
  bool resc = false;
  #define RESC() do { if (resc) { asm volatile("s_waitcnt lgkmcnt(0)" ::: "memory"); \
      _Pragma("unroll") for (int d_ = 0; d_ < 4; ++d_) _Pragma("unroll") for (int r = 0; r < 16; ++r) o[d_][r] *= wsf[crow(r, hi)]; } } while (0)
  f32x16 C0, C1;
  int s_prev = 0, s_cur = 0, s_next = 1;
  #define ROT() do { s_prev = s_cur; s_cur = s_next; s_next = (s_next == NSLOT - 1) ? 0 : s_next + 1; } while (0)
  if (!primed) { DMA_K(2, 2); WAIT_BAR(4); }
  else { WAIT_BAR(0); }
  u32x4 pwA0, pwA1, pwA2, pwA3, pwB0, pwB1, pwB2, pwB3;
  #define PKW(P, B) cvtpk_s(P[B], P[B + 1])
  qkt(C0, C1, Kbase, qr, negm, r32, hi); asm volatile("s_nop 15\n\ts_nop 7" : "+v"(C0), "+v"(C1)); CMASK(C0, C1, 0);
  { const float rm = rowmax(C0, C1); mhat = fadd_s(mhat, rm);
    _Pragma("unroll") for (int r = 0; r < 16; ++r) { C0[r] = fsub_s(C0[r], rm); C1[r] = fsub_s(C1[r], rm); }
    _Pragma("unroll") for (int r = 0; r < 16; ++r) negm[r] = -mhat; asm volatile("" : "+v"(negm));
    float sacc = 0.f;
    _Pragma("unroll") for (int r = 0; r < 16; ++r) { C0[r] = __builtin_amdgcn_exp2f(C0[r]); C1[r] = __builtin_amdgcn_exp2f(C1[r]); }
    _Pragma("unroll") for (int r = 0; r < 16; ++r) sacc += C0[r] + C1[r];
    l_reg = sacc;
    pwA0 = (u32x4){PKW(C0, 0), PKW(C0, 2), PKW(C0, 4), PKW(C0, 6)}; pwA1 = (u32x4){PKW(C0, 8), PKW(C0, 10), PKW(C0, 12), PKW(C0, 14)};
    pwA2 = (u32x4){PKW(C1, 0), PKW(C1, 2), PKW(C1, 4), PKW(C1, 6)}; pwA3 = (u32x4){PKW(C1, 8), PKW(C1, 10), PKW(C1, 12), PKW(C1, 14)}; }
  WAIT_BAR(0);
  DMA_K(3, 0); DMA_V(1, 1);
  ROT();
  kload8(kf, kp0 + s_cur * KSLOT);
  WAIT_BAR(3);
  s16x4 vlo[8], vhi[8];
  #define PAF(w) __builtin_bit_cast(bf16x8, w)
  #define VFR(i) (bf16x8){vlo[i][0], vlo[i][1], vlo[i][2], vlo[i][3], vhi[i][0], vhi[i][1], vhi[i][2], vhi[i][3]}
  #define PIN(x) asm volatile("" : "+v"(x))
  #define MX3(a, b, c) __builtin_fmaxf(__builtin_fmaxf((a), (b)), (c))
  #define EX(v) __builtin_amdgcn_exp2f(v)
  #define VRD(s, f) do { vlo[s] = vtr(vp_ + (((f) >> 2) * 4096 + ((f) & 3) * 1024)); vhi[s] = vtr(vp_ + (((f) >> 2) * 4096 + ((f) & 3) * 1024 + 512)); } while (0)
  #define KRD(G, j) do { if (G) { kload2(kf, kp0 + s_next * KSLOT, j); SBAR(); } } while (0)
  #define GAPB(MF, X, B, PWW) do { MF; X[B] = EX(X[B]); X[B + 1] = EX(X[B + 1]); sacc += X[B]; sacc += X[B + 1]; PIN(sacc); PWW = PKW(X, B); PIN(PWW); SBAR(); } while (0)
  #define MFQ(a, b, c) __builtin_amdgcn_mfma_f32_32x32x16_bf16(a, b, c, 0, 0, 0)
  #define STEP(PP0, PP1, PP2, PP3, PN0, PN1, PN2, PN3, t, GK, GV, GL) do { SBAR(); \
    const lds_cptr vp_ = vp0 + s_prev * VSLOT; \
    VRD(0, 0); SBAR(); C0 = MFQ(kf[0], qr[0], negm); SBAR(); \
    VRD(4, 4); SBAR(); C1 = MFQ(kf[1], qr[0], negm); SBAR(); \
    VRD(1, 1); SBAR(); C0 = MFQ(kf[2], qr[1], C0); SBAR(); \
    VRD(5, 5); SBAR(); C1 = MFQ(kf[3], qr[1], C1); SBAR(); \
    VRD(2, 2); SBAR(); C0 = MFQ(kf[4], qr[2], C0); SBAR(); \
    VRD(6, 6); SBAR(); C1 = MFQ(kf[5], qr[2], C1); SBAR(); \
    VRD(3, 3); SBAR(); C0 = MFQ(kf[6], qr[3], C0); SBAR(); \
    VRD(7, 7); SBAR(); C1 = MFQ(kf[7], qr[3], C1); SBAR(); \
    if (GK) { DMA_K((t) + 3, s_cur); } if (GV) { DMA_V((t) + 1, s_next); } \
    CMASK(C0, C1, t); \
    { float a = MX3(C0[0], C0[1], C1[0]), b = MX3(C0[2], C0[3], C1[1]); a = MX3(a, C1[2], C1[3]); \
      _Pragma("unroll") for (int r = 4; r < 16; r += 4) { a = MX3(a, C0[r], C0[r + 1]); b = MX3(b, C0[r + 2], C0[r + 3]); a = MX3(a, C1[r], C1[r + 1]); b = MX3(b, C1[r + 2], C1[r + 3]); } \
      float rm = __builtin_fmaxf(a, b); { auto rr = __builtin_amdgcn_permlane32_swap(__float_as_uint(rm), __float_as_uint(rm), false, false); rm = __builtin_fmaxf(__uint_as_float(rr[0]), __uint_as_float(rr[1])); } \
      resc = false; \
      if (__builtin_expect(__any(rm > (float)THRL), 0)) { const float dl = __builtin_fmaxf(rm, 0.f); mhat += dl; \
        _Pragma("unroll") for (int r = 0; r < 16; ++r) { C0[r] -= dl; C1[r] -= dl; } \
        _Pragma("unroll") for (int r = 0; r < 16; ++r) negm[r] = -mhat; asm volatile("" : "+v"(negm)); \
        const float f = __builtin_amdgcn_exp2f(-dl); l_reg *= f; if (hi == 0) wsf[r32] = f; resc = true; } } \
    SBAR(); float sacc = 0.f; \
    GAPB(o[0] = MFQ(PAF(PP0), VFR(0), o[0]), C0, 0,  PN0[0]); VRD(0, 8);  SBAR(); \
    GAPB(o[1] = MFQ(PAF(PP0), VFR(4), o[1]), C0, 2,  PN0[1]); VRD(4, 12); SBAR(); \
    GAPB(o[0] = MFQ(PAF(PP1), VFR(1), o[0]), C0, 4,  PN0[2]); VRD(1, 9);  SBAR(); \
    GAPB(o[1] = MFQ(PAF(PP1), VFR(5), o[1]), C0, 6,  PN0[3]); VRD(5, 13); SBAR(); \
    GAPB(o[0] = MFQ(PAF(PP2), VFR(2), o[0]), C0, 8,  PN1[0]); VRD(2, 10); SBAR(); \
    GAPB(o[1] = MFQ(PAF(PP2), VFR(6), o[1]), C0, 10, PN1[1]); VRD(6, 14); SBAR(); \
    GAPB(o[0] = MFQ(PAF(PP3), VFR(3), o[0]), C0, 12, PN1[2]); VRD(3, 11); SBAR(); \
    GAPB(o[1] = MFQ(PAF(PP3), VFR(7), o[1]), C0, 14, PN1[3]); VRD(7, 15); SBAR(); \
    GAPB(o[2] = MFQ(PAF(PP0), VFR(0), o[2]), C1, 0,  PN2[0]); \
    GAPB(o[3] = MFQ(PAF(PP0), VFR(4), o[3]), C1, 2,  PN2[1]); \
    KRD(GL, 0); GAPB(o[2] = MFQ(PAF(PP1), VFR(1), o[2]), C1, 4,  PN2[2]); \
    KRD(GL, 1); GAPB(o[3] = MFQ(PAF(PP1), VFR(5), o[3]), C1, 6,  PN2[3]); \
    KRD(GL, 2); GAPB(o[2] = MFQ(PAF(PP2), VFR(2), o[2]), C1, 8,  PN3[0]); \
    KRD(GL, 3); GAPB(o[3] = MFQ(PAF(PP2), VFR(6), o[3]), C1, 10, PN3[1]); \
    GAPB(o[2] = MFQ(PAF(PP3), VFR(3), o[2]), C1, 12, PN3[2]); \
    GAPB(o[3] = MFQ(PAF(PP3), VFR(7), o[3]), C1, 14, PN3[3]); \
    l_reg += sacc; \
    } while (0)
  #define STEP_AB(t, GK, GV, GL) STEP(pwA0, pwA1, pwA2, pwA3, pwB0, pwB1, pwB2, pwB3, t, GK, GV, GL)
  #define STEP_BA(t, GK, GV, GL) STEP(pwB0, pwB1, pwB2, pwB3, pwA0, pwA1, pwA2, pwA3, t, GK, GV, GL)
  int t = 1;
  #undef CMASK
  #define CMASK(P0, P1, t) do {} while (0)
  for (; t + 5 < NT; t += 2) {
    STEP_AB(t, true, true, true);     WAIT_BAR(3); RESC(); ROT();
    STEP_BA(t + 1, true, true, true); WAIT_BAR(3); RESC(); ROT();
  }
  #undef CMASK
  #define CMASK(P0, P1, t) do { int jb_ = (t) - (NT - 4); if (jb_ >= 0) cmask(P0, P1, jb_, qrel, hi); } while (0)
  #define ENDW(tt) do { if ((tt) + 3 < NT) { WAIT_BAR(3); } else if ((tt) + 2 < NT) { WAIT_BAR(2); } else { WAIT_BAR(0); } } while (0)
  for (; t + 1 < NT; t += 2) {
    STEP_AB(t, (t + 3 < NT), (t + 1 < NT), (t + 1 < NT));         ENDW(t);     RESC(); ROT();
    STEP_BA(t + 1, (t + 4 < NT), (t + 2 < NT), (t + 2 < NT));     ENDW(t + 1); RESC(); ROT();
  }
  STEP_AB(NT - 1, false, false, false); RESC();
  { SBAR();
    const int vb = vb0 + s_cur * VSLOT;
    #pragma unroll
    for (int d0 = 0; d0 < 4; ++d0) { s16x4 lo[4], hh[4];
      #pragma unroll
      for (int ks = 0; ks < 4; ++ks) {
        asm volatile("ds_read_b64_tr_b16 %0,%1 offset:%c2" : "=&v"(lo[ks]) : "v"(vb), "i"(d0 * 4096 + ks * 1024) : "memory");
        asm volatile("ds_read_b64_tr_b16 %0,%1 offset:%c2" : "=&v"(hh[ks]) : "v"(vb), "i"(d0 * 4096 + ks * 1024 + 512) : "memory"); }
      asm volatile("s_waitcnt lgkmcnt(0)" ::: "memory"); SBAR();
      #define PK(k) (bf16x8){lo[k][0], lo[k][1], lo[k][2], lo[k][3], hh[k][0], hh[k][1], hh[k][2], hh[k][3]}
      o[d0] = MFQ(PAF(pwB0), PK(0), o[d0]); o[d0] = MFQ(PAF(pwB1), PK(1), o[d0]); o[d0] = MFQ(PAF(pwB2), PK(2), o[d0]); o[d0] = MFQ(PAF(pwB3), PK(3), o[d0]);
      #undef PK
    } }
  asm volatile("s_waitcnt lgkmcnt(0)\n\ts_barrier" ::: "memory");
  if (has_next) {
    const long nrow = (long)nb * SEQ; const int nq0 = nqb * QB;
    const bf16* nQw = Q + (nrow + nq0 + wid * QBLK) * DMA + nhq * D;
    const bf16* nks = K + nrow * DMA + nhq * D + (long)lane * DMA + wid * 8;
    const bf16* nvs = V + nrow * DMA + nh * 128 + (long)(16 * (wid & 3) + (lane >> 2)) * DMA + (wid >> 2) * 32 + (lane & 3) * 8;
    glds16(nks, (unsigned)__builtin_amdgcn_readfirstlane(kdst));
    glds16(nvs, (unsigned)__builtin_amdgcn_readfirstlane(vdst)); glds16(nvs + 64, (unsigned)__builtin_amdgcn_readfirstlane(vdst + 8192));
    glds16(nks + (long)KVBLK * DMA, (unsigned)__builtin_amdgcn_readfirstlane(kdst + KSLOT));
    glds16(nks + (long)2 * KVBLK * DMA, (unsigned)__builtin_amdgcn_readfirstlane(kdst + 2 * KSLOT));
    #pragma unroll
    for (int d0 = 0; d0 < 4; ++d0) qr[d0] = *reinterpret_cast<const bf16x8*>(&nQw[(long)r32 * DMA + d0 * 16 + hi * 8]);
  }
  { auto rr = __builtin_amdgcn_permlane32_swap(__float_as_uint(l_reg), __float_as_uint(l_reg), false, false); l_reg = __uint_as_float(rr[0]) + __uint_as_float(rr[1]); }
  if (hi == 0) wsf[32 + r32] = l_reg; asm volatile("s_waitcnt lgkmcnt(0)" ::: "memory");
  float rli[16];
  #pragma unroll
  for (int r = 0; r < 16; ++r) rli[r] = __builtin_amdgcn_rcpf(wsf[32 + crow(r, hi)]);
  int lane_e = lane; asm volatile("" : "+v"(lane_e));
  const int erow = lane_e >> 3, ech = lane_e & 7;
  bf16* Ow = O + (rowbase + q0 + wid * QBLK) * DMA + h * 128;
  bf16* stg = (bf16*)(shm + L_OST) + wid * 2048;
  if (mode == 0) {
    #pragma unroll
    for (int ps = 0; ps < 2; ++ps) {
      #pragma unroll
      for (int r = 0; r < 16; ++r) { const int orow = crow(r, hi);
        #pragma unroll
        for (int d0 = 0; d0 < 2; ++d0) stg[orow * 64 + d0 * 32 + r32] = f2bf(o[2 * ps + d0][r] * rli[r]); }
      asm volatile("s_waitcnt lgkmcnt(0)" ::: "memory");
      #pragma unroll
      for (int i = 0; i < 4; ++i) { const int row = i * 8 + erow, ch = ech; const u32x4 v = *(const u32x4*)(stg + row * 64 + ch * 8); *(u32x4*)(Ow + (long)row * DMA + ps * 64 + ch * 8) = v; }
      asm volatile("s_waitcnt lgkmcnt(0)" ::: "memory");
    }
    asm volatile("s_waitcnt vmcnt(0)" ::: "memory");
  } else {
    const bf16* Zw = SZ1 + (rowbase + q0 + wid * QBLK) * DMA + h * 128; bf16* Gw = OG + (rowbase + q0 + wid * QBLK) * DMA + h * 128;
    float dk[2][4][8]; float ss[4] = {0.f, 0.f, 0.f, 0.f};
    #pragma unroll
    for (int ps = 0; ps < 2; ++ps) {
      #pragma unroll
      for (int r = 0; r < 16; ++r) { const int orow = crow(r, hi);
        #pragma unroll
        for (int d0 = 0; d0 < 2; ++d0) stg[orow * 64 + d0 * 32 + r32] = f2bf(o[2 * ps + d0][r] * rli[r]); }
      asm volatile("s_waitcnt lgkmcnt(0)" ::: "memory");
      #pragma unroll
      for (int i = 0; i < 4; ++i) { const int row = i * 8 + erow, ch = ech;
        const u32x4 v1 = *(const u32x4*)(stg + row * 64 + ch * 8); const u32x4 v0 = *(const u32x4*)(Ow + (long)row * DMA + ps * 64 + ch * 8);
        #pragma unroll
        for (int j = 0; j < 4; ++j) { const float a0 = __uint_as_float(v0[j] << 16), a1 = __uint_as_float(v0[j] & 0xffff0000u), b0 = __uint_as_float(v1[j] << 16), b1 = __uint_as_float(v1[j] & 0xffff0000u);
          const float d0_ = a0 - lam * b0, d1_ = a1 - lam * b1; dk[ps][i][2 * j] = d0_; dk[ps][i][2 * j + 1] = d1_; ss[i] += d0_ * d0_ + d1_ * d1_; } }
      asm volatile("s_waitcnt lgkmcnt(0)" ::: "memory");
    }
    #pragma unroll
    for (int i = 0; i < 4; ++i) { float t_ = ss[i];
      t_ += __int_as_float(__builtin_amdgcn_ds_swizzle(__float_as_int(t_), 0x1f | (1 << 10))); t_ += __int_as_float(__builtin_amdgcn_ds_swizzle(__float_as_int(t_), 0x1f | (2 << 10)));
      t_ += __int_as_float(__builtin_amdgcn_ds_swizzle(__float_as_int(t_), 0x1f | (4 << 10))); ss[i] = rsqrtf(t_ * (1.0f / 128.0f) + RMS_EPS) * ONE_M_LI; }
    #pragma unroll
    for (int ps = 0; ps < 2; ++ps) {
      const int ch = ech; const float* gp = g_sub + ps * 64 + ch * 8; const f32x4_t g0 = *(const f32x4_t*)gp, g1 = *(const f32x4_t*)(gp + 4);
      #pragma unroll
      for (int i = 0; i < 4; ++i) { const int row = i * 8 + erow;
        const u32x4 z = NT_LD((const u32x4*)(Zw + (long)row * DMA + ps * 64 + ch * 8)); u32x4 w;
        #pragma unroll
        for (int j = 0; j < 4; ++j) { const float z0 = __uint_as_float(z[j] << 16), z1 = __uint_as_float(z[j] & 0xffff0000u);
          const float ga = (j < 2) ? g0[2 * j] : g1[2 * j - 4], gb = (j < 2) ? g0[2 * j + 1] : g1[2 * j - 3];
          w[j] = cvtpk_s(dk[ps][i][2 * j] * ss[i] * ga * z0, dk[ps][i][2 * j + 1] * ss[i] * gb * z1); }
        *(u32x4*)(Gw + (long)row * DMA + ps * 64 + ch * 8) = w; }
    }
  }
  asm volatile("s_waitcnt lgkmcnt(0)" ::: "memory");
  #undef DMA_K
  #undef DMA_V
  #undef CMASK
  #undef RESC
  #undef ROT
  #undef PKW
  #undef PAF
  #undef VFR
  #undef PIN
  #undef MX3
  #undef EX
  #undef VRD
  #undef KRD
  #undef GAPB
  #undef MFQ
  #undef STEP
  #undef STEP_AB
  #undef STEP_BA
  #undef ENDW
}
#undef SBAR
#undef WAIT_BAR
}

constexpr int NWAVES = 8;
constexpr size_t MiB = 1u << 20;
constexpr size_t WS_CTL = 0, CTL_ZERO_BYTES = 1 * MiB;
constexpr size_t WS_MOD = 256 * 1024;
constexpr size_t WS_LAM = 1 * MiB;
constexpr size_t WS_HN = 1 * MiB + 128 * 1024;
constexpr size_t WS_LB16 = 1 * MiB + 4096;
constexpr size_t WS_WIN0 = 2 * MiB, WS_WGLU = 6 * MiB, WS_WOUT0 = 8 * MiB, WS_WKV = 10 * MiB, WS_WIN1 = 14 * MiB, WS_WOUT1 = 18 * MiB;
constexpr size_t WS_BTA = 20 * MiB;
constexpr size_t WS_BTB = 28 * MiB;
constexpr size_t WS_S0 = 48 * MiB, WS_S1 = 112 * MiB, WS_S2 = 176 * MiB, WS_S3 = 240 * MiB, WS_S4 = 304 * MiB, WS_S5 = 368 * MiB, WS_S6 = 432 * MiB, WS_END = 496 * MiB;
constexpr int CW_BAR = 4096;
constexpr int CW_TMO = 8, CW_SEAM = 16384, SEAM_BANK = 128 * 64;
constexpr size_t WS_XCH = 40 * MiB;
constexpr int RING_OFF = 0, RING_BYTES = 131072;
constexpr int LDSCTL_OFF = RING_BYTES, MISC_OFF = LDSCTL_OFF + 320;
constexpr int LDS_BYTES = 147456;

#define GAS __attribute__((address_space(1)))
#define LAS __attribute__((address_space(3)))
typedef unsigned v4u __attribute__((ext_vector_type(4)));
typedef GAS unsigned gu32;
#define RLX_AGENT __ATOMIC_RELAXED, __HIP_MEMORY_SCOPE_AGENT
#define LDS_WAIT() asm volatile("s_waitcnt lgkmcnt(0)" ::: "memory")
#define VM_WAIT() asm volatile("s_waitcnt vmcnt(0)" ::: "memory")

#define XB_TMO      128
#define XB_XCNT(j)  (256  + 64 * (j))
#define XB_XSUB(j)  (1280 + 64 * (j))
#define XB_XGEN(j)  (2304 + 64 * (j))
#define XB_TOP      3328
#define XB_TOPGEN   3392
#define XCD_BAR_WORDS 3456
#define XB_SPIN_CAP (1u << 18)
__device__ __forceinline__ unsigned xb_ld(unsigned* p)              { return __hip_atomic_load(p, __ATOMIC_RELAXED, __HIP_MEMORY_SCOPE_AGENT); }
__device__ __forceinline__ unsigned xb_add(unsigned* p, unsigned v) { return __hip_atomic_fetch_add(p, v, __ATOMIC_RELAXED, __HIP_MEMORY_SCOPE_AGENT); }
__device__ __forceinline__ unsigned xb_xcc_id() { return (unsigned)__builtin_amdgcn_s_getreg((3 << 11) | 20) & 0xFu; }
#define XB_SPIN(cond, bar) do { unsigned _sp = 0; while (cond) { __builtin_amdgcn_s_sleep(1); \
    if ((++_sp & 255u) == 0u) { if (xb_ld(&(bar)[XB_TMO])) break; if (_sp > XB_SPIN_CAP) { atomicAdd(&(bar)[XB_TMO], 1u); break; } } } } while (0)
struct XcdBarrier { unsigned* bar; unsigned x; volatile LAS unsigned* st; };
__device__ __forceinline__ XcdBarrier xcd_barrier_post(unsigned* bar, volatile LAS unsigned* st, int tid) {
    XcdBarrier b; b.bar = bar; b.x = xb_xcc_id(); b.st = st;
    if (tid == 0) (void)xb_add(&bar[XB_XCNT(b.x)], 1u);
    return b;
}
__device__ __forceinline__ void xcd_barrier_complete(unsigned* bar, unsigned x, unsigned& nloc, unsigned& nx) {
    const unsigned G = gridDim.x * gridDim.y * gridDim.z;
    unsigned sum, cnt, mine, sp = 0u;
    for (;;) {
        sum = 0u; cnt = 0u; mine = 0u;
#pragma unroll
        for (unsigned j = 0; j < 16; ++j) { const unsigned c = xb_ld(&bar[XB_XCNT(j)]); sum += c; cnt += (c > 0u) ? 1u : 0u; mine = (j == x) ? c : mine; }
        if (sum == G) break;
        __builtin_amdgcn_s_sleep(1);
        if ((++sp & 255u) == 0u) { if (xb_ld(&bar[XB_TMO])) break; if (sp > XB_SPIN_CAP) { atomicAdd(&bar[XB_TMO], 1u); break; } }
    }
    nloc = mine > 0u ? mine : 1u; nx = cnt > 0u ? cnt : 1u;
}
__device__ __forceinline__ void xcd_barrier(const XcdBarrier& b, int tid) {
    asm volatile("s_waitcnt vmcnt(0)" ::: "memory");
    __syncthreads();
    if (tid == 0) {
        unsigned* bar = b.bar;
        __builtin_amdgcn_s_waitcnt(0);
        unsigned nloc = b.st[0], nx = b.st[1];
        if (nloc == 0u) { xcd_barrier_complete(bar, b.x, nloc, nx); b.st[0] = nloc; b.st[1] = nx; }
        const unsigned old = xb_add(&bar[XB_XSUB(b.x)], 1u);
        const unsigned gen = old / nloc;
        if (old + 1u == (gen + 1u) * nloc) {
            __builtin_amdgcn_fence(__ATOMIC_RELEASE, "agent");
            asm volatile("s_waitcnt vmcnt(0)" ::: "memory");
            const unsigned og = xb_add(&bar[XB_TOP], 1u);
            const unsigned tg = og / nx;
            if (og + 1u == (tg + 1u) * nx) xb_add(&bar[XB_TOPGEN], 1u);
            else XB_SPIN(xb_ld(&bar[XB_TOPGEN]) == tg, bar);
            __builtin_amdgcn_fence(__ATOMIC_ACQUIRE, "agent");
            xb_add(&bar[XB_XGEN(b.x)], 1u);
            asm volatile("s_waitcnt vmcnt(0)" ::: "memory");
        } else {
            XB_SPIN(xb_ld(&bar[XB_XGEN(b.x)]) == gen, bar);
            __builtin_amdgcn_fence(__ATOMIC_ACQUIRE, "agent");
            asm volatile("s_waitcnt vmcnt(0)" ::: "memory");
        }
    }
    __syncthreads();
}

__device__ __forceinline__ void p0_transpose_item(const float* W, int K, int N, bf16_t* WT, int row_off, const float* kscale, LAS float* scr, int item, int lane) {
    const int nblk = N / 32, kb = item / nblk, nb = item % nblk, k0 = 64 * kb, n0 = 32 * nb;
    float tv[32];
#pragma unroll
    for (int i = 0; i < 32; ++i) tv[i] = NT_LD(W + (size_t)(k0 + 2 * i + (lane >> 5)) * N + n0 + (lane & 31));
#pragma unroll
    for (int i = 0; i < 32; ++i) { const int kk = 2 * i + (lane >> 5); float v = tv[i]; if (kscale) v *= kscale[k0 + kk]; scr[kk * 33 + (lane & 31)] = v; }
    LDS_WAIT(); asm volatile("" ::: "memory");
    const int c = lane & 7;
#pragma unroll
    for (int j = 0; j < 4; ++j) { const int n = (lane >> 3) + 8 * j; const LAS float* s = scr + (8 * c) * 33 + n;
        v4u o; o.x = pk2bf(s[0 * 33], s[1 * 33]); o.y = pk2bf(s[2 * 33], s[3 * 33]); o.z = pk2bf(s[4 * 33], s[5 * 33]); o.w = pk2bf(s[6 * 33], s[7 * 33]);
        *(GAS v4u*)(WT + (size_t)(row_off + n0 + n) * K + k0 + 8 * c) = o; }
    LDS_WAIT(); asm volatile("" ::: "memory");
}

__device__ __forceinline__ int lane_now_asm() { int r; asm volatile("v_mbcnt_lo_u32_b32 %0, -1, 0\n\tv_mbcnt_hi_u32_b32 %0, -1, %0" : "=v"(r)); return r; }
struct Args {
    const float* in[28]; float* out; unsigned char* ws;
    int ph_lo, ph_hi, use_bar, flags;
};

__global__ void __launch_bounds__(NWAVES * 64, 2) mega_fwd(Args args) {
    extern __shared__ __attribute__((aligned(16))) unsigned char lds_raw[];
    LAS unsigned char* lds = (LAS unsigned char*)lds_raw;
    volatile LAS unsigned* MISC = (volatile LAS unsigned*)(lds + MISC_OFF);
    const int wave = __builtin_amdgcn_readfirstlane((int)threadIdx.x >> 6);
#define LANE_NOW() lane_now_asm()
#define TID_NOW() (wave * 64 + LANE_NOW())
    const int G = gridDim.x; const int bx = blockIdx.x; const int vcu = (G % 8 == 0) ? (bx % 8) * (G / 8) + bx / 8 : bx;
    unsigned char* ws = args.ws;
    gu32* ctl = (gu32*)(ws + WS_CTL);
    const float* x = args.in[0]; const float* cvec = args.in[1]; const float* ada_w = args.in[2]; const float* ada_b = args.in[3];
    const float* g_pre = args.in[4]; const float* g_post = args.in[5];
    float* out = args.out;
    float* mod = (float*)(ws + WS_MOD); float* lamp = (float*)(ws + WS_LAM); float* lb16 = (float*)(ws + WS_LB16);
    bf16_t* Win0 = (bf16_t*)(ws + WS_WIN0); bf16_t* Wglu = (bf16_t*)(ws + WS_WGLU); bf16_t* Wout0 = (bf16_t*)(ws + WS_WOUT0); bf16_t* Wkv = (bf16_t*)(ws + WS_WKV);
    bf16_t* Win1 = (bf16_t*)(ws + WS_WIN1); bf16_t* Wout1 = (bf16_t*)(ws + WS_WOUT1); bf16_t* BtA = (bf16_t*)(ws + WS_BTA); bf16_t* BtB = (bf16_t*)(ws + WS_BTB);
    bf16_t* A0 = (bf16_t*)(ws + WS_S0); bf16_t* US = (bf16_t*)(ws + WS_S1); bf16_t* SZ = (bf16_t*)(ws + WS_S3); bf16_t* YG = (bf16_t*)(ws + WS_S4); float* EB = (float*)(ws + WS_S0);
    bf16_t* Y2 = (bf16_t*)(ws + WS_S0); bf16_t* YO = (bf16_t*)(ws + WS_S1); bf16_t* AKV = (bf16_t*)(ws + WS_S0); bf16_t* AIN1 = (bf16_t*)(ws + WS_S2);
    bf16_t* KB = (bf16_t*)(ws + WS_S3); bf16_t* VB = (bf16_t*)(ws + WS_S4); bf16_t* QB = (bf16_t*)(ws + WS_S5); bf16_t* SZ1 = (bf16_t*)(ws + WS_S6);
    bf16_t* O0 = (bf16_t*)(ws + (H1_AKV ? WS_S1 : WS_S0)); bf16_t* O1 = (bf16_t*)(ws + WS_S1); bf16_t* OG = (bf16_t*)(ws + WS_S2); bf16_t* YO1 = (bf16_t*)(ws + (H1_AKV ? WS_S3 : WS_S0));
    float* HN = (float*)(ws + WS_HN);

    for (int u = TID_NOW(); u < (LDS_BYTES - LDSCTL_OFF) / 4; u += NWAVES * 64) ((LAS unsigned*)(lds + LDSCTL_OFF))[u] = 0u;
    __syncthreads();
    XcdBarrier bar; bar.bar = (unsigned*)(ctl + CW_BAR); bar.x = 0; bar.st = nullptr;
    if (args.use_bar) bar = xcd_barrier_post((unsigned*)(ctl + CW_BAR), MISC + 8, TID_NOW());
    const int lo = args.ph_lo, hi = args.ph_hi;
#define IN(k) (lo <= (k) && (k) < hi)
#define REPS(k) (1 + ((REPEAT_MASK >> (k)) & 1))
#define SEAM(k) do { if (IN(k) && IN((k) + 1) && args.use_bar) xcd_barrier(bar, TID_NOW()); } while (0)
    const int gw = vcu * NWAVES + wave, NGW = G * NWAVES;
#define LANE_L() ({ int l_ = LANE_NOW(); asm volatile("" : "+v"(l_)); l_; })

    if (IN(0)) for (int rep_ = 0; rep_ < REPS(0); ++rep_) {
        const int tid = TID_NOW(), lane = tid & 63;
        for (int it = vcu; it < NGRP * 4; it += G) {
            const int g = it >> 2, qt = it & 3;
            LAS float* LBP = (LAS float*)(lds + RING_OFF);
            LAS float* BBR = LBP + 17 * 128;
            LAS float* CC = BBR + 64 * 32;
            LAS float* KM = CC + 16 * 130 + 12;
            __syncthreads();
            if (tid < 64) {
                const int p = tid;
                const float dt = expf(args.in[9][g]);
                const float lr = args.in[7][g * 64 + p], li = args.in[8][g * 64 + p];
                const float mag = expf(lr * dt); const float sn = sinf(li * dt), cs = cosf(li * dt);
                const float lbr = mag * cs, lbi = mag * sn;
                float pr = 1.f, pi = 0.f;
                for (int d = 0; d <= 16; ++d) { LBP[(d * 64 + p) * 2] = pr; LBP[(d * 64 + p) * 2 + 1] = pi; const float nr = pr * lbr - pi * lbi, ni = pr * lbi + pi * lbr; pr = nr; pi = ni; }
                if (qt == 0) { lb16[(g * 64 + p) * 2] = LBP[(16 * 64 + p) * 2]; lb16[(g * 64 + p) * 2 + 1] = LBP[(16 * 64 + p) * 2 + 1]; }
                const float nr = lbr - 1.0f, ni = lbi, den = lr * lr + li * li;
                const float cr = (nr * lr + ni * li) / den, ci = (ni * lr - nr * li) / den;
                for (int c = 0; c < 16; ++c) { const float br = args.in[10][(g * 64 + p) * 16 + c], bi = args.in[11][(g * 64 + p) * 16 + c];
                    BBR[(p * 16 + c) * 2] = cr * br - ci * bi; BBR[(p * 16 + c) * 2 + 1] = cr * bi + ci * br; }
            }
            for (int e = tid; e < 1024; e += 512) { const int co = e >> 6, p = e & 63; CC[(co * 65 + p) * 2] = args.in[12][(g * 16 + co) * 64 + p]; CC[(co * 65 + p) * 2 + 1] = args.in[13][(g * 16 + co) * 64 + p]; }
            __syncthreads();
            {
                const int pair = tid >> 1, hh = tid & 1, d = pair >> 4, co = pair & 15; float acc8[8];
#pragma unroll
                for (int j = 0; j < 8; ++j) acc8[j] = 0.f;
                for (int p = 0; p < 64; ++p) { const float cr = CC[(co * 65 + p) * 2], cim = CC[(co * 65 + p) * 2 + 1], lr = LBP[(d * 64 + p) * 2], lim = LBP[(d * 64 + p) * 2 + 1];
                    const float wr_ = cr * lr - cim * lim, wi_ = cr * lim + cim * lr; const LAS f32x4_t* bp = (const LAS f32x4_t*)(BBR + (p * 16 + 8 * hh) * 2);
#pragma unroll
                    for (int q4 = 0; q4 < 4; ++q4) { const f32x4_t bb = bp[q4]; acc8[2 * q4] += wr_ * bb.x - wi_ * bb.y; acc8[2 * q4 + 1] += wr_ * bb.z - wi_ * bb.w; } }
#pragma unroll
                for (int j = 0; j < 8; ++j) KM[(d * 16 + co) * 16 + 8 * hh + j] = acc8[j];
            }
            __syncthreads();
            for (int e = tid; e < 64 * 48; e += 512) {
                const int n = 64 * qt + e / 48, pc = e % 48, s = n >> 4, co = n & 15; float v[8];
                if (pc < 32) { const int s2 = pc >> 1, ci0 = (pc & 1) * 8;
#pragma unroll
                    for (int j = 0; j < 8; ++j) v[j] = (s2 <= s) ? KM[((s - s2) * 16 + co) * 16 + ci0 + j] : 0.f;
                } else { const int j0 = (pc - 32) * 8;
#pragma unroll
                    for (int jj = 0; jj < 4; ++jj) { const int p = (j0 >> 1) + jj; const float cr = CC[(co * 65 + p) * 2], cim = CC[(co * 65 + p) * 2 + 1], lr = LBP[((s + 1) * 64 + p) * 2], lim = LBP[((s + 1) * 64 + p) * 2 + 1];
                        v[2 * jj] = cr * lr - cim * lim; v[2 * jj + 1] = -(cr * lim + cim * lr); } }
                v4u o; o.x = pk2bf(v[0], v[1]); o.y = pk2bf(v[2], v[3]); o.z = pk2bf(v[4], v[5]); o.w = pk2bf(v[6], v[7]);
                *(GAS v4u*)(BtB + ((size_t)g * 256 + n) * 384 + pc * 8) = o; }
            for (int e = tid; e < 64 * 32; e += 512) {
                const int n = 64 * qt + (e >> 5), pc = e & 31; float v[8];
                if (n < 128) { const int p = n >> 1, ri = n & 1, s2 = pc >> 1, ci0 = (pc & 1) * 8; const float lr = LBP[((15 - s2) * 64 + p) * 2], lim = LBP[((15 - s2) * 64 + p) * 2 + 1];
#pragma unroll
                    for (int j = 0; j < 8; ++j) { const float br = BBR[(p * 16 + ci0 + j) * 2], bi = BBR[(p * 16 + ci0 + j) * 2 + 1]; v[j] = ri ? (lr * bi + lim * br) : (lr * br - lim * bi); }
                } else {
#pragma unroll
                    for (int j = 0; j < 8; ++j) v[j] = 0.f; }
                v4u o; o.x = pk2bf(v[0], v[1]); o.y = pk2bf(v[2], v[3]); o.z = pk2bf(v[4], v[5]); o.w = pk2bf(v[6], v[7]);
                *(GAS v4u*)(BtA + ((size_t)g * 256 + n) * 256 + pc * 8) = o; }
        }
        __syncthreads();
        {
            LAS float* scr = (LAS float*)(lds + RING_OFF + wave * 16384);
            constexpr int I_2K = (DM / 64) * (2048 / 32), I_1K = (DM / 64) * (1024 / 32);
            constexpr int NITEMS = 2 * I_2K + 5 * I_1K;
            for (int it = gw; it < NITEMS; it += NGW) {
                int r = it;
                if (r < I_2K) { p0_transpose_item(args.in[6], DM, 2048, Win0, 0, nullptr, scr, r, lane); continue; } r -= I_2K;
                if (r < I_2K) { p0_transpose_item(args.in[21], DM, 2048, Win1, 0, nullptr, scr, r, lane); continue; } r -= I_2K;
                if (r < I_1K) { p0_transpose_item(args.in[15], DM, 1024, Wglu, 0, nullptr, scr, r, lane); continue; } r -= I_1K;
                if (r < I_1K) { p0_transpose_item(args.in[17], DM, 1024, Wout0, 0, nullptr, scr, r, lane); continue; } r -= I_1K;
                if (r < I_1K) { p0_transpose_item(args.in[19], DM, 1024, Wkv, 0, args.in[18], scr, r, lane); continue; } r -= I_1K;
                if (r < I_1K) { p0_transpose_item(args.in[20], DM, 1024, Wkv, 1024, args.in[18], scr, r, lane); continue; } r -= I_1K;
                p0_transpose_item(args.in[27], DM, 1024, Wout1, 0, nullptr, scr, r, lane);
            }
        }
        if (!(args.flags & 1)) {
            __syncthreads();
            LAS float* sc = (LAS float*)(lds + RING_OFF);
            LAS float* red = sc + 8192;
            bool have = false;
            for (int it = vcu; it < 2 * 96; it += G) {
                if (!have) { for (int e = tid; e < 8192; e += 512) sc[e] = silu_f(cvec[e]); have = true; __syncthreads(); }
                const int l = it / 96, cc = it % 96, j = cc * 32 + (lane & 31), kh = lane >> 5;
                float acc[8];
#pragma unroll
                for (int b = 0; b < 8; ++b) acc[b] = 0.f;
                const float* wp = ada_w + ((size_t)l * 1024 + wave * 128 + kh) * 3072 + j;
                for (int k0 = 0; k0 < 64; k0 += 32) {
                    float w[32];
#pragma unroll
                    for (int kk = 0; kk < 32; ++kk) w[kk] = NT_LD(wp + (size_t)(2 * (k0 + kk)) * 3072);
#pragma unroll
                    for (int kk = 0; kk < 32; ++kk) {
#pragma unroll
                        for (int b = 0; b < 8; ++b) acc[b] += w[kk] * sc[b * 1024 + wave * 128 + 2 * (k0 + kk) + kh];
                        if ((kk & 3) == 3) asm volatile("" ::: "memory"); }
                }
#pragma unroll
                for (int b = 0; b < 8; ++b) { acc[b] += __shfl_xor(acc[b], 32); if (lane < 32) red[(wave * 8 + b) * 32 + lane] = acc[b]; }
                __syncthreads();
                if (tid < 256) { const int b = tid >> 5, jl = tid & 31; float sum = ada_b[l * 3072 + cc * 32 + jl];
#pragma unroll
                  for (int w = 0; w < 8; ++w) sum += red[(w * 8 + b) * 32 + jl];
                  mod[((size_t)(l * 8 + b)) * 3072 + cc * 32 + jl] = sum; }
                __syncthreads();
            }
            if (bx == 0 && tid == 0) lamp[0] = diff_lambda(args.in[22], args.in[23], args.in[24], args.in[25]);
        }
    }
    SEAM(0);
    if (IN(1)) for (int rep_ = 0; rep_ < REPS(1); ++rep_) e_norm0_b(x, mod, g_pre, A0, gw, NGW, LANE_L());
    SEAM(1);
#ifdef EXTRA_BARS
    if (args.use_bar) for (int eb = 0; eb < EXTRA_BARS; ++eb) xcd_barrier(bar, TID_NOW());
#endif
    if (IN(2)) for (int rep_ = 0; rep_ < REPS(2); ++rep_) {
        pg8::Gemm g = pg8::gemm_std(A0, DM, Win0, DM, DM); pg8::Order S; S.init(MTOK / 256, 2048 / 256, 1, G, bx);
        pg8::EpiRow8<pg8::F_In0> E{{US, SZ}};
        pg8::gemm_phase<pg8::EpiRow8<pg8::F_In0>, ALIGN_E>(lds + RING_OFF, g, S, E, TID_NOW());
    }
    SEAM(2);
#if SSM_FUSED
    if (IN(3)) {
        pg8::Gemm gA = pg8::gemm_std(US, US_P, BtA, 256, 256); gA.a_gstep = (size_t)NTILE * US_P * 2; gA.b_gstep = (size_t)256 * 256 * 2;
        pg8::Gemm gB = pg8::gemm_std(US, US_P, BtB, 384, 384); gB.a_gstep = (size_t)NTILE * US_P * 2; gB.b_gstep = (size_t)256 * 384 * 2;
        pg8::EpiScan ES{lb16, US, LDSCTL_OFF + 2048};
        pg8::EpiRow8<pg8::F_SsmB> EB2{{US, args.in[14], YG}};
        for (int uu = 0; (long)uu * G + bx < NGRP * NB; ++uu) {
            pg8::Order S; S.init(NTILE / 256, 1, NGRP, G, bx); S.only = uu;
            pg8::gemm_phase<pg8::EpiScan, false>(lds + RING_OFF, gA, S, ES, TID_NOW());
            pg8::gemm_phase<pg8::EpiRow8<pg8::F_SsmB>, false>(lds + RING_OFF, gB, S, EB2, TID_NOW());
        }
    }
    SEAM(5);
#else
    if (IN(3)) for (int rep_ = 0; rep_ < REPS(3); ++rep_) {
        pg8::Gemm g = pg8::gemm_std(US, US_P, BtA, 256, 256); g.a_gstep = (size_t)NTILE * US_P * 2; g.b_gstep = (size_t)256 * 256 * 2;
        pg8::Order S; S.init(NTILE / 256, 1, NGRP, G, bx);
        pg8::EpiRow8<pg8::F_SsmA> E{{EB}};
        pg8::gemm_phase<pg8::EpiRow8<pg8::F_SsmA>, ALIGN_E>(lds + RING_OFF, g, S, E, TID_NOW());
    }
    SEAM(3);
    if (IN(4)) for (int rep_ = 0; rep_ < REPS(4); ++rep_) {
        for (int it = vcu + G * wave; it < NB * NGRP; it += G * NWAVES) {
            const int b = it / NGRP, g = it % NGRP, p = LANE_L();
            const float lr = lb16[(g * 64 + p) * 2], li = lb16[(g * 64 + p) * 2 + 1];
            float sr = 0.f, si = 0.f;
            const float* ep = EB + ((size_t)g * NTILE + b * 256) * 128 + 2 * p;
            bf16_t* sp = US + us_off(g, b * 256, 256 + 2 * p);
            for (int t0 = 0; t0 < 256; t0 += 16) {
                float er[16], ei[16];
#pragma unroll
                for (int j = 0; j < 16; ++j) { const float2 e = *(const float2*)(ep + (size_t)(t0 + j) * 128); er[j] = e.x; ei[j] = e.y; }
#pragma unroll
                for (int j = 0; j < 16; ++j) { *(unsigned*)(sp + (size_t)(t0 + j) * US_P) = pk2bf(sr, si);
                    const float nr = lr * sr - li * si + er[j], ni = lr * si + li * sr + ei[j]; sr = nr; si = ni; }
            }
        }
    }
    SEAM(4);
    if (IN(5)) for (int rep_ = 0; rep_ < REPS(5); ++rep_) {
        pg8::Gemm g = pg8::gemm_std(US, US_P, BtB, 384, 384); g.a_gstep = (size_t)NTILE * US_P * 2; g.b_gstep = (size_t)256 * 384 * 2;
        pg8::Order S; S.init(NTILE / 256, 1, NGRP, G, bx);
        pg8::EpiRow8<pg8::F_SsmB> E{{US, args.in[14], YG}};
        pg8::gemm_phase<pg8::EpiRow8<pg8::F_SsmB>, ALIGN_E>(lds + RING_OFF, g, S, E, TID_NOW());
    }
    SEAM(5);
#endif
    if (IN(6)) for (int rep_ = 0; rep_ < REPS(6); ++rep_) {
        pg8::Gemm g = pg8::gemm_std(YG, DM, Wglu, DM, DM);
        g.a_rs = 32u; g.a_c16 = (unsigned)((size_t)NTILE * YG_P * 2); g.a_kstep = (size_t)4 * NTILE * YG_P * 2; g.a_tstep = (size_t)256 * 32;
        pg8::Order S; S.init(MTOK / 256, 1024 / 256, 1, G, bx);
        pg8::EpiRow8<pg8::F_Glu> E{{YG, SZ, args.in[16], Y2}};
        pg8::gemm_phase<pg8::EpiRow8<pg8::F_Glu>, ALIGN_E>(lds + RING_OFF, g, S, E, TID_NOW());
    }
    SEAM(6);
#if FUSE_EPI
    if (IN(7)) {
        pg8::Gemm g = pg8::gemm_std(Y2, DM, Wout0, DM, DM);
        for (int half = 0; half < 2; ++half) {
            pg8::Order S; S.init(MTOK / 512, 1024 / 256, 1, G, bx); S.pm_off = half * (MTOK / 512);
            pg8::PanelRms st1{(unsigned*)(ws + WS_XCH), (unsigned*)(ctl + CW_SEAM), (unsigned*)(ctl + CW_TMO), RMS_EPS};
            pg8::PanelRms st2{(unsigned*)(ws + WS_XCH + 1 * MiB), (unsigned*)(ctl + CW_SEAM + SEAM_BANK), (unsigned*)(ctl + CW_TMO), RMS_EPS};
            pg8::EpiMid E{x, out, AKV, AIN1, mod, g_post, g_pre + 1024, st1, st2};
            pg8::gemm_phase<pg8::EpiMid, false>(lds + RING_OFF, g, S, E, TID_NOW());
        }
    }
#else
    if (IN(7)) {
        pg8::Gemm g = pg8::gemm_std(Y2, DM, Wout0, DM, DM); pg8::Order S; S.init(MTOK / 256, 1024 / 256, 1, G, bx);
        pg8::EpiRow8<pg8::F_Plain> E{{YO}};
        pg8::gemm_phase<pg8::EpiRow8<pg8::F_Plain>, ALIGN_E>(lds + RING_OFF, g, S, E, TID_NOW());
    }
    SEAM(7);
    if (IN(8)) { if (H1_BF16) e_mid(x, YO, mod, g_post, g_pre, (float*)nullptr, YO, AKV, AIN1, gw, NGW, LANE_L()); else e_mid_b(x, YO, mod, g_post, g_pre, (H1_RECOMP || H1_AKV) ? (float*)nullptr : out, AKV, AIN1, gw, NGW, LANE_L(), H1_AKV ? HN : (float*)nullptr); }
#endif
    SEAM(8);
    if (IN(9)) for (int rep_ = 0; rep_ < REPS(9); ++rep_) {
        pg8::Gemm g = pg8::gemm_std(AKV, DM, Wkv, DM, DM); g.a_gstep = (size_t)(WS_S2 - WS_S0); g.b_gstep = (size_t)(WS_WIN1 - WS_WKV);
        pg8::Order S; S.init(MTOK / 256, 2048 / 256, 2, G, bx); S.mode2 = (G == 256);
        pg8::EpiRow8<pg8::F_Split2> E{{{KB, QB}, {VB, SZ1}}};
        pg8::gemm_phase<pg8::EpiRow8<pg8::F_Split2>, ALIGN_E>(lds + RING_OFF, g, S, E, TID_NOW());
    }
    SEAM(9);
    if (IN(10)) {
#if ATTN_V128
#if ATTN_FUSE_POST
        { const float lam = __int_as_float(__builtin_amdgcn_readfirstlane(__float_as_int(lamp[0])));
          attn_body::bf16x8 qr[4]; bool primed = false;
#if ATTN_PRIO
          if (wave >= 4) __builtin_amdgcn_s_setprio(1);
#endif
          const int nun = (64 * 16 - vcu + G - 1) / G;
#pragma unroll 1
          for (int su = 0; su < 2 * nun; ++su) {
            const int i = su >> 1, cc = su & 1;
            const long L = (long)i * G + vcu; const int pr = (int)(L % 256), qi = (int)(L / 256);
            const int bh = pr >> 2, j = pr & 3; const int qb = (qi & 1) ? (8 * (qi >> 1) + 7 - j) : (8 * (qi >> 1) + j); const int h = bh & 7, b = bh >> 3;
            const bool has_next = su + 1 < 2 * nun;
            const int i2 = (su + 1) >> 1, cc2 = (su + 1) & 1;
            const long L2 = (long)i2 * G + vcu; const int pr2 = (int)(L2 % 256), qi2 = (int)(L2 / 256);
            const int bh2 = pr2 >> 2, j2 = pr2 & 3; const int qb2 = (qi2 & 1) ? (8 * (qi2 >> 1) + 7 - j2) : (8 * (qi2 >> 1) + j2); const int h2 = bh2 & 7, b2 = bh2 >> 3;
            attn3::attn_unit<8>(TID_NOW(), b, 2 * h + cc, h, qb, QB, KB, VB, O0, (char*)lds_raw + RING_OFF, cc, SZ1, args.in[26], lam, OG, primed, has_next, b2, 2 * h2 + cc2, h2, qb2, qr);
            primed = true;
          }
#if ATTN_PRIO
          __builtin_amdgcn_s_setprio(0);
#endif
          }
#else
        for (int i = 0;; ++i) {
            const long L = (long)i * G + vcu; if (L >= 128 * 16) break;
            const int pr = (int)(L % 256), qi = (int)(L / 256);
            const int combo = pr >> 1, j = pr & 1;
            const int k4 = qi >> 1; const int qb = (qi & 1) ? (4 * k4 + 3 - j) : (4 * k4 + j);
            const int c = combo & 1, h = (combo >> 1) & 7, b = combo >> 4;
            { attn_body::bf16x8 qr_[4]; attn3::attn_unit<8>(TID_NOW(), b, 2 * h + c, h, qb, QB, KB, VB, c ? O1 : O0, (char*)lds_raw + RING_OFF, 0, SZ1, args.in[26], 0.f, OG, false, false, 0, 0, 0, 0, qr_); asm volatile("s_barrier" ::: "memory"); }
        }
#endif
#else
        for (int i = 0;; ++i) {
            const long L = (long)i * G + vcu; if (L >= 256 * 16) break;
            const int combo = (int)(L % 256), qi = (int)(L / 256);
            const int qb = (qi & 1) ? (qi >> 1) : (15 - (qi >> 1));
            const int vh = combo & 1, c = (combo >> 1) & 1, h = (combo >> 2) & 7, b = combo >> 5;
            attn_body::attn_unit<8>(TID_NOW(), b, 2 * h + c, 2 * h + vh, qb, QB, KB, VB, c ? O1 : O0, (char*)lds_raw + RING_OFF);
        }
#endif
    }
    SEAM(10);
#if !(ATTN_V128 && ATTN_FUSE_POST)
    if (IN(11)) for (int rep_ = 0; rep_ < REPS(11); ++rep_) e_attn_post(O0, O1, SZ1, args.in[26], lamp[0], OG, gw, NGW, LANE_L());
    SEAM(11);
#endif
#if FUSE_EPI
    if (IN(12)) {
        pg8::Gemm g = pg8::gemm_std(OG, DM, Wout1, DM, DM);
        for (int half = 0; half < 2; ++half) {
            pg8::Order S; S.init(MTOK / 512, 1024 / 256, 1, G, bx); S.pm_off = half * (MTOK / 512);
            pg8::PanelRms st{(unsigned*)(ws + WS_XCH + 2 * MiB), (unsigned*)(ctl + CW_SEAM + 2 * SEAM_BANK), (unsigned*)(ctl + CW_TMO), RMS_EPS};
            pg8::EpiFinal E{out, out, mod + 8 * 3072, g_post + 1024, st};
            pg8::gemm_phase<pg8::EpiFinal, false>(lds + RING_OFF, g, S, E, TID_NOW());
        }
    }
#else
    if (IN(12)) {
        pg8::Gemm g = pg8::gemm_std(OG, DM, Wout1, DM, DM); pg8::Order S; S.init(MTOK / 256, 1024 / 256, 1, G, bx);
        pg8::EpiRow8<pg8::F_Plain> E{{YO1}};
        pg8::gemm_phase<pg8::EpiRow8<pg8::F_Plain>, ALIGN_E>(lds + RING_OFF, g, S, E, TID_NOW());
    }
    SEAM(12);
    if (IN(13)) { if (H1_BF16) e_final_b(YO, out, YO1, mod, g_post, gw, NGW, LANE_L()); else if (H1_AKV) e_final_k(AKV, HN, YO1, out, mod, g_post, gw, NGW, LANE_L()); else if (H1_RECOMP) e_final_x(x, YO, YO1, out, mod, g_post, gw, NGW, LANE_L()); else e_final_bm(out, YO1, mod, g_post, gw, NGW, LANE_L()); }
#endif
#undef IN
#undef SEAM
}

#ifndef FASTMASK
#define FASTMASK 0x3fff
#endif
#ifndef ONE_LAUNCH
#define ONE_LAUNCH 1
#endif
constexpr int NPHASE = 14;

extern "C" void kernel_launch(void* const* d_in, const int* in_sizes, int n_in, void* d_out, int out_size, void* d_ws, size_t ws_size, hipStream_t stream) {
    static int grid = 0;
    if (grid == 0) {
        if (n_in != 28 || out_size != MTOK * DM || ws_size < WS_END) { fprintf(stderr, "kernel_launch: unexpected shapes (n_in %d out %d ws %zu)\n", n_in, out_size, ws_size); grid = -1; return; }
        int dev = 0, cus = 0, per_cu = 0;
        if (hipGetDevice(&dev) != hipSuccess || hipDeviceGetAttribute(&cus, hipDeviceAttributeMultiprocessorCount, dev) != hipSuccess) { grid = -1; return; }
        if (hipFuncSetAttribute((const void*)mega_fwd, hipFuncAttributeMaxDynamicSharedMemorySize, LDS_BYTES) != hipSuccess) { fprintf(stderr, "kernel_launch: hipFuncSetAttribute failed\n"); grid = -1; return; }
        if (hipOccupancyMaxActiveBlocksPerMultiprocessor(&per_cu, (const void*)mega_fwd, NWAVES * 64, LDS_BYTES) != hipSuccess || per_cu < 1) { fprintf(stderr, "kernel_launch: occupancy query says %d\n", per_cu); }
        (void)hipGetLastError();
        grid = cus;
    }
    if (grid < 0) return;
    if (hipMemsetAsync((char*)d_ws + WS_CTL + (size_t)CW_BAR * 4, 0, (size_t)XCD_BAR_WORDS * 4, stream) != hipSuccess) { fprintf(stderr, "kernel_launch: memset failed\n"); return; }
    Args a{};
    for (int i = 0; i < 28; ++i) a.in[i] = (const float*)d_in[i];
    a.out = (float*)d_out; a.ws = (unsigned char*)d_ws;
#if ONE_LAUNCH
    a.ph_lo = 0; a.ph_hi = NPHASE; a.use_bar = 1; a.flags = 0;
    hipLaunchKernelGGL(mega_fwd, dim3(grid), dim3(NWAVES * 64), LDS_BYTES, stream, a);
#else
    const float* x = a.in[0]; unsigned char* ws = a.ws; float* out = a.out;
    float* mod = (float*)(ws + WS_MOD); float* lam = (float*)(ws + WS_LAM);
    bf16_t* A0 = (bf16_t*)(ws + WS_S0); bf16_t* US = (bf16_t*)(ws + WS_S1); bf16_t* SZ = (bf16_t*)(ws + WS_S3); bf16_t* YG = (bf16_t*)(ws + WS_S4);
    bf16_t* Y2 = (bf16_t*)(ws + WS_S0); bf16_t* YO = (bf16_t*)(ws + WS_S1); bf16_t* AKV = (bf16_t*)(ws + WS_S0); bf16_t* AIN1 = (bf16_t*)(ws + WS_S2);
    bf16_t* KB = (bf16_t*)(ws + WS_S3); bf16_t* VB = (bf16_t*)(ws + WS_S4); bf16_t* QB = (bf16_t*)(ws + WS_S5); bf16_t* SZ1 = (bf16_t*)(ws + WS_S6);
    bf16_t* O0 = (bf16_t*)(ws + WS_S0); bf16_t* O1 = (bf16_t*)(ws + WS_S1); bf16_t* OG = (bf16_t*)(ws + WS_S2); bf16_t* YO1 = (bf16_t*)(ws + WS_S0);
    const int EG = 2048;
    auto fast1 = [&](int lo, int hi, int flags) { a.ph_lo = lo; a.ph_hi = hi; a.use_bar = 0; a.flags = flags; hipLaunchKernelGGL(mega_fwd, dim3(grid), dim3(NWAVES * 64), LDS_BYTES, stream, a); };
    auto fast = [&](int lo, int hi, int flags) { fast1(lo, hi, flags); if (lo == EXTRA_PHASE) fast1(lo, hi, flags); };
    const unsigned FM = FASTMASK;
    if (FM & 1u) fast(0, 1, 0);
    else { fast(0, 1, 1); n_adaln<<<(2 * 8 * 3072 + 255) / 256, 256, 0, stream>>>(a.in[1], a.in[2], a.in[3], mod); n_lambda<<<1, 64, 0, stream>>>(a.in[22], a.in[23], a.in[24], a.in[25], lam); }
    if (FM & 2u) fast(1, 2, 0); else n_norm0<<<EG, 256, 0, stream>>>(x, mod, a.in[4], A0);
    if (FM & 4u) fast(2, 3, 0); else n_gemm<<<dim3(2048 / 64, MTOK / 64), 256, 0, stream>>>(AL_Row{A0}, WL_Plain{a.in[6], 2048}, EP_In0{US, SZ}, 2048);
    if (FM & 8u) { fast(3, 4, 0); fast(4, 5, 0); fast(5, 6, 0); }
    else n_ssm<<<NB * NGRP / 4, 256, 0, stream>>>(US, a.in[7], a.in[8], a.in[9], a.in[10], a.in[11], a.in[12], a.in[13], a.in[14], YG);
    if (FM & 64u) fast(6, 7, 0); else n_gemm<<<dim3(1024 / 64, MTOK / 64), 256, 0, stream>>>(AL_YG{YG}, WL_Plain{a.in[15], 1024}, EP_Glu{YG, SZ, a.in[16], Y2}, 1024);
    if (FM & 128u) fast(7, 8, 0); else n_gemm<<<dim3(1024 / 64, MTOK / 64), 256, 0, stream>>>(AL_Row{Y2}, WL_Plain{a.in[17], 1024}, EP_Plain{YO}, 1024);
    if (FM & 256u) fast(8, 9, 0); else n_mid<<<EG, 256, 0, stream>>>(x, YO, mod, a.in[5], a.in[4], out, AKV, AIN1);
    if (FM & 512u) fast(9, 10, 0);
    else { n_gemm<<<dim3(2048 / 64, MTOK / 64), 256, 0, stream>>>(AL_Row{AKV}, WL_KV{a.in[19], a.in[20], a.in[18]}, EP_KV{KB, VB}, 2048);
           n_gemm<<<dim3(2048 / 64, MTOK / 64), 256, 0, stream>>>(AL_Row{AIN1}, WL_Plain{a.in[21], 2048}, EP_In1{QB, SZ1}, 2048); }
    if (FM & 1024u) fast(10, 11, 0); else n_attn<<<MTOK * 8 / 4, 256, 0, stream>>>(QB, KB, VB, O0, O1);
    if (FM & 2048u) fast(11, 12, 0); else n_attn_post<<<EG, 256, 0, stream>>>(O0, O1, SZ1, a.in[26], lam, OG);
    if (FM & 4096u) fast(12, 13, 0); else n_gemm<<<dim3(1024 / 64, MTOK / 64), 256, 0, stream>>>(AL_Row{OG}, WL_Plain{a.in[27], 1024}, EP_Plain{YO1}, 1024);
    if (FM & 8192u) fast(13, 14, 0); else n_final<<<EG, 256, 0, stream>>>(out, YO1, mod, a.in[5]);
#endif
    const hipError_t le = hipPeekAtLastError();
    if (le != hipSuccess) fprintf(stderr, "kernel_launch: launch failed: %s\n", hipGetErrorName(le));
}
```

```cpp
#include <hip/hip_runtime.h>
#include <cstdio>
#include <cstdint>
#include <cmath>
#define FASTMASK 0x3fff
#define ONE_LAUNCH 1
#define REPEAT_MASK 0

typedef unsigned short bf16_t;
constexpr int NB = 8, SEQL = 4096, DM = 1024, MTOK = NB * SEQL;
constexpr int NGRP = 64, NTILE = MTOK / 16;
constexpr int US_P = 384, YG_P = 256;
constexpr float LAMBDA_INIT = 0.35550907f;
constexpr float ONE_M_LI = 1.0f - LAMBDA_INIT;
constexpr float RMS_EPS = 1e-6f;
constexpr float QC2 = 0.125f * 1.4426950408889634f;

__device__ __forceinline__ float bf2f(bf16_t v) { return __uint_as_float((unsigned)v << 16); }
__device__ __forceinline__ unsigned f2bf_u(float f) { unsigned u = __float_as_uint(f); return (u + 0x7fffu + ((u >> 16) & 1u)) >> 16; }
__device__ __forceinline__ bf16_t f2bf(float f) { return (bf16_t)f2bf_u(f); }
__device__ __forceinline__ unsigned pk2bf(float lo, float hi) { return f2bf_u(lo) | (f2bf_u(hi) << 16); }
__device__ __forceinline__ float silu_f(float v) { return v / (1.0f + __expf(-v)); }
__device__ __forceinline__ float sigmoid_f(float v) { return 1.0f / (1.0f + __expf(-v)); }
__device__ __forceinline__ float gelu_tanh_f(float v) {
    const float u = 0.7978845608028654f * (v + 0.044715f * v * v * v);
    const float e = __expf(2.0f * u);
    const float t = 1.0f - 2.0f / (e + 1.0f);
    return 0.5f * v * (1.0f + t);
}
__device__ __forceinline__ float wave_sum_f(float v) {
#pragma unroll
    for (int o = 1; o < 64; o <<= 1) v += __shfl_xor(v, o);
    return v;
}
__device__ __forceinline__ float wave_max_f(float v) {
#pragma unroll
    for (int o = 1; o < 64; o <<= 1) v = fmaxf(v, __shfl_xor(v, o));
    return v;
}
__device__ __forceinline__ size_t us_off(int g, int tile, int col) { return ((size_t)g * NTILE + tile) * US_P + col; }
__device__ __forceinline__ size_t yg_off(int g, int tile, int col) { return ((size_t)g * NTILE + tile) * YG_P + col; }

typedef float f32x4_t __attribute__((ext_vector_type(4)));
typedef unsigned u32x4_t __attribute__((ext_vector_type(4)));
typedef unsigned u32x2_t __attribute__((ext_vector_type(2)));
#ifndef USE_NT
#define USE_NT 1
#endif
#if USE_NT
#define NT_LD(p) __builtin_nontemporal_load(p)
#define NT_ST(p, v) __builtin_nontemporal_store((v), (p))
#else
#define NT_LD(p) (*(p))
#define NT_ST(p, v) (*(p) = (v))
#endif

__device__ __forceinline__ void e_norm0(const float* __restrict__ x, const float* __restrict__ mod, const float* __restrict__ g_pre, bf16_t* a0, int gw, int ngw, int lane) {
    for (int m = gw; m < MTOK; m += ngw) {
        const int b = m / SEQL;
        const f32x4_t* xr = (const f32x4_t*)(x + (size_t)m * DM) + lane;
        f32x4_t v[4]; float s = 0.f;
#pragma unroll
        for (int j = 0; j < 4; ++j) { v[j] = NT_LD(xr + 64 * j); s += (v[j].x * v[j].x + v[j].y * v[j].y) + (v[j].z * v[j].z + v[j].w * v[j].w); }
        const float r = rsqrtf(wave_sum_f(s) * (1.0f / DM) + RMS_EPS);
        const float* sh = mod + (size_t)b * 3072; const float* sc = sh + 1024;
        u32x2_t* o = (u32x2_t*)(a0 + (size_t)m * DM) + lane;
#pragma unroll
        for (int j = 0; j < 4; ++j) {
            const int c = 256 * j + 4 * lane;
            const f32x4_t g = *(const f32x4_t*)(g_pre + c), scv = *(const f32x4_t*)(sc + c), shv = *(const f32x4_t*)(sh + c);
            f32x4_t y = v[j] * r * g * (scv + 1.0f) + shv;
            u32x2_t w; w.x = pk2bf(y.x, y.y); w.y = pk2bf(y.z, y.w); o[64 * j] = w;
        }
    }
}
__device__ __forceinline__ void e_mid(const float* __restrict__ x, const bf16_t* __restrict__ yo, const float* __restrict__ mod, const float* __restrict__ g_post, const float* __restrict__ g_pre,
                                      float* h1, bf16_t* h1b, bf16_t* akv, bf16_t* ain1, int gw, int ngw, int lane) {
    for (int m = gw; m < MTOK; m += ngw) {
        const int b = m / SEQL;
        const f32x4_t* xr = (const f32x4_t*)(x + (size_t)m * DM) + lane;
        const u32x2_t* yr = (const u32x2_t*)(yo + (size_t)m * DM) + lane;
        f32x4_t v[4], y[4]; float s = 0.f;
#pragma unroll
        for (int j = 0; j < 4; ++j) { v[j] = NT_LD(xr + 64 * j); const u32x2_t w = NT_LD(yr + 64 * j);
            y[j].x = __uint_as_float(w.x << 16); y[j].y = __uint_as_float(w.x & 0xffff0000u); y[j].z = __uint_as_float(w.y << 16); y[j].w = __uint_as_float(w.y & 0xffff0000u);
            s += (y[j].x * y[j].x + y[j].y * y[j].y) + (y[j].z * y[j].z + y[j].w * y[j].w); }
        const float ry = rsqrtf(wave_sum_f(s) * (1.0f / DM) + RMS_EPS);
        const float* gate0 = mod + (size_t)b * 3072 + 2048;
        const float* sh1 = mod + (size_t)(8 + b) * 3072; const float* sc1 = sh1 + 1024;
        float s2 = 0.f;
        f32x4_t* ho = (f32x4_t*)(h1 + (size_t)m * DM) + lane;
#pragma unroll
        for (int j = 0; j < 4; ++j) { const int c = 256 * j + 4 * lane;
            const f32x4_t gp = *(const f32x4_t*)(g_post + c), gt = *(const f32x4_t*)(gate0 + c);
            v[j] = v[j] + gt * (y[j] * ry * gp);
            if (h1) NT_ST(ho + 64 * j, v[j]);
            if (h1b) { u32x2_t wq; wq.x = pk2bf(v[j].x, v[j].y); wq.y = pk2bf(v[j].z, v[j].w); ((u32x2_t*)(h1b + (size_t)m * DM) + lane)[64 * j] = wq; }
            s2 += (v[j].x * v[j].x + v[j].y * v[j].y) + (v[j].z * v[j].z + v[j].w * v[j].w); }
        const float rh = rsqrtf(wave_sum_f(s2) * (1.0f / DM) + RMS_EPS);
        u32x2_t* o1 = (u32x2_t*)(akv + (size_t)m * DM) + lane; u32x2_t* o2 = (u32x2_t*)(ain1 + (size_t)m * DM) + lane;
#pragma unroll
        for (int j = 0; j < 4; ++j) { const int c = 256 * j + 4 * lane;
            const f32x4_t n = v[j] * rh;
            u32x2_t w; w.x = pk2bf(n.x, n.y); w.y = pk2bf(n.z, n.w); o1[64 * j] = w;
            const f32x4_t g = *(const f32x4_t*)(g_pre + 1024 + c), scv = *(const f32x4_t*)(sc1 + c), shv = *(const f32x4_t*)(sh1 + c);
            const f32x4_t z = n * g * (scv + 1.0f) + shv;
            w.x = pk2bf(z.x, z.y); w.y = pk2bf(z.z, z.w); o2[64 * j] = w; }
    }
}
__device__ __forceinline__ void e_attn_post(const bf16_t* __restrict__ o0, const bf16_t* __restrict__ o1, const bf16_t* __restrict__ sz1, const float* __restrict__ g_sub, float lam,
                                            bf16_t* og, int gw, int ngw, int lane) {
    for (int m = gw; m < MTOK; m += ngw) {
#pragma unroll
        for (int j = 0; j < 2; ++j) {
            const int c = 512 * j + 8 * lane;
            const u32x4_t a = *(const u32x4_t*)(o0 + (size_t)m * DM + c), bq = *(const u32x4_t*)(o1 + (size_t)m * DM + c), zq = *(const u32x4_t*)(sz1 + (size_t)m * DM + c);
            float d[8]; float s = 0.f;
#pragma unroll
            for (int i = 0; i < 4; ++i) { const unsigned wa = a[i], wb = bq[i];
                d[2 * i] = __uint_as_float(wa << 16) - lam * __uint_as_float(wb << 16); d[2 * i + 1] = __uint_as_float(wa & 0xffff0000u) - lam * __uint_as_float(wb & 0xffff0000u);
                s += d[2 * i] * d[2 * i] + d[2 * i + 1] * d[2 * i + 1]; }
            s += __shfl_xor(s, 1); s += __shfl_xor(s, 2); s += __shfl_xor(s, 4); s += __shfl_xor(s, 8);
            const float r = rsqrtf(s * (1.0f / 128.0f) + RMS_EPS) * ONE_M_LI;
            const float* gs = g_sub + (c & 127);
            u32x4_t w;
#pragma unroll
            for (int i = 0; i < 4; ++i) { const unsigned wz = zq[i];
                const float z0 = __uint_as_float(wz << 16), z1 = __uint_as_float(wz & 0xffff0000u);
                w[i] = pk2bf(d[2 * i] * r * gs[2 * i] * z0, d[2 * i + 1] * r * gs[2 * i + 1] * z1); }
            *(u32x4_t*)(og + (size_t)m * DM + c) = w;
        }
    }
}
__device__ __forceinline__ void e_final(float* out, const bf16_t* __restrict__ yo1, const float* __restrict__ mod, const float* __restrict__ g_post, int gw, int ngw, int lane) {
    for (int m = gw; m < MTOK; m += ngw) {
        const int b = m / SEQL;
        f32x4_t* hr = (f32x4_t*)(out + (size_t)m * DM) + lane;
        const u32x2_t* yr = (const u32x2_t*)(yo1 + (size_t)m * DM) + lane;
        f32x4_t v[4], y[4]; float s = 0.f;
#pragma unroll
        for (int j = 0; j < 4; ++j) { v[j] = NT_LD(hr + 64 * j); const u32x2_t w = NT_LD(yr + 64 * j);
            y[j].x = __uint_as_float(w.x << 16); y[j].y = __uint_as_float(w.x & 0xffff0000u); y[j].z = __uint_as_float(w.y << 16); y[j].w = __uint_as_float(w.y & 0xffff0000u);
            s += (y[j].x * y[j].x + y[j].y * y[j].y) + (y[j].z * y[j].z + y[j].w * y[j].w); }
        const float ry = rsqrtf(wave_sum_f(s) * (1.0f / DM) + RMS_EPS);
        const float* gate1 = mod + (size_t)(8 + b) * 3072 + 2048;
#pragma unroll
        for (int j = 0; j < 4; ++j) { const int c = 256 * j + 4 * lane;
            const f32x4_t gp = *(const f32x4_t*)(g_post + 1024 + c), gt = *(const f32x4_t*)(gate1 + c);
            NT_ST(hr + 64 * j, v[j] + gt * (y[j] * ry * gp)); }
    }
}
__device__ __forceinline__ void e_final2(const float* __restrict__ x, const bf16_t* __restrict__ yo, const bf16_t* __restrict__ yo1, float* out, const float* __restrict__ mod, const float* __restrict__ g_post, int gw, int ngw, int lane) {
    for (int m = gw; m < MTOK; m += ngw) {
        const int b = m / SEQL;
        const f32x4_t* xr = (const f32x4_t*)(x + (size_t)m * DM) + lane;
        const u32x2_t* y0r = (const u32x2_t*)(yo + (size_t)m * DM) + lane; const u32x2_t* y1r = (const u32x2_t*)(yo1 + (size_t)m * DM) + lane;
        f32x4_t v[4], y0[4], y1[4]; float s0 = 0.f, s1 = 0.f;
#pragma unroll
        for (int j = 0; j < 4; ++j) { v[j] = xr[64 * j]; const u32x2_t w0 = y0r[64 * j], w1 = y1r[64 * j];
            y0[j].x = __uint_as_float(w0.x << 16); y0[j].y = __uint_as_float(w0.x & 0xffff0000u); y0[j].z = __uint_as_float(w0.y << 16); y0[j].w = __uint_as_float(w0.y & 0xffff0000u);
            y1[j].x = __uint_as_float(w1.x << 16); y1[j].y = __uint_as_float(w1.x & 0xffff0000u); y1[j].z = __uint_as_float(w1.y << 16); y1[j].w = __uint_as_float(w1.y & 0xffff0000u);
            s0 += (y0[j].x * y0[j].x + y0[j].y * y0[j].y) + (y0[j].z * y0[j].z + y0[j].w * y0[j].w);
            s1 += (y1[j].x * y1[j].x + y1[j].y * y1[j].y) + (y1[j].z * y1[j].z + y1[j].w * y1[j].w); }
        const float r0 = rsqrtf(wave_sum_f(s0) * (1.0f / DM) + RMS_EPS), r1 = rsqrtf(wave_sum_f(s1) * (1.0f / DM) + RMS_EPS);
        const float* gate0 = mod + (size_t)b * 3072 + 2048; const float* gate1 = mod + (size_t)(8 + b) * 3072 + 2048;
        f32x4_t* orow = (f32x4_t*)(out + (size_t)m * DM) + lane;
#pragma unroll
        for (int j = 0; j < 4; ++j) { const int c = 256 * j + 4 * lane;
            const f32x4_t gp0 = *(const f32x4_t*)(g_post + c), gt0 = *(const f32x4_t*)(gate0 + c), gp1 = *(const f32x4_t*)(g_post + 1024 + c), gt1 = *(const f32x4_t*)(gate1 + c);
            const f32x4_t h = v[j] + gt0 * (y0[j] * r0 * gp0);
            orow[64 * j] = h + gt1 * (y1[j] * r1 * gp1); }
    }
}
__device__ __forceinline__ void e_final_b(const bf16_t* __restrict__ h1b, float* out, const bf16_t* __restrict__ yo1, const float* __restrict__ mod, const float* __restrict__ g_post, int gw, int ngw, int lane) {
    for (int m = gw; m < MTOK; m += ngw) {
        const int b = m / SEQL;
        const u32x2_t* hr = (const u32x2_t*)(h1b + (size_t)m * DM) + lane;
        const u32x2_t* yr = (const u32x2_t*)(yo1 + (size_t)m * DM) + lane;
        f32x4_t v[4], y[4]; float s = 0.f;
#pragma unroll
        for (int j = 0; j < 4; ++j) { const u32x2_t hw = NT_LD(hr + 64 * j); const u32x2_t w = NT_LD(yr + 64 * j);
            v[j].x = __uint_as_float(hw.x << 16); v[j].y = __uint_as_float(hw.x & 0xffff0000u); v[j].z = __uint_as_float(hw.y << 16); v[j].w = __uint_as_float(hw.y & 0xffff0000u);
            y[j].x = __uint_as_float(w.x << 16); y[j].y = __uint_as_float(w.x & 0xffff0000u); y[j].z = __uint_as_float(w.y << 16); y[j].w = __uint_as_float(w.y & 0xffff0000u);
            s += (y[j].x * y[j].x + y[j].y * y[j].y) + (y[j].z * y[j].z + y[j].w * y[j].w); }
        const float ry = rsqrtf(wave_sum_f(s) * (1.0f / DM) + RMS_EPS);
        const float* gate1 = mod + (size_t)(8 + b) * 3072 + 2048;
        f32x4_t* orow = (f32x4_t*)(out + (size_t)m * DM) + lane;
#pragma unroll
        for (int j = 0; j < 4; ++j) { const int c = 256 * j + 4 * lane;
            const f32x4_t gp = *(const f32x4_t*)(g_post + 1024 + c), gt = *(const f32x4_t*)(gate1 + c);
            NT_ST(orow + 64 * j, v[j] + gt * (y[j] * ry * gp)); }
    }
}

#define ER 2
__device__ __forceinline__ void unpk4(const u32x2_t w, f32x4_t& y) { y.x = __uint_as_float(w.x << 16); y.y = __uint_as_float(w.x & 0xffff0000u); y.z = __uint_as_float(w.y << 16); y.w = __uint_as_float(w.y & 0xffff0000u); }
__device__ __forceinline__ float ssq4(const f32x4_t v) { return (v.x * v.x + v.y * v.y) + (v.z * v.z + v.w * v.w); }
__device__ __forceinline__ void e_norm0_r(const float* __restrict__ x, const float* __restrict__ mod, const float* __restrict__ g_pre, bf16_t* a0, int gw, int ngw, int lane) {
    for (int m0 = gw; m0 < MTOK; m0 += ER * ngw) {
        f32x4_t v[ER][4]; float s[ER];
#pragma unroll
        for (int r = 0; r < ER; ++r) { const int m = min(m0 + r * ngw, MTOK - 1); const f32x4_t* xr = (const f32x4_t*)(x + (size_t)m * DM) + lane;
#pragma unroll
            for (int j = 0; j < 4; ++j) v[r][j] = NT_LD(xr + 64 * j); }
#pragma unroll
        for (int r = 0; r < ER; ++r) { s[r] = 0.f;
#pragma unroll
            for (int j = 0; j < 4; ++j) s[r] += ssq4(v[r][j]); }
#pragma unroll
        for (int r = 0; r < ER; ++r) { const int m = m0 + r * ngw; if (m >= MTOK) break;
            const int b = m / SEQL; const float rr = rsqrtf(wave_sum_f(s[r]) * (1.0f / DM) + RMS_EPS);
            const float* sh = mod + (size_t)b * 3072; const float* sc = sh + 1024;
            u32x2_t* o = (u32x2_t*)(a0 + (size_t)m * DM) + lane;
#pragma unroll
            for (int j = 0; j < 4; ++j) { const int c = 256 * j + 4 * lane;
                const f32x4_t g = *(const f32x4_t*)(g_pre + c), scv = *(const f32x4_t*)(sc + c), shv = *(const f32x4_t*)(sh + c);
                const f32x4_t y = v[r][j] * rr * g * (scv + 1.0f) + shv;
                u32x2_t w; w.x = pk2bf(y.x, y.y); w.y = pk2bf(y.z, y.w); o[64 * j] = w; } }
    }
}
__device__ __forceinline__ void e_mid_r(const float* __restrict__ x, const bf16_t* __restrict__ yo, const float* __restrict__ mod, const float* __restrict__ g_post, const float* __restrict__ g_pre,
                                        float* h1, bf16_t* akv, bf16_t* ain1, int gw, int ngw, int lane) {
    for (int m0 = gw; m0 < MTOK; m0 += ER * ngw) {
        f32x4_t v[ER][4], y[ER][4]; float s[ER];
#pragma unroll
        for (int r = 0; r < ER; ++r) { const int m = min(m0 + r * ngw, MTOK - 1); const f32x4_t* xr = (const f32x4_t*)(x + (size_t)m * DM) + lane; const u32x2_t* yr = (const u32x2_t*)(yo + (size_t)m * DM) + lane;
#pragma unroll
            for (int j = 0; j < 4; ++j) { v[r][j] = NT_LD(xr + 64 * j); unpk4(NT_LD(yr + 64 * j), y[r][j]); } }
#pragma unroll
        for (int r = 0; r < ER; ++r) { s[r] = 0.f;
#pragma unroll
            for (int j = 0; j < 4; ++j) s[r] += ssq4(y[r][j]); }
#pragma unroll
        for (int r = 0; r < ER; ++r) { const int m = m0 + r * ngw; if (m >= MTOK) break;
            const int b = m / SEQL; const float ry = rsqrtf(wave_sum_f(s[r]) * (1.0f / DM) + RMS_EPS);
            const float* gate0 = mod + (size_t)b * 3072 + 2048; const float* sh1 = mod + (size_t)(8 + b) * 3072; const float* sc1 = sh1 + 1024;
            float s2 = 0.f; f32x4_t* ho = (f32x4_t*)(h1 + (size_t)m * DM) + lane;
#pragma unroll
            for (int j = 0; j < 4; ++j) { const int c = 256 * j + 4 * lane;
                const f32x4_t gp = *(const f32x4_t*)(g_post + c), gt = *(const f32x4_t*)(gate0 + c);
                v[r][j] = v[r][j] + gt * (y[r][j] * ry * gp); NT_ST(ho + 64 * j, v[r][j]); s2 += ssq4(v[r][j]); }
            const float rh = rsqrtf(wave_sum_f(s2) * (1.0f / DM) + RMS_EPS);
            u32x2_t* o1 = (u32x2_t*)(akv + (size_t)m * DM) + lane; u32x2_t* o2 = (u32x2_t*)(ain1 + (size_t)m * DM) + lane;
#pragma unroll
            for (int j = 0; j < 4; ++j) { const int c = 256 * j + 4 * lane;
                const f32x4_t nn = v[r][j] * rh; u32x2_t w; w.x = pk2bf(nn.x, nn.y); w.y = pk2bf(nn.z, nn.w); o1[64 * j] = w;
                const f32x4_t g = *(const f32x4_t*)(g_pre + 1024 + c), scv = *(const f32x4_t*)(sc1 + c), shv = *(const f32x4_t*)(sh1 + c);
                const f32x4_t z = nn * g * (scv + 1.0f) + shv; w.x = pk2bf(z.x, z.y); w.y = pk2bf(z.z, z.w); o2[64 * j] = w; } }
    }
}
__device__ __forceinline__ void e_final_r(float* out, const bf16_t* __restrict__ yo1, const float* __restrict__ mod, const float* __restrict__ g_post, int gw, int ngw, int lane) {
    for (int m0 = gw; m0 < MTOK; m0 += ER * ngw) {
        f32x4_t v[ER][4], y[ER][4]; float s[ER];
#pragma unroll
        for (int r = 0; r < ER; ++r) { const int m = min(m0 + r * ngw, MTOK - 1); const f32x4_t* hr = (const f32x4_t*)(out + (size_t)m * DM) + lane; const u32x2_t* yr = (const u32x2_t*)(yo1 + (size_t)m * DM) + lane;
#pragma unroll
            for (int j = 0; j < 4; ++j) { v[r][j] = NT_LD(hr + 64 * j); unpk4(NT_LD(yr + 64 * j), y[r][j]); } }
#pragma unroll
        for (int r = 0; r < ER; ++r) { s[r] = 0.f;
#pragma unroll
            for (int j = 0; j < 4; ++j) s[r] += ssq4(y[r][j]); }
#pragma unroll
        for (int r = 0; r < ER; ++r) { const int m = m0 + r * ngw; if (m >= MTOK) break;
            const int b = m / SEQL; const float ry = rsqrtf(wave_sum_f(s[r]) * (1.0f / DM) + RMS_EPS);
            const float* gate1 = mod + (size_t)(8 + b) * 3072 + 2048; f32x4_t* hr = (f32x4_t*)(out + (size_t)m * DM) + lane;
#pragma unroll
            for (int j = 0; j < 4; ++j) { const int c = 256 * j + 4 * lane;
                const f32x4_t gp = *(const f32x4_t*)(g_post + 1024 + c), gt = *(const f32x4_t*)(gate1 + c);
                NT_ST(hr + 64 * j, v[r][j] + gt * (y[r][j] * ry * gp)); } }
    }
}

__device__ __forceinline__ void unpk4b(const u32x2_t w, f32x4_t& y) { y.x = __uint_as_float(w.x << 16); y.y = __uint_as_float(w.x & 0xffff0000u); y.z = __uint_as_float(w.y << 16); y.w = __uint_as_float(w.y & 0xffff0000u); }
__device__ __forceinline__ float ssq4b(const f32x4_t v) { return (v.x * v.x + v.y * v.y) + (v.z * v.z + v.w * v.w); }
__device__ __forceinline__ void e_norm0_b(const float* __restrict__ x, const float* __restrict__ mod, const float* __restrict__ g_pre, bf16_t* a0, int gw, int ngw, int lane) {
    for (int b = 0; b < NB; ++b) {
        const float* sh = mod + (size_t)b * 3072; const float* sc = sh + 1024;
        f32x4_t G[4], SH[4];
#pragma unroll
        for (int j = 0; j < 4; ++j) { const int c = 256 * j + 4 * lane; G[j] = *(const f32x4_t*)(g_pre + c) * (*(const f32x4_t*)(sc + c) + 1.0f); SH[j] = *(const f32x4_t*)(sh + c); }
        for (int r0 = gw; r0 < SEQL; r0 += 2 * ngw) {
            const int ra = r0, rb = r0 + ngw; const bool hb = rb < SEQL;
            const int ma = b * SEQL + ra, mb = b * SEQL + (hb ? rb : ra);
            f32x4_t va[4], vb[4];
            const f32x4_t* xa = (const f32x4_t*)(x + (size_t)ma * DM) + lane; const f32x4_t* xb = (const f32x4_t*)(x + (size_t)mb * DM) + lane;
#pragma unroll
            for (int j = 0; j < 4; ++j) { va[j] = NT_LD(xa + 64 * j); vb[j] = NT_LD(xb + 64 * j); }
            float sa = 0.f, sb = 0.f;
#pragma unroll
            for (int j = 0; j < 4; ++j) { sa += ssq4b(va[j]); sb += ssq4b(vb[j]); }
            const float rra = rsqrtf(wave_sum_f(sa) * (1.0f / DM) + RMS_EPS), rrb = rsqrtf(wave_sum_f(sb) * (1.0f / DM) + RMS_EPS);
            u32x2_t* oa = (u32x2_t*)(a0 + (size_t)ma * DM) + lane; u32x2_t* ob = (u32x2_t*)(a0 + (size_t)mb * DM) + lane;
#pragma unroll
            for (int j = 0; j < 4; ++j) { const f32x4_t y = va[j] * rra * G[j] + SH[j]; u32x2_t w; w.x = pk2bf(y.x, y.y); w.y = pk2bf(y.z, y.w); oa[64 * j] = w; }
            if (hb) {
#pragma unroll
                for (int j = 0; j < 4; ++j) { const f32x4_t y = vb[j] * rrb * G[j] + SH[j]; u32x2_t w; w.x = pk2bf(y.x, y.y); w.y = pk2bf(y.z, y.w); ob[64 * j] = w; } }
        }
    }
}
__device__ __forceinline__ void e_mid_b(const float* __restrict__ x, const bf16_t* __restrict__ yo, const float* __restrict__ mod, const float* __restrict__ g_post, const float* __restrict__ g_pre,
                                        float* h1, bf16_t* akv, bf16_t* ain1, int gw, int ngw, int lane, float* hnorm = nullptr) {
    for (int b = 0; b < NB; ++b) {
        const float* gate0 = mod + (size_t)b * 3072 + 2048; const float* sh1 = mod + (size_t)(8 + b) * 3072; const float* sc1 = sh1 + 1024;
        f32x4_t GG[4], GF[4], SH[4];
#pragma unroll
        for (int j = 0; j < 4; ++j) { const int c = 256 * j + 4 * lane; GG[j] = *(const f32x4_t*)(gate0 + c) * *(const f32x4_t*)(g_post + c);
            GF[j] = *(const f32x4_t*)(g_pre + 1024 + c) * (*(const f32x4_t*)(sc1 + c) + 1.0f); SH[j] = *(const f32x4_t*)(sh1 + c); }
        for (int r0 = gw; r0 < SEQL; r0 += 2 * ngw) {
            const int ra = r0, rb = r0 + ngw; const bool hb = rb < SEQL;
            const int mr[2] = {b * SEQL + ra, b * SEQL + (hb ? rb : ra)};
            f32x4_t v[2][4], y[2][4];
#pragma unroll
            for (int q = 0; q < 2; ++q) { const f32x4_t* xr = (const f32x4_t*)(x + (size_t)mr[q] * DM) + lane; const u32x2_t* yr = (const u32x2_t*)(yo + (size_t)mr[q] * DM) + lane;
#pragma unroll
                for (int j = 0; j < 4; ++j) { v[q][j] = NT_LD(xr + 64 * j); unpk4b(NT_LD(yr + 64 * j), y[q][j]); } }
            float s[2] = {0.f, 0.f};
#pragma unroll
            for (int q = 0; q < 2; ++q)
#pragma unroll
                for (int j = 0; j < 4; ++j) s[q] += ssq4b(y[q][j]);
            float ry[2]; ry[0] = rsqrtf(wave_sum_f(s[0]) * (1.0f / DM) + RMS_EPS); ry[1] = rsqrtf(wave_sum_f(s[1]) * (1.0f / DM) + RMS_EPS);
            float s2[2] = {0.f, 0.f};
#pragma unroll
            for (int q = 0; q < 2; ++q)
#pragma unroll
                for (int j = 0; j < 4; ++j) { v[q][j] = v[q][j] + GG[j] * (y[q][j] * ry[q]); s2[q] += ssq4b(v[q][j]); }
            float rh[2]; rh[0] = rsqrtf(wave_sum_f(s2[0]) * (1.0f / DM) + RMS_EPS); rh[1] = rsqrtf(wave_sum_f(s2[1]) * (1.0f / DM) + RMS_EPS);
            if (hnorm && lane == 0) { hnorm[mr[0]] = 1.0f / rh[0]; if (hb) hnorm[mr[1]] = 1.0f / rh[1]; }
#pragma unroll
            for (int q = 0; q < 2; ++q) { if (q == 1 && !hb) break;
                f32x4_t* ho = (f32x4_t*)(h1 + (size_t)mr[q] * DM) + lane; u32x2_t* o1 = (u32x2_t*)(akv + (size_t)mr[q] * DM) + lane; u32x2_t* o2 = (u32x2_t*)(ain1 + (size_t)mr[q] * DM) + lane;
#pragma unroll
                for (int j = 0; j < 4; ++j) { if (h1) NT_ST(ho + 64 * j, v[q][j]);
                    const f32x4_t nn = v[q][j] * rh[q]; u32x2_t w; w.x = pk2bf(nn.x, nn.y); w.y = pk2bf(nn.z, nn.w); o1[64 * j] = w;
                    const f32x4_t z = nn * GF[j] + SH[j]; w.x = pk2bf(z.x, z.y); w.y = pk2bf(z.z, z.w); o2[64 * j] = w; } }
        }
    }
}
__device__ __forceinline__ void e_final_bm(float* out, const bf16_t* __restrict__ yo1, const float* __restrict__ mod, const float* __restrict__ g_post, int gw, int ngw, int lane) {
    for (int b = 0; b < NB; ++b) {
        const float* gate1 = mod + (size_t)(8 + b) * 3072 + 2048;
        f32x4_t GG[4];
#pragma unroll
        for (int j = 0; j < 4; ++j) { const int c = 256 * j + 4 * lane; GG[j] = *(const f32x4_t*)(gate1 + c) * *(const f32x4_t*)(g_post + 1024 + c); }
        for (int r0 = gw; r0 < SEQL; r0 += 2 * ngw) {
            const int ra = r0, rb = r0 + ngw; const bool hb = rb < SEQL;
            const int mr[2] = {b * SEQL + ra, b * SEQL + (hb ? rb : ra)};
            f32x4_t v[2][4], y[2][4];
#pragma unroll
            for (int q = 0; q < 2; ++q) { const f32x4_t* hr = (const f32x4_t*)(out + (size_t)mr[q] * DM) + lane; const u32x2_t* yr = (const u32x2_t*)(yo1 + (size_t)mr[q] * DM) + lane;
#pragma unroll
                for (int j = 0; j < 4; ++j) { v[q][j] = NT_LD(hr + 64 * j); unpk4b(NT_LD(yr + 64 * j), y[q][j]); } }
            float s[2] = {0.f, 0.f};
#pragma unroll
            for (int q = 0; q < 2; ++q)
#pragma unroll
                for (int j = 0; j < 4; ++j) s[q] += ssq4b(y[q][j]);
            float ry[2]; ry[0] = rsqrtf(wave_sum_f(s[0]) * (1.0f / DM) + RMS_EPS); ry[1] = rsqrtf(wave_sum_f(s[1]) * (1.0f / DM) + RMS_EPS);
#pragma unroll
            for (int q = 0; q < 2; ++q) { if (q == 1 && !hb) break;
                f32x4_t* hr = (f32x4_t*)(out + (size_t)mr[q] * DM) + lane;
#pragma unroll
                for (int j = 0; j < 4; ++j) NT_ST(hr + 64 * j, v[q][j] + GG[j] * (y[q][j] * ry[q])); }
        }
    }
}
__device__ __forceinline__ void e_final_x(const float* __restrict__ x, const bf16_t* __restrict__ yo, const bf16_t* __restrict__ yo1, float* out, const float* __restrict__ mod, const float* __restrict__ g_post, int gw, int ngw, int lane) {
    for (int b = 0; b < NB; ++b) {
        const float* gate0 = mod + (size_t)b * 3072 + 2048; const float* gate1 = mod + (size_t)(8 + b) * 3072 + 2048;
        f32x4_t G0[4], G1[4];
#pragma unroll
        for (int j = 0; j < 4; ++j) { const int c = 256 * j + 4 * lane; G0[j] = *(const f32x4_t*)(gate0 + c) * *(const f32x4_t*)(g_post + c); G1[j] = *(const f32x4_t*)(gate1 + c) * *(const f32x4_t*)(g_post + 1024 + c); }
        for (int r0 = gw; r0 < SEQL; r0 += 2 * ngw) {
            const int ra = r0, rb = r0 + ngw; const bool hb = rb < SEQL;
            const int mr[2] = {b * SEQL + ra, b * SEQL + (hb ? rb : ra)};
            f32x4_t v[2][4], y0[2][4], y1[2][4];
#pragma unroll
            for (int q = 0; q < 2; ++q) { const f32x4_t* xr = (const f32x4_t*)(x + (size_t)mr[q] * DM) + lane; const u32x2_t* ar = (const u32x2_t*)(yo + (size_t)mr[q] * DM) + lane; const u32x2_t* br = (const u32x2_t*)(yo1 + (size_t)mr[q] * DM) + lane;
#pragma unroll
                for (int j = 0; j < 4; ++j) { v[q][j] = NT_LD(xr + 64 * j); unpk4b(NT_LD(ar + 64 * j), y0[q][j]); unpk4b(NT_LD(br + 64 * j), y1[q][j]); } }
            float s0[2] = {0.f, 0.f}, s1[2] = {0.f, 0.f};
#pragma unroll
            for (int q = 0; q < 2; ++q)
#pragma unroll
                for (int j = 0; j < 4; ++j) { s0[q] += ssq4b(y0[q][j]); s1[q] += ssq4b(y1[q][j]); }
            float r0_[2], r1_[2];
#pragma unroll
            for (int q = 0; q < 2; ++q) { r0_[q] = rsqrtf(wave_sum_f(s0[q]) * (1.0f / DM) + RMS_EPS); r1_[q] = rsqrtf(wave_sum_f(s1[q]) * (1.0f / DM) + RMS_EPS); }
#pragma unroll
            for (int q = 0; q < 2; ++q) { if (q == 1 && !hb) break;
                f32x4_t* orow = (f32x4_t*)(out + (size_t)mr[q] * DM) + lane;
#pragma unroll
                for (int j = 0; j < 4; ++j) { const f32x4_t h = v[q][j] + G0[j] * (y0[q][j] * r0_[q]); NT_ST(orow + 64 * j, h + G1[j] * (y1[q][j] * r1_[q])); } }
        }
    }
}
__device__ __forceinline__ void e_final_k(const bf16_t* __restrict__ akv, const float* __restrict__ hnorm, const bf16_t* __restrict__ yo1, float* out, const float* __restrict__ mod, const float* __restrict__ g_post, int gw, int ngw, int lane) {
    for (int b = 0; b < NB; ++b) {
        const float* gate1 = mod + (size_t)(8 + b) * 3072 + 2048;
        f32x4_t G1[4];
#pragma unroll
        for (int j = 0; j < 4; ++j) { const int c = 256 * j + 4 * lane; G1[j] = *(const f32x4_t*)(gate1 + c) * *(const f32x4_t*)(g_post + 1024 + c); }
        for (int r0 = gw; r0 < SEQL; r0 += 2 * ngw) {
            const int ra = r0, rb = r0 + ngw; const bool hb = rb < SEQL;
            const int mr[2] = {b * SEQL + ra, b * SEQL + (hb ? rb : ra)};
            f32x4_t v[2][4], y1[2][4]; float hn[2];
#pragma unroll
            for (int q = 0; q < 2; ++q) { const u32x2_t* ar = (const u32x2_t*)(akv + (size_t)mr[q] * DM) + lane; const u32x2_t* br = (const u32x2_t*)(yo1 + (size_t)mr[q] * DM) + lane; hn[q] = hnorm[mr[q]];
#pragma unroll
                for (int j = 0; j < 4; ++j) { unpk4b(NT_LD(ar + 64 * j), v[q][j]); unpk4b(NT_LD(br + 64 * j), y1[q][j]); } }
            float s1[2] = {0.f, 0.f};
#pragma unroll
            for (int q = 0; q < 2; ++q)
#pragma unroll
                for (int j = 0; j < 4; ++j) s1[q] += ssq4b(y1[q][j]);
            float r1_[2];
#pragma unroll
            for (int q = 0; q < 2; ++q) r1_[q] = rsqrtf(wave_sum_f(s1[q]) * (1.0f / DM) + RMS_EPS);
#pragma unroll
            for (int q = 0; q < 2; ++q) { if (q == 1 && !hb) break;
                f32x4_t* orow = (f32x4_t*)(out + (size_t)mr[q] * DM) + lane;
#pragma unroll
                for (int j = 0; j < 4; ++j) NT_ST(orow + 64 * j, v[q][j] * hn[q] + G1[j] * (y1[q][j] * r1_[q])); }
        }
    }
}
__device__ __forceinline__ float diff_lambda(const float* lq1, const float* lk1, const float* lq2, const float* lk2) {
    float s1 = 0.f, s2 = 0.f;
    for (int i = 0; i < 64; ++i) { s1 += lq1[i] * lk1[i]; s2 += lq2[i] * lk2[i]; }
    return expf(s1) - expf(s2) + LAMBDA_INIT;
}

__global__ void n_adaln(const float* __restrict__ c, const float* __restrict__ ada_w, const float* __restrict__ ada_b, float* mod) {
    const int idx = blockIdx.x * 256 + threadIdx.x;
    if (idx >= 2 * 8 * 3072) return;
    const int j = idx % 3072, b = (idx / 3072) % 8, l = idx / (3072 * 8);
    float acc = ada_b[l * 3072 + j];
    const float* w = ada_w + (size_t)l * 1024 * 3072 + j; const float* cb = c + b * 1024;
    for (int k = 0; k < 1024; ++k) acc += silu_f(cb[k]) * w[(size_t)k * 3072];
    mod[idx] = acc;
}
__global__ void n_lambda(const float* lq1, const float* lk1, const float* lq2, const float* lk2, float* out) {
    if (threadIdx.x == 0 && blockIdx.x == 0) out[0] = diff_lambda(lq1, lk1, lq2, lk2);
}
__global__ void n_norm0(const float* x, const float* mod, const float* g_pre, bf16_t* a0) {
    e_norm0(x, mod, g_pre, a0, blockIdx.x * 4 + (threadIdx.x >> 6), gridDim.x * 4, threadIdx.x & 63);
}
__global__ void n_mid(const float* x, const bf16_t* yo, const float* mod, const float* g_post, const float* g_pre, float* h1, bf16_t* akv, bf16_t* ain1) {
    e_mid(x, yo, mod, g_post, g_pre, h1, (bf16_t*)nullptr, akv, ain1, blockIdx.x * 4 + (threadIdx.x >> 6), gridDim.x * 4, threadIdx.x & 63);
}
__global__ void n_attn_post(const bf16_t* o0, const bf16_t* o1, const bf16_t* sz1, const float* g_sub, const float* lamp, bf16_t* og) {
    e_attn_post(o0, o1, sz1, g_sub, lamp[0], og, blockIdx.x * 4 + (threadIdx.x >> 6), gridDim.x * 4, threadIdx.x & 63);
}
__global__ void n_final(float* out, const bf16_t* yo1, const float* mod, const float* g_post) {
    e_final(out, yo1, mod, g_post, blockIdx.x * 4 + (threadIdx.x >> 6), gridDim.x * 4, threadIdx.x & 63);
}

struct AL_Row { const bf16_t* A; __device__ float ld(int m, int k) const { return bf2f(A[(size_t)m * DM + k]); } };
struct AL_YG  { const bf16_t* A; __device__ float ld(int m, int k) const { return bf2f(A[yg_off(k >> 4, m >> 4, (m & 15) * 16 + (k & 15))]); } };
struct WL_Plain { const float* W; long N; __device__ float ld(int k, int n) const { return W[(size_t)k * N + n]; } };
struct WL_KV { const float* wk; const float* wv; const float* g; __device__ float ld(int k, int n) const { return g[k] * (n < 1024 ? wk[(size_t)k * 1024 + n] : wv[(size_t)k * 1024 + n - 1024]); } };
struct EP_In0 { bf16_t* US; bf16_t* SZ; __device__ void st(int m, int n, float a) const {
    if (n < 1024) US[us_off(n >> 4, m >> 4, (m & 15) * 16 + (n & 15))] = f2bf(a); else SZ[(size_t)m * DM + n - 1024] = f2bf(silu_f(a)); } };
struct EP_Glu { const bf16_t* YG; const bf16_t* SZ; const float* bias; bf16_t* Y2; __device__ void st(int m, int n, float a) const {
    const float yv = bf2f(YG[yg_off(n >> 4, m >> 4, (m & 15) * 16 + (n & 15))]); const float t = a + bias[n];
    Y2[(size_t)m * DM + n] = f2bf(yv * sigmoid_f(t) * bf2f(SZ[(size_t)m * DM + n])); } };
struct EP_Plain { bf16_t* O; __device__ void st(int m, int n, float a) const { O[(size_t)m * DM + n] = f2bf(a); } };
struct EP_KV { bf16_t* K; bf16_t* V; __device__ void st(int m, int n, float a) const { if (n < 1024) K[(size_t)m * DM + n] = f2bf(a); else V[(size_t)m * DM + n - 1024] = f2bf(a); } };
struct EP_In1 { bf16_t* Q; bf16_t* SZ1; __device__ void st(int m, int n, float a) const { if (n < 1024) Q[(size_t)m * DM + n] = f2bf(a * QC2); else SZ1[(size_t)m * DM + n - 1024] = f2bf(silu_f(a)); } };

template <class AL, class WL, class EP>
__global__ void __launch_bounds__(256) n_gemm(AL al, WL wl, EP ep, int N) {
    __shared__ float As[16][68]; __shared__ float Ws[16][68];
    const int tid = threadIdx.x, tx = tid & 15, ty = tid >> 4;
    const int m0 = blockIdx.y * 64, n0 = blockIdx.x * 64;
    float acc[4][4];
#pragma unroll
    for (int i = 0; i < 4; ++i)
#pragma unroll
        for (int j = 0; j < 4; ++j) acc[i][j] = 0.f;
    for (int k0 = 0; k0 < 1024; k0 += 16) {
#pragma unroll
        for (int i = 0; i < 4; ++i) { const int e = tid + 256 * i; const int mm = e >> 4, kk = e & 15; As[kk][mm] = al.ld(m0 + mm, k0 + kk); }
#pragma unroll
        for (int i = 0; i < 4; ++i) { const int e = tid + 256 * i; const int kk = e >> 6, nn = e & 63; Ws[kk][nn] = wl.ld(k0 + kk, n0 + nn); }
        __syncthreads();
#pragma unroll
        for (int kk = 0; kk < 16; ++kk) {
            float a[4], b[4];
#pragma unroll
            for (int i = 0; i < 4; ++i) { a[i] = As[kk][ty * 4 + i]; b[i] = Ws[kk][tx * 4 + i]; }
#pragma unroll
            for (int i = 0; i < 4; ++i)
#pragma unroll
                for (int j = 0; j < 4; ++j) acc[i][j] += a[i] * b[j];
        }
        __syncthreads();
    }
#pragma unroll
    for (int i = 0; i < 4; ++i)
#pragma unroll
        for (int j = 0; j < 4; ++j) ep.st(m0 + ty * 4 + i, n0 + tx * 4 + j, acc[i][j]);
}

__global__ void __launch_bounds__(256) n_ssm(const bf16_t* __restrict__ US, const float* lam_re, const float* lam_im, const float* log_dt, const float* b_re, const float* b_im,
                                             const float* c_re, const float* c_im, const float* d_skip, bf16_t* YG) {
    const int wv = blockIdx.x * 4 + (threadIdx.x >> 6), lane = threadIdx.x & 63;
    if (wv >= NB * NGRP) return;
    const int b = wv / NGRP, g = wv % NGRP, p = lane;
    const float dt = expf(log_dt[g]);
    const float lr = lam_re[g * 64 + p], li = lam_im[g * 64 + p];
    const float mag = expf(lr * dt); float sn, cs; sn = sinf(li * dt); cs = cosf(li * dt);
    const float lbr = mag * cs, lbi = mag * sn;
    const float nr = lbr - 1.0f, ni = lbi, den = lr * lr + li * li;
    const float cr = (nr * lr + ni * li) / den, ci = (ni * lr - nr * li) / den;
    float bbr[16], bbi[16], ccr[16], cci[16];
#pragma unroll
    for (int c = 0; c < 16; ++c) { const float br = b_re[(g * 64 + p) * 16 + c], bi = b_im[(g * 64 + p) * 16 + c];
        bbr[c] = cr * br - ci * bi; bbi[c] = cr * bi + ci * br;
        ccr[c] = c_re[(g * 16 + c) * 64 + p]; cci[c] = c_im[(g * 16 + c) * 64 + p]; }
    const float dsk = d_skip[g * 16 + (lane & 15)];
    float sr = 0.f, si = 0.f;
    for (int t = 0; t < SEQL; ++t) {
        const int m = b * SEQL + t;
        const bf16_t* up = US + us_off(g, m >> 4, (m & 15) * 16);
        float u[16];
        { const u32x4_t w0 = *(const u32x4_t*)up, w1 = *(const u32x4_t*)(up + 8);
#pragma unroll
          for (int i = 0; i < 4; ++i) { u[2 * i] = __uint_as_float(w0[i] << 16); u[2 * i + 1] = __uint_as_float(w0[i] & 0xffff0000u); u[8 + 2 * i] = __uint_as_float(w1[i] << 16); u[8 + 2 * i + 1] = __uint_as_float(w1[i] & 0xffff0000u); } }
        float bur = 0.f, bui = 0.f;
#pragma unroll
        for (int c = 0; c < 16; ++c) { bur += bbr[c] * u[c]; bui += bbi[c] * u[c]; }
        const float nsr = lbr * sr - lbi * si + bur, nsi = lbr * si + lbi * sr + bui; sr = nsr; si = nsi;
        float yv = 0.f;
#pragma unroll
        for (int c = 0; c < 16; ++c) { const float part = wave_sum_f(ccr[c] * sr - cci[c] * si); if ((lane & 15) == c) yv = part; }
        if (lane < 16) { const float yy = yv + dsk * bf2f(up[lane]); YG[yg_off(g, m >> 4, (m & 15) * 16 + lane)] = f2bf(gelu_tanh_f(yy)); }
    }
}

__global__ void __launch_bounds__(256) n_attn(const bf16_t* __restrict__ Q, const bf16_t* __restrict__ K, const bf16_t* __restrict__ V, bf16_t* O0, bf16_t* O1) {
    __shared__ float qs[4][128];
    const int w = threadIdx.x >> 6, lane = threadIdx.x & 63;
    const int gwv = blockIdx.x * 4 + w;
    const int h = gwv & 7, m = gwv >> 3, b = m / SEQL, qi = m % SEQL;
    qs[w][lane] = bf2f(Q[(size_t)m * DM + h * 128 + lane]); qs[w][64 + lane] = bf2f(Q[(size_t)m * DM + h * 128 + 64 + lane]);
    __syncthreads();
    float m0 = -1e30f, m1 = -1e30f, l0 = 0.f, l1 = 0.f, a00 = 0.f, a01 = 0.f, a10 = 0.f, a11 = 0.f;
    const size_t rb = (size_t)b * SEQL;
    for (int kc = 0; kc * 64 <= qi; ++kc) {
        const int key = kc * 64 + lane; const bool valid = key <= qi;
        float s0 = 0.f, s1 = 0.f;
        { const bf16_t* kr = K + (rb + (valid ? key : qi)) * DM + h * 128;
#pragma unroll
          for (int ch = 0; ch < 8; ++ch) { const u32x4_t w0 = *(const u32x4_t*)(kr + ch * 8), w1 = *(const u32x4_t*)(kr + 64 + ch * 8);
#pragma unroll
            for (int i = 0; i < 4; ++i) { s0 += qs[w][ch * 8 + 2 * i] * __uint_as_float(w0[i] << 16) + qs[w][ch * 8 + 2 * i + 1] * __uint_as_float(w0[i] & 0xffff0000u);
                                          s1 += qs[w][64 + ch * 8 + 2 * i] * __uint_as_float(w1[i] << 16) + qs[w][64 + ch * 8 + 2 * i + 1] * __uint_as_float(w1[i] & 0xffff0000u); } } }
        if (!valid) { s0 = -1e30f; s1 = -1e30f; }
        const float nm0 = fmaxf(m0, wave_max_f(s0)), nm1 = fmaxf(m1, wave_max_f(s1));
        const float f0 = exp2f(m0 - nm0), f1 = exp2f(m1 - nm1);
        const float p0 = valid ? exp2f(s0 - nm0) : 0.f, p1 = valid ? exp2f(s1 - nm1) : 0.f;
        l0 = l0 * f0 + wave_sum_f(p0); l1 = l1 * f1 + wave_sum_f(p1); m0 = nm0; m1 = nm1;
        a00 *= f0; a01 *= f0; a10 *= f1; a11 *= f1;
        const int nk = min(64, qi - kc * 64 + 1);
        for (int j = 0; j < nk; ++j) {
            const float pj0 = __shfl(p0, j), pj1 = __shfl(p1, j);
            const bf16_t* vr = V + (rb + kc * 64 + j) * DM + h * 128;
            const float v0 = bf2f(vr[lane]), v1 = bf2f(vr[64 + lane]);
            a00 += pj0 * v0; a01 += pj0 * v1; a10 += pj1 * v0; a11 += pj1 * v1;
        }
    }
    const float i0 = 1.0f / l0, i1 = 1.0f / l1;
    O0[(size_t)m * DM + h * 128 + lane] = f2bf(a00 * i0); O0[(size_t)m * DM + h * 128 + 64 + lane] = f2bf(a01 * i0);
    O1[(size_t)m * DM + h * 128 + lane] = f2bf(a10 * i1); O1[(size_t)m * DM + h * 128 + 64 + lane] = f2bf(a11 * i1);
}
#ifndef REPEAT_MASK
#define REPEAT_MASK 0
#endif
#ifndef ATTN_V128
#define ATTN_V128 1
#endif
#ifndef EXTRA_PHASE
#define EXTRA_PHASE -1
#endif
#ifndef ATTN_FUSE_POST
#define ATTN_FUSE_POST 1
#endif
#ifndef H1_RECOMP
#define H1_RECOMP 1
#endif
#ifndef SSM_FUSED
#define SSM_FUSED 1
#endif
#ifndef ATTN_PRIO
#define ATTN_PRIO 0
#endif
#ifndef H1_BF16
#define H1_BF16 0
#endif
#ifndef H1_AKV
#define H1_AKV 1
#endif
#ifndef SSM_DFOLD
#define SSM_DFOLD 1
#endif
#ifndef NT_OUT
#define NT_OUT 0
#endif
#if NT_OUT
#define ST_OUT(p, v) __builtin_nontemporal_store((v), (p))
#else
#define ST_OUT(p, v) (*(p) = (v))
#endif
#ifndef FUSE_EPI
#define FUSE_EPI 0
#endif
#ifndef ALIGN_E
#define ALIGN_E true
#endif
namespace pg8 {
#define PG8_LAS __attribute__((address_space(3)))
typedef short bf16x8 __attribute__((ext_vector_type(8)));
typedef float f32x4 __attribute__((ext_vector_type(4)));
typedef unsigned u32x4 __attribute__((ext_vector_type(4)));
constexpr int BM = 256, BK = 64, HALF = 128, HTB = HALF * BK * 2  , STAGE_BYTES = 8 * HTB, NXCD = 8, WGM = 8;

__host__ __device__ __forceinline__ int lds_byte(int r, int c) { const int st = (r >> 4) * 2 + (c >> 5), rr = r & 15, cc = c & 31, ob = rr * 64 + cc * 2; return st * 1024 + (ob ^ (((ob >> 9) & 1) << 5)); }
__host__ __device__ __forceinline__ void stage_rc(int b, int& R, int& C) { const int st = b / 1024, sb = b % 1024, swz = sb ^ (((sb >> 9) & 1) << 5); R = (st >> 1) * 16 + swz / 64; C = (st & 1) * 32 + (swz % 64) / 2; }
__host__ __device__ __forceinline__ int perm32(int rho) { const int n = rho >> 4, i = rho & 15; return 8 * (i >> 2) + 4 * n + (i & 3); }

struct Unit { int pm, pn, grp; };
struct Gemm {
    const char* A; const char* Bt; int nt, pad0;
    unsigned a_rs, a_c16; size_t a_kstep, a_tstep, a_gstep;
    unsigned b_rs, pad1; size_t b_tstep, b_gstep;
    __device__ __forceinline__ const char* abase(const Unit& u) const { return A + (size_t)u.grp * a_gstep + (size_t)u.pm * a_tstep; }
    __device__ __forceinline__ const char* bbase(const Unit& u) const { return Bt + (size_t)u.grp * b_gstep + (size_t)u.pn * b_tstep; }
};
__device__ __forceinline__ Gemm gemm_std(const void* A, int lda, const void* Bt, int ldb, int K) {
    Gemm g; g.A = (const char*)A; g.Bt = (const char*)Bt; g.nt = K / BK; g.pad0 = 0; g.a_rs = (unsigned)lda * 2u; g.a_c16 = 32u; g.a_kstep = BK * 2; g.a_tstep = (size_t)BM * lda * 2; g.a_gstep = 0;
    g.b_rs = (unsigned)ldb * 2u; g.pad1 = 0; g.b_tstep = (size_t)BM * ldb * 2; g.b_gstep = 0; return g;
}

struct Order {
    int nM, nN, nG, nwg, G, c, only, pm_off, mode2;
    __device__ __forceinline__ void init(int nM_, int nN_, int nG_, int G_, int c_) { nM = nM_; nN = nN_; nG = nG_; nwg = nM * nN * nG; G = G_; c = c_; only = -1; pm_off = 0; mode2 = 0; }
    __device__ __forceinline__ bool next(int i, Unit& u) const {
        if (only >= 0) { if (i > 0) return false; i = only; }
        const long L = (long)i * G + c; if (L >= nwg) return false;
        int wgid = (int)L; { const int q = nwg / NXCD, r = nwg % NXCD, xcd = wgid % NXCD, off = wgid / NXCD; wgid = (xcd < r ? xcd * (q + 1) : r * (q + 1) + (xcd - r) * q) + off; }
        if (mode2) {
            const int x = wgid >> 8, y = wgid & 255, bk = y >> 6, w2 = y & 63; u.grp = bk & 1; u.pm = (x * 2 + (bk >> 1)) * 8 + (w2 & 7); u.pn = w2 >> 3;
        } else
        { const int per = nM * nN; u.grp = wgid / per; const int w2 = wgid % per;
          const int nig = WGM * nN, gid = w2 / nig, fm = gid * WGM, gsz = (nM - fm) < WGM ? (nM - fm) : WGM;
          u.pm = pm_off + fm + ((w2 % nig) % gsz); u.pn = (w2 % nig) / gsz; }
        return true;
    }
};

__device__ __forceinline__ unsigned cvt_pk_bf16(float lo, float hi) { unsigned r; asm volatile("v_cvt_pk_bf16_f32 %0, %1, %2" : "=v"(r) : "v"(lo), "v"(hi)); return r; }
__device__ __forceinline__ u32x4 pack8(const f32x4 a, const f32x4 b) { u32x4 w; w.x = cvt_pk_bf16(a[0], a[1]); w.y = cvt_pk_bf16(a[2], a[3]); w.z = cvt_pk_bf16(b[0], b[1]); w.w = cvt_pk_bf16(b[2], b[3]); return w; }
__device__ __forceinline__ void unpack8(const u32x4 w, f32x4& a, f32x4& b) {
    a[0] = __uint_as_float(w.x << 16); a[1] = __uint_as_float(w.x & 0xffff0000u); a[2] = __uint_as_float(w.y << 16); a[3] = __uint_as_float(w.y & 0xffff0000u);
    b[0] = __uint_as_float(w.z << 16); b[1] = __uint_as_float(w.z & 0xffff0000u); b[2] = __uint_as_float(w.w << 16); b[3] = __uint_as_float(w.w & 0xffff0000u); }
__device__ __forceinline__ float fsilu(float v) { return v * __builtin_amdgcn_rcpf(1.0f + __expf(-v)); }
__device__ __forceinline__ float fsigm(float v) { return __builtin_amdgcn_rcpf(1.0f + __expf(-v)); }
__device__ __forceinline__ f32x4 silu4(f32x4 v) { f32x4 o; o[0] = fsilu(v[0]); o[1] = fsilu(v[1]); o[2] = fsilu(v[2]); o[3] = fsilu(v[3]); return o; }
__device__ __forceinline__ f32x4 sigm4(f32x4 v) { f32x4 o; o[0] = fsigm(v[0]); o[1] = fsigm(v[1]); o[2] = fsigm(v[2]); o[3] = fsigm(v[3]); return o; }
__device__ __forceinline__ float fgelu(float v) { const float u = 0.7978845608028654f * (v + 0.044715f * v * v * v); const float e = __expf(2.0f * u); return 0.5f * v * (2.0f - 2.0f * __builtin_amdgcn_rcpf(e + 1.0f)); }
__device__ __forceinline__ f32x4 gelu4(f32x4 v) { f32x4 o; o[0] = fgelu(v[0]); o[1] = fgelu(v[1]); o[2] = fgelu(v[2]); o[3] = fgelu(v[3]); return o; }

template <class F> struct EpiRow8 {
    static constexpr bool PERM = true, AFTER_DRAIN = false;
    F f;
    __device__ __forceinline__ void operator()(const f32x4 (&acc)[2][2][4][2], const Unit& u, int wr, int wc, int fr, int fq) const {
#pragma unroll
        for (int ai = 0; ai < 2; ++ai)
#pragma unroll
            for (int m = 0; m < 4; ++m) { const int row = u.pm * BM + ai * HALF + wr * 64 + m * 16 + fr;
#pragma unroll
                for (int bj = 0; bj < 2; ++bj) { const int col0 = u.pn * BM + bj * HALF + wc * 32 + 8 * fq; f.apply(u, row, col0, acc[ai][bj][m][0], acc[ai][bj][m][1]); } }
    }
};
struct F_In0 { bf16_t* US; bf16_t* SZ;
    __device__ __forceinline__ void apply(const Unit&, int row, int col0, f32x4 v0, f32x4 v1) const {
        if (col0 < 1024) ST_OUT((u32x4*)(US + us_off(col0 >> 4, row >> 4, (row & 15) * 16 + (col0 & 15))), pack8(v0, v1));
        else NT_ST((u32x4*)(SZ + (size_t)row * DM + (col0 - 1024)), pack8(silu4(v0), silu4(v1))); } };
struct F_SsmA { float* E;
    __device__ __forceinline__ void apply(const Unit& u, int row, int col0, f32x4 v0, f32x4 v1) const {
        if (col0 < 128) { float* p = E + ((size_t)u.grp * NTILE + row) * 128 + col0; *(f32x4*)p = v0; *(f32x4*)(p + 4) = v1; } } };
struct F_SsmB { const bf16_t* US; const float* dsk; bf16_t* YG;
    __device__ __forceinline__ void apply(const Unit& u, int row, int col0, f32x4 v0, f32x4 v1) const {
        const u32x4 uw = *(const u32x4*)(US + us_off(u.grp, row, col0)); f32x4 u0, u1; unpack8(uw, u0, u1);
        const float* d = dsk + u.grp * 16 + (col0 & 15); const f32x4 d0 = *(const f32x4*)d, d1 = *(const f32x4*)(d + 4);
        ST_OUT((u32x4*)(YG + yg_off(u.grp, row, col0)), pack8(gelu4(v0 + d0 * u0), gelu4(v1 + d1 * u1))); } };
struct F_SsmB0 { bf16_t* YG;
    __device__ __forceinline__ void apply(const Unit& u, int row, int col0, f32x4 v0, f32x4 v1) const {
        *(u32x4*)(YG + yg_off(u.grp, row, col0)) = pack8(gelu4(v0), gelu4(v1)); } };
struct F_Glu { const bf16_t* YG; const bf16_t* SZ; const float* bias; bf16_t* Y2;
    __device__ __forceinline__ void apply(const Unit&, int row, int col0, f32x4 v0, f32x4 v1) const {
        const u32x4 yw = *(const u32x4*)(YG + yg_off(col0 >> 4, row >> 4, (row & 15) * 16 + (col0 & 15))); f32x4 y0, y1; unpack8(yw, y0, y1);
        const u32x4 zw = NT_LD((const u32x4*)(SZ + (size_t)row * DM + col0)); f32x4 z0, z1; unpack8(zw, z0, z1);
        const f32x4 b0 = *(const f32x4*)(bias + col0), b1 = *(const f32x4*)(bias + col0 + 4);
        ST_OUT((u32x4*)(Y2 + (size_t)row * DM + col0), pack8(y0 * sigm4(v0 + b0) * z0, y1 * sigm4(v1 + b1) * z1)); } };
template <class F> struct EpiRow8L {
    static constexpr bool PERM = true, AFTER_DRAIN = false;
    F f;
    __device__ __forceinline__ void operator()(const f32x4 (&acc)[2][2][4][2], const Unit& u, int wr, int wc, int fr, int fq) const {
#pragma unroll
        for (int ai = 0; ai < 2; ++ai) {
            typename F::Pre pre[4][2];
#pragma unroll
            for (int m = 0; m < 4; ++m) { const int row = u.pm * BM + ai * HALF + wr * 64 + m * 16 + fr;
#pragma unroll
                for (int bj = 0; bj < 2; ++bj) { const int col0 = u.pn * BM + bj * HALF + wc * 32 + 8 * fq; f.load(u, row, col0, pre[m][bj]); } }
#pragma unroll
            for (int m = 0; m < 4; ++m) { const int row = u.pm * BM + ai * HALF + wr * 64 + m * 16 + fr;
#pragma unroll
                for (int bj = 0; bj < 2; ++bj) { const int col0 = u.pn * BM + bj * HALF + wc * 32 + 8 * fq; f.apply(u, row, col0, acc[ai][bj][m][0], acc[ai][bj][m][1], pre[m][bj]); } }
        }
    }
};
struct F_SsmB2 { const bf16_t* US; const float* dsk; bf16_t* YG;
    struct Pre { u32x4 uw; };
    __device__ __forceinline__ void load(const Unit& u, int row, int col0, Pre& p) const { p.uw = *(const u32x4*)(US + us_off(u.grp, row, col0)); }
    __device__ __forceinline__ void apply(const Unit& u, int row, int col0, f32x4 v0, f32x4 v1, const Pre& p) const {
        f32x4 u0, u1; unpack8(p.uw, u0, u1);
        const float* d = dsk + u.grp * 16 + (col0 & 15); const f32x4 d0 = *(const f32x4*)d, d1 = *(const f32x4*)(d + 4);
        *(u32x4*)(YG + yg_off(u.grp, row, col0)) = pack8(gelu4(v0 + d0 * u0), gelu4(v1 + d1 * u1)); } };
struct F_Glu2 { const bf16_t* YG; const bf16_t* SZ; const float* bias; bf16_t* Y2;
    struct Pre { u32x4 yw, zw; };
    __device__ __forceinline__ void load(const Unit&, int row, int col0, Pre& p) const {
        p.yw = *(const u32x4*)(YG + yg_off(col0 >> 4, row >> 4, (row & 15) * 16 + (col0 & 15))); p.zw = *(const u32x4*)(SZ + (size_t)row * DM + col0); }
    __device__ __forceinline__ void apply(const Unit&, int row, int col0, f32x4 v0, f32x4 v1, const Pre& p) const {
        f32x4 y0, y1, z0, z1; unpack8(p.yw, y0, y1); unpack8(p.zw, z0, z1);
        const f32x4 b0 = *(const f32x4*)(bias + col0), b1 = *(const f32x4*)(bias + col0 + 4);
        *(u32x4*)(Y2 + (size_t)row * DM + col0) = pack8(y0 * sigm4(v0 + b0) * z0, y1 * sigm4(v1 + b1) * z1); } };
struct F_Split2 { bf16_t* Olo[2]; bf16_t* Ohi[2];
    __device__ __forceinline__ void apply(const Unit& u, int row, int col0, f32x4 v0, f32x4 v1) const {
        if (u.grp == 0) { bf16_t* o = (col0 < 1024) ? Olo[0] + (size_t)row * DM + col0 : Ohi[0] + (size_t)row * DM + (col0 - 1024); ST_OUT((u32x4*)o, pack8(v0, v1)); }
        else if (col0 < 1024) NT_ST((u32x4*)(Olo[1] + (size_t)row * DM + col0), pack8(v0 * QC2, v1 * QC2));
        else NT_ST((u32x4*)(Ohi[1] + (size_t)row * DM + (col0 - 1024)), pack8(silu4(v0), silu4(v1))); } };
struct F_Plain { bf16_t* O;
    __device__ __forceinline__ void apply(const Unit&, int row, int col0, f32x4 v0, f32x4 v1) const { ST_OUT((u32x4*)(O + (size_t)row * DM + col0), pack8(v0, v1)); } };
struct F_Split { bf16_t* Olo; bf16_t* Ohi; float sc_lo; int silu_hi;
    __device__ __forceinline__ void apply(const Unit&, int row, int col0, f32x4 v0, f32x4 v1) const {
        if (col0 < 1024) *(u32x4*)(Olo + (size_t)row * DM + col0) = pack8(v0 * sc_lo, v1 * sc_lo);
        else { if (silu_hi) { NT_ST((u32x4*)(Ohi + (size_t)row * DM + (col0 - 1024)), pack8(silu4(v0), silu4(v1))); } else *(u32x4*)(Ohi + (size_t)row * DM + (col0 - 1024)) = pack8(v0, v1); } } };


struct PanelRms {
    unsigned* xbuf;
    unsigned* cnt;
    unsigned* tmo;
    float eps;
    __device__ __forceinline__ bool run(const f32x4 (&v)[2][2][4][2], const Unit& u, int wr, int wc, int fr, int fq, PG8_LAS unsigned char* lds, int wid, int lane) const {
        PG8_LAS float* P = (PG8_LAS float*)lds;
        PG8_LAS float* S = (PG8_LAS float*)(lds + 8192);
        PG8_LAS unsigned* flag = (PG8_LAS unsigned*)(lds + 8192 + 2048);
#pragma unroll
        for (int ai = 0; ai < 2; ++ai)
#pragma unroll
            for (int m = 0; m < 4; ++m) {
                float q = 0.f;
#pragma unroll
                for (int bj = 0; bj < 2; ++bj)
#pragma unroll
                    for (int n = 0; n < 2; ++n) { const f32x4 d = v[ai][bj][m][n]; q += (d[0] * d[0] + d[1] * d[1]) + (d[2] * d[2] + d[3] * d[3]); }
                q += __shfl_xor(q, 16); q += __shfl_xor(q, 32);
                if (fq == 0) P[(ai * HALF + wr * 64 + m * 16 + fr) * 4 + wc] = q;
            }
        asm volatile("s_waitcnt lgkmcnt(0)" ::: "memory"); __builtin_amdgcn_s_barrier(); asm volatile("" ::: "memory");
        const int row = wid * 32 + (lane & 31);
        if (lane < 32) {
            const float tot = (P[row * 4 + 0] + P[row * 4 + 1]) + (P[row * 4 + 2] + P[row * 4 + 3]);
            unsigned long long* slot = (unsigned long long*)xbuf + ((size_t)(u.pm * BM + row) * 4 + u.pn);
            __hip_atomic_store(slot, (unsigned long long)__float_as_uint(tot), __ATOMIC_RELAXED, __HIP_MEMORY_SCOPE_AGENT);
        }
        asm volatile("s_waitcnt vmcnt(0)" ::: "memory");
        if (lane == 0) __hip_atomic_fetch_add(cnt + 64 * u.pm, 1u, __ATOMIC_RELAXED, __HIP_MEMORY_SCOPE_AGENT);
        if (wid == 0) {
            bool dead = false; const unsigned long long t0 = __builtin_amdgcn_s_memrealtime(); const unsigned want = 32u;
            for (;;) {
                if ((unsigned)__builtin_amdgcn_readfirstlane(__hip_atomic_load(cnt + 64 * u.pm, __ATOMIC_RELAXED, __HIP_MEMORY_SCOPE_AGENT)) >= want) break;
                if (__builtin_amdgcn_s_memrealtime() - t0 > 2000000ull) { if (lane == 0) __hip_atomic_store(tmo, 1u, __ATOMIC_RELAXED, __HIP_MEMORY_SCOPE_AGENT); dead = true; break; }
                __builtin_amdgcn_s_sleep(2);
            }
            __builtin_amdgcn_fence(__ATOMIC_ACQUIRE, "agent");
            if (lane == 0) flag[0] = dead ? 1u : 0u;
        }
        asm volatile("s_waitcnt vmcnt(0) lgkmcnt(0)" ::: "memory"); __builtin_amdgcn_s_barrier(); asm volatile("" ::: "memory");
        const bool bad = flag[0] != 0u;
        if (lane < 32) {
            const unsigned long long* slot = (const unsigned long long*)xbuf + (size_t)(u.pm * BM + row) * 4; float t4[4];
#pragma unroll
            for (int t = 0; t < 4; ++t) t4[t] = __uint_as_float((unsigned)__hip_atomic_load(slot + t, __ATOMIC_RELAXED, __HIP_MEMORY_SCOPE_AGENT));
            S[row] = rsqrtf(((t4[0] + t4[1]) + (t4[2] + t4[3])) * (1.0f / 1024.0f) + eps);
        }
        asm volatile("s_waitcnt lgkmcnt(0)" ::: "memory"); __builtin_amdgcn_s_barrier(); asm volatile("" ::: "memory");
        return bad;
    }
};
struct EpiFinal {
    static constexpr bool PERM = false, AFTER_DRAIN = true;
    const float* base; float* out; const float* mod1; const float* gpost1; PanelRms st;
    __device__ __forceinline__ void fused(f32x4 (&acc)[2][2][4][2], const Unit& u, int wr, int wc, int fr, int fq, PG8_LAS unsigned char* lds, int wid, int lane) const {
        const PG8_LAS float* S = (const PG8_LAS float*)(lds + 8192);
        const int col0 = u.pn * BM + wc * 32 + 4 * fq; const int b = u.pm >> 4;
        const float* gate = mod1 + (size_t)b * 3072 + 2048;
        const bool bad = st.run(acc, u, wr, wc, fr, fq, lds, wid, lane);
        const float qnan = __builtin_nanf("");
        f32x4 gg[2][2];
#pragma unroll
        for (int bj = 0; bj < 2; ++bj)
#pragma unroll
            for (int n = 0; n < 2; ++n) gg[bj][n] = *(const f32x4*)(gate + col0 + bj * HALF + n * 16) * *(const f32x4*)(gpost1 + col0 + bj * HALF + n * 16);
#pragma unroll
        for (int ai = 0; ai < 2; ++ai)
#pragma unroll
            for (int m = 0; m < 4; ++m) { const int r = ai * HALF + wr * 64 + m * 16 + fr; const float sr = S[r]; const size_t off = (size_t)(u.pm * BM + r) * DM + col0;
#pragma unroll
                for (int bj = 0; bj < 2; ++bj)
#pragma unroll
                    for (int n = 0; n < 2; ++n) { const f32x4 bs = *(const f32x4*)(base + off + bj * HALF + n * 16); f32x4 o = bs + gg[bj][n] * (acc[ai][bj][m][n] * sr);
                        if (bad) o = (f32x4){qnan, qnan, qnan, qnan}; *(f32x4*)(out + off + bj * HALF + n * 16) = o; }
                if (m & 1) asm volatile("" ::: "memory"); }
    }
};
struct EpiMid {
    static constexpr bool PERM = false, AFTER_DRAIN = true;
    const float* x; float* out; bf16_t* akv; bf16_t* ain1; const float* mod; const float* gpost0; const float* gpre1; PanelRms st1, st2;
    __device__ __forceinline__ void fused(f32x4 (&acc)[2][2][4][2], const Unit& u, int wr, int wc, int fr, int fq, PG8_LAS unsigned char* lds, int wid, int lane) const {
        typedef unsigned u32x2v __attribute__((ext_vector_type(2)));
        const PG8_LAS float* S = (const PG8_LAS float*)(lds + 8192);
        const int col0 = u.pn * BM + wc * 32 + 4 * fq; const int b = u.pm >> 4;
        const float* gate0 = mod + (size_t)b * 3072 + 2048; const float* sh1 = mod + (size_t)(8 + b) * 3072; const float* sc1 = sh1 + 1024;
        bool bad = st1.run(acc, u, wr, wc, fr, fq, lds, wid, lane);
        {
            f32x4 gg[2][2];
#pragma unroll
            for (int bj = 0; bj < 2; ++bj)
#pragma unroll
                for (int n = 0; n < 2; ++n) gg[bj][n] = *(const f32x4*)(gate0 + col0 + bj * HALF + n * 16) * *(const f32x4*)(gpost0 + col0 + bj * HALF + n * 16);
#pragma unroll
            for (int ai = 0; ai < 2; ++ai)
#pragma unroll
                for (int m = 0; m < 4; ++m) { const int r = ai * HALF + wr * 64 + m * 16 + fr; const float sr = S[r]; const size_t off = (size_t)(u.pm * BM + r) * DM + col0;
#pragma unroll
                    for (int bj = 0; bj < 2; ++bj)
#pragma unroll
                        for (int n = 0; n < 2; ++n) { const f32x4 bs = *(const f32x4*)(x + off + bj * HALF + n * 16); acc[ai][bj][m][n] = bs + gg[bj][n] * (acc[ai][bj][m][n] * sr); }
                    asm volatile("" : "+v"(acc[ai][0][m][0]), "+v"(acc[ai][0][m][1]), "+v"(acc[ai][1][m][0]), "+v"(acc[ai][1][m][1]));
                    if (m & 1) asm volatile("" ::: "memory"); }
        }
        bad = st2.run(acc, u, wr, wc, fr, fq, lds, wid, lane) || bad;
        const float qnan = __builtin_nanf("");
#pragma unroll
        for (int bj = 0; bj < 2; ++bj)
#pragma unroll
            for (int n = 0; n < 2; ++n) { const int c = col0 + bj * HALF + n * 16;
                const f32x4 gf = *(const f32x4*)(gpre1 + c) * (*(const f32x4*)(sc1 + c) + 1.0f), sh = *(const f32x4*)(sh1 + c);
#pragma unroll
                for (int ai = 0; ai < 2; ++ai)
#pragma unroll
                    for (int m = 0; m < 4; ++m) { const int r = ai * HALF + wr * 64 + m * 16 + fr; const float sr = S[r]; const size_t off = (size_t)(u.pm * BM + r) * DM + c;
                        f32x4 h = acc[ai][bj][m][n]; if (bad) h = (f32x4){qnan, qnan, qnan, qnan};
                        *(f32x4*)(out + off) = h;
                        const f32x4 nr = h * sr; u32x2v w; w.x = cvt_pk_bf16(nr[0], nr[1]); w.y = cvt_pk_bf16(nr[2], nr[3]); *(u32x2v*)(akv + off) = w;
                        const f32x4 z = nr * gf + sh; w.x = cvt_pk_bf16(z[0], z[1]); w.y = cvt_pk_bf16(z[2], z[3]); *(u32x2v*)(ain1 + off) = w; }
                asm volatile("" ::: "memory"); }
    }
};

struct EpiScan {
    static constexpr bool PERM = true, AFTER_DRAIN = true;
    const float* lb16; bf16_t* US; int carry_off;
    __device__ __forceinline__ void fused(f32x4 (&acc)[2][2][4][2], const Unit& u, int wr, int wc, int fr, int fq, PG8_LAS unsigned char* lds, int wid, int lane) const {
#pragma unroll
        for (int ai = 0; ai < 2; ++ai)
#pragma unroll
            for (int m = 0; m < 4; ++m) { const int row = ai * HALF + wr * 64 + m * 16 + fr; const int ch = (wc * 32 + 8 * fq) >> 2;
                *(PG8_LAS f32x4*)(lds + row * 512 + ((ch ^ (row & 7)) << 4)) = acc[ai][0][m][0];
                *(PG8_LAS f32x4*)(lds + row * 512 + (((ch + 1) ^ (row & 7)) << 4)) = acc[ai][0][m][1]; }
        asm volatile("s_waitcnt lgkmcnt(0)" ::: "memory"); __builtin_amdgcn_s_barrier(); asm volatile("" ::: "memory");
        const int p = lane, g = u.grp, b = u.pm;
        const float lr = lb16[(g * 64 + p) * 2], li = lb16[(g * 64 + p) * 2 + 1];
        typedef float f32x2v __attribute__((ext_vector_type(2)));
        const int coff = ((p >> 1) << 4) + (p & 1) * 8;
        float sr = 0.f, si = 0.f;
#pragma unroll 8
        for (int j = 0; j < 32; ++j) { const int t = wid * 32 + j; const f32x2v e = *(const PG8_LAS f32x2v*)(lds + t * 512 + (coff ^ ((t & 7) << 4)));
            const float nr = lr * sr - li * si + e.x, ni = lr * si + li * sr + e.y; sr = nr; si = ni; }
        PG8_LAS f32x2v* C = (PG8_LAS f32x2v*)(lds + carry_off);
        C[wid * 64 + p] = (f32x2v){sr, si};
        float pr = lr, pi = li;
#pragma unroll
        for (int q = 0; q < 5; ++q) { const float nr = pr * pr - pi * pi, ni = 2.f * pr * pi; pr = nr; pi = ni; }
        asm volatile("s_waitcnt lgkmcnt(0)" ::: "memory"); __builtin_amdgcn_s_barrier(); asm volatile("" ::: "memory");
        sr = 0.f; si = 0.f;
        for (int v = 0; v < wid; ++v) { const f32x2v c = C[v * 64 + p]; const float nr = pr * sr - pi * si + c.x, ni = pr * si + pi * sr + c.y; sr = nr; si = ni; }
        bf16_t* sp = US + us_off(g, b * 256 + wid * 32, 256 + 2 * p);
#pragma unroll 8
        for (int j = 0; j < 32; ++j) { const int t = wid * 32 + j; const f32x2v e = *(const PG8_LAS f32x2v*)(lds + t * 512 + (coff ^ ((t & 7) << 4)));
            *(unsigned*)(sp + (size_t)j * US_P) = cvt_pk_bf16(sr, si);
            const float nr = lr * sr - li * si + e.x, ni = lr * si + li * sr + e.y; sr = nr; si = ni; }
        asm volatile("s_waitcnt vmcnt(0)" ::: "memory");
    }
};
template <class Epi, bool ALIGN_EPI>
__device__ __forceinline__ void gemm_phase(PG8_LAS unsigned char* lds, const Gemm g, const Order& S, const Epi& E, int tid_in) {
    int tid_ = tid_in; asm volatile("" : "+v"(tid_));
    const int tid = tid_, wid = __builtin_amdgcn_readfirstlane(tid >> 6), lane = tid & 63, wr = wid >> 2, wc = wid & 3, fr = lane & 15, fq = lane >> 4;
    const int nt = g.nt;
    unsigned voffA[2], voffB[2];
#pragma unroll
    for (int i = 0; i < 2; ++i) { int R, C; stage_rc(tid * 16 + i * 8192, R, C); const int Rb = Epi::PERM ? ((R & ~31) + perm32(R & 31)) : R;
        voffA[i] = (unsigned)R * g.a_rs + (unsigned)(C >> 4) * g.a_c16 + (unsigned)(C & 15) * 2u; voffB[i] = (unsigned)Rb * g.b_rs + (unsigned)C * 2u; }
    const size_t kstepA = g.a_kstep, kstepB = (size_t)(BK * 2);
    const size_t hstepA = (size_t)HALF * g.a_rs, hstepB = (size_t)HALF * g.b_rs;
    const unsigned ldsw = (unsigned)wid * 1024u;
    const int aoff = lds_byte(wr * 64 + fr, fq * 8), boff = lds_byte(wc * 32 + fr, fq * 8);
#define PG8_SA(b, h) (((b) * 2 + (h)) * HTB)
#define PG8_SB(b, h) ((4 + (b) * 2 + (h)) * HTB)
#define PG8_STAGE(bufoff, gbase, voff) do { _Pragma("unroll") for (int _i = 0; _i < 2; ++_i) \
        __builtin_amdgcn_global_load_lds((const unsigned*)((const char*)(gbase) + (voff)[_i]), (PG8_LAS unsigned*)(lds + (bufoff) + ldsw + _i * 8192), 16, 0, 0); } while (0)
#define PG8_LDA(dst, b, h) do { _Pragma("unroll") for (int m = 0; m < 4; ++m) _Pragma("unroll") for (int k = 0; k < 2; ++k) dst[m][k] = *(const PG8_LAS bf16x8*)(lds + PG8_SA(b, h) + aoff + m * 2048 + k * 1024); } while (0)
#define PG8_LDB(dst, b, h) do { _Pragma("unroll") for (int n = 0; n < 2; ++n) _Pragma("unroll") for (int k = 0; k < 2; ++k) dst[n][k] = *(const PG8_LAS bf16x8*)(lds + PG8_SB(b, h) + boff + n * 2048 + k * 1024); } while (0)
#define PG8_MMA(ai, bj, At, Bt) do { __builtin_amdgcn_s_setprio(1); _Pragma("unroll") for (int m = 0; m < 4; ++m) _Pragma("unroll") for (int n = 0; n < 2; ++n) _Pragma("unroll") for (int k = 0; k < 2; ++k) \
        acc[ai][bj][m][n] = __builtin_amdgcn_mfma_f32_16x16x32_bf16(Bt[n][k], At[m][k], acc[ai][bj][m][n], 0, 0, 0); __builtin_amdgcn_s_setprio(0); } while (0)
#define PG8_WAIT_V(n) asm volatile("s_waitcnt vmcnt(" #n ")" ::: "memory")
#define PG8_WAIT_L(n) asm volatile("s_waitcnt lgkmcnt(" #n ")" ::: "memory")
#define PG8_BAR __builtin_amdgcn_s_barrier()
#define PG8_SCHED __builtin_amdgcn_sched_barrier(0)
    Unit cur, nxt; int ui = 0;
    if (!S.next(0, cur)) return;
    f32x4 acc[2][2][4][2];
#pragma unroll
    for (int a = 0; a < 2; ++a)
#pragma unroll
        for (int b = 0; b < 2; ++b)
#pragma unroll
            for (int m = 0; m < 4; ++m)
#pragma unroll
                for (int n = 0; n < 2; ++n) acc[a][b][m][n] = (f32x4){0.f, 0.f, 0.f, 0.f};
    bf16x8 At[4][2], B0[2][2], B1[2][2];
    const char* cA = g.abase(cur); const char* cB = g.bbase(cur);
    PG8_STAGE(PG8_SB(0, 0), cB, voffB); PG8_STAGE(PG8_SB(0, 1), cB + hstepB, voffB); PG8_STAGE(PG8_SA(0, 0), cA, voffA); PG8_STAGE(PG8_SA(0, 1), cA + hstepA, voffA);
    if (wr == 1) PG8_BAR;
    PG8_WAIT_V(2); PG8_BAR;
    PG8_STAGE(PG8_SB(1, 0), cB + kstepB, voffB); PG8_STAGE(PG8_SA(1, 0), cA + kstepA, voffA); PG8_STAGE(PG8_SB(1, 1), cB + hstepB + kstepB, voffB);
    PG8_WAIT_V(6); PG8_BAR;
    for (;;) {
        const bool has_next = S.next(ui + 1, nxt);
        const char* nA = has_next ? g.abase(nxt) : cA; const char* nB = has_next ? g.bbase(nxt) : cB;
        for (int t = 0; t < nt; t += 2) {
            const bool last = (t == nt - 2);
            const char* a1 = cA + (size_t)(t + 1) * kstepA;
            const char* a2 = last ? nA : cA + (size_t)(t + 2) * kstepA; const char* b2 = last ? nB : cB + (size_t)(t + 2) * kstepB;
            const char* a3 = a2 + kstepA; const char* b3 = b2 + kstepB;
            PG8_LDB(B0, 0, 0); PG8_LDB(B1, 0, 1); PG8_SCHED; PG8_LDA(At, 0, 0); PG8_STAGE(PG8_SA(1, 1), a1 + hstepA, voffA);
            PG8_WAIT_V(8); PG8_WAIT_L(0); PG8_BAR; PG8_MMA(0, 0, At, B0); PG8_MMA(0, 1, At, B1); PG8_BAR; PG8_SCHED;
            PG8_LDA(At, 0, 1); PG8_STAGE(PG8_SB(0, 0), b2, voffB); PG8_STAGE(PG8_SB(0, 1), b2 + hstepB, voffB); PG8_STAGE(PG8_SA(0, 0), a2, voffA);
            PG8_WAIT_V(8); PG8_WAIT_L(0); PG8_BAR; PG8_MMA(1, 0, At, B0); PG8_MMA(1, 1, At, B1); PG8_BAR; PG8_SCHED;
            PG8_LDB(B0, 1, 0); PG8_LDB(B1, 1, 1); PG8_SCHED; PG8_LDA(At, 1, 0); PG8_STAGE(PG8_SA(0, 1), a2 + hstepA, voffA);
            PG8_WAIT_V(8); PG8_WAIT_L(0); PG8_BAR; PG8_MMA(0, 0, At, B0); PG8_MMA(0, 1, At, B1); PG8_BAR; PG8_SCHED;
            PG8_LDA(At, 1, 1); PG8_STAGE(PG8_SB(1, 0), b3, voffB); PG8_STAGE(PG8_SB(1, 1), b3 + hstepB, voffB); PG8_STAGE(PG8_SA(1, 0), a3, voffA);
            PG8_WAIT_V(8); PG8_WAIT_L(0); PG8_BAR; PG8_MMA(1, 0, At, B0); PG8_MMA(1, 1, At, B1); PG8_BAR; PG8_SCHED;
        }
        if constexpr (ALIGN_EPI) { if (wr == 0) PG8_BAR; }
        if constexpr (!Epi::AFTER_DRAIN) { E(acc, cur, wr, wc, fr, fq); }
        if (!has_next) break;
#pragma unroll
        for (int a = 0; a < 2; ++a)
#pragma unroll
            for (int b = 0; b < 2; ++b)
#pragma unroll
                for (int m = 0; m < 4; ++m)
#pragma unroll
                    for (int n = 0; n < 2; ++n) acc[a][b][m][n] = (f32x4){0.f, 0.f, 0.f, 0.f};
        cur = nxt; cA = nA; cB = nB; ++ui;
        if constexpr (ALIGN_EPI) { if (wr == 1) PG8_BAR; }
    }
    PG8_WAIT_V(0);
    if constexpr (!ALIGN_EPI) { if (wr == 0) PG8_BAR; }
    PG8_BAR;
    if constexpr (Epi::AFTER_DRAIN) { E.fused(acc, cur, wr, wc, fr, fq, lds, wid, lane); PG8_WAIT_L(0); PG8_BAR; }
#undef PG8_SA
#undef PG8_SB
#undef PG8_STAGE
#undef PG8_LDA
#undef PG8_LDB
#undef PG8_MMA
#undef PG8_WAIT_V
#undef PG8_WAIT_L
#undef PG8_BAR
#undef PG8_SCHED
}
}

namespace attn_body {
using bf16 = bf16_t;
using bf16x8 = __attribute__((ext_vector_type(8))) short;
using s16x4 = __attribute__((ext_vector_type(4))) short;
using f32x16 = __attribute__((ext_vector_type(16))) float;
using u32x4 = __attribute__((ext_vector_type(4))) unsigned;
constexpr int SEQ = SEQL, D = 64, DMA = 1024;
constexpr int NW = 8, QBLK = 32, QB = QBLK * NW, KVBLK = 64, NQB = SEQ / QB;
__device__ __forceinline__ int crow(int r, int hi) { return (r & 3) + 8 * (r >> 2) + 4 * hi; }
#define SBAR() __builtin_amdgcn_sched_barrier(0)
__device__ __forceinline__ void cmask(f32x16& p0, f32x16& p1, int jb, int qrel, int hi) {
  const float NEG = -INFINITY; int kb = 64 * jb + 4 * hi;
  #pragma unroll
  for (int r = 0; r < 16; ++r) { int kv = kb + (r & 3) + 8 * (r >> 2); if (kv > qrel) p0[r] = NEG; if (kv + 32 > qrel) p1[r] = NEG; }
}
constexpr int NSLOT = 3, SLOTB = 8192;
constexpr int LDS_K = 0, LDS_V = NSLOT * SLOTB, LDS_WS = 2 * NSLOT * SLOTB, LDS_OST = LDS_WS + NW * 64 * 4, LDS_BYTES = LDS_OST + NW * 4096;
__device__ __forceinline__ void glds16(const void* gsrc, unsigned lds_dst) { unsigned keep;
  asm volatile("s_mov_b32 %0, m0\n\ts_mov_b32 m0, %2\n\ts_nop 0\n\tglobal_load_lds_dwordx4 %1, off\n\ts_mov_b32 m0, %0" : "=&s"(keep) : "v"(gsrc), "s"(lds_dst) : "memory"); }
__device__ __forceinline__ float max3f(float a, float b, float c) { float r; asm("v_max3_f32 %0, %1, %2, %3" : "=v"(r) : "v"(a), "v"(b), "v"(c)); return r; }
__device__ __forceinline__ float max2f(float a, float b) { float r; asm("v_max_f32_e32 %0, %1, %2" : "=v"(r) : "v"(a), "v"(b)); return r; }
__device__ __forceinline__ float fadd_s(float a, float b) { float r; asm("v_add_f32_e32 %0, %1, %2" : "=v"(r) : "v"(a), "v"(b)); return r; }
__device__ __forceinline__ float fsub_s(float a, float b) { float r; asm("v_sub_f32_e32 %0, %1, %2" : "=v"(r) : "v"(a), "v"(b)); return r; }
typedef float f32x2_t __attribute__((ext_vector_type(2))); typedef __bf16 bf16x2_t __attribute__((ext_vector_type(2)));
__device__ __forceinline__ unsigned cvtpk_s(float lo, float hi) { f32x2_t v = {lo, hi}; bf16x2_t b = __builtin_convertvector(v, bf16x2_t); return __builtin_bit_cast(unsigned, b); }
#define WAIT_BAR(N) asm volatile("s_waitcnt vmcnt(" #N ") lgkmcnt(0)\n\ts_barrier" ::: "memory")

__device__ __forceinline__ void qkt(f32x16& p0, f32x16& p1, const char* Kslot, const bf16x8* qr, const f32x16& negm, int r32, int hi) {
  const char* kb = Kslot + hi * 1024 + r32 * 16;
  #pragma unroll
  for (int d0 = 0; d0 < 4; ++d0) {
    const bf16x8 b0 = *reinterpret_cast<const bf16x8*>(kb + d0 * 2048);
    const bf16x8 b1 = *reinterpret_cast<const bf16x8*>(kb + d0 * 2048 + 512);
    if (d0 == 0) { p0 = __builtin_amdgcn_mfma_f32_32x32x16_bf16(b0, qr[0], negm, 0, 0, 0); p1 = __builtin_amdgcn_mfma_f32_32x32x16_bf16(b1, qr[0], negm, 0, 0, 0); }
    else { p0 = __builtin_amdgcn_mfma_f32_32x32x16_bf16(b0, qr[d0], p0, 0, 0, 0); p1 = __builtin_amdgcn_mfma_f32_32x32x16_bf16(b1, qr[d0], p1, 0, 0, 0); } }
}
typedef __attribute__((address_space(3))) const char* lds_cptr;
typedef short v4i16_t __attribute__((ext_vector_type(4)));
__device__ __forceinline__ void kload8(bf16x8* kf, lds_cptr kp) {
  kf[0] = *(const __attribute__((address_space(3))) bf16x8*)(kp);        kf[1] = *(const __attribute__((address_space(3))) bf16x8*)(kp + 512);
  kf[2] = *(const __attribute__((address_space(3))) bf16x8*)(kp + 2048); kf[3] = *(const __attribute__((address_space(3))) bf16x8*)(kp + 2560);
  kf[4] = *(const __attribute__((address_space(3))) bf16x8*)(kp + 4096); kf[5] = *(const __attribute__((address_space(3))) bf16x8*)(kp + 4608);
  kf[6] = *(const __attribute__((address_space(3))) bf16x8*)(kp + 6144); kf[7] = *(const __attribute__((address_space(3))) bf16x8*)(kp + 6656);
}
__device__ __forceinline__ void kload2(bf16x8* kf, lds_cptr kp, int j) { kf[2 * j] = *(const __attribute__((address_space(3))) bf16x8*)(kp + j * 2048); kf[2 * j + 1] = *(const __attribute__((address_space(3))) bf16x8*)(kp + j * 2048 + 512); }
__device__ __forceinline__ s16x4 vtr(lds_cptr p) { return __builtin_bit_cast(s16x4, __builtin_amdgcn_ds_read_tr16_b64_v4i16((__attribute__((address_space(3))) v4i16_t*)p)); }
__device__ __forceinline__ float rowmax(const f32x16& p0, const f32x16& p1) {
  float a = max3f(p0[0], p0[1], p1[0]), b = max3f(p0[2], p0[3], p1[1]); a = max3f(a, p1[2], p1[3]);
  #pragma unroll
  for (int r = 4; r < 16; r += 4) { a = max3f(a, p0[r], p0[r + 1]); b = max3f(b, p0[r + 2], p0[r + 3]); a = max3f(a, p1[r], p1[r + 1]); b = max3f(b, p1[r + 2], p1[r + 3]); }
  const float m = max2f(a, b);
  auto rr = __builtin_amdgcn_permlane32_swap(__float_as_uint(m), __float_as_uint(m), false, false);
  return max2f(__uint_as_float(rr[0]), __uint_as_float(rr[1]));
}
__device__ __forceinline__ void pv(f32x16* o, int vb, bf16x8 pa0, bf16x8 pa1, bf16x8 pa2, bf16x8 pa3) {
  #pragma unroll
  for (int d0 = 0; d0 < 2; ++d0) { s16x4 lo[4], hi[4];
    #pragma unroll
    for (int ks = 0; ks < 4; ++ks) {
      asm volatile("ds_read_b64_tr_b16 %0,%1 offset:%c2" : "=&v"(lo[ks]) : "v"(vb), "i"(d0 * 4096 + ks * 1024) : "memory");
      asm volatile("ds_read_b64_tr_b16 %0,%1 offset:%c2" : "=&v"(hi[ks]) : "v"(vb), "i"(d0 * 4096 + ks * 1024 + 512) : "memory"); }
    asm volatile("s_waitcnt lgkmcnt(0)" ::: "memory"); SBAR();
    #define PK(k) (bf16x8){lo[k][0], lo[k][1], lo[k][2], lo[k][3], hi[k][0], hi[k][1], hi[k][2], hi[k][3]}
    o[d0] = __builtin_amdgcn_mfma_f32_32x32x16_bf16(pa0, PK(0), o[d0], 0, 0, 0);
    o[d0] = __builtin_amdgcn_mfma_f32_32x32x16_bf16(pa1, PK(1), o[d0], 0, 0, 0);
    o[d0] = __builtin_amdgcn_mfma_f32_32x32x16_bf16(pa2, PK(2), o[d0], 0, 0, 0);
    o[d0] = __builtin_amdgcn_mfma_f32_32x32x16_bf16(pa3, PK(3), o[d0], 0, 0, 0);
    #undef PK
  }
}
#define ATTN_STORE16(p, v) (*(u32x4*)(p) = (v))
template <int THRL> __device__ __forceinline__ void attn_unit(int tid_in, int b, int hq, int hv, int qb, const bf16* Q, const bf16* __restrict__ K, const bf16* __restrict__ V, bf16* O, char* shm) {
  const int tid = tid_in, lane = tid & 63, r32 = lane & 31, hi = lane >> 5; const int wid = __builtin_amdgcn_readfirstlane(tid >> 6);
  const long rowbase = (long)b * SEQ; const int q0 = qb * QB;
  const bf16* Qw = Q + (rowbase + q0 + wid * QBLK) * DMA + hq * D;
  const bf16* Kh = K + rowbase * DMA + hq * D, *Vh = V + rowbase * DMA + hv * D;
  const unsigned lds0 = (unsigned)(uintptr_t)shm;
  float* wsf = (float*)(shm + LDS_WS) + wid * 64;
  const bf16* ksrc = Kh + (long)lane * DMA + wid * 8;
  const bf16* vsrc = Vh + (long)(16 * (wid & 3) + (lane >> 2)) * DMA + (wid >> 2) * 32 + (lane & 3) * 8;
  const unsigned kdst = lds0 + LDS_K + wid * 1024, vdst = lds0 + LDS_V + wid * 1024;
  #define DMA_K(t, slot) glds16(ksrc + (long)(t) * KVBLK * DMA, (unsigned)__builtin_amdgcn_readfirstlane(kdst + (slot)))
  #define DMA_V(t, slot) glds16(vsrc + (long)(t) * KVBLK * DMA, (unsigned)__builtin_amdgcn_readfirstlane(vdst + (slot)))
  const int vb0 = (int)(lds0 + LDS_V) + ((lane >> 4) & 1) * 32 + (lane & 3) * 8 + (4 * hi + ((lane & 15) >> 2)) * 64;
  const char* Kbase = shm + LDS_K; bf16x8 kf[8];
  const lds_cptr shm3 = (lds_cptr)shm; const lds_cptr kp0 = shm3 + LDS_K + hi * 1024 + r32 * 16; const lds_cptr vp0 = shm3 + LDS_V + ((lane >> 4) & 1) * 32 + (lane & 3) * 8 + (4 * hi + ((lane & 15) >> 2)) * 64;
  const int NT = (q0 + QB) / KVBLK;
  DMA_K(0, 0); DMA_V(0, 0); DMA_K(1, SLOTB);
  bf16x8 qr[4];
  #pragma unroll
  for (int d0 = 0; d0 < 4; ++d0) qr[d0] = *reinterpret_cast<const bf16x8*>(&Qw[(long)r32 * DMA + d0 * 16 + hi * 8]);
  float mhat = 0.f, l_reg = 0.f; f32x16 o[2]; o[0] = f32x16{}; o[1] = f32x16{}; f32x16 negm = f32x16{}; asm volatile("" : "+v"(negm));
  const int qrel = wid * QBLK + r32;
  #define CMASK(P0, P1, t) do { int jb_ = (t) - (NT - 4); if (jb_ >= 0) cmask(P0, P1, jb_, qrel, hi); } while (0)
  bool resc = false;
  #define START(P0, P1) do { const float rm = rowmax(P0, P1); resc = false; \
    { const float dl = rm; mhat = fadd_s(mhat, dl); \
      _Pragma("unroll") for (int r = 0; r < 16; ++r) { P0[r] = fsub_s(P0[r], dl); P1[r] = fsub_s(P1[r], dl); } \
      _Pragma("unroll") for (int r = 0; r < 16; ++r) negm[r] = -mhat; asm volatile("" : "+v"(negm)); } \
    _Pragma("unroll") for (int r = 0; r < 16; ++r) P0[r] = __builtin_amdgcn_exp2f(P0[r]); } while (0)
  #define RESC() do { if (resc) { asm volatile("s_waitcnt lgkmcnt(0)" ::: "memory"); \
      _Pragma("unroll") for (int d_ = 0; d_ < 2; ++d_) _Pragma("unroll") for (int r = 0; r < 16; ++r) o[d_][r] *= wsf[crow(r, hi)]; } } while (0)
  f32x16 pA0, pA1, pB0, pB1;
  int sl_prev = 0, sl_cur = 0, sl_next = SLOTB;
  #define ROT() do { sl_prev = sl_cur; sl_cur = sl_next; sl_next = (sl_next == (NSLOT - 1) * SLOTB) ? 0 : sl_next + SLOTB; } while (0)
  DMA_K(2, 2 * SLOTB);
  WAIT_BAR(3);
  qkt(pA0, pA1, Kbase, qr, negm, r32, hi); asm volatile("s_nop 15\n\ts_nop 7" : "+v"(pA0), "+v"(pA1)); CMASK(pA0, pA1, 0);
  START(pA0, pA1);
  _Pragma("unroll") for (int r = 0; r < 16; ++r) pA1[r] = __builtin_amdgcn_exp2f(pA1[r]);
  WAIT_BAR(0);
  DMA_K(3, 0); DMA_V(1, SLOTB);
  ROT();
  kload8(kf, kp0 + sl_cur);
  WAIT_BAR(2);
  s16x4 vlo[8], vhi[8]; u32x4 pw0, pw1, pw2, pw3;
  #define PKW(P, B) cvtpk_s(P[B], P[B + 1])
  #define PAF(k) __builtin_bit_cast(bf16x8, pw##k)
  #define VFR(i) (bf16x8){vlo[i][0], vlo[i][1], vlo[i][2], vlo[i][3], vhi[i][0], vhi[i][1], vhi[i][2], vhi[i][3]}
  #define PIN(x) asm volatile("" : "+v"(x))
  #define MX3(a, b, c) __builtin_fmaxf(__builtin_fmaxf((a), (b)), (c))
  #define GAPA(MF, A0, A1, A2, A3, W0, W1, PW) do { MF; sacc += A0; sacc += A1; sacc += A2; sacc += A3; PIN(sacc); W0; W1; PIN(PW); SBAR(); } while (0)
  #define EX(v) __builtin_amdgcn_exp2f(v)
  #define GAPB(MF, X, B) do { MF; X[B] = EX(X[B]); X[B + 1] = EX(X[B + 1]); X[B + 2] = EX(X[B + 2]); X[B + 3] = EX(X[B + 3]); PIN(X); SBAR(); } while (0)
  #define VRD(i) do { vlo[i] = vtr(vp_ + (((i) >> 2) * 4096 + ((i) & 3) * 1024)); vhi[i] = vtr(vp_ + (((i) >> 2) * 4096 + ((i) & 3) * 1024 + 512)); } while (0)
  #define KRD(G, j) do { if (G) { kload2(kf, kp0 + sl_next, j); SBAR(); } } while (0)
  #define STEP(C0, C1, P0, P1, t, GK, GV, GL) do { SBAR(); \
    const lds_cptr vp_ = vp0 + sl_prev; \
    VRD(0); SBAR(); float sacc = (P0[0] + P0[1]); \
    GAPA(C0 = __builtin_amdgcn_mfma_f32_32x32x16_bf16(kf[0], qr[0], negm, 0, 0, 0), P0[2], P0[3], P0[4], P0[5],     pw0[0] = PKW(P0, 0), pw0[1] = PKW(P0, 2), pw0); \
    VRD(4); SBAR(); GAPA(C1 = __builtin_amdgcn_mfma_f32_32x32x16_bf16(kf[1], qr[0], negm, 0, 0, 0), P0[6], P0[7], P0[8], P0[9],     pw0[2] = PKW(P0, 4), pw0[3] = PKW(P0, 6), pw0); \
    VRD(1); SBAR(); GAPA(C0 = __builtin_amdgcn_mfma_f32_32x32x16_bf16(kf[2], qr[1], C0, 0, 0, 0),   P0[10], P0[11], P0[12], P0[13], pw1[0] = PKW(P0, 8), pw1[1] = PKW(P0, 10), pw1); \
    VRD(5); SBAR(); GAPA(C1 = __builtin_amdgcn_mfma_f32_32x32x16_bf16(kf[3], qr[1], C1, 0, 0, 0),   P0[14], P0[15], P1[0], P1[1],   pw1[2] = PKW(P0, 12), pw1[3] = PKW(P0, 14), pw1); \
    VRD(2); SBAR(); GAPA(C0 = __builtin_amdgcn_mfma_f32_32x32x16_bf16(kf[4], qr[2], C0, 0, 0, 0),   P1[2], P1[3], P1[4], P1[5],     pw2[0] = PKW(P1, 0), pw2[1] = PKW(P1, 2), pw2); \
    VRD(6); SBAR(); GAPA(C1 = __builtin_amdgcn_mfma_f32_32x32x16_bf16(kf[5], qr[2], C1, 0, 0, 0),   P1[6], P1[7], P1[8], P1[9],     pw2[2] = PKW(P1, 4), pw2[3] = PKW(P1, 6), pw2); \
    VRD(3); SBAR(); GAPA(C0 = __builtin_amdgcn_mfma_f32_32x32x16_bf16(kf[6], qr[3], C0, 0, 0, 0),   P1[10], P1[11], P1[12], P1[13], pw3[0] = PKW(P1, 8), pw3[1] = PKW(P1, 10), pw3); \
    VRD(7); SBAR(); GAPA(C1 = __builtin_amdgcn_mfma_f32_32x32x16_bf16(kf[7], qr[3], C1, 0, 0, 0),   P1[14], P1[15], 0.f, 0.f,       pw3[2] = PKW(P1, 12), pw3[3] = PKW(P1, 14), pw3); \
    l_reg += sacc; \
    if (GK) { DMA_K((t) + 3, sl_cur); } if (GV) { DMA_V((t) + 1, sl_next); } \
    CMASK(C0, C1, t); \
    { float a = MX3(C0[0], C0[1], C1[0]), b = MX3(C0[2], C0[3], C1[1]); a = MX3(a, C1[2], C1[3]); \
      _Pragma("unroll") for (int r = 4; r < 16; r += 4) { a = MX3(a, C0[r], C0[r + 1]); b = MX3(b, C0[r + 2], C0[r + 3]); a = MX3(a, C1[r], C1[r + 1]); b = MX3(b, C1[r + 2], C1[r + 3]); } \
      float rm = __builtin_fmaxf(a, b); { auto rr = __builtin_amdgcn_permlane32_swap(__float_as_uint(rm), __float_as_uint(rm), false, false); rm = __builtin_fmaxf(__uint_as_float(rr[0]), __uint_as_float(rr[1])); } \
      resc = false; \
      if (__builtin_expect(__any(rm > (float)THRL), 0)) { const float dl = __builtin_fmaxf(rm, 0.f); mhat += dl; \
        _Pragma("unroll") for (int r = 0; r < 16; ++r) { C0[r] -= dl; C1[r] -= dl; } \
        _Pragma("unroll") for (int r = 0; r < 16; ++r) negm[r] = -mhat; asm volatile("" : "+v"(negm)); \
        const float f = __builtin_amdgcn_exp2f(-dl); l_reg *= f; if (hi == 0) wsf[r32] = f; resc = true; } } \
    SBAR(); \
    GAPB(o[0] = __builtin_amdgcn_mfma_f32_32x32x16_bf16(PAF(0), VFR(0), o[0], 0, 0, 0), C0, 0); \
    GAPB(o[1] = __builtin_amdgcn_mfma_f32_32x32x16_bf16(PAF(0), VFR(4), o[1], 0, 0, 0), C0, 4); \
    KRD(GL, 0); GAPB(o[0] = __builtin_amdgcn_mfma_f32_32x32x16_bf16(PAF(1), VFR(1), o[0], 0, 0, 0), C0, 8); \
    KRD(GL, 1); GAPB(o[1] = __builtin_amdgcn_mfma_f32_32x32x16_bf16(PAF(1), VFR(5), o[1], 0, 0, 0), C0, 12); \
    KRD(GL, 2); GAPB(o[0] = __builtin_amdgcn_mfma_f32_32x32x16_bf16(PAF(2), VFR(2), o[0], 0, 0, 0), C1, 0); \
    KRD(GL, 3); GAPB(o[1] = __builtin_amdgcn_mfma_f32_32x32x16_bf16(PAF(2), VFR(6), o[1], 0, 0, 0), C1, 4); \
    GAPB(o[0] = __builtin_amdgcn_mfma_f32_32x32x16_bf16(PAF(3), VFR(3), o[0], 0, 0, 0), C1, 8); \
    GAPB(o[1] = __builtin_amdgcn_mfma_f32_32x32x16_bf16(PAF(3), VFR(7), o[1], 0, 0, 0), C1, 12); \
    } while (0)
  int t = 1;
  #undef CMASK
  #define CMASK(P0, P1, t) do {} while (0)
  for (; t + 5 < NT; t += 2) {
    STEP(pB0, pB1, pA0, pA1, t, true, true, true);     WAIT_BAR(2); RESC(); ROT();
    STEP(pA0, pA1, pB0, pB1, t + 1, true, true, true); WAIT_BAR(2); RESC(); ROT();
  }
  #undef CMASK
  #define CMASK(P0, P1, t) do { int jb_ = (t) - (NT - 4); if (jb_ >= 0) cmask(P0, P1, jb_, qrel, hi); } while (0)
  #define ENDW(tt) do { if ((tt) + 3 < NT) { WAIT_BAR(2); } else if ((tt) + 2 < NT) { WAIT_BAR(1); } else { WAIT_BAR(0); } } while (0)
  for (; t + 1 < NT; t += 2) {
    STEP(pB0, pB1, pA0, pA1, t, (t + 3 < NT), (t + 1 < NT), (t + 1 < NT));         ENDW(t);     RESC(); ROT();
    STEP(pA0, pA1, pB0, pB1, t + 1, (t + 4 < NT), (t + 2 < NT), (t + 2 < NT));     ENDW(t + 1); RESC(); ROT();
  }
  STEP(pB0, pB1, pA0, pA1, NT - 1, false, false, false); RESC();
  { float sacc = pB0[0] + pB0[1]; _Pragma("unroll") for (int r = 2; r < 16; ++r) sacc += pB0[r]; _Pragma("unroll") for (int r = 0; r < 16; ++r) sacc += pB1[r]; l_reg += sacc;
    pw0 = (u32x4){PKW(pB0, 0), PKW(pB0, 2), PKW(pB0, 4), PKW(pB0, 6)}; pw1 = (u32x4){PKW(pB0, 8), PKW(pB0, 10), PKW(pB0, 12), PKW(pB0, 14)}; pw2 = (u32x4){PKW(pB1, 0), PKW(pB1, 2), PKW(pB1, 4), PKW(pB1, 6)}; pw3 = (u32x4){PKW(pB1, 8), PKW(pB1, 10), PKW(pB1, 12), PKW(pB1, 14)};
    SBAR(); pv(o, vb0 + sl_cur, PAF(0), PAF(1), PAF(2), PAF(3)); }
  #undef PKW
  #undef PAF
  #undef VFR
  #undef PIN
  #undef MX3
  #undef GAPA
  #undef GAPB
  #undef EX
  #undef VRD
  #undef KRD
  #undef STEP
  #undef ENDW
  { auto rr = __builtin_amdgcn_permlane32_swap(__float_as_uint(l_reg), __float_as_uint(l_reg), false, false); l_reg = __uint_as_float(rr[0]) + __uint_as_float(rr[1]); }
  if (hi == 0) wsf[32 + r32] = l_reg; asm volatile("s_waitcnt lgkmcnt(0)" ::: "memory");
  float rli[16];
  #pragma unroll
  for (int r = 0; r < 16; ++r) rli[r] = __builtin_amdgcn_rcpf(wsf[32 + crow(r, hi)]);
  bf16* Ow = O + (rowbase + q0 + wid * QBLK) * DMA + hv * D;
  { bf16* stg = (bf16*)(shm + LDS_OST) + wid * 2048;
    #pragma unroll
    for (int r = 0; r < 16; ++r) { const int orow = crow(r, hi);
      #pragma unroll
      for (int d0 = 0; d0 < 2; ++d0) stg[orow * 64 + d0 * 32 + r32] = f2bf(o[d0][r] * rli[r]); }
    asm volatile("s_waitcnt lgkmcnt(0)" ::: "memory");
    #pragma unroll
    for (int i = 0; i < 4; ++i) { const int row = i * 8 + (lane >> 3), ch = lane & 7; const u32x4 v = *(const u32x4*)(stg + row * 64 + ch * 8); ATTN_STORE16(Ow + (long)row * DMA + ch * 8, v); } }
  asm volatile("s_waitcnt lgkmcnt(0)\n\ts_barrier" ::: "memory");
  #undef DMA_K
  #undef DMA_V
  #undef CMASK
  #undef START
  #undef RESC
  #undef ROT
}
constexpr int ATTN_LDS_BYTES = LDS_BYTES;
#undef SBAR
#undef WAIT_BAR
}

namespace attn3 {
using namespace attn_body;
constexpr int KSLOT = 8192, VSLOT = 16384;
constexpr int L_K = 0, L_V = NSLOT * KSLOT, L_WS = L_V + NSLOT * VSLOT, L_OST = L_WS + NW * 64 * 4, L_BYTES = L_OST + NW * 4096;
#define SBAR() __builtin_amdgcn_sched_barrier(0)
#define WAIT_BAR(N) asm volatile("s_waitcnt vmcnt(" #N ") lgkmcnt(0)\n\ts_barrier" ::: "memory")
template <int THRL> __device__ __forceinline__ void attn_unit(int tid_in, int b, int hq, int h, int qb, const bf16* Q, const bf16* __restrict__ K, const bf16* __restrict__ V, bf16* O, char* shm,
                                                             int mode, const bf16* SZ1, const float* g_sub, float lam, bf16* OG,
                                                             bool primed, bool has_next, int nb, int nhq, int nh, int nqb, bf16x8 (&qr)[4]) {
  int tid_ = tid_in; asm volatile("" : "+v"(tid_));
  const int tid = tid_, lane = tid & 63, r32 = lane & 31, hi = lane >> 5; const int wid = __builtin_amdgcn_readfirstlane(tid >> 6);
  const long rowbase = (long)b * SEQ; const int q0 = qb * QB;
  const bf16* Qw = Q + (rowbase + q0 + wid * QBLK) * DMA + hq * D;
  const bf16* Kh = K + rowbase * DMA + hq * D, *Vh = V + rowbase * DMA + h * 128;
  const unsigned lds0 = (unsigned)(uintptr_t)shm;
  float* wsf = (float*)(shm + L_WS) + wid * 64;
  const bf16* ksrc = Kh + (long)lane * DMA + wid * 8;
  const bf16* vsrc = Vh + (long)(16 * (wid & 3) + (lane >> 2)) * DMA + (wid >> 2) * 32 + (lane & 3) * 8;
  const unsigned kdst = lds0 + L_K + wid * 1024, vdst = lds0 + L_V + wid * 1024;
  #define DMA_K(t, si) glds16(ksrc + (long)(t) * KVBLK * DMA, (unsigned)__builtin_amdgcn_readfirstlane(kdst + (si) * KSLOT))
  #define DMA_V(t, si) do { glds16(vsrc + (long)(t) * KVBLK * DMA, (unsigned)__builtin_amdgcn_readfirstlane(vdst + (si) * VSLOT)); \
                            glds16(vsrc + (long)(t) * KVBLK * DMA + 64, (unsigned)__builtin_amdgcn_readfirstlane(vdst + (si) * VSLOT + 8192)); } while (0)
  const int vb0 = (int)(lds0 + L_V) + ((lane >> 4) & 1) * 32 + (lane & 3) * 8 + (4 * hi + ((lane & 15) >> 2)) * 64;
  const char* Kbase = shm + L_K; bf16x8 kf[8];
  const lds_cptr shm3 = (lds_cptr)shm; const lds_cptr kp0 = shm3 + L_K + hi * 1024 + r32 * 16; const lds_cptr vp0 = shm3 + L_V + ((lane >> 4) & 1) * 32 + (lane & 3) * 8 + (4 * hi + ((lane & 15) >> 2)) * 64;
  const int NT = (q0 + QB) / KVBLK;
  if (!primed) { DMA_K(0, 0); DMA_V(0, 0); DMA_K(1, 1);
    #pragma unroll
    for (int d0 = 0; d0 < 4; ++d0) qr[d0] = *reinterpret_cast<const bf16x8*>(&Qw[(long)r32 * DMA + d0 * 16 + hi * 8]); }
  float mhat = 0.f, l_reg = 0.f; f32x16 o[4]; f32x16 negm;
  { float zf = 0.f; asm volatile("" : "+v"(zf));
    _Pragma("unroll") for (int r = 0; r < 16; ++r) { o[0][r] = zf; o[1][r] = zf; o[2][r] = zf; o[3][r] = zf; negm[r] = zf; } }
  asm volatile("" : "+v"(negm));
  const int qrel = wid * QBLK + r32;
  #define CMASK(P0, P1, t) do { int jb_ = (t) - (NT - 4); if (jb_ >= 0) cmask(P0, P1, jb_, qrel, hi); } while (0)
  bool resc = false;
  #define RESC() do { if (resc) { asm volatile("s_waitcnt lgkmcnt(0)" ::: "memory"); \
      _Pragma("unroll") for (int d_ = 0; d_ < 4; ++d_) _Pragma("unroll") for (int r = 0; r < 16; ++r) o[d_][r] *= wsf[crow(r, hi)]; } } while (0)
  f32x16 C0, C1;
  int s_prev = 0, s_cur = 0, s_next = 1;
  #define ROT() do { s_prev = s_cur; s_cur = s_next; s_next = (s_next == NSLOT - 1) ? 0 : s_next + 1; } while (0)
  if (!primed) { DMA_K(2, 2); WAIT_BAR(4); }
  else { WAIT_BAR(0); }
  u32x4 pwA0, pwA1, pwA2, pwA3, pwB0, pwB1, pwB2, pwB3;
  #define PKW(P, B) cvtpk_s(P[B], P[B + 1])
  qkt(C0, C1, Kbase, qr, negm, r32, hi); asm volatile("s_nop 15\n\ts_nop 7" : "+v"(C0), "+v"(C1)); CMASK(C0, C1, 0);
  { const float rm = rowmax(C0, C1); mhat = fadd_s(mhat, rm);
    _Pragma("unroll") for (int r = 0; r < 16; ++r) { C0[r] = fsub_s(C0[r], rm); C1[r] = fsub_s(C1[r], rm); }
    _Pragma("unroll") for (int r = 0; r < 16; ++r) negm[r] = -mhat; asm volatile("" : "+v"(negm));
    float sacc = 0.f;
    _Pragma("unroll") for (int r = 0; r < 16; ++r) { C0[r] = __builtin_amdgcn_exp2f(C0[r]); C1[r] = __builtin_amdgcn_exp2f(C1[r]); }
    _Pragma("unroll") for (int r = 0; r < 16; ++r) sacc += C0[r] + C1[r];
    l_reg = sacc;
    pwA0 = (u32x4){PKW(C0, 0), PKW(C0, 2), PKW(C0, 4), PKW(C0, 6)}; pwA1 = (u32x4){PKW(C0, 8), PKW(C0, 10), PKW(C0, 12), PKW(C0, 14)};
    pwA2 = (u32x4){PKW(C1, 0), PKW(C1, 2), PKW(C1, 4), PKW(C1, 6)}; pwA3 = (u32x4){PKW(C1, 8), PKW(C1, 10), PKW(C1, 12), PKW(C1, 14)}; }
  WAIT_BAR(0);
  DMA_K(3, 0); DMA_V(1, 1);
  ROT();
  kload8(kf, kp0 + s_cur * KSLOT);
  WAIT_BAR(3);
  s16x4 vlo[8], vhi[8];
  #define PAF(w) __builtin_bit_cast(bf16x8, w)
  #define VFR(i) (bf16x8){vlo[i][0], vlo[i][1], vlo[i][2], vlo[i][3], vhi[i][0], vhi[i][1], vhi[i][2], vhi[i][3]}
  #define PIN(x) asm volatile("" : "+v"(x))
  #define MX3(a, b, c) __builtin_fmaxf(__builtin_fmaxf((a), (b)), (c))
  #define EX(v) __builtin_amdgcn_exp2f(v)
  #define VRD(s, f) do { vlo[s] = vtr(vp_ + (((f) >> 2) * 4096 + ((f) & 3) * 1024)); vhi[s] = vtr(vp_ + (((f) >> 2) * 4096 + ((f) & 3) * 1024 + 512)); } while (0)
  #define KRD(G, j) do { if (G) { kload2(kf, kp0 + s_next * KSLOT, j); SBAR(); } } while (0)
  #define GAPB(MF, X, B, PWW) do { MF; X[B] = EX(X[B]); X[B + 1] = EX(X[B + 1]); sacc += X[B]; sacc += X[B + 1]; PIN(sacc); PWW = PKW(X, B); PIN(PWW); SBAR(); } while (0)
  #define MFQ(a, b, c) __builtin_amdgcn_mfma_f32_32x32x16_bf16(a, b, c, 0, 0, 0)
  #define STEP(PP0, PP1, PP2, PP3, PN0, PN1, PN2, PN3, t, GK, GV, GL) do { SBAR(); \
    const lds_cptr vp_ = vp0 + s_prev * VSLOT; \
    VRD(0, 0); SBAR(); C0 = MFQ(kf[0], qr[0], negm); SBAR(); \
    VRD(4, 4); SBAR(); C1 = MFQ(kf[1], qr[0], negm); SBAR(); \
    VRD(1, 1); SBAR(); C0 = MFQ(kf[2], qr[1], C0); SBAR(); \
    VRD(5, 5); SBAR(); C1 = MFQ(kf[3], qr[1], C1); SBAR(); \
    VRD(2, 2); SBAR(); C0 = MFQ(kf[4], qr[2], C0); SBAR(); \
    VRD(6, 6); SBAR(); C1 = MFQ(kf[5], qr[2], C1); SBAR(); \
    VRD(3, 3); SBAR(); C0 = MFQ(kf[6], qr[3], C0); SBAR(); \
    VRD(7, 7); SBAR(); C1 = MFQ(kf[7], qr[3], C1); SBAR(); \
    if (GK) { DMA_K((t) + 3, s_cur); } if (GV) { DMA_V((t) + 1, s_next); } \
    CMASK(C0, C1, t); \
    { float a = MX3(C0[0], C0[1], C1[0]), b = MX3(C0[2], C0[3], C1[1]); a = MX3(a, C1[2], C1[3]); \
      _Pragma("unroll") for (int r = 4; r < 16; r += 4) { a = MX3(a, C0[r], C0[r + 1]); b = MX3(b, C0[r + 2], C0[r + 3]); a = MX3(a, C1[r], C1[r + 1]); b = MX3(b, C1[r + 2], C1[r + 3]); } \
      float rm = __builtin_fmaxf(a, b); { auto rr = __builtin_amdgcn_permlane32_swap(__float_as_uint(rm), __float_as_uint(rm), false, false); rm = __builtin_fmaxf(__uint_as_float(rr[0]), __uint_as_float(rr[1])); } \
      resc = false; \
      if (__builtin_expect(__any(rm > (float)THRL), 0)) { const float dl = __builtin_fmaxf(rm, 0.f); mhat += dl; \
        _Pragma("unroll") for (int r = 0; r < 16; ++r) { C0[r] -= dl; C1[r] -= dl; } \
        _Pragma("unroll") for (int r = 0; r < 16; ++r) negm[r] = -mhat; asm volatile("" : "+v"(negm)); \
        const float f = __builtin_amdgcn_exp2f(-dl); l_reg *= f; if (hi == 0) wsf[r32] = f; resc = true; } } \
    SBAR(); float sacc = 0.f; \
    GAPB(o[0] = MFQ(PAF(PP0), VFR(0), o[0]), C0, 0,  PN0[0]); VRD(0, 8);  SBAR(); \
    GAPB(o[1] = MFQ(PAF(PP0), VFR(4), o[1]), C0, 2,  PN0[1]); VRD(4, 12); SBAR(); \
    GAPB(o[0] = MFQ(PAF(PP1), VFR(1), o[0]), C0, 4,  PN0[2]); VRD(1, 9);  SBAR(); \
    GAPB(o[1] = MFQ(PAF(PP1), VFR(5), o[1]), C0, 6,  PN0[3]); VRD(5, 13); SBAR(); \
    GAPB(o[0] = MFQ(PAF(PP2), VFR(2), o[0]), C0, 8,  PN1[0]); VRD(2, 10); SBAR(); \
    GAPB(o[1] = MFQ(PAF(PP2), VFR(6), o[1]), C0, 10, PN1[1]); VRD(6, 14); SBAR(); \
    GAPB(o[0] = MFQ(PAF(PP3), VFR(3), o[0]), C0, 12, PN1[2]); VRD(3, 11); SBAR(); \
    GAPB(o[1] = MFQ(PAF(PP3), VFR(7), o[1]), C0, 14, PN1[3]); VRD(7, 15); SBAR(); \
    GAPB(o[2] = MFQ(PAF(PP0), VFR(0), o[2]), C1, 0,  PN2[0]); \
    GAPB(o[3] = MFQ(PAF(PP0), VFR(4), o[3]), C1, 2,  PN2[1]); \
    KRD(GL, 0); GAPB(o[2] = MFQ(PAF(PP1), VFR(1), o[2]), C1, 4,  PN2[2]); \
    KRD(GL, 1); GAPB(o[3] = MFQ(PAF(PP1), VFR(5), o[3]), C1, 6,  PN2[3]); \
    KRD(GL, 2); GAPB(o[2] = MFQ(PAF(PP2), VFR(2), o[2]), C1, 8,  PN3[0]); \
    KRD(GL, 3); GAPB(o[3] = MFQ(PAF(PP2), VFR(6), o[3]), C1, 10, PN3[1]); \
    GAPB(o[2] = MFQ(PAF(PP3), VFR(3), o[2]), C1, 12, PN3[2]); \
    GAPB(o[3] = MFQ(PAF(PP3), VFR(7), o[3]), C1, 14, PN3[3]); \
    l_reg += sacc; \
    } while (0)
  #define STEP_AB(t, GK, GV, GL) STEP(pwA0, pwA1, pwA2, pwA3, pwB0, pwB1, pwB2, pwB3, t, GK, GV, GL)
  #define STEP_BA(t, GK, GV, GL) STEP(pwB0, pwB1, pwB2, pwB3, pwA0, pwA1, pwA2, pwA3, t, GK, GV, GL)
  int t = 1;
  #undef CMASK
  #define CMASK(P0, P1, t) do {} while (0)
  for (; t + 5 < NT; t += 2) {
    STEP_AB(t, true, true, true);     WAIT_BAR(3); RESC(); ROT();
    STEP_BA(t + 1, true, true, true); WAIT_BAR(3); RESC(); ROT();
  }
  #undef CMASK
  #define CMASK(P0, P1, t) do { int jb_ = (t) - (NT - 4); if (jb_ >= 0) cmask(P0, P1, jb_, qrel, hi); } while (0)
  #define ENDW(tt) do { if ((tt) + 3 < NT) { WAIT_BAR(3); } else if ((tt) + 2 < NT) { WAIT_BAR(2); } else { WAIT_BAR(0); } } while (0)
  for (; t + 1 < NT; t += 2) {
    STEP_AB(t, (t + 3 < NT), (t + 1 < NT), (t + 1 < NT));         ENDW(t);     RESC(); ROT();
    STEP_BA(t + 1, (t + 4 < NT), (t + 2 < NT), (t + 2 < NT));     ENDW(t + 1); RESC(); ROT();
  }
  STEP_AB(NT - 1, false, false, false); RESC();
  { SBAR();
    const int vb = vb0 + s_cur * VSLOT;
    #pragma unroll
    for (int d0 = 0; d0 < 4; ++d0) { s16x4 lo[4], hh[4];
      #pragma unroll
      for (int ks = 0; ks < 4; ++ks) {
        asm volatile("ds_read_b64_tr_b16 %0,%1 offset:%c2" : "=&v"(lo[ks]) : "v"(vb), "i"(d0 * 4096 + ks * 1024) : "memory");
        asm volatile("ds_read_b64_tr_b16 %0,%1 offset:%c2" : "=&v"(hh[ks]) : "v"(vb), "i"(d0 * 4096 + ks * 1024 + 512) : "memory"); }
      asm volatile("s_waitcnt lgkmcnt(0)" ::: "memory"); SBAR();
      #define PK(k) (bf16x8){lo[k][0], lo[k][1], lo[k][2], lo[k][3], hh[k][0], hh[k][1], hh[k][2], hh[k][3]}
      o[d0] = MFQ(PAF(pwB0), PK(0), o[d0]); o[d0] = MFQ(PAF(pwB1), PK(1), o[d0]); o[d0] = MFQ(PAF(pwB2), PK(2), o[d0]); o[d0] = MFQ(PAF(pwB3), PK(3), o[d0]);
      #undef PK
    } }
  asm volatile("s_waitcnt lgkmcnt(0)\n\ts_barrier" ::: "memory");
  if (has_next) {
    const long nrow = (long)nb * SEQ; const int nq0 = nqb * QB;
    const bf16* nQw = Q + (nrow + nq0 + wid * QBLK) * DMA + nhq * D;
    const bf16* nks = K + nrow * DMA + nhq * D + (long)lane * DMA + wid * 8;
    const bf16* nvs = V + nrow * DMA + nh * 128 + (long)(16 * (wid & 3) + (lane >> 2)) * DMA + (wid >> 2) * 32 + (lane & 3) * 8;
    glds16(nks, (unsigned)__builtin_amdgcn_readfirstlane(kdst));
    glds16(nvs, (unsigned)__builtin_amdgcn_readfirstlane(vdst)); glds16(nvs + 64, (unsigned)__builtin_amdgcn_readfirstlane(vdst + 8192));
    glds16(nks + (long)KVBLK * DMA, (unsigned)__builtin_amdgcn_readfirstlane(kdst + KSLOT));
    glds16(nks + (long)2 * KVBLK * DMA, (unsigned)__builtin_amdgcn_readfirstlane(kdst + 2 * KSLOT));
    #pragma unroll
    for (int d0 = 0; d0 < 4; ++d0) qr[d0] = *reinterpret_cast<const bf16x8*>(&nQw[(long)r32 * DMA + d0 * 16 + hi * 8]);
  }
  { auto rr = __builtin_amdgcn_permlane32_swap(__float_as_uint(l_reg), __float_as_uint(l_reg), false, false); l_reg = __uint_as_float(rr[0]) + __uint_as_float(rr[1]); }
  if (hi == 0) wsf[32 + r32] = l_reg; asm volatile("s_waitcnt lgkmcnt(0)" ::: "memory");
  float rli[16];
  #pragma unroll
  for (int r = 0; r < 16; ++r) rli[r] = __builtin_amdgcn_rcpf(wsf[32 + crow(r, hi)]);
  int lane_e = lane; asm volatile("" : "+v"(lane_e));
  const int erow = lane_e >> 3, ech = lane_e & 7;
  bf16* Ow = O + (rowbase + q0 + wid * QBLK) * DMA + h * 128;
  bf16* stg = (bf16*)(shm + L_OST) + wid * 2048;
  if (mode == 0) {
    #pragma unroll
    for (int ps = 0; ps < 2; ++ps) {
      #pragma unroll
      for (int r = 0; r < 16; ++r) { const int orow = crow(r, hi);
        #pragma unroll
        for (int d0 = 0; d0 < 2; ++d0) stg[orow * 64 + d0 * 32 + r32] = f2bf(o[2 * ps + d0][r] * rli[r]); }
      asm volatile("s_waitcnt lgkmcnt(0)" ::: "memory");
      #pragma unroll
      for (int i = 0; i < 4; ++i) { const int row = i * 8 + erow, ch = ech; const u32x4 v = *(const u32x4*)(stg + row * 64 + ch * 8); *(u32x4*)(Ow + (long)row * DMA + ps * 64 + ch * 8) = v; }
      asm volatile("s_waitcnt lgkmcnt(0)" ::: "memory");
    }
    asm volatile("s_waitcnt vmcnt(0)" ::: "memory");
  } else {
    const bf16* Zw = SZ1 + (rowbase + q0 + wid * QBLK) * DMA + h * 128; bf16* Gw = OG + (rowbase + q0 + wid * QBLK) * DMA + h * 128;
    float dk[2][4][8]; float ss[4] = {0.f, 0.f, 0.f, 0.f};
    #pragma unroll
    for (int ps = 0; ps < 2; ++ps) {
      #pragma unroll
      for (int r = 0; r < 16; ++r) { const int orow = crow(r, hi);
        #pragma unroll
        for (int d0 = 0; d0 < 2; ++d0) stg[orow * 64 + d0 * 32 + r32] = f2bf(o[2 * ps + d0][r] * rli[r]); }
      asm volatile("s_waitcnt lgkmcnt(0)" ::: "memory");
      #pragma unroll
      for (int i = 0; i < 4; ++i) { const int row = i * 8 + erow, ch = ech;
        const u32x4 v1 = *(const u32x4*)(stg + row * 64 + ch * 8); const u32x4 v0 = *(const u32x4*)(Ow + (long)row * DMA + ps * 64 + ch * 8);
        #pragma unroll
        for (int j = 0; j < 4; ++j) { const float a0 = __uint_as_float(v0[j] << 16), a1 = __uint_as_float(v0[j] & 0xffff0000u), b0 = __uint_as_float(v1[j] << 16), b1 = __uint_as_float(v1[j] & 0xffff0000u);
          const float d0_ = a0 - lam * b0, d1_ = a1 - lam * b1; dk[ps][i][2 * j] = d0_; dk[ps][i][2 * j + 1] = d1_; ss[i] += d0_ * d0_ + d1_ * d1_; } }
      asm volatile("s_waitcnt lgkmcnt(0)" ::: "memory");
    }
    #pragma unroll
    for (int i = 0; i < 4; ++i) { float t_ = ss[i];
      t_ += __int_as_float(__builtin_amdgcn_ds_swizzle(__float_as_int(t_), 0x1f | (1 << 10))); t_ += __int_as_float(__builtin_amdgcn_ds_swizzle(__float_as_int(t_), 0x1f | (2 << 10)));
      t_ += __int_as_float(__builtin_amdgcn_ds_swizzle(__float_as_int(t_), 0x1f | (4 << 10))); ss[i] = rsqrtf(t_ * (1.0f / 128.0f) + RMS_EPS) * ONE_M_LI; }
    #pragma unroll
    for (int ps = 0; ps < 2; ++ps) {
      const int ch = ech; const float* gp = g_sub + ps * 64 + ch * 8; const f32x4_t g0 = *(const f32x4_t*)gp, g1 = *(const f32x4_t*)(gp + 4);
      #pragma unroll
      for (int i = 0; i < 4; ++i) { const int row = i * 8 + erow;
        const u32x4 z = NT_LD((const u32x4*)(Zw + (long)row * DMA + ps * 64 + ch * 8)); u32x4 w;
        #pragma unroll
        for (int j = 0; j < 4; ++j) { const float z0 = __uint_as_float(z[j] << 16), z1 = __uint_as_float(z[j] & 0xffff0000u);
          const float ga = (j < 2) ? g0[2 * j] : g1[2 * j - 4], gb = (j < 2) ? g0[2 * j + 1] : g1[2 * j - 3];
          w[j] = cvtpk_s(dk[ps][i][2 * j] * ss[i] * ga * z0, dk[ps][i][2 * j + 1] * ss[i] * gb * z1); }
        *(u32x4*)(Gw + (long)row * DMA + ps * 64 + ch * 8) = w; }
    }
  }
  asm volatile("s_waitcnt lgkmcnt(0)" ::: "memory");
  #undef DMA_K
  #undef DMA_V
  #undef CMASK
  #undef RESC
  #undef ROT
  #undef PKW
  #undef PAF
  #undef VFR
  #undef PIN
  #undef MX3
  #undef EX
  #undef VRD
  #undef KRD
  #undef GAPB
  #undef MFQ
  #undef STEP
  #undef STEP_AB
  #undef STEP_BA
  #undef ENDW
}
#undef SBAR
#undef WAIT_BAR
}

constexpr int NWAVES = 8;
constexpr size_t MiB = 1u << 20;
constexpr size_t WS_CTL = 0, CTL_ZERO_BYTES = 1 * MiB;
constexpr size_t WS_MOD = 256 * 1024;
constexpr size_t WS_LAM = 1 * MiB;
constexpr size_t WS_HN = 1 * MiB + 128 * 1024;
constexpr size_t WS_LB16 = 1 * MiB + 4096;
constexpr size_t WS_WIN0 = 2 * MiB, WS_WGLU = 6 * MiB, WS_WOUT0 = 8 * MiB, WS_WKV = 10 * MiB, WS_WIN1 = 14 * MiB, WS_WOUT1 = 18 * MiB;
constexpr size_t WS_BTA = 20 * MiB;
constexpr size_t WS_BTB = 28 * MiB;
constexpr size_t WS_S0 = 48 * MiB, WS_S1 = 112 * MiB, WS_S2 = 176 * MiB, WS_S3 = 240 * MiB, WS_S4 = 304 * MiB, WS_S5 = 368 * MiB, WS_S6 = 432 * MiB, WS_END = 496 * MiB;
constexpr int CW_BAR = 4096;
constexpr int CW_TMO = 8, CW_SEAM = 16384, SEAM_BANK = 128 * 64;
constexpr size_t WS_XCH = 40 * MiB;
constexpr int RING_OFF = 0, RING_BYTES = 131072;
constexpr int LDSCTL_OFF = RING_BYTES, MISC_OFF = LDSCTL_OFF + 320;
constexpr int LDS_BYTES = 147456;

#define GAS __attribute__((address_space(1)))
#define LAS __attribute__((address_space(3)))
typedef unsigned v4u __attribute__((ext_vector_type(4)));
typedef GAS unsigned gu32;
#define RLX_AGENT __ATOMIC_RELAXED, __HIP_MEMORY_SCOPE_AGENT
#define LDS_WAIT() asm volatile("s_waitcnt lgkmcnt(0)" ::: "memory")
#define VM_WAIT() asm volatile("s_waitcnt vmcnt(0)" ::: "memory")

#define XB_TMO      128
#define XB_XCNT(j)  (256  + 64 * (j))
#define XB_XSUB(j)  (1280 + 64 * (j))
#define XB_XGEN(j)  (2304 + 64 * (j))
#define XB_TOP      3328
#define XB_TOPGEN   3392
#define XCD_BAR_WORDS 3456
#define XB_SPIN_CAP (1u << 18)
__device__ __forceinline__ unsigned xb_ld(unsigned* p)              { return __hip_atomic_load(p, __ATOMIC_RELAXED, __HIP_MEMORY_SCOPE_AGENT); }
__device__ __forceinline__ unsigned xb_add(unsigned* p, unsigned v) { return __hip_atomic_fetch_add(p, v, __ATOMIC_RELAXED, __HIP_MEMORY_SCOPE_AGENT); }
__device__ __forceinline__ unsigned xb_xcc_id() { return (unsigned)__builtin_amdgcn_s_getreg((3 << 11) | 20) & 0xFu; }
#define XB_SPIN(cond, bar) do { unsigned _sp = 0; while (cond) { __builtin_amdgcn_s_sleep(1); \
    if ((++_sp & 255u) == 0u) { if (xb_ld(&(bar)[XB_TMO])) break; if (_sp > XB_SPIN_CAP) { atomicAdd(&(bar)[XB_TMO], 1u); break; } } } } while (0)
struct XcdBarrier { unsigned* bar; unsigned x; volatile LAS unsigned* st; };
__device__ __forceinline__ XcdBarrier xcd_barrier_post(unsigned* bar, volatile LAS unsigned* st, int tid) {
    XcdBarrier b; b.bar = bar; b.x = xb_xcc_id(); b.st = st;
    if (tid == 0) (void)xb_add(&bar[XB_XCNT(b.x)], 1u);
    return b;
}
__device__ __forceinline__ void xcd_barrier_complete(unsigned* bar, unsigned x, unsigned& nloc, unsigned& nx) {
    const unsigned G = gridDim.x * gridDim.y * gridDim.z;
    unsigned sum, cnt, mine, sp = 0u;
    for (;;) {
        sum = 0u; cnt = 0u; mine = 0u;
#pragma unroll
        for (unsigned j = 0; j < 16; ++j) { const unsigned c = xb_ld(&bar[XB_XCNT(j)]); sum += c; cnt += (c > 0u) ? 1u : 0u; mine = (j == x) ? c : mine; }
        if (sum == G) break;
        __builtin_amdgcn_s_sleep(1);
        if ((++sp & 255u) == 0u) { if (xb_ld(&bar[XB_TMO])) break; if (sp > XB_SPIN_CAP) { atomicAdd(&bar[XB_TMO], 1u); break; } }
    }
    nloc = mine > 0u ? mine : 1u; nx = cnt > 0u ? cnt : 1u;
}
__device__ __forceinline__ void xcd_barrier(const XcdBarrier& b, int tid) {
    asm volatile("s_waitcnt vmcnt(0)" ::: "memory");
    __syncthreads();
    if (tid == 0) {
        unsigned* bar = b.bar;
        __builtin_amdgcn_s_waitcnt(0);
        unsigned nloc = b.st[0], nx = b.st[1];
        if (nloc == 0u) { xcd_barrier_complete(bar, b.x, nloc, nx); b.st[0] = nloc; b.st[1] = nx; }
        const unsigned old = xb_add(&bar[XB_XSUB(b.x)], 1u);
        const unsigned gen = old / nloc;
        if (old + 1u == (gen + 1u) * nloc) {
            __builtin_amdgcn_fence(__ATOMIC_RELEASE, "agent");
            asm volatile("s_waitcnt vmcnt(0)" ::: "memory");
            const unsigned og = xb_add(&bar[XB_TOP], 1u);
            const unsigned tg = og / nx;
            if (og + 1u == (tg + 1u) * nx) xb_add(&bar[XB_TOPGEN], 1u);
            else XB_SPIN(xb_ld(&bar[XB_TOPGEN]) == tg, bar);
            __builtin_amdgcn_fence(__ATOMIC_ACQUIRE, "agent");
            xb_add(&bar[XB_XGEN(b.x)], 1u);
            asm volatile("s_waitcnt vmcnt(0)" ::: "memory");
        } else {
            XB_SPIN(xb_ld(&bar[XB_XGEN(b.x)]) == gen, bar);
            __builtin_amdgcn_fence(__ATOMIC_ACQUIRE, "agent");
            asm volatile("s_waitcnt vmcnt(0)" ::: "memory");
        }
    }
    __syncthreads();
}

__device__ __forceinline__ void p0_transpose_item(const float* W, int K, int N, bf16_t* WT, int row_off, const float* kscale, LAS float* scr, int item, int lane) {
    const int nblk = N / 32, kb = item / nblk, nb = item % nblk, k0 = 64 * kb, n0 = 32 * nb;
    float tv[32];
#pragma unroll
    for (int i = 0; i < 32; ++i) tv[i] = NT_LD(W + (size_t)(k0 + 2 * i + (lane >> 5)) * N + n0 + (lane & 31));
#pragma unroll
    for (int i = 0; i < 32; ++i) { const int kk = 2 * i + (lane >> 5); float v = tv[i]; if (kscale) v *= kscale[k0 + kk]; scr[kk * 33 + (lane & 31)] = v; }
    LDS_WAIT(); asm volatile("" ::: "memory");
    const int c = lane & 7;
#pragma unroll
    for (int j = 0; j < 4; ++j) { const int n = (lane >> 3) + 8 * j; const LAS float* s = scr + (8 * c) * 33 + n;
        v4u o; o.x = pk2bf(s[0 * 33], s[1 * 33]); o.y = pk2bf(s[2 * 33], s[3 * 33]); o.z = pk2bf(s[4 * 33], s[5 * 33]); o.w = pk2bf(s[6 * 33], s[7 * 33]);
        *(GAS v4u*)(WT + (size_t)(row_off + n0 + n) * K + k0 + 8 * c) = o; }
    LDS_WAIT(); asm volatile("" ::: "memory");
}

__device__ __forceinline__ int lane_now_asm() { int r; asm volatile("v_mbcnt_lo_u32_b32 %0, -1, 0\n\tv_mbcnt_hi_u32_b32 %0, -1, %0" : "=v"(r)); return r; }
struct Args {
    const float* in[28]; float* out; unsigned char* ws;
    int ph_lo, ph_hi, use_bar, flags;
};

__global__ void __launch_bounds__(NWAVES * 64, 2) mega_fwd(Args args) {
    extern __shared__ __attribute__((aligned(16))) unsigned char lds_raw[];
    LAS unsigned char* lds = (LAS unsigned char*)lds_raw;
    volatile LAS unsigned* MISC = (volatile LAS unsigned*)(lds + MISC_OFF);
    const int wave = __builtin_amdgcn_readfirstlane((int)threadIdx.x >> 6);
#define LANE_NOW() lane_now_asm()
#define TID_NOW() (wave * 64 + LANE_NOW())
    const int G = gridDim.x; const int bx = blockIdx.x; const int vcu = (G % 8 == 0) ? (bx % 8) * (G / 8) + bx / 8 : bx;
    unsigned char* ws = args.ws;
    gu32* ctl = (gu32*)(ws + WS_CTL);
    const float* x = args.in[0]; const float* cvec = args.in[1]; const float* ada_w = args.in[2]; const float* ada_b = args.in[3];
    const float* g_pre = args.in[4]; const float* g_post = args.in[5];
    float* out = args.out;
    float* mod = (float*)(ws + WS_MOD); float* lamp = (float*)(ws + WS_LAM); float* lb16 = (float*)(ws + WS_LB16);
    bf16_t* Win0 = (bf16_t*)(ws + WS_WIN0); bf16_t* Wglu = (bf16_t*)(ws + WS_WGLU); bf16_t* Wout0 = (bf16_t*)(ws + WS_WOUT0); bf16_t* Wkv = (bf16_t*)(ws + WS_WKV);
    bf16_t* Win1 = (bf16_t*)(ws + WS_WIN1); bf16_t* Wout1 = (bf16_t*)(ws + WS_WOUT1); bf16_t* BtA = (bf16_t*)(ws + WS_BTA); bf16_t* BtB = (bf16_t*)(ws + WS_BTB);
    bf16_t* A0 = (bf16_t*)(ws + WS_S0); bf16_t* US = (bf16_t*)(ws + WS_S1); bf16_t* SZ = (bf16_t*)(ws + WS_S3); bf16_t* YG = (bf16_t*)(ws + WS_S4); float* EB = (float*)(ws + WS_S0);
    bf16_t* Y2 = (bf16_t*)(ws + WS_S0); bf16_t* YO = (bf16_t*)(ws + WS_S1); bf16_t* AKV = (bf16_t*)(ws + WS_S0); bf16_t* AIN1 = (bf16_t*)(ws + WS_S2);
    bf16_t* KB = (bf16_t*)(ws + WS_S3); bf16_t* VB = (bf16_t*)(ws + WS_S4); bf16_t* QB = (bf16_t*)(ws + WS_S5); bf16_t* SZ1 = (bf16_t*)(ws + WS_S6);
    bf16_t* O0 = (bf16_t*)(ws + (H1_AKV ? WS_S1 : WS_S0)); bf16_t* O1 = (bf16_t*)(ws + WS_S1); bf16_t* OG = (bf16_t*)(ws + WS_S2); bf16_t* YO1 = (bf16_t*)(ws + (H1_AKV ? WS_S3 : WS_S0));
    float* HN = (float*)(ws + WS_HN);

    for (int u = TID_NOW(); u < (LDS_BYTES - LDSCTL_OFF) / 4; u += NWAVES * 64) ((LAS unsigned*)(lds + LDSCTL_OFF))[u] = 0u;
    __syncthreads();
    XcdBarrier bar; bar.bar = (unsigned*)(ctl + CW_BAR); bar.x = 0; bar.st = nullptr;
    if (args.use_bar) bar = xcd_barrier_post((unsigned*)(ctl + CW_BAR), MISC + 8, TID_NOW());
    const int lo = args.ph_lo, hi = args.ph_hi;
#define IN(k) (lo <= (k) && (k) < hi)
#define REPS(k) (1 + ((REPEAT_MASK >> (k)) & 1))
#define SEAM(k) do { if (IN(k) && IN((k) + 1) && args.use_bar) xcd_barrier(bar, TID_NOW()); } while (0)
    const int gw = vcu * NWAVES + wave, NGW = G * NWAVES;
#define LANE_L() ({ int l_ = LANE_NOW(); asm volatile("" : "+v"(l_)); l_; })

    if (IN(0)) for (int rep_ = 0; rep_ < REPS(0); ++rep_) {
        const int tid = TID_NOW(), lane = tid & 63;
        for (int it = vcu; it < NGRP * 4; it += G) {
            const int g = it >> 2, qt = it & 3;
            LAS float* LBP = (LAS float*)(lds + RING_OFF);
            LAS float* BBR = LBP + 17 * 128;
            LAS float* CC = BBR + 64 * 32;
            LAS float* KM = CC + 16 * 130 + 12;
            __syncthreads();
            if (tid < 64) {
                const int p = tid;
                const float dt = expf(args.in[9][g]);
                const float lr = args.in[7][g * 64 + p], li = args.in[8][g * 64 + p];
                const float mag = expf(lr * dt); const float sn = sinf(li * dt), cs = cosf(li * dt);
                const float lbr = mag * cs, lbi = mag * sn;
                float pr = 1.f, pi = 0.f;
                for (int d = 0; d <= 16; ++d) { LBP[(d * 64 + p) * 2] = pr; LBP[(d * 64 + p) * 2 + 1] = pi; const float nr = pr * lbr - pi * lbi, ni = pr * lbi + pi * lbr; pr = nr; pi = ni; }
                if (qt == 0) { lb16[(g * 64 + p) * 2] = LBP[(16 * 64 + p) * 2]; lb16[(g * 64 + p) * 2 + 1] = LBP[(16 * 64 + p) * 2 + 1]; }
                const float nr = lbr - 1.0f, ni = lbi, den = lr * lr + li * li;
                const float cr = (nr * lr + ni * li) / den, ci = (ni * lr - nr * li) / den;
                for (int c = 0; c < 16; ++c) { const float br = args.in[10][(g * 64 + p) * 16 + c], bi = args.in[11][(g * 64 + p) * 16 + c];
                    BBR[(p * 16 + c) * 2] = cr * br - ci * bi; BBR[(p * 16 + c) * 2 + 1] = cr * bi + ci * br; }
            }
            for (int e = tid; e < 1024; e += 512) { const int co = e >> 6, p = e & 63; CC[(co * 65 + p) * 2] = args.in[12][(g * 16 + co) * 64 + p]; CC[(co * 65 + p) * 2 + 1] = args.in[13][(g * 16 + co) * 64 + p]; }
            __syncthreads();
            {
                const int pair = tid >> 1, hh = tid & 1, d = pair >> 4, co = pair & 15; float acc8[8];
#pragma unroll
                for (int j = 0; j < 8; ++j) acc8[j] = 0.f;
                for (int p = 0; p < 64; ++p) { const float cr = CC[(co * 65 + p) * 2], cim = CC[(co * 65 + p) * 2 + 1], lr = LBP[(d * 64 + p) * 2], lim = LBP[(d * 64 + p) * 2 + 1];
                    const float wr_ = cr * lr - cim * lim, wi_ = cr * lim + cim * lr; const LAS f32x4_t* bp = (const LAS f32x4_t*)(BBR + (p * 16 + 8 * hh) * 2);
#pragma unroll
                    for (int q4 = 0; q4 < 4; ++q4) { const f32x4_t bb = bp[q4]; acc8[2 * q4] += wr_ * bb.x - wi_ * bb.y; acc8[2 * q4 + 1] += wr_ * bb.z - wi_ * bb.w; } }
#pragma unroll
                for (int j = 0; j < 8; ++j) KM[(d * 16 + co) * 16 + 8 * hh + j] = acc8[j] + ((SSM_DFOLD && d == 0 && co == 8 * hh + j) ? args.in[14][g * 16 + co] : 0.f);
            }
            __syncthreads();
            for (int e = tid; e < 64 * 48; e += 512) {
                const int n = 64 * qt + e / 48, pc = e % 48, s = n >> 4, co = n & 15; float v[8];
                if (pc < 32) { const int s2 = pc >> 1, ci0 = (pc & 1) * 8;
#pragma unroll
                    for (int j = 0; j < 8; ++j) v[j] = (s2 <= s) ? KM[((s - s2) * 16 + co) * 16 + ci0 + j] : 0.f;
                } else { const int j0 = (pc - 32) * 8;
#pragma unroll
                    for (int jj = 0; jj < 4; ++jj) { const int p = (j0 >> 1) + jj; const float cr = CC[(co * 65 + p) * 2], cim = CC[(co * 65 + p) * 2 + 1], lr = LBP[((s + 1) * 64 + p) * 2], lim = LBP[((s + 1) * 64 + p) * 2 + 1];
                        v[2 * jj] = cr * lr - cim * lim; v[2 * jj + 1] = -(cr * lim + cim * lr); } }
                v4u o; o.x = pk2bf(v[0], v[1]); o.y = pk2bf(v[2], v[3]); o.z = pk2bf(v[4], v[5]); o.w = pk2bf(v[6], v[7]);
                *(GAS v4u*)(BtB + ((size_t)g * 256 + n) * 384 + pc * 8) = o; }
            for (int e = tid; e < 64 * 32; e += 512) {
                const int n = 64 * qt + (e >> 5), pc = e & 31; float v[8];
                if (n < 128) { const int p = n >> 1, ri = n & 1, s2 = pc >> 1, ci0 = (pc & 1) * 8; const float lr = LBP[((15 - s2) * 64 + p) * 2], lim = LBP[((15 - s2) * 64 + p) * 2 + 1];
#pragma unroll
                    for (int j = 0; j < 8; ++j) { const float br = BBR[(p * 16 + ci0 + j) * 2], bi = BBR[(p * 16 + ci0 + j) * 2 + 1]; v[j] = ri ? (lr * bi + lim * br) : (lr * br - lim * bi); }
                } else {
#pragma unroll
                    for (int j = 0; j < 8; ++j) v[j] = 0.f; }
                v4u o; o.x = pk2bf(v[0], v[1]); o.y = pk2bf(v[2], v[3]); o.z = pk2bf(v[4], v[5]); o.w = pk2bf(v[6], v[7]);
                *(GAS v4u*)(BtA + ((size_t)g * 256 + n) * 256 + pc * 8) = o; }
        }
        __syncthreads();
        {
            LAS float* scr = (LAS float*)(lds + RING_OFF + wave * 16384);
            constexpr int I_2K = (DM / 64) * (2048 / 32), I_1K = (DM / 64) * (1024 / 32);
            constexpr int NITEMS = 2 * I_2K + 5 * I_1K;
            for (int it = gw; it < NITEMS; it += NGW) {
                int r = it;
                if (r < I_2K) { p0_transpose_item(args.in[6], DM, 2048, Win0, 0, nullptr, scr, r, lane); continue; } r -= I_2K;
                if (r < I_2K) { p0_transpose_item(args.in[21], DM, 2048, Win1, 0, nullptr, scr, r, lane); continue; } r -= I_2K;
                if (r < I_1K) { p0_transpose_item(args.in[15], DM, 1024, Wglu, 0, nullptr, scr, r, lane); continue; } r -= I_1K;
                if (r < I_1K) { p0_transpose_item(args.in[17], DM, 1024, Wout0, 0, nullptr, scr, r, lane); continue; } r -= I_1K;
                if (r < I_1K) { p0_transpose_item(args.in[19], DM, 1024, Wkv, 0, args.in[18], scr, r, lane); continue; } r -= I_1K;
                if (r < I_1K) { p0_transpose_item(args.in[20], DM, 1024, Wkv, 1024, args.in[18], scr, r, lane); continue; } r -= I_1K;
                p0_transpose_item(args.in[27], DM, 1024, Wout1, 0, nullptr, scr, r, lane);
            }
        }
        if (!(args.flags & 1)) {
            __syncthreads();
            LAS float* sc = (LAS float*)(lds + RING_OFF);
            LAS float* red = sc + 8192;
            bool have = false;
            for (int it = vcu; it < 2 * 96; it += G) {
                if (!have) { for (int e = tid; e < 8192; e += 512) sc[e] = silu_f(cvec[e]); have = true; __syncthreads(); }
                const int l = it / 96, cc = it % 96, j = cc * 32 + (lane & 31), kh = lane >> 5;
                float acc[8];
#pragma unroll
                for (int b = 0; b < 8; ++b) acc[b] = 0.f;
                const float* wp = ada_w + ((size_t)l * 1024 + wave * 128 + kh) * 3072 + j;
                for (int k0 = 0; k0 < 64; k0 += 32) {
                    float w[32];
#pragma unroll
                    for (int kk = 0; kk < 32; ++kk) w[kk] = NT_LD(wp + (size_t)(2 * (k0 + kk)) * 3072);
#pragma unroll
                    for (int kk = 0; kk < 32; ++kk) {
#pragma unroll
                        for (int b = 0; b < 8; ++b) acc[b] += w[kk] * sc[b * 1024 + wave * 128 + 2 * (k0 + kk) + kh];
                        if ((kk & 3) == 3) asm volatile("" ::: "memory"); }
                }
#pragma unroll
                for (int b = 0; b < 8; ++b) { acc[b] += __shfl_xor(acc[b], 32); if (lane < 32) red[(wave * 8 + b) * 32 + lane] = acc[b]; }
                __syncthreads();
                if (tid < 256) { const int b = tid >> 5, jl = tid & 31; float sum = ada_b[l * 3072 + cc * 32 + jl];
#pragma unroll
                  for (int w = 0; w < 8; ++w) sum += red[(w * 8 + b) * 32 + jl];
                  mod[((size_t)(l * 8 + b)) * 3072 + cc * 32 + jl] = sum; }
                __syncthreads();
            }
            if (bx == 0 && tid == 0) lamp[0] = diff_lambda(args.in[22], args.in[23], args.in[24], args.in[25]);
        }
    }
    SEAM(0);
    if (IN(1)) for (int rep_ = 0; rep_ < REPS(1); ++rep_) e_norm0_b(x, mod, g_pre, A0, gw, NGW, LANE_L());
    SEAM(1);
#ifdef EXTRA_BARS
    if (args.use_bar) for (int eb = 0; eb < EXTRA_BARS; ++eb) xcd_barrier(bar, TID_NOW());
#endif
    if (IN(2)) for (int rep_ = 0; rep_ < REPS(2); ++rep_) {
        pg8::Gemm g = pg8::gemm_std(A0, DM, Win0, DM, DM); pg8::Order S; S.init(MTOK / 256, 2048 / 256, 1, G, bx);
        pg8::EpiRow8<pg8::F_In0> E{{US, SZ}};
        pg8::gemm_phase<pg8::EpiRow8<pg8::F_In0>, ALIGN_E>(lds + RING_OFF, g, S, E, TID_NOW());
    }
    SEAM(2);
#if SSM_FUSED
    if (IN(3)) {
        pg8::Gemm gA = pg8::gemm_std(US, US_P, BtA, 256, 256); gA.a_gstep = (size_t)NTILE * US_P * 2; gA.b_gstep = (size_t)256 * 256 * 2;
        pg8::Gemm gB = pg8::gemm_std(US, US_P, BtB, 384, 384); gB.a_gstep = (size_t)NTILE * US_P * 2; gB.b_gstep = (size_t)256 * 384 * 2;
        pg8::EpiScan ES{lb16, US, LDSCTL_OFF + 2048};
#if SSM_DFOLD
        pg8::EpiRow8<pg8::F_SsmB0> EB2{{YG}};
#else
        pg8::EpiRow8<pg8::F_SsmB> EB2{{US, args.in[14], YG}};
#endif
        for (int uu = 0; (long)uu * G + bx < NGRP * NB; ++uu) {
            pg8::Order S; S.init(NTILE / 256, 1, NGRP, G, bx); S.only = uu;
            pg8::gemm_phase<pg8::EpiScan, false>(lds + RING_OFF, gA, S, ES, TID_NOW());
#if SSM_DFOLD
            pg8::gemm_phase<pg8::EpiRow8<pg8::F_SsmB0>, false>(lds + RING_OFF, gB, S, EB2, TID_NOW());
#else
            pg8::gemm_phase<pg8::EpiRow8<pg8::F_SsmB>, false>(lds + RING_OFF, gB, S, EB2, TID_NOW());
#endif
        }
    }
    SEAM(5);
#else
    if (IN(3)) for (int rep_ = 0; rep_ < REPS(3); ++rep_) {
        pg8::Gemm g = pg8::gemm_std(US, US_P, BtA, 256, 256); g.a_gstep = (size_t)NTILE * US_P * 2; g.b_gstep = (size_t)256 * 256 * 2;
        pg8::Order S; S.init(NTILE / 256, 1, NGRP, G, bx);
        pg8::EpiRow8<pg8::F_SsmA> E{{EB}};
        pg8::gemm_phase<pg8::EpiRow8<pg8::F_SsmA>, ALIGN_E>(lds + RING_OFF, g, S, E, TID_NOW());
    }
    SEAM(3);
    if (IN(4)) for (int rep_ = 0; rep_ < REPS(4); ++rep_) {
        for (int it = vcu + G * wave; it < NB * NGRP; it += G * NWAVES) {
            const int b = it / NGRP, g = it % NGRP, p = LANE_L();
            const float lr = lb16[(g * 64 + p) * 2], li = lb16[(g * 64 + p) * 2 + 1];
            float sr = 0.f, si = 0.f;
            const float* ep = EB + ((size_t)g * NTILE + b * 256) * 128 + 2 * p;
            bf16_t* sp = US + us_off(g, b * 256, 256 + 2 * p);
            for (int t0 = 0; t0 < 256; t0 += 16) {
                float er[16], ei[16];
#pragma unroll
                for (int j = 0; j < 16; ++j) { const float2 e = *(const float2*)(ep + (size_t)(t0 + j) * 128); er[j] = e.x; ei[j] = e.y; }
#pragma unroll
                for (int j = 0; j < 16; ++j) { *(unsigned*)(sp + (size_t)(t0 + j) * US_P) = pk2bf(sr, si);
                    const float nr = lr * sr - li * si + er[j], ni = lr * si + li * sr + ei[j]; sr = nr; si = ni; }
            }
        }
    }
    SEAM(4);
    if (IN(5)) for (int rep_ = 0; rep_ < REPS(5); ++rep_) {
        pg8::Gemm g = pg8::gemm_std(US, US_P, BtB, 384, 384); g.a_gstep = (size_t)NTILE * US_P * 2; g.b_gstep = (size_t)256 * 384 * 2;
        pg8::Order S; S.init(NTILE / 256, 1, NGRP, G, bx);
        pg8::EpiRow8<pg8::F_SsmB> E{{US, args.in[14], YG}};
        pg8::gemm_phase<pg8::EpiRow8<pg8::F_SsmB>, ALIGN_E>(lds + RING_OFF, g, S, E, TID_NOW());
    }
    SEAM(5);
#endif
    if (IN(6)) for (int rep_ = 0; rep_ < REPS(6); ++rep_) {
        pg8::Gemm g = pg8::gemm_std(YG, DM, Wglu, DM, DM);
        g.a_rs = 32u; g.a_c16 = (unsigned)((size_t)NTILE * YG_P * 2); g.a_kstep = (size_t)4 * NTILE * YG_P * 2; g.a_tstep = (size_t)256 * 32;
        pg8::Order S; S.init(MTOK / 256, 1024 / 256, 1, G, bx);
        pg8::EpiRow8<pg8::F_Glu> E{{YG, SZ, args.in[16], Y2}};
        pg8::gemm_phase<pg8::EpiRow8<pg8::F_Glu>, ALIGN_E>(lds + RING_OFF, g, S, E, TID_NOW());
    }
    SEAM(6);
#if FUSE_EPI
    if (IN(7)) {
        pg8::Gemm g = pg8::gemm_std(Y2, DM, Wout0, DM, DM);
        for (int half = 0; half < 2; ++half) {
            pg8::Order S; S.init(MTOK / 512, 1024 / 256, 1, G, bx); S.pm_off = half * (MTOK / 512);
            pg8::PanelRms st1{(unsigned*)(ws + WS_XCH), (unsigned*)(ctl + CW_SEAM), (unsigned*)(ctl + CW_TMO), RMS_EPS};
            pg8::PanelRms st2{(unsigned*)(ws + WS_XCH + 1 * MiB), (unsigned*)(ctl + CW_SEAM + SEAM_BANK), (unsigned*)(ctl + CW_TMO), RMS_EPS};
            pg8::EpiMid E{x, out, AKV, AIN1, mod, g_post, g_pre + 1024, st1, st2};
            pg8::gemm_phase<pg8::EpiMid, false>(lds + RING_OFF, g, S, E, TID_NOW());
        }
    }
#else
    if (IN(7)) {
        pg8::Gemm g = pg8::gemm_std(Y2, DM, Wout0, DM, DM); pg8::Order S; S.init(MTOK / 256, 1024 / 256, 1, G, bx);
        pg8::EpiRow8<pg8::F_Plain> E{{YO}};
        pg8::gemm_phase<pg8::EpiRow8<pg8::F_Plain>, ALIGN_E>(lds + RING_OFF, g, S, E, TID_NOW());
    }
    SEAM(7);
    if (IN(8)) { if (H1_BF16) e_mid(x, YO, mod, g_post, g_pre, (float*)nullptr, YO, AKV, AIN1, gw, NGW, LANE_L()); else e_mid_b(x, YO, mod, g_post, g_pre, (H1_RECOMP || H1_AKV) ? (float*)nullptr : out, AKV, AIN1, gw, NGW, LANE_L(), H1_AKV ? HN : (float*)nullptr); }
#endif
    SEAM(8);
    if (IN(9)) for (int rep_ = 0; rep_ < REPS(9); ++rep_) {
        pg8::Gemm g = pg8::gemm_std(AKV, DM, Wkv, DM, DM); g.a_gstep = (size_t)(WS_S2 - WS_S0); g.b_gstep = (size_t)(WS_WIN1 - WS_WKV);
        pg8::Order S; S.init(MTOK / 256, 2048 / 256, 2, G, bx); S.mode2 = (G == 256);
        pg8::EpiRow8<pg8::F_Split2> E{{{KB, QB}, {VB, SZ1}}};
        pg8::gemm_phase<pg8::EpiRow8<pg8::F_Split2>, ALIGN_E>(lds + RING_OFF, g, S, E, TID_NOW());
    }
    SEAM(9);
    if (IN(10)) {
#if ATTN_V128
#if ATTN_FUSE_POST
        { const float lam = __int_as_float(__builtin_amdgcn_readfirstlane(__float_as_int(lamp[0])));
          attn_body::bf16x8 qr[4]; bool primed = false;
#if ATTN_PRIO
          if (wave >= 4) __builtin_amdgcn_s_setprio(1);
#endif
          const int nun = (64 * 16 - vcu + G - 1) / G;
#pragma unroll 1
          for (int su = 0; su < 2 * nun; ++su) {
            const int i = su >> 1, cc = su & 1;
            const long L = (long)i * G + vcu; const int pr = (int)(L % 256), qi = (int)(L / 256);
            const int bh = pr >> 2, j = pr & 3; const int qb = (qi & 1) ? (8 * (qi >> 1) + 7 - j) : (8 * (qi >> 1) + j); const int h = bh & 7, b = bh >> 3;
            const bool has_next = su + 1 < 2 * nun;
            const int i2 = (su + 1) >> 1, cc2 = (su + 1) & 1;
            const long L2 = (long)i2 * G + vcu; const int pr2 = (int)(L2 % 256), qi2 = (int)(L2 / 256);
            const int bh2 = pr2 >> 2, j2 = pr2 & 3; const int qb2 = (qi2 & 1) ? (8 * (qi2 >> 1) + 7 - j2) : (8 * (qi2 >> 1) + j2); const int h2 = bh2 & 7, b2 = bh2 >> 3;
            attn3::attn_unit<8>(TID_NOW(), b, 2 * h + cc, h, qb, QB, KB, VB, O0, (char*)lds_raw + RING_OFF, cc, SZ1, args.in[26], lam, OG, primed, has_next, b2, 2 * h2 + cc2, h2, qb2, qr);
            primed = true;
          }
#if ATTN_PRIO
          __builtin_amdgcn_s_setprio(0);
#endif
          }
#else
        for (int i = 0;; ++i) {
            const long L = (long)i * G + vcu; if (L >= 128 * 16) break;
            const int pr = (int)(L % 256), qi = (int)(L / 256);
            const int combo = pr >> 1, j = pr & 1;
            const int k4 = qi >> 1; const int qb = (qi & 1) ? (4 * k4 + 3 - j) : (4 * k4 + j);
            const int c = combo & 1, h = (combo >> 1) & 7, b = combo >> 4;
            { attn_body::bf16x8 qr_[4]; attn3::attn_unit<8>(TID_NOW(), b, 2 * h + c, h, qb, QB, KB, VB, c ? O1 : O0, (char*)lds_raw + RING_OFF, 0, SZ1, args.in[26], 0.f, OG, false, false, 0, 0, 0, 0, qr_); asm volatile("s_barrier" ::: "memory"); }
        }
#endif
#else
        for (int i = 0;; ++i) {
            const long L = (long)i * G + vcu; if (L >= 256 * 16) break;
            const int combo = (int)(L % 256), qi = (int)(L / 256);
            const int qb = (qi & 1) ? (qi >> 1) : (15 - (qi >> 1));
            const int vh = combo & 1, c = (combo >> 1) & 1, h = (combo >> 2) & 7, b = combo >> 5;
            attn_body::attn_unit<8>(TID_NOW(), b, 2 * h + c, 2 * h + vh, qb, QB, KB, VB, c ? O1 : O0, (char*)lds_raw + RING_OFF);
        }
#endif
    }
    SEAM(10);
#if !(ATTN_V128 && ATTN_FUSE_POST)
    if (IN(11)) for (int rep_ = 0; rep_ < REPS(11); ++rep_) e_attn_post(O0, O1, SZ1, args.in[26], lamp[0], OG, gw, NGW, LANE_L());
    SEAM(11);
#endif
#if FUSE_EPI
    if (IN(12)) {
        pg8::Gemm g = pg8::gemm_std(OG, DM, Wout1, DM, DM);
        for (int half = 0; half < 2; ++half) {
            pg8::Order S; S.init(MTOK / 512, 1024 / 256, 1, G, bx); S.pm_off = half * (MTOK / 512);
            pg8::PanelRms st{(unsigned*)(ws + WS_XCH + 2 * MiB), (unsigned*)(ctl + CW_SEAM + 2 * SEAM_BANK), (unsigned*)(ctl + CW_TMO), RMS_EPS};
            pg8::EpiFinal E{out, out, mod + 8 * 3072, g_post + 1024, st};
            pg8::gemm_phase<pg8::EpiFinal, false>(lds + RING_OFF, g, S, E, TID_NOW());
        }
    }
#else
    if (IN(12)) {
        pg8::Gemm g = pg8::gemm_std(OG, DM, Wout1, DM, DM); pg8::Order S; S.init(MTOK / 256, 1024 / 256, 1, G, bx);
        pg8::EpiRow8<pg8::F_Plain> E{{YO1}};
        pg8::gemm_phase<pg8::EpiRow8<pg8::F_Plain>, ALIGN_E>(lds + RING_OFF, g, S, E, TID_NOW());
    }
    SEAM(12);
    if (IN(13)) { if (H1_BF16) e_final_b(YO, out, YO1, mod, g_post, gw, NGW, LANE_L()); else if (H1_AKV) e_final_k(AKV, HN, YO1, out, mod, g_post, gw, NGW, LANE_L()); else if (H1_RECOMP) e_final_x(x, YO, YO1, out, mod, g_post, gw, NGW, LANE_L()); else e_final_bm(out, YO1, mod, g_post, gw, NGW, LANE_L()); }
#endif
#undef IN
#undef SEAM
}

#ifndef FASTMASK
#define FASTMASK 0x3fff
#endif
#ifndef ONE_LAUNCH
#define ONE_LAUNCH 1
#endif
constexpr int NPHASE = 14;

extern "C" void kernel_launch(void* const* d_in, const int* in_sizes, int n_in, void* d_out, int out_size, void* d_ws, size_t ws_size, hipStream_t stream) {
    static int grid = 0;
    if (grid == 0) {
        if (n_in != 28 || out_size != MTOK * DM || ws_size < WS_END) { fprintf(stderr, "kernel_launch: unexpected shapes (n_in %d out %d ws %zu)\n", n_in, out_size, ws_size); grid = -1; return; }
        int dev = 0, cus = 0, per_cu = 0;
        if (hipGetDevice(&dev) != hipSuccess || hipDeviceGetAttribute(&cus, hipDeviceAttributeMultiprocessorCount, dev) != hipSuccess) { grid = -1; return; }
        if (hipFuncSetAttribute((const void*)mega_fwd, hipFuncAttributeMaxDynamicSharedMemorySize, LDS_BYTES) != hipSuccess) { fprintf(stderr, "kernel_launch: hipFuncSetAttribute failed\n"); grid = -1; return; }
        if (hipOccupancyMaxActiveBlocksPerMultiprocessor(&per_cu, (const void*)mega_fwd, NWAVES * 64, LDS_BYTES) != hipSuccess || per_cu < 1) { fprintf(stderr, "kernel_launch: occupancy query says %d\n", per_cu); }
        (void)hipGetLastError();
        grid = cus;
    }
    if (grid < 0) return;
    if (hipMemsetAsync((char*)d_ws + WS_CTL + (size_t)CW_BAR * 4, 0, (size_t)XCD_BAR_WORDS * 4, stream) != hipSuccess) { fprintf(stderr, "kernel_launch: memset failed\n"); return; }
    Args a{};
    for (int i = 0; i < 28; ++i) a.in[i] = (const float*)d_in[i];
    a.out = (float*)d_out; a.ws = (unsigned char*)d_ws;
#if ONE_LAUNCH
    a.ph_lo = 0; a.ph_hi = NPHASE; a.use_bar = 1; a.flags = 0;
    hipLaunchKernelGGL(mega_fwd, dim3(grid), dim3(NWAVES * 64), LDS_BYTES, stream, a);
#else
    const float* x = a.in[0]; unsigned char* ws = a.ws; float* out = a.out;
    float* mod = (float*)(ws + WS_MOD); float* lam = (float*)(ws + WS_LAM);
    bf16_t* A0 = (bf16_t*)(ws + WS_S0); bf16_t* US = (bf16_t*)(ws + WS_S1); bf16_t* SZ = (bf16_t*)(ws + WS_S3); bf16_t* YG = (bf16_t*)(ws + WS_S4);
    bf16_t* Y2 = (bf16_t*)(ws + WS_S0); bf16_t* YO = (bf16_t*)(ws + WS_S1); bf16_t* AKV = (bf16_t*)(ws + WS_S0); bf16_t* AIN1 = (bf16_t*)(ws + WS_S2);
    bf16_t* KB = (bf16_t*)(ws + WS_S3); bf16_t* VB = (bf16_t*)(ws + WS_S4); bf16_t* QB = (bf16_t*)(ws + WS_S5); bf16_t* SZ1 = (bf16_t*)(ws + WS_S6);
    bf16_t* O0 = (bf16_t*)(ws + WS_S0); bf16_t* O1 = (bf16_t*)(ws + WS_S1); bf16_t* OG = (bf16_t*)(ws + WS_S2); bf16_t* YO1 = (bf16_t*)(ws + WS_S0);
    const int EG = 2048;
    auto fast1 = [&](int lo, int hi, int flags) { a.ph_lo = lo; a.ph_hi = hi; a.use_bar = 0; a.flags = flags; hipLaunchKernelGGL(mega_fwd, dim3(grid), dim3(NWAVES * 64), LDS_BYTES, stream, a); };
    auto fast = [&](int lo, int hi, int flags) { fast1(lo, hi, flags); if (lo == EXTRA_PHASE) fast1(lo, hi, flags); };
    const unsigned FM = FASTMASK;
    if (FM & 1u) fast(0, 1, 0);
    else { fast(0, 1, 1); n_adaln<<<(2 * 8 * 3072 + 255) / 256, 256, 0, stream>>>(a.in[1], a.in[2], a.in[3], mod); n_lambda<<<1, 64, 0, stream>>>(a.in[22], a.in[23], a.in[24], a.in[25], lam); }
    if (FM & 2u) fast(1, 2, 0); else n_norm0<<<EG, 256, 0, stream>>>(x, mod, a.in[4], A0);
    if (FM & 4u) fast(2, 3, 0); else n_gemm<<<dim3(2048 / 64, MTOK / 64), 256, 0, stream>>>(AL_Row{A0}, WL_Plain{a.in[6], 2048}, EP_In0{US, SZ}, 2048);
    if (FM & 8u) { fast(3, 4, 0); fast(4, 5, 0); fast(5, 6, 0); }
    else n_ssm<<<NB * NGRP / 4, 256, 0, stream>>>(US, a.in[7], a.in[8], a.in[9], a.in[10], a.in[11], a.in[12], a.in[13], a.in[14], YG);
    if (FM & 64u) fast(6, 7, 0); else n_gemm<<<dim3(1024 / 64, MTOK / 64), 256, 0, stream>>>(AL_YG{YG}, WL_Plain{a.in[15], 1024}, EP_Glu{YG, SZ, a.in[16], Y2}, 1024);
    if (FM & 128u) fast(7, 8, 0); else n_gemm<<<dim3(1024 / 64, MTOK / 64), 256, 0, stream>>>(AL_Row{Y2}, WL_Plain{a.in[17], 1024}, EP_Plain{YO}, 1024);
    if (FM & 256u) fast(8, 9, 0); else n_mid<<<EG, 256, 0, stream>>>(x, YO, mod, a.in[5], a.in[4], out, AKV, AIN1);
    if (FM & 512u) fast(9, 10, 0);
    else { n_gemm<<<dim3(2048 / 64, MTOK / 64), 256, 0, stream>>>(AL_Row{AKV}, WL_KV{a.in[19], a.in[20], a.in[18]}, EP_KV{KB, VB}, 2048);
           n_gemm<<<dim3(2048 / 64, MTOK / 64), 256, 0, stream>>>(AL_Row{AIN1}, WL_Plain{a.in[21], 2048}, EP_In1{QB, SZ1}, 2048); }
    if (FM & 1024u) fast(10, 11, 0); else n_attn<<<MTOK * 8 / 4, 256, 0, stream>>>(QB, KB, VB, O0, O1);
    if (FM & 2048u) fast(11, 12, 0); else n_attn_post<<<EG, 256, 0, stream>>>(O0, O1, SZ1, a.in[26], lam, OG);
    if (FM & 4096u) fast(12, 13, 0); else n_gemm<<<dim3(1024 / 64, MTOK / 64), 256, 0, stream>>>(AL_Row{OG}, WL_Plain{a.in[27], 1024}, EP_Plain{YO1}, 1024);
    if (FM & 8192u) fast(13, 14, 0); else n_final<<<EG, 256, 0, stream>>>(out, YO1, mod, a.in[5]);
#endif
    const hipError_t le = hipPeekAtLastError();
    if (le != hipSuccess) fprintf(stderr, "kernel_launch: launch failed: %s\n", hipGetErrorName(le));
}
```

```cpp
#include <hip/hip_runtime.h>
#include <cstdio>
#include <cstdint>
#include <cmath>
#define FASTMASK 0x3fff
#define ONE_LAUNCH 1
#define REPEAT_MASK 0

typedef unsigned short bf16_t;
constexpr int NB = 8, SEQL = 4096, DM = 1024, MTOK = NB * SEQL;
constexpr int NGRP = 64, NTILE = MTOK / 16;
constexpr int US_P = 384, YG_P = 256;
constexpr float LAMBDA_INIT = 0.35550907f;
constexpr float ONE_M_LI = 1.0f - LAMBDA_INIT;
constexpr float RMS_EPS = 1e-6f;
constexpr float QC2 = 0.125f * 1.4426950408889634f;

__device__ __forceinline__ float bf2f(bf16_t v) { return __uint_as_float((unsigned)v << 16); }
__device__ __forceinline__ unsigned f2bf_u(float f) { unsigned u = __float_as_uint(f); return (u + 0x7fffu + ((u >> 16) & 1u)) >> 16; }
__device__ __forceinline__ bf16_t f2bf(float f) { return (bf16_t)f2bf_u(f); }
__device__ __forceinline__ unsigned pk2bf(float lo, float hi) { return f2bf_u(lo) | (f2bf_u(hi) << 16); }
__device__ __forceinline__ float silu_f(float v) { return v / (1.0f + __expf(-v)); }
__device__ __forceinline__ float sigmoid_f(float v) { return 1.0f / (1.0f + __expf(-v)); }
__device__ __forceinline__ float gelu_tanh_f(float v) {
    const float u = 0.7978845608028654f * (v + 0.044715f * v * v * v);
    const float e = __expf(2.0f * u);
    const float t = 1.0f - 2.0f / (e + 1.0f);
    return 0.5f * v * (1.0f + t);
}
__device__ __forceinline__ float wave_sum_f(float v) {
#pragma unroll
    for (int o = 1; o < 64; o <<= 1) v += __shfl_xor(v, o);
    return v;
}
__device__ __forceinline__ float wave_max_f(float v) {
#pragma unroll
    for (int o = 1; o < 64; o <<= 1) v = fmaxf(v, __shfl_xor(v, o));
    return v;
}
__device__ __forceinline__ size_t us_off(int g, int tile, int col) { return ((size_t)g * NTILE + tile) * US_P + col; }
__device__ __forceinline__ size_t yg_off(int g, int tile, int col) { return ((size_t)g * NTILE + tile) * YG_P + col; }

typedef float f32x4_t __attribute__((ext_vector_type(4)));
typedef unsigned u32x4_t __attribute__((ext_vector_type(4)));
typedef unsigned u32x2_t __attribute__((ext_vector_type(2)));
#ifndef USE_NT
#define USE_NT 1
#endif
#if USE_NT
#define NT_LD(p) __builtin_nontemporal_load(p)
#define NT_ST(p, v) __builtin_nontemporal_store((v), (p))
#else
#define NT_LD(p) (*(p))
#define NT_ST(p, v) (*(p) = (v))
#endif

__device__ __forceinline__ void e_norm0(const float* __restrict__ x, const float* __restrict__ mod, const float* __restrict__ g_pre, bf16_t* a0, int gw, int ngw, int lane) {
    for (int m = gw; m < MTOK; m += ngw) {
        const int b = m / SEQL;
        const f32x4_t* xr = (const f32x4_t*)(x + (size_t)m * DM) + lane;
        f32x4_t v[4]; float s = 0.f;
#pragma unroll
        for (int j = 0; j < 4; ++j) { v[j] = NT_LD(xr + 64 * j); s += (v[j].x * v[j].x + v[j].y * v[j].y) + (v[j].z * v[j].z + v[j].w * v[j].w); }
        const float r = rsqrtf(wave_sum_f(s) * (1.0f / DM) + RMS_EPS);
        const float* sh = mod + (size_t)b * 3072; const float* sc = sh + 1024;
        u32x2_t* o = (u32x2_t*)(a0 + (size_t)m * DM) + lane;
#pragma unroll
        for (int j = 0; j < 4; ++j) {
            const int c = 256 * j + 4 * lane;
            const f32x4_t g = *(const f32x4_t*)(g_pre + c), scv = *(const f32x4_t*)(sc + c), shv = *(const f32x4_t*)(sh + c);
            f32x4_t y = v[j] * r * g * (scv + 1.0f) + shv;
            u32x2_t w; w.x = pk2bf(y.x, y.y); w.y = pk2bf(y.z, y.w); o[64 * j] = w;
        }
    }
}
__device__ __forceinline__ void e_mid(const float* __restrict__ x, const bf16_t* __restrict__ yo, const float* __restrict__ mod, const float* __restrict__ g_post, const float* __restrict__ g_pre,
                                      float* h1, bf16_t* h1b, bf16_t* akv, bf16_t* ain1, int gw, int ngw, int lane) {
    for (int m = gw; m < MTOK; m += ngw) {
        const int b = m / SEQL;
        const f32x4_t* xr = (const f32x4_t*)(x + (size_t)m * DM) + lane;
        const u32x2_t* yr = (const u32x2_t*)(yo + (size_t)m * DM) + lane;
        f32x4_t v[4], y[4]; float s = 0.f;
#pragma unroll
        for (int j = 0; j < 4; ++j) { v[j] = NT_LD(xr + 64 * j); const u32x2_t w = NT_LD(yr + 64 * j);
            y[j].x = __uint_as_float(w.x << 16); y[j].y = __uint_as_float(w.x & 0xffff0000u); y[j].z = __uint_as_float(w.y << 16); y[j].w = __uint_as_float(w.y & 0xffff0000u);
            s += (y[j].x * y[j].x + y[j].y * y[j].y) + (y[j].z * y[j].z + y[j].w * y[j].w); }
        const float ry = rsqrtf(wave_sum_f(s) * (1.0f / DM) + RMS_EPS);
        const float* gate0 = mod + (size_t)b * 3072 + 2048;
        const float* sh1 = mod + (size_t)(8 + b) * 3072; const float* sc1 = sh1 + 1024;
        float s2 = 0.f;
        f32x4_t* ho = (f32x4_t*)(h1 + (size_t)m * DM) + lane;
#pragma unroll
        for (int j = 0; j < 4; ++j) { const int c = 256 * j + 4 * lane;
            const f32x4_t gp = *(const f32x4_t*)(g_post + c), gt = *(const f32x4_t*)(gate0 + c);
            v[j] = v[j] + gt * (y[j] * ry * gp);
            if (h1) NT_ST(ho + 64 * j, v[j]);
            if (h1b) { u32x2_t wq; wq.x = pk2bf(v[j].x, v[j].y); wq.y = pk2bf(v[j].z, v[j].w); ((u32x2_t*)(h1b + (size_t)m * DM) + lane)[64 * j] = wq; }
            s2 += (v[j].x * v[j].x + v[j].y * v[j].y) + (v[j].z * v[j].z + v[j].w * v[j].w); }
        const float rh = rsqrtf(wave_sum_f(s2) * (1.0f / DM) + RMS_EPS);
        u32x2_t* o1 = (u32x2_t*)(akv + (size_t)m * DM) + lane; u32x2_t* o2 = (u32x2_t*)(ain1 + (size_t)m * DM) + lane;
#pragma unroll
        for (int j = 0; j < 4; ++j) { const int c = 256 * j + 4 * lane;
            const f32x4_t n = v[j] * rh;
            u32x2_t w; w.x = pk2bf(n.x, n.y); w.y = pk2bf(n.z, n.w); o1[64 * j] = w;
            const f32x4_t g = *(const f32x4_t*)(g_pre + 1024 + c), scv = *(const f32x4_t*)(sc1 + c), shv = *(const f32x4_t*)(sh1 + c);
            const f32x4_t z = n * g * (scv + 1.0f) + shv;
            w.x = pk2bf(z.x, z.y); w.y = pk2bf(z.z, z.w); o2[64 * j] = w; }
    }
}
__device__ __forceinline__ void e_attn_post(const bf16_t* __restrict__ o0, const bf16_t* __restrict__ o1, const bf16_t* __restrict__ sz1, const float* __restrict__ g_sub, float lam,
                                            bf16_t* og, int gw, int ngw, int lane) {
    for (int m = gw; m < MTOK; m += ngw) {
#pragma unroll
        for (int j = 0; j < 2; ++j) {
            const int c = 512 * j + 8 * lane;
            const u32x4_t a = *(const u32x4_t*)(o0 + (size_t)m * DM + c), bq = *(const u32x4_t*)(o1 + (size_t)m * DM + c), zq = *(const u32x4_t*)(sz1 + (size_t)m * DM + c);
            float d[8]; float s = 0.f;
#pragma unroll
            for (int i = 0; i < 4; ++i) { const unsigned wa = a[i], wb = bq[i];
                d[2 * i] = __uint_as_float(wa << 16) - lam * __uint_as_float(wb << 16); d[2 * i + 1] = __uint_as_float(wa & 0xffff0000u) - lam * __uint_as_float(wb & 0xffff0000u);
                s += d[2 * i] * d[2 * i] + d[2 * i + 1] * d[2 * i + 1]; }
            s += __shfl_xor(s, 1); s += __shfl_xor(s, 2); s += __shfl_xor(s, 4); s += __shfl_xor(s, 8);
            const float r = rsqrtf(s * (1.0f / 128.0f) + RMS_EPS) * ONE_M_LI;
            const float* gs = g_sub + (c & 127);
            u32x4_t w;
#pragma unroll
            for (int i = 0; i < 4; ++i) { const unsigned wz = zq[i];
                const float z0 = __uint_as_float(wz << 16), z1 = __uint_as_float(wz & 0xffff0000u);
                w[i] = pk2bf(d[2 * i] * r * gs[2 * i] * z0, d[2 * i + 1] * r * gs[2 * i + 1] * z1); }
            *(u32x4_t*)(og + (size_t)m * DM + c) = w;
        }
    }
}
__device__ __forceinline__ void e_final(float* out, const bf16_t* __restrict__ yo1, const float* __restrict__ mod, const float* __restrict__ g_post, int gw, int ngw, int lane) {
    for (int m = gw; m < MTOK; m += ngw) {
        const int b = m / SEQL;
        f32x4_t* hr = (f32x4_t*)(out + (size_t)m * DM) + lane;
        const u32x2_t* yr = (const u32x2_t*)(yo1 + (size_t)m * DM) + lane;
        f32x4_t v[4], y[4]; float s = 0.f;
#pragma unroll
        for (int j = 0; j < 4; ++j) { v[j] = NT_LD(hr + 64 * j); const u32x2_t w = NT_LD(yr + 64 * j);
            y[j].x = __uint_as_float(w.x << 16); y[j].y = __uint_as_float(w.x & 0xffff0000u); y[j].z = __uint_as_float(w.y << 16); y[j].w = __uint_as_float(w.y & 0xffff0000u);
            s += (y[j].x * y[j].x + y[j].y * y[j].y) + (y[j].z * y[j].z + y[j].w * y[j].w); }
        const float ry = rsqrtf(wave_sum_f(s) * (1.0f / DM) + RMS_EPS);
        const float* gate1 = mod + (size_t)(8 + b) * 3072 + 2048;
#pragma unroll
        for (int j = 0; j < 4; ++j) { const int c = 256 * j + 4 * lane;
            const f32x4_t gp = *(const f32x4_t*)(g_post + 1024 + c), gt = *(const f32x4_t*)(gate1 + c);
            NT_ST(hr + 64 * j, v[j] + gt * (y[j] * ry * gp)); }
    }
}
__device__ __forceinline__ void e_final2(const float* __restrict__ x, const bf16_t* __restrict__ yo, const bf16_t* __restrict__ yo1, float* out, const float* __restrict__ mod, const float* __restrict__ g_post, int gw, int ngw, int lane) {
    for (int m = gw; m < MTOK; m += ngw) {
        const int b = m / SEQL;
        const f32x4_t* xr = (const f32x4_t*)(x + (size_t)m * DM) + lane;
        const u32x2_t* y0r = (const u32x2_t*)(yo + (size_t)m * DM) + lane; const u32x2_t* y1r = (const u32x2_t*)(yo1 + (size_t)m * DM) + lane;
        f32x4_t v[4], y0[4], y1[4]; float s0 = 0.f, s1 = 0.f;
#pragma unroll
        for (int j = 0; j < 4; ++j) { v[j] = xr[64 * j]; const u32x2_t w0 = y0r[64 * j], w1 = y1r[64 * j];
            y0[j].x = __uint_as_float(w0.x << 16); y0[j].y = __uint_as_float(w0.x & 0xffff0000u); y0[j].z = __uint_as_float(w0.y << 16); y0[j].w = __uint_as_float(w0.y & 0xffff0000u);
            y1[j].x = __uint_as_float(w1.x << 16); y1[j].y = __uint_as_float(w1.x & 0xffff0000u); y1[j].z = __uint_as_float(w1.y << 16); y1[j].w = __uint_as_float(w1.y & 0xffff0000u);
            s0 += (y0[j].x * y0[j].x + y0[j].y * y0[j].y) + (y0[j].z * y0[j].z + y0[j].w * y0[j].w);
            s1 += (y1[j].x * y1[j].x + y1[j].y * y1[j].y) + (y1[j].z * y1[j].z + y1[j].w * y1[j].w); }
        const float r0 = rsqrtf(wave_sum_f(s0) * (1.0f / DM) + RMS_EPS), r1 = rsqrtf(wave_sum_f(s1) * (1.0f / DM) + RMS_EPS);
        const float* gate0 = mod + (size_t)b * 3072 + 2048; const float* gate1 = mod + (size_t)(8 + b) * 3072 + 2048;
        f32x4_t* orow = (f32x4_t*)(out + (size_t)m * DM) + lane;
#pragma unroll
        for (int j = 0; j < 4; ++j) { const int c = 256 * j + 4 * lane;
            const f32x4_t gp0 = *(const f32x4_t*)(g_post + c), gt0 = *(const f32x4_t*)(gate0 + c), gp1 = *(const f32x4_t*)(g_post + 1024 + c), gt1 = *(const f32x4_t*)(gate1 + c);
            const f32x4_t h = v[j] + gt0 * (y0[j] * r0 * gp0);
            orow[64 * j] = h + gt1 * (y1[j] * r1 * gp1); }
    }
}
__device__ __forceinline__ void e_final_b(const bf16_t* __restrict__ h1b, float* out, const bf16_t* __restrict__ yo1, const float* __restrict__ mod, const float* __restrict__ g_post, int gw, int ngw, int lane) {
    for (int m = gw; m < MTOK; m += ngw) {
        const int b = m / SEQL;
        const u32x2_t* hr = (const u32x2_t*)(h1b + (size_t)m * DM) + lane;
        const u32x2_t* yr = (const u32x2_t*)(yo1 + (size_t)m * DM) + lane;
        f32x4_t v[4], y[4]; float s = 0.f;
#pragma unroll
        for (int j = 0; j < 4; ++j) { const u32x2_t hw = NT_LD(hr + 64 * j); const u32x2_t w = NT_LD(yr + 64 * j);
            v[j].x = __uint_as_float(hw.x << 16); v[j].y = __uint_as_float(hw.x & 0xffff0000u); v[j].z = __uint_as_float(hw.y << 16); v[j].w = __uint_as_float(hw.y & 0xffff0000u);
            y[j].x = __uint_as_float(w.x << 16); y[j].y = __uint_as_float(w.x & 0xffff0000u); y[j].z = __uint_as_float(w.y << 16); y[j].w = __uint_as_float(w.y & 0xffff0000u);
            s += (y[j].x * y[j].x + y[j].y * y[j].y) + (y[j].z * y[j].z + y[j].w * y[j].w); }
        const float ry = rsqrtf(wave_sum_f(s) * (1.0f / DM) + RMS_EPS);
        const float* gate1 = mod + (size_t)(8 + b) * 3072 + 2048;
        f32x4_t* orow = (f32x4_t*)(out + (size_t)m * DM) + lane;
#pragma unroll
        for (int j = 0; j < 4; ++j) { const int c = 256 * j + 4 * lane;
            const f32x4_t gp = *(const f32x4_t*)(g_post + 1024 + c), gt = *(const f32x4_t*)(gate1 + c);
            NT_ST(orow + 64 * j, v[j] + gt * (y[j] * ry * gp)); }
    }
}

#define ER 2
__device__ __forceinline__ void unpk4(const u32x2_t w, f32x4_t& y) { y.x = __uint_as_float(w.x << 16); y.y = __uint_as_float(w.x & 0xffff0000u); y.z = __uint_as_float(w.y << 16); y.w = __uint_as_float(w.y & 0xffff0000u); }
__device__ __forceinline__ float ssq4(const f32x4_t v) { return (v.x * v.x + v.y * v.y) + (v.z * v.z + v.w * v.w); }
__device__ __forceinline__ void e_norm0_r(const float* __restrict__ x, const float* __restrict__ mod, const float* __restrict__ g_pre, bf16_t* a0, int gw, int ngw, int lane) {
    for (int m0 = gw; m0 < MTOK; m0 += ER * ngw) {
        f32x4_t v[ER][4]; float s[ER];
#pragma unroll
        for (int r = 0; r < ER; ++r) { const int m = min(m0 + r * ngw, MTOK - 1); const f32x4_t* xr = (const f32x4_t*)(x + (size_t)m * DM) + lane;
#pragma unroll
            for (int j = 0; j < 4; ++j) v[r][j] = NT_LD(xr + 64 * j); }
#pragma unroll
        for (int r = 0; r < ER; ++r) { s[r] = 0.f;
#pragma unroll
            for (int j = 0; j < 4; ++j) s[r] += ssq4(v[r][j]); }
#pragma unroll
        for (int r = 0; r < ER; ++r) { const int m = m0 + r * ngw; if (m >= MTOK) break;
            const int b = m / SEQL; const float rr = rsqrtf(wave_sum_f(s[r]) * (1.0f / DM) + RMS_EPS);
            const float* sh = mod + (size_t)b * 3072; const float* sc = sh + 1024;
            u32x2_t* o = (u32x2_t*)(a0 + (size_t)m * DM) + lane;
#pragma unroll
            for (int j = 0; j < 4; ++j) { const int c = 256 * j + 4 * lane;
                const f32x4_t g = *(const f32x4_t*)(g_pre + c), scv = *(const f32x4_t*)(sc + c), shv = *(const f32x4_t*)(sh + c);
                const f32x4_t y = v[r][j] * rr * g * (scv + 1.0f) + shv;
                u32x2_t w; w.x = pk2bf(y.x, y.y); w.y = pk2bf(y.z, y.w); o[64 * j] = w; } }
    }
}
__device__ __forceinline__ void e_mid_r(const float* __restrict__ x, const bf16_t* __restrict__ yo, const float* __restrict__ mod, const float* __restrict__ g_post, const float* __restrict__ g_pre,
                                        float* h1, bf16_t* akv, bf16_t* ain1, int gw, int ngw, int lane) {
    for (int m0 = gw; m0 < MTOK; m0 += ER * ngw) {
        f32x4_t v[ER][4], y[ER][4]; float s[ER];
#pragma unroll
        for (int r = 0; r < ER; ++r) { const int m = min(m0 + r * ngw, MTOK - 1); const f32x4_t* xr = (const f32x4_t*)(x + (size_t)m * DM) + lane; const u32x2_t* yr = (const u32x2_t*)(yo + (size_t)m * DM) + lane;
#pragma unroll
            for (int j = 0; j < 4; ++j) { v[r][j] = NT_LD(xr + 64 * j); unpk4(NT_LD(yr + 64 * j), y[r][j]); } }
#pragma unroll
        for (int r = 0; r < ER; ++r) { s[r] = 0.f;
#pragma unroll
            for (int j = 0; j < 4; ++j) s[r] += ssq4(y[r][j]); }
#pragma unroll
        for (int r = 0; r < ER; ++r) { const int m = m0 + r * ngw; if (m >= MTOK) break;
            const int b = m / SEQL; const float ry = rsqrtf(wave_sum_f(s[r]) * (1.0f / DM) + RMS_EPS);
            const float* gate0 = mod + (size_t)b * 3072 + 2048; const float* sh1 = mod + (size_t)(8 + b) * 3072; const float* sc1 = sh1 + 1024;
            float s2 = 0.f; f32x4_t* ho = (f32x4_t*)(h1 + (size_t)m * DM) + lane;
#pragma unroll
            for (int j = 0; j < 4; ++j) { const int c = 256 * j + 4 * lane;
                const f32x4_t gp = *(const f32x4_t*)(g_post + c), gt = *(const f32x4_t*)(gate0 + c);
                v[r][j] = v[r][j] + gt * (y[r][j] * ry * gp); NT_ST(ho + 64 * j, v[r][j]); s2 += ssq4(v[r][j]); }
            const float rh = rsqrtf(wave_sum_f(s2) * (1.0f / DM) + RMS_EPS);
            u32x2_t* o1 = (u32x2_t*)(akv + (size_t)m * DM) + lane; u32x2_t* o2 = (u32x2_t*)(ain1 + (size_t)m * DM) + lane;
#pragma unroll
            for (int j = 0; j < 4; ++j) { const int c = 256 * j + 4 * lane;
                const f32x4_t nn = v[r][j] * rh; u32x2_t w; w.x = pk2bf(nn.x, nn.y); w.y = pk2bf(nn.z, nn.w); o1[64 * j] = w;
                const f32x4_t g = *(const f32x4_t*)(g_pre + 1024 + c), scv = *(const f32x4_t*)(sc1 + c), shv = *(const f32x4_t*)(sh1 + c);
                const f32x4_t z = nn * g * (scv + 1.0f) + shv; w.x = pk2bf(z.x, z.y); w.y = pk2bf(z.z, z.w); o2[64 * j] = w; } }
    }
}
__device__ __forceinline__ void e_final_r(float* out, const bf16_t* __restrict__ yo1, const float* __restrict__ mod, const float* __restrict__ g_post, int gw, int ngw, int lane) {
    for (int m0 = gw; m0 < MTOK; m0 += ER * ngw) {
        f32x4_t v[ER][4], y[ER][4]; float s[ER];
#pragma unroll
        for (int r = 0; r < ER; ++r) { const int m = min(m0 + r * ngw, MTOK - 1); const f32x4_t* hr = (const f32x4_t*)(out + (size_t)m * DM) + lane; const u32x2_t* yr = (const u32x2_t*)(yo1 + (size_t)m * DM) + lane;
#pragma unroll
            for (int j = 0; j < 4; ++j) { v[r][j] = NT_LD(hr + 64 * j); unpk4(NT_LD(yr + 64 * j), y[r][j]); } }
#pragma unroll
        for (int r = 0; r < ER; ++r) { s[r] = 0.f;
#pragma unroll
            for (int j = 0; j < 4; ++j) s[r] += ssq4(y[r][j]); }
#pragma unroll
        for (int r = 0; r < ER; ++r) { const int m = m0 + r * ngw; if (m >= MTOK) break;
            const int b = m / SEQL; const float ry = rsqrtf(wave_sum_f(s[r]) * (1.0f / DM) + RMS_EPS);
            const float* gate1 = mod + (size_t)(8 + b) * 3072 + 2048; f32x4_t* hr = (f32x4_t*)(out + (size_t)m * DM) + lane;
#pragma unroll
            for (int j = 0; j < 4; ++j) { const int c = 256 * j + 4 * lane;
                const f32x4_t gp = *(const f32x4_t*)(g_post + 1024 + c), gt = *(const f32x4_t*)(gate1 + c);
                NT_ST(hr + 64 * j, v[r][j] + gt * (y[r][j] * ry * gp)); } }
    }
}

__device__ __forceinline__ void unpk4b(const u32x2_t w, f32x4_t& y) { y.x = __uint_as_float(w.x << 16); y.y = __uint_as_float(w.x & 0xffff0000u); y.z = __uint_as_float(w.y << 16); y.w = __uint_as_float(w.y & 0xffff0000u); }
__device__ __forceinline__ float ssq4b(const f32x4_t v) { return (v.x * v.x + v.y * v.y) + (v.z * v.z + v.w * v.w); }
__device__ __forceinline__ void e_norm0_b(const float* __restrict__ x, const float* __restrict__ mod, const float* __restrict__ g_pre, bf16_t* a0, int gw, int ngw, int lane) {
    for (int b = 0; b < NB; ++b) {
        const float* sh = mod + (size_t)b * 3072; const float* sc = sh + 1024;
        f32x4_t G[4], SH[4];
#pragma unroll
        for (int j = 0; j < 4; ++j) { const int c = 256 * j + 4 * lane; G[j] = *(const f32x4_t*)(g_pre + c) * (*(const f32x4_t*)(sc + c) + 1.0f); SH[j] = *(const f32x4_t*)(sh + c); }
        for (int r0 = gw; r0 < SEQL; r0 += 2 * ngw) {
            const int ra = r0, rb = r0 + ngw; const bool hb = rb < SEQL;
            const int ma = b * SEQL + ra, mb = b * SEQL + (hb ? rb : ra);
            f32x4_t va[4], vb[4];
            const f32x4_t* xa = (const f32x4_t*)(x + (size_t)ma * DM) + lane; const f32x4_t* xb = (const f32x4_t*)(x + (size_t)mb * DM) + lane;
#pragma unroll
            for (int j = 0; j < 4; ++j) { va[j] = NT_LD(xa + 64 * j); vb[j] = NT_LD(xb + 64 * j); }
            float sa = 0.f, sb = 0.f;
#pragma unroll
            for (int j = 0; j < 4; ++j) { sa += ssq4b(va[j]); sb += ssq4b(vb[j]); }
            const float rra = rsqrtf(wave_sum_f(sa) * (1.0f / DM) + RMS_EPS), rrb = rsqrtf(wave_sum_f(sb) * (1.0f / DM) + RMS_EPS);
            u32x2_t* oa = (u32x2_t*)(a0 + (size_t)ma * DM) + lane; u32x2_t* ob = (u32x2_t*)(a0 + (size_t)mb * DM) + lane;
#pragma unroll
            for (int j = 0; j < 4; ++j) { const f32x4_t y = va[j] * rra * G[j] + SH[j]; u32x2_t w; w.x = pk2bf(y.x, y.y); w.y = pk2bf(y.z, y.w); oa[64 * j] = w; }
            if (hb) {
#pragma unroll
                for (int j = 0; j < 4; ++j) { const f32x4_t y = vb[j] * rrb * G[j] + SH[j]; u32x2_t w; w.x = pk2bf(y.x, y.y); w.y = pk2bf(y.z, y.w); ob[64 * j] = w; } }
        }
    }
}
__device__ __forceinline__ void e_mid_b(const float* __restrict__ x, const bf16_t* __restrict__ yo, const float* __restrict__ mod, const float* __restrict__ g_post, const float* __restrict__ g_pre,
                                        float* h1, bf16_t* akv, bf16_t* ain1, int gw, int ngw, int lane, float* hnorm = nullptr) {
    for (int b = 0; b < NB; ++b) {
        const float* gate0 = mod + (size_t)b * 3072 + 2048; const float* sh1 = mod + (size_t)(8 + b) * 3072; const float* sc1 = sh1 + 1024;
        f32x4_t GG[4], GF[4], SH[4];
#pragma unroll
        for (int j = 0; j < 4; ++j) { const int c = 256 * j + 4 * lane; GG[j] = *(const f32x4_t*)(gate0 + c) * *(const f32x4_t*)(g_post + c);
            GF[j] = *(const f32x4_t*)(g_pre + 1024 + c) * (*(const f32x4_t*)(sc1 + c) + 1.0f); SH[j] = *(const f32x4_t*)(sh1 + c); }
        for (int r0 = gw; r0 < SEQL; r0 += 2 * ngw) {
            const int ra = r0, rb = r0 + ngw; const bool hb = rb < SEQL;
            const int mr[2] = {b * SEQL + ra, b * SEQL + (hb ? rb : ra)};
            f32x4_t v[2][4], y[2][4];
#pragma unroll
            for (int q = 0; q < 2; ++q) { const f32x4_t* xr = (const f32x4_t*)(x + (size_t)mr[q] * DM) + lane; const u32x2_t* yr = (const u32x2_t*)(yo + (size_t)mr[q] * DM) + lane;
#pragma unroll
                for (int j = 0; j < 4; ++j) { v[q][j] = NT_LD(xr + 64 * j); unpk4b(NT_LD(yr + 64 * j), y[q][j]); } }
            float s[2] = {0.f, 0.f};
#pragma unroll
            for (int q = 0; q < 2; ++q)
#pragma unroll
                for (int j = 0; j < 4; ++j) s[q] += ssq4b(y[q][j]);
            float ry[2]; ry[0] = rsqrtf(wave_sum_f(s[0]) * (1.0f / DM) + RMS_EPS); ry[1] = rsqrtf(wave_sum_f(s[1]) * (1.0f / DM) + RMS_EPS);
            float s2[2] = {0.f, 0.f};
#pragma unroll
            for (int q = 0; q < 2; ++q)
#pragma unroll
                for (int j = 0; j < 4; ++j) { v[q][j] = v[q][j] + GG[j] * (y[q][j] * ry[q]); s2[q] += ssq4b(v[q][j]); }
            float rh[2]; rh[0] = rsqrtf(wave_sum_f(s2[0]) * (1.0f / DM) + RMS_EPS); rh[1] = rsqrtf(wave_sum_f(s2[1]) * (1.0f / DM) + RMS_EPS);
            if (hnorm && lane == 0) { hnorm[mr[0]] = 1.0f / rh[0]; if (hb) hnorm[mr[1]] = 1.0f / rh[1]; }
#pragma unroll
            for (int q = 0; q < 2; ++q) { if (q == 1 && !hb) break;
                f32x4_t* ho = (f32x4_t*)(h1 + (size_t)mr[q] * DM) + lane; u32x2_t* o1 = (u32x2_t*)(akv + (size_t)mr[q] * DM) + lane; u32x2_t* o2 = (u32x2_t*)(ain1 + (size_t)mr[q] * DM) + lane;
#pragma unroll
                for (int j = 0; j < 4; ++j) { if (h1) NT_ST(ho + 64 * j, v[q][j]);
                    const f32x4_t nn = v[q][j] * rh[q]; u32x2_t w; w.x = pk2bf(nn.x, nn.y); w.y = pk2bf(nn.z, nn.w); o1[64 * j] = w;
                    const f32x4_t z = nn * GF[j] + SH[j]; w.x = pk2bf(z.x, z.y); w.y = pk2bf(z.z, z.w); o2[64 * j] = w; } }
        }
    }
}
__device__ __forceinline__ void e_final_bm(float* out, const bf16_t* __restrict__ yo1, const float* __restrict__ mod, const float* __restrict__ g_post, int gw, int ngw, int lane) {
    for (int b = 0; b < NB; ++b) {
        const float* gate1 = mod + (size_t)(8 + b) * 3072 + 2048;
        f32x4_t GG[4];
#pragma unroll
        for (int j = 0; j < 4; ++j) { const int c = 256 * j + 4 * lane; GG[j] = *(const f32x4_t*)(gate1 + c) * *(const f32x4_t*)(g_post + 1024 + c); }
        for (int r0 = gw; r0 < SEQL; r0 += 2 * ngw) {
            const int ra = r0, rb = r0 + ngw; const bool hb = rb < SEQL;
            const int mr[2] = {b * SEQL + ra, b * SEQL + (hb ? rb : ra)};
            f32x4_t v[2][4], y[2][4];
#pragma unroll
            for (int q = 0; q < 2; ++q) { const f32x4_t* hr = (const f32x4_t*)(out + (size_t)mr[q] * DM) + lane; const u32x2_t* yr = (const u32x2_t*)(yo1 + (size_t)mr[q] * DM) + lane;
#pragma unroll
                for (int j = 0; j < 4; ++j) { v[q][j] = NT_LD(hr + 64 * j); unpk4b(NT_LD(yr + 64 * j), y[q][j]); } }
            float s[2] = {0.f, 0.f};
#pragma unroll
            for (int q = 0; q < 2; ++q)
#pragma unroll
                for (int j = 0; j < 4; ++j) s[q] += ssq4b(y[q][j]);
            float ry[2]; ry[0] = rsqrtf(wave_sum_f(s[0]) * (1.0f / DM) + RMS_EPS); ry[1] = rsqrtf(wave_sum_f(s[1]) * (1.0f / DM) + RMS_EPS);
#pragma unroll
            for (int q = 0; q < 2; ++q) { if (q == 1 && !hb) break;
                f32x4_t* hr = (f32x4_t*)(out + (size_t)mr[q] * DM) + lane;
#pragma unroll
                for (int j = 0; j < 4; ++j) NT_ST(hr + 64 * j, v[q][j] + GG[j] * (y[q][j] * ry[q])); }
        }
    }
}
__device__ __forceinline__ void e_final_x(const float* __restrict__ x, const bf16_t* __restrict__ yo, const bf16_t* __restrict__ yo1, float* out, const float* __restrict__ mod, const float* __restrict__ g_post, int gw, int ngw, int lane) {
    for (int b = 0; b < NB; ++b) {
        const float* gate0 = mod + (size_t)b * 3072 + 2048; const float* gate1 = mod + (size_t)(8 + b) * 3072 + 2048;
        f32x4_t G0[4], G1[4];
#pragma unroll
        for (int j = 0; j < 4; ++j) { const int c = 256 * j + 4 * lane; G0[j] = *(const f32x4_t*)(gate0 + c) * *(const f32x4_t*)(g_post + c); G1[j] = *(const f32x4_t*)(gate1 + c) * *(const f32x4_t*)(g_post + 1024 + c); }
        for (int r0 = gw; r0 < SEQL; r0 += 2 * ngw) {
            const int ra = r0, rb = r0 + ngw; const bool hb = rb < SEQL;
            const int mr[2] = {b * SEQL + ra, b * SEQL + (hb ? rb : ra)};
            f32x4_t v[2][4], y0[2][4], y1[2][4];
#pragma unroll
            for (int q = 0; q < 2; ++q) { const f32x4_t* xr = (const f32x4_t*)(x + (size_t)mr[q] * DM) + lane; const u32x2_t* ar = (const u32x2_t*)(yo + (size_t)mr[q] * DM) + lane; const u32x2_t* br = (const u32x2_t*)(yo1 + (size_t)mr[q] * DM) + lane;
#pragma unroll
                for (int j = 0; j < 4; ++j) { v[q][j] = NT_LD(xr + 64 * j); unpk4b(NT_LD(ar + 64 * j), y0[q][j]); unpk4b(NT_LD(br + 64 * j), y1[q][j]); } }
            float s0[2] = {0.f, 0.f}, s1[2] = {0.f, 0.f};
#pragma unroll
            for (int q = 0; q < 2; ++q)
#pragma unroll
                for (int j = 0; j < 4; ++j) { s0[q] += ssq4b(y0[q][j]); s1[q] += ssq4b(y1[q][j]); }
            float r0_[2], r1_[2];
#pragma unroll
            for (int q = 0; q < 2; ++q) { r0_[q] = rsqrtf(wave_sum_f(s0[q]) * (1.0f / DM) + RMS_EPS); r1_[q] = rsqrtf(wave_sum_f(s1[q]) * (1.0f / DM) + RMS_EPS); }
#pragma unroll
            for (int q = 0; q < 2; ++q) { if (q == 1 && !hb) break;
                f32x4_t* orow = (f32x4_t*)(out + (size_t)mr[q] * DM) + lane;
#pragma unroll
                for (int j = 0; j < 4; ++j) { const f32x4_t h = v[q][j] + G0[j] * (y0[q][j] * r0_[q]); NT_ST(orow + 64 * j, h + G1[j] * (y1[q][j] * r1_[q])); } }
        }
    }
}
__device__ __forceinline__ void e_final_k(const bf16_t* __restrict__ akv, const float* __restrict__ hnorm, const bf16_t* __restrict__ yo1, float* out, const float* __restrict__ mod, const float* __restrict__ g_post, int gw, int ngw, int lane) {
    for (int b = 0; b < NB; ++b) {
        const float* gate1 = mod + (size_t)(8 + b) * 3072 + 2048;
        f32x4_t G1[4];
#pragma unroll
        for (int j = 0; j < 4; ++j) { const int c = 256 * j + 4 * lane; G1[j] = *(const f32x4_t*)(gate1 + c) * *(const f32x4_t*)(g_post + 1024 + c); }
        for (int r0 = gw; r0 < SEQL; r0 += 2 * ngw) {
            const int ra = r0, rb = r0 + ngw; const bool hb = rb < SEQL;
            const int mr[2] = {b * SEQL + ra, b * SEQL + (hb ? rb : ra)};
            f32x4_t v[2][4], y1[2][4]; float hn[2];
#pragma unroll
            for (int q = 0; q < 2; ++q) { const u32x2_t* ar = (const u32x2_t*)(akv + (size_t)mr[q] * DM) + lane; const u32x2_t* br = (const u32x2_t*)(yo1 + (size_t)mr[q] * DM) + lane; hn[q] = hnorm[mr[q]];
#pragma unroll
                for (int j = 0; j < 4; ++j) { unpk4b(NT_LD(ar + 64 * j), v[q][j]); unpk4b(NT_LD(br + 64 * j), y1[q][j]); } }
            float s1[2] = {0.f, 0.f};
#pragma unroll
            for (int q = 0; q < 2; ++q)
#pragma unroll
                for (int j = 0; j < 4; ++j) s1[q] += ssq4b(y1[q][j]);
            float r1_[2];
#pragma unroll
            for (int q = 0; q < 2; ++q) r1_[q] = rsqrtf(wave_sum_f(s1[q]) * (1.0f / DM) + RMS_EPS);
#pragma unroll
            for (int q = 0; q < 2; ++q) { if (q == 1 && !hb) break;
                f32x4_t* orow = (f32x4_t*)(out + (size_t)mr[q] * DM) + lane;
#pragma unroll
                for (int j = 0; j < 4; ++j) NT_ST(orow + 64 * j, v[q][j] * hn[q] + G1[j] * (y1[q][j] * r1_[q])); }
        }
    }
}
__device__ __forceinline__ float diff_lambda(const float* lq1, const float* lk1, const float* lq2, const float* lk2) {
    float s1 = 0.f, s2 = 0.f;
    for (int i = 0; i < 64; ++i) { s1 += lq1[i] * lk1[i]; s2 += lq2[i] * lk2[i]; }
    return expf(s1) - expf(s2) + LAMBDA_INIT;
}

__global__ void n_adaln(const float* __restrict__ c, const float* __restrict__ ada_w, const float* __restrict__ ada_b, float* mod) {
    const int idx = blockIdx.x * 256 + threadIdx.x;
    if (idx >= 2 * 8 * 3072) return;
    const int j = idx % 3072, b = (idx / 3072) % 8, l = idx / (3072 * 8);
    float acc = ada_b[l * 3072 + j];
    const float* w = ada_w + (size_t)l * 1024 * 3072 + j; const float* cb = c + b * 1024;
    for (int k = 0; k < 1024; ++k) acc += silu_f(cb[k]) * w[(size_t)k * 3072];
    mod[idx] = acc;
}
__global__ void n_lambda(const float* lq1, const float* lk1, const float* lq2, const float* lk2, float* out) {
    if (threadIdx.x == 0 && blockIdx.x == 0) out[0] = diff_lambda(lq1, lk1, lq2, lk2);
}
__global__ void n_norm0(const float* x, const float* mod, const float* g_pre, bf16_t* a0) {
    e_norm0(x, mod, g_pre, a0, blockIdx.x * 4 + (threadIdx.x >> 6), gridDim.x * 4, threadIdx.x & 63);
}
__global__ void n_mid(const float* x, const bf16_t* yo, const float* mod, const float* g_post, const float* g_pre, float* h1, bf16_t* akv, bf16_t* ain1) {
    e_mid(x, yo, mod, g_post, g_pre, h1, (bf16_t*)nullptr, akv, ain1, blockIdx.x * 4 + (threadIdx.x >> 6), gridDim.x * 4, threadIdx.x & 63);
}
__global__ void n_attn_post(const bf16_t* o0, const bf16_t* o1, const bf16_t* sz1, const float* g_sub, const float* lamp, bf16_t* og) {
    e_attn_post(o0, o1, sz1, g_sub, lamp[0], og, blockIdx.x * 4 + (threadIdx.x >> 6), gridDim.x * 4, threadIdx.x & 63);
}
__global__ void n_final(float* out, const bf16_t* yo1, const float* mod, const float* g_post) {
    e_final(out, yo1, mod, g_post, blockIdx.x * 4 + (threadIdx.x >> 6), gridDim.x * 4, threadIdx.x & 63);
}

struct AL_Row { const bf16_t* A; __device__ float ld(int m, int k) const { return bf2f(A[(size_t)m * DM + k]); } };
struct AL_YG  { const bf16_t* A; __device__ float ld(int m, int k) const { return bf2f(A[yg_off(k >> 4, m >> 4, (m & 15) * 16 + (k & 15))]); } };
struct WL_Plain { const float* W; long N; __device__ float ld(int k, int n) const { return W[(size_t)k * N + n]; } };
struct WL_KV { const float* wk; const float* wv; const float* g; __device__ float ld(int k, int n) const { return g[k] * (n < 1024 ? wk[(size_t)k * 1024 + n] : wv[(size_t)k * 1024 + n - 1024]); } };
struct EP_In0 { bf16_t* US; bf16_t* SZ; __device__ void st(int m, int n, float a) const {
    if (n < 1024) US[us_off(n >> 4, m >> 4, (m & 15) * 16 + (n & 15))] = f2bf(a); else SZ[(size_t)m * DM + n - 1024] = f2bf(silu_f(a)); } };
struct EP_Glu { const bf16_t* YG; const bf16_t* SZ; const float* bias; bf16_t* Y2; __device__ void st(int m, int n, float a) const {
    const float yv = bf2f(YG[yg_off(n >> 4, m >> 4, (m & 15) * 16 + (n & 15))]); const float t = a + bias[n];
    Y2[(size_t)m * DM + n] = f2bf(yv * sigmoid_f(t) * bf2f(SZ[(size_t)m * DM + n])); } };
struct EP_Plain { bf16_t* O; __device__ void st(int m, int n, float a) const { O[(size_t)m * DM + n] = f2bf(a); } };
struct EP_KV { bf16_t* K; bf16_t* V; __device__ void st(int m, int n, float a) const { if (n < 1024) K[(size_t)m * DM + n] = f2bf(a); else V[(size_t)m * DM + n - 1024] = f2bf(a); } };
struct EP_In1 { bf16_t* Q; bf16_t* SZ1; __device__ void st(int m, int n, float a) const { if (n < 1024) Q[(size_t)m * DM + n] = f2bf(a * QC2); else SZ1[(size_t)m * DM + n - 1024] = f2bf(silu_f(a)); } };

template <class AL, class WL, class EP>
__global__ void __launch_bounds__(256) n_gemm(AL al, WL wl, EP ep, int N) {
    __shared__ float As[16][68]; __shared__ float Ws[16][68];
    const int tid = threadIdx.x, tx = tid & 15, ty = tid >> 4;
    const int m0 = blockIdx.y * 64, n0 = blockIdx.x * 64;
    float acc[4][4];
#pragma unroll
    for (int i = 0; i < 4; ++i)
#pragma unroll
        for (int j = 0; j < 4; ++j) acc[i][j] = 0.f;
    for (int k0 = 0; k0 < 1024; k0 += 16) {
#pragma unroll
        for (int i = 0; i < 4; ++i) { const int e = tid + 256 * i; const int mm = e >> 4, kk = e & 15; As[kk][mm] = al.ld(m0 + mm, k0 + kk); }
#pragma unroll
        for (int i = 0; i < 4; ++i) { const int e = tid + 256 * i; const int kk = e >> 6, nn = e & 63; Ws[kk][nn] = wl.ld(k0 + kk, n0 + nn); }
        __syncthreads();
#pragma unroll
        for (int kk = 0; kk < 16; ++kk) {
            float a[4], b[4];
#pragma unroll
            for (int i = 0; i < 4; ++i) { a[i] = As[kk][ty * 4 + i]; b[i] = Ws[kk][tx * 4 + i]; }
#pragma unroll
            for (int i = 0; i < 4; ++i)
#pragma unroll
                for (int j = 0; j < 4; ++j) acc[i][j] += a[i] * b[j];
        }
        __syncthreads();
    }
#pragma unroll
    for (int i = 0; i < 4; ++i)
#pragma unroll
        for (int j = 0; j < 4; ++j) ep.st(m0 + ty * 4 + i, n0 + tx * 4 + j, acc[i][j]);
}

__global__ void __launch_bounds__(256) n_ssm(const bf16_t* __restrict__ US, const float* lam_re, const float* lam_im, const float* log_dt, const float* b_re, const float* b_im,
                                             const float* c_re, const float* c_im, const float* d_skip, bf16_t* YG) {
    const int wv = blockIdx.x * 4 + (threadIdx.x >> 6), lane = threadIdx.x & 63;
    if (wv >= NB * NGRP) return;
    const int b = wv / NGRP, g = wv % NGRP, p = lane;
    const float dt = expf(log_dt[g]);
    const float lr = lam_re[g * 64 + p], li = lam_im[g * 64 + p];
    const float mag = expf(lr * dt); float sn, cs; sn = sinf(li * dt); cs = cosf(li * dt);
    const float lbr = mag * cs, lbi = mag * sn;
    const float nr = lbr - 1.0f, ni = lbi, den = lr * lr + li * li;
    const float cr = (nr * lr + ni * li) / den, ci = (ni * lr - nr * li) / den;
    float bbr[16], bbi[16], ccr[16], cci[16];
#pragma unroll
    for (int c = 0; c < 16; ++c) { const float br = b_re[(g * 64 + p) * 16 + c], bi = b_im[(g * 64 + p) * 16 + c];
        bbr[c] = cr * br - ci * bi; bbi[c] = cr * bi + ci * br;
        ccr[c] = c_re[(g * 16 + c) * 64 + p]; cci[c] = c_im[(g * 16 + c) * 64 + p]; }
    const float dsk = d_skip[g * 16 + (lane & 15)];
    float sr = 0.f, si = 0.f;
    for (int t = 0; t < SEQL; ++t) {
        const int m = b * SEQL + t;
        const bf16_t* up = US + us_off(g, m >> 4, (m & 15) * 16);
        float u[16];
        { const u32x4_t w0 = *(const u32x4_t*)up, w1 = *(const u32x4_t*)(up + 8);
#pragma unroll
          for (int i = 0; i < 4; ++i) { u[2 * i] = __uint_as_float(w0[i] << 16); u[2 * i + 1] = __uint_as_float(w0[i] & 0xffff0000u); u[8 + 2 * i] = __uint_as_float(w1[i] << 16); u[8 + 2 * i + 1] = __uint_as_float(w1[i] & 0xffff0000u); } }
        float bur = 0.f, bui = 0.f;
#pragma unroll
        for (int c = 0; c < 16; ++c) { bur += bbr[c] * u[c]; bui += bbi[c] * u[c]; }
        const float nsr = lbr * sr - lbi * si + bur, nsi = lbr * si + lbi * sr + bui; sr = nsr; si = nsi;
        float yv = 0.f;
#pragma unroll
        for (int c = 0; c < 16; ++c) { const float part = wave_sum_f(ccr[c] * sr - cci[c] * si); if ((lane & 15) == c) yv = part; }
        if (lane < 16) { const float yy = yv + dsk * bf2f(up[lane]); YG[yg_off(g, m >> 4, (m & 15) * 16 + lane)] = f2bf(gelu_tanh_f(yy)); }
    }
}

__global__ void __launch_bounds__(256) n_attn(const bf16_t* __restrict__ Q, const bf16_t* __restrict__ K, const bf16_t* __restrict__ V, bf16_t* O0, bf16_t* O1) {
    __shared__ float qs[4][128];
    const int w = threadIdx.x >> 6, lane = threadIdx.x & 63;
    const int gwv = blockIdx.x * 4 + w;
    const int h = gwv & 7, m = gwv >> 3, b = m / SEQL, qi = m % SEQL;
    qs[w][lane] = bf2f(Q[(size_t)m * DM + h * 128 + lane]); qs[w][64 + lane] = bf2f(Q[(size_t)m * DM + h * 128 + 64 + lane]);
    __syncthreads();
    float m0 = -1e30f, m1 = -1e30f, l0 = 0.f, l1 = 0.f, a00 = 0.f, a01 = 0.f, a10 = 0.f, a11 = 0.f;
    const size_t rb = (size_t)b * SEQL;
    for (int kc = 0; kc * 64 <= qi; ++kc) {
        const int key = kc * 64 + lane; const bool valid = key <= qi;
        float s0 = 0.f, s1 = 0.f;
        { const bf16_t* kr = K + (rb + (valid ? key : qi)) * DM + h * 128;
#pragma unroll
          for (int ch = 0; ch < 8; ++ch) { const u32x4_t w0 = *(const u32x4_t*)(kr + ch * 8), w1 = *(const u32x4_t*)(kr + 64 + ch * 8);
#pragma unroll
            for (int i = 0; i < 4; ++i) { s0 += qs[w][ch * 8 + 2 * i] * __uint_as_float(w0[i] << 16) + qs[w][ch * 8 + 2 * i + 1] * __uint_as_float(w0[i] & 0xffff0000u);
                                          s1 += qs[w][64 + ch * 8 + 2 * i] * __uint_as_float(w1[i] << 16) + qs[w][64 + ch * 8 + 2 * i + 1] * __uint_as_float(w1[i] & 0xffff0000u); } } }
        if (!valid) { s0 = -1e30f; s1 = -1e30f; }
        const float nm0 = fmaxf(m0, wave_max_f(s0)), nm1 = fmaxf(m1, wave_max_f(s1));
        const float f0 = exp2f(m0 - nm0), f1 = exp2f(m1 - nm1);
        const float p0 = valid ? exp2f(s0 - nm0) : 0.f, p1 = valid ? exp2f(s1 - nm1) : 0.f;
        l0 = l0 * f0 + wave_sum_f(p0); l1 = l1 * f1 + wave_sum_f(p1); m0 = nm0; m1 = nm1;
        a00 *= f0; a01 *= f0; a10 *= f1; a11 *= f1;
        const int nk = min(64, qi - kc * 64 + 1);
        for (int j = 0; j < nk; ++j) {
            const float pj0 = __shfl(p0, j), pj1 = __shfl(p1, j);
            const bf16_t* vr = V + (rb + kc * 64 + j) * DM + h * 128;
            const float v0 = bf2f(vr[lane]), v1 = bf2f(vr[64 + lane]);
            a00 += pj0 * v0; a01 += pj0 * v1; a10 += pj1 * v0; a11 += pj1 * v1;
        }
    }
    const float i0 = 1.0f / l0, i1 = 1.0f / l1;
    O0[(size_t)m * DM + h * 128 + lane] = f2bf(a00 * i0); O0[(size_t)m * DM + h * 128 + 64 + lane] = f2bf(a01 * i0);
    O1[(size_t)m * DM + h * 128 + lane] = f2bf(a10 * i1); O1[(size_t)m * DM + h * 128 + 64 + lane] = f2bf(a11 * i1);
}
#ifndef REPEAT_MASK
#define REPEAT_MASK 0
#endif
#ifndef ATTN_V128
#define ATTN_V128 1
#endif
#ifndef EXTRA_PHASE
#define EXTRA_PHASE -1
#endif
#ifndef ATTN_FUSE_POST
#define ATTN_FUSE_POST 1
#endif
#ifndef H1_RECOMP
#define H1_RECOMP 1
#endif
#ifndef SSM_FUSED
#define SSM_FUSED 1
#endif
#ifndef ATTN_PRIO
#define ATTN_PRIO 0
#endif
#ifndef H1_BF16
#define H1_BF16 0
#endif
#ifndef H1_AKV
#define H1_AKV 1
#endif
#ifndef SSM_DFOLD
#define SSM_DFOLD 1
#endif
#ifndef NT_OUT
#define NT_OUT 0
#endif
#if NT_OUT
#define ST_OUT(p, v) __builtin_nontemporal_store((v), (p))
#else
#define ST_OUT(p, v) (*(p) = (v))
#endif
#ifndef FUSE_EPI
#define FUSE_EPI 0
#endif
#ifndef ALIGN_E
#define ALIGN_E true
#endif
namespace pg8 {
#define PG8_LAS __attribute__((address_space(3)))
typedef short bf16x8 __attribute__((ext_vector_type(8)));
typedef float f32x4 __attribute__((ext_vector_type(4)));
typedef unsigned u32x4 __attribute__((ext_vector_type(4)));
constexpr int BM = 256, BK = 64, HALF = 128, HTB = HALF * BK * 2  , STAGE_BYTES = 8 * HTB, NXCD = 8, WGM = 8;

__host__ __device__ __forceinline__ int lds_byte(int r, int c) { const int st = (r >> 4) * 2 + (c >> 5), rr = r & 15, cc = c & 31, ob = rr * 64 + cc * 2; return st * 1024 + (ob ^ (((ob >> 9) & 1) << 5)); }
__host__ __device__ __forceinline__ void stage_rc(int b, int& R, int& C) { const int st = b / 1024, sb = b % 1024, swz = sb ^ (((sb >> 9) & 1) << 5); R = (st >> 1) * 16 + swz / 64; C = (st & 1) * 32 + (swz % 64) / 2; }
__host__ __device__ __forceinline__ int perm32(int rho) { const int n = rho >> 4, i = rho & 15; return 8 * (i >> 2) + 4 * n + (i & 3); }

struct Unit { int pm, pn, grp; };
struct Gemm {
    const char* A; const char* Bt; int nt, pad0;
    unsigned a_rs, a_c16; size_t a_kstep, a_tstep, a_gstep;
    unsigned b_rs, pad1; size_t b_tstep, b_gstep;
    __device__ __forceinline__ const char* abase(const Unit& u) const { return A + (size_t)u.grp * a_gstep + (size_t)u.pm * a_tstep; }
    __device__ __forceinline__ const char* bbase(const Unit& u) const { return Bt + (size_t)u.grp * b_gstep + (size_t)u.pn * b_tstep; }
};
__device__ __forceinline__ Gemm gemm_std(const void* A, int lda, const void* Bt, int ldb, int K) {
    Gemm g; g.A = (const char*)A; g.Bt = (const char*)Bt; g.nt = K / BK; g.pad0 = 0; g.a_rs = (unsigned)lda * 2u; g.a_c16 = 32u; g.a_kstep = BK * 2; g.a_tstep = (size_t)BM * lda * 2; g.a_gstep = 0;
    g.b_rs = (unsigned)ldb * 2u; g.pad1 = 0; g.b_tstep = (size_t)BM * ldb * 2; g.b_gstep = 0; return g;
}

struct Order {
    int nM, nN, nG, nwg, G, c, only, pm_off, mode2;
    __device__ __forceinline__ void init(int nM_, int nN_, int nG_, int G_, int c_) { nM = nM_; nN = nN_; nG = nG_; nwg = nM * nN * nG; G = G_; c = c_; only = -1; pm_off = 0; mode2 = 0; }
    __device__ __forceinline__ bool next(int i, Unit& u) const {
        if (only >= 0) { if (i > 0) return false; i = only; }
        const long L = (long)i * G + c; if (L >= nwg) return false;
        int wgid = (int)L; { const int q = nwg / NXCD, r = nwg % NXCD, xcd = wgid % NXCD, off = wgid / NXCD; wgid = (xcd < r ? xcd * (q + 1) : r * (q + 1) + (xcd - r) * q) + off; }
        if (mode2) {
            const int x = wgid >> 8, y = wgid & 255, bk = y >> 6, w2 = y & 63; u.grp = bk & 1; u.pm = (x * 2 + (bk >> 1)) * 8 + (w2 & 7); u.pn = w2 >> 3;
        } else
        { const int per = nM * nN; u.grp = wgid / per; const int w2 = wgid % per;
          const int nig = WGM * nN, gid = w2 / nig, fm = gid * WGM, gsz = (nM - fm) < WGM ? (nM - fm) : WGM;
          u.pm = pm_off + fm + ((w2 % nig) % gsz); u.pn = (w2 % nig) / gsz; }
        return true;
    }
};

__device__ __forceinline__ unsigned cvt_pk_bf16(float lo, float hi) { unsigned r; asm volatile("v_cvt_pk_bf16_f32 %0, %1, %2" : "=v"(r) : "v"(lo), "v"(hi)); return r; }
__device__ __forceinline__ u32x4 pack8(const f32x4 a, const f32x4 b) { u32x4 w; w.x = cvt_pk_bf16(a[0], a[1]); w.y = cvt_pk_bf16(a[2], a[3]); w.z = cvt_pk_bf16(b[0], b[1]); w.w = cvt_pk_bf16(b[2], b[3]); return w; }
__device__ __forceinline__ void unpack8(const u32x4 w, f32x4& a, f32x4& b) {
    a[0] = __uint_as_float(w.x << 16); a[1] = __uint_as_float(w.x & 0xffff0000u); a[2] = __uint_as_float(w.y << 16); a[3] = __uint_as_float(w.y & 0xffff0000u);
    b[0] = __uint_as_float(w.z << 16); b[1] = __uint_as_float(w.z & 0xffff0000u); b[2] = __uint_as_float(w.w << 16); b[3] = __uint_as_float(w.w & 0xffff0000u); }
__device__ __forceinline__ float fsilu(float v) { return v * __builtin_amdgcn_rcpf(1.0f + __expf(-v)); }
__device__ __forceinline__ float fsigm(float v) { return __builtin_amdgcn_rcpf(1.0f + __expf(-v)); }
__device__ __forceinline__ f32x4 silu4(f32x4 v) { f32x4 o; o[0] = fsilu(v[0]); o[1] = fsilu(v[1]); o[2] = fsilu(v[2]); o[3] = fsilu(v[3]); return o; }
__device__ __forceinline__ f32x4 sigm4(f32x4 v) { f32x4 o; o[0] = fsigm(v[0]); o[1] = fsigm(v[1]); o[2] = fsigm(v[2]); o[3] = fsigm(v[3]); return o; }
__device__ __forceinline__ float fgelu(float v) { const float u = 0.7978845608028654f * (v + 0.044715f * v * v * v); const float e = __expf(2.0f * u); return 0.5f * v * (2.0f - 2.0f * __builtin_amdgcn_rcpf(e + 1.0f)); }
__device__ __forceinline__ f32x4 gelu4(f32x4 v) { f32x4 o; o[0] = fgelu(v[0]); o[1] = fgelu(v[1]); o[2] = fgelu(v[2]); o[3] = fgelu(v[3]); return o; }

template <class F> struct EpiRow8 {
    static constexpr bool PERM = true, AFTER_DRAIN = false;
    F f;
    __device__ __forceinline__ void operator()(const f32x4 (&acc)[2][2][4][2], const Unit& u, int wr, int wc, int fr, int fq) const {
#pragma unroll
        for (int ai = 0; ai < 2; ++ai)
#pragma unroll
            for (int m = 0; m < 4; ++m) { const int row = u.pm * BM + ai * HALF + wr * 64 + m * 16 + fr;
#pragma unroll
                for (int bj = 0; bj < 2; ++bj) { const int col0 = u.pn * BM + bj * HALF + wc * 32 + 8 * fq; f.apply(u, row, col0, acc[ai][bj][m][0], acc[ai][bj][m][1]); } }
    }
};
struct F_In0 { bf16_t* US; bf16_t* SZ;
    __device__ __forceinline__ void apply(const Unit&, int row, int col0, f32x4 v0, f32x4 v1) const {
        if (col0 < 1024) ST_OUT((u32x4*)(US + us_off(col0 >> 4, row >> 4, (row & 15) * 16 + (col0 & 15))), pack8(v0, v1));
        else NT_ST((u32x4*)(SZ + (size_t)row * DM + (col0 - 1024)), pack8(silu4(v0), silu4(v1))); } };
struct F_SsmA { float* E;
    __device__ __forceinline__ void apply(const Unit& u, int row, int col0, f32x4 v0, f32x4 v1) const {
        if (col0 < 128) { float* p = E + ((size_t)u.grp * NTILE + row) * 128 + col0; *(f32x4*)p = v0; *(f32x4*)(p + 4) = v1; } } };
struct F_SsmB { const bf16_t* US; const float* dsk; bf16_t* YG;
    __device__ __forceinline__ void apply(const Unit& u, int row, int col0, f32x4 v0, f32x4 v1) const {
        const u32x4 uw = *(const u32x4*)(US + us_off(u.grp, row, col0)); f32x4 u0, u1; unpack8(uw, u0, u1);
        const float* d = dsk + u.grp * 16 + (col0 & 15); const f32x4 d0 = *(const f32x4*)d, d1 = *(const f32x4*)(d + 4);
        ST_OUT((u32x4*)(YG + yg_off(u.grp, row, col0)), pack8(gelu4(v0 + d0 * u0), gelu4(v1 + d1 * u1))); } };
struct F_SsmB0 { bf16_t* YG;
    __device__ __forceinline__ void apply(const Unit& u, int row, int col0, f32x4 v0, f32x4 v1) const {
        *(u32x4*)(YG + yg_off(u.grp, row, col0)) = pack8(gelu4(v0), gelu4(v1)); } };
struct F_Glu { const bf16_t* YG; const bf16_t* SZ; const float* bias; bf16_t* Y2;
    __device__ __forceinline__ void apply(const Unit&, int row, int col0, f32x4 v0, f32x4 v1) const {
        const u32x4 yw = *(const u32x4*)(YG + yg_off(col0 >> 4, row >> 4, (row & 15) * 16 + (col0 & 15))); f32x4 y0, y1; unpack8(yw, y0, y1);
        const u32x4 zw = NT_LD((const u32x4*)(SZ + (size_t)row * DM + col0)); f32x4 z0, z1; unpack8(zw, z0, z1);
        const f32x4 b0 = *(const f32x4*)(bias + col0), b1 = *(const f32x4*)(bias + col0 + 4);
        ST_OUT((u32x4*)(Y2 + (size_t)row * DM + col0), pack8(y0 * sigm4(v0 + b0) * z0, y1 * sigm4(v1 + b1) * z1)); } };
template <class F> struct EpiRow8L {
    static constexpr bool PERM = true, AFTER_DRAIN = false;
    F f;
    __device__ __forceinline__ void operator()(const f32x4 (&acc)[2][2][4][2], const Unit& u, int wr, int wc, int fr, int fq) const {
#pragma unroll
        for (int ai = 0; ai < 2; ++ai) {
            typename F::Pre pre[4][2];
#pragma unroll
            for (int m = 0; m < 4; ++m) { const int row = u.pm * BM + ai * HALF + wr * 64 + m * 16 + fr;
#pragma unroll
                for (int bj = 0; bj < 2; ++bj) { const int col0 = u.pn * BM + bj * HALF + wc * 32 + 8 * fq; f.load(u, row, col0, pre[m][bj]); } }
#pragma unroll
            for (int m = 0; m < 4; ++m) { const int row = u.pm * BM + ai * HALF + wr * 64 + m * 16 + fr;
#pragma unroll
                for (int bj = 0; bj < 2; ++bj) { const int col0 = u.pn * BM + bj * HALF + wc * 32 + 8 * fq; f.apply(u, row, col0, acc[ai][bj][m][0], acc[ai][bj][m][1], pre[m][bj]); } }
        }
    }
};
struct F_SsmB2 { const bf16_t* US; const float* dsk; bf16_t* YG;
    struct Pre { u32x4 uw; };
    __device__ __forceinline__ void load(const Unit& u, int row, int col0, Pre& p) const { p.uw = *(const u32x4*)(US + us_off(u.grp, row, col0)); }
    __device__ __forceinline__ void apply(const Unit& u, int row, int col0, f32x4 v0, f32x4 v1, const Pre& p) const {
        f32x4 u0, u1; unpack8(p.uw, u0, u1);
        const float* d = dsk + u.grp * 16 + (col0 & 15); const f32x4 d0 = *(const f32x4*)d, d1 = *(const f32x4*)(d + 4);
        *(u32x4*)(YG + yg_off(u.grp, row, col0)) = pack8(gelu4(v0 + d0 * u0), gelu4(v1 + d1 * u1)); } };
struct F_Glu2 { const bf16_t* YG; const bf16_t* SZ; const float* bias; bf16_t* Y2;
    struct Pre { u32x4 yw, zw; };
    __device__ __forceinline__ void load(const Unit&, int row, int col0, Pre& p) const {
        p.yw = *(const u32x4*)(YG + yg_off(col0 >> 4, row >> 4, (row & 15) * 16 + (col0 & 15))); p.zw = *(const u32x4*)(SZ + (size_t)row * DM + col0); }
    __device__ __forceinline__ void apply(const Unit&, int row, int col0, f32x4 v0, f32x4 v1, const Pre& p) const {
        f32x4 y0, y1, z0, z1; unpack8(p.yw, y0, y1); unpack8(p.zw, z0, z1);
        const f32x4 b0 = *(const f32x4*)(bias + col0), b1 = *(const f32x4*)(bias + col0 + 4);
        *(u32x4*)(Y2 + (size_t)row * DM + col0) = pack8(y0 * sigm4(v0 + b0) * z0, y1 * sigm4(v1 + b1) * z1); } };
struct F_Split2 { bf16_t* Olo[2]; bf16_t* Ohi[2];
    __device__ __forceinline__ void apply(const Unit& u, int row, int col0, f32x4 v0, f32x4 v1) const {
        if (u.grp == 0) { bf16_t* o = (col0 < 1024) ? Olo[0] + (size_t)row * DM + col0 : Ohi[0] + (size_t)row * DM + (col0 - 1024); NT_ST((u32x4*)o, pack8(v0, v1)); }
        else if (col0 < 1024) NT_ST((u32x4*)(Olo[1] + (size_t)row * DM + col0), pack8(v0 * QC2, v1 * QC2));
        else NT_ST((u32x4*)(Ohi[1] + (size_t)row * DM + (col0 - 1024)), pack8(silu4(v0), silu4(v1))); } };
struct F_Plain { bf16_t* O;
    __device__ __forceinline__ void apply(const Unit&, int row, int col0, f32x4 v0, f32x4 v1) const { ST_OUT((u32x4*)(O + (size_t)row * DM + col0), pack8(v0, v1)); } };
struct F_Split { bf16_t* Olo; bf16_t* Ohi; float sc_lo; int silu_hi;
    __device__ __forceinline__ void apply(const Unit&, int row, int col0, f32x4 v0, f32x4 v1) const {
        if (col0 < 1024) *(u32x4*)(Olo + (size_t)row * DM + col0) = pack8(v0 * sc_lo, v1 * sc_lo);
        else { if (silu_hi) { NT_ST((u32x4*)(Ohi + (size_t)row * DM + (col0 - 1024)), pack8(silu4(v0), silu4(v1))); } else *(u32x4*)(Ohi + (size_t)row * DM + (col0 - 1024)) = pack8(v0, v1); } } };


struct PanelRms {
    unsigned* xbuf;
    unsigned* cnt;
    unsigned* tmo;
    float eps;
    __device__ __forceinline__ bool run(const f32x4 (&v)[2][2][4][2], const Unit& u, int wr, int wc, int fr, int fq, PG8_LAS unsigned char* lds, int wid, int lane) const {
        PG8_LAS float* P = (PG8_LAS float*)lds;
        PG8_LAS float* S = (PG8_LAS float*)(lds + 8192);
        PG8_LAS unsigned* flag = (PG8_LAS unsigned*)(lds + 8192 + 2048);
#pragma unroll
        for (int ai = 0; ai < 2; ++ai)
#pragma unroll
            for (int m = 0; m < 4; ++m) {
                float q = 0.f;
#pragma unroll
                for (int bj = 0; bj < 2; ++bj)
#pragma unroll
                    for (int n = 0; n < 2; ++n) { const f32x4 d = v[ai][bj][m][n]; q += (d[0] * d[0] + d[1] * d[1]) + (d[2] * d[2] + d[3] * d[3]); }
                q += __shfl_xor(q, 16); q += __shfl_xor(q, 32);
                if (fq == 0) P[(ai * HALF + wr * 64 + m * 16 + fr) * 4 + wc] = q;
            }
        asm volatile("s_waitcnt lgkmcnt(0)" ::: "memory"); __builtin_amdgcn_s_barrier(); asm volatile("" ::: "memory");
        const int row = wid * 32 + (lane & 31);
        if (lane < 32) {
            const float tot = (P[row * 4 + 0] + P[row * 4 + 1]) + (P[row * 4 + 2] + P[row * 4 + 3]);
            unsigned long long* slot = (unsigned long long*)xbuf + ((size_t)(u.pm * BM + row) * 4 + u.pn);
            __hip_atomic_store(slot, (unsigned long long)__float_as_uint(tot), __ATOMIC_RELAXED, __HIP_MEMORY_SCOPE_AGENT);
        }
        asm volatile("s_waitcnt vmcnt(0)" ::: "memory");
        if (lane == 0) __hip_atomic_fetch_add(cnt + 64 * u.pm, 1u, __ATOMIC_RELAXED, __HIP_MEMORY_SCOPE_AGENT);
        if (wid == 0) {
            bool dead = false; const unsigned long long t0 = __builtin_amdgcn_s_memrealtime(); const unsigned want = 32u;
            for (;;) {
                if ((unsigned)__builtin_amdgcn_readfirstlane(__hip_atomic_load(cnt + 64 * u.pm, __ATOMIC_RELAXED, __HIP_MEMORY_SCOPE_AGENT)) >= want) break;
                if (__builtin_amdgcn_s_memrealtime() - t0 > 2000000ull) { if (lane == 0) __hip_atomic_store(tmo, 1u, __ATOMIC_RELAXED, __HIP_MEMORY_SCOPE_AGENT); dead = true; break; }
                __builtin_amdgcn_s_sleep(2);
            }
            __builtin_amdgcn_fence(__ATOMIC_ACQUIRE, "agent");
            if (lane == 0) flag[0] = dead ? 1u : 0u;
        }
        asm volatile("s_waitcnt vmcnt(0) lgkmcnt(0)" ::: "memory"); __builtin_amdgcn_s_barrier(); asm volatile("" ::: "memory");
        const bool bad = flag[0] != 0u;
        if (lane < 32) {
            const unsigned long long* slot = (const unsigned long long*)xbuf + (size_t)(u.pm * BM + row) * 4; float t4[4];
#pragma unroll
            for (int t = 0; t < 4; ++t) t4[t] = __uint_as_float((unsigned)__hip_atomic_load(slot + t, __ATOMIC_RELAXED, __HIP_MEMORY_SCOPE_AGENT));
            S[row] = rsqrtf(((t4[0] + t4[1]) + (t4[2] + t4[3])) * (1.0f / 1024.0f) + eps);
        }
        asm volatile("s_waitcnt lgkmcnt(0)" ::: "memory"); __builtin_amdgcn_s_barrier(); asm volatile("" ::: "memory");
        return bad;
    }
};
struct EpiFinal {
    static constexpr bool PERM = false, AFTER_DRAIN = true;
    const float* base; float* out; const float* mod1; const float* gpost1; PanelRms st;
    __device__ __forceinline__ void fused(f32x4 (&acc)[2][2][4][2], const Unit& u, int wr, int wc, int fr, int fq, PG8_LAS unsigned char* lds, int wid, int lane) const {
        const PG8_LAS float* S = (const PG8_LAS float*)(lds + 8192);
        const int col0 = u.pn * BM + wc * 32 + 4 * fq; const int b = u.pm >> 4;
        const float* gate = mod1 + (size_t)b * 3072 + 2048;
        const bool bad = st.run(acc, u, wr, wc, fr, fq, lds, wid, lane);
        const float qnan = __builtin_nanf("");
        f32x4 gg[2][2];
#pragma unroll
        for (int bj = 0; bj < 2; ++bj)
#pragma unroll
            for (int n = 0; n < 2; ++n) gg[bj][n] = *(const f32x4*)(gate + col0 + bj * HALF + n * 16) * *(const f32x4*)(gpost1 + col0 + bj * HALF + n * 16);
#pragma unroll
        for (int ai = 0; ai < 2; ++ai)
#pragma unroll
            for (int m = 0; m < 4; ++m) { const int r = ai * HALF + wr * 64 + m * 16 + fr; const float sr = S[r]; const size_t off = (size_t)(u.pm * BM + r) * DM + col0;
#pragma unroll
                for (int bj = 0; bj < 2; ++bj)
#pragma unroll
                    for (int n = 0; n < 2; ++n) { const f32x4 bs = *(const f32x4*)(base + off + bj * HALF + n * 16); f32x4 o = bs + gg[bj][n] * (acc[ai][bj][m][n] * sr);
                        if (bad) o = (f32x4){qnan, qnan, qnan, qnan}; *(f32x4*)(out + off + bj * HALF + n * 16) = o; }
                if (m & 1) asm volatile("" ::: "memory"); }
    }
};
struct EpiMid {
    static constexpr bool PERM = false, AFTER_DRAIN = true;
    const float* x; float* out; bf16_t* akv; bf16_t* ain1; const float* mod; const float* gpost0; const float* gpre1; PanelRms st1, st2;
    __device__ __forceinline__ void fused(f32x4 (&acc)[2][2][4][2], const Unit& u, int wr, int wc, int fr, int fq, PG8_LAS unsigned char* lds, int wid, int lane) const {
        typedef unsigned u32x2v __attribute__((ext_vector_type(2)));
        const PG8_LAS float* S = (const PG8_LAS float*)(lds + 8192);
        const int col0 = u.pn * BM + wc * 32 + 4 * fq; const int b = u.pm >> 4;
        const float* gate0 = mod + (size_t)b * 3072 + 2048; const float* sh1 = mod + (size_t)(8 + b) * 3072; const float* sc1 = sh1 + 1024;
        bool bad = st1.run(acc, u, wr, wc, fr, fq, lds, wid, lane);
        {
            f32x4 gg[2][2];
#pragma unroll
            for (int bj = 0; bj < 2; ++bj)
#pragma unroll
                for (int n = 0; n < 2; ++n) gg[bj][n] = *(const f32x4*)(gate0 + col0 + bj * HALF + n * 16) * *(const f32x4*)(gpost0 + col0 + bj * HALF + n * 16);
#pragma unroll
            for (int ai = 0; ai < 2; ++ai)
#pragma unroll
                for (int m = 0; m < 4; ++m) { const int r = ai * HALF + wr * 64 + m * 16 + fr; const float sr = S[r]; const size_t off = (size_t)(u.pm * BM + r) * DM + col0;
#pragma unroll
                    for (int bj = 0; bj < 2; ++bj)
#pragma unroll
                        for (int n = 0; n < 2; ++n) { const f32x4 bs = *(const f32x4*)(x + off + bj * HALF + n * 16); acc[ai][bj][m][n] = bs + gg[bj][n] * (acc[ai][bj][m][n] * sr); }
                    asm volatile("" : "+v"(acc[ai][0][m][0]), "+v"(acc[ai][0][m][1]), "+v"(acc[ai][1][m][0]), "+v"(acc[ai][1][m][1]));
                    if (m & 1) asm volatile("" ::: "memory"); }
        }
        bad = st2.run(acc, u, wr, wc, fr, fq, lds, wid, lane) || bad;
        const float qnan = __builtin_nanf("");
#pragma unroll
        for (int bj = 0; bj < 2; ++bj)
#pragma unroll
            for (int n = 0; n < 2; ++n) { const int c = col0 + bj * HALF + n * 16;
                const f32x4 gf = *(const f32x4*)(gpre1 + c) * (*(const f32x4*)(sc1 + c) + 1.0f), sh = *(const f32x4*)(sh1 + c);
#pragma unroll
                for (int ai = 0; ai < 2; ++ai)
#pragma unroll
                    for (int m = 0; m < 4; ++m) { const int r = ai * HALF + wr * 64 + m * 16 + fr; const float sr = S[r]; const size_t off = (size_t)(u.pm * BM + r) * DM + c;
                        f32x4 h = acc[ai][bj][m][n]; if (bad) h = (f32x4){qnan, qnan, qnan, qnan};
                        *(f32x4*)(out + off) = h;
                        const f32x4 nr = h * sr; u32x2v w; w.x = cvt_pk_bf16(nr[0], nr[1]); w.y = cvt_pk_bf16(nr[2], nr[3]); *(u32x2v*)(akv + off) = w;
                        const f32x4 z = nr * gf + sh; w.x = cvt_pk_bf16(z[0], z[1]); w.y = cvt_pk_bf16(z[2], z[3]); *(u32x2v*)(ain1 + off) = w; }
                asm volatile("" ::: "memory"); }
    }
};

struct EpiScan {
    static constexpr bool PERM = true, AFTER_DRAIN = true;
    const float* lb16; bf16_t* US; int carry_off;
    __device__ __forceinline__ void fused(f32x4 (&acc)[2][2][4][2], const Unit& u, int wr, int wc, int fr, int fq, PG8_LAS unsigned char* lds, int wid, int lane) const {
#pragma unroll
        for (int ai = 0; ai < 2; ++ai)
#pragma unroll
            for (int m = 0; m < 4; ++m) { const int row = ai * HALF + wr * 64 + m * 16 + fr; const int ch = (wc * 32 + 8 * fq) >> 2;
                *(PG8_LAS f32x4*)(lds + row * 512 + ((ch ^ (row & 7)) << 4)) = acc[ai][0][m][0];
                *(PG8_LAS f32x4*)(lds + row * 512 + (((ch + 1) ^ (row & 7)) << 4)) = acc[ai][0][m][1]; }
        asm volatile("s_waitcnt lgkmcnt(0)" ::: "memory"); __builtin_amdgcn_s_barrier(); asm volatile("" ::: "memory");
        const int p = lane, g = u.grp, b = u.pm;
        const float lr = lb16[(g * 64 + p) * 2], li = lb16[(g * 64 + p) * 2 + 1];
        typedef float f32x2v __attribute__((ext_vector_type(2)));
        const int coff = ((p >> 1) << 4) + (p & 1) * 8;
        float sr = 0.f, si = 0.f;
#pragma unroll 8
        for (int j = 0; j < 32; ++j) { const int t = wid * 32 + j; const f32x2v e = *(const PG8_LAS f32x2v*)(lds + t * 512 + (coff ^ ((t & 7) << 4)));
            const float nr = lr * sr - li * si + e.x, ni = lr * si + li * sr + e.y; sr = nr; si = ni; }
        PG8_LAS f32x2v* C = (PG8_LAS f32x2v*)(lds + carry_off);
        C[wid * 64 + p] = (f32x2v){sr, si};
        float pr = lr, pi = li;
#pragma unroll
        for (int q = 0; q < 5; ++q) { const float nr = pr * pr - pi * pi, ni = 2.f * pr * pi; pr = nr; pi = ni; }
        asm volatile("s_waitcnt lgkmcnt(0)" ::: "memory"); __builtin_amdgcn_s_barrier(); asm volatile("" ::: "memory");
        sr = 0.f; si = 0.f;
        for (int v = 0; v < wid; ++v) { const f32x2v c = C[v * 64 + p]; const float nr = pr * sr - pi * si + c.x, ni = pr * si + pi * sr + c.y; sr = nr; si = ni; }
        bf16_t* sp = US + us_off(g, b * 256 + wid * 32, 256 + 2 * p);
#pragma unroll 8
        for (int j = 0; j < 32; ++j) { const int t = wid * 32 + j; const f32x2v e = *(const PG8_LAS f32x2v*)(lds + t * 512 + (coff ^ ((t & 7) << 4)));
            *(unsigned*)(sp + (size_t)j * US_P) = cvt_pk_bf16(sr, si);
            const float nr = lr * sr - li * si + e.x, ni = lr * si + li * sr + e.y; sr = nr; si = ni; }
        asm volatile("s_waitcnt vmcnt(0)" ::: "memory");
    }
};
template <class Epi, bool ALIGN_EPI>
__device__ __forceinline__ void gemm_phase(PG8_LAS unsigned char* lds, const Gemm g, const Order& S, const Epi& E, int tid_in) {
    int tid_ = tid_in; asm volatile("" : "+v"(tid_));
    const int tid = tid_, wid = __builtin_amdgcn_readfirstlane(tid >> 6), lane = tid & 63, wr = wid >> 2, wc = wid & 3, fr = lane & 15, fq = lane >> 4;
    const int nt = g.nt;
    unsigned voffA[2], voffB[2];
#pragma unroll
    for (int i = 0; i < 2; ++i) { int R, C; stage_rc(tid * 16 + i * 8192, R, C); const int Rb = Epi::PERM ? ((R & ~31) + perm32(R & 31)) : R;
        voffA[i] = (unsigned)R * g.a_rs + (unsigned)(C >> 4) * g.a_c16 + (unsigned)(C & 15) * 2u; voffB[i] = (unsigned)Rb * g.b_rs + (unsigned)C * 2u; }
    const size_t kstepA = g.a_kstep, kstepB = (size_t)(BK * 2);
    const size_t hstepA = (size_t)HALF * g.a_rs, hstepB = (size_t)HALF * g.b_rs;
    const unsigned ldsw = (unsigned)wid * 1024u;
    const int aoff = lds_byte(wr * 64 + fr, fq * 8), boff = lds_byte(wc * 32 + fr, fq * 8);
#define PG8_SA(b, h) (((b) * 2 + (h)) * HTB)
#define PG8_SB(b, h) ((4 + (b) * 2 + (h)) * HTB)
#define PG8_STAGE(bufoff, gbase, voff) do { _Pragma("unroll") for (int _i = 0; _i < 2; ++_i) \
        __builtin_amdgcn_global_load_lds((const unsigned*)((const char*)(gbase) + (voff)[_i]), (PG8_LAS unsigned*)(lds + (bufoff) + ldsw + _i * 8192), 16, 0, 0); } while (0)
#define PG8_LDA(dst, b, h) do { _Pragma("unroll") for (int m = 0; m < 4; ++m) _Pragma("unroll") for (int k = 0; k < 2; ++k) dst[m][k] = *(const PG8_LAS bf16x8*)(lds + PG8_SA(b, h) + aoff + m * 2048 + k * 1024); } while (0)
#define PG8_LDB(dst, b, h) do { _Pragma("unroll") for (int n = 0; n < 2; ++n) _Pragma("unroll") for (int k = 0; k < 2; ++k) dst[n][k] = *(const PG8_LAS bf16x8*)(lds + PG8_SB(b, h) + boff + n * 2048 + k * 1024); } while (0)
#define PG8_MMA(ai, bj, At, Bt) do { __builtin_amdgcn_s_setprio(1); _Pragma("unroll") for (int m = 0; m < 4; ++m) _Pragma("unroll") for (int n = 0; n < 2; ++n) _Pragma("unroll") for (int k = 0; k < 2; ++k) \
        acc[ai][bj][m][n] = __builtin_amdgcn_mfma_f32_16x16x32_bf16(Bt[n][k], At[m][k], acc[ai][bj][m][n], 0, 0, 0); __builtin_amdgcn_s_setprio(0); } while (0)
#define PG8_WAIT_V(n) asm volatile("s_waitcnt vmcnt(" #n ")" ::: "memory")
#define PG8_WAIT_L(n) asm volatile("s_waitcnt lgkmcnt(" #n ")" ::: "memory")
#define PG8_BAR __builtin_amdgcn_s_barrier()
#define PG8_SCHED __builtin_amdgcn_sched_barrier(0)
    Unit cur, nxt; int ui = 0;
    if (!S.next(0, cur)) return;
    f32x4 acc[2][2][4][2];
#pragma unroll
    for (int a = 0; a < 2; ++a)
#pragma unroll
        for (int b = 0; b < 2; ++b)
#pragma unroll
            for (int m = 0; m < 4; ++m)
#pragma unroll
                for (int n = 0; n < 2; ++n) acc[a][b][m][n] = (f32x4){0.f, 0.f, 0.f, 0.f};
    bf16x8 At[4][2], B0[2][2], B1[2][2];
    const char* cA = g.abase(cur); const char* cB = g.bbase(cur);
    PG8_STAGE(PG8_SB(0, 0), cB, voffB); PG8_STAGE(PG8_SB(0, 1), cB + hstepB, voffB); PG8_STAGE(PG8_SA(0, 0), cA, voffA); PG8_STAGE(PG8_SA(0, 1), cA + hstepA, voffA);
    if (wr == 1) PG8_BAR;
    PG8_WAIT_V(2); PG8_BAR;
    PG8_STAGE(PG8_SB(1, 0), cB + kstepB, voffB); PG8_STAGE(PG8_SA(1, 0), cA + kstepA, voffA); PG8_STAGE(PG8_SB(1, 1), cB + hstepB + kstepB, voffB);
    PG8_WAIT_V(6); PG8_BAR;
    for (;;) {
        const bool has_next = S.next(ui + 1, nxt);
        const char* nA = has_next ? g.abase(nxt) : cA; const char* nB = has_next ? g.bbase(nxt) : cB;
        for (int t = 0; t < nt; t += 2) {
            const bool last = (t == nt - 2);
            const char* a1 = cA + (size_t)(t + 1) * kstepA;
            const char* a2 = last ? nA : cA + (size_t)(t + 2) * kstepA; const char* b2 = last ? nB : cB + (size_t)(t + 2) * kstepB;
            const char* a3 = a2 + kstepA; const char* b3 = b2 + kstepB;
            PG8_LDB(B0, 0, 0); PG8_LDB(B1, 0, 1); PG8_SCHED; PG8_LDA(At, 0, 0); PG8_STAGE(PG8_SA(1, 1), a1 + hstepA, voffA);
            PG8_WAIT_V(8); PG8_WAIT_L(0); PG8_BAR; PG8_MMA(0, 0, At, B0); PG8_MMA(0, 1, At, B1); PG8_BAR; PG8_SCHED;
            PG8_LDA(At, 0, 1); PG8_STAGE(PG8_SB(0, 0), b2, voffB); PG8_STAGE(PG8_SB(0, 1), b2 + hstepB, voffB); PG8_STAGE(PG8_SA(0, 0), a2, voffA);
            PG8_WAIT_V(8); PG8_WAIT_L(0); PG8_BAR; PG8_MMA(1, 0, At, B0); PG8_MMA(1, 1, At, B1); PG8_BAR; PG8_SCHED;
            PG8_LDB(B0, 1, 0); PG8_LDB(B1, 1, 1); PG8_SCHED; PG8_LDA(At, 1, 0); PG8_STAGE(PG8_SA(0, 1), a2 + hstepA, voffA);
            PG8_WAIT_V(8); PG8_WAIT_L(0); PG8_BAR; PG8_MMA(0, 0, At, B0); PG8_MMA(0, 1, At, B1); PG8_BAR; PG8_SCHED;
            PG8_LDA(At, 1, 1); PG8_STAGE(PG8_SB(1, 0), b3, voffB); PG8_STAGE(PG8_SB(1, 1), b3 + hstepB, voffB); PG8_STAGE(PG8_SA(1, 0), a3, voffA);
            PG8_WAIT_V(8); PG8_WAIT_L(0); PG8_BAR; PG8_MMA(1, 0, At, B0); PG8_MMA(1, 1, At, B1); PG8_BAR; PG8_SCHED;
        }
        if constexpr (ALIGN_EPI) { if (wr == 0) PG8_BAR; }
        if constexpr (!Epi::AFTER_DRAIN) { E(acc, cur, wr, wc, fr, fq); }
        if (!has_next) break;
#pragma unroll
        for (int a = 0; a < 2; ++a)
#pragma unroll
            for (int b = 0; b < 2; ++b)
#pragma unroll
                for (int m = 0; m < 4; ++m)
#pragma unroll
                    for (int n = 0; n < 2; ++n) acc[a][b][m][n] = (f32x4){0.f, 0.f, 0.f, 0.f};
        cur = nxt; cA = nA; cB = nB; ++ui;
        if constexpr (ALIGN_EPI) { if (wr == 1) PG8_BAR; }
    }
    PG8_WAIT_V(0);
    if constexpr (!ALIGN_EPI) { if (wr == 0) PG8_BAR; }
    PG8_BAR;
    if constexpr (Epi::AFTER_DRAIN) { E.fused(acc, cur, wr, wc, fr, fq, lds, wid, lane); PG8_WAIT_L(0); PG8_BAR; }
#undef PG8_SA
#undef PG8_SB
#undef PG8_STAGE
#undef PG8_LDA
#undef PG8_LDB
#undef PG8_MMA
#undef PG8_WAIT_V
#undef PG8_WAIT_L
#undef PG8_BAR
#undef PG8_SCHED
}
}

namespace attn_body {
using bf16 = bf16_t;
using bf16x8 = __attribute__((ext_vector_type(8))) short;
using s16x4 = __attribute__((ext_vector_type(4))) short;
using f32x16 = __attribute__((ext_vector_type(16))) float;
using u32x4 = __attribute__((ext_vector_type(4))) unsigned;
constexpr int SEQ = SEQL, D = 64, DMA = 1024;
constexpr int NW = 8, QBLK = 32, QB = QBLK * NW, KVBLK = 64, NQB = SEQ / QB;
__device__ __forceinline__ int crow(int r, int hi) { return (r & 3) + 8 * (r >> 2) + 4 * hi; }
#define SBAR() __builtin_amdgcn_sched_barrier(0)
__device__ __forceinline__ void cmask(f32x16& p0, f32x16& p1, int jb, int qrel, int hi) {
  const float NEG = -INFINITY; int kb = 64 * jb + 4 * hi;
  #pragma unroll
  for (int r = 0; r < 16; ++r) { int kv = kb + (r & 3) + 8 * (r >> 2); if (kv > qrel) p0[r] = NEG; if (kv + 32 > qrel) p1[r] = NEG; }
}
constexpr int NSLOT = 3, SLOTB = 8192;
constexpr int LDS_K = 0, LDS_V = NSLOT * SLOTB, LDS_WS = 2 * NSLOT * SLOTB, LDS_OST = LDS_WS + NW * 64 * 4, LDS_BYTES = LDS_OST + NW * 4096;
__device__ __forceinline__ void glds16(const void* gsrc, unsigned lds_dst) { unsigned keep;
  asm volatile("s_mov_b32 %0, m0\n\ts_mov_b32 m0, %2\n\ts_nop 0\n\tglobal_load_lds_dwordx4 %1, off\n\ts_mov_b32 m0, %0" : "=&s"(keep) : "v"(gsrc), "s"(lds_dst) : "memory"); }
__device__ __forceinline__ float max3f(float a, float b, float c) { float r; asm("v_max3_f32 %0, %1, %2, %3" : "=v"(r) : "v"(a), "v"(b), "v"(c)); return r; }
__device__ __forceinline__ float max2f(float a, float b) { float r; asm("v_max_f32_e32 %0, %1, %2" : "=v"(r) : "v"(a), "v"(b)); return r; }
__device__ __forceinline__ float fadd_s(float a, float b) { float r; asm("v_add_f32_e32 %0, %1, %2" : "=v"(r) : "v"(a), "v"(b)); return r; }
__device__ __forceinline__ float fsub_s(float a, float b) { float r; asm("v_sub_f32_e32 %0, %1, %2" : "=v"(r) : "v"(a), "v"(b)); return r; }
typedef float f32x2_t __attribute__((ext_vector_type(2))); typedef __bf16 bf16x2_t __attribute__((ext_vector_type(2)));
__device__ __forceinline__ unsigned cvtpk_s(float lo, float hi) { f32x2_t v = {lo, hi}; bf16x2_t b = __builtin_convertvector(v, bf16x2_t); return __builtin_bit_cast(unsigned, b); }
#define WAIT_BAR(N) asm volatile("s_waitcnt vmcnt(" #N ") lgkmcnt(0)\n\ts_barrier" ::: "memory")

__device__ __forceinline__ void qkt(f32x16& p0, f32x16& p1, const char* Kslot, const bf16x8* qr, const f32x16& negm, int r32, int hi) {
  const char* kb = Kslot + hi * 1024 + r32 * 16;
  #pragma unroll
  for (int d0 = 0; d0 < 4; ++d0) {
    const bf16x8 b0 = *reinterpret_cast<const bf16x8*>(kb + d0 * 2048);
    const bf16x8 b1 = *reinterpret_cast<const bf16x8*>(kb + d0 * 2048 + 512);
    if (d0 == 0) { p0 = __builtin_amdgcn_mfma_f32_32x32x16_bf16(b0, qr[0], negm, 0, 0, 0); p1 = __builtin_amdgcn_mfma_f32_32x32x16_bf16(b1, qr[0], negm, 0, 0, 0); }
    else { p0 = __builtin_amdgcn_mfma_f32_32x32x16_bf16(b0, qr[d0], p0, 0, 0, 0); p1 = __builtin_amdgcn_mfma_f32_32x32x16_bf16(b1, qr[d0], p1, 0, 0, 0); } }
}
typedef __attribute__((address_space(3))) const char* lds_cptr;
typedef short v4i16_t __attribute__((ext_vector_type(4)));
__device__ __forceinline__ void kload8(bf16x8* kf, lds_cptr kp) {
  kf[0] = *(const __attribute__((address_space(3))) bf16x8*)(kp);        kf[1] = *(const __attribute__((address_space(3))) bf16x8*)(kp + 512);
  kf[2] = *(const __attribute__((address_space(3))) bf16x8*)(kp + 2048); kf[3] = *(const __attribute__((address_space(3))) bf16x8*)(kp + 2560);
  kf[4] = *(const __attribute__((address_space(3))) bf16x8*)(kp + 4096); kf[5] = *(const __attribute__((address_space(3))) bf16x8*)(kp + 4608);
  kf[6] = *(const __attribute__((address_space(3))) bf16x8*)(kp + 6144); kf[7] = *(const __attribute__((address_space(3))) bf16x8*)(kp + 6656);
}
__device__ __forceinline__ void kload2(bf16x8* kf, lds_cptr kp, int j) { kf[2 * j] = *(const __attribute__((address_space(3))) bf16x8*)(kp + j * 2048); kf[2 * j + 1] = *(const __attribute__((address_space(3))) bf16x8*)(kp + j * 2048 + 512); }
__device__ __forceinline__ s16x4 vtr(lds_cptr p) { return __builtin_bit_cast(s16x4, __builtin_amdgcn_ds_read_tr16_b64_v4i16((__attribute__((address_space(3))) v4i16_t*)p)); }
__device__ __forceinline__ float rowmax(const f32x16& p0, const f32x16& p1) {
  float a = max3f(p0[0], p0[1], p1[0]), b = max3f(p0[2], p0[3], p1[1]); a = max3f(a, p1[2], p1[3]);
  #pragma unroll
  for (int r = 4; r < 16; r += 4) { a = max3f(a, p0[r], p0[r + 1]); b = max3f(b, p0[r + 2], p0[r + 3]); a = max3f(a, p1[r], p1[r + 1]); b = max3f(b, p1[r + 2], p1[r + 3]); }
  const float m = max2f(a, b);
  auto rr = __builtin_amdgcn_permlane32_swap(__float_as_uint(m), __float_as_uint(m), false, false);
  return max2f(__uint_as_float(rr[0]), __uint_as_float(rr[1]));
}
__device__ __forceinline__ void pv(f32x16* o, int vb, bf16x8 pa0, bf16x8 pa1, bf16x8 pa2, bf16x8 pa3) {
  #pragma unroll
  for (int d0 = 0; d0 < 2; ++d0) { s16x4 lo[4], hi[4];
    #pragma unroll
    for (int ks = 0; ks < 4; ++ks) {
      asm volatile("ds_read_b64_tr_b16 %0,%1 offset:%c2" : "=&v"(lo[ks]) : "v"(vb), "i"(d0 * 4096 + ks * 1024) : "memory");
      asm volatile("ds_read_b64_tr_b16 %0,%1 offset:%c2" : "=&v"(hi[ks]) : "v"(vb), "i"(d0 * 4096 + ks * 1024 + 512) : "memory"); }
    asm volatile("s_waitcnt lgkmcnt(0)" ::: "memory"); SBAR();
    #define PK(k) (bf16x8){lo[k][0], lo[k][1], lo[k][2], lo[k][3], hi[k][0], hi[k][1], hi[k][2], hi[k][3]}
    o[d0] = __builtin_amdgcn_mfma_f32_32x32x16_bf16(pa0, PK(0), o[d0], 0, 0, 0);
    o[d0] = __builtin_amdgcn_mfma_f32_32x32x16_bf16(pa1, PK(1), o[d0], 0, 0, 0);
    o[d0] = __builtin_amdgcn_mfma_f32_32x32x16_bf16(pa2, PK(2), o[d0], 0, 0, 0);
    o[d0] = __builtin_amdgcn_mfma_f32_32x32x16_bf16(pa3, PK(3), o[d0], 0, 0, 0);
    #undef PK
  }
}
#define ATTN_STORE16(p, v) (*(u32x4*)(p) = (v))
template <int THRL> __device__ __forceinline__ void attn_unit(int tid_in, int b, int hq, int hv, int qb, const bf16* Q, const bf16* __restrict__ K, const bf16* __restrict__ V, bf16* O, char* shm) {
  const int tid = tid_in, lane = tid & 63, r32 = lane & 31, hi = lane >> 5; const int wid = __builtin_amdgcn_readfirstlane(tid >> 6);
  const long rowbase = (long)b * SEQ; const int q0 = qb * QB;
  const bf16* Qw = Q + (rowbase + q0 + wid * QBLK) * DMA + hq * D;
  const bf16* Kh = K + rowbase * DMA + hq * D, *Vh = V + rowbase * DMA + hv * D;
  const unsigned lds0 = (unsigned)(uintptr_t)shm;
  float* wsf = (float*)(shm + LDS_WS) + wid * 64;
  const bf16* ksrc = Kh + (long)lane * DMA + wid * 8;
  const bf16* vsrc = Vh + (long)(16 * (wid & 3) + (lane >> 2)) * DMA + (wid >> 2) * 32 + (lane & 3) * 8;
  const unsigned kdst = lds0 + LDS_K + wid * 1024, vdst = lds0 + LDS_V + wid * 1024;
  #define DMA_K(t, slot) glds16(ksrc + (long)(t) * KVBLK * DMA, (unsigned)__builtin_amdgcn_readfirstlane(kdst + (slot)))
  #define DMA_V(t, slot) glds16(vsrc + (long)(t) * KVBLK * DMA, (unsigned)__builtin_amdgcn_readfirstlane(vdst + (slot)))
  const int vb0 = (int)(lds0 + LDS_V) + ((lane >> 4) & 1) * 32 + (lane & 3) * 8 + (4 * hi + ((lane & 15) >> 2)) * 64;
  const char* Kbase = shm + LDS_K; bf16x8 kf[8];
  const lds_cptr shm3 = (lds_cptr)shm; const lds_cptr kp0 = shm3 + LDS_K + hi * 1024 + r32 * 16; const lds_cptr vp0 = shm3 + LDS_V + ((lane >> 4) & 1) * 32 + (lane & 3) * 8 + (4 * hi + ((lane & 15) >> 2)) * 64;
  const int NT = (q0 + QB) / KVBLK;
  DMA_K(0, 0); DMA_V(0, 0); DMA_K(1, SLOTB);
  bf16x8 qr[4];
  #pragma unroll
  for (int d0 = 0; d0 < 4; ++d0) qr[d0] = *reinterpret_cast<const bf16x8*>(&Qw[(long)r32 * DMA + d0 * 16 + hi * 8]);
  float mhat = 0.f, l_reg = 0.f; f32x16 o[2]; o[0] = f32x16{}; o[1] = f32x16{}; f32x16 negm = f32x16{}; asm volatile("" : "+v"(negm));
  const int qrel = wid * QBLK + r32;
  #define CMASK(P0, P1, t) do { int jb_ = (t) - (NT - 4); if (jb_ >= 0) cmask(P0, P1, jb_, qrel, hi); } while (0)
  bool resc = false;
  #define START(P0, P1) do { const float rm = rowmax(P0, P1); resc = false; \
    { const float dl = rm; mhat = fadd_s(mhat, dl); \
      _Pragma("unroll") for (int r = 0; r < 16; ++r) { P0[r] = fsub_s(P0[r], dl); P1[r] = fsub_s(P1[r], dl); } \
      _Pragma("unroll") for (int r = 0; r < 16; ++r) negm[r] = -mhat; asm volatile("" : "+v"(negm)); } \
    _Pragma("unroll") for (int r = 0; r < 16; ++r) P0[r] = __builtin_amdgcn_exp2f(P0[r]); } while (0)
  #define RESC() do { if (resc) { asm volatile("s_waitcnt lgkmcnt(0)" ::: "memory"); \
      _Pragma("unroll") for (int d_ = 0; d_ < 2; ++d_) _Pragma("unroll") for (int r = 0; r < 16; ++r) o[d_][r] *= wsf[crow(r, hi)]; } } while (0)
  f32x16 pA0, pA1, pB0, pB1;
  int sl_prev = 0, sl_cur = 0, sl_next = SLOTB;
  #define ROT() do { sl_prev = sl_cur; sl_cur = sl_next; sl_next = (sl_next == (NSLOT - 1) * SLOTB) ? 0 : sl_next + SLOTB; } while (0)
  DMA_K(2, 2 * SLOTB);
  WAIT_BAR(3);
  qkt(pA0, pA1, Kbase, qr, negm, r32, hi); asm volatile("s_nop 15\n\ts_nop 7" : "+v"(pA0), "+v"(pA1)); CMASK(pA0, pA1, 0);
  START(pA0, pA1);
  _Pragma("unroll") for (int r = 0; r < 16; ++r) pA1[r] = __builtin_amdgcn_exp2f(pA1[r]);
  WAIT_BAR(0);
  DMA_K(3, 0); DMA_V(1, SLOTB);
  ROT();
  kload8(kf, kp0 + sl_cur);
  WAIT_BAR(2);
  s16x4 vlo[8], vhi[8]; u32x4 pw0, pw1, pw2, pw3;
  #define PKW(P, B) cvtpk_s(P[B], P[B + 1])
  #define PAF(k) __builtin_bit_cast(bf16x8, pw##k)
  #define VFR(i) (bf16x8){vlo[i][0], vlo[i][1], vlo[i][2], vlo[i][3], vhi[i][0], vhi[i][1], vhi[i][2], vhi[i][3]}
  #define PIN(x) asm volatile("" : "+v"(x))
  #define MX3(a, b, c) __builtin_fmaxf(__builtin_fmaxf((a), (b)), (c))
  #define GAPA(MF, A0, A1, A2, A3, W0, W1, PW) do { MF; sacc += A0; sacc += A1; sacc += A2; sacc += A3; PIN(sacc); W0; W1; PIN(PW); SBAR(); } while (0)
  #define EX(v) __builtin_amdgcn_exp2f(v)
  #define GAPB(MF, X, B) do { MF; X[B] = EX(X[B]); X[B + 1] = EX(X[B + 1]); X[B + 2] = EX(X[B + 2]); X[B + 3] = EX(X[B + 3]); PIN(X); SBAR(); } while (0)
  #define VRD(i) do { vlo[i] = vtr(vp_ + (((i) >> 2) * 4096 + ((i) & 3) * 1024)); vhi[i] = vtr(vp_ + (((i) >> 2) * 4096 + ((i) & 3) * 1024 + 512)); } while (0)
  #define KRD(G, j) do { if (G) { kload2(kf, kp0 + sl_next, j); SBAR(); } } while (0)
  #define STEP(C0, C1, P0, P1, t, GK, GV, GL) do { SBAR(); \
    const lds_cptr vp_ = vp0 + sl_prev; \
    VRD(0); SBAR(); float sacc = (P0[0] + P0[1]); \
    GAPA(C0 = __builtin_amdgcn_mfma_f32_32x32x16_bf16(kf[0], qr[0], negm, 0, 0, 0), P0[2], P0[3], P0[4], P0[5],     pw0[0] = PKW(P0, 0), pw0[1] = PKW(P0, 2), pw0); \
    VRD(4); SBAR(); GAPA(C1 = __builtin_amdgcn_mfma_f32_32x32x16_bf16(kf[1], qr[0], negm, 0, 0, 0), P0[6], P0[7], P0[8], P0[9],     pw0[2] = PKW(P0, 4), pw0[3] = PKW(P0, 6), pw0); \
    VRD(1); SBAR(); GAPA(C0 = __builtin_amdgcn_mfma_f32_32x32x16_bf16(kf[2], qr[1], C0, 0, 0, 0),   P0[10], P0[11], P0[12], P0[13], pw1[0] = PKW(P0, 8), pw1[1] = PKW(P0, 10), pw1); \
    VRD(5); SBAR(); GAPA(C1 = __builtin_amdgcn_mfma_f32_32x32x16_bf16(kf[3], qr[1], C1, 0, 0, 0),   P0[14], P0[15], P1[0], P1[1],   pw1[2] = PKW(P0, 12), pw1[3] = PKW(P0, 14), pw1); \
    VRD(2); SBAR(); GAPA(C0 = __builtin_amdgcn_mfma_f32_32x32x16_bf16(kf[4], qr[2], C0, 0, 0, 0),   P1[2], P1[3], P1[4], P1[5],     pw2[0] = PKW(P1, 0), pw2[1] = PKW(P1, 2), pw2); \
    VRD(6); SBAR(); GAPA(C1 = __builtin_amdgcn_mfma_f32_32x32x16_bf16(kf[5], qr[2], C1, 0, 0, 0),   P1[6], P1[7], P1[8], P1[9],     pw2[2] = PKW(P1, 4), pw2[3] = PKW(P1, 6), pw2); \
    VRD(3); SBAR(); GAPA(C0 = __builtin_amdgcn_mfma_f32_32x32x16_bf16(kf[6], qr[3], C0, 0, 0, 0),   P1[10], P1[11], P1[12], P1[13], pw3[0] = PKW(P1, 8), pw3[1] = PKW(P1, 10), pw3); \
    VRD(7); SBAR(); GAPA(C1 = __builtin_amdgcn_mfma_f32_32x32x16_bf16(kf[7], qr[3], C1, 0, 0, 0),   P1[14], P1[15], 0.f, 0.f,       pw3[2] = PKW(P1, 12), pw3[3] = PKW(P1, 14), pw3); \
    l_reg += sacc; \
    if (GK) { DMA_K((t) + 3, sl_cur); } if (GV) { DMA_V((t) + 1, sl_next); } \
    CMASK(C0, C1, t); \
    { float a = MX3(C0[0], C0[1], C1[0]), b = MX3(C0[2], C0[3], C1[1]); a = MX3(a, C1[2], C1[3]); \
      _Pragma("unroll") for (int r = 4; r < 16; r += 4) { a = MX3(a, C0[r], C0[r + 1]); b = MX3(b, C0[r + 2], C0[r + 3]); a = MX3(a, C1[r], C1[r + 1]); b = MX3(b, C1[r + 2], C1[r + 3]); } \
      float rm = __builtin_fmaxf(a, b); { auto rr = __builtin_amdgcn_permlane32_swap(__float_as_uint(rm), __float_as_uint(rm), false, false); rm = __builtin_fmaxf(__uint_as_float(rr[0]), __uint_as_float(rr[1])); } \
      resc = false; \
      if (__builtin_expect(__any(rm > (float)THRL), 0)) { const float dl = __builtin_fmaxf(rm, 0.f); mhat += dl; \
        _Pragma("unroll") for (int r = 0; r < 16; ++r) { C0[r] -= dl; C1[r] -= dl; } \
        _Pragma("unroll") for (int r = 0; r < 16; ++r) negm[r] = -mhat; asm volatile("" : "+v"(negm)); \
        const float f = __builtin_amdgcn_exp2f(-dl); l_reg *= f; if (hi == 0) wsf[r32] = f; resc = true; } } \
    SBAR(); \
    GAPB(o[0] = __builtin_amdgcn_mfma_f32_32x32x16_bf16(PAF(0), VFR(0), o[0], 0, 0, 0), C0, 0); \
    GAPB(o[1] = __builtin_amdgcn_mfma_f32_32x32x16_bf16(PAF(0), VFR(4), o[1], 0, 0, 0), C0, 4); \
    KRD(GL, 0); GAPB(o[0] = __builtin_amdgcn_mfma_f32_32x32x16_bf16(PAF(1), VFR(1), o[0], 0, 0, 0), C0, 8); \
    KRD(GL, 1); GAPB(o[1] = __builtin_amdgcn_mfma_f32_32x32x16_bf16(PAF(1), VFR(5), o[1], 0, 0, 0), C0, 12); \
    KRD(GL, 2); GAPB(o[0] = __builtin_amdgcn_mfma_f32_32x32x16_bf16(PAF(2), VFR(2), o[0], 0, 0, 0), C1, 0); \
    KRD(GL, 3); GAPB(o[1] = __builtin_amdgcn_mfma_f32_32x32x16_bf16(PAF(2), VFR(6), o[1], 0, 0, 0), C1, 4); \
    GAPB(o[0] = __builtin_amdgcn_mfma_f32_32x32x16_bf16(PAF(3), VFR(3), o[0], 0, 0, 0), C1, 8); \
    GAPB(o[1] = __builtin_amdgcn_mfma_f32_32x32x16_bf16(PAF(3), VFR(7), o[1], 0, 0, 0), C1, 12); \
    } while (0)
  int t = 1;
  #undef CMASK
  #define CMASK(P0, P1, t) do {} while (0)
  for (; t + 5 < NT; t += 2) {
    STEP(pB0, pB1, pA0, pA1, t, true, true, true);     WAIT_BAR(2); RESC(); ROT();
    STEP(pA0, pA1, pB0, pB1, t + 1, true, true, true); WAIT_BAR(2); RESC(); ROT();
  }
  #undef CMASK
  #define CMASK(P0, P1, t) do { int jb_ = (t) - (NT - 4); if (jb_ >= 0) cmask(P0, P1, jb_, qrel, hi); } while (0)
  #define ENDW(tt) do { if ((tt) + 3 < NT) { WAIT_BAR(2); } else if ((tt) + 2 < NT) { WAIT_BAR(1); } else { WAIT_BAR(0); } } while (0)
  for (; t + 1 < NT; t += 2) {
    STEP(pB0, pB1, pA0, pA1, t, (t + 3 < NT), (t + 1 < NT), (t + 1 < NT));         ENDW(t);     RESC(); ROT();
    STEP(pA0, pA1, pB0, pB1, t + 1, (t + 4 < NT), (t + 2 < NT), (t + 2 < NT));     ENDW(t + 1); RESC(); ROT();
  }
  STEP(pB0, pB1, pA0, pA1, NT - 1, false, false, false); RESC();
  { float sacc = pB0[0] + pB0[1]; _Pragma("unroll") for (int r = 2; r < 16; ++r) sacc += pB0[r]; _Pragma("unroll") for (int r = 0; r < 16; ++r) sacc += pB1[r]; l_reg += sacc;
    pw0 = (u32x4){PKW(pB0, 0), PKW(pB0, 2), PKW(pB0, 4), PKW(pB0, 6)}; pw1 = (u32x4){PKW(pB0, 8), PKW(pB0, 10), PKW(pB0, 12), PKW(pB0, 14)}; pw2 = (u32x4){PKW(pB1, 0), PKW(pB1, 2), PKW(pB1, 4), PKW(pB1, 6)}; pw3 = (u32x4){PKW(pB1, 8), PKW(pB1, 10), PKW(pB1, 12), PKW(pB1, 14)};
    SBAR(); pv(o, vb0 + sl_cur, PAF(0), PAF(1), PAF(2), PAF(3)); }
  #undef PKW
  #undef PAF
  #undef VFR
  #undef PIN
  #undef MX3
  #undef GAPA
  #undef GAPB
  #undef EX
  #undef VRD
  #undef KRD
  #undef STEP
  #undef ENDW
  { auto rr = __builtin_amdgcn_permlane32_swap(__float_as_uint(l_reg), __float_as_uint(l_reg), false, false); l_reg = __uint_as_float(rr[0]) + __uint_as_float(rr[1]); }
  if (hi == 0) wsf[32 + r32] = l_reg; asm volatile("s_waitcnt lgkmcnt(0)" ::: "memory");
  float rli[16];
  #pragma unroll
  for (int r = 0; r < 16; ++r) rli[r] = __builtin_amdgcn_rcpf(wsf[32 + crow(r, hi)]);
  bf16* Ow = O + (rowbase + q0 + wid * QBLK) * DMA + hv * D;
  { bf16* stg = (bf16*)(shm + LDS_OST) + wid * 2048;
    #pragma unroll
    for (int r = 0; r < 16; ++r) { const int orow = crow(r, hi);
      #pragma unroll
      for (int d0 = 0; d0 < 2; ++d0) stg[orow * 64 + d0 * 32 + r32] = f2bf(o[d0][r] * rli[r]); }
    asm volatile("s_waitcnt lgkmcnt(0)" ::: "memory");
    #pragma unroll
    for (int i = 0; i < 4; ++i) { const int row = i * 8 + (lane >> 3), ch = lane & 7; const u32x4 v = *(const u32x4*)(stg + row * 64 + ch * 8); ATTN_STORE16(Ow + (long)row * DMA + ch * 8, v); } }
  asm volatile("s_waitcnt lgkmcnt(0)\n\ts_barrier" ::: "memory");
  #undef DMA_K
  #undef DMA_V
  #undef CMASK
  #undef START
  #undef RESC
  #undef ROT
}
constexpr int ATTN_LDS_BYTES = LDS_BYTES;
#undef SBAR
#undef WAIT_BAR
}

namespace attn3 {
using namespace attn_body;
constexpr int KSLOT = 8192, VSLOT = 16384;
constexpr int L_K = 0, L_V = NSLOT * KSLOT, L_WS = L_V + NSLOT * VSLOT, L_OST = L_WS + NW * 64 * 4, L_BYTES = L_OST + NW * 4096;
#define SBAR() __builtin_amdgcn_sched_barrier(0)
#define WAIT_BAR(N) asm volatile("s_waitcnt vmcnt(" #N ") lgkmcnt(0)\n\ts_barrier" ::: "memory")
template <int THRL> __device__ __forceinline__ void attn_unit(int tid_in, int b, int hq, int h, int qb, const bf16* Q, const bf16* __restrict__ K, const bf16* __restrict__ V, bf16* O, char* shm,
                                                             int mode, const bf16* SZ1, const float* g_sub, float lam, bf16* OG,
                                                             bool primed, bool has_next, int nb, int nhq, int nh, int nqb, bf16x8 (&qr)[4]) {
  int tid_ = tid_in; asm volatile("" : "+v"(tid_));
  const int tid = tid_, lane = tid & 63, r32 = lane & 31, hi = lane >> 5; const int wid = __builtin_amdgcn_readfirstlane(tid >> 6);
  const long rowbase = (long)b * SEQ; const int q0 = qb * QB;
  const bf16* Qw = Q + (rowbase + q0 + wid * QBLK) * DMA + hq * D;
  const bf16* Kh = K + rowbase * DMA + hq * D, *Vh = V + rowbase * DMA + h * 128;
  const unsigned lds0 = (unsigned)(uintptr_t)shm;
  float* wsf = (float*)(shm + L_WS) + wid * 64;
  const bf16* ksrc = Kh + (long)lane * DMA + wid * 8;
  const bf16* vsrc = Vh + (long)(16 * (wid & 3) + (lane >> 2)) * DMA + (wid >> 2) * 32 + (lane & 3) * 8;
  const unsigned kdst = lds0 + L_K + wid * 1024, vdst = lds0 + L_V + wid * 1024;
  #define DMA_K(t, si) glds16(ksrc + (long)(t) * KVBLK * DMA, (unsigned)__builtin_amdgcn_readfirstlane(kdst + (si) * KSLOT))
  #define DMA_V(t, si) do { glds16(vsrc + (long)(t) * KVBLK * DMA, (unsigned)__builtin_amdgcn_readfirstlane(vdst + (si) * VSLOT)); \
                            glds16(vsrc + (long)(t) * KVBLK * DMA + 64, (unsigned)__builtin_amdgcn_readfirstlane(vdst + (si) * VSLOT + 8192)); } while (0)
  const int vb0 = (int)(lds0 + L_V) + ((lane >> 4) & 1) * 32 + (lane & 3) * 8 + (4 * hi + ((lane & 15) >> 2)) * 64;
  const char* Kbase = shm + L_K; bf16x8 kf[8];
  const lds_cptr shm3 = (lds_cptr)shm; const lds_cptr kp0 = shm3 + L_K + hi * 1024 + r32 * 16; const lds_cptr vp0 = shm3 + L_V + ((lane >> 4) & 1) * 32 + (lane & 3) * 8 + (4 * hi + ((lane & 15) >> 2)) * 64;
  const int NT = (q0 + QB) / KVBLK;
  if (!primed) { DMA_K(0, 0); DMA_V(0, 0); DMA_K(1, 1);
    #pragma unroll
    for (int d0 = 0; d0 < 4; ++d0) qr[d0] = *reinterpret_cast<const bf16x8*>(&Qw[(long)r32 * DMA + d0 * 16 + hi * 8]); }
  float mhat = 0.f, l_reg = 0.f; f32x16 o[4]; f32x16 negm;
  { float zf = 0.f; asm volatile("" : "+v"(zf));
    _Pragma("unroll") for (int r = 0; r < 16; ++r) { o[0][r] = zf; o[1][r] = zf; o[2][r] = zf; o[3][r] = zf; negm[r] = zf; } }
  asm volatile("" : "+v"(negm));
  const int qrel = wid * QBLK + r32;
  #define CMASK(P0, P1, t) do { int jb_ = (t) - (NT - 4); if (jb_ >= 0) cmask(P0, P1, jb_, qrel, hi); } while (0)
  bool resc = false;
  #define RESC() do { if (resc) { asm volatile("s_waitcnt lgkmcnt(0)" ::: "memory"); \
      _Pragma("unroll") for (int d_ = 0; d_ < 4; ++d_) _Pragma("unroll") for (int r = 0; r < 16; ++r) o[d_][r] *= wsf[crow(r, hi)]; } } while (0)
  f32x16 C0, C1;
  int s_prev = 0, s_cur = 0, s_next = 1;
  #define ROT() do { s_prev = s_cur; s_cur = s_next; s_next = (s_next == NSLOT - 1) ? 0 : s_next + 1; } while (0)
  if (!primed) { DMA_K(2, 2); WAIT_BAR(4); }
  else { WAIT_BAR(0); }
  u32x4 pwA0, pwA1, pwA2, pwA3, pwB0, pwB1, pwB2, pwB3;
  #define PKW(P, B) cvtpk_s(P[B], P[B + 1])
  qkt(C0, C1, Kbase, qr, negm, r32, hi); asm volatile("s_nop 15\n\ts_nop 7" : "+v"(C0), "+v"(C1)); CMASK(C0, C1, 0);
  { const float rm = rowmax(C0, C1); mhat = fadd_s(mhat, rm);
    _Pragma("unroll") for (int r = 0; r < 16; ++r) { C0[r] = fsub_s(C0[r], rm); C1[r] = fsub_s(C1[r], rm); }
    _Pragma("unroll") for (int r = 0; r < 16; ++r) negm[r] = -mhat; asm volatile("" : "+v"(negm));
    float sacc = 0.f;
    _Pragma("unroll") for (int r = 0; r < 16; ++r) { C0[r] = __builtin_amdgcn_exp2f(C0[r]); C1[r] = __builtin_amdgcn_exp2f(C1[r]); }
    _Pragma("unroll") for (int r = 0; r < 16; ++r) sacc += C0[r] + C1[r];
    l_reg = sacc;
    pwA0 = (u32x4){PKW(C0, 0), PKW(C0, 2), PKW(C0, 4), PKW(C0, 6)}; pwA1 = (u32x4){PKW(C0, 8), PKW(C0, 10), PKW(C0, 12), PKW(C0, 14)};
    pwA2 = (u32x4){PKW(C1, 0), PKW(C1, 2), PKW(C1, 4), PKW(C1, 6)}; pwA3 = (u32x4){PKW(C1, 8), PKW(C1, 10), PKW(C1, 12), PKW(C1, 14)}; }
  WAIT_BAR(0);
  DMA_K(3, 0); DMA_V(1, 1);
  ROT();
  kload8(kf, kp0 + s_cur * KSLOT);
  WAIT_BAR(3);
  s16x4 vlo[8], vhi[8];
  #define PAF(w) __builtin_bit_cast(bf16x8, w)
  #define VFR(i) (bf16x8){vlo[i][0], vlo[i][1], vlo[i][2], vlo[i][3], vhi[i][0], vhi[i][1], vhi[i][2], vhi[i][3]}
  #define PIN(x) asm volatile("" : "+v"(x))
  #define MX3(a, b, c) __builtin_fmaxf(__builtin_fmaxf((a), (b)), (c))
  #define EX(v) __builtin_amdgcn_exp2f(v)
  #define VRD(s, f) do { vlo[s] = vtr(vp_ + (((f) >> 2) * 4096 + ((f) & 3) * 1024)); vhi[s] = vtr(vp_ + (((f) >> 2) * 4096 + ((f) & 3) * 1024 + 512)); } while (0)
  #define KRD(G, j) do { if (G) { kload2(kf, kp0 + s_next * KSLOT, j); SBAR(); } } while (0)
  #define GAPB(MF, X, B, PWW) do { MF; X[B] = EX(X[B]); X[B + 1] = EX(X[B + 1]); sacc += X[B]; sacc += X[B + 1]; PIN(sacc); PWW = PKW(X, B); PIN(PWW); SBAR(); } while (0)
  #define MFQ(a, b, c) __builtin_amdgcn_mfma_f32_32x32x16_bf16(a, b, c, 0, 0, 0)
  #define STEP(PP0, PP1, PP2, PP3, PN0, PN1, PN2, PN3, t, GK, GV, GL) do { SBAR(); \
    const lds_cptr vp_ = vp0 + s_prev * VSLOT; \
    VRD(0, 0); SBAR(); C0 = MFQ(kf[0], qr[0], negm); SBAR(); \
    VRD(4, 4); SBAR(); C1 = MFQ(kf[1], qr[0], negm); SBAR(); \
    VRD(1, 1); SBAR(); C0 = MFQ(kf[2], qr[1], C0); SBAR(); \
    VRD(5, 5); SBAR(); C1 = MFQ(kf[3], qr[1], C1); SBAR(); \
    VRD(2, 2); SBAR(); C0 = MFQ(kf[4], qr[2], C0); SBAR(); \
    VRD(6, 6); SBAR(); C1 = MFQ(kf[5], qr[2], C1); SBAR(); \
    VRD(3, 3); SBAR(); C0 = MFQ(kf[6], qr[3], C0); SBAR(); \
    VRD(7, 7); SBAR(); C1 = MFQ(kf[7], qr[3], C1); SBAR(); \
    if (GK) { DMA_K((t) + 3, s_cur); } if (GV) { DMA_V((t) + 1, s_next); } \
    CMASK(C0, C1, t); \
    { float a = MX3(C0[0], C0[1], C1[0]), b = MX3(C0[2], C0[3], C1[1]); a = MX3(a, C1[2], C1[3]); \
      _Pragma("unroll") for (int r = 4; r < 16; r += 4) { a = MX3(a, C0[r], C0[r + 1]); b = MX3(b, C0[r + 2], C0[r + 3]); a = MX3(a, C1[r], C1[r + 1]); b = MX3(b, C1[r + 2], C1[r + 3]); } \
      float rm = __builtin_fmaxf(a, b); { auto rr = __builtin_amdgcn_permlane32_swap(__float_as_uint(rm), __float_as_uint(rm), false, false); rm = __builtin_fmaxf(__uint_as_float(rr[0]), __uint_as_float(rr[1])); } \
      resc = false; \
      if (__builtin_expect(__any(rm > (float)THRL), 0)) { const float dl = __builtin_fmaxf(rm, 0.f); mhat += dl; \
        _Pragma("unroll") for (int r = 0; r < 16; ++r) { C0[r] -= dl; C1[r] -= dl; } \
        _Pragma("unroll") for (int r = 0; r < 16; ++r) negm[r] = -mhat; asm volatile("" : "+v"(negm)); \
        const float f = __builtin_amdgcn_exp2f(-dl); l_reg *= f; if (hi == 0) wsf[r32] = f; resc = true; } } \
    SBAR(); float sacc = 0.f; \
    GAPB(o[0] = MFQ(PAF(PP0), VFR(0), o[0]), C0, 0,  PN0[0]); VRD(0, 8);  SBAR(); \
    GAPB(o[1] = MFQ(PAF(PP0), VFR(4), o[1]), C0, 2,  PN0[1]); VRD(4, 12); SBAR(); \
    GAPB(o[0] = MFQ(PAF(PP1), VFR(1), o[0]), C0, 4,  PN0[2]); VRD(1, 9);  SBAR(); \
    GAPB(o[1] = MFQ(PAF(PP1), VFR(5), o[1]), C0, 6,  PN0[3]); VRD(5, 13); SBAR(); \
    GAPB(o[0] = MFQ(PAF(PP2), VFR(2), o[0]), C0, 8,  PN1[0]); VRD(2, 10); SBAR(); \
    GAPB(o[1] = MFQ(PAF(PP2), VFR(6), o[1]), C0, 10, PN1[1]); VRD(6, 14); SBAR(); \
    GAPB(o[0] = MFQ(PAF(PP3), VFR(3), o[0]), C0, 12, PN1[2]); VRD(3, 11); SBAR(); \
    GAPB(o[1] = MFQ(PAF(PP3), VFR(7), o[1]), C0, 14, PN1[3]); VRD(7, 15); SBAR(); \
    GAPB(o[2] = MFQ(PAF(PP0), VFR(0), o[2]), C1, 0,  PN2[0]); \
    GAPB(o[3] = MFQ(PAF(PP0), VFR(4), o[3]), C1, 2,  PN2[1]); \
    KRD(GL, 0); GAPB(o[2] = MFQ(PAF(PP1), VFR(1), o[2]), C1, 4,  PN2[2]); \
    KRD(GL, 1); GAPB(o[3] = MFQ(PAF(PP1), VFR(5), o[3]), C1, 6,  PN2[3]); \
    KRD(GL, 2); GAPB(o[2] = MFQ(PAF(PP2), VFR(2), o[2]), C1, 8,  PN3[0]); \
    KRD(GL, 3); GAPB(o[3] = MFQ(PAF(PP2), VFR(6), o[3]), C1, 10, PN3[1]); \
    GAPB(o[2] = MFQ(PAF(PP3), VFR(3), o[2]), C1, 12, PN3[2]); \
    GAPB(o[3] = MFQ(PAF(PP3), VFR(7), o[3]), C1, 14, PN3[3]); \
    l_reg += sacc; \
    } while (0)
  #define STEP_AB(t, GK, GV, GL) STEP(pwA0, pwA1, pwA2, pwA3, pwB0, pwB1, pwB2, pwB3, t, GK, GV, GL)
  #define STEP_BA(t, GK, GV, GL) STEP(pwB0, pwB1, pwB2, pwB3, pwA0, pwA1, pwA2, pwA3, t, GK, GV, GL)
  int t = 1;
  #undef CMASK
  #define CMASK(P0, P1, t) do {} while (0)
  for (; t + 5 < NT; t += 2) {
    STEP_AB(t, true, true, true);     WAIT_BAR(3); RESC(); ROT();
    STEP_BA(t + 1, true, true, true); WAIT_BAR(3); RESC(); ROT();
  }
  #undef CMASK
  #define CMASK(P0, P1, t) do { int jb_ = (t) - (NT - 4); if (jb_ >= 0) cmask(P0, P1, jb_, qrel, hi); } while (0)
  #define ENDW(tt) do { if ((tt) + 3 < NT) { WAIT_BAR(3); } else if ((tt) + 2 < NT) { WAIT_BAR(2); } else { WAIT_BAR(0); } } while (0)
  for (; t + 1 < NT; t += 2) {
    STEP_AB(t, (t + 3 < NT), (t + 1 < NT), (t + 1 < NT));         ENDW(t);     RESC(); ROT();
    STEP_BA(t + 1, (t + 4 < NT), (t + 2 < NT), (t + 2 < NT));     ENDW(t + 1); RESC(); ROT();
  }
  STEP_AB(NT - 1, false, false, false); RESC();
  { SBAR();
    const int vb = vb0 + s_cur * VSLOT;
    #pragma unroll
    for (int d0 = 0; d0 < 4; ++d0) { s16x4 lo[4], hh[4];
      #pragma unroll
      for (int ks = 0; ks < 4; ++ks) {
        asm volatile("ds_read_b64_tr_b16 %0,%1 offset:%c2" : "=&v"(lo[ks]) : "v"(vb), "i"(d0 * 4096 + ks * 1024) : "memory");
        asm volatile("ds_read_b64_tr_b16 %0,%1 offset:%c2" : "=&v"(hh[ks]) : "v"(vb), "i"(d0 * 4096 + ks * 1024 + 512) : "memory"); }
      asm volatile("s_waitcnt lgkmcnt(0)" ::: "memory"); SBAR();
      #define PK(k) (bf16x8){lo[k][0], lo[k][1], lo[k][2], lo[k][3], hh[k][0], hh[k][1], hh[k][2], hh[k][3]}
      o[d0] = MFQ(PAF(pwB0), PK(0), o[d0]); o[d0] = MFQ(PAF(pwB1), PK(1), o[d0]); o[d0] = MFQ(PAF(pwB2), PK(2), o[d0]); o[d0] = MFQ(PAF(pwB3), PK(3), o[d0]);
      #undef PK
    } }
  asm volatile("s_waitcnt lgkmcnt(0)\n\ts_barrier" ::: "memory");
  if (has_next) {
    const long nrow = (long)nb * SEQ; const int nq0 = nqb * QB;
    const bf16* nQw = Q + (nrow + nq0 + wid * QBLK) * DMA + nhq * D;
    const bf16* nks = K + nrow * DMA + nhq * D + (long)lane * DMA + wid * 8;
    const bf16* nvs = V + nrow * DMA + nh * 128 + (long)(16 * (wid & 3) + (lane >> 2)) * DMA + (wid >> 2) * 32 + (lane & 3) * 8;
    glds16(nks, (unsigned)__builtin_amdgcn_readfirstlane(kdst));
    glds16(nvs, (unsigned)__builtin_amdgcn_readfirstlane(vdst)); glds16(nvs + 64, (unsigned)__builtin_amdgcn_readfirstlane(vdst + 8192));
    glds16(nks + (long)KVBLK * DMA, (unsigned)__builtin_amdgcn_readfirstlane(kdst + KSLOT));
    glds16(nks + (long)2 * KVBLK * DMA, (unsigned)__builtin_amdgcn_readfirstlane(kdst + 2 * KSLOT));
    #pragma unroll
    for (int d0 = 0; d0 < 4; ++d0) qr[d0] = *reinterpret_cast<const bf16x8*>(&nQw[(long)r32 * DMA + d0 * 16 + hi * 8]);
  }
  { auto rr = __builtin_amdgcn_permlane32_swap(__float_as_uint(l_reg), __float_as_uint(l_reg), false, false); l_reg = __uint_as_float(rr[0]) + __uint_as_float(rr[1]); }
  if (hi == 0) wsf[32 + r32] = l_reg; asm volatile("s_waitcnt lgkmcnt(0)" ::: "memory");
  float rli[16];
  #pragma unroll
  for (int r = 0; r < 16; ++r) rli[r] = __builtin_amdgcn_rcpf(wsf[32 + crow(r, hi)]);
  int lane_e = lane; asm volatile("" : "+v"(lane_e));
  const int erow = lane_e >> 3, ech = lane_e & 7;
  bf16* Ow = O + (rowbase + q0 + wid * QBLK) * DMA + h * 128;
  bf16* stg = (bf16*)(shm + L_OST) + wid * 2048;
  if (mode == 0) {
    #pragma unroll
    for (int ps = 0; ps < 2; ++ps) {
      #pragma unroll
      for (int r = 0; r < 16; ++r) { const int orow = crow(r, hi);
        #pragma unroll
        for (int d0 = 0; d0 < 2; ++d0) stg[orow * 64 + d0 * 32 + r32] = f2bf(o[2 * ps + d0][r] * rli[r]); }
      asm volatile("s_waitcnt lgkmcnt(0)" ::: "memory");
      #pragma unroll
      for (int i = 0; i < 4; ++i) { const int row = i * 8 + erow, ch = ech; const u32x4 v = *(const u32x4*)(stg + row * 64 + ch * 8); *(u32x4*)(Ow + (long)row * DMA + ps * 64 + ch * 8) = v; }
      asm volatile("s_waitcnt lgkmcnt(0)" ::: "memory");
    }
    asm volatile("s_waitcnt vmcnt(0)" ::: "memory");
  } else {
    const bf16* Zw = SZ1 + (rowbase + q0 + wid * QBLK) * DMA + h * 128; bf16* Gw = OG + (rowbase + q0 + wid * QBLK) * DMA + h * 128;
    float dk[2][4][8]; float ss[4] = {0.f, 0.f, 0.f, 0.f};
    #pragma unroll
    for (int ps = 0; ps < 2; ++ps) {
      #pragma unroll
      for (int r = 0; r < 16; ++r) { const int orow = crow(r, hi);
        #pragma unroll
        for (int d0 = 0; d0 < 2; ++d0) stg[orow * 64 + d0 * 32 + r32] = f2bf(o[2 * ps + d0][r] * rli[r]); }
      asm volatile("s_waitcnt lgkmcnt(0)" ::: "memory");
      #pragma unroll
      for (int i = 0; i < 4; ++i) { const int row = i * 8 + erow, ch = ech;
        const u32x4 v1 = *(const u32x4*)(stg + row * 64 + ch * 8); const u32x4 v0 = *(const u32x4*)(Ow + (long)row * DMA + ps * 64 + ch * 8);
        #pragma unroll
        for (int j = 0; j < 4; ++j) { const float a0 = __uint_as_float(v0[j] << 16), a1 = __uint_as_float(v0[j] & 0xffff0000u), b0 = __uint_as_float(v1[j] << 16), b1 = __uint_as_float(v1[j] & 0xffff0000u);
          const float d0_ = a0 - lam * b0, d1_ = a1 - lam * b1; dk[ps][i][2 * j] = d0_; dk[ps][i][2 * j + 1] = d1_; ss[i] += d0_ * d0_ + d1_ * d1_; } }
      asm volatile("s_waitcnt lgkmcnt(0)" ::: "memory");
    }
    #pragma unroll
    for (int i = 0; i < 4; ++i) { float t_ = ss[i];
      t_ += __int_as_float(__builtin_amdgcn_ds_swizzle(__float_as_int(t_), 0x1f | (1 << 10))); t_ += __int_as_float(__builtin_amdgcn_ds_swizzle(__float_as_int(t_), 0x1f | (2 << 10)));
      t_ += __int_as_float(__builtin_amdgcn_ds_swizzle(__float_as_int(t_), 0x1f | (4 << 10))); ss[i] = rsqrtf(t_ * (1.0f / 128.0f) + RMS_EPS) * ONE_M_LI; }
    #pragma unroll
    for (int ps = 0; ps < 2; ++ps) {
      const int ch = ech; const float* gp = g_sub + ps * 64 + ch * 8; const f32x4_t g0 = *(const f32x4_t*)gp, g1 = *(const f32x4_t*)(gp + 4);
      #pragma unroll
      for (int i = 0; i < 4; ++i) { const int row = i * 8 + erow;
        const u32x4 z = NT_LD((const u32x4*)(Zw + (long)row * DMA + ps * 64 + ch * 8)); u32x4 w;
        #pragma unroll
        for (int j = 0; j < 4; ++j) { const float z0 = __uint_as_float(z[j] << 16), z1 = __uint_as_float(z[j] & 0xffff0000u);
          const float ga = (j < 2) ? g0[2 * j] : g1[2 * j - 4], gb = (j < 2) ? g0[2 * j + 1] : g1[2 * j - 3];
          w[j] = cvtpk_s(dk[ps][i][2 * j] * ss[i] * ga * z0, dk[ps][i][2 * j + 1] * ss[i] * gb * z1); }
        *(u32x4*)(Gw + (long)row * DMA + ps * 64 + ch * 8) = w; }
    }
  }
  asm volatile("s_waitcnt lgkmcnt(0)" ::: "memory");
  #undef DMA_K
  #undef DMA_V
  #undef CMASK
  #undef RESC
  #undef ROT
  #undef PKW
  #undef PAF
  #undef VFR
  #undef PIN
  #undef MX3
  #undef EX
  #undef VRD
  #undef KRD
  #undef GAPB
  #undef MFQ
  #undef STEP
  #undef STEP_AB
  #undef STEP_BA
  #undef ENDW
}
#undef SBAR
#undef WAIT_BAR
}

constexpr int NWAVES = 8;
constexpr size_t MiB = 1u << 20;
constexpr size_t WS_CTL = 0, CTL_ZERO_BYTES = 1 * MiB;
constexpr size_t WS_MOD = 256 * 1024;
constexpr size_t WS_LAM = 1 * MiB;
constexpr size_t WS_HN = 1 * MiB + 128 * 1024;
constexpr size_t WS_LB16 = 1 * MiB + 4096;
constexpr size_t WS_WIN0 = 2 * MiB, WS_WGLU = 6 * MiB, WS_WOUT0 = 8 * MiB, WS_WKV = 10 * MiB, WS_WIN1 = 14 * MiB, WS_WOUT1 = 18 * MiB;
constexpr size_t WS_BTA = 20 * MiB;
constexpr size_t WS_BTB = 28 * MiB;
constexpr size_t WS_S0 = 48 * MiB, WS_S1 = 112 * MiB, WS_S2 = 176 * MiB, WS_S3 = 240 * MiB, WS_S4 = 304 * MiB, WS_S5 = 368 * MiB, WS_S6 = 432 * MiB, WS_END = 496 * MiB;
constexpr int CW_BAR = 4096;
constexpr int CW_TMO = 8, CW_SEAM = 16384, SEAM_BANK = 128 * 64;
constexpr size_t WS_XCH = 40 * MiB;
constexpr int RING_OFF = 0, RING_BYTES = 131072;
constexpr int LDSCTL_OFF = RING_BYTES, MISC_OFF = LDSCTL_OFF + 320;
constexpr int LDS_BYTES = 147456;

#define GAS __attribute__((address_space(1)))
#define LAS __attribute__((address_space(3)))
typedef unsigned v4u __attribute__((ext_vector_type(4)));
typedef GAS unsigned gu32;
#define RLX_AGENT __ATOMIC_RELAXED, __HIP_MEMORY_SCOPE_AGENT
#define LDS_WAIT() asm volatile("s_waitcnt lgkmcnt(0)" ::: "memory")
#define VM_WAIT() asm volatile("s_waitcnt vmcnt(0)" ::: "memory")

#define XB_TMO      128
#define XB_XCNT(j)  (256  + 64 * (j))
#define XB_XSUB(j)  (1280 + 64 * (j))
#define XB_XGEN(j)  (2304 + 64 * (j))
#define XB_TOP      3328
#define XB_TOPGEN   3392
#define XCD_BAR_WORDS 3456
#define XB_SPIN_CAP (1u << 18)
__device__ __forceinline__ unsigned xb_ld(unsigned* p)              { return __hip_atomic_load(p, __ATOMIC_RELAXED, __HIP_MEMORY_SCOPE_AGENT); }
__device__ __forceinline__ unsigned xb_add(unsigned* p, unsigned v) { return __hip_atomic_fetch_add(p, v, __ATOMIC_RELAXED, __HIP_MEMORY_SCOPE_AGENT); }
__device__ __forceinline__ unsigned xb_xcc_id() { return (unsigned)__builtin_amdgcn_s_getreg((3 << 11) | 20) & 0xFu; }
#define XB_SPIN(cond, bar) do { unsigned _sp = 0; while (cond) { __builtin_amdgcn_s_sleep(1); \
    if ((++_sp & 255u) == 0u) { if (xb_ld(&(bar)[XB_TMO])) break; if (_sp > XB_SPIN_CAP) { atomicAdd(&(bar)[XB_TMO], 1u); break; } } } } while (0)
struct XcdBarrier { unsigned* bar; unsigned x; volatile LAS unsigned* st; };
__device__ __forceinline__ XcdBarrier xcd_barrier_post(unsigned* bar, volatile LAS unsigned* st, int tid) {
    XcdBarrier b; b.bar = bar; b.x = xb_xcc_id(); b.st = st;
    if (tid == 0) (void)xb_add(&bar[XB_XCNT(b.x)], 1u);
    return b;
}
__device__ __forceinline__ void xcd_barrier_complete(unsigned* bar, unsigned x, unsigned& nloc, unsigned& nx) {
    const unsigned G = gridDim.x * gridDim.y * gridDim.z;
    unsigned sum, cnt, mine, sp = 0u;
    for (;;) {
        sum = 0u; cnt = 0u; mine = 0u;
#pragma unroll
        for (unsigned j = 0; j < 16; ++j) { const unsigned c = xb_ld(&bar[XB_XCNT(j)]); sum += c; cnt += (c > 0u) ? 1u : 0u; mine = (j == x) ? c : mine; }
        if (sum == G) break;
        __builtin_amdgcn_s_sleep(1);
        if ((++sp & 255u) == 0u) { if (xb_ld(&bar[XB_TMO])) break; if (sp > XB_SPIN_CAP) { atomicAdd(&bar[XB_TMO], 1u); break; } }
    }
    nloc = mine > 0u ? mine : 1u; nx = cnt > 0u ? cnt : 1u;
}
__device__ __forceinline__ void xcd_barrier(const XcdBarrier& b, int tid) {
    asm volatile("s_waitcnt vmcnt(0)" ::: "memory");
    __syncthreads();
    if (tid == 0) {
        unsigned* bar = b.bar;
        __builtin_amdgcn_s_waitcnt(0);
        unsigned nloc = b.st[0], nx = b.st[1];
        if (nloc == 0u) { xcd_barrier_complete(bar, b.x, nloc, nx); b.st[0] = nloc; b.st[1] = nx; }
        const unsigned old = xb_add(&bar[XB_XSUB(b.x)], 1u);
        const unsigned gen = old / nloc;
        if (old + 1u == (gen + 1u) * nloc) {
            __builtin_amdgcn_fence(__ATOMIC_RELEASE, "agent");
            asm volatile("s_waitcnt vmcnt(0)" ::: "memory");
            const unsigned og = xb_add(&bar[XB_TOP], 1u);
            const unsigned tg = og / nx;
            if (og + 1u == (tg + 1u) * nx) xb_add(&bar[XB_TOPGEN], 1u);
            else XB_SPIN(xb_ld(&bar[XB_TOPGEN]) == tg, bar);
            __builtin_amdgcn_fence(__ATOMIC_ACQUIRE, "agent");
            xb_add(&bar[XB_XGEN(b.x)], 1u);
            asm volatile("s_waitcnt vmcnt(0)" ::: "memory");
        } else {
            XB_SPIN(xb_ld(&bar[XB_XGEN(b.x)]) == gen, bar);
            __builtin_amdgcn_fence(__ATOMIC_ACQUIRE, "agent");
            asm volatile("s_waitcnt vmcnt(0)" ::: "memory");
        }
    }
    __syncthreads();
}

__device__ __forceinline__ void p0_transpose_item(const float* W, int K, int N, bf16_t* WT, int row_off, const float* kscale, LAS float* scr, int item, int lane) {
    const int nblk = N / 32, kb = item / nblk, nb = item % nblk, k0 = 64 * kb, n0 = 32 * nb;
    float tv[32];
#pragma unroll
    for (int i = 0; i < 32; ++i) tv[i] = NT_LD(W + (size_t)(k0 + 2 * i + (lane >> 5)) * N + n0 + (lane & 31));
#pragma unroll
    for (int i = 0; i < 32; ++i) { const int kk = 2 * i + (lane >> 5); float v = tv[i]; if (kscale) v *= kscale[k0 + kk]; scr[kk * 33 + (lane & 31)] = v; }
    LDS_WAIT(); asm volatile("" ::: "memory");
    const int c = lane & 7;
#pragma unroll
    for (int j = 0; j < 4; ++j) { const int n = (lane >> 3) + 8 * j; const LAS float* s = scr + (8 * c) * 33 + n;
        v4u o; o.x = pk2bf(s[0 * 33], s[1 * 33]); o.y = pk2bf(s[2 * 33], s[3 * 33]); o.z = pk2bf(s[4 * 33], s[5 * 33]); o.w = pk2bf(s[6 * 33], s[7 * 33]);
        *(GAS v4u*)(WT + (size_t)(row_off + n0 + n) * K + k0 + 8 * c) = o; }
    LDS_WAIT(); asm volatile("" ::: "memory");
}

__device__ __forceinline__ int lane_now_asm() { int r; asm volatile("v_mbcnt_lo_u32_b32 %0, -1, 0\n\tv_mbcnt_hi_u32_b32 %0, -1, %0" : "=v"(r)); return r; }
struct Args {
    const float* in[28]; float* out; unsigned char* ws;
    int ph_lo, ph_hi, use_bar, flags;
};

__global__ void __launch_bounds__(NWAVES * 64, 2) mega_fwd(Args args) {
    extern __shared__ __attribute__((aligned(16))) unsigned char lds_raw[];
    LAS unsigned char* lds = (LAS unsigned char*)lds_raw;
    volatile LAS unsigned* MISC = (volatile LAS unsigned*)(lds + MISC_OFF);
    const int wave = __builtin_amdgcn_readfirstlane((int)threadIdx.x >> 6);
#define LANE_NOW() lane_now_asm()
#define TID_NOW() (wave * 64 + LANE_NOW())
    const int G = gridDim.x; const int bx = blockIdx.x; const int vcu = (G % 8 == 0) ? (bx % 8) * (G / 8) + bx / 8 : bx;
    unsigned char* ws = args.ws;
    gu32* ctl = (gu32*)(ws + WS_CTL);
    const float* x = args.in[0]; const float* cvec = args.in[1]; const float* ada_w = args.in[2]; const float* ada_b = args.in[3];
    const float* g_pre = args.in[4]; const float* g_post = args.in[5];
    float* out = args.out;
    float* mod = (float*)(ws + WS_MOD); float* lamp = (float*)(ws + WS_LAM); float* lb16 = (float*)(ws + WS_LB16);
    bf16_t* Win0 = (bf16_t*)(ws + WS_WIN0); bf16_t* Wglu = (bf16_t*)(ws + WS_WGLU); bf16_t* Wout0 = (bf16_t*)(ws + WS_WOUT0); bf16_t* Wkv = (bf16_t*)(ws + WS_WKV);
    bf16_t* Win1 = (bf16_t*)(ws + WS_WIN1); bf16_t* Wout1 = (bf16_t*)(ws + WS_WOUT1); bf16_t* BtA = (bf16_t*)(ws + WS_BTA); bf16_t* BtB = (bf16_t*)(ws + WS_BTB);
    bf16_t* A0 = (bf16_t*)(ws + WS_S0); bf16_t* US = (bf16_t*)(ws + WS_S1); bf16_t* SZ = (bf16_t*)(ws + WS_S3); bf16_t* YG = (bf16_t*)(ws + WS_S4); float* EB = (float*)(ws + WS_S0);
    bf16_t* Y2 = (bf16_t*)(ws + WS_S0); bf16_t* YO = (bf16_t*)(ws + WS_S1); bf16_t* AKV = (bf16_t*)(ws + WS_S0); bf16_t* AIN1 = (bf16_t*)(ws + WS_S2);
    bf16_t* KB = (bf16_t*)(ws + WS_S3); bf16_t* VB = (bf16_t*)(ws + WS_S4); bf16_t* QB = (bf16_t*)(ws + WS_S5); bf16_t* SZ1 = (bf16_t*)(ws + WS_S6);
    bf16_t* O0 = (bf16_t*)(ws + (H1_AKV ? WS_S1 : WS_S0)); bf16_t* O1 = (bf16_t*)(ws + WS_S1); bf16_t* OG = (bf16_t*)(ws + WS_S2); bf16_t* YO1 = (bf16_t*)(ws + (H1_AKV ? WS_S3 : WS_S0));
    float* HN = (float*)(ws + WS_HN);

    for (int u = TID_NOW(); u < (LDS_BYTES - LDSCTL_OFF) / 4; u += NWAVES * 64) ((LAS unsigned*)(lds + LDSCTL_OFF))[u] = 0u;
    __syncthreads();
    XcdBarrier bar; bar.bar = (unsigned*)(ctl + CW_BAR); bar.x = 0; bar.st = nullptr;
    if (args.use_bar) bar = xcd_barrier_post((unsigned*)(ctl + CW_BAR), MISC + 8, TID_NOW());
    const int lo = args.ph_lo, hi = args.ph_hi;
#define IN(k) (lo <= (k) && (k) < hi)
#define REPS(k) (1 + ((REPEAT_MASK >> (k)) & 1))
#define SEAM(k) do { if (IN(k) && IN((k) + 1) && args.use_bar) xcd_barrier(bar, TID_NOW()); } while (0)
    const int gw = vcu * NWAVES + wave, NGW = G * NWAVES;
#define LANE_L() ({ int l_ = LANE_NOW(); asm volatile("" : "+v"(l_)); l_; })

    if (IN(0)) for (int rep_ = 0; rep_ < REPS(0); ++rep_) {
        const int tid = TID_NOW(), lane = tid & 63;
        for (int it = vcu; it < NGRP * 4; it += G) {
            const int g = it >> 2, qt = it & 3;
            LAS float* LBP = (LAS float*)(lds + RING_OFF);
            LAS float* BBR = LBP + 17 * 128;
            LAS float* CC = BBR + 64 * 32;
            LAS float* KM = CC + 16 * 130 + 12;
            __syncthreads();
            if (tid < 64) {
                const int p = tid;
                const float dt = expf(args.in[9][g]);
                const float lr = args.in[7][g * 64 + p], li = args.in[8][g * 64 + p];
                const float mag = expf(lr * dt); const float sn = sinf(li * dt), cs = cosf(li * dt);
                const float lbr = mag * cs, lbi = mag * sn;
                float pr = 1.f, pi = 0.f;
                for (int d = 0; d <= 16; ++d) { LBP[(d * 64 + p) * 2] = pr; LBP[(d * 64 + p) * 2 + 1] = pi; const float nr = pr * lbr - pi * lbi, ni = pr * lbi + pi * lbr; pr = nr; pi = ni; }
                if (qt == 0) { lb16[(g * 64 + p) * 2] = LBP[(16 * 64 + p) * 2]; lb16[(g * 64 + p) * 2 + 1] = LBP[(16 * 64 + p) * 2 + 1]; }
                const float nr = lbr - 1.0f, ni = lbi, den = lr * lr + li * li;
                const float cr = (nr * lr + ni * li) / den, ci = (ni * lr - nr * li) / den;
                for (int c = 0; c < 16; ++c) { const float br = args.in[10][(g * 64 + p) * 16 + c], bi = args.in[11][(g * 64 + p) * 16 + c];
                    BBR[(p * 16 + c) * 2] = cr * br - ci * bi; BBR[(p * 16 + c) * 2 + 1] = cr * bi + ci * br; }
            }
            for (int e = tid; e < 1024; e += 512) { const int co = e >> 6, p = e & 63; CC[(co * 65 + p) * 2] = args.in[12][(g * 16 + co) * 64 + p]; CC[(co * 65 + p) * 2 + 1] = args.in[13][(g * 16 + co) * 64 + p]; }
            __syncthreads();
            {
                const int pair = tid >> 1, hh = tid & 1, d = pair >> 4, co = pair & 15; float acc8[8];
#pragma unroll
                for (int j = 0; j < 8; ++j) acc8[j] = 0.f;
                for (int p = 0; p < 64; ++p) { const float cr = CC[(co * 65 + p) * 2], cim = CC[(co * 65 + p) * 2 + 1], lr = LBP[(d * 64 + p) * 2], lim = LBP[(d * 64 + p) * 2 + 1];
                    const float wr_ = cr * lr - cim * lim, wi_ = cr * lim + cim * lr; const LAS f32x4_t* bp = (const LAS f32x4_t*)(BBR + (p * 16 + 8 * hh) * 2);
#pragma unroll
                    for (int q4 = 0; q4 < 4; ++q4) { const f32x4_t bb = bp[q4]; acc8[2 * q4] += wr_ * bb.x - wi_ * bb.y; acc8[2 * q4 + 1] += wr_ * bb.z - wi_ * bb.w; } }
#pragma unroll
                for (int j = 0; j < 8; ++j) KM[(d * 16 + co) * 16 + 8 * hh + j] = acc8[j] + ((SSM_DFOLD && d == 0 && co == 8 * hh + j) ? args.in[14][g * 16 + co] : 0.f);
            }
            __syncthreads();
            for (int e = tid; e < 64 * 48; e += 512) {
                const int n = 64 * qt + e / 48, pc = e % 48, s = n >> 4, co = n & 15; float v[8];
                if (pc < 32) { const int s2 = pc >> 1, ci0 = (pc & 1) * 8;
#pragma unroll
                    for (int j = 0; j < 8; ++j) v[j] = (s2 <= s) ? KM[((s - s2) * 16 + co) * 16 + ci0 + j] : 0.f;
                } else { const int j0 = (pc - 32) * 8;
#pragma unroll
                    for (int jj = 0; jj < 4; ++jj) { const int p = (j0 >> 1) + jj; const float cr = CC[(co * 65 + p) * 2], cim = CC[(co * 65 + p) * 2 + 1], lr = LBP[((s + 1) * 64 + p) * 2], lim = LBP[((s + 1) * 64 + p) * 2 + 1];
                        v[2 * jj] = cr * lr - cim * lim; v[2 * jj + 1] = -(cr * lim + cim * lr); } }
                v4u o; o.x = pk2bf(v[0], v[1]); o.y = pk2bf(v[2], v[3]); o.z = pk2bf(v[4], v[5]); o.w = pk2bf(v[6], v[7]);
                *(GAS v4u*)(BtB + ((size_t)g * 256 + n) * 384 + pc * 8) = o; }
            for (int e = tid; e < 64 * 32; e += 512) {
                const int n = 64 * qt + (e >> 5), pc = e & 31; float v[8];
                if (n < 128) { const int p = n >> 1, ri = n & 1, s2 = pc >> 1, ci0 = (pc & 1) * 8; const float lr = LBP[((15 - s2) * 64 + p) * 2], lim = LBP[((15 - s2) * 64 + p) * 2 + 1];
#pragma unroll
                    for (int j = 0; j < 8; ++j) { const float br = BBR[(p * 16 + ci0 + j) * 2], bi = BBR[(p * 16 + ci0 + j) * 2 + 1]; v[j] = ri ? (lr * bi + lim * br) : (lr * br - lim * bi); }
                } else {
#pragma unroll
                    for (int j = 0; j < 8; ++j) v[j] = 0.f; }
                v4u o; o.x = pk2bf(v[0], v[1]); o.y = pk2bf(v[2], v[3]); o.z = pk2bf(v[4], v[5]); o.w = pk2bf(v[6], v[7]);
                *(GAS v4u*)(BtA + ((size_t)g * 256 + n) * 256 + pc * 8) = o; }
        }
        __syncthreads();
        {
            LAS float* scr = (LAS float*)(lds + RING_OFF + wave * 16384);
            constexpr int I_2K = (DM / 64) * (2048 / 32), I_1K = (DM / 64) * (1024 / 32);
            constexpr int NITEMS = 2 * I_2K + 5 * I_1K;
            for (int it = gw; it < NITEMS; it += NGW) {
                int r = it;
                if (r < I_2K) { p0_transpose_item(args.in[6], DM, 2048, Win0, 0, nullptr, scr, r, lane); continue; } r -= I_2K;
                if (r < I_2K) { p0_transpose_item(args.in[21], DM, 2048, Win1, 0, nullptr, scr, r, lane); continue; } r -= I_2K;
                if (r < I_1K) { p0_transpose_item(args.in[15], DM, 1024, Wglu, 0, nullptr, scr, r, lane); continue; } r -= I_1K;
                if (r < I_1K) { p0_transpose_item(args.in[17], DM, 1024, Wout0, 0, nullptr, scr, r, lane); continue; } r -= I_1K;
                if (r < I_1K) { p0_transpose_item(args.in[19], DM, 1024, Wkv, 0, args.in[18], scr, r, lane); continue; } r -= I_1K;
                if (r < I_1K) { p0_transpose_item(args.in[20], DM, 1024, Wkv, 1024, args.in[18], scr, r, lane); continue; } r -= I_1K;
                p0_transpose_item(args.in[27], DM, 1024, Wout1, 0, nullptr, scr, r, lane);
            }
        }
        if (!(args.flags & 1)) {
            __syncthreads();
            LAS float* sc = (LAS float*)(lds + RING_OFF);
            LAS float* red = sc + 8192;
            bool have = false;
            for (int it = vcu; it < 2 * 96; it += G) {
                if (!have) { for (int e = tid; e < 8192; e += 512) sc[e] = silu_f(cvec[e]); have = true; __syncthreads(); }
                const int l = it / 96, cc = it % 96, j = cc * 32 + (lane & 31), kh = lane >> 5;
                float acc[8];
#pragma unroll
                for (int b = 0; b < 8; ++b) acc[b] = 0.f;
                const float* wp = ada_w + ((size_t)l * 1024 + wave * 128 + kh) * 3072 + j;
                for (int k0 = 0; k0 < 64; k0 += 32) {
                    float w[32];
#pragma unroll
                    for (int kk = 0; kk < 32; ++kk) w[kk] = NT_LD(wp + (size_t)(2 * (k0 + kk)) * 3072);
#pragma unroll
                    for (int kk = 0; kk < 32; ++kk) {
#pragma unroll
                        for (int b = 0; b < 8; ++b) acc[b] += w[kk] * sc[b * 1024 + wave * 128 + 2 * (k0 + kk) + kh];
                        if ((kk & 3) == 3) asm volatile("" ::: "memory"); }
                }
#pragma unroll
                for (int b = 0; b < 8; ++b) { acc[b] += __shfl_xor(acc[b], 32); if (lane < 32) red[(wave * 8 + b) * 32 + lane] = acc[b]; }
                __syncthreads();
                if (tid < 256) { const int b = tid >> 5, jl = tid & 31; float sum = ada_b[l * 3072 + cc * 32 + jl];
#pragma unroll
                  for (int w = 0; w < 8; ++w) sum += red[(w * 8 + b) * 32 + jl];
                  mod[((size_t)(l * 8 + b)) * 3072 + cc * 32 + jl] = sum; }
                __syncthreads();
            }
            if (bx == 0 && tid == 0) lamp[0] = diff_lambda(args.in[22], args.in[23], args.in[24], args.in[25]);
        }
    }
    SEAM(0);
    if (IN(1)) for (int rep_ = 0; rep_ < REPS(1); ++rep_) e_norm0_b(x, mod, g_pre, A0, gw, NGW, LANE_L());
    SEAM(1);
#ifdef EXTRA_BARS
    if (args.use_bar) for (int eb = 0; eb < EXTRA_BARS; ++eb) xcd_barrier(bar, TID_NOW());
#endif
    if (IN(2)) for (int rep_ = 0; rep_ < REPS(2); ++rep_) {
        pg8::Gemm g = pg8::gemm_std(A0, DM, Win0, DM, DM); pg8::Order S; S.init(MTOK / 256, 2048 / 256, 1, G, bx);
        pg8::EpiRow8<pg8::F_In0> E{{US, SZ}};
        pg8::gemm_phase<pg8::EpiRow8<pg8::F_In0>, ALIGN_E>(lds + RING_OFF, g, S, E, TID_NOW());
    }
    SEAM(2);
#if SSM_FUSED
    if (IN(3)) {
        pg8::Gemm gA = pg8::gemm_std(US, US_P, BtA, 256, 256); gA.a_gstep = (size_t)NTILE * US_P * 2; gA.b_gstep = (size_t)256 * 256 * 2;
        pg8::Gemm gB = pg8::gemm_std(US, US_P, BtB, 384, 384); gB.a_gstep = (size_t)NTILE * US_P * 2; gB.b_gstep = (size_t)256 * 384 * 2;
        pg8::EpiScan ES{lb16, US, LDSCTL_OFF + 2048};
#if SSM_DFOLD
        pg8::EpiRow8<pg8::F_SsmB0> EB2{{YG}};
#else
        pg8::EpiRow8<pg8::F_SsmB> EB2{{US, args.in[14], YG}};
#endif
        for (int uu = 0; (long)uu * G + bx < NGRP * NB; ++uu) {
            pg8::Order S; S.init(NTILE / 256, 1, NGRP, G, bx); S.only = uu;
            pg8::gemm_phase<pg8::EpiScan, false>(lds + RING_OFF, gA, S, ES, TID_NOW());
#if SSM_DFOLD
            pg8::gemm_phase<pg8::EpiRow8<pg8::F_SsmB0>, false>(lds + RING_OFF, gB, S, EB2, TID_NOW());
#else
            pg8::gemm_phase<pg8::EpiRow8<pg8::F_SsmB>, false>(lds + RING_OFF, gB, S, EB2, TID_NOW());
#endif
        }
    }
    SEAM(5);
#else
    if (IN(3)) for (int rep_ = 0; rep_ < REPS(3); ++rep_) {
        pg8::Gemm g = pg8::gemm_std(US, US_P, BtA, 256, 256); g.a_gstep = (size_t)NTILE * US_P * 2; g.b_gstep = (size_t)256 * 256 * 2;
        pg8::Order S; S.init(NTILE / 256, 1, NGRP, G, bx);
        pg8::EpiRow8<pg8::F_SsmA> E{{EB}};
        pg8::gemm_phase<pg8::EpiRow8<pg8::F_SsmA>, ALIGN_E>(lds + RING_OFF, g, S, E, TID_NOW());
    }
    SEAM(3);
    if (IN(4)) for (int rep_ = 0; rep_ < REPS(4); ++rep_) {
        for (int it = vcu + G * wave; it < NB * NGRP; it += G * NWAVES) {
            const int b = it / NGRP, g = it % NGRP, p = LANE_L();
            const float lr = lb16[(g * 64 + p) * 2], li = lb16[(g * 64 + p) * 2 + 1];
            float sr = 0.f, si = 0.f;
            const float* ep = EB + ((size_t)g * NTILE + b * 256) * 128 + 2 * p;
            bf16_t* sp = US + us_off(g, b * 256, 256 + 2 * p);
            for (int t0 = 0; t0 < 256; t0 += 16) {
                float er[16], ei[16];
#pragma unroll
                for (int j = 0; j < 16; ++j) { const float2 e = *(const float2*)(ep + (size_t)(t0 + j) * 128); er[j] = e.x; ei[j] = e.y; }
#pragma unroll
                for (int j = 0; j < 16; ++j) { *(unsigned*)(sp + (size_t)(t0 + j) * US_P) = pk2bf(sr, si);
                    const float nr = lr * sr - li * si + er[j], ni = lr * si + li * sr + ei[j]; sr = nr; si = ni; }
            }
        }
    }
    SEAM(4);
    if (IN(5)) for (int rep_ = 0; rep_ < REPS(5); ++rep_) {
        pg8::Gemm g = pg8::gemm_std(US, US_P, BtB, 384, 384); g.a_gstep = (size_t)NTILE * US_P * 2; g.b_gstep = (size_t)256 * 384 * 2;
        pg8::Order S; S.init(NTILE / 256, 1, NGRP, G, bx);
        pg8::EpiRow8<pg8::F_SsmB> E{{US, args.in[14], YG}};
        pg8::gemm_phase<pg8::EpiRow8<pg8::F_SsmB>, ALIGN_E>(lds + RING_OFF, g, S, E, TID_NOW());
    }
    SEAM(5);
#endif
    if (IN(6)) for (int rep_ = 0; rep_ < REPS(6); ++rep_) {
        pg8::Gemm g = pg8::gemm_std(YG, DM, Wglu, DM, DM);
        g.a_rs = 32u; g.a_c16 = (unsigned)((size_t)NTILE * YG_P * 2); g.a_kstep = (size_t)4 * NTILE * YG_P * 2; g.a_tstep = (size_t)256 * 32;
        pg8::Order S; S.init(MTOK / 256, 1024 / 256, 1, G, bx);
        pg8::EpiRow8<pg8::F_Glu> E{{YG, SZ, args.in[16], Y2}};
        pg8::gemm_phase<pg8::EpiRow8<pg8::F_Glu>, ALIGN_E>(lds + RING_OFF, g, S, E, TID_NOW());
    }
    SEAM(6);
#if FUSE_EPI
    if (IN(7)) {
        pg8::Gemm g = pg8::gemm_std(Y2, DM, Wout0, DM, DM);
        for (int half = 0; half < 2; ++half) {
            pg8::Order S; S.init(MTOK / 512, 1024 / 256, 1, G, bx); S.pm_off = half * (MTOK / 512);
            pg8::PanelRms st1{(unsigned*)(ws + WS_XCH), (unsigned*)(ctl + CW_SEAM), (unsigned*)(ctl + CW_TMO), RMS_EPS};
            pg8::PanelRms st2{(unsigned*)(ws + WS_XCH + 1 * MiB), (unsigned*)(ctl + CW_SEAM + SEAM_BANK), (unsigned*)(ctl + CW_TMO), RMS_EPS};
            pg8::EpiMid E{x, out, AKV, AIN1, mod, g_post, g_pre + 1024, st1, st2};
            pg8::gemm_phase<pg8::EpiMid, false>(lds + RING_OFF, g, S, E, TID_NOW());
        }
    }
#else
    if (IN(7)) {
        pg8::Gemm g = pg8::gemm_std(Y2, DM, Wout0, DM, DM); pg8::Order S; S.init(MTOK / 256, 1024 / 256, 1, G, bx);
        pg8::EpiRow8<pg8::F_Plain> E{{YO}};
        pg8::gemm_phase<pg8::EpiRow8<pg8::F_Plain>, ALIGN_E>(lds + RING_OFF, g, S, E, TID_NOW());
    }
    SEAM(7);
    if (IN(8)) { if (H1_BF16) e_mid(x, YO, mod, g_post, g_pre, (float*)nullptr, YO, AKV, AIN1, gw, NGW, LANE_L()); else e_mid_b(x, YO, mod, g_post, g_pre, (H1_RECOMP || H1_AKV) ? (float*)nullptr : out, AKV, AIN1, gw, NGW, LANE_L(), H1_AKV ? HN : (float*)nullptr); }
#endif
    SEAM(8);
    if (IN(9)) for (int rep_ = 0; rep_ < REPS(9); ++rep_) {
        pg8::Gemm g = pg8::gemm_std(AKV, DM, Wkv, DM, DM); g.a_gstep = (size_t)(WS_S2 - WS_S0); g.b_gstep = (size_t)(WS_WIN1 - WS_WKV);
        pg8::Order S; S.init(MTOK / 256, 2048 / 256, 2, G, bx); S.mode2 = (G == 256);
        pg8::EpiRow8<pg8::F_Split2> E{{{KB, QB}, {VB, SZ1}}};
        pg8::gemm_phase<pg8::EpiRow8<pg8::F_Split2>, ALIGN_E>(lds + RING_OFF, g, S, E, TID_NOW());
    }
    SEAM(9);
    if (IN(10)) {
#if ATTN_V128
#if ATTN_FUSE_POST
        { const float lam = __int_as_float(__builtin_amdgcn_readfirstlane(__float_as_int(lamp[0])));
          attn_body::bf16x8 qr[4]; bool primed = false;
#if ATTN_PRIO
          if (wave >= 4) __builtin_amdgcn_s_setprio(1);
#endif
          const int nun = (64 * 16 - vcu + G - 1) / G;
#pragma unroll 1
          for (int su = 0; su < 2 * nun; ++su) {
            const int i = su >> 1, cc = su & 1;
            const long L = (long)i * G + vcu; const int pr = (int)(L % 256), qi = (int)(L / 256);
            const int bh = pr >> 2, j = pr & 3; const int qb = (qi & 1) ? (8 * (qi >> 1) + 7 - j) : (8 * (qi >> 1) + j); const int h = bh & 7, b = bh >> 3;
            const bool has_next = su + 1 < 2 * nun;
            const int i2 = (su + 1) >> 1, cc2 = (su + 1) & 1;
            const long L2 = (long)i2 * G + vcu; const int pr2 = (int)(L2 % 256), qi2 = (int)(L2 / 256);
            const int bh2 = pr2 >> 2, j2 = pr2 & 3; const int qb2 = (qi2 & 1) ? (8 * (qi2 >> 1) + 7 - j2) : (8 * (qi2 >> 1) + j2); const int h2 = bh2 & 7, b2 = bh2 >> 3;
            attn3::attn_unit<8>(TID_NOW(), b, 2 * h + cc, h, qb, QB, KB, VB, O0, (char*)lds_raw + RING_OFF, cc, SZ1, args.in[26], lam, OG, primed, has_next, b2, 2 * h2 + cc2, h2, qb2, qr);
            primed = true;
          }
#if ATTN_PRIO
          __builtin_amdgcn_s_setprio(0);
#endif
          }
#else
        for (int i = 0;; ++i) {
            const long L = (long)i * G + vcu; if (L >= 128 * 16) break;
            const int pr = (int)(L % 256), qi = (int)(L / 256);
            const int combo = pr >> 1, j = pr & 1;
            const int k4 = qi >> 1; const int qb = (qi & 1) ? (4 * k4 + 3 - j) : (4 * k4 + j);
            const int c = combo & 1, h = (combo >> 1) & 7, b = combo >> 4;
            { attn_body::bf16x8 qr_[4]; attn3::attn_unit<8>(TID_NOW(), b, 2 * h + c, h, qb, QB, KB, VB, c ? O1 : O0, (char*)lds_raw + RING_OFF, 0, SZ1, args.in[26], 0.f, OG, false, false, 0, 0, 0, 0, qr_); asm volatile("s_barrier" ::: "memory"); }
        }
#endif
#else
        for (int i = 0;; ++i) {
            const long L = (long)i * G + vcu; if (L >= 256 * 16) break;
            const int combo = (int)(L % 256), qi = (int)(L / 256);
            const int qb = (qi & 1) ? (qi >> 1) : (15 - (qi >> 1));
            const int vh = combo & 1, c = (combo >> 1) & 1, h = (combo >> 2) & 7, b = combo >> 5;
            attn_body::attn_unit<8>(TID_NOW(), b, 2 * h + c, 2 * h + vh, qb, QB, KB, VB, c ? O1 : O0, (char*)lds_raw + RING_OFF);
        }
#endif
    }
    SEAM(10);
#if !(ATTN_V128 && ATTN_FUSE_POST)
    if (IN(11)) for (int rep_ = 0; rep_ < REPS(11); ++rep_) e_attn_post(O0, O1, SZ1, args.in[26], lamp[0], OG, gw, NGW, LANE_L());
    SEAM(11);
#endif
#if FUSE_EPI
    if (IN(12)) {
        pg8::Gemm g = pg8::gemm_std(OG, DM, Wout1, DM, DM);
        for (int half = 0; half < 2; ++half) {
            pg8::Order S; S.init(MTOK / 512, 1024 / 256, 1, G, bx); S.pm_off = half * (MTOK / 512);
            pg8::PanelRms st{(unsigned*)(ws + WS_XCH + 2 * MiB), (unsigned*)(ctl + CW_SEAM + 2 * SEAM_BANK), (unsigned*)(ctl + CW_TMO), RMS_EPS};
            pg8::EpiFinal E{out, out, mod + 8 * 3072, g_post + 1024, st};
            pg8::gemm_phase<pg8::EpiFinal, false>(lds + RING_OFF, g, S, E, TID_NOW());
        }
    }
#else
    if (IN(12)) {
        pg8::Gemm g = pg8::gemm_std(OG, DM, Wout1, DM, DM); pg8::Order S; S.init(MTOK / 256, 1024 / 256, 1, G, bx);
        pg8::EpiRow8<pg8::F_Plain> E{{YO1}};
        pg8::gemm_phase<pg8::EpiRow8<pg8::F_Plain>, ALIGN_E>(lds + RING_OFF, g, S, E, TID_NOW());
    }
    SEAM(12);
    if (IN(13)) { if (H1_BF16) e_final_b(YO, out, YO1, mod, g_post, gw, NGW, LANE_L()); else if (H1_AKV) e_final_k(AKV, HN, YO1, out, mod, g_post, gw, NGW, LANE_L()); else if (H1_RECOMP) e_final_x(x, YO, YO1, out, mod, g_post, gw, NGW, LANE_L()); else e_final_bm(out, YO1, mod, g_post, gw, NGW, LANE_L()); }
#endif
#undef IN
#undef SEAM
}

#ifndef FASTMASK
#define FASTMASK 0x3fff
#endif
#ifndef ONE_LAUNCH
#define ONE_LAUNCH 1
#endif
constexpr int NPHASE = 14;

extern "C" void kernel_launch(void* const* d_in, const int* in_sizes, int n_in, void* d_out, int out_size, void* d_ws, size_t ws_size, hipStream_t stream) {
    static int grid = 0;
    if (grid == 0) {
        if (n_in != 28 || out_size != MTOK * DM || ws_size < WS_END) { fprintf(stderr, "kernel_launch: unexpected shapes (n_in %d out %d ws %zu)\n", n_in, out_size, ws_size); grid = -1; return; }
        int dev = 0, cus = 0, per_cu = 0;
        if (hipGetDevice(&dev) != hipSuccess || hipDeviceGetAttribute(&cus, hipDeviceAttributeMultiprocessorCount, dev) != hipSuccess) { grid = -1; return; }
        if (hipFuncSetAttribute((const void*)mega_fwd, hipFuncAttributeMaxDynamicSharedMemorySize, LDS_BYTES) != hipSuccess) { fprintf(stderr, "kernel_launch: hipFuncSetAttribute failed\n"); grid = -1; return; }
        if (hipOccupancyMaxActiveBlocksPerMultiprocessor(&per_cu, (const void*)mega_fwd, NWAVES * 64, LDS_BYTES) != hipSuccess || per_cu < 1) { fprintf(stderr, "kernel_launch: occupancy query says %d\n", per_cu); }
        (void)hipGetLastError();
        grid = cus;
    }
    if (grid < 0) return;
    if (hipMemsetAsync((char*)d_ws + WS_CTL + (size_t)CW_BAR * 4, 0, (size_t)XCD_BAR_WORDS * 4, stream) != hipSuccess) { fprintf(stderr, "kernel_launch: memset failed\n"); return; }
    Args a{};
    for (int i = 0; i < 28; ++i) a.in[i] = (const float*)d_in[i];
    a.out = (float*)d_out; a.ws = (unsigned char*)d_ws;
#if ONE_LAUNCH
    a.ph_lo = 0; a.ph_hi = NPHASE; a.use_bar = 1; a.flags = 0;
    hipLaunchKernelGGL(mega_fwd, dim3(grid), dim3(NWAVES * 64), LDS_BYTES, stream, a);
#else
    const float* x = a.in[0]; unsigned char* ws = a.ws; float* out = a.out;
    float* mod = (float*)(ws + WS_MOD); float* lam = (float*)(ws + WS_LAM);
    bf16_t* A0 = (bf16_t*)(ws + WS_S0); bf16_t* US = (bf16_t*)(ws + WS_S1); bf16_t* SZ = (bf16_t*)(ws + WS_S3); bf16_t* YG = (bf16_t*)(ws + WS_S4);
    bf16_t* Y2 = (bf16_t*)(ws + WS_S0); bf16_t* YO = (bf16_t*)(ws + WS_S1); bf16_t* AKV = (bf16_t*)(ws + WS_S0); bf16_t* AIN1 = (bf16_t*)(ws + WS_S2);
    bf16_t* KB = (bf16_t*)(ws + WS_S3); bf16_t* VB = (bf16_t*)(ws + WS_S4); bf16_t* QB = (bf16_t*)(ws + WS_S5); bf16_t* SZ1 = (bf16_t*)(ws + WS_S6);
    bf16_t* O0 = (bf16_t*)(ws + WS_S0); bf16_t* O1 = (bf16_t*)(ws + WS_S1); bf16_t* OG = (bf16_t*)(ws + WS_S2); bf16_t* YO1 = (bf16_t*)(ws + WS_S0);
    const int EG = 2048;
    auto fast1 = [&](int lo, int hi, int flags) { a.ph_lo = lo; a.ph_hi = hi; a.use_bar = 0; a.flags = flags; hipLaunchKernelGGL(mega_fwd, dim3(grid), dim3(NWAVES * 64), LDS_BYTES, stream, a); };
    auto fast = [&](int lo, int hi, int flags) { fast1(lo, hi, flags); if (lo == EXTRA_PHASE) fast1(lo, hi, flags); };
    const unsigned FM = FASTMASK;
    if (FM & 1u) fast(0, 1, 0);
    else { fast(0, 1, 1); n_adaln<<<(2 * 8 * 3072 + 255) / 256, 256, 0, stream>>>(a.in[1], a.in[2], a.in[3], mod); n_lambda<<<1, 64, 0, stream>>>(a.in[22], a.in[23], a.in[24], a.in[25], lam); }
    if (FM & 2u) fast(1, 2, 0); else n_norm0<<<EG, 256, 0, stream>>>(x, mod, a.in[4], A0);
    if (FM & 4u) fast(2, 3, 0); else n_gemm<<<dim3(2048 / 64, MTOK / 64), 256, 0, stream>>>(AL_Row{A0}, WL_Plain{a.in[6], 2048}, EP_In0{US, SZ}, 2048);
    if (FM & 8u) { fast(3, 4, 0); fast(4, 5, 0); fast(5, 6, 0); }
    else n_ssm<<<NB * NGRP / 4, 256, 0, stream>>>(US, a.in[7], a.in[8], a.in[9], a.in[10], a.in[11], a.in[12], a.in[13], a.in[14], YG);
    if (FM & 64u) fast(6, 7, 0); else n_gemm<<<dim3(1024 / 64, MTOK / 64), 256, 0, stream>>>(AL_YG{YG}, WL_Plain{a.in[15], 1024}, EP_Glu{YG, SZ, a.in[16], Y2}, 1024);
    if (FM & 128u) fast(7, 8, 0); else n_gemm<<<dim3(1024 / 64, MTOK / 64), 256, 0, stream>>>(AL_Row{Y2}, WL_Plain{a.in[17], 1024}, EP_Plain{YO}, 1024);
    if (FM & 256u) fast(8, 9, 0); else n_mid<<<EG, 256, 0, stream>>>(x, YO, mod, a.in[5], a.in[4], out, AKV, AIN1);
    if (FM & 512u) fast(9, 10, 0);
    else { n_gemm<<<dim3(2048 / 64, MTOK / 64), 256, 0, stream>>>(AL_Row{AKV}, WL_KV{a.in[19], a.in[20], a.in[18]}, EP_KV{KB, VB}, 2048);
           n_gemm<<<dim3(2048 / 64, MTOK / 64), 256, 0, stream>>>(AL_Row{AIN1}, WL_Plain{a.in[21], 2048}, EP_In1{QB, SZ1}, 2048); }
    if (FM & 1024u) fast(10, 11, 0); else n_attn<<<MTOK * 8 / 4, 256, 0, stream>>>(QB, KB, VB, O0, O1);
    if (FM & 2048u) fast(11, 12, 0); else n_attn_post<<<EG, 256, 0, stream>>>(O0, O1, SZ1, a.in[26], lam, OG);
    if (FM & 4096u) fast(12, 13, 0); else n_gemm<<<dim3(1024 / 64, MTOK / 64), 256, 0, stream>>>(AL_Row{OG}, WL_Plain{a.in[27], 1024}, EP_Plain{YO1}, 1024);
    if (FM & 8192u) fast(13, 14, 0); else n_final<<<EG, 256, 0, stream>>>(out, YO1, mod, a.in[5]);
#endif
    const hipError_t le = hipPeekAtLastError();
    if (le != hipSuccess) fprintf(stderr, "kernel_launch: launch failed: %s\n", hipGetErrorName(le));
}
```

```cpp
#include <hip/hip_runtime.h>
#include <cstdio>
#include <cstdint>
#include <cmath>
#define FASTMASK 0x3fff
#define ONE_LAUNCH 1
#define REPEAT_MASK 0

typedef unsigned short bf16_t;
constexpr int NB = 8, SEQL = 4096, DM = 1024, MTOK = NB * SEQL;
constexpr int NGRP = 64, NTILE = MTOK / 16;
constexpr int US_P = 384, YG_P = 256;
constexpr float LAMBDA_INIT = 0.35550907f;
constexpr float ONE_M_LI = 1.0f - LAMBDA_INIT;
constexpr float RMS_EPS = 1e-6f;
constexpr float QC2 = 0.125f * 1.4426950408889634f;

__device__ __forceinline__ float bf2f(bf16_t v) { return __uint_as_float((unsigned)v << 16); }
__device__ __forceinline__ unsigned f2bf_u(float f) { unsigned u = __float_as_uint(f); return (u + 0x7fffu + ((u >> 16) & 1u)) >> 16; }
__device__ __forceinline__ bf16_t f2bf(float f) { return (bf16_t)f2bf_u(f); }
__device__ __forceinline__ unsigned pk2bf(float lo, float hi) { return f2bf_u(lo) | (f2bf_u(hi) << 16); }
__device__ __forceinline__ float silu_f(float v) { return v / (1.0f + __expf(-v)); }
__device__ __forceinline__ float sigmoid_f(float v) { return 1.0f / (1.0f + __expf(-v)); }
__device__ __forceinline__ float gelu_tanh_f(float v) {
    const float u = 0.7978845608028654f * (v + 0.044715f * v * v * v);
    const float e = __expf(2.0f * u);
    const float t = 1.0f - 2.0f / (e + 1.0f);
    return 0.5f * v * (1.0f + t);
}
__device__ __forceinline__ float wave_sum_f(float v) {
#pragma unroll
    for (int o = 1; o < 64; o <<= 1) v += __shfl_xor(v, o);
    return v;
}
__device__ __forceinline__ float wave_max_f(float v) {
#pragma unroll
    for (int o = 1; o < 64; o <<= 1) v = fmaxf(v, __shfl_xor(v, o));
    return v;
}
__device__ __forceinline__ size_t us_off(int g, int tile, int col) { return ((size_t)g * NTILE + tile) * US_P + col; }
__device__ __forceinline__ size_t yg_off(int g, int tile, int col) { return ((size_t)g * NTILE + tile) * YG_P + col; }

typedef float f32x4_t __attribute__((ext_vector_type(4)));
typedef unsigned u32x4_t __attribute__((ext_vector_type(4)));
typedef unsigned u32x2_t __attribute__((ext_vector_type(2)));
#ifndef USE_NT
#define USE_NT 1
#endif
#if USE_NT
#define NT_LD(p) __builtin_nontemporal_load(p)
#define NT_ST(p, v) __builtin_nontemporal_store((v), (p))
#else
#define NT_LD(p) (*(p))
#define NT_ST(p, v) (*(p) = (v))
#endif

__device__ __forceinline__ void e_norm0(const float* __restrict__ x, const float* __restrict__ mod, const float* __restrict__ g_pre, bf16_t* a0, int gw, int ngw, int lane) {
    for (int m = gw; m < MTOK; m += ngw) {
        const int b = m / SEQL;
        const f32x4_t* xr = (const f32x4_t*)(x + (size_t)m * DM) + lane;
        f32x4_t v[4]; float s = 0.f;
#pragma unroll
        for (int j = 0; j < 4; ++j) { v[j] = NT_LD(xr + 64 * j); s += (v[j].x * v[j].x + v[j].y * v[j].y) + (v[j].z * v[j].z + v[j].w * v[j].w); }
        const float r = rsqrtf(wave_sum_f(s) * (1.0f / DM) + RMS_EPS);
        const float* sh = mod + (size_t)b * 3072; const float* sc = sh + 1024;
        u32x2_t* o = (u32x2_t*)(a0 + (size_t)m * DM) + lane;
#pragma unroll
        for (int j = 0; j < 4; ++j) {
            const int c = 256 * j + 4 * lane;
            const f32x4_t g = *(const f32x4_t*)(g_pre + c), scv = *(const f32x4_t*)(sc + c), shv = *(const f32x4_t*)(sh + c);
            f32x4_t y = v[j] * r * g * (scv + 1.0f) + shv;
            u32x2_t w; w.x = pk2bf(y.x, y.y); w.y = pk2bf(y.z, y.w); o[64 * j] = w;
        }
    }
}
__device__ __forceinline__ void e_mid(const float* __restrict__ x, const bf16_t* __restrict__ yo, const float* __restrict__ mod, const float* __restrict__ g_post, const float* __restrict__ g_pre,
                                      float* h1, bf16_t* h1b, bf16_t* akv, bf16_t* ain1, int gw, int ngw, int lane) {
    for (int m = gw; m < MTOK; m += ngw) {
        const int b = m / SEQL;
        const f32x4_t* xr = (const f32x4_t*)(x + (size_t)m * DM) + lane;
        const u32x2_t* yr = (const u32x2_t*)(yo + (size_t)m * DM) + lane;
        f32x4_t v[4], y[4]; float s = 0.f;
#pragma unroll
        for (int j = 0; j < 4; ++j) { v[j] = NT_LD(xr + 64 * j); const u32x2_t w = NT_LD(yr + 64 * j);
            y[j].x = __uint_as_float(w.x << 16); y[j].y = __uint_as_float(w.x & 0xffff0000u); y[j].z = __uint_as_float(w.y << 16); y[j].w = __uint_as_float(w.y & 0xffff0000u);
            s += (y[j].x * y[j].x + y[j].y * y[j].y) + (y[j].z * y[j].z + y[j].w * y[j].w); }
        const float ry = rsqrtf(wave_sum_f(s) * (1.0f / DM) + RMS_EPS);
        const float* gate0 = mod + (size_t)b * 3072 + 2048;
        const float* sh1 = mod + (size_t)(8 + b) * 3072; const float* sc1 = sh1 + 1024;
        float s2 = 0.f;
        f32x4_t* ho = (f32x4_t*)(h1 + (size_t)m * DM) + lane;
#pragma unroll
        for (int j = 0; j < 4; ++j) { const int c = 256 * j + 4 * lane;
            const f32x4_t gp = *(const f32x4_t*)(g_post + c), gt = *(const f32x4_t*)(gate0 + c);
            v[j] = v[j] + gt * (y[j] * ry * gp);
            if (h1) NT_ST(ho + 64 * j, v[j]);
            if (h1b) { u32x2_t wq; wq.x = pk2bf(v[j].x, v[j].y); wq.y = pk2bf(v[j].z, v[j].w); ((u32x2_t*)(h1b + (size_t)m * DM) + lane)[64 * j] = wq; }
            s2 += (v[j].x * v[j].x + v[j].y * v[j].y) + (v[j].z * v[j].z + v[j].w * v[j].w); }
        const float rh = rsqrtf(wave_sum_f(s2) * (1.0f / DM) + RMS_EPS);
        u32x2_t* o1 = (u32x2_t*)(akv + (size_t)m * DM) + lane; u32x2_t* o2 = (u32x2_t*)(ain1 + (size_t)m * DM) + lane;
#pragma unroll
        for (int j = 0; j < 4; ++j) { const int c = 256 * j + 4 * lane;
            const f32x4_t n = v[j] * rh;
            u32x2_t w; w.x = pk2bf(n.x, n.y); w.y = pk2bf(n.z, n.w); o1[64 * j] = w;
            const f32x4_t g = *(const f32x4_t*)(g_pre + 1024 + c), scv = *(const f32x4_t*)(sc1 + c), shv = *(const f32x4_t*)(sh1 + c);
            const f32x4_t z = n * g * (scv + 1.0f) + shv;
            w.x = pk2bf(z.x, z.y); w.y = pk2bf(z.z, z.w); o2[64 * j] = w; }
    }
}
__device__ __forceinline__ void e_attn_post(const bf16_t* __restrict__ o0, const bf16_t* __restrict__ o1, const bf16_t* __restrict__ sz1, const float* __restrict__ g_sub, float lam,
                                            bf16_t* og, int gw, int ngw, int lane) {
    for (int m = gw; m < MTOK; m += ngw) {
#pragma unroll
        for (int j = 0; j < 2; ++j) {
            const int c = 512 * j + 8 * lane;
            const u32x4_t a = *(const u32x4_t*)(o0 + (size_t)m * DM + c), bq = *(const u32x4_t*)(o1 + (size_t)m * DM + c), zq = *(const u32x4_t*)(sz1 + (size_t)m * DM + c);
            float d[8]; float s = 0.f;
#pragma unroll
            for (int i = 0; i < 4; ++i) { const unsigned wa = a[i], wb = bq[i];
                d[2 * i] = __uint_as_float(wa << 16) - lam * __uint_as_float(wb << 16); d[2 * i + 1] = __uint_as_float(wa & 0xffff0000u) - lam * __uint_as_float(wb & 0xffff0000u);
                s += d[2 * i] * d[2 * i] + d[2 * i + 1] * d[2 * i + 1]; }
            s += __shfl_xor(s, 1); s += __shfl_xor(s, 2); s += __shfl_xor(s, 4); s += __shfl_xor(s, 8);
            const float r = rsqrtf(s * (1.0f / 128.0f) + RMS_EPS) * ONE_M_LI;
            const float* gs = g_sub + (c & 127);
            u32x4_t w;
#pragma unroll
            for (int i = 0; i < 4; ++i) { const unsigned wz = zq[i];
                const float z0 = __uint_as_float(wz << 16), z1 = __uint_as_float(wz & 0xffff0000u);
                w[i] = pk2bf(d[2 * i] * r * gs[2 * i] * z0, d[2 * i + 1] * r * gs[2 * i + 1] * z1); }
            *(u32x4_t*)(og + (size_t)m * DM + c) = w;
        }
    }
}
__device__ __forceinline__ void e_final(float* out, const bf16_t* __restrict__ yo1, const float* __restrict__ mod, const float* __restrict__ g_post, int gw, int ngw, int lane) {
    for (int m = gw; m < MTOK; m += ngw) {
        const int b = m / SEQL;
        f32x4_t* hr = (f32x4_t*)(out + (size_t)m * DM) + lane;
        const u32x2_t* yr = (const u32x2_t*)(yo1 + (size_t)m * DM) + lane;
        f32x4_t v[4], y[4]; float s = 0.f;
#pragma unroll
        for (int j = 0; j < 4; ++j) { v[j] = NT_LD(hr + 64 * j); const u32x2_t w = NT_LD(yr + 64 * j);
            y[j].x = __uint_as_float(w.x << 16); y[j].y = __uint_as_float(w.x & 0xffff0000u); y[j].z = __uint_as_float(w.y << 16); y[j].w = __uint_as_float(w.y & 0xffff0000u);
            s += (y[j].x * y[j].x + y[j].y * y[j].y) + (y[j].z * y[j].z + y[j].w * y[j].w); }
        const float ry = rsqrtf(wave_sum_f(s) * (1.0f / DM) + RMS_EPS);
        const float* gate1 = mod + (size_t)(8 + b) * 3072 + 2048;
#pragma unroll
        for (int j = 0; j < 4; ++j) { const int c = 256 * j + 4 * lane;
            const f32x4_t gp = *(const f32x4_t*)(g_post + 1024 + c), gt = *(const f32x4_t*)(gate1 + c);
            NT_ST(hr + 64 * j, v[j] + gt * (y[j] * ry * gp)); }
    }
}
__device__ __forceinline__ void e_final2(const float* __restrict__ x, const bf16_t* __restrict__ yo, const bf16_t* __restrict__ yo1, float* out, const float* __restrict__ mod, const float* __restrict__ g_post, int gw, int ngw, int lane) {
    for (int m = gw; m < MTOK; m += ngw) {
        const int b = m / SEQL;
        const f32x4_t* xr = (const f32x4_t*)(x + (size_t)m * DM) + lane;
        const u32x2_t* y0r = (const u32x2_t*)(yo + (size_t)m * DM) + lane; const u32x2_t* y1r = (const u32x2_t*)(yo1 + (size_t)m * DM) + lane;
        f32x4_t v[4], y0[4], y1[4]; float s0 = 0.f, s1 = 0.f;
#pragma unroll
        for (int j = 0; j < 4; ++j) { v[j] = xr[64 * j]; const u32x2_t w0 = y0r[64 * j], w1 = y1r[64 * j];
            y0[j].x = __uint_as_float(w0.x << 16); y0[j].y = __uint_as_float(w0.x & 0xffff0000u); y0[j].z = __uint_as_float(w0.y << 16); y0[j].w = __uint_as_float(w0.y & 0xffff0000u);
            y1[j].x = __uint_as_float(w1.x << 16); y1[j].y = __uint_as_float(w1.x & 0xffff0000u); y1[j].z = __uint_as_float(w1.y << 16); y1[j].w = __uint_as_float(w1.y & 0xffff0000u);
            s0 += (y0[j].x * y0[j].x + y0[j].y * y0[j].y) + (y0[j].z * y0[j].z + y0[j].w * y0[j].w);
            s1 += (y1[j].x * y1[j].x + y1[j].y * y1[j].y) + (y1[j].z * y1[j].z + y1[j].w * y1[j].w); }
        const float r0 = rsqrtf(wave_sum_f(s0) * (1.0f / DM) + RMS_EPS), r1 = rsqrtf(wave_sum_f(s1) * (1.0f / DM) + RMS_EPS);
        const float* gate0 = mod + (size_t)b * 3072 + 2048; const float* gate1 = mod + (size_t)(8 + b) * 3072 + 2048;
        f32x4_t* orow = (f32x4_t*)(out + (size_t)m * DM) + lane;
#pragma unroll
        for (int j = 0; j < 4; ++j) { const int c = 256 * j + 4 * lane;
            const f32x4_t gp0 = *(const f32x4_t*)(g_post + c), gt0 = *(const f32x4_t*)(gate0 + c), gp1 = *(const f32x4_t*)(g_post + 1024 + c), gt1 = *(const f32x4_t*)(gate1 + c);
            const f32x4_t h = v[j] + gt0 * (y0[j] * r0 * gp0);
            orow[64 * j] = h + gt1 * (y1[j] * r1 * gp1); }
    }
}
__device__ __forceinline__ void e_final_b(const bf16_t* __restrict__ h1b, float* out, const bf16_t* __restrict__ yo1, const float* __restrict__ mod, const float* __restrict__ g_post, int gw, int ngw, int lane) {
    for (int m = gw; m < MTOK; m += ngw) {
        const int b = m / SEQL;
        const u32x2_t* hr = (const u32x2_t*)(h1b + (size_t)m * DM) + lane;
        const u32x2_t* yr = (const u32x2_t*)(yo1 + (size_t)m * DM) + lane;
        f32x4_t v[4], y[4]; float s = 0.f;
#pragma unroll
        for (int j = 0; j < 4; ++j) { const u32x2_t hw = NT_LD(hr + 64 * j); const u32x2_t w = NT_LD(yr + 64 * j);
            v[j].x = __uint_as_float(hw.x << 16); v[j].y = __uint_as_float(hw.x & 0xffff0000u); v[j].z = __uint_as_float(hw.y << 16); v[j].w = __uint_as_float(hw.y & 0xffff0000u);
            y[j].x = __uint_as_float(w.x << 16); y[j].y = __uint_as_float(w.x & 0xffff0000u); y[j].z = __uint_as_float(w.y << 16); y[j].w = __uint_as_float(w.y & 0xffff0000u);
            s += (y[j].x * y[j].x + y[j].y * y[j].y) + (y[j].z * y[j].z + y[j].w * y[j].w); }
        const float ry = rsqrtf(wave_sum_f(s) * (1.0f / DM) + RMS_EPS);
        const float* gate1 = mod + (size_t)(8 + b) * 3072 + 2048;
        f32x4_t* orow = (f32x4_t*)(out + (size_t)m * DM) + lane;
#pragma unroll
        for (int j = 0; j < 4; ++j) { const int c = 256 * j + 4 * lane;
            const f32x4_t gp = *(const f32x4_t*)(g_post + 1024 + c), gt = *(const f32x4_t*)(gate1 + c);
            NT_ST(orow + 64 * j, v[j] + gt * (y[j] * ry * gp)); }
    }
}

#define ER 2
__device__ __forceinline__ void unpk4(const u32x2_t w, f32x4_t& y) { y.x = __uint_as_float(w.x << 16); y.y = __uint_as_float(w.x & 0xffff0000u); y.z = __uint_as_float(w.y << 16); y.w = __uint_as_float(w.y & 0xffff0000u); }
__device__ __forceinline__ float ssq4(const f32x4_t v) { return (v.x * v.x + v.y * v.y) + (v.z * v.z + v.w * v.w); }
__device__ __forceinline__ void e_norm0_r(const float* __restrict__ x, const float* __restrict__ mod, const float* __restrict__ g_pre, bf16_t* a0, int gw, int ngw, int lane) {
    for (int m0 = gw; m0 < MTOK; m0 += ER * ngw) {
        f32x4_t v[ER][4]; float s[ER];
#pragma unroll
        for (int r = 0; r < ER; ++r) { const int m = min(m0 + r * ngw, MTOK - 1); const f32x4_t* xr = (const f32x4_t*)(x + (size_t)m * DM) + lane;
#pragma unroll
            for (int j = 0; j < 4; ++j) v[r][j] = NT_LD(xr + 64 * j); }
#pragma unroll
        for (int r = 0; r < ER; ++r) { s[r] = 0.f;
#pragma unroll
            for (int j = 0; j < 4; ++j) s[r] += ssq4(v[r][j]); }
#pragma unroll
        for (int r = 0; r < ER; ++r) { const int m = m0 + r * ngw; if (m >= MTOK) break;
            const int b = m / SEQL; const float rr = rsqrtf(wave_sum_f(s[r]) * (1.0f / DM) + RMS_EPS);
            const float* sh = mod + (size_t)b * 3072; const float* sc = sh + 1024;
            u32x2_t* o = (u32x2_t*)(a0 + (size_t)m * DM) + lane;
#pragma unroll
            for (int j = 0; j < 4; ++j) { const int c = 256 * j + 4 * lane;
                const f32x4_t g = *(const f32x4_t*)(g_pre + c), scv = *(const f32x4_t*)(sc + c), shv = *(const f32x4_t*)(sh + c);
                const f32x4_t y = v[r][j] * rr * g * (scv + 1.0f) + shv;
                u32x2_t w; w.x = pk2bf(y.x, y.y); w.y = pk2bf(y.z, y.w); o[64 * j] = w; } }
    }
}
__device__ __forceinline__ void e_mid_r(const float* __restrict__ x, const bf16_t* __restrict__ yo, const float* __restrict__ mod, const float* __restrict__ g_post, const float* __restrict__ g_pre,
                                        float* h1, bf16_t* akv, bf16_t* ain1, int gw, int ngw, int lane) {
    for (int m0 = gw; m0 < MTOK; m0 += ER * ngw) {
        f32x4_t v[ER][4], y[ER][4]; float s[ER];
#pragma unroll
        for (int r = 0; r < ER; ++r) { const int m = min(m0 + r * ngw, MTOK - 1); const f32x4_t* xr = (const f32x4_t*)(x + (size_t)m * DM) + lane; const u32x2_t* yr = (const u32x2_t*)(yo + (size_t)m * DM) + lane;
#pragma unroll
            for (int j = 0; j < 4; ++j) { v[r][j] = NT_LD(xr + 64 * j); unpk4(NT_LD(yr + 64 * j), y[r][j]); } }
#pragma unroll
        for (int r = 0; r < ER; ++r) { s[r] = 0.f;
#pragma unroll
            for (int j = 0; j < 4; ++j) s[r] += ssq4(y[r][j]); }
#pragma unroll
        for (int r = 0; r < ER; ++r) { const int m = m0 + r * ngw; if (m >= MTOK) break;
            const int b = m / SEQL; const float ry = rsqrtf(wave_sum_f(s[r]) * (1.0f / DM) + RMS_EPS);
            const float* gate0 = mod + (size_t)b * 3072 + 2048; const float* sh1 = mod + (size_t)(8 + b) * 3072; const float* sc1 = sh1 + 1024;
            float s2 = 0.f; f32x4_t* ho = (f32x4_t*)(h1 + (size_t)m * DM) + lane;
#pragma unroll
            for (int j = 0; j < 4; ++j) { const int c = 256 * j + 4 * lane;
                const f32x4_t gp = *(const f32x4_t*)(g_post + c), gt = *(const f32x4_t*)(gate0 + c);
                v[r][j] = v[r][j] + gt * (y[r][j] * ry * gp); NT_ST(ho + 64 * j, v[r][j]); s2 += ssq4(v[r][j]); }
            const float rh = rsqrtf(wave_sum_f(s2) * (1.0f / DM) + RMS_EPS);
            u32x2_t* o1 = (u32x2_t*)(akv + (size_t)m * DM) + lane; u32x2_t* o2 = (u32x2_t*)(ain1 + (size_t)m * DM) + lane;
#pragma unroll
            for (int j = 0; j < 4; ++j) { const int c = 256 * j + 4 * lane;
                const f32x4_t nn = v[r][j] * rh; u32x2_t w; w.x = pk2bf(nn.x, nn.y); w.y = pk2bf(nn.z, nn.w); o1[64 * j] = w;
                const f32x4_t g = *(const f32x4_t*)(g_pre + 1024 + c), scv = *(const f32x4_t*)(sc1 + c), shv = *(const f32x4_t*)(sh1 + c);
                const f32x4_t z = nn * g * (scv + 1.0f) + shv; w.x = pk2bf(z.x, z.y); w.y = pk2bf(z.z, z.w); o2[64 * j] = w; } }
    }
}
__device__ __forceinline__ void e_final_r(float* out, const bf16_t* __restrict__ yo1, const float* __restrict__ mod, const float* __restrict__ g_post, int gw, int ngw, int lane) {
    for (int m0 = gw; m0 < MTOK; m0 += ER * ngw) {
        f32x4_t v[ER][4], y[ER][4]; float s[ER];
#pragma unroll
        for (int r = 0; r < ER; ++r) { const int m = min(m0 + r * ngw, MTOK - 1); const f32x4_t* hr = (const f32x4_t*)(out + (size_t)m * DM) + lane; const u32x2_t* yr = (const u32x2_t*)(yo1 + (size_t)m * DM) + lane;
#pragma unroll
            for (int j = 0; j < 4; ++j) { v[r][j] = NT_LD(hr + 64 * j); unpk4(NT_LD(yr + 64 * j), y[r][j]); } }
#pragma unroll
        for (int r = 0; r < ER; ++r) { s[r] = 0.f;
#pragma unroll
            for (int j = 0; j < 4; ++j) s[r] += ssq4(y[r][j]); }
#pragma unroll
        for (int r = 0; r < ER; ++r) { const int m = m0 + r * ngw; if (m >= MTOK) break;
            const int b = m / SEQL; const float ry = rsqrtf(wave_sum_f(s[r]) * (1.0f / DM) + RMS_EPS);
            const float* gate1 = mod + (size_t)(8 + b) * 3072 + 2048; f32x4_t* hr = (f32x4_t*)(out + (size_t)m * DM) + lane;
#pragma unroll
            for (int j = 0; j < 4; ++j) { const int c = 256 * j + 4 * lane;
                const f32x4_t gp = *(const f32x4_t*)(g_post + 1024 + c), gt = *(const f32x4_t*)(gate1 + c);
                NT_ST(hr + 64 * j, v[r][j] + gt * (y[r][j] * ry * gp)); } }
    }
}

__device__ __forceinline__ void unpk4b(const u32x2_t w, f32x4_t& y) { y.x = __uint_as_float(w.x << 16); y.y = __uint_as_float(w.x & 0xffff0000u); y.z = __uint_as_float(w.y << 16); y.w = __uint_as_float(w.y & 0xffff0000u); }
__device__ __forceinline__ float ssq4b(const f32x4_t v) { return (v.x * v.x + v.y * v.y) + (v.z * v.z + v.w * v.w); }
__device__ __forceinline__ void e_norm0_b(const float* __restrict__ x, const float* __restrict__ mod, const float* __restrict__ g_pre, bf16_t* a0, int gw, int ngw, int lane, int b_lo = 0, int b_hi = NB) {
    for (int b = b_lo; b < b_hi; ++b) {
        const float* sh = mod + (size_t)b * 3072; const float* sc = sh + 1024;
        f32x4_t G[4], SH[4];
#pragma unroll
        for (int j = 0; j < 4; ++j) { const int c = 256 * j + 4 * lane; G[j] = *(const f32x4_t*)(g_pre + c) * (*(const f32x4_t*)(sc + c) + 1.0f); SH[j] = *(const f32x4_t*)(sh + c); }
        for (int r0 = gw; r0 < SEQL; r0 += 2 * ngw) {
            const int ra = r0, rb = r0 + ngw; const bool hb = rb < SEQL;
            const int ma = b * SEQL + ra, mb = b * SEQL + (hb ? rb : ra);
            f32x4_t va[4], vb[4];
            const f32x4_t* xa = (const f32x4_t*)(x + (size_t)ma * DM) + lane; const f32x4_t* xb = (const f32x4_t*)(x + (size_t)mb * DM) + lane;
#pragma unroll
            for (int j = 0; j < 4; ++j) { va[j] = NT_LD(xa + 64 * j); vb[j] = NT_LD(xb + 64 * j); }
            float sa = 0.f, sb = 0.f;
#pragma unroll
            for (int j = 0; j < 4; ++j) { sa += ssq4b(va[j]); sb += ssq4b(vb[j]); }
            const float rra = rsqrtf(wave_sum_f(sa) * (1.0f / DM) + RMS_EPS), rrb = rsqrtf(wave_sum_f(sb) * (1.0f / DM) + RMS_EPS);
            u32x2_t* oa = (u32x2_t*)(a0 + (size_t)ma * DM) + lane; u32x2_t* ob = (u32x2_t*)(a0 + (size_t)mb * DM) + lane;
#pragma unroll
            for (int j = 0; j < 4; ++j) { const f32x4_t y = va[j] * rra * G[j] + SH[j]; u32x2_t w; w.x = pk2bf(y.x, y.y); w.y = pk2bf(y.z, y.w); oa[64 * j] = w; }
            if (hb) {
#pragma unroll
                for (int j = 0; j < 4; ++j) { const f32x4_t y = vb[j] * rrb * G[j] + SH[j]; u32x2_t w; w.x = pk2bf(y.x, y.y); w.y = pk2bf(y.z, y.w); ob[64 * j] = w; } }
        }
    }
}
__device__ __forceinline__ void e_mid_b(const float* __restrict__ x, const bf16_t* __restrict__ yo, const float* __restrict__ mod, const float* __restrict__ g_post, const float* __restrict__ g_pre,
                                        float* h1, bf16_t* akv, bf16_t* ain1, int gw, int ngw, int lane, float* hnorm = nullptr, int b_lo = 0, int b_hi = NB) {
    for (int b = b_lo; b < b_hi; ++b) {
        const float* gate0 = mod + (size_t)b * 3072 + 2048; const float* sh1 = mod + (size_t)(8 + b) * 3072; const float* sc1 = sh1 + 1024;
        f32x4_t GG[4], GF[4], SH[4];
#pragma unroll
        for (int j = 0; j < 4; ++j) { const int c = 256 * j + 4 * lane; GG[j] = *(const f32x4_t*)(gate0 + c) * *(const f32x4_t*)(g_post + c);
            GF[j] = *(const f32x4_t*)(g_pre + 1024 + c) * (*(const f32x4_t*)(sc1 + c) + 1.0f); SH[j] = *(const f32x4_t*)(sh1 + c); }
        for (int r0 = gw; r0 < SEQL; r0 += 2 * ngw) {
            const int ra = r0, rb = r0 + ngw; const bool hb = rb < SEQL;
            const int mr[2] = {b * SEQL + ra, b * SEQL + (hb ? rb : ra)};
            f32x4_t v[2][4], y[2][4];
#pragma unroll
            for (int q = 0; q < 2; ++q) { const f32x4_t* xr = (const f32x4_t*)(x + (size_t)mr[q] * DM) + lane; const u32x2_t* yr = (const u32x2_t*)(yo + (size_t)mr[q] * DM) + lane;
#pragma unroll
                for (int j = 0; j < 4; ++j) { v[q][j] = NT_LD(xr + 64 * j); unpk4b(NT_LD(yr + 64 * j), y[q][j]); } }
            float s[2] = {0.f, 0.f};
#pragma unroll
            for (int q = 0; q < 2; ++q)
#pragma unroll
                for (int j = 0; j < 4; ++j) s[q] += ssq4b(y[q][j]);
            float ry[2]; ry[0] = rsqrtf(wave_sum_f(s[0]) * (1.0f / DM) + RMS_EPS); ry[1] = rsqrtf(wave_sum_f(s[1]) * (1.0f / DM) + RMS_EPS);
            float s2[2] = {0.f, 0.f};
#pragma unroll
            for (int q = 0; q < 2; ++q)
#pragma unroll
                for (int j = 0; j < 4; ++j) { v[q][j] = v[q][j] + GG[j] * (y[q][j] * ry[q]); s2[q] += ssq4b(v[q][j]); }
            float rh[2]; rh[0] = rsqrtf(wave_sum_f(s2[0]) * (1.0f / DM) + RMS_EPS); rh[1] = rsqrtf(wave_sum_f(s2[1]) * (1.0f / DM) + RMS_EPS);
            if (hnorm && lane == 0) { hnorm[mr[0]] = 1.0f / rh[0]; if (hb) hnorm[mr[1]] = 1.0f / rh[1]; }
#pragma unroll
            for (int q = 0; q < 2; ++q) { if (q == 1 && !hb) break;
                f32x4_t* ho = (f32x4_t*)(h1 + (size_t)mr[q] * DM) + lane; u32x2_t* o1 = (u32x2_t*)(akv + (size_t)mr[q] * DM) + lane; u32x2_t* o2 = (u32x2_t*)(ain1 + (size_t)mr[q] * DM) + lane;
#pragma unroll
                for (int j = 0; j < 4; ++j) { if (h1) NT_ST(ho + 64 * j, v[q][j]);
                    const f32x4_t nn = v[q][j] * rh[q]; u32x2_t w; w.x = pk2bf(nn.x, nn.y); w.y = pk2bf(nn.z, nn.w); o1[64 * j] = w;
                    const f32x4_t z = nn * GF[j] + SH[j]; w.x = pk2bf(z.x, z.y); w.y = pk2bf(z.z, z.w); o2[64 * j] = w; } }
        }
    }
}
__device__ __forceinline__ void e_final_bm(float* out, const bf16_t* __restrict__ yo1, const float* __restrict__ mod, const float* __restrict__ g_post, int gw, int ngw, int lane) {
    for (int b = 0; b < NB; ++b) {
        const float* gate1 = mod + (size_t)(8 + b) * 3072 + 2048;
        f32x4_t GG[4];
#pragma unroll
        for (int j = 0; j < 4; ++j) { const int c = 256 * j + 4 * lane; GG[j] = *(const f32x4_t*)(gate1 + c) * *(const f32x4_t*)(g_post + 1024 + c); }
        for (int r0 = gw; r0 < SEQL; r0 += 2 * ngw) {
            const int ra = r0, rb = r0 + ngw; const bool hb = rb < SEQL;
            const int mr[2] = {b * SEQL + ra, b * SEQL + (hb ? rb : ra)};
            f32x4_t v[2][4], y[2][4];
#pragma unroll
            for (int q = 0; q < 2; ++q) { const f32x4_t* hr = (const f32x4_t*)(out + (size_t)mr[q] * DM) + lane; const u32x2_t* yr = (const u32x2_t*)(yo1 + (size_t)mr[q] * DM) + lane;
#pragma unroll
                for (int j = 0; j < 4; ++j) { v[q][j] = NT_LD(hr + 64 * j); unpk4b(NT_LD(yr + 64 * j), y[q][j]); } }
            float s[2] = {0.f, 0.f};
#pragma unroll
            for (int q = 0; q < 2; ++q)
#pragma unroll
                for (int j = 0; j < 4; ++j) s[q] += ssq4b(y[q][j]);
            float ry[2]; ry[0] = rsqrtf(wave_sum_f(s[0]) * (1.0f / DM) + RMS_EPS); ry[1] = rsqrtf(wave_sum_f(s[1]) * (1.0f / DM) + RMS_EPS);
#pragma unroll
            for (int q = 0; q < 2; ++q) { if (q == 1 && !hb) break;
                f32x4_t* hr = (f32x4_t*)(out + (size_t)mr[q] * DM) + lane;
#pragma unroll
                for (int j = 0; j < 4; ++j) NT_ST(hr + 64 * j, v[q][j] + GG[j] * (y[q][j] * ry[q])); }
        }
    }
}
__device__ __forceinline__ void e_final_x(const float* __restrict__ x, const bf16_t* __restrict__ yo, const bf16_t* __restrict__ yo1, float* out, const float* __restrict__ mod, const float* __restrict__ g_post, int gw, int ngw, int lane) {
    for (int b = 0; b < NB; ++b) {
        const float* gate0 = mod + (size_t)b * 3072 + 2048; const float* gate1 = mod + (size_t)(8 + b) * 3072 + 2048;
        f32x4_t G0[4], G1[4];
#pragma unroll
        for (int j = 0; j < 4; ++j) { const int c = 256 * j + 4 * lane; G0[j] = *(const f32x4_t*)(gate0 + c) * *(const f32x4_t*)(g_post + c); G1[j] = *(const f32x4_t*)(gate1 + c) * *(const f32x4_t*)(g_post + 1024 + c); }
        for (int r0 = gw; r0 < SEQL; r0 += 2 * ngw) {
            const int ra = r0, rb = r0 + ngw; const bool hb = rb < SEQL;
            const int mr[2] = {b * SEQL + ra, b * SEQL + (hb ? rb : ra)};
            f32x4_t v[2][4], y0[2][4], y1[2][4];
#pragma unroll
            for (int q = 0; q < 2; ++q) { const f32x4_t* xr = (const f32x4_t*)(x + (size_t)mr[q] * DM) + lane; const u32x2_t* ar = (const u32x2_t*)(yo + (size_t)mr[q] * DM) + lane; const u32x2_t* br = (const u32x2_t*)(yo1 + (size_t)mr[q] * DM) + lane;
#pragma unroll
                for (int j = 0; j < 4; ++j) { v[q][j] = NT_LD(xr + 64 * j); unpk4b(NT_LD(ar + 64 * j), y0[q][j]); unpk4b(NT_LD(br + 64 * j), y1[q][j]); } }
            float s0[2] = {0.f, 0.f}, s1[2] = {0.f, 0.f};
#pragma unroll
            for (int q = 0; q < 2; ++q)
#pragma unroll
                for (int j = 0; j < 4; ++j) { s0[q] += ssq4b(y0[q][j]); s1[q] += ssq4b(y1[q][j]); }
            float r0_[2], r1_[2];
#pragma unroll
            for (int q = 0; q < 2; ++q) { r0_[q] = rsqrtf(wave_sum_f(s0[q]) * (1.0f / DM) + RMS_EPS); r1_[q] = rsqrtf(wave_sum_f(s1[q]) * (1.0f / DM) + RMS_EPS); }
#pragma unroll
            for (int q = 0; q < 2; ++q) { if (q == 1 && !hb) break;
                f32x4_t* orow = (f32x4_t*)(out + (size_t)mr[q] * DM) + lane;
#pragma unroll
                for (int j = 0; j < 4; ++j) { const f32x4_t h = v[q][j] + G0[j] * (y0[q][j] * r0_[q]); NT_ST(orow + 64 * j, h + G1[j] * (y1[q][j] * r1_[q])); } }
        }
    }
}
__device__ __forceinline__ void e_final_k(const bf16_t* __restrict__ akv, const float* __restrict__ hnorm, const bf16_t* __restrict__ yo1, float* out, const float* __restrict__ mod, const float* __restrict__ g_post, int gw, int ngw, int lane, int b_lo = 0, int b_hi = NB) {
    for (int b = b_lo; b < b_hi; ++b) {
        const float* gate1 = mod + (size_t)(8 + b) * 3072 + 2048;
        f32x4_t G1[4];
#pragma unroll
        for (int j = 0; j < 4; ++j) { const int c = 256 * j + 4 * lane; G1[j] = *(const f32x4_t*)(gate1 + c) * *(const f32x4_t*)(g_post + 1024 + c); }
        for (int r0 = gw; r0 < SEQL; r0 += 2 * ngw) {
            const int ra = r0, rb = r0 + ngw; const bool hb = rb < SEQL;
            const int mr[2] = {b * SEQL + ra, b * SEQL + (hb ? rb : ra)};
            f32x4_t v[2][4], y1[2][4]; float hn[2];
#pragma unroll
            for (int q = 0; q < 2; ++q) { const u32x2_t* ar = (const u32x2_t*)(akv + (size_t)mr[q] * DM) + lane; const u32x2_t* br = (const u32x2_t*)(yo1 + (size_t)mr[q] * DM) + lane; hn[q] = hnorm[mr[q]];
#pragma unroll
                for (int j = 0; j < 4; ++j) { unpk4b(NT_LD(ar + 64 * j), v[q][j]); unpk4b(NT_LD(br + 64 * j), y1[q][j]); } }
            float s1[2] = {0.f, 0.f};
#pragma unroll
            for (int q = 0; q < 2; ++q)
#pragma unroll
                for (int j = 0; j < 4; ++j) s1[q] += ssq4b(y1[q][j]);
            float r1_[2];
#pragma unroll
            for (int q = 0; q < 2; ++q) r1_[q] = rsqrtf(wave_sum_f(s1[q]) * (1.0f / DM) + RMS_EPS);
#pragma unroll
            for (int q = 0; q < 2; ++q) { if (q == 1 && !hb) break;
                f32x4_t* orow = (f32x4_t*)(out + (size_t)mr[q] * DM) + lane;
#pragma unroll
                for (int j = 0; j < 4; ++j) NT_ST(orow + 64 * j, v[q][j] * hn[q] + G1[j] * (y1[q][j] * r1_[q])); }
        }
    }
}
__device__ __forceinline__ float diff_lambda(const float* lq1, const float* lk1, const float* lq2, const float* lk2) {
    float s1 = 0.f, s2 = 0.f;
    for (int i = 0; i < 64; ++i) { s1 += lq1[i] * lk1[i]; s2 += lq2[i] * lk2[i]; }
    return expf(s1) - expf(s2) + LAMBDA_INIT;
}

__global__ void n_adaln(const float* __restrict__ c, const float* __restrict__ ada_w, const float* __restrict__ ada_b, float* mod) {
    const int idx = blockIdx.x * 256 + threadIdx.x;
    if (idx >= 2 * 8 * 3072) return;
    const int j = idx % 3072, b = (idx / 3072) % 8, l = idx / (3072 * 8);
    float acc = ada_b[l * 3072 + j];
    const float* w = ada_w + (size_t)l * 1024 * 3072 + j; const float* cb = c + b * 1024;
    for (int k = 0; k < 1024; ++k) acc += silu_f(cb[k]) * w[(size_t)k * 3072];
    mod[idx] = acc;
}
__global__ void n_lambda(const float* lq1, const float* lk1, const float* lq2, const float* lk2, float* out) {
    if (threadIdx.x == 0 && blockIdx.x == 0) out[0] = diff_lambda(lq1, lk1, lq2, lk2);
}
__global__ void n_norm0(const float* x, const float* mod, const float* g_pre, bf16_t* a0) {
    e_norm0(x, mod, g_pre, a0, blockIdx.x * 4 + (threadIdx.x >> 6), gridDim.x * 4, threadIdx.x & 63);
}
__global__ void n_mid(const float* x, const bf16_t* yo, const float* mod, const float* g_post, const float* g_pre, float* h1, bf16_t* akv, bf16_t* ain1) {
    e_mid(x, yo, mod, g_post, g_pre, h1, (bf16_t*)nullptr, akv, ain1, blockIdx.x * 4 + (threadIdx.x >> 6), gridDim.x * 4, threadIdx.x & 63);
}
__global__ void n_attn_post(const bf16_t* o0, const bf16_t* o1, const bf16_t* sz1, const float* g_sub, const float* lamp, bf16_t* og) {
    e_attn_post(o0, o1, sz1, g_sub, lamp[0], og, blockIdx.x * 4 + (threadIdx.x >> 6), gridDim.x * 4, threadIdx.x & 63);
}
__global__ void n_final(float* out, const bf16_t* yo1, const float* mod, const float* g_post) {
    e_final(out, yo1, mod, g_post, blockIdx.x * 4 + (threadIdx.x >> 6), gridDim.x * 4, threadIdx.x & 63);
}

struct AL_Row { const bf16_t* A; __device__ float ld(int m, int k) const { return bf2f(A[(size_t)m * DM + k]); } };
struct AL_YG  { const bf16_t* A; __device__ float ld(int m, int k) const { return bf2f(A[yg_off(k >> 4, m >> 4, (m & 15) * 16 + (k & 15))]); } };
struct WL_Plain { const float* W; long N; __device__ float ld(int k, int n) const { return W[(size_t)k * N + n]; } };
struct WL_KV { const float* wk; const float* wv; const float* g; __device__ float ld(int k, int n) const { return g[k] * (n < 1024 ? wk[(size_t)k * 1024 + n] : wv[(size_t)k * 1024 + n - 1024]); } };
struct EP_In0 { bf16_t* US; bf16_t* SZ; __device__ void st(int m, int n, float a) const {
    if (n < 1024) US[us_off(n >> 4, m >> 4, (m & 15) * 16 + (n & 15))] = f2bf(a); else SZ[(size_t)m * DM + n - 1024] = f2bf(silu_f(a)); } };
struct EP_Glu { const bf16_t* YG; const bf16_t* SZ; const float* bias; bf16_t* Y2; __device__ void st(int m, int n, float a) const {
    const float yv = bf2f(YG[yg_off(n >> 4, m >> 4, (m & 15) * 16 + (n & 15))]); const float t = a + bias[n];
    Y2[(size_t)m * DM + n] = f2bf(yv * sigmoid_f(t) * bf2f(SZ[(size_t)m * DM + n])); } };
struct EP_Plain { bf16_t* O; __device__ void st(int m, int n, float a) const { O[(size_t)m * DM + n] = f2bf(a); } };
struct EP_KV { bf16_t* K; bf16_t* V; __device__ void st(int m, int n, float a) const { if (n < 1024) K[(size_t)m * DM + n] = f2bf(a); else V[(size_t)m * DM + n - 1024] = f2bf(a); } };
struct EP_In1 { bf16_t* Q; bf16_t* SZ1; __device__ void st(int m, int n, float a) const { if (n < 1024) Q[(size_t)m * DM + n] = f2bf(a * QC2); else SZ1[(size_t)m * DM + n - 1024] = f2bf(silu_f(a)); } };

template <class AL, class WL, class EP>
__global__ void __launch_bounds__(256) n_gemm(AL al, WL wl, EP ep, int N) {
    __shared__ float As[16][68]; __shared__ float Ws[16][68];
    const int tid = threadIdx.x, tx = tid & 15, ty = tid >> 4;
    const int m0 = blockIdx.y * 64, n0 = blockIdx.x * 64;
    float acc[4][4];
#pragma unroll
    for (int i = 0; i < 4; ++i)
#pragma unroll
        for (int j = 0; j < 4; ++j) acc[i][j] = 0.f;
    for (int k0 = 0; k0 < 1024; k0 += 16) {
#pragma unroll
        for (int i = 0; i < 4; ++i) { const int e = tid + 256 * i; const int mm = e >> 4, kk = e & 15; As[kk][mm] = al.ld(m0 + mm, k0 + kk); }
#pragma unroll
        for (int i = 0; i < 4; ++i) { const int e = tid + 256 * i; const int kk = e >> 6, nn = e & 63; Ws[kk][nn] = wl.ld(k0 + kk, n0 + nn); }
        __syncthreads();
#pragma unroll
        for (int kk = 0; kk < 16; ++kk) {
            float a[4], b[4];
#pragma unroll
            for (int i = 0; i < 4; ++i) { a[i] = As[kk][ty * 4 + i]; b[i] = Ws[kk][tx * 4 + i]; }
#pragma unroll
            for (int i = 0; i < 4; ++i)
#pragma unroll
                for (int j = 0; j < 4; ++j) acc[i][j] += a[i] * b[j];
        }
        __syncthreads();
    }
#pragma unroll
    for (int i = 0; i < 4; ++i)
#pragma unroll
        for (int j = 0; j < 4; ++j) ep.st(m0 + ty * 4 + i, n0 + tx * 4 + j, acc[i][j]);
}

__global__ void __launch_bounds__(256) n_ssm(const bf16_t* __restrict__ US, const float* lam_re, const float* lam_im, const float* log_dt, const float* b_re, const float* b_im,
                                             const float* c_re, const float* c_im, const float* d_skip, bf16_t* YG) {
    const int wv = blockIdx.x * 4 + (threadIdx.x >> 6), lane = threadIdx.x & 63;
    if (wv >= NB * NGRP) return;
    const int b = wv / NGRP, g = wv % NGRP, p = lane;
    const float dt = expf(log_dt[g]);
    const float lr = lam_re[g * 64 + p], li = lam_im[g * 64 + p];
    const float mag = expf(lr * dt); float sn, cs; sn = sinf(li * dt); cs = cosf(li * dt);
    const float lbr = mag * cs, lbi = mag * sn;
    const float nr = lbr - 1.0f, ni = lbi, den = lr * lr + li * li;
    const float cr = (nr * lr + ni * li) / den, ci = (ni * lr - nr * li) / den;
    float bbr[16], bbi[16], ccr[16], cci[16];
#pragma unroll
    for (int c = 0; c < 16; ++c) { const float br = b_re[(g * 64 + p) * 16 + c], bi = b_im[(g * 64 + p) * 16 + c];
        bbr[c] = cr * br - ci * bi; bbi[c] = cr * bi + ci * br;
        ccr[c] = c_re[(g * 16 + c) * 64 + p]; cci[c] = c_im[(g * 16 + c) * 64 + p]; }
    const float dsk = d_skip[g * 16 + (lane & 15)];
    float sr = 0.f, si = 0.f;
    for (int t = 0; t < SEQL; ++t) {
        const int m = b * SEQL + t;
        const bf16_t* up = US + us_off(g, m >> 4, (m & 15) * 16);
        float u[16];
        { const u32x4_t w0 = *(const u32x4_t*)up, w1 = *(const u32x4_t*)(up + 8);
#pragma unroll
          for (int i = 0; i < 4; ++i) { u[2 * i] = __uint_as_float(w0[i] << 16); u[2 * i + 1] = __uint_as_float(w0[i] & 0xffff0000u); u[8 + 2 * i] = __uint_as_float(w1[i] << 16); u[8 + 2 * i + 1] = __uint_as_float(w1[i] & 0xffff0000u); } }
        float bur = 0.f, bui = 0.f;
#pragma unroll
        for (int c = 0; c < 16; ++c) { bur += bbr[c] * u[c]; bui += bbi[c] * u[c]; }
        const float nsr = lbr * sr - lbi * si + bur, nsi = lbr * si + lbi * sr + bui; sr = nsr; si = nsi;
        float yv = 0.f;
#pragma unroll
        for (int c = 0; c < 16; ++c) { const float part = wave_sum_f(ccr[c] * sr - cci[c] * si); if ((lane & 15) == c) yv = part; }
        if (lane < 16) { const float yy = yv + dsk * bf2f(up[lane]); YG[yg_off(g, m >> 4, (m & 15) * 16 + lane)] = f2bf(gelu_tanh_f(yy)); }
    }
}

__global__ void __launch_bounds__(256) n_attn(const bf16_t* __restrict__ Q, const bf16_t* __restrict__ K, const bf16_t* __restrict__ V, bf16_t* O0, bf16_t* O1) {
    __shared__ float qs[4][128];
    const int w = threadIdx.x >> 6, lane = threadIdx.x & 63;
    const int gwv = blockIdx.x * 4 + w;
    const int h = gwv & 7, m = gwv >> 3, b = m / SEQL, qi = m % SEQL;
    qs[w][lane] = bf2f(Q[(size_t)m * DM + h * 128 + lane]); qs[w][64 + lane] = bf2f(Q[(size_t)m * DM + h * 128 + 64 + lane]);
    __syncthreads();
    float m0 = -1e30f, m1 = -1e30f, l0 = 0.f, l1 = 0.f, a00 = 0.f, a01 = 0.f, a10 = 0.f, a11 = 0.f;
    const size_t rb = (size_t)b * SEQL;
    for (int kc = 0; kc * 64 <= qi; ++kc) {
        const int key = kc * 64 + lane; const bool valid = key <= qi;
        float s0 = 0.f, s1 = 0.f;
        { const bf16_t* kr = K + (rb + (valid ? key : qi)) * DM + h * 128;
#pragma unroll
          for (int ch = 0; ch < 8; ++ch) { const u32x4_t w0 = *(const u32x4_t*)(kr + ch * 8), w1 = *(const u32x4_t*)(kr + 64 + ch * 8);
#pragma unroll
            for (int i = 0; i < 4; ++i) { s0 += qs[w][ch * 8 + 2 * i] * __uint_as_float(w0[i] << 16) + qs[w][ch * 8 + 2 * i + 1] * __uint_as_float(w0[i] & 0xffff0000u);
                                          s1 += qs[w][64 + ch * 8 + 2 * i] * __uint_as_float(w1[i] << 16) + qs[w][64 + ch * 8 + 2 * i + 1] * __uint_as_float(w1[i] & 0xffff0000u); } } }
        if (!valid) { s0 = -1e30f; s1 = -1e30f; }
        const float nm0 = fmaxf(m0, wave_max_f(s0)), nm1 = fmaxf(m1, wave_max_f(s1));
        const float f0 = exp2f(m0 - nm0), f1 = exp2f(m1 - nm1);
        const float p0 = valid ? exp2f(s0 - nm0) : 0.f, p1 = valid ? exp2f(s1 - nm1) : 0.f;
        l0 = l0 * f0 + wave_sum_f(p0); l1 = l1 * f1 + wave_sum_f(p1); m0 = nm0; m1 = nm1;
        a00 *= f0; a01 *= f0; a10 *= f1; a11 *= f1;
        const int nk = min(64, qi - kc * 64 + 1);
        for (int j = 0; j < nk; ++j) {
            const float pj0 = __shfl(p0, j), pj1 = __shfl(p1, j);
            const bf16_t* vr = V + (rb + kc * 64 + j) * DM + h * 128;
            const float v0 = bf2f(vr[lane]), v1 = bf2f(vr[64 + lane]);
            a00 += pj0 * v0; a01 += pj0 * v1; a10 += pj1 * v0; a11 += pj1 * v1;
        }
    }
    const float i0 = 1.0f / l0, i1 = 1.0f / l1;
    O0[(size_t)m * DM + h * 128 + lane] = f2bf(a00 * i0); O0[(size_t)m * DM + h * 128 + 64 + lane] = f2bf(a01 * i0);
    O1[(size_t)m * DM + h * 128 + lane] = f2bf(a10 * i1); O1[(size_t)m * DM + h * 128 + 64 + lane] = f2bf(a11 * i1);
}
#ifndef REPEAT_MASK
#define REPEAT_MASK 0
#endif
#ifndef ATTN_V128
#define ATTN_V128 1
#endif
#ifndef EXTRA_PHASE
#define EXTRA_PHASE -1
#endif
#ifndef ATTN_FUSE_POST
#define ATTN_FUSE_POST 1
#endif
#ifndef H1_RECOMP
#define H1_RECOMP 1
#endif
#ifndef SSM_FUSED
#define SSM_FUSED 1
#endif
#ifndef ATTN_PRIO
#define ATTN_PRIO 0
#endif
#ifndef H1_BF16
#define H1_BF16 0
#endif
#ifndef H1_AKV
#define H1_AKV 1
#endif
#ifndef SSM_DFOLD
#define SSM_DFOLD 1
#endif
#ifndef XCC_LOCAL
#define XCC_LOCAL 1
#endif
#ifndef NT_OUT
#define NT_OUT 0
#endif
#if NT_OUT
#define ST_OUT(p, v) __builtin_nontemporal_store((v), (p))
#else
#define ST_OUT(p, v) (*(p) = (v))
#endif
#ifndef FUSE_EPI
#define FUSE_EPI 0
#endif
#ifndef ALIGN_E
#define ALIGN_E true
#endif
namespace pg8 {
#define PG8_LAS __attribute__((address_space(3)))
typedef short bf16x8 __attribute__((ext_vector_type(8)));
typedef float f32x4 __attribute__((ext_vector_type(4)));
typedef unsigned u32x4 __attribute__((ext_vector_type(4)));
constexpr int BM = 256, BK = 64, HALF = 128, HTB = HALF * BK * 2  , STAGE_BYTES = 8 * HTB, NXCD = 8, WGM = 8;

__host__ __device__ __forceinline__ int lds_byte(int r, int c) { const int st = (r >> 4) * 2 + (c >> 5), rr = r & 15, cc = c & 31, ob = rr * 64 + cc * 2; return st * 1024 + (ob ^ (((ob >> 9) & 1) << 5)); }
__host__ __device__ __forceinline__ void stage_rc(int b, int& R, int& C) { const int st = b / 1024, sb = b % 1024, swz = sb ^ (((sb >> 9) & 1) << 5); R = (st >> 1) * 16 + swz / 64; C = (st & 1) * 32 + (swz % 64) / 2; }
__host__ __device__ __forceinline__ int perm32(int rho) { const int n = rho >> 4, i = rho & 15; return 8 * (i >> 2) + 4 * n + (i & 3); }

struct Unit { int pm, pn, grp; };
struct Gemm {
    const char* A; const char* Bt; int nt, pad0;
    unsigned a_rs, a_c16; size_t a_kstep, a_tstep, a_gstep;
    unsigned b_rs, pad1; size_t b_tstep, b_gstep;
    __device__ __forceinline__ const char* abase(const Unit& u) const { return A + (size_t)u.grp * a_gstep + (size_t)u.pm * a_tstep; }
    __device__ __forceinline__ const char* bbase(const Unit& u) const { return Bt + (size_t)u.grp * b_gstep + (size_t)u.pn * b_tstep; }
};
__device__ __forceinline__ Gemm gemm_std(const void* A, int lda, const void* Bt, int ldb, int K) {
    Gemm g; g.A = (const char*)A; g.Bt = (const char*)Bt; g.nt = K / BK; g.pad0 = 0; g.a_rs = (unsigned)lda * 2u; g.a_c16 = 32u; g.a_kstep = BK * 2; g.a_tstep = (size_t)BM * lda * 2; g.a_gstep = 0;
    g.b_rs = (unsigned)ldb * 2u; g.pad1 = 0; g.b_tstep = (size_t)BM * ldb * 2; g.b_gstep = 0; return g;
}

struct Order {
    int nM, nN, nG, nwg, G, c, only, pm_off, mode2;
    __device__ __forceinline__ void init(int nM_, int nN_, int nG_, int G_, int c_) { nM = nM_; nN = nN_; nG = nG_; nwg = nM * nN * nG; G = G_; c = c_; only = -1; pm_off = 0; mode2 = 0; }
    __device__ __forceinline__ bool next(int i, Unit& u) const {
        if (only >= 0) { if (i > 0) return false; i = only; }
        const long L = (long)i * G + c; if (L >= nwg) return false;
        int wgid = (int)L; { const int q = nwg / NXCD, r = nwg % NXCD, xcd = wgid % NXCD, off = wgid / NXCD; wgid = (xcd < r ? xcd * (q + 1) : r * (q + 1) + (xcd - r) * q) + off; }
        if (mode2) {
            const int x = wgid >> 8, y = wgid & 255, bk = y >> 6, w2 = y & 63; u.grp = bk & 1; u.pm = (x * 2 + (bk >> 1)) * 8 + (w2 & 7); u.pn = w2 >> 3;
        } else
        { const int per = nM * nN; u.grp = wgid / per; const int w2 = wgid % per;
          const int nig = WGM * nN, gid = w2 / nig, fm = gid * WGM, gsz = (nM - fm) < WGM ? (nM - fm) : WGM;
          u.pm = pm_off + fm + ((w2 % nig) % gsz); u.pn = (w2 % nig) / gsz; }
        return true;
    }
};

__device__ __forceinline__ unsigned cvt_pk_bf16(float lo, float hi) { unsigned r; asm volatile("v_cvt_pk_bf16_f32 %0, %1, %2" : "=v"(r) : "v"(lo), "v"(hi)); return r; }
__device__ __forceinline__ u32x4 pack8(const f32x4 a, const f32x4 b) { u32x4 w; w.x = cvt_pk_bf16(a[0], a[1]); w.y = cvt_pk_bf16(a[2], a[3]); w.z = cvt_pk_bf16(b[0], b[1]); w.w = cvt_pk_bf16(b[2], b[3]); return w; }
__device__ __forceinline__ void unpack8(const u32x4 w, f32x4& a, f32x4& b) {
    a[0] = __uint_as_float(w.x << 16); a[1] = __uint_as_float(w.x & 0xffff0000u); a[2] = __uint_as_float(w.y << 16); a[3] = __uint_as_float(w.y & 0xffff0000u);
    b[0] = __uint_as_float(w.z << 16); b[1] = __uint_as_float(w.z & 0xffff0000u); b[2] = __uint_as_float(w.w << 16); b[3] = __uint_as_float(w.w & 0xffff0000u); }
__device__ __forceinline__ float fsilu(float v) { return v * __builtin_amdgcn_rcpf(1.0f + __expf(-v)); }
__device__ __forceinline__ float fsigm(float v) { return __builtin_amdgcn_rcpf(1.0f + __expf(-v)); }
__device__ __forceinline__ f32x4 silu4(f32x4 v) { f32x4 o; o[0] = fsilu(v[0]); o[1] = fsilu(v[1]); o[2] = fsilu(v[2]); o[3] = fsilu(v[3]); return o; }
__device__ __forceinline__ f32x4 sigm4(f32x4 v) { f32x4 o; o[0] = fsigm(v[0]); o[1] = fsigm(v[1]); o[2] = fsigm(v[2]); o[3] = fsigm(v[3]); return o; }
__device__ __forceinline__ float fgelu(float v) { const float u = 0.7978845608028654f * (v + 0.044715f * v * v * v); const float e = __expf(2.0f * u); return 0.5f * v * (2.0f - 2.0f * __builtin_amdgcn_rcpf(e + 1.0f)); }
__device__ __forceinline__ f32x4 gelu4(f32x4 v) { f32x4 o; o[0] = fgelu(v[0]); o[1] = fgelu(v[1]); o[2] = fgelu(v[2]); o[3] = fgelu(v[3]); return o; }

template <class F> struct EpiRow8 {
    static constexpr bool PERM = true, AFTER_DRAIN = false;
    F f;
    __device__ __forceinline__ void operator()(const f32x4 (&acc)[2][2][4][2], const Unit& u, int wr, int wc, int fr, int fq) const {
#pragma unroll
        for (int ai = 0; ai < 2; ++ai)
#pragma unroll
            for (int m = 0; m < 4; ++m) { const int row = u.pm * BM + ai * HALF + wr * 64 + m * 16 + fr;
#pragma unroll
                for (int bj = 0; bj < 2; ++bj) { const int col0 = u.pn * BM + bj * HALF + wc * 32 + 8 * fq; f.apply(u, row, col0, acc[ai][bj][m][0], acc[ai][bj][m][1]); } }
    }
};
struct F_In0 { bf16_t* US; bf16_t* SZ;
    __device__ __forceinline__ void apply(const Unit&, int row, int col0, f32x4 v0, f32x4 v1) const {
        if (col0 < 1024) ST_OUT((u32x4*)(US + us_off(col0 >> 4, row >> 4, (row & 15) * 16 + (col0 & 15))), pack8(v0, v1));
        else NT_ST((u32x4*)(SZ + (size_t)row * DM + (col0 - 1024)), pack8(silu4(v0), silu4(v1))); } };
struct F_SsmA { float* E;
    __device__ __forceinline__ void apply(const Unit& u, int row, int col0, f32x4 v0, f32x4 v1) const {
        if (col0 < 128) { float* p = E + ((size_t)u.grp * NTILE + row) * 128 + col0; *(f32x4*)p = v0; *(f32x4*)(p + 4) = v1; } } };
struct F_SsmB { const bf16_t* US; const float* dsk; bf16_t* YG;
    __device__ __forceinline__ void apply(const Unit& u, int row, int col0, f32x4 v0, f32x4 v1) const {
        const u32x4 uw = *(const u32x4*)(US + us_off(u.grp, row, col0)); f32x4 u0, u1; unpack8(uw, u0, u1);
        const float* d = dsk + u.grp * 16 + (col0 & 15); const f32x4 d0 = *(const f32x4*)d, d1 = *(const f32x4*)(d + 4);
        ST_OUT((u32x4*)(YG + yg_off(u.grp, row, col0)), pack8(gelu4(v0 + d0 * u0), gelu4(v1 + d1 * u1))); } };
struct F_SsmB0 { bf16_t* YG;
    __device__ __forceinline__ void apply(const Unit& u, int row, int col0, f32x4 v0, f32x4 v1) const {
        *(u32x4*)(YG + yg_off(u.grp, row, col0)) = pack8(gelu4(v0), gelu4(v1)); } };
struct F_Glu { const bf16_t* YG; const bf16_t* SZ; const float* bias; bf16_t* Y2;
    __device__ __forceinline__ void apply(const Unit&, int row, int col0, f32x4 v0, f32x4 v1) const {
        const u32x4 yw = *(const u32x4*)(YG + yg_off(col0 >> 4, row >> 4, (row & 15) * 16 + (col0 & 15))); f32x4 y0, y1; unpack8(yw, y0, y1);
        const u32x4 zw = NT_LD((const u32x4*)(SZ + (size_t)row * DM + col0)); f32x4 z0, z1; unpack8(zw, z0, z1);
        const f32x4 b0 = *(const f32x4*)(bias + col0), b1 = *(const f32x4*)(bias + col0 + 4);
        ST_OUT((u32x4*)(Y2 + (size_t)row * DM + col0), pack8(y0 * sigm4(v0 + b0) * z0, y1 * sigm4(v1 + b1) * z1)); } };
template <class F> struct EpiRow8L {
    static constexpr bool PERM = true, AFTER_DRAIN = false;
    F f;
    __device__ __forceinline__ void operator()(const f32x4 (&acc)[2][2][4][2], const Unit& u, int wr, int wc, int fr, int fq) const {
#pragma unroll
        for (int ai = 0; ai < 2; ++ai) {
            typename F::Pre pre[4][2];
#pragma unroll
            for (int m = 0; m < 4; ++m) { const int row = u.pm * BM + ai * HALF + wr * 64 + m * 16 + fr;
#pragma unroll
                for (int bj = 0; bj < 2; ++bj) { const int col0 = u.pn * BM + bj * HALF + wc * 32 + 8 * fq; f.load(u, row, col0, pre[m][bj]); } }
#pragma unroll
            for (int m = 0; m < 4; ++m) { const int row = u.pm * BM + ai * HALF + wr * 64 + m * 16 + fr;
#pragma unroll
                for (int bj = 0; bj < 2; ++bj) { const int col0 = u.pn * BM + bj * HALF + wc * 32 + 8 * fq; f.apply(u, row, col0, acc[ai][bj][m][0], acc[ai][bj][m][1], pre[m][bj]); } }
        }
    }
};
struct F_SsmB2 { const bf16_t* US; const float* dsk; bf16_t* YG;
    struct Pre { u32x4 uw; };
    __device__ __forceinline__ void load(const Unit& u, int row, int col0, Pre& p) const { p.uw = *(const u32x4*)(US + us_off(u.grp, row, col0)); }
    __device__ __forceinline__ void apply(const Unit& u, int row, int col0, f32x4 v0, f32x4 v1, const Pre& p) const {
        f32x4 u0, u1; unpack8(p.uw, u0, u1);
        const float* d = dsk + u.grp * 16 + (col0 & 15); const f32x4 d0 = *(const f32x4*)d, d1 = *(const f32x4*)(d + 4);
        *(u32x4*)(YG + yg_off(u.grp, row, col0)) = pack8(gelu4(v0 + d0 * u0), gelu4(v1 + d1 * u1)); } };
struct F_Glu2 { const bf16_t* YG; const bf16_t* SZ; const float* bias; bf16_t* Y2;
    struct Pre { u32x4 yw, zw; };
    __device__ __forceinline__ void load(const Unit&, int row, int col0, Pre& p) const {
        p.yw = *(const u32x4*)(YG + yg_off(col0 >> 4, row >> 4, (row & 15) * 16 + (col0 & 15))); p.zw = *(const u32x4*)(SZ + (size_t)row * DM + col0); }
    __device__ __forceinline__ void apply(const Unit&, int row, int col0, f32x4 v0, f32x4 v1, const Pre& p) const {
        f32x4 y0, y1, z0, z1; unpack8(p.yw, y0, y1); unpack8(p.zw, z0, z1);
        const f32x4 b0 = *(const f32x4*)(bias + col0), b1 = *(const f32x4*)(bias + col0 + 4);
        *(u32x4*)(Y2 + (size_t)row * DM + col0) = pack8(y0 * sigm4(v0 + b0) * z0, y1 * sigm4(v1 + b1) * z1); } };
struct F_Split2 { bf16_t* Olo[2]; bf16_t* Ohi[2];
    __device__ __forceinline__ void apply(const Unit& u, int row, int col0, f32x4 v0, f32x4 v1) const {
        if (u.grp == 0) { bf16_t* o = (col0 < 1024) ? Olo[0] + (size_t)row * DM + col0 : Ohi[0] + (size_t)row * DM + (col0 - 1024); NT_ST((u32x4*)o, pack8(v0, v1)); }
        else if (col0 < 1024) NT_ST((u32x4*)(Olo[1] + (size_t)row * DM + col0), pack8(v0 * QC2, v1 * QC2));
        else NT_ST((u32x4*)(Ohi[1] + (size_t)row * DM + (col0 - 1024)), pack8(silu4(v0), silu4(v1))); } };
struct F_Plain { bf16_t* O;
    __device__ __forceinline__ void apply(const Unit&, int row, int col0, f32x4 v0, f32x4 v1) const { ST_OUT((u32x4*)(O + (size_t)row * DM + col0), pack8(v0, v1)); } };
struct F_Split { bf16_t* Olo; bf16_t* Ohi; float sc_lo; int silu_hi;
    __device__ __forceinline__ void apply(const Unit&, int row, int col0, f32x4 v0, f32x4 v1) const {
        if (col0 < 1024) *(u32x4*)(Olo + (size_t)row * DM + col0) = pack8(v0 * sc_lo, v1 * sc_lo);
        else { if (silu_hi) { NT_ST((u32x4*)(Ohi + (size_t)row * DM + (col0 - 1024)), pack8(silu4(v0), silu4(v1))); } else *(u32x4*)(Ohi + (size_t)row * DM + (col0 - 1024)) = pack8(v0, v1); } } };


struct PanelRms {
    unsigned* xbuf;
    unsigned* cnt;
    unsigned* tmo;
    float eps;
    __device__ __forceinline__ bool run(const f32x4 (&v)[2][2][4][2], const Unit& u, int wr, int wc, int fr, int fq, PG8_LAS unsigned char* lds, int wid, int lane) const {
        PG8_LAS float* P = (PG8_LAS float*)lds;
        PG8_LAS float* S = (PG8_LAS float*)(lds + 8192);
        PG8_LAS unsigned* flag = (PG8_LAS unsigned*)(lds + 8192 + 2048);
#pragma unroll
        for (int ai = 0; ai < 2; ++ai)
#pragma unroll
            for (int m = 0; m < 4; ++m) {
                float q = 0.f;
#pragma unroll
                for (int bj = 0; bj < 2; ++bj)
#pragma unroll
                    for (int n = 0; n < 2; ++n) { const f32x4 d = v[ai][bj][m][n]; q += (d[0] * d[0] + d[1] * d[1]) + (d[2] * d[2] + d[3] * d[3]); }
                q += __shfl_xor(q, 16); q += __shfl_xor(q, 32);
                if (fq == 0) P[(ai * HALF + wr * 64 + m * 16 + fr) * 4 + wc] = q;
            }
        asm volatile("s_waitcnt lgkmcnt(0)" ::: "memory"); __builtin_amdgcn_s_barrier(); asm volatile("" ::: "memory");
        const int row = wid * 32 + (lane & 31);
        if (lane < 32) {
            const float tot = (P[row * 4 + 0] + P[row * 4 + 1]) + (P[row * 4 + 2] + P[row * 4 + 3]);
            unsigned long long* slot = (unsigned long long*)xbuf + ((size_t)(u.pm * BM + row) * 4 + u.pn);
            __hip_atomic_store(slot, (unsigned long long)__float_as_uint(tot), __ATOMIC_RELAXED, __HIP_MEMORY_SCOPE_AGENT);
        }
        asm volatile("s_waitcnt vmcnt(0)" ::: "memory");
        if (lane == 0) __hip_atomic_fetch_add(cnt + 64 * u.pm, 1u, __ATOMIC_RELAXED, __HIP_MEMORY_SCOPE_AGENT);
        if (wid == 0) {
            bool dead = false; const unsigned long long t0 = __builtin_amdgcn_s_memrealtime(); const unsigned want = 32u;
            for (;;) {
                if ((unsigned)__builtin_amdgcn_readfirstlane(__hip_atomic_load(cnt + 64 * u.pm, __ATOMIC_RELAXED, __HIP_MEMORY_SCOPE_AGENT)) >= want) break;
                if (__builtin_amdgcn_s_memrealtime() - t0 > 2000000ull) { if (lane == 0) __hip_atomic_store(tmo, 1u, __ATOMIC_RELAXED, __HIP_MEMORY_SCOPE_AGENT); dead = true; break; }
                __builtin_amdgcn_s_sleep(2);
            }
            __builtin_amdgcn_fence(__ATOMIC_ACQUIRE, "agent");
            if (lane == 0) flag[0] = dead ? 1u : 0u;
        }
        asm volatile("s_waitcnt vmcnt(0) lgkmcnt(0)" ::: "memory"); __builtin_amdgcn_s_barrier(); asm volatile("" ::: "memory");
        const bool bad = flag[0] != 0u;
        if (lane < 32) {
            const unsigned long long* slot = (const unsigned long long*)xbuf + (size_t)(u.pm * BM + row) * 4; float t4[4];
#pragma unroll
            for (int t = 0; t < 4; ++t) t4[t] = __uint_as_float((unsigned)__hip_atomic_load(slot + t, __ATOMIC_RELAXED, __HIP_MEMORY_SCOPE_AGENT));
            S[row] = rsqrtf(((t4[0] + t4[1]) + (t4[2] + t4[3])) * (1.0f / 1024.0f) + eps);
        }
        asm volatile("s_waitcnt lgkmcnt(0)" ::: "memory"); __builtin_amdgcn_s_barrier(); asm volatile("" ::: "memory");
        return bad;
    }
};
struct EpiFinal {
    static constexpr bool PERM = false, AFTER_DRAIN = true;
    const float* base; float* out; const float* mod1; const float* gpost1; PanelRms st;
    __device__ __forceinline__ void fused(f32x4 (&acc)[2][2][4][2], const Unit& u, int wr, int wc, int fr, int fq, PG8_LAS unsigned char* lds, int wid, int lane) const {
        const PG8_LAS float* S = (const PG8_LAS float*)(lds + 8192);
        const int col0 = u.pn * BM + wc * 32 + 4 * fq; const int b = u.pm >> 4;
        const float* gate = mod1 + (size_t)b * 3072 + 2048;
        const bool bad = st.run(acc, u, wr, wc, fr, fq, lds, wid, lane);
        const float qnan = __builtin_nanf("");
        f32x4 gg[2][2];
#pragma unroll
        for (int bj = 0; bj < 2; ++bj)
#pragma unroll
            for (int n = 0; n < 2; ++n) gg[bj][n] = *(const f32x4*)(gate + col0 + bj * HALF + n * 16) * *(const f32x4*)(gpost1 + col0 + bj * HALF + n * 16);
#pragma unroll
        for (int ai = 0; ai < 2; ++ai)
#pragma unroll
            for (int m = 0; m < 4; ++m) { const int r = ai * HALF + wr * 64 + m * 16 + fr; const float sr = S[r]; const size_t off = (size_t)(u.pm * BM + r) * DM + col0;
#pragma unroll
                for (int bj = 0; bj < 2; ++bj)
#pragma unroll
                    for (int n = 0; n < 2; ++n) { const f32x4 bs = *(const f32x4*)(base + off + bj * HALF + n * 16); f32x4 o = bs + gg[bj][n] * (acc[ai][bj][m][n] * sr);
                        if (bad) o = (f32x4){qnan, qnan, qnan, qnan}; *(f32x4*)(out + off + bj * HALF + n * 16) = o; }
                if (m & 1) asm volatile("" ::: "memory"); }
    }
};
struct EpiMid {
    static constexpr bool PERM = false, AFTER_DRAIN = true;
    const float* x; float* out; bf16_t* akv; bf16_t* ain1; const float* mod; const float* gpost0; const float* gpre1; PanelRms st1, st2;
    __device__ __forceinline__ void fused(f32x4 (&acc)[2][2][4][2], const Unit& u, int wr, int wc, int fr, int fq, PG8_LAS unsigned char* lds, int wid, int lane) const {
        typedef unsigned u32x2v __attribute__((ext_vector_type(2)));
        const PG8_LAS float* S = (const PG8_LAS float*)(lds + 8192);
        const int col0 = u.pn * BM + wc * 32 + 4 * fq; const int b = u.pm >> 4;
        const float* gate0 = mod + (size_t)b * 3072 + 2048; const float* sh1 = mod + (size_t)(8 + b) * 3072; const float* sc1 = sh1 + 1024;
        bool bad = st1.run(acc, u, wr, wc, fr, fq, lds, wid, lane);
        {
            f32x4 gg[2][2];
#pragma unroll
            for (int bj = 0; bj < 2; ++bj)
#pragma unroll
                for (int n = 0; n < 2; ++n) gg[bj][n] = *(const f32x4*)(gate0 + col0 + bj * HALF + n * 16) * *(const f32x4*)(gpost0 + col0 + bj * HALF + n * 16);
#pragma unroll
            for (int ai = 0; ai < 2; ++ai)
#pragma unroll
                for (int m = 0; m < 4; ++m) { const int r = ai * HALF + wr * 64 + m * 16 + fr; const float sr = S[r]; const size_t off = (size_t)(u.pm * BM + r) * DM + col0;
#pragma unroll
                    for (int bj = 0; bj < 2; ++bj)
#pragma unroll
                        for (int n = 0; n < 2; ++n) { const f32x4 bs = *(const f32x4*)(x + off + bj * HALF + n * 16); acc[ai][bj][m][n] = bs + gg[bj][n] * (acc[ai][bj][m][n] * sr); }
                    asm volatile("" : "+v"(acc[ai][0][m][0]), "+v"(acc[ai][0][m][1]), "+v"(acc[ai][1][m][0]), "+v"(acc[ai][1][m][1]));
                    if (m & 1) asm volatile("" ::: "memory"); }
        }
        bad = st2.run(acc, u, wr, wc, fr, fq, lds, wid, lane) || bad;
        const float qnan = __builtin_nanf("");
#pragma unroll
        for (int bj = 0; bj < 2; ++bj)
#pragma unroll
            for (int n = 0; n < 2; ++n) { const int c = col0 + bj * HALF + n * 16;
                const f32x4 gf = *(const f32x4*)(gpre1 + c) * (*(const f32x4*)(sc1 + c) + 1.0f), sh = *(const f32x4*)(sh1 + c);
#pragma unroll
                for (int ai = 0; ai < 2; ++ai)
#pragma unroll
                    for (int m = 0; m < 4; ++m) { const int r = ai * HALF + wr * 64 + m * 16 + fr; const float sr = S[r]; const size_t off = (size_t)(u.pm * BM + r) * DM + c;
                        f32x4 h = acc[ai][bj][m][n]; if (bad) h = (f32x4){qnan, qnan, qnan, qnan};
                        *(f32x4*)(out + off) = h;
                        const f32x4 nr = h * sr; u32x2v w; w.x = cvt_pk_bf16(nr[0], nr[1]); w.y = cvt_pk_bf16(nr[2], nr[3]); *(u32x2v*)(akv + off) = w;
                        const f32x4 z = nr * gf + sh; w.x = cvt_pk_bf16(z[0], z[1]); w.y = cvt_pk_bf16(z[2], z[3]); *(u32x2v*)(ain1 + off) = w; }
                asm volatile("" ::: "memory"); }
    }
};

struct EpiScan {
    static constexpr bool PERM = true, AFTER_DRAIN = true;
    const float* lb16; bf16_t* US; int carry_off;
    __device__ __forceinline__ void fused(f32x4 (&acc)[2][2][4][2], const Unit& u, int wr, int wc, int fr, int fq, PG8_LAS unsigned char* lds, int wid, int lane) const {
#pragma unroll
        for (int ai = 0; ai < 2; ++ai)
#pragma unroll
            for (int m = 0; m < 4; ++m) { const int row = ai * HALF + wr * 64 + m * 16 + fr; const int ch = (wc * 32 + 8 * fq) >> 2;
                *(PG8_LAS f32x4*)(lds + row * 512 + ((ch ^ (row & 7)) << 4)) = acc[ai][0][m][0];
                *(PG8_LAS f32x4*)(lds + row * 512 + (((ch + 1) ^ (row & 7)) << 4)) = acc[ai][0][m][1]; }
        asm volatile("s_waitcnt lgkmcnt(0)" ::: "memory"); __builtin_amdgcn_s_barrier(); asm volatile("" ::: "memory");
        const int p = lane, g = u.grp, b = u.pm;
        const float lr = lb16[(g * 64 + p) * 2], li = lb16[(g * 64 + p) * 2 + 1];
        typedef float f32x2v __attribute__((ext_vector_type(2)));
        const int coff = ((p >> 1) << 4) + (p & 1) * 8;
        float sr = 0.f, si = 0.f;
#pragma unroll 8
        for (int j = 0; j < 32; ++j) { const int t = wid * 32 + j; const f32x2v e = *(const PG8_LAS f32x2v*)(lds + t * 512 + (coff ^ ((t & 7) << 4)));
            const float nr = lr * sr - li * si + e.x, ni = lr * si + li * sr + e.y; sr = nr; si = ni; }
        PG8_LAS f32x2v* C = (PG8_LAS f32x2v*)(lds + carry_off);
        C[wid * 64 + p] = (f32x2v){sr, si};
        float pr = lr, pi = li;
#pragma unroll
        for (int q = 0; q < 5; ++q) { const float nr = pr * pr - pi * pi, ni = 2.f * pr * pi; pr = nr; pi = ni; }
        asm volatile("s_waitcnt lgkmcnt(0)" ::: "memory"); __builtin_amdgcn_s_barrier(); asm volatile("" ::: "memory");
        sr = 0.f; si = 0.f;
        for (int v = 0; v < wid; ++v) { const f32x2v c = C[v * 64 + p]; const float nr = pr * sr - pi * si + c.x, ni = pr * si + pi * sr + c.y; sr = nr; si = ni; }
        bf16_t* sp = US + us_off(g, b * 256 + wid * 32, 256 + 2 * p);
#pragma unroll 8
        for (int j = 0; j < 32; ++j) { const int t = wid * 32 + j; const f32x2v e = *(const PG8_LAS f32x2v*)(lds + t * 512 + (coff ^ ((t & 7) << 4)));
            *(unsigned*)(sp + (size_t)j * US_P) = cvt_pk_bf16(sr, si);
            const float nr = lr * sr - li * si + e.x, ni = lr * si + li * sr + e.y; sr = nr; si = ni; }
        asm volatile("s_waitcnt vmcnt(0)" ::: "memory");
    }
};
template <class Epi, bool ALIGN_EPI>
__device__ __forceinline__ void gemm_phase(PG8_LAS unsigned char* lds, const Gemm g, const Order& S, const Epi& E, int tid_in) {
    int tid_ = tid_in; asm volatile("" : "+v"(tid_));
    const int tid = tid_, wid = __builtin_amdgcn_readfirstlane(tid >> 6), lane = tid & 63, wr = wid >> 2, wc = wid & 3, fr = lane & 15, fq = lane >> 4;
    const int nt = g.nt;
    unsigned voffA[2], voffB[2];
#pragma unroll
    for (int i = 0; i < 2; ++i) { int R, C; stage_rc(tid * 16 + i * 8192, R, C); const int Rb = Epi::PERM ? ((R & ~31) + perm32(R & 31)) : R;
        voffA[i] = (unsigned)R * g.a_rs + (unsigned)(C >> 4) * g.a_c16 + (unsigned)(C & 15) * 2u; voffB[i] = (unsigned)Rb * g.b_rs + (unsigned)C * 2u; }
    const size_t kstepA = g.a_kstep, kstepB = (size_t)(BK * 2);
    const size_t hstepA = (size_t)HALF * g.a_rs, hstepB = (size_t)HALF * g.b_rs;
    const unsigned ldsw = (unsigned)wid * 1024u;
    const int aoff = lds_byte(wr * 64 + fr, fq * 8), boff = lds_byte(wc * 32 + fr, fq * 8);
#define PG8_SA(b, h) (((b) * 2 + (h)) * HTB)
#define PG8_SB(b, h) ((4 + (b) * 2 + (h)) * HTB)
#define PG8_STAGE(bufoff, gbase, voff) do { _Pragma("unroll") for (int _i = 0; _i < 2; ++_i) \
        __builtin_amdgcn_global_load_lds((const unsigned*)((const char*)(gbase) + (voff)[_i]), (PG8_LAS unsigned*)(lds + (bufoff) + ldsw + _i * 8192), 16, 0, 0); } while (0)
#define PG8_LDA(dst, b, h) do { _Pragma("unroll") for (int m = 0; m < 4; ++m) _Pragma("unroll") for (int k = 0; k < 2; ++k) dst[m][k] = *(const PG8_LAS bf16x8*)(lds + PG8_SA(b, h) + aoff + m * 2048 + k * 1024); } while (0)
#define PG8_LDB(dst, b, h) do { _Pragma("unroll") for (int n = 0; n < 2; ++n) _Pragma("unroll") for (int k = 0; k < 2; ++k) dst[n][k] = *(const PG8_LAS bf16x8*)(lds + PG8_SB(b, h) + boff + n * 2048 + k * 1024); } while (0)
#define PG8_MMA(ai, bj, At, Bt) do { __builtin_amdgcn_s_setprio(1); _Pragma("unroll") for (int m = 0; m < 4; ++m) _Pragma("unroll") for (int n = 0; n < 2; ++n) _Pragma("unroll") for (int k = 0; k < 2; ++k) \
        acc[ai][bj][m][n] = __builtin_amdgcn_mfma_f32_16x16x32_bf16(Bt[n][k], At[m][k], acc[ai][bj][m][n], 0, 0, 0); __builtin_amdgcn_s_setprio(0); } while (0)
#define PG8_WAIT_V(n) asm volatile("s_waitcnt vmcnt(" #n ")" ::: "memory")
#define PG8_WAIT_L(n) asm volatile("s_waitcnt lgkmcnt(" #n ")" ::: "memory")
#define PG8_BAR __builtin_amdgcn_s_barrier()
#define PG8_SCHED __builtin_amdgcn_sched_barrier(0)
    Unit cur, nxt; int ui = 0;
    if (!S.next(0, cur)) return;
    f32x4 acc[2][2][4][2];
#pragma unroll
    for (int a = 0; a < 2; ++a)
#pragma unroll
        for (int b = 0; b < 2; ++b)
#pragma unroll
            for (int m = 0; m < 4; ++m)
#pragma unroll
                for (int n = 0; n < 2; ++n) acc[a][b][m][n] = (f32x4){0.f, 0.f, 0.f, 0.f};
    bf16x8 At[4][2], B0[2][2], B1[2][2];
    const char* cA = g.abase(cur); const char* cB = g.bbase(cur);
    PG8_STAGE(PG8_SB(0, 0), cB, voffB); PG8_STAGE(PG8_SB(0, 1), cB + hstepB, voffB); PG8_STAGE(PG8_SA(0, 0), cA, voffA); PG8_STAGE(PG8_SA(0, 1), cA + hstepA, voffA);
    if (wr == 1) PG8_BAR;
    PG8_WAIT_V(2); PG8_BAR;
    PG8_STAGE(PG8_SB(1, 0), cB + kstepB, voffB); PG8_STAGE(PG8_SA(1, 0), cA + kstepA, voffA); PG8_STAGE(PG8_SB(1, 1), cB + hstepB + kstepB, voffB);
    PG8_WAIT_V(6); PG8_BAR;
    for (;;) {
        const bool has_next = S.next(ui + 1, nxt);
        const char* nA = has_next ? g.abase(nxt) : cA; const char* nB = has_next ? g.bbase(nxt) : cB;
        for (int t = 0; t < nt; t += 2) {
            const bool last = (t == nt - 2);
            const char* a1 = cA + (size_t)(t + 1) * kstepA;
            const char* a2 = last ? nA : cA + (size_t)(t + 2) * kstepA; const char* b2 = last ? nB : cB + (size_t)(t + 2) * kstepB;
            const char* a3 = a2 + kstepA; const char* b3 = b2 + kstepB;
            PG8_LDB(B0, 0, 0); PG8_LDB(B1, 0, 1); PG8_SCHED; PG8_LDA(At, 0, 0); PG8_STAGE(PG8_SA(1, 1), a1 + hstepA, voffA);
            PG8_WAIT_V(8); PG8_WAIT_L(0); PG8_BAR; PG8_MMA(0, 0, At, B0); PG8_MMA(0, 1, At, B1); PG8_BAR; PG8_SCHED;
            PG8_LDA(At, 0, 1); PG8_STAGE(PG8_SB(0, 0), b2, voffB); PG8_STAGE(PG8_SB(0, 1), b2 + hstepB, voffB); PG8_STAGE(PG8_SA(0, 0), a2, voffA);
            PG8_WAIT_V(8); PG8_WAIT_L(0); PG8_BAR; PG8_MMA(1, 0, At, B0); PG8_MMA(1, 1, At, B1); PG8_BAR; PG8_SCHED;
            PG8_LDB(B0, 1, 0); PG8_LDB(B1, 1, 1); PG8_SCHED; PG8_LDA(At, 1, 0); PG8_STAGE(PG8_SA(0, 1), a2 + hstepA, voffA);
            PG8_WAIT_V(8); PG8_WAIT_L(0); PG8_BAR; PG8_MMA(0, 0, At, B0); PG8_MMA(0, 1, At, B1); PG8_BAR; PG8_SCHED;
            PG8_LDA(At, 1, 1); PG8_STAGE(PG8_SB(1, 0), b3, voffB); PG8_STAGE(PG8_SB(1, 1), b3 + hstepB, voffB); PG8_STAGE(PG8_SA(1, 0), a3, voffA);
            PG8_WAIT_V(8); PG8_WAIT_L(0); PG8_BAR; PG8_MMA(1, 0, At, B0); PG8_MMA(1, 1, At, B1); PG8_BAR; PG8_SCHED;
        }
        if constexpr (ALIGN_EPI) { if (wr == 0) PG8_BAR; }
        if constexpr (!Epi::AFTER_DRAIN) { E(acc, cur, wr, wc, fr, fq); }
        if (!has_next) break;
#pragma unroll
        for (int a = 0; a < 2; ++a)
#pragma unroll
            for (int b = 0; b < 2; ++b)
#pragma unroll
                for (int m = 0; m < 4; ++m)
#pragma unroll
                    for (int n = 0; n < 2; ++n) acc[a][b][m][n] = (f32x4){0.f, 0.f, 0.f, 0.f};
        cur = nxt; cA = nA; cB = nB; ++ui;
        if constexpr (ALIGN_EPI) { if (wr == 1) PG8_BAR; }
    }
    PG8_WAIT_V(0);
    if constexpr (!ALIGN_EPI) { if (wr == 0) PG8_BAR; }
    PG8_BAR;
    if constexpr (Epi::AFTER_DRAIN) { E.fused(acc, cur, wr, wc, fr, fq, lds, wid, lane); PG8_WAIT_L(0); PG8_BAR; }
#undef PG8_SA
#undef PG8_SB
#undef PG8_STAGE
#undef PG8_LDA
#undef PG8_LDB
#undef PG8_MMA
#undef PG8_WAIT_V
#undef PG8_WAIT_L
#undef PG8_BAR
#undef PG8_SCHED
}
}

namespace attn_body {
using bf16 = bf16_t;
using bf16x8 = __attribute__((ext_vector_type(8))) short;
using s16x4 = __attribute__((ext_vector_type(4))) short;
using f32x16 = __attribute__((ext_vector_type(16))) float;
using u32x4 = __attribute__((ext_vector_type(4))) unsigned;
constexpr int SEQ = SEQL, D = 64, DMA = 1024;
constexpr int NW = 8, QBLK = 32, QB = QBLK * NW, KVBLK = 64, NQB = SEQ / QB;
__device__ __forceinline__ int crow(int r, int hi) { return (r & 3) + 8 * (r >> 2) + 4 * hi; }
#define SBAR() __builtin_amdgcn_sched_barrier(0)
__device__ __forceinline__ void cmask(f32x16& p0, f32x16& p1, int jb, int qrel, int hi) {
  const float NEG = -INFINITY; int kb = 64 * jb + 4 * hi;
  #pragma unroll
  for (int r = 0; r < 16; ++r) { int kv = kb + (r & 3) + 8 * (r >> 2); if (kv > qrel) p0[r] = NEG; if (kv + 32 > qrel) p1[r] = NEG; }
}
constexpr int NSLOT = 3, SLOTB = 8192;
constexpr int LDS_K = 0, LDS_V = NSLOT * SLOTB, LDS_WS = 2 * NSLOT * SLOTB, LDS_OST = LDS_WS + NW * 64 * 4, LDS_BYTES = LDS_OST + NW * 4096;
__device__ __forceinline__ void glds16(const void* gsrc, unsigned lds_dst) { unsigned keep;
  asm volatile("s_mov_b32 %0, m0\n\ts_mov_b32 m0, %2\n\ts_nop 0\n\tglobal_load_lds_dwordx4 %1, off\n\ts_mov_b32 m0, %0" : "=&s"(keep) : "v"(gsrc), "s"(lds_dst) : "memory"); }
__device__ __forceinline__ float max3f(float a, float b, float c) { float r; asm("v_max3_f32 %0, %1, %2, %3" : "=v"(r) : "v"(a), "v"(b), "v"(c)); return r; }
__device__ __forceinline__ float max2f(float a, float b) { float r; asm("v_max_f32_e32 %0, %1, %2" : "=v"(r) : "v"(a), "v"(b)); return r; }
__device__ __forceinline__ float fadd_s(float a, float b) { float r; asm("v_add_f32_e32 %0, %1, %2" : "=v"(r) : "v"(a), "v"(b)); return r; }
__device__ __forceinline__ float fsub_s(float a, float b) { float r; asm("v_sub_f32_e32 %0, %1, %2" : "=v"(r) : "v"(a), "v"(b)); return r; }
typedef float f32x2_t __attribute__((ext_vector_type(2))); typedef __bf16 bf16x2_t __attribute__((ext_vector_type(2)));
__device__ __forceinline__ unsigned cvtpk_s(float lo, float hi) { f32x2_t v = {lo, hi}; bf16x2_t b = __builtin_convertvector(v, bf16x2_t); return __builtin_bit_cast(unsigned, b); }
#define WAIT_BAR(N) asm volatile("s_waitcnt vmcnt(" #N ") lgkmcnt(0)\n\ts_barrier" ::: "memory")

__device__ __forceinline__ void qkt(f32x16& p0, f32x16& p1, const char* Kslot, const bf16x8* qr, const f32x16& negm, int r32, int hi) {
  const char* kb = Kslot + hi * 1024 + r32 * 16;
  #pragma unroll
  for (int d0 = 0; d0 < 4; ++d0) {
    const bf16x8 b0 = *reinterpret_cast<const bf16x8*>(kb + d0 * 2048);
    const bf16x8 b1 = *reinterpret_cast<const bf16x8*>(kb + d0 * 2048 + 512);
    if (d0 == 0) { p0 = __builtin_amdgcn_mfma_f32_32x32x16_bf16(b0, qr[0], negm, 0, 0, 0); p1 = __builtin_amdgcn_mfma_f32_32x32x16_bf16(b1, qr[0], negm, 0, 0, 0); }
    else { p0 = __builtin_amdgcn_mfma_f32_32x32x16_bf16(b0, qr[d0], p0, 0, 0, 0); p1 = __builtin_amdgcn_mfma_f32_32x32x16_bf16(b1, qr[d0], p1, 0, 0, 0); } }
}
typedef __attribute__((address_space(3))) const char* lds_cptr;
typedef short v4i16_t __attribute__((ext_vector_type(4)));
__device__ __forceinline__ void kload8(bf16x8* kf, lds_cptr kp) {
  kf[0] = *(const __attribute__((address_space(3))) bf16x8*)(kp);        kf[1] = *(const __attribute__((address_space(3))) bf16x8*)(kp + 512);
  kf[2] = *(const __attribute__((address_space(3))) bf16x8*)(kp + 2048); kf[3] = *(const __attribute__((address_space(3))) bf16x8*)(kp + 2560);
  kf[4] = *(const __attribute__((address_space(3))) bf16x8*)(kp + 4096); kf[5] = *(const __attribute__((address_space(3))) bf16x8*)(kp + 4608);
  kf[6] = *(const __attribute__((address_space(3))) bf16x8*)(kp + 6144); kf[7] = *(const __attribute__((address_space(3))) bf16x8*)(kp + 6656);
}
__device__ __forceinline__ void kload2(bf16x8* kf, lds_cptr kp, int j) { kf[2 * j] = *(const __attribute__((address_space(3))) bf16x8*)(kp + j * 2048); kf[2 * j + 1] = *(const __attribute__((address_space(3))) bf16x8*)(kp + j * 2048 + 512); }
__device__ __forceinline__ s16x4 vtr(lds_cptr p) { return __builtin_bit_cast(s16x4, __builtin_amdgcn_ds_read_tr16_b64_v4i16((__attribute__((address_space(3))) v4i16_t*)p)); }
__device__ __forceinline__ float rowmax(const f32x16& p0, const f32x16& p1) {
  float a = max3f(p0[0], p0[1], p1[0]), b = max3f(p0[2], p0[3], p1[1]); a = max3f(a, p1[2], p1[3]);
  #pragma unroll
  for (int r = 4; r < 16; r += 4) { a = max3f(a, p0[r], p0[r + 1]); b = max3f(b, p0[r + 2], p0[r + 3]); a = max3f(a, p1[r], p1[r + 1]); b = max3f(b, p1[r + 2], p1[r + 3]); }
  const float m = max2f(a, b);
  auto rr = __builtin_amdgcn_permlane32_swap(__float_as_uint(m), __float_as_uint(m), false, false);
  return max2f(__uint_as_float(rr[0]), __uint_as_float(rr[1]));
}
__device__ __forceinline__ void pv(f32x16* o, int vb, bf16x8 pa0, bf16x8 pa1, bf16x8 pa2, bf16x8 pa3) {
  #pragma unroll
  for (int d0 = 0; d0 < 2; ++d0) { s16x4 lo[4], hi[4];
    #pragma unroll
    for (int ks = 0; ks < 4; ++ks) {
      asm volatile("ds_read_b64_tr_b16 %0,%1 offset:%c2" : "=&v"(lo[ks]) : "v"(vb), "i"(d0 * 4096 + ks * 1024) : "memory");
      asm volatile("ds_read_b64_tr_b16 %0,%1 offset:%c2" : "=&v"(hi[ks]) : "v"(vb), "i"(d0 * 4096 + ks * 1024 + 512) : "memory"); }
    asm volatile("s_waitcnt lgkmcnt(0)" ::: "memory"); SBAR();
    #define PK(k) (bf16x8){lo[k][0], lo[k][1], lo[k][2], lo[k][3], hi[k][0], hi[k][1], hi[k][2], hi[k][3]}
    o[d0] = __builtin_amdgcn_mfma_f32_32x32x16_bf16(pa0, PK(0), o[d0], 0, 0, 0);
    o[d0] = __builtin_amdgcn_mfma_f32_32x32x16_bf16(pa1, PK(1), o[d0], 0, 0, 0);
    o[d0] = __builtin_amdgcn_mfma_f32_32x32x16_bf16(pa2, PK(2), o[d0], 0, 0, 0);
    o[d0] = __builtin_amdgcn_mfma_f32_32x32x16_bf16(pa3, PK(3), o[d0], 0, 0, 0);
    #undef PK
  }
}
#define ATTN_STORE16(p, v) (*(u32x4*)(p) = (v))
template <int THRL> __device__ __forceinline__ void attn_unit(int tid_in, int b, int hq, int hv, int qb, const bf16* Q, const bf16* __restrict__ K, const bf16* __restrict__ V, bf16* O, char* shm) {
  const int tid = tid_in, lane = tid & 63, r32 = lane & 31, hi = lane >> 5; const int wid = __builtin_amdgcn_readfirstlane(tid >> 6);
  const long rowbase = (long)b * SEQ; const int q0 = qb * QB;
  const bf16* Qw = Q + (rowbase + q0 + wid * QBLK) * DMA + hq * D;
  const bf16* Kh = K + rowbase * DMA + hq * D, *Vh = V + rowbase * DMA + hv * D;
  const unsigned lds0 = (unsigned)(uintptr_t)shm;
  float* wsf = (float*)(shm + LDS_WS) + wid * 64;
  const bf16* ksrc = Kh + (long)lane * DMA + wid * 8;
  const bf16* vsrc = Vh + (long)(16 * (wid & 3) + (lane >> 2)) * DMA + (wid >> 2) * 32 + (lane & 3) * 8;
  const unsigned kdst = lds0 + LDS_K + wid * 1024, vdst = lds0 + LDS_V + wid * 1024;
  #define DMA_K(t, slot) glds16(ksrc + (long)(t) * KVBLK * DMA, (unsigned)__builtin_amdgcn_readfirstlane(kdst + (slot)))
  #define DMA_V(t, slot) glds16(vsrc + (long)(t) * KVBLK * DMA, (unsigned)__builtin_amdgcn_readfirstlane(vdst + (slot)))
  const int vb0 = (int)(lds0 + LDS_V) + ((lane >> 4) & 1) * 32 + (lane & 3) * 8 + (4 * hi + ((lane & 15) >> 2)) * 64;
  const char* Kbase = shm + LDS_K; bf16x8 kf[8];
  const lds_cptr shm3 = (lds_cptr)shm; const lds_cptr kp0 = shm3 + LDS_K + hi * 1024 + r32 * 16; const lds_cptr vp0 = shm3 + LDS_V + ((lane >> 4) & 1) * 32 + (lane & 3) * 8 + (4 * hi + ((lane & 15) >> 2)) * 64;
  const int NT = (q0 + QB) / KVBLK;
  DMA_K(0, 0); DMA_V(0, 0); DMA_K(1, SLOTB);
  bf16x8 qr[4];
  #pragma unroll
  for (int d0 = 0; d0 < 4; ++d0) qr[d0] = *reinterpret_cast<const bf16x8*>(&Qw[(long)r32 * DMA + d0 * 16 + hi * 8]);
  float mhat = 0.f, l_reg = 0.f; f32x16 o[2]; o[0] = f32x16{}; o[1] = f32x16{}; f32x16 negm = f32x16{}; asm volatile("" : "+v"(negm));
  const int qrel = wid * QBLK + r32;
  #define CMASK(P0, P1, t) do { int jb_ = (t) - (NT - 4); if (jb_ >= 0) cmask(P0, P1, jb_, qrel, hi); } while (0)
  bool resc = false;
  #define START(P0, P1) do { const float rm = rowmax(P0, P1); resc = false; \
    { const float dl = rm; mhat = fadd_s(mhat, dl); \
      _Pragma("unroll") for (int r = 0; r < 16; ++r) { P0[r] = fsub_s(P0[r], dl); P1[r] = fsub_s(P1[r], dl); } \
      _Pragma("unroll") for (int r = 0; r < 16; ++r) negm[r] = -mhat; asm volatile("" : "+v"(negm)); } \
    _Pragma("unroll") for (int r = 0; r < 16; ++r) P0[r] = __builtin_amdgcn_exp2f(P0[r]); } while (0)
  #define RESC() do { if (resc) { asm volatile("s_waitcnt lgkmcnt(0)" ::: "memory"); \
      _Pragma("unroll") for (int d_ = 0; d_ < 2; ++d_) _Pragma("unroll") for (int r = 0; r < 16; ++r) o[d_][r] *= wsf[crow(r, hi)]; } } while (0)
  f32x16 pA0, pA1, pB0, pB1;
  int sl_prev = 0, sl_cur = 0, sl_next = SLOTB;
  #define ROT() do { sl_prev = sl_cur; sl_cur = sl_next; sl_next = (sl_next == (NSLOT - 1) * SLOTB) ? 0 : sl_next + SLOTB; } while (0)
  DMA_K(2, 2 * SLOTB);
  WAIT_BAR(3);
  qkt(pA0, pA1, Kbase, qr, negm, r32, hi); asm volatile("s_nop 15\n\ts_nop 7" : "+v"(pA0), "+v"(pA1)); CMASK(pA0, pA1, 0);
  START(pA0, pA1);
  _Pragma("unroll") for (int r = 0; r < 16; ++r) pA1[r] = __builtin_amdgcn_exp2f(pA1[r]);
  WAIT_BAR(0);
  DMA_K(3, 0); DMA_V(1, SLOTB);
  ROT();
  kload8(kf, kp0 + sl_cur);
  WAIT_BAR(2);
  s16x4 vlo[8], vhi[8]; u32x4 pw0, pw1, pw2, pw3;
  #define PKW(P, B) cvtpk_s(P[B], P[B + 1])
  #define PAF(k) __builtin_bit_cast(bf16x8, pw##k)
  #define VFR(i) (bf16x8){vlo[i][0], vlo[i][1], vlo[i][2], vlo[i][3], vhi[i][0], vhi[i][1], vhi[i][2], vhi[i][3]}
  #define PIN(x) asm volatile("" : "+v"(x))
  #define MX3(a, b, c) __builtin_fmaxf(__builtin_fmaxf((a), (b)), (c))
  #define GAPA(MF, A0, A1, A2, A3, W0, W1, PW) do { MF; sacc += A0; sacc += A1; sacc += A2; sacc += A3; PIN(sacc); W0; W1; PIN(PW); SBAR(); } while (0)
  #define EX(v) __builtin_amdgcn_exp2f(v)
  #define GAPB(MF, X, B) do { MF; X[B] = EX(X[B]); X[B + 1] = EX(X[B + 1]); X[B + 2] = EX(X[B + 2]); X[B + 3] = EX(X[B + 3]); PIN(X); SBAR(); } while (0)
  #define VRD(i) do { vlo[i] = vtr(vp_ + (((i) >> 2) * 4096 + ((i) & 3) * 1024)); vhi[i] = vtr(vp_ + (((i) >> 2) * 4096 + ((i) & 3) * 1024 + 512)); } while (0)
  #define KRD(G, j) do { if (G) { kload2(kf, kp0 + sl_next, j); SBAR(); } } while (0)
  #define STEP(C0, C1, P0, P1, t, GK, GV, GL) do { SBAR(); \
    const lds_cptr vp_ = vp0 + sl_prev; \
    VRD(0); SBAR(); float sacc = (P0[0] + P0[1]); \
    GAPA(C0 = __builtin_amdgcn_mfma_f32_32x32x16_bf16(kf[0], qr[0], negm, 0, 0, 0), P0[2], P0[3], P0[4], P0[5],     pw0[0] = PKW(P0, 0), pw0[1] = PKW(P0, 2), pw0); \
    VRD(4); SBAR(); GAPA(C1 = __builtin_amdgcn_mfma_f32_32x32x16_bf16(kf[1], qr[0], negm, 0, 0, 0), P0[6], P0[7], P0[8], P0[9],     pw0[2] = PKW(P0, 4), pw0[3] = PKW(P0, 6), pw0); \
    VRD(1); SBAR(); GAPA(C0 = __builtin_amdgcn_mfma_f32_32x32x16_bf16(kf[2], qr[1], C0, 0, 0, 0),   P0[10], P0[11], P0[12], P0[13], pw1[0] = PKW(P0, 8), pw1[1] = PKW(P0, 10), pw1); \
    VRD(5); SBAR(); GAPA(C1 = __builtin_amdgcn_mfma_f32_32x32x16_bf16(kf[3], qr[1], C1, 0, 0, 0),   P0[14], P0[15], P1[0], P1[1],   pw1[2] = PKW(P0, 12), pw1[3] = PKW(P0, 14), pw1); \
    VRD(2); SBAR(); GAPA(C0 = __builtin_amdgcn_mfma_f32_32x32x16_bf16(kf[4], qr[2], C0, 0, 0, 0),   P1[2], P1[3], P1[4], P1[5],     pw2[0] = PKW(P1, 0), pw2[1] = PKW(P1, 2), pw2); \
    VRD(6); SBAR(); GAPA(C1 = __builtin_amdgcn_mfma_f32_32x32x16_bf16(kf[5], qr[2], C1, 0, 0, 0),   P1[6], P1[7], P1[8], P1[9],     pw2[2] = PKW(P1, 4), pw2[3] = PKW(P1, 6), pw2); \
    VRD(3); SBAR(); GAPA(C0 = __builtin_amdgcn_mfma_f32_32x32x16_bf16(kf[6], qr[3], C0, 0, 0, 0),   P1[10], P1[11], P1[12], P1[13], pw3[0] = PKW(P1, 8), pw3[1] = PKW(P1, 10), pw3); \
    VRD(7); SBAR(); GAPA(C1 = __builtin_amdgcn_mfma_f32_32x32x16_bf16(kf[7], qr[3], C1, 0, 0, 0),   P1[14], P1[15], 0.f, 0.f,       pw3[2] = PKW(P1, 12), pw3[3] = PKW(P1, 14), pw3); \
    l_reg += sacc; \
    if (GK) { DMA_K((t) + 3, sl_cur); } if (GV) { DMA_V((t) + 1, sl_next); } \
    CMASK(C0, C1, t); \
    { float a = MX3(C0[0], C0[1], C1[0]), b = MX3(C0[2], C0[3], C1[1]); a = MX3(a, C1[2], C1[3]); \
      _Pragma("unroll") for (int r = 4; r < 16; r += 4) { a = MX3(a, C0[r], C0[r + 1]); b = MX3(b, C0[r + 2], C0[r + 3]); a = MX3(a, C1[r], C1[r + 1]); b = MX3(b, C1[r + 2], C1[r + 3]); } \
      float rm = __builtin_fmaxf(a, b); { auto rr = __builtin_amdgcn_permlane32_swap(__float_as_uint(rm), __float_as_uint(rm), false, false); rm = __builtin_fmaxf(__uint_as_float(rr[0]), __uint_as_float(rr[1])); } \
      resc = false; \
      if (__builtin_expect(__any(rm > (float)THRL), 0)) { const float dl = __builtin_fmaxf(rm, 0.f); mhat += dl; \
        _Pragma("unroll") for (int r = 0; r < 16; ++r) { C0[r] -= dl; C1[r] -= dl; } \
        _Pragma("unroll") for (int r = 0; r < 16; ++r) negm[r] = -mhat; asm volatile("" : "+v"(negm)); \
        const float f = __builtin_amdgcn_exp2f(-dl); l_reg *= f; if (hi == 0) wsf[r32] = f; resc = true; } } \
    SBAR(); \
    GAPB(o[0] = __builtin_amdgcn_mfma_f32_32x32x16_bf16(PAF(0), VFR(0), o[0], 0, 0, 0), C0, 0); \
    GAPB(o[1] = __builtin_amdgcn_mfma_f32_32x32x16_bf16(PAF(0), VFR(4), o[1], 0, 0, 0), C0, 4); \
    KRD(GL, 0); GAPB(o[0] = __builtin_amdgcn_mfma_f32_32x32x16_bf16(PAF(1), VFR(1), o[0], 0, 0, 0), C0, 8); \
    KRD(GL, 1); GAPB(o[1] = __builtin_amdgcn_mfma_f32_32x32x16_bf16(PAF(1), VFR(5), o[1], 0, 0, 0), C0, 12); \
    KRD(GL, 2); GAPB(o[0] = __builtin_amdgcn_mfma_f32_32x32x16_bf16(PAF(2), VFR(2), o[0], 0, 0, 0), C1, 0); \
    KRD(GL, 3); GAPB(o[1] = __builtin_amdgcn_mfma_f32_32x32x16_bf16(PAF(2), VFR(6), o[1], 0, 0, 0), C1, 4); \
    GAPB(o[0] = __builtin_amdgcn_mfma_f32_32x32x16_bf16(PAF(3), VFR(3), o[0], 0, 0, 0), C1, 8); \
    GAPB(o[1] = __builtin_amdgcn_mfma_f32_32x32x16_bf16(PAF(3), VFR(7), o[1], 0, 0, 0), C1, 12); \
    } while (0)
  int t = 1;
  #undef CMASK
  #define CMASK(P0, P1, t) do {} while (0)
  for (; t + 5 < NT; t += 2) {
    STEP(pB0, pB1, pA0, pA1, t, true, true, true);     WAIT_BAR(2); RESC(); ROT();
    STEP(pA0, pA1, pB0, pB1, t + 1, true, true, true); WAIT_BAR(2); RESC(); ROT();
  }
  #undef CMASK
  #define CMASK(P0, P1, t) do { int jb_ = (t) - (NT - 4); if (jb_ >= 0) cmask(P0, P1, jb_, qrel, hi); } while (0)
  #define ENDW(tt) do { if ((tt) + 3 < NT) { WAIT_BAR(2); } else if ((tt) + 2 < NT) { WAIT_BAR(1); } else { WAIT_BAR(0); } } while (0)
  for (; t + 1 < NT; t += 2) {
    STEP(pB0, pB1, pA0, pA1, t, (t + 3 < NT), (t + 1 < NT), (t + 1 < NT));         ENDW(t);     RESC(); ROT();
    STEP(pA0, pA1, pB0, pB1, t + 1, (t + 4 < NT), (t + 2 < NT), (t + 2 < NT));     ENDW(t + 1); RESC(); ROT();
  }
  STEP(pB0, pB1, pA0, pA1, NT - 1, false, false, false); RESC();
  { float sacc = pB0[0] + pB0[1]; _Pragma("unroll") for (int r = 2; r < 16; ++r) sacc += pB0[r]; _Pragma("unroll") for (int r = 0; r < 16; ++r) sacc += pB1[r]; l_reg += sacc;
    pw0 = (u32x4){PKW(pB0, 0), PKW(pB0, 2), PKW(pB0, 4), PKW(pB0, 6)}; pw1 = (u32x4){PKW(pB0, 8), PKW(pB0, 10), PKW(pB0, 12), PKW(pB0, 14)}; pw2 = (u32x4){PKW(pB1, 0), PKW(pB1, 2), PKW(pB1, 4), PKW(pB1, 6)}; pw3 = (u32x4){PKW(pB1, 8), PKW(pB1, 10), PKW(pB1, 12), PKW(pB1, 14)};
    SBAR(); pv(o, vb0 + sl_cur, PAF(0), PAF(1), PAF(2), PAF(3)); }
  #undef PKW
  #undef PAF
  #undef VFR
  #undef PIN
  #undef MX3
  #undef GAPA
  #undef GAPB
  #undef EX
  #undef VRD
  #undef KRD
  #undef STEP
  #undef ENDW
  { auto rr = __builtin_amdgcn_permlane32_swap(__float_as_uint(l_reg), __float_as_uint(l_reg), false, false); l_reg = __uint_as_float(rr[0]) + __uint_as_float(rr[1]); }
  if (hi == 0) wsf[32 + r32] = l_reg; asm volatile("s_waitcnt lgkmcnt(0)" ::: "memory");
  float rli[16];
  #pragma unroll
  for (int r = 0; r < 16; ++r) rli[r] = __builtin_amdgcn_rcpf(wsf[32 + crow(r, hi)]);
  bf16* Ow = O + (rowbase + q0 + wid * QBLK) * DMA + hv * D;
  { bf16* stg = (bf16*)(shm + LDS_OST) + wid * 2048;
    #pragma unroll
    for (int r = 0; r < 16; ++r) { const int orow = crow(r, hi);
      #pragma unroll
      for (int d0 = 0; d0 < 2; ++d0) stg[orow * 64 + d0 * 32 + r32] = f2bf(o[d0][r] * rli[r]); }
    asm volatile("s_waitcnt lgkmcnt(0)" ::: "memory");
    #pragma unroll
    for (int i = 0; i < 4; ++i) { const int row = i * 8 + (lane >> 3), ch = lane & 7; const u32x4 v = *(const u32x4*)(stg + row * 64 + ch * 8); ATTN_STORE16(Ow + (long)row * DMA + ch * 8, v); } }
  asm volatile("s_waitcnt lgkmcnt(0)\n\ts_barrier" ::: "memory");
  #undef DMA_K
  #undef DMA_V
  #undef CMASK
  #undef START
  #undef RESC
  #undef ROT
}
constexpr int ATTN_LDS_BYTES = LDS_BYTES;
#undef SBAR
#undef WAIT_BAR
}

namespace attn3 {
using namespace attn_body;
constexpr int KSLOT = 8192, VSLOT = 16384;
constexpr int L_K = 0, L_V = NSLOT * KSLOT, L_WS = L_V + NSLOT * VSLOT, L_OST = L_WS + NW * 64 * 4, L_BYTES = L_OST + NW * 4096;
#define SBAR() __builtin_amdgcn_sched_barrier(0)
#define WAIT_BAR(N) asm volatile("s_waitcnt vmcnt(" #N ") lgkmcnt(0)\n\ts_barrier" ::: "memory")
template <int THRL> __device__ __forceinline__ void attn_unit(int tid_in, int b, int hq, int h, int qb, const bf16* Q, const bf16* __restrict__ K, const bf16* __restrict__ V, bf16* O, char* shm,
                                                             int mode, const bf16* SZ1, const float* g_sub, float lam, bf16* OG,
                                                             bool primed, bool has_next, int nb, int nhq, int nh, int nqb, bf16x8 (&qr)[4]) {
  int tid_ = tid_in; asm volatile("" : "+v"(tid_));
  const int tid = tid_, lane = tid & 63, r32 = lane & 31, hi = lane >> 5; const int wid = __builtin_amdgcn_readfirstlane(tid >> 6);
  const long rowbase = (long)b * SEQ; const int q0 = qb * QB;
  const bf16* Qw = Q + (rowbase + q0 + wid * QBLK) * DMA + hq * D;
  const bf16* Kh = K + rowbase * DMA + hq * D, *Vh = V + rowbase * DMA + h * 128;
  const unsigned lds0 = (unsigned)(uintptr_t)shm;
  float* wsf = (float*)(shm + L_WS) + wid * 64;
  const bf16* ksrc = Kh + (long)lane * DMA + wid * 8;
  const bf16* vsrc = Vh + (long)(16 * (wid & 3) + (lane >> 2)) * DMA + (wid >> 2) * 32 + (lane & 3) * 8;
  const unsigned kdst = lds0 + L_K + wid * 1024, vdst = lds0 + L_V + wid * 1024;
  #define DMA_K(t, si) glds16(ksrc + (long)(t) * KVBLK * DMA, (unsigned)__builtin_amdgcn_readfirstlane(kdst + (si) * KSLOT))
  #define DMA_V(t, si) do { glds16(vsrc + (long)(t) * KVBLK * DMA, (unsigned)__builtin_amdgcn_readfirstlane(vdst + (si) * VSLOT)); \
                            glds16(vsrc + (long)(t) * KVBLK * DMA + 64, (unsigned)__builtin_amdgcn_readfirstlane(vdst + (si) * VSLOT + 8192)); } while (0)
  const int vb0 = (int)(lds0 + L_V) + ((lane >> 4) & 1) * 32 + (lane & 3) * 8 + (4 * hi + ((lane & 15) >> 2)) * 64;
  const char* Kbase = shm + L_K; bf16x8 kf[8];
  const lds_cptr shm3 = (lds_cptr)shm; const lds_cptr kp0 = shm3 + L_K + hi * 1024 + r32 * 16; const lds_cptr vp0 = shm3 + L_V + ((lane >> 4) & 1) * 32 + (lane & 3) * 8 + (4 * hi + ((lane & 15) >> 2)) * 64;
  const int NT = (q0 + QB) / KVBLK;
  if (!primed) { DMA_K(0, 0); DMA_V(0, 0); DMA_K(1, 1);
    #pragma unroll
    for (int d0 = 0; d0 < 4; ++d0) qr[d0] = *reinterpret_cast<const bf16x8*>(&Qw[(long)r32 * DMA + d0 * 16 + hi * 8]); }
  float mhat = 0.f, l_reg = 0.f; f32x16 o[4]; f32x16 negm;
  { float zf = 0.f; asm volatile("" : "+v"(zf));
    _Pragma("unroll") for (int r = 0; r < 16; ++r) { o[0][r] = zf; o[1][r] = zf; o[2][r] = zf; o[3][r] = zf; negm[r] = zf; } }
  asm volatile("" : "+v"(negm));
  const int qrel = wid * QBLK + r32;
  #define CMASK(P0, P1, t) do { int jb_ = (t) - (NT - 4); if (jb_ >= 0) cmask(P0, P1, jb_, qrel, hi); } while (0)
  bool resc = false;
  #define RESC() do { if (resc) { asm volatile("s_waitcnt lgkmcnt(0)" ::: "memory"); \
      _Pragma("unroll") for (int d_ = 0; d_ < 4; ++d_) _Pragma("unroll") for (int r = 0; r < 16; ++r) o[d_][r] *= wsf[crow(r, hi)]; } } while (0)
  f32x16 C0, C1;
  int s_prev = 0, s_cur = 0, s_next = 1;
  #define ROT() do { s_prev = s_cur; s_cur = s_next; s_next = (s_next == NSLOT - 1) ? 0 : s_next + 1; } while (0)
  if (!primed) { DMA_K(2, 2); WAIT_BAR(4); }
  else { WAIT_BAR(0); }
  u32x4 pwA0, pwA1, pwA2, pwA3, pwB0, pwB1, pwB2, pwB3;
  #define PKW(P, B) cvtpk_s(P[B], P[B + 1])
  qkt(C0, C1, Kbase, qr, negm, r32, hi); asm volatile("s_nop 15\n\ts_nop 7" : "+v"(C0), "+v"(C1)); CMASK(C0, C1, 0);
  { const float rm = rowmax(C0, C1); mhat = fadd_s(mhat, rm);
    _Pragma("unroll") for (int r = 0; r < 16; ++r) { C0[r] = fsub_s(C0[r], rm); C1[r] = fsub_s(C1[r], rm); }
    _Pragma("unroll") for (int r = 0; r < 16; ++r) negm[r] = -mhat; asm volatile("" : "+v"(negm));
    float sacc = 0.f;
    _Pragma("unroll") for (int r = 0; r < 16; ++r) { C0[r] = __builtin_amdgcn_exp2f(C0[r]); C1[r] = __builtin_amdgcn_exp2f(C1[r]); }
    _Pragma("unroll") for (int r = 0; r < 16; ++r) sacc += C0[r] + C1[r];
    l_reg = sacc;
    pwA0 = (u32x4){PKW(C0, 0), PKW(C0, 2), PKW(C0, 4), PKW(C0, 6)}; pwA1 = (u32x4){PKW(C0, 8), PKW(C0, 10), PKW(C0, 12), PKW(C0, 14)};
    pwA2 = (u32x4){PKW(C1, 0), PKW(C1, 2), PKW(C1, 4), PKW(C1, 6)}; pwA3 = (u32x4){PKW(C1, 8), PKW(C1, 10), PKW(C1, 12), PKW(C1, 14)}; }
  WAIT_BAR(0);
  DMA_K(3, 0); DMA_V(1, 1);
  ROT();
  kload8(kf, kp0 + s_cur * KSLOT);
  WAIT_BAR(3);
  s16x4 vlo[8], vhi[8];
  #define PAF(w) __builtin_bit_cast(bf16x8, w)
  #define VFR(i) (bf16x8){vlo[i][0], vlo[i][1], vlo[i][2], vlo[i][3], vhi[i][0], vhi[i][1], vhi[i][2], vhi[i][3]}
  #define PIN(x) asm volatile("" : "+v"(x))
  #define MX3(a, b, c) __builtin_fmaxf(__builtin_fmaxf((a), (b)), (c))
  #define EX(v) __builtin_amdgcn_exp2f(v)
  #define VRD(s, f) do { vlo[s] = vtr(vp_ + (((f) >> 2) * 4096 + ((f) & 3) * 1024)); vhi[s] = vtr(vp_ + (((f) >> 2) * 4096 + ((f) & 3) * 1024 + 512)); } while (0)
  #define KRD(G, j) do { if (G) { kload2(kf, kp0 + s_next * KSLOT, j); SBAR(); } } while (0)
  #define GAPB(MF, X, B, PWW) do { MF; X[B] = EX(X[B]); X[B + 1] = EX(X[B + 1]); sacc += X[B]; sacc += X[B + 1]; PIN(sacc); PWW = PKW(X, B); PIN(PWW); SBAR(); } while (0)
  #define MFQ(a, b, c) __builtin_amdgcn_mfma_f32_32x32x16_bf16(a, b, c, 0, 0, 0)
  #define STEP(PP0, PP1, PP2, PP3, PN0, PN1, PN2, PN3, t, GK, GV, GL) do { SBAR(); \
    const lds_cptr vp_ = vp0 + s_prev * VSLOT; \
    VRD(0, 0); SBAR(); C0 = MFQ(kf[0], qr[0], negm); SBAR(); \
    VRD(4, 4); SBAR(); C1 = MFQ(kf[1], qr[0], negm); SBAR(); \
    VRD(1, 1); SBAR(); C0 = MFQ(kf[2], qr[1], C0); SBAR(); \
    VRD(5, 5); SBAR(); C1 = MFQ(kf[3], qr[1], C1); SBAR(); \
    VRD(2, 2); SBAR(); C0 = MFQ(kf[4], qr[2], C0); SBAR(); \
    VRD(6, 6); SBAR(); C1 = MFQ(kf[5], qr[2], C1); SBAR(); \
    VRD(3, 3); SBAR(); C0 = MFQ(kf[6], qr[3], C0); SBAR(); \
    VRD(7, 7); SBAR(); C1 = MFQ(kf[7], qr[3], C1); SBAR(); \
    if (GK) { DMA_K((t) + 3, s_cur); } if (GV) { DMA_V((t) + 1, s_next); } \
    CMASK(C0, C1, t); \
    { float a = MX3(C0[0], C0[1], C1[0]), b = MX3(C0[2], C0[3], C1[1]); a = MX3(a, C1[2], C1[3]); \
      _Pragma("unroll") for (int r = 4; r < 16; r += 4) { a = MX3(a, C0[r], C0[r + 1]); b = MX3(b, C0[r + 2], C0[r + 3]); a = MX3(a, C1[r], C1[r + 1]); b = MX3(b, C1[r + 2], C1[r + 3]); } \
      float rm = __builtin_fmaxf(a, b); { auto rr = __builtin_amdgcn_permlane32_swap(__float_as_uint(rm), __float_as_uint(rm), false, false); rm = __builtin_fmaxf(__uint_as_float(rr[0]), __uint_as_float(rr[1])); } \
      resc = false; \
      if (__builtin_expect(__any(rm > (float)THRL), 0)) { const float dl = __builtin_fmaxf(rm, 0.f); mhat += dl; \
        _Pragma("unroll") for (int r = 0; r < 16; ++r) { C0[r] -= dl; C1[r] -= dl; } \
        _Pragma("unroll") for (int r = 0; r < 16; ++r) negm[r] = -mhat; asm volatile("" : "+v"(negm)); \
        const float f = __builtin_amdgcn_exp2f(-dl); l_reg *= f; if (hi == 0) wsf[r32] = f; resc = true; } } \
    SBAR(); float sacc = 0.f; \
    GAPB(o[0] = MFQ(PAF(PP0), VFR(0), o[0]), C0, 0,  PN0[0]); VRD(0, 8);  SBAR(); \
    GAPB(o[1] = MFQ(PAF(PP0), VFR(4), o[1]), C0, 2,  PN0[1]); VRD(4, 12); SBAR(); \
    GAPB(o[0] = MFQ(PAF(PP1), VFR(1), o[0]), C0, 4,  PN0[2]); VRD(1, 9);  SBAR(); \
    GAPB(o[1] = MFQ(PAF(PP1), VFR(5), o[1]), C0, 6,  PN0[3]); VRD(5, 13); SBAR(); \
    GAPB(o[0] = MFQ(PAF(PP2), VFR(2), o[0]), C0, 8,  PN1[0]); VRD(2, 10); SBAR(); \
    GAPB(o[1] = MFQ(PAF(PP2), VFR(6), o[1]), C0, 10, PN1[1]); VRD(6, 14); SBAR(); \
    GAPB(o[0] = MFQ(PAF(PP3), VFR(3), o[0]), C0, 12, PN1[2]); VRD(3, 11); SBAR(); \
    GAPB(o[1] = MFQ(PAF(PP3), VFR(7), o[1]), C0, 14, PN1[3]); VRD(7, 15); SBAR(); \
    GAPB(o[2] = MFQ(PAF(PP0), VFR(0), o[2]), C1, 0,  PN2[0]); \
    GAPB(o[3] = MFQ(PAF(PP0), VFR(4), o[3]), C1, 2,  PN2[1]); \
    KRD(GL, 0); GAPB(o[2] = MFQ(PAF(PP1), VFR(1), o[2]), C1, 4,  PN2[2]); \
    KRD(GL, 1); GAPB(o[3] = MFQ(PAF(PP1), VFR(5), o[3]), C1, 6,  PN2[3]); \
    KRD(GL, 2); GAPB(o[2] = MFQ(PAF(PP2), VFR(2), o[2]), C1, 8,  PN3[0]); \
    KRD(GL, 3); GAPB(o[3] = MFQ(PAF(PP2), VFR(6), o[3]), C1, 10, PN3[1]); \
    GAPB(o[2] = MFQ(PAF(PP3), VFR(3), o[2]), C1, 12, PN3[2]); \
    GAPB(o[3] = MFQ(PAF(PP3), VFR(7), o[3]), C1, 14, PN3[3]); \
    l_reg += sacc; \
    } while (0)
  #define STEP_AB(t, GK, GV, GL) STEP(pwA0, pwA1, pwA2, pwA3, pwB0, pwB1, pwB2, pwB3, t, GK, GV, GL)
  #define STEP_BA(t, GK, GV, GL) STEP(pwB0, pwB1, pwB2, pwB3, pwA0, pwA1, pwA2, pwA3, t, GK, GV, GL)
  int t = 1;
  #undef CMASK
  #define CMASK(P0, P1, t) do {} while (0)
  for (; t + 5 < NT; t += 2) {
    STEP_AB(t, true, true, true);     WAIT_BAR(3); RESC(); ROT();
    STEP_BA(t + 1, true, true, true); WAIT_BAR(3); RESC(); ROT();
  }
  #undef CMASK
  #define CMASK(P0, P1, t) do { int jb_ = (t) - (NT - 4); if (jb_ >= 0) cmask(P0, P1, jb_, qrel, hi); } while (0)
  #define ENDW(tt) do { if ((tt) + 3 < NT) { WAIT_BAR(3); } else if ((tt) + 2 < NT) { WAIT_BAR(2); } else { WAIT_BAR(0); } } while (0)
  for (; t + 1 < NT; t += 2) {
    STEP_AB(t, (t + 3 < NT), (t + 1 < NT), (t + 1 < NT));         ENDW(t);     RESC(); ROT();
    STEP_BA(t + 1, (t + 4 < NT), (t + 2 < NT), (t + 2 < NT));     ENDW(t + 1); RESC(); ROT();
  }
  STEP_AB(NT - 1, false, false, false); RESC();
  { SBAR();
    const int vb = vb0 + s_cur * VSLOT;
    #pragma unroll
    for (int d0 = 0; d0 < 4; ++d0) { s16x4 lo[4], hh[4];
      #pragma unroll
      for (int ks = 0; ks < 4; ++ks) {
        asm volatile("ds_read_b64_tr_b16 %0,%1 offset:%c2" : "=&v"(lo[ks]) : "v"(vb), "i"(d0 * 4096 + ks * 1024) : "memory");
        asm volatile("ds_read_b64_tr_b16 %0,%1 offset:%c2" : "=&v"(hh[ks]) : "v"(vb), "i"(d0 * 4096 + ks * 1024 + 512) : "memory"); }
      asm volatile("s_waitcnt lgkmcnt(0)" ::: "memory"); SBAR();
      #define PK(k) (bf16x8){lo[k][0], lo[k][1], lo[k][2], lo[k][3], hh[k][0], hh[k][1], hh[k][2], hh[k][3]}
      o[d0] = MFQ(PAF(pwB0), PK(0), o[d0]); o[d0] = MFQ(PAF(pwB1), PK(1), o[d0]); o[d0] = MFQ(PAF(pwB2), PK(2), o[d0]); o[d0] = MFQ(PAF(pwB3), PK(3), o[d0]);
      #undef PK
    } }
  asm volatile("s_waitcnt lgkmcnt(0)\n\ts_barrier" ::: "memory");
  if (has_next) {
    const long nrow = (long)nb * SEQ; const int nq0 = nqb * QB;
    const bf16* nQw = Q + (nrow + nq0 + wid * QBLK) * DMA + nhq * D;
    const bf16* nks = K + nrow * DMA + nhq * D + (long)lane * DMA + wid * 8;
    const bf16* nvs = V + nrow * DMA + nh * 128 + (long)(16 * (wid & 3) + (lane >> 2)) * DMA + (wid >> 2) * 32 + (lane & 3) * 8;
    glds16(nks, (unsigned)__builtin_amdgcn_readfirstlane(kdst));
    glds16(nvs, (unsigned)__builtin_amdgcn_readfirstlane(vdst)); glds16(nvs + 64, (unsigned)__builtin_amdgcn_readfirstlane(vdst + 8192));
    glds16(nks + (long)KVBLK * DMA, (unsigned)__builtin_amdgcn_readfirstlane(kdst + KSLOT));
    glds16(nks + (long)2 * KVBLK * DMA, (unsigned)__builtin_amdgcn_readfirstlane(kdst + 2 * KSLOT));
    #pragma unroll
    for (int d0 = 0; d0 < 4; ++d0) qr[d0] = *reinterpret_cast<const bf16x8*>(&nQw[(long)r32 * DMA + d0 * 16 + hi * 8]);
  }
  { auto rr = __builtin_amdgcn_permlane32_swap(__float_as_uint(l_reg), __float_as_uint(l_reg), false, false); l_reg = __uint_as_float(rr[0]) + __uint_as_float(rr[1]); }
  if (hi == 0) wsf[32 + r32] = l_reg; asm volatile("s_waitcnt lgkmcnt(0)" ::: "memory");
  float rli[16];
  #pragma unroll
  for (int r = 0; r < 16; ++r) rli[r] = __builtin_amdgcn_rcpf(wsf[32 + crow(r, hi)]);
  int lane_e = lane; asm volatile("" : "+v"(lane_e));
  const int erow = lane_e >> 3, ech = lane_e & 7;
  bf16* Ow = O + (rowbase + q0 + wid * QBLK) * DMA + h * 128;
  bf16* stg = (bf16*)(shm + L_OST) + wid * 2048;
  if (mode == 0) {
    #pragma unroll
    for (int ps = 0; ps < 2; ++ps) {
      #pragma unroll
      for (int r = 0; r < 16; ++r) { const int orow = crow(r, hi);
        #pragma unroll
        for (int d0 = 0; d0 < 2; ++d0) stg[orow * 64 + d0 * 32 + r32] = f2bf(o[2 * ps + d0][r] * rli[r]); }
      asm volatile("s_waitcnt lgkmcnt(0)" ::: "memory");
      #pragma unroll
      for (int i = 0; i < 4; ++i) { const int row = i * 8 + erow, ch = ech; const u32x4 v = *(const u32x4*)(stg + row * 64 + ch * 8); *(u32x4*)(Ow + (long)row * DMA + ps * 64 + ch * 8) = v; }
      asm volatile("s_waitcnt lgkmcnt(0)" ::: "memory");
    }
    asm volatile("s_waitcnt vmcnt(0)" ::: "memory");
  } else {
    const bf16* Zw = SZ1 + (rowbase + q0 + wid * QBLK) * DMA + h * 128; bf16* Gw = OG + (rowbase + q0 + wid * QBLK) * DMA + h * 128;
    float dk[2][4][8]; float ss[4] = {0.f, 0.f, 0.f, 0.f};
    #pragma unroll
    for (int ps = 0; ps < 2; ++ps) {
      #pragma unroll
      for (int r = 0; r < 16; ++r) { const int orow = crow(r, hi);
        #pragma unroll
        for (int d0 = 0; d0 < 2; ++d0) stg[orow * 64 + d0 * 32 + r32] = f2bf(o[2 * ps + d0][r] * rli[r]); }
      asm volatile("s_waitcnt lgkmcnt(0)" ::: "memory");
      #pragma unroll
      for (int i = 0; i < 4; ++i) { const int row = i * 8 + erow, ch = ech;
        const u32x4 v1 = *(const u32x4*)(stg + row * 64 + ch * 8); const u32x4 v0 = *(const u32x4*)(Ow + (long)row * DMA + ps * 64 + ch * 8);
        #pragma unroll
        for (int j = 0; j < 4; ++j) { const float a0 = __uint_as_float(v0[j] << 16), a1 = __uint_as_float(v0[j] & 0xffff0000u), b0 = __uint_as_float(v1[j] << 16), b1 = __uint_as_float(v1[j] & 0xffff0000u);
          const float d0_ = a0 - lam * b0, d1_ = a1 - lam * b1; dk[ps][i][2 * j] = d0_; dk[ps][i][2 * j + 1] = d1_; ss[i] += d0_ * d0_ + d1_ * d1_; } }
      asm volatile("s_waitcnt lgkmcnt(0)" ::: "memory");
    }
    #pragma unroll
    for (int i = 0; i < 4; ++i) { float t_ = ss[i];
      t_ += __int_as_float(__builtin_amdgcn_ds_swizzle(__float_as_int(t_), 0x1f | (1 << 10))); t_ += __int_as_float(__builtin_amdgcn_ds_swizzle(__float_as_int(t_), 0x1f | (2 << 10)));
      t_ += __int_as_float(__builtin_amdgcn_ds_swizzle(__float_as_int(t_), 0x1f | (4 << 10))); ss[i] = rsqrtf(t_ * (1.0f / 128.0f) + RMS_EPS) * ONE_M_LI; }
    #pragma unroll
    for (int ps = 0; ps < 2; ++ps) {
      const int ch = ech; const float* gp = g_sub + ps * 64 + ch * 8; const f32x4_t g0 = *(const f32x4_t*)gp, g1 = *(const f32x4_t*)(gp + 4);
      #pragma unroll
      for (int i = 0; i < 4; ++i) { const int row = i * 8 + erow;
        const u32x4 z = NT_LD((const u32x4*)(Zw + (long)row * DMA + ps * 64 + ch * 8)); u32x4 w;
        #pragma unroll
        for (int j = 0; j < 4; ++j) { const float z0 = __uint_as_float(z[j] << 16), z1 = __uint_as_float(z[j] & 0xffff0000u);
          const float ga = (j < 2) ? g0[2 * j] : g1[2 * j - 4], gb = (j < 2) ? g0[2 * j + 1] : g1[2 * j - 3];
          w[j] = cvtpk_s(dk[ps][i][2 * j] * ss[i] * ga * z0, dk[ps][i][2 * j + 1] * ss[i] * gb * z1); }
        *(u32x4*)(Gw + (long)row * DMA + ps * 64 + ch * 8) = w; }
    }
  }
  asm volatile("s_waitcnt lgkmcnt(0)" ::: "memory");
  #undef DMA_K
  #undef DMA_V
  #undef CMASK
  #undef RESC
  #undef ROT
  #undef PKW
  #undef PAF
  #undef VFR
  #undef PIN
  #undef MX3
  #undef EX
  #undef VRD
  #undef KRD
  #undef GAPB
  #undef MFQ
  #undef STEP
  #undef STEP_AB
  #undef STEP_BA
  #undef ENDW
}
#undef SBAR
#undef WAIT_BAR
}

constexpr int NWAVES = 8;
constexpr size_t MiB = 1u << 20;
constexpr size_t WS_CTL = 0, CTL_ZERO_BYTES = 1 * MiB;
constexpr size_t WS_MOD = 256 * 1024;
constexpr size_t WS_LAM = 1 * MiB;
constexpr size_t WS_HN = 1 * MiB + 128 * 1024;
constexpr size_t WS_LB16 = 1 * MiB + 4096;
constexpr size_t WS_WIN0 = 2 * MiB, WS_WGLU = 6 * MiB, WS_WOUT0 = 8 * MiB, WS_WKV = 10 * MiB, WS_WIN1 = 14 * MiB, WS_WOUT1 = 18 * MiB;
constexpr size_t WS_BTA = 20 * MiB;
constexpr size_t WS_BTB = 28 * MiB;
constexpr size_t WS_S0 = 48 * MiB, WS_S1 = 112 * MiB, WS_S2 = 176 * MiB, WS_S3 = 240 * MiB, WS_S4 = 304 * MiB, WS_S5 = 368 * MiB, WS_S6 = 432 * MiB, WS_END = 496 * MiB;
constexpr int CW_BAR = 4096;
constexpr int CW_TMO = 8, CW_SEAM = 16384, SEAM_BANK = 128 * 64;
constexpr size_t WS_XCH = 40 * MiB;
constexpr int RING_OFF = 0, RING_BYTES = 131072;
constexpr int LDSCTL_OFF = RING_BYTES, MISC_OFF = LDSCTL_OFF + 320;
constexpr int LDS_BYTES = 147456;

#define GAS __attribute__((address_space(1)))
#define LAS __attribute__((address_space(3)))
typedef unsigned v4u __attribute__((ext_vector_type(4)));
typedef GAS unsigned gu32;
#define RLX_AGENT __ATOMIC_RELAXED, __HIP_MEMORY_SCOPE_AGENT
#define LDS_WAIT() asm volatile("s_waitcnt lgkmcnt(0)" ::: "memory")
#define VM_WAIT() asm volatile("s_waitcnt vmcnt(0)" ::: "memory")

#define XB_TMO      128
#define XB_XCNT(j)  (256  + 64 * (j))
#define XB_XSUB(j)  (1280 + 64 * (j))
#define XB_XGEN(j)  (2304 + 64 * (j))
#define XB_TOP      3328
#define XB_TOPGEN   3392
#define XCD_BAR_WORDS 3456
#define XB_SPIN_CAP (1u << 18)
__device__ __forceinline__ unsigned xb_ld(unsigned* p)              { return __hip_atomic_load(p, __ATOMIC_RELAXED, __HIP_MEMORY_SCOPE_AGENT); }
__device__ __forceinline__ unsigned xb_add(unsigned* p, unsigned v) { return __hip_atomic_fetch_add(p, v, __ATOMIC_RELAXED, __HIP_MEMORY_SCOPE_AGENT); }
__device__ __forceinline__ unsigned xb_xcc_id() { return (unsigned)__builtin_amdgcn_s_getreg((3 << 11) | 20) & 0xFu; }
#define XB_SPIN(cond, bar) do { unsigned _sp = 0; while (cond) { __builtin_amdgcn_s_sleep(1); \
    if ((++_sp & 255u) == 0u) { if (xb_ld(&(bar)[XB_TMO])) break; if (_sp > XB_SPIN_CAP) { atomicAdd(&(bar)[XB_TMO], 1u); break; } } } } while (0)
struct XcdBarrier { unsigned* bar; unsigned x; volatile LAS unsigned* st; };
__device__ __forceinline__ XcdBarrier xcd_barrier_post(unsigned* bar, volatile LAS unsigned* st, int tid) {
    XcdBarrier b; b.bar = bar; b.x = xb_xcc_id(); b.st = st;
    if (tid == 0) st[4] = xb_add(&bar[XB_XCNT(b.x)], 1u);
    return b;
}
__device__ __forceinline__ void xcc_barrier(unsigned* lb, unsigned x, unsigned nloc, int tid) {
    asm volatile("s_waitcnt vmcnt(0)" ::: "memory");
    __syncthreads();
    if (tid == 0) {
        __builtin_amdgcn_s_waitcnt(0);
        const unsigned old = xb_add(&lb[XB_XSUB(x)], 1u); const unsigned gen = old / nloc;
        if (old + 1u == (gen + 1u) * nloc) xb_add(&lb[XB_XGEN(x)], 1u);
        else XB_SPIN(xb_ld(&lb[XB_XGEN(x)]) == gen, lb);
        __builtin_amdgcn_fence(__ATOMIC_ACQUIRE, "agent");
        asm volatile("s_waitcnt vmcnt(0)" ::: "memory");
    }
    __syncthreads();
}
__device__ __forceinline__ void xcd_barrier_complete(unsigned* bar, unsigned x, unsigned& nloc, unsigned& nx) {
    const unsigned G = gridDim.x * gridDim.y * gridDim.z;
    unsigned sum, cnt, mine, sp = 0u;
    for (;;) {
        sum = 0u; cnt = 0u; mine = 0u;
#pragma unroll
        for (unsigned j = 0; j < 16; ++j) { const unsigned c = xb_ld(&bar[XB_XCNT(j)]); sum += c; cnt += (c > 0u) ? 1u : 0u; mine = (j == x) ? c : mine; }
        if (sum == G) break;
        __builtin_amdgcn_s_sleep(1);
        if ((++sp & 255u) == 0u) { if (xb_ld(&bar[XB_TMO])) break; if (sp > XB_SPIN_CAP) { atomicAdd(&bar[XB_TMO], 1u); break; } }
    }
    nloc = mine > 0u ? mine : 1u; nx = cnt > 0u ? cnt : 1u;
}
__device__ __forceinline__ void xcd_barrier(const XcdBarrier& b, int tid) {
    asm volatile("s_waitcnt vmcnt(0)" ::: "memory");
    __syncthreads();
    if (tid == 0) {
        unsigned* bar = b.bar;
        __builtin_amdgcn_s_waitcnt(0);
        unsigned nloc = b.st[0], nx = b.st[1];
        if (nloc == 0u) { xcd_barrier_complete(bar, b.x, nloc, nx); b.st[0] = nloc; b.st[1] = nx; }
        const unsigned old = xb_add(&bar[XB_XSUB(b.x)], 1u);
        const unsigned gen = old / nloc;
        if (old + 1u == (gen + 1u) * nloc) {
            __builtin_amdgcn_fence(__ATOMIC_RELEASE, "agent");
            asm volatile("s_waitcnt vmcnt(0)" ::: "memory");
            const unsigned og = xb_add(&bar[XB_TOP], 1u);
            const unsigned tg = og / nx;
            if (og + 1u == (tg + 1u) * nx) xb_add(&bar[XB_TOPGEN], 1u);
            else XB_SPIN(xb_ld(&bar[XB_TOPGEN]) == tg, bar);
            __builtin_amdgcn_fence(__ATOMIC_ACQUIRE, "agent");
            xb_add(&bar[XB_XGEN(b.x)], 1u);
            asm volatile("s_waitcnt vmcnt(0)" ::: "memory");
        } else {
            XB_SPIN(xb_ld(&bar[XB_XGEN(b.x)]) == gen, bar);
            __builtin_amdgcn_fence(__ATOMIC_ACQUIRE, "agent");
            asm volatile("s_waitcnt vmcnt(0)" ::: "memory");
        }
    }
    __syncthreads();
}

__device__ __forceinline__ void p0_transpose_item(const float* W, int K, int N, bf16_t* WT, int row_off, const float* kscale, LAS float* scr, int item, int lane) {
    const int nblk = N / 32, kb = item / nblk, nb = item % nblk, k0 = 64 * kb, n0 = 32 * nb;
    float tv[32];
#pragma unroll
    for (int i = 0; i < 32; ++i) tv[i] = NT_LD(W + (size_t)(k0 + 2 * i + (lane >> 5)) * N + n0 + (lane & 31));
#pragma unroll
    for (int i = 0; i < 32; ++i) { const int kk = 2 * i + (lane >> 5); float v = tv[i]; if (kscale) v *= kscale[k0 + kk]; scr[kk * 33 + (lane & 31)] = v; }
    LDS_WAIT(); asm volatile("" ::: "memory");
    const int c = lane & 7;
#pragma unroll
    for (int j = 0; j < 4; ++j) { const int n = (lane >> 3) + 8 * j; const LAS float* s = scr + (8 * c) * 33 + n;
        v4u o; o.x = pk2bf(s[0 * 33], s[1 * 33]); o.y = pk2bf(s[2 * 33], s[3 * 33]); o.z = pk2bf(s[4 * 33], s[5 * 33]); o.w = pk2bf(s[6 * 33], s[7 * 33]);
        *(GAS v4u*)(WT + (size_t)(row_off + n0 + n) * K + k0 + 8 * c) = o; }
    LDS_WAIT(); asm volatile("" ::: "memory");
}

__device__ __forceinline__ int lane_now_asm() { int r; asm volatile("v_mbcnt_lo_u32_b32 %0, -1, 0\n\tv_mbcnt_hi_u32_b32 %0, -1, %0" : "=v"(r)); return r; }
struct Args {
    const float* in[28]; float* out; unsigned char* ws;
    int ph_lo, ph_hi, use_bar, flags;
};

__global__ void __launch_bounds__(NWAVES * 64, 2) mega_fwd(Args args) {
    extern __shared__ __attribute__((aligned(16))) unsigned char lds_raw[];
    LAS unsigned char* lds = (LAS unsigned char*)lds_raw;
    volatile LAS unsigned* MISC = (volatile LAS unsigned*)(lds + MISC_OFF);
    const int wave = __builtin_amdgcn_readfirstlane((int)threadIdx.x >> 6);
#define LANE_NOW() lane_now_asm()
#define TID_NOW() (wave * 64 + LANE_NOW())
    const int G = gridDim.x;
    unsigned char* ws = args.ws;
    gu32* ctl = (gu32*)(ws + WS_CTL);
    const float* x = args.in[0]; const float* cvec = args.in[1]; const float* ada_w = args.in[2]; const float* ada_b = args.in[3];
    const float* g_pre = args.in[4]; const float* g_post = args.in[5];
    float* out = args.out;
    float* mod = (float*)(ws + WS_MOD); float* lamp = (float*)(ws + WS_LAM); float* lb16 = (float*)(ws + WS_LB16);
    bf16_t* Win0 = (bf16_t*)(ws + WS_WIN0); bf16_t* Wglu = (bf16_t*)(ws + WS_WGLU); bf16_t* Wout0 = (bf16_t*)(ws + WS_WOUT0); bf16_t* Wkv = (bf16_t*)(ws + WS_WKV);
    bf16_t* Win1 = (bf16_t*)(ws + WS_WIN1); bf16_t* Wout1 = (bf16_t*)(ws + WS_WOUT1); bf16_t* BtA = (bf16_t*)(ws + WS_BTA); bf16_t* BtB = (bf16_t*)(ws + WS_BTB);
    bf16_t* A0 = (bf16_t*)(ws + WS_S0); bf16_t* US = (bf16_t*)(ws + WS_S1); bf16_t* SZ = (bf16_t*)(ws + WS_S3); bf16_t* YG = (bf16_t*)(ws + WS_S4); float* EB = (float*)(ws + WS_S0);
    bf16_t* Y2 = (bf16_t*)(ws + WS_S0); bf16_t* YO = (bf16_t*)(ws + WS_S1); bf16_t* AKV = (bf16_t*)(ws + WS_S0); bf16_t* AIN1 = (bf16_t*)(ws + WS_S2);
    bf16_t* KB = (bf16_t*)(ws + WS_S3); bf16_t* VB = (bf16_t*)(ws + WS_S4); bf16_t* QB = (bf16_t*)(ws + WS_S5); bf16_t* SZ1 = (bf16_t*)(ws + WS_S6);
    bf16_t* O0 = (bf16_t*)(ws + (H1_AKV ? WS_S1 : WS_S0)); bf16_t* O1 = (bf16_t*)(ws + WS_S1); bf16_t* OG = (bf16_t*)(ws + WS_S2); bf16_t* YO1 = (bf16_t*)(ws + (H1_AKV ? WS_S3 : WS_S0));
    float* HN = (float*)(ws + WS_HN);

    for (int u = TID_NOW(); u < (LDS_BYTES - LDSCTL_OFF) / 4; u += NWAVES * 64) ((LAS unsigned*)(lds + LDSCTL_OFF))[u] = 0u;
    __syncthreads();
    XcdBarrier bar; bar.bar = (unsigned*)(ctl + CW_BAR); bar.x = 0; bar.st = nullptr;
    bool xcl = false; int bx = blockIdx.x; unsigned px = 0;
    if (args.use_bar) {
        bar = xcd_barrier_post((unsigned*)(ctl + CW_BAR), MISC + 8, TID_NOW());
        if (XCC_LOCAL && G == 256) {
            if (TID_NOW() == 0) { unsigned nloc_, nx_; xcd_barrier_complete(bar.bar, bar.x, nloc_, nx_); bool uni = (nx_ == 8u);
                for (unsigned j = 0; j < 8; ++j) uni = uni && (xb_ld(&bar.bar[XB_XCNT(j)]) == 32u);
                MISC[8] = nloc_; MISC[9] = nx_; MISC[13] = uni ? 1u : 0u; }
            __syncthreads();
            xcl = (__builtin_amdgcn_readfirstlane((int)MISC[13]) != 0); px = bar.x;
            if (xcl) bx = __builtin_amdgcn_readfirstlane((int)MISC[12]) * 8 + (int)px;
        }
    }
    const int vcu = (G % 8 == 0) ? (bx % 8) * (G / 8) + bx / 8 : bx;
    const int rankx = bx >> 3;
    unsigned* lbar = (unsigned*)(ctl + CW_BAR) + XCD_BAR_WORDS;
    const int lo = args.ph_lo, hi = args.ph_hi;
#define IN(k) (lo <= (k) && (k) < hi)
#define REPS(k) (1 + ((REPEAT_MASK >> (k)) & 1))
#define SEAM(k) do { if (IN(k) && IN((k) + 1) && args.use_bar) { if ((k) == 0 || !xcl) xcd_barrier(bar, TID_NOW()); else xcc_barrier(lbar, px, 32u, TID_NOW()); } } while (0)
    const int gw = vcu * NWAVES + wave, NGW = G * NWAVES;
    const int egw = xcl ? rankx * NWAVES + wave : gw, engw = xcl ? 32 * NWAVES : NGW, eb_lo = xcl ? (int)px : 0, eb_hi = xcl ? (int)px + 1 : NB;
#define LANE_L() ({ int l_ = LANE_NOW(); asm volatile("" : "+v"(l_)); l_; })

    if (IN(0)) for (int rep_ = 0; rep_ < REPS(0); ++rep_) {
        const int tid = TID_NOW(), lane = tid & 63;
        for (int it = vcu; it < NGRP * 4; it += G) {
            const int g = it >> 2, qt = it & 3;
            LAS float* LBP = (LAS float*)(lds + RING_OFF);
            LAS float* BBR = LBP + 17 * 128;
            LAS float* CC = BBR + 64 * 32;
            LAS float* KM = CC + 16 * 130 + 12;
            __syncthreads();
            if (tid < 64) {
                const int p = tid;
                const float dt = expf(args.in[9][g]);
                const float lr = args.in[7][g * 64 + p], li = args.in[8][g * 64 + p];
                const float mag = expf(lr * dt); const float sn = sinf(li * dt), cs = cosf(li * dt);
                const float lbr = mag * cs, lbi = mag * sn;
                float pr = 1.f, pi = 0.f;
                for (int d = 0; d <= 16; ++d) { LBP[(d * 64 + p) * 2] = pr; LBP[(d * 64 + p) * 2 + 1] = pi; const float nr = pr * lbr - pi * lbi, ni = pr * lbi + pi * lbr; pr = nr; pi = ni; }
                if (qt == 0) { lb16[(g * 64 + p) * 2] = LBP[(16 * 64 + p) * 2]; lb16[(g * 64 + p) * 2 + 1] = LBP[(16 * 64 + p) * 2 + 1]; }
                const float nr = lbr - 1.0f, ni = lbi, den = lr * lr + li * li;
                const float cr = (nr * lr + ni * li) / den, ci = (ni * lr - nr * li) / den;
                for (int c = 0; c < 16; ++c) { const float br = args.in[10][(g * 64 + p) * 16 + c], bi = args.in[11][(g * 64 + p) * 16 + c];
                    BBR[(p * 16 + c) * 2] = cr * br - ci * bi; BBR[(p * 16 + c) * 2 + 1] = cr * bi + ci * br; }
            }
            for (int e = tid; e < 1024; e += 512) { const int co = e >> 6, p = e & 63; CC[(co * 65 + p) * 2] = args.in[12][(g * 16 + co) * 64 + p]; CC[(co * 65 + p) * 2 + 1] = args.in[13][(g * 16 + co) * 64 + p]; }
            __syncthreads();
            {
                const int pair = tid >> 1, hh = tid & 1, d = pair >> 4, co = pair & 15; float acc8[8];
#pragma unroll
                for (int j = 0; j < 8; ++j) acc8[j] = 0.f;
                for (int p = 0; p < 64; ++p) { const float cr = CC[(co * 65 + p) * 2], cim = CC[(co * 65 + p) * 2 + 1], lr = LBP[(d * 64 + p) * 2], lim = LBP[(d * 64 + p) * 2 + 1];
                    const float wr_ = cr * lr - cim * lim, wi_ = cr * lim + cim * lr; const LAS f32x4_t* bp = (const LAS f32x4_t*)(BBR + (p * 16 + 8 * hh) * 2);
#pragma unroll
                    for (int q4 = 0; q4 < 4; ++q4) { const f32x4_t bb = bp[q4]; acc8[2 * q4] += wr_ * bb.x - wi_ * bb.y; acc8[2 * q4 + 1] += wr_ * bb.z - wi_ * bb.w; } }
#pragma unroll
                for (int j = 0; j < 8; ++j) KM[(d * 16 + co) * 16 + 8 * hh + j] = acc8[j] + ((SSM_DFOLD && d == 0 && co == 8 * hh + j) ? args.in[14][g * 16 + co] : 0.f);
            }
            __syncthreads();
            for (int e = tid; e < 64 * 48; e += 512) {
                const int n = 64 * qt + e / 48, pc = e % 48, s = n >> 4, co = n & 15; float v[8];
                if (pc < 32) { const int s2 = pc >> 1, ci0 = (pc & 1) * 8;
#pragma unroll
                    for (int j = 0; j < 8; ++j) v[j] = (s2 <= s) ? KM[((s - s2) * 16 + co) * 16 + ci0 + j] : 0.f;
                } else { const int j0 = (pc - 32) * 8;
#pragma unroll
                    for (int jj = 0; jj < 4; ++jj) { const int p = (j0 >> 1) + jj; const float cr = CC[(co * 65 + p) * 2], cim = CC[(co * 65 + p) * 2 + 1], lr = LBP[((s + 1) * 64 + p) * 2], lim = LBP[((s + 1) * 64 + p) * 2 + 1];
                        v[2 * jj] = cr * lr - cim * lim; v[2 * jj + 1] = -(cr * lim + cim * lr); } }
                v4u o; o.x = pk2bf(v[0], v[1]); o.y = pk2bf(v[2], v[3]); o.z = pk2bf(v[4], v[5]); o.w = pk2bf(v[6], v[7]);
                *(GAS v4u*)(BtB + ((size_t)g * 256 + n) * 384 + pc * 8) = o; }
            for (int e = tid; e < 64 * 32; e += 512) {
                const int n = 64 * qt + (e >> 5), pc = e & 31; float v[8];
                if (n < 128) { const int p = n >> 1, ri = n & 1, s2 = pc >> 1, ci0 = (pc & 1) * 8; const float lr = LBP[((15 - s2) * 64 + p) * 2], lim = LBP[((15 - s2) * 64 + p) * 2 + 1];
#pragma unroll
                    for (int j = 0; j < 8; ++j) { const float br = BBR[(p * 16 + ci0 + j) * 2], bi = BBR[(p * 16 + ci0 + j) * 2 + 1]; v[j] = ri ? (lr * bi + lim * br) : (lr * br - lim * bi); }
                } else {
#pragma unroll
                    for (int j = 0; j < 8; ++j) v[j] = 0.f; }
                v4u o; o.x = pk2bf(v[0], v[1]); o.y = pk2bf(v[2], v[3]); o.z = pk2bf(v[4], v[5]); o.w = pk2bf(v[6], v[7]);
                *(GAS v4u*)(BtA + ((size_t)g * 256 + n) * 256 + pc * 8) = o; }
        }
        __syncthreads();
        {
            LAS float* scr = (LAS float*)(lds + RING_OFF + wave * 16384);
            constexpr int I_2K = (DM / 64) * (2048 / 32), I_1K = (DM / 64) * (1024 / 32);
            constexpr int NITEMS = 2 * I_2K + 5 * I_1K;
            for (int it = gw; it < NITEMS; it += NGW) {
                int r = it;
                if (r < I_2K) { p0_transpose_item(args.in[6], DM, 2048, Win0, 0, nullptr, scr, r, lane); continue; } r -= I_2K;
                if (r < I_2K) { p0_transpose_item(args.in[21], DM, 2048, Win1, 0, nullptr, scr, r, lane); continue; } r -= I_2K;
                if (r < I_1K) { p0_transpose_item(args.in[15], DM, 1024, Wglu, 0, nullptr, scr, r, lane); continue; } r -= I_1K;
                if (r < I_1K) { p0_transpose_item(args.in[17], DM, 1024, Wout0, 0, nullptr, scr, r, lane); continue; } r -= I_1K;
                if (r < I_1K) { p0_transpose_item(args.in[19], DM, 1024, Wkv, 0, args.in[18], scr, r, lane); continue; } r -= I_1K;
                if (r < I_1K) { p0_transpose_item(args.in[20], DM, 1024, Wkv, 1024, args.in[18], scr, r, lane); continue; } r -= I_1K;
                p0_transpose_item(args.in[27], DM, 1024, Wout1, 0, nullptr, scr, r, lane);
            }
        }
        if (!(args.flags & 1)) {
            __syncthreads();
            LAS float* sc = (LAS float*)(lds + RING_OFF);
            LAS float* red = sc + 8192;
            bool have = false;
            for (int it = vcu; it < 2 * 96; it += G) {
                if (!have) { for (int e = tid; e < 8192; e += 512) sc[e] = silu_f(cvec[e]); have = true; __syncthreads(); }
                const int l = it / 96, cc = it % 96, j = cc * 32 + (lane & 31), kh = lane >> 5;
                float acc[8];
#pragma unroll
                for (int b = 0; b < 8; ++b) acc[b] = 0.f;
                const float* wp = ada_w + ((size_t)l * 1024 + wave * 128 + kh) * 3072 + j;
                for (int k0 = 0; k0 < 64; k0 += 32) {
                    float w[32];
#pragma unroll
                    for (int kk = 0; kk < 32; ++kk) w[kk] = NT_LD(wp + (size_t)(2 * (k0 + kk)) * 3072);
#pragma unroll
                    for (int kk = 0; kk < 32; ++kk) {
#pragma unroll
                        for (int b = 0; b < 8; ++b) acc[b] += w[kk] * sc[b * 1024 + wave * 128 + 2 * (k0 + kk) + kh];
                        if ((kk & 3) == 3) asm volatile("" ::: "memory"); }
                }
#pragma unroll
                for (int b = 0; b < 8; ++b) { acc[b] += __shfl_xor(acc[b], 32); if (lane < 32) red[(wave * 8 + b) * 32 + lane] = acc[b]; }
                __syncthreads();
                if (tid < 256) { const int b = tid >> 5, jl = tid & 31; float sum = ada_b[l * 3072 + cc * 32 + jl];
#pragma unroll
                  for (int w = 0; w < 8; ++w) sum += red[(w * 8 + b) * 32 + jl];
                  mod[((size_t)(l * 8 + b)) * 3072 + cc * 32 + jl] = sum; }
                __syncthreads();
            }
            if (bx == 0 && tid == 0) lamp[0] = diff_lambda(args.in[22], args.in[23], args.in[24], args.in[25]);
        }
    }
    SEAM(0);
    if (IN(1)) for (int rep_ = 0; rep_ < REPS(1); ++rep_) e_norm0_b(x, mod, g_pre, A0, egw, engw, LANE_L(), eb_lo, eb_hi);
    SEAM(1);
#ifdef EXTRA_BARS
    if (args.use_bar) for (int eb = 0; eb < EXTRA_BARS; ++eb) xcd_barrier(bar, TID_NOW());
#endif
    if (IN(2)) for (int rep_ = 0; rep_ < REPS(2); ++rep_) {
        pg8::Gemm g = pg8::gemm_std(A0, DM, Win0, DM, DM); pg8::Order S; S.init(MTOK / 256, 2048 / 256, 1, G, bx);
        pg8::EpiRow8<pg8::F_In0> E{{US, SZ}};
        pg8::gemm_phase<pg8::EpiRow8<pg8::F_In0>, ALIGN_E>(lds + RING_OFF, g, S, E, TID_NOW());
    }
    SEAM(2);
#if SSM_FUSED
    if (IN(3)) {
        pg8::Gemm gA = pg8::gemm_std(US, US_P, BtA, 256, 256); gA.a_gstep = (size_t)NTILE * US_P * 2; gA.b_gstep = (size_t)256 * 256 * 2;
        pg8::Gemm gB = pg8::gemm_std(US, US_P, BtB, 384, 384); gB.a_gstep = (size_t)NTILE * US_P * 2; gB.b_gstep = (size_t)256 * 384 * 2;
        pg8::EpiScan ES{lb16, US, LDSCTL_OFF + 2048};
#if SSM_DFOLD
        pg8::EpiRow8<pg8::F_SsmB0> EB2{{YG}};
#else
        pg8::EpiRow8<pg8::F_SsmB> EB2{{US, args.in[14], YG}};
#endif
        for (int uu = 0; xcl ? (uu * 32 + rankx < NGRP) : ((long)uu * G + bx < NGRP * NB); ++uu) {
            pg8::Order S; if (xcl) { S.init(1, 1, NGRP, 32, rankx); S.pm_off = (int)px; } else S.init(NTILE / 256, 1, NGRP, G, bx); S.only = uu;
            pg8::gemm_phase<pg8::EpiScan, false>(lds + RING_OFF, gA, S, ES, TID_NOW());
#if SSM_DFOLD
            pg8::gemm_phase<pg8::EpiRow8<pg8::F_SsmB0>, false>(lds + RING_OFF, gB, S, EB2, TID_NOW());
#else
            pg8::gemm_phase<pg8::EpiRow8<pg8::F_SsmB>, false>(lds + RING_OFF, gB, S, EB2, TID_NOW());
#endif
        }
    }
    SEAM(5);
#else
    if (IN(3)) for (int rep_ = 0; rep_ < REPS(3); ++rep_) {
        pg8::Gemm g = pg8::gemm_std(US, US_P, BtA, 256, 256); g.a_gstep = (size_t)NTILE * US_P * 2; g.b_gstep = (size_t)256 * 256 * 2;
        pg8::Order S; S.init(NTILE / 256, 1, NGRP, G, bx);
        pg8::EpiRow8<pg8::F_SsmA> E{{EB}};
        pg8::gemm_phase<pg8::EpiRow8<pg8::F_SsmA>, ALIGN_E>(lds + RING_OFF, g, S, E, TID_NOW());
    }
    SEAM(3);
    if (IN(4)) for (int rep_ = 0; rep_ < REPS(4); ++rep_) {
        for (int it = vcu + G * wave; it < NB * NGRP; it += G * NWAVES) {
            const int b = it / NGRP, g = it % NGRP, p = LANE_L();
            const float lr = lb16[(g * 64 + p) * 2], li = lb16[(g * 64 + p) * 2 + 1];
            float sr = 0.f, si = 0.f;
            const float* ep = EB + ((size_t)g * NTILE + b * 256) * 128 + 2 * p;
            bf16_t* sp = US + us_off(g, b * 256, 256 + 2 * p);
            for (int t0 = 0; t0 < 256; t0 += 16) {
                float er[16], ei[16];
#pragma unroll
                for (int j = 0; j < 16; ++j) { const float2 e = *(const float2*)(ep + (size_t)(t0 + j) * 128); er[j] = e.x; ei[j] = e.y; }
#pragma unroll
                for (int j = 0; j < 16; ++j) { *(unsigned*)(sp + (size_t)(t0 + j) * US_P) = pk2bf(sr, si);
                    const float nr = lr * sr - li * si + er[j], ni = lr * si + li * sr + ei[j]; sr = nr; si = ni; }
            }
        }
    }
    SEAM(4);
    if (IN(5)) for (int rep_ = 0; rep_ < REPS(5); ++rep_) {
        pg8::Gemm g = pg8::gemm_std(US, US_P, BtB, 384, 384); g.a_gstep = (size_t)NTILE * US_P * 2; g.b_gstep = (size_t)256 * 384 * 2;
        pg8::Order S; S.init(NTILE / 256, 1, NGRP, G, bx);
        pg8::EpiRow8<pg8::F_SsmB> E{{US, args.in[14], YG}};
        pg8::gemm_phase<pg8::EpiRow8<pg8::F_SsmB>, ALIGN_E>(lds + RING_OFF, g, S, E, TID_NOW());
    }
    SEAM(5);
#endif
    if (IN(6)) for (int rep_ = 0; rep_ < REPS(6); ++rep_) {
        pg8::Gemm g = pg8::gemm_std(YG, DM, Wglu, DM, DM);
        g.a_rs = 32u; g.a_c16 = (unsigned)((size_t)NTILE * YG_P * 2); g.a_kstep = (size_t)4 * NTILE * YG_P * 2; g.a_tstep = (size_t)256 * 32;
        pg8::Order S; S.init(MTOK / 256, 1024 / 256, 1, G, bx);
        pg8::EpiRow8<pg8::F_Glu> E{{YG, SZ, args.in[16], Y2}};
        pg8::gemm_phase<pg8::EpiRow8<pg8::F_Glu>, ALIGN_E>(lds + RING_OFF, g, S, E, TID_NOW());
    }
    SEAM(6);
#if FUSE_EPI
    if (IN(7)) {
        pg8::Gemm g = pg8::gemm_std(Y2, DM, Wout0, DM, DM);
        for (int half = 0; half < 2; ++half) {
            pg8::Order S; S.init(MTOK / 512, 1024 / 256, 1, G, bx); S.pm_off = half * (MTOK / 512);
            pg8::PanelRms st1{(unsigned*)(ws + WS_XCH), (unsigned*)(ctl + CW_SEAM), (unsigned*)(ctl + CW_TMO), RMS_EPS};
            pg8::PanelRms st2{(unsigned*)(ws + WS_XCH + 1 * MiB), (unsigned*)(ctl + CW_SEAM + SEAM_BANK), (unsigned*)(ctl + CW_TMO), RMS_EPS};
            pg8::EpiMid E{x, out, AKV, AIN1, mod, g_post, g_pre + 1024, st1, st2};
            pg8::gemm_phase<pg8::EpiMid, false>(lds + RING_OFF, g, S, E, TID_NOW());
        }
    }
#else
    if (IN(7)) {
        pg8::Gemm g = pg8::gemm_std(Y2, DM, Wout0, DM, DM); pg8::Order S; S.init(MTOK / 256, 1024 / 256, 1, G, bx);
        pg8::EpiRow8<pg8::F_Plain> E{{YO}};
        pg8::gemm_phase<pg8::EpiRow8<pg8::F_Plain>, ALIGN_E>(lds + RING_OFF, g, S, E, TID_NOW());
    }
    SEAM(7);
    if (IN(8)) { if (H1_BF16) e_mid(x, YO, mod, g_post, g_pre, (float*)nullptr, YO, AKV, AIN1, gw, NGW, LANE_L()); else e_mid_b(x, YO, mod, g_post, g_pre, (H1_RECOMP || H1_AKV) ? (float*)nullptr : out, AKV, AIN1, egw, engw, LANE_L(), H1_AKV ? HN : (float*)nullptr, eb_lo, eb_hi); }
#endif
    SEAM(8);
    if (IN(9)) for (int rep_ = 0; rep_ < REPS(9); ++rep_) {
        pg8::Gemm g = pg8::gemm_std(AKV, DM, Wkv, DM, DM); g.a_gstep = (size_t)(WS_S2 - WS_S0); g.b_gstep = (size_t)(WS_WIN1 - WS_WKV);
        pg8::Order S; S.init(MTOK / 256, 2048 / 256, 2, G, bx); S.mode2 = (G == 256);
        pg8::EpiRow8<pg8::F_Split2> E{{{KB, QB}, {VB, SZ1}}};
        pg8::gemm_phase<pg8::EpiRow8<pg8::F_Split2>, ALIGN_E>(lds + RING_OFF, g, S, E, TID_NOW());
    }
    SEAM(9);
    if (IN(10)) {
#if ATTN_V128
#if ATTN_FUSE_POST
        { const float lam = __int_as_float(__builtin_amdgcn_readfirstlane(__float_as_int(lamp[0])));
          attn_body::bf16x8 qr[4]; bool primed = false;
#if ATTN_PRIO
          if (wave >= 4) __builtin_amdgcn_s_setprio(1);
#endif
          const int nun = (64 * 16 - vcu + G - 1) / G;
#pragma unroll 1
          for (int su = 0; su < 2 * nun; ++su) {
            const int i = su >> 1, cc = su & 1;
            const long L = (long)i * G + vcu; const int pr = (int)(L % 256), qi = (int)(L / 256);
            const int bh = pr >> 2, j = pr & 3; const int qb = (qi & 1) ? (8 * (qi >> 1) + 7 - j) : (8 * (qi >> 1) + j); const int h = bh & 7, b = bh >> 3;
            const bool has_next = su + 1 < 2 * nun;
            const int i2 = (su + 1) >> 1, cc2 = (su + 1) & 1;
            const long L2 = (long)i2 * G + vcu; const int pr2 = (int)(L2 % 256), qi2 = (int)(L2 / 256);
            const int bh2 = pr2 >> 2, j2 = pr2 & 3; const int qb2 = (qi2 & 1) ? (8 * (qi2 >> 1) + 7 - j2) : (8 * (qi2 >> 1) + j2); const int h2 = bh2 & 7, b2 = bh2 >> 3;
            attn3::attn_unit<8>(TID_NOW(), b, 2 * h + cc, h, qb, QB, KB, VB, O0, (char*)lds_raw + RING_OFF, cc, SZ1, args.in[26], lam, OG, primed, has_next, b2, 2 * h2 + cc2, h2, qb2, qr);
            primed = true;
          }
#if ATTN_PRIO
          __builtin_amdgcn_s_setprio(0);
#endif
          }
#else
        for (int i = 0;; ++i) {
            const long L = (long)i * G + vcu; if (L >= 128 * 16) break;
            const int pr = (int)(L % 256), qi = (int)(L / 256);
            const int combo = pr >> 1, j = pr & 1;
            const int k4 = qi >> 1; const int qb = (qi & 1) ? (4 * k4 + 3 - j) : (4 * k4 + j);
            const int c = combo & 1, h = (combo >> 1) & 7, b = combo >> 4;
            { attn_body::bf16x8 qr_[4]; attn3::attn_unit<8>(TID_NOW(), b, 2 * h + c, h, qb, QB, KB, VB, c ? O1 : O0, (char*)lds_raw + RING_OFF, 0, SZ1, args.in[26], 0.f, OG, false, false, 0, 0, 0, 0, qr_); asm volatile("s_barrier" ::: "memory"); }
        }
#endif
#else
        for (int i = 0;; ++i) {
            const long L = (long)i * G + vcu; if (L >= 256 * 16) break;
            const int combo = (int)(L % 256), qi = (int)(L / 256);
            const int qb = (qi & 1) ? (qi >> 1) : (15 - (qi >> 1));
            const int vh = combo & 1, c = (combo >> 1) & 1, h = (combo >> 2) & 7, b = combo >> 5;
            attn_body::attn_unit<8>(TID_NOW(), b, 2 * h + c, 2 * h + vh, qb, QB, KB, VB, c ? O1 : O0, (char*)lds_raw + RING_OFF);
        }
#endif
    }
    SEAM(10);
#if !(ATTN_V128 && ATTN_FUSE_POST)
    if (IN(11)) for (int rep_ = 0; rep_ < REPS(11); ++rep_) e_attn_post(O0, O1, SZ1, args.in[26], lamp[0], OG, gw, NGW, LANE_L());
    SEAM(11);
#endif
#if FUSE_EPI
    if (IN(12)) {
        pg8::Gemm g = pg8::gemm_std(OG, DM, Wout1, DM, DM);
        for (int half = 0; half < 2; ++half) {
            pg8::Order S; S.init(MTOK / 512, 1024 / 256, 1, G, bx); S.pm_off = half * (MTOK / 512);
            pg8::PanelRms st{(unsigned*)(ws + WS_XCH + 2 * MiB), (unsigned*)(ctl + CW_SEAM + 2 * SEAM_BANK), (unsigned*)(ctl + CW_TMO), RMS_EPS};
            pg8::EpiFinal E{out, out, mod + 8 * 3072, g_post + 1024, st};
            pg8::gemm_phase<pg8::EpiFinal, false>(lds + RING_OFF, g, S, E, TID_NOW());
        }
    }
#else
    if (IN(12)) {
        pg8::Gemm g = pg8::gemm_std(OG, DM, Wout1, DM, DM); pg8::Order S; S.init(MTOK / 256, 1024 / 256, 1, G, bx);
        pg8::EpiRow8<pg8::F_Plain> E{{YO1}};
        pg8::gemm_phase<pg8::EpiRow8<pg8::F_Plain>, ALIGN_E>(lds + RING_OFF, g, S, E, TID_NOW());
    }
    SEAM(12);
    if (IN(13)) { if (H1_BF16) e_final_b(YO, out, YO1, mod, g_post, gw, NGW, LANE_L()); else if (H1_AKV) e_final_k(AKV, HN, YO1, out, mod, g_post, egw, engw, LANE_L(), eb_lo, eb_hi); else if (H1_RECOMP) e_final_x(x, YO, YO1, out, mod, g_post, gw, NGW, LANE_L()); else e_final_bm(out, YO1, mod, g_post, gw, NGW, LANE_L()); }
#endif
#undef IN
#undef SEAM
}

#ifndef FASTMASK
#define FASTMASK 0x3fff
#endif
#ifndef ONE_LAUNCH
#define ONE_LAUNCH 1
#endif
constexpr int NPHASE = 14;

extern "C" void kernel_launch(void* const* d_in, const int* in_sizes, int n_in, void* d_out, int out_size, void* d_ws, size_t ws_size, hipStream_t stream) {
    static int grid = 0;
    if (grid == 0) {
        if (n_in != 28 || out_size != MTOK * DM || ws_size < WS_END) { fprintf(stderr, "kernel_launch: unexpected shapes (n_in %d out %d ws %zu)\n", n_in, out_size, ws_size); grid = -1; return; }
        int dev = 0, cus = 0, per_cu = 0;
        if (hipGetDevice(&dev) != hipSuccess || hipDeviceGetAttribute(&cus, hipDeviceAttributeMultiprocessorCount, dev) != hipSuccess) { grid = -1; return; }
        if (hipFuncSetAttribute((const void*)mega_fwd, hipFuncAttributeMaxDynamicSharedMemorySize, LDS_BYTES) != hipSuccess) { fprintf(stderr, "kernel_launch: hipFuncSetAttribute failed\n"); grid = -1; return; }
        if (hipOccupancyMaxActiveBlocksPerMultiprocessor(&per_cu, (const void*)mega_fwd, NWAVES * 64, LDS_BYTES) != hipSuccess || per_cu < 1) { fprintf(stderr, "kernel_launch: occupancy query says %d\n", per_cu); }
        (void)hipGetLastError();
        grid = cus;
    }
    if (grid < 0) return;
    if (hipMemsetAsync((char*)d_ws + WS_CTL + (size_t)CW_BAR * 4, 0, (size_t)XCD_BAR_WORDS * 8, stream) != hipSuccess) { fprintf(stderr, "kernel_launch: memset failed\n"); return; }
    Args a{};
    for (int i = 0; i < 28; ++i) a.in[i] = (const float*)d_in[i];
    a.out = (float*)d_out; a.ws = (unsigned char*)d_ws;
#if ONE_LAUNCH
    a.ph_lo = 0; a.ph_hi = NPHASE; a.use_bar = 1; a.flags = 0;
    hipLaunchKernelGGL(mega_fwd, dim3(grid), dim3(NWAVES * 64), LDS_BYTES, stream, a);
#else
    const float* x = a.in[0]; unsigned char* ws = a.ws; float* out = a.out;
    float* mod = (float*)(ws + WS_MOD); float* lam = (float*)(ws + WS_LAM);
    bf16_t* A0 = (bf16_t*)(ws + WS_S0); bf16_t* US = (bf16_t*)(ws + WS_S1); bf16_t* SZ = (bf16_t*)(ws + WS_S3); bf16_t* YG = (bf16_t*)(ws + WS_S4);
    bf16_t* Y2 = (bf16_t*)(ws + WS_S0); bf16_t* YO = (bf16_t*)(ws + WS_S1); bf16_t* AKV = (bf16_t*)(ws + WS_S0); bf16_t* AIN1 = (bf16_t*)(ws + WS_S2);
    bf16_t* KB = (bf16_t*)(ws + WS_S3); bf16_t* VB = (bf16_t*)(ws + WS_S4); bf16_t* QB = (bf16_t*)(ws + WS_S5); bf16_t* SZ1 = (bf16_t*)(ws + WS_S6);
    bf16_t* O0 = (bf16_t*)(ws + WS_S0); bf16_t* O1 = (bf16_t*)(ws + WS_S1); bf16_t* OG = (bf16_t*)(ws + WS_S2); bf16_t* YO1 = (bf16_t*)(ws + WS_S0);
    const int EG = 2048;
    auto fast1 = [&](int lo, int hi, int flags) { a.ph_lo = lo; a.ph_hi = hi; a.use_bar = 0; a.flags = flags; hipLaunchKernelGGL(mega_fwd, dim3(grid), dim3(NWAVES * 64), LDS_BYTES, stream, a); };
    auto fast = [&](int lo, int hi, int flags) { fast1(lo, hi, flags); if (lo == EXTRA_PHASE) fast1(lo, hi, flags); };
    const unsigned FM = FASTMASK;
    if (FM & 1u) fast(0, 1, 0);
    else { fast(0, 1, 1); n_adaln<<<(2 * 8 * 3072 + 255) / 256, 256, 0, stream>>>(a.in[1], a.in[2], a.in[3], mod); n_lambda<<<1, 64, 0, stream>>>(a.in[22], a.in[23], a.in[24], a.in[25], lam); }
    if (FM & 2u) fast(1, 2, 0); else n_norm0<<<EG, 256, 0, stream>>>(x, mod, a.in[4], A0);
    if (FM & 4u) fast(2, 3, 0); else n_gemm<<<dim3(2048 / 64, MTOK / 64), 256, 0, stream>>>(AL_Row{A0}, WL_Plain{a.in[6], 2048}, EP_In0{US, SZ}, 2048);
    if (FM & 8u) { fast(3, 4, 0); fast(4, 5, 0); fast(5, 6, 0); }
    else n_ssm<<<NB * NGRP / 4, 256, 0, stream>>>(US, a.in[7], a.in[8], a.in[9], a.in[10], a.in[11], a.in[12], a.in[13], a.in[14], YG);
    if (FM & 64u) fast(6, 7, 0); else n_gemm<<<dim3(1024 / 64, MTOK / 64), 256, 0, stream>>>(AL_YG{YG}, WL_Plain{a.in[15], 1024}, EP_Glu{YG, SZ, a.in[16], Y2}, 1024);
    if (FM & 128u) fast(7, 8, 0); else n_gemm<<<dim3(1024 / 64, MTOK / 64), 256, 0, stream>>>(AL_Row{Y2}, WL_Plain{a.in[17], 1024}, EP_Plain{YO}, 1024);
    if (FM & 256u) fast(8, 9, 0); else n_mid<<<EG, 256, 0, stream>>>(x, YO, mod, a.in[5], a.in[4], out, AKV, AIN1);
    if (FM & 512u) fast(9, 10, 0);
    else { n_gemm<<<dim3(2048 / 64, MTOK / 64), 256, 0, stream>>>(AL_Row{AKV}, WL_KV{a.in[19], a.in[20], a.in[18]}, EP_KV{KB, VB}, 2048);
           n_gemm<<<dim3(2048 / 64, MTOK / 64), 256, 0, stream>>>(AL_Row{AIN1}, WL_Plain{a.in[21], 2048}, EP_In1{QB, SZ1}, 2048); }
    if (FM & 1024u) fast(10, 11, 0); else n_attn<<<MTOK * 8 / 4, 256, 0, stream>>>(QB, KB, VB, O0, O1);
    if (FM & 2048u) fast(11, 12, 0); else n_attn_post<<<EG, 256, 0, stream>>>(O0, O1, SZ1, a.in[26], lam, OG);
    if (FM & 4096u) fast(12, 13, 0); else n_gemm<<<dim3(1024 / 64, MTOK / 64), 256, 0, stream>>>(AL_Row{OG}, WL_Plain{a.in[27], 1024}, EP_Plain{YO1}, 1024);
    if (FM & 8192u) fast(13, 14, 0); else n_final<<<EG, 256, 0, stream>>>(out, YO1, mod, a.in[5]);
#endif
    const hipError_t le = hipPeekAtLastError();
    if (le != hipSuccess) fprintf(stderr, "kernel_launch: launch failed: %s\n", hipGetErrorName(le));
}
```

```cpp
#include <hip/hip_runtime.h>
#include <cstdio>
#include <cstdint>
#include <cmath>
#define FASTMASK 0x3fff
#define ONE_LAUNCH 1
#define REPEAT_MASK 0

typedef unsigned short bf16_t;
constexpr int NB = 8, SEQL = 4096, DM = 1024, MTOK = NB * SEQL;
constexpr int NGRP = 64, NTILE = MTOK / 16;
constexpr int US_P = 384, YG_P = 256;
constexpr float LAMBDA_INIT = 0.35550907f;
constexpr float ONE_M_LI = 1.0f - LAMBDA_INIT;
constexpr float RMS_EPS = 1e-6f;
constexpr float QC2 = 0.125f * 1.4426950408889634f;

__device__ __forceinline__ float bf2f(bf16_t v) { return __uint_as_float((unsigned)v << 16); }
__device__ __forceinline__ unsigned f2bf_u(float f) { unsigned u = __float_as_uint(f); return (u + 0x7fffu + ((u >> 16) & 1u)) >> 16; }
__device__ __forceinline__ bf16_t f2bf(float f) { return (bf16_t)f2bf_u(f); }
__device__ __forceinline__ unsigned pk2bf(float lo, float hi) { return f2bf_u(lo) | (f2bf_u(hi) << 16); }
__device__ __forceinline__ float silu_f(float v) { return v / (1.0f + __expf(-v)); }
__device__ __forceinline__ float sigmoid_f(float v) { return 1.0f / (1.0f + __expf(-v)); }
__device__ __forceinline__ float gelu_tanh_f(float v) {
    const float u = 0.7978845608028654f * (v + 0.044715f * v * v * v);
    const float e = __expf(2.0f * u);
    const float t = 1.0f - 2.0f / (e + 1.0f);
    return 0.5f * v * (1.0f + t);
}
__device__ __forceinline__ float wave_sum_f(float v) {
#pragma unroll
    for (int o = 1; o < 64; o <<= 1) v += __shfl_xor(v, o);
    return v;
}
__device__ __forceinline__ float wave_max_f(float v) {
#pragma unroll
    for (int o = 1; o < 64; o <<= 1) v = fmaxf(v, __shfl_xor(v, o));
    return v;
}
__device__ __forceinline__ size_t us_off(int g, int tile, int col) { return ((size_t)g * NTILE + tile) * US_P + col; }
__device__ __forceinline__ size_t yg_off(int g, int tile, int col) { return ((size_t)g * NTILE + tile) * YG_P + col; }

typedef float f32x4_t __attribute__((ext_vector_type(4)));
typedef unsigned u32x4_t __attribute__((ext_vector_type(4)));
typedef unsigned u32x2_t __attribute__((ext_vector_type(2)));
#ifndef USE_NT
#define USE_NT 1
#endif
#if USE_NT
#define NT_LD(p) __builtin_nontemporal_load(p)
#define NT_ST(p, v) __builtin_nontemporal_store((v), (p))
#else
#define NT_LD(p) (*(p))
#define NT_ST(p, v) (*(p) = (v))
#endif

__device__ __forceinline__ void e_norm0(const float* __restrict__ x, const float* __restrict__ mod, const float* __restrict__ g_pre, bf16_t* a0, int gw, int ngw, int lane) {
    for (int m = gw; m < MTOK; m += ngw) {
        const int b = m / SEQL;
        const f32x4_t* xr = (const f32x4_t*)(x + (size_t)m * DM) + lane;
        f32x4_t v[4]; float s = 0.f;
#pragma unroll
        for (int j = 0; j < 4; ++j) { v[j] = NT_LD(xr + 64 * j); s += (v[j].x * v[j].x + v[j].y * v[j].y) + (v[j].z * v[j].z + v[j].w * v[j].w); }
        const float r = rsqrtf(wave_sum_f(s) * (1.0f / DM) + RMS_EPS);
        const float* sh = mod + (size_t)b * 3072; const float* sc = sh + 1024;
        u32x2_t* o = (u32x2_t*)(a0 + (size_t)m * DM) + lane;
#pragma unroll
        for (int j = 0; j < 4; ++j) {
            const int c = 256 * j + 4 * lane;
            const f32x4_t g = *(const f32x4_t*)(g_pre + c), scv = *(const f32x4_t*)(sc + c), shv = *(const f32x4_t*)(sh + c);
            f32x4_t y = v[j] * r * g * (scv + 1.0f) + shv;
            u32x2_t w; w.x = pk2bf(y.x, y.y); w.y = pk2bf(y.z, y.w); o[64 * j] = w;
        }
    }
}
__device__ __forceinline__ void e_mid(const float* __restrict__ x, const bf16_t* __restrict__ yo, const float* __restrict__ mod, const float* __restrict__ g_post, const float* __restrict__ g_pre,
                                      float* h1, bf16_t* h1b, bf16_t* akv, bf16_t* ain1, int gw, int ngw, int lane) {
    for (int m = gw; m < MTOK; m += ngw) {
        const int b = m / SEQL;
        const f32x4_t* xr = (const f32x4_t*)(x + (size_t)m * DM) + lane;
        const u32x2_t* yr = (const u32x2_t*)(yo + (size_t)m * DM) + lane;
        f32x4_t v[4], y[4]; float s = 0.f;
#pragma unroll
        for (int j = 0; j < 4; ++j) { v[j] = NT_LD(xr + 64 * j); const u32x2_t w = NT_LD(yr + 64 * j);
            y[j].x = __uint_as_float(w.x << 16); y[j].y = __uint_as_float(w.x & 0xffff0000u); y[j].z = __uint_as_float(w.y << 16); y[j].w = __uint_as_float(w.y & 0xffff0000u);
            s += (y[j].x * y[j].x + y[j].y * y[j].y) + (y[j].z * y[j].z + y[j].w * y[j].w); }
        const float ry = rsqrtf(wave_sum_f(s) * (1.0f / DM) + RMS_EPS);
        const float* gate0 = mod + (size_t)b * 3072 + 2048;
        const float* sh1 = mod + (size_t)(8 + b) * 3072; const float* sc1 = sh1 + 1024;
        float s2 = 0.f;
        f32x4_t* ho = (f32x4_t*)(h1 + (size_t)m * DM) + lane;
#pragma unroll
        for (int j = 0; j < 4; ++j) { const int c = 256 * j + 4 * lane;
            const f32x4_t gp = *(const f32x4_t*)(g_post + c), gt = *(const f32x4_t*)(gate0 + c);
            v[j] = v[j] + gt * (y[j] * ry * gp);
            if (h1) NT_ST(ho + 64 * j, v[j]);
            if (h1b) { u32x2_t wq; wq.x = pk2bf(v[j].x, v[j].y); wq.y = pk2bf(v[j].z, v[j].w); ((u32x2_t*)(h1b + (size_t)m * DM) + lane)[64 * j] = wq; }
            s2 += (v[j].x * v[j].x + v[j].y * v[j].y) + (v[j].z * v[j].z + v[j].w * v[j].w); }
        const float rh = rsqrtf(wave_sum_f(s2) * (1.0f / DM) + RMS_EPS);
        u32x2_t* o1 = (u32x2_t*)(akv + (size_t)m * DM) + lane; u32x2_t* o2 = (u32x2_t*)(ain1 + (size_t)m * DM) + lane;
#pragma unroll
        for (int j = 0; j < 4; ++j) { const int c = 256 * j + 4 * lane;
            const f32x4_t n = v[j] * rh;
            u32x2_t w; w.x = pk2bf(n.x, n.y); w.y = pk2bf(n.z, n.w); o1[64 * j] = w;
            const f32x4_t g = *(const f32x4_t*)(g_pre + 1024 + c), scv = *(const f32x4_t*)(sc1 + c), shv = *(const f32x4_t*)(sh1 + c);
            const f32x4_t z = n * g * (scv + 1.0f) + shv;
            w.x = pk2bf(z.x, z.y); w.y = pk2bf(z.z, z.w); o2[64 * j] = w; }
    }
}
__device__ __forceinline__ void e_attn_post(const bf16_t* __restrict__ o0, const bf16_t* __restrict__ o1, const bf16_t* __restrict__ sz1, const float* __restrict__ g_sub, float lam,
                                            bf16_t* og, int gw, int ngw, int lane) {
    for (int m = gw; m < MTOK; m += ngw) {
#pragma unroll
        for (int j = 0; j < 2; ++j) {
            const int c = 512 * j + 8 * lane;
            const u32x4_t a = *(const u32x4_t*)(o0 + (size_t)m * DM + c), bq = *(const u32x4_t*)(o1 + (size_t)m * DM + c), zq = *(const u32x4_t*)(sz1 + (size_t)m * DM + c);
            float d[8]; float s = 0.f;
#pragma unroll
            for (int i = 0; i < 4; ++i) { const unsigned wa = a[i], wb = bq[i];
                d[2 * i] = __uint_as_float(wa << 16) - lam * __uint_as_float(wb << 16); d[2 * i + 1] = __uint_as_float(wa & 0xffff0000u) - lam * __uint_as_float(wb & 0xffff0000u);
                s += d[2 * i] * d[2 * i] + d[2 * i + 1] * d[2 * i + 1]; }
            s += __shfl_xor(s, 1); s += __shfl_xor(s, 2); s += __shfl_xor(s, 4); s += __shfl_xor(s, 8);
            const float r = rsqrtf(s * (1.0f / 128.0f) + RMS_EPS) * ONE_M_LI;
            const float* gs = g_sub + (c & 127);
            u32x4_t w;
#pragma unroll
            for (int i = 0; i < 4; ++i) { const unsigned wz = zq[i];
                const float z0 = __uint_as_float(wz << 16), z1 = __uint_as_float(wz & 0xffff0000u);
                w[i] = pk2bf(d[2 * i] * r * gs[2 * i] * z0, d[2 * i + 1] * r * gs[2 * i + 1] * z1); }
            *(u32x4_t*)(og + (size_t)m * DM + c) = w;
        }
    }
}
__device__ __forceinline__ void e_final(float* out, const bf16_t* __restrict__ yo1, const float* __restrict__ mod, const float* __restrict__ g_post, int gw, int ngw, int lane) {
    for (int m = gw; m < MTOK; m += ngw) {
        const int b = m / SEQL;
        f32x4_t* hr = (f32x4_t*)(out + (size_t)m * DM) + lane;
        const u32x2_t* yr = (const u32x2_t*)(yo1 + (size_t)m * DM) + lane;
        f32x4_t v[4], y[4]; float s = 0.f;
#pragma unroll
        for (int j = 0; j < 4; ++j) { v[j] = NT_LD(hr + 64 * j); const u32x2_t w = NT_LD(yr + 64 * j);
            y[j].x = __uint_as_float(w.x << 16); y[j].y = __uint_as_float(w.x & 0xffff0000u); y[j].z = __uint_as_float(w.y << 16); y[j].w = __uint_as_float(w.y & 0xffff0000u);
            s += (y[j].x * y[j].x + y[j].y * y[j].y) + (y[j].z * y[j].z + y[j].w * y[j].w); }
        const float ry = rsqrtf(wave_sum_f(s) * (1.0f / DM) + RMS_EPS);
        const float* gate1 = mod + (size_t)(8 + b) * 3072 + 2048;
#pragma unroll
        for (int j = 0; j < 4; ++j) { const int c = 256 * j + 4 * lane;
            const f32x4_t gp = *(const f32x4_t*)(g_post + 1024 + c), gt = *(const f32x4_t*)(gate1 + c);
            NT_ST(hr + 64 * j, v[j] + gt * (y[j] * ry * gp)); }
    }
}
__device__ __forceinline__ void e_final2(const float* __restrict__ x, const bf16_t* __restrict__ yo, const bf16_t* __restrict__ yo1, float* out, const float* __restrict__ mod, const float* __restrict__ g_post, int gw, int ngw, int lane) {
    for (int m = gw; m < MTOK; m += ngw) {
        const int b = m / SEQL;
        const f32x4_t* xr = (const f32x4_t*)(x + (size_t)m * DM) + lane;
        const u32x2_t* y0r = (const u32x2_t*)(yo + (size_t)m * DM) + lane; const u32x2_t* y1r = (const u32x2_t*)(yo1 + (size_t)m * DM) + lane;
        f32x4_t v[4], y0[4], y1[4]; float s0 = 0.f, s1 = 0.f;
#pragma unroll
        for (int j = 0; j < 4; ++j) { v[j] = xr[64 * j]; const u32x2_t w0 = y0r[64 * j], w1 = y1r[64 * j];
            y0[j].x = __uint_as_float(w0.x << 16); y0[j].y = __uint_as_float(w0.x & 0xffff0000u); y0[j].z = __uint_as_float(w0.y << 16); y0[j].w = __uint_as_float(w0.y & 0xffff0000u);
            y1[j].x = __uint_as_float(w1.x << 16); y1[j].y = __uint_as_float(w1.x & 0xffff0000u); y1[j].z = __uint_as_float(w1.y << 16); y1[j].w = __uint_as_float(w1.y & 0xffff0000u);
            s0 += (y0[j].x * y0[j].x + y0[j].y * y0[j].y) + (y0[j].z * y0[j].z + y0[j].w * y0[j].w);
            s1 += (y1[j].x * y1[j].x + y1[j].y * y1[j].y) + (y1[j].z * y1[j].z + y1[j].w * y1[j].w); }
        const float r0 = rsqrtf(wave_sum_f(s0) * (1.0f / DM) + RMS_EPS), r1 = rsqrtf(wave_sum_f(s1) * (1.0f / DM) + RMS_EPS);
        const float* gate0 = mod + (size_t)b * 3072 + 2048; const float* gate1 = mod + (size_t)(8 + b) * 3072 + 2048;
        f32x4_t* orow = (f32x4_t*)(out + (size_t)m * DM) + lane;
#pragma unroll
        for (int j = 0; j < 4; ++j) { const int c = 256 * j + 4 * lane;
            const f32x4_t gp0 = *(const f32x4_t*)(g_post + c), gt0 = *(const f32x4_t*)(gate0 + c), gp1 = *(const f32x4_t*)(g_post + 1024 + c), gt1 = *(const f32x4_t*)(gate1 + c);
            const f32x4_t h = v[j] + gt0 * (y0[j] * r0 * gp0);
            orow[64 * j] = h + gt1 * (y1[j] * r1 * gp1); }
    }
}
__device__ __forceinline__ void e_final_b(const bf16_t* __restrict__ h1b, float* out, const bf16_t* __restrict__ yo1, const float* __restrict__ mod, const float* __restrict__ g_post, int gw, int ngw, int lane) {
    for (int m = gw; m < MTOK; m += ngw) {
        const int b = m / SEQL;
        const u32x2_t* hr = (const u32x2_t*)(h1b + (size_t)m * DM) + lane;
        const u32x2_t* yr = (const u32x2_t*)(yo1 + (size_t)m * DM) + lane;
        f32x4_t v[4], y[4]; float s = 0.f;
#pragma unroll
        for (int j = 0; j < 4; ++j) { const u32x2_t hw = NT_LD(hr + 64 * j); const u32x2_t w = NT_LD(yr + 64 * j);
            v[j].x = __uint_as_float(hw.x << 16); v[j].y = __uint_as_float(hw.x & 0xffff0000u); v[j].z = __uint_as_float(hw.y << 16); v[j].w = __uint_as_float(hw.y & 0xffff0000u);
            y[j].x = __uint_as_float(w.x << 16); y[j].y = __uint_as_float(w.x & 0xffff0000u); y[j].z = __uint_as_float(w.y << 16); y[j].w = __uint_as_float(w.y & 0xffff0000u);
            s += (y[j].x * y[j].x + y[j].y * y[j].y) + (y[j].z * y[j].z + y[j].w * y[j].w); }
        const float ry = rsqrtf(wave_sum_f(s) * (1.0f / DM) + RMS_EPS);
        const float* gate1 = mod + (size_t)(8 + b) * 3072 + 2048;
        f32x4_t* orow = (f32x4_t*)(out + (size_t)m * DM) + lane;
#pragma unroll
        for (int j = 0; j < 4; ++j) { const int c = 256 * j + 4 * lane;
            const f32x4_t gp = *(const f32x4_t*)(g_post + 1024 + c), gt = *(const f32x4_t*)(gate1 + c);
            NT_ST(orow + 64 * j, v[j] + gt * (y[j] * ry * gp)); }
    }
}

#define ER 2
__device__ __forceinline__ void unpk4(const u32x2_t w, f32x4_t& y) { y.x = __uint_as_float(w.x << 16); y.y = __uint_as_float(w.x & 0xffff0000u); y.z = __uint_as_float(w.y << 16); y.w = __uint_as_float(w.y & 0xffff0000u); }
__device__ __forceinline__ float ssq4(const f32x4_t v) { return (v.x * v.x + v.y * v.y) + (v.z * v.z + v.w * v.w); }
__device__ __forceinline__ void e_norm0_r(const float* __restrict__ x, const float* __restrict__ mod, const float* __restrict__ g_pre, bf16_t* a0, int gw, int ngw, int lane) {
    for (int m0 = gw; m0 < MTOK; m0 += ER * ngw) {
        f32x4_t v[ER][4]; float s[ER];
#pragma unroll
        for (int r = 0; r < ER; ++r) { const int m = min(m0 + r * ngw, MTOK - 1); const f32x4_t* xr = (const f32x4_t*)(x + (size_t)m * DM) + lane;
#pragma unroll
            for (int j = 0; j < 4; ++j) v[r][j] = NT_LD(xr + 64 * j); }
#pragma unroll
        for (int r = 0; r < ER; ++r) { s[r] = 0.f;
#pragma unroll
            for (int j = 0; j < 4; ++j) s[r] += ssq4(v[r][j]); }
#pragma unroll
        for (int r = 0; r < ER; ++r) { const int m = m0 + r * ngw; if (m >= MTOK) break;
            const int b = m / SEQL; const float rr = rsqrtf(wave_sum_f(s[r]) * (1.0f / DM) + RMS_EPS);
            const float* sh = mod + (size_t)b * 3072; const float* sc = sh + 1024;
            u32x2_t* o = (u32x2_t*)(a0 + (size_t)m * DM) + lane;
#pragma unroll
            for (int j = 0; j < 4; ++j) { const int c = 256 * j + 4 * lane;
                const f32x4_t g = *(const f32x4_t*)(g_pre + c), scv = *(const f32x4_t*)(sc + c), shv = *(const f32x4_t*)(sh + c);
                const f32x4_t y = v[r][j] * rr * g * (scv + 1.0f) + shv;
                u32x2_t w; w.x = pk2bf(y.x, y.y); w.y = pk2bf(y.z, y.w); o[64 * j] = w; } }
    }
}
__device__ __forceinline__ void e_mid_r(const float* __restrict__ x, const bf16_t* __restrict__ yo, const float* __restrict__ mod, const float* __restrict__ g_post, const float* __restrict__ g_pre,
                                        float* h1, bf16_t* akv, bf16_t* ain1, int gw, int ngw, int lane) {
    for (int m0 = gw; m0 < MTOK; m0 += ER * ngw) {
        f32x4_t v[ER][4], y[ER][4]; float s[ER];
#pragma unroll
        for (int r = 0; r < ER; ++r) { const int m = min(m0 + r * ngw, MTOK - 1); const f32x4_t* xr = (const f32x4_t*)(x + (size_t)m * DM) + lane; const u32x2_t* yr = (const u32x2_t*)(yo + (size_t)m * DM) + lane;
#pragma unroll
            for (int j = 0; j < 4; ++j) { v[r][j] = NT_LD(xr + 64 * j); unpk4(NT_LD(yr + 64 * j), y[r][j]); } }
#pragma unroll
        for (int r = 0; r < ER; ++r) { s[r] = 0.f;
#pragma unroll
            for (int j = 0; j < 4; ++j) s[r] += ssq4(y[r][j]); }
#pragma unroll
        for (int r = 0; r < ER; ++r) { const int m = m0 + r * ngw; if (m >= MTOK) break;
            const int b = m / SEQL; const float ry = rsqrtf(wave_sum_f(s[r]) * (1.0f / DM) + RMS_EPS);
            const float* gate0 = mod + (size_t)b * 3072 + 2048; const float* sh1 = mod + (size_t)(8 + b) * 3072; const float* sc1 = sh1 + 1024;
            float s2 = 0.f; f32x4_t* ho = (f32x4_t*)(h1 + (size_t)m * DM) + lane;
#pragma unroll
            for (int j = 0; j < 4; ++j) { const int c = 256 * j + 4 * lane;
                const f32x4_t gp = *(const f32x4_t*)(g_post + c), gt = *(const f32x4_t*)(gate0 + c);
                v[r][j] = v[r][j] + gt * (y[r][j] * ry * gp); NT_ST(ho + 64 * j, v[r][j]); s2 += ssq4(v[r][j]); }
            const float rh = rsqrtf(wave_sum_f(s2) * (1.0f / DM) + RMS_EPS);
            u32x2_t* o1 = (u32x2_t*)(akv + (size_t)m * DM) + lane; u32x2_t* o2 = (u32x2_t*)(ain1 + (size_t)m * DM) + lane;
#pragma unroll
            for (int j = 0; j < 4; ++j) { const int c = 256 * j + 4 * lane;
                const f32x4_t nn = v[r][j] * rh; u32x2_t w; w.x = pk2bf(nn.x, nn.y); w.y = pk2bf(nn.z, nn.w); o1[64 * j] = w;
                const f32x4_t g = *(const f32x4_t*)(g_pre + 1024 + c), scv = *(const f32x4_t*)(sc1 + c), shv = *(const f32x4_t*)(sh1 + c);
                const f32x4_t z = nn * g * (scv + 1.0f) + shv; w.x = pk2bf(z.x, z.y); w.y = pk2bf(z.z, z.w); o2[64 * j] = w; } }
    }
}
__device__ __forceinline__ void e_final_r(float* out, const bf16_t* __restrict__ yo1, const float* __restrict__ mod, const float* __restrict__ g_post, int gw, int ngw, int lane) {
    for (int m0 = gw; m0 < MTOK; m0 += ER * ngw) {
        f32x4_t v[ER][4], y[ER][4]; float s[ER];
#pragma unroll
        for (int r = 0; r < ER; ++r) { const int m = min(m0 + r * ngw, MTOK - 1); const f32x4_t* hr = (const f32x4_t*)(out + (size_t)m * DM) + lane; const u32x2_t* yr = (const u32x2_t*)(yo1 + (size_t)m * DM) + lane;
#pragma unroll
            for (int j = 0; j < 4; ++j) { v[r][j] = NT_LD(hr + 64 * j); unpk4(NT_LD(yr + 64 * j), y[r][j]); } }
#pragma unroll
        for (int r = 0; r < ER; ++r) { s[r] = 0.f;
#pragma unroll
            for (int j = 0; j < 4; ++j) s[r] += ssq4(y[r][j]); }
#pragma unroll
        for (int r = 0; r < ER; ++r) { const int m = m0 + r * ngw; if (m >= MTOK) break;
            const int b = m / SEQL; const float ry = rsqrtf(wave_sum_f(s[r]) * (1.0f / DM) + RMS_EPS);
            const float* gate1 = mod + (size_t)(8 + b) * 3072 + 2048; f32x4_t* hr = (f32x4_t*)(out + (size_t)m * DM) + lane;
#pragma unroll
            for (int j = 0; j < 4; ++j) { const int c = 256 * j + 4 * lane;
                const f32x4_t gp = *(const f32x4_t*)(g_post + 1024 + c), gt = *(const f32x4_t*)(gate1 + c);
                NT_ST(hr + 64 * j, v[r][j] + gt * (y[r][j] * ry * gp)); } }
    }
}

__device__ __forceinline__ void unpk4b(const u32x2_t w, f32x4_t& y) { y.x = __uint_as_float(w.x << 16); y.y = __uint_as_float(w.x & 0xffff0000u); y.z = __uint_as_float(w.y << 16); y.w = __uint_as_float(w.y & 0xffff0000u); }
__device__ __forceinline__ float ssq4b(const f32x4_t v) { return (v.x * v.x + v.y * v.y) + (v.z * v.z + v.w * v.w); }
__device__ __forceinline__ void e_norm0_b(const float* __restrict__ x, const float* __restrict__ mod, const float* __restrict__ g_pre, bf16_t* a0, int gw, int ngw, int lane, int b_lo = 0, int b_hi = NB) {
    for (int b = b_lo; b < b_hi; ++b) {
        const float* sh = mod + (size_t)b * 3072; const float* sc = sh + 1024;
        f32x4_t G[4], SH[4];
#pragma unroll
        for (int j = 0; j < 4; ++j) { const int c = 256 * j + 4 * lane; G[j] = *(const f32x4_t*)(g_pre + c) * (*(const f32x4_t*)(sc + c) + 1.0f); SH[j] = *(const f32x4_t*)(sh + c); }
        for (int r0 = gw; r0 < SEQL; r0 += 2 * ngw) {
            const int ra = r0, rb = r0 + ngw; const bool hb = rb < SEQL;
            const int ma = b * SEQL + ra, mb = b * SEQL + (hb ? rb : ra);
            f32x4_t va[4], vb[4];
            const f32x4_t* xa = (const f32x4_t*)(x + (size_t)ma * DM) + lane; const f32x4_t* xb = (const f32x4_t*)(x + (size_t)mb * DM) + lane;
#pragma unroll
            for (int j = 0; j < 4; ++j) { va[j] = NT_LD(xa + 64 * j); vb[j] = NT_LD(xb + 64 * j); }
            float sa = 0.f, sb = 0.f;
#pragma unroll
            for (int j = 0; j < 4; ++j) { sa += ssq4b(va[j]); sb += ssq4b(vb[j]); }
            const float rra = rsqrtf(wave_sum_f(sa) * (1.0f / DM) + RMS_EPS), rrb = rsqrtf(wave_sum_f(sb) * (1.0f / DM) + RMS_EPS);
            u32x2_t* oa = (u32x2_t*)(a0 + (size_t)ma * DM) + lane; u32x2_t* ob = (u32x2_t*)(a0 + (size_t)mb * DM) + lane;
#pragma unroll
            for (int j = 0; j < 4; ++j) { const f32x4_t y = va[j] * rra * G[j] + SH[j]; u32x2_t w; w.x = pk2bf(y.x, y.y); w.y = pk2bf(y.z, y.w); oa[64 * j] = w; }
            if (hb) {
#pragma unroll
                for (int j = 0; j < 4; ++j) { const f32x4_t y = vb[j] * rrb * G[j] + SH[j]; u32x2_t w; w.x = pk2bf(y.x, y.y); w.y = pk2bf(y.z, y.w); ob[64 * j] = w; } }
        }
    }
}
__device__ __forceinline__ void e_mid_b(const float* __restrict__ x, const bf16_t* __restrict__ yo, const float* __restrict__ mod, const float* __restrict__ g_post, const float* __restrict__ g_pre,
                                        float* h1, bf16_t* akv, bf16_t* ain1, int gw, int ngw, int lane, float* hnorm = nullptr, int b_lo = 0, int b_hi = NB) {
    for (int b = b_lo; b < b_hi; ++b) {
        const float* gate0 = mod + (size_t)b * 3072 + 2048; const float* sh1 = mod + (size_t)(8 + b) * 3072; const float* sc1 = sh1 + 1024;
        f32x4_t GG[4], GF[4], SH[4];
#pragma unroll
        for (int j = 0; j < 4; ++j) { const int c = 256 * j + 4 * lane; GG[j] = *(const f32x4_t*)(gate0 + c) * *(const f32x4_t*)(g_post + c);
            GF[j] = *(const f32x4_t*)(g_pre + 1024 + c) * (*(const f32x4_t*)(sc1 + c) + 1.0f); SH[j] = *(const f32x4_t*)(sh1 + c); }
        for (int r0 = gw; r0 < SEQL; r0 += 2 * ngw) {
            const int ra = r0, rb = r0 + ngw; const bool hb = rb < SEQL;
            const int mr[2] = {b * SEQL + ra, b * SEQL + (hb ? rb : ra)};
            f32x4_t v[2][4], y[2][4];
#pragma unroll
            for (int q = 0; q < 2; ++q) { const f32x4_t* xr = (const f32x4_t*)(x + (size_t)mr[q] * DM) + lane; const u32x2_t* yr = (const u32x2_t*)(yo + (size_t)mr[q] * DM) + lane;
#pragma unroll
                for (int j = 0; j < 4; ++j) { v[q][j] = NT_LD(xr + 64 * j); unpk4b(NT_LD(yr + 64 * j), y[q][j]); } }
            float s[2] = {0.f, 0.f};
#pragma unroll
            for (int q = 0; q < 2; ++q)
#pragma unroll
                for (int j = 0; j < 4; ++j) s[q] += ssq4b(y[q][j]);
            float ry[2]; ry[0] = rsqrtf(wave_sum_f(s[0]) * (1.0f / DM) + RMS_EPS); ry[1] = rsqrtf(wave_sum_f(s[1]) * (1.0f / DM) + RMS_EPS);
            float s2[2] = {0.f, 0.f};
#pragma unroll
            for (int q = 0; q < 2; ++q)
#pragma unroll
                for (int j = 0; j < 4; ++j) { v[q][j] = v[q][j] + GG[j] * (y[q][j] * ry[q]); s2[q] += ssq4b(v[q][j]); }
            float rh[2]; rh[0] = rsqrtf(wave_sum_f(s2[0]) * (1.0f / DM) + RMS_EPS); rh[1] = rsqrtf(wave_sum_f(s2[1]) * (1.0f / DM) + RMS_EPS);
            if (hnorm && lane == 0) { hnorm[mr[0]] = 1.0f / rh[0]; if (hb) hnorm[mr[1]] = 1.0f / rh[1]; }
#pragma unroll
            for (int q = 0; q < 2; ++q) { if (q == 1 && !hb) break;
                f32x4_t* ho = (f32x4_t*)(h1 + (size_t)mr[q] * DM) + lane; u32x2_t* o1 = (u32x2_t*)(akv + (size_t)mr[q] * DM) + lane; u32x2_t* o2 = (u32x2_t*)(ain1 + (size_t)mr[q] * DM) + lane;
#pragma unroll
                for (int j = 0; j < 4; ++j) { if (h1) NT_ST(ho + 64 * j, v[q][j]);
                    const f32x4_t nn = v[q][j] * rh[q]; u32x2_t w; w.x = pk2bf(nn.x, nn.y); w.y = pk2bf(nn.z, nn.w); o1[64 * j] = w;
                    const f32x4_t z = nn * GF[j] + SH[j]; w.x = pk2bf(z.x, z.y); w.y = pk2bf(z.z, z.w); o2[64 * j] = w; } }
        }
    }
}
__device__ __forceinline__ void e_final_bm(float* out, const bf16_t* __restrict__ yo1, const float* __restrict__ mod, const float* __restrict__ g_post, int gw, int ngw, int lane) {
    for (int b = 0; b < NB; ++b) {
        const float* gate1 = mod + (size_t)(8 + b) * 3072 + 2048;
        f32x4_t GG[4];
#pragma unroll
        for (int j = 0; j < 4; ++j) { const int c = 256 * j + 4 * lane; GG[j] = *(const f32x4_t*)(gate1 + c) * *(const f32x4_t*)(g_post + 1024 + c); }
        for (int r0 = gw; r0 < SEQL; r0 += 2 * ngw) {
            const int ra = r0, rb = r0 + ngw; const bool hb = rb < SEQL;
            const int mr[2] = {b * SEQL + ra, b * SEQL + (hb ? rb : ra)};
            f32x4_t v[2][4], y[2][4];
#pragma unroll
            for (int q = 0; q < 2; ++q) { const f32x4_t* hr = (const f32x4_t*)(out + (size_t)mr[q] * DM) + lane; const u32x2_t* yr = (const u32x2_t*)(yo1 + (size_t)mr[q] * DM) + lane;
#pragma unroll
                for (int j = 0; j < 4; ++j) { v[q][j] = NT_LD(hr + 64 * j); unpk4b(NT_LD(yr + 64 * j), y[q][j]); } }
            float s[2] = {0.f, 0.f};
#pragma unroll
            for (int q = 0; q < 2; ++q)
#pragma unroll
                for (int j = 0; j < 4; ++j) s[q] += ssq4b(y[q][j]);
            float ry[2]; ry[0] = rsqrtf(wave_sum_f(s[0]) * (1.0f / DM) + RMS_EPS); ry[1] = rsqrtf(wave_sum_f(s[1]) * (1.0f / DM) + RMS_EPS);
#pragma unroll
            for (int q = 0; q < 2; ++q) { if (q == 1 && !hb) break;
                f32x4_t* hr = (f32x4_t*)(out + (size_t)mr[q] * DM) + lane;
#pragma unroll
                for (int j = 0; j < 4; ++j) NT_ST(hr + 64 * j, v[q][j] + GG[j] * (y[q][j] * ry[q])); }
        }
    }
}
__device__ __forceinline__ void e_final_x(const float* __restrict__ x, const bf16_t* __restrict__ yo, const bf16_t* __restrict__ yo1, float* out, const float* __restrict__ mod, const float* __restrict__ g_post, int gw, int ngw, int lane) {
    for (int b = 0; b < NB; ++b) {
        const float* gate0 = mod + (size_t)b * 3072 + 2048; const float* gate1 = mod + (size_t)(8 + b) * 3072 + 2048;
        f32x4_t G0[4], G1[4];
#pragma unroll
        for (int j = 0; j < 4; ++j) { const int c = 256 * j + 4 * lane; G0[j] = *(const f32x4_t*)(gate0 + c) * *(const f32x4_t*)(g_post + c); G1[j] = *(const f32x4_t*)(gate1 + c) * *(const f32x4_t*)(g_post + 1024 + c); }
        for (int r0 = gw; r0 < SEQL; r0 += 2 * ngw) {
            const int ra = r0, rb = r0 + ngw; const bool hb = rb < SEQL;
            const int mr[2] = {b * SEQL + ra, b * SEQL + (hb ? rb : ra)};
            f32x4_t v[2][4], y0[2][4], y1[2][4];
#pragma unroll
            for (int q = 0; q < 2; ++q) { const f32x4_t* xr = (const f32x4_t*)(x + (size_t)mr[q] * DM) + lane; const u32x2_t* ar = (const u32x2_t*)(yo + (size_t)mr[q] * DM) + lane; const u32x2_t* br = (const u32x2_t*)(yo1 + (size_t)mr[q] * DM) + lane;
#pragma unroll
                for (int j = 0; j < 4; ++j) { v[q][j] = NT_LD(xr + 64 * j); unpk4b(NT_LD(ar + 64 * j), y0[q][j]); unpk4b(NT_LD(br + 64 * j), y1[q][j]); } }
            float s0[2] = {0.f, 0.f}, s1[2] = {0.f, 0.f};
#pragma unroll
            for (int q = 0; q < 2; ++q)
#pragma unroll
                for (int j = 0; j < 4; ++j) { s0[q] += ssq4b(y0[q][j]); s1[q] += ssq4b(y1[q][j]); }
            float r0_[2], r1_[2];
#pragma unroll
            for (int q = 0; q < 2; ++q) { r0_[q] = rsqrtf(wave_sum_f(s0[q]) * (1.0f / DM) + RMS_EPS); r1_[q] = rsqrtf(wave_sum_f(s1[q]) * (1.0f / DM) + RMS_EPS); }
#pragma unroll
            for (int q = 0; q < 2; ++q) { if (q == 1 && !hb) break;
                f32x4_t* orow = (f32x4_t*)(out + (size_t)mr[q] * DM) + lane;
#pragma unroll
                for (int j = 0; j < 4; ++j) { const f32x4_t h = v[q][j] + G0[j] * (y0[q][j] * r0_[q]); NT_ST(orow + 64 * j, h + G1[j] * (y1[q][j] * r1_[q])); } }
        }
    }
}
__device__ __forceinline__ void e_final_k(const bf16_t* __restrict__ akv, const float* __restrict__ hnorm, const bf16_t* __restrict__ yo1, float* out, const float* __restrict__ mod, const float* __restrict__ g_post, int gw, int ngw, int lane, int b_lo = 0, int b_hi = NB) {
    for (int b = b_lo; b < b_hi; ++b) {
        const float* gate1 = mod + (size_t)(8 + b) * 3072 + 2048;
        f32x4_t G1[4];
#pragma unroll
        for (int j = 0; j < 4; ++j) { const int c = 256 * j + 4 * lane; G1[j] = *(const f32x4_t*)(gate1 + c) * *(const f32x4_t*)(g_post + 1024 + c); }
        for (int r0 = gw; r0 < SEQL; r0 += 2 * ngw) {
            const int ra = r0, rb = r0 + ngw; const bool hb = rb < SEQL;
            const int mr[2] = {b * SEQL + ra, b * SEQL + (hb ? rb : ra)};
            f32x4_t v[2][4], y1[2][4]; float hn[2];
#pragma unroll
            for (int q = 0; q < 2; ++q) { const u32x2_t* ar = (const u32x2_t*)(akv + (size_t)mr[q] * DM) + lane; const u32x2_t* br = (const u32x2_t*)(yo1 + (size_t)mr[q] * DM) + lane; hn[q] = hnorm[mr[q]];
#pragma unroll
                for (int j = 0; j < 4; ++j) { unpk4b(NT_LD(ar + 64 * j), v[q][j]); unpk4b(NT_LD(br + 64 * j), y1[q][j]); } }
            float s1[2] = {0.f, 0.f};
#pragma unroll
            for (int q = 0; q < 2; ++q)
#pragma unroll
                for (int j = 0; j < 4; ++j) s1[q] += ssq4b(y1[q][j]);
            float r1_[2];
#pragma unroll
            for (int q = 0; q < 2; ++q) r1_[q] = rsqrtf(wave_sum_f(s1[q]) * (1.0f / DM) + RMS_EPS);
#pragma unroll
            for (int q = 0; q < 2; ++q) { if (q == 1 && !hb) break;
                f32x4_t* orow = (f32x4_t*)(out + (size_t)mr[q] * DM) + lane;
#pragma unroll
                for (int j = 0; j < 4; ++j) NT_ST(orow + 64 * j, v[q][j] * hn[q] + G1[j] * (y1[q][j] * r1_[q])); }
        }
    }
}
__device__ __forceinline__ float diff_lambda(const float* lq1, const float* lk1, const float* lq2, const float* lk2) {
    float s1 = 0.f, s2 = 0.f;
    for (int i = 0; i < 64; ++i) { s1 += lq1[i] * lk1[i]; s2 += lq2[i] * lk2[i]; }
    return expf(s1) - expf(s2) + LAMBDA_INIT;
}

__global__ void n_adaln(const float* __restrict__ c, const float* __restrict__ ada_w, const float* __restrict__ ada_b, float* mod) {
    const int idx = blockIdx.x * 256 + threadIdx.x;
    if (idx >= 2 * 8 * 3072) return;
    const int j = idx % 3072, b = (idx / 3072) % 8, l = idx / (3072 * 8);
    float acc = ada_b[l * 3072 + j];
    const float* w = ada_w + (size_t)l * 1024 * 3072 + j; const float* cb = c + b * 1024;
    for (int k = 0; k < 1024; ++k) acc += silu_f(cb[k]) * w[(size_t)k * 3072];
    mod[idx] = acc;
}
__global__ void n_lambda(const float* lq1, const float* lk1, const float* lq2, const float* lk2, float* out) {
    if (threadIdx.x == 0 && blockIdx.x == 0) out[0] = diff_lambda(lq1, lk1, lq2, lk2);
}
__global__ void n_norm0(const float* x, const float* mod, const float* g_pre, bf16_t* a0) {
    e_norm0(x, mod, g_pre, a0, blockIdx.x * 4 + (threadIdx.x >> 6), gridDim.x * 4, threadIdx.x & 63);
}
__global__ void n_mid(const float* x, const bf16_t* yo, const float* mod, const float* g_post, const float* g_pre, float* h1, bf16_t* akv, bf16_t* ain1) {
    e_mid(x, yo, mod, g_post, g_pre, h1, (bf16_t*)nullptr, akv, ain1, blockIdx.x * 4 + (threadIdx.x >> 6), gridDim.x * 4, threadIdx.x & 63);
}
__global__ void n_attn_post(const bf16_t* o0, const bf16_t* o1, const bf16_t* sz1, const float* g_sub, const float* lamp, bf16_t* og) {
    e_attn_post(o0, o1, sz1, g_sub, lamp[0], og, blockIdx.x * 4 + (threadIdx.x >> 6), gridDim.x * 4, threadIdx.x & 63);
}
__global__ void n_final(float* out, const bf16_t* yo1, const float* mod, const float* g_post) {
    e_final(out, yo1, mod, g_post, blockIdx.x * 4 + (threadIdx.x >> 6), gridDim.x * 4, threadIdx.x & 63);
}

struct AL_Row { const bf16_t* A; __device__ float ld(int m, int k) const { return bf2f(A[(size_t)m * DM + k]); } };
struct AL_YG  { const bf16_t* A; __device__ float ld(int m, int k) const { return bf2f(A[yg_off(k >> 4, m >> 4, (m & 15) * 16 + (k & 15))]); } };
struct WL_Plain { const float* W; long N; __device__ float ld(int k, int n) const { return W[(size_t)k * N + n]; } };
struct WL_KV { const float* wk; const float* wv; const float* g; __device__ float ld(int k, int n) const { return g[k] * (n < 1024 ? wk[(size_t)k * 1024 + n] : wv[(size_t)k * 1024 + n - 1024]); } };
struct EP_In0 { bf16_t* US; bf16_t* SZ; __device__ void st(int m, int n, float a) const {
    if (n < 1024) US[us_off(n >> 4, m >> 4, (m & 15) * 16 + (n & 15))] = f2bf(a); else SZ[(size_t)m * DM + n - 1024] = f2bf(silu_f(a)); } };
struct EP_Glu { const bf16_t* YG; const bf16_t* SZ; const float* bias; bf16_t* Y2; __device__ void st(int m, int n, float a) const {
    const float yv = bf2f(YG[yg_off(n >> 4, m >> 4, (m & 15) * 16 + (n & 15))]); const float t = a + bias[n];
    Y2[(size_t)m * DM + n] = f2bf(yv * sigmoid_f(t) * bf2f(SZ[(size_t)m * DM + n])); } };
struct EP_Plain { bf16_t* O; __device__ void st(int m, int n, float a) const { O[(size_t)m * DM + n] = f2bf(a); } };
struct EP_KV { bf16_t* K; bf16_t* V; __device__ void st(int m, int n, float a) const { if (n < 1024) K[(size_t)m * DM + n] = f2bf(a); else V[(size_t)m * DM + n - 1024] = f2bf(a); } };
struct EP_In1 { bf16_t* Q; bf16_t* SZ1; __device__ void st(int m, int n, float a) const { if (n < 1024) Q[(size_t)m * DM + n] = f2bf(a * QC2); else SZ1[(size_t)m * DM + n - 1024] = f2bf(silu_f(a)); } };

template <class AL, class WL, class EP>
__global__ void __launch_bounds__(256) n_gemm(AL al, WL wl, EP ep, int N) {
    __shared__ float As[16][68]; __shared__ float Ws[16][68];
    const int tid = threadIdx.x, tx = tid & 15, ty = tid >> 4;
    const int m0 = blockIdx.y * 64, n0 = blockIdx.x * 64;
    float acc[4][4];
#pragma unroll
    for (int i = 0; i < 4; ++i)
#pragma unroll
        for (int j = 0; j < 4; ++j) acc[i][j] = 0.f;
    for (int k0 = 0; k0 < 1024; k0 += 16) {
#pragma unroll
        for (int i = 0; i < 4; ++i) { const int e = tid + 256 * i; const int mm = e >> 4, kk = e & 15; As[kk][mm] = al.ld(m0 + mm, k0 + kk); }
#pragma unroll
        for (int i = 0; i < 4; ++i) { const int e = tid + 256 * i; const int kk = e >> 6, nn = e & 63; Ws[kk][nn] = wl.ld(k0 + kk, n0 + nn); }
        __syncthreads();
#pragma unroll
        for (int kk = 0; kk < 16; ++kk) {
            float a[4], b[4];
#pragma unroll
            for (int i = 0; i < 4; ++i) { a[i] = As[kk][ty * 4 + i]; b[i] = Ws[kk][tx * 4 + i]; }
#pragma unroll
            for (int i = 0; i < 4; ++i)
#pragma unroll
                for (int j = 0; j < 4; ++j) acc[i][j] += a[i] * b[j];
        }
        __syncthreads();
    }
#pragma unroll
    for (int i = 0; i < 4; ++i)
#pragma unroll
        for (int j = 0; j < 4; ++j) ep.st(m0 + ty * 4 + i, n0 + tx * 4 + j, acc[i][j]);
}

__global__ void __launch_bounds__(256) n_ssm(const bf16_t* __restrict__ US, const float* lam_re, const float* lam_im, const float* log_dt, const float* b_re, const float* b_im,
                                             const float* c_re, const float* c_im, const float* d_skip, bf16_t* YG) {
    const int wv = blockIdx.x * 4 + (threadIdx.x >> 6), lane = threadIdx.x & 63;
    if (wv >= NB * NGRP) return;
    const int b = wv / NGRP, g = wv % NGRP, p = lane;
    const float dt = expf(log_dt[g]);
    const float lr = lam_re[g * 64 + p], li = lam_im[g * 64 + p];
    const float mag = expf(lr * dt); float sn, cs; sn = sinf(li * dt); cs = cosf(li * dt);
    const float lbr = mag * cs, lbi = mag * sn;
    const float nr = lbr - 1.0f, ni = lbi, den = lr * lr + li * li;
    const float cr = (nr * lr + ni * li) / den, ci = (ni * lr - nr * li) / den;
    float bbr[16], bbi[16], ccr[16], cci[16];
#pragma unroll
    for (int c = 0; c < 16; ++c) { const float br = b_re[(g * 64 + p) * 16 + c], bi = b_im[(g * 64 + p) * 16 + c];
        bbr[c] = cr * br - ci * bi; bbi[c] = cr * bi + ci * br;
        ccr[c] = c_re[(g * 16 + c) * 64 + p]; cci[c] = c_im[(g * 16 + c) * 64 + p]; }
    const float dsk = d_skip[g * 16 + (lane & 15)];
    float sr = 0.f, si = 0.f;
    for (int t = 0; t < SEQL; ++t) {
        const int m = b * SEQL + t;
        const bf16_t* up = US + us_off(g, m >> 4, (m & 15) * 16);
        float u[16];
        { const u32x4_t w0 = *(const u32x4_t*)up, w1 = *(const u32x4_t*)(up + 8);
#pragma unroll
          for (int i = 0; i < 4; ++i) { u[2 * i] = __uint_as_float(w0[i] << 16); u[2 * i + 1] = __uint_as_float(w0[i] & 0xffff0000u); u[8 + 2 * i] = __uint_as_float(w1[i] << 16); u[8 + 2 * i + 1] = __uint_as_float(w1[i] & 0xffff0000u); } }
        float bur = 0.f, bui = 0.f;
#pragma unroll
        for (int c = 0; c < 16; ++c) { bur += bbr[c] * u[c]; bui += bbi[c] * u[c]; }
        const float nsr = lbr * sr - lbi * si + bur, nsi = lbr * si + lbi * sr + bui; sr = nsr; si = nsi;
        float yv = 0.f;
#pragma unroll
        for (int c = 0; c < 16; ++c) { const float part = wave_sum_f(ccr[c] * sr - cci[c] * si); if ((lane & 15) == c) yv = part; }
        if (lane < 16) { const float yy = yv + dsk * bf2f(up[lane]); YG[yg_off(g, m >> 4, (m & 15) * 16 + lane)] = f2bf(gelu_tanh_f(yy)); }
    }
}

__global__ void __launch_bounds__(256) n_attn(const bf16_t* __restrict__ Q, const bf16_t* __restrict__ K, const bf16_t* __restrict__ V, bf16_t* O0, bf16_t* O1) {
    __shared__ float qs[4][128];
    const int w = threadIdx.x >> 6, lane = threadIdx.x & 63;
    const int gwv = blockIdx.x * 4 + w;
    const int h = gwv & 7, m = gwv >> 3, b = m / SEQL, qi = m % SEQL;
    qs[w][lane] = bf2f(Q[(size_t)m * DM + h * 128 + lane]); qs[w][64 + lane] = bf2f(Q[(size_t)m * DM + h * 128 + 64 + lane]);
    __syncthreads();
    float m0 = -1e30f, m1 = -1e30f, l0 = 0.f, l1 = 0.f, a00 = 0.f, a01 = 0.f, a10 = 0.f, a11 = 0.f;
    const size_t rb = (size_t)b * SEQL;
    for (int kc = 0; kc * 64 <= qi; ++kc) {
        const int key = kc * 64 + lane; const bool valid = key <= qi;
        float s0 = 0.f, s1 = 0.f;
        { const bf16_t* kr = K + (rb + (valid ? key : qi)) * DM + h * 128;
#pragma unroll
          for (int ch = 0; ch < 8; ++ch) { const u32x4_t w0 = *(const u32x4_t*)(kr + ch * 8), w1 = *(const u32x4_t*)(kr + 64 + ch * 8);
#pragma unroll
            for (int i = 0; i < 4; ++i) { s0 += qs[w][ch * 8 + 2 * i] * __uint_as_float(w0[i] << 16) + qs[w][ch * 8 + 2 * i + 1] * __uint_as_float(w0[i] & 0xffff0000u);
                                          s1 += qs[w][64 + ch * 8 + 2 * i] * __uint_as_float(w1[i] << 16) + qs[w][64 + ch * 8 + 2 * i + 1] * __uint_as_float(w1[i] & 0xffff0000u); } } }
        if (!valid) { s0 = -1e30f; s1 = -1e30f; }
        const float nm0 = fmaxf(m0, wave_max_f(s0)), nm1 = fmaxf(m1, wave_max_f(s1));
        const float f0 = exp2f(m0 - nm0), f1 = exp2f(m1 - nm1);
        const float p0 = valid ? exp2f(s0 - nm0) : 0.f, p1 = valid ? exp2f(s1 - nm1) : 0.f;
        l0 = l0 * f0 + wave_sum_f(p0); l1 = l1 * f1 + wave_sum_f(p1); m0 = nm0; m1 = nm1;
        a00 *= f0; a01 *= f0; a10 *= f1; a11 *= f1;
        const int nk = min(64, qi - kc * 64 + 1);
        for (int j = 0; j < nk; ++j) {
            const float pj0 = __shfl(p0, j), pj1 = __shfl(p1, j);
            const bf16_t* vr = V + (rb + kc * 64 + j) * DM + h * 128;
            const float v0 = bf2f(vr[lane]), v1 = bf2f(vr[64 + lane]);
            a00 += pj0 * v0; a01 += pj0 * v1; a10 += pj1 * v0; a11 += pj1 * v1;
        }
    }
    const float i0 = 1.0f / l0, i1 = 1.0f / l1;
    O0[(size_t)m * DM + h * 128 + lane] = f2bf(a00 * i0); O0[(size_t)m * DM + h * 128 + 64 + lane] = f2bf(a01 * i0);
    O1[(size_t)m * DM + h * 128 + lane] = f2bf(a10 * i1); O1[(size_t)m * DM + h * 128 + 64 + lane] = f2bf(a11 * i1);
}
#ifndef REPEAT_MASK
#define REPEAT_MASK 0
#endif
#ifndef ATTN_V128
#define ATTN_V128 1
#endif
#ifndef EXTRA_PHASE
#define EXTRA_PHASE -1
#endif
#ifndef ATTN_FUSE_POST
#define ATTN_FUSE_POST 1
#endif
#ifndef H1_RECOMP
#define H1_RECOMP 1
#endif
#ifndef SSM_FUSED
#define SSM_FUSED 1
#endif
#ifndef ATTN_PRIO
#define ATTN_PRIO 0
#endif
#ifndef H1_BF16
#define H1_BF16 0
#endif
#ifndef H1_AKV
#define H1_AKV 1
#endif
#ifndef SSM_DFOLD
#define SSM_DFOLD 1
#endif
#ifndef ATTN_LAZY
#define ATTN_LAZY 1
#endif
#ifndef XCC_LOCAL
#define XCC_LOCAL 1
#endif
#ifndef NT_OUT
#define NT_OUT 0
#endif
#if NT_OUT
#define ST_OUT(p, v) __builtin_nontemporal_store((v), (p))
#else
#define ST_OUT(p, v) (*(p) = (v))
#endif
#ifndef FUSE_EPI
#define FUSE_EPI 0
#endif
#ifndef ALIGN_E
#define ALIGN_E true
#endif
namespace pg8 {
#define PG8_LAS __attribute__((address_space(3)))
typedef short bf16x8 __attribute__((ext_vector_type(8)));
typedef float f32x4 __attribute__((ext_vector_type(4)));
typedef unsigned u32x4 __attribute__((ext_vector_type(4)));
constexpr int BM = 256, BK = 64, HALF = 128, HTB = HALF * BK * 2  , STAGE_BYTES = 8 * HTB, NXCD = 8, WGM = 8;

__host__ __device__ __forceinline__ int lds_byte(int r, int c) { const int st = (r >> 4) * 2 + (c >> 5), rr = r & 15, cc = c & 31, ob = rr * 64 + cc * 2; return st * 1024 + (ob ^ (((ob >> 9) & 1) << 5)); }
__host__ __device__ __forceinline__ void stage_rc(int b, int& R, int& C) { const int st = b / 1024, sb = b % 1024, swz = sb ^ (((sb >> 9) & 1) << 5); R = (st >> 1) * 16 + swz / 64; C = (st & 1) * 32 + (swz % 64) / 2; }
__host__ __device__ __forceinline__ int perm32(int rho) { const int n = rho >> 4, i = rho & 15; return 8 * (i >> 2) + 4 * n + (i & 3); }

struct Unit { int pm, pn, grp; };
struct Gemm {
    const char* A; const char* Bt; int nt, pad0;
    unsigned a_rs, a_c16; size_t a_kstep, a_tstep, a_gstep;
    unsigned b_rs, pad1; size_t b_tstep, b_gstep;
    __device__ __forceinline__ const char* abase(const Unit& u) const { return A + (size_t)u.grp * a_gstep + (size_t)u.pm * a_tstep; }
    __device__ __forceinline__ const char* bbase(const Unit& u) const { return Bt + (size_t)u.grp * b_gstep + (size_t)u.pn * b_tstep; }
};
__device__ __forceinline__ Gemm gemm_std(const void* A, int lda, const void* Bt, int ldb, int K) {
    Gemm g; g.A = (const char*)A; g.Bt = (const char*)Bt; g.nt = K / BK; g.pad0 = 0; g.a_rs = (unsigned)lda * 2u; g.a_c16 = 32u; g.a_kstep = BK * 2; g.a_tstep = (size_t)BM * lda * 2; g.a_gstep = 0;
    g.b_rs = (unsigned)ldb * 2u; g.pad1 = 0; g.b_tstep = (size_t)BM * ldb * 2; g.b_gstep = 0; return g;
}

struct Order {
    int nM, nN, nG, nwg, G, c, only, pm_off, mode2;
    __device__ __forceinline__ void init(int nM_, int nN_, int nG_, int G_, int c_) { nM = nM_; nN = nN_; nG = nG_; nwg = nM * nN * nG; G = G_; c = c_; only = -1; pm_off = 0; mode2 = 0; }
    __device__ __forceinline__ bool next(int i, Unit& u) const {
        if (only >= 0) { if (i > 0) return false; i = only; }
        const long L = (long)i * G + c; if (L >= nwg) return false;
        int wgid = (int)L; { const int q = nwg / NXCD, r = nwg % NXCD, xcd = wgid % NXCD, off = wgid / NXCD; wgid = (xcd < r ? xcd * (q + 1) : r * (q + 1) + (xcd - r) * q) + off; }
        if (mode2) {
            const int x = wgid >> 8, y = wgid & 255, bk = y >> 6, w2 = y & 63; u.grp = bk & 1; u.pm = (x * 2 + (bk >> 1)) * 8 + (w2 & 7); u.pn = w2 >> 3;
        } else
        { const int per = nM * nN; u.grp = wgid / per; const int w2 = wgid % per;
          const int nig = WGM * nN, gid = w2 / nig, fm = gid * WGM, gsz = (nM - fm) < WGM ? (nM - fm) : WGM;
          u.pm = pm_off + fm + ((w2 % nig) % gsz); u.pn = (w2 % nig) / gsz; }
        return true;
    }
};

__device__ __forceinline__ unsigned cvt_pk_bf16(float lo, float hi) { unsigned r; asm volatile("v_cvt_pk_bf16_f32 %0, %1, %2" : "=v"(r) : "v"(lo), "v"(hi)); return r; }
__device__ __forceinline__ u32x4 pack8(const f32x4 a, const f32x4 b) { u32x4 w; w.x = cvt_pk_bf16(a[0], a[1]); w.y = cvt_pk_bf16(a[2], a[3]); w.z = cvt_pk_bf16(b[0], b[1]); w.w = cvt_pk_bf16(b[2], b[3]); return w; }
__device__ __forceinline__ void unpack8(const u32x4 w, f32x4& a, f32x4& b) {
    a[0] = __uint_as_float(w.x << 16); a[1] = __uint_as_float(w.x & 0xffff0000u); a[2] = __uint_as_float(w.y << 16); a[3] = __uint_as_float(w.y & 0xffff0000u);
    b[0] = __uint_as_float(w.z << 16); b[1] = __uint_as_float(w.z & 0xffff0000u); b[2] = __uint_as_float(w.w << 16); b[3] = __uint_as_float(w.w & 0xffff0000u); }
__device__ __forceinline__ float fsilu(float v) { return v * __builtin_amdgcn_rcpf(1.0f + __expf(-v)); }
__device__ __forceinline__ float fsigm(float v) { return __builtin_amdgcn_rcpf(1.0f + __expf(-v)); }
__device__ __forceinline__ f32x4 silu4(f32x4 v) { f32x4 o; o[0] = fsilu(v[0]); o[1] = fsilu(v[1]); o[2] = fsilu(v[2]); o[3] = fsilu(v[3]); return o; }
__device__ __forceinline__ f32x4 sigm4(f32x4 v) { f32x4 o; o[0] = fsigm(v[0]); o[1] = fsigm(v[1]); o[2] = fsigm(v[2]); o[3] = fsigm(v[3]); return o; }
__device__ __forceinline__ float fgelu(float v) { const float u = 0.7978845608028654f * (v + 0.044715f * v * v * v); const float e = __expf(2.0f * u); return 0.5f * v * (2.0f - 2.0f * __builtin_amdgcn_rcpf(e + 1.0f)); }
__device__ __forceinline__ f32x4 gelu4(f32x4 v) { f32x4 o; o[0] = fgelu(v[0]); o[1] = fgelu(v[1]); o[2] = fgelu(v[2]); o[3] = fgelu(v[3]); return o; }

template <class F> struct EpiRow8 {
    static constexpr bool PERM = true, AFTER_DRAIN = false;
    F f;
    __device__ __forceinline__ void operator()(const f32x4 (&acc)[2][2][4][2], const Unit& u, int wr, int wc, int fr, int fq) const {
#pragma unroll
        for (int ai = 0; ai < 2; ++ai)
#pragma unroll
            for (int m = 0; m < 4; ++m) { const int row = u.pm * BM + ai * HALF + wr * 64 + m * 16 + fr;
#pragma unroll
                for (int bj = 0; bj < 2; ++bj) { const int col0 = u.pn * BM + bj * HALF + wc * 32 + 8 * fq; f.apply(u, row, col0, acc[ai][bj][m][0], acc[ai][bj][m][1]); } }
    }
};
struct F_In0 { bf16_t* US; bf16_t* SZ;
    __device__ __forceinline__ void apply(const Unit&, int row, int col0, f32x4 v0, f32x4 v1) const {
        if (col0 < 1024) ST_OUT((u32x4*)(US + us_off(col0 >> 4, row >> 4, (row & 15) * 16 + (col0 & 15))), pack8(v0, v1));
        else NT_ST((u32x4*)(SZ + (size_t)row * DM + (col0 - 1024)), pack8(silu4(v0), silu4(v1))); } };
struct F_SsmA { float* E;
    __device__ __forceinline__ void apply(const Unit& u, int row, int col0, f32x4 v0, f32x4 v1) const {
        if (col0 < 128) { float* p = E + ((size_t)u.grp * NTILE + row) * 128 + col0; *(f32x4*)p = v0; *(f32x4*)(p + 4) = v1; } } };
struct F_SsmB { const bf16_t* US; const float* dsk; bf16_t* YG;
    __device__ __forceinline__ void apply(const Unit& u, int row, int col0, f32x4 v0, f32x4 v1) const {
        const u32x4 uw = *(const u32x4*)(US + us_off(u.grp, row, col0)); f32x4 u0, u1; unpack8(uw, u0, u1);
        const float* d = dsk + u.grp * 16 + (col0 & 15); const f32x4 d0 = *(const f32x4*)d, d1 = *(const f32x4*)(d + 4);
        ST_OUT((u32x4*)(YG + yg_off(u.grp, row, col0)), pack8(gelu4(v0 + d0 * u0), gelu4(v1 + d1 * u1))); } };
struct F_SsmB0 { bf16_t* YG;
    __device__ __forceinline__ void apply(const Unit& u, int row, int col0, f32x4 v0, f32x4 v1) const {
        *(u32x4*)(YG + yg_off(u.grp, row, col0)) = pack8(gelu4(v0), gelu4(v1)); } };
struct F_Glu { const bf16_t* YG; const bf16_t* SZ; const float* bias; bf16_t* Y2;
    __device__ __forceinline__ void apply(const Unit&, int row, int col0, f32x4 v0, f32x4 v1) const {
        const u32x4 yw = *(const u32x4*)(YG + yg_off(col0 >> 4, row >> 4, (row & 15) * 16 + (col0 & 15))); f32x4 y0, y1; unpack8(yw, y0, y1);
        const u32x4 zw = NT_LD((const u32x4*)(SZ + (size_t)row * DM + col0)); f32x4 z0, z1; unpack8(zw, z0, z1);
        const f32x4 b0 = *(const f32x4*)(bias + col0), b1 = *(const f32x4*)(bias + col0 + 4);
        ST_OUT((u32x4*)(Y2 + (size_t)row * DM + col0), pack8(y0 * sigm4(v0 + b0) * z0, y1 * sigm4(v1 + b1) * z1)); } };
template <class F> struct EpiRow8L {
    static constexpr bool PERM = true, AFTER_DRAIN = false;
    F f;
    __device__ __forceinline__ void operator()(const f32x4 (&acc)[2][2][4][2], const Unit& u, int wr, int wc, int fr, int fq) const {
#pragma unroll
        for (int ai = 0; ai < 2; ++ai) {
            typename F::Pre pre[4][2];
#pragma unroll
            for (int m = 0; m < 4; ++m) { const int row = u.pm * BM + ai * HALF + wr * 64 + m * 16 + fr;
#pragma unroll
                for (int bj = 0; bj < 2; ++bj) { const int col0 = u.pn * BM + bj * HALF + wc * 32 + 8 * fq; f.load(u, row, col0, pre[m][bj]); } }
#pragma unroll
            for (int m = 0; m < 4; ++m) { const int row = u.pm * BM + ai * HALF + wr * 64 + m * 16 + fr;
#pragma unroll
                for (int bj = 0; bj < 2; ++bj) { const int col0 = u.pn * BM + bj * HALF + wc * 32 + 8 * fq; f.apply(u, row, col0, acc[ai][bj][m][0], acc[ai][bj][m][1], pre[m][bj]); } }
        }
    }
};
struct F_SsmB2 { const bf16_t* US; const float* dsk; bf16_t* YG;
    struct Pre { u32x4 uw; };
    __device__ __forceinline__ void load(const Unit& u, int row, int col0, Pre& p) const { p.uw = *(const u32x4*)(US + us_off(u.grp, row, col0)); }
    __device__ __forceinline__ void apply(const Unit& u, int row, int col0, f32x4 v0, f32x4 v1, const Pre& p) const {
        f32x4 u0, u1; unpack8(p.uw, u0, u1);
        const float* d = dsk + u.grp * 16 + (col0 & 15); const f32x4 d0 = *(const f32x4*)d, d1 = *(const f32x4*)(d + 4);
        *(u32x4*)(YG + yg_off(u.grp, row, col0)) = pack8(gelu4(v0 + d0 * u0), gelu4(v1 + d1 * u1)); } };
struct F_Glu2 { const bf16_t* YG; const bf16_t* SZ; const float* bias; bf16_t* Y2;
    struct Pre { u32x4 yw, zw; };
    __device__ __forceinline__ void load(const Unit&, int row, int col0, Pre& p) const {
        p.yw = *(const u32x4*)(YG + yg_off(col0 >> 4, row >> 4, (row & 15) * 16 + (col0 & 15))); p.zw = *(const u32x4*)(SZ + (size_t)row * DM + col0); }
    __device__ __forceinline__ void apply(const Unit&, int row, int col0, f32x4 v0, f32x4 v1, const Pre& p) const {
        f32x4 y0, y1, z0, z1; unpack8(p.yw, y0, y1); unpack8(p.zw, z0, z1);
        const f32x4 b0 = *(const f32x4*)(bias + col0), b1 = *(const f32x4*)(bias + col0 + 4);
        *(u32x4*)(Y2 + (size_t)row * DM + col0) = pack8(y0 * sigm4(v0 + b0) * z0, y1 * sigm4(v1 + b1) * z1); } };
struct F_Split2 { bf16_t* Olo[2]; bf16_t* Ohi[2];
    __device__ __forceinline__ void apply(const Unit& u, int row, int col0, f32x4 v0, f32x4 v1) const {
        if (u.grp == 0) { bf16_t* o = (col0 < 1024) ? Olo[0] + (size_t)row * DM + col0 : Ohi[0] + (size_t)row * DM + (col0 - 1024); NT_ST((u32x4*)o, pack8(v0, v1)); }
        else if (col0 < 1024) NT_ST((u32x4*)(Olo[1] + (size_t)row * DM + col0), pack8(v0 * QC2, v1 * QC2));
        else NT_ST((u32x4*)(Ohi[1] + (size_t)row * DM + (col0 - 1024)), pack8(silu4(v0), silu4(v1))); } };
struct F_Plain { bf16_t* O;
    __device__ __forceinline__ void apply(const Unit&, int row, int col0, f32x4 v0, f32x4 v1) const { ST_OUT((u32x4*)(O + (size_t)row * DM + col0), pack8(v0, v1)); } };
struct F_Split { bf16_t* Olo; bf16_t* Ohi; float sc_lo; int silu_hi;
    __device__ __forceinline__ void apply(const Unit&, int row, int col0, f32x4 v0, f32x4 v1) const {
        if (col0 < 1024) *(u32x4*)(Olo + (size_t)row * DM + col0) = pack8(v0 * sc_lo, v1 * sc_lo);
        else { if (silu_hi) { NT_ST((u32x4*)(Ohi + (size_t)row * DM + (col0 - 1024)), pack8(silu4(v0), silu4(v1))); } else *(u32x4*)(Ohi + (size_t)row * DM + (col0 - 1024)) = pack8(v0, v1); } } };


struct PanelRms {
    unsigned* xbuf;
    unsigned* cnt;
    unsigned* tmo;
    float eps;
    __device__ __forceinline__ bool run(const f32x4 (&v)[2][2][4][2], const Unit& u, int wr, int wc, int fr, int fq, PG8_LAS unsigned char* lds, int wid, int lane) const {
        PG8_LAS float* P = (PG8_LAS float*)lds;
        PG8_LAS float* S = (PG8_LAS float*)(lds + 8192);
        PG8_LAS unsigned* flag = (PG8_LAS unsigned*)(lds + 8192 + 2048);
#pragma unroll
        for (int ai = 0; ai < 2; ++ai)
#pragma unroll
            for (int m = 0; m < 4; ++m) {
                float q = 0.f;
#pragma unroll
                for (int bj = 0; bj < 2; ++bj)
#pragma unroll
                    for (int n = 0; n < 2; ++n) { const f32x4 d = v[ai][bj][m][n]; q += (d[0] * d[0] + d[1] * d[1]) + (d[2] * d[2] + d[3] * d[3]); }
                q += __shfl_xor(q, 16); q += __shfl_xor(q, 32);
                if (fq == 0) P[(ai * HALF + wr * 64 + m * 16 + fr) * 4 + wc] = q;
            }
        asm volatile("s_waitcnt lgkmcnt(0)" ::: "memory"); __builtin_amdgcn_s_barrier(); asm volatile("" ::: "memory");
        const int row = wid * 32 + (lane & 31);
        if (lane < 32) {
            const float tot = (P[row * 4 + 0] + P[row * 4 + 1]) + (P[row * 4 + 2] + P[row * 4 + 3]);
            unsigned long long* slot = (unsigned long long*)xbuf + ((size_t)(u.pm * BM + row) * 4 + u.pn);
            __hip_atomic_store(slot, (unsigned long long)__float_as_uint(tot), __ATOMIC_RELAXED, __HIP_MEMORY_SCOPE_AGENT);
        }
        asm volatile("s_waitcnt vmcnt(0)" ::: "memory");
        if (lane == 0) __hip_atomic_fetch_add(cnt + 64 * u.pm, 1u, __ATOMIC_RELAXED, __HIP_MEMORY_SCOPE_AGENT);
        if (wid == 0) {
            bool dead = false; const unsigned long long t0 = __builtin_amdgcn_s_memrealtime(); const unsigned want = 32u;
            for (;;) {
                if ((unsigned)__builtin_amdgcn_readfirstlane(__hip_atomic_load(cnt + 64 * u.pm, __ATOMIC_RELAXED, __HIP_MEMORY_SCOPE_AGENT)) >= want) break;
                if (__builtin_amdgcn_s_memrealtime() - t0 > 2000000ull) { if (lane == 0) __hip_atomic_store(tmo, 1u, __ATOMIC_RELAXED, __HIP_MEMORY_SCOPE_AGENT); dead = true; break; }
                __builtin_amdgcn_s_sleep(2);
            }
            __builtin_amdgcn_fence(__ATOMIC_ACQUIRE, "agent");
            if (lane == 0) flag[0] = dead ? 1u : 0u;
        }
        asm volatile("s_waitcnt vmcnt(0) lgkmcnt(0)" ::: "memory"); __builtin_amdgcn_s_barrier(); asm volatile("" ::: "memory");
        const bool bad = flag[0] != 0u;
        if (lane < 32) {
            const unsigned long long* slot = (const unsigned long long*)xbuf + (size_t)(u.pm * BM + row) * 4; float t4[4];
#pragma unroll
            for (int t = 0; t < 4; ++t) t4[t] = __uint_as_float((unsigned)__hip_atomic_load(slot + t, __ATOMIC_RELAXED, __HIP_MEMORY_SCOPE_AGENT));
            S[row] = rsqrtf(((t4[0] + t4[1]) + (t4[2] + t4[3])) * (1.0f / 1024.0f) + eps);
        }
        asm volatile("s_waitcnt lgkmcnt(0)" ::: "memory"); __builtin_amdgcn_s_barrier(); asm volatile("" ::: "memory");
        return bad;
    }
};
struct EpiFinal {
    static constexpr bool PERM = false, AFTER_DRAIN = true;
    const float* base; float* out; const float* mod1; const float* gpost1; PanelRms st;
    __device__ __forceinline__ void fused(f32x4 (&acc)[2][2][4][2], const Unit& u, int wr, int wc, int fr, int fq, PG8_LAS unsigned char* lds, int wid, int lane) const {
        const PG8_LAS float* S = (const PG8_LAS float*)(lds + 8192);
        const int col0 = u.pn * BM + wc * 32 + 4 * fq; const int b = u.pm >> 4;
        const float* gate = mod1 + (size_t)b * 3072 + 2048;
        const bool bad = st.run(acc, u, wr, wc, fr, fq, lds, wid, lane);
        const float qnan = __builtin_nanf("");
        f32x4 gg[2][2];
#pragma unroll
        for (int bj = 0; bj < 2; ++bj)
#pragma unroll
            for (int n = 0; n < 2; ++n) gg[bj][n] = *(const f32x4*)(gate + col0 + bj * HALF + n * 16) * *(const f32x4*)(gpost1 + col0 + bj * HALF + n * 16);
#pragma unroll
        for (int ai = 0; ai < 2; ++ai)
#pragma unroll
            for (int m = 0; m < 4; ++m) { const int r = ai * HALF + wr * 64 + m * 16 + fr; const float sr = S[r]; const size_t off = (size_t)(u.pm * BM + r) * DM + col0;
#pragma unroll
                for (int bj = 0; bj < 2; ++bj)
#pragma unroll
                    for (int n = 0; n < 2; ++n) { const f32x4 bs = *(const f32x4*)(base + off + bj * HALF + n * 16); f32x4 o = bs + gg[bj][n] * (acc[ai][bj][m][n] * sr);
                        if (bad) o = (f32x4){qnan, qnan, qnan, qnan}; *(f32x4*)(out + off + bj * HALF + n * 16) = o; }
                if (m & 1) asm volatile("" ::: "memory"); }
    }
};
struct EpiMid {
    static constexpr bool PERM = false, AFTER_DRAIN = true;
    const float* x; float* out; bf16_t* akv; bf16_t* ain1; const float* mod; const float* gpost0; const float* gpre1; PanelRms st1, st2;
    __device__ __forceinline__ void fused(f32x4 (&acc)[2][2][4][2], const Unit& u, int wr, int wc, int fr, int fq, PG8_LAS unsigned char* lds, int wid, int lane) const {
        typedef unsigned u32x2v __attribute__((ext_vector_type(2)));
        const PG8_LAS float* S = (const PG8_LAS float*)(lds + 8192);
        const int col0 = u.pn * BM + wc * 32 + 4 * fq; const int b = u.pm >> 4;
        const float* gate0 = mod + (size_t)b * 3072 + 2048; const float* sh1 = mod + (size_t)(8 + b) * 3072; const float* sc1 = sh1 + 1024;
        bool bad = st1.run(acc, u, wr, wc, fr, fq, lds, wid, lane);
        {
            f32x4 gg[2][2];
#pragma unroll
            for (int bj = 0; bj < 2; ++bj)
#pragma unroll
                for (int n = 0; n < 2; ++n) gg[bj][n] = *(const f32x4*)(gate0 + col0 + bj * HALF + n * 16) * *(const f32x4*)(gpost0 + col0 + bj * HALF + n * 16);
#pragma unroll
            for (int ai = 0; ai < 2; ++ai)
#pragma unroll
                for (int m = 0; m < 4; ++m) { const int r = ai * HALF + wr * 64 + m * 16 + fr; const float sr = S[r]; const size_t off = (size_t)(u.pm * BM + r) * DM + col0;
#pragma unroll
                    for (int bj = 0; bj < 2; ++bj)
#pragma unroll
                        for (int n = 0; n < 2; ++n) { const f32x4 bs = *(const f32x4*)(x + off + bj * HALF + n * 16); acc[ai][bj][m][n] = bs + gg[bj][n] * (acc[ai][bj][m][n] * sr); }
                    asm volatile("" : "+v"(acc[ai][0][m][0]), "+v"(acc[ai][0][m][1]), "+v"(acc[ai][1][m][0]), "+v"(acc[ai][1][m][1]));
                    if (m & 1) asm volatile("" ::: "memory"); }
        }
        bad = st2.run(acc, u, wr, wc, fr, fq, lds, wid, lane) || bad;
        const float qnan = __builtin_nanf("");
#pragma unroll
        for (int bj = 0; bj < 2; ++bj)
#pragma unroll
            for (int n = 0; n < 2; ++n) { const int c = col0 + bj * HALF + n * 16;
                const f32x4 gf = *(const f32x4*)(gpre1 + c) * (*(const f32x4*)(sc1 + c) + 1.0f), sh = *(const f32x4*)(sh1 + c);
#pragma unroll
                for (int ai = 0; ai < 2; ++ai)
#pragma unroll
                    for (int m = 0; m < 4; ++m) { const int r = ai * HALF + wr * 64 + m * 16 + fr; const float sr = S[r]; const size_t off = (size_t)(u.pm * BM + r) * DM + c;
                        f32x4 h = acc[ai][bj][m][n]; if (bad) h = (f32x4){qnan, qnan, qnan, qnan};
                        *(f32x4*)(out + off) = h;
                        const f32x4 nr = h * sr; u32x2v w; w.x = cvt_pk_bf16(nr[0], nr[1]); w.y = cvt_pk_bf16(nr[2], nr[3]); *(u32x2v*)(akv + off) = w;
                        const f32x4 z = nr * gf + sh; w.x = cvt_pk_bf16(z[0], z[1]); w.y = cvt_pk_bf16(z[2], z[3]); *(u32x2v*)(ain1 + off) = w; }
                asm volatile("" ::: "memory"); }
    }
};

struct EpiScan {
    static constexpr bool PERM = true, AFTER_DRAIN = true;
    const float* lb16; bf16_t* US; int carry_off;
    __device__ __forceinline__ void fused(f32x4 (&acc)[2][2][4][2], const Unit& u, int wr, int wc, int fr, int fq, PG8_LAS unsigned char* lds, int wid, int lane) const {
#pragma unroll
        for (int ai = 0; ai < 2; ++ai)
#pragma unroll
            for (int m = 0; m < 4; ++m) { const int row = ai * HALF + wr * 64 + m * 16 + fr; const int ch = (wc * 32 + 8 * fq) >> 2;
                *(PG8_LAS f32x4*)(lds + row * 512 + ((ch ^ (row & 7)) << 4)) = acc[ai][0][m][0];
                *(PG8_LAS f32x4*)(lds + row * 512 + (((ch + 1) ^ (row & 7)) << 4)) = acc[ai][0][m][1]; }
        asm volatile("s_waitcnt lgkmcnt(0)" ::: "memory"); __builtin_amdgcn_s_barrier(); asm volatile("" ::: "memory");
        const int p = lane, g = u.grp, b = u.pm;
        const float lr = lb16[(g * 64 + p) * 2], li = lb16[(g * 64 + p) * 2 + 1];
        typedef float f32x2v __attribute__((ext_vector_type(2)));
        const int coff = ((p >> 1) << 4) + (p & 1) * 8;
        float sr = 0.f, si = 0.f;
#pragma unroll 8
        for (int j = 0; j < 32; ++j) { const int t = wid * 32 + j; const f32x2v e = *(const PG8_LAS f32x2v*)(lds + t * 512 + (coff ^ ((t & 7) << 4)));
            const float nr = lr * sr - li * si + e.x, ni = lr * si + li * sr + e.y; sr = nr; si = ni; }
        PG8_LAS f32x2v* C = (PG8_LAS f32x2v*)(lds + carry_off);
        C[wid * 64 + p] = (f32x2v){sr, si};
        float pr = lr, pi = li;
#pragma unroll
        for (int q = 0; q < 5; ++q) { const float nr = pr * pr - pi * pi, ni = 2.f * pr * pi; pr = nr; pi = ni; }
        asm volatile("s_waitcnt lgkmcnt(0)" ::: "memory"); __builtin_amdgcn_s_barrier(); asm volatile("" ::: "memory");
        sr = 0.f; si = 0.f;
        for (int v = 0; v < wid; ++v) { const f32x2v c = C[v * 64 + p]; const float nr = pr * sr - pi * si + c.x, ni = pr * si + pi * sr + c.y; sr = nr; si = ni; }
        bf16_t* sp = US + us_off(g, b * 256 + wid * 32, 256 + 2 * p);
#pragma unroll 8
        for (int j = 0; j < 32; ++j) { const int t = wid * 32 + j; const f32x2v e = *(const PG8_LAS f32x2v*)(lds + t * 512 + (coff ^ ((t & 7) << 4)));
            *(unsigned*)(sp + (size_t)j * US_P) = cvt_pk_bf16(sr, si);
            const float nr = lr * sr - li * si + e.x, ni = lr * si + li * sr + e.y; sr = nr; si = ni; }
        asm volatile("s_waitcnt vmcnt(0)" ::: "memory");
    }
};
template <class Epi, bool ALIGN_EPI>
__device__ __forceinline__ void gemm_phase(PG8_LAS unsigned char* lds, const Gemm g, const Order& S, const Epi& E, int tid_in) {
    int tid_ = tid_in; asm volatile("" : "+v"(tid_));
    const int tid = tid_, wid = __builtin_amdgcn_readfirstlane(tid >> 6), lane = tid & 63, wr = wid >> 2, wc = wid & 3, fr = lane & 15, fq = lane >> 4;
    const int nt = g.nt;
    unsigned voffA[2], voffB[2];
#pragma unroll
    for (int i = 0; i < 2; ++i) { int R, C; stage_rc(tid * 16 + i * 8192, R, C); const int Rb = Epi::PERM ? ((R & ~31) + perm32(R & 31)) : R;
        voffA[i] = (unsigned)R * g.a_rs + (unsigned)(C >> 4) * g.a_c16 + (unsigned)(C & 15) * 2u; voffB[i] = (unsigned)Rb * g.b_rs + (unsigned)C * 2u; }
    const size_t kstepA = g.a_kstep, kstepB = (size_t)(BK * 2);
    const size_t hstepA = (size_t)HALF * g.a_rs, hstepB = (size_t)HALF * g.b_rs;
    const unsigned ldsw = (unsigned)wid * 1024u;
    const int aoff = lds_byte(wr * 64 + fr, fq * 8), boff = lds_byte(wc * 32 + fr, fq * 8);
#define PG8_SA(b, h) (((b) * 2 + (h)) * HTB)
#define PG8_SB(b, h) ((4 + (b) * 2 + (h)) * HTB)
#define PG8_STAGE(bufoff, gbase, voff) do { _Pragma("unroll") for (int _i = 0; _i < 2; ++_i) \
        __builtin_amdgcn_global_load_lds((const unsigned*)((const char*)(gbase) + (voff)[_i]), (PG8_LAS unsigned*)(lds + (bufoff) + ldsw + _i * 8192), 16, 0, 0); } while (0)
#define PG8_LDA(dst, b, h) do { _Pragma("unroll") for (int m = 0; m < 4; ++m) _Pragma("unroll") for (int k = 0; k < 2; ++k) dst[m][k] = *(const PG8_LAS bf16x8*)(lds + PG8_SA(b, h) + aoff + m * 2048 + k * 1024); } while (0)
#define PG8_LDB(dst, b, h) do { _Pragma("unroll") for (int n = 0; n < 2; ++n) _Pragma("unroll") for (int k = 0; k < 2; ++k) dst[n][k] = *(const PG8_LAS bf16x8*)(lds + PG8_SB(b, h) + boff + n * 2048 + k * 1024); } while (0)
#define PG8_MMA(ai, bj, At, Bt) do { __builtin_amdgcn_s_setprio(1); _Pragma("unroll") for (int m = 0; m < 4; ++m) _Pragma("unroll") for (int n = 0; n < 2; ++n) _Pragma("unroll") for (int k = 0; k < 2; ++k) \
        acc[ai][bj][m][n] = __builtin_amdgcn_mfma_f32_16x16x32_bf16(Bt[n][k], At[m][k], acc[ai][bj][m][n], 0, 0, 0); __builtin_amdgcn_s_setprio(0); } while (0)
#define PG8_WAIT_V(n) asm volatile("s_waitcnt vmcnt(" #n ")" ::: "memory")
#define PG8_WAIT_L(n) asm volatile("s_waitcnt lgkmcnt(" #n ")" ::: "memory")
#define PG8_BAR __builtin_amdgcn_s_barrier()
#define PG8_SCHED __builtin_amdgcn_sched_barrier(0)
    Unit cur, nxt; int ui = 0;
    if (!S.next(0, cur)) return;
    f32x4 acc[2][2][4][2];
#pragma unroll
    for (int a = 0; a < 2; ++a)
#pragma unroll
        for (int b = 0; b < 2; ++b)
#pragma unroll
            for (int m = 0; m < 4; ++m)
#pragma unroll
                for (int n = 0; n < 2; ++n) acc[a][b][m][n] = (f32x4){0.f, 0.f, 0.f, 0.f};
    bf16x8 At[4][2], B0[2][2], B1[2][2];
    const char* cA = g.abase(cur); const char* cB = g.bbase(cur);
    PG8_STAGE(PG8_SB(0, 0), cB, voffB); PG8_STAGE(PG8_SB(0, 1), cB + hstepB, voffB); PG8_STAGE(PG8_SA(0, 0), cA, voffA); PG8_STAGE(PG8_SA(0, 1), cA + hstepA, voffA);
    if (wr == 1) PG8_BAR;
    PG8_WAIT_V(2); PG8_BAR;
    PG8_STAGE(PG8_SB(1, 0), cB + kstepB, voffB); PG8_STAGE(PG8_SA(1, 0), cA + kstepA, voffA); PG8_STAGE(PG8_SB(1, 1), cB + hstepB + kstepB, voffB);
    PG8_WAIT_V(6); PG8_BAR;
    for (;;) {
        const bool has_next = S.next(ui + 1, nxt);
        const char* nA = has_next ? g.abase(nxt) : cA; const char* nB = has_next ? g.bbase(nxt) : cB;
        for (int t = 0; t < nt; t += 2) {
            const bool last = (t == nt - 2);
            const char* a1 = cA + (size_t)(t + 1) * kstepA;
            const char* a2 = last ? nA : cA + (size_t)(t + 2) * kstepA; const char* b2 = last ? nB : cB + (size_t)(t + 2) * kstepB;
            const char* a3 = a2 + kstepA; const char* b3 = b2 + kstepB;
            PG8_LDB(B0, 0, 0); PG8_LDB(B1, 0, 1); PG8_SCHED; PG8_LDA(At, 0, 0); PG8_STAGE(PG8_SA(1, 1), a1 + hstepA, voffA);
            PG8_WAIT_V(8); PG8_WAIT_L(0); PG8_BAR; PG8_MMA(0, 0, At, B0); PG8_MMA(0, 1, At, B1); PG8_BAR; PG8_SCHED;
            PG8_LDA(At, 0, 1); PG8_STAGE(PG8_SB(0, 0), b2, voffB); PG8_STAGE(PG8_SB(0, 1), b2 + hstepB, voffB); PG8_STAGE(PG8_SA(0, 0), a2, voffA);
            PG8_WAIT_V(8); PG8_WAIT_L(0); PG8_BAR; PG8_MMA(1, 0, At, B0); PG8_MMA(1, 1, At, B1); PG8_BAR; PG8_SCHED;
            PG8_LDB(B0, 1, 0); PG8_LDB(B1, 1, 1); PG8_SCHED; PG8_LDA(At, 1, 0); PG8_STAGE(PG8_SA(0, 1), a2 + hstepA, voffA);
            PG8_WAIT_V(8); PG8_WAIT_L(0); PG8_BAR; PG8_MMA(0, 0, At, B0); PG8_MMA(0, 1, At, B1); PG8_BAR; PG8_SCHED;
            PG8_LDA(At, 1, 1); PG8_STAGE(PG8_SB(1, 0), b3, voffB); PG8_STAGE(PG8_SB(1, 1), b3 + hstepB, voffB); PG8_STAGE(PG8_SA(1, 0), a3, voffA);
            PG8_WAIT_V(8); PG8_WAIT_L(0); PG8_BAR; PG8_MMA(1, 0, At, B0); PG8_MMA(1, 1, At, B1); PG8_BAR; PG8_SCHED;
        }
        if constexpr (ALIGN_EPI) { if (wr == 0) PG8_BAR; }
        if constexpr (!Epi::AFTER_DRAIN) { E(acc, cur, wr, wc, fr, fq); }
        if (!has_next) break;
#pragma unroll
        for (int a = 0; a < 2; ++a)
#pragma unroll
            for (int b = 0; b < 2; ++b)
#pragma unroll
                for (int m = 0; m < 4; ++m)
#pragma unroll
                    for (int n = 0; n < 2; ++n) acc[a][b][m][n] = (f32x4){0.f, 0.f, 0.f, 0.f};
        cur = nxt; cA = nA; cB = nB; ++ui;
        if constexpr (ALIGN_EPI) { if (wr == 1) PG8_BAR; }
    }
    PG8_WAIT_V(0);
    if constexpr (!ALIGN_EPI) { if (wr == 0) PG8_BAR; }
    PG8_BAR;
    if constexpr (Epi::AFTER_DRAIN) { E.fused(acc, cur, wr, wc, fr, fq, lds, wid, lane); PG8_WAIT_L(0); PG8_BAR; }
#undef PG8_SA
#undef PG8_SB
#undef PG8_STAGE
#undef PG8_LDA
#undef PG8_LDB
#undef PG8_MMA
#undef PG8_WAIT_V
#undef PG8_WAIT_L
#undef PG8_BAR
#undef PG8_SCHED
}
}

namespace attn_body {
using bf16 = bf16_t;
using bf16x8 = __attribute__((ext_vector_type(8))) short;
using s16x4 = __attribute__((ext_vector_type(4))) short;
using f32x16 = __attribute__((ext_vector_type(16))) float;
using u32x4 = __attribute__((ext_vector_type(4))) unsigned;
constexpr int SEQ = SEQL, D = 64, DMA = 1024;
constexpr int NW = 8, QBLK = 32, QB = QBLK * NW, KVBLK = 64, NQB = SEQ / QB;
__device__ __forceinline__ int crow(int r, int hi) { return (r & 3) + 8 * (r >> 2) + 4 * hi; }
#define SBAR() __builtin_amdgcn_sched_barrier(0)
__device__ __forceinline__ void cmask(f32x16& p0, f32x16& p1, int jb, int qrel, int hi) {
  const float NEG = -INFINITY; int kb = 64 * jb + 4 * hi;
  #pragma unroll
  for (int r = 0; r < 16; ++r) { int kv = kb + (r & 3) + 8 * (r >> 2); if (kv > qrel) p0[r] = NEG; if (kv + 32 > qrel) p1[r] = NEG; }
}
constexpr int NSLOT = 3, SLOTB = 8192;
constexpr int LDS_K = 0, LDS_V = NSLOT * SLOTB, LDS_WS = 2 * NSLOT * SLOTB, LDS_OST = LDS_WS + NW * 64 * 4, LDS_BYTES = LDS_OST + NW * 4096;
__device__ __forceinline__ void glds16(const void* gsrc, unsigned lds_dst) { unsigned keep;
  asm volatile("s_mov_b32 %0, m0\n\ts_mov_b32 m0, %2\n\ts_nop 0\n\tglobal_load_lds_dwordx4 %1, off\n\ts_mov_b32 m0, %0" : "=&s"(keep) : "v"(gsrc), "s"(lds_dst) : "memory"); }
__device__ __forceinline__ float max3f(float a, float b, float c) { float r; asm("v_max3_f32 %0, %1, %2, %3" : "=v"(r) : "v"(a), "v"(b), "v"(c)); return r; }
__device__ __forceinline__ float max2f(float a, float b) { float r; asm("v_max_f32_e32 %0, %1, %2" : "=v"(r) : "v"(a), "v"(b)); return r; }
__device__ __forceinline__ float fadd_s(float a, float b) { float r; asm("v_add_f32_e32 %0, %1, %2" : "=v"(r) : "v"(a), "v"(b)); return r; }
__device__ __forceinline__ float fsub_s(float a, float b) { float r; asm("v_sub_f32_e32 %0, %1, %2" : "=v"(r) : "v"(a), "v"(b)); return r; }
typedef float f32x2_t __attribute__((ext_vector_type(2))); typedef __bf16 bf16x2_t __attribute__((ext_vector_type(2)));
__device__ __forceinline__ unsigned cvtpk_s(float lo, float hi) { f32x2_t v = {lo, hi}; bf16x2_t b = __builtin_convertvector(v, bf16x2_t); return __builtin_bit_cast(unsigned, b); }
#define WAIT_BAR(N) asm volatile("s_waitcnt vmcnt(" #N ") lgkmcnt(0)\n\ts_barrier" ::: "memory")

__device__ __forceinline__ void qkt(f32x16& p0, f32x16& p1, const char* Kslot, const bf16x8* qr, const f32x16& negm, int r32, int hi) {
  const char* kb = Kslot + hi * 1024 + r32 * 16;
  #pragma unroll
  for (int d0 = 0; d0 < 4; ++d0) {
    const bf16x8 b0 = *reinterpret_cast<const bf16x8*>(kb + d0 * 2048);
    const bf16x8 b1 = *reinterpret_cast<const bf16x8*>(kb + d0 * 2048 + 512);
    if (d0 == 0) { p0 = __builtin_amdgcn_mfma_f32_32x32x16_bf16(b0, qr[0], negm, 0, 0, 0); p1 = __builtin_amdgcn_mfma_f32_32x32x16_bf16(b1, qr[0], negm, 0, 0, 0); }
    else { p0 = __builtin_amdgcn_mfma_f32_32x32x16_bf16(b0, qr[d0], p0, 0, 0, 0); p1 = __builtin_amdgcn_mfma_f32_32x32x16_bf16(b1, qr[d0], p1, 0, 0, 0); } }
}
typedef __attribute__((address_space(3))) const char* lds_cptr;
typedef short v4i16_t __attribute__((ext_vector_type(4)));
__device__ __forceinline__ void kload8(bf16x8* kf, lds_cptr kp) {
  kf[0] = *(const __attribute__((address_space(3))) bf16x8*)(kp);        kf[1] = *(const __attribute__((address_space(3))) bf16x8*)(kp + 512);
  kf[2] = *(const __attribute__((address_space(3))) bf16x8*)(kp + 2048); kf[3] = *(const __attribute__((address_space(3))) bf16x8*)(kp + 2560);
  kf[4] = *(const __attribute__((address_space(3))) bf16x8*)(kp + 4096); kf[5] = *(const __attribute__((address_space(3))) bf16x8*)(kp + 4608);
  kf[6] = *(const __attribute__((address_space(3))) bf16x8*)(kp + 6144); kf[7] = *(const __attribute__((address_space(3))) bf16x8*)(kp + 6656);
}
__device__ __forceinline__ void kload2(bf16x8* kf, lds_cptr kp, int j) { kf[2 * j] = *(const __attribute__((address_space(3))) bf16x8*)(kp + j * 2048); kf[2 * j + 1] = *(const __attribute__((address_space(3))) bf16x8*)(kp + j * 2048 + 512); }
__device__ __forceinline__ s16x4 vtr(lds_cptr p) { return __builtin_bit_cast(s16x4, __builtin_amdgcn_ds_read_tr16_b64_v4i16((__attribute__((address_space(3))) v4i16_t*)p)); }
__device__ __forceinline__ float rowmax(const f32x16& p0, const f32x16& p1) {
  float a = max3f(p0[0], p0[1], p1[0]), b = max3f(p0[2], p0[3], p1[1]); a = max3f(a, p1[2], p1[3]);
  #pragma unroll
  for (int r = 4; r < 16; r += 4) { a = max3f(a, p0[r], p0[r + 1]); b = max3f(b, p0[r + 2], p0[r + 3]); a = max3f(a, p1[r], p1[r + 1]); b = max3f(b, p1[r + 2], p1[r + 3]); }
  const float m = max2f(a, b);
  auto rr = __builtin_amdgcn_permlane32_swap(__float_as_uint(m), __float_as_uint(m), false, false);
  return max2f(__uint_as_float(rr[0]), __uint_as_float(rr[1]));
}
__device__ __forceinline__ void pv(f32x16* o, int vb, bf16x8 pa0, bf16x8 pa1, bf16x8 pa2, bf16x8 pa3) {
  #pragma unroll
  for (int d0 = 0; d0 < 2; ++d0) { s16x4 lo[4], hi[4];
    #pragma unroll
    for (int ks = 0; ks < 4; ++ks) {
      asm volatile("ds_read_b64_tr_b16 %0,%1 offset:%c2" : "=&v"(lo[ks]) : "v"(vb), "i"(d0 * 4096 + ks * 1024) : "memory");
      asm volatile("ds_read_b64_tr_b16 %0,%1 offset:%c2" : "=&v"(hi[ks]) : "v"(vb), "i"(d0 * 4096 + ks * 1024 + 512) : "memory"); }
    asm volatile("s_waitcnt lgkmcnt(0)" ::: "memory"); SBAR();
    #define PK(k) (bf16x8){lo[k][0], lo[k][1], lo[k][2], lo[k][3], hi[k][0], hi[k][1], hi[k][2], hi[k][3]}
    o[d0] = __builtin_amdgcn_mfma_f32_32x32x16_bf16(pa0, PK(0), o[d0], 0, 0, 0);
    o[d0] = __builtin_amdgcn_mfma_f32_32x32x16_bf16(pa1, PK(1), o[d0], 0, 0, 0);
    o[d0] = __builtin_amdgcn_mfma_f32_32x32x16_bf16(pa2, PK(2), o[d0], 0, 0, 0);
    o[d0] = __builtin_amdgcn_mfma_f32_32x32x16_bf16(pa3, PK(3), o[d0], 0, 0, 0);
    #undef PK
  }
}
#define ATTN_STORE16(p, v) (*(u32x4*)(p) = (v))
template <int THRL> __device__ __forceinline__ void attn_unit(int tid_in, int b, int hq, int hv, int qb, const bf16* Q, const bf16* __restrict__ K, const bf16* __restrict__ V, bf16* O, char* shm) {
  const int tid = tid_in, lane = tid & 63, r32 = lane & 31, hi = lane >> 5; const int wid = __builtin_amdgcn_readfirstlane(tid >> 6);
  const long rowbase = (long)b * SEQ; const int q0 = qb * QB;
  const bf16* Qw = Q + (rowbase + q0 + wid * QBLK) * DMA + hq * D;
  const bf16* Kh = K + rowbase * DMA + hq * D, *Vh = V + rowbase * DMA + hv * D;
  const unsigned lds0 = (unsigned)(uintptr_t)shm;
  float* wsf = (float*)(shm + LDS_WS) + wid * 64;
  const bf16* ksrc = Kh + (long)lane * DMA + wid * 8;
  const bf16* vsrc = Vh + (long)(16 * (wid & 3) + (lane >> 2)) * DMA + (wid >> 2) * 32 + (lane & 3) * 8;
  const unsigned kdst = lds0 + LDS_K + wid * 1024, vdst = lds0 + LDS_V + wid * 1024;
  #define DMA_K(t, slot) glds16(ksrc + (long)(t) * KVBLK * DMA, (unsigned)__builtin_amdgcn_readfirstlane(kdst + (slot)))
  #define DMA_V(t, slot) glds16(vsrc + (long)(t) * KVBLK * DMA, (unsigned)__builtin_amdgcn_readfirstlane(vdst + (slot)))
  const int vb0 = (int)(lds0 + LDS_V) + ((lane >> 4) & 1) * 32 + (lane & 3) * 8 + (4 * hi + ((lane & 15) >> 2)) * 64;
  const char* Kbase = shm + LDS_K; bf16x8 kf[8];
  const lds_cptr shm3 = (lds_cptr)shm; const lds_cptr kp0 = shm3 + LDS_K + hi * 1024 + r32 * 16; const lds_cptr vp0 = shm3 + LDS_V + ((lane >> 4) & 1) * 32 + (lane & 3) * 8 + (4 * hi + ((lane & 15) >> 2)) * 64;
  const int NT = (q0 + QB) / KVBLK;
  DMA_K(0, 0); DMA_V(0, 0); DMA_K(1, SLOTB);
  bf16x8 qr[4];
  #pragma unroll
  for (int d0 = 0; d0 < 4; ++d0) qr[d0] = *reinterpret_cast<const bf16x8*>(&Qw[(long)r32 * DMA + d0 * 16 + hi * 8]);
  float mhat = 0.f, l_reg = 0.f; f32x16 o[2]; o[0] = f32x16{}; o[1] = f32x16{}; f32x16 negm = f32x16{}; asm volatile("" : "+v"(negm));
  const int qrel = wid * QBLK + r32;
  #define CMASK(P0, P1, t) do { int jb_ = (t) - (NT - 4); if (jb_ >= 0) cmask(P0, P1, jb_, qrel, hi); } while (0)
  bool resc = false;
  #define START(P0, P1) do { const float rm = rowmax(P0, P1); resc = false; \
    { const float dl = rm; mhat = fadd_s(mhat, dl); \
      _Pragma("unroll") for (int r = 0; r < 16; ++r) { P0[r] = fsub_s(P0[r], dl); P1[r] = fsub_s(P1[r], dl); } \
      _Pragma("unroll") for (int r = 0; r < 16; ++r) negm[r] = -mhat; asm volatile("" : "+v"(negm)); } \
    _Pragma("unroll") for (int r = 0; r < 16; ++r) P0[r] = __builtin_amdgcn_exp2f(P0[r]); } while (0)
  #define RESC() do { if (resc) { asm volatile("s_waitcnt lgkmcnt(0)" ::: "memory"); \
      _Pragma("unroll") for (int d_ = 0; d_ < 2; ++d_) _Pragma("unroll") for (int r = 0; r < 16; ++r) o[d_][r] *= wsf[crow(r, hi)]; } } while (0)
  f32x16 pA0, pA1, pB0, pB1;
  int sl_prev = 0, sl_cur = 0, sl_next = SLOTB;
  #define ROT() do { sl_prev = sl_cur; sl_cur = sl_next; sl_next = (sl_next == (NSLOT - 1) * SLOTB) ? 0 : sl_next + SLOTB; } while (0)
  DMA_K(2, 2 * SLOTB);
  WAIT_BAR(3);
  qkt(pA0, pA1, Kbase, qr, negm, r32, hi); asm volatile("s_nop 15\n\ts_nop 7" : "+v"(pA0), "+v"(pA1)); CMASK(pA0, pA1, 0);
  START(pA0, pA1);
  _Pragma("unroll") for (int r = 0; r < 16; ++r) pA1[r] = __builtin_amdgcn_exp2f(pA1[r]);
  WAIT_BAR(0);
  DMA_K(3, 0); DMA_V(1, SLOTB);
  ROT();
  kload8(kf, kp0 + sl_cur);
  WAIT_BAR(2);
  s16x4 vlo[8], vhi[8]; u32x4 pw0, pw1, pw2, pw3;
  #define PKW(P, B) cvtpk_s(P[B], P[B + 1])
  #define PAF(k) __builtin_bit_cast(bf16x8, pw##k)
  #define VFR(i) (bf16x8){vlo[i][0], vlo[i][1], vlo[i][2], vlo[i][3], vhi[i][0], vhi[i][1], vhi[i][2], vhi[i][3]}
  #define PIN(x) asm volatile("" : "+v"(x))
  #define MX3(a, b, c) __builtin_fmaxf(__builtin_fmaxf((a), (b)), (c))
  #define GAPA(MF, A0, A1, A2, A3, W0, W1, PW) do { MF; sacc += A0; sacc += A1; sacc += A2; sacc += A3; PIN(sacc); W0; W1; PIN(PW); SBAR(); } while (0)
  #define EX(v) __builtin_amdgcn_exp2f(v)
  #define GAPB(MF, X, B) do { MF; X[B] = EX(X[B]); X[B + 1] = EX(X[B + 1]); X[B + 2] = EX(X[B + 2]); X[B + 3] = EX(X[B + 3]); PIN(X); SBAR(); } while (0)
  #define VRD(i) do { vlo[i] = vtr(vp_ + (((i) >> 2) * 4096 + ((i) & 3) * 1024)); vhi[i] = vtr(vp_ + (((i) >> 2) * 4096 + ((i) & 3) * 1024 + 512)); } while (0)
  #define KRD(G, j) do { if (G) { kload2(kf, kp0 + sl_next, j); SBAR(); } } while (0)
  #define STEP(C0, C1, P0, P1, t, GK, GV, GL) do { SBAR(); \
    const lds_cptr vp_ = vp0 + sl_prev; \
    VRD(0); SBAR(); float sacc = (P0[0] + P0[1]); \
    GAPA(C0 = __builtin_amdgcn_mfma_f32_32x32x16_bf16(kf[0], qr[0], negm, 0, 0, 0), P0[2], P0[3], P0[4], P0[5],     pw0[0] = PKW(P0, 0), pw0[1] = PKW(P0, 2), pw0); \
    VRD(4); SBAR(); GAPA(C1 = __builtin_amdgcn_mfma_f32_32x32x16_bf16(kf[1], qr[0], negm, 0, 0, 0), P0[6], P0[7], P0[8], P0[9],     pw0[2] = PKW(P0, 4), pw0[3] = PKW(P0, 6), pw0); \
    VRD(1); SBAR(); GAPA(C0 = __builtin_amdgcn_mfma_f32_32x32x16_bf16(kf[2], qr[1], C0, 0, 0, 0),   P0[10], P0[11], P0[12], P0[13], pw1[0] = PKW(P0, 8), pw1[1] = PKW(P0, 10), pw1); \
    VRD(5); SBAR(); GAPA(C1 = __builtin_amdgcn_mfma_f32_32x32x16_bf16(kf[3], qr[1], C1, 0, 0, 0),   P0[14], P0[15], P1[0], P1[1],   pw1[2] = PKW(P0, 12), pw1[3] = PKW(P0, 14), pw1); \
    VRD(2); SBAR(); GAPA(C0 = __builtin_amdgcn_mfma_f32_32x32x16_bf16(kf[4], qr[2], C0, 0, 0, 0),   P1[2], P1[3], P1[4], P1[5],     pw2[0] = PKW(P1, 0), pw2[1] = PKW(P1, 2), pw2); \
    VRD(6); SBAR(); GAPA(C1 = __builtin_amdgcn_mfma_f32_32x32x16_bf16(kf[5], qr[2], C1, 0, 0, 0),   P1[6], P1[7], P1[8], P1[9],     pw2[2] = PKW(P1, 4), pw2[3] = PKW(P1, 6), pw2); \
    VRD(3); SBAR(); GAPA(C0 = __builtin_amdgcn_mfma_f32_32x32x16_bf16(kf[6], qr[3], C0, 0, 0, 0),   P1[10], P1[11], P1[12], P1[13], pw3[0] = PKW(P1, 8), pw3[1] = PKW(P1, 10), pw3); \
    VRD(7); SBAR(); GAPA(C1 = __builtin_amdgcn_mfma_f32_32x32x16_bf16(kf[7], qr[3], C1, 0, 0, 0),   P1[14], P1[15], 0.f, 0.f,       pw3[2] = PKW(P1, 12), pw3[3] = PKW(P1, 14), pw3); \
    l_reg += sacc; \
    if (GK) { DMA_K((t) + 3, sl_cur); } if (GV) { DMA_V((t) + 1, sl_next); } \
    CMASK(C0, C1, t); \
    { float a = MX3(C0[0], C0[1], C1[0]), b = MX3(C0[2], C0[3], C1[1]); a = MX3(a, C1[2], C1[3]); \
      _Pragma("unroll") for (int r = 4; r < 16; r += 4) { a = MX3(a, C0[r], C0[r + 1]); b = MX3(b, C0[r + 2], C0[r + 3]); a = MX3(a, C1[r], C1[r + 1]); b = MX3(b, C1[r + 2], C1[r + 3]); } \
      float rm = __builtin_fmaxf(a, b); { auto rr = __builtin_amdgcn_permlane32_swap(__float_as_uint(rm), __float_as_uint(rm), false, false); rm = __builtin_fmaxf(__uint_as_float(rr[0]), __uint_as_float(rr[1])); } \
      resc = false; \
      if (__builtin_expect(__any(rm > (float)THRL), 0)) { const float dl = __builtin_fmaxf(rm, 0.f); mhat += dl; \
        _Pragma("unroll") for (int r = 0; r < 16; ++r) { C0[r] -= dl; C1[r] -= dl; } \
        _Pragma("unroll") for (int r = 0; r < 16; ++r) negm[r] = -mhat; asm volatile("" : "+v"(negm)); \
        const float f = __builtin_amdgcn_exp2f(-dl); l_reg *= f; if (hi == 0) wsf[r32] = f; resc = true; } } \
    SBAR(); \
    GAPB(o[0] = __builtin_amdgcn_mfma_f32_32x32x16_bf16(PAF(0), VFR(0), o[0], 0, 0, 0), C0, 0); \
    GAPB(o[1] = __builtin_amdgcn_mfma_f32_32x32x16_bf16(PAF(0), VFR(4), o[1], 0, 0, 0), C0, 4); \
    KRD(GL, 0); GAPB(o[0] = __builtin_amdgcn_mfma_f32_32x32x16_bf16(PAF(1), VFR(1), o[0], 0, 0, 0), C0, 8); \
    KRD(GL, 1); GAPB(o[1] = __builtin_amdgcn_mfma_f32_32x32x16_bf16(PAF(1), VFR(5), o[1], 0, 0, 0), C0, 12); \
    KRD(GL, 2); GAPB(o[0] = __builtin_amdgcn_mfma_f32_32x32x16_bf16(PAF(2), VFR(2), o[0], 0, 0, 0), C1, 0); \
    KRD(GL, 3); GAPB(o[1] = __builtin_amdgcn_mfma_f32_32x32x16_bf16(PAF(2), VFR(6), o[1], 0, 0, 0), C1, 4); \
    GAPB(o[0] = __builtin_amdgcn_mfma_f32_32x32x16_bf16(PAF(3), VFR(3), o[0], 0, 0, 0), C1, 8); \
    GAPB(o[1] = __builtin_amdgcn_mfma_f32_32x32x16_bf16(PAF(3), VFR(7), o[1], 0, 0, 0), C1, 12); \
    } while (0)
  int t = 1;
  #undef CMASK
  #define CMASK(P0, P1, t) do {} while (0)
  for (; t + 5 < NT; t += 2) {
    STEP(pB0, pB1, pA0, pA1, t, true, true, true);     WAIT_BAR(2); RESC(); ROT();
    STEP(pA0, pA1, pB0, pB1, t + 1, true, true, true); WAIT_BAR(2); RESC(); ROT();
  }
  #undef CMASK
  #define CMASK(P0, P1, t) do { int jb_ = (t) - (NT - 4); if (jb_ >= 0) cmask(P0, P1, jb_, qrel, hi); } while (0)
  #define ENDW(tt) do { if ((tt) + 3 < NT) { WAIT_BAR(2); } else if ((tt) + 2 < NT) { WAIT_BAR(1); } else { WAIT_BAR(0); } } while (0)
  for (; t + 1 < NT; t += 2) {
    STEP(pB0, pB1, pA0, pA1, t, (t + 3 < NT), (t + 1 < NT), (t + 1 < NT));         ENDW(t);     RESC(); ROT();
    STEP(pA0, pA1, pB0, pB1, t + 1, (t + 4 < NT), (t + 2 < NT), (t + 2 < NT));     ENDW(t + 1); RESC(); ROT();
  }
  STEP(pB0, pB1, pA0, pA1, NT - 1, false, false, false); RESC();
  { float sacc = pB0[0] + pB0[1]; _Pragma("unroll") for (int r = 2; r < 16; ++r) sacc += pB0[r]; _Pragma("unroll") for (int r = 0; r < 16; ++r) sacc += pB1[r]; l_reg += sacc;
    pw0 = (u32x4){PKW(pB0, 0), PKW(pB0, 2), PKW(pB0, 4), PKW(pB0, 6)}; pw1 = (u32x4){PKW(pB0, 8), PKW(pB0, 10), PKW(pB0, 12), PKW(pB0, 14)}; pw2 = (u32x4){PKW(pB1, 0), PKW(pB1, 2), PKW(pB1, 4), PKW(pB1, 6)}; pw3 = (u32x4){PKW(pB1, 8), PKW(pB1, 10), PKW(pB1, 12), PKW(pB1, 14)};
    SBAR(); pv(o, vb0 + sl_cur, PAF(0), PAF(1), PAF(2), PAF(3)); }
  #undef PKW
  #undef PAF
  #undef VFR
  #undef PIN
  #undef MX3
  #undef GAPA
  #undef GAPB
  #undef EX
  #undef VRD
  #undef KRD
  #undef STEP
  #undef ENDW
  { auto rr = __builtin_amdgcn_permlane32_swap(__float_as_uint(l_reg), __float_as_uint(l_reg), false, false); l_reg = __uint_as_float(rr[0]) + __uint_as_float(rr[1]); }
  if (hi == 0) wsf[32 + r32] = l_reg; asm volatile("s_waitcnt lgkmcnt(0)" ::: "memory");
  float rli[16];
  #pragma unroll
  for (int r = 0; r < 16; ++r) rli[r] = __builtin_amdgcn_rcpf(wsf[32 + crow(r, hi)]);
  bf16* Ow = O + (rowbase + q0 + wid * QBLK) * DMA + hv * D;
  { bf16* stg = (bf16*)(shm + LDS_OST) + wid * 2048;
    #pragma unroll
    for (int r = 0; r < 16; ++r) { const int orow = crow(r, hi);
      #pragma unroll
      for (int d0 = 0; d0 < 2; ++d0) stg[orow * 64 + d0 * 32 + r32] = f2bf(o[d0][r] * rli[r]); }
    asm volatile("s_waitcnt lgkmcnt(0)" ::: "memory");
    #pragma unroll
    for (int i = 0; i < 4; ++i) { const int row = i * 8 + (lane >> 3), ch = lane & 7; const u32x4 v = *(const u32x4*)(stg + row * 64 + ch * 8); ATTN_STORE16(Ow + (long)row * DMA + ch * 8, v); } }
  asm volatile("s_waitcnt lgkmcnt(0)\n\ts_barrier" ::: "memory");
  #undef DMA_K
  #undef DMA_V
  #undef CMASK
  #undef START
  #undef RESC
  #undef ROT
}
constexpr int ATTN_LDS_BYTES = LDS_BYTES;
#undef SBAR
#undef WAIT_BAR
}

namespace attn3 {
using namespace attn_body;
constexpr int KSLOT = 8192, VSLOT = 16384;
constexpr int L_K = 0, L_V = NSLOT * KSLOT, L_WS = L_V + NSLOT * VSLOT, L_OST = L_WS + NW * 64 * 4, L_BYTES = L_OST + NW * 4096;
#define SBAR() __builtin_amdgcn_sched_barrier(0)
#define WAIT_BAR(N) asm volatile("s_waitcnt vmcnt(" #N ") lgkmcnt(0)\n\ts_barrier" ::: "memory")
template <int THRL> __device__ __forceinline__ void attn_unit(int tid_in, int b, int hq, int h, int qb, const bf16* Q, const bf16* __restrict__ K, const bf16* __restrict__ V, bf16* O, char* shm,
                                                             int mode, const bf16* SZ1, const float* g_sub, float lam, bf16* OG,
                                                             bool primed, bool has_next, int nb, int nhq, int nh, int nqb, bf16x8 (&qr)[4]) {
  int tid_ = tid_in; asm volatile("" : "+v"(tid_));
  const int tid = tid_, lane = tid & 63, r32 = lane & 31, hi = lane >> 5; const int wid = __builtin_amdgcn_readfirstlane(tid >> 6);
  const long rowbase = (long)b * SEQ; const int q0 = qb * QB;
  const bf16* Qw = Q + (rowbase + q0 + wid * QBLK) * DMA + hq * D;
  const bf16* Kh = K + rowbase * DMA + hq * D, *Vh = V + rowbase * DMA + h * 128;
  const unsigned lds0 = (unsigned)(uintptr_t)shm;
  float* wsf = (float*)(shm + L_WS) + wid * 64;
  const bf16* ksrc = Kh + (long)lane * DMA + wid * 8;
  const bf16* vsrc = Vh + (long)(16 * (wid & 3) + (lane >> 2)) * DMA + (wid >> 2) * 32 + (lane & 3) * 8;
  const unsigned kdst = lds0 + L_K + wid * 1024, vdst = lds0 + L_V + wid * 1024;
  #define DMA_K(t, si) glds16(ksrc + (long)(t) * KVBLK * DMA, (unsigned)__builtin_amdgcn_readfirstlane(kdst + (si) * KSLOT))
  #define DMA_V(t, si) do { glds16(vsrc + (long)(t) * KVBLK * DMA, (unsigned)__builtin_amdgcn_readfirstlane(vdst + (si) * VSLOT)); \
                            glds16(vsrc + (long)(t) * KVBLK * DMA + 64, (unsigned)__builtin_amdgcn_readfirstlane(vdst + (si) * VSLOT + 8192)); } while (0)
  const int vb0 = (int)(lds0 + L_V) + ((lane >> 4) & 1) * 32 + (lane & 3) * 8 + (4 * hi + ((lane & 15) >> 2)) * 64;
  const char* Kbase = shm + L_K; bf16x8 kf[8];
  const lds_cptr shm3 = (lds_cptr)shm; const lds_cptr kp0 = shm3 + L_K + hi * 1024 + r32 * 16; const lds_cptr vp0 = shm3 + L_V + ((lane >> 4) & 1) * 32 + (lane & 3) * 8 + (4 * hi + ((lane & 15) >> 2)) * 64;
  const int NT = (q0 + QB) / KVBLK;
  if (!primed) { DMA_K(0, 0); DMA_V(0, 0); DMA_K(1, 1);
    #pragma unroll
    for (int d0 = 0; d0 < 4; ++d0) qr[d0] = *reinterpret_cast<const bf16x8*>(&Qw[(long)r32 * DMA + d0 * 16 + hi * 8]); }
  float mhat = 0.f, l_reg = 0.f; f32x16 o[4]; f32x16 negm;
  { float zf = 0.f; asm volatile("" : "+v"(zf));
    _Pragma("unroll") for (int r = 0; r < 16; ++r) { o[0][r] = zf; o[1][r] = zf; o[2][r] = zf; o[3][r] = zf; negm[r] = zf; } }
  asm volatile("" : "+v"(negm));
  const int qrel = wid * QBLK + r32;
  #define CMASK(P0, P1, t) do { int jb_ = (t) - (NT - 4); if (jb_ >= 0) cmask(P0, P1, jb_, qrel, hi); } while (0)
  bool resc = false;
  #define RESC() do { if (resc) { asm volatile("s_waitcnt lgkmcnt(0)" ::: "memory"); \
      _Pragma("unroll") for (int d_ = 0; d_ < 4; ++d_) _Pragma("unroll") for (int r = 0; r < 16; ++r) o[d_][r] *= wsf[crow(r, hi)]; } } while (0)
  f32x16 C0, C1;
  int s_prev = 0, s_cur = 0, s_next = 1;
  #define ROT() do { s_prev = s_cur; s_cur = s_next; s_next = (s_next == NSLOT - 1) ? 0 : s_next + 1; } while (0)
  if (!primed) { DMA_K(2, 2); WAIT_BAR(4); }
  else { WAIT_BAR(0); }
  u32x4 pwA0, pwA1, pwA2, pwA3, pwB0, pwB1, pwB2, pwB3;
  #define PKW(P, B) cvtpk_s(P[B], P[B + 1])
  qkt(C0, C1, Kbase, qr, negm, r32, hi); asm volatile("s_nop 15\n\ts_nop 7" : "+v"(C0), "+v"(C1)); CMASK(C0, C1, 0);
  { const float rm = rowmax(C0, C1); mhat = fadd_s(mhat, rm);
    _Pragma("unroll") for (int r = 0; r < 16; ++r) { C0[r] = fsub_s(C0[r], rm); C1[r] = fsub_s(C1[r], rm); }
    _Pragma("unroll") for (int r = 0; r < 16; ++r) negm[r] = -mhat; asm volatile("" : "+v"(negm));
    float sacc = 0.f;
    _Pragma("unroll") for (int r = 0; r < 16; ++r) { C0[r] = __builtin_amdgcn_exp2f(C0[r]); C1[r] = __builtin_amdgcn_exp2f(C1[r]); }
    _Pragma("unroll") for (int r = 0; r < 16; ++r) sacc += C0[r] + C1[r];
    l_reg = sacc;
    pwA0 = (u32x4){PKW(C0, 0), PKW(C0, 2), PKW(C0, 4), PKW(C0, 6)}; pwA1 = (u32x4){PKW(C0, 8), PKW(C0, 10), PKW(C0, 12), PKW(C0, 14)};
    pwA2 = (u32x4){PKW(C1, 0), PKW(C1, 2), PKW(C1, 4), PKW(C1, 6)}; pwA3 = (u32x4){PKW(C1, 8), PKW(C1, 10), PKW(C1, 12), PKW(C1, 14)}; }
  WAIT_BAR(0);
  DMA_K(3, 0); DMA_V(1, 1);
  ROT();
  kload8(kf, kp0 + s_cur * KSLOT);
  WAIT_BAR(3);
  s16x4 vlo[8], vhi[8];
  #define PAF(w) __builtin_bit_cast(bf16x8, w)
  #define VFR(i) (bf16x8){vlo[i][0], vlo[i][1], vlo[i][2], vlo[i][3], vhi[i][0], vhi[i][1], vhi[i][2], vhi[i][3]}
  #define PIN(x) asm volatile("" : "+v"(x))
  #define MX3(a, b, c) __builtin_fmaxf(__builtin_fmaxf((a), (b)), (c))
  #define EX(v) __builtin_amdgcn_exp2f(v)
  #define VRD(s, f) do { vlo[s] = vtr(vp_ + (((f) >> 2) * 4096 + ((f) & 3) * 1024)); vhi[s] = vtr(vp_ + (((f) >> 2) * 4096 + ((f) & 3) * 1024 + 512)); } while (0)
  #define KRD(G, j) do { if (G) { kload2(kf, kp0 + s_next * KSLOT, j); SBAR(); } } while (0)
  #define GAPB(MF, X, B, PWW) do { MF; X[B] = EX(X[B]); X[B + 1] = EX(X[B + 1]); sacc += X[B]; sacc += X[B + 1]; PIN(sacc); PWW = PKW(X, B); PIN(PWW); SBAR(); } while (0)
  #define MFQ(a, b, c) __builtin_amdgcn_mfma_f32_32x32x16_bf16(a, b, c, 0, 0, 0)
#if ATTN_LAZY
  #define STEP_MAX() do {} while (0)
  #define STEP_END() do { RESC(); resc = false; \
      if (__builtin_expect(__any(sacc > (float)(1 << THRL)), 0)) { float s2; \
        { auto rr = __builtin_amdgcn_permlane32_swap(__float_as_uint(sacc), __float_as_uint(sacc), false, false); s2 = __uint_as_float(rr[0]) + __uint_as_float(rr[1]); } \
        const float dl = __builtin_fmaxf(__builtin_floorf(__builtin_amdgcn_logf(s2)), 0.f); mhat += dl; \
        _Pragma("unroll") for (int r = 0; r < 16; ++r) negm[r] = -mhat; asm volatile("" : "+v"(negm)); \
        const float f = __builtin_amdgcn_exp2f(-dl); l_reg *= f; if (hi == 0) wsf[r32] = f; resc = true; } } while (0)
  #define RESC_OUT() do {} while (0)
#else
  #define STEP_MAX() do { float a = MX3(C0[0], C0[1], C1[0]), b = MX3(C0[2], C0[3], C1[1]); a = MX3(a, C1[2], C1[3]); \
      _Pragma("unroll") for (int r = 4; r < 16; r += 4) { a = MX3(a, C0[r], C0[r + 1]); b = MX3(b, C0[r + 2], C0[r + 3]); a = MX3(a, C1[r], C1[r + 1]); b = MX3(b, C1[r + 2], C1[r + 3]); } \
      float rm = __builtin_fmaxf(a, b); { auto rr = __builtin_amdgcn_permlane32_swap(__float_as_uint(rm), __float_as_uint(rm), false, false); rm = __builtin_fmaxf(__uint_as_float(rr[0]), __uint_as_float(rr[1])); } \
      resc = false; \
      if (__builtin_expect(__any(rm > (float)THRL), 0)) { const float dl = __builtin_fmaxf(rm, 0.f); mhat += dl; \
        _Pragma("unroll") for (int r = 0; r < 16; ++r) { C0[r] -= dl; C1[r] -= dl; } \
        _Pragma("unroll") for (int r = 0; r < 16; ++r) negm[r] = -mhat; asm volatile("" : "+v"(negm)); \
        const float f = __builtin_amdgcn_exp2f(-dl); l_reg *= f; if (hi == 0) wsf[r32] = f; resc = true; } } while (0)
  #define STEP_END() do {} while (0)
  #define RESC_OUT() RESC()
#endif
  #define STEP(PP0, PP1, PP2, PP3, PN0, PN1, PN2, PN3, t, GK, GV, GL) do { SBAR(); \
    const lds_cptr vp_ = vp0 + s_prev * VSLOT; \
    VRD(0, 0); SBAR(); C0 = MFQ(kf[0], qr[0], negm); SBAR(); \
    VRD(4, 4); SBAR(); C1 = MFQ(kf[1], qr[0], negm); SBAR(); \
    VRD(1, 1); SBAR(); C0 = MFQ(kf[2], qr[1], C0); SBAR(); \
    VRD(5, 5); SBAR(); C1 = MFQ(kf[3], qr[1], C1); SBAR(); \
    VRD(2, 2); SBAR(); C0 = MFQ(kf[4], qr[2], C0); SBAR(); \
    VRD(6, 6); SBAR(); C1 = MFQ(kf[5], qr[2], C1); SBAR(); \
    VRD(3, 3); SBAR(); C0 = MFQ(kf[6], qr[3], C0); SBAR(); \
    VRD(7, 7); SBAR(); C1 = MFQ(kf[7], qr[3], C1); SBAR(); \
    if (GK) { DMA_K((t) + 3, s_cur); } if (GV) { DMA_V((t) + 1, s_next); } \
    CMASK(C0, C1, t); \
    STEP_MAX(); \
    SBAR(); float sacc = 0.f; \
    GAPB(o[0] = MFQ(PAF(PP0), VFR(0), o[0]), C0, 0,  PN0[0]); VRD(0, 8);  SBAR(); \
    GAPB(o[1] = MFQ(PAF(PP0), VFR(4), o[1]), C0, 2,  PN0[1]); VRD(4, 12); SBAR(); \
    GAPB(o[0] = MFQ(PAF(PP1), VFR(1), o[0]), C0, 4,  PN0[2]); VRD(1, 9);  SBAR(); \
    GAPB(o[1] = MFQ(PAF(PP1), VFR(5), o[1]), C0, 6,  PN0[3]); VRD(5, 13); SBAR(); \
    GAPB(o[0] = MFQ(PAF(PP2), VFR(2), o[0]), C0, 8,  PN1[0]); VRD(2, 10); SBAR(); \
    GAPB(o[1] = MFQ(PAF(PP2), VFR(6), o[1]), C0, 10, PN1[1]); VRD(6, 14); SBAR(); \
    GAPB(o[0] = MFQ(PAF(PP3), VFR(3), o[0]), C0, 12, PN1[2]); VRD(3, 11); SBAR(); \
    GAPB(o[1] = MFQ(PAF(PP3), VFR(7), o[1]), C0, 14, PN1[3]); VRD(7, 15); SBAR(); \
    GAPB(o[2] = MFQ(PAF(PP0), VFR(0), o[2]), C1, 0,  PN2[0]); \
    GAPB(o[3] = MFQ(PAF(PP0), VFR(4), o[3]), C1, 2,  PN2[1]); \
    KRD(GL, 0); GAPB(o[2] = MFQ(PAF(PP1), VFR(1), o[2]), C1, 4,  PN2[2]); \
    KRD(GL, 1); GAPB(o[3] = MFQ(PAF(PP1), VFR(5), o[3]), C1, 6,  PN2[3]); \
    KRD(GL, 2); GAPB(o[2] = MFQ(PAF(PP2), VFR(2), o[2]), C1, 8,  PN3[0]); \
    KRD(GL, 3); GAPB(o[3] = MFQ(PAF(PP2), VFR(6), o[3]), C1, 10, PN3[1]); \
    GAPB(o[2] = MFQ(PAF(PP3), VFR(3), o[2]), C1, 12, PN3[2]); \
    GAPB(o[3] = MFQ(PAF(PP3), VFR(7), o[3]), C1, 14, PN3[3]); \
    l_reg += sacc; \
    STEP_END(); \
    } while (0)
  #define STEP_AB(t, GK, GV, GL) STEP(pwA0, pwA1, pwA2, pwA3, pwB0, pwB1, pwB2, pwB3, t, GK, GV, GL)
  #define STEP_BA(t, GK, GV, GL) STEP(pwB0, pwB1, pwB2, pwB3, pwA0, pwA1, pwA2, pwA3, t, GK, GV, GL)
  int t = 1;
  #undef CMASK
  #define CMASK(P0, P1, t) do {} while (0)
  for (; t + 5 < NT; t += 2) {
    STEP_AB(t, true, true, true);     WAIT_BAR(3); RESC_OUT(); ROT();
    STEP_BA(t + 1, true, true, true); WAIT_BAR(3); RESC_OUT(); ROT();
  }
  #undef CMASK
  #define CMASK(P0, P1, t) do { int jb_ = (t) - (NT - 4); if (jb_ >= 0) cmask(P0, P1, jb_, qrel, hi); } while (0)
  #define ENDW(tt) do { if ((tt) + 3 < NT) { WAIT_BAR(3); } else if ((tt) + 2 < NT) { WAIT_BAR(2); } else { WAIT_BAR(0); } } while (0)
  for (; t + 1 < NT; t += 2) {
    STEP_AB(t, (t + 3 < NT), (t + 1 < NT), (t + 1 < NT));         ENDW(t);     RESC_OUT(); ROT();
    STEP_BA(t + 1, (t + 4 < NT), (t + 2 < NT), (t + 2 < NT));     ENDW(t + 1); RESC_OUT(); ROT();
  }
  STEP_AB(NT - 1, false, false, false); RESC_OUT();
  { SBAR();
    const int vb = vb0 + s_cur * VSLOT;
    #pragma unroll
    for (int d0 = 0; d0 < 4; ++d0) { s16x4 lo[4], hh[4];
      #pragma unroll
      for (int ks = 0; ks < 4; ++ks) {
        asm volatile("ds_read_b64_tr_b16 %0,%1 offset:%c2" : "=&v"(lo[ks]) : "v"(vb), "i"(d0 * 4096 + ks * 1024) : "memory");
        asm volatile("ds_read_b64_tr_b16 %0,%1 offset:%c2" : "=&v"(hh[ks]) : "v"(vb), "i"(d0 * 4096 + ks * 1024 + 512) : "memory"); }
      asm volatile("s_waitcnt lgkmcnt(0)" ::: "memory"); SBAR();
      #define PK(k) (bf16x8){lo[k][0], lo[k][1], lo[k][2], lo[k][3], hh[k][0], hh[k][1], hh[k][2], hh[k][3]}
      o[d0] = MFQ(PAF(pwB0), PK(0), o[d0]); o[d0] = MFQ(PAF(pwB1), PK(1), o[d0]); o[d0] = MFQ(PAF(pwB2), PK(2), o[d0]); o[d0] = MFQ(PAF(pwB3), PK(3), o[d0]);
      #undef PK
    } }
#if ATTN_LAZY
  RESC();
#endif
  asm volatile("s_waitcnt lgkmcnt(0)\n\ts_barrier" ::: "memory");
  if (has_next) {
    const long nrow = (long)nb * SEQ; const int nq0 = nqb * QB;
    const bf16* nQw = Q + (nrow + nq0 + wid * QBLK) * DMA + nhq * D;
    const bf16* nks = K + nrow * DMA + nhq * D + (long)lane * DMA + wid * 8;
    const bf16* nvs = V + nrow * DMA + nh * 128 + (long)(16 * (wid & 3) + (lane >> 2)) * DMA + (wid >> 2) * 32 + (lane & 3) * 8;
    glds16(nks, (unsigned)__builtin_amdgcn_readfirstlane(kdst));
    glds16(nvs, (unsigned)__builtin_amdgcn_readfirstlane(vdst)); glds16(nvs + 64, (unsigned)__builtin_amdgcn_readfirstlane(vdst + 8192));
    glds16(nks + (long)KVBLK * DMA, (unsigned)__builtin_amdgcn_readfirstlane(kdst + KSLOT));
    glds16(nks + (long)2 * KVBLK * DMA, (unsigned)__builtin_amdgcn_readfirstlane(kdst + 2 * KSLOT));
    #pragma unroll
    for (int d0 = 0; d0 < 4; ++d0) qr[d0] = *reinterpret_cast<const bf16x8*>(&nQw[(long)r32 * DMA + d0 * 16 + hi * 8]);
  }
  { auto rr = __builtin_amdgcn_permlane32_swap(__float_as_uint(l_reg), __float_as_uint(l_reg), false, false); l_reg = __uint_as_float(rr[0]) + __uint_as_float(rr[1]); }
  if (hi == 0) wsf[32 + r32] = l_reg; asm volatile("s_waitcnt lgkmcnt(0)" ::: "memory");
  float rli[16];
  #pragma unroll
  for (int r = 0; r < 16; ++r) rli[r] = __builtin_amdgcn_rcpf(wsf[32 + crow(r, hi)]);
  int lane_e = lane; asm volatile("" : "+v"(lane_e));
  const int erow = lane_e >> 3, ech = lane_e & 7;
  bf16* Ow = O + (rowbase + q0 + wid * QBLK) * DMA + h * 128;
  bf16* stg = (bf16*)(shm + L_OST) + wid * 2048;
  if (mode == 0) {
    #pragma unroll
    for (int ps = 0; ps < 2; ++ps) {
      #pragma unroll
      for (int r = 0; r < 16; ++r) { const int orow = crow(r, hi);
        #pragma unroll
        for (int d0 = 0; d0 < 2; ++d0) stg[orow * 64 + d0 * 32 + r32] = f2bf(o[2 * ps + d0][r] * rli[r]); }
      asm volatile("s_waitcnt lgkmcnt(0)" ::: "memory");
      #pragma unroll
      for (int i = 0; i < 4; ++i) { const int row = i * 8 + erow, ch = ech; const u32x4 v = *(const u32x4*)(stg + row * 64 + ch * 8); *(u32x4*)(Ow + (long)row * DMA + ps * 64 + ch * 8) = v; }
      asm volatile("s_waitcnt lgkmcnt(0)" ::: "memory");
    }
    asm volatile("s_waitcnt vmcnt(0)" ::: "memory");
  } else {
    const bf16* Zw = SZ1 + (rowbase + q0 + wid * QBLK) * DMA + h * 128; bf16* Gw = OG + (rowbase + q0 + wid * QBLK) * DMA + h * 128;
    float dk[2][4][8]; float ss[4] = {0.f, 0.f, 0.f, 0.f};
    #pragma unroll
    for (int ps = 0; ps < 2; ++ps) {
      #pragma unroll
      for (int r = 0; r < 16; ++r) { const int orow = crow(r, hi);
        #pragma unroll
        for (int d0 = 0; d0 < 2; ++d0) stg[orow * 64 + d0 * 32 + r32] = f2bf(o[2 * ps + d0][r] * rli[r]); }
      asm volatile("s_waitcnt lgkmcnt(0)" ::: "memory");
      #pragma unroll
      for (int i = 0; i < 4; ++i) { const int row = i * 8 + erow, ch = ech;
        const u32x4 v1 = *(const u32x4*)(stg + row * 64 + ch * 8); const u32x4 v0 = *(const u32x4*)(Ow + (long)row * DMA + ps * 64 + ch * 8);
        #pragma unroll
        for (int j = 0; j < 4; ++j) { const float a0 = __uint_as_float(v0[j] << 16), a1 = __uint_as_float(v0[j] & 0xffff0000u), b0 = __uint_as_float(v1[j] << 16), b1 = __uint_as_float(v1[j] & 0xffff0000u);
          const float d0_ = a0 - lam * b0, d1_ = a1 - lam * b1; dk[ps][i][2 * j] = d0_; dk[ps][i][2 * j + 1] = d1_; ss[i] += d0_ * d0_ + d1_ * d1_; } }
      asm volatile("s_waitcnt lgkmcnt(0)" ::: "memory");
    }
    #pragma unroll
    for (int i = 0; i < 4; ++i) { float t_ = ss[i];
      t_ += __int_as_float(__builtin_amdgcn_ds_swizzle(__float_as_int(t_), 0x1f | (1 << 10))); t_ += __int_as_float(__builtin_amdgcn_ds_swizzle(__float_as_int(t_), 0x1f | (2 << 10)));
      t_ += __int_as_float(__builtin_amdgcn_ds_swizzle(__float_as_int(t_), 0x1f | (4 << 10))); ss[i] = rsqrtf(t_ * (1.0f / 128.0f) + RMS_EPS) * ONE_M_LI; }
    #pragma unroll
    for (int ps = 0; ps < 2; ++ps) {
      const int ch = ech; const float* gp = g_sub + ps * 64 + ch * 8; const f32x4_t g0 = *(const f32x4_t*)gp, g1 = *(const f32x4_t*)(gp + 4);
      #pragma unroll
      for (int i = 0; i < 4; ++i) { const int row = i * 8 + erow;
        const u32x4 z = NT_LD((const u32x4*)(Zw + (long)row * DMA + ps * 64 + ch * 8)); u32x4 w;
        #pragma unroll
        for (int j = 0; j < 4; ++j) { const float z0 = __uint_as_float(z[j] << 16), z1 = __uint_as_float(z[j] & 0xffff0000u);
          const float ga = (j < 2) ? g0[2 * j] : g1[2 * j - 4], gb = (j < 2) ? g0[2 * j + 1] : g1[2 * j - 3];
          w[j] = cvtpk_s(dk[ps][i][2 * j] * ss[i] * ga * z0, dk[ps][i][2 * j + 1] * ss[i] * gb * z1); }
        *(u32x4*)(Gw + (long)row * DMA + ps * 64 + ch * 8) = w; }
    }
  }
  asm volatile("s_waitcnt lgkmcnt(0)" ::: "memory");
  #undef DMA_K
  #undef DMA_V
  #undef CMASK
  #undef RESC
  #undef ROT
  #undef PKW
  #undef PAF
  #undef VFR
  #undef PIN
  #undef MX3
  #undef EX
  #undef VRD
  #undef KRD
  #undef GAPB
  #undef MFQ
  #undef STEP
  #undef STEP_AB
  #undef STEP_BA
  #undef ENDW
  #undef STEP_MAX
  #undef STEP_END
  #undef RESC_OUT
}
#undef SBAR
#undef WAIT_BAR
}

constexpr int NWAVES = 8;
constexpr size_t MiB = 1u << 20;
constexpr size_t WS_CTL = 0, CTL_ZERO_BYTES = 1 * MiB;
constexpr size_t WS_MOD = 256 * 1024;
constexpr size_t WS_LAM = 1 * MiB;
constexpr size_t WS_HN = 1 * MiB + 128 * 1024;
constexpr size_t WS_LB16 = 1 * MiB + 4096;
constexpr size_t WS_WIN0 = 2 * MiB, WS_WGLU = 6 * MiB, WS_WOUT0 = 8 * MiB, WS_WKV = 10 * MiB, WS_WIN1 = 14 * MiB, WS_WOUT1 = 18 * MiB;
constexpr size_t WS_BTA = 20 * MiB;
constexpr size_t WS_BTB = 28 * MiB;
constexpr size_t WS_S0 = 48 * MiB, WS_S1 = 112 * MiB, WS_S2 = 176 * MiB, WS_S3 = 240 * MiB, WS_S4 = 304 * MiB, WS_S5 = 368 * MiB, WS_S6 = 432 * MiB, WS_END = 496 * MiB;
constexpr int CW_BAR = 4096;
constexpr int CW_TMO = 8, CW_SEAM = 16384, SEAM_BANK = 128 * 64;
constexpr size_t WS_XCH = 40 * MiB;
constexpr int RING_OFF = 0, RING_BYTES = 131072;
constexpr int LDSCTL_OFF = RING_BYTES, MISC_OFF = LDSCTL_OFF + 320;
constexpr int LDS_BYTES = 147456;

#define GAS __attribute__((address_space(1)))
#define LAS __attribute__((address_space(3)))
typedef unsigned v4u __attribute__((ext_vector_type(4)));
typedef GAS unsigned gu32;
#define RLX_AGENT __ATOMIC_RELAXED, __HIP_MEMORY_SCOPE_AGENT
#define LDS_WAIT() asm volatile("s_waitcnt lgkmcnt(0)" ::: "memory")
#define VM_WAIT() asm volatile("s_waitcnt vmcnt(0)" ::: "memory")

#define XB_TMO      128
#define XB_XCNT(j)  (256  + 64 * (j))
#define XB_XSUB(j)  (1280 + 64 * (j))
#define XB_XGEN(j)  (2304 + 64 * (j))
#define XB_TOP      3328
#define XB_TOPGEN   3392
#define XCD_BAR_WORDS 3456
#define XB_SPIN_CAP (1u << 18)
__device__ __forceinline__ unsigned xb_ld(unsigned* p)              { return __hip_atomic_load(p, __ATOMIC_RELAXED, __HIP_MEMORY_SCOPE_AGENT); }
__device__ __forceinline__ unsigned xb_add(unsigned* p, unsigned v) { return __hip_atomic_fetch_add(p, v, __ATOMIC_RELAXED, __HIP_MEMORY_SCOPE_AGENT); }
__device__ __forceinline__ unsigned xb_xcc_id() { return (unsigned)__builtin_amdgcn_s_getreg((3 << 11) | 20) & 0xFu; }
#define XB_SPIN(cond, bar) do { unsigned _sp = 0; while (cond) { __builtin_amdgcn_s_sleep(1); \
    if ((++_sp & 255u) == 0u) { if (xb_ld(&(bar)[XB_TMO])) break; if (_sp > XB_SPIN_CAP) { atomicAdd(&(bar)[XB_TMO], 1u); break; } } } } while (0)
struct XcdBarrier { unsigned* bar; unsigned x; volatile LAS unsigned* st; };
__device__ __forceinline__ XcdBarrier xcd_barrier_post(unsigned* bar, volatile LAS unsigned* st, int tid) {
    XcdBarrier b; b.bar = bar; b.x = xb_xcc_id(); b.st = st;
    if (tid == 0) st[4] = xb_add(&bar[XB_XCNT(b.x)], 1u);
    return b;
}
__device__ __forceinline__ void xcc_barrier(unsigned* lb, unsigned x, unsigned nloc, int tid) {
    asm volatile("s_waitcnt vmcnt(0)" ::: "memory");
    __syncthreads();
    if (tid == 0) {
        __builtin_amdgcn_s_waitcnt(0);
        const unsigned old = xb_add(&lb[XB_XSUB(x)], 1u); const unsigned gen = old / nloc;
        if (old + 1u == (gen + 1u) * nloc) xb_add(&lb[XB_XGEN(x)], 1u);
        else XB_SPIN(xb_ld(&lb[XB_XGEN(x)]) == gen, lb);
        __builtin_amdgcn_fence(__ATOMIC_ACQUIRE, "agent");
        asm volatile("s_waitcnt vmcnt(0)" ::: "memory");
    }
    __syncthreads();
}
__device__ __forceinline__ void xcd_barrier_complete(unsigned* bar, unsigned x, unsigned& nloc, unsigned& nx) {
    const unsigned G = gridDim.x * gridDim.y * gridDim.z;
    unsigned sum, cnt, mine, sp = 0u;
    for (;;) {
        sum = 0u; cnt = 0u; mine = 0u;
#pragma unroll
        for (unsigned j = 0; j < 16; ++j) { const unsigned c = xb_ld(&bar[XB_XCNT(j)]); sum += c; cnt += (c > 0u) ? 1u : 0u; mine = (j == x) ? c : mine; }
        if (sum == G) break;
        __builtin_amdgcn_s_sleep(1);
        if ((++sp & 255u) == 0u) { if (xb_ld(&bar[XB_TMO])) break; if (sp > XB_SPIN_CAP) { atomicAdd(&bar[XB_TMO], 1u); break; } }
    }
    nloc = mine > 0u ? mine : 1u; nx = cnt > 0u ? cnt : 1u;
}
__device__ __forceinline__ void xcd_barrier(const XcdBarrier& b, int tid) {
    asm volatile("s_waitcnt vmcnt(0)" ::: "memory");
    __syncthreads();
    if (tid == 0) {
        unsigned* bar = b.bar;
        __builtin_amdgcn_s_waitcnt(0);
        unsigned nloc = b.st[0], nx = b.st[1];
        if (nloc == 0u) { xcd_barrier_complete(bar, b.x, nloc, nx); b.st[0] = nloc; b.st[1] = nx; }
        const unsigned old = xb_add(&bar[XB_XSUB(b.x)], 1u);
        const unsigned gen = old / nloc;
        if (old + 1u == (gen + 1u) * nloc) {
            __builtin_amdgcn_fence(__ATOMIC_RELEASE, "agent");
            asm volatile("s_waitcnt vmcnt(0)" ::: "memory");
            const unsigned og = xb_add(&bar[XB_TOP], 1u);
            const unsigned tg = og / nx;
            if (og + 1u == (tg + 1u) * nx) xb_add(&bar[XB_TOPGEN], 1u);
            else XB_SPIN(xb_ld(&bar[XB_TOPGEN]) == tg, bar);
            __builtin_amdgcn_fence(__ATOMIC_ACQUIRE, "agent");
            xb_add(&bar[XB_XGEN(b.x)], 1u);
            asm volatile("s_waitcnt vmcnt(0)" ::: "memory");
        } else {
            XB_SPIN(xb_ld(&bar[XB_XGEN(b.x)]) == gen, bar);
            __builtin_amdgcn_fence(__ATOMIC_ACQUIRE, "agent");
            asm volatile("s_waitcnt vmcnt(0)" ::: "memory");
        }
    }
    __syncthreads();
}

__device__ __forceinline__ void p0_transpose_item(const float* W, int K, int N, bf16_t* WT, int row_off, const float* kscale, LAS float* scr, int item, int lane) {
    const int nblk = N / 32, kb = item / nblk, nb = item % nblk, k0 = 64 * kb, n0 = 32 * nb;
    float tv[32];
#pragma unroll
    for (int i = 0; i < 32; ++i) tv[i] = NT_LD(W + (size_t)(k0 + 2 * i + (lane >> 5)) * N + n0 + (lane & 31));
#pragma unroll
    for (int i = 0; i < 32; ++i) { const int kk = 2 * i + (lane >> 5); float v = tv[i]; if (kscale) v *= kscale[k0 + kk]; scr[kk * 33 + (lane & 31)] = v; }
    LDS_WAIT(); asm volatile("" ::: "memory");
    const int c = lane & 7;
#pragma unroll
    for (int j = 0; j < 4; ++j) { const int n = (lane >> 3) + 8 * j; const LAS float* s = scr + (8 * c) * 33 + n;
        v4u o; o.x = pk2bf(s[0 * 33], s[1 * 33]); o.y = pk2bf(s[2 * 33], s[3 * 33]); o.z = pk2bf(s[4 * 33], s[5 * 33]); o.w = pk2bf(s[6 * 33], s[7 * 33]);
        *(GAS v4u*)(WT + (size_t)(row_off + n0 + n) * K + k0 + 8 * c) = o; }
    LDS_WAIT(); asm volatile("" ::: "memory");
}

__device__ __forceinline__ int lane_now_asm() { int r; asm volatile("v_mbcnt_lo_u32_b32 %0, -1, 0\n\tv_mbcnt_hi_u32_b32 %0, -1, %0" : "=v"(r)); return r; }
struct Args {
    const float* in[28]; float* out; unsigned char* ws;
    int ph_lo, ph_hi, use_bar, flags;
};

__global__ void __launch_bounds__(NWAVES * 64, 2) mega_fwd(Args args) {
    extern __shared__ __attribute__((aligned(16))) unsigned char lds_raw[];
    LAS unsigned char* lds = (LAS unsigned char*)lds_raw;
    volatile LAS unsigned* MISC = (volatile LAS unsigned*)(lds + MISC_OFF);
    const int wave = __builtin_amdgcn_readfirstlane((int)threadIdx.x >> 6);
#define LANE_NOW() lane_now_asm()
#define TID_NOW() (wave * 64 + LANE_NOW())
    const int G = gridDim.x;
    unsigned char* ws = args.ws;
    gu32* ctl = (gu32*)(ws + WS_CTL);
    const float* x = args.in[0]; const float* cvec = args.in[1]; const float* ada_w = args.in[2]; const float* ada_b = args.in[3];
    const float* g_pre = args.in[4]; const float* g_post = args.in[5];
    float* out = args.out;
    float* mod = (float*)(ws + WS_MOD); float* lamp = (float*)(ws + WS_LAM); float* lb16 = (float*)(ws + WS_LB16);
    bf16_t* Win0 = (bf16_t*)(ws + WS_WIN0); bf16_t* Wglu = (bf16_t*)(ws + WS_WGLU); bf16_t* Wout0 = (bf16_t*)(ws + WS_WOUT0); bf16_t* Wkv = (bf16_t*)(ws + WS_WKV);
    bf16_t* Win1 = (bf16_t*)(ws + WS_WIN1); bf16_t* Wout1 = (bf16_t*)(ws + WS_WOUT1); bf16_t* BtA = (bf16_t*)(ws + WS_BTA); bf16_t* BtB = (bf16_t*)(ws + WS_BTB);
    bf16_t* A0 = (bf16_t*)(ws + WS_S0); bf16_t* US = (bf16_t*)(ws + WS_S1); bf16_t* SZ = (bf16_t*)(ws + WS_S3); bf16_t* YG = (bf16_t*)(ws + WS_S4); float* EB = (float*)(ws + WS_S0);
    bf16_t* Y2 = (bf16_t*)(ws + WS_S0); bf16_t* YO = (bf16_t*)(ws + WS_S1); bf16_t* AKV = (bf16_t*)(ws + WS_S0); bf16_t* AIN1 = (bf16_t*)(ws + WS_S2);
    bf16_t* KB = (bf16_t*)(ws + WS_S3); bf16_t* VB = (bf16_t*)(ws + WS_S4); bf16_t* QB = (bf16_t*)(ws + WS_S5); bf16_t* SZ1 = (bf16_t*)(ws + WS_S6);
    bf16_t* O0 = (bf16_t*)(ws + (H1_AKV ? WS_S1 : WS_S0)); bf16_t* O1 = (bf16_t*)(ws + WS_S1); bf16_t* OG = (bf16_t*)(ws + WS_S2); bf16_t* YO1 = (bf16_t*)(ws + (H1_AKV ? WS_S3 : WS_S0));
    float* HN = (float*)(ws + WS_HN);

    for (int u = TID_NOW(); u < (LDS_BYTES - LDSCTL_OFF) / 4; u += NWAVES * 64) ((LAS unsigned*)(lds + LDSCTL_OFF))[u] = 0u;
    __syncthreads();
    XcdBarrier bar; bar.bar = (unsigned*)(ctl + CW_BAR); bar.x = 0; bar.st = nullptr;
    bool xcl = false; int bx = blockIdx.x; unsigned px = 0;
    if (args.use_bar) {
        bar = xcd_barrier_post((unsigned*)(ctl + CW_BAR), MISC + 8, TID_NOW());
        if (XCC_LOCAL && G == 256) {
            if (TID_NOW() == 0) { unsigned nloc_, nx_; xcd_barrier_complete(bar.bar, bar.x, nloc_, nx_); bool uni = (nx_ == 8u);
                for (unsigned j = 0; j < 8; ++j) uni = uni && (xb_ld(&bar.bar[XB_XCNT(j)]) == 32u);
                MISC[8] = nloc_; MISC[9] = nx_; MISC[13] = uni ? 1u : 0u; }
            __syncthreads();
            xcl = (__builtin_amdgcn_readfirstlane((int)MISC[13]) != 0); px = bar.x;
            if (xcl) bx = __builtin_amdgcn_readfirstlane((int)MISC[12]) * 8 + (int)px;
        }
    }
    const int vcu = (G % 8 == 0) ? (bx % 8) * (G / 8) + bx / 8 : bx;
    const int rankx = bx >> 3;
    unsigned* lbar = (unsigned*)(ctl + CW_BAR) + XCD_BAR_WORDS;
    const int lo = args.ph_lo, hi = args.ph_hi;
#define IN(k) (lo <= (k) && (k) < hi)
#define REPS(k) (1 + ((REPEAT_MASK >> (k)) & 1))
#define SEAM(k) do { if (IN(k) && IN((k) + 1) && args.use_bar) { if ((k) == 0 || !xcl) xcd_barrier(bar, TID_NOW()); else xcc_barrier(lbar, px, 32u, TID_NOW()); } } while (0)
    const int gw = vcu * NWAVES + wave, NGW = G * NWAVES;
    const int egw = xcl ? rankx * NWAVES + wave : gw, engw = xcl ? 32 * NWAVES : NGW, eb_lo = xcl ? (int)px : 0, eb_hi = xcl ? (int)px + 1 : NB;
#define LANE_L() ({ int l_ = LANE_NOW(); asm volatile("" : "+v"(l_)); l_; })

    if (IN(0)) for (int rep_ = 0; rep_ < REPS(0); ++rep_) {
        const int tid = TID_NOW(), lane = tid & 63;
        for (int it = vcu; it < NGRP * 4; it += G) {
            const int g = it >> 2, qt = it & 3;
            LAS float* LBP = (LAS float*)(lds + RING_OFF);
            LAS float* BBR = LBP + 17 * 128;
            LAS float* CC = BBR + 64 * 32;
            LAS float* KM = CC + 16 * 130 + 12;
            __syncthreads();
            if (tid < 64) {
                const int p = tid;
                const float dt = expf(args.in[9][g]);
                const float lr = args.in[7][g * 64 + p], li = args.in[8][g * 64 + p];
                const float mag = expf(lr * dt); const float sn = sinf(li * dt), cs = cosf(li * dt);
                const float lbr = mag * cs, lbi = mag * sn;
                float pr = 1.f, pi = 0.f;
                for (int d = 0; d <= 16; ++d) { LBP[(d * 64 + p) * 2] = pr; LBP[(d * 64 + p) * 2 + 1] = pi; const float nr = pr * lbr - pi * lbi, ni = pr * lbi + pi * lbr; pr = nr; pi = ni; }
                if (qt == 0) { lb16[(g * 64 + p) * 2] = LBP[(16 * 64 + p) * 2]; lb16[(g * 64 + p) * 2 + 1] = LBP[(16 * 64 + p) * 2 + 1]; }
                const float nr = lbr - 1.0f, ni = lbi, den = lr * lr + li * li;
                const float cr = (nr * lr + ni * li) / den, ci = (ni * lr - nr * li) / den;
                for (int c = 0; c < 16; ++c) { const float br = args.in[10][(g * 64 + p) * 16 + c], bi = args.in[11][(g * 64 + p) * 16 + c];
                    BBR[(p * 16 + c) * 2] = cr * br - ci * bi; BBR[(p * 16 + c) * 2 + 1] = cr * bi + ci * br; }
            }
            for (int e = tid; e < 1024; e += 512) { const int co = e >> 6, p = e & 63; CC[(co * 65 + p) * 2] = args.in[12][(g * 16 + co) * 64 + p]; CC[(co * 65 + p) * 2 + 1] = args.in[13][(g * 16 + co) * 64 + p]; }
            __syncthreads();
            {
                const int pair = tid >> 1, hh = tid & 1, d = pair >> 4, co = pair & 15; float acc8[8];
#pragma unroll
                for (int j = 0; j < 8; ++j) acc8[j] = 0.f;
                for (int p = 0; p < 64; ++p) { const float cr = CC[(co * 65 + p) * 2], cim = CC[(co * 65 + p) * 2 + 1], lr = LBP[(d * 64 + p) * 2], lim = LBP[(d * 64 + p) * 2 + 1];
                    const float wr_ = cr * lr - cim * lim, wi_ = cr * lim + cim * lr; const LAS f32x4_t* bp = (const LAS f32x4_t*)(BBR + (p * 16 + 8 * hh) * 2);
#pragma unroll
                    for (int q4 = 0; q4 < 4; ++q4) { const f32x4_t bb = bp[q4]; acc8[2 * q4] += wr_ * bb.x - wi_ * bb.y; acc8[2 * q4 + 1] += wr_ * bb.z - wi_ * bb.w; } }
#pragma unroll
                for (int j = 0; j < 8; ++j) KM[(d * 16 + co) * 16 + 8 * hh + j] = acc8[j] + ((SSM_DFOLD && d == 0 && co == 8 * hh + j) ? args.in[14][g * 16 + co] : 0.f);
            }
            __syncthreads();
            for (int e = tid; e < 64 * 48; e += 512) {
                const int n = 64 * qt + e / 48, pc = e % 48, s = n >> 4, co = n & 15; float v[8];
                if (pc < 32) { const int s2 = pc >> 1, ci0 = (pc & 1) * 8;
#pragma unroll
                    for (int j = 0; j < 8; ++j) v[j] = (s2 <= s) ? KM[((s - s2) * 16 + co) * 16 + ci0 + j] : 0.f;
                } else { const int j0 = (pc - 32) * 8;
#pragma unroll
                    for (int jj = 0; jj < 4; ++jj) { const int p = (j0 >> 1) + jj; const float cr = CC[(co * 65 + p) * 2], cim = CC[(co * 65 + p) * 2 + 1], lr = LBP[((s + 1) * 64 + p) * 2], lim = LBP[((s + 1) * 64 + p) * 2 + 1];
                        v[2 * jj] = cr * lr - cim * lim; v[2 * jj + 1] = -(cr * lim + cim * lr); } }
                v4u o; o.x = pk2bf(v[0], v[1]); o.y = pk2bf(v[2], v[3]); o.z = pk2bf(v[4], v[5]); o.w = pk2bf(v[6], v[7]);
                *(GAS v4u*)(BtB + ((size_t)g * 256 + n) * 384 + pc * 8) = o; }
            for (int e = tid; e < 64 * 32; e += 512) {
                const int n = 64 * qt + (e >> 5), pc = e & 31; float v[8];
                if (n < 128) { const int p = n >> 1, ri = n & 1, s2 = pc >> 1, ci0 = (pc & 1) * 8; const float lr = LBP[((15 - s2) * 64 + p) * 2], lim = LBP[((15 - s2) * 64 + p) * 2 + 1];
#pragma unroll
                    for (int j = 0; j < 8; ++j) { const float br = BBR[(p * 16 + ci0 + j) * 2], bi = BBR[(p * 16 + ci0 + j) * 2 + 1]; v[j] = ri ? (lr * bi + lim * br) : (lr * br - lim * bi); }
                } else {
#pragma unroll
                    for (int j = 0; j < 8; ++j) v[j] = 0.f; }
                v4u o; o.x = pk2bf(v[0], v[1]); o.y = pk2bf(v[2], v[3]); o.z = pk2bf(v[4], v[5]); o.w = pk2bf(v[6], v[7]);
                *(GAS v4u*)(BtA + ((size_t)g * 256 + n) * 256 + pc * 8) = o; }
        }
        __syncthreads();
        {
            LAS float* scr = (LAS float*)(lds + RING_OFF + wave * 16384);
            constexpr int I_2K = (DM / 64) * (2048 / 32), I_1K = (DM / 64) * (1024 / 32);
            constexpr int NITEMS = 2 * I_2K + 5 * I_1K;
            for (int it = gw; it < NITEMS; it += NGW) {
                int r = it;
                if (r < I_2K) { p0_transpose_item(args.in[6], DM, 2048, Win0, 0, nullptr, scr, r, lane); continue; } r -= I_2K;
                if (r < I_2K) { p0_transpose_item(args.in[21], DM, 2048, Win1, 0, nullptr, scr, r, lane); continue; } r -= I_2K;
                if (r < I_1K) { p0_transpose_item(args.in[15], DM, 1024, Wglu, 0, nullptr, scr, r, lane); continue; } r -= I_1K;
                if (r < I_1K) { p0_transpose_item(args.in[17], DM, 1024, Wout0, 0, nullptr, scr, r, lane); continue; } r -= I_1K;
                if (r < I_1K) { p0_transpose_item(args.in[19], DM, 1024, Wkv, 0, args.in[18], scr, r, lane); continue; } r -= I_1K;
                if (r < I_1K) { p0_transpose_item(args.in[20], DM, 1024, Wkv, 1024, args.in[18], scr, r, lane); continue; } r -= I_1K;
                p0_transpose_item(args.in[27], DM, 1024, Wout1, 0, nullptr, scr, r, lane);
            }
        }
        if (!(args.flags & 1)) {
            __syncthreads();
            LAS float* sc = (LAS float*)(lds + RING_OFF);
            LAS float* red = sc + 8192;
            bool have = false;
            for (int it = vcu; it < 2 * 96; it += G) {
                if (!have) { for (int e = tid; e < 8192; e += 512) sc[e] = silu_f(cvec[e]); have = true; __syncthreads(); }
                const int l = it / 96, cc = it % 96, j = cc * 32 + (lane & 31), kh = lane >> 5;
                float acc[8];
#pragma unroll
                for (int b = 0; b < 8; ++b) acc[b] = 0.f;
                const float* wp = ada_w + ((size_t)l * 1024 + wave * 128 + kh) * 3072 + j;
                for (int k0 = 0; k0 < 64; k0 += 32) {
                    float w[32];
#pragma unroll
                    for (int kk = 0; kk < 32; ++kk) w[kk] = NT_LD(wp + (size_t)(2 * (k0 + kk)) * 3072);
#pragma unroll
                    for (int kk = 0; kk < 32; ++kk) {
#pragma unroll
                        for (int b = 0; b < 8; ++b) acc[b] += w[kk] * sc[b * 1024 + wave * 128 + 2 * (k0 + kk) + kh];
                        if ((kk & 3) == 3) asm volatile("" ::: "memory"); }
                }
#pragma unroll
                for (int b = 0; b < 8; ++b) { acc[b] += __shfl_xor(acc[b], 32); if (lane < 32) red[(wave * 8 + b) * 32 + lane] = acc[b]; }
                __syncthreads();
                if (tid < 256) { const int b = tid >> 5, jl = tid & 31; float sum = ada_b[l * 3072 + cc * 32 + jl];
#pragma unroll
                  for (int w = 0; w < 8; ++w) sum += red[(w * 8 + b) * 32 + jl];
                  mod[((size_t)(l * 8 + b)) * 3072 + cc * 32 + jl] = sum; }
                __syncthreads();
            }
            if (bx == 0 && tid == 0) lamp[0] = diff_lambda(args.in[22], args.in[23], args.in[24], args.in[25]);
        }
    }
    SEAM(0);
    if (IN(1)) for (int rep_ = 0; rep_ < REPS(1); ++rep_) e_norm0_b(x, mod, g_pre, A0, egw, engw, LANE_L(), eb_lo, eb_hi);
    SEAM(1);
#ifdef EXTRA_BARS
    if (args.use_bar) for (int eb = 0; eb < EXTRA_BARS; ++eb) xcd_barrier(bar, TID_NOW());
#endif
    if (IN(2)) for (int rep_ = 0; rep_ < REPS(2); ++rep_) {
        pg8::Gemm g = pg8::gemm_std(A0, DM, Win0, DM, DM); pg8::Order S; S.init(MTOK / 256, 2048 / 256, 1, G, bx);
        pg8::EpiRow8<pg8::F_In0> E{{US, SZ}};
        pg8::gemm_phase<pg8::EpiRow8<pg8::F_In0>, ALIGN_E>(lds + RING_OFF, g, S, E, TID_NOW());
    }
    SEAM(2);
#if SSM_FUSED
    if (IN(3)) {
        pg8::Gemm gA = pg8::gemm_std(US, US_P, BtA, 256, 256); gA.a_gstep = (size_t)NTILE * US_P * 2; gA.b_gstep = (size_t)256 * 256 * 2;
        pg8::Gemm gB = pg8::gemm_std(US, US_P, BtB, 384, 384); gB.a_gstep = (size_t)NTILE * US_P * 2; gB.b_gstep = (size_t)256 * 384 * 2;
        pg8::EpiScan ES{lb16, US, LDSCTL_OFF + 2048};
#if SSM_DFOLD
        pg8::EpiRow8<pg8::F_SsmB0> EB2{{YG}};
#else
        pg8::EpiRow8<pg8::F_SsmB> EB2{{US, args.in[14], YG}};
#endif
        for (int uu = 0; xcl ? (uu * 32 + rankx < NGRP) : ((long)uu * G + bx < NGRP * NB); ++uu) {
            pg8::Order S; if (xcl) { S.init(1, 1, NGRP, 32, rankx); S.pm_off = (int)px; } else S.init(NTILE / 256, 1, NGRP, G, bx); S.only = uu;
            pg8::gemm_phase<pg8::EpiScan, false>(lds + RING_OFF, gA, S, ES, TID_NOW());
#if SSM_DFOLD
            pg8::gemm_phase<pg8::EpiRow8<pg8::F_SsmB0>, false>(lds + RING_OFF, gB, S, EB2, TID_NOW());
#else
            pg8::gemm_phase<pg8::EpiRow8<pg8::F_SsmB>, false>(lds + RING_OFF, gB, S, EB2, TID_NOW());
#endif
        }
    }
    SEAM(5);
#else
    if (IN(3)) for (int rep_ = 0; rep_ < REPS(3); ++rep_) {
        pg8::Gemm g = pg8::gemm_std(US, US_P, BtA, 256, 256); g.a_gstep = (size_t)NTILE * US_P * 2; g.b_gstep = (size_t)256 * 256 * 2;
        pg8::Order S; S.init(NTILE / 256, 1, NGRP, G, bx);
        pg8::EpiRow8<pg8::F_SsmA> E{{EB}};
        pg8::gemm_phase<pg8::EpiRow8<pg8::F_SsmA>, ALIGN_E>(lds + RING_OFF, g, S, E, TID_NOW());
    }
    SEAM(3);
    if (IN(4)) for (int rep_ = 0; rep_ < REPS(4); ++rep_) {
        for (int it = vcu + G * wave; it < NB * NGRP; it += G * NWAVES) {
            const int b = it / NGRP, g = it % NGRP, p = LANE_L();
            const float lr = lb16[(g * 64 + p) * 2], li = lb16[(g * 64 + p) * 2 + 1];
            float sr = 0.f, si = 0.f;
            const float* ep = EB + ((size_t)g * NTILE + b * 256) * 128 + 2 * p;
            bf16_t* sp = US + us_off(g, b * 256, 256 + 2 * p);
            for (int t0 = 0; t0 < 256; t0 += 16) {
                float er[16], ei[16];
#pragma unroll
                for (int j = 0; j < 16; ++j) { const float2 e = *(const float2*)(ep + (size_t)(t0 + j) * 128); er[j] = e.x; ei[j] = e.y; }
#pragma unroll
                for (int j = 0; j < 16; ++j) { *(unsigned*)(sp + (size_t)(t0 + j) * US_P) = pk2bf(sr, si);
                    const float nr = lr * sr - li * si + er[j], ni = lr * si + li * sr + ei[j]; sr = nr; si = ni; }
            }
        }
    }
    SEAM(4);
    if (IN(5)) for (int rep_ = 0; rep_ < REPS(5); ++rep_) {
        pg8::Gemm g = pg8::gemm_std(US, US_P, BtB, 384, 384); g.a_gstep = (size_t)NTILE * US_P * 2; g.b_gstep = (size_t)256 * 384 * 2;
        pg8::Order S; S.init(NTILE / 256, 1, NGRP, G, bx);
        pg8::EpiRow8<pg8::F_SsmB> E{{US, args.in[14], YG}};
        pg8::gemm_phase<pg8::EpiRow8<pg8::F_SsmB>, ALIGN_E>(lds + RING_OFF, g, S, E, TID_NOW());
    }
    SEAM(5);
#endif
    if (IN(6)) for (int rep_ = 0; rep_ < REPS(6); ++rep_) {
        pg8::Gemm g = pg8::gemm_std(YG, DM, Wglu, DM, DM);
        g.a_rs = 32u; g.a_c16 = (unsigned)((size_t)NTILE * YG_P * 2); g.a_kstep = (size_t)4 * NTILE * YG_P * 2; g.a_tstep = (size_t)256 * 32;
        pg8::Order S; S.init(MTOK / 256, 1024 / 256, 1, G, bx);
        pg8::EpiRow8<pg8::F_Glu> E{{YG, SZ, args.in[16], Y2}};
        pg8::gemm_phase<pg8::EpiRow8<pg8::F_Glu>, ALIGN_E>(lds + RING_OFF, g, S, E, TID_NOW());
    }
    SEAM(6);
#if FUSE_EPI
    if (IN(7)) {
        pg8::Gemm g = pg8::gemm_std(Y2, DM, Wout0, DM, DM);
        for (int half = 0; half < 2; ++half) {
            pg8::Order S; S.init(MTOK / 512, 1024 / 256, 1, G, bx); S.pm_off = half * (MTOK / 512);
            pg8::PanelRms st1{(unsigned*)(ws + WS_XCH), (unsigned*)(ctl + CW_SEAM), (unsigned*)(ctl + CW_TMO), RMS_EPS};
            pg8::PanelRms st2{(unsigned*)(ws + WS_XCH + 1 * MiB), (unsigned*)(ctl + CW_SEAM + SEAM_BANK), (unsigned*)(ctl + CW_TMO), RMS_EPS};
            pg8::EpiMid E{x, out, AKV, AIN1, mod, g_post, g_pre + 1024, st1, st2};
            pg8::gemm_phase<pg8::EpiMid, false>(lds + RING_OFF, g, S, E, TID_NOW());
        }
    }
#else
    if (IN(7)) {
        pg8::Gemm g = pg8::gemm_std(Y2, DM, Wout0, DM, DM); pg8::Order S; S.init(MTOK / 256, 1024 / 256, 1, G, bx);
        pg8::EpiRow8<pg8::F_Plain> E{{YO}};
        pg8::gemm_phase<pg8::EpiRow8<pg8::F_Plain>, ALIGN_E>(lds + RING_OFF, g, S, E, TID_NOW());
    }
    SEAM(7);
    if (IN(8)) { if (H1_BF16) e_mid(x, YO, mod, g_post, g_pre, (float*)nullptr, YO, AKV, AIN1, gw, NGW, LANE_L()); else e_mid_b(x, YO, mod, g_post, g_pre, (H1_RECOMP || H1_AKV) ? (float*)nullptr : out, AKV, AIN1, egw, engw, LANE_L(), H1_AKV ? HN : (float*)nullptr, eb_lo, eb_hi); }
#endif
    SEAM(8);
    if (IN(9)) for (int rep_ = 0; rep_ < REPS(9); ++rep_) {
        pg8::Gemm g = pg8::gemm_std(AKV, DM, Wkv, DM, DM); g.a_gstep = (size_t)(WS_S2 - WS_S0); g.b_gstep = (size_t)(WS_WIN1 - WS_WKV);
        pg8::Order S; S.init(MTOK / 256, 2048 / 256, 2, G, bx); S.mode2 = (G == 256);
        pg8::EpiRow8<pg8::F_Split2> E{{{KB, QB}, {VB, SZ1}}};
        pg8::gemm_phase<pg8::EpiRow8<pg8::F_Split2>, ALIGN_E>(lds + RING_OFF, g, S, E, TID_NOW());
    }
    SEAM(9);
    if (IN(10)) {
#if ATTN_V128
#if ATTN_FUSE_POST
        { const float lam = __int_as_float(__builtin_amdgcn_readfirstlane(__float_as_int(lamp[0])));
          attn_body::bf16x8 qr[4]; bool primed = false;
#if ATTN_PRIO
          if (wave >= 4) __builtin_amdgcn_s_setprio(1);
#endif
          const int nun = (64 * 16 - vcu + G - 1) / G;
#pragma unroll 1
          for (int su = 0; su < 2 * nun; ++su) {
            const int i = su >> 1, cc = su & 1;
            const long L = (long)i * G + vcu; const int pr = (int)(L % 256), qi = (int)(L / 256);
            const int bh = pr >> 2, j = pr & 3; const int qb = (qi & 1) ? (8 * (qi >> 1) + 7 - j) : (8 * (qi >> 1) + j); const int h = bh & 7, b = bh >> 3;
            const bool has_next = su + 1 < 2 * nun;
            const int i2 = (su + 1) >> 1, cc2 = (su + 1) & 1;
            const long L2 = (long)i2 * G + vcu; const int pr2 = (int)(L2 % 256), qi2 = (int)(L2 / 256);
            const int bh2 = pr2 >> 2, j2 = pr2 & 3; const int qb2 = (qi2 & 1) ? (8 * (qi2 >> 1) + 7 - j2) : (8 * (qi2 >> 1) + j2); const int h2 = bh2 & 7, b2 = bh2 >> 3;
            attn3::attn_unit<8>(TID_NOW(), b, 2 * h + cc, h, qb, QB, KB, VB, O0, (char*)lds_raw + RING_OFF, cc, SZ1, args.in[26], lam, OG, primed, has_next, b2, 2 * h2 + cc2, h2, qb2, qr);
            primed = true;
          }
#if ATTN_PRIO
          __builtin_amdgcn_s_setprio(0);
#endif
          }
#else
        for (int i = 0;; ++i) {
            const long L = (long)i * G + vcu; if (L >= 128 * 16) break;
            const int pr = (int)(L % 256), qi = (int)(L / 256);
            const int combo = pr >> 1, j = pr & 1;
            const int k4 = qi >> 1; const int qb = (qi & 1) ? (4 * k4 + 3 - j) : (4 * k4 + j);
            const int c = combo & 1, h = (combo >> 1) & 7, b = combo >> 4;
            { attn_body::bf16x8 qr_[4]; attn3::attn_unit<8>(TID_NOW(), b, 2 * h + c, h, qb, QB, KB, VB, c ? O1 : O0, (char*)lds_raw + RING_OFF, 0, SZ1, args.in[26], 0.f, OG, false, false, 0, 0, 0, 0, qr_); asm volatile("s_barrier" ::: "memory"); }
        }
#endif
#else
        for (int i = 0;; ++i) {
            const long L = (long)i * G + vcu; if (L >= 256 * 16) break;
            const int combo = (int)(L % 256), qi = (int)(L / 256);
            const int qb = (qi & 1) ? (qi >> 1) : (15 - (qi >> 1));
            const int vh = combo & 1, c = (combo >> 1) & 1, h = (combo >> 2) & 7, b = combo >> 5;
            attn_body::attn_unit<8>(TID_NOW(), b, 2 * h + c, 2 * h + vh, qb, QB, KB, VB, c ? O1 : O0, (char*)lds_raw + RING_OFF);
        }
#endif
    }
    SEAM(10);
#if !(ATTN_V128 && ATTN_FUSE_POST)
    if (IN(11)) for (int rep_ = 0; rep_ < REPS(11); ++rep_) e_attn_post(O0, O1, SZ1, args.in[26], lamp[0], OG, gw, NGW, LANE_L());
    SEAM(11);
#endif
#if FUSE_EPI
    if (IN(12)) {
        pg8::Gemm g = pg8::gemm_std(OG, DM, Wout1, DM, DM);
        for (int half = 0; half < 2; ++half) {
            pg8::Order S; S.init(MTOK / 512, 1024 / 256, 1, G, bx); S.pm_off = half * (MTOK / 512);
            pg8::PanelRms st{(unsigned*)(ws + WS_XCH + 2 * MiB), (unsigned*)(ctl + CW_SEAM + 2 * SEAM_BANK), (unsigned*)(ctl + CW_TMO), RMS_EPS};
            pg8::EpiFinal E{out, out, mod + 8 * 3072, g_post + 1024, st};
            pg8::gemm_phase<pg8::EpiFinal, false>(lds + RING_OFF, g, S, E, TID_NOW());
        }
    }
#else
    if (IN(12)) {
        pg8::Gemm g = pg8::gemm_std(OG, DM, Wout1, DM, DM); pg8::Order S; S.init(MTOK / 256, 1024 / 256, 1, G, bx);
        pg8::EpiRow8<pg8::F_Plain> E{{YO1}};
        pg8::gemm_phase<pg8::EpiRow8<pg8::F_Plain>, ALIGN_E>(lds + RING_OFF, g, S, E, TID_NOW());
    }
    SEAM(12);
    if (IN(13)) { if (H1_BF16) e_final_b(YO, out, YO1, mod, g_post, gw, NGW, LANE_L()); else if (H1_AKV) e_final_k(AKV, HN, YO1, out, mod, g_post, egw, engw, LANE_L(), eb_lo, eb_hi); else if (H1_RECOMP) e_final_x(x, YO, YO1, out, mod, g_post, gw, NGW, LANE_L()); else e_final_bm(out, YO1, mod, g_post, gw, NGW, LANE_L()); }
#endif
#undef IN
#undef SEAM
}

#ifndef FASTMASK
#define FASTMASK 0x3fff
#endif
#ifndef ONE_LAUNCH
#define ONE_LAUNCH 1
#endif
constexpr int NPHASE = 14;

extern "C" void kernel_launch(void* const* d_in, const int* in_sizes, int n_in, void* d_out, int out_size, void* d_ws, size_t ws_size, hipStream_t stream) {
    static int grid = 0;
    if (grid == 0) {
        if (n_in != 28 || out_size != MTOK * DM || ws_size < WS_END) { fprintf(stderr, "kernel_launch: unexpected shapes (n_in %d out %d ws %zu)\n", n_in, out_size, ws_size); grid = -1; return; }
        int dev = 0, cus = 0, per_cu = 0;
        if (hipGetDevice(&dev) != hipSuccess || hipDeviceGetAttribute(&cus, hipDeviceAttributeMultiprocessorCount, dev) != hipSuccess) { grid = -1; return; }
        if (hipFuncSetAttribute((const void*)mega_fwd, hipFuncAttributeMaxDynamicSharedMemorySize, LDS_BYTES) != hipSuccess) { fprintf(stderr, "kernel_launch: hipFuncSetAttribute failed\n"); grid = -1; return; }
        if (hipOccupancyMaxActiveBlocksPerMultiprocessor(&per_cu, (const void*)mega_fwd, NWAVES * 64, LDS_BYTES) != hipSuccess || per_cu < 1) { fprintf(stderr, "kernel_launch: occupancy query says %d\n", per_cu); }
        (void)hipGetLastError();
        grid = cus;
    }
    if (grid < 0) return;
    if (hipMemsetAsync((char*)d_ws + WS_CTL + (size_t)CW_BAR * 4, 0, (size_t)XCD_BAR_WORDS * 8, stream) != hipSuccess) { fprintf(stderr, "kernel_launch: memset failed\n"); return; }
    Args a{};
    for (int i = 0; i < 28; ++i) a.in[i] = (const float*)d_in[i];
    a.out = (float*)d_out; a.ws = (unsigned char*)d_ws;
#if ONE_LAUNCH
    a.ph_lo = 0; a.ph_hi = NPHASE; a.use_bar = 1; a.flags = 0;
    hipLaunchKernelGGL(mega_fwd, dim3(grid), dim3(NWAVES * 64), LDS_BYTES, stream, a);
#else
    const float* x = a.in[0]; unsigned char* ws = a.ws; float* out = a.out;
    float* mod = (float*)(ws + WS_MOD); float* lam = (float*)(ws + WS_LAM);
    bf16_t* A0 = (bf16_t*)(ws + WS_S0); bf16_t* US = (bf16_t*)(ws + WS_S1); bf16_t* SZ = (bf16_t*)(ws + WS_S3); bf16_t* YG = (bf16_t*)(ws + WS_S4);
    bf16_t* Y2 = (bf16_t*)(ws + WS_S0); bf16_t* YO = (bf16_t*)(ws + WS_S1); bf16_t* AKV = (bf16_t*)(ws + WS_S0); bf16_t* AIN1 = (bf16_t*)(ws + WS_S2);
    bf16_t* KB = (bf16_t*)(ws + WS_S3); bf16_t* VB = (bf16_t*)(ws + WS_S4); bf16_t* QB = (bf16_t*)(ws + WS_S5); bf16_t* SZ1 = (bf16_t*)(ws + WS_S6);
    bf16_t* O0 = (bf16_t*)(ws + WS_S0); bf16_t* O1 = (bf16_t*)(ws + WS_S1); bf16_t* OG = (bf16_t*)(ws + WS_S2); bf16_t* YO1 = (bf16_t*)(ws + WS_S0);
    const int EG = 2048;
    auto fast1 = [&](int lo, int hi, int flags) { a.ph_lo = lo; a.ph_hi = hi; a.use_bar = 0; a.flags = flags; hipLaunchKernelGGL(mega_fwd, dim3(grid), dim3(NWAVES * 64), LDS_BYTES, stream, a); };
    auto fast = [&](int lo, int hi, int flags) { fast1(lo, hi, flags); if (lo == EXTRA_PHASE) fast1(lo, hi, flags); };
    const unsigned FM = FASTMASK;
    if (FM & 1u) fast(0, 1, 0);
    else { fast(0, 1, 1); n_adaln<<<(2 * 8 * 3072 + 255) / 256, 256, 0, stream>>>(a.in[1], a.in[2], a.in[3], mod); n_lambda<<<1, 64, 0, stream>>>(a.in[22], a.in[23], a.in[24], a.in[25], lam); }
    if (FM & 2u) fast(1, 2, 0); else n_norm0<<<EG, 256, 0, stream>>>(x, mod, a.in[4], A0);
    if (FM & 4u) fast(2, 3, 0); else n_gemm<<<dim3(2048 / 64, MTOK / 64), 256, 0, stream>>>(AL_Row{A0}, WL_Plain{a.in[6], 2048}, EP_In0{US, SZ}, 2048);
    if (FM & 8u) { fast(3, 4, 0); fast(4, 5, 0); fast(5, 6, 0); }
    else n_ssm<<<NB * NGRP / 4, 256, 0, stream>>>(US, a.in[7], a.in[8], a.in[9], a.in[10], a.in[11], a.in[12], a.in[13], a.in[14], YG);
    if (FM & 64u) fast(6, 7, 0); else n_gemm<<<dim3(1024 / 64, MTOK / 64), 256, 0, stream>>>(AL_YG{YG}, WL_Plain{a.in[15], 1024}, EP_Glu{YG, SZ, a.in[16], Y2}, 1024);
    if (FM & 128u) fast(7, 8, 0); else n_gemm<<<dim3(1024 / 64, MTOK / 64), 256, 0, stream>>>(AL_Row{Y2}, WL_Plain{a.in[17], 1024}, EP_Plain{YO}, 1024);
    if (FM & 256u) fast(8, 9, 0); else n_mid<<<EG, 256, 0, stream>>>(x, YO, mod, a.in[5], a.in[4], out, AKV, AIN1);
    if (FM & 512u) fast(9, 10, 0);
    else { n_gemm<<<dim3(2048 / 64, MTOK / 64), 256, 0, stream>>>(AL_Row{AKV}, WL_KV{a.in[19], a.in[20], a.in[18]}, EP_KV{KB, VB}, 2048);
           n_gemm<<<dim3(2048 / 64, MTOK / 64), 256, 0, stream>>>(AL_Row{AIN1}, WL_Plain{a.in[21], 2048}, EP_In1{QB, SZ1}, 2048); }
    if (FM & 1024u) fast(10, 11, 0); else n_attn<<<MTOK * 8 / 4, 256, 0, stream>>>(QB, KB, VB, O0, O1);
    if (FM & 2048u) fast(11, 12, 0); else n_attn_post<<<EG, 256, 0, stream>>>(O0, O1, SZ1, a.in[26], lam, OG);
    if (FM & 4096u) fast(12, 13, 0); else n_gemm<<<dim3(1024 / 64, MTOK / 64), 256, 0, stream>>>(AL_Row{OG}, WL_Plain{a.in[27], 1024}, EP_Plain{YO1}, 1024);
    if (FM & 8192u) fast(13, 14, 0); else n_final<<<EG, 256, 0, stream>>>(out, YO1, mod, a.in[5]);
#endif
    const hipError_t le = hipPeekAtLastError();
    if (le != hipSuccess) fprintf(stderr, "kernel_launch: launch failed: %s\n", hipGetErrorName(le));
}
```

```cpp
#include <hip/hip_runtime.h>
#include <cstdio>
#include <cstdint>
#include <cmath>
#define FASTMASK 0x3fff
#define ONE_LAUNCH 1
#define REPEAT_MASK 0

typedef unsigned short bf16_t;
constexpr int NB = 8, SEQL = 4096, DM = 1024, MTOK = NB * SEQL;
constexpr int NGRP = 64, NTILE = MTOK / 16;
constexpr int US_P = 384, YG_P = 256;
constexpr float LAMBDA_INIT = 0.35550907f;
constexpr float ONE_M_LI = 1.0f - LAMBDA_INIT;
constexpr float RMS_EPS = 1e-6f;
constexpr float QC2 = 0.125f * 1.4426950408889634f;

__device__ __forceinline__ float bf2f(bf16_t v) { return __uint_as_float((unsigned)v << 16); }
__device__ __forceinline__ unsigned f2bf_u(float f) { unsigned u = __float_as_uint(f); return (u + 0x7fffu + ((u >> 16) & 1u)) >> 16; }
__device__ __forceinline__ bf16_t f2bf(float f) { return (bf16_t)f2bf_u(f); }
__device__ __forceinline__ unsigned pk2bf(float lo, float hi) { return f2bf_u(lo) | (f2bf_u(hi) << 16); }
__device__ __forceinline__ float silu_f(float v) { return v / (1.0f + __expf(-v)); }
__device__ __forceinline__ float sigmoid_f(float v) { return 1.0f / (1.0f + __expf(-v)); }
__device__ __forceinline__ float gelu_tanh_f(float v) {
    const float u = 0.7978845608028654f * (v + 0.044715f * v * v * v);
    const float e = __expf(2.0f * u);
    const float t = 1.0f - 2.0f / (e + 1.0f);
    return 0.5f * v * (1.0f + t);
}
__device__ __forceinline__ float wave_sum_f(float v) {
#pragma unroll
    for (int o = 1; o < 64; o <<= 1) v += __shfl_xor(v, o);
    return v;
}
__device__ __forceinline__ float wave_max_f(float v) {
#pragma unroll
    for (int o = 1; o < 64; o <<= 1) v = fmaxf(v, __shfl_xor(v, o));
    return v;
}
__device__ __forceinline__ size_t us_off(int g, int tile, int col) { return ((size_t)g * NTILE + tile) * US_P + col; }
__device__ __forceinline__ size_t yg_off(int g, int tile, int col) { return ((size_t)g * NTILE + tile) * YG_P + col; }

typedef float f32x4_t __attribute__((ext_vector_type(4)));
typedef unsigned u32x4_t __attribute__((ext_vector_type(4)));
typedef unsigned u32x2_t __attribute__((ext_vector_type(2)));
#ifndef USE_NT
#define USE_NT 1
#endif
#if USE_NT
#define NT_LD(p) __builtin_nontemporal_load(p)
#define NT_ST(p, v) __builtin_nontemporal_store((v), (p))
#else
#define NT_LD(p) (*(p))
#define NT_ST(p, v) (*(p) = (v))
#endif

__device__ __forceinline__ void e_norm0(const float* __restrict__ x, const float* __restrict__ mod, const float* __restrict__ g_pre, bf16_t* a0, int gw, int ngw, int lane) {
    for (int m = gw; m < MTOK; m += ngw) {
        const int b = m / SEQL;
        const f32x4_t* xr = (const f32x4_t*)(x + (size_t)m * DM) + lane;
        f32x4_t v[4]; float s = 0.f;
#pragma unroll
        for (int j = 0; j < 4; ++j) { v[j] = NT_LD(xr + 64 * j); s += (v[j].x * v[j].x + v[j].y * v[j].y) + (v[j].z * v[j].z + v[j].w * v[j].w); }
        const float r = rsqrtf(wave_sum_f(s) * (1.0f / DM) + RMS_EPS);
        const float* sh = mod + (size_t)b * 3072; const float* sc = sh + 1024;
        u32x2_t* o = (u32x2_t*)(a0 + (size_t)m * DM) + lane;
#pragma unroll
        for (int j = 0; j < 4; ++j) {
            const int c = 256 * j + 4 * lane;
            const f32x4_t g = *(const f32x4_t*)(g_pre + c), scv = *(const f32x4_t*)(sc + c), shv = *(const f32x4_t*)(sh + c);
            f32x4_t y = v[j] * r * g * (scv + 1.0f) + shv;
            u32x2_t w; w.x = pk2bf(y.x, y.y); w.y = pk2bf(y.z, y.w); o[64 * j] = w;
        }
    }
}
__device__ __forceinline__ void e_mid(const float* __restrict__ x, const bf16_t* __restrict__ yo, const float* __restrict__ mod, const float* __restrict__ g_post, const float* __restrict__ g_pre,
                                      float* h1, bf16_t* h1b, bf16_t* akv, bf16_t* ain1, int gw, int ngw, int lane) {
    for (int m = gw; m < MTOK; m += ngw) {
        const int b = m / SEQL;
        const f32x4_t* xr = (const f32x4_t*)(x + (size_t)m * DM) + lane;
        const u32x2_t* yr = (const u32x2_t*)(yo + (size_t)m * DM) + lane;
        f32x4_t v[4], y[4]; float s = 0.f;
#pragma unroll
        for (int j = 0; j < 4; ++j) { v[j] = NT_LD(xr + 64 * j); const u32x2_t w = NT_LD(yr + 64 * j);
            y[j].x = __uint_as_float(w.x << 16); y[j].y = __uint_as_float(w.x & 0xffff0000u); y[j].z = __uint_as_float(w.y << 16); y[j].w = __uint_as_float(w.y & 0xffff0000u);
            s += (y[j].x * y[j].x + y[j].y * y[j].y) + (y[j].z * y[j].z + y[j].w * y[j].w); }
        const float ry = rsqrtf(wave_sum_f(s) * (1.0f / DM) + RMS_EPS);
        const float* gate0 = mod + (size_t)b * 3072 + 2048;
        const float* sh1 = mod + (size_t)(8 + b) * 3072; const float* sc1 = sh1 + 1024;
        float s2 = 0.f;
        f32x4_t* ho = (f32x4_t*)(h1 + (size_t)m * DM) + lane;
#pragma unroll
        for (int j = 0; j < 4; ++j) { const int c = 256 * j + 4 * lane;
            const f32x4_t gp = *(const f32x4_t*)(g_post + c), gt = *(const f32x4_t*)(gate0 + c);
            v[j] = v[j] + gt * (y[j] * ry * gp);
            if (h1) NT_ST(ho + 64 * j, v[j]);
            if (h1b) { u32x2_t wq; wq.x = pk2bf(v[j].x, v[j].y); wq.y = pk2bf(v[j].z, v[j].w); ((u32x2_t*)(h1b + (size_t)m * DM) + lane)[64 * j] = wq; }
            s2 += (v[j].x * v[j].x + v[j].y * v[j].y) + (v[j].z * v[j].z + v[j].w * v[j].w); }
        const float rh = rsqrtf(wave_sum_f(s2) * (1.0f / DM) + RMS_EPS);
        u32x2_t* o1 = (u32x2_t*)(akv + (size_t)m * DM) + lane; u32x2_t* o2 = (u32x2_t*)(ain1 + (size_t)m * DM) + lane;
#pragma unroll
        for (int j = 0; j < 4; ++j) { const int c = 256 * j + 4 * lane;
            const f32x4_t n = v[j] * rh;
            u32x2_t w; w.x = pk2bf(n.x, n.y); w.y = pk2bf(n.z, n.w); o1[64 * j] = w;
            const f32x4_t g = *(const f32x4_t*)(g_pre + 1024 + c), scv = *(const f32x4_t*)(sc1 + c), shv = *(const f32x4_t*)(sh1 + c);
            const f32x4_t z = n * g * (scv + 1.0f) + shv;
            w.x = pk2bf(z.x, z.y); w.y = pk2bf(z.z, z.w); o2[64 * j] = w; }
    }
}
__device__ __forceinline__ void e_attn_post(const bf16_t* __restrict__ o0, const bf16_t* __restrict__ o1, const bf16_t* __restrict__ sz1, const float* __restrict__ g_sub, float lam,
                                            bf16_t* og, int gw, int ngw, int lane) {
    for (int m = gw; m < MTOK; m += ngw) {
#pragma unroll
        for (int j = 0; j < 2; ++j) {
            const int c = 512 * j + 8 * lane;
            const u32x4_t a = *(const u32x4_t*)(o0 + (size_t)m * DM + c), bq = *(const u32x4_t*)(o1 + (size_t)m * DM + c), zq = *(const u32x4_t*)(sz1 + (size_t)m * DM + c);
            float d[8]; float s = 0.f;
#pragma unroll
            for (int i = 0; i < 4; ++i) { const unsigned wa = a[i], wb = bq[i];
                d[2 * i] = __uint_as_float(wa << 16) - lam * __uint_as_float(wb << 16); d[2 * i + 1] = __uint_as_float(wa & 0xffff0000u) - lam * __uint_as_float(wb & 0xffff0000u);
                s += d[2 * i] * d[2 * i] + d[2 * i + 1] * d[2 * i + 1]; }
            s += __shfl_xor(s, 1); s += __shfl_xor(s, 2); s += __shfl_xor(s, 4); s += __shfl_xor(s, 8);
            const float r = rsqrtf(s * (1.0f / 128.0f) + RMS_EPS) * ONE_M_LI;
            const float* gs = g_sub + (c & 127);
            u32x4_t w;
#pragma unroll
            for (int i = 0; i < 4; ++i) { const unsigned wz = zq[i];
                const float z0 = __uint_as_float(wz << 16), z1 = __uint_as_float(wz & 0xffff0000u);
                w[i] = pk2bf(d[2 * i] * r * gs[2 * i] * z0, d[2 * i + 1] * r * gs[2 * i + 1] * z1); }
            *(u32x4_t*)(og + (size_t)m * DM + c) = w;
        }
    }
}
__device__ __forceinline__ void e_final(float* out, const bf16_t* __restrict__ yo1, const float* __restrict__ mod, const float* __restrict__ g_post, int gw, int ngw, int lane) {
    for (int m = gw; m < MTOK; m += ngw) {
        const int b = m / SEQL;
        f32x4_t* hr = (f32x4_t*)(out + (size_t)m * DM) + lane;
        const u32x2_t* yr = (const u32x2_t*)(yo1 + (size_t)m * DM) + lane;
        f32x4_t v[4], y[4]; float s = 0.f;
#pragma unroll
        for (int j = 0; j < 4; ++j) { v[j] = NT_LD(hr + 64 * j); const u32x2_t w = NT_LD(yr + 64 * j);
            y[j].x = __uint_as_float(w.x << 16); y[j].y = __uint_as_float(w.x & 0xffff0000u); y[j].z = __uint_as_float(w.y << 16); y[j].w = __uint_as_float(w.y & 0xffff0000u);
            s += (y[j].x * y[j].x + y[j].y * y[j].y) + (y[j].z * y[j].z + y[j].w * y[j].w); }
        const float ry = rsqrtf(wave_sum_f(s) * (1.0f / DM) + RMS_EPS);
        const float* gate1 = mod + (size_t)(8 + b) * 3072 + 2048;
#pragma unroll
        for (int j = 0; j < 4; ++j) { const int c = 256 * j + 4 * lane;
            const f32x4_t gp = *(const f32x4_t*)(g_post + 1024 + c), gt = *(const f32x4_t*)(gate1 + c);
            NT_ST(hr + 64 * j, v[j] + gt * (y[j] * ry * gp)); }
    }
}
__device__ __forceinline__ void e_final2(const float* __restrict__ x, const bf16_t* __restrict__ yo, const bf16_t* __restrict__ yo1, float* out, const float* __restrict__ mod, const float* __restrict__ g_post, int gw, int ngw, int lane) {
    for (int m = gw; m < MTOK; m += ngw) {
        const int b = m / SEQL;
        const f32x4_t* xr = (const f32x4_t*)(x + (size_t)m * DM) + lane;
        const u32x2_t* y0r = (const u32x2_t*)(yo + (size_t)m * DM) + lane; const u32x2_t* y1r = (const u32x2_t*)(yo1 + (size_t)m * DM) + lane;
        f32x4_t v[4], y0[4], y1[4]; float s0 = 0.f, s1 = 0.f;
#pragma unroll
        for (int j = 0; j < 4; ++j) { v[j] = xr[64 * j]; const u32x2_t w0 = y0r[64 * j], w1 = y1r[64 * j];
            y0[j].x = __uint_as_float(w0.x << 16); y0[j].y = __uint_as_float(w0.x & 0xffff0000u); y0[j].z = __uint_as_float(w0.y << 16); y0[j].w = __uint_as_float(w0.y & 0xffff0000u);
            y1[j].x = __uint_as_float(w1.x << 16); y1[j].y = __uint_as_float(w1.x & 0xffff0000u); y1[j].z = __uint_as_float(w1.y << 16); y1[j].w = __uint_as_float(w1.y & 0xffff0000u);
            s0 += (y0[j].x * y0[j].x + y0[j].y * y0[j].y) + (y0[j].z * y0[j].z + y0[j].w * y0[j].w);
            s1 += (y1[j].x * y1[j].x + y1[j].y * y1[j].y) + (y1[j].z * y1[j].z + y1[j].w * y1[j].w); }
        const float r0 = rsqrtf(wave_sum_f(s0) * (1.0f / DM) + RMS_EPS), r1 = rsqrtf(wave_sum_f(s1) * (1.0f / DM) + RMS_EPS);
        const float* gate0 = mod + (size_t)b * 3072 + 2048; const float* gate1 = mod + (size_t)(8 + b) * 3072 + 2048;
        f32x4_t* orow = (f32x4_t*)(out + (size_t)m * DM) + lane;
#pragma unroll
        for (int j = 0; j < 4; ++j) { const int c = 256 * j + 4 * lane;
            const f32x4_t gp0 = *(const f32x4_t*)(g_post + c), gt0 = *(const f32x4_t*)(gate0 + c), gp1 = *(const f32x4_t*)(g_post + 1024 + c), gt1 = *(const f32x4_t*)(gate1 + c);
            const f32x4_t h = v[j] + gt0 * (y0[j] * r0 * gp0);
            orow[64 * j] = h + gt1 * (y1[j] * r1 * gp1); }
    }
}
__device__ __forceinline__ void e_final_b(const bf16_t* __restrict__ h1b, float* out, const bf16_t* __restrict__ yo1, const float* __restrict__ mod, const float* __restrict__ g_post, int gw, int ngw, int lane) {
    for (int m = gw; m < MTOK; m += ngw) {
        const int b = m / SEQL;
        const u32x2_t* hr = (const u32x2_t*)(h1b + (size_t)m * DM) + lane;
        const u32x2_t* yr = (const u32x2_t*)(yo1 + (size_t)m * DM) + lane;
        f32x4_t v[4], y[4]; float s = 0.f;
#pragma unroll
        for (int j = 0; j < 4; ++j) { const u32x2_t hw = NT_LD(hr + 64 * j); const u32x2_t w = NT_LD(yr + 64 * j);
            v[j].x = __uint_as_float(hw.x << 16); v[j].y = __uint_as_float(hw.x & 0xffff0000u); v[j].z = __uint_as_float(hw.y << 16); v[j].w = __uint_as_float(hw.y & 0xffff0000u);
            y[j].x = __uint_as_float(w.x << 16); y[j].y = __uint_as_float(w.x & 0xffff0000u); y[j].z = __uint_as_float(w.y << 16); y[j].w = __uint_as_float(w.y & 0xffff0000u);
            s += (y[j].x * y[j].x + y[j].y * y[j].y) + (y[j].z * y[j].z + y[j].w * y[j].w); }
        const float ry = rsqrtf(wave_sum_f(s) * (1.0f / DM) + RMS_EPS);
        const float* gate1 = mod + (size_t)(8 + b) * 3072 + 2048;
        f32x4_t* orow = (f32x4_t*)(out + (size_t)m * DM) + lane;
#pragma unroll
        for (int j = 0; j < 4; ++j) { const int c = 256 * j + 4 * lane;
            const f32x4_t gp = *(const f32x4_t*)(g_post + 1024 + c), gt = *(const f32x4_t*)(gate1 + c);
            NT_ST(orow + 64 * j, v[j] + gt * (y[j] * ry * gp)); }
    }
}

#define ER 2
__device__ __forceinline__ void unpk4(const u32x2_t w, f32x4_t& y) { y.x = __uint_as_float(w.x << 16); y.y = __uint_as_float(w.x & 0xffff0000u); y.z = __uint_as_float(w.y << 16); y.w = __uint_as_float(w.y & 0xffff0000u); }
__device__ __forceinline__ float ssq4(const f32x4_t v) { return (v.x * v.x + v.y * v.y) + (v.z * v.z + v.w * v.w); }
__device__ __forceinline__ void e_norm0_r(const float* __restrict__ x, const float* __restrict__ mod, const float* __restrict__ g_pre, bf16_t* a0, int gw, int ngw, int lane) {
    for (int m0 = gw; m0 < MTOK; m0 += ER * ngw) {
        f32x4_t v[ER][4]; float s[ER];
#pragma unroll
        for (int r = 0; r < ER; ++r) { const int m = min(m0 + r * ngw, MTOK - 1); const f32x4_t* xr = (const f32x4_t*)(x + (size_t)m * DM) + lane;
#pragma unroll
            for (int j = 0; j < 4; ++j) v[r][j] = NT_LD(xr + 64 * j); }
#pragma unroll
        for (int r = 0; r < ER; ++r) { s[r] = 0.f;
#pragma unroll
            for (int j = 0; j < 4; ++j) s[r] += ssq4(v[r][j]); }
#pragma unroll
        for (int r = 0; r < ER; ++r) { const int m = m0 + r * ngw; if (m >= MTOK) break;
            const int b = m / SEQL; const float rr = rsqrtf(wave_sum_f(s[r]) * (1.0f / DM) + RMS_EPS);
            const float* sh = mod + (size_t)b * 3072; const float* sc = sh + 1024;
            u32x2_t* o = (u32x2_t*)(a0 + (size_t)m * DM) + lane;
#pragma unroll
            for (int j = 0; j < 4; ++j) { const int c = 256 * j + 4 * lane;
                const f32x4_t g = *(const f32x4_t*)(g_pre + c), scv = *(const f32x4_t*)(sc + c), shv = *(const f32x4_t*)(sh + c);
                const f32x4_t y = v[r][j] * rr * g * (scv + 1.0f) + shv;
                u32x2_t w; w.x = pk2bf(y.x, y.y); w.y = pk2bf(y.z, y.w); o[64 * j] = w; } }
    }
}
__device__ __forceinline__ void e_mid_r(const float* __restrict__ x, const bf16_t* __restrict__ yo, const float* __restrict__ mod, const float* __restrict__ g_post, const float* __restrict__ g_pre,
                                        float* h1, bf16_t* akv, bf16_t* ain1, int gw, int ngw, int lane) {
    for (int m0 = gw; m0 < MTOK; m0 += ER * ngw) {
        f32x4_t v[ER][4], y[ER][4]; float s[ER];
#pragma unroll
        for (int r = 0; r < ER; ++r) { const int m = min(m0 + r * ngw, MTOK - 1); const f32x4_t* xr = (const f32x4_t*)(x + (size_t)m * DM) + lane; const u32x2_t* yr = (const u32x2_t*)(yo + (size_t)m * DM) + lane;
#pragma unroll
            for (int j = 0; j < 4; ++j) { v[r][j] = NT_LD(xr + 64 * j); unpk4(NT_LD(yr + 64 * j), y[r][j]); } }
#pragma unroll
        for (int r = 0; r < ER; ++r) { s[r] = 0.f;
#pragma unroll
            for (int j = 0; j < 4; ++j) s[r] += ssq4(y[r][j]); }
#pragma unroll
        for (int r = 0; r < ER; ++r) { const int m = m0 + r * ngw; if (m >= MTOK) break;
            const int b = m / SEQL; const float ry = rsqrtf(wave_sum_f(s[r]) * (1.0f / DM) + RMS_EPS);
            const float* gate0 = mod + (size_t)b * 3072 + 2048; const float* sh1 = mod + (size_t)(8 + b) * 3072; const float* sc1 = sh1 + 1024;
            float s2 = 0.f; f32x4_t* ho = (f32x4_t*)(h1 + (size_t)m * DM) + lane;
#pragma unroll
            for (int j = 0; j < 4; ++j) { const int c = 256 * j + 4 * lane;
                const f32x4_t gp = *(const f32x4_t*)(g_post + c), gt = *(const f32x4_t*)(gate0 + c);
                v[r][j] = v[r][j] + gt * (y[r][j] * ry * gp); NT_ST(ho + 64 * j, v[r][j]); s2 += ssq4(v[r][j]); }
            const float rh = rsqrtf(wave_sum_f(s2) * (1.0f / DM) + RMS_EPS);
            u32x2_t* o1 = (u32x2_t*)(akv + (size_t)m * DM) + lane; u32x2_t* o2 = (u32x2_t*)(ain1 + (size_t)m * DM) + lane;
#pragma unroll
            for (int j = 0; j < 4; ++j) { const int c = 256 * j + 4 * lane;
                const f32x4_t nn = v[r][j] * rh; u32x2_t w; w.x = pk2bf(nn.x, nn.y); w.y = pk2bf(nn.z, nn.w); o1[64 * j] = w;
                const f32x4_t g = *(const f32x4_t*)(g_pre + 1024 + c), scv = *(const f32x4_t*)(sc1 + c), shv = *(const f32x4_t*)(sh1 + c);
                const f32x4_t z = nn * g * (scv + 1.0f) + shv; w.x = pk2bf(z.x, z.y); w.y = pk2bf(z.z, z.w); o2[64 * j] = w; } }
    }
}
__device__ __forceinline__ void e_final_r(float* out, const bf16_t* __restrict__ yo1, const float* __restrict__ mod, const float* __restrict__ g_post, int gw, int ngw, int lane) {
    for (int m0 = gw; m0 < MTOK; m0 += ER * ngw) {
        f32x4_t v[ER][4], y[ER][4]; float s[ER];
#pragma unroll
        for (int r = 0; r < ER; ++r) { const int m = min(m0 + r * ngw, MTOK - 1); const f32x4_t* hr = (const f32x4_t*)(out + (size_t)m * DM) + lane; const u32x2_t* yr = (const u32x2_t*)(yo1 + (size_t)m * DM) + lane;
#pragma unroll
            for (int j = 0; j < 4; ++j) { v[r][j] = NT_LD(hr + 64 * j); unpk4(NT_LD(yr + 64 * j), y[r][j]); } }
#pragma unroll
        for (int r = 0; r < ER; ++r) { s[r] = 0.f;
#pragma unroll
            for (int j = 0; j < 4; ++j) s[r] += ssq4(y[r][j]); }
#pragma unroll
        for (int r = 0; r < ER; ++r) { const int m = m0 + r * ngw; if (m >= MTOK) break;
            const int b = m / SEQL; const float ry = rsqrtf(wave_sum_f(s[r]) * (1.0f / DM) + RMS_EPS);
            const float* gate1 = mod + (size_t)(8 + b) * 3072 + 2048; f32x4_t* hr = (f32x4_t*)(out + (size_t)m * DM) + lane;
#pragma unroll
            for (int j = 0; j < 4; ++j) { const int c = 256 * j + 4 * lane;
                const f32x4_t gp = *(const f32x4_t*)(g_post + 1024 + c), gt = *(const f32x4_t*)(gate1 + c);
                NT_ST(hr + 64 * j, v[r][j] + gt * (y[r][j] * ry * gp)); } }
    }
}

__device__ __forceinline__ void unpk4b(const u32x2_t w, f32x4_t& y) { y.x = __uint_as_float(w.x << 16); y.y = __uint_as_float(w.x & 0xffff0000u); y.z = __uint_as_float(w.y << 16); y.w = __uint_as_float(w.y & 0xffff0000u); }
__device__ __forceinline__ float ssq4b(const f32x4_t v) { return (v.x * v.x + v.y * v.y) + (v.z * v.z + v.w * v.w); }
__device__ __forceinline__ void e_norm0_b(const float* __restrict__ x, const float* __restrict__ mod, const float* __restrict__ g_pre, bf16_t* a0, int gw, int ngw, int lane, int b_lo = 0, int b_hi = NB) {
    for (int b = b_lo; b < b_hi; ++b) {
        const float* sh = mod + (size_t)b * 3072; const float* sc = sh + 1024;
        f32x4_t G[4], SH[4];
#pragma unroll
        for (int j = 0; j < 4; ++j) { const int c = 256 * j + 4 * lane; G[j] = *(const f32x4_t*)(g_pre + c) * (*(const f32x4_t*)(sc + c) + 1.0f); SH[j] = *(const f32x4_t*)(sh + c); }
        for (int r0 = gw; r0 < SEQL; r0 += 2 * ngw) {
            const int ra = r0, rb = r0 + ngw; const bool hb = rb < SEQL;
            const int ma = b * SEQL + ra, mb = b * SEQL + (hb ? rb : ra);
            f32x4_t va[4], vb[4];
            const f32x4_t* xa = (const f32x4_t*)(x + (size_t)ma * DM) + lane; const f32x4_t* xb = (const f32x4_t*)(x + (size_t)mb * DM) + lane;
#pragma unroll
            for (int j = 0; j < 4; ++j) { va[j] = NT_LD(xa + 64 * j); vb[j] = NT_LD(xb + 64 * j); }
            float sa = 0.f, sb = 0.f;
#pragma unroll
            for (int j = 0; j < 4; ++j) { sa += ssq4b(va[j]); sb += ssq4b(vb[j]); }
            const float rra = rsqrtf(wave_sum_f(sa) * (1.0f / DM) + RMS_EPS), rrb = rsqrtf(wave_sum_f(sb) * (1.0f / DM) + RMS_EPS);
            u32x2_t* oa = (u32x2_t*)(a0 + (size_t)ma * DM) + lane; u32x2_t* ob = (u32x2_t*)(a0 + (size_t)mb * DM) + lane;
#pragma unroll
            for (int j = 0; j < 4; ++j) { const f32x4_t y = va[j] * rra * G[j] + SH[j]; u32x2_t w; w.x = pk2bf(y.x, y.y); w.y = pk2bf(y.z, y.w); oa[64 * j] = w; }
            if (hb) {
#pragma unroll
                for (int j = 0; j < 4; ++j) { const f32x4_t y = vb[j] * rrb * G[j] + SH[j]; u32x2_t w; w.x = pk2bf(y.x, y.y); w.y = pk2bf(y.z, y.w); ob[64 * j] = w; } }
        }
    }
}
__device__ __forceinline__ void e_mid_b(const float* __restrict__ x, const bf16_t* __restrict__ yo, const float* __restrict__ mod, const float* __restrict__ g_post, const float* __restrict__ g_pre,
                                        float* h1, bf16_t* akv, bf16_t* ain1, int gw, int ngw, int lane, float* hnorm = nullptr, int b_lo = 0, int b_hi = NB) {
    for (int b = b_lo; b < b_hi; ++b) {
        const float* gate0 = mod + (size_t)b * 3072 + 2048; const float* sh1 = mod + (size_t)(8 + b) * 3072; const float* sc1 = sh1 + 1024;
        f32x4_t GG[4], GF[4], SH[4];
#pragma unroll
        for (int j = 0; j < 4; ++j) { const int c = 256 * j + 4 * lane; GG[j] = *(const f32x4_t*)(gate0 + c) * *(const f32x4_t*)(g_post + c);
            GF[j] = *(const f32x4_t*)(g_pre + 1024 + c) * (*(const f32x4_t*)(sc1 + c) + 1.0f); SH[j] = *(const f32x4_t*)(sh1 + c); }
        for (int r0 = gw; r0 < SEQL; r0 += 2 * ngw) {
            const int ra = r0, rb = r0 + ngw; const bool hb = rb < SEQL;
            const int mr[2] = {b * SEQL + ra, b * SEQL + (hb ? rb : ra)};
            f32x4_t v[2][4], y[2][4];
#pragma unroll
            for (int q = 0; q < 2; ++q) { const f32x4_t* xr = (const f32x4_t*)(x + (size_t)mr[q] * DM) + lane; const u32x2_t* yr = (const u32x2_t*)(yo + (size_t)mr[q] * DM) + lane;
#pragma unroll
                for (int j = 0; j < 4; ++j) { v[q][j] = NT_LD(xr + 64 * j); unpk4b(NT_LD(yr + 64 * j), y[q][j]); } }
            float s[2] = {0.f, 0.f};
#pragma unroll
            for (int q = 0; q < 2; ++q)
#pragma unroll
                for (int j = 0; j < 4; ++j) s[q] += ssq4b(y[q][j]);
            float ry[2]; ry[0] = rsqrtf(wave_sum_f(s[0]) * (1.0f / DM) + RMS_EPS); ry[1] = rsqrtf(wave_sum_f(s[1]) * (1.0f / DM) + RMS_EPS);
            float s2[2] = {0.f, 0.f};
#pragma unroll
            for (int q = 0; q < 2; ++q)
#pragma unroll
                for (int j = 0; j < 4; ++j) { v[q][j] = v[q][j] + GG[j] * (y[q][j] * ry[q]); s2[q] += ssq4b(v[q][j]); }
            float rh[2]; rh[0] = rsqrtf(wave_sum_f(s2[0]) * (1.0f / DM) + RMS_EPS); rh[1] = rsqrtf(wave_sum_f(s2[1]) * (1.0f / DM) + RMS_EPS);
            if (hnorm && lane == 0) { hnorm[mr[0]] = 1.0f / rh[0]; if (hb) hnorm[mr[1]] = 1.0f / rh[1]; }
#pragma unroll
            for (int q = 0; q < 2; ++q) { if (q == 1 && !hb) break;
                f32x4_t* ho = (f32x4_t*)(h1 + (size_t)mr[q] * DM) + lane; u32x2_t* o1 = (u32x2_t*)(akv + (size_t)mr[q] * DM) + lane; u32x2_t* o2 = (u32x2_t*)(ain1 + (size_t)mr[q] * DM) + lane;
#pragma unroll
                for (int j = 0; j < 4; ++j) { if (h1) NT_ST(ho + 64 * j, v[q][j]);
                    const f32x4_t nn = v[q][j] * rh[q]; u32x2_t w; w.x = pk2bf(nn.x, nn.y); w.y = pk2bf(nn.z, nn.w); o1[64 * j] = w;
                    const f32x4_t z = nn * GF[j] + SH[j]; w.x = pk2bf(z.x, z.y); w.y = pk2bf(z.z, z.w); o2[64 * j] = w; } }
        }
    }
}
__device__ __forceinline__ void e_final_bm(float* out, const bf16_t* __restrict__ yo1, const float* __restrict__ mod, const float* __restrict__ g_post, int gw, int ngw, int lane) {
    for (int b = 0; b < NB; ++b) {
        const float* gate1 = mod + (size_t)(8 + b) * 3072 + 2048;
        f32x4_t GG[4];
#pragma unroll
        for (int j = 0; j < 4; ++j) { const int c = 256 * j + 4 * lane; GG[j] = *(const f32x4_t*)(gate1 + c) * *(const f32x4_t*)(g_post + 1024 + c); }
        for (int r0 = gw; r0 < SEQL; r0 += 2 * ngw) {
            const int ra = r0, rb = r0 + ngw; const bool hb = rb < SEQL;
            const int mr[2] = {b * SEQL + ra, b * SEQL + (hb ? rb : ra)};
            f32x4_t v[2][4], y[2][4];
#pragma unroll
            for (int q = 0; q < 2; ++q) { const f32x4_t* hr = (const f32x4_t*)(out + (size_t)mr[q] * DM) + lane; const u32x2_t* yr = (const u32x2_t*)(yo1 + (size_t)mr[q] * DM) + lane;
#pragma unroll
                for (int j = 0; j < 4; ++j) { v[q][j] = NT_LD(hr + 64 * j); unpk4b(NT_LD(yr + 64 * j), y[q][j]); } }
            float s[2] = {0.f, 0.f};
#pragma unroll
            for (int q = 0; q < 2; ++q)
#pragma unroll
                for (int j = 0; j < 4; ++j) s[q] += ssq4b(y[q][j]);
            float ry[2]; ry[0] = rsqrtf(wave_sum_f(s[0]) * (1.0f / DM) + RMS_EPS); ry[1] = rsqrtf(wave_sum_f(s[1]) * (1.0f / DM) + RMS_EPS);
#pragma unroll
            for (int q = 0; q < 2; ++q) { if (q == 1 && !hb) break;
                f32x4_t* hr = (f32x4_t*)(out + (size_t)mr[q] * DM) + lane;
#pragma unroll
                for (int j = 0; j < 4; ++j) NT_ST(hr + 64 * j, v[q][j] + GG[j] * (y[q][j] * ry[q])); }
        }
    }
}
__device__ __forceinline__ void e_final_x(const float* __restrict__ x, const bf16_t* __restrict__ yo, const bf16_t* __restrict__ yo1, float* out, const float* __restrict__ mod, const float* __restrict__ g_post, int gw, int ngw, int lane) {
    for (int b = 0; b < NB; ++b) {
        const float* gate0 = mod + (size_t)b * 3072 + 2048; const float* gate1 = mod + (size_t)(8 + b) * 3072 + 2048;
        f32x4_t G0[4], G1[4];
#pragma unroll
        for (int j = 0; j < 4; ++j) { const int c = 256 * j + 4 * lane; G0[j] = *(const f32x4_t*)(gate0 + c) * *(const f32x4_t*)(g_post + c); G1[j] = *(const f32x4_t*)(gate1 + c) * *(const f32x4_t*)(g_post + 1024 + c); }
        for (int r0 = gw; r0 < SEQL; r0 += 2 * ngw) {
            const int ra = r0, rb = r0 + ngw; const bool hb = rb < SEQL;
            const int mr[2] = {b * SEQL + ra, b * SEQL + (hb ? rb : ra)};
            f32x4_t v[2][4], y0[2][4], y1[2][4];
#pragma unroll
            for (int q = 0; q < 2; ++q) { const f32x4_t* xr = (const f32x4_t*)(x + (size_t)mr[q] * DM) + lane; const u32x2_t* ar = (const u32x2_t*)(yo + (size_t)mr[q] * DM) + lane; const u32x2_t* br = (const u32x2_t*)(yo1 + (size_t)mr[q] * DM) + lane;
#pragma unroll
                for (int j = 0; j < 4; ++j) { v[q][j] = NT_LD(xr + 64 * j); unpk4b(NT_LD(ar + 64 * j), y0[q][j]); unpk4b(NT_LD(br + 64 * j), y1[q][j]); } }
            float s0[2] = {0.f, 0.f}, s1[2] = {0.f, 0.f};
#pragma unroll
            for (int q = 0; q < 2; ++q)
#pragma unroll
                for (int j = 0; j < 4; ++j) { s0[q] += ssq4b(y0[q][j]); s1[q] += ssq4b(y1[q][j]); }
            float r0_[2], r1_[2];
#pragma unroll
            for (int q = 0; q < 2; ++q) { r0_[q] = rsqrtf(wave_sum_f(s0[q]) * (1.0f / DM) + RMS_EPS); r1_[q] = rsqrtf(wave_sum_f(s1[q]) * (1.0f / DM) + RMS_EPS); }
#pragma unroll
            for (int q = 0; q < 2; ++q) { if (q == 1 && !hb) break;
                f32x4_t* orow = (f32x4_t*)(out + (size_t)mr[q] * DM) + lane;
#pragma unroll
                for (int j = 0; j < 4; ++j) { const f32x4_t h = v[q][j] + G0[j] * (y0[q][j] * r0_[q]); NT_ST(orow + 64 * j, h + G1[j] * (y1[q][j] * r1_[q])); } }
        }
    }
}
__device__ __forceinline__ void e_final_k(const bf16_t* __restrict__ akv, const float* __restrict__ hnorm, const bf16_t* __restrict__ yo1, float* out, const float* __restrict__ mod, const float* __restrict__ g_post, int gw, int ngw, int lane, int b_lo = 0, int b_hi = NB) {
    for (int b = b_lo; b < b_hi; ++b) {
        const float* gate1 = mod + (size_t)(8 + b) * 3072 + 2048;
        f32x4_t G1[4];
#pragma unroll
        for (int j = 0; j < 4; ++j) { const int c = 256 * j + 4 * lane; G1[j] = *(const f32x4_t*)(gate1 + c) * *(const f32x4_t*)(g_post + 1024 + c); }
        for (int r0 = gw; r0 < SEQL; r0 += 2 * ngw) {
            const int ra = r0, rb = r0 + ngw; const bool hb = rb < SEQL;
            const int mr[2] = {b * SEQL + ra, b * SEQL + (hb ? rb : ra)};
            f32x4_t v[2][4], y1[2][4]; float hn[2];
#pragma unroll
            for (int q = 0; q < 2; ++q) { const u32x2_t* ar = (const u32x2_t*)(akv + (size_t)mr[q] * DM) + lane; const u32x2_t* br = (const u32x2_t*)(yo1 + (size_t)mr[q] * DM) + lane; hn[q] = hnorm[mr[q]];
#pragma unroll
                for (int j = 0; j < 4; ++j) { unpk4b(NT_LD(ar + 64 * j), v[q][j]); unpk4b(NT_LD(br + 64 * j), y1[q][j]); } }
            float s1[2] = {0.f, 0.f};
#pragma unroll
            for (int q = 0; q < 2; ++q)
#pragma unroll
                for (int j = 0; j < 4; ++j) s1[q] += ssq4b(y1[q][j]);
            float r1_[2];
#pragma unroll
            for (int q = 0; q < 2; ++q) r1_[q] = rsqrtf(wave_sum_f(s1[q]) * (1.0f / DM) + RMS_EPS);
#pragma unroll
            for (int q = 0; q < 2; ++q) { if (q == 1 && !hb) break;
                f32x4_t* orow = (f32x4_t*)(out + (size_t)mr[q] * DM) + lane;
#pragma unroll
                for (int j = 0; j < 4; ++j) NT_ST(orow + 64 * j, v[q][j] * hn[q] + G1[j] * (y1[q][j] * r1_[q])); }
        }
    }
}
__device__ __forceinline__ float diff_lambda(const float* lq1, const float* lk1, const float* lq2, const float* lk2) {
    float s1 = 0.f, s2 = 0.f;
    for (int i = 0; i < 64; ++i) { s1 += lq1[i] * lk1[i]; s2 += lq2[i] * lk2[i]; }
    return expf(s1) - expf(s2) + LAMBDA_INIT;
}

__global__ void n_adaln(const float* __restrict__ c, const float* __restrict__ ada_w, const float* __restrict__ ada_b, float* mod) {
    const int idx = blockIdx.x * 256 + threadIdx.x;
    if (idx >= 2 * 8 * 3072) return;
    const int j = idx % 3072, b = (idx / 3072) % 8, l = idx / (3072 * 8);
    float acc = ada_b[l * 3072 + j];
    const float* w = ada_w + (size_t)l * 1024 * 3072 + j; const float* cb = c + b * 1024;
    for (int k = 0; k < 1024; ++k) acc += silu_f(cb[k]) * w[(size_t)k * 3072];
    mod[idx] = acc;
}
__global__ void n_lambda(const float* lq1, const float* lk1, const float* lq2, const float* lk2, float* out) {
    if (threadIdx.x == 0 && blockIdx.x == 0) out[0] = diff_lambda(lq1, lk1, lq2, lk2);
}
__global__ void n_norm0(const float* x, const float* mod, const float* g_pre, bf16_t* a0) {
    e_norm0(x, mod, g_pre, a0, blockIdx.x * 4 + (threadIdx.x >> 6), gridDim.x * 4, threadIdx.x & 63);
}
__global__ void n_mid(const float* x, const bf16_t* yo, const float* mod, const float* g_post, const float* g_pre, float* h1, bf16_t* akv, bf16_t* ain1) {
    e_mid(x, yo, mod, g_post, g_pre, h1, (bf16_t*)nullptr, akv, ain1, blockIdx.x * 4 + (threadIdx.x >> 6), gridDim.x * 4, threadIdx.x & 63);
}
__global__ void n_attn_post(const bf16_t* o0, const bf16_t* o1, const bf16_t* sz1, const float* g_sub, const float* lamp, bf16_t* og) {
    e_attn_post(o0, o1, sz1, g_sub, lamp[0], og, blockIdx.x * 4 + (threadIdx.x >> 6), gridDim.x * 4, threadIdx.x & 63);
}
__global__ void n_final(float* out, const bf16_t* yo1, const float* mod, const float* g_post) {
    e_final(out, yo1, mod, g_post, blockIdx.x * 4 + (threadIdx.x >> 6), gridDim.x * 4, threadIdx.x & 63);
}

struct AL_Row { const bf16_t* A; __device__ float ld(int m, int k) const { return bf2f(A[(size_t)m * DM + k]); } };
struct AL_YG  { const bf16_t* A; __device__ float ld(int m, int k) const { return bf2f(A[yg_off(k >> 4, m >> 4, (m & 15) * 16 + (k & 15))]); } };
struct WL_Plain { const float* W; long N; __device__ float ld(int k, int n) const { return W[(size_t)k * N + n]; } };
struct WL_KV { const float* wk; const float* wv; const float* g; __device__ float ld(int k, int n) const { return g[k] * (n < 1024 ? wk[(size_t)k * 1024 + n] : wv[(size_t)k * 1024 + n - 1024]); } };
struct EP_In0 { bf16_t* US; bf16_t* SZ; __device__ void st(int m, int n, float a) const {
    if (n < 1024) US[us_off(n >> 4, m >> 4, (m & 15) * 16 + (n & 15))] = f2bf(a); else SZ[(size_t)m * DM + n - 1024] = f2bf(silu_f(a)); } };
struct EP_Glu { const bf16_t* YG; const bf16_t* SZ; const float* bias; bf16_t* Y2; __device__ void st(int m, int n, float a) const {
    const float yv = bf2f(YG[yg_off(n >> 4, m >> 4, (m & 15) * 16 + (n & 15))]); const float t = a + bias[n];
    Y2[(size_t)m * DM + n] = f2bf(yv * sigmoid_f(t) * bf2f(SZ[(size_t)m * DM + n])); } };
struct EP_Plain { bf16_t* O; __device__ void st(int m, int n, float a) const { O[(size_t)m * DM + n] = f2bf(a); } };
struct EP_KV { bf16_t* K; bf16_t* V; __device__ void st(int m, int n, float a) const { if (n < 1024) K[(size_t)m * DM + n] = f2bf(a); else V[(size_t)m * DM + n - 1024] = f2bf(a); } };
struct EP_In1 { bf16_t* Q; bf16_t* SZ1; __device__ void st(int m, int n, float a) const { if (n < 1024) Q[(size_t)m * DM + n] = f2bf(a * QC2); else SZ1[(size_t)m * DM + n - 1024] = f2bf(silu_f(a)); } };

template <class AL, class WL, class EP>
__global__ void __launch_bounds__(256) n_gemm(AL al, WL wl, EP ep, int N) {
    __shared__ float As[16][68]; __shared__ float Ws[16][68];
    const int tid = threadIdx.x, tx = tid & 15, ty = tid >> 4;
    const int m0 = blockIdx.y * 64, n0 = blockIdx.x * 64;
    float acc[4][4];
#pragma unroll
    for (int i = 0; i < 4; ++i)
#pragma unroll
        for (int j = 0; j < 4; ++j) acc[i][j] = 0.f;
    for (int k0 = 0; k0 < 1024; k0 += 16) {
#pragma unroll
        for (int i = 0; i < 4; ++i) { const int e = tid + 256 * i; const int mm = e >> 4, kk = e & 15; As[kk][mm] = al.ld(m0 + mm, k0 + kk); }
#pragma unroll
        for (int i = 0; i < 4; ++i) { const int e = tid + 256 * i; const int kk = e >> 6, nn = e & 63; Ws[kk][nn] = wl.ld(k0 + kk, n0 + nn); }
        __syncthreads();
#pragma unroll
        for (int kk = 0; kk < 16; ++kk) {
            float a[4], b[4];
#pragma unroll
            for (int i = 0; i < 4; ++i) { a[i] = As[kk][ty * 4 + i]; b[i] = Ws[kk][tx * 4 + i]; }
#pragma unroll
            for (int i = 0; i < 4; ++i)
#pragma unroll
                for (int j = 0; j < 4; ++j) acc[i][j] += a[i] * b[j];
        }
        __syncthreads();
    }
#pragma unroll
    for (int i = 0; i < 4; ++i)
#pragma unroll
        for (int j = 0; j < 4; ++j) ep.st(m0 + ty * 4 + i, n0 + tx * 4 + j, acc[i][j]);
}

__global__ void __launch_bounds__(256) n_ssm(const bf16_t* __restrict__ US, const float* lam_re, const float* lam_im, const float* log_dt, const float* b_re, const float* b_im,
                                             const float* c_re, const float* c_im, const float* d_skip, bf16_t* YG) {
    const int wv = blockIdx.x * 4 + (threadIdx.x >> 6), lane = threadIdx.x & 63;
    if (wv >= NB * NGRP) return;
    const int b = wv / NGRP, g = wv % NGRP, p = lane;
    const float dt = expf(log_dt[g]);
    const float lr = lam_re[g * 64 + p], li = lam_im[g * 64 + p];
    const float mag = expf(lr * dt); float sn, cs; sn = sinf(li * dt); cs = cosf(li * dt);
    const float lbr = mag * cs, lbi = mag * sn;
    const float nr = lbr - 1.0f, ni = lbi, den = lr * lr + li * li;
    const float cr = (nr * lr + ni * li) / den, ci = (ni * lr - nr * li) / den;
    float bbr[16], bbi[16], ccr[16], cci[16];
#pragma unroll
    for (int c = 0; c < 16; ++c) { const float br = b_re[(g * 64 + p) * 16 + c], bi = b_im[(g * 64 + p) * 16 + c];
        bbr[c] = cr * br - ci * bi; bbi[c] = cr * bi + ci * br;
        ccr[c] = c_re[(g * 16 + c) * 64 + p]; cci[c] = c_im[(g * 16 + c) * 64 + p]; }
    const float dsk = d_skip[g * 16 + (lane & 15)];
    float sr = 0.f, si = 0.f;
    for (int t = 0; t < SEQL; ++t) {
        const int m = b * SEQL + t;
        const bf16_t* up = US + us_off(g, m >> 4, (m & 15) * 16);
        float u[16];
        { const u32x4_t w0 = *(const u32x4_t*)up, w1 = *(const u32x4_t*)(up + 8);
#pragma unroll
          for (int i = 0; i < 4; ++i) { u[2 * i] = __uint_as_float(w0[i] << 16); u[2 * i + 1] = __uint_as_float(w0[i] & 0xffff0000u); u[8 + 2 * i] = __uint_as_float(w1[i] << 16); u[8 + 2 * i + 1] = __uint_as_float(w1[i] & 0xffff0000u); } }
        float bur = 0.f, bui = 0.f;
#pragma unroll
        for (int c = 0; c < 16; ++c) { bur += bbr[c] * u[c]; bui += bbi[c] * u[c]; }
        const float nsr = lbr * sr - lbi * si + bur, nsi = lbr * si + lbi * sr + bui; sr = nsr; si = nsi;
        float yv = 0.f;
#pragma unroll
        for (int c = 0; c < 16; ++c) { const float part = wave_sum_f(ccr[c] * sr - cci[c] * si); if ((lane & 15) == c) yv = part; }
        if (lane < 16) { const float yy = yv + dsk * bf2f(up[lane]); YG[yg_off(g, m >> 4, (m & 15) * 16 + lane)] = f2bf(gelu_tanh_f(yy)); }
    }
}

__global__ void __launch_bounds__(256) n_attn(const bf16_t* __restrict__ Q, const bf16_t* __restrict__ K, const bf16_t* __restrict__ V, bf16_t* O0, bf16_t* O1) {
    __shared__ float qs[4][128];
    const int w = threadIdx.x >> 6, lane = threadIdx.x & 63;
    const int gwv = blockIdx.x * 4 + w;
    const int h = gwv & 7, m = gwv >> 3, b = m / SEQL, qi = m % SEQL;
    qs[w][lane] = bf2f(Q[(size_t)m * DM + h * 128 + lane]); qs[w][64 + lane] = bf2f(Q[(size_t)m * DM + h * 128 + 64 + lane]);
    __syncthreads();
    float m0 = -1e30f, m1 = -1e30f, l0 = 0.f, l1 = 0.f, a00 = 0.f, a01 = 0.f, a10 = 0.f, a11 = 0.f;
    const size_t rb = (size_t)b * SEQL;
    for (int kc = 0; kc * 64 <= qi; ++kc) {
        const int key = kc * 64 + lane; const bool valid = key <= qi;
        float s0 = 0.f, s1 = 0.f;
        { const bf16_t* kr = K + (rb + (valid ? key : qi)) * DM + h * 128;
#pragma unroll
          for (int ch = 0; ch < 8; ++ch) { const u32x4_t w0 = *(const u32x4_t*)(kr + ch * 8), w1 = *(const u32x4_t*)(kr + 64 + ch * 8);
#pragma unroll
            for (int i = 0; i < 4; ++i) { s0 += qs[w][ch * 8 + 2 * i] * __uint_as_float(w0[i] << 16) + qs[w][ch * 8 + 2 * i + 1] * __uint_as_float(w0[i] & 0xffff0000u);
                                          s1 += qs[w][64 + ch * 8 + 2 * i] * __uint_as_float(w1[i] << 16) + qs[w][64 + ch * 8 + 2 * i + 1] * __uint_as_float(w1[i] & 0xffff0000u); } } }
        if (!valid) { s0 = -1e30f; s1 = -1e30f; }
        const float nm0 = fmaxf(m0, wave_max_f(s0)), nm1 = fmaxf(m1, wave_max_f(s1));
        const float f0 = exp2f(m0 - nm0), f1 = exp2f(m1 - nm1);
        const float p0 = valid ? exp2f(s0 - nm0) : 0.f, p1 = valid ? exp2f(s1 - nm1) : 0.f;
        l0 = l0 * f0 + wave_sum_f(p0); l1 = l1 * f1 + wave_sum_f(p1); m0 = nm0; m1 = nm1;
        a00 *= f0; a01 *= f0; a10 *= f1; a11 *= f1;
        const int nk = min(64, qi - kc * 64 + 1);
        for (int j = 0; j < nk; ++j) {
            const float pj0 = __shfl(p0, j), pj1 = __shfl(p1, j);
            const bf16_t* vr = V + (rb + kc * 64 + j) * DM + h * 128;
            const float v0 = bf2f(vr[lane]), v1 = bf2f(vr[64 + lane]);
            a00 += pj0 * v0; a01 += pj0 * v1; a10 += pj1 * v0; a11 += pj1 * v1;
        }
    }
    const float i0 = 1.0f / l0, i1 = 1.0f / l1;
    O0[(size_t)m * DM + h * 128 + lane] = f2bf(a00 * i0); O0[(size_t)m * DM + h * 128 + 64 + lane] = f2bf(a01 * i0);
    O1[(size_t)m * DM + h * 128 + lane] = f2bf(a10 * i1); O1[(size_t)m * DM + h * 128 + 64 + lane] = f2bf(a11 * i1);
}
#ifndef REPEAT_MASK
#define REPEAT_MASK 0
#endif
#ifndef ATTN_V128
#define ATTN_V128 1
#endif
#ifndef EXTRA_PHASE
#define EXTRA_PHASE -1
#endif
#ifndef ATTN_FUSE_POST
#define ATTN_FUSE_POST 1
#endif
#ifndef H1_RECOMP
#define H1_RECOMP 1
#endif
#ifndef SSM_FUSED
#define SSM_FUSED 1
#endif
#ifndef ATTN_PRIO
#define ATTN_PRIO 0
#endif
#ifndef H1_BF16
#define H1_BF16 0
#endif
#ifndef H1_AKV
#define H1_AKV 1
#endif
#ifndef SSM_DFOLD
#define SSM_DFOLD 1
#endif
#ifndef CLK_PROBE
#define CLK_PROBE 0
#endif
#ifndef CLK_MODE
#define CLK_MODE 0
#endif
#ifndef ATTN_DSKIP
#define ATTN_DSKIP 1
#endif
#ifndef ATTN_LAZY
#define ATTN_LAZY 1
#endif
#ifndef XCC_LOCAL
#define XCC_LOCAL 1
#endif
#ifndef NT_OUT
#define NT_OUT 0
#endif
#if NT_OUT
#define ST_OUT(p, v) __builtin_nontemporal_store((v), (p))
#else
#define ST_OUT(p, v) (*(p) = (v))
#endif
#ifndef FUSE_EPI
#define FUSE_EPI 0
#endif
#ifndef ALIGN_E
#define ALIGN_E true
#endif
namespace pg8 {
#define PG8_LAS __attribute__((address_space(3)))
typedef short bf16x8 __attribute__((ext_vector_type(8)));
typedef float f32x4 __attribute__((ext_vector_type(4)));
typedef unsigned u32x4 __attribute__((ext_vector_type(4)));
constexpr int BM = 256, BK = 64, HALF = 128, HTB = HALF * BK * 2  , STAGE_BYTES = 8 * HTB, NXCD = 8, WGM = 8;

__host__ __device__ __forceinline__ int lds_byte(int r, int c) { const int st = (r >> 4) * 2 + (c >> 5), rr = r & 15, cc = c & 31, ob = rr * 64 + cc * 2; return st * 1024 + (ob ^ (((ob >> 9) & 1) << 5)); }
__host__ __device__ __forceinline__ void stage_rc(int b, int& R, int& C) { const int st = b / 1024, sb = b % 1024, swz = sb ^ (((sb >> 9) & 1) << 5); R = (st >> 1) * 16 + swz / 64; C = (st & 1) * 32 + (swz % 64) / 2; }
__host__ __device__ __forceinline__ int perm32(int rho) { const int n = rho >> 4, i = rho & 15; return 8 * (i >> 2) + 4 * n + (i & 3); }

struct Unit { int pm, pn, grp; };
struct Gemm {
    const char* A; const char* Bt; int nt, pad0;
    unsigned a_rs, a_c16; size_t a_kstep, a_tstep, a_gstep;
    unsigned b_rs, pad1; size_t b_tstep, b_gstep;
    __device__ __forceinline__ const char* abase(const Unit& u) const { return A + (size_t)u.grp * a_gstep + (size_t)u.pm * a_tstep; }
    __device__ __forceinline__ const char* bbase(const Unit& u) const { return Bt + (size_t)u.grp * b_gstep + (size_t)u.pn * b_tstep; }
};
__device__ __forceinline__ Gemm gemm_std(const void* A, int lda, const void* Bt, int ldb, int K) {
    Gemm g; g.A = (const char*)A; g.Bt = (const char*)Bt; g.nt = K / BK; g.pad0 = 0; g.a_rs = (unsigned)lda * 2u; g.a_c16 = 32u; g.a_kstep = BK * 2; g.a_tstep = (size_t)BM * lda * 2; g.a_gstep = 0;
    g.b_rs = (unsigned)ldb * 2u; g.pad1 = 0; g.b_tstep = (size_t)BM * ldb * 2; g.b_gstep = 0; return g;
}

struct Order {
    int nM, nN, nG, nwg, G, c, only, pm_off, mode2;
    __device__ __forceinline__ void init(int nM_, int nN_, int nG_, int G_, int c_) { nM = nM_; nN = nN_; nG = nG_; nwg = nM * nN * nG; G = G_; c = c_; only = -1; pm_off = 0; mode2 = 0; }
    __device__ __forceinline__ bool next(int i, Unit& u) const {
        if (only >= 0) { if (i > 0) return false; i = only; }
        const long L = (long)i * G + c; if (L >= nwg) return false;
        int wgid = (int)L; { const int q = nwg / NXCD, r = nwg % NXCD, xcd = wgid % NXCD, off = wgid / NXCD; wgid = (xcd < r ? xcd * (q + 1) : r * (q + 1) + (xcd - r) * q) + off; }
        if (mode2) {
            const int x = wgid >> 8, y = wgid & 255, bk = y >> 6, w2 = y & 63; u.grp = bk & 1; u.pm = (x * 2 + (bk >> 1)) * 8 + (w2 & 7); u.pn = w2 >> 3;
        } else
        { const int per = nM * nN; u.grp = wgid / per; const int w2 = wgid % per;
          const int nig = WGM * nN, gid = w2 / nig, fm = gid * WGM, gsz = (nM - fm) < WGM ? (nM - fm) : WGM;
          u.pm = pm_off + fm + ((w2 % nig) % gsz); u.pn = (w2 % nig) / gsz; }
        return true;
    }
};

__device__ __forceinline__ unsigned cvt_pk_bf16(float lo, float hi) { unsigned r; asm volatile("v_cvt_pk_bf16_f32 %0, %1, %2" : "=v"(r) : "v"(lo), "v"(hi)); return r; }
__device__ __forceinline__ u32x4 pack8(const f32x4 a, const f32x4 b) { u32x4 w; w.x = cvt_pk_bf16(a[0], a[1]); w.y = cvt_pk_bf16(a[2], a[3]); w.z = cvt_pk_bf16(b[0], b[1]); w.w = cvt_pk_bf16(b[2], b[3]); return w; }
__device__ __forceinline__ void unpack8(const u32x4 w, f32x4& a, f32x4& b) {
    a[0] = __uint_as_float(w.x << 16); a[1] = __uint_as_float(w.x & 0xffff0000u); a[2] = __uint_as_float(w.y << 16); a[3] = __uint_as_float(w.y & 0xffff0000u);
    b[0] = __uint_as_float(w.z << 16); b[1] = __uint_as_float(w.z & 0xffff0000u); b[2] = __uint_as_float(w.w << 16); b[3] = __uint_as_float(w.w & 0xffff0000u); }
__device__ __forceinline__ float fsilu(float v) { return v * __builtin_amdgcn_rcpf(1.0f + __expf(-v)); }
__device__ __forceinline__ float fsigm(float v) { return __builtin_amdgcn_rcpf(1.0f + __expf(-v)); }
__device__ __forceinline__ f32x4 silu4(f32x4 v) { f32x4 o; o[0] = fsilu(v[0]); o[1] = fsilu(v[1]); o[2] = fsilu(v[2]); o[3] = fsilu(v[3]); return o; }
__device__ __forceinline__ f32x4 sigm4(f32x4 v) { f32x4 o; o[0] = fsigm(v[0]); o[1] = fsigm(v[1]); o[2] = fsigm(v[2]); o[3] = fsigm(v[3]); return o; }
__device__ __forceinline__ float fgelu(float v) { const float u = 0.7978845608028654f * (v + 0.044715f * v * v * v); const float e = __expf(2.0f * u); return 0.5f * v * (2.0f - 2.0f * __builtin_amdgcn_rcpf(e + 1.0f)); }
__device__ __forceinline__ f32x4 gelu4(f32x4 v) { f32x4 o; o[0] = fgelu(v[0]); o[1] = fgelu(v[1]); o[2] = fgelu(v[2]); o[3] = fgelu(v[3]); return o; }

template <class F> struct EpiRow8 {
    static constexpr bool PERM = true, AFTER_DRAIN = false;
    F f;
    __device__ __forceinline__ void operator()(const f32x4 (&acc)[2][2][4][2], const Unit& u, int wr, int wc, int fr, int fq) const {
#pragma unroll
        for (int ai = 0; ai < 2; ++ai)
#pragma unroll
            for (int m = 0; m < 4; ++m) { const int row = u.pm * BM + ai * HALF + wr * 64 + m * 16 + fr;
#pragma unroll
                for (int bj = 0; bj < 2; ++bj) { const int col0 = u.pn * BM + bj * HALF + wc * 32 + 8 * fq; f.apply(u, row, col0, acc[ai][bj][m][0], acc[ai][bj][m][1]); } }
    }
};
struct F_In0 { bf16_t* US; bf16_t* SZ;
    __device__ __forceinline__ void apply(const Unit&, int row, int col0, f32x4 v0, f32x4 v1) const {
        if (col0 < 1024) ST_OUT((u32x4*)(US + us_off(col0 >> 4, row >> 4, (row & 15) * 16 + (col0 & 15))), pack8(v0, v1));
        else NT_ST((u32x4*)(SZ + (size_t)row * DM + (col0 - 1024)), pack8(silu4(v0), silu4(v1))); } };
struct F_SsmA { float* E;
    __device__ __forceinline__ void apply(const Unit& u, int row, int col0, f32x4 v0, f32x4 v1) const {
        if (col0 < 128) { float* p = E + ((size_t)u.grp * NTILE + row) * 128 + col0; *(f32x4*)p = v0; *(f32x4*)(p + 4) = v1; } } };
struct F_SsmB { const bf16_t* US; const float* dsk; bf16_t* YG;
    __device__ __forceinline__ void apply(const Unit& u, int row, int col0, f32x4 v0, f32x4 v1) const {
        const u32x4 uw = *(const u32x4*)(US + us_off(u.grp, row, col0)); f32x4 u0, u1; unpack8(uw, u0, u1);
        const float* d = dsk + u.grp * 16 + (col0 & 15); const f32x4 d0 = *(const f32x4*)d, d1 = *(const f32x4*)(d + 4);
        ST_OUT((u32x4*)(YG + yg_off(u.grp, row, col0)), pack8(gelu4(v0 + d0 * u0), gelu4(v1 + d1 * u1))); } };
struct F_SsmB0 { bf16_t* YG;
    __device__ __forceinline__ void apply(const Unit& u, int row, int col0, f32x4 v0, f32x4 v1) const {
        *(u32x4*)(YG + yg_off(u.grp, row, col0)) = pack8(gelu4(v0), gelu4(v1)); } };
struct F_Glu { const bf16_t* YG; const bf16_t* SZ; const float* bias; bf16_t* Y2;
    __device__ __forceinline__ void apply(const Unit&, int row, int col0, f32x4 v0, f32x4 v1) const {
        const u32x4 yw = *(const u32x4*)(YG + yg_off(col0 >> 4, row >> 4, (row & 15) * 16 + (col0 & 15))); f32x4 y0, y1; unpack8(yw, y0, y1);
        const u32x4 zw = NT_LD((const u32x4*)(SZ + (size_t)row * DM + col0)); f32x4 z0, z1; unpack8(zw, z0, z1);
        const f32x4 b0 = *(const f32x4*)(bias + col0), b1 = *(const f32x4*)(bias + col0 + 4);
        ST_OUT((u32x4*)(Y2 + (size_t)row * DM + col0), pack8(y0 * sigm4(v0 + b0) * z0, y1 * sigm4(v1 + b1) * z1)); } };
template <class F> struct EpiRow8L {
    static constexpr bool PERM = true, AFTER_DRAIN = false;
    F f;
    __device__ __forceinline__ void operator()(const f32x4 (&acc)[2][2][4][2], const Unit& u, int wr, int wc, int fr, int fq) const {
#pragma unroll
        for (int ai = 0; ai < 2; ++ai) {
            typename F::Pre pre[4][2];
#pragma unroll
            for (int m = 0; m < 4; ++m) { const int row = u.pm * BM + ai * HALF + wr * 64 + m * 16 + fr;
#pragma unroll
                for (int bj = 0; bj < 2; ++bj) { const int col0 = u.pn * BM + bj * HALF + wc * 32 + 8 * fq; f.load(u, row, col0, pre[m][bj]); } }
#pragma unroll
            for (int m = 0; m < 4; ++m) { const int row = u.pm * BM + ai * HALF + wr * 64 + m * 16 + fr;
#pragma unroll
                for (int bj = 0; bj < 2; ++bj) { const int col0 = u.pn * BM + bj * HALF + wc * 32 + 8 * fq; f.apply(u, row, col0, acc[ai][bj][m][0], acc[ai][bj][m][1], pre[m][bj]); } }
        }
    }
};
struct F_SsmB2 { const bf16_t* US; const float* dsk; bf16_t* YG;
    struct Pre { u32x4 uw; };
    __device__ __forceinline__ void load(const Unit& u, int row, int col0, Pre& p) const { p.uw = *(const u32x4*)(US + us_off(u.grp, row, col0)); }
    __device__ __forceinline__ void apply(const Unit& u, int row, int col0, f32x4 v0, f32x4 v1, const Pre& p) const {
        f32x4 u0, u1; unpack8(p.uw, u0, u1);
        const float* d = dsk + u.grp * 16 + (col0 & 15); const f32x4 d0 = *(const f32x4*)d, d1 = *(const f32x4*)(d + 4);
        *(u32x4*)(YG + yg_off(u.grp, row, col0)) = pack8(gelu4(v0 + d0 * u0), gelu4(v1 + d1 * u1)); } };
struct F_Glu2 { const bf16_t* YG; const bf16_t* SZ; const float* bias; bf16_t* Y2;
    struct Pre { u32x4 yw, zw; };
    __device__ __forceinline__ void load(const Unit&, int row, int col0, Pre& p) const {
        p.yw = *(const u32x4*)(YG + yg_off(col0 >> 4, row >> 4, (row & 15) * 16 + (col0 & 15))); p.zw = *(const u32x4*)(SZ + (size_t)row * DM + col0); }
    __device__ __forceinline__ void apply(const Unit&, int row, int col0, f32x4 v0, f32x4 v1, const Pre& p) const {
        f32x4 y0, y1, z0, z1; unpack8(p.yw, y0, y1); unpack8(p.zw, z0, z1);
        const f32x4 b0 = *(const f32x4*)(bias + col0), b1 = *(const f32x4*)(bias + col0 + 4);
        *(u32x4*)(Y2 + (size_t)row * DM + col0) = pack8(y0 * sigm4(v0 + b0) * z0, y1 * sigm4(v1 + b1) * z1); } };
struct F_Split2 { bf16_t* Olo[2]; bf16_t* Ohi[2];
    __device__ __forceinline__ void apply(const Unit& u, int row, int col0, f32x4 v0, f32x4 v1) const {
        if (u.grp == 0) { bf16_t* o = (col0 < 1024) ? Olo[0] + (size_t)row * DM + col0 : Ohi[0] + (size_t)row * DM + (col0 - 1024); NT_ST((u32x4*)o, pack8(v0, v1)); }
        else if (col0 < 1024) NT_ST((u32x4*)(Olo[1] + (size_t)row * DM + col0), pack8(v0 * QC2, v1 * QC2));
        else NT_ST((u32x4*)(Ohi[1] + (size_t)row * DM + (col0 - 1024)), pack8(silu4(v0), silu4(v1))); } };
struct F_Plain { bf16_t* O;
    __device__ __forceinline__ void apply(const Unit&, int row, int col0, f32x4 v0, f32x4 v1) const { ST_OUT((u32x4*)(O + (size_t)row * DM + col0), pack8(v0, v1)); } };
struct F_Split { bf16_t* Olo; bf16_t* Ohi; float sc_lo; int silu_hi;
    __device__ __forceinline__ void apply(const Unit&, int row, int col0, f32x4 v0, f32x4 v1) const {
        if (col0 < 1024) *(u32x4*)(Olo + (size_t)row * DM + col0) = pack8(v0 * sc_lo, v1 * sc_lo);
        else { if (silu_hi) { NT_ST((u32x4*)(Ohi + (size_t)row * DM + (col0 - 1024)), pack8(silu4(v0), silu4(v1))); } else *(u32x4*)(Ohi + (size_t)row * DM + (col0 - 1024)) = pack8(v0, v1); } } };


struct PanelRms {
    unsigned* xbuf;
    unsigned* cnt;
    unsigned* tmo;
    float eps;
    __device__ __forceinline__ bool run(const f32x4 (&v)[2][2][4][2], const Unit& u, int wr, int wc, int fr, int fq, PG8_LAS unsigned char* lds, int wid, int lane) const {
        PG8_LAS float* P = (PG8_LAS float*)lds;
        PG8_LAS float* S = (PG8_LAS float*)(lds + 8192);
        PG8_LAS unsigned* flag = (PG8_LAS unsigned*)(lds + 8192 + 2048);
#pragma unroll
        for (int ai = 0; ai < 2; ++ai)
#pragma unroll
            for (int m = 0; m < 4; ++m) {
                float q = 0.f;
#pragma unroll
                for (int bj = 0; bj < 2; ++bj)
#pragma unroll
                    for (int n = 0; n < 2; ++n) { const f32x4 d = v[ai][bj][m][n]; q += (d[0] * d[0] + d[1] * d[1]) + (d[2] * d[2] + d[3] * d[3]); }
                q += __shfl_xor(q, 16); q += __shfl_xor(q, 32);
                if (fq == 0) P[(ai * HALF + wr * 64 + m * 16 + fr) * 4 + wc] = q;
            }
        asm volatile("s_waitcnt lgkmcnt(0)" ::: "memory"); __builtin_amdgcn_s_barrier(); asm volatile("" ::: "memory");
        const int row = wid * 32 + (lane & 31);
        if (lane < 32) {
            const float tot = (P[row * 4 + 0] + P[row * 4 + 1]) + (P[row * 4 + 2] + P[row * 4 + 3]);
            unsigned long long* slot = (unsigned long long*)xbuf + ((size_t)(u.pm * BM + row) * 4 + u.pn);
            __hip_atomic_store(slot, (unsigned long long)__float_as_uint(tot), __ATOMIC_RELAXED, __HIP_MEMORY_SCOPE_AGENT);
        }
        asm volatile("s_waitcnt vmcnt(0)" ::: "memory");
        if (lane == 0) __hip_atomic_fetch_add(cnt + 64 * u.pm, 1u, __ATOMIC_RELAXED, __HIP_MEMORY_SCOPE_AGENT);
        if (wid == 0) {
            bool dead = false; const unsigned long long t0 = __builtin_amdgcn_s_memrealtime(); const unsigned want = 32u;
            for (;;) {
                if ((unsigned)__builtin_amdgcn_readfirstlane(__hip_atomic_load(cnt + 64 * u.pm, __ATOMIC_RELAXED, __HIP_MEMORY_SCOPE_AGENT)) >= want) break;
                if (__builtin_amdgcn_s_memrealtime() - t0 > 2000000ull) { if (lane == 0) __hip_atomic_store(tmo, 1u, __ATOMIC_RELAXED, __HIP_MEMORY_SCOPE_AGENT); dead = true; break; }
                __builtin_amdgcn_s_sleep(2);
            }
            __builtin_amdgcn_fence(__ATOMIC_ACQUIRE, "agent");
            if (lane == 0) flag[0] = dead ? 1u : 0u;
        }
        asm volatile("s_waitcnt vmcnt(0) lgkmcnt(0)" ::: "memory"); __builtin_amdgcn_s_barrier(); asm volatile("" ::: "memory");
        const bool bad = flag[0] != 0u;
        if (lane < 32) {
            const unsigned long long* slot = (const unsigned long long*)xbuf + (size_t)(u.pm * BM + row) * 4; float t4[4];
#pragma unroll
            for (int t = 0; t < 4; ++t) t4[t] = __uint_as_float((unsigned)__hip_atomic_load(slot + t, __ATOMIC_RELAXED, __HIP_MEMORY_SCOPE_AGENT));
            S[row] = rsqrtf(((t4[0] + t4[1]) + (t4[2] + t4[3])) * (1.0f / 1024.0f) + eps);
        }
        asm volatile("s_waitcnt lgkmcnt(0)" ::: "memory"); __builtin_amdgcn_s_barrier(); asm volatile("" ::: "memory");
        return bad;
    }
};
struct EpiFinal {
    static constexpr bool PERM = false, AFTER_DRAIN = true;
    const float* base; float* out; const float* mod1; const float* gpost1; PanelRms st;
    __device__ __forceinline__ void fused(f32x4 (&acc)[2][2][4][2], const Unit& u, int wr, int wc, int fr, int fq, PG8_LAS unsigned char* lds, int wid, int lane) const {
        const PG8_LAS float* S = (const PG8_LAS float*)(lds + 8192);
        const int col0 = u.pn * BM + wc * 32 + 4 * fq; const int b = u.pm >> 4;
        const float* gate = mod1 + (size_t)b * 3072 + 2048;
        const bool bad = st.run(acc, u, wr, wc, fr, fq, lds, wid, lane);
        const float qnan = __builtin_nanf("");
        f32x4 gg[2][2];
#pragma unroll
        for (int bj = 0; bj < 2; ++bj)
#pragma unroll
            for (int n = 0; n < 2; ++n) gg[bj][n] = *(const f32x4*)(gate + col0 + bj * HALF + n * 16) * *(const f32x4*)(gpost1 + col0 + bj * HALF + n * 16);
#pragma unroll
        for (int ai = 0; ai < 2; ++ai)
#pragma unroll
            for (int m = 0; m < 4; ++m) { const int r = ai * HALF + wr * 64 + m * 16 + fr; const float sr = S[r]; const size_t off = (size_t)(u.pm * BM + r) * DM + col0;
#pragma unroll
                for (int bj = 0; bj < 2; ++bj)
#pragma unroll
                    for (int n = 0; n < 2; ++n) { const f32x4 bs = *(const f32x4*)(base + off + bj * HALF + n * 16); f32x4 o = bs + gg[bj][n] * (acc[ai][bj][m][n] * sr);
                        if (bad) o = (f32x4){qnan, qnan, qnan, qnan}; *(f32x4*)(out + off + bj * HALF + n * 16) = o; }
                if (m & 1) asm volatile("" ::: "memory"); }
    }
};
struct EpiMid {
    static constexpr bool PERM = false, AFTER_DRAIN = true;
    const float* x; float* out; bf16_t* akv; bf16_t* ain1; const float* mod; const float* gpost0; const float* gpre1; PanelRms st1, st2;
    __device__ __forceinline__ void fused(f32x4 (&acc)[2][2][4][2], const Unit& u, int wr, int wc, int fr, int fq, PG8_LAS unsigned char* lds, int wid, int lane) const {
        typedef unsigned u32x2v __attribute__((ext_vector_type(2)));
        const PG8_LAS float* S = (const PG8_LAS float*)(lds + 8192);
        const int col0 = u.pn * BM + wc * 32 + 4 * fq; const int b = u.pm >> 4;
        const float* gate0 = mod + (size_t)b * 3072 + 2048; const float* sh1 = mod + (size_t)(8 + b) * 3072; const float* sc1 = sh1 + 1024;
        bool bad = st1.run(acc, u, wr, wc, fr, fq, lds, wid, lane);
        {
            f32x4 gg[2][2];
#pragma unroll
            for (int bj = 0; bj < 2; ++bj)
#pragma unroll
                for (int n = 0; n < 2; ++n) gg[bj][n] = *(const f32x4*)(gate0 + col0 + bj * HALF + n * 16) * *(const f32x4*)(gpost0 + col0 + bj * HALF + n * 16);
#pragma unroll
            for (int ai = 0; ai < 2; ++ai)
#pragma unroll
                for (int m = 0; m < 4; ++m) { const int r = ai * HALF + wr * 64 + m * 16 + fr; const float sr = S[r]; const size_t off = (size_t)(u.pm * BM + r) * DM + col0;
#pragma unroll
                    for (int bj = 0; bj < 2; ++bj)
#pragma unroll
                        for (int n = 0; n < 2; ++n) { const f32x4 bs = *(const f32x4*)(x + off + bj * HALF + n * 16); acc[ai][bj][m][n] = bs + gg[bj][n] * (acc[ai][bj][m][n] * sr); }
                    asm volatile("" : "+v"(acc[ai][0][m][0]), "+v"(acc[ai][0][m][1]), "+v"(acc[ai][1][m][0]), "+v"(acc[ai][1][m][1]));
                    if (m & 1) asm volatile("" ::: "memory"); }
        }
        bad = st2.run(acc, u, wr, wc, fr, fq, lds, wid, lane) || bad;
        const float qnan = __builtin_nanf("");
#pragma unroll
        for (int bj = 0; bj < 2; ++bj)
#pragma unroll
            for (int n = 0; n < 2; ++n) { const int c = col0 + bj * HALF + n * 16;
                const f32x4 gf = *(const f32x4*)(gpre1 + c) * (*(const f32x4*)(sc1 + c) + 1.0f), sh = *(const f32x4*)(sh1 + c);
#pragma unroll
                for (int ai = 0; ai < 2; ++ai)
#pragma unroll
                    for (int m = 0; m < 4; ++m) { const int r = ai * HALF + wr * 64 + m * 16 + fr; const float sr = S[r]; const size_t off = (size_t)(u.pm * BM + r) * DM + c;
                        f32x4 h = acc[ai][bj][m][n]; if (bad) h = (f32x4){qnan, qnan, qnan, qnan};
                        *(f32x4*)(out + off) = h;
                        const f32x4 nr = h * sr; u32x2v w; w.x = cvt_pk_bf16(nr[0], nr[1]); w.y = cvt_pk_bf16(nr[2], nr[3]); *(u32x2v*)(akv + off) = w;
                        const f32x4 z = nr * gf + sh; w.x = cvt_pk_bf16(z[0], z[1]); w.y = cvt_pk_bf16(z[2], z[3]); *(u32x2v*)(ain1 + off) = w; }
                asm volatile("" ::: "memory"); }
    }
};

struct EpiScan {
    static constexpr bool PERM = true, AFTER_DRAIN = true;
    const float* lb16; bf16_t* US; int carry_off;
    __device__ __forceinline__ void fused(f32x4 (&acc)[2][2][4][2], const Unit& u, int wr, int wc, int fr, int fq, PG8_LAS unsigned char* lds, int wid, int lane) const {
#pragma unroll
        for (int ai = 0; ai < 2; ++ai)
#pragma unroll
            for (int m = 0; m < 4; ++m) { const int row = ai * HALF + wr * 64 + m * 16 + fr; const int ch = (wc * 32 + 8 * fq) >> 2;
                *(PG8_LAS f32x4*)(lds + row * 512 + ((ch ^ (row & 7)) << 4)) = acc[ai][0][m][0];
                *(PG8_LAS f32x4*)(lds + row * 512 + (((ch + 1) ^ (row & 7)) << 4)) = acc[ai][0][m][1]; }
        asm volatile("s_waitcnt lgkmcnt(0)" ::: "memory"); __builtin_amdgcn_s_barrier(); asm volatile("" ::: "memory");
        const int p = lane, g = u.grp, b = u.pm;
        const float lr = lb16[(g * 64 + p) * 2], li = lb16[(g * 64 + p) * 2 + 1];
        typedef float f32x2v __attribute__((ext_vector_type(2)));
        const int coff = ((p >> 1) << 4) + (p & 1) * 8;
        float sr = 0.f, si = 0.f;
#pragma unroll 8
        for (int j = 0; j < 32; ++j) { const int t = wid * 32 + j; const f32x2v e = *(const PG8_LAS f32x2v*)(lds + t * 512 + (coff ^ ((t & 7) << 4)));
            const float nr = lr * sr - li * si + e.x, ni = lr * si + li * sr + e.y; sr = nr; si = ni; }
        PG8_LAS f32x2v* C = (PG8_LAS f32x2v*)(lds + carry_off);
        C[wid * 64 + p] = (f32x2v){sr, si};
        float pr = lr, pi = li;
#pragma unroll
        for (int q = 0; q < 5; ++q) { const float nr = pr * pr - pi * pi, ni = 2.f * pr * pi; pr = nr; pi = ni; }
        asm volatile("s_waitcnt lgkmcnt(0)" ::: "memory"); __builtin_amdgcn_s_barrier(); asm volatile("" ::: "memory");
        sr = 0.f; si = 0.f;
        for (int v = 0; v < wid; ++v) { const f32x2v c = C[v * 64 + p]; const float nr = pr * sr - pi * si + c.x, ni = pr * si + pi * sr + c.y; sr = nr; si = ni; }
        bf16_t* sp = US + us_off(g, b * 256 + wid * 32, 256 + 2 * p);
#pragma unroll 8
        for (int j = 0; j < 32; ++j) { const int t = wid * 32 + j; const f32x2v e = *(const PG8_LAS f32x2v*)(lds + t * 512 + (coff ^ ((t & 7) << 4)));
            *(unsigned*)(sp + (size_t)j * US_P) = cvt_pk_bf16(sr, si);
            const float nr = lr * sr - li * si + e.x, ni = lr * si + li * sr + e.y; sr = nr; si = ni; }
        asm volatile("s_waitcnt vmcnt(0)" ::: "memory");
    }
};
template <class Epi, bool ALIGN_EPI>
__device__ __forceinline__ void gemm_phase(PG8_LAS unsigned char* lds, const Gemm g, const Order& S, const Epi& E, int tid_in) {
    int tid_ = tid_in; asm volatile("" : "+v"(tid_));
    const int tid = tid_, wid = __builtin_amdgcn_readfirstlane(tid >> 6), lane = tid & 63, wr = wid >> 2, wc = wid & 3, fr = lane & 15, fq = lane >> 4;
    const int nt = g.nt;
    unsigned voffA[2], voffB[2];
#pragma unroll
    for (int i = 0; i < 2; ++i) { int R, C; stage_rc(tid * 16 + i * 8192, R, C); const int Rb = Epi::PERM ? ((R & ~31) + perm32(R & 31)) : R;
        voffA[i] = (unsigned)R * g.a_rs + (unsigned)(C >> 4) * g.a_c16 + (unsigned)(C & 15) * 2u; voffB[i] = (unsigned)Rb * g.b_rs + (unsigned)C * 2u; }
    const size_t kstepA = g.a_kstep, kstepB = (size_t)(BK * 2);
    const size_t hstepA = (size_t)HALF * g.a_rs, hstepB = (size_t)HALF * g.b_rs;
    const unsigned ldsw = (unsigned)wid * 1024u;
    const int aoff = lds_byte(wr * 64 + fr, fq * 8), boff = lds_byte(wc * 32 + fr, fq * 8);
#define PG8_SA(b, h) (((b) * 2 + (h)) * HTB)
#define PG8_SB(b, h) ((4 + (b) * 2 + (h)) * HTB)
#define PG8_STAGE(bufoff, gbase, voff) do { _Pragma("unroll") for (int _i = 0; _i < 2; ++_i) \
        __builtin_amdgcn_global_load_lds((const unsigned*)((const char*)(gbase) + (voff)[_i]), (PG8_LAS unsigned*)(lds + (bufoff) + ldsw + _i * 8192), 16, 0, 0); } while (0)
#define PG8_LDA(dst, b, h) do { _Pragma("unroll") for (int m = 0; m < 4; ++m) _Pragma("unroll") for (int k = 0; k < 2; ++k) dst[m][k] = *(const PG8_LAS bf16x8*)(lds + PG8_SA(b, h) + aoff + m * 2048 + k * 1024); } while (0)
#define PG8_LDB(dst, b, h) do { _Pragma("unroll") for (int n = 0; n < 2; ++n) _Pragma("unroll") for (int k = 0; k < 2; ++k) dst[n][k] = *(const PG8_LAS bf16x8*)(lds + PG8_SB(b, h) + boff + n * 2048 + k * 1024); } while (0)
#define PG8_MMA(ai, bj, At, Bt) do { __builtin_amdgcn_s_setprio(1); _Pragma("unroll") for (int m = 0; m < 4; ++m) _Pragma("unroll") for (int n = 0; n < 2; ++n) _Pragma("unroll") for (int k = 0; k < 2; ++k) \
        acc[ai][bj][m][n] = __builtin_amdgcn_mfma_f32_16x16x32_bf16(Bt[n][k], At[m][k], acc[ai][bj][m][n], 0, 0, 0); __builtin_amdgcn_s_setprio(0); } while (0)
#define PG8_WAIT_V(n) asm volatile("s_waitcnt vmcnt(" #n ")" ::: "memory")
#define PG8_WAIT_L(n) asm volatile("s_waitcnt lgkmcnt(" #n ")" ::: "memory")
#define PG8_BAR __builtin_amdgcn_s_barrier()
#define PG8_SCHED __builtin_amdgcn_sched_barrier(0)
    Unit cur, nxt; int ui = 0;
    if (!S.next(0, cur)) return;
    f32x4 acc[2][2][4][2];
#pragma unroll
    for (int a = 0; a < 2; ++a)
#pragma unroll
        for (int b = 0; b < 2; ++b)
#pragma unroll
            for (int m = 0; m < 4; ++m)
#pragma unroll
                for (int n = 0; n < 2; ++n) acc[a][b][m][n] = (f32x4){0.f, 0.f, 0.f, 0.f};
    bf16x8 At[4][2], B0[2][2], B1[2][2];
    const char* cA = g.abase(cur); const char* cB = g.bbase(cur);
    PG8_STAGE(PG8_SB(0, 0), cB, voffB); PG8_STAGE(PG8_SB(0, 1), cB + hstepB, voffB); PG8_STAGE(PG8_SA(0, 0), cA, voffA); PG8_STAGE(PG8_SA(0, 1), cA + hstepA, voffA);
    if (wr == 1) PG8_BAR;
    PG8_WAIT_V(2); PG8_BAR;
    PG8_STAGE(PG8_SB(1, 0), cB + kstepB, voffB); PG8_STAGE(PG8_SA(1, 0), cA + kstepA, voffA); PG8_STAGE(PG8_SB(1, 1), cB + hstepB + kstepB, voffB);
    PG8_WAIT_V(6); PG8_BAR;
    for (;;) {
        const bool has_next = S.next(ui + 1, nxt);
        const char* nA = has_next ? g.abase(nxt) : cA; const char* nB = has_next ? g.bbase(nxt) : cB;
        for (int t = 0; t < nt; t += 2) {
            const bool last = (t == nt - 2);
            const char* a1 = cA + (size_t)(t + 1) * kstepA;
            const char* a2 = last ? nA : cA + (size_t)(t + 2) * kstepA; const char* b2 = last ? nB : cB + (size_t)(t + 2) * kstepB;
            const char* a3 = a2 + kstepA; const char* b3 = b2 + kstepB;
            PG8_LDB(B0, 0, 0); PG8_LDB(B1, 0, 1); PG8_SCHED; PG8_LDA(At, 0, 0); PG8_STAGE(PG8_SA(1, 1), a1 + hstepA, voffA);
            PG8_WAIT_V(8); PG8_WAIT_L(0); PG8_BAR; PG8_MMA(0, 0, At, B0); PG8_MMA(0, 1, At, B1); PG8_BAR; PG8_SCHED;
            PG8_LDA(At, 0, 1); PG8_STAGE(PG8_SB(0, 0), b2, voffB); PG8_STAGE(PG8_SB(0, 1), b2 + hstepB, voffB); PG8_STAGE(PG8_SA(0, 0), a2, voffA);
            PG8_WAIT_V(8); PG8_WAIT_L(0); PG8_BAR; PG8_MMA(1, 0, At, B0); PG8_MMA(1, 1, At, B1); PG8_BAR; PG8_SCHED;
            PG8_LDB(B0, 1, 0); PG8_LDB(B1, 1, 1); PG8_SCHED; PG8_LDA(At, 1, 0); PG8_STAGE(PG8_SA(0, 1), a2 + hstepA, voffA);
            PG8_WAIT_V(8); PG8_WAIT_L(0); PG8_BAR; PG8_MMA(0, 0, At, B0); PG8_MMA(0, 1, At, B1); PG8_BAR; PG8_SCHED;
            PG8_LDA(At, 1, 1); PG8_STAGE(PG8_SB(1, 0), b3, voffB); PG8_STAGE(PG8_SB(1, 1), b3 + hstepB, voffB); PG8_STAGE(PG8_SA(1, 0), a3, voffA);
            PG8_WAIT_V(8); PG8_WAIT_L(0); PG8_BAR; PG8_MMA(1, 0, At, B0); PG8_MMA(1, 1, At, B1); PG8_BAR; PG8_SCHED;
        }
        if constexpr (ALIGN_EPI) { if (wr == 0) PG8_BAR; }
        if constexpr (!Epi::AFTER_DRAIN) { E(acc, cur, wr, wc, fr, fq); }
        if (!has_next) break;
#pragma unroll
        for (int a = 0; a < 2; ++a)
#pragma unroll
            for (int b = 0; b < 2; ++b)
#pragma unroll
                for (int m = 0; m < 4; ++m)
#pragma unroll
                    for (int n = 0; n < 2; ++n) acc[a][b][m][n] = (f32x4){0.f, 0.f, 0.f, 0.f};
        cur = nxt; cA = nA; cB = nB; ++ui;
        if constexpr (ALIGN_EPI) { if (wr == 1) PG8_BAR; }
    }
    PG8_WAIT_V(0);
    if constexpr (!ALIGN_EPI) { if (wr == 0) PG8_BAR; }
    PG8_BAR;
    if constexpr (Epi::AFTER_DRAIN) { E.fused(acc, cur, wr, wc, fr, fq, lds, wid, lane); PG8_WAIT_L(0); PG8_BAR; }
#undef PG8_SA
#undef PG8_SB
#undef PG8_STAGE
#undef PG8_LDA
#undef PG8_LDB
#undef PG8_MMA
#undef PG8_WAIT_V
#undef PG8_WAIT_L
#undef PG8_BAR
#undef PG8_SCHED
}
}

namespace attn_body {
using bf16 = bf16_t;
using bf16x8 = __attribute__((ext_vector_type(8))) short;
using s16x4 = __attribute__((ext_vector_type(4))) short;
using f32x16 = __attribute__((ext_vector_type(16))) float;
using u32x4 = __attribute__((ext_vector_type(4))) unsigned;
constexpr int SEQ = SEQL, D = 64, DMA = 1024;
constexpr int NW = 8, QBLK = 32, QB = QBLK * NW, KVBLK = 64, NQB = SEQ / QB;
__device__ __forceinline__ int crow(int r, int hi) { return (r & 3) + 8 * (r >> 2) + 4 * hi; }
#define SBAR() __builtin_amdgcn_sched_barrier(0)
__device__ __forceinline__ void cmask(f32x16& p0, f32x16& p1, int jb, int qrel, int hi) {
  const float NEG = -INFINITY; int kb = 64 * jb + 4 * hi;
  #pragma unroll
  for (int r = 0; r < 16; ++r) { int kv = kb + (r & 3) + 8 * (r >> 2); if (kv > qrel) p0[r] = NEG; if (kv + 32 > qrel) p1[r] = NEG; }
}
constexpr int NSLOT = 3, SLOTB = 8192;
constexpr int LDS_K = 0, LDS_V = NSLOT * SLOTB, LDS_WS = 2 * NSLOT * SLOTB, LDS_OST = LDS_WS + NW * 64 * 4, LDS_BYTES = LDS_OST + NW * 4096;
__device__ __forceinline__ void glds16(const void* gsrc, unsigned lds_dst) { unsigned keep;
  asm volatile("s_mov_b32 %0, m0\n\ts_mov_b32 m0, %2\n\ts_nop 0\n\tglobal_load_lds_dwordx4 %1, off\n\ts_mov_b32 m0, %0" : "=&s"(keep) : "v"(gsrc), "s"(lds_dst) : "memory"); }
__device__ __forceinline__ float max3f(float a, float b, float c) { float r; asm("v_max3_f32 %0, %1, %2, %3" : "=v"(r) : "v"(a), "v"(b), "v"(c)); return r; }
__device__ __forceinline__ float max2f(float a, float b) { float r; asm("v_max_f32_e32 %0, %1, %2" : "=v"(r) : "v"(a), "v"(b)); return r; }
__device__ __forceinline__ float fadd_s(float a, float b) { float r; asm("v_add_f32_e32 %0, %1, %2" : "=v"(r) : "v"(a), "v"(b)); return r; }
__device__ __forceinline__ float fsub_s(float a, float b) { float r; asm("v_sub_f32_e32 %0, %1, %2" : "=v"(r) : "v"(a), "v"(b)); return r; }
typedef float f32x2_t __attribute__((ext_vector_type(2))); typedef __bf16 bf16x2_t __attribute__((ext_vector_type(2)));
__device__ __forceinline__ unsigned cvtpk_s(float lo, float hi) { f32x2_t v = {lo, hi}; bf16x2_t b = __builtin_convertvector(v, bf16x2_t); return __builtin_bit_cast(unsigned, b); }
#define WAIT_BAR(N) asm volatile("s_waitcnt vmcnt(" #N ") lgkmcnt(0)\n\ts_barrier" ::: "memory")

__device__ __forceinline__ void qkt(f32x16& p0, f32x16& p1, const char* Kslot, const bf16x8* qr, const f32x16& negm, int r32, int hi) {
  const char* kb = Kslot + hi * 1024 + r32 * 16;
  #pragma unroll
  for (int d0 = 0; d0 < 4; ++d0) {
    const bf16x8 b0 = *reinterpret_cast<const bf16x8*>(kb + d0 * 2048);
    const bf16x8 b1 = *reinterpret_cast<const bf16x8*>(kb + d0 * 2048 + 512);
    if (d0 == 0) { p0 = __builtin_amdgcn_mfma_f32_32x32x16_bf16(b0, qr[0], negm, 0, 0, 0); p1 = __builtin_amdgcn_mfma_f32_32x32x16_bf16(b1, qr[0], negm, 0, 0, 0); }
    else { p0 = __builtin_amdgcn_mfma_f32_32x32x16_bf16(b0, qr[d0], p0, 0, 0, 0); p1 = __builtin_amdgcn_mfma_f32_32x32x16_bf16(b1, qr[d0], p1, 0, 0, 0); } }
}
typedef __attribute__((address_space(3))) const char* lds_cptr;
typedef short v4i16_t __attribute__((ext_vector_type(4)));
__device__ __forceinline__ void kload8(bf16x8* kf, lds_cptr kp) {
  kf[0] = *(const __attribute__((address_space(3))) bf16x8*)(kp);        kf[1] = *(const __attribute__((address_space(3))) bf16x8*)(kp + 512);
  kf[2] = *(const __attribute__((address_space(3))) bf16x8*)(kp + 2048); kf[3] = *(const __attribute__((address_space(3))) bf16x8*)(kp + 2560);
  kf[4] = *(const __attribute__((address_space(3))) bf16x8*)(kp + 4096); kf[5] = *(const __attribute__((address_space(3))) bf16x8*)(kp + 4608);
  kf[6] = *(const __attribute__((address_space(3))) bf16x8*)(kp + 6144); kf[7] = *(const __attribute__((address_space(3))) bf16x8*)(kp + 6656);
}
__device__ __forceinline__ void kload2(bf16x8* kf, lds_cptr kp, int j) { kf[2 * j] = *(const __attribute__((address_space(3))) bf16x8*)(kp + j * 2048); kf[2 * j + 1] = *(const __attribute__((address_space(3))) bf16x8*)(kp + j * 2048 + 512); }
__device__ __forceinline__ s16x4 vtr(lds_cptr p) { return __builtin_bit_cast(s16x4, __builtin_amdgcn_ds_read_tr16_b64_v4i16((__attribute__((address_space(3))) v4i16_t*)p)); }
__device__ __forceinline__ float rowmax(const f32x16& p0, const f32x16& p1) {
  float a = max3f(p0[0], p0[1], p1[0]), b = max3f(p0[2], p0[3], p1[1]); a = max3f(a, p1[2], p1[3]);
  #pragma unroll
  for (int r = 4; r < 16; r += 4) { a = max3f(a, p0[r], p0[r + 1]); b = max3f(b, p0[r + 2], p0[r + 3]); a = max3f(a, p1[r], p1[r + 1]); b = max3f(b, p1[r + 2], p1[r + 3]); }
  const float m = max2f(a, b);
  auto rr = __builtin_amdgcn_permlane32_swap(__float_as_uint(m), __float_as_uint(m), false, false);
  return max2f(__uint_as_float(rr[0]), __uint_as_float(rr[1]));
}
__device__ __forceinline__ void pv(f32x16* o, int vb, bf16x8 pa0, bf16x8 pa1, bf16x8 pa2, bf16x8 pa3) {
  #pragma unroll
  for (int d0 = 0; d0 < 2; ++d0) { s16x4 lo[4], hi[4];
    #pragma unroll
    for (int ks = 0; ks < 4; ++ks) {
      asm volatile("ds_read_b64_tr_b16 %0,%1 offset:%c2" : "=&v"(lo[ks]) : "v"(vb), "i"(d0 * 4096 + ks * 1024) : "memory");
      asm volatile("ds_read_b64_tr_b16 %0,%1 offset:%c2" : "=&v"(hi[ks]) : "v"(vb), "i"(d0 * 4096 + ks * 1024 + 512) : "memory"); }
    asm volatile("s_waitcnt lgkmcnt(0)" ::: "memory"); SBAR();
    #define PK(k) (bf16x8){lo[k][0], lo[k][1], lo[k][2], lo[k][3], hi[k][0], hi[k][1], hi[k][2], hi[k][3]}
    o[d0] = __builtin_amdgcn_mfma_f32_32x32x16_bf16(pa0, PK(0), o[d0], 0, 0, 0);
    o[d0] = __builtin_amdgcn_mfma_f32_32x32x16_bf16(pa1, PK(1), o[d0], 0, 0, 0);
    o[d0] = __builtin_amdgcn_mfma_f32_32x32x16_bf16(pa2, PK(2), o[d0], 0, 0, 0);
    o[d0] = __builtin_amdgcn_mfma_f32_32x32x16_bf16(pa3, PK(3), o[d0], 0, 0, 0);
    #undef PK
  }
}
#define ATTN_STORE16(p, v) (*(u32x4*)(p) = (v))
template <int THRL> __device__ __forceinline__ void attn_unit(int tid_in, int b, int hq, int hv, int qb, const bf16* Q, const bf16* __restrict__ K, const bf16* __restrict__ V, bf16* O, char* shm) {
  const int tid = tid_in, lane = tid & 63, r32 = lane & 31, hi = lane >> 5; const int wid = __builtin_amdgcn_readfirstlane(tid >> 6);
  const long rowbase = (long)b * SEQ; const int q0 = qb * QB;
  const bf16* Qw = Q + (rowbase + q0 + wid * QBLK) * DMA + hq * D;
  const bf16* Kh = K + rowbase * DMA + hq * D, *Vh = V + rowbase * DMA + hv * D;
  const unsigned lds0 = (unsigned)(uintptr_t)shm;
  float* wsf = (float*)(shm + LDS_WS) + wid * 64;
  const bf16* ksrc = Kh + (long)lane * DMA + wid * 8;
  const bf16* vsrc = Vh + (long)(16 * (wid & 3) + (lane >> 2)) * DMA + (wid >> 2) * 32 + (lane & 3) * 8;
  const unsigned kdst = lds0 + LDS_K + wid * 1024, vdst = lds0 + LDS_V + wid * 1024;
  #define DMA_K(t, slot) glds16(ksrc + (long)(t) * KVBLK * DMA, (unsigned)__builtin_amdgcn_readfirstlane(kdst + (slot)))
  #define DMA_V(t, slot) glds16(vsrc + (long)(t) * KVBLK * DMA, (unsigned)__builtin_amdgcn_readfirstlane(vdst + (slot)))
  const int vb0 = (int)(lds0 + LDS_V) + ((lane >> 4) & 1) * 32 + (lane & 3) * 8 + (4 * hi + ((lane & 15) >> 2)) * 64;
  const char* Kbase = shm + LDS_K; bf16x8 kf[8];
  const lds_cptr shm3 = (lds_cptr)shm; const lds_cptr kp0 = shm3 + LDS_K + hi * 1024 + r32 * 16; const lds_cptr vp0 = shm3 + LDS_V + ((lane >> 4) & 1) * 32 + (lane & 3) * 8 + (4 * hi + ((lane & 15) >> 2)) * 64;
  const int NT = (q0 + QB) / KVBLK;
  DMA_K(0, 0); DMA_V(0, 0); DMA_K(1, SLOTB);
  bf16x8 qr[4];
  #pragma unroll
  for (int d0 = 0; d0 < 4; ++d0) qr[d0] = *reinterpret_cast<const bf16x8*>(&Qw[(long)r32 * DMA + d0 * 16 + hi * 8]);
  float mhat = 0.f, l_reg = 0.f; f32x16 o[2]; o[0] = f32x16{}; o[1] = f32x16{}; f32x16 negm = f32x16{}; asm volatile("" : "+v"(negm));
  const int qrel = wid * QBLK + r32;
  #define CMASK(P0, P1, t) do { int jb_ = (t) - (NT - 4); if (jb_ >= 0) cmask(P0, P1, jb_, qrel, hi); } while (0)
  bool resc = false;
  #define START(P0, P1) do { const float rm = rowmax(P0, P1); resc = false; \
    { const float dl = rm; mhat = fadd_s(mhat, dl); \
      _Pragma("unroll") for (int r = 0; r < 16; ++r) { P0[r] = fsub_s(P0[r], dl); P1[r] = fsub_s(P1[r], dl); } \
      _Pragma("unroll") for (int r = 0; r < 16; ++r) negm[r] = -mhat; asm volatile("" : "+v"(negm)); } \
    _Pragma("unroll") for (int r = 0; r < 16; ++r) P0[r] = __builtin_amdgcn_exp2f(P0[r]); } while (0)
  #define RESC() do { if (resc) { asm volatile("s_waitcnt lgkmcnt(0)" ::: "memory"); \
      _Pragma("unroll") for (int d_ = 0; d_ < 2; ++d_) _Pragma("unroll") for (int r = 0; r < 16; ++r) o[d_][r] *= wsf[crow(r, hi)]; } } while (0)
  f32x16 pA0, pA1, pB0, pB1;
  int sl_prev = 0, sl_cur = 0, sl_next = SLOTB;
  #define ROT() do { sl_prev = sl_cur; sl_cur = sl_next; sl_next = (sl_next == (NSLOT - 1) * SLOTB) ? 0 : sl_next + SLOTB; } while (0)
  DMA_K(2, 2 * SLOTB);
  WAIT_BAR(3);
  qkt(pA0, pA1, Kbase, qr, negm, r32, hi); asm volatile("s_nop 15\n\ts_nop 7" : "+v"(pA0), "+v"(pA1)); CMASK(pA0, pA1, 0);
  START(pA0, pA1);
  _Pragma("unroll") for (int r = 0; r < 16; ++r) pA1[r] = __builtin_amdgcn_exp2f(pA1[r]);
  WAIT_BAR(0);
  DMA_K(3, 0); DMA_V(1, SLOTB);
  ROT();
  kload8(kf, kp0 + sl_cur);
  WAIT_BAR(2);
  s16x4 vlo[8], vhi[8]; u32x4 pw0, pw1, pw2, pw3;
  #define PKW(P, B) cvtpk_s(P[B], P[B + 1])
  #define PAF(k) __builtin_bit_cast(bf16x8, pw##k)
  #define VFR(i) (bf16x8){vlo[i][0], vlo[i][1], vlo[i][2], vlo[i][3], vhi[i][0], vhi[i][1], vhi[i][2], vhi[i][3]}
  #define PIN(x) asm volatile("" : "+v"(x))
  #define MX3(a, b, c) __builtin_fmaxf(__builtin_fmaxf((a), (b)), (c))
  #define GAPA(MF, A0, A1, A2, A3, W0, W1, PW) do { MF; sacc += A0; sacc += A1; sacc += A2; sacc += A3; PIN(sacc); W0; W1; PIN(PW); SBAR(); } while (0)
  #define EX(v) __builtin_amdgcn_exp2f(v)
  #define GAPB(MF, X, B) do { MF; X[B] = EX(X[B]); X[B + 1] = EX(X[B + 1]); X[B + 2] = EX(X[B + 2]); X[B + 3] = EX(X[B + 3]); PIN(X); SBAR(); } while (0)
  #define VRD(i) do { vlo[i] = vtr(vp_ + (((i) >> 2) * 4096 + ((i) & 3) * 1024)); vhi[i] = vtr(vp_ + (((i) >> 2) * 4096 + ((i) & 3) * 1024 + 512)); } while (0)
  #define KRD(G, j) do { if (G) { kload2(kf, kp0 + sl_next, j); SBAR(); } } while (0)
  #define STEP(C0, C1, P0, P1, t, GK, GV, GL) do { SBAR(); \
    const lds_cptr vp_ = vp0 + sl_prev; \
    VRD(0); SBAR(); float sacc = (P0[0] + P0[1]); \
    GAPA(C0 = __builtin_amdgcn_mfma_f32_32x32x16_bf16(kf[0], qr[0], negm, 0, 0, 0), P0[2], P0[3], P0[4], P0[5],     pw0[0] = PKW(P0, 0), pw0[1] = PKW(P0, 2), pw0); \
    VRD(4); SBAR(); GAPA(C1 = __builtin_amdgcn_mfma_f32_32x32x16_bf16(kf[1], qr[0], negm, 0, 0, 0), P0[6], P0[7], P0[8], P0[9],     pw0[2] = PKW(P0, 4), pw0[3] = PKW(P0, 6), pw0); \
    VRD(1); SBAR(); GAPA(C0 = __builtin_amdgcn_mfma_f32_32x32x16_bf16(kf[2], qr[1], C0, 0, 0, 0),   P0[10], P0[11], P0[12], P0[13], pw1[0] = PKW(P0, 8), pw1[1] = PKW(P0, 10), pw1); \
    VRD(5); SBAR(); GAPA(C1 = __builtin_amdgcn_mfma_f32_32x32x16_bf16(kf[3], qr[1], C1, 0, 0, 0),   P0[14], P0[15], P1[0], P1[1],   pw1[2] = PKW(P0, 12), pw1[3] = PKW(P0, 14), pw1); \
    VRD(2); SBAR(); GAPA(C0 = __builtin_amdgcn_mfma_f32_32x32x16_bf16(kf[4], qr[2], C0, 0, 0, 0),   P1[2], P1[3], P1[4], P1[5],     pw2[0] = PKW(P1, 0), pw2[1] = PKW(P1, 2), pw2); \
    VRD(6); SBAR(); GAPA(C1 = __builtin_amdgcn_mfma_f32_32x32x16_bf16(kf[5], qr[2], C1, 0, 0, 0),   P1[6], P1[7], P1[8], P1[9],     pw2[2] = PKW(P1, 4), pw2[3] = PKW(P1, 6), pw2); \
    VRD(3); SBAR(); GAPA(C0 = __builtin_amdgcn_mfma_f32_32x32x16_bf16(kf[6], qr[3], C0, 0, 0, 0),   P1[10], P1[11], P1[12], P1[13], pw3[0] = PKW(P1, 8), pw3[1] = PKW(P1, 10), pw3); \
    VRD(7); SBAR(); GAPA(C1 = __builtin_amdgcn_mfma_f32_32x32x16_bf16(kf[7], qr[3], C1, 0, 0, 0),   P1[14], P1[15], 0.f, 0.f,       pw3[2] = PKW(P1, 12), pw3[3] = PKW(P1, 14), pw3); \
    l_reg += sacc; \
    if (GK) { DMA_K((t) + 3, sl_cur); } if (GV) { DMA_V((t) + 1, sl_next); } \
    CMASK(C0, C1, t); \
    { float a = MX3(C0[0], C0[1], C1[0]), b = MX3(C0[2], C0[3], C1[1]); a = MX3(a, C1[2], C1[3]); \
      _Pragma("unroll") for (int r = 4; r < 16; r += 4) { a = MX3(a, C0[r], C0[r + 1]); b = MX3(b, C0[r + 2], C0[r + 3]); a = MX3(a, C1[r], C1[r + 1]); b = MX3(b, C1[r + 2], C1[r + 3]); } \
      float rm = __builtin_fmaxf(a, b); { auto rr = __builtin_amdgcn_permlane32_swap(__float_as_uint(rm), __float_as_uint(rm), false, false); rm = __builtin_fmaxf(__uint_as_float(rr[0]), __uint_as_float(rr[1])); } \
      resc = false; \
      if (__builtin_expect(__any(rm > (float)THRL), 0)) { const float dl = __builtin_fmaxf(rm, 0.f); mhat += dl; \
        _Pragma("unroll") for (int r = 0; r < 16; ++r) { C0[r] -= dl; C1[r] -= dl; } \
        _Pragma("unroll") for (int r = 0; r < 16; ++r) negm[r] = -mhat; asm volatile("" : "+v"(negm)); \
        const float f = __builtin_amdgcn_exp2f(-dl); l_reg *= f; if (hi == 0) wsf[r32] = f; resc = true; } } \
    SBAR(); \
    GAPB(o[0] = __builtin_amdgcn_mfma_f32_32x32x16_bf16(PAF(0), VFR(0), o[0], 0, 0, 0), C0, 0); \
    GAPB(o[1] = __builtin_amdgcn_mfma_f32_32x32x16_bf16(PAF(0), VFR(4), o[1], 0, 0, 0), C0, 4); \
    KRD(GL, 0); GAPB(o[0] = __builtin_amdgcn_mfma_f32_32x32x16_bf16(PAF(1), VFR(1), o[0], 0, 0, 0), C0, 8); \
    KRD(GL, 1); GAPB(o[1] = __builtin_amdgcn_mfma_f32_32x32x16_bf16(PAF(1), VFR(5), o[1], 0, 0, 0), C0, 12); \
    KRD(GL, 2); GAPB(o[0] = __builtin_amdgcn_mfma_f32_32x32x16_bf16(PAF(2), VFR(2), o[0], 0, 0, 0), C1, 0); \
    KRD(GL, 3); GAPB(o[1] = __builtin_amdgcn_mfma_f32_32x32x16_bf16(PAF(2), VFR(6), o[1], 0, 0, 0), C1, 4); \
    GAPB(o[0] = __builtin_amdgcn_mfma_f32_32x32x16_bf16(PAF(3), VFR(3), o[0], 0, 0, 0), C1, 8); \
    GAPB(o[1] = __builtin_amdgcn_mfma_f32_32x32x16_bf16(PAF(3), VFR(7), o[1], 0, 0, 0), C1, 12); \
    } while (0)
  int t = 1;
  #undef CMASK
  #define CMASK(P0, P1, t) do {} while (0)
  for (; t + 5 < NT; t += 2) {
    STEP(pB0, pB1, pA0, pA1, t, true, true, true);     WAIT_BAR(2); RESC(); ROT();
    STEP(pA0, pA1, pB0, pB1, t + 1, true, true, true); WAIT_BAR(2); RESC(); ROT();
  }
  #undef CMASK
  #define CMASK(P0, P1, t) do { int jb_ = (t) - (NT - 4); if (jb_ >= 0) cmask(P0, P1, jb_, qrel, hi); } while (0)
  #define ENDW(tt) do { if ((tt) + 3 < NT) { WAIT_BAR(2); } else if ((tt) + 2 < NT) { WAIT_BAR(1); } else { WAIT_BAR(0); } } while (0)
  for (; t + 1 < NT; t += 2) {
    STEP(pB0, pB1, pA0, pA1, t, (t + 3 < NT), (t + 1 < NT), (t + 1 < NT));         ENDW(t);     RESC(); ROT();
    STEP(pA0, pA1, pB0, pB1, t + 1, (t + 4 < NT), (t + 2 < NT), (t + 2 < NT));     ENDW(t + 1); RESC(); ROT();
  }
  STEP(pB0, pB1, pA0, pA1, NT - 1, false, false, false); RESC();
  { float sacc = pB0[0] + pB0[1]; _Pragma("unroll") for (int r = 2; r < 16; ++r) sacc += pB0[r]; _Pragma("unroll") for (int r = 0; r < 16; ++r) sacc += pB1[r]; l_reg += sacc;
    pw0 = (u32x4){PKW(pB0, 0), PKW(pB0, 2), PKW(pB0, 4), PKW(pB0, 6)}; pw1 = (u32x4){PKW(pB0, 8), PKW(pB0, 10), PKW(pB0, 12), PKW(pB0, 14)}; pw2 = (u32x4){PKW(pB1, 0), PKW(pB1, 2), PKW(pB1, 4), PKW(pB1, 6)}; pw3 = (u32x4){PKW(pB1, 8), PKW(pB1, 10), PKW(pB1, 12), PKW(pB1, 14)};
    SBAR(); pv(o, vb0 + sl_cur, PAF(0), PAF(1), PAF(2), PAF(3)); }
  #undef PKW
  #undef PAF
  #undef VFR
  #undef PIN
  #undef MX3
  #undef GAPA
  #undef GAPB
  #undef EX
  #undef VRD
  #undef KRD
  #undef STEP
  #undef ENDW
  { auto rr = __builtin_amdgcn_permlane32_swap(__float_as_uint(l_reg), __float_as_uint(l_reg), false, false); l_reg = __uint_as_float(rr[0]) + __uint_as_float(rr[1]); }
  if (hi == 0) wsf[32 + r32] = l_reg; asm volatile("s_waitcnt lgkmcnt(0)" ::: "memory");
  float rli[16];
  #pragma unroll
  for (int r = 0; r < 16; ++r) rli[r] = __builtin_amdgcn_rcpf(wsf[32 + crow(r, hi)]);
  bf16* Ow = O + (rowbase + q0 + wid * QBLK) * DMA + hv * D;
  { bf16* stg = (bf16*)(shm + LDS_OST) + wid * 2048;
    #pragma unroll
    for (int r = 0; r < 16; ++r) { const int orow = crow(r, hi);
      #pragma unroll
      for (int d0 = 0; d0 < 2; ++d0) stg[orow * 64 + d0 * 32 + r32] = f2bf(o[d0][r] * rli[r]); }
    asm volatile("s_waitcnt lgkmcnt(0)" ::: "memory");
    #pragma unroll
    for (int i = 0; i < 4; ++i) { const int row = i * 8 + (lane >> 3), ch = lane & 7; const u32x4 v = *(const u32x4*)(stg + row * 64 + ch * 8); ATTN_STORE16(Ow + (long)row * DMA + ch * 8, v); } }
  asm volatile("s_waitcnt lgkmcnt(0)\n\ts_barrier" ::: "memory");
  #undef DMA_K
  #undef DMA_V
  #undef CMASK
  #undef START
  #undef RESC
  #undef ROT
}
constexpr int ATTN_LDS_BYTES = LDS_BYTES;
#undef SBAR
#undef WAIT_BAR
}

namespace attn3 {
using namespace attn_body;
constexpr int KSLOT = 8192, VSLOT = 16384;
constexpr int L_K = 0, L_V = NSLOT * KSLOT, L_WS = L_V + NSLOT * VSLOT, L_OST = L_WS + NW * 64 * 4, L_BYTES = L_OST + NW * 4096;
#define SBAR() __builtin_amdgcn_sched_barrier(0)
#define WAIT_BAR(N) asm volatile("s_waitcnt vmcnt(" #N ") lgkmcnt(0)\n\ts_barrier" ::: "memory")
template <int THRL> __device__ __forceinline__ void attn_unit(int tid_in, int b, int hq, int h, int qb, const bf16* Q, const bf16* __restrict__ K, const bf16* __restrict__ V, bf16* O, char* shm,
                                                             int mode, const bf16* SZ1, const float* g_sub, float lam, bf16* OG,
                                                             bool primed, bool has_next, int nb, int nhq, int nh, int nqb, bf16x8 (&qr)[4]) {
  int tid_ = tid_in; asm volatile("" : "+v"(tid_));
  const int tid = tid_, lane = tid & 63, r32 = lane & 31, hi = lane >> 5; const int wid = __builtin_amdgcn_readfirstlane(tid >> 6);
  const long rowbase = (long)b * SEQ; const int q0 = qb * QB;
  const bf16* Qw = Q + (rowbase + q0 + wid * QBLK) * DMA + hq * D;
  const bf16* Kh = K + rowbase * DMA + hq * D, *Vh = V + rowbase * DMA + h * 128;
  const unsigned lds0 = (unsigned)(uintptr_t)shm;
  float* wsf = (float*)(shm + L_WS) + wid * 64;
  const bf16* ksrc = Kh + (long)lane * DMA + wid * 8;
  const bf16* vsrc = Vh + (long)(16 * (wid & 3) + (lane >> 2)) * DMA + (wid >> 2) * 32 + (lane & 3) * 8;
  const unsigned kdst = lds0 + L_K + wid * 1024, vdst = lds0 + L_V + wid * 1024;
  #define DMA_K(t, si) glds16(ksrc + (long)(t) * KVBLK * DMA, (unsigned)__builtin_amdgcn_readfirstlane(kdst + (si) * KSLOT))
  #define DMA_V(t, si) do { glds16(vsrc + (long)(t) * KVBLK * DMA, (unsigned)__builtin_amdgcn_readfirstlane(vdst + (si) * VSLOT)); \
                            glds16(vsrc + (long)(t) * KVBLK * DMA + 64, (unsigned)__builtin_amdgcn_readfirstlane(vdst + (si) * VSLOT + 8192)); } while (0)
  const int vb0 = (int)(lds0 + L_V) + ((lane >> 4) & 1) * 32 + (lane & 3) * 8 + (4 * hi + ((lane & 15) >> 2)) * 64;
  const char* Kbase = shm + L_K; bf16x8 kf[8];
  const lds_cptr shm3 = (lds_cptr)shm; const lds_cptr kp0 = shm3 + L_K + hi * 1024 + r32 * 16; const lds_cptr vp0 = shm3 + L_V + ((lane >> 4) & 1) * 32 + (lane & 3) * 8 + (4 * hi + ((lane & 15) >> 2)) * 64;
  const int NT = (q0 + QB) / KVBLK;
  if (!primed) { DMA_K(0, 0); DMA_V(0, 0); DMA_K(1, 1);
    #pragma unroll
    for (int d0 = 0; d0 < 4; ++d0) qr[d0] = *reinterpret_cast<const bf16x8*>(&Qw[(long)r32 * DMA + d0 * 16 + hi * 8]); }
  float mhat = 0.f, l_reg = 0.f; f32x16 o[4]; f32x16 negm;
  { float zf = 0.f; asm volatile("" : "+v"(zf));
    _Pragma("unroll") for (int r = 0; r < 16; ++r) { o[0][r] = zf; o[1][r] = zf; o[2][r] = zf; o[3][r] = zf; negm[r] = zf; } }
  asm volatile("" : "+v"(negm));
  const int qrel = wid * QBLK + r32;
  #define CMASK(P0, P1, t) do { int jb_ = (t) - (NT - 4); if (jb_ >= 0) cmask(P0, P1, jb_, qrel, hi); } while (0)
  bool resc = false;
  #define RESC() do { if (resc) { asm volatile("s_waitcnt lgkmcnt(0)" ::: "memory"); \
      _Pragma("unroll") for (int d_ = 0; d_ < 4; ++d_) _Pragma("unroll") for (int r = 0; r < 16; ++r) o[d_][r] *= wsf[crow(r, hi)]; } } while (0)
  f32x16 C0, C1;
  int s_prev = 0, s_cur = 0, s_next = 1;
  #define ROT() do { s_prev = s_cur; s_cur = s_next; s_next = (s_next == NSLOT - 1) ? 0 : s_next + 1; } while (0)
  if (!primed) { DMA_K(2, 2); WAIT_BAR(4); }
  else { WAIT_BAR(0); }
  u32x4 pwA0, pwA1, pwA2, pwA3, pwB0, pwB1, pwB2, pwB3;
  #define PKW(P, B) cvtpk_s(P[B], P[B + 1])
  qkt(C0, C1, Kbase, qr, negm, r32, hi); asm volatile("s_nop 15\n\ts_nop 7" : "+v"(C0), "+v"(C1)); CMASK(C0, C1, 0);
  { const float rm = rowmax(C0, C1); mhat = fadd_s(mhat, rm);
    _Pragma("unroll") for (int r = 0; r < 16; ++r) { C0[r] = fsub_s(C0[r], rm); C1[r] = fsub_s(C1[r], rm); }
    _Pragma("unroll") for (int r = 0; r < 16; ++r) negm[r] = -mhat; asm volatile("" : "+v"(negm));
    float sacc = 0.f;
    _Pragma("unroll") for (int r = 0; r < 16; ++r) { C0[r] = __builtin_amdgcn_exp2f(C0[r]); C1[r] = __builtin_amdgcn_exp2f(C1[r]); }
    _Pragma("unroll") for (int r = 0; r < 16; ++r) sacc += C0[r] + C1[r];
    l_reg = sacc;
    pwA0 = (u32x4){PKW(C0, 0), PKW(C0, 2), PKW(C0, 4), PKW(C0, 6)}; pwA1 = (u32x4){PKW(C0, 8), PKW(C0, 10), PKW(C0, 12), PKW(C0, 14)};
    pwA2 = (u32x4){PKW(C1, 0), PKW(C1, 2), PKW(C1, 4), PKW(C1, 6)}; pwA3 = (u32x4){PKW(C1, 8), PKW(C1, 10), PKW(C1, 12), PKW(C1, 14)}; }
  WAIT_BAR(0);
  DMA_K(3, 0); DMA_V(1, 1);
  ROT();
  kload8(kf, kp0 + s_cur * KSLOT);
  WAIT_BAR(3);
  s16x4 vlo[8], vhi[8];
  #define PAF(w) __builtin_bit_cast(bf16x8, w)
  #define VFR(i) (bf16x8){vlo[i][0], vlo[i][1], vlo[i][2], vlo[i][3], vhi[i][0], vhi[i][1], vhi[i][2], vhi[i][3]}
  #define PIN(x) asm volatile("" : "+v"(x))
  #define MX3(a, b, c) __builtin_fmaxf(__builtin_fmaxf((a), (b)), (c))
  #define EX(v) __builtin_amdgcn_exp2f(v)
  #define VRD(s, f) do { vlo[s] = vtr(vp_ + (((f) >> 2) * 4096 + ((f) & 3) * 1024)); vhi[s] = vtr(vp_ + (((f) >> 2) * 4096 + ((f) & 3) * 1024 + 512)); } while (0)
  #define KRD(G, j) do { if (G) { kload2(kf, kp0 + s_next * KSLOT, j); SBAR(); } } while (0)
  #define GAPB(MF, X, B, PWW) do { MF; X[B] = EX(X[B]); X[B + 1] = EX(X[B + 1]); sacc += X[B]; sacc += X[B + 1]; PIN(sacc); PWW = PKW(X, B); PIN(PWW); SBAR(); } while (0)
  #define MFQ(a, b, c) __builtin_amdgcn_mfma_f32_32x32x16_bf16(a, b, c, 0, 0, 0)
#if ATTN_LAZY
  #define STEP_MAX() do {} while (0)
  #define STEP_END() do { RESC(); resc = false; \
      if (__builtin_expect(__any(sacc > (float)(1 << THRL)), 0)) { float s2; \
        { auto rr = __builtin_amdgcn_permlane32_swap(__float_as_uint(sacc), __float_as_uint(sacc), false, false); s2 = __uint_as_float(rr[0]) + __uint_as_float(rr[1]); } \
        const float dl = __builtin_fmaxf(__builtin_floorf(__builtin_amdgcn_logf(s2)), 0.f); mhat += dl; \
        _Pragma("unroll") for (int r = 0; r < 16; ++r) negm[r] = -mhat; asm volatile("" : "+v"(negm)); \
        const float f = __builtin_amdgcn_exp2f(-dl); l_reg *= f; if (hi == 0) wsf[r32] = f; resc = true; } } while (0)
  #define RESC_OUT() do {} while (0)
#else
  #define STEP_MAX() do { float a = MX3(C0[0], C0[1], C1[0]), b = MX3(C0[2], C0[3], C1[1]); a = MX3(a, C1[2], C1[3]); \
      _Pragma("unroll") for (int r = 4; r < 16; r += 4) { a = MX3(a, C0[r], C0[r + 1]); b = MX3(b, C0[r + 2], C0[r + 3]); a = MX3(a, C1[r], C1[r + 1]); b = MX3(b, C1[r + 2], C1[r + 3]); } \
      float rm = __builtin_fmaxf(a, b); { auto rr = __builtin_amdgcn_permlane32_swap(__float_as_uint(rm), __float_as_uint(rm), false, false); rm = __builtin_fmaxf(__uint_as_float(rr[0]), __uint_as_float(rr[1])); } \
      resc = false; \
      if (__builtin_expect(__any(rm > (float)THRL), 0)) { const float dl = __builtin_fmaxf(rm, 0.f); mhat += dl; \
        _Pragma("unroll") for (int r = 0; r < 16; ++r) { C0[r] -= dl; C1[r] -= dl; } \
        _Pragma("unroll") for (int r = 0; r < 16; ++r) negm[r] = -mhat; asm volatile("" : "+v"(negm)); \
        const float f = __builtin_amdgcn_exp2f(-dl); l_reg *= f; if (hi == 0) wsf[r32] = f; resc = true; } } while (0)
  #define STEP_END() do {} while (0)
  #define RESC_OUT() RESC()
#endif
  #define STEP(PP0, PP1, PP2, PP3, PN0, PN1, PN2, PN3, t, GK, GV, GL) do { SBAR(); \
    const lds_cptr vp_ = vp0 + s_prev * VSLOT; \
    VRD(0, 0); SBAR(); C0 = MFQ(kf[0], qr[0], negm); SBAR(); \
    VRD(4, 4); SBAR(); C1 = MFQ(kf[1], qr[0], negm); SBAR(); \
    VRD(1, 1); SBAR(); C0 = MFQ(kf[2], qr[1], C0); SBAR(); \
    VRD(5, 5); SBAR(); C1 = MFQ(kf[3], qr[1], C1); SBAR(); \
    VRD(2, 2); SBAR(); C0 = MFQ(kf[4], qr[2], C0); SBAR(); \
    VRD(6, 6); SBAR(); C1 = MFQ(kf[5], qr[2], C1); SBAR(); \
    VRD(3, 3); SBAR(); C0 = MFQ(kf[6], qr[3], C0); SBAR(); \
    VRD(7, 7); SBAR(); C1 = MFQ(kf[7], qr[3], C1); SBAR(); \
    if (GK) { DMA_K((t) + 3, s_cur); } if (GV) { DMA_V((t) + 1, s_next); } \
    CMASK(C0, C1, t); \
    STEP_MAX(); \
    SBAR(); float sacc = 0.f; \
    GAPB(o[0] = MFQ(PAF(PP0), VFR(0), o[0]), C0, 0,  PN0[0]); VRD(0, 8);  SBAR(); \
    GAPB(o[1] = MFQ(PAF(PP0), VFR(4), o[1]), C0, 2,  PN0[1]); VRD(4, 12); SBAR(); \
    GAPB(o[0] = MFQ(PAF(PP1), VFR(1), o[0]), C0, 4,  PN0[2]); VRD(1, 9);  SBAR(); \
    GAPB(o[1] = MFQ(PAF(PP1), VFR(5), o[1]), C0, 6,  PN0[3]); VRD(5, 13); SBAR(); \
    GAPB(o[0] = MFQ(PAF(PP2), VFR(2), o[0]), C0, 8,  PN1[0]); VRD(2, 10); SBAR(); \
    GAPB(o[1] = MFQ(PAF(PP2), VFR(6), o[1]), C0, 10, PN1[1]); VRD(6, 14); SBAR(); \
    GAPB(o[0] = MFQ(PAF(PP3), VFR(3), o[0]), C0, 12, PN1[2]); VRD(3, 11); SBAR(); \
    GAPB(o[1] = MFQ(PAF(PP3), VFR(7), o[1]), C0, 14, PN1[3]); VRD(7, 15); SBAR(); \
    GAPB(o[2] = MFQ(PAF(PP0), VFR(0), o[2]), C1, 0,  PN2[0]); \
    GAPB(o[3] = MFQ(PAF(PP0), VFR(4), o[3]), C1, 2,  PN2[1]); \
    KRD(GL, 0); GAPB(o[2] = MFQ(PAF(PP1), VFR(1), o[2]), C1, 4,  PN2[2]); \
    KRD(GL, 1); GAPB(o[3] = MFQ(PAF(PP1), VFR(5), o[3]), C1, 6,  PN2[3]); \
    KRD(GL, 2); GAPB(o[2] = MFQ(PAF(PP2), VFR(2), o[2]), C1, 8,  PN3[0]); \
    KRD(GL, 3); GAPB(o[3] = MFQ(PAF(PP2), VFR(6), o[3]), C1, 10, PN3[1]); \
    GAPB(o[2] = MFQ(PAF(PP3), VFR(3), o[2]), C1, 12, PN3[2]); \
    GAPB(o[3] = MFQ(PAF(PP3), VFR(7), o[3]), C1, 14, PN3[3]); \
    l_reg += sacc; \
    STEP_END(); \
    } while (0)
  #define STEP_AB(t, GK, GV, GL) STEP(pwA0, pwA1, pwA2, pwA3, pwB0, pwB1, pwB2, pwB3, t, GK, GV, GL)
  #define STEP_BA(t, GK, GV, GL) STEP(pwB0, pwB1, pwB2, pwB3, pwA0, pwA1, pwA2, pwA3, t, GK, GV, GL)
  int t = 1;
  #undef CMASK
  #define CMASK(P0, P1, t) do {} while (0)
  for (; t + 5 < NT; t += 2) {
    STEP_AB(t, true, true, true);     WAIT_BAR(3); RESC_OUT(); ROT();
    STEP_BA(t + 1, true, true, true); WAIT_BAR(3); RESC_OUT(); ROT();
  }
  #undef CMASK
  #define CMASK(P0, P1, t) do { int jb_ = (t) - (NT - 4); if (jb_ >= 0) cmask(P0, P1, jb_, qrel, hi); } while (0)
  #define ENDW(tt) do { if ((tt) + 3 < NT) { WAIT_BAR(3); } else if ((tt) + 2 < NT) { WAIT_BAR(2); } else { WAIT_BAR(0); } } while (0)
#if ATTN_DSKIP
  #define PKV(k) (bf16x8){lo[k][0], lo[k][1], lo[k][2], lo[k][3], hh[k][0], hh[k][1], hh[k][2], hh[k][3]}
  #define PVONLY(PW0, PW1, PW2, PW3, vb) do { SBAR(); \
    _Pragma("unroll") for (int d0 = 0; d0 < 4; ++d0) { s16x4 lo[4], hh[4]; \
      _Pragma("unroll") for (int ks = 0; ks < 4; ++ks) { \
        asm volatile("ds_read_b64_tr_b16 %0,%1 offset:%c2" : "=&v"(lo[ks]) : "v"(vb), "i"(d0 * 4096 + ks * 1024) : "memory"); \
        asm volatile("ds_read_b64_tr_b16 %0,%1 offset:%c2" : "=&v"(hh[ks]) : "v"(vb), "i"(d0 * 4096 + ks * 1024 + 512) : "memory"); } \
      asm volatile("s_waitcnt lgkmcnt(0)" ::: "memory"); SBAR(); \
      o[d0] = MFQ(PAF(PW0), PKV(0), o[d0]); o[d0] = MFQ(PAF(PW1), PKV(1), o[d0]); o[d0] = MFQ(PAF(PW2), PKV(2), o[d0]); o[d0] = MFQ(PAF(PW3), PKV(3), o[d0]); } } while (0)
  const int tl = NT - 4 + (wid >> 1);
  for (; t + 1 <= tl; t += 2) {
    STEP_AB(t, (t + 3 < NT), (t + 1 < NT), (t + 1 < NT));         ENDW(t);     RESC_OUT(); ROT();
    STEP_BA(t + 1, (t + 4 < NT), (t + 2 < NT), (t + 2 < NT));     ENDW(t + 1); RESC_OUT(); ROT();
  }
  if (t <= tl) { STEP_AB(t, (t + 3 < NT), (t + 1 < NT), (t + 1 < NT)); if (t + 1 < NT) { ENDW(t); RESC_OUT(); ROT(); } else { RESC_OUT(); } ++t; }
  { const int vb = vb0 + ((tl == NT - 1) ? s_cur : s_prev) * VSLOT;
    if (tl & 1) { PVONLY(pwB0, pwB1, pwB2, pwB3, vb); } else { PVONLY(pwA0, pwA1, pwA2, pwA3, vb); } }
  for (; t < NT; ++t) {
    if (t + 3 < NT) { DMA_K(t + 3, s_cur); } if (t + 1 < NT) { DMA_V(t + 1, s_next); }
    if (t + 1 < NT) { ENDW(t); ROT(); } }
  #undef PKV
  #undef PVONLY
#else
  for (; t + 1 < NT; t += 2) {
    STEP_AB(t, (t + 3 < NT), (t + 1 < NT), (t + 1 < NT));         ENDW(t);     RESC_OUT(); ROT();
    STEP_BA(t + 1, (t + 4 < NT), (t + 2 < NT), (t + 2 < NT));     ENDW(t + 1); RESC_OUT(); ROT();
  }
  STEP_AB(NT - 1, false, false, false); RESC_OUT();
  { SBAR();
    const int vb = vb0 + s_cur * VSLOT;
    #pragma unroll
    for (int d0 = 0; d0 < 4; ++d0) { s16x4 lo[4], hh[4];
      #pragma unroll
      for (int ks = 0; ks < 4; ++ks) {
        asm volatile("ds_read_b64_tr_b16 %0,%1 offset:%c2" : "=&v"(lo[ks]) : "v"(vb), "i"(d0 * 4096 + ks * 1024) : "memory");
        asm volatile("ds_read_b64_tr_b16 %0,%1 offset:%c2" : "=&v"(hh[ks]) : "v"(vb), "i"(d0 * 4096 + ks * 1024 + 512) : "memory"); }
      asm volatile("s_waitcnt lgkmcnt(0)" ::: "memory"); SBAR();
      #define PK(k) (bf16x8){lo[k][0], lo[k][1], lo[k][2], lo[k][3], hh[k][0], hh[k][1], hh[k][2], hh[k][3]}
      o[d0] = MFQ(PAF(pwB0), PK(0), o[d0]); o[d0] = MFQ(PAF(pwB1), PK(1), o[d0]); o[d0] = MFQ(PAF(pwB2), PK(2), o[d0]); o[d0] = MFQ(PAF(pwB3), PK(3), o[d0]);
      #undef PK
    } }
#endif
#if ATTN_LAZY
  RESC();
#endif
  asm volatile("s_waitcnt lgkmcnt(0)\n\ts_barrier" ::: "memory");
  if (has_next) {
    const long nrow = (long)nb * SEQ; const int nq0 = nqb * QB;
    const bf16* nQw = Q + (nrow + nq0 + wid * QBLK) * DMA + nhq * D;
    const bf16* nks = K + nrow * DMA + nhq * D + (long)lane * DMA + wid * 8;
    const bf16* nvs = V + nrow * DMA + nh * 128 + (long)(16 * (wid & 3) + (lane >> 2)) * DMA + (wid >> 2) * 32 + (lane & 3) * 8;
    glds16(nks, (unsigned)__builtin_amdgcn_readfirstlane(kdst));
    glds16(nvs, (unsigned)__builtin_amdgcn_readfirstlane(vdst)); glds16(nvs + 64, (unsigned)__builtin_amdgcn_readfirstlane(vdst + 8192));
    glds16(nks + (long)KVBLK * DMA, (unsigned)__builtin_amdgcn_readfirstlane(kdst + KSLOT));
    glds16(nks + (long)2 * KVBLK * DMA, (unsigned)__builtin_amdgcn_readfirstlane(kdst + 2 * KSLOT));
    #pragma unroll
    for (int d0 = 0; d0 < 4; ++d0) qr[d0] = *reinterpret_cast<const bf16x8*>(&nQw[(long)r32 * DMA + d0 * 16 + hi * 8]);
  }
  { auto rr = __builtin_amdgcn_permlane32_swap(__float_as_uint(l_reg), __float_as_uint(l_reg), false, false); l_reg = __uint_as_float(rr[0]) + __uint_as_float(rr[1]); }
  if (hi == 0) wsf[32 + r32] = l_reg; asm volatile("s_waitcnt lgkmcnt(0)" ::: "memory");
  float rli[16];
  #pragma unroll
  for (int r = 0; r < 16; ++r) rli[r] = __builtin_amdgcn_rcpf(wsf[32 + crow(r, hi)]);
  int lane_e = lane; asm volatile("" : "+v"(lane_e));
  const int erow = lane_e >> 3, ech = lane_e & 7;
  bf16* Ow = O + (rowbase + q0 + wid * QBLK) * DMA + h * 128;
  bf16* stg = (bf16*)(shm + L_OST) + wid * 2048;
  if (mode == 0) {
    #pragma unroll
    for (int ps = 0; ps < 2; ++ps) {
      #pragma unroll
      for (int r = 0; r < 16; ++r) { const int orow = crow(r, hi);
        #pragma unroll
        for (int d0 = 0; d0 < 2; ++d0) stg[orow * 64 + d0 * 32 + r32] = f2bf(o[2 * ps + d0][r] * rli[r]); }
      asm volatile("s_waitcnt lgkmcnt(0)" ::: "memory");
      #pragma unroll
      for (int i = 0; i < 4; ++i) { const int row = i * 8 + erow, ch = ech; const u32x4 v = *(const u32x4*)(stg + row * 64 + ch * 8); *(u32x4*)(Ow + (long)row * DMA + ps * 64 + ch * 8) = v; }
      asm volatile("s_waitcnt lgkmcnt(0)" ::: "memory");
    }
    asm volatile("s_waitcnt vmcnt(0)" ::: "memory");
  } else {
    const bf16* Zw = SZ1 + (rowbase + q0 + wid * QBLK) * DMA + h * 128; bf16* Gw = OG + (rowbase + q0 + wid * QBLK) * DMA + h * 128;
    float dk[2][4][8]; float ss[4] = {0.f, 0.f, 0.f, 0.f};
    #pragma unroll
    for (int ps = 0; ps < 2; ++ps) {
      #pragma unroll
      for (int r = 0; r < 16; ++r) { const int orow = crow(r, hi);
        #pragma unroll
        for (int d0 = 0; d0 < 2; ++d0) stg[orow * 64 + d0 * 32 + r32] = f2bf(o[2 * ps + d0][r] * rli[r]); }
      asm volatile("s_waitcnt lgkmcnt(0)" ::: "memory");
      #pragma unroll
      for (int i = 0; i < 4; ++i) { const int row = i * 8 + erow, ch = ech;
        const u32x4 v1 = *(const u32x4*)(stg + row * 64 + ch * 8); const u32x4 v0 = *(const u32x4*)(Ow + (long)row * DMA + ps * 64 + ch * 8);
        #pragma unroll
        for (int j = 0; j < 4; ++j) { const float a0 = __uint_as_float(v0[j] << 16), a1 = __uint_as_float(v0[j] & 0xffff0000u), b0 = __uint_as_float(v1[j] << 16), b1 = __uint_as_float(v1[j] & 0xffff0000u);
          const float d0_ = a0 - lam * b0, d1_ = a1 - lam * b1; dk[ps][i][2 * j] = d0_; dk[ps][i][2 * j + 1] = d1_; ss[i] += d0_ * d0_ + d1_ * d1_; } }
      asm volatile("s_waitcnt lgkmcnt(0)" ::: "memory");
    }
    #pragma unroll
    for (int i = 0; i < 4; ++i) { float t_ = ss[i];
      t_ += __int_as_float(__builtin_amdgcn_ds_swizzle(__float_as_int(t_), 0x1f | (1 << 10))); t_ += __int_as_float(__builtin_amdgcn_ds_swizzle(__float_as_int(t_), 0x1f | (2 << 10)));
      t_ += __int_as_float(__builtin_amdgcn_ds_swizzle(__float_as_int(t_), 0x1f | (4 << 10))); ss[i] = rsqrtf(t_ * (1.0f / 128.0f) + RMS_EPS) * ONE_M_LI; }
    #pragma unroll
    for (int ps = 0; ps < 2; ++ps) {
      const int ch = ech; const float* gp = g_sub + ps * 64 + ch * 8; const f32x4_t g0 = *(const f32x4_t*)gp, g1 = *(const f32x4_t*)(gp + 4);
      #pragma unroll
      for (int i = 0; i < 4; ++i) { const int row = i * 8 + erow;
        const u32x4 z = NT_LD((const u32x4*)(Zw + (long)row * DMA + ps * 64 + ch * 8)); u32x4 w;
        #pragma unroll
        for (int j = 0; j < 4; ++j) { const float z0 = __uint_as_float(z[j] << 16), z1 = __uint_as_float(z[j] & 0xffff0000u);
          const float ga = (j < 2) ? g0[2 * j] : g1[2 * j - 4], gb = (j < 2) ? g0[2 * j + 1] : g1[2 * j - 3];
          w[j] = cvtpk_s(dk[ps][i][2 * j] * ss[i] * ga * z0, dk[ps][i][2 * j + 1] * ss[i] * gb * z1); }
        *(u32x4*)(Gw + (long)row * DMA + ps * 64 + ch * 8) = w; }
    }
  }
  asm volatile("s_waitcnt lgkmcnt(0)" ::: "memory");
  #undef DMA_K
  #undef DMA_V
  #undef CMASK
  #undef RESC
  #undef ROT
  #undef PKW
  #undef PAF
  #undef VFR
  #undef PIN
  #undef MX3
  #undef EX
  #undef VRD
  #undef KRD
  #undef GAPB
  #undef MFQ
  #undef STEP
  #undef STEP_AB
  #undef STEP_BA
  #undef ENDW
  #undef STEP_MAX
  #undef STEP_END
  #undef RESC_OUT
}
#undef SBAR
#undef WAIT_BAR
}

constexpr int NWAVES = 8;
constexpr size_t MiB = 1u << 20;
constexpr size_t WS_CTL = 0, CTL_ZERO_BYTES = 1 * MiB;
constexpr size_t WS_MOD = 256 * 1024;
constexpr size_t WS_LAM = 1 * MiB;
constexpr size_t WS_HN = 1 * MiB + 128 * 1024;
constexpr size_t WS_LB16 = 1 * MiB + 4096;
constexpr size_t WS_WIN0 = 2 * MiB, WS_WGLU = 6 * MiB, WS_WOUT0 = 8 * MiB, WS_WKV = 10 * MiB, WS_WIN1 = 14 * MiB, WS_WOUT1 = 18 * MiB;
constexpr size_t WS_BTA = 20 * MiB;
constexpr size_t WS_BTB = 28 * MiB;
constexpr size_t WS_S0 = 48 * MiB, WS_S1 = 112 * MiB, WS_S2 = 176 * MiB, WS_S3 = 240 * MiB, WS_S4 = 304 * MiB, WS_S5 = 368 * MiB, WS_S6 = 432 * MiB, WS_END = 496 * MiB;
constexpr int CW_BAR = 4096;
constexpr int CW_TMO = 8, CW_SEAM = 16384, SEAM_BANK = 128 * 64;
constexpr size_t WS_XCH = 40 * MiB;
constexpr int RING_OFF = 0, RING_BYTES = 131072;
constexpr int LDSCTL_OFF = RING_BYTES, MISC_OFF = LDSCTL_OFF + 320;
constexpr int LDS_BYTES = 147456;

#define GAS __attribute__((address_space(1)))
#define LAS __attribute__((address_space(3)))
typedef unsigned v4u __attribute__((ext_vector_type(4)));
typedef GAS unsigned gu32;
#define RLX_AGENT __ATOMIC_RELAXED, __HIP_MEMORY_SCOPE_AGENT
#define LDS_WAIT() asm volatile("s_waitcnt lgkmcnt(0)" ::: "memory")
#define VM_WAIT() asm volatile("s_waitcnt vmcnt(0)" ::: "memory")

#define XB_TMO      128
#define XB_XCNT(j)  (256  + 64 * (j))
#define XB_XSUB(j)  (1280 + 64 * (j))
#define XB_XGEN(j)  (2304 + 64 * (j))
#define XB_TOP      3328
#define XB_TOPGEN   3392
#define XCD_BAR_WORDS 3456
#define XB_SPIN_CAP (1u << 18)
__device__ __forceinline__ unsigned xb_ld(unsigned* p)              { return __hip_atomic_load(p, __ATOMIC_RELAXED, __HIP_MEMORY_SCOPE_AGENT); }
__device__ __forceinline__ unsigned xb_add(unsigned* p, unsigned v) { return __hip_atomic_fetch_add(p, v, __ATOMIC_RELAXED, __HIP_MEMORY_SCOPE_AGENT); }
__device__ __forceinline__ unsigned xb_xcc_id() { return (unsigned)__builtin_amdgcn_s_getreg((3 << 11) | 20) & 0xFu; }
#define XB_SPIN(cond, bar) do { unsigned _sp = 0; while (cond) { __builtin_amdgcn_s_sleep(1); \
    if ((++_sp & 255u) == 0u) { if (xb_ld(&(bar)[XB_TMO])) break; if (_sp > XB_SPIN_CAP) { atomicAdd(&(bar)[XB_TMO], 1u); break; } } } } while (0)
struct XcdBarrier { unsigned* bar; unsigned x; volatile LAS unsigned* st; };
__device__ __forceinline__ XcdBarrier xcd_barrier_post(unsigned* bar, volatile LAS unsigned* st, int tid) {
    XcdBarrier b; b.bar = bar; b.x = xb_xcc_id(); b.st = st;
    if (tid == 0) st[4] = xb_add(&bar[XB_XCNT(b.x)], 1u);
    return b;
}
__device__ __forceinline__ void xcc_barrier(unsigned* lb, unsigned x, unsigned nloc, int tid) {
    asm volatile("s_waitcnt vmcnt(0)" ::: "memory");
    __syncthreads();
    if (tid == 0) {
        __builtin_amdgcn_s_waitcnt(0);
        const unsigned old = xb_add(&lb[XB_XSUB(x)], 1u); const unsigned gen = old / nloc;
        if (old + 1u == (gen + 1u) * nloc) xb_add(&lb[XB_XGEN(x)], 1u);
        else XB_SPIN(xb_ld(&lb[XB_XGEN(x)]) == gen, lb);
        __builtin_amdgcn_fence(__ATOMIC_ACQUIRE, "agent");
        asm volatile("s_waitcnt vmcnt(0)" ::: "memory");
    }
    __syncthreads();
}
__device__ __forceinline__ void xcd_barrier_complete(unsigned* bar, unsigned x, unsigned& nloc, unsigned& nx) {
    const unsigned G = gridDim.x * gridDim.y * gridDim.z;
    unsigned sum, cnt, mine, sp = 0u;
    for (;;) {
        sum = 0u; cnt = 0u; mine = 0u;
#pragma unroll
        for (unsigned j = 0; j < 16; ++j) { const unsigned c = xb_ld(&bar[XB_XCNT(j)]); sum += c; cnt += (c > 0u) ? 1u : 0u; mine = (j == x) ? c : mine; }
        if (sum == G) break;
        __builtin_amdgcn_s_sleep(1);
        if ((++sp & 255u) == 0u) { if (xb_ld(&bar[XB_TMO])) break; if (sp > XB_SPIN_CAP) { atomicAdd(&bar[XB_TMO], 1u); break; } }
    }
    nloc = mine > 0u ? mine : 1u; nx = cnt > 0u ? cnt : 1u;
}
__device__ __forceinline__ void xcd_barrier(const XcdBarrier& b, int tid) {
    asm volatile("s_waitcnt vmcnt(0)" ::: "memory");
    __syncthreads();
    if (tid == 0) {
        unsigned* bar = b.bar;
        __builtin_amdgcn_s_waitcnt(0);
        unsigned nloc = b.st[0], nx = b.st[1];
        if (nloc == 0u) { xcd_barrier_complete(bar, b.x, nloc, nx); b.st[0] = nloc; b.st[1] = nx; }
        const unsigned old = xb_add(&bar[XB_XSUB(b.x)], 1u);
        const unsigned gen = old / nloc;
        if (old + 1u == (gen + 1u) * nloc) {
            __builtin_amdgcn_fence(__ATOMIC_RELEASE, "agent");
            asm volatile("s_waitcnt vmcnt(0)" ::: "memory");
            const unsigned og = xb_add(&bar[XB_TOP], 1u);
            const unsigned tg = og / nx;
            if (og + 1u == (tg + 1u) * nx) xb_add(&bar[XB_TOPGEN], 1u);
            else XB_SPIN(xb_ld(&bar[XB_TOPGEN]) == tg, bar);
            __builtin_amdgcn_fence(__ATOMIC_ACQUIRE, "agent");
            xb_add(&bar[XB_XGEN(b.x)], 1u);
            asm volatile("s_waitcnt vmcnt(0)" ::: "memory");
        } else {
            XB_SPIN(xb_ld(&bar[XB_XGEN(b.x)]) == gen, bar);
            __builtin_amdgcn_fence(__ATOMIC_ACQUIRE, "agent");
            asm volatile("s_waitcnt vmcnt(0)" ::: "memory");
        }
    }
    __syncthreads();
}

__device__ __forceinline__ void p0_transpose_item(const float* W, int K, int N, bf16_t* WT, int row_off, const float* kscale, LAS float* scr, int item, int lane) {
    const int nblk = N / 32, kb = item / nblk, nb = item % nblk, k0 = 64 * kb, n0 = 32 * nb;
    float tv[32];
#pragma unroll
    for (int i = 0; i < 32; ++i) tv[i] = NT_LD(W + (size_t)(k0 + 2 * i + (lane >> 5)) * N + n0 + (lane & 31));
#pragma unroll
    for (int i = 0; i < 32; ++i) { const int kk = 2 * i + (lane >> 5); float v = tv[i]; if (kscale) v *= kscale[k0 + kk]; scr[kk * 33 + (lane & 31)] = v; }
    LDS_WAIT(); asm volatile("" ::: "memory");
    const int c = lane & 7;
#pragma unroll
    for (int j = 0; j < 4; ++j) { const int n = (lane >> 3) + 8 * j; const LAS float* s = scr + (8 * c) * 33 + n;
        v4u o; o.x = pk2bf(s[0 * 33], s[1 * 33]); o.y = pk2bf(s[2 * 33], s[3 * 33]); o.z = pk2bf(s[4 * 33], s[5 * 33]); o.w = pk2bf(s[6 * 33], s[7 * 33]);
        *(GAS v4u*)(WT + (size_t)(row_off + n0 + n) * K + k0 + 8 * c) = o; }
    LDS_WAIT(); asm volatile("" ::: "memory");
}

__device__ __forceinline__ int lane_now_asm() { int r; asm volatile("v_mbcnt_lo_u32_b32 %0, -1, 0\n\tv_mbcnt_hi_u32_b32 %0, -1, %0" : "=v"(r)); return r; }
struct Args {
    const float* in[28]; float* out; unsigned char* ws;
    int ph_lo, ph_hi, use_bar, flags;
};

__global__ void __launch_bounds__(NWAVES * 64, 2) mega_fwd(Args args) {
    extern __shared__ __attribute__((aligned(16))) unsigned char lds_raw[];
    LAS unsigned char* lds = (LAS unsigned char*)lds_raw;
    volatile LAS unsigned* MISC = (volatile LAS unsigned*)(lds + MISC_OFF);
    const int wave = __builtin_amdgcn_readfirstlane((int)threadIdx.x >> 6);
#define LANE_NOW() lane_now_asm()
#define TID_NOW() (wave * 64 + LANE_NOW())
    const int G = gridDim.x;
    unsigned char* ws = args.ws;
    gu32* ctl = (gu32*)(ws + WS_CTL);
    const float* x = args.in[0]; const float* cvec = args.in[1]; const float* ada_w = args.in[2]; const float* ada_b = args.in[3];
    const float* g_pre = args.in[4]; const float* g_post = args.in[5];
    float* out = args.out;
    float* mod = (float*)(ws + WS_MOD); float* lamp = (float*)(ws + WS_LAM); float* lb16 = (float*)(ws + WS_LB16);
    bf16_t* Win0 = (bf16_t*)(ws + WS_WIN0); bf16_t* Wglu = (bf16_t*)(ws + WS_WGLU); bf16_t* Wout0 = (bf16_t*)(ws + WS_WOUT0); bf16_t* Wkv = (bf16_t*)(ws + WS_WKV);
    bf16_t* Win1 = (bf16_t*)(ws + WS_WIN1); bf16_t* Wout1 = (bf16_t*)(ws + WS_WOUT1); bf16_t* BtA = (bf16_t*)(ws + WS_BTA); bf16_t* BtB = (bf16_t*)(ws + WS_BTB);
    bf16_t* A0 = (bf16_t*)(ws + WS_S0); bf16_t* US = (bf16_t*)(ws + WS_S1); bf16_t* SZ = (bf16_t*)(ws + WS_S3); bf16_t* YG = (bf16_t*)(ws + WS_S4); float* EB = (float*)(ws + WS_S0);
    bf16_t* Y2 = (bf16_t*)(ws + WS_S0); bf16_t* YO = (bf16_t*)(ws + WS_S1); bf16_t* AKV = (bf16_t*)(ws + WS_S0); bf16_t* AIN1 = (bf16_t*)(ws + WS_S2);
    bf16_t* KB = (bf16_t*)(ws + WS_S3); bf16_t* VB = (bf16_t*)(ws + WS_S4); bf16_t* QB = (bf16_t*)(ws + WS_S5); bf16_t* SZ1 = (bf16_t*)(ws + WS_S6);
    bf16_t* O0 = (bf16_t*)(ws + (H1_AKV ? WS_S1 : WS_S0)); bf16_t* O1 = (bf16_t*)(ws + WS_S1); bf16_t* OG = (bf16_t*)(ws + WS_S2); bf16_t* YO1 = (bf16_t*)(ws + (H1_AKV ? WS_S3 : WS_S0));
    float* HN = (float*)(ws + WS_HN);

    for (int u = TID_NOW(); u < (LDS_BYTES - LDSCTL_OFF) / 4; u += NWAVES * 64) ((LAS unsigned*)(lds + LDSCTL_OFF))[u] = 0u;
    __syncthreads();
    XcdBarrier bar; bar.bar = (unsigned*)(ctl + CW_BAR); bar.x = 0; bar.st = nullptr;

#if CLK_PROBE
    unsigned long long pc0_ = 0, pr0_ = 1, pc1_ = 0, pr1_ = 2;
#endif
    bool xcl = false; int bx = blockIdx.x; unsigned px = 0;
    if (args.use_bar) {
        bar = xcd_barrier_post((unsigned*)(ctl + CW_BAR), MISC + 8, TID_NOW());
        if (XCC_LOCAL && G == 256) {
            if (TID_NOW() == 0) { unsigned nloc_, nx_; xcd_barrier_complete(bar.bar, bar.x, nloc_, nx_); bool uni = (nx_ == 8u);
                for (unsigned j = 0; j < 8; ++j) uni = uni && (xb_ld(&bar.bar[XB_XCNT(j)]) == 32u);
                MISC[8] = nloc_; MISC[9] = nx_; MISC[13] = uni ? 1u : 0u; }
            __syncthreads();
            xcl = (__builtin_amdgcn_readfirstlane((int)MISC[13]) != 0); px = bar.x;
            if (xcl) bx = __builtin_amdgcn_readfirstlane((int)MISC[12]) * 8 + (int)px;
        }
    }
    const int vcu = (G % 8 == 0) ? (bx % 8) * (G / 8) + bx / 8 : bx;
    const int rankx = bx >> 3;
    unsigned* lbar = (unsigned*)(ctl + CW_BAR) + XCD_BAR_WORDS;
    const int lo = args.ph_lo, hi = args.ph_hi;
#define IN(k) (lo <= (k) && (k) < hi)
#define REPS(k) (1 + ((REPEAT_MASK >> (k)) & 1))
#define SEAM(k) do { if (IN(k) && IN((k) + 1) && args.use_bar) { if ((k) == 0 || !xcl) xcd_barrier(bar, TID_NOW()); else xcc_barrier(lbar, px, 32u, TID_NOW()); } } while (0)
    const int gw = vcu * NWAVES + wave, NGW = G * NWAVES;
    const int egw = xcl ? rankx * NWAVES + wave : gw, engw = xcl ? 32 * NWAVES : NGW, eb_lo = xcl ? (int)px : 0, eb_hi = xcl ? (int)px + 1 : NB;
#define LANE_L() ({ int l_ = LANE_NOW(); asm volatile("" : "+v"(l_)); l_; })

    if (IN(0)) for (int rep_ = 0; rep_ < REPS(0); ++rep_) {
        const int tid = TID_NOW(), lane = tid & 63;
        for (int it = vcu; it < NGRP * 4; it += G) {
            const int g = it >> 2, qt = it & 3;
            LAS float* LBP = (LAS float*)(lds + RING_OFF);
            LAS float* BBR = LBP + 17 * 128;
            LAS float* CC = BBR + 64 * 32;
            LAS float* KM = CC + 16 * 130 + 12;
            __syncthreads();
            if (tid < 64) {
                const int p = tid;
                const float dt = expf(args.in[9][g]);
                const float lr = args.in[7][g * 64 + p], li = args.in[8][g * 64 + p];
                const float mag = expf(lr * dt); const float sn = sinf(li * dt), cs = cosf(li * dt);
                const float lbr = mag * cs, lbi = mag * sn;
                float pr = 1.f, pi = 0.f;
                for (int d = 0; d <= 16; ++d) { LBP[(d * 64 + p) * 2] = pr; LBP[(d * 64 + p) * 2 + 1] = pi; const float nr = pr * lbr - pi * lbi, ni = pr * lbi + pi * lbr; pr = nr; pi = ni; }
                if (qt == 0) { lb16[(g * 64 + p) * 2] = LBP[(16 * 64 + p) * 2]; lb16[(g * 64 + p) * 2 + 1] = LBP[(16 * 64 + p) * 2 + 1]; }
                const float nr = lbr - 1.0f, ni = lbi, den = lr * lr + li * li;
                const float cr = (nr * lr + ni * li) / den, ci = (ni * lr - nr * li) / den;
                for (int c = 0; c < 16; ++c) { const float br = args.in[10][(g * 64 + p) * 16 + c], bi = args.in[11][(g * 64 + p) * 16 + c];
                    BBR[(p * 16 + c) * 2] = cr * br - ci * bi; BBR[(p * 16 + c) * 2 + 1] = cr * bi + ci * br; }
            }
            for (int e = tid; e < 1024; e += 512) { const int co = e >> 6, p = e & 63; CC[(co * 65 + p) * 2] = args.in[12][(g * 16 + co) * 64 + p]; CC[(co * 65 + p) * 2 + 1] = args.in[13][(g * 16 + co) * 64 + p]; }
            __syncthreads();
            {
                const int pair = tid >> 1, hh = tid & 1, d = pair >> 4, co = pair & 15; float acc8[8];
#pragma unroll
                for (int j = 0; j < 8; ++j) acc8[j] = 0.f;
                for (int p = 0; p < 64; ++p) { const float cr = CC[(co * 65 + p) * 2], cim = CC[(co * 65 + p) * 2 + 1], lr = LBP[(d * 64 + p) * 2], lim = LBP[(d * 64 + p) * 2 + 1];
                    const float wr_ = cr * lr - cim * lim, wi_ = cr * lim + cim * lr; const LAS f32x4_t* bp = (const LAS f32x4_t*)(BBR + (p * 16 + 8 * hh) * 2);
#pragma unroll
                    for (int q4 = 0; q4 < 4; ++q4) { const f32x4_t bb = bp[q4]; acc8[2 * q4] += wr_ * bb.x - wi_ * bb.y; acc8[2 * q4 + 1] += wr_ * bb.z - wi_ * bb.w; } }
#pragma unroll
                for (int j = 0; j < 8; ++j) KM[(d * 16 + co) * 16 + 8 * hh + j] = acc8[j] + ((SSM_DFOLD && d == 0 && co == 8 * hh + j) ? args.in[14][g * 16 + co] : 0.f);
            }
            __syncthreads();
            for (int e = tid; e < 64 * 48; e += 512) {
                const int n = 64 * qt + e / 48, pc = e % 48, s = n >> 4, co = n & 15; float v[8];
                if (pc < 32) { const int s2 = pc >> 1, ci0 = (pc & 1) * 8;
#pragma unroll
                    for (int j = 0; j < 8; ++j) v[j] = (s2 <= s) ? KM[((s - s2) * 16 + co) * 16 + ci0 + j] : 0.f;
                } else { const int j0 = (pc - 32) * 8;
#pragma unroll
                    for (int jj = 0; jj < 4; ++jj) { const int p = (j0 >> 1) + jj; const float cr = CC[(co * 65 + p) * 2], cim = CC[(co * 65 + p) * 2 + 1], lr = LBP[((s + 1) * 64 + p) * 2], lim = LBP[((s + 1) * 64 + p) * 2 + 1];
                        v[2 * jj] = cr * lr - cim * lim; v[2 * jj + 1] = -(cr * lim + cim * lr); } }
                v4u o; o.x = pk2bf(v[0], v[1]); o.y = pk2bf(v[2], v[3]); o.z = pk2bf(v[4], v[5]); o.w = pk2bf(v[6], v[7]);
                *(GAS v4u*)(BtB + ((size_t)g * 256 + n) * 384 + pc * 8) = o; }
            for (int e = tid; e < 64 * 32; e += 512) {
                const int n = 64 * qt + (e >> 5), pc = e & 31; float v[8];
                if (n < 128) { const int p = n >> 1, ri = n & 1, s2 = pc >> 1, ci0 = (pc & 1) * 8; const float lr = LBP[((15 - s2) * 64 + p) * 2], lim = LBP[((15 - s2) * 64 + p) * 2 + 1];
#pragma unroll
                    for (int j = 0; j < 8; ++j) { const float br = BBR[(p * 16 + ci0 + j) * 2], bi = BBR[(p * 16 + ci0 + j) * 2 + 1]; v[j] = ri ? (lr * bi + lim * br) : (lr * br - lim * bi); }
                } else {
#pragma unroll
                    for (int j = 0; j < 8; ++j) v[j] = 0.f; }
                v4u o; o.x = pk2bf(v[0], v[1]); o.y = pk2bf(v[2], v[3]); o.z = pk2bf(v[4], v[5]); o.w = pk2bf(v[6], v[7]);
                *(GAS v4u*)(BtA + ((size_t)g * 256 + n) * 256 + pc * 8) = o; }
        }
        __syncthreads();
        {
            LAS float* scr = (LAS float*)(lds + RING_OFF + wave * 16384);
            constexpr int I_2K = (DM / 64) * (2048 / 32), I_1K = (DM / 64) * (1024 / 32);
            constexpr int NITEMS = 2 * I_2K + 5 * I_1K;
            for (int it = gw; it < NITEMS; it += NGW) {
                int r = it;
                if (r < I_2K) { p0_transpose_item(args.in[6], DM, 2048, Win0, 0, nullptr, scr, r, lane); continue; } r -= I_2K;
                if (r < I_2K) { p0_transpose_item(args.in[21], DM, 2048, Win1, 0, nullptr, scr, r, lane); continue; } r -= I_2K;
                if (r < I_1K) { p0_transpose_item(args.in[15], DM, 1024, Wglu, 0, nullptr, scr, r, lane); continue; } r -= I_1K;
                if (r < I_1K) { p0_transpose_item(args.in[17], DM, 1024, Wout0, 0, nullptr, scr, r, lane); continue; } r -= I_1K;
                if (r < I_1K) { p0_transpose_item(args.in[19], DM, 1024, Wkv, 0, args.in[18], scr, r, lane); continue; } r -= I_1K;
                if (r < I_1K) { p0_transpose_item(args.in[20], DM, 1024, Wkv, 1024, args.in[18], scr, r, lane); continue; } r -= I_1K;
                p0_transpose_item(args.in[27], DM, 1024, Wout1, 0, nullptr, scr, r, lane);
            }
        }
        if (!(args.flags & 1)) {
            __syncthreads();
            LAS float* sc = (LAS float*)(lds + RING_OFF);
            LAS float* red = sc + 8192;
            bool have = false;
            for (int it = vcu; it < 2 * 96; it += G) {
                if (!have) { for (int e = tid; e < 8192; e += 512) sc[e] = silu_f(cvec[e]); have = true; __syncthreads(); }
                const int l = it / 96, cc = it % 96, j = cc * 32 + (lane & 31), kh = lane >> 5;
                float acc[8];
#pragma unroll
                for (int b = 0; b < 8; ++b) acc[b] = 0.f;
                const float* wp = ada_w + ((size_t)l * 1024 + wave * 128 + kh) * 3072 + j;
                for (int k0 = 0; k0 < 64; k0 += 32) {
                    float w[32];
#pragma unroll
                    for (int kk = 0; kk < 32; ++kk) w[kk] = NT_LD(wp + (size_t)(2 * (k0 + kk)) * 3072);
#pragma unroll
                    for (int kk = 0; kk < 32; ++kk) {
#pragma unroll
                        for (int b = 0; b < 8; ++b) acc[b] += w[kk] * sc[b * 1024 + wave * 128 + 2 * (k0 + kk) + kh];
                        if ((kk & 3) == 3) asm volatile("" ::: "memory"); }
                }
#pragma unroll
                for (int b = 0; b < 8; ++b) { acc[b] += __shfl_xor(acc[b], 32); if (lane < 32) red[(wave * 8 + b) * 32 + lane] = acc[b]; }
                __syncthreads();
                if (tid < 256) { const int b = tid >> 5, jl = tid & 31; float sum = ada_b[l * 3072 + cc * 32 + jl];
#pragma unroll
                  for (int w = 0; w < 8; ++w) sum += red[(w * 8 + b) * 32 + jl];
                  mod[((size_t)(l * 8 + b)) * 3072 + cc * 32 + jl] = sum; }
                __syncthreads();
            }
            if (bx == 0 && tid == 0) lamp[0] = diff_lambda(args.in[22], args.in[23], args.in[24], args.in[25]);
        }
    }
    SEAM(0);
    if (IN(1)) for (int rep_ = 0; rep_ < REPS(1); ++rep_) e_norm0_b(x, mod, g_pre, A0, egw, engw, LANE_L(), eb_lo, eb_hi);
    SEAM(1);
#ifdef EXTRA_BARS
    if (args.use_bar) for (int eb = 0; eb < EXTRA_BARS; ++eb) xcd_barrier(bar, TID_NOW());
#endif
    if (IN(2)) for (int rep_ = 0; rep_ < REPS(2); ++rep_) {
        pg8::Gemm g = pg8::gemm_std(A0, DM, Win0, DM, DM); pg8::Order S; S.init(MTOK / 256, 2048 / 256, 1, G, bx);
        pg8::EpiRow8<pg8::F_In0> E{{US, SZ}};
        pg8::gemm_phase<pg8::EpiRow8<pg8::F_In0>, ALIGN_E>(lds + RING_OFF, g, S, E, TID_NOW());
    }
    SEAM(2);
#if SSM_FUSED
    if (IN(3)) {
        pg8::Gemm gA = pg8::gemm_std(US, US_P, BtA, 256, 256); gA.a_gstep = (size_t)NTILE * US_P * 2; gA.b_gstep = (size_t)256 * 256 * 2;
        pg8::Gemm gB = pg8::gemm_std(US, US_P, BtB, 384, 384); gB.a_gstep = (size_t)NTILE * US_P * 2; gB.b_gstep = (size_t)256 * 384 * 2;
        pg8::EpiScan ES{lb16, US, LDSCTL_OFF + 2048};
#if SSM_DFOLD
        pg8::EpiRow8<pg8::F_SsmB0> EB2{{YG}};
#else
        pg8::EpiRow8<pg8::F_SsmB> EB2{{US, args.in[14], YG}};
#endif
        for (int uu = 0; xcl ? (uu * 32 + rankx < NGRP) : ((long)uu * G + bx < NGRP * NB); ++uu) {
            pg8::Order S; if (xcl) { S.init(1, 1, NGRP, 32, rankx); S.pm_off = (int)px; } else S.init(NTILE / 256, 1, NGRP, G, bx); S.only = uu;
            pg8::gemm_phase<pg8::EpiScan, false>(lds + RING_OFF, gA, S, ES, TID_NOW());
#if SSM_DFOLD
            pg8::gemm_phase<pg8::EpiRow8<pg8::F_SsmB0>, false>(lds + RING_OFF, gB, S, EB2, TID_NOW());
#else
            pg8::gemm_phase<pg8::EpiRow8<pg8::F_SsmB>, false>(lds + RING_OFF, gB, S, EB2, TID_NOW());
#endif
        }
    }
    SEAM(5);
#else
    if (IN(3)) for (int rep_ = 0; rep_ < REPS(3); ++rep_) {
        pg8::Gemm g = pg8::gemm_std(US, US_P, BtA, 256, 256); g.a_gstep = (size_t)NTILE * US_P * 2; g.b_gstep = (size_t)256 * 256 * 2;
        pg8::Order S; S.init(NTILE / 256, 1, NGRP, G, bx);
        pg8::EpiRow8<pg8::F_SsmA> E{{EB}};
        pg8::gemm_phase<pg8::EpiRow8<pg8::F_SsmA>, ALIGN_E>(lds + RING_OFF, g, S, E, TID_NOW());
    }
    SEAM(3);
    if (IN(4)) for (int rep_ = 0; rep_ < REPS(4); ++rep_) {
        for (int it = vcu + G * wave; it < NB * NGRP; it += G * NWAVES) {
            const int b = it / NGRP, g = it % NGRP, p = LANE_L();
            const float lr = lb16[(g * 64 + p) * 2], li = lb16[(g * 64 + p) * 2 + 1];
            float sr = 0.f, si = 0.f;
            const float* ep = EB + ((size_t)g * NTILE + b * 256) * 128 + 2 * p;
            bf16_t* sp = US + us_off(g, b * 256, 256 + 2 * p);
            for (int t0 = 0; t0 < 256; t0 += 16) {
                float er[16], ei[16];
#pragma unroll
                for (int j = 0; j < 16; ++j) { const float2 e = *(const float2*)(ep + (size_t)(t0 + j) * 128); er[j] = e.x; ei[j] = e.y; }
#pragma unroll
                for (int j = 0; j < 16; ++j) { *(unsigned*)(sp + (size_t)(t0 + j) * US_P) = pk2bf(sr, si);
                    const float nr = lr * sr - li * si + er[j], ni = lr * si + li * sr + ei[j]; sr = nr; si = ni; }
            }
        }
    }
    SEAM(4);
    if (IN(5)) for (int rep_ = 0; rep_ < REPS(5); ++rep_) {
        pg8::Gemm g = pg8::gemm_std(US, US_P, BtB, 384, 384); g.a_gstep = (size_t)NTILE * US_P * 2; g.b_gstep = (size_t)256 * 384 * 2;
        pg8::Order S; S.init(NTILE / 256, 1, NGRP, G, bx);
        pg8::EpiRow8<pg8::F_SsmB> E{{US, args.in[14], YG}};
        pg8::gemm_phase<pg8::EpiRow8<pg8::F_SsmB>, ALIGN_E>(lds + RING_OFF, g, S, E, TID_NOW());
    }
    SEAM(5);
#endif
    if (IN(6)) for (int rep_ = 0; rep_ < REPS(6); ++rep_) {
        pg8::Gemm g = pg8::gemm_std(YG, DM, Wglu, DM, DM);
        g.a_rs = 32u; g.a_c16 = (unsigned)((size_t)NTILE * YG_P * 2); g.a_kstep = (size_t)4 * NTILE * YG_P * 2; g.a_tstep = (size_t)256 * 32;
        pg8::Order S; S.init(MTOK / 256, 1024 / 256, 1, G, bx);
        pg8::EpiRow8<pg8::F_Glu> E{{YG, SZ, args.in[16], Y2}};
        pg8::gemm_phase<pg8::EpiRow8<pg8::F_Glu>, ALIGN_E>(lds + RING_OFF, g, S, E, TID_NOW());
    }
    SEAM(6);
#if FUSE_EPI
    if (IN(7)) {
        pg8::Gemm g = pg8::gemm_std(Y2, DM, Wout0, DM, DM);
        for (int half = 0; half < 2; ++half) {
            pg8::Order S; S.init(MTOK / 512, 1024 / 256, 1, G, bx); S.pm_off = half * (MTOK / 512);
            pg8::PanelRms st1{(unsigned*)(ws + WS_XCH), (unsigned*)(ctl + CW_SEAM), (unsigned*)(ctl + CW_TMO), RMS_EPS};
            pg8::PanelRms st2{(unsigned*)(ws + WS_XCH + 1 * MiB), (unsigned*)(ctl + CW_SEAM + SEAM_BANK), (unsigned*)(ctl + CW_TMO), RMS_EPS};
            pg8::EpiMid E{x, out, AKV, AIN1, mod, g_post, g_pre + 1024, st1, st2};
            pg8::gemm_phase<pg8::EpiMid, false>(lds + RING_OFF, g, S, E, TID_NOW());
        }
    }
#else
    if (IN(7)) {
        pg8::Gemm g = pg8::gemm_std(Y2, DM, Wout0, DM, DM); pg8::Order S; S.init(MTOK / 256, 1024 / 256, 1, G, bx);
        pg8::EpiRow8<pg8::F_Plain> E{{YO}};
        pg8::gemm_phase<pg8::EpiRow8<pg8::F_Plain>, ALIGN_E>(lds + RING_OFF, g, S, E, TID_NOW());
    }
    SEAM(7);
    if (IN(8)) { if (H1_BF16) e_mid(x, YO, mod, g_post, g_pre, (float*)nullptr, YO, AKV, AIN1, gw, NGW, LANE_L()); else e_mid_b(x, YO, mod, g_post, g_pre, (H1_RECOMP || H1_AKV) ? (float*)nullptr : out, AKV, AIN1, egw, engw, LANE_L(), H1_AKV ? HN : (float*)nullptr, eb_lo, eb_hi); }
#endif
    SEAM(8);
    if (IN(9)) for (int rep_ = 0; rep_ < REPS(9); ++rep_) {
        pg8::Gemm g = pg8::gemm_std(AKV, DM, Wkv, DM, DM); g.a_gstep = (size_t)(WS_S2 - WS_S0); g.b_gstep = (size_t)(WS_WIN1 - WS_WKV);
        pg8::Order S; S.init(MTOK / 256, 2048 / 256, 2, G, bx); S.mode2 = (G == 256);
        pg8::EpiRow8<pg8::F_Split2> E{{{KB, QB}, {VB, SZ1}}};
        pg8::gemm_phase<pg8::EpiRow8<pg8::F_Split2>, ALIGN_E>(lds + RING_OFF, g, S, E, TID_NOW());
    }
    SEAM(9);
#if CLK_PROBE
#define CLK_T0(k) do { if ((k) == CLK_PROBE) { pc0_ = __builtin_amdgcn_s_memtime(); pr0_ = __builtin_amdgcn_s_memrealtime(); } } while (0)
#define CLK_T1(k) do { if ((k) == CLK_PROBE) { pc1_ = __builtin_amdgcn_s_memtime(); pr1_ = __builtin_amdgcn_s_memrealtime(); } } while (0)
#else
#define CLK_T0(k) do {} while (0)
#define CLK_T1(k) do {} while (0)
#endif
    CLK_T0(10);
    if (IN(10)) {
#if ATTN_V128
#if ATTN_FUSE_POST
        { const float lam = __int_as_float(__builtin_amdgcn_readfirstlane(__float_as_int(lamp[0])));
          attn_body::bf16x8 qr[4]; bool primed = false;
#if ATTN_PRIO
          if (wave >= 4) __builtin_amdgcn_s_setprio(1);
#endif
          const int nun = (64 * 16 - vcu + G - 1) / G;
#pragma unroll 1
          for (int su = 0; su < 2 * nun; ++su) {
            const int i = su >> 1, cc = su & 1;
            const long L = (long)i * G + vcu; const int pr = (int)(L % 256), qi = (int)(L / 256);
            const int bh = pr >> 2, j = pr & 3; const int qb = (qi & 1) ? (8 * (qi >> 1) + 7 - j) : (8 * (qi >> 1) + j); const int h = bh & 7, b = bh >> 3;
            const bool has_next = su + 1 < 2 * nun;
            const int i2 = (su + 1) >> 1, cc2 = (su + 1) & 1;
            const long L2 = (long)i2 * G + vcu; const int pr2 = (int)(L2 % 256), qi2 = (int)(L2 / 256);
            const int bh2 = pr2 >> 2, j2 = pr2 & 3; const int qb2 = (qi2 & 1) ? (8 * (qi2 >> 1) + 7 - j2) : (8 * (qi2 >> 1) + j2); const int h2 = bh2 & 7, b2 = bh2 >> 3;
            attn3::attn_unit<8>(TID_NOW(), b, 2 * h + cc, h, qb, QB, KB, VB, O0, (char*)lds_raw + RING_OFF, cc, SZ1, args.in[26], lam, OG, primed, has_next, b2, 2 * h2 + cc2, h2, qb2, qr);
            primed = true;
          }
#if ATTN_PRIO
          __builtin_amdgcn_s_setprio(0);
#endif
          }
#else
        for (int i = 0;; ++i) {
            const long L = (long)i * G + vcu; if (L >= 128 * 16) break;
            const int pr = (int)(L % 256), qi = (int)(L / 256);
            const int combo = pr >> 1, j = pr & 1;
            const int k4 = qi >> 1; const int qb = (qi & 1) ? (4 * k4 + 3 - j) : (4 * k4 + j);
            const int c = combo & 1, h = (combo >> 1) & 7, b = combo >> 4;
            { attn_body::bf16x8 qr_[4]; attn3::attn_unit<8>(TID_NOW(), b, 2 * h + c, h, qb, QB, KB, VB, c ? O1 : O0, (char*)lds_raw + RING_OFF, 0, SZ1, args.in[26], 0.f, OG, false, false, 0, 0, 0, 0, qr_); asm volatile("s_barrier" ::: "memory"); }
        }
#endif
#else
        for (int i = 0;; ++i) {
            const long L = (long)i * G + vcu; if (L >= 256 * 16) break;
            const int combo = (int)(L % 256), qi = (int)(L / 256);
            const int qb = (qi & 1) ? (qi >> 1) : (15 - (qi >> 1));
            const int vh = combo & 1, c = (combo >> 1) & 1, h = (combo >> 2) & 7, b = combo >> 5;
            attn_body::attn_unit<8>(TID_NOW(), b, 2 * h + c, 2 * h + vh, qb, QB, KB, VB, c ? O1 : O0, (char*)lds_raw + RING_OFF);
        }
#endif
    }
    CLK_T1(10);
    SEAM(10);
#if !(ATTN_V128 && ATTN_FUSE_POST)
    if (IN(11)) for (int rep_ = 0; rep_ < REPS(11); ++rep_) e_attn_post(O0, O1, SZ1, args.in[26], lamp[0], OG, gw, NGW, LANE_L());
    SEAM(11);
#endif
#if FUSE_EPI
    if (IN(12)) {
        pg8::Gemm g = pg8::gemm_std(OG, DM, Wout1, DM, DM);
        for (int half = 0; half < 2; ++half) {
            pg8::Order S; S.init(MTOK / 512, 1024 / 256, 1, G, bx); S.pm_off = half * (MTOK / 512);
            pg8::PanelRms st{(unsigned*)(ws + WS_XCH + 2 * MiB), (unsigned*)(ctl + CW_SEAM + 2 * SEAM_BANK), (unsigned*)(ctl + CW_TMO), RMS_EPS};
            pg8::EpiFinal E{out, out, mod + 8 * 3072, g_post + 1024, st};
            pg8::gemm_phase<pg8::EpiFinal, false>(lds + RING_OFF, g, S, E, TID_NOW());
        }
    }
#else
    if (IN(12)) {
        pg8::Gemm g = pg8::gemm_std(OG, DM, Wout1, DM, DM); pg8::Order S; S.init(MTOK / 256, 1024 / 256, 1, G, bx);
        pg8::EpiRow8<pg8::F_Plain> E{{YO1}};
        pg8::gemm_phase<pg8::EpiRow8<pg8::F_Plain>, ALIGN_E>(lds + RING_OFF, g, S, E, TID_NOW());
    }
    SEAM(12);
    if (IN(13)) { if (H1_BF16) e_final_b(YO, out, YO1, mod, g_post, gw, NGW, LANE_L()); else if (H1_AKV) e_final_k(AKV, HN, YO1, out, mod, g_post, egw, engw, LANE_L(), eb_lo, eb_hi); else if (H1_RECOMP) e_final_x(x, YO, YO1, out, mod, g_post, gw, NGW, LANE_L()); else e_final_bm(out, YO1, mod, g_post, gw, NGW, LANE_L()); }
#endif
#if CLK_PROBE
    if (bx == 0 && wave == 0) {
        const float dc_ = (float)(pc1_ - pc0_), dr_ = (float)(pr1_ - pr0_);
#if CLK_MODE == 0
        const unsigned long long spin_ = (unsigned long long)(dc_ * 100.0f / dr_ * 10.0f);
#else
        const unsigned long long spin_ = (unsigned long long)dr_;
#endif
        const unsigned long long t0_ = __builtin_amdgcn_s_memrealtime();
        while (__builtin_amdgcn_s_memrealtime() - t0_ < spin_) __builtin_amdgcn_s_sleep(8);
    }
#endif
#undef IN
#undef SEAM
}

#ifndef FASTMASK
#define FASTMASK 0x3fff
#endif
#ifndef ONE_LAUNCH
#define ONE_LAUNCH 1
#endif
constexpr int NPHASE = 14;

extern "C" void kernel_launch(void* const* d_in, const int* in_sizes, int n_in, void* d_out, int out_size, void* d_ws, size_t ws_size, hipStream_t stream) {
    static int grid = 0;
    if (grid == 0) {
        if (n_in != 28 || out_size != MTOK * DM || ws_size < WS_END) { fprintf(stderr, "kernel_launch: unexpected shapes (n_in %d out %d ws %zu)\n", n_in, out_size, ws_size); grid = -1; return; }
        int dev = 0, cus = 0, per_cu = 0;
        if (hipGetDevice(&dev) != hipSuccess || hipDeviceGetAttribute(&cus, hipDeviceAttributeMultiprocessorCount, dev) != hipSuccess) { grid = -1; return; }
        if (hipFuncSetAttribute((const void*)mega_fwd, hipFuncAttributeMaxDynamicSharedMemorySize, LDS_BYTES) != hipSuccess) { fprintf(stderr, "kernel_launch: hipFuncSetAttribute failed\n"); grid = -1; return; }
        if (hipOccupancyMaxActiveBlocksPerMultiprocessor(&per_cu, (const void*)mega_fwd, NWAVES * 64, LDS_BYTES) != hipSuccess || per_cu < 1) { fprintf(stderr, "kernel_launch: occupancy query says %d\n", per_cu); }
        (void)hipGetLastError();
        grid = cus;
    }
    if (grid < 0) return;
    if (hipMemsetAsync((char*)d_ws + WS_CTL + (size_t)CW_BAR * 4, 0, (size_t)XCD_BAR_WORDS * 8, stream) != hipSuccess) { fprintf(stderr, "kernel_launch: memset failed\n"); return; }
    Args a{};
    for (int i = 0; i < 28; ++i) a.in[i] = (const float*)d_in[i];
    a.out = (float*)d_out; a.ws = (unsigned char*)d_ws;
#if ONE_LAUNCH
    a.ph_lo = 0; a.ph_hi = NPHASE; a.use_bar = 1; a.flags = 0;
    hipLaunchKernelGGL(mega_fwd, dim3(grid), dim3(NWAVES * 64), LDS_BYTES, stream, a);
#else
    const float* x = a.in[0]; unsigned char* ws = a.ws; float* out = a.out;
    float* mod = (float*)(ws + WS_MOD); float* lam = (float*)(ws + WS_LAM);
    bf16_t* A0 = (bf16_t*)(ws + WS_S0); bf16_t* US = (bf16_t*)(ws + WS_S1); bf16_t* SZ = (bf16_t*)(ws + WS_S3); bf16_t* YG = (bf16_t*)(ws + WS_S4);
    bf16_t* Y2 = (bf16_t*)(ws + WS_S0); bf16_t* YO = (bf16_t*)(ws + WS_S1); bf16_t* AKV = (bf16_t*)(ws + WS_S0); bf16_t* AIN1 = (bf16_t*)(ws + WS_S2);
    bf16_t* KB = (bf16_t*)(ws + WS_S3); bf16_t* VB = (bf16_t*)(ws + WS_S4); bf16_t* QB = (bf16_t*)(ws + WS_S5); bf16_t* SZ1 = (bf16_t*)(ws + WS_S6);
    bf16_t* O0 = (bf16_t*)(ws + WS_S0); bf16_t* O1 = (bf16_t*)(ws + WS_S1); bf16_t* OG = (bf16_t*)(ws + WS_S2); bf16_t* YO1 = (bf16_t*)(ws + WS_S0);
    const int EG = 2048;
    auto fast1 = [&](int lo, int hi, int flags) { a.ph_lo = lo; a.ph_hi = hi; a.use_bar = 0; a.flags = flags; hipLaunchKernelGGL(mega_fwd, dim3(grid), dim3(NWAVES * 64), LDS_BYTES, stream, a); };
    auto fast = [&](int lo, int hi, int flags) { fast1(lo, hi, flags); if (lo == EXTRA_PHASE) fast1(lo, hi, flags); };
    const unsigned FM = FASTMASK;
    if (FM & 1u) fast(0, 1, 0);
    else { fast(0, 1, 1); n_adaln<<<(2 * 8 * 3072 + 255) / 256, 256, 0, stream>>>(a.in[1], a.in[2], a.in[3], mod); n_lambda<<<1, 64, 0, stream>>>(a.in[22], a.in[23], a.in[24], a.in[25], lam); }
    if (FM & 2u) fast(1, 2, 0); else n_norm0<<<EG, 256, 0, stream>>>(x, mod, a.in[4], A0);
    if (FM & 4u) fast(2, 3, 0); else n_gemm<<<dim3(2048 / 64, MTOK / 64), 256, 0, stream>>>(AL_Row{A0}, WL_Plain{a.in[6], 2048}, EP_In0{US, SZ}, 2048);
    if (FM & 8u) { fast(3, 4, 0); fast(4, 5, 0); fast(5, 6, 0); }
    else n_ssm<<<NB * NGRP / 4, 256, 0, stream>>>(US, a.in[7], a.in[8], a.in[9], a.in[10], a.in[11], a.in[12], a.in[13], a.in[14], YG);
    if (FM & 64u) fast(6, 7, 0); else n_gemm<<<dim3(1024 / 64, MTOK / 64), 256, 0, stream>>>(AL_YG{YG}, WL_Plain{a.in[15], 1024}, EP_Glu{YG, SZ, a.in[16], Y2}, 1024);
    if (FM & 128u) fast(7, 8, 0); else n_gemm<<<dim3(1024 / 64, MTOK / 64), 256, 0, stream>>>(AL_Row{Y2}, WL_Plain{a.in[17], 1024}, EP_Plain{YO}, 1024);
    if (FM & 256u) fast(8, 9, 0); else n_mid<<<EG, 256, 0, stream>>>(x, YO, mod, a.in[5], a.in[4], out, AKV, AIN1);
    if (FM & 512u) fast(9, 10, 0);
    else { n_gemm<<<dim3(2048 / 64, MTOK / 64), 256, 0, stream>>>(AL_Row{AKV}, WL_KV{a.in[19], a.in[20], a.in[18]}, EP_KV{KB, VB}, 2048);
           n_gemm<<<dim3(2048 / 64, MTOK / 64), 256, 0, stream>>>(AL_Row{AIN1}, WL_Plain{a.in[21], 2048}, EP_In1{QB, SZ1}, 2048); }
    if (FM & 1024u) fast(10, 11, 0); else n_attn<<<MTOK * 8 / 4, 256, 0, stream>>>(QB, KB, VB, O0, O1);
    if (FM & 2048u) fast(11, 12, 0); else n_attn_post<<<EG, 256, 0, stream>>>(O0, O1, SZ1, a.in[26], lam, OG);
    if (FM & 4096u) fast(12, 13, 0); else n_gemm<<<dim3(1024 / 64, MTOK / 64), 256, 0, stream>>>(AL_Row{OG}, WL_Plain{a.in[27], 1024}, EP_Plain{YO1}, 1024);
    if (FM & 8192u) fast(13, 14, 0); else n_final<<<EG, 256, 0, stream>>>(out, YO1, mod, a.in[5]);
#endif
    const hipError_t le = hipPeekAtLastError();
    if (le != hipSuccess) fprintf(stderr, "kernel_launch: launch failed: %s\n", hipGetErrorName(le));
}
```
